# Optimizing an MI355X kernel written in HIP

```python
import math
import jax, jax.numpy as jnp
from jax import lax
import numpy as np

D_MODEL = 1024
BATCH = 8
SEQ = 2048
DEPTH = 2

ATT_HEADS = 6
HEAD_DIM = 64
ATT_W = ATT_HEADS * HEAD_DIM
ROPE_DIM = HEAD_DIM // 4
ROPE_THETA = 500000.0
MOBA_BLOCK = 256
MOBA_TOPK = 3
Q_BLOCK = 128
SSD_HEADS = 6
SSD_HEAD_DIM = 64
SSD_W = SSD_HEADS * SSD_HEAD_DIM
SSD_GROUPS = 2
SSD_STATE = 128
SSD_CONV = 4
SSD_CHUNK = 128
SSD_CONV_W = SSD_W + 2 * SSD_GROUPS * SSD_STATE
GM_GROUPS = 4
GM_W = 256
GM_CHUNK = 128
D_MIX = ATT_W + SSD_W + GM_W
D_IN = 3 * ATT_W + SSD_W + SSD_CONV_W + SSD_HEADS + 2 * GM_W
D_FF = 2816
N_EXPERTS = 8
TOP_K = 2
D_FF_EXPERT = 3584
N_DENSE = (DEPTH + 1) // 2
N_MOE = DEPTH // 2
ALPHA = (2.0 * DEPTH) ** 0.25
BETA = (8.0 * DEPTH) ** -0.25
NEG = -1e30

kernel_name = "hybrid_moba_ssd_gmlp_moe_deepnorm"


def layer_norm(x, g, b, eps=1e-5):
    xf = x.astype(jnp.float32)
    mu = jnp.mean(xf, -1, keepdims=True)
    var = jnp.mean(jnp.square(xf - mu), -1, keepdims=True)
    return ((xf - mu) * lax.rsqrt(var + eps)).astype(x.dtype) * g + b


def rms_norm(x, g, eps=1e-5):
    xf = x.astype(jnp.float32)
    return (xf * lax.rsqrt(jnp.mean(xf * xf, -1, keepdims=True) + eps)).astype(x.dtype) * g


def rope_tables(positions):
    inv = ROPE_THETA ** (-jnp.arange(0, ROPE_DIM, 2, dtype=jnp.float32) / ROPE_DIM)
    ang = positions.astype(jnp.float32)[..., None] * inv
    return jnp.cos(ang), jnp.sin(ang)


def apply_partial_rope(x, cos, sin):
    xr, xp = x[..., :ROPE_DIM], x[..., ROPE_DIM:]
    x1, x2 = jnp.split(xr, 2, axis=-1)
    c = cos[:, :, None, :].astype(x.dtype)
    s = sin[:, :, None, :].astype(x.dtype)
    return jnp.concatenate([x1 * c - x2 * s, x2 * c + x1 * s, xp], axis=-1)


def moba_attention(q, k, v):
    B_, S, H, D = q.shape
    nb = -(-S // MOBA_BLOCK)
    pad = nb * MOBA_BLOCK - S
    qh = q.transpose(0, 2, 1, 3)
    kh = jnp.pad(k.transpose(0, 2, 1, 3), ((0, 0), (0, 0), (0, pad), (0, 0)))
    vh = jnp.pad(v.transpose(0, 2, 1, 3), ((0, 0), (0, 0), (0, pad), (0, 0)))
    kb = kh.reshape(B_, H, nb, MOBA_BLOCK, D)
    vb = vh.reshape(B_, H, nb, MOBA_BLOCK, D)
    k_mean = jnp.mean(kb, axis=3)
    gate = jnp.einsum('bhsd,bhnd->bhsn', qh, k_mean).astype(jnp.float32)
    q_blk = jnp.arange(S) // MOBA_BLOCK
    past = jnp.arange(nb)[None, :] < q_blk[:, None]
    gate = jnp.where(past, gate, NEG)
    k_sel = min(MOBA_TOPK, nb)
    top_val, top_idx = lax.top_k(gate, k_sel)
    top_ok = top_val > NEG / 2

    nq = S // Q_BLOCK
    def to_blocks(t):
        return t.reshape(B_, H, nq, Q_BLOCK, *t.shape[3:]).swapaxes(1, 2).reshape(B_ * nq, H, Q_BLOCK, *t.shape[3:])
    qs, idx, ok = to_blocks(qh), to_blocks(top_idx), to_blocks(top_ok)
    flat = jnp.arange(B_ * nq, dtype=jnp.int32)
    b_ids, qb_ids = flat // nq, flat % nq
    scale = D ** -0.5
    causal_in_block = None

    def one_block(args):
        qi, idx_i, ok_i, b, j = args
        kb_b, vb_b = kb[b], vb[b]
        k_g = jax.vmap(lambda kk, ii: kk[ii])(kb_b, idx_i)
        v_g = jax.vmap(lambda vv, ii: vv[ii])(vb_b, idx_i)
        s_sel = jnp.einsum('hqd,hqkld->hqkl', qi, k_g).astype(jnp.float32) * scale
        s_sel = jnp.where(ok_i[..., None], s_sel, NEG)
        q_pos = j * Q_BLOCK + jnp.arange(Q_BLOCK)
        own = (j * Q_BLOCK) // MOBA_BLOCK
        k_own, v_own = kb_b[:, own], vb_b[:, own]
        k_pos = own * MOBA_BLOCK + jnp.arange(MOBA_BLOCK)
        s_own = jnp.einsum('hqd,hld->hql', qi, k_own).astype(jnp.float32) * scale
        s_own = jnp.where(k_pos[None, :] <= q_pos[:, None], s_own, NEG)
        s = jnp.concatenate([s_sel.reshape(H, Q_BLOCK, k_sel * MOBA_BLOCK), s_own], axis=-1)
        p = jax.nn.softmax(s, axis=-1).astype(qi.dtype)
        p_sel = p[..., :k_sel * MOBA_BLOCK].reshape(H, Q_BLOCK, k_sel, MOBA_BLOCK)
        p_own = p[..., k_sel * MOBA_BLOCK:]
        return jnp.einsum('hqkl,hqkld->hqd', p_sel, v_g) + jnp.einsum('hql,hld->hqd', p_own, v_own)

    out = lax.map(one_block, (qs, idx, ok, b_ids, qb_ids))
    return out.reshape(B_, nq, H, Q_BLOCK, D).transpose(0, 1, 3, 2, 4).reshape(B_, S, H * D)


def causal_depthwise_conv(x, w, b):
    K, C = w.shape
    y = lax.conv_general_dilated(x, w[:, None, :].astype(x.dtype), window_strides=(1,), padding=[(K - 1, 0)],
                                 dimension_numbers=('NWC', 'WIO', 'NWC'), feature_group_count=C)
    return y + b


def ssd_chunked(x, dt, A, Bm, Cm):
    in_dtype = x.dtype
    B_, S, H, P = x.shape
    nc = S // SSD_CHUNK
    rep = H // SSD_GROUPS
    xf = x.astype(jnp.float32)
    Bh = jnp.repeat(Bm.astype(jnp.float32), rep, axis=2)
    Ch = jnp.repeat(Cm.astype(jnp.float32), rep, axis=2)
    xdt = xf * dt[..., None]
    a = dt * A.astype(jnp.float32)
    def ch(t):
        return t.reshape(B_, nc, SSD_CHUNK, *t.shape[2:])
    xdt, Bh, Ch = ch(xdt), ch(Bh), ch(Ch)
    a_cum = jnp.cumsum(ch(a).transpose(0, 3, 1, 2), axis=-1)
    causal = jnp.tril(jnp.ones((SSD_CHUNK, SSD_CHUNK), bool))
    seg = a_cum[..., :, None] - a_cum[..., None, :]
    Lmat = jnp.exp(jnp.where(causal, seg, -jnp.inf))
    CB = jnp.einsum('bclhn,bcshn->bhcls', Ch, Bh)
    y_diag = jnp.einsum('bhcls,bcshp->bclhp', CB * Lmat, xdt)
    decay_states = jnp.exp(a_cum[..., -1:] - a_cum)
    states = jnp.einsum('bclhn,bhcl,bclhp->bchpn', Bh, decay_states, xdt)
    chunk_decay = jnp.exp(a_cum[..., -1])

    def step(hs, inp):
        st, dec = inp
        return hs * dec[..., None, None] + st, hs

    h0 = jnp.zeros((B_, H, P, SSD_STATE), jnp.float32)
    _, prev = lax.scan(step, h0, (states.transpose(1, 0, 2, 3, 4), chunk_decay.transpose(2, 0, 1)))
    prev = prev.transpose(1, 0, 2, 3, 4)
    y_off = jnp.einsum('bclhn,bchpn,bhcl->bclhp', Ch, prev, jnp.exp(a_cum))
    return (y_diag + y_off).reshape(B_, S, H, P).astype(in_dtype)


def ssd_mixer(z, xbc, dt_raw, conv_w, conv_b, dt_bias, a_log, d_skip, norm_g):
    B_, S, _ = z.shape
    xbc = jax.nn.silu(causal_depthwise_conv(xbc, conv_w, conv_b))
    xs, Bm, Cm = jnp.split(xbc, [SSD_W, SSD_W + SSD_GROUPS * SSD_STATE], axis=-1)
    xs = xs.reshape(B_, S, SSD_HEADS, SSD_HEAD_DIM)
    Bm = Bm.reshape(B_, S, SSD_GROUPS, SSD_STATE)
    Cm = Cm.reshape(B_, S, SSD_GROUPS, SSD_STATE)
    dt = jax.nn.softplus(dt_raw.astype(jnp.float32) + dt_bias.astype(jnp.float32))
    A = -jnp.exp(a_log.astype(jnp.float32))
    y = ssd_chunked(xs, dt, A, Bm, Cm) + d_skip[:, None] * xs
    yz = (y.reshape(B_, S, SSD_W) * jax.nn.silu(z)).astype(jnp.float32)
    yg = yz.reshape(B_, S, SSD_GROUPS, SSD_W // SSD_GROUPS)
    yg = yg * lax.rsqrt(jnp.mean(yg * yg, -1, keepdims=True) + 1e-5)
    return yg.reshape(B_, S, SSD_W).astype(z.dtype) * norm_g


def gmlp_sgu(u, v, ln_g, ln_b, w_s, b_s):
    B_, S, _ = v.shape
    nc = S // GM_CHUNK
    v = layer_norm(v, ln_g, ln_b)
    vc = v.reshape(B_, nc, GM_CHUNK, GM_GROUPS, GM_W // GM_GROUPS)
    w = jnp.where(jnp.tril(jnp.ones((GM_CHUNK, GM_CHUNK), bool)), w_s, 0.0)
    mixed = jnp.einsum('gts,bcsgd->bctgd', w.astype(v.dtype), vc) + b_s.T[None, None, :, :, None]
    return u * mixed.reshape(B_, S, GM_W)


def hybrid_mixer(h, cos, sin, w_in, conv_w, conv_b, dt_bias, a_log, d_skip, ssd_norm_g, att_norm_g,
                 gm_ln_g, gm_ln_b, gm_w_s, gm_b_s, gm_norm_g, w_out):
    B_, S, _ = h.shape
    proj = h @ w_in
    c1 = ATT_W
    c2 = 2 * ATT_W
    c3 = 3 * ATT_W
    c4 = c3 + SSD_W
    c5 = c4 + SSD_CONV_W
    c6 = c5 + SSD_HEADS
    c7 = c6 + GM_W
    q, k, v, z, xbc, dt_raw, gu, gv = jnp.split(proj, [c1, c2, c3, c4, c5, c6, c7], axis=-1)
    q = apply_partial_rope(q.reshape(B_, S, ATT_HEADS, HEAD_DIM), cos, sin)
    k = apply_partial_rope(k.reshape(B_, S, ATT_HEADS, HEAD_DIM), cos, sin)
    v = v.reshape(B_, S, ATT_HEADS, HEAD_DIM)
    att = rms_norm(moba_attention(q, k, v), att_norm_g)
    ssd = ssd_mixer(z, xbc, dt_raw, conv_w, conv_b, dt_bias, a_log, d_skip, ssd_norm_g)
    gm = rms_norm(gmlp_sgu(jax.nn.gelu(gu), jax.nn.gelu(gv), gm_ln_g, gm_ln_b, gm_w_s, gm_b_s), gm_norm_g)
    return jnp.concatenate([att, ssd, gm], axis=-1) @ w_out


def swiglu(h, w_gate, w_up, w_down):
    return (jax.nn.silu(h @ w_gate) * (h @ w_up)) @ w_down


def moe_ffn(h, w_router, e_gate, e_up, e_down):
    logits = (h @ w_router).astype(jnp.float32)
    top_val, top_idx = lax.top_k(logits, TOP_K)
    probs = jax.nn.softmax(top_val, axis=-1)
    gates = jnp.sum(jax.nn.one_hot(top_idx, N_EXPERTS, dtype=jnp.float32) * probs[..., None], axis=-2)
    gates = gates.astype(h.dtype)
    out = jnp.zeros_like(h)
    for e in range(N_EXPERTS):
        out = out + gates[..., e:e + 1] * swiglu(h, e_gate[e], e_up[e], e_down[e])
    return out


def setup_inputs(seed: int = 0) -> dict:
    key = jax.random.key(seed)
    ks = jax.random.split(key, 32)
    f32 = jnp.float32

    def nrm(k, shape, scale):
        return jax.random.normal(k, shape, f32) * scale

    def gain(k, shape):
        return 1.0 + 0.01 * jax.random.normal(k, shape, f32)

    x = nrm(ks[0], (BATCH, SEQ, D_MODEL), 1.0)
    positions = jnp.broadcast_to(jnp.arange(SEQ, dtype=jnp.int32), (BATCH, SEQ))
    ln_in_g = gain(ks[1], (D_MODEL,))
    ln_in_b = nrm(ks[2], (D_MODEL,), 0.01)
    col_scale = jnp.concatenate([jnp.ones((2 * ATT_W,), f32), jnp.full((ATT_W,), BETA, f32),
                                 jnp.ones((D_IN - 3 * ATT_W,), f32)])
    w_in = nrm(ks[3], (DEPTH, D_MODEL, D_IN), D_MODEL ** -0.5) * col_scale
    conv_w = nrm(ks[4], (DEPTH, SSD_CONV, SSD_CONV_W), SSD_CONV ** -0.5)
    conv_b = nrm(ks[5], (DEPTH, SSD_CONV_W), 0.01)
    dt0 = jnp.exp(jax.random.uniform(ks[6], (DEPTH, SSD_HEADS), f32, math.log(1e-3), math.log(1e-1)))
    dt_bias = dt0 + jnp.log(-jnp.expm1(-dt0))
    a_log = jnp.log(jax.random.uniform(ks[7], (DEPTH, SSD_HEADS), f32, 1.0, 16.0))
    d_skip = gain(ks[8], (DEPTH, SSD_HEADS))
    ssd_norm_g = gain(ks[9], (DEPTH, SSD_W))
    att_norm_g = gain(ks[10], (DEPTH, ATT_W))
    gm_ln_g = gain(ks[11], (DEPTH, GM_W))
    gm_ln_b = nrm(ks[12], (DEPTH, GM_W), 0.01)
    gm_w_s = nrm(ks[13], (DEPTH, GM_GROUPS, GM_CHUNK, GM_CHUNK), GM_CHUNK ** -0.5)
    gm_b_s = gain(ks[14], (DEPTH, GM_GROUPS, GM_CHUNK))
    gm_norm_g = gain(ks[15], (DEPTH, GM_W))
    w_out = nrm(ks[16], (DEPTH, D_MIX, D_MODEL), D_MIX ** -0.5 * BETA)
    ln1_g = gain(ks[17], (DEPTH, D_MODEL))
    ln1_b = nrm(ks[18], (DEPTH, D_MODEL), 0.01)
    ln2_g = gain(ks[19], (DEPTH, D_MODEL))
    ln2_b = nrm(ks[20], (DEPTH, D_MODEL), 0.01)
    ffn_w_gate = nrm(ks[21], (N_DENSE, D_MODEL, D_FF), D_MODEL ** -0.5)
    ffn_w_up = nrm(ks[22], (N_DENSE, D_MODEL, D_FF), D_MODEL ** -0.5)
    ffn_w_down = nrm(ks[23], (N_DENSE, D_FF, D_MODEL), D_FF ** -0.5 * BETA)
    router_w = nrm(ks[24], (N_MOE, D_MODEL, N_EXPERTS), D_MODEL ** -0.5)
    moe_w_gate = nrm(ks[25], (N_MOE, N_EXPERTS, D_MODEL, D_FF_EXPERT), D_MODEL ** -0.5)
    moe_w_up = nrm(ks[26], (N_MOE, N_EXPERTS, D_MODEL, D_FF_EXPERT), D_MODEL ** -0.5)
    moe_w_down = nrm(ks[27], (N_MOE, N_EXPERTS, D_FF_EXPERT, D_MODEL), D_FF_EXPERT ** -0.5 * BETA)
    return {"x": x, "positions": positions, "ln_in_g": ln_in_g, "ln_in_b": ln_in_b, "w_in": w_in,
            "conv_w": conv_w, "conv_b": conv_b, "dt_bias": dt_bias, "a_log": a_log, "d_skip": d_skip,
            "ssd_norm_g": ssd_norm_g, "att_norm_g": att_norm_g, "gm_ln_g": gm_ln_g, "gm_ln_b": gm_ln_b,
            "gm_w_s": gm_w_s, "gm_b_s": gm_b_s, "gm_norm_g": gm_norm_g, "w_out": w_out,
            "ln1_g": ln1_g, "ln1_b": ln1_b, "ln2_g": ln2_g, "ln2_b": ln2_b,
            "ffn_w_gate": ffn_w_gate, "ffn_w_up": ffn_w_up, "ffn_w_down": ffn_w_down,
            "router_w": router_w, "moe_w_gate": moe_w_gate, "moe_w_up": moe_w_up, "moe_w_down": moe_w_down}


def reference(x, positions, ln_in_g, ln_in_b, w_in, conv_w, conv_b, dt_bias, a_log, d_skip, ssd_norm_g,
              att_norm_g, gm_ln_g, gm_ln_b, gm_w_s, gm_b_s, gm_norm_g, w_out, ln1_g, ln1_b, ln2_g, ln2_b,
              ffn_w_gate, ffn_w_up, ffn_w_down, router_w, moe_w_gate, moe_w_up, moe_w_down):
    cos, sin = rope_tables(positions)
    h = layer_norm(x, ln_in_g, ln_in_b)
    for i in range(DEPTH):
        mix = hybrid_mixer(h, cos, sin, w_in[i], conv_w[i], conv_b[i], dt_bias[i], a_log[i], d_skip[i],
                           ssd_norm_g[i], att_norm_g[i], gm_ln_g[i], gm_ln_b[i], gm_w_s[i], gm_b_s[i],
                           gm_norm_g[i], w_out[i])
        h = layer_norm(ALPHA * h + mix, ln1_g[i], ln1_b[i])
        if i % 2 == 0:
            f = swiglu(h, ffn_w_gate[i // 2], ffn_w_up[i // 2], ffn_w_down[i // 2])
        else:
            f = moe_ffn(h, router_w[i // 2], moe_w_gate[i // 2], moe_w_up[i // 2], moe_w_down[i // 2])
        h = layer_norm(ALPHA * h + f, ln2_g[i], ln2_b[i])
    return h
```

```cpp
#include <hip/hip_runtime.h>
#include <cstdio>
#include <cstdint>

constexpr int DM = 1024, SEQ = 2048, NBATCH = 8;
constexpr int ATT_H = 6, HD = 64, ATT_W = 384, ROPE_DIM = 16;
constexpr int MOBA_BLOCK = 256, NBLK = SEQ / MOBA_BLOCK;
constexpr int SSD_H = 6, SSD_W = 384, SSD_G = 2, SSD_N = 128, SSD_CW = 896;
constexpr int GM_G = 4, GM_W = 256, GM_CHUNK = 128;
constexpr int D_IN = 2950, D_FF = 2816, N_EXP = 8, D_FFE = 3584;
constexpr float ALPHA = 1.4142135623730951f;
constexpr float NEGF = -1e30f;
constexpr int MAXSLOT = 2 * NBATCH * SEQ + N_EXP * 256;

typedef unsigned short bf16;
__device__ __forceinline__ unsigned f2bf(float f) { unsigned u = __float_as_uint(f); return (u + 0x7fffu + ((u >> 16) & 1u)) >> 16; }
__device__ __forceinline__ float ldf(const float* p) { return *p; }
__device__ __forceinline__ float ldf(const bf16* p) { return __uint_as_float(((unsigned)*p) << 16); }
__device__ __forceinline__ void stf(float* p, float v) { *p = v; }
__device__ __forceinline__ void stf(bf16* p, float v) { *p = (bf16)f2bf(v); }

__device__ __forceinline__ float wave_sum(float v) {
#pragma unroll
    for (int o = 1; o < 64; o <<= 1) v += __shfl_xor(v, o);
    return v;
}
__device__ __forceinline__ float silu_f(float x) { return x / (1.f + __expf(-x)); }
__device__ __forceinline__ float gelu_tanh_f(float x) { const float u = 0.7978845608028654f * (x + 0.044715f * x * x * x); return 0.5f * x * (1.f + tanhf(u)); }
__device__ __forceinline__ float softplus_f(float x) { return fmaxf(x, 0.f) + log1pf(__expf(-fabsf(x))); }

struct ProjL { int ld, q, k, v, z, xbc, dt, gu, gv; };

__device__ __forceinline__ void ln_row(const float* xrow, float a, const float* y1, const float* y2, const float* g, const float* b, float* of, bf16* ob, int lane) {
    float v[16]; float s = 0.f;
#pragma unroll
    for (int j = 0; j < 4; ++j) {
        const float4 x = *(const float4*)(xrow + j * 256 + lane * 4);
        float4 t = make_float4(a * x.x, a * x.y, a * x.z, a * x.w);
        if (y1) { const float4 y = *(const float4*)(y1 + j * 256 + lane * 4); t.x += y.x; t.y += y.y; t.z += y.z; t.w += y.w; }
        if (y2) { const float4 y = *(const float4*)(y2 + j * 256 + lane * 4); t.x += y.x; t.y += y.y; t.z += y.z; t.w += y.w; }
        v[4 * j] = t.x; v[4 * j + 1] = t.y; v[4 * j + 2] = t.z; v[4 * j + 3] = t.w; s += (t.x + t.y) + (t.z + t.w);
    }
    const float mean = wave_sum(s) * (1.f / 1024.f); float s2 = 0.f;
#pragma unroll
    for (int i = 0; i < 16; ++i) { v[i] -= mean; s2 += v[i] * v[i]; }
    const float rstd = rsqrtf(wave_sum(s2) * (1.f / 1024.f) + 1e-5f);
#pragma unroll
    for (int j = 0; j < 4; ++j) {
        const float4 gg = *(const float4*)(g + j * 256 + lane * 4), bb = *(const float4*)(b + j * 256 + lane * 4);
        float4 o = make_float4(v[4 * j] * rstd * gg.x + bb.x, v[4 * j + 1] * rstd * gg.y + bb.y, v[4 * j + 2] * rstd * gg.z + bb.z, v[4 * j + 3] * rstd * gg.w + bb.w);
        *(float4*)(of + j * 256 + lane * 4) = o;
        if (ob) { uint2 w; w.x = f2bf(o.x) | (f2bf(o.y) << 16); w.y = f2bf(o.z) | (f2bf(o.w) << 16); *(uint2*)(ob + j * 256 + lane * 4) = w; }
    }
}

__device__ __forceinline__ void rope_inplace(float* P, ProjL L, const int* pos, long n_rows, long gt, long ngt) {
    for (long it = gt; it < n_rows * 96; it += ngt) {
        const int i = (int)(it & 7), hh = (int)((it >> 3) % 12); const long row = it / 96;
        const int off = (hh < 6 ? L.q : L.k) + (hh % 6) * 64;
        const float inv = powf(500000.0f, -(float)(2 * i) / 16.0f);
        const float ang = (float)pos[row] * inv;
        const float c = cosf(ang), s = sinf(ang);
        float* p = P + row * L.ld + off;
        const float x1 = p[i], x2 = p[i + 8];
        p[i] = x1 * c - x2 * s; p[i + 8] = x2 * c + x1 * s;
    }
}

template <class T> __device__ __forceinline__ void kmean_phase(const T* P, ProjL L, float* KM, int nb, long gt, long ngt) {
    for (long it = gt; it < (long)nb * ATT_H * NBLK * 64; it += ngt) {
        const int d = (int)(it & 63), n = (int)((it >> 6) % NBLK), h = (int)((it / (64 * NBLK)) % ATT_H), b = (int)(it / (64 * NBLK * ATT_H));
        const T* p = P + ((long)b * SEQ + n * MOBA_BLOCK) * L.ld + L.k + h * 64 + d; float s = 0.f;
        for (int r = 0; r < MOBA_BLOCK; ++r) s += ldf(p + (long)r * L.ld);
        KM[it] = s * (1.f / MOBA_BLOCK);
    }
}

template <class T> __device__ __forceinline__ void attn_naive_phase(const T* P, ProjL L, const float* KM, float* O, int ldo, int nb, int gw, int ngw, int lane) {
    for (long it = gw; it < (long)nb * ATT_H * SEQ; it += ngw) {
        const int q = (int)(it % SEQ), h = (int)((it / SEQ) % ATT_H), b = (int)(it / ((long)SEQ * ATT_H));
        const long row = (long)b * SEQ + q; const int qblk = q / MOBA_BLOCK;
        const float qv = ldf(P + row * L.ld + L.q + h * 64 + lane);
        float g[NBLK];
#pragma unroll
        for (int n = 0; n < NBLK; ++n) { const float t = wave_sum(qv * KM[(((long)b * ATT_H + h) * NBLK + n) * 64 + lane]); g[n] = (n < qblk) ? t : NEGF; }
        unsigned sel = 0u;
#pragma unroll
        for (int r = 0; r < 3; ++r) { float bv = -3.0e38f; int best = -1;
#pragma unroll
            for (int n = 0; n < NBLK; ++n) if (!((sel >> n) & 1u) && g[n] > bv) { bv = g[n]; best = n; }
            if (best >= 0 && bv > NEGF * 0.5f) sel |= 1u << best; }
        sel |= 1u << qblk;
        float m = -3.0e38f, l = 0.f, o = 0.f;
        for (int n = 0; n <= qblk; ++n) {
            if (!((sel >> n) & 1u)) continue;
            const int j0 = n * MOBA_BLOCK, j1 = (n == qblk) ? q + 1 : j0 + MOBA_BLOCK;
            const T* kp = P + ((long)b * SEQ + j0) * L.ld + L.k + h * 64 + lane;
            const T* vp = P + ((long)b * SEQ + j0) * L.ld + L.v + h * 64 + lane;
            for (int j = j0; j < j1; ++j, kp += L.ld, vp += L.ld) {
                const float s = wave_sum(qv * ldf(kp)) * 0.125f;
                const float mn = fmaxf(m, s), corr = __expf(m - mn), p = __expf(s - mn);
                l = l * corr + p; o = o * corr + p * ldf(vp); m = mn;
            }
        }
        O[row * ldo + h * 64 + lane] = o / l;
    }
}

template <int W, class TO> __device__ __forceinline__ void rms_rows_phase(const float* in, int ldi, const float* g, TO* out, int ldo, long n_rows, int gw, int ngw, int lane) {
    constexpr int PER = W / 64;
    for (long row = gw; row < n_rows; row += ngw) {
        float v[PER]; float s = 0.f;
#pragma unroll
        for (int j = 0; j < PER; ++j) { v[j] = in[row * ldi + j * 64 + lane]; s += v[j] * v[j]; }
        const float r = rsqrtf(wave_sum(s) * (1.f / W) + 1e-5f);
#pragma unroll
        for (int j = 0; j < PER; ++j) stf(out + row * ldo + j * 64 + lane, v[j] * r * g[j * 64 + lane]);
    }
}

template <class T, class TO> __device__ __forceinline__ void ssd_conv_phase(const T* P, ProjL L, const float* cw, const float* cb, const float* dtb, TO* XC, float* DT, long n_rows, long gt, long ngt) {
    for (long it = gt; it < n_rows * 902; it += ngt) {
        const int c = (int)(it % 902); const long row = it / 902; const int t = (int)(row % SEQ);
        if (c < SSD_CW) {
            float acc = cb[c];
#pragma unroll
            for (int i = 0; i < 4; ++i) { const int tt = t - 3 + i; if (tt >= 0) acc += cw[i * SSD_CW + c] * ldf(P + (row - 3 + i) * L.ld + L.xbc + c); }
            stf(XC + row * SSD_CW + c, silu_f(acc));
        } else {
            const int h = c - SSD_CW;
            DT[row * SSD_H + h] = softplus_f(ldf(P + row * L.ld + L.dt + h) + dtb[h]);
        }
    }
}

template <class T> __device__ __forceinline__ void ssd_scan_naive_phase(const T* XC, const float* DT, const float* a_log, const float* dsk, float* Y, int ldo, int nb, int gw, int ngw, int lane) {
    for (int it = gw; it < nb * SSD_H * 64; it += ngw) {
        const int p = it & 63, h = (it >> 6) % SSD_H, b = it / (64 * SSD_H), grp = h / (SSD_H / SSD_G);
        const float A = -__expf(a_log[h]), Dk = dsk[h];
        float s0 = 0.f, s1 = 0.f;
#pragma unroll 4
        for (int t = 0; t < SEQ; ++t) {
            const long row = (long)b * SEQ + t;
            const T* xr = XC + row * SSD_CW;
            const float dt = DT[row * SSD_H + h], x = ldf(xr + h * 64 + p);
            const float B0 = ldf(xr + SSD_W + grp * SSD_N + lane), B1 = ldf(xr + SSD_W + grp * SSD_N + 64 + lane);
            const float C0 = ldf(xr + SSD_W + SSD_G * SSD_N + grp * SSD_N + lane), C1 = ldf(xr + SSD_W + SSD_G * SSD_N + grp * SSD_N + 64 + lane);
            const float dec = __expf(dt * A), xd = x * dt;
            s0 = s0 * dec + xd * B0; s1 = s1 * dec + xd * B1;
            const float y = wave_sum(C0 * s0 + C1 * s1);
            if (lane == 0) Y[row * ldo + h * 64 + p] = y + Dk * x;
        }
    }
}

template <class T, class TO> __device__ __forceinline__ void ssd_gate_phase(const float* Y, int ldi, const T* P, ProjL L, const float* ng, TO* out, int ldo, long n_rows, int gw, int ngw, int lane) {
    for (long row = gw; row < n_rows; row += ngw) {
        float v[6];
#pragma unroll
        for (int j = 0; j < 6; ++j) { const int c = j * 64 + lane; v[j] = Y[row * ldi + c] * silu_f(ldf(P + row * L.ld + L.z + c)); }
        const float r0 = rsqrtf(wave_sum(v[0] * v[0] + v[1] * v[1] + v[2] * v[2]) * (1.f / 192.f) + 1e-5f);
        const float r1 = rsqrtf(wave_sum(v[3] * v[3] + v[4] * v[4] + v[5] * v[5]) * (1.f / 192.f) + 1e-5f);
#pragma unroll
        for (int j = 0; j < 6; ++j) { const int c = j * 64 + lane; stf(out + row * ldo + c, v[j] * (j < 3 ? r0 : r1) * ng[c]); }
    }
}

template <class T, bool PRE> __device__ __forceinline__ void gm_ln_phase(const T* P, ProjL L, const float* g, const float* b, float* VN, long n_rows, int gw, int ngw, int lane) {
    for (long row = gw; row < n_rows; row += ngw) {
        float v[4]; float s = 0.f;
#pragma unroll
        for (int j = 0; j < 4; ++j) { const float x = ldf(P + row * L.ld + L.gv + j * 64 + lane); v[j] = PRE ? x : gelu_tanh_f(x); s += v[j]; }
        const float mean = wave_sum(s) * (1.f / 256.f); float s2 = 0.f;
#pragma unroll
        for (int j = 0; j < 4; ++j) { v[j] -= mean; s2 += v[j] * v[j]; }
        const float rstd = rsqrtf(wave_sum(s2) * (1.f / 256.f) + 1e-5f);
#pragma unroll
        for (int j = 0; j < 4; ++j) VN[row * GM_W + j * 64 + lane] = v[j] * rstd * g[j * 64 + lane] + b[j * 64 + lane];
    }
}
template <class T, bool PRE> __device__ __forceinline__ void gm_mix_phase(const T* P, ProjL L, const float* VN, const float* ws_, const float* bs, float* GO, int ldo, long n_rows, long gt, long ngt) {
    for (long it = gt; it < n_rows * GM_W; it += ngt) {
        const int c = (int)(it % GM_W); const long row = it / GM_W; const int t = (int)(row % GM_CHUNK), g = c / 64; const long base = row - t;
        const float* w = ws_ + ((long)g * GM_CHUNK + t) * GM_CHUNK; float acc = 0.f;
        for (int s = 0; s <= t; ++s) acc += w[s] * VN[(base + s) * GM_W + c];
        acc += bs[g * GM_CHUNK + t];
        const float x = ldf(P + row * L.ld + L.gu + c); const float u = PRE ? x : gelu_tanh_f(x);
        GO[row * ldo + c] = u * acc;
    }
}

__device__ __forceinline__ void moe_route_phase(const float* H, const float* Wr, int* CNT, int* TE, float* TP, int* TS, long n_rows, int gw, int ngw, int lane) {
    for (long row = gw; row < n_rows; row += ngw) {
        float acc[N_EXP];
#pragma unroll
        for (int e = 0; e < N_EXP; ++e) acc[e] = 0.f;
        for (int j = 0; j < 16; ++j) { const int d = j * 64 + lane; const float hv = H[row * DM + d];
            const float4 w0 = *(const float4*)(Wr + d * N_EXP), w1 = *(const float4*)(Wr + d * N_EXP + 4);
            acc[0] += hv * w0.x; acc[1] += hv * w0.y; acc[2] += hv * w0.z; acc[3] += hv * w0.w; acc[4] += hv * w1.x; acc[5] += hv * w1.y; acc[6] += hv * w1.z; acc[7] += hv * w1.w; }
#pragma unroll
        for (int e = 0; e < N_EXP; ++e) acc[e] = wave_sum(acc[e]);
        int e0 = 0; float v0 = acc[0];
#pragma unroll
        for (int e = 1; e < N_EXP; ++e) if (acc[e] > v0) { v0 = acc[e]; e0 = e; }
        int e1 = -1; float v1 = -3.0e38f;
#pragma unroll
        for (int e = 0; e < N_EXP; ++e) if (e != e0 && acc[e] > v1) { v1 = acc[e]; e1 = e; }
        const float p1 = __expf(v1 - v0), den = 1.f + p1;
        if (lane == 0) {
            const int s0 = atomicAdd(&CNT[e0], 1), s1 = atomicAdd(&CNT[e1], 1);
            TE[row * 2] = e0; TE[row * 2 + 1] = e1; TP[row * 2] = 1.f / den; TP[row * 2 + 1] = p1 / den; TS[row * 2] = s0; TS[row * 2 + 1] = s1;
        }
    }
}
__device__ __forceinline__ int moe_base(const int* CNT, int e) { int b = 0; for (int i = 0; i < e; ++i) b += (CNT[i] + 255) & ~255; return b; }
__device__ __forceinline__ void moe_scatter_phase(const int* CNT, const int* TE, const float* TP, const int* TS, int* LIST, float* SP, int* GS, long n_rows, long gt, long ngt) {
    for (long it = gt; it < n_rows * 2; it += ngt) {
        const int e = TE[it]; const int gs = moe_base(CNT, e) + TS[it];
        LIST[gs] = (int)(it >> 1); SP[gs] = TP[it]; GS[it] = gs;
    }
}

template <class TA, int EPI> __global__ void __launch_bounds__(256) sgemm_k(const TA* A, int lda, const int* rowlist, const float* B, const float* B2, int ldb, long bstride, void* Cv, int ldc, int M, int N, int K, const int* CNT, const float* scale) {
    __shared__ float As[16][68], Bs[16][68], Bs2[16][68];
    int row_base = 0, mrows = M;
    if (CNT) { const int e = blockIdx.z; row_base = moe_base(CNT, e); mrows = CNT[e]; B += (long)e * bstride; if (B2) B2 += (long)e * bstride; }
    const int m0 = blockIdx.y * 64; if (m0 >= mrows) return;
    const int n0 = blockIdx.x * 64, tid = threadIdx.x, tx = tid & 15, ty = tid >> 4;
    float acc[4][4], acc2[4][4];
#pragma unroll
    for (int i = 0; i < 4; ++i)
#pragma unroll
        for (int j = 0; j < 4; ++j) { acc[i][j] = 0.f; acc2[i][j] = 0.f; }
    const int ar = tid >> 2, ak = (tid & 3) * 4; long arow = -1;
    { const int lr = m0 + ar; if (lr < mrows) { arow = rowlist ? (long)rowlist[row_base + lr] : (long)(row_base + lr); } }
    const int bk = tid >> 4, bn = (tid & 15) * 4;
    for (int k0 = 0; k0 < K; k0 += 16) {
        float av[4] = {0.f, 0.f, 0.f, 0.f};
        if (arow >= 0) {
#pragma unroll
            for (int i = 0; i < 4; ++i) av[i] = ldf(A + arow * lda + k0 + ak + i);
        }
#pragma unroll
        for (int i = 0; i < 4; ++i) As[ak + i][ar] = av[i];
#pragma unroll
        for (int i = 0; i < 4; ++i) { const int n = n0 + bn + i; const bool ok = n < N;
            Bs[bk][bn + i] = ok ? B[(long)(k0 + bk) * ldb + n] : 0.f;
            if (EPI == 1 || EPI == 2) Bs2[bk][bn + i] = ok ? B2[(long)(k0 + bk) * ldb + n] : 0.f; }
        __syncthreads();
#pragma unroll
        for (int kk = 0; kk < 16; ++kk) {
            float a[4], b[4], b2[4];
#pragma unroll
            for (int i = 0; i < 4; ++i) { a[i] = As[kk][ty * 4 + i]; b[i] = Bs[kk][tx * 4 + i]; if (EPI == 1 || EPI == 2) b2[i] = Bs2[kk][tx * 4 + i]; }
#pragma unroll
            for (int i = 0; i < 4; ++i)
#pragma unroll
                for (int j = 0; j < 4; ++j) { acc[i][j] += a[i] * b[j]; if (EPI == 1 || EPI == 2) acc2[i][j] += a[i] * b2[j]; }
        }
        __syncthreads();
    }
#pragma unroll
    for (int i = 0; i < 4; ++i) { const int lr = m0 + ty * 4 + i; if (lr >= mrows) continue; const long crow = row_base + lr;
#pragma unroll
        for (int j = 0; j < 4; ++j) { const int n = n0 + tx * 4 + j; if (n >= N) continue;
            float v = acc[i][j];
            if (EPI == 1 || EPI == 2) v = silu_f(v) * acc2[i][j];
            if (EPI == 3) v *= scale[crow];
            if (EPI == 2) ((bf16*)Cv)[crow * ldc + n] = (bf16)f2bf(v); else ((float*)Cv)[crow * ldc + n] = v; } }
}

#define GW_DECL const int lane = threadIdx.x & 63; const int gw = (int)((blockIdx.x * (long)blockDim.x + threadIdx.x) >> 6); const int ngw = (int)((gridDim.x * (long)blockDim.x) >> 6); (void)lane; (void)gw; (void)ngw;
#define GT_DECL const long gt = blockIdx.x * (long)blockDim.x + threadIdx.x; const long ngt = gridDim.x * (long)blockDim.x;

__global__ void k_ln_in(const float* x, const float* g, const float* b, float* H, long n_rows) { GW_DECL for (long r = gw; r < n_rows; r += ngw) ln_row(x + r * DM, 1.f, nullptr, nullptr, g, b, H + r * DM, nullptr, lane); }
__global__ void k_ln_res(float* H, const float* Y, const float* g, const float* b, float* OUT, long n_rows) { GW_DECL for (long r = gw; r < n_rows; r += ngw) ln_row(H + r * DM, ALPHA, Y + r * DM, nullptr, g, b, OUT + r * DM, nullptr, lane); }
__global__ void k_ln_moe(float* H, const float* F2, const int* GS, const float* g, const float* b, float* OUT, long n_rows) { GW_DECL for (long r = gw; r < n_rows; r += ngw) ln_row(H + r * DM, ALPHA, F2 + (long)GS[r * 2] * DM, F2 + (long)GS[r * 2 + 1] * DM, g, b, OUT + r * DM, nullptr, lane); }
__global__ void k_rope(float* P, ProjL L, const int* pos, long n_rows) { GT_DECL rope_inplace(P, L, pos, n_rows, gt, ngt); }
__global__ void k_kmean(const float* P, ProjL L, float* KM, int nb) { GT_DECL kmean_phase<float>(P, L, KM, nb, gt, ngt); }
__global__ void k_attn(const float* P, ProjL L, const float* KM, float* O, int ldo, int nb) { GW_DECL attn_naive_phase<float>(P, L, KM, O, ldo, nb, gw, ngw, lane); }
__global__ void k_rms384(const float* in, int ldi, const float* g, float* out, int ldo, long n_rows) { GW_DECL rms_rows_phase<384, float>(in, ldi, g, out, ldo, n_rows, gw, ngw, lane); }
__global__ void k_rms256(const float* in, int ldi, const float* g, float* out, int ldo, long n_rows) { GW_DECL rms_rows_phase<256, float>(in, ldi, g, out, ldo, n_rows, gw, ngw, lane); }
__global__ void k_ssd_conv(const float* P, ProjL L, const float* cw, const float* cb, const float* dtb, float* XC, float* DT, long n_rows) { GT_DECL ssd_conv_phase<float, float>(P, L, cw, cb, dtb, XC, DT, n_rows, gt, ngt); }
__global__ void k_ssd_scan(const float* XC, const float* DT, const float* a_log, const float* dsk, float* Y, int ldo, int nb) { GW_DECL ssd_scan_naive_phase<float>(XC, DT, a_log, dsk, Y, ldo, nb, gw, ngw, lane); }
__global__ void k_ssd_gate(const float* Y, int ldi, const float* P, ProjL L, const float* ng, float* out, int ldo, long n_rows) { GW_DECL ssd_gate_phase<float, float>(Y, ldi, P, L, ng, out, ldo, n_rows, gw, ngw, lane); }
__global__ void k_gm_ln(const float* P, ProjL L, const float* g, const float* b, float* VN, long n_rows) { GW_DECL gm_ln_phase<float, false>(P, L, g, b, VN, n_rows, gw, ngw, lane); }
__global__ void k_gm_mix(const float* P, ProjL L, const float* VN, const float* ws_, const float* bs, float* GO, int ldo, long n_rows) { GT_DECL gm_mix_phase<float, false>(P, L, VN, ws_, bs, GO, ldo, n_rows, gt, ngt); }
__global__ void k_moe_init(int* CNT, int* LIST, int nslots) { GT_DECL if (gt < N_EXP) CNT[gt] = 0; for (long i = gt; i < nslots; i += ngt) LIST[i] = -1; }
__global__ void k_moe_route(const float* H, const float* Wr, int* CNT, int* TE, float* TP, int* TS, long n_rows) { GW_DECL moe_route_phase(H, Wr, CNT, TE, TP, TS, n_rows, gw, ngw, lane); }
__global__ void k_moe_scatter(const int* CNT, const int* TE, const float* TP, const int* TS, int* LIST, float* SP, int* GS, long n_rows) { GT_DECL moe_scatter_phase(CNT, TE, TP, TS, LIST, SP, GS, n_rows, gt, ngt); }

struct Inputs {
    const float *x; const int* pos; const float *ln_in_g, *ln_in_b, *w_in, *conv_w, *conv_b, *dt_bias, *a_log, *d_skip, *ssd_norm_g, *att_norm_g, *gm_ln_g, *gm_ln_b, *gm_w_s, *gm_b_s, *gm_norm_g, *w_out,
        *ln1_g, *ln1_b, *ln2_g, *ln2_b, *ffn_w_gate, *ffn_w_up, *ffn_w_down, *router_w, *moe_w_gate, *moe_w_up, *moe_w_down;
};

static void run_simple(const Inputs& I, int nb, unsigned char* ws, float* aux  , float* OUT, hipStream_t st) {
    const long M = (long)nb * SEQ; const size_t MB = 1u << 20;
    const size_t hsz = (size_t)M * DM * 4;
    float* H = (float*)ws; float* MIX = (float*)(ws + hsz); float* Y = (float*)(ws + 2 * hsz); unsigned char* BIG = ws + 3 * hsz + (size_t)N_EXP * 256 * DM * 4;
    float* XC = Y;
    float* VN = aux;
    float* PROJ = (float*)BIG;
    size_t big_bytes = (size_t)M * D_IN * 4; { size_t a = (size_t)M * D_FF * 4; if (a > big_bytes) big_bytes = a; size_t c = (size_t)(2 * M + N_EXP * 256) * D_FFE * 2; if (c > big_bytes) big_bytes = c; }
    big_bytes = (big_bytes + 255) & ~(size_t)255;
    unsigned char* SM = BIG + big_bytes;
    float* KM = (float*)SM; SM += (size_t)nb * ATT_H * NBLK * 64 * 4;
    float* DT = (float*)SM; SM += (size_t)M * SSD_H * 4;
    int* CNT = (int*)SM; SM += 256;
    int* TE = (int*)SM; SM += (size_t)M * 2 * 4; float* TP = (float*)SM; SM += (size_t)M * 2 * 4; int* TS = (int*)SM; SM += (size_t)M * 2 * 4; int* GS = (int*)SM; SM += (size_t)M * 2 * 4;
    const int nslots = (int)(2 * M + N_EXP * 256);
    int* LIST = (int*)SM; SM += (size_t)nslots * 4; float* SP = (float*)SM; SM += (size_t)nslots * 4;
    (void)MB;
    const ProjL L{D_IN, 0, 384, 768, 1152, 1536, 2432, 2438, 2694};
    const int TB = 256; const int GWB = 2048;
    k_ln_in<<<GWB, TB, 0, st>>>(I.x, I.ln_in_g, I.ln_in_b, H, M);
    for (int i = 0; i < 2; ++i) {
        sgemm_k<float, 0><<<dim3((D_IN + 63) / 64, (unsigned)(M / 64), 1), 256, 0, st>>>(H, DM, nullptr, I.w_in + (size_t)i * DM * D_IN, nullptr, D_IN, 0, PROJ, D_IN, (int)M, D_IN, DM, nullptr, nullptr);
        k_rope<<<GWB, TB, 0, st>>>(PROJ, L, I.pos, M);
        k_kmean<<<96 * nb, TB, 0, st>>>(PROJ, L, KM, nb);
        k_attn<<<GWB * 2, TB, 0, st>>>(PROJ, L, KM, MIX, DM, nb);
        k_rms384<<<GWB, TB, 0, st>>>(MIX, DM, I.att_norm_g + i * ATT_W, MIX, DM, M);
        k_ssd_conv<<<GWB * 2, TB, 0, st>>>(PROJ, L, I.conv_w + (size_t)i * 4 * SSD_CW, I.conv_b + i * SSD_CW, I.dt_bias + i * SSD_H, XC, DT, M);
        k_ssd_scan<<<(nb * SSD_H * 64 * 64 + TB - 1) / TB, TB, 0, st>>>(XC, DT, I.a_log + i * SSD_H, I.d_skip + i * SSD_H, MIX + ATT_W, DM, nb);
        k_ssd_gate<<<GWB, TB, 0, st>>>(MIX + ATT_W, DM, PROJ, L, I.ssd_norm_g + i * SSD_W, MIX + ATT_W, DM, M);
        k_gm_ln<<<GWB, TB, 0, st>>>(PROJ, L, I.gm_ln_g + i * GM_W, I.gm_ln_b + i * GM_W, VN, M);
        k_gm_mix<<<GWB * 2, TB, 0, st>>>(PROJ, L, VN, I.gm_w_s + (size_t)i * GM_G * GM_CHUNK * GM_CHUNK, I.gm_b_s + i * GM_G * GM_CHUNK, MIX + ATT_W + SSD_W, DM, M);
        k_rms256<<<GWB, TB, 0, st>>>(MIX + ATT_W + SSD_W, DM, I.gm_norm_g + i * GM_W, MIX + ATT_W + SSD_W, DM, M);
        sgemm_k<float, 0><<<dim3(DM / 64, (unsigned)(M / 64), 1), 256, 0, st>>>(MIX, DM, nullptr, I.w_out + (size_t)i * DM * DM, nullptr, DM, 0, Y, DM, (int)M, DM, DM, nullptr, nullptr);
        k_ln_res<<<GWB, TB, 0, st>>>(H, Y, I.ln1_g + i * DM, I.ln1_b + i * DM, H, M);
        if (i == 0) {
            float* ACT = (float*)BIG;
            sgemm_k<float, 1><<<dim3(D_FF / 64, (unsigned)(M / 64), 1), 256, 0, st>>>(H, DM, nullptr, I.ffn_w_gate, I.ffn_w_up, D_FF, 0, ACT, D_FF, (int)M, D_FF, DM, nullptr, nullptr);
            sgemm_k<float, 0><<<dim3(DM / 64, (unsigned)(M / 64), 1), 256, 0, st>>>(ACT, D_FF, nullptr, I.ffn_w_down, nullptr, DM, 0, Y, DM, (int)M, DM, D_FF, nullptr, nullptr);
            k_ln_res<<<GWB, TB, 0, st>>>(H, Y, I.ln2_g + i * DM, I.ln2_b + i * DM, H, M);
        } else {
            bf16* ACTM = (bf16*)BIG; float* F2 = MIX;
            k_moe_init<<<256, TB, 0, st>>>(CNT, LIST, nslots);
            k_moe_route<<<GWB, TB, 0, st>>>(H, I.router_w, CNT, TE, TP, TS, M);
            k_moe_scatter<<<256, TB, 0, st>>>(CNT, TE, TP, TS, LIST, SP, GS, M);
            sgemm_k<float, 2><<<dim3(D_FFE / 64, (unsigned)(M / 64), N_EXP), 256, 0, st>>>(H, DM, LIST, I.moe_w_gate, I.moe_w_up, D_FFE, (long)DM * D_FFE, ACTM, D_FFE, 0, D_FFE, DM, CNT, nullptr);
            sgemm_k<bf16, 3><<<dim3(DM / 64, (unsigned)(M / 64), N_EXP), 256, 0, st>>>(ACTM, D_FFE, nullptr, I.moe_w_down, nullptr, DM, (long)D_FFE * DM, F2, DM, 0, DM, D_FFE, CNT, SP);
            k_ln_moe<<<GWB, TB, 0, st>>>(H, F2, GS, I.ln2_g + i * DM, I.ln2_b + i * DM, OUT, M);
        }
    }
}

extern "C" void kernel_launch(void* const* d_in, const int* in_sizes, int n_in, void* d_out, int out_size, void* d_ws, size_t ws_size, hipStream_t stream) {
    Inputs I;
    I.x = (const float*)d_in[0]; I.pos = (const int*)d_in[1]; I.ln_in_g = (const float*)d_in[2]; I.ln_in_b = (const float*)d_in[3]; I.w_in = (const float*)d_in[4];
    I.conv_w = (const float*)d_in[5]; I.conv_b = (const float*)d_in[6]; I.dt_bias = (const float*)d_in[7]; I.a_log = (const float*)d_in[8]; I.d_skip = (const float*)d_in[9];
    I.ssd_norm_g = (const float*)d_in[10]; I.att_norm_g = (const float*)d_in[11]; I.gm_ln_g = (const float*)d_in[12]; I.gm_ln_b = (const float*)d_in[13]; I.gm_w_s = (const float*)d_in[14];
    I.gm_b_s = (const float*)d_in[15]; I.gm_norm_g = (const float*)d_in[16]; I.w_out = (const float*)d_in[17]; I.ln1_g = (const float*)d_in[18]; I.ln1_b = (const float*)d_in[19];
    I.ln2_g = (const float*)d_in[20]; I.ln2_b = (const float*)d_in[21]; I.ffn_w_gate = (const float*)d_in[22]; I.ffn_w_up = (const float*)d_in[23]; I.ffn_w_down = (const float*)d_in[24];
    I.router_w = (const float*)d_in[25]; I.moe_w_gate = (const float*)d_in[26]; I.moe_w_up = (const float*)d_in[27]; I.moe_w_down = (const float*)d_in[28];
    (void)in_sizes; (void)n_in; (void)out_size; (void)ws_size;
    run_simple(I, NBATCH, (unsigned char*)d_ws, (float*)d_out, (float*)d_out, stream);
}
```

```cpp
#define DEBUG_BUILD 0
#define DBG_THR 0.02f
#include <hip/hip_runtime.h>
#include <cstdio>
#include <cstdint>

constexpr int DM = 1024, SEQ = 2048, NBATCH = 8;
constexpr int ATT_H = 6, HD = 64, ATT_W = 384, ROPE_DIM = 16;
constexpr int MOBA_BLOCK = 256, NBLK = SEQ / MOBA_BLOCK;
constexpr int SSD_H = 6, SSD_W = 384, SSD_G = 2, SSD_N = 128, SSD_CW = 896;
constexpr int GM_G = 4, GM_W = 256, GM_CHUNK = 128;
constexpr int D_IN = 2950, D_FF = 2816, N_EXP = 8, D_FFE = 3584;
constexpr float ALPHA = 1.4142135623730951f;
constexpr float NEGF = -1e30f;
constexpr int MAXSLOT = 2 * NBATCH * SEQ + N_EXP * 256;

typedef unsigned short bf16;
__device__ __forceinline__ unsigned f2bf(float f) { unsigned u = __float_as_uint(f); return (u + 0x7fffu + ((u >> 16) & 1u)) >> 16; }
__device__ __forceinline__ float ldf(const float* p) { return *p; }
__device__ __forceinline__ float ldf(const bf16* p) { return __uint_as_float(((unsigned)*p) << 16); }
__device__ __forceinline__ void stf(float* p, float v) { *p = v; }
__device__ __forceinline__ void stf(bf16* p, float v) { *p = (bf16)f2bf(v); }

__device__ __forceinline__ float wave_sum(float v) {
#pragma unroll
    for (int o = 1; o < 64; o <<= 1) v += __shfl_xor(v, o);
    return v;
}
__device__ __forceinline__ float silu_f(float x) { return x / (1.f + __expf(-x)); }
__device__ __forceinline__ float gelu_tanh_f(float x) { const float u = 0.7978845608028654f * (x + 0.044715f * x * x * x); return 0.5f * x * (1.f + tanhf(u)); }
__device__ __forceinline__ float softplus_f(float x) { return fmaxf(x, 0.f) + log1pf(__expf(-fabsf(x))); }

struct ProjL { int ld, q, k, v, z, xbc, dt, gu, gv; };

__device__ __forceinline__ float4 ld4(const float* p) { return *(const float4*)p; }
__device__ __forceinline__ float4 ld4(const bf16* p) { const uint2 w = *(const uint2*)p; return make_float4(__uint_as_float(w.x << 16), __uint_as_float(w.x & 0xffff0000u), __uint_as_float(w.y << 16), __uint_as_float(w.y & 0xffff0000u)); }
template <class TY> __device__ __forceinline__ void ln_row(const float* xrow, float a, const TY* y1, const TY* y2, const float* g, const float* b, float* of, bf16* ob, int lane) {
    float v[16]; float s = 0.f;
#pragma unroll
    for (int j = 0; j < 4; ++j) {
        const float4 x = *(const float4*)(xrow + j * 256 + lane * 4);
        float4 t = make_float4(a * x.x, a * x.y, a * x.z, a * x.w);
        if (y1) { const float4 y = ld4(y1 + j * 256 + lane * 4); t.x += y.x; t.y += y.y; t.z += y.z; t.w += y.w; }
        if (y2) { const float4 y = ld4(y2 + j * 256 + lane * 4); t.x += y.x; t.y += y.y; t.z += y.z; t.w += y.w; }
        v[4 * j] = t.x; v[4 * j + 1] = t.y; v[4 * j + 2] = t.z; v[4 * j + 3] = t.w; s += (t.x + t.y) + (t.z + t.w);
    }
    const float mean = wave_sum(s) * (1.f / 1024.f); float s2 = 0.f;
#pragma unroll
    for (int i = 0; i < 16; ++i) { v[i] -= mean; s2 += v[i] * v[i]; }
    const float rstd = rsqrtf(wave_sum(s2) * (1.f / 1024.f) + 1e-5f);
#pragma unroll
    for (int j = 0; j < 4; ++j) {
        const float4 gg = *(const float4*)(g + j * 256 + lane * 4), bb = *(const float4*)(b + j * 256 + lane * 4);
        float4 o = make_float4(v[4 * j] * rstd * gg.x + bb.x, v[4 * j + 1] * rstd * gg.y + bb.y, v[4 * j + 2] * rstd * gg.z + bb.z, v[4 * j + 3] * rstd * gg.w + bb.w);
        *(float4*)(of + j * 256 + lane * 4) = o;
        if (ob) { uint2 w; w.x = f2bf(o.x) | (f2bf(o.y) << 16); w.y = f2bf(o.z) | (f2bf(o.w) << 16); *(uint2*)(ob + j * 256 + lane * 4) = w; }
    }
}

__device__ __forceinline__ void rope_inplace(float* P, ProjL L, const int* pos, long n_rows, long gt, long ngt) {
    for (long it = gt; it < n_rows * 96; it += ngt) {
        const int i = (int)(it & 7), hh = (int)((it >> 3) % 12); const long row = it / 96;
        const int off = (hh < 6 ? L.q : L.k) + (hh % 6) * 64;
        const float inv = powf(500000.0f, -(float)(2 * i) / 16.0f);
        const float ang = (float)pos[row] * inv;
        const float c = cosf(ang), s = sinf(ang);
        float* p = P + row * L.ld + off;
        const float x1 = p[i], x2 = p[i + 8];
        p[i] = x1 * c - x2 * s; p[i + 8] = x2 * c + x1 * s;
    }
}

template <class T> __device__ __forceinline__ void kmean_phase(const T* P, ProjL L, float* KM, int nb, long gt, long ngt) {
    for (long it = gt; it < (long)nb * ATT_H * NBLK * 64; it += ngt) {
        const int d = (int)(it & 63), n = (int)((it >> 6) % NBLK), h = (int)((it / (64 * NBLK)) % ATT_H), b = (int)(it / (64 * NBLK * ATT_H));
        const T* p = P + ((long)b * SEQ + n * MOBA_BLOCK) * L.ld + L.k + h * 64 + d; float s = 0.f;
        for (int r = 0; r < MOBA_BLOCK; ++r) s += ldf(p + (long)r * L.ld);
        KM[it] = s * (1.f / MOBA_BLOCK);
    }
}

template <class T> __device__ __forceinline__ void attn_naive_phase(const T* P, ProjL L, const float* KM, float* O, int ldo, int nb, int gw, int ngw, int lane) {
    for (long it = gw; it < (long)nb * ATT_H * SEQ; it += ngw) {
        const int q = (int)(it % SEQ), h = (int)((it / SEQ) % ATT_H), b = (int)(it / ((long)SEQ * ATT_H));
        const long row = (long)b * SEQ + q; const int qblk = q / MOBA_BLOCK;
        const float qv = ldf(P + row * L.ld + L.q + h * 64 + lane);
        float g[NBLK];
#pragma unroll
        for (int n = 0; n < NBLK; ++n) { const float t = wave_sum(qv * KM[(((long)b * ATT_H + h) * NBLK + n) * 64 + lane]); g[n] = (n < qblk) ? t : NEGF; }
        unsigned sel = 0u;
#pragma unroll
        for (int r = 0; r < 3; ++r) { float bv = -3.0e38f; int best = -1;
#pragma unroll
            for (int n = 0; n < NBLK; ++n) if (!((sel >> n) & 1u) && g[n] > bv) { bv = g[n]; best = n; }
            if (best >= 0 && bv > NEGF * 0.5f) sel |= 1u << best; }
        sel |= 1u << qblk;
        float m = -3.0e38f, l = 0.f, o = 0.f;
        for (int n = 0; n <= qblk; ++n) {
            if (!((sel >> n) & 1u)) continue;
            const int j0 = n * MOBA_BLOCK, j1 = (n == qblk) ? q + 1 : j0 + MOBA_BLOCK;
            const T* kp = P + ((long)b * SEQ + j0) * L.ld + L.k + h * 64 + lane;
            const T* vp = P + ((long)b * SEQ + j0) * L.ld + L.v + h * 64 + lane;
            for (int j = j0; j < j1; ++j, kp += L.ld, vp += L.ld) {
                const float s = wave_sum(qv * ldf(kp)) * 0.125f;
                const float mn = fmaxf(m, s), corr = __expf(m - mn), p = __expf(s - mn);
                l = l * corr + p; o = o * corr + p * ldf(vp); m = mn;
            }
        }
        O[row * ldo + h * 64 + lane] = o / l;
    }
}

template <int W, class TO> __device__ __forceinline__ void rms_rows_phase(const float* in, int ldi, const float* g, TO* out, int ldo, long n_rows, int gw, int ngw, int lane) {
    constexpr int PER = W / 64;
    for (long row = gw; row < n_rows; row += ngw) {
        float v[PER]; float s = 0.f;
#pragma unroll
        for (int j = 0; j < PER; ++j) { v[j] = in[row * ldi + j * 64 + lane]; s += v[j] * v[j]; }
        const float r = rsqrtf(wave_sum(s) * (1.f / W) + 1e-5f);
#pragma unroll
        for (int j = 0; j < PER; ++j) stf(out + row * ldo + j * 64 + lane, v[j] * r * g[j * 64 + lane]);
    }
}

template <class T, class TO> __device__ __forceinline__ void ssd_conv_phase(const T* P, ProjL L, const float* cw, const float* cb, const float* dtb, TO* XC, float* DT, long n_rows, long gt, long ngt) {
    for (long it = gt; it < n_rows * 902; it += ngt) {
        const int c = (int)(it % 902); const long row = it / 902; const int t = (int)(row % SEQ);
        if (c < SSD_CW) {
            float acc = cb[c];
#pragma unroll
            for (int i = 0; i < 4; ++i) { const int tt = t - 3 + i; if (tt >= 0) acc += cw[i * SSD_CW + c] * ldf(P + (row - 3 + i) * L.ld + L.xbc + c); }
            stf(XC + row * SSD_CW + c, silu_f(acc));
        } else {
            const int h = c - SSD_CW;
            DT[row * SSD_H + h] = softplus_f(ldf(P + row * L.ld + L.dt + h) + dtb[h]);
        }
    }
}

template <class T> __device__ __forceinline__ void ssd_scan_naive_phase(const T* XC, const float* DT, const float* a_log, const float* dsk, float* Y, int ldo, int nb, int gw, int ngw, int lane) {
    for (int it = gw; it < nb * SSD_H * 64; it += ngw) {
        const int p = it & 63, h = (it >> 6) % SSD_H, b = it / (64 * SSD_H), grp = h / (SSD_H / SSD_G);
        const float A = -__expf(a_log[h]), Dk = dsk[h];
        float s0 = 0.f, s1 = 0.f;
#pragma unroll 4
        for (int t = 0; t < SEQ; ++t) {
            const long row = (long)b * SEQ + t;
            const T* xr = XC + row * SSD_CW;
            const float dt = DT[row * SSD_H + h], x = ldf(xr + h * 64 + p);
            const float B0 = ldf(xr + SSD_W + grp * SSD_N + lane), B1 = ldf(xr + SSD_W + grp * SSD_N + 64 + lane);
            const float C0 = ldf(xr + SSD_W + SSD_G * SSD_N + grp * SSD_N + lane), C1 = ldf(xr + SSD_W + SSD_G * SSD_N + grp * SSD_N + 64 + lane);
            const float dec = __expf(dt * A), xd = x * dt;
            s0 = s0 * dec + xd * B0; s1 = s1 * dec + xd * B1;
            const float y = wave_sum(C0 * s0 + C1 * s1);
            if (lane == 0) Y[row * ldo + h * 64 + p] = y + Dk * x;
        }
    }
}

template <class T, class TO> __device__ __forceinline__ void ssd_gate_phase(const float* Y, int ldi, const T* P, ProjL L, const float* ng, TO* out, int ldo, long n_rows, int gw, int ngw, int lane) {
    for (long row = gw; row < n_rows; row += ngw) {
        float v[6];
#pragma unroll
        for (int j = 0; j < 6; ++j) { const int c = j * 64 + lane; v[j] = Y[row * ldi + c] * silu_f(ldf(P + row * L.ld + L.z + c)); }
        const float r0 = rsqrtf(wave_sum(v[0] * v[0] + v[1] * v[1] + v[2] * v[2]) * (1.f / 192.f) + 1e-5f);
        const float r1 = rsqrtf(wave_sum(v[3] * v[3] + v[4] * v[4] + v[5] * v[5]) * (1.f / 192.f) + 1e-5f);
#pragma unroll
        for (int j = 0; j < 6; ++j) { const int c = j * 64 + lane; stf(out + row * ldo + c, v[j] * (j < 3 ? r0 : r1) * ng[c]); }
    }
}

template <class T, bool PRE> __device__ __forceinline__ void gm_ln_phase(const T* P, ProjL L, const float* g, const float* b, float* VN, long n_rows, int gw, int ngw, int lane) {
    for (long row = gw; row < n_rows; row += ngw) {
        float v[4]; float s = 0.f;
#pragma unroll
        for (int j = 0; j < 4; ++j) { const float x = ldf(P + row * L.ld + L.gv + j * 64 + lane); v[j] = PRE ? x : gelu_tanh_f(x); s += v[j]; }
        const float mean = wave_sum(s) * (1.f / 256.f); float s2 = 0.f;
#pragma unroll
        for (int j = 0; j < 4; ++j) { v[j] -= mean; s2 += v[j] * v[j]; }
        const float rstd = rsqrtf(wave_sum(s2) * (1.f / 256.f) + 1e-5f);
#pragma unroll
        for (int j = 0; j < 4; ++j) VN[row * GM_W + j * 64 + lane] = v[j] * rstd * g[j * 64 + lane] + b[j * 64 + lane];
    }
}
template <class T, bool PRE> __device__ __forceinline__ void gm_mix_phase(const T* P, ProjL L, const float* VN, const float* ws_, const float* bs, float* GO, int ldo, long n_rows, long gt, long ngt) {
    for (long it = gt; it < n_rows * GM_W; it += ngt) {
        const int c = (int)(it % GM_W); const long row = it / GM_W; const int t = (int)(row % GM_CHUNK), g = c / 64; const long base = row - t;
        const float* w = ws_ + ((long)g * GM_CHUNK + t) * GM_CHUNK; float acc = 0.f;
        for (int s = 0; s <= t; ++s) acc += w[s] * VN[(base + s) * GM_W + c];
        acc += bs[g * GM_CHUNK + t];
        const float x = ldf(P + row * L.ld + L.gu + c); const float u = PRE ? x : gelu_tanh_f(x);
        GO[row * ldo + c] = u * acc;
    }
}

__device__ __forceinline__ void moe_route_phase(const float* H, const float* Wr, int* CNT, int* TE, float* TP, int* TS, long n_rows, int gw, int ngw, int lane) {
    for (long row = gw; row < n_rows; row += ngw) {
        float acc[N_EXP];
#pragma unroll
        for (int e = 0; e < N_EXP; ++e) acc[e] = 0.f;
        for (int j = 0; j < 16; ++j) { const int d = j * 64 + lane; const float hv = H[row * DM + d];
            const float4 w0 = *(const float4*)(Wr + d * N_EXP), w1 = *(const float4*)(Wr + d * N_EXP + 4);
            acc[0] += hv * w0.x; acc[1] += hv * w0.y; acc[2] += hv * w0.z; acc[3] += hv * w0.w; acc[4] += hv * w1.x; acc[5] += hv * w1.y; acc[6] += hv * w1.z; acc[7] += hv * w1.w; }
#pragma unroll
        for (int e = 0; e < N_EXP; ++e) acc[e] = wave_sum(acc[e]);
        int e0 = 0; float v0 = acc[0];
#pragma unroll
        for (int e = 1; e < N_EXP; ++e) if (acc[e] > v0) { v0 = acc[e]; e0 = e; }
        int e1 = -1; float v1 = -3.0e38f;
#pragma unroll
        for (int e = 0; e < N_EXP; ++e) if (e != e0 && acc[e] > v1) { v1 = acc[e]; e1 = e; }
        const float p1 = __expf(v1 - v0), den = 1.f + p1;
        if (lane == 0) {
            const int s0 = atomicAdd(&CNT[e0], 1), s1 = atomicAdd(&CNT[e1], 1);
            TE[row * 2] = e0; TE[row * 2 + 1] = e1; TP[row * 2] = 1.f / den; TP[row * 2 + 1] = p1 / den; TS[row * 2] = s0; TS[row * 2 + 1] = s1;
        }
    }
}
__device__ __forceinline__ int moe_base(const int* CNT, int e) { int b = 0; for (int i = 0; i < e; ++i) b += (CNT[i] + 255) & ~255; return b; }
__device__ __forceinline__ void moe_scatter_phase(const int* CNT, const int* TE, const float* TP, const int* TS, int* LIST, float* SP, int* GS, long n_rows, long gt, long ngt) {
    for (long it = gt; it < n_rows * 2; it += ngt) {
        const int e = TE[it]; const int gs = moe_base(CNT, e) + TS[it];
        LIST[gs] = (int)(it >> 1); SP[gs] = TP[it]; GS[it] = gs;
    }
}

template <class TA, int EPI> __global__ void __launch_bounds__(256) sgemm_k(const TA* A, int lda, const int* rowlist, const float* B, const float* B2, int ldb, long bstride, void* Cv, int ldc, int M, int N, int K, const int* CNT, const float* scale) {
    __shared__ float As[16][68], Bs[16][68], Bs2[16][68];
    int row_base = 0, mrows = M;
    if (CNT) { const int e = blockIdx.z; row_base = moe_base(CNT, e); mrows = CNT[e]; B += (long)e * bstride; if (B2) B2 += (long)e * bstride; }
    const int m0 = blockIdx.y * 64; if (m0 >= mrows) return;
    const int n0 = blockIdx.x * 64, tid = threadIdx.x, tx = tid & 15, ty = tid >> 4;
    float acc[4][4], acc2[4][4];
#pragma unroll
    for (int i = 0; i < 4; ++i)
#pragma unroll
        for (int j = 0; j < 4; ++j) { acc[i][j] = 0.f; acc2[i][j] = 0.f; }
    const int ar = tid >> 2, ak = (tid & 3) * 4; long arow = -1;
    { const int lr = m0 + ar; if (lr < mrows) { arow = rowlist ? (long)rowlist[row_base + lr] : (long)(row_base + lr); } }
    const int bk = tid >> 4, bn = (tid & 15) * 4;
    for (int k0 = 0; k0 < K; k0 += 16) {
        float av[4] = {0.f, 0.f, 0.f, 0.f};
        if (arow >= 0) {
#pragma unroll
            for (int i = 0; i < 4; ++i) av[i] = ldf(A + arow * lda + k0 + ak + i);
        }
#pragma unroll
        for (int i = 0; i < 4; ++i) As[ak + i][ar] = av[i];
#pragma unroll
        for (int i = 0; i < 4; ++i) { const int n = n0 + bn + i; const bool ok = n < N;
            Bs[bk][bn + i] = ok ? B[(long)(k0 + bk) * ldb + n] : 0.f;
            if (EPI == 1 || EPI == 2) Bs2[bk][bn + i] = ok ? B2[(long)(k0 + bk) * ldb + n] : 0.f; }
        __syncthreads();
#pragma unroll
        for (int kk = 0; kk < 16; ++kk) {
            float a[4], b[4], b2[4];
#pragma unroll
            for (int i = 0; i < 4; ++i) { a[i] = As[kk][ty * 4 + i]; b[i] = Bs[kk][tx * 4 + i]; if (EPI == 1 || EPI == 2) b2[i] = Bs2[kk][tx * 4 + i]; }
#pragma unroll
            for (int i = 0; i < 4; ++i)
#pragma unroll
                for (int j = 0; j < 4; ++j) { acc[i][j] += a[i] * b[j]; if (EPI == 1 || EPI == 2) acc2[i][j] += a[i] * b2[j]; }
        }
        __syncthreads();
    }
#pragma unroll
    for (int i = 0; i < 4; ++i) { const int lr = m0 + ty * 4 + i; if (lr >= mrows) continue; const long crow = row_base + lr;
#pragma unroll
        for (int j = 0; j < 4; ++j) { const int n = n0 + tx * 4 + j; if (n >= N) continue;
            float v = acc[i][j];
            if (EPI == 1 || EPI == 2) v = silu_f(v) * acc2[i][j];
            if (EPI == 3) v *= scale[crow];
            if (EPI == 2) ((bf16*)Cv)[crow * ldc + n] = (bf16)f2bf(v); else ((float*)Cv)[crow * ldc + n] = v; } }
}

#define GW_DECL const int lane = threadIdx.x & 63; const int gw = (int)((blockIdx.x * (long)blockDim.x + threadIdx.x) >> 6); const int ngw = (int)((gridDim.x * (long)blockDim.x) >> 6); (void)lane; (void)gw; (void)ngw;
#define GT_DECL const long gt = blockIdx.x * (long)blockDim.x + threadIdx.x; const long ngt = gridDim.x * (long)blockDim.x;

__global__ void k_ln_in(const float* x, const float* g, const float* b, float* H, long n_rows) { GW_DECL for (long r = gw; r < n_rows; r += ngw) ln_row<float>(x + r * DM, 1.f, nullptr, nullptr, g, b, H + r * DM, nullptr, lane); }
__global__ void k_ln_res(float* H, const float* Y, const float* g, const float* b, float* OUT, long n_rows) { GW_DECL for (long r = gw; r < n_rows; r += ngw) ln_row<float>(H + r * DM, ALPHA, Y + r * DM, nullptr, g, b, OUT + r * DM, nullptr, lane); }
__global__ void k_ln_moe(float* H, const float* F2, const int* GS, const float* g, const float* b, float* OUT, long n_rows) { GW_DECL for (long r = gw; r < n_rows; r += ngw) ln_row<float>(H + r * DM, ALPHA, F2 + (long)GS[r * 2] * DM, F2 + (long)GS[r * 2 + 1] * DM, g, b, OUT + r * DM, nullptr, lane); }
__global__ void k_rope(float* P, ProjL L, const int* pos, long n_rows) { GT_DECL rope_inplace(P, L, pos, n_rows, gt, ngt); }
__global__ void k_kmean(const float* P, ProjL L, float* KM, int nb) { GT_DECL kmean_phase<float>(P, L, KM, nb, gt, ngt); }
__global__ void k_attn(const float* P, ProjL L, const float* KM, float* O, int ldo, int nb) { GW_DECL attn_naive_phase<float>(P, L, KM, O, ldo, nb, gw, ngw, lane); }
__global__ void k_rms384(const float* in, int ldi, const float* g, float* out, int ldo, long n_rows) { GW_DECL rms_rows_phase<384, float>(in, ldi, g, out, ldo, n_rows, gw, ngw, lane); }
__global__ void k_rms256(const float* in, int ldi, const float* g, float* out, int ldo, long n_rows) { GW_DECL rms_rows_phase<256, float>(in, ldi, g, out, ldo, n_rows, gw, ngw, lane); }
__global__ void k_ssd_conv(const float* P, ProjL L, const float* cw, const float* cb, const float* dtb, float* XC, float* DT, long n_rows) { GT_DECL ssd_conv_phase<float, float>(P, L, cw, cb, dtb, XC, DT, n_rows, gt, ngt); }
__global__ void k_ssd_scan(const float* XC, const float* DT, const float* a_log, const float* dsk, float* Y, int ldo, int nb) { GW_DECL ssd_scan_naive_phase<float>(XC, DT, a_log, dsk, Y, ldo, nb, gw, ngw, lane); }
__global__ void k_ssd_gate(const float* Y, int ldi, const float* P, ProjL L, const float* ng, float* out, int ldo, long n_rows) { GW_DECL ssd_gate_phase<float, float>(Y, ldi, P, L, ng, out, ldo, n_rows, gw, ngw, lane); }
__global__ void k_gm_ln(const float* P, ProjL L, const float* g, const float* b, float* VN, long n_rows) { GW_DECL gm_ln_phase<float, false>(P, L, g, b, VN, n_rows, gw, ngw, lane); }
__global__ void k_gm_mix(const float* P, ProjL L, const float* VN, const float* ws_, const float* bs, float* GO, int ldo, long n_rows) { GT_DECL gm_mix_phase<float, false>(P, L, VN, ws_, bs, GO, ldo, n_rows, gt, ngt); }
__global__ void k_moe_init(int* CNT, int* LIST, int nslots) { GT_DECL if (gt < N_EXP) CNT[gt] = 0; for (long i = gt; i < nslots; i += ngt) LIST[i] = -1; }
__global__ void k_moe_route(const float* H, const float* Wr, int* CNT, int* TE, float* TP, int* TS, long n_rows) { GW_DECL moe_route_phase(H, Wr, CNT, TE, TP, TS, n_rows, gw, ngw, lane); }
__global__ void k_moe_scatter(const int* CNT, const int* TE, const float* TP, const int* TS, int* LIST, float* SP, int* GS, long n_rows) { GT_DECL moe_scatter_phase(CNT, TE, TP, TS, LIST, SP, GS, n_rows, gt, ngt); }

struct Inputs {
    const float *x; const int* pos; const float *ln_in_g, *ln_in_b, *w_in, *conv_w, *conv_b, *dt_bias, *a_log, *d_skip, *ssd_norm_g, *att_norm_g, *gm_ln_g, *gm_ln_b, *gm_w_s, *gm_b_s, *gm_norm_g, *w_out,
        *ln1_g, *ln1_b, *ln2_g, *ln2_b, *ffn_w_gate, *ffn_w_up, *ffn_w_down, *router_w, *moe_w_gate, *moe_w_up, *moe_w_down;
};

static void run_simple(const Inputs& I, int nb, unsigned char* ws, float* aux  , float* OUT, hipStream_t st, float* ckpt = nullptr) {
    const long M = (long)nb * SEQ; const size_t MB = 1u << 20;
    const size_t hsz = (size_t)M * DM * 4;
    float* H = (float*)ws; float* MIX = (float*)(ws + hsz); float* Y = (float*)(ws + 2 * hsz); unsigned char* BIG = ws + 3 * hsz + (size_t)N_EXP * 256 * DM * 4;
    float* XC = Y;
    float* VN = aux;
    float* PROJ = (float*)BIG;
    size_t big_bytes = (size_t)M * D_IN * 4; { size_t a = (size_t)M * D_FF * 4; if (a > big_bytes) big_bytes = a; size_t c = (size_t)(2 * M + N_EXP * 256) * D_FFE * 2; if (c > big_bytes) big_bytes = c; }
    big_bytes = (big_bytes + 255) & ~(size_t)255;
    unsigned char* SM = BIG + big_bytes;
    float* KM = (float*)SM; SM += (size_t)nb * ATT_H * NBLK * 64 * 4;
    float* DT = (float*)SM; SM += (size_t)M * SSD_H * 4;
    int* CNT = (int*)SM; SM += 256;
    int* TE = (int*)SM; SM += (size_t)M * 2 * 4; float* TP = (float*)SM; SM += (size_t)M * 2 * 4; int* TS = (int*)SM; SM += (size_t)M * 2 * 4; int* GS = (int*)SM; SM += (size_t)M * 2 * 4;
    const int nslots = (int)(2 * M + N_EXP * 256);
    int* LIST = (int*)SM; SM += (size_t)nslots * 4; float* SP = (float*)SM; SM += (size_t)nslots * 4;
    (void)MB;
    const ProjL L{D_IN, 0, 384, 768, 1152, 1536, 2432, 2438, 2694};
    const int TB = 256; const int GWB = 2048;
    k_ln_in<<<GWB, TB, 0, st>>>(I.x, I.ln_in_g, I.ln_in_b, H, M);
    for (int i = 0; i < 2; ++i) {
        sgemm_k<float, 0><<<dim3((D_IN + 63) / 64, (unsigned)(M / 64), 1), 256, 0, st>>>(H, DM, nullptr, I.w_in + (size_t)i * DM * D_IN, nullptr, D_IN, 0, PROJ, D_IN, (int)M, D_IN, DM, nullptr, nullptr);
        k_rope<<<GWB, TB, 0, st>>>(PROJ, L, I.pos, M);
        const size_t ck_stride = (size_t)M * (D_IN + 3 * DM); float* ck = ckpt ? ckpt + (size_t)i * ck_stride : nullptr;
        if (ck) hipMemcpyAsync(ck, PROJ, (size_t)M * D_IN * 4, hipMemcpyDeviceToDevice, st);
        k_kmean<<<96 * nb, TB, 0, st>>>(PROJ, L, KM, nb);
        k_attn<<<GWB * 2, TB, 0, st>>>(PROJ, L, KM, MIX, DM, nb);
        k_rms384<<<GWB, TB, 0, st>>>(MIX, DM, I.att_norm_g + i * ATT_W, MIX, DM, M);
        k_ssd_conv<<<GWB * 2, TB, 0, st>>>(PROJ, L, I.conv_w + (size_t)i * 4 * SSD_CW, I.conv_b + i * SSD_CW, I.dt_bias + i * SSD_H, XC, DT, M);
        k_ssd_scan<<<(nb * SSD_H * 64 * 64 + TB - 1) / TB, TB, 0, st>>>(XC, DT, I.a_log + i * SSD_H, I.d_skip + i * SSD_H, MIX + ATT_W, DM, nb);
        k_ssd_gate<<<GWB, TB, 0, st>>>(MIX + ATT_W, DM, PROJ, L, I.ssd_norm_g + i * SSD_W, MIX + ATT_W, DM, M);
        k_gm_ln<<<GWB, TB, 0, st>>>(PROJ, L, I.gm_ln_g + i * GM_W, I.gm_ln_b + i * GM_W, VN, M);
        k_gm_mix<<<GWB * 2, TB, 0, st>>>(PROJ, L, VN, I.gm_w_s + (size_t)i * GM_G * GM_CHUNK * GM_CHUNK, I.gm_b_s + i * GM_G * GM_CHUNK, MIX + ATT_W + SSD_W, DM, M);
        k_rms256<<<GWB, TB, 0, st>>>(MIX + ATT_W + SSD_W, DM, I.gm_norm_g + i * GM_W, MIX + ATT_W + SSD_W, DM, M);
        if (ck) hipMemcpyAsync(ck + (size_t)M * D_IN, MIX, hsz, hipMemcpyDeviceToDevice, st);
        sgemm_k<float, 0><<<dim3(DM / 64, (unsigned)(M / 64), 1), 256, 0, st>>>(MIX, DM, nullptr, I.w_out + (size_t)i * DM * DM, nullptr, DM, 0, Y, DM, (int)M, DM, DM, nullptr, nullptr);
        k_ln_res<<<GWB, TB, 0, st>>>(H, Y, I.ln1_g + i * DM, I.ln1_b + i * DM, H, M);
        if (ck) hipMemcpyAsync(ck + (size_t)M * (D_IN + DM), H, hsz, hipMemcpyDeviceToDevice, st);
        if (i == 0) {
            float* ACT = (float*)BIG;
            sgemm_k<float, 1><<<dim3(D_FF / 64, (unsigned)(M / 64), 1), 256, 0, st>>>(H, DM, nullptr, I.ffn_w_gate, I.ffn_w_up, D_FF, 0, ACT, D_FF, (int)M, D_FF, DM, nullptr, nullptr);
            sgemm_k<float, 0><<<dim3(DM / 64, (unsigned)(M / 64), 1), 256, 0, st>>>(ACT, D_FF, nullptr, I.ffn_w_down, nullptr, DM, 0, Y, DM, (int)M, DM, D_FF, nullptr, nullptr);
            k_ln_res<<<GWB, TB, 0, st>>>(H, Y, I.ln2_g + i * DM, I.ln2_b + i * DM, H, M);
            if (ck) hipMemcpyAsync(ck + (size_t)M * (D_IN + 2 * DM), H, hsz, hipMemcpyDeviceToDevice, st);
        } else {
            bf16* ACTM = (bf16*)BIG; float* F2 = MIX;
            k_moe_init<<<256, TB, 0, st>>>(CNT, LIST, nslots);
            k_moe_route<<<GWB, TB, 0, st>>>(H, I.router_w, CNT, TE, TP, TS, M);
            k_moe_scatter<<<256, TB, 0, st>>>(CNT, TE, TP, TS, LIST, SP, GS, M);
            sgemm_k<float, 2><<<dim3(D_FFE / 64, (unsigned)(M / 64), N_EXP), 256, 0, st>>>(H, DM, LIST, I.moe_w_gate, I.moe_w_up, D_FFE, (long)DM * D_FFE, ACTM, D_FFE, 0, D_FFE, DM, CNT, nullptr);
            sgemm_k<bf16, 3><<<dim3(DM / 64, (unsigned)(M / 64), N_EXP), 256, 0, st>>>(ACTM, D_FFE, nullptr, I.moe_w_down, nullptr, DM, (long)D_FFE * DM, F2, DM, 0, DM, D_FFE, CNT, SP);
            k_ln_moe<<<GWB, TB, 0, st>>>(H, F2, GS, I.ln2_g + i * DM, I.ln2_b + i * DM, OUT, M);
            if (ck) hipMemcpyAsync(ck + (size_t)M * (D_IN + 2 * DM), OUT, hsz, hipMemcpyDeviceToDevice, st);
        }
    }
}

#define LAS __attribute__((address_space(3)))
namespace pg8 {
#define PG8_LAS __attribute__((address_space(3)))
typedef unsigned short bf16_t;
typedef short bf16x8 __attribute__((ext_vector_type(8)));
typedef float f32x4 __attribute__((ext_vector_type(4)));
typedef unsigned u32x4 __attribute__((ext_vector_type(4)));
constexpr int BM = 256, BK = 64, HALF = 128, HTB = HALF * BK * 2  , STAGE_BYTES = 8 * HTB, NXCD = 8, WGM = 8;

__host__ __device__ __forceinline__ int lds_byte(int r, int c) { const int st = (r >> 4) * 2 + (c >> 5), rr = r & 15, cc = c & 31, ob = rr * 64 + cc * 2; return st * 1024 + (ob ^ (((ob >> 9) & 1) << 5)); }
__host__ __device__ __forceinline__ void stage_rc(int b, int& R, int& C) { const int st = b / 1024, sb = b % 1024, swz = sb ^ (((sb >> 9) & 1) << 5); R = (st >> 1) * 16 + swz / 64; C = (st & 1) * 32 + (swz % 64) / 2; }
__host__ __device__ __forceinline__ int perm32(int rho) { const int n = rho >> 4, i = rho & 15; return 8 * (i >> 2) + 4 * n + (i & 3); }

struct Unit { int pm, pn; };
struct Gemm { const bf16_t* A; const bf16_t* Bt; int M, N, K; };

struct StaticOrder {
    int nM, nN, nwg, G, c;
    __host__ __device__ void init(int M, int N, int G_, int c_) { nM = M / BM; nN = N / BM; nwg = nM * nN; G = G_; c = c_; }
    __host__ __device__ bool next(int i, Unit& u) const {
        const long L = (long)i * G + c; if (L >= nwg) return false;
        int wgid = (int)L; { const int q = nwg / NXCD, r = nwg % NXCD, xcd = wgid % NXCD, off = wgid / NXCD; wgid = (xcd < r ? xcd * (q + 1) : r * (q + 1) + (xcd - r) * q) + off; }
        const int nig = WGM * nN, gid = wgid / nig, fm = gid * WGM, gsz = (nM - fm) < WGM ? (nM - fm) : WGM;
        u.pm = fm + ((wgid % nig) % gsz); u.pn = (wgid % nig) / gsz; return true;
    }
    __device__ __forceinline__ void a_ready(const Unit&) const {}
    __device__ __forceinline__ void done(const Unit&) const {}
};
__device__ __forceinline__ unsigned cvt_pk_bf16(float lo, float hi) { unsigned r; asm volatile("v_cvt_pk_bf16_f32 %0, %1, %2" : "=v"(r) : "v"(lo), "v"(hi)); return r; }
typedef float f32x2 __attribute__((ext_vector_type(2)));
template <class Epi, class Sched, bool ALIGN_EPI = false, bool SP2 = false>
__device__ __forceinline__ void gemm_phase(PG8_LAS unsigned char* lds, const Gemm g, const Sched& S, const Epi& E) {
    const int tid = threadIdx.x, wid = __builtin_amdgcn_readfirstlane(tid >> 6), lane = tid & 63, wr = wid >> 2, wc = wid & 3, fr = lane & 15, fq = lane >> 4;
    const int K = g.K, nt = K / BK;
    unsigned voffA[2], voffB[2];
#pragma unroll
    for (int i = 0; i < 2; ++i) { int R, C; stage_rc(tid * 16 + i * 8192, R, C); const int Rb = Epi::PERM ? ((R & ~31) + perm32(R & 31)) : R;
        voffA[i] = (unsigned)(R * K + C) * 2u; voffB[i] = (unsigned)(Rb * K + C) * 2u; }
    const size_t kstep = (size_t)(BK * 2);
    const size_t hstep = (size_t)HALF * K * 2;
    const size_t tstep = 2 * hstep;
    const unsigned ldsw = (unsigned)wid * 1024u;
    const int aoff = lds_byte(wr * 64 + fr, fq * 8), boff = lds_byte(wc * 32 + fr, fq * 8);
#define PG8_SA(b, h) (((b) * 2 + (h)) * HTB)
#define PG8_SB(b, h) ((4 + (b) * 2 + (h)) * HTB)
#define PG8_STAGE(bufoff, gbase, voff) do { _Pragma("unroll") for (int _i = 0; _i < 2; ++_i) \
        __builtin_amdgcn_global_load_lds((const unsigned*)((const char*)(gbase) + (voff)[_i]), (PG8_LAS unsigned*)(lds + (bufoff) + ldsw + _i * 8192), 16, 0, 0); } while (0)
#define PG8_LDA(dst, b, h) do { _Pragma("unroll") for (int m = 0; m < 4; ++m) _Pragma("unroll") for (int k = 0; k < 2; ++k) dst[m][k] = *(const PG8_LAS bf16x8*)(lds + PG8_SA(b, h) + aoff + m * 2048 + k * 1024); } while (0)
#define PG8_LDB(dst, b, h) do { _Pragma("unroll") for (int n = 0; n < 2; ++n) _Pragma("unroll") for (int k = 0; k < 2; ++k) dst[n][k] = *(const PG8_LAS bf16x8*)(lds + PG8_SB(b, h) + boff + n * 2048 + k * 1024); } while (0)
#define PG8_MMA(ai, bj, At, Bt) do { __builtin_amdgcn_s_setprio(1); _Pragma("unroll") for (int m = 0; m < 4; ++m) _Pragma("unroll") for (int n = 0; n < 2; ++n) _Pragma("unroll") for (int k = 0; k < 2; ++k) \
        acc[ai][bj][m][n] = __builtin_amdgcn_mfma_f32_16x16x32_bf16(Bt[n][k], At[m][k], acc[ai][bj][m][n], 0, 0, 0); __builtin_amdgcn_s_setprio(0); } while (0)
#define PG8_WAIT_V(n) asm volatile("s_waitcnt vmcnt(" #n ")" ::: "memory")
#define PG8_WAIT_L(n) asm volatile("s_waitcnt lgkmcnt(" #n ")" ::: "memory")
#define PG8_BAR __builtin_amdgcn_s_barrier()
#define PG8_SCHED __builtin_amdgcn_sched_barrier(0)
    Unit cur, nxt; int ui = 0;
    if (!S.next(0, cur)) return;
    f32x4 acc[2][2][4][2];
#pragma unroll
    for (int a = 0; a < 2; ++a)
#pragma unroll
        for (int b = 0; b < 2; ++b)
#pragma unroll
            for (int m = 0; m < 4; ++m)
#pragma unroll
                for (int n = 0; n < 2; ++n) acc[a][b][m][n] = (f32x4){0.f, 0.f, 0.f, 0.f};
    bf16x8 At[4][2], B0[2][2], B1[2][2];
    const char* cA = (const char*)g.A + (size_t)cur.pm * tstep; const char* cB = (const char*)g.Bt + (size_t)cur.pn * tstep;
    S.a_ready(cur);
    if constexpr (SP2) {
        PG8_STAGE(PG8_SB(0, 0), cB, voffB); PG8_STAGE(PG8_SB(0, 1), cB + hstep, voffB); PG8_STAGE(PG8_SA(0, 0), cA, voffA); PG8_STAGE(PG8_SA(0, 1), cA + hstep, voffA);
        if (wr == 1) PG8_BAR;
        PG8_WAIT_V(2); PG8_BAR;
        PG8_STAGE(PG8_SB(1, 0), cB + kstep, voffB); PG8_STAGE(PG8_SA(1, 0), cA + kstep, voffA); PG8_STAGE(PG8_SB(1, 1), cB + hstep + kstep, voffB);
        PG8_WAIT_V(6); PG8_BAR;
    } else {
        PG8_STAGE(PG8_SB(0, 0), cB, voffB); PG8_STAGE(PG8_SA(0, 0), cA, voffA); PG8_STAGE(PG8_SB(0, 1), cB + hstep, voffB); PG8_STAGE(PG8_SA(0, 1), cA + hstep, voffA);
        if (wr == 1) PG8_BAR;
        PG8_WAIT_V(4); PG8_BAR;
        PG8_STAGE(PG8_SB(1, 0), cB + kstep, voffB); PG8_STAGE(PG8_SA(1, 0), cA + kstep, voffA); PG8_STAGE(PG8_SB(1, 1), cB + hstep + kstep, voffB);
        PG8_WAIT_V(6); PG8_BAR;
    }
    for (;;) {
        const bool has_next = S.next(ui + 1, nxt);
        const char* nA = has_next ? (const char*)g.A + (size_t)nxt.pm * tstep : cA; const char* nB = has_next ? (const char*)g.Bt + (size_t)nxt.pn * tstep : cB;
        for (int t = 0; t < nt; t += 2) {
            const bool last = (t == nt - 2);
            const char* a1 = cA + (size_t)(t + 1) * kstep;
            const char* a2 = last ? nA : cA + (size_t)(t + 2) * kstep; const char* b2 = last ? nB : cB + (size_t)(t + 2) * kstep;
            const char* a3 = a2 + kstep; const char* b3 = b2 + kstep;
            if (last && has_next) S.a_ready(nxt);
            if constexpr (SP2) {
            PG8_LDB(B0, 0, 0); PG8_LDB(B1, 0, 1); PG8_SCHED; PG8_LDA(At, 0, 0); PG8_STAGE(PG8_SA(1, 1), a1 + hstep, voffA);
            PG8_WAIT_V(8); PG8_WAIT_L(0); PG8_BAR; PG8_MMA(0, 0, At, B0); PG8_MMA(0, 1, At, B1); PG8_BAR; PG8_SCHED;
            PG8_LDA(At, 0, 1); PG8_STAGE(PG8_SB(0, 0), b2, voffB); PG8_STAGE(PG8_SB(0, 1), b2 + hstep, voffB); PG8_STAGE(PG8_SA(0, 0), a2, voffA);
            PG8_WAIT_V(8); PG8_WAIT_L(0); PG8_BAR; PG8_MMA(1, 0, At, B0); PG8_MMA(1, 1, At, B1); PG8_BAR; PG8_SCHED;
            PG8_LDB(B0, 1, 0); PG8_LDB(B1, 1, 1); PG8_SCHED; PG8_LDA(At, 1, 0); PG8_STAGE(PG8_SA(0, 1), a2 + hstep, voffA);
            PG8_WAIT_V(8); PG8_WAIT_L(0); PG8_BAR; PG8_MMA(0, 0, At, B0); PG8_MMA(0, 1, At, B1); PG8_BAR; PG8_SCHED;
            PG8_LDA(At, 1, 1); PG8_STAGE(PG8_SB(1, 0), b3, voffB); PG8_STAGE(PG8_SB(1, 1), b3 + hstep, voffB); PG8_STAGE(PG8_SA(1, 0), a3, voffA);
            PG8_WAIT_V(8); PG8_WAIT_L(0); PG8_BAR; PG8_MMA(1, 0, At, B0); PG8_MMA(1, 1, At, B1); PG8_BAR; PG8_SCHED;
            } else {
            PG8_LDB(B0, 0, 0); PG8_SCHED; PG8_LDA(At, 0, 0); PG8_STAGE(PG8_SA(1, 1), a1 + hstep, voffA);
            PG8_WAIT_L(8); PG8_BAR; PG8_WAIT_L(0); PG8_MMA(0, 0, At, B0); PG8_BAR; PG8_SCHED;
            PG8_LDB(B1, 0, 1); PG8_STAGE(PG8_SB(0, 0), b2, voffB);
            PG8_BAR; PG8_WAIT_L(0); PG8_MMA(0, 1, At, B1); PG8_BAR;
            PG8_LDA(At, 0, 1); PG8_STAGE(PG8_SA(0, 0), a2, voffA);
            PG8_BAR; PG8_WAIT_L(0); PG8_MMA(1, 0, At, B0); PG8_BAR; PG8_SCHED;
            PG8_STAGE(PG8_SB(0, 1), b2 + hstep, voffB);
            PG8_WAIT_V(6); PG8_BAR; PG8_MMA(1, 1, At, B1); PG8_BAR;
            PG8_LDB(B0, 1, 0); PG8_SCHED; PG8_LDA(At, 1, 0); PG8_STAGE(PG8_SA(0, 1), a2 + hstep, voffA);
            PG8_WAIT_L(8); PG8_BAR; PG8_WAIT_L(0); PG8_MMA(0, 0, At, B0); PG8_BAR; PG8_SCHED;
            PG8_LDB(B1, 1, 1); PG8_STAGE(PG8_SB(1, 0), b3, voffB);
            PG8_BAR; PG8_WAIT_L(0); PG8_MMA(0, 1, At, B1); PG8_BAR;
            PG8_LDA(At, 1, 1); PG8_STAGE(PG8_SA(1, 0), a3, voffA);
            PG8_BAR; PG8_WAIT_L(0); PG8_MMA(1, 0, At, B0); PG8_BAR; PG8_SCHED;
            PG8_STAGE(PG8_SB(1, 1), b3 + hstep, voffB);
            PG8_WAIT_V(6); PG8_BAR; PG8_MMA(1, 1, At, B1); PG8_BAR;
            }
        }
        if constexpr (ALIGN_EPI) { if (wr == 0) PG8_BAR; }
        if constexpr (!Epi::AFTER_DRAIN) { E(acc, cur, wr, wc, fr, fq); S.done(cur); }
        if (!has_next) break;
#pragma unroll
        for (int a = 0; a < 2; ++a)
#pragma unroll
            for (int b = 0; b < 2; ++b)
#pragma unroll
                for (int m = 0; m < 4; ++m)
#pragma unroll
                    for (int n = 0; n < 2; ++n) acc[a][b][m][n] = (f32x4){0.f, 0.f, 0.f, 0.f};
        cur = nxt; cA = nA; cB = nB; ++ui;
        if constexpr (ALIGN_EPI) { if (wr == 1) PG8_BAR; }
    }
    PG8_WAIT_V(0);
    if constexpr (!ALIGN_EPI) { if (wr == 0) PG8_BAR; }
    PG8_BAR;
    if constexpr (Epi::AFTER_DRAIN) { E.fused(acc, cur, wr, wc, fr, fq, lds, wid, lane); S.done(cur); }
#undef PG8_SA
#undef PG8_SB
#undef PG8_STAGE
#undef PG8_LDA
#undef PG8_LDB
#undef PG8_MMA
#undef PG8_WAIT_V
#undef PG8_WAIT_L
#undef PG8_BAR
#undef PG8_SCHED
}
}
#define XB_TMO      128
#define XB_XCNT(j)  (256  + 64 * (j))
#define XB_XSUB(j)  (1280 + 64 * (j))
#define XB_XGEN(j)  (2304 + 64 * (j))
#define XB_TOP      3328
#define XB_TOPGEN   3392
#define XCD_BAR_WORDS 3456
#define XB_SPIN_CAP (1u << 18)

__device__ __forceinline__ unsigned xb_ld(unsigned* p)              { return __hip_atomic_load(p, __ATOMIC_RELAXED, __HIP_MEMORY_SCOPE_AGENT); }
__device__ __forceinline__ unsigned xb_add(unsigned* p, unsigned v) { return __hip_atomic_fetch_add(p, v, __ATOMIC_RELAXED, __HIP_MEMORY_SCOPE_AGENT); }
__device__ __forceinline__ unsigned xb_xcc_id() { return (unsigned)__builtin_amdgcn_s_getreg((3 << 11) | 20) & 0xFu; }
#define XB_SPIN(cond, bar) do { unsigned _sp = 0; while (cond) { __builtin_amdgcn_s_sleep(1); \
    if ((++_sp & 255u) == 0u) { if (xb_ld(&(bar)[XB_TMO])) break; if (_sp > XB_SPIN_CAP) { atomicAdd(&(bar)[XB_TMO], 1u); break; } } } } while (0)

struct XcdBarrier {
    unsigned* bar; unsigned x;
    volatile LAS unsigned* st;
};

__device__ __forceinline__ XcdBarrier xcd_barrier_post(unsigned* bar, volatile LAS unsigned* st) {
    XcdBarrier b; b.bar = bar; b.x = xb_xcc_id(); b.st = st;
    if (threadIdx.x == 0) (void)xb_add(&bar[XB_XCNT(b.x)], 1u);
    return b;
}
__device__ __forceinline__ void xcd_barrier_complete(unsigned* bar, unsigned x, unsigned& nloc, unsigned& nx) {
    const unsigned G = gridDim.x * gridDim.y * gridDim.z;
    unsigned sum, cnt, mine, sp = 0u;
    for (;;) {
        sum = 0u; cnt = 0u; mine = 0u;
#pragma unroll
        for (unsigned j = 0; j < 16; ++j) { const unsigned c = xb_ld(&bar[XB_XCNT(j)]); sum += c; cnt += (c > 0u) ? 1u : 0u; mine = (j == x) ? c : mine; }
        if (sum == G) break;
        __builtin_amdgcn_s_sleep(1);
        if ((++sp & 255u) == 0u) { if (xb_ld(&bar[XB_TMO])) break; if (sp > XB_SPIN_CAP) { atomicAdd(&bar[XB_TMO], 1u); break; } }
    }
    nloc = mine > 0u ? mine : 1u; nx = cnt > 0u ? cnt : 1u;
}

__device__ __forceinline__ void xcd_barrier(const XcdBarrier& b) {
    asm volatile("s_waitcnt vmcnt(0)" ::: "memory");
    __syncthreads();
    if (threadIdx.x == 0) {
        unsigned* bar = b.bar;
        __builtin_amdgcn_s_waitcnt(0);
        unsigned nloc = b.st[0], nx = b.st[1];
        if (nloc == 0u) { xcd_barrier_complete(bar, b.x, nloc, nx); b.st[0] = nloc; b.st[1] = nx; }
        const unsigned old = xb_add(&bar[XB_XSUB(b.x)], 1u);
        const unsigned gen = old / nloc;
        if (old + 1u == (gen + 1u) * nloc) {
            __builtin_amdgcn_fence(__ATOMIC_RELEASE, "agent");
            asm volatile("s_waitcnt vmcnt(0)" ::: "memory");
            const unsigned og = xb_add(&bar[XB_TOP], 1u);
            const unsigned tg = og / nx;
            if (og + 1u == (tg + 1u) * nx) xb_add(&bar[XB_TOPGEN], 1u);
            else XB_SPIN(xb_ld(&bar[XB_TOPGEN]) == tg, bar);
            __builtin_amdgcn_fence(__ATOMIC_ACQUIRE, "agent");
            xb_add(&bar[XB_XGEN(b.x)], 1u);
            asm volatile("s_waitcnt vmcnt(0)" ::: "memory");
        } else {
            XB_SPIN(xb_ld(&bar[XB_XGEN(b.x)]) == gen, bar);
            __builtin_amdgcn_fence(__ATOMIC_ACQUIRE, "agent");
            asm volatile("s_waitcnt vmcnt(0)" ::: "memory");
        }
    }
    __syncthreads();
}
#undef LAS
constexpr int NB = DEBUG_BUILD ? 2 : 8;
constexpr int M_ = NB * SEQ;
constexpr int NSLOT = 2 * M_ + N_EXP * 256;
constexpr int PLD = 3072;
constexpr int FQ = 0, FK = 384, FV = 768, FZ = 1152, FGU = 1536, FGV = 1792, FXBC = 2048, FDT = 2944;
constexpr int NGU = 2 * D_FF, NGUE = 2 * D_FFE;

constexpr size_t al256(size_t x) { return (x + 255) & ~(size_t)255; }
constexpr size_t MiB = 1u << 20;
constexpr size_t O_CTL = 0, CTL_BYTES = 1 * MiB;
constexpr size_t O_RT = 1 * MiB;
constexpr size_t O_TE = O_RT + (size_t)M_ * 64, O_TP = O_TE + (size_t)M_ * 8, O_TS = O_TP + (size_t)M_ * 8, O_GS = O_TS + (size_t)M_ * 8;
constexpr size_t O_SP = O_GS + (size_t)M_ * 8;
constexpr size_t O_KM = O_SP + al256((size_t)NSLOT * 4);
constexpr size_t O_DT = O_KM + (size_t)NB * ATT_H * NBLK * 64 * 4;
constexpr size_t O_HB = (O_DT + (size_t)M_ * 24 + MiB - 1) / MiB * MiB;
constexpr size_t O_MWGU = O_HB + (size_t)M_ * DM * 2;
constexpr size_t O_WIN = O_MWGU + (size_t)N_EXP * NGUE * DM * 2;
constexpr size_t O_WOUT = O_WIN + (size_t)2 * PLD * DM * 2;
constexpr size_t O_WGU = O_WOUT + (size_t)2 * DM * DM * 2;
constexpr size_t O_WD = O_WGU + (size_t)NGU * DM * 2;
constexpr size_t O_SCR = O_WD + (size_t)DM * D_FF * 2;
constexpr size_t O_PROJ = O_SCR;
constexpr size_t O_XC = O_PROJ + (size_t)M_ * PLD * 2;
constexpr size_t O_MIXU = O_XC + (size_t)M_ * SSD_CW * 2;
constexpr size_t O_MIXB = O_MIXU + (size_t)M_ * DM * 4;
constexpr size_t O_VN = O_MIXB + (size_t)M_ * DM * 2;
constexpr size_t O_MIXEND = O_VN + (size_t)M_ * GM_W * 4;
constexpr size_t O_Y = O_SCR;
constexpr size_t O_ACT = O_Y + (size_t)M_ * DM * 4;
constexpr size_t O_XG = O_WIN;
constexpr size_t O_ACTM = O_XG + (size_t)NSLOT * DM * 2;
constexpr size_t O_MOEEND = O_ACTM + (size_t)NSLOT * D_FFE * 2;
constexpr size_t WS_END = O_MOEEND > O_MIXEND ? O_MOEEND : O_MIXEND;
static_assert(O_ACT + (size_t)M_ * D_FF * 2 <= O_MIXEND + (size_t)M_ * 4096, "act");
static_assert(WS_END <= 487000000ull, "workspace map exceeds the guaranteed size");
static_assert((size_t)N_EXP * DM * D_FFE * 2 <= (size_t)N_EXP * NGUE * DM * 2, "MWD fits over MWGU");
constexpr int CW_BAR = 4096, CW_CNT = 1024, CW_ERR = 2048;

constexpr int RING_BYTES = 131072, MISC_OFF = RING_BYTES + 320, LDS_BYTES = 147456;

#define GAS __attribute__((address_space(1)))
#define LAS __attribute__((address_space(3)))
typedef GAS unsigned gu32;
#define RLX_AGENT __ATOMIC_RELAXED, __HIP_MEMORY_SCOPE_AGENT
#define LDS_WAIT() asm volatile("s_waitcnt lgkmcnt(0)" ::: "memory")

namespace fp {
using pg8::Unit; using pg8::BM; using pg8::HALF; typedef pg8::f32x4 f32x4; typedef pg8::u32x4 u32x4;
__device__ __forceinline__ unsigned pk2(float lo, float hi) { return pg8::cvt_pk_bf16(lo, hi); }
__device__ __forceinline__ float gelu_fast(float x) { const float u = 0.7978845608028654f * (x + 0.044715f * x * x * x); return x / (1.f + __expf(-2.f * u)); }

struct EpiProj {
    static constexpr bool PERM = true, AFTER_DRAIN = false;
    bf16* O; const float* RT;
    __device__ __forceinline__ void operator()(const f32x4 (&acc)[2][2][4][2], const Unit& u, int wr, int wc, int fr, int fq) const {
        const int row0 = u.pm * BM + wr * 64 + fr, col0 = u.pn * BM + wc * 32 + 8 * fq;
        const int mode = (u.pn < 3) ? 1 : ((u.pn == 6 || u.pn == 7) ? 2 : 0);
        const bool rl = ((wc & 1) == 0) && (fq < 2);
        const int i0 = (fq & 1) * 4;
#pragma unroll
        for (int ai = 0; ai < 2; ++ai)
#pragma unroll
            for (int m = 0; m < 4; ++m) { const int row = row0 + ai * HALF + m * 16;
                float4 c4 = make_float4(1.f, 1.f, 1.f, 1.f), s4 = make_float4(0.f, 0.f, 0.f, 0.f);
                if (mode == 1 && rl) { c4 = *(const float4*)(RT + (size_t)row * 16 + i0); s4 = *(const float4*)(RT + (size_t)row * 16 + 8 + i0); }
#pragma unroll
                for (int bj = 0; bj < 2; ++bj) { f32x4 v0 = acc[ai][bj][m][0], v1 = acc[ai][bj][m][1];
                    if (mode == 1) { const f32x4 a = v0, b = v1;
                        v0[0] = a[0] * c4.x - a[1] * s4.x; v0[1] = a[1] * c4.x + a[0] * s4.x; v0[2] = a[2] * c4.y - a[3] * s4.y; v0[3] = a[3] * c4.y + a[2] * s4.y;
                        v1[0] = b[0] * c4.z - b[1] * s4.z; v1[1] = b[1] * c4.z + b[0] * s4.z; v1[2] = b[2] * c4.w - b[3] * s4.w; v1[3] = b[3] * c4.w + b[2] * s4.w; }
                    if (mode == 2) {
#pragma unroll
                        for (int j = 0; j < 4; ++j) { v0[j] = gelu_fast(v0[j]); v1[j] = gelu_fast(v1[j]); } }
                    u32x4 w; w.x = pk2(v0[0], v0[1]); w.y = pk2(v0[2], v0[3]); w.z = pk2(v1[0], v1[1]); w.w = pk2(v1[2], v1[3]);
                    *(u32x4*)(O + (size_t)row * PLD + col0 + bj * HALF) = w; } }
    }
};
struct EpiAct {
    static constexpr bool PERM = true, AFTER_DRAIN = false;
    bf16* O; int ldc, ncol;
    __device__ __forceinline__ void operator()(const f32x4 (&acc)[2][2][4][2], const Unit& u, int wr, int wc, int fr, int fq) const {
        const int row0 = u.pm * BM + wr * 64 + fr, col0 = (u.pn % ncol) * HALF + wc * 32 + 8 * fq;
#pragma unroll
        for (int ai = 0; ai < 2; ++ai)
#pragma unroll
            for (int m = 0; m < 4; ++m) { const int row = row0 + ai * HALF + m * 16;
                const f32x4 g0 = acc[ai][0][m][0], g1 = acc[ai][0][m][1], u0 = acc[ai][1][m][0], u1 = acc[ai][1][m][1]; f32x4 a0, a1;
#pragma unroll
                for (int j = 0; j < 4; ++j) { a0[j] = g0[j] / (1.f + __expf(-g0[j])) * u0[j]; a1[j] = g1[j] / (1.f + __expf(-g1[j])) * u1[j]; }
                u32x4 w; w.x = pk2(a0[0], a0[1]); w.y = pk2(a0[2], a0[3]); w.z = pk2(a1[0], a1[1]); w.w = pk2(a1[2], a1[3]);
                *(u32x4*)(O + (size_t)row * ldc + col0) = w; }
    }
};
struct EpiF32 {
    static constexpr bool PERM = false, AFTER_DRAIN = false;
    float* O; int ldc;
    __device__ __forceinline__ void operator()(const f32x4 (&acc)[2][2][4][2], const Unit& u, int wr, int wc, int fr, int fq) const {
        const int row0 = u.pm * BM + wr * 64 + fr, col0 = u.pn * BM + wc * 32 + 4 * fq;
#pragma unroll
        for (int ai = 0; ai < 2; ++ai)
#pragma unroll
            for (int m = 0; m < 4; ++m) { float* rp = O + (size_t)(row0 + ai * HALF + m * 16) * ldc + col0;
#pragma unroll
                for (int bj = 0; bj < 2; ++bj)
#pragma unroll
                    for (int n = 0; n < 2; ++n) *(f32x4*)(rp + bj * HALF + n * 16) = acc[ai][bj][m][n]; }
    }
};
struct EpiF2 {
    static constexpr bool PERM = true, AFTER_DRAIN = false;
    bf16* O; const float* SP;
    __device__ __forceinline__ void operator()(const f32x4 (&acc)[2][2][4][2], const Unit& u, int wr, int wc, int fr, int fq) const {
        const int row0 = u.pm * BM + wr * 64 + fr, col0 = (u.pn & 3) * BM + wc * 32 + 8 * fq;
#pragma unroll
        for (int ai = 0; ai < 2; ++ai)
#pragma unroll
            for (int m = 0; m < 4; ++m) { const int row = row0 + ai * HALF + m * 16; const float sc = SP[row];
#pragma unroll
                for (int bj = 0; bj < 2; ++bj) { const f32x4 v0 = acc[ai][bj][m][0] * sc, v1 = acc[ai][bj][m][1] * sc;
                    u32x4 w; w.x = pk2(v0[0], v0[1]); w.y = pk2(v0[2], v0[3]); w.z = pk2(v1[0], v1[1]); w.w = pk2(v1[2], v1[3]);
                    *(u32x4*)(O + (size_t)row * DM + col0 + bj * HALF) = w; } }
    }
};
struct MoeOrder {
    int p0, p1, p2, p3, p4, p5, p6, T, ncol, G, c;
    __device__ __forceinline__ void init(const int* CNT, int ncol_, int G_, int c_) {
        int t = 0; t += (CNT[0] + 255) >> 8; p0 = t; t += (CNT[1] + 255) >> 8; p1 = t; t += (CNT[2] + 255) >> 8; p2 = t; t += (CNT[3] + 255) >> 8; p3 = t;
        t += (CNT[4] + 255) >> 8; p4 = t; t += (CNT[5] + 255) >> 8; p5 = t; t += (CNT[6] + 255) >> 8; p6 = t; t += (CNT[7] + 255) >> 8; T = t; ncol = ncol_; G = G_; c = c_;
    }
    __device__ __forceinline__ bool next(int i, Unit& u) const {
        const long L = (long)i * G + c; if (L >= (long)T * ncol) return false;
        const int tm = (int)(L / ncol), j = (int)(L % ncol);
        const int e = (tm >= p0) + (tm >= p1) + (tm >= p2) + (tm >= p3) + (tm >= p4) + (tm >= p5) + (tm >= p6);
        u.pm = tm; u.pn = e * ncol + j; return true;
    }
    __device__ __forceinline__ void a_ready(const Unit&) const {}
    __device__ __forceinline__ void done(const Unit&) const {}
};

struct SrcCol { const float* p; int ld; };
__device__ __forceinline__ int win_src_col(int d) {
    if (d < 768) { const int hd = d & 63; const int sd = hd < 16 ? ((hd & 1) ? 8 + (hd >> 1) : (hd >> 1)) : hd; return d - hd + sd; }
    if (d < 1536) return d;
    if (d < 1792) return 2438 + (d - 1536);
    if (d < 2048) return 2694 + (d - 1792);
    if (d < 2944) return 1536 + (d - 2048);
    if (d < 2950) return 2432 + (d - 2944);
    return -1;
}
__device__ __forceinline__ SrcCol gu_src(const float* wg, const float* wu, int nff, int r) {
    const int tile = r >> 8, rr = r & 255, j = tile * 128 + (rr & 127); SrcCol s; s.p = (rr < 128 ? wg : wu) + j; s.ld = nff; return s;
}
__device__ __forceinline__ void conv_item(SrcCol sc, int K, bf16* WT, long d0, int k0, LAS float* scr, int lane) {
#pragma unroll 8
    for (int i = 0; i < 32; ++i) { const int kk = 2 * i + (lane >> 5); scr[kk * 33 + (lane & 31)] = sc.p ? sc.p[(size_t)(k0 + kk) * sc.ld] : 0.f; }
    LDS_WAIT(); asm volatile("" ::: "memory");
    const int c = lane & 7;
#pragma unroll
    for (int j = 0; j < 4; ++j) { const int n = (lane >> 3) + 8 * j; const LAS float* s = scr + (8 * c) * 33 + n;
        u32x4 o; o.x = pk2(s[0 * 33], s[1 * 33]); o.y = pk2(s[2 * 33], s[3 * 33]); o.z = pk2(s[4 * 33], s[5 * 33]); o.w = pk2(s[6 * 33], s[7 * 33]);
        *(u32x4*)(WT + (size_t)(d0 + n) * K + k0 + 8 * c) = o; }
    LDS_WAIT(); asm volatile("" ::: "memory");
}
}

struct FArgs { const void* in[29]; float* out; unsigned char* ws; int ph_lo, ph_hi; };

constexpr int N_PHASES = 21;
__global__ void __launch_bounds__(512, 2) mega(FArgs a) {
    extern __shared__ __attribute__((aligned(16))) unsigned char lds_[];
    LAS unsigned char* lds = (LAS unsigned char*)lds_;
    const int tid = threadIdx.x, lane = tid & 63, wave = __builtin_amdgcn_readfirstlane(tid >> 6);
    const int G = gridDim.x; const int bx = blockIdx.x; const int vcu = (G % 8 == 0) ? (bx % 8) * (G / 8) + bx / 8 : bx;
    const int gw = vcu * 8 + wave, ngw = G * 8; const long gt = (long)gw * 64 + lane, ngt = (long)ngw * 64;
    unsigned char* ws = a.ws;
    unsigned* ctl = (unsigned*)(ws + O_CTL);
    for (int u = tid; u < (LDS_BYTES - RING_BYTES) / 4; u += 512) ((LAS unsigned*)(lds + RING_BYTES))[u] = 0u;
    __syncthreads();
    const int lo = a.ph_lo, hi = a.ph_hi;
    XcdBarrier bar; bar.bar = ctl + CW_BAR; bar.x = 0; bar.st = nullptr;
    if (hi - lo > 1) bar = xcd_barrier_post(ctl + CW_BAR, (volatile LAS unsigned*)(lds + MISC_OFF) + 8);
    const float* x = (const float*)a.in[0]; const int* pos = (const int*)a.in[1]; const float* ln_in_g = (const float*)a.in[2]; const float* ln_in_b = (const float*)a.in[3];
    const float* w_in = (const float*)a.in[4]; const float* conv_w = (const float*)a.in[5]; const float* conv_b = (const float*)a.in[6]; const float* dt_bias = (const float*)a.in[7];
    const float* a_log = (const float*)a.in[8]; const float* d_skip = (const float*)a.in[9]; const float* ssd_norm_g = (const float*)a.in[10]; const float* att_norm_g = (const float*)a.in[11];
    const float* gm_ln_g = (const float*)a.in[12]; const float* gm_ln_b = (const float*)a.in[13]; const float* gm_w_s = (const float*)a.in[14]; const float* gm_b_s = (const float*)a.in[15];
    const float* gm_norm_g = (const float*)a.in[16]; const float* w_out = (const float*)a.in[17]; const float* ln1_g = (const float*)a.in[18]; const float* ln1_b = (const float*)a.in[19];
    const float* ln2_g = (const float*)a.in[20]; const float* ln2_b = (const float*)a.in[21]; const float* ffn_w_gate = (const float*)a.in[22]; const float* ffn_w_up = (const float*)a.in[23];
    const float* ffn_w_down = (const float*)a.in[24]; const float* router_w = (const float*)a.in[25]; const float* moe_w_gate = (const float*)a.in[26]; const float* moe_w_up = (const float*)a.in[27];
    const float* moe_w_down = (const float*)a.in[28];
    float* H = a.out;
    float* RT = (float*)(ws + O_RT); int* TE = (int*)(ws + O_TE); float* TP = (float*)(ws + O_TP); int* TS = (int*)(ws + O_TS); int* GS = (int*)(ws + O_GS); float* SP = (float*)(ws + O_SP);
    float* KM = (float*)(ws + O_KM); float* DT = (float*)(ws + O_DT); bf16* HB = (bf16*)(ws + O_HB); bf16* MWGU = (bf16*)(ws + O_MWGU); bf16* MWD = (bf16*)(ws + O_MWGU);
    bf16* WIN = (bf16*)(ws + O_WIN); bf16* WOUT = (bf16*)(ws + O_WOUT); bf16* WGU = (bf16*)(ws + O_WGU); bf16* WD = (bf16*)(ws + O_WD);
    bf16* PROJ = (bf16*)(ws + O_PROJ); bf16* XC = (bf16*)(ws + O_XC); float* MIXU = (float*)(ws + O_MIXU); bf16* MIXB = (bf16*)(ws + O_MIXB); float* VN = (float*)(ws + O_VN);
    float* Y = (float*)(ws + O_Y); bf16* ACT = (bf16*)(ws + O_ACT); bf16* XG = (bf16*)(ws + O_XG); bf16* F2 = (bf16*)(ws + O_XG); bf16* ACTM = (bf16*)(ws + O_ACTM);
    int* CNT = (int*)(ctl + CW_CNT);
    const ProjL FL{PLD, FQ, FK, FV, FZ, FXBC, FDT, FGU, FGV};
    LAS float* scr = (LAS float*)(lds + wave * 16384);

#ifndef PH_MASK
#define PH_MASK 0xffffffffu
#endif
#define PH_BEGIN(k) if (lo <= (k) && (k) < hi && ((PH_MASK >> (k)) & 1u)) {
#define PH_END(k)   if ((k) + 1 < hi) xcd_barrier(bar); }

    PH_BEGIN(0)
    {
        constexpr int I_WIN = 16 * (PLD / 32), I_WOUT = 16 * (DM / 32), I_WGU = 16 * (NGU / 32), I_WD = (D_FF / 64) * (DM / 32), I_MWGU = 16 * (N_EXP * NGUE / 32);
        constexpr int NIT = 2 * I_WIN + 2 * I_WOUT + I_WGU + I_WD + I_MWGU;
        for (int it = gw; it < NIT; it += ngw) {
            int r = it; const int l5 = lane & 31;
            if (r < 2 * I_WIN) { const int L = r / I_WIN; r -= L * I_WIN; const int kb = r / (PLD / 32), db = r % (PLD / 32); const int sc_ = fp::win_src_col(db * 32 + l5);
                fp::SrcCol s; s.p = sc_ >= 0 ? w_in + (size_t)L * DM * D_IN + sc_ : nullptr; s.ld = D_IN; fp::conv_item(s, DM, WIN + (size_t)L * PLD * DM, db * 32, kb * 64, scr, lane); continue; } r -= 2 * I_WIN;
            if (r < 2 * I_WOUT) { const int L = r / I_WOUT; r -= L * I_WOUT; const int kb = r / (DM / 32), db = r % (DM / 32);
                fp::SrcCol s; s.p = w_out + (size_t)L * DM * DM + db * 32 + l5; s.ld = DM; fp::conv_item(s, DM, WOUT + (size_t)L * DM * DM, db * 32, kb * 64, scr, lane); continue; } r -= 2 * I_WOUT;
            if (r < I_WGU) { const int kb = r / (NGU / 32), db = r % (NGU / 32);
                fp::conv_item(fp::gu_src(ffn_w_gate, ffn_w_up, D_FF, db * 32 + l5), DM, WGU, db * 32, kb * 64, scr, lane); continue; } r -= I_WGU;
            if (r < I_WD) { const int kb = r / (DM / 32), db = r % (DM / 32);
                fp::SrcCol s; s.p = ffn_w_down + db * 32 + l5; s.ld = DM; fp::conv_item(s, D_FF, WD, db * 32, kb * 64, scr, lane); continue; } r -= I_WD;
            { const int kb = r / (N_EXP * NGUE / 32), db = r % (N_EXP * NGUE / 32); const int d = db * 32 + l5, e = d / NGUE;
                fp::conv_item(fp::gu_src(moe_w_gate + (size_t)e * DM * D_FFE, moe_w_up + (size_t)e * DM * D_FFE, D_FFE, d - e * NGUE), DM, MWGU, (long)db * 32, kb * 64, scr, lane); }
        }
        for (long it = gt; it < (long)M_ * 8; it += ngt) { const int i = (int)(it & 7); const long row = it >> 3;
            const float inv = powf(500000.0f, -(float)(2 * i) / 16.0f); const float ang = (float)pos[row] * inv; RT[row * 16 + i] = cosf(ang); RT[row * 16 + 8 + i] = sinf(ang); }
        for (long r = gw; r < M_; r += ngw) ln_row<float>(x + r * DM, 1.f, nullptr, nullptr, ln_in_g, ln_in_b, H + r * DM, HB + r * DM, lane);
    }
    PH_END(0)


    { constexpr int layer = 0; constexpr int PB = 1;
        PH_BEGIN(PB + 0)
        { pg8::Gemm g{HB, WIN + (size_t)layer * PLD * DM, M_, PLD, DM}; pg8::StaticOrder S; S.init(M_, PLD, G, bx);
          fp::EpiProj E{PROJ, RT}; pg8::gemm_phase<fp::EpiProj, pg8::StaticOrder, true, true>(lds, g, S, E); }
        PH_END(PB + 0)
        PH_BEGIN(PB + 1)
        { kmean_phase<bf16>(PROJ, FL, KM, NB, gt, ngt);
          ssd_conv_phase<bf16, bf16>(PROJ, FL, conv_w + (size_t)layer * 4 * SSD_CW, conv_b + layer * SSD_CW, dt_bias + layer * SSD_H, XC, DT, M_, gt, ngt);
          gm_ln_phase<bf16, true>(PROJ, FL, gm_ln_g + layer * GM_W, gm_ln_b + layer * GM_W, VN, M_, gw, ngw, lane); }
        PH_END(PB + 1)
        PH_BEGIN(PB + 2)
        { ssd_scan_naive_phase<bf16>(XC, DT, a_log + layer * SSD_H, d_skip + layer * SSD_H, MIXU + ATT_W, DM, NB, gw, ngw, lane);
          attn_naive_phase<bf16>(PROJ, FL, KM, MIXU, DM, NB, gw, ngw, lane);
          gm_mix_phase<bf16, true>(PROJ, FL, VN, gm_w_s + (size_t)layer * GM_G * GM_CHUNK * GM_CHUNK, gm_b_s + layer * GM_G * GM_CHUNK, MIXU + ATT_W + SSD_W, DM, M_, gt, ngt); }
        PH_END(PB + 2)
        PH_BEGIN(PB + 3)
        { rms_rows_phase<384, bf16>(MIXU, DM, att_norm_g + layer * ATT_W, MIXB, DM, M_, gw, ngw, lane);
          ssd_gate_phase<bf16, bf16>(MIXU + ATT_W, DM, PROJ, FL, ssd_norm_g + layer * SSD_W, MIXB + ATT_W, DM, M_, gw, ngw, lane);
          rms_rows_phase<256, bf16>(MIXU + ATT_W + SSD_W, DM, gm_norm_g + layer * GM_W, MIXB + ATT_W + SSD_W, DM, M_, gw, ngw, lane); }
        PH_END(PB + 3)
        PH_BEGIN(PB + 4)
        { pg8::Gemm g{MIXB, WOUT + (size_t)layer * DM * DM, M_, DM, DM}; pg8::StaticOrder S; S.init(M_, DM, G, bx);
          fp::EpiF32 E{Y, DM}; pg8::gemm_phase<fp::EpiF32, pg8::StaticOrder, false, true>(lds, g, S, E); }
        PH_END(PB + 4)
        PH_BEGIN(PB + 5)
        { for (long r = gw; r < M_; r += ngw) ln_row<float>(H + r * DM, ALPHA, Y + r * DM, nullptr, ln1_g + layer * DM, ln1_b + layer * DM, H + r * DM, HB + r * DM, lane);
          if (layer == 1) { asm volatile("s_waitcnt vmcnt(0)" ::: "memory"); moe_route_phase(H, router_w, CNT, TE, TP, TS, M_, gw, ngw, lane); } }
        PH_END(PB + 5)
        if constexpr (layer == 0) {
            PH_BEGIN(PB + 6)
            { pg8::Gemm g{HB, WGU, M_, NGU, DM}; pg8::StaticOrder S; S.init(M_, NGU, G, bx);
              fp::EpiAct E{ACT, D_FF, NGU / 256}; pg8::gemm_phase<fp::EpiAct, pg8::StaticOrder, true, true>(lds, g, S, E); }
            PH_END(PB + 6)
            PH_BEGIN(PB + 7)
            { pg8::Gemm g{ACT, WD, M_, DM, D_FF}; pg8::StaticOrder S; S.init(M_, DM, G, bx);
              fp::EpiF32 E{Y, DM}; pg8::gemm_phase<fp::EpiF32, pg8::StaticOrder, false, true>(lds, g, S, E); }
            PH_END(PB + 7)
            PH_BEGIN(PB + 8)
            { for (long r = gw; r < M_; r += ngw) ln_row<float>(H + r * DM, ALPHA, Y + r * DM, nullptr, ln2_g + layer * DM, ln2_b + layer * DM, H + r * DM, HB + r * DM, lane); }
            PH_END(PB + 8)
        } else {
            PH_BEGIN(PB + 6)
            { for (long it = gw; it < (long)M_ * 2; it += ngw) { const int e = TE[it]; const int gs = moe_base(CNT, e) + TS[it];
                  if (lane == 0) { SP[gs] = TP[it]; GS[it] = gs; }
                  const uint4* src = (const uint4*)(HB + (it >> 1) * DM); uint4* dst = (uint4*)(XG + (size_t)gs * DM); dst[lane] = src[lane]; dst[lane + 64] = src[lane + 64]; }
              for (int it = gw; it < N_EXP * 256; it += ngw) { const int e = it >> 8, r = it & 255; const int c = CNT[e]; const int slot = moe_base(CNT, e) + c + r;
                  if (c + r < ((c + 255) & ~255)) { uint4* dst = (uint4*)(XG + (size_t)slot * DM); const uint4 z = make_uint4(0u, 0u, 0u, 0u); dst[lane] = z; dst[lane + 64] = z; if (lane == 0) SP[slot] = 0.f; } } }
            PH_END(PB + 6)
            PH_BEGIN(PB + 7)
            { pg8::Gemm g{XG, MWGU, NSLOT, N_EXP * NGUE, DM}; fp::MoeOrder S; S.init(CNT, NGUE / 256, G, bx);
              fp::EpiAct E{ACTM, D_FFE, NGUE / 256}; pg8::gemm_phase<fp::EpiAct, fp::MoeOrder, true, true>(lds, g, S, E); }
            PH_END(PB + 7)
            PH_BEGIN(PB + 8)
            { constexpr int I_MWD = (D_FFE / 64) * (N_EXP * DM / 32);
              for (int it = gw; it < I_MWD; it += ngw) { const int kb = it / (N_EXP * DM / 32), db = it % (N_EXP * DM / 32); const int d = db * 32 + (lane & 31), e = d / DM;
                  fp::SrcCol s; s.p = moe_w_down + (size_t)e * D_FFE * DM + (d - e * DM); s.ld = DM; fp::conv_item(s, D_FFE, MWD, (long)db * 32, kb * 64, scr, lane); } }
            PH_END(PB + 8)
            PH_BEGIN(PB + 9)
            { pg8::Gemm g{ACTM, MWD, NSLOT, N_EXP * DM, D_FFE}; fp::MoeOrder S; S.init(CNT, DM / 256, G, bx);
              fp::EpiF2 E{F2, SP}; pg8::gemm_phase<fp::EpiF2, fp::MoeOrder, true, true>(lds, g, S, E); }
            PH_END(PB + 9)
            PH_BEGIN(PB + 10)
            { for (long r = gw; r < M_; r += ngw) ln_row<bf16>(H + r * DM, ALPHA, F2 + (size_t)GS[r * 2] * DM, F2 + (size_t)GS[r * 2 + 1] * DM, ln2_g + layer * DM, ln2_b + layer * DM, H + r * DM, nullptr, lane); }
            PH_END(PB + 10)
        }
    }

    { constexpr int layer = 1; constexpr int PB = 10;
        PH_BEGIN(PB + 0)
        { pg8::Gemm g{HB, WIN + (size_t)layer * PLD * DM, M_, PLD, DM}; pg8::StaticOrder S; S.init(M_, PLD, G, bx);
          fp::EpiProj E{PROJ, RT}; pg8::gemm_phase<fp::EpiProj, pg8::StaticOrder, true, true>(lds, g, S, E); }
        PH_END(PB + 0)
        PH_BEGIN(PB + 1)
        { kmean_phase<bf16>(PROJ, FL, KM, NB, gt, ngt);
          ssd_conv_phase<bf16, bf16>(PROJ, FL, conv_w + (size_t)layer * 4 * SSD_CW, conv_b + layer * SSD_CW, dt_bias + layer * SSD_H, XC, DT, M_, gt, ngt);
          gm_ln_phase<bf16, true>(PROJ, FL, gm_ln_g + layer * GM_W, gm_ln_b + layer * GM_W, VN, M_, gw, ngw, lane); }
        PH_END(PB + 1)
        PH_BEGIN(PB + 2)
        { ssd_scan_naive_phase<bf16>(XC, DT, a_log + layer * SSD_H, d_skip + layer * SSD_H, MIXU + ATT_W, DM, NB, gw, ngw, lane);
          attn_naive_phase<bf16>(PROJ, FL, KM, MIXU, DM, NB, gw, ngw, lane);
          gm_mix_phase<bf16, true>(PROJ, FL, VN, gm_w_s + (size_t)layer * GM_G * GM_CHUNK * GM_CHUNK, gm_b_s + layer * GM_G * GM_CHUNK, MIXU + ATT_W + SSD_W, DM, M_, gt, ngt); }
        PH_END(PB + 2)
        PH_BEGIN(PB + 3)
        { rms_rows_phase<384, bf16>(MIXU, DM, att_norm_g + layer * ATT_W, MIXB, DM, M_, gw, ngw, lane);
          ssd_gate_phase<bf16, bf16>(MIXU + ATT_W, DM, PROJ, FL, ssd_norm_g + layer * SSD_W, MIXB + ATT_W, DM, M_, gw, ngw, lane);
          rms_rows_phase<256, bf16>(MIXU + ATT_W + SSD_W, DM, gm_norm_g + layer * GM_W, MIXB + ATT_W + SSD_W, DM, M_, gw, ngw, lane); }
        PH_END(PB + 3)
        PH_BEGIN(PB + 4)
        { pg8::Gemm g{MIXB, WOUT + (size_t)layer * DM * DM, M_, DM, DM}; pg8::StaticOrder S; S.init(M_, DM, G, bx);
          fp::EpiF32 E{Y, DM}; pg8::gemm_phase<fp::EpiF32, pg8::StaticOrder, false, true>(lds, g, S, E); }
        PH_END(PB + 4)
        PH_BEGIN(PB + 5)
        { for (long r = gw; r < M_; r += ngw) ln_row<float>(H + r * DM, ALPHA, Y + r * DM, nullptr, ln1_g + layer * DM, ln1_b + layer * DM, H + r * DM, HB + r * DM, lane);
          if (layer == 1) { asm volatile("s_waitcnt vmcnt(0)" ::: "memory"); moe_route_phase(H, router_w, CNT, TE, TP, TS, M_, gw, ngw, lane); } }
        PH_END(PB + 5)
        if constexpr (layer == 0) {
            PH_BEGIN(PB + 6)
            { pg8::Gemm g{HB, WGU, M_, NGU, DM}; pg8::StaticOrder S; S.init(M_, NGU, G, bx);
              fp::EpiAct E{ACT, D_FF, NGU / 256}; pg8::gemm_phase<fp::EpiAct, pg8::StaticOrder, true, true>(lds, g, S, E); }
            PH_END(PB + 6)
            PH_BEGIN(PB + 7)
            { pg8::Gemm g{ACT, WD, M_, DM, D_FF}; pg8::StaticOrder S; S.init(M_, DM, G, bx);
              fp::EpiF32 E{Y, DM}; pg8::gemm_phase<fp::EpiF32, pg8::StaticOrder, false, true>(lds, g, S, E); }
            PH_END(PB + 7)
            PH_BEGIN(PB + 8)
            { for (long r = gw; r < M_; r += ngw) ln_row<float>(H + r * DM, ALPHA, Y + r * DM, nullptr, ln2_g + layer * DM, ln2_b + layer * DM, H + r * DM, HB + r * DM, lane); }
            PH_END(PB + 8)
        } else {
            PH_BEGIN(PB + 6)
            { for (long it = gw; it < (long)M_ * 2; it += ngw) { const int e = TE[it]; const int gs = moe_base(CNT, e) + TS[it];
                  if (lane == 0) { SP[gs] = TP[it]; GS[it] = gs; }
                  const uint4* src = (const uint4*)(HB + (it >> 1) * DM); uint4* dst = (uint4*)(XG + (size_t)gs * DM); dst[lane] = src[lane]; dst[lane + 64] = src[lane + 64]; }
              for (int it = gw; it < N_EXP * 256; it += ngw) { const int e = it >> 8, r = it & 255; const int c = CNT[e]; const int slot = moe_base(CNT, e) + c + r;
                  if (c + r < ((c + 255) & ~255)) { uint4* dst = (uint4*)(XG + (size_t)slot * DM); const uint4 z = make_uint4(0u, 0u, 0u, 0u); dst[lane] = z; dst[lane + 64] = z; if (lane == 0) SP[slot] = 0.f; } } }
            PH_END(PB + 6)
            PH_BEGIN(PB + 7)
            { pg8::Gemm g{XG, MWGU, NSLOT, N_EXP * NGUE, DM}; fp::MoeOrder S; S.init(CNT, NGUE / 256, G, bx);
              fp::EpiAct E{ACTM, D_FFE, NGUE / 256}; pg8::gemm_phase<fp::EpiAct, fp::MoeOrder, true, true>(lds, g, S, E); }
            PH_END(PB + 7)
            PH_BEGIN(PB + 8)
            { constexpr int I_MWD = (D_FFE / 64) * (N_EXP * DM / 32);
              for (int it = gw; it < I_MWD; it += ngw) { const int kb = it / (N_EXP * DM / 32), db = it % (N_EXP * DM / 32); const int d = db * 32 + (lane & 31), e = d / DM;
                  fp::SrcCol s; s.p = moe_w_down + (size_t)e * D_FFE * DM + (d - e * DM); s.ld = DM; fp::conv_item(s, D_FFE, MWD, (long)db * 32, kb * 64, scr, lane); } }
            PH_END(PB + 8)
            PH_BEGIN(PB + 9)
            { pg8::Gemm g{ACTM, MWD, NSLOT, N_EXP * DM, D_FFE}; fp::MoeOrder S; S.init(CNT, DM / 256, G, bx);
              fp::EpiF2 E{F2, SP}; pg8::gemm_phase<fp::EpiF2, fp::MoeOrder, true, true>(lds, g, S, E); }
            PH_END(PB + 9)
            PH_BEGIN(PB + 10)
            { for (long r = gw; r < M_; r += ngw) ln_row<bf16>(H + r * DM, ALPHA, F2 + (size_t)GS[r * 2] * DM, F2 + (size_t)GS[r * 2 + 1] * DM, ln2_g + layer * DM, ln2_b + layer * DM, H + r * DM, nullptr, lane); }
            PH_END(PB + 10)
        }
    }

#undef PH_BEGIN
#undef PH_END
}

__device__ __forceinline__ void blk_acc(float d2, float s2, float* err) {
    d2 = wave_sum(d2); s2 = wave_sum(s2); if ((threadIdx.x & 63) == 0) { atomicAdd(err, d2); atomicAdd(err + 1, s2); }
}
__global__ void k_cmp_proj(const bf16* F, const float* S, long rows, float* err) {
    float d2 = 0.f, s2 = 0.f;
    for (long it = blockIdx.x * (long)blockDim.x + threadIdx.x; it < rows * 2950; it += gridDim.x * (long)blockDim.x) {
        const long row = it / 2950; const int d = (int)(it % 2950); const int sc = fp::win_src_col(d);
        float s = S[row * D_IN + sc]; if (d >= FGU && d < FXBC) s = gelu_tanh_f(s);
        const float f = ldf(F + row * PLD + d); d2 += (f - s) * (f - s); s2 += s * s; }
    blk_acc(d2, s2, err);
}
template <class TF> __global__ void k_cmp(const TF* F, int ldf_, const float* S, int lds_, long rows, int cols, float* err) {
    float d2 = 0.f, s2 = 0.f;
    for (long it = blockIdx.x * (long)blockDim.x + threadIdx.x; it < rows * cols; it += gridDim.x * (long)blockDim.x) {
        const long row = it / cols; const int c = (int)(it % cols); const float f = ldf(F + row * ldf_ + c), s = S[row * lds_ + c]; d2 += (f - s) * (f - s); s2 += s * s; }
    blk_acc(d2, s2, err);
}
__global__ void k_encode(const float* err, int nck, const float* Sout, float* out, long rows_s, long rows_all, float thr) {
    int k = 0; for (int i = 0; i < nck; ++i) { const float r = err[2 * i] / fmaxf(err[2 * i + 1], 1e-30f); if (!(r <= thr)) { k = i + 1; break; } }
    for (long it = blockIdx.x * (long)blockDim.x + threadIdx.x; it < rows_all * DM; it += gridDim.x * (long)blockDim.x)
        out[it] = (it < rows_s * DM) ? Sout[it] * (1.f + (float)k) : 0.f;
}
#if DEBUG_BUILD
constexpr size_t S_BASE = (WS_END + 2 * MiB - 1) / MiB * MiB;
#endif
extern "C" void kernel_launch(void* const* d_in, const int* in_sizes, int n_in, void* d_out, int out_size, void* d_ws, size_t ws_size, hipStream_t stream) {
    (void)in_sizes; (void)n_in; (void)out_size;
    static int grid = 0;
    if (grid == 0) {
        int dev = 0, cus = 0, per_cu = 0;
        if (hipGetDevice(&dev) != hipSuccess || hipDeviceGetAttribute(&cus, hipDeviceAttributeMultiprocessorCount, dev) != hipSuccess) { grid = -1; return; }
        if (hipFuncSetAttribute((const void*)mega, hipFuncAttributeMaxDynamicSharedMemorySize, LDS_BYTES) != hipSuccess) { fprintf(stderr, "kernel_launch: hipFuncSetAttribute failed\n"); grid = -1; return; }
        if (hipOccupancyMaxActiveBlocksPerMultiprocessor(&per_cu, (const void*)mega, 512, LDS_BYTES) != hipSuccess || per_cu < 1) fprintf(stderr, "kernel_launch: occupancy query reports %d\n", per_cu);
        (void)hipGetLastError();
        grid = cus;
        if (ws_size < WS_END) { fprintf(stderr, "kernel_launch: workspace too small: %zu < %zu\n", ws_size, (size_t)WS_END); grid = -1; }
    }
    if (grid < 0) return;
    unsigned char* ws = (unsigned char*)d_ws;
    if (hipMemsetAsync(ws + O_CTL, 0, CTL_BYTES, stream) != hipSuccess) return;
    FArgs a{};
    for (int i = 0; i < 29; ++i) a.in[i] = d_in[i];
    a.out = (float*)d_out; a.ws = ws;
#if !DEBUG_BUILD
    a.ph_lo = 0; a.ph_hi = N_PHASES;
    hipLaunchKernelGGL(mega, dim3(grid), dim3(512), LDS_BYTES, stream, a);
#else
    Inputs I;
    I.x = (const float*)d_in[0]; I.pos = (const int*)d_in[1]; I.ln_in_g = (const float*)d_in[2]; I.ln_in_b = (const float*)d_in[3]; I.w_in = (const float*)d_in[4];
    I.conv_w = (const float*)d_in[5]; I.conv_b = (const float*)d_in[6]; I.dt_bias = (const float*)d_in[7]; I.a_log = (const float*)d_in[8]; I.d_skip = (const float*)d_in[9];
    I.ssd_norm_g = (const float*)d_in[10]; I.att_norm_g = (const float*)d_in[11]; I.gm_ln_g = (const float*)d_in[12]; I.gm_ln_b = (const float*)d_in[13]; I.gm_w_s = (const float*)d_in[14];
    I.gm_b_s = (const float*)d_in[15]; I.gm_norm_g = (const float*)d_in[16]; I.w_out = (const float*)d_in[17]; I.ln1_g = (const float*)d_in[18]; I.ln1_b = (const float*)d_in[19];
    I.ln2_g = (const float*)d_in[20]; I.ln2_b = (const float*)d_in[21]; I.ffn_w_gate = (const float*)d_in[22]; I.ffn_w_up = (const float*)d_in[23]; I.ffn_w_down = (const float*)d_in[24];
    I.router_w = (const float*)d_in[25]; I.moe_w_gate = (const float*)d_in[26]; I.moe_w_up = (const float*)d_in[27]; I.moe_w_down = (const float*)d_in[28];
    const long MS = SEQ;
    unsigned char* sws = ws + S_BASE;
    float* saux = (float*)(sws + 96 * MiB); float* sout = (float*)(sws + 100 * MiB); float* ckpt = (float*)(sws + 110 * MiB);
    const size_t ck_stride = (size_t)MS * (D_IN + 3 * DM);
    run_simple(I, 1, sws, saux, sout, stream, ckpt);
    float* err = (float*)(ws + O_CTL) + CW_ERR;
    const bf16* PROJ = (const bf16*)(ws + O_PROJ); const bf16* MIXB = (const bf16*)(ws + O_MIXB); const float* Hf = (const float*)d_out;
    for (int ph = 0; ph < N_PHASES; ++ph) {
        a.ph_lo = ph; a.ph_hi = ph + 1;
        hipLaunchKernelGGL(mega, dim3(grid), dim3(512), LDS_BYTES, stream, a);
        const int layer = ph >= 10 ? 1 : 0; const int rel = ph - (layer ? 9 : 0); const float* ck = ckpt + layer * ck_stride; float* e = err + layer * 12;
        if (rel == 1) k_cmp_proj<<<512, 256, 0, stream>>>(PROJ, ck, MS, e + 0);
        if (rel == 4) { k_cmp<bf16><<<512, 256, 0, stream>>>(MIXB, DM, ck + (size_t)MS * D_IN, DM, MS, 384, e + 2);
                        k_cmp<bf16><<<512, 256, 0, stream>>>(MIXB + 384, DM, ck + (size_t)MS * D_IN + 384, DM, MS, 384, e + 4);
                        k_cmp<bf16><<<512, 256, 0, stream>>>(MIXB + 768, DM, ck + (size_t)MS * D_IN + 768, DM, MS, 256, e + 6); }
        if (rel == 6) k_cmp<float><<<512, 256, 0, stream>>>(Hf, DM, ck + (size_t)MS * (D_IN + DM), DM, MS, DM, e + 8);
        if ((layer == 0 && rel == 9) || (layer == 1 && rel == 11)) k_cmp<float><<<512, 256, 0, stream>>>(Hf, DM, ck + (size_t)MS * (D_IN + 2 * DM), DM, MS, DM, e + 10);
    }
    k_encode<<<1024, 256, 0, stream>>>(err, 12, sout, (float*)d_out, MS, (long)NBATCH * SEQ, DBG_THR);
#endif
}
```

```cpp
#define DEBUG_BUILD 0
#define DBG_THR 0.02f
#include <hip/hip_runtime.h>
#include <cstdio>
#include <cstdint>

constexpr int DM = 1024, SEQ = 2048, NBATCH = 8;
constexpr int ATT_H = 6, HD = 64, ATT_W = 384, ROPE_DIM = 16;
constexpr int MOBA_BLOCK = 256, NBLK = SEQ / MOBA_BLOCK;
constexpr int SSD_H = 6, SSD_W = 384, SSD_G = 2, SSD_N = 128, SSD_CW = 896;
constexpr int GM_G = 4, GM_W = 256, GM_CHUNK = 128;
constexpr int D_IN = 2950, D_FF = 2816, N_EXP = 8, D_FFE = 3584;
constexpr float ALPHA = 1.4142135623730951f;
constexpr float NEGF = -1e30f;
constexpr int MAXSLOT = 2 * NBATCH * SEQ + N_EXP * 256;

typedef unsigned short bf16;
__device__ __forceinline__ unsigned f2bf(float f) { unsigned u = __float_as_uint(f); return (u + 0x7fffu + ((u >> 16) & 1u)) >> 16; }
__device__ __forceinline__ float ldf(const float* p) { return *p; }
__device__ __forceinline__ float ldf(const bf16* p) { return __uint_as_float(((unsigned)*p) << 16); }
__device__ __forceinline__ void stf(float* p, float v) { *p = v; }
__device__ __forceinline__ void stf(bf16* p, float v) { *p = (bf16)f2bf(v); }

__device__ __forceinline__ float wave_sum(float v) {
#pragma unroll
    for (int o = 1; o < 64; o <<= 1) v += __shfl_xor(v, o);
    return v;
}
__device__ __forceinline__ float silu_f(float x) { return x / (1.f + __expf(-x)); }
__device__ __forceinline__ float gelu_tanh_f(float x) { const float u = 0.7978845608028654f * (x + 0.044715f * x * x * x); return 0.5f * x * (1.f + tanhf(u)); }
__device__ __forceinline__ float softplus_f(float x) { return fmaxf(x, 0.f) + log1pf(__expf(-fabsf(x))); }

struct ProjL { int ld, q, k, v, z, xbc, dt, gu, gv; };

__device__ __forceinline__ float4 ld4(const float* p) { return *(const float4*)p; }
__device__ __forceinline__ float4 ld4(const bf16* p) { const uint2 w = *(const uint2*)p; return make_float4(__uint_as_float(w.x << 16), __uint_as_float(w.x & 0xffff0000u), __uint_as_float(w.y << 16), __uint_as_float(w.y & 0xffff0000u)); }
template <class TY> __device__ __forceinline__ void ln_row(const float* xrow, float a, const TY* y1, const TY* y2, const float* g, const float* b, float* of, bf16* ob, int lane) {
    float v[16]; float s = 0.f;
#pragma unroll
    for (int j = 0; j < 4; ++j) {
        const float4 x = *(const float4*)(xrow + j * 256 + lane * 4);
        float4 t = make_float4(a * x.x, a * x.y, a * x.z, a * x.w);
        if (y1) { const float4 y = ld4(y1 + j * 256 + lane * 4); t.x += y.x; t.y += y.y; t.z += y.z; t.w += y.w; }
        if (y2) { const float4 y = ld4(y2 + j * 256 + lane * 4); t.x += y.x; t.y += y.y; t.z += y.z; t.w += y.w; }
        v[4 * j] = t.x; v[4 * j + 1] = t.y; v[4 * j + 2] = t.z; v[4 * j + 3] = t.w; s += (t.x + t.y) + (t.z + t.w);
    }
    const float mean = wave_sum(s) * (1.f / 1024.f); float s2 = 0.f;
#pragma unroll
    for (int i = 0; i < 16; ++i) { v[i] -= mean; s2 += v[i] * v[i]; }
    const float rstd = rsqrtf(wave_sum(s2) * (1.f / 1024.f) + 1e-5f);
#pragma unroll
    for (int j = 0; j < 4; ++j) {
        const float4 gg = *(const float4*)(g + j * 256 + lane * 4), bb = *(const float4*)(b + j * 256 + lane * 4);
        float4 o = make_float4(v[4 * j] * rstd * gg.x + bb.x, v[4 * j + 1] * rstd * gg.y + bb.y, v[4 * j + 2] * rstd * gg.z + bb.z, v[4 * j + 3] * rstd * gg.w + bb.w);
        *(float4*)(of + j * 256 + lane * 4) = o;
        if (ob) { uint2 w; w.x = f2bf(o.x) | (f2bf(o.y) << 16); w.y = f2bf(o.z) | (f2bf(o.w) << 16); *(uint2*)(ob + j * 256 + lane * 4) = w; }
    }
}

__device__ __forceinline__ void rope_inplace(float* P, ProjL L, const int* pos, long n_rows, long gt, long ngt) {
    for (long it = gt; it < n_rows * 96; it += ngt) {
        const int i = (int)(it & 7), hh = (int)((it >> 3) % 12); const long row = it / 96;
        const int off = (hh < 6 ? L.q : L.k) + (hh % 6) * 64;
        const float inv = powf(500000.0f, -(float)(2 * i) / 16.0f);
        const float ang = (float)pos[row] * inv;
        const float c = cosf(ang), s = sinf(ang);
        float* p = P + row * L.ld + off;
        const float x1 = p[i], x2 = p[i + 8];
        p[i] = x1 * c - x2 * s; p[i + 8] = x2 * c + x1 * s;
    }
}

template <class T> __device__ __forceinline__ void kmean_phase(const T* P, ProjL L, float* KM, int nb, long gt, long ngt) {
    for (long it = gt; it < (long)nb * ATT_H * NBLK * 64; it += ngt) {
        const int d = (int)(it & 63), n = (int)((it >> 6) % NBLK), h = (int)((it / (64 * NBLK)) % ATT_H), b = (int)(it / (64 * NBLK * ATT_H));
        const T* p = P + ((long)b * SEQ + n * MOBA_BLOCK) * L.ld + L.k + h * 64 + d; float s = 0.f;
        for (int r = 0; r < MOBA_BLOCK; ++r) s += ldf(p + (long)r * L.ld);
        KM[it] = s * (1.f / MOBA_BLOCK);
    }
}

template <class T> __device__ __forceinline__ void attn_naive_phase(const T* P, ProjL L, const float* KM, float* O, int ldo, int nb, int gw, int ngw, int lane) {
    for (long it = gw; it < (long)nb * ATT_H * SEQ; it += ngw) {
        const int q = (int)(it % SEQ), h = (int)((it / SEQ) % ATT_H), b = (int)(it / ((long)SEQ * ATT_H));
        const long row = (long)b * SEQ + q; const int qblk = q / MOBA_BLOCK;
        const float qv = ldf(P + row * L.ld + L.q + h * 64 + lane);
        float g[NBLK];
#pragma unroll
        for (int n = 0; n < NBLK; ++n) { const float t = wave_sum(qv * KM[(((long)b * ATT_H + h) * NBLK + n) * 64 + lane]); g[n] = (n < qblk) ? t : NEGF; }
        unsigned sel = 0u;
#pragma unroll
        for (int r = 0; r < 3; ++r) { float bv = -3.0e38f; int best = -1;
#pragma unroll
            for (int n = 0; n < NBLK; ++n) if (!((sel >> n) & 1u) && g[n] > bv) { bv = g[n]; best = n; }
            if (best >= 0 && bv > NEGF * 0.5f) sel |= 1u << best; }
        sel |= 1u << qblk;
        float m = -3.0e38f, l = 0.f, o = 0.f;
        for (int n = 0; n <= qblk; ++n) {
            if (!((sel >> n) & 1u)) continue;
            const int j0 = n * MOBA_BLOCK, j1 = (n == qblk) ? q + 1 : j0 + MOBA_BLOCK;
            const T* kp = P + ((long)b * SEQ + j0) * L.ld + L.k + h * 64 + lane;
            const T* vp = P + ((long)b * SEQ + j0) * L.ld + L.v + h * 64 + lane;
            for (int j = j0; j < j1; ++j, kp += L.ld, vp += L.ld) {
                const float s = wave_sum(qv * ldf(kp)) * 0.125f;
                const float mn = fmaxf(m, s), corr = __expf(m - mn), p = __expf(s - mn);
                l = l * corr + p; o = o * corr + p * ldf(vp); m = mn;
            }
        }
        O[row * ldo + h * 64 + lane] = o / l;
    }
}

template <int W, class TO> __device__ __forceinline__ void rms_rows_phase(const float* in, int ldi, const float* g, TO* out, int ldo, long n_rows, int gw, int ngw, int lane) {
    constexpr int PER = W / 64;
    for (long row = gw; row < n_rows; row += ngw) {
        float v[PER]; float s = 0.f;
#pragma unroll
        for (int j = 0; j < PER; ++j) { v[j] = in[row * ldi + j * 64 + lane]; s += v[j] * v[j]; }
        const float r = rsqrtf(wave_sum(s) * (1.f / W) + 1e-5f);
#pragma unroll
        for (int j = 0; j < PER; ++j) stf(out + row * ldo + j * 64 + lane, v[j] * r * g[j * 64 + lane]);
    }
}

template <class T, class TO> __device__ __forceinline__ void ssd_conv_phase(const T* P, ProjL L, const float* cw, const float* cb, const float* dtb, TO* XC, float* DT, long n_rows, long gt, long ngt) {
    for (long it = gt; it < n_rows * 902; it += ngt) {
        const int c = (int)(it % 902); const long row = it / 902; const int t = (int)(row % SEQ);
        if (c < SSD_CW) {
            float acc = cb[c];
#pragma unroll
            for (int i = 0; i < 4; ++i) { const int tt = t - 3 + i; if (tt >= 0) acc += cw[i * SSD_CW + c] * ldf(P + (row - 3 + i) * L.ld + L.xbc + c); }
            stf(XC + row * SSD_CW + c, silu_f(acc));
        } else {
            const int h = c - SSD_CW;
            DT[row * SSD_H + h] = softplus_f(ldf(P + row * L.ld + L.dt + h) + dtb[h]);
        }
    }
}

template <class T> __device__ __forceinline__ void ssd_scan_naive_phase(const T* XC, const float* DT, const float* a_log, const float* dsk, float* Y, int ldo, int nb, int gw, int ngw, int lane) {
    for (int it = gw; it < nb * SSD_H * 64; it += ngw) {
        const int p = it & 63, h = (it >> 6) % SSD_H, b = it / (64 * SSD_H), grp = h / (SSD_H / SSD_G);
        const float A = -__expf(a_log[h]), Dk = dsk[h];
        float s0 = 0.f, s1 = 0.f;
#pragma unroll 4
        for (int t = 0; t < SEQ; ++t) {
            const long row = (long)b * SEQ + t;
            const T* xr = XC + row * SSD_CW;
            const float dt = DT[row * SSD_H + h], x = ldf(xr + h * 64 + p);
            const float B0 = ldf(xr + SSD_W + grp * SSD_N + lane), B1 = ldf(xr + SSD_W + grp * SSD_N + 64 + lane);
            const float C0 = ldf(xr + SSD_W + SSD_G * SSD_N + grp * SSD_N + lane), C1 = ldf(xr + SSD_W + SSD_G * SSD_N + grp * SSD_N + 64 + lane);
            const float dec = __expf(dt * A), xd = x * dt;
            s0 = s0 * dec + xd * B0; s1 = s1 * dec + xd * B1;
            const float y = wave_sum(C0 * s0 + C1 * s1);
            if (lane == 0) Y[row * ldo + h * 64 + p] = y + Dk * x;
        }
    }
}

template <class T, class TO> __device__ __forceinline__ void ssd_gate_phase(const float* Y, int ldi, const T* P, ProjL L, const float* ng, TO* out, int ldo, long n_rows, int gw, int ngw, int lane) {
    for (long row = gw; row < n_rows; row += ngw) {
        float v[6];
#pragma unroll
        for (int j = 0; j < 6; ++j) { const int c = j * 64 + lane; v[j] = Y[row * ldi + c] * silu_f(ldf(P + row * L.ld + L.z + c)); }
        const float r0 = rsqrtf(wave_sum(v[0] * v[0] + v[1] * v[1] + v[2] * v[2]) * (1.f / 192.f) + 1e-5f);
        const float r1 = rsqrtf(wave_sum(v[3] * v[3] + v[4] * v[4] + v[5] * v[5]) * (1.f / 192.f) + 1e-5f);
#pragma unroll
        for (int j = 0; j < 6; ++j) { const int c = j * 64 + lane; stf(out + row * ldo + c, v[j] * (j < 3 ? r0 : r1) * ng[c]); }
    }
}

template <class T, bool PRE> __device__ __forceinline__ void gm_ln_phase(const T* P, ProjL L, const float* g, const float* b, float* VN, long n_rows, int gw, int ngw, int lane) {
    for (long row = gw; row < n_rows; row += ngw) {
        float v[4]; float s = 0.f;
#pragma unroll
        for (int j = 0; j < 4; ++j) { const float x = ldf(P + row * L.ld + L.gv + j * 64 + lane); v[j] = PRE ? x : gelu_tanh_f(x); s += v[j]; }
        const float mean = wave_sum(s) * (1.f / 256.f); float s2 = 0.f;
#pragma unroll
        for (int j = 0; j < 4; ++j) { v[j] -= mean; s2 += v[j] * v[j]; }
        const float rstd = rsqrtf(wave_sum(s2) * (1.f / 256.f) + 1e-5f);
#pragma unroll
        for (int j = 0; j < 4; ++j) VN[row * GM_W + j * 64 + lane] = v[j] * rstd * g[j * 64 + lane] + b[j * 64 + lane];
    }
}
template <class T, bool PRE> __device__ __forceinline__ void gm_mix_phase(const T* P, ProjL L, const float* VN, const float* ws_, const float* bs, float* GO, int ldo, long n_rows, long gt, long ngt) {
    for (long it = gt; it < n_rows * GM_W; it += ngt) {
        const int c = (int)(it % GM_W); const long row = it / GM_W; const int t = (int)(row % GM_CHUNK), g = c / 64; const long base = row - t;
        const float* w = ws_ + ((long)g * GM_CHUNK + t) * GM_CHUNK; float acc = 0.f;
        for (int s = 0; s <= t; ++s) acc += w[s] * VN[(base + s) * GM_W + c];
        acc += bs[g * GM_CHUNK + t];
        const float x = ldf(P + row * L.ld + L.gu + c); const float u = PRE ? x : gelu_tanh_f(x);
        GO[row * ldo + c] = u * acc;
    }
}

__device__ __forceinline__ void moe_route_phase(const float* H, const float* Wr, int* CNT, int* TE, float* TP, int* TS, long n_rows, int gw, int ngw, int lane) {
    for (long row = gw; row < n_rows; row += ngw) {
        float acc[N_EXP];
#pragma unroll
        for (int e = 0; e < N_EXP; ++e) acc[e] = 0.f;
        for (int j = 0; j < 16; ++j) { const int d = j * 64 + lane; const float hv = H[row * DM + d];
            const float4 w0 = *(const float4*)(Wr + d * N_EXP), w1 = *(const float4*)(Wr + d * N_EXP + 4);
            acc[0] += hv * w0.x; acc[1] += hv * w0.y; acc[2] += hv * w0.z; acc[3] += hv * w0.w; acc[4] += hv * w1.x; acc[5] += hv * w1.y; acc[6] += hv * w1.z; acc[7] += hv * w1.w; }
#pragma unroll
        for (int e = 0; e < N_EXP; ++e) acc[e] = wave_sum(acc[e]);
        int e0 = 0; float v0 = acc[0];
#pragma unroll
        for (int e = 1; e < N_EXP; ++e) if (acc[e] > v0) { v0 = acc[e]; e0 = e; }
        int e1 = -1; float v1 = -3.0e38f;
#pragma unroll
        for (int e = 0; e < N_EXP; ++e) if (e != e0 && acc[e] > v1) { v1 = acc[e]; e1 = e; }
        const float p1 = __expf(v1 - v0), den = 1.f + p1;
        if (lane == 0) {
            const int s0 = atomicAdd(&CNT[e0], 1), s1 = atomicAdd(&CNT[e1], 1);
            TE[row * 2] = e0; TE[row * 2 + 1] = e1; TP[row * 2] = 1.f / den; TP[row * 2 + 1] = p1 / den; TS[row * 2] = s0; TS[row * 2 + 1] = s1;
        }
    }
}
__device__ __forceinline__ int moe_base(const int* CNT, int e) { int b = 0; for (int i = 0; i < e; ++i) b += (CNT[i] + 255) & ~255; return b; }
__device__ __forceinline__ void moe_scatter_phase(const int* CNT, const int* TE, const float* TP, const int* TS, int* LIST, float* SP, int* GS, long n_rows, long gt, long ngt) {
    for (long it = gt; it < n_rows * 2; it += ngt) {
        const int e = TE[it]; const int gs = moe_base(CNT, e) + TS[it];
        LIST[gs] = (int)(it >> 1); SP[gs] = TP[it]; GS[it] = gs;
    }
}

template <class TA, int EPI> __global__ void __launch_bounds__(256) sgemm_k(const TA* A, int lda, const int* rowlist, const float* B, const float* B2, int ldb, long bstride, void* Cv, int ldc, int M, int N, int K, const int* CNT, const float* scale) {
    __shared__ float As[16][68], Bs[16][68], Bs2[16][68];
    int row_base = 0, mrows = M;
    if (CNT) { const int e = blockIdx.z; row_base = moe_base(CNT, e); mrows = CNT[e]; B += (long)e * bstride; if (B2) B2 += (long)e * bstride; }
    const int m0 = blockIdx.y * 64; if (m0 >= mrows) return;
    const int n0 = blockIdx.x * 64, tid = threadIdx.x, tx = tid & 15, ty = tid >> 4;
    float acc[4][4], acc2[4][4];
#pragma unroll
    for (int i = 0; i < 4; ++i)
#pragma unroll
        for (int j = 0; j < 4; ++j) { acc[i][j] = 0.f; acc2[i][j] = 0.f; }
    const int ar = tid >> 2, ak = (tid & 3) * 4; long arow = -1;
    { const int lr = m0 + ar; if (lr < mrows) { arow = rowlist ? (long)rowlist[row_base + lr] : (long)(row_base + lr); } }
    const int bk = tid >> 4, bn = (tid & 15) * 4;
    for (int k0 = 0; k0 < K; k0 += 16) {
        float av[4] = {0.f, 0.f, 0.f, 0.f};
        if (arow >= 0) {
#pragma unroll
            for (int i = 0; i < 4; ++i) av[i] = ldf(A + arow * lda + k0 + ak + i);
        }
#pragma unroll
        for (int i = 0; i < 4; ++i) As[ak + i][ar] = av[i];
#pragma unroll
        for (int i = 0; i < 4; ++i) { const int n = n0 + bn + i; const bool ok = n < N;
            Bs[bk][bn + i] = ok ? B[(long)(k0 + bk) * ldb + n] : 0.f;
            if (EPI == 1 || EPI == 2) Bs2[bk][bn + i] = ok ? B2[(long)(k0 + bk) * ldb + n] : 0.f; }
        __syncthreads();
#pragma unroll
        for (int kk = 0; kk < 16; ++kk) {
            float a[4], b[4], b2[4];
#pragma unroll
            for (int i = 0; i < 4; ++i) { a[i] = As[kk][ty * 4 + i]; b[i] = Bs[kk][tx * 4 + i]; if (EPI == 1 || EPI == 2) b2[i] = Bs2[kk][tx * 4 + i]; }
#pragma unroll
            for (int i = 0; i < 4; ++i)
#pragma unroll
                for (int j = 0; j < 4; ++j) { acc[i][j] += a[i] * b[j]; if (EPI == 1 || EPI == 2) acc2[i][j] += a[i] * b2[j]; }
        }
        __syncthreads();
    }
#pragma unroll
    for (int i = 0; i < 4; ++i) { const int lr = m0 + ty * 4 + i; if (lr >= mrows) continue; const long crow = row_base + lr;
#pragma unroll
        for (int j = 0; j < 4; ++j) { const int n = n0 + tx * 4 + j; if (n >= N) continue;
            float v = acc[i][j];
            if (EPI == 1 || EPI == 2) v = silu_f(v) * acc2[i][j];
            if (EPI == 3) v *= scale[crow];
            if (EPI == 2) ((bf16*)Cv)[crow * ldc + n] = (bf16)f2bf(v); else ((float*)Cv)[crow * ldc + n] = v; } }
}

#define GW_DECL const int lane = threadIdx.x & 63; const int gw = (int)((blockIdx.x * (long)blockDim.x + threadIdx.x) >> 6); const int ngw = (int)((gridDim.x * (long)blockDim.x) >> 6); (void)lane; (void)gw; (void)ngw;
#define GT_DECL const long gt = blockIdx.x * (long)blockDim.x + threadIdx.x; const long ngt = gridDim.x * (long)blockDim.x;

__global__ void k_ln_in(const float* x, const float* g, const float* b, float* H, long n_rows) { GW_DECL for (long r = gw; r < n_rows; r += ngw) ln_row<float>(x + r * DM, 1.f, nullptr, nullptr, g, b, H + r * DM, nullptr, lane); }
__global__ void k_ln_res(float* H, const float* Y, const float* g, const float* b, float* OUT, long n_rows) { GW_DECL for (long r = gw; r < n_rows; r += ngw) ln_row<float>(H + r * DM, ALPHA, Y + r * DM, nullptr, g, b, OUT + r * DM, nullptr, lane); }
__global__ void k_ln_moe(float* H, const float* F2, const int* GS, const float* g, const float* b, float* OUT, long n_rows) { GW_DECL for (long r = gw; r < n_rows; r += ngw) ln_row<float>(H + r * DM, ALPHA, F2 + (long)GS[r * 2] * DM, F2 + (long)GS[r * 2 + 1] * DM, g, b, OUT + r * DM, nullptr, lane); }
__global__ void k_rope(float* P, ProjL L, const int* pos, long n_rows) { GT_DECL rope_inplace(P, L, pos, n_rows, gt, ngt); }
__global__ void k_kmean(const float* P, ProjL L, float* KM, int nb) { GT_DECL kmean_phase<float>(P, L, KM, nb, gt, ngt); }
__global__ void k_attn(const float* P, ProjL L, const float* KM, float* O, int ldo, int nb) { GW_DECL attn_naive_phase<float>(P, L, KM, O, ldo, nb, gw, ngw, lane); }
__global__ void k_rms384(const float* in, int ldi, const float* g, float* out, int ldo, long n_rows) { GW_DECL rms_rows_phase<384, float>(in, ldi, g, out, ldo, n_rows, gw, ngw, lane); }
__global__ void k_rms256(const float* in, int ldi, const float* g, float* out, int ldo, long n_rows) { GW_DECL rms_rows_phase<256, float>(in, ldi, g, out, ldo, n_rows, gw, ngw, lane); }
__global__ void k_ssd_conv(const float* P, ProjL L, const float* cw, const float* cb, const float* dtb, float* XC, float* DT, long n_rows) { GT_DECL ssd_conv_phase<float, float>(P, L, cw, cb, dtb, XC, DT, n_rows, gt, ngt); }
__global__ void k_ssd_scan(const float* XC, const float* DT, const float* a_log, const float* dsk, float* Y, int ldo, int nb) { GW_DECL ssd_scan_naive_phase<float>(XC, DT, a_log, dsk, Y, ldo, nb, gw, ngw, lane); }
__global__ void k_ssd_gate(const float* Y, int ldi, const float* P, ProjL L, const float* ng, float* out, int ldo, long n_rows) { GW_DECL ssd_gate_phase<float, float>(Y, ldi, P, L, ng, out, ldo, n_rows, gw, ngw, lane); }
__global__ void k_gm_ln(const float* P, ProjL L, const float* g, const float* b, float* VN, long n_rows) { GW_DECL gm_ln_phase<float, false>(P, L, g, b, VN, n_rows, gw, ngw, lane); }
__global__ void k_gm_mix(const float* P, ProjL L, const float* VN, const float* ws_, const float* bs, float* GO, int ldo, long n_rows) { GT_DECL gm_mix_phase<float, false>(P, L, VN, ws_, bs, GO, ldo, n_rows, gt, ngt); }
__global__ void k_moe_init(int* CNT, int* LIST, int nslots) { GT_DECL if (gt < N_EXP) CNT[gt] = 0; for (long i = gt; i < nslots; i += ngt) LIST[i] = -1; }
__global__ void k_moe_route(const float* H, const float* Wr, int* CNT, int* TE, float* TP, int* TS, long n_rows) { GW_DECL moe_route_phase(H, Wr, CNT, TE, TP, TS, n_rows, gw, ngw, lane); }
__global__ void k_moe_scatter(const int* CNT, const int* TE, const float* TP, const int* TS, int* LIST, float* SP, int* GS, long n_rows) { GT_DECL moe_scatter_phase(CNT, TE, TP, TS, LIST, SP, GS, n_rows, gt, ngt); }

struct Inputs {
    const float *x; const int* pos; const float *ln_in_g, *ln_in_b, *w_in, *conv_w, *conv_b, *dt_bias, *a_log, *d_skip, *ssd_norm_g, *att_norm_g, *gm_ln_g, *gm_ln_b, *gm_w_s, *gm_b_s, *gm_norm_g, *w_out,
        *ln1_g, *ln1_b, *ln2_g, *ln2_b, *ffn_w_gate, *ffn_w_up, *ffn_w_down, *router_w, *moe_w_gate, *moe_w_up, *moe_w_down;
};

static void run_simple(const Inputs& I, int nb, unsigned char* ws, float* aux  , float* OUT, hipStream_t st, float* ckpt = nullptr) {
    const long M = (long)nb * SEQ; const size_t MB = 1u << 20;
    const size_t hsz = (size_t)M * DM * 4;
    float* H = (float*)ws; float* MIX = (float*)(ws + hsz); float* Y = (float*)(ws + 2 * hsz); unsigned char* BIG = ws + 3 * hsz + (size_t)N_EXP * 256 * DM * 4;
    float* XC = Y;
    float* VN = aux;
    float* PROJ = (float*)BIG;
    size_t big_bytes = (size_t)M * D_IN * 4; { size_t a = (size_t)M * D_FF * 4; if (a > big_bytes) big_bytes = a; size_t c = (size_t)(2 * M + N_EXP * 256) * D_FFE * 2; if (c > big_bytes) big_bytes = c; }
    big_bytes = (big_bytes + 255) & ~(size_t)255;
    unsigned char* SM = BIG + big_bytes;
    float* KM = (float*)SM; SM += (size_t)nb * ATT_H * NBLK * 64 * 4;
    float* DT = (float*)SM; SM += (size_t)M * SSD_H * 4;
    int* CNT = (int*)SM; SM += 256;
    int* TE = (int*)SM; SM += (size_t)M * 2 * 4; float* TP = (float*)SM; SM += (size_t)M * 2 * 4; int* TS = (int*)SM; SM += (size_t)M * 2 * 4; int* GS = (int*)SM; SM += (size_t)M * 2 * 4;
    const int nslots = (int)(2 * M + N_EXP * 256);
    int* LIST = (int*)SM; SM += (size_t)nslots * 4; float* SP = (float*)SM; SM += (size_t)nslots * 4;
    (void)MB;
    const ProjL L{D_IN, 0, 384, 768, 1152, 1536, 2432, 2438, 2694};
    const int TB = 256; const int GWB = 2048;
    k_ln_in<<<GWB, TB, 0, st>>>(I.x, I.ln_in_g, I.ln_in_b, H, M);
    for (int i = 0; i < 2; ++i) {
        sgemm_k<float, 0><<<dim3((D_IN + 63) / 64, (unsigned)(M / 64), 1), 256, 0, st>>>(H, DM, nullptr, I.w_in + (size_t)i * DM * D_IN, nullptr, D_IN, 0, PROJ, D_IN, (int)M, D_IN, DM, nullptr, nullptr);
        k_rope<<<GWB, TB, 0, st>>>(PROJ, L, I.pos, M);
        const size_t ck_stride = (size_t)M * (D_IN + 3 * DM); float* ck = ckpt ? ckpt + (size_t)i * ck_stride : nullptr;
        if (ck) hipMemcpyAsync(ck, PROJ, (size_t)M * D_IN * 4, hipMemcpyDeviceToDevice, st);
        k_kmean<<<96 * nb, TB, 0, st>>>(PROJ, L, KM, nb);
        k_attn<<<GWB * 2, TB, 0, st>>>(PROJ, L, KM, MIX, DM, nb);
        k_rms384<<<GWB, TB, 0, st>>>(MIX, DM, I.att_norm_g + i * ATT_W, MIX, DM, M);
        k_ssd_conv<<<GWB * 2, TB, 0, st>>>(PROJ, L, I.conv_w + (size_t)i * 4 * SSD_CW, I.conv_b + i * SSD_CW, I.dt_bias + i * SSD_H, XC, DT, M);
        k_ssd_scan<<<(nb * SSD_H * 64 * 64 + TB - 1) / TB, TB, 0, st>>>(XC, DT, I.a_log + i * SSD_H, I.d_skip + i * SSD_H, MIX + ATT_W, DM, nb);
        k_ssd_gate<<<GWB, TB, 0, st>>>(MIX + ATT_W, DM, PROJ, L, I.ssd_norm_g + i * SSD_W, MIX + ATT_W, DM, M);
        k_gm_ln<<<GWB, TB, 0, st>>>(PROJ, L, I.gm_ln_g + i * GM_W, I.gm_ln_b + i * GM_W, VN, M);
        k_gm_mix<<<GWB * 2, TB, 0, st>>>(PROJ, L, VN, I.gm_w_s + (size_t)i * GM_G * GM_CHUNK * GM_CHUNK, I.gm_b_s + i * GM_G * GM_CHUNK, MIX + ATT_W + SSD_W, DM, M);
        k_rms256<<<GWB, TB, 0, st>>>(MIX + ATT_W + SSD_W, DM, I.gm_norm_g + i * GM_W, MIX + ATT_W + SSD_W, DM, M);
        if (ck) hipMemcpyAsync(ck + (size_t)M * D_IN, MIX, hsz, hipMemcpyDeviceToDevice, st);
        sgemm_k<float, 0><<<dim3(DM / 64, (unsigned)(M / 64), 1), 256, 0, st>>>(MIX, DM, nullptr, I.w_out + (size_t)i * DM * DM, nullptr, DM, 0, Y, DM, (int)M, DM, DM, nullptr, nullptr);
        k_ln_res<<<GWB, TB, 0, st>>>(H, Y, I.ln1_g + i * DM, I.ln1_b + i * DM, H, M);
        if (ck) hipMemcpyAsync(ck + (size_t)M * (D_IN + DM), H, hsz, hipMemcpyDeviceToDevice, st);
        if (i == 0) {
            float* ACT = (float*)BIG;
            sgemm_k<float, 1><<<dim3(D_FF / 64, (unsigned)(M / 64), 1), 256, 0, st>>>(H, DM, nullptr, I.ffn_w_gate, I.ffn_w_up, D_FF, 0, ACT, D_FF, (int)M, D_FF, DM, nullptr, nullptr);
            sgemm_k<float, 0><<<dim3(DM / 64, (unsigned)(M / 64), 1), 256, 0, st>>>(ACT, D_FF, nullptr, I.ffn_w_down, nullptr, DM, 0, Y, DM, (int)M, DM, D_FF, nullptr, nullptr);
            k_ln_res<<<GWB, TB, 0, st>>>(H, Y, I.ln2_g + i * DM, I.ln2_b + i * DM, H, M);
            if (ck) hipMemcpyAsync(ck + (size_t)M * (D_IN + 2 * DM), H, hsz, hipMemcpyDeviceToDevice, st);
        } else {
            bf16* ACTM = (bf16*)BIG; float* F2 = MIX;
            k_moe_init<<<256, TB, 0, st>>>(CNT, LIST, nslots);
            k_moe_route<<<GWB, TB, 0, st>>>(H, I.router_w, CNT, TE, TP, TS, M);
            k_moe_scatter<<<256, TB, 0, st>>>(CNT, TE, TP, TS, LIST, SP, GS, M);
            sgemm_k<float, 2><<<dim3(D_FFE / 64, (unsigned)(M / 64), N_EXP), 256, 0, st>>>(H, DM, LIST, I.moe_w_gate, I.moe_w_up, D_FFE, (long)DM * D_FFE, ACTM, D_FFE, 0, D_FFE, DM, CNT, nullptr);
            sgemm_k<bf16, 3><<<dim3(DM / 64, (unsigned)(M / 64), N_EXP), 256, 0, st>>>(ACTM, D_FFE, nullptr, I.moe_w_down, nullptr, DM, (long)D_FFE * DM, F2, DM, 0, DM, D_FFE, CNT, SP);
            k_ln_moe<<<GWB, TB, 0, st>>>(H, F2, GS, I.ln2_g + i * DM, I.ln2_b + i * DM, OUT, M);
            if (ck) hipMemcpyAsync(ck + (size_t)M * (D_IN + 2 * DM), OUT, hsz, hipMemcpyDeviceToDevice, st);
        }
    }
}

#define LAS __attribute__((address_space(3)))
namespace pg8 {
#define PG8_LAS __attribute__((address_space(3)))
typedef unsigned short bf16_t;
typedef short bf16x8 __attribute__((ext_vector_type(8)));
typedef float f32x4 __attribute__((ext_vector_type(4)));
typedef unsigned u32x4 __attribute__((ext_vector_type(4)));
constexpr int BM = 256, BK = 64, HALF = 128, HTB = HALF * BK * 2  , STAGE_BYTES = 8 * HTB, NXCD = 8, WGM = 8;

__host__ __device__ __forceinline__ int lds_byte(int r, int c) { const int st = (r >> 4) * 2 + (c >> 5), rr = r & 15, cc = c & 31, ob = rr * 64 + cc * 2; return st * 1024 + (ob ^ (((ob >> 9) & 1) << 5)); }
__host__ __device__ __forceinline__ void stage_rc(int b, int& R, int& C) { const int st = b / 1024, sb = b % 1024, swz = sb ^ (((sb >> 9) & 1) << 5); R = (st >> 1) * 16 + swz / 64; C = (st & 1) * 32 + (swz % 64) / 2; }
__host__ __device__ __forceinline__ int perm32(int rho) { const int n = rho >> 4, i = rho & 15; return 8 * (i >> 2) + 4 * n + (i & 3); }

struct Unit { int pm, pn; };
struct Gemm { const bf16_t* A; const bf16_t* Bt; int M, N, K; };

struct StaticOrder {
    int nM, nN, nwg, G, c;
    __host__ __device__ void init(int M, int N, int G_, int c_) { nM = M / BM; nN = N / BM; nwg = nM * nN; G = G_; c = c_; }
    __host__ __device__ bool next(int i, Unit& u) const {
        const long L = (long)i * G + c; if (L >= nwg) return false;
        int wgid = (int)L; { const int q = nwg / NXCD, r = nwg % NXCD, xcd = wgid % NXCD, off = wgid / NXCD; wgid = (xcd < r ? xcd * (q + 1) : r * (q + 1) + (xcd - r) * q) + off; }
        const int nig = WGM * nN, gid = wgid / nig, fm = gid * WGM, gsz = (nM - fm) < WGM ? (nM - fm) : WGM;
        u.pm = fm + ((wgid % nig) % gsz); u.pn = (wgid % nig) / gsz; return true;
    }
    __device__ __forceinline__ void a_ready(const Unit&) const {}
    __device__ __forceinline__ void done(const Unit&) const {}
};
__device__ __forceinline__ unsigned cvt_pk_bf16(float lo, float hi) { unsigned r; asm volatile("v_cvt_pk_bf16_f32 %0, %1, %2" : "=v"(r) : "v"(lo), "v"(hi)); return r; }
typedef float f32x2 __attribute__((ext_vector_type(2)));
template <class Epi, class Sched, bool ALIGN_EPI = false, bool SP2 = false>
__device__ __forceinline__ void gemm_phase(PG8_LAS unsigned char* lds, const Gemm g, const Sched& S, const Epi& E) {
    const int tid = threadIdx.x, wid = __builtin_amdgcn_readfirstlane(tid >> 6), lane = tid & 63, wr = wid >> 2, wc = wid & 3, fr = lane & 15, fq = lane >> 4;
    const int K = g.K, nt = K / BK;
    unsigned voffA[2], voffB[2];
#pragma unroll
    for (int i = 0; i < 2; ++i) { int R, C; stage_rc(tid * 16 + i * 8192, R, C); const int Rb = Epi::PERM ? ((R & ~31) + perm32(R & 31)) : R;
        voffA[i] = (unsigned)(R * K + C) * 2u; voffB[i] = (unsigned)(Rb * K + C) * 2u; }
    const size_t kstep = (size_t)(BK * 2);
    const size_t hstep = (size_t)HALF * K * 2;
    const size_t tstep = 2 * hstep;
    const unsigned ldsw = (unsigned)wid * 1024u;
    const int aoff = lds_byte(wr * 64 + fr, fq * 8), boff = lds_byte(wc * 32 + fr, fq * 8);
#define PG8_SA(b, h) (((b) * 2 + (h)) * HTB)
#define PG8_SB(b, h) ((4 + (b) * 2 + (h)) * HTB)
#define PG8_STAGE(bufoff, gbase, voff) do { _Pragma("unroll") for (int _i = 0; _i < 2; ++_i) \
        __builtin_amdgcn_global_load_lds((const unsigned*)((const char*)(gbase) + (voff)[_i]), (PG8_LAS unsigned*)(lds + (bufoff) + ldsw + _i * 8192), 16, 0, 0); } while (0)
#define PG8_LDA(dst, b, h) do { _Pragma("unroll") for (int m = 0; m < 4; ++m) _Pragma("unroll") for (int k = 0; k < 2; ++k) dst[m][k] = *(const PG8_LAS bf16x8*)(lds + PG8_SA(b, h) + aoff + m * 2048 + k * 1024); } while (0)
#define PG8_LDB(dst, b, h) do { _Pragma("unroll") for (int n = 0; n < 2; ++n) _Pragma("unroll") for (int k = 0; k < 2; ++k) dst[n][k] = *(const PG8_LAS bf16x8*)(lds + PG8_SB(b, h) + boff + n * 2048 + k * 1024); } while (0)
#define PG8_MMA(ai, bj, At, Bt) do { __builtin_amdgcn_s_setprio(1); _Pragma("unroll") for (int m = 0; m < 4; ++m) _Pragma("unroll") for (int n = 0; n < 2; ++n) _Pragma("unroll") for (int k = 0; k < 2; ++k) \
        acc[ai][bj][m][n] = __builtin_amdgcn_mfma_f32_16x16x32_bf16(Bt[n][k], At[m][k], acc[ai][bj][m][n], 0, 0, 0); __builtin_amdgcn_s_setprio(0); } while (0)
#define PG8_WAIT_V(n) asm volatile("s_waitcnt vmcnt(" #n ")" ::: "memory")
#define PG8_WAIT_L(n) asm volatile("s_waitcnt lgkmcnt(" #n ")" ::: "memory")
#define PG8_BAR __builtin_amdgcn_s_barrier()
#define PG8_SCHED __builtin_amdgcn_sched_barrier(0)
    Unit cur, nxt; int ui = 0;
    if (!S.next(0, cur)) return;
    f32x4 acc[2][2][4][2];
#pragma unroll
    for (int a = 0; a < 2; ++a)
#pragma unroll
        for (int b = 0; b < 2; ++b)
#pragma unroll
            for (int m = 0; m < 4; ++m)
#pragma unroll
                for (int n = 0; n < 2; ++n) acc[a][b][m][n] = (f32x4){0.f, 0.f, 0.f, 0.f};
    bf16x8 At[4][2], B0[2][2], B1[2][2];
    const char* cA = (const char*)g.A + (size_t)cur.pm * tstep; const char* cB = (const char*)g.Bt + (size_t)cur.pn * tstep;
    S.a_ready(cur);
    if constexpr (SP2) {
        PG8_STAGE(PG8_SB(0, 0), cB, voffB); PG8_STAGE(PG8_SB(0, 1), cB + hstep, voffB); PG8_STAGE(PG8_SA(0, 0), cA, voffA); PG8_STAGE(PG8_SA(0, 1), cA + hstep, voffA);
        if (wr == 1) PG8_BAR;
        PG8_WAIT_V(2); PG8_BAR;
        PG8_STAGE(PG8_SB(1, 0), cB + kstep, voffB); PG8_STAGE(PG8_SA(1, 0), cA + kstep, voffA); PG8_STAGE(PG8_SB(1, 1), cB + hstep + kstep, voffB);
        PG8_WAIT_V(6); PG8_BAR;
    } else {
        PG8_STAGE(PG8_SB(0, 0), cB, voffB); PG8_STAGE(PG8_SA(0, 0), cA, voffA); PG8_STAGE(PG8_SB(0, 1), cB + hstep, voffB); PG8_STAGE(PG8_SA(0, 1), cA + hstep, voffA);
        if (wr == 1) PG8_BAR;
        PG8_WAIT_V(4); PG8_BAR;
        PG8_STAGE(PG8_SB(1, 0), cB + kstep, voffB); PG8_STAGE(PG8_SA(1, 0), cA + kstep, voffA); PG8_STAGE(PG8_SB(1, 1), cB + hstep + kstep, voffB);
        PG8_WAIT_V(6); PG8_BAR;
    }
    for (;;) {
        const bool has_next = S.next(ui + 1, nxt);
        const char* nA = has_next ? (const char*)g.A + (size_t)nxt.pm * tstep : cA; const char* nB = has_next ? (const char*)g.Bt + (size_t)nxt.pn * tstep : cB;
        for (int t = 0; t < nt; t += 2) {
            const bool last = (t == nt - 2);
            const char* a1 = cA + (size_t)(t + 1) * kstep;
            const char* a2 = last ? nA : cA + (size_t)(t + 2) * kstep; const char* b2 = last ? nB : cB + (size_t)(t + 2) * kstep;
            const char* a3 = a2 + kstep; const char* b3 = b2 + kstep;
            if (last && has_next) S.a_ready(nxt);
            if constexpr (SP2) {
            PG8_LDB(B0, 0, 0); PG8_LDB(B1, 0, 1); PG8_SCHED; PG8_LDA(At, 0, 0); PG8_STAGE(PG8_SA(1, 1), a1 + hstep, voffA);
            PG8_WAIT_V(8); PG8_WAIT_L(0); PG8_BAR; PG8_MMA(0, 0, At, B0); PG8_MMA(0, 1, At, B1); PG8_BAR; PG8_SCHED;
            PG8_LDA(At, 0, 1); PG8_STAGE(PG8_SB(0, 0), b2, voffB); PG8_STAGE(PG8_SB(0, 1), b2 + hstep, voffB); PG8_STAGE(PG8_SA(0, 0), a2, voffA);
            PG8_WAIT_V(8); PG8_WAIT_L(0); PG8_BAR; PG8_MMA(1, 0, At, B0); PG8_MMA(1, 1, At, B1); PG8_BAR; PG8_SCHED;
            PG8_LDB(B0, 1, 0); PG8_LDB(B1, 1, 1); PG8_SCHED; PG8_LDA(At, 1, 0); PG8_STAGE(PG8_SA(0, 1), a2 + hstep, voffA);
            PG8_WAIT_V(8); PG8_WAIT_L(0); PG8_BAR; PG8_MMA(0, 0, At, B0); PG8_MMA(0, 1, At, B1); PG8_BAR; PG8_SCHED;
            PG8_LDA(At, 1, 1); PG8_STAGE(PG8_SB(1, 0), b3, voffB); PG8_STAGE(PG8_SB(1, 1), b3 + hstep, voffB); PG8_STAGE(PG8_SA(1, 0), a3, voffA);
            PG8_WAIT_V(8); PG8_WAIT_L(0); PG8_BAR; PG8_MMA(1, 0, At, B0); PG8_MMA(1, 1, At, B1); PG8_BAR; PG8_SCHED;
            } else {
            PG8_LDB(B0, 0, 0); PG8_SCHED; PG8_LDA(At, 0, 0); PG8_STAGE(PG8_SA(1, 1), a1 + hstep, voffA);
            PG8_WAIT_L(8); PG8_BAR; PG8_WAIT_L(0); PG8_MMA(0, 0, At, B0); PG8_BAR; PG8_SCHED;
            PG8_LDB(B1, 0, 1); PG8_STAGE(PG8_SB(0, 0), b2, voffB);
            PG8_BAR; PG8_WAIT_L(0); PG8_MMA(0, 1, At, B1); PG8_BAR;
            PG8_LDA(At, 0, 1); PG8_STAGE(PG8_SA(0, 0), a2, voffA);
            PG8_BAR; PG8_WAIT_L(0); PG8_MMA(1, 0, At, B0); PG8_BAR; PG8_SCHED;
            PG8_STAGE(PG8_SB(0, 1), b2 + hstep, voffB);
            PG8_WAIT_V(6); PG8_BAR; PG8_MMA(1, 1, At, B1); PG8_BAR;
            PG8_LDB(B0, 1, 0); PG8_SCHED; PG8_LDA(At, 1, 0); PG8_STAGE(PG8_SA(0, 1), a2 + hstep, voffA);
            PG8_WAIT_L(8); PG8_BAR; PG8_WAIT_L(0); PG8_MMA(0, 0, At, B0); PG8_BAR; PG8_SCHED;
            PG8_LDB(B1, 1, 1); PG8_STAGE(PG8_SB(1, 0), b3, voffB);
            PG8_BAR; PG8_WAIT_L(0); PG8_MMA(0, 1, At, B1); PG8_BAR;
            PG8_LDA(At, 1, 1); PG8_STAGE(PG8_SA(1, 0), a3, voffA);
            PG8_BAR; PG8_WAIT_L(0); PG8_MMA(1, 0, At, B0); PG8_BAR; PG8_SCHED;
            PG8_STAGE(PG8_SB(1, 1), b3 + hstep, voffB);
            PG8_WAIT_V(6); PG8_BAR; PG8_MMA(1, 1, At, B1); PG8_BAR;
            }
        }
        if constexpr (ALIGN_EPI) { if (wr == 0) PG8_BAR; }
        if constexpr (!Epi::AFTER_DRAIN) { E(acc, cur, wr, wc, fr, fq); S.done(cur); }
        if (!has_next) break;
#pragma unroll
        for (int a = 0; a < 2; ++a)
#pragma unroll
            for (int b = 0; b < 2; ++b)
#pragma unroll
                for (int m = 0; m < 4; ++m)
#pragma unroll
                    for (int n = 0; n < 2; ++n) acc[a][b][m][n] = (f32x4){0.f, 0.f, 0.f, 0.f};
        cur = nxt; cA = nA; cB = nB; ++ui;
        if constexpr (ALIGN_EPI) { if (wr == 1) PG8_BAR; }
    }
    PG8_WAIT_V(0);
    if constexpr (!ALIGN_EPI) { if (wr == 0) PG8_BAR; }
    PG8_BAR;
    if constexpr (Epi::AFTER_DRAIN) { E.fused(acc, cur, wr, wc, fr, fq, lds, wid, lane); S.done(cur); }
#undef PG8_SA
#undef PG8_SB
#undef PG8_STAGE
#undef PG8_LDA
#undef PG8_LDB
#undef PG8_MMA
#undef PG8_WAIT_V
#undef PG8_WAIT_L
#undef PG8_BAR
#undef PG8_SCHED
}
}
#define XB_TMO      128
#define XB_XCNT(j)  (256  + 64 * (j))
#define XB_XSUB(j)  (1280 + 64 * (j))
#define XB_XGEN(j)  (2304 + 64 * (j))
#define XB_TOP      3328
#define XB_TOPGEN   3392
#define XCD_BAR_WORDS 3456
#define XB_SPIN_CAP (1u << 24)

__device__ __forceinline__ unsigned xb_ld(unsigned* p)              { return __hip_atomic_load(p, __ATOMIC_RELAXED, __HIP_MEMORY_SCOPE_AGENT); }
__device__ __forceinline__ unsigned xb_add(unsigned* p, unsigned v) { return __hip_atomic_fetch_add(p, v, __ATOMIC_RELAXED, __HIP_MEMORY_SCOPE_AGENT); }
__device__ __forceinline__ unsigned xb_xcc_id() { return (unsigned)__builtin_amdgcn_s_getreg((3 << 11) | 20) & 0xFu; }
#define XB_SPIN(cond, bar) do { unsigned _sp = 0; while (cond) { __builtin_amdgcn_s_sleep(1); \
    if ((++_sp & 255u) == 0u) { if (xb_ld(&(bar)[XB_TMO])) break; if (_sp > XB_SPIN_CAP) { atomicAdd(&(bar)[XB_TMO], 1u); break; } } } } while (0)

struct XcdBarrier {
    unsigned* bar; unsigned x;
    volatile LAS unsigned* st;
};

__device__ __forceinline__ XcdBarrier xcd_barrier_post(unsigned* bar, volatile LAS unsigned* st) {
    XcdBarrier b; b.bar = bar; b.x = xb_xcc_id(); b.st = st;
    if (threadIdx.x == 0) (void)xb_add(&bar[XB_XCNT(b.x)], 1u);
    return b;
}
__device__ __forceinline__ void xcd_barrier_complete(unsigned* bar, unsigned x, unsigned& nloc, unsigned& nx) {
    const unsigned G = gridDim.x * gridDim.y * gridDim.z;
    unsigned sum, cnt, mine, sp = 0u;
    for (;;) {
        sum = 0u; cnt = 0u; mine = 0u;
#pragma unroll
        for (unsigned j = 0; j < 16; ++j) { const unsigned c = xb_ld(&bar[XB_XCNT(j)]); sum += c; cnt += (c > 0u) ? 1u : 0u; mine = (j == x) ? c : mine; }
        if (sum == G) break;
        __builtin_amdgcn_s_sleep(1);
        if ((++sp & 255u) == 0u) { if (xb_ld(&bar[XB_TMO])) break; if (sp > XB_SPIN_CAP) { atomicAdd(&bar[XB_TMO], 1u); break; } }
    }
    nloc = mine > 0u ? mine : 1u; nx = cnt > 0u ? cnt : 1u;
}

__device__ __forceinline__ void xcd_barrier(const XcdBarrier& b) {
    asm volatile("s_waitcnt vmcnt(0)" ::: "memory");
    __syncthreads();
    if (threadIdx.x == 0) {
        unsigned* bar = b.bar;
        __builtin_amdgcn_s_waitcnt(0);
        unsigned nloc = b.st[0], nx = b.st[1];
        if (nloc == 0u) { xcd_barrier_complete(bar, b.x, nloc, nx); b.st[0] = nloc; b.st[1] = nx; }
        const unsigned old = xb_add(&bar[XB_XSUB(b.x)], 1u);
        const unsigned gen = old / nloc;
        if (old + 1u == (gen + 1u) * nloc) {
            __builtin_amdgcn_fence(__ATOMIC_RELEASE, "agent");
            asm volatile("s_waitcnt vmcnt(0)" ::: "memory");
            const unsigned og = xb_add(&bar[XB_TOP], 1u);
            const unsigned tg = og / nx;
            if (og + 1u == (tg + 1u) * nx) xb_add(&bar[XB_TOPGEN], 1u);
            else XB_SPIN(xb_ld(&bar[XB_TOPGEN]) == tg, bar);
            __builtin_amdgcn_fence(__ATOMIC_ACQUIRE, "agent");
            xb_add(&bar[XB_XGEN(b.x)], 1u);
            asm volatile("s_waitcnt vmcnt(0)" ::: "memory");
        } else {
            XB_SPIN(xb_ld(&bar[XB_XGEN(b.x)]) == gen, bar);
            __builtin_amdgcn_fence(__ATOMIC_ACQUIRE, "agent");
            asm volatile("s_waitcnt vmcnt(0)" ::: "memory");
        }
    }
    __syncthreads();
}
#include <hip/hip_bf16.h>
#include <cmath>
namespace attn_body {
using bf16=__hip_bfloat16;
using bf16x8=__attribute__((ext_vector_type(8)))short;
using s16x4=__attribute__((ext_vector_type(4)))short;
using f32x16=__attribute__((ext_vector_type(16)))float;
using u32x4=__attribute__((ext_vector_type(4)))unsigned;
constexpr int NHEAD=6,SEQ=2048,D=64,QP=3072,OP=1024;
constexpr int NW=8,QBLK=32,QB=QBLK*NW,KVBLK=64,NQB=SEQ/QB;
constexpr int ATTN_UNIT_ROWS=QB;
__device__ __forceinline__ int crow(int r,int hi){return (r&3)+8*(r>>2)+4*hi;}
#define SBAR() __builtin_amdgcn_sched_barrier(0)
__device__ __forceinline__ void cmask(f32x16&p0,f32x16&p1,int jb,int qrel,int hi){
  const float NEG=-INFINITY; int kb=64*jb+4*hi;
  #pragma unroll
  for(int r=0;r<16;++r){int kv=kb+(r&3)+8*(r>>2); if(kv>qrel)p0[r]=NEG; if(kv+32>qrel)p1[r]=NEG;}
}

constexpr int NSLOT=3, SLOTB=8192;
constexpr int LDS_K=0, LDS_V=NSLOT*SLOTB, LDS_WS=2*NSLOT*SLOTB, LDS_OST=LDS_WS+NW*64*4, LDS_BYTES=LDS_OST+NW*4096;
constexpr float C2=0.125f*1.4426950408889634f;
__device__ __forceinline__ void glds16(const void*gsrc,unsigned lds_dst){unsigned keep;
  asm volatile("s_mov_b32 %0, m0\n\ts_mov_b32 m0, %2\n\ts_nop 0\n\tglobal_load_lds_dwordx4 %1, off\n\ts_mov_b32 m0, %0":"=&s"(keep):"v"(gsrc),"s"(lds_dst):"memory");}
__device__ __forceinline__ float max3f(float a,float b,float c){float r;asm("v_max3_f32 %0, %1, %2, %3":"=v"(r):"v"(a),"v"(b),"v"(c));return r;}
__device__ __forceinline__ float max2f(float a,float b){float r;asm("v_max_f32_e32 %0, %1, %2":"=v"(r):"v"(a),"v"(b));return r;}
__device__ __forceinline__ float fadd_s(float a,float b){float r;asm("v_add_f32_e32 %0, %1, %2":"=v"(r):"v"(a),"v"(b));return r;}
__device__ __forceinline__ float fsub_s(float a,float b){float r;asm("v_sub_f32_e32 %0, %1, %2":"=v"(r):"v"(a),"v"(b));return r;}
typedef float f32x2_t __attribute__((ext_vector_type(2))); typedef __bf16 bf16x2_t __attribute__((ext_vector_type(2)));
__device__ __forceinline__ unsigned cvtpk_s(float lo,float hi){f32x2_t v={lo,hi};bf16x2_t b=__builtin_convertvector(v,bf16x2_t);return __builtin_bit_cast(unsigned,b);}
#define WAIT_BAR(N) asm volatile("s_waitcnt vmcnt(" #N ") lgkmcnt(0)\n\ts_barrier":::"memory")

__device__ __forceinline__ void qkt(f32x16&p0,f32x16&p1,const char*Kslot,const bf16x8*qr,int r32,int hi){ const f32x16 negm=f32x16{};
  const char*kb=Kslot+hi*1024+r32*16;
  #pragma unroll
  for(int d0=0;d0<4;++d0){
    const bf16x8 b0=*reinterpret_cast<const bf16x8*>(kb+d0*2048);
    const bf16x8 b1=*reinterpret_cast<const bf16x8*>(kb+d0*2048+512);
    if(d0==0){p0=__builtin_amdgcn_mfma_f32_32x32x16_bf16(b0,qr[0],negm,0,0,0);p1=__builtin_amdgcn_mfma_f32_32x32x16_bf16(b1,qr[0],negm,0,0,0);}
    else{p0=__builtin_amdgcn_mfma_f32_32x32x16_bf16(b0,qr[d0],p0,0,0,0);p1=__builtin_amdgcn_mfma_f32_32x32x16_bf16(b1,qr[d0],p1,0,0,0);}}
}
typedef __attribute__((address_space(3))) const char* lds_cptr;
typedef short v4i16_t __attribute__((ext_vector_type(4)));
__device__ __forceinline__ void kload8(bf16x8*kf,lds_cptr kp){
  kf[0]=*(const __attribute__((address_space(3))) bf16x8*)(kp);      kf[1]=*(const __attribute__((address_space(3))) bf16x8*)(kp+512);
  kf[2]=*(const __attribute__((address_space(3))) bf16x8*)(kp+2048); kf[3]=*(const __attribute__((address_space(3))) bf16x8*)(kp+2560);
  kf[4]=*(const __attribute__((address_space(3))) bf16x8*)(kp+4096); kf[5]=*(const __attribute__((address_space(3))) bf16x8*)(kp+4608);
  kf[6]=*(const __attribute__((address_space(3))) bf16x8*)(kp+6144); kf[7]=*(const __attribute__((address_space(3))) bf16x8*)(kp+6656);
}
__device__ __forceinline__ void kload2(bf16x8*kf,lds_cptr kp,int j){ kf[2*j]=*(const __attribute__((address_space(3))) bf16x8*)(kp+j*2048); kf[2*j+1]=*(const __attribute__((address_space(3))) bf16x8*)(kp+j*2048+512); }
__device__ __forceinline__ s16x4 vtr(lds_cptr p){ return __builtin_bit_cast(s16x4,__builtin_amdgcn_ds_read_tr16_b64_v4i16((__attribute__((address_space(3))) v4i16_t*)p)); }
__device__ __forceinline__ float rowmax(const f32x16&p0,const f32x16&p1){
  float a=max3f(p0[0],p0[1],p1[0]),b=max3f(p0[2],p0[3],p1[1]);a=max3f(a,p1[2],p1[3]);
  #pragma unroll
  for(int r=4;r<16;r+=4){a=max3f(a,p0[r],p0[r+1]);b=max3f(b,p0[r+2],p0[r+3]);a=max3f(a,p1[r],p1[r+1]);b=max3f(b,p1[r+2],p1[r+3]);}
  const float m=max2f(a,b);
  auto rr=__builtin_amdgcn_permlane32_swap(__float_as_uint(m),__float_as_uint(m),false,false);
  return max2f(__uint_as_float(rr[0]),__uint_as_float(rr[1]));
}
__device__ __forceinline__ void pv(f32x16*o,int vb,bf16x8 pa0,bf16x8 pa1,bf16x8 pa2,bf16x8 pa3){
  #pragma unroll
  for(int d0=0;d0<2;++d0){s16x4 lo[4],hi[4];
    #pragma unroll
    for(int ks=0;ks<4;++ks){
      asm volatile("ds_read_b64_tr_b16 %0,%1 offset:%c2":"=&v"(lo[ks]):"v"(vb),"i"(d0*4096+ks*1024):"memory");
      asm volatile("ds_read_b64_tr_b16 %0,%1 offset:%c2":"=&v"(hi[ks]):"v"(vb),"i"(d0*4096+ks*1024+512):"memory");}
    asm volatile("s_waitcnt lgkmcnt(0)":::"memory");SBAR();
    #define PK(k) (bf16x8){lo[k][0],lo[k][1],lo[k][2],lo[k][3],hi[k][0],hi[k][1],hi[k][2],hi[k][3]}
    o[d0]=__builtin_amdgcn_mfma_f32_32x32x16_bf16(pa0,PK(0),o[d0],0,0,0);
    o[d0]=__builtin_amdgcn_mfma_f32_32x32x16_bf16(pa1,PK(1),o[d0],0,0,0);
    o[d0]=__builtin_amdgcn_mfma_f32_32x32x16_bf16(pa2,PK(2),o[d0],0,0,0);
    o[d0]=__builtin_amdgcn_mfma_f32_32x32x16_bf16(pa3,PK(3),o[d0],0,0,0);
    #undef PK
  }
}

#ifndef ATTN_STORE16
#define ATTN_STORE16(p,v) (*(u32x4*)(p)=(v))
#endif
template<int THRL> __device__ __forceinline__ void attn_unit(int b,int h,int qb,const bf16*Q,const bf16*__restrict__ K,const bf16*__restrict__ V,bf16*O,const float*__restrict__ KM,char*shm){
  const int tid=threadIdx.x,lane=tid&63,r32=lane&31,hi=lane>>5; const int wid=__builtin_amdgcn_readfirstlane(tid>>6);
  const long rowbase=(long)b*SEQ; const int q0=qb*QB;
  const bf16*Qw=Q+(rowbase+q0+wid*QBLK)*QP+h*D;
  const bf16*Kh=K+rowbase*QP+h*D,*Vh=V+rowbase*QP+h*D;
  const unsigned lds0=(unsigned)(uintptr_t)shm;
  float*wsf=(float*)(shm+LDS_WS)+wid*64;
  const bf16*ksrc=Kh+(long)lane*QP+wid*8;
  const bf16*vsrc=Vh+(long)(16*(wid&3)+(lane>>2))*QP+(wid>>2)*32+(lane&3)*8;
  const unsigned kdst=lds0+LDS_K+wid*1024, vdst=lds0+LDS_V+wid*1024;
  #define TI(t) (((t)<4)?(NT-4+(t)):((t)-4))
  #define DMA_K(t,slot) glds16(ksrc+(long)TI(t)*KVBLK*QP,(unsigned)__builtin_amdgcn_readfirstlane(kdst+(slot)))
  #define DMA_V(t,slot) glds16(vsrc+(long)TI(t)*KVBLK*QP,(unsigned)__builtin_amdgcn_readfirstlane(vdst+(slot)))
  const int vb0=(int)(lds0+LDS_V)+((lane>>4)&1)*32+(lane&3)*8+(4*hi+((lane&15)>>2))*64;
  const char*Kbase=shm+LDS_K; bf16x8 kf[8];
  const lds_cptr shm3=(lds_cptr)shm; const lds_cptr kp0=shm3+LDS_K+hi*1024+r32*16; const lds_cptr vp0=shm3+LDS_V+((lane>>4)&1)*32+(lane&3)*8+(4*hi+((lane&15)>>2))*64;
  const int NT=(q0+QB)/KVBLK;
  DMA_K(0,0);DMA_V(0,0);DMA_K(1,SLOTB);
  bf16x8 qr[4];
  #pragma unroll
  for(int d0=0;d0<4;++d0)qr[d0]=*reinterpret_cast<const bf16x8*>(&Qw[(long)r32*QP+d0*16+hi*8]);

  unsigned sel=0u;
  if(qb>0){ float gt_[8];
    #pragma unroll
    for(int n=0;n<8;++n){ float a_=0.f;
      if(n<qb){ const float*km=KM+((long)(b*NHEAD+h)*8+n)*64+hi*8;
        #pragma unroll
        for(int d0=0;d0<4;++d0){ const float4 k0=*reinterpret_cast<const float4*>(km+d0*16), k1=*reinterpret_cast<const float4*>(km+d0*16+4);
          const bf16x8 qv=qr[d0];
          a_+=__uint_as_float(((unsigned)(unsigned short)qv[0])<<16)*k0.x+__uint_as_float(((unsigned)(unsigned short)qv[1])<<16)*k0.y+__uint_as_float(((unsigned)(unsigned short)qv[2])<<16)*k0.z+__uint_as_float(((unsigned)(unsigned short)qv[3])<<16)*k0.w
             +__uint_as_float(((unsigned)(unsigned short)qv[4])<<16)*k1.x+__uint_as_float(((unsigned)(unsigned short)qv[5])<<16)*k1.y+__uint_as_float(((unsigned)(unsigned short)qv[6])<<16)*k1.z+__uint_as_float(((unsigned)(unsigned short)qv[7])<<16)*k1.w; }
        a_+=__shfl_xor(a_,32); }
      gt_[n]=(n<qb)?a_:-1e30f; }
    #pragma unroll
    for(int r_=0;r_<3;++r_){ float bv=-3.0e38f; int best=-1;
      #pragma unroll
      for(int n=0;n<8;++n) if(!((sel>>n)&1u)&&gt_[n]>bv){bv=gt_[n];best=n;}
      if(best>=0&&bv>-0.5e30f) sel|=1u<<best; } }
  float mhat=0.f,l_reg=0.f;f32x16 o[2];o[0]=f32x16{};o[1]=f32x16{};
  const int qrel=wid*QBLK+r32;
  #define CMASK(P0,P1,t) do{ if((t)<4){cmask(P0,P1,(t),qrel,hi);} else if(!((sel>>(((t)-4)>>2))&1u)){ _Pragma("unroll") for(int r_=0;r_<16;++r_){P0[r_]=-INFINITY;P1[r_]=-INFINITY;} } }while(0)
  bool resc=false;
  #define START(P0,P1) do{ const float rm=rowmax(P0,P1); resc=false; \
    { const float dl=rm; mhat=fadd_s(mhat,dl); \
      _Pragma("unroll") for(int r=0;r<16;++r){P0[r]=fsub_s(P0[r],dl);P1[r]=fsub_s(P1[r],dl);} \
      } \
    _Pragma("unroll") for(int r=0;r<16;++r)P0[r]=__builtin_amdgcn_exp2f(P0[r]); }while(0)
  #define RESC() do{ if(resc){ asm volatile("s_waitcnt lgkmcnt(0)":::"memory"); \
      _Pragma("unroll") for(int d_=0;d_<2;++d_) _Pragma("unroll") for(int r=0;r<16;++r)o[d_][r]*=wsf[crow(r,hi)]; } }while(0)
  f32x16 pA0,pA1,pB0,pB1;
  int sl_prev=0,sl_cur=0,sl_next=SLOTB;
  #define ROT() do{sl_prev=sl_cur;sl_cur=sl_next;sl_next=(sl_next==(NSLOT-1)*SLOTB)?0:sl_next+SLOTB;}while(0)
  DMA_K(2,2*SLOTB);
  WAIT_BAR(3);
  qkt(pA0,pA1,Kbase,qr,r32,hi);asm volatile("s_nop 15\n\ts_nop 7":"+v"(pA0),"+v"(pA1));CMASK(pA0,pA1,0);
  START(pA0,pA1);
  _Pragma("unroll") for(int r=0;r<16;++r)pA1[r]=__builtin_amdgcn_exp2f(pA1[r]);
  WAIT_BAR(0);
  DMA_K(3,0);DMA_V(1,SLOTB);
  ROT();
  kload8(kf,kp0+sl_cur);
  WAIT_BAR(2);
  s16x4 vlo[8],vhi[8]; u32x4 pw0,pw1,pw2,pw3;
  #define PKW(P,B) cvtpk_s(P[B],P[B+1])
  #define PAF(k) __builtin_bit_cast(bf16x8,pw##k)
  #define VFR(i) (bf16x8){vlo[i][0],vlo[i][1],vlo[i][2],vlo[i][3],vhi[i][0],vhi[i][1],vhi[i][2],vhi[i][3]}
  #define PIN(x) asm volatile("":"+v"(x))
  #define MX3(a,b,c) __builtin_fmaxf(__builtin_fmaxf((a),(b)),(c))
  #define GAPA(MF,A0,A1,A2,A3,W0,W1,PW) do{ MF; sacc+=A0; sacc+=A1; sacc+=A2; sacc+=A3; PIN(sacc); W0; W1; PIN(PW); SBAR(); }while(0)
  #define EX(v) __builtin_amdgcn_exp2f(v)
  #define GAPB(MF,X,B) do{ MF; X[B]=EX(X[B]); X[B+1]=EX(X[B+1]); X[B+2]=EX(X[B+2]); X[B+3]=EX(X[B+3]); PIN(X); SBAR(); }while(0)
  #define VRD(i) do{ vlo[i]=vtr(vp_+(((i)>>2)*4096+((i)&3)*1024)); vhi[i]=vtr(vp_+(((i)>>2)*4096+((i)&3)*1024+512)); }while(0)
  #define KRD(G,j) do{ if(G){ kload2(kf,kp0+sl_next,j); SBAR(); } }while(0)
  #define STEP(C0,C1,P0,P1,t,GK,GV,GL) do{ SBAR(); \
    const lds_cptr vp_=vp0+sl_prev; \
    VRD(0); SBAR(); float sacc=(P0[0]+P0[1]); \
    GAPA(C0=__builtin_amdgcn_mfma_f32_32x32x16_bf16(kf[0],qr[0],f32x16{},0,0,0), P0[2],P0[3],P0[4],P0[5],     pw0[0]=PKW(P0,0), pw0[1]=PKW(P0,2), pw0); \
    VRD(4); SBAR(); GAPA(C1=__builtin_amdgcn_mfma_f32_32x32x16_bf16(kf[1],qr[0],f32x16{},0,0,0), P0[6],P0[7],P0[8],P0[9],     pw0[2]=PKW(P0,4), pw0[3]=PKW(P0,6), pw0); \
    VRD(1); SBAR(); GAPA(C0=__builtin_amdgcn_mfma_f32_32x32x16_bf16(kf[2],qr[1],C0,0,0,0),   P0[10],P0[11],P0[12],P0[13], pw1[0]=PKW(P0,8), pw1[1]=PKW(P0,10), pw1); \
    VRD(5); SBAR(); GAPA(C1=__builtin_amdgcn_mfma_f32_32x32x16_bf16(kf[3],qr[1],C1,0,0,0),   P0[14],P0[15],P1[0],P1[1],   pw1[2]=PKW(P0,12),pw1[3]=PKW(P0,14), pw1); \
    VRD(2); SBAR(); GAPA(C0=__builtin_amdgcn_mfma_f32_32x32x16_bf16(kf[4],qr[2],C0,0,0,0),   P1[2],P1[3],P1[4],P1[5],     pw2[0]=PKW(P1,0), pw2[1]=PKW(P1,2), pw2); \
    VRD(6); SBAR(); GAPA(C1=__builtin_amdgcn_mfma_f32_32x32x16_bf16(kf[5],qr[2],C1,0,0,0),   P1[6],P1[7],P1[8],P1[9],     pw2[2]=PKW(P1,4), pw2[3]=PKW(P1,6), pw2); \
    VRD(3); SBAR(); GAPA(C0=__builtin_amdgcn_mfma_f32_32x32x16_bf16(kf[6],qr[3],C0,0,0,0),   P1[10],P1[11],P1[12],P1[13], pw3[0]=PKW(P1,8), pw3[1]=PKW(P1,10), pw3); \
    VRD(7); SBAR(); GAPA(C1=__builtin_amdgcn_mfma_f32_32x32x16_bf16(kf[7],qr[3],C1,0,0,0),   P1[14],P1[15],0.f,0.f,       pw3[2]=PKW(P1,12),pw3[3]=PKW(P1,14), pw3); \
    l_reg+=sacc; \
    if(GK){DMA_K((t)+3,sl_cur);} if(GV){DMA_V((t)+1,sl_next);} \
    CMASK(C0,C1,t); \
    _Pragma("unroll") for(int r=0;r<16;++r){C0[r]-=mhat;C1[r]-=mhat;} \
    { float a=MX3(C0[0],C0[1],C1[0]),b=MX3(C0[2],C0[3],C1[1]); a=MX3(a,C1[2],C1[3]); \
      _Pragma("unroll") for(int r=4;r<16;r+=4){a=MX3(a,C0[r],C0[r+1]);b=MX3(b,C0[r+2],C0[r+3]);a=MX3(a,C1[r],C1[r+1]);b=MX3(b,C1[r+2],C1[r+3]);} \
      float rm=__builtin_fmaxf(a,b); { auto rr=__builtin_amdgcn_permlane32_swap(__float_as_uint(rm),__float_as_uint(rm),false,false); rm=__builtin_fmaxf(__uint_as_float(rr[0]),__uint_as_float(rr[1])); } \
      resc=false; \
      if(__builtin_expect(__any(rm>(float)THRL),0)){ const float dl=__builtin_fmaxf(rm,0.f); mhat+=dl; \
        _Pragma("unroll") for(int r=0;r<16;++r){C0[r]-=dl;C1[r]-=dl;} \
        const float f=__builtin_amdgcn_exp2f(-dl); l_reg*=f; if(hi==0)wsf[r32]=f; resc=true; } } \
    SBAR(); \
    GAPB(o[0]=__builtin_amdgcn_mfma_f32_32x32x16_bf16(PAF(0),VFR(0),o[0],0,0,0), C0,0); \
    GAPB(o[1]=__builtin_amdgcn_mfma_f32_32x32x16_bf16(PAF(0),VFR(4),o[1],0,0,0), C0,4); \
    KRD(GL,0); GAPB(o[0]=__builtin_amdgcn_mfma_f32_32x32x16_bf16(PAF(1),VFR(1),o[0],0,0,0), C0,8); \
    KRD(GL,1); GAPB(o[1]=__builtin_amdgcn_mfma_f32_32x32x16_bf16(PAF(1),VFR(5),o[1],0,0,0), C0,12); \
    KRD(GL,2); GAPB(o[0]=__builtin_amdgcn_mfma_f32_32x32x16_bf16(PAF(2),VFR(2),o[0],0,0,0), C1,0); \
    KRD(GL,3); GAPB(o[1]=__builtin_amdgcn_mfma_f32_32x32x16_bf16(PAF(2),VFR(6),o[1],0,0,0), C1,4); \
    GAPB(o[0]=__builtin_amdgcn_mfma_f32_32x32x16_bf16(PAF(3),VFR(3),o[0],0,0,0), C1,8); \
    GAPB(o[1]=__builtin_amdgcn_mfma_f32_32x32x16_bf16(PAF(3),VFR(7),o[1],0,0,0), C1,12); \
    }while(0)
  int t=1;
  for(;t+5<NT;t+=2){
    STEP(pB0,pB1,pA0,pA1,t,true,true,true);     WAIT_BAR(2); RESC(); ROT();
    STEP(pA0,pA1,pB0,pB1,t+1,true,true,true);   WAIT_BAR(2); RESC(); ROT();
  }
  #define ENDW(tt) do{ if((tt)+3<NT){WAIT_BAR(2);} else if((tt)+2<NT){WAIT_BAR(1);} else {WAIT_BAR(0);} }while(0)
  for(;t+1<NT;t+=2){
    STEP(pB0,pB1,pA0,pA1,t,(t+3<NT),(t+1<NT),(t+1<NT));       ENDW(t);   RESC(); ROT();
    STEP(pA0,pA1,pB0,pB1,t+1,(t+4<NT),(t+2<NT),(t+2<NT));     ENDW(t+1); RESC(); ROT();
  }
  STEP(pB0,pB1,pA0,pA1,NT-1,false,false,false); RESC();
  { float sacc=pB0[0]+pB0[1]; _Pragma("unroll") for(int r=2;r<16;++r)sacc+=pB0[r]; _Pragma("unroll") for(int r=0;r<16;++r)sacc+=pB1[r]; l_reg+=sacc;
    pw0=(u32x4){PKW(pB0,0),PKW(pB0,2),PKW(pB0,4),PKW(pB0,6)};pw1=(u32x4){PKW(pB0,8),PKW(pB0,10),PKW(pB0,12),PKW(pB0,14)};pw2=(u32x4){PKW(pB1,0),PKW(pB1,2),PKW(pB1,4),PKW(pB1,6)};pw3=(u32x4){PKW(pB1,8),PKW(pB1,10),PKW(pB1,12),PKW(pB1,14)};
    SBAR(); pv(o,vb0+sl_cur,PAF(0),PAF(1),PAF(2),PAF(3)); }
  #undef PKW
  #undef PAF
  #undef VFR
  #undef PIN
  #undef MX3
  #undef GAPA
  #undef GAPB
  #undef EX
  #undef VRD
  #undef KRD
  #undef STEP
  #undef ENDW
  {auto rr=__builtin_amdgcn_permlane32_swap(__float_as_uint(l_reg),__float_as_uint(l_reg),false,false);l_reg=__uint_as_float(rr[0])+__uint_as_float(rr[1]);}
  if(hi==0)wsf[32+r32]=l_reg;asm volatile("s_waitcnt lgkmcnt(0)":::"memory");
  float rli[16];
  #pragma unroll
  for(int r=0;r<16;++r)rli[r]=__builtin_amdgcn_rcpf(wsf[32+crow(r,hi)]);
  bf16*Ow=O+(rowbase+q0+wid*QBLK)*OP+h*D;
  { bf16*stg=(bf16*)(shm+LDS_OST)+wid*2048;
    #pragma unroll
    for(int r=0;r<16;++r){const int orow=crow(r,hi);
      #pragma unroll
      for(int d0=0;d0<2;++d0)stg[orow*64+d0*32+r32]=__float2bfloat16(o[d0][r]*rli[r]);}
    asm volatile("s_waitcnt lgkmcnt(0)":::"memory");
    #pragma unroll
    for(int i=0;i<4;++i){const int row=i*8+(lane>>3),ch=lane&7; const u32x4 v=*(const u32x4*)(stg+row*64+ch*8); ATTN_STORE16(Ow+(long)row*OP+ch*8,v);} }
  asm volatile("s_waitcnt lgkmcnt(0)\n\ts_barrier":::"memory");
  #undef DMA_K
  #undef DMA_V
  #undef TI
  #undef CMASK
  #undef START
  #undef RESC
  #undef ROT
}
constexpr int ATTN_LDS_BYTES=LDS_BYTES;
#undef SBAR
#undef WAIT_BAR
}
#undef LAS
constexpr int NB = DEBUG_BUILD ? 2 : 8;
constexpr int M_ = NB * SEQ;
constexpr int NSLOT = 2 * M_ + N_EXP * 256;
constexpr int PLD = 3072;
constexpr int FQ = 0, FK = 384, FV = 768, FZ = 1152, FGU = 1536, FGV = 1792, FXBC = 2048, FDT = 2944;
constexpr int NGU = 2 * D_FF, NGUE = 2 * D_FFE;

constexpr size_t al256(size_t x) { return (x + 255) & ~(size_t)255; }
constexpr size_t MiB = 1u << 20;
constexpr size_t O_CTL = 0, CTL_BYTES = 1 * MiB;
constexpr size_t O_RT = 1 * MiB;
constexpr size_t O_TE = O_RT + (size_t)M_ * 64, O_TP = O_TE + (size_t)M_ * 8, O_TS = O_TP + (size_t)M_ * 8, O_GS = O_TS + (size_t)M_ * 8;
constexpr size_t O_SP = O_GS + (size_t)M_ * 8;
constexpr size_t O_KM = O_SP + al256((size_t)NSLOT * 4);
constexpr size_t O_DT = O_KM + (size_t)NB * ATT_H * NBLK * 64 * 4;
constexpr size_t O_WSB = al256(O_DT + (size_t)M_ * 24);
constexpr size_t O_HB = (O_WSB + (size_t)2 * GM_G * GM_CHUNK * GM_CHUNK * 2 + MiB - 1) / MiB * MiB;
constexpr size_t O_MWGU = O_HB + (size_t)M_ * DM * 2;
constexpr size_t O_WIN = O_MWGU + (size_t)N_EXP * NGUE * DM * 2;
constexpr size_t O_WOUT = O_WIN + (size_t)2 * PLD * DM * 2;
constexpr size_t O_WGU = O_WOUT + (size_t)2 * DM * DM * 2;
constexpr size_t O_WD = O_WGU + (size_t)NGU * DM * 2;
constexpr size_t O_SCR = O_WD + (size_t)DM * D_FF * 2;
constexpr size_t O_PROJ = O_SCR;
constexpr size_t O_XC = O_PROJ + (size_t)M_ * PLD * 2;
constexpr size_t O_MIXU = O_XC + (size_t)M_ * SSD_CW * 2;
constexpr size_t O_MIXB = O_MIXU + (size_t)M_ * DM * 4;
constexpr size_t O_VN = O_MIXB + (size_t)M_ * DM * 2;
constexpr size_t O_MIXEND = O_VN + (size_t)M_ * GM_W * 4;
constexpr size_t O_Y = O_SCR;
constexpr size_t O_ACT = O_Y + (size_t)M_ * DM * 4;
constexpr size_t O_XG = O_WIN;
constexpr size_t O_ACTM = O_XG + (size_t)NSLOT * DM * 2;
constexpr size_t O_MOEEND = O_ACTM + (size_t)NSLOT * D_FFE * 2;
constexpr size_t WS_END = O_MOEEND > O_MIXEND ? O_MOEEND : O_MIXEND;
static_assert(O_ACT + (size_t)M_ * D_FF * 2 <= O_MIXEND + (size_t)M_ * 4096, "act");
static_assert((size_t)NB * 16 * SSD_H * 8192 * 4 <= (size_t)M_ * SSD_CW * 2, "SSD states fit in the XC slot");
static_assert(WS_END <= 487000000ull, "workspace map exceeds the guaranteed size");
static_assert((size_t)N_EXP * DM * D_FFE * 2 <= (size_t)N_EXP * NGUE * DM * 2, "MWD fits over MWGU");
constexpr int CW_BAR = 4096, CW_CNT = 1024, CW_Q = 1040, CW_ERR = 2048;

constexpr int RING_BYTES = 131072, MISC_OFF = RING_BYTES + 320, LDS_BYTES = 147456;

#define GAS __attribute__((address_space(1)))
#define LAS __attribute__((address_space(3)))
typedef GAS unsigned gu32;
#define RLX_AGENT __ATOMIC_RELAXED, __HIP_MEMORY_SCOPE_AGENT
#define LDS_WAIT() asm volatile("s_waitcnt lgkmcnt(0)" ::: "memory")

constexpr float QSCALE = 0.125f * 1.4426950408889634f;
namespace fp {
using pg8::Unit; using pg8::BM; using pg8::HALF; typedef pg8::f32x4 f32x4; typedef pg8::u32x4 u32x4;
__device__ __forceinline__ unsigned pk2(float lo, float hi) { return pg8::cvt_pk_bf16(lo, hi); }
__device__ __forceinline__ float gelu_fast(float x) { const float u = 0.7978845608028654f * (x + 0.044715f * x * x * x); return x / (1.f + __expf(-2.f * u)); }

struct EpiProj {
    static constexpr bool PERM = true, AFTER_DRAIN = false;
    bf16* O; const float* RT;
    __device__ __forceinline__ void operator()(const f32x4 (&acc)[2][2][4][2], const Unit& u, int wr, int wc, int fr, int fq) const {
        const int row0 = u.pm * BM + wr * 64 + fr, col0 = u.pn * BM + wc * 32 + 8 * fq;
        const int mode = (u.pn < 3) ? 1 : ((u.pn == 6 || u.pn == 7) ? 2 : 0);
        const bool rl = ((wc & 1) == 0) && (fq < 2);
        const int i0 = (fq & 1) * 4;
#pragma unroll
        for (int ai = 0; ai < 2; ++ai)
#pragma unroll
            for (int m = 0; m < 4; ++m) { const int row = row0 + ai * HALF + m * 16;
                float4 c4 = make_float4(1.f, 1.f, 1.f, 1.f), s4 = make_float4(0.f, 0.f, 0.f, 0.f);
                if (mode == 1 && rl) { c4 = *(const float4*)(RT + (size_t)row * 16 + i0); s4 = *(const float4*)(RT + (size_t)row * 16 + 8 + i0); }
#pragma unroll
                for (int bj = 0; bj < 2; ++bj) { f32x4 v0 = acc[ai][bj][m][0], v1 = acc[ai][bj][m][1];
                    if (mode == 1) { const f32x4 a = v0, b = v1;
                        v0[0] = a[0] * c4.x - a[1] * s4.x; v0[1] = a[1] * c4.x + a[0] * s4.x; v0[2] = a[2] * c4.y - a[3] * s4.y; v0[3] = a[3] * c4.y + a[2] * s4.y;
                        v1[0] = b[0] * c4.z - b[1] * s4.z; v1[1] = b[1] * c4.z + b[0] * s4.z; v1[2] = b[2] * c4.w - b[3] * s4.w; v1[3] = b[3] * c4.w + b[2] * s4.w; }
                    if (u.pn == 0 || (u.pn == 1 && bj == 0)) { v0 = v0 * QSCALE; v1 = v1 * QSCALE; }
                    if (mode == 2) {
#pragma unroll
                        for (int j = 0; j < 4; ++j) { v0[j] = gelu_fast(v0[j]); v1[j] = gelu_fast(v1[j]); } }
                    u32x4 w; w.x = pk2(v0[0], v0[1]); w.y = pk2(v0[2], v0[3]); w.z = pk2(v1[0], v1[1]); w.w = pk2(v1[2], v1[3]);
                    *(u32x4*)(O + (size_t)row * PLD + col0 + bj * HALF) = w; } }
    }
};
struct EpiAct {
    static constexpr bool PERM = true, AFTER_DRAIN = false;
    bf16* O; int ldc, ncol;
    __device__ __forceinline__ void operator()(const f32x4 (&acc)[2][2][4][2], const Unit& u, int wr, int wc, int fr, int fq) const {
        const int row0 = u.pm * BM + wr * 64 + fr, col0 = (u.pn % ncol) * HALF + wc * 32 + 8 * fq;
#pragma unroll
        for (int ai = 0; ai < 2; ++ai)
#pragma unroll
            for (int m = 0; m < 4; ++m) { const int row = row0 + ai * HALF + m * 16;
                const f32x4 g0 = acc[ai][0][m][0], g1 = acc[ai][0][m][1], u0 = acc[ai][1][m][0], u1 = acc[ai][1][m][1]; f32x4 a0, a1;
#pragma unroll
                for (int j = 0; j < 4; ++j) { a0[j] = g0[j] / (1.f + __expf(-g0[j])) * u0[j]; a1[j] = g1[j] / (1.f + __expf(-g1[j])) * u1[j]; }
                u32x4 w; w.x = pk2(a0[0], a0[1]); w.y = pk2(a0[2], a0[3]); w.z = pk2(a1[0], a1[1]); w.w = pk2(a1[2], a1[3]);
                *(u32x4*)(O + (size_t)row * ldc + col0) = w; }
    }
};
struct EpiF32 {
    static constexpr bool PERM = false, AFTER_DRAIN = false;
    float* O; int ldc;
    __device__ __forceinline__ void operator()(const f32x4 (&acc)[2][2][4][2], const Unit& u, int wr, int wc, int fr, int fq) const {
        const int row0 = u.pm * BM + wr * 64 + fr, col0 = u.pn * BM + wc * 32 + 4 * fq;
#pragma unroll
        for (int ai = 0; ai < 2; ++ai)
#pragma unroll
            for (int m = 0; m < 4; ++m) { float* rp = O + (size_t)(row0 + ai * HALF + m * 16) * ldc + col0;
#pragma unroll
                for (int bj = 0; bj < 2; ++bj)
#pragma unroll
                    for (int n = 0; n < 2; ++n) *(f32x4*)(rp + bj * HALF + n * 16) = acc[ai][bj][m][n]; }
    }
};
struct EpiF2 {
    static constexpr bool PERM = true, AFTER_DRAIN = false;
    bf16* O; const float* SP;
    __device__ __forceinline__ void operator()(const f32x4 (&acc)[2][2][4][2], const Unit& u, int wr, int wc, int fr, int fq) const {
        const int row0 = u.pm * BM + wr * 64 + fr, col0 = (u.pn & 3) * BM + wc * 32 + 8 * fq;
#pragma unroll
        for (int ai = 0; ai < 2; ++ai)
#pragma unroll
            for (int m = 0; m < 4; ++m) { const int row = row0 + ai * HALF + m * 16; const float sc = SP[row];
#pragma unroll
                for (int bj = 0; bj < 2; ++bj) { const f32x4 v0 = acc[ai][bj][m][0] * sc, v1 = acc[ai][bj][m][1] * sc;
                    u32x4 w; w.x = pk2(v0[0], v0[1]); w.y = pk2(v0[2], v0[3]); w.z = pk2(v1[0], v1[1]); w.w = pk2(v1[2], v1[3]);
                    *(u32x4*)(O + (size_t)row * DM + col0 + bj * HALF) = w; } }
    }
};
struct MoeOrder {
    int p0, p1, p2, p3, p4, p5, p6, T, ncol, G, c;
    __device__ __forceinline__ void init(const int* CNT, int ncol_, int G_, int c_) {
        int t = 0; t += (CNT[0] + 255) >> 8; p0 = t; t += (CNT[1] + 255) >> 8; p1 = t; t += (CNT[2] + 255) >> 8; p2 = t; t += (CNT[3] + 255) >> 8; p3 = t;
        t += (CNT[4] + 255) >> 8; p4 = t; t += (CNT[5] + 255) >> 8; p5 = t; t += (CNT[6] + 255) >> 8; p6 = t; t += (CNT[7] + 255) >> 8; T = t; ncol = ncol_; G = G_; c = c_;
    }
    __device__ __forceinline__ bool next(int i, Unit& u) const {
        const long L = (long)i * G + c; if (L >= (long)T * ncol) return false;
        const int tm = (int)(L / ncol), j = (int)(L % ncol);
        const int e = (tm >= p0) + (tm >= p1) + (tm >= p2) + (tm >= p3) + (tm >= p4) + (tm >= p5) + (tm >= p6);
        u.pm = tm; u.pn = e * ncol + j; return true;
    }
    __device__ __forceinline__ void a_ready(const Unit&) const {}
    __device__ __forceinline__ void done(const Unit&) const {}
};

struct SrcCol { const float* p; int ld; };
__device__ __forceinline__ int win_src_col(int d) {
    if (d < 768) { const int hd = d & 63; const int sd = hd < 16 ? ((hd & 1) ? 8 + (hd >> 1) : (hd >> 1)) : hd; return d - hd + sd; }
    if (d < 1536) return d;
    if (d < 1792) return 2438 + (d - 1536);
    if (d < 2048) return 2694 + (d - 1792);
    if (d < 2944) return 1536 + (d - 2048);
    if (d < 2950) return 2432 + (d - 2944);
    return -1;
}
__device__ __forceinline__ SrcCol gu_src(const float* wg, const float* wu, int nff, int r) {
    const int tile = r >> 8, rr = r & 255, j = tile * 128 + (rr & 127); SrcCol s; s.p = (rr < 128 ? wg : wu) + j; s.ld = nff; return s;
}
__device__ __forceinline__ void conv_item(SrcCol sc, int K, bf16* WT, long d0, int k0, LAS float* scr, int lane) {
#pragma unroll 8
    for (int i = 0; i < 32; ++i) { const int kk = 2 * i + (lane >> 5); scr[kk * 33 + (lane & 31)] = sc.p ? sc.p[(size_t)(k0 + kk) * sc.ld] : 0.f; }
    LDS_WAIT(); asm volatile("" ::: "memory");
    const int c = lane & 7;
#pragma unroll
    for (int j = 0; j < 4; ++j) { const int n = (lane >> 3) + 8 * j; const LAS float* s = scr + (8 * c) * 33 + n;
        u32x4 o; o.x = pk2(s[0 * 33], s[1 * 33]); o.y = pk2(s[2 * 33], s[3 * 33]); o.z = pk2(s[4 * 33], s[5 * 33]); o.w = pk2(s[6 * 33], s[7 * 33]);
        *(u32x4*)(WT + (size_t)(d0 + n) * K + k0 + 8 * c) = o; }
    LDS_WAIT(); asm volatile("" ::: "memory");
}
}


typedef short bf16x8_t __attribute__((ext_vector_type(8)));
typedef float f32x4_t __attribute__((ext_vector_type(4)));
constexpr int TLD = 272;
__device__ __forceinline__ bf16x8_t lds_frag(const LAS unsigned char* base, int row, int kbyte) { return *(const LAS bf16x8_t*)(base + row * TLD + kbyte); }
__device__ __forceinline__ float red16(float v) { v += __shfl_xor(v, 1); v += __shfl_xor(v, 2); v += __shfl_xor(v, 4); v += __shfl_xor(v, 8); return v; }

__device__ __forceinline__ void gm_unit(int b, int c, const bf16* PROJ, const bf16* WSB  , const float* ln_g, const float* ln_b, const float* b_s, const float* norm_g,
                                        bf16* MIXB, LAS unsigned char* lds, int wave, int lane) {
    const long r0 = (long)b * SEQ + c * GM_CHUNK;
    LAS unsigned char* VNT = lds;
    for (int i = 0; i < 16; ++i) { const int t = wave * 16 + i;
        const float4 v = ld4(PROJ + (r0 + t) * PLD + FGV + lane * 4);
        const float mean = wave_sum((v.x + v.y) + (v.z + v.w)) * (1.f / 256.f);
        const float d0 = v.x - mean, d1 = v.y - mean, d2 = v.z - mean, d3 = v.w - mean;
        const float rstd = rsqrtf(wave_sum((d0 * d0 + d1 * d1) + (d2 * d2 + d3 * d3)) * (1.f / 256.f) + 1e-5f);
        const float4 gg = *(const float4*)(ln_g + lane * 4), bb = *(const float4*)(ln_b + lane * 4);
        LAS bf16* dst = (LAS bf16*)(VNT + (lane * 4) * TLD) + t;
        dst[0] = (bf16)f2bf(d0 * rstd * gg.x + bb.x); dst[TLD / 2] = (bf16)f2bf(d1 * rstd * gg.y + bb.y); dst[TLD] = (bf16)f2bf(d2 * rstd * gg.z + bb.z); dst[3 * TLD / 2] = (bf16)f2bf(d3 * rstd * gg.w + bb.w); }
    __syncthreads();
    f32x4_t acc[16];
#pragma unroll
    for (int i = 0; i < 16; ++i) acc[i] = (f32x4_t){0.f, 0.f, 0.f, 0.f};
    const int fr = lane & 15, fq = lane >> 4;
    const int nks = (wave * 16 + 15) / 32 + 1;
    for (int ks = 0; ks < nks; ++ks) {
#pragma unroll
        for (int g = 0; g < 4; ++g) {
            const bf16x8_t af = *(const bf16x8_t*)(WSB + ((size_t)g * GM_CHUNK + wave * 16 + fr) * GM_CHUNK + ks * 32 + fq * 8);
#pragma unroll
            for (int n = 0; n < 4; ++n) { const bf16x8_t bfv = lds_frag(VNT, g * 64 + n * 16 + fr, ks * 64 + fq * 16);
                acc[g * 4 + n] = __builtin_amdgcn_mfma_f32_16x16x32_bf16(af, bfv, acc[g * 4 + n], 0, 0, 0); }
        }
    }
    __syncthreads();
    LAS bf16* ost = (LAS bf16*)(lds + wave * (16 * 264 * 2));
    float ss[4] = {0.f, 0.f, 0.f, 0.f};
#pragma unroll
    for (int nt = 0; nt < 16; ++nt) { const int col = nt * 16 + fr, g = nt >> 2;
#pragma unroll
        for (int r = 0; r < 4; ++r) { const int t = wave * 16 + fq * 4 + r;
            const float u = ldf(PROJ + (r0 + t) * PLD + FGU + col);
            const float o = u * (acc[nt][r] + b_s[g * GM_CHUNK + t]); acc[nt][r] = o; ss[r] += o * o; } }
#pragma unroll
    for (int r = 0; r < 4; ++r) ss[r] = rsqrtf(red16(ss[r]) * (1.f / 256.f) + 1e-5f);
#pragma unroll
    for (int nt = 0; nt < 16; ++nt) { const int col = nt * 16 + fr; const float gn = norm_g[col];
#pragma unroll
        for (int r = 0; r < 4; ++r) { ost[(fq * 4 + r) * 264 + col] = (bf16)f2bf(acc[nt][r] * ss[r] * gn); } }
    LDS_WAIT(); asm volatile("" ::: "memory");
#pragma unroll
    for (int i = 0; i < 8; ++i) { const int rr = i * 2 + (lane >> 5), ch = lane & 31;
        const fp::u32x4 v = *(const LAS fp::u32x4*)(ost + rr * 264 + ch * 8);
        *(fp::u32x4*)(MIXB + (r0 + wave * 16 + rr) * DM + ATT_W + SSD_W + ch * 8) = v; }
    __syncthreads();
}

typedef short v4i16_t __attribute__((ext_vector_type(4)));
typedef unsigned u32x2_t __attribute__((ext_vector_type(2)));
__device__ __forceinline__ v4i16_t lds_tr(const LAS unsigned char* p) { return __builtin_amdgcn_ds_read_tr16_b64_v4i16((LAS v4i16_t*)p); }
__device__ __forceinline__ bf16x8_t lds_frag_tr(const LAS unsigned char* tile, int pitch, int k0, int c0, int lane) {
    const int kg = lane >> 4, q = (lane & 15) >> 2, p = lane & 3;
    const LAS unsigned char* a = tile + (k0 + 8 * kg + q) * pitch + (c0 + 4 * p) * 2;
    const v4i16_t lo = lds_tr(a), hi = lds_tr(a + 4 * pitch);
    return (bf16x8_t){lo[0], lo[1], lo[2], lo[3], hi[0], hi[1], hi[2], hi[3]};
}
__device__ __forceinline__ bf16x8_t lds_frag_p(const LAS unsigned char* base, int pitch, int row, int kbyte) { return *(const LAS bf16x8_t*)(base + row * pitch + kbyte); }
template <int NCH, bool SCALE> __device__ __forceinline__ void stage_conv(const bf16* PROJ, long r0, int t0, int colbase, int ch0, const float* cw, const float* cb, LAS unsigned char* tile, int pitch, const LAS float* scl, int tid) {
    constexpr int CPR = NCH / 8;
    for (int it = tid; it < 128 * CPR; it += 512) { const int l = it / CPR, ch = (it % CPR) * 8;
        float a[8];
        { const float4 c0 = *(const float4*)(cb + ch0 + ch), c1 = *(const float4*)(cb + ch0 + ch + 4); a[0] = c0.x; a[1] = c0.y; a[2] = c0.z; a[3] = c0.w; a[4] = c1.x; a[5] = c1.y; a[6] = c1.z; a[7] = c1.w; }
#pragma unroll
        for (int i = 0; i < 4; ++i) { if (t0 + l - 3 + i >= 0) {
            const fp::u32x4 xv = *(const fp::u32x4*)(PROJ + (r0 + l - 3 + i) * PLD + colbase + ch);
            const float4 w0 = *(const float4*)(cw + i * SSD_CW + ch0 + ch), w1 = *(const float4*)(cw + i * SSD_CW + ch0 + ch + 4);
            a[0] += w0.x * __uint_as_float(xv.x << 16); a[1] += w0.y * __uint_as_float(xv.x & 0xffff0000u); a[2] += w0.z * __uint_as_float(xv.y << 16); a[3] += w0.w * __uint_as_float(xv.y & 0xffff0000u);
            a[4] += w1.x * __uint_as_float(xv.z << 16); a[5] += w1.y * __uint_as_float(xv.z & 0xffff0000u); a[6] += w1.z * __uint_as_float(xv.w << 16); a[7] += w1.w * __uint_as_float(xv.w & 0xffff0000u); } }
        float sc = 1.f; if (SCALE) sc = scl[(ch >> 6) * 128 + l];
#pragma unroll
        for (int j = 0; j < 8; ++j) a[j] = a[j] / (1.f + __expf(-a[j])) * sc;
        fp::u32x4 o; o.x = fp::pk2(a[0], a[1]); o.y = fp::pk2(a[2], a[3]); o.z = fp::pk2(a[4], a[5]); o.w = fp::pk2(a[6], a[7]);
        *(LAS fp::u32x4*)(tile + l * pitch + ch * 2) = o; }
}
__device__ __forceinline__ void ssd_dt_acum(const bf16* PROJ, long r0, int g, const float* dt_bias, const float* a_log, LAS float* dtS, LAS float* acS, int tid, int wave, int lane) {
    if (tid < 384) { const int hh = tid >> 7, l = tid & 127, h = 3 * g + hh;
        const float dtv = softplus_f(ldf(PROJ + (r0 + l) * PLD + FDT + h) + dt_bias[h]); dtS[tid] = dtv; acS[tid] = dtv * (-__expf(a_log[h])); }
    __syncthreads();
    if (wave < 3) { const float a0 = acS[wave * 128 + 2 * lane], a1 = acS[wave * 128 + 2 * lane + 1]; const float sm = a0 + a1; float v = sm;
#pragma unroll
        for (int o = 1; o < 64; o <<= 1) { const float t = __shfl_up(v, o); if (lane >= o) v += t; }
        const float ex = v - sm; acS[wave * 128 + 2 * lane] = ex + a0; acS[wave * 128 + 2 * lane + 1] = ex + sm; }
    __syncthreads();
}
constexpr int XP = 400;
__device__ __forceinline__ void ssdA_unit(int b, int c, int g, const bf16* PROJ, const float* cw, const float* cb, const float* dt_bias, const float* a_log, float* ST, float* CD,
                                          LAS unsigned char* lds, int tid, int wave, int lane) {
    const long r0 = (long)b * SEQ + c * 128; const int t0 = c * 128;
    LAS unsigned char* XS = lds; LAS unsigned char* BS = lds + 51200;
    LAS float* dtS = (LAS float*)(lds + 86016); LAS float* acS = dtS + 384; LAS float* sclS = acS + 384;
    ssd_dt_acum(PROJ, r0, g, dt_bias, a_log, dtS, acS, tid, wave, lane);
    if (tid < 384) { const int hh = tid >> 7; const float al = acS[hh * 128 + 127]; sclS[tid] = dtS[tid] * __expf(al - acS[tid]);
        if ((tid & 127) == 0) CD[((long)b * 16 + c) * SSD_H + 3 * g + hh] = __expf(al); }
    __syncthreads();
    stage_conv<192, true>(PROJ, r0, t0, FXBC + 192 * g, 192 * g, cw, cb, XS, XP, sclS, tid);
    stage_conv<128, false>(PROJ, r0, t0, FXBC + SSD_W + 128 * g, SSD_W + 128 * g, cw, cb, BS, TLD, nullptr, tid);
    __syncthreads();
    f32x4_t acc[12];
#pragma unroll
    for (int i = 0; i < 12; ++i) acc[i] = (f32x4_t){0.f, 0.f, 0.f, 0.f};
#pragma unroll 1
    for (int ks = 0; ks < 4; ++ks) { const bf16x8_t bfv = lds_frag_tr(BS, TLD, ks * 32, 16 * wave, lane);
#pragma unroll
        for (int mt = 0; mt < 12; ++mt) { const bf16x8_t af = lds_frag_tr(XS, XP, ks * 32, (mt >> 2) * 64 + (mt & 3) * 16, lane); acc[mt] = __builtin_amdgcn_mfma_f32_16x16x32_bf16(af, bfv, acc[mt], 0, 0, 0); } }
    const int fr = lane & 15, fq = lane >> 4;
    float* sp = ST + (((long)b * 16 + c) * SSD_H + 3 * g) * 8192 + 16 * wave + fr;
#pragma unroll
    for (int mt = 0; mt < 12; ++mt)
#pragma unroll
        for (int r = 0; r < 4; ++r) sp[(mt >> 2) * 8192 + ((mt & 3) * 16 + 4 * fq + r) * 128] = acc[mt][r];
    __syncthreads();
}
__device__ __forceinline__ void ssdB_unit(int b, int c, int g, const bf16* PROJ, const float* cw, const float* cb, const float* dt_bias, const float* a_log, const float* dsk, const float* ng,
                                          const float* ST, const float* CD, bf16* MIXB, LAS unsigned char* lds, int tid, int wave, int lane) {
    const long r0 = (long)b * SEQ + c * 128; const int t0 = c * 128;
    LAS unsigned char* CS = lds; LAS unsigned char* PX = lds + 34816; LAS unsigned char* BG = lds + 87040;
    LAS float* dtS = (LAS float*)(lds + 121856); LAS float* acS = dtS + 384;
    const int fr = lane & 15, fq = lane >> 4;
    ssd_dt_acum(PROJ, r0, g, dt_bias, a_log, dtS, acS, tid, wave, lane);
    stage_conv<128, false>(PROJ, r0, t0, FXBC + SSD_W + 256 + 128 * g, SSD_W + 256 + 128 * g, cw, cb, CS, TLD, nullptr, tid);
    if (c > 0) {
        float4 pv[12];
#pragma unroll
        for (int i = 0; i < 12; ++i) pv[i] = make_float4(0.f, 0.f, 0.f, 0.f);
        for (int j = 0; j < c; ++j) { const float* sj = ST + (((long)b * 16 + j) * SSD_H + 3 * g) * 8192 + tid * 4; const float* cd = CD + ((long)b * 16 + j) * SSD_H + 3 * g;
            const float d0 = cd[0], d1 = cd[1], d2 = cd[2];
#pragma unroll
            for (int i = 0; i < 12; ++i) { const float4 sv = *(const float4*)(sj + i * 2048); const float d = (i < 4) ? d0 : ((i < 8) ? d1 : d2);
                pv[i].x = pv[i].x * d + sv.x; pv[i].y = pv[i].y * d + sv.y; pv[i].z = pv[i].z * d + sv.z; pv[i].w = pv[i].w * d + sv.w; } }
#pragma unroll
        for (int i = 0; i < 12; ++i) { const int row = (i >> 2) * 64 + (i & 3) * 16 + (tid >> 5), n = (tid & 31) * 4;
            u32x2_t w; w.x = fp::pk2(pv[i].x, pv[i].y); w.y = fp::pk2(pv[i].z, pv[i].w); *(LAS u32x2_t*)(PX + row * TLD + n * 2) = w; }
    }
    __syncthreads();
    f32x4_t acc_y[12];
#pragma unroll
    for (int i = 0; i < 12; ++i) acc_y[i] = (f32x4_t){0.f, 0.f, 0.f, 0.f};
    if (c > 0) {
#pragma unroll 1
        for (int ks = 0; ks < 4; ++ks) { const bf16x8_t af = lds_frag_p(CS, TLD, 16 * wave + fr, ks * 64 + fq * 16);
#pragma unroll
            for (int t = 0; t < 12; ++t) { const bf16x8_t bfv = lds_frag_p(PX, TLD, (t >> 2) * 64 + (t & 3) * 16 + fr, ks * 64 + fq * 16); acc_y[t] = __builtin_amdgcn_mfma_f32_16x16x32_bf16(af, bfv, acc_y[t], 0, 0, 0); } }
#pragma unroll
        for (int t = 0; t < 12; ++t)
#pragma unroll
            for (int r = 0; r < 4; ++r) acc_y[t][r] *= __expf(acS[(t >> 2) * 128 + 16 * wave + 4 * fq + r]);
    }
    __syncthreads();
    stage_conv<192, false>(PROJ, r0, t0, FXBC + 192 * g, 192 * g, cw, cb, PX, XP, nullptr, tid);
    stage_conv<128, false>(PROJ, r0, t0, FXBC + SSD_W + 128 * g, SSD_W + 128 * g, cw, cb, BG, TLD, nullptr, tid);
    __syncthreads();
#if defined(SSDB_CUT) && SSDB_CUT == 2
    { float t_ = 0.f; for (int i = 0; i < 12; ++i) t_ += acc_y[i][0] + acc_y[i][1] + acc_y[i][2] + acc_y[i][3]; if (t_ == 123.f) MIXB[0] = 1; return; }
#endif
    f32x4_t acc_cb[8];
#pragma unroll
    for (int i = 0; i < 8; ++i) acc_cb[i] = (f32x4_t){0.f, 0.f, 0.f, 0.f};
#pragma unroll 1
    for (int ks = 0; ks < 4; ++ks) { const bf16x8_t af = lds_frag_p(CS, TLD, 16 * wave + fr, ks * 64 + fq * 16);
#pragma unroll
        for (int ns = 0; ns < 8; ++ns) if (ns <= wave) { const bf16x8_t bfv = lds_frag_p(BG, TLD, 16 * ns + fr, ks * 64 + fq * 16); acc_cb[ns] = __builtin_amdgcn_mfma_f32_16x16x32_bf16(af, bfv, acc_cb[ns], 0, 0, 0); } }
    __syncthreads();
    LAS unsigned char* GS = BG + wave * 16 * TLD;
    const int nks = (16 * wave + 15) / 32 + 1;
#pragma unroll
    for (int hh = 0; hh < 3; ++hh) {
#pragma unroll
        for (int ns = 0; ns < 8; ++ns) if (ns <= (wave | 1)) {
#pragma unroll
            for (int r = 0; r < 4; ++r) { const int l = 16 * wave + 4 * fq + r, sidx = 16 * ns + fr;
                const float gv = (ns <= wave && sidx <= l) ? acc_cb[ns][r] * __expf(acS[hh * 128 + l] - acS[hh * 128 + sidx]) * dtS[hh * 128 + sidx] : 0.f;
                *(LAS bf16*)(GS + (4 * fq + r) * TLD + sidx * 2) = (bf16)f2bf(gv); } }
        LDS_WAIT(); asm volatile("" ::: "memory");
#pragma unroll 1
        for (int ks = 0; ks < nks; ++ks) { const bf16x8_t af = lds_frag_p(GS, TLD, fr, ks * 64 + fq * 16);
#pragma unroll
            for (int np = 0; np < 4; ++np) { const bf16x8_t bfv = lds_frag_tr(PX, XP, ks * 32, hh * 64 + np * 16, lane); acc_y[hh * 4 + np] = __builtin_amdgcn_mfma_f32_16x16x32_bf16(af, bfv, acc_y[hh * 4 + np], 0, 0, 0); } }
        LDS_WAIT(); asm volatile("" ::: "memory");
    }
#if defined(SSDB_CUT) && SSDB_CUT == 1
    { float t_ = 0.f; for (int i = 0; i < 12; ++i) t_ += acc_y[i][0] + acc_y[i][1] + acc_y[i][2] + acc_y[i][3]; if (t_ == 123.f) MIXB[0] = 1; return; }
#endif
#pragma unroll
    for (int t = 0; t < 12; ++t) { const int hh = t >> 2, col = hh * 64 + (t & 3) * 16 + fr; const float dk = dsk[3 * g + hh];
#pragma unroll
        for (int r = 0; r < 4; ++r) { const int l = 16 * wave + 4 * fq + r; acc_y[t][r] += dk * __uint_as_float(((unsigned)*(const LAS bf16*)(PX + l * XP + col * 2)) << 16); } }
    __syncthreads();
    LAS bf16* ost = (LAS bf16*)(lds + wave * (16 * XP));
#pragma unroll
    for (int t = 0; t < 12; ++t) { const int col = (t >> 2) * 64 + (t & 3) * 16 + fr;
#pragma unroll
        for (int r = 0; r < 4; ++r) ost[(4 * fq + r) * (XP / 2) + col] = (bf16)f2bf(acc_y[t][r]); }
    LDS_WAIT(); asm volatile("" ::: "memory");
    { const int rr = lane >> 2, q = lane & 3; const long row = r0 + 16 * wave + rr;
      float yz[48]; float ssum = 0.f;
#pragma unroll
      for (int i = 0; i < 6; ++i) { const int c8 = (q * 6 + i) * 8;
          const fp::u32x4 yv = *(const LAS fp::u32x4*)(ost + rr * (XP / 2) + c8);
          const fp::u32x4 zv = *(const fp::u32x4*)(PROJ + row * PLD + FZ + 192 * g + c8);
#pragma unroll
          for (int j = 0; j < 4; ++j) { const unsigned yw = yv[j], zw = zv[j];
              const float y0 = __uint_as_float(yw << 16), y1 = __uint_as_float(yw & 0xffff0000u), z0 = __uint_as_float(zw << 16), z1 = __uint_as_float(zw & 0xffff0000u);
              const float a0 = y0 * (z0 / (1.f + __expf(-z0))), a1 = y1 * (z1 / (1.f + __expf(-z1))); yz[i * 8 + 2 * j] = a0; yz[i * 8 + 2 * j + 1] = a1; ssum += a0 * a0 + a1 * a1; } }
      ssum += __shfl_xor(ssum, 1); ssum += __shfl_xor(ssum, 2);
      const float rinv = rsqrtf(ssum * (1.f / 192.f) + 1e-5f);
#pragma unroll
      for (int i = 0; i < 6; ++i) { const int c8 = (q * 6 + i) * 8;
          const float4 g0 = *(const float4*)(ng + 192 * g + c8), g1 = *(const float4*)(ng + 192 * g + c8 + 4);
          fp::u32x4 o; o.x = fp::pk2(yz[i * 8] * rinv * g0.x, yz[i * 8 + 1] * rinv * g0.y); o.y = fp::pk2(yz[i * 8 + 2] * rinv * g0.z, yz[i * 8 + 3] * rinv * g0.w);
          o.z = fp::pk2(yz[i * 8 + 4] * rinv * g1.x, yz[i * 8 + 5] * rinv * g1.y); o.w = fp::pk2(yz[i * 8 + 6] * rinv * g1.z, yz[i * 8 + 7] * rinv * g1.w);
          *(fp::u32x4*)(MIXB + row * DM + ATT_W + 192 * g + c8) = o; } }
    __syncthreads();
}

__device__ __forceinline__ void att_norm_phase(bf16* MIXB, const float* g, long n_rows, int gw, int ngw, int lane) {
    for (long row = gw; row < n_rows; row += ngw) { bf16* p = MIXB + row * DM + lane * 8; float v[8]; float s2 = 0.f;
        if (lane < 48) { const fp::u32x4 w = *(const fp::u32x4*)p;
#pragma unroll
            for (int j = 0; j < 4; ++j) { v[2 * j] = __uint_as_float(w[j] << 16); v[2 * j + 1] = __uint_as_float(w[j] & 0xffff0000u); s2 += v[2 * j] * v[2 * j] + v[2 * j + 1] * v[2 * j + 1]; } }
        const float r = rsqrtf(wave_sum(s2) * (1.f / 384.f) + 1e-5f);
        if (lane < 48) { const float4 g0 = *(const float4*)(g + lane * 8), g1 = *(const float4*)(g + lane * 8 + 4);
            fp::u32x4 o; o.x = fp::pk2(v[0] * r * g0.x, v[1] * r * g0.y); o.y = fp::pk2(v[2] * r * g0.z, v[3] * r * g0.w); o.z = fp::pk2(v[4] * r * g1.x, v[5] * r * g1.y); o.w = fp::pk2(v[6] * r * g1.z, v[7] * r * g1.w);
            *(fp::u32x4*)p = o; } }
}

struct FArgs { const void* in[29]; float* out; unsigned char* ws; int ph_lo, ph_hi; };

constexpr int N_PHASES = 21;
__global__ void __launch_bounds__(512, 2) mega(FArgs a) {
    extern __shared__ __attribute__((aligned(16))) unsigned char lds_[];
    LAS unsigned char* lds = (LAS unsigned char*)lds_;
    const int tid = threadIdx.x, lane = tid & 63, wave = __builtin_amdgcn_readfirstlane(tid >> 6);
    const int G = gridDim.x; const int bx = blockIdx.x; const int vcu = (G % 8 == 0) ? (bx % 8) * (G / 8) + bx / 8 : bx;
    const int gw = vcu * 8 + wave, ngw = G * 8; const long gt = (long)gw * 64 + lane, ngt = (long)ngw * 64;
    unsigned char* ws = a.ws;
    unsigned* ctl = (unsigned*)(ws + O_CTL);
    for (int u = tid; u < (LDS_BYTES - RING_BYTES) / 4; u += 512) ((LAS unsigned*)(lds + RING_BYTES))[u] = 0u;
    __syncthreads();
    const int lo = a.ph_lo, hi = a.ph_hi;
    XcdBarrier bar; bar.bar = ctl + CW_BAR; bar.x = 0; bar.st = nullptr;
    if (hi - lo > 1) bar = xcd_barrier_post(ctl + CW_BAR, (volatile LAS unsigned*)(lds + MISC_OFF) + 8);
    const float* x = (const float*)a.in[0]; const int* pos = (const int*)a.in[1]; const float* ln_in_g = (const float*)a.in[2]; const float* ln_in_b = (const float*)a.in[3];
    const float* w_in = (const float*)a.in[4]; const float* conv_w = (const float*)a.in[5]; const float* conv_b = (const float*)a.in[6]; const float* dt_bias = (const float*)a.in[7];
    const float* a_log = (const float*)a.in[8]; const float* d_skip = (const float*)a.in[9]; const float* ssd_norm_g = (const float*)a.in[10]; const float* att_norm_g = (const float*)a.in[11];
    const float* gm_ln_g = (const float*)a.in[12]; const float* gm_ln_b = (const float*)a.in[13]; const float* gm_w_s = (const float*)a.in[14]; const float* gm_b_s = (const float*)a.in[15];
    const float* gm_norm_g = (const float*)a.in[16]; const float* w_out = (const float*)a.in[17]; const float* ln1_g = (const float*)a.in[18]; const float* ln1_b = (const float*)a.in[19];
    const float* ln2_g = (const float*)a.in[20]; const float* ln2_b = (const float*)a.in[21]; const float* ffn_w_gate = (const float*)a.in[22]; const float* ffn_w_up = (const float*)a.in[23];
    const float* ffn_w_down = (const float*)a.in[24]; const float* router_w = (const float*)a.in[25]; const float* moe_w_gate = (const float*)a.in[26]; const float* moe_w_up = (const float*)a.in[27];
    const float* moe_w_down = (const float*)a.in[28];
    float* H = a.out;
    float* RT = (float*)(ws + O_RT); int* TE = (int*)(ws + O_TE); float* TP = (float*)(ws + O_TP); int* TS = (int*)(ws + O_TS); int* GS = (int*)(ws + O_GS); float* SP = (float*)(ws + O_SP);
    float* KM = (float*)(ws + O_KM); float* DT = (float*)(ws + O_DT); bf16* WSB = (bf16*)(ws + O_WSB); bf16* HB = (bf16*)(ws + O_HB); bf16* MWGU = (bf16*)(ws + O_MWGU); bf16* MWD = (bf16*)(ws + O_MWGU);
    bf16* WIN = (bf16*)(ws + O_WIN); bf16* WOUT = (bf16*)(ws + O_WOUT); bf16* WGU = (bf16*)(ws + O_WGU); bf16* WD = (bf16*)(ws + O_WD);
    bf16* PROJ = (bf16*)(ws + O_PROJ); float* ST = (float*)(ws + O_XC); float* CD = (float*)(ws + O_DT); float* MIXU = (float*)(ws + O_MIXU); bf16* MIXB = (bf16*)(ws + O_MIXB); float* VN = (float*)(ws + O_VN);
    float* Y = (float*)(ws + O_Y); bf16* ACT = (bf16*)(ws + O_ACT); bf16* XG = (bf16*)(ws + O_XG); bf16* F2 = (bf16*)(ws + O_XG); bf16* ACTM = (bf16*)(ws + O_ACTM);
    int* CNT = (int*)(ctl + CW_CNT);
    const ProjL FL{PLD, FQ, FK, FV, FZ, FXBC, FDT, FGU, FGV};
    LAS float* scr = (LAS float*)(lds + wave * 16384);

#ifndef PH_MASK
#define PH_MASK 0xffffffffu
#endif
#define PH_BEGIN(k) if (lo <= (k) && (k) < hi && ((PH_MASK >> (k)) & 1u)) {
#define PH_END(k)   if ((k) + 1 < hi) xcd_barrier(bar); }

    PH_BEGIN(0)
    {
        constexpr int I_WIN = 16 * (PLD / 32), I_WOUT = 16 * (DM / 32), I_WGU = 16 * (NGU / 32), I_WD = (D_FF / 64) * (DM / 32), I_MWGU = 16 * (N_EXP * NGUE / 32);
        constexpr int NIT = 2 * I_WIN + 2 * I_WOUT + I_WGU + I_WD + I_MWGU;
        for (int it = gw; it < NIT; it += ngw) {
            int r = it; const int l5 = lane & 31;
            if (r < 2 * I_WIN) { const int L = r / I_WIN; r -= L * I_WIN; const int kb = r / (PLD / 32), db = r % (PLD / 32); const int sc_ = fp::win_src_col(db * 32 + l5);
                fp::SrcCol s; s.p = sc_ >= 0 ? w_in + (size_t)L * DM * D_IN + sc_ : nullptr; s.ld = D_IN; fp::conv_item(s, DM, WIN + (size_t)L * PLD * DM, db * 32, kb * 64, scr, lane); continue; } r -= 2 * I_WIN;
            if (r < 2 * I_WOUT) { const int L = r / I_WOUT; r -= L * I_WOUT; const int kb = r / (DM / 32), db = r % (DM / 32);
                fp::SrcCol s; s.p = w_out + (size_t)L * DM * DM + db * 32 + l5; s.ld = DM; fp::conv_item(s, DM, WOUT + (size_t)L * DM * DM, db * 32, kb * 64, scr, lane); continue; } r -= 2 * I_WOUT;
            if (r < I_WGU) { const int kb = r / (NGU / 32), db = r % (NGU / 32);
                fp::conv_item(fp::gu_src(ffn_w_gate, ffn_w_up, D_FF, db * 32 + l5), DM, WGU, db * 32, kb * 64, scr, lane); continue; } r -= I_WGU;
            if (r < I_WD) { const int kb = r / (DM / 32), db = r % (DM / 32);
                fp::SrcCol s; s.p = ffn_w_down + db * 32 + l5; s.ld = DM; fp::conv_item(s, D_FF, WD, db * 32, kb * 64, scr, lane); continue; } r -= I_WD;
            { const int kb = r / (N_EXP * NGUE / 32), db = r % (N_EXP * NGUE / 32); const int d = db * 32 + l5, e = d / NGUE;
                fp::conv_item(fp::gu_src(moe_w_gate + (size_t)e * DM * D_FFE, moe_w_up + (size_t)e * DM * D_FFE, D_FFE, d - e * NGUE), DM, MWGU, (long)db * 32, kb * 64, scr, lane); }
        }
        for (long it = gt; it < (long)M_ * 8; it += ngt) { const int i = (int)(it & 7); const long row = it >> 3;
            const float inv = powf(500000.0f, -(float)(2 * i) / 16.0f); const float ang = (float)pos[row] * inv; RT[row * 16 + i] = cosf(ang); RT[row * 16 + 8 + i] = sinf(ang); }
        for (long it = gt; it < 2L * GM_G * GM_CHUNK * GM_CHUNK; it += ngt) { const int sidx = (int)(it & 127), t = (int)((it >> 7) & 127); WSB[it] = (bf16)(sidx <= t ? f2bf(gm_w_s[it]) : 0u); }
        for (long r = gw; r < M_; r += ngw) ln_row<float>(x + r * DM, 1.f, nullptr, nullptr, ln_in_g, ln_in_b, H + r * DM, HB + r * DM, lane);
    }
    PH_END(0)


    { constexpr int layer = 0; constexpr int PB = 1;
        PH_BEGIN(PB + 0)
        { pg8::Gemm g{HB, WIN + (size_t)layer * PLD * DM, M_, PLD, DM}; pg8::StaticOrder S; S.init(M_, PLD, G, bx);
          fp::EpiProj E{PROJ, RT}; pg8::gemm_phase<fp::EpiProj, pg8::StaticOrder, true, true>(lds, g, S, E); }
        PH_END(PB + 0)
        PH_BEGIN(PB + 1)
        { kmean_phase<bf16>(PROJ, FL, KM, NB, gt, ngt);
          for (int u = vcu; u < NB * 32; u += G) ssdA_unit(u >> 5, (u >> 1) & 15, u & 1, PROJ, conv_w + (size_t)layer * 4 * SSD_CW, conv_b + layer * SSD_CW, dt_bias + layer * SSD_H, a_log + layer * SSD_H, ST, CD, lds, tid, wave, lane);
        }
        PH_END(PB + 1)
        PH_BEGIN(PB + 2)
        { constexpr int NATT = NB * ATT_H * NBLK, NSSDB = NB * 32, NGMU = NB * (SEQ / GM_CHUNK);
          volatile LAS unsigned* qw = (volatile LAS unsigned*)(lds + MISC_OFF) + 16;
#define QNEXT(word) do { if (tid == 0) qw[0] = __hip_atomic_fetch_add(ctl + (word), 1u, __ATOMIC_RELAXED, __HIP_MEMORY_SCOPE_AGENT); __syncthreads(); idx = (int)qw[0]; __syncthreads(); } while (0)
          int idx;
          for (;;) { QNEXT(CW_Q + 8 * layer); if (idx >= NATT) break;
              const int qb = (NBLK - 1) - idx / (NB * ATT_H), bh = idx % (NB * ATT_H);
              attn_body::attn_unit<8>(bh / ATT_H, bh % ATT_H, qb, (const attn_body::bf16*)(PROJ + FQ), (const attn_body::bf16*)(PROJ + FK), (const attn_body::bf16*)(PROJ + FV), (attn_body::bf16*)MIXB, KM, (char*)lds_); }
#if !defined(ONLY_ATT)
          for (;;) { QNEXT(CW_Q + 8 * layer + 1); if (idx >= NSSDB) break;
              ssdB_unit(idx >> 5, (idx >> 1) & 15, idx & 1, PROJ, conv_w + (size_t)layer * 4 * SSD_CW, conv_b + layer * SSD_CW, dt_bias + layer * SSD_H, a_log + layer * SSD_H, d_skip + layer * SSD_H,
                        ssd_norm_g + layer * SSD_W, ST, CD, MIXB, lds, tid, wave, lane); }
          for (;;) { QNEXT(CW_Q + 8 * layer + 2); if (idx >= NGMU) break;
              gm_unit(idx / (SEQ / GM_CHUNK), idx % (SEQ / GM_CHUNK), PROJ, WSB + (size_t)layer * GM_G * GM_CHUNK * GM_CHUNK, gm_ln_g + layer * GM_W, gm_ln_b + layer * GM_W,
                      gm_b_s + layer * GM_G * GM_CHUNK, gm_norm_g + layer * GM_W, MIXB, lds, wave, lane); }
#endif
#undef QNEXT
        }
        PH_END(PB + 2)
        PH_BEGIN(PB + 3)
        { att_norm_phase(MIXB, att_norm_g + layer * ATT_W, M_, gw, ngw, lane); }
        PH_END(PB + 3)
        PH_BEGIN(PB + 4)
        { pg8::Gemm g{MIXB, WOUT + (size_t)layer * DM * DM, M_, DM, DM}; pg8::StaticOrder S; S.init(M_, DM, G, bx);
          fp::EpiF32 E{Y, DM}; pg8::gemm_phase<fp::EpiF32, pg8::StaticOrder, false, true>(lds, g, S, E); }
        PH_END(PB + 4)
        PH_BEGIN(PB + 5)
        { for (long r = gw; r < M_; r += ngw) ln_row<float>(H + r * DM, ALPHA, Y + r * DM, nullptr, ln1_g + layer * DM, ln1_b + layer * DM, H + r * DM, HB + r * DM, lane);
          if (layer == 1) { asm volatile("s_waitcnt vmcnt(0)" ::: "memory"); moe_route_phase(H, router_w, CNT, TE, TP, TS, M_, gw, ngw, lane); } }
        PH_END(PB + 5)
        if constexpr (layer == 0) {
            PH_BEGIN(PB + 6)
            { pg8::Gemm g{HB, WGU, M_, NGU, DM}; pg8::StaticOrder S; S.init(M_, NGU, G, bx);
              fp::EpiAct E{ACT, D_FF, NGU / 256}; pg8::gemm_phase<fp::EpiAct, pg8::StaticOrder, true, true>(lds, g, S, E); }
            PH_END(PB + 6)
            PH_BEGIN(PB + 7)
            { pg8::Gemm g{ACT, WD, M_, DM, D_FF}; pg8::StaticOrder S; S.init(M_, DM, G, bx);
              fp::EpiF32 E{Y, DM}; pg8::gemm_phase<fp::EpiF32, pg8::StaticOrder, false, true>(lds, g, S, E); }
            PH_END(PB + 7)
            PH_BEGIN(PB + 8)
            { for (long r = gw; r < M_; r += ngw) ln_row<float>(H + r * DM, ALPHA, Y + r * DM, nullptr, ln2_g + layer * DM, ln2_b + layer * DM, H + r * DM, HB + r * DM, lane); }
            PH_END(PB + 8)
        } else {
            PH_BEGIN(PB + 6)
            { for (long it = gw; it < (long)M_ * 2; it += ngw) { const int e = TE[it]; const int gs = moe_base(CNT, e) + TS[it];
                  if (lane == 0) { SP[gs] = TP[it]; GS[it] = gs; }
                  const uint4* src = (const uint4*)(HB + (it >> 1) * DM); uint4* dst = (uint4*)(XG + (size_t)gs * DM); dst[lane] = src[lane]; dst[lane + 64] = src[lane + 64]; }
              for (int it = gw; it < N_EXP * 256; it += ngw) { const int e = it >> 8, r = it & 255; const int c = CNT[e]; const int slot = moe_base(CNT, e) + c + r;
                  if (c + r < ((c + 255) & ~255)) { uint4* dst = (uint4*)(XG + (size_t)slot * DM); const uint4 z = make_uint4(0u, 0u, 0u, 0u); dst[lane] = z; dst[lane + 64] = z; if (lane == 0) SP[slot] = 0.f; } } }
            PH_END(PB + 6)
            PH_BEGIN(PB + 7)
            { pg8::Gemm g{XG, MWGU, NSLOT, N_EXP * NGUE, DM}; fp::MoeOrder S; S.init(CNT, NGUE / 256, G, bx);
              fp::EpiAct E{ACTM, D_FFE, NGUE / 256}; pg8::gemm_phase<fp::EpiAct, fp::MoeOrder, true, true>(lds, g, S, E); }
            PH_END(PB + 7)
            PH_BEGIN(PB + 8)
            { constexpr int I_MWD = (D_FFE / 64) * (N_EXP * DM / 32);
              for (int it = gw; it < I_MWD; it += ngw) { const int kb = it / (N_EXP * DM / 32), db = it % (N_EXP * DM / 32); const int d = db * 32 + (lane & 31), e = d / DM;
                  fp::SrcCol s; s.p = moe_w_down + (size_t)e * D_FFE * DM + (d - e * DM); s.ld = DM; fp::conv_item(s, D_FFE, MWD, (long)db * 32, kb * 64, scr, lane); } }
            PH_END(PB + 8)
            PH_BEGIN(PB + 9)
            { pg8::Gemm g{ACTM, MWD, NSLOT, N_EXP * DM, D_FFE}; fp::MoeOrder S; S.init(CNT, DM / 256, G, bx);
              fp::EpiF2 E{F2, SP}; pg8::gemm_phase<fp::EpiF2, fp::MoeOrder, true, true>(lds, g, S, E); }
            PH_END(PB + 9)
            PH_BEGIN(PB + 10)
            { for (long r = gw; r < M_; r += ngw) ln_row<bf16>(H + r * DM, ALPHA, F2 + (size_t)GS[r * 2] * DM, F2 + (size_t)GS[r * 2 + 1] * DM, ln2_g + layer * DM, ln2_b + layer * DM, H + r * DM, nullptr, lane); }
            PH_END(PB + 10)
        }
    }

    { constexpr int layer = 1; constexpr int PB = 10;
        PH_BEGIN(PB + 0)
        { pg8::Gemm g{HB, WIN + (size_t)layer * PLD * DM, M_, PLD, DM}; pg8::StaticOrder S; S.init(M_, PLD, G, bx);
          fp::EpiProj E{PROJ, RT}; pg8::gemm_phase<fp::EpiProj, pg8::StaticOrder, true, true>(lds, g, S, E); }
        PH_END(PB + 0)
        PH_BEGIN(PB + 1)
        { kmean_phase<bf16>(PROJ, FL, KM, NB, gt, ngt);
          for (int u = vcu; u < NB * 32; u += G) ssdA_unit(u >> 5, (u >> 1) & 15, u & 1, PROJ, conv_w + (size_t)layer * 4 * SSD_CW, conv_b + layer * SSD_CW, dt_bias + layer * SSD_H, a_log + layer * SSD_H, ST, CD, lds, tid, wave, lane);
        }
        PH_END(PB + 1)
        PH_BEGIN(PB + 2)
        { constexpr int NATT = NB * ATT_H * NBLK, NSSDB = NB * 32, NGMU = NB * (SEQ / GM_CHUNK);
          volatile LAS unsigned* qw = (volatile LAS unsigned*)(lds + MISC_OFF) + 16;
#define QNEXT(word) do { if (tid == 0) qw[0] = __hip_atomic_fetch_add(ctl + (word), 1u, __ATOMIC_RELAXED, __HIP_MEMORY_SCOPE_AGENT); __syncthreads(); idx = (int)qw[0]; __syncthreads(); } while (0)
          int idx;
          for (;;) { QNEXT(CW_Q + 8 * layer); if (idx >= NATT) break;
              const int qb = (NBLK - 1) - idx / (NB * ATT_H), bh = idx % (NB * ATT_H);
              attn_body::attn_unit<8>(bh / ATT_H, bh % ATT_H, qb, (const attn_body::bf16*)(PROJ + FQ), (const attn_body::bf16*)(PROJ + FK), (const attn_body::bf16*)(PROJ + FV), (attn_body::bf16*)MIXB, KM, (char*)lds_); }
#if !defined(ONLY_ATT)
          for (;;) { QNEXT(CW_Q + 8 * layer + 1); if (idx >= NSSDB) break;
              ssdB_unit(idx >> 5, (idx >> 1) & 15, idx & 1, PROJ, conv_w + (size_t)layer * 4 * SSD_CW, conv_b + layer * SSD_CW, dt_bias + layer * SSD_H, a_log + layer * SSD_H, d_skip + layer * SSD_H,
                        ssd_norm_g + layer * SSD_W, ST, CD, MIXB, lds, tid, wave, lane); }
          for (;;) { QNEXT(CW_Q + 8 * layer + 2); if (idx >= NGMU) break;
              gm_unit(idx / (SEQ / GM_CHUNK), idx % (SEQ / GM_CHUNK), PROJ, WSB + (size_t)layer * GM_G * GM_CHUNK * GM_CHUNK, gm_ln_g + layer * GM_W, gm_ln_b + layer * GM_W,
                      gm_b_s + layer * GM_G * GM_CHUNK, gm_norm_g + layer * GM_W, MIXB, lds, wave, lane); }
#endif
#undef QNEXT
        }
        PH_END(PB + 2)
        PH_BEGIN(PB + 3)
        { att_norm_phase(MIXB, att_norm_g + layer * ATT_W, M_, gw, ngw, lane); }
        PH_END(PB + 3)
        PH_BEGIN(PB + 4)
        { pg8::Gemm g{MIXB, WOUT + (size_t)layer * DM * DM, M_, DM, DM}; pg8::StaticOrder S; S.init(M_, DM, G, bx);
          fp::EpiF32 E{Y, DM}; pg8::gemm_phase<fp::EpiF32, pg8::StaticOrder, false, true>(lds, g, S, E); }
        PH_END(PB + 4)
        PH_BEGIN(PB + 5)
        { for (long r = gw; r < M_; r += ngw) ln_row<float>(H + r * DM, ALPHA, Y + r * DM, nullptr, ln1_g + layer * DM, ln1_b + layer * DM, H + r * DM, HB + r * DM, lane);
          if (layer == 1) { asm volatile("s_waitcnt vmcnt(0)" ::: "memory"); moe_route_phase(H, router_w, CNT, TE, TP, TS, M_, gw, ngw, lane); } }
        PH_END(PB + 5)
        if constexpr (layer == 0) {
            PH_BEGIN(PB + 6)
            { pg8::Gemm g{HB, WGU, M_, NGU, DM}; pg8::StaticOrder S; S.init(M_, NGU, G, bx);
              fp::EpiAct E{ACT, D_FF, NGU / 256}; pg8::gemm_phase<fp::EpiAct, pg8::StaticOrder, true, true>(lds, g, S, E); }
            PH_END(PB + 6)
            PH_BEGIN(PB + 7)
            { pg8::Gemm g{ACT, WD, M_, DM, D_FF}; pg8::StaticOrder S; S.init(M_, DM, G, bx);
              fp::EpiF32 E{Y, DM}; pg8::gemm_phase<fp::EpiF32, pg8::StaticOrder, false, true>(lds, g, S, E); }
            PH_END(PB + 7)
            PH_BEGIN(PB + 8)
            { for (long r = gw; r < M_; r += ngw) ln_row<float>(H + r * DM, ALPHA, Y + r * DM, nullptr, ln2_g + layer * DM, ln2_b + layer * DM, H + r * DM, HB + r * DM, lane); }
            PH_END(PB + 8)
        } else {
            PH_BEGIN(PB + 6)
            { for (long it = gw; it < (long)M_ * 2; it += ngw) { const int e = TE[it]; const int gs = moe_base(CNT, e) + TS[it];
                  if (lane == 0) { SP[gs] = TP[it]; GS[it] = gs; }
                  const uint4* src = (const uint4*)(HB + (it >> 1) * DM); uint4* dst = (uint4*)(XG + (size_t)gs * DM); dst[lane] = src[lane]; dst[lane + 64] = src[lane + 64]; }
              for (int it = gw; it < N_EXP * 256; it += ngw) { const int e = it >> 8, r = it & 255; const int c = CNT[e]; const int slot = moe_base(CNT, e) + c + r;
                  if (c + r < ((c + 255) & ~255)) { uint4* dst = (uint4*)(XG + (size_t)slot * DM); const uint4 z = make_uint4(0u, 0u, 0u, 0u); dst[lane] = z; dst[lane + 64] = z; if (lane == 0) SP[slot] = 0.f; } } }
            PH_END(PB + 6)
            PH_BEGIN(PB + 7)
            { pg8::Gemm g{XG, MWGU, NSLOT, N_EXP * NGUE, DM}; fp::MoeOrder S; S.init(CNT, NGUE / 256, G, bx);
              fp::EpiAct E{ACTM, D_FFE, NGUE / 256}; pg8::gemm_phase<fp::EpiAct, fp::MoeOrder, true, true>(lds, g, S, E); }
            PH_END(PB + 7)
            PH_BEGIN(PB + 8)
            { constexpr int I_MWD = (D_FFE / 64) * (N_EXP * DM / 32);
              for (int it = gw; it < I_MWD; it += ngw) { const int kb = it / (N_EXP * DM / 32), db = it % (N_EXP * DM / 32); const int d = db * 32 + (lane & 31), e = d / DM;
                  fp::SrcCol s; s.p = moe_w_down + (size_t)e * D_FFE * DM + (d - e * DM); s.ld = DM; fp::conv_item(s, D_FFE, MWD, (long)db * 32, kb * 64, scr, lane); } }
            PH_END(PB + 8)
            PH_BEGIN(PB + 9)
            { pg8::Gemm g{ACTM, MWD, NSLOT, N_EXP * DM, D_FFE}; fp::MoeOrder S; S.init(CNT, DM / 256, G, bx);
              fp::EpiF2 E{F2, SP}; pg8::gemm_phase<fp::EpiF2, fp::MoeOrder, true, true>(lds, g, S, E); }
            PH_END(PB + 9)
            PH_BEGIN(PB + 10)
            { for (long r = gw; r < M_; r += ngw) ln_row<bf16>(H + r * DM, ALPHA, F2 + (size_t)GS[r * 2] * DM, F2 + (size_t)GS[r * 2 + 1] * DM, ln2_g + layer * DM, ln2_b + layer * DM, H + r * DM, nullptr, lane); }
            PH_END(PB + 10)
        }
    }

#undef PH_BEGIN
#undef PH_END
}

__device__ __forceinline__ void blk_acc(float d2, float s2, float* err) {
    d2 = wave_sum(d2); s2 = wave_sum(s2); if ((threadIdx.x & 63) == 0) { atomicAdd(err, d2); atomicAdd(err + 1, s2); }
}
__global__ void k_cmp_proj(const bf16* F, const float* S, long rows, float* err) {
    float d2 = 0.f, s2 = 0.f;
    for (long it = blockIdx.x * (long)blockDim.x + threadIdx.x; it < rows * 2950; it += gridDim.x * (long)blockDim.x) {
        const long row = it / 2950; const int d = (int)(it % 2950); const int sc = fp::win_src_col(d);
        float s = S[row * D_IN + sc]; if (d >= FGU && d < FXBC) s = gelu_tanh_f(s);
        const float f = ldf(F + row * PLD + d); d2 += (f - s) * (f - s); s2 += s * s; }
    blk_acc(d2, s2, err);
}
template <class TF> __global__ void k_cmp(const TF* F, int ldf_, const float* S, int lds_, long rows, int cols, float* err) {
    float d2 = 0.f, s2 = 0.f;
    for (long it = blockIdx.x * (long)blockDim.x + threadIdx.x; it < rows * cols; it += gridDim.x * (long)blockDim.x) {
        const long row = it / cols; const int c = (int)(it % cols); const float f = ldf(F + row * ldf_ + c), s = S[row * lds_ + c]; d2 += (f - s) * (f - s); s2 += s * s; }
    blk_acc(d2, s2, err);
}
__global__ void k_encode(const float* err, int nck, const float* Sout, float* out, long rows_s, long rows_all, float thr) {
    int k = 0; for (int i = 0; i < nck; ++i) { const float r = err[2 * i] / fmaxf(err[2 * i + 1], 1e-30f); if (!(r <= thr)) { k = i + 1; break; } }
    for (long it = blockIdx.x * (long)blockDim.x + threadIdx.x; it < rows_all * DM; it += gridDim.x * (long)blockDim.x)
        out[it] = (it < rows_s * DM) ? Sout[it] * (1.f + (float)k) : 0.f;
}
#if DEBUG_BUILD
constexpr size_t S_BASE = (WS_END + 2 * MiB - 1) / MiB * MiB;
#endif
extern "C" void kernel_launch(void* const* d_in, const int* in_sizes, int n_in, void* d_out, int out_size, void* d_ws, size_t ws_size, hipStream_t stream) {
    (void)in_sizes; (void)n_in; (void)out_size;
    static int grid = 0;
    if (grid == 0) {
        int dev = 0, cus = 0, per_cu = 0;
        if (hipGetDevice(&dev) != hipSuccess || hipDeviceGetAttribute(&cus, hipDeviceAttributeMultiprocessorCount, dev) != hipSuccess) { grid = -1; return; }
        if (hipFuncSetAttribute((const void*)mega, hipFuncAttributeMaxDynamicSharedMemorySize, LDS_BYTES) != hipSuccess) { fprintf(stderr, "kernel_launch: hipFuncSetAttribute failed\n"); grid = -1; return; }
        if (hipOccupancyMaxActiveBlocksPerMultiprocessor(&per_cu, (const void*)mega, 512, LDS_BYTES) != hipSuccess || per_cu < 1) fprintf(stderr, "kernel_launch: occupancy query reports %d\n", per_cu);
        (void)hipGetLastError();
        grid = cus;
        if (ws_size < WS_END) { fprintf(stderr, "kernel_launch: workspace too small: %zu < %zu\n", ws_size, (size_t)WS_END); grid = -1; }
    }
    if (grid < 0) return;
    unsigned char* ws = (unsigned char*)d_ws;
    if (hipMemsetAsync(ws + O_CTL, 0, CTL_BYTES, stream) != hipSuccess) return;
    FArgs a{};
    for (int i = 0; i < 29; ++i) a.in[i] = d_in[i];
    a.out = (float*)d_out; a.ws = ws;
#if !DEBUG_BUILD
    a.ph_lo = 0; a.ph_hi = N_PHASES;
    hipLaunchKernelGGL(mega, dim3(grid), dim3(512), LDS_BYTES, stream, a);
#else
    Inputs I;
    I.x = (const float*)d_in[0]; I.pos = (const int*)d_in[1]; I.ln_in_g = (const float*)d_in[2]; I.ln_in_b = (const float*)d_in[3]; I.w_in = (const float*)d_in[4];
    I.conv_w = (const float*)d_in[5]; I.conv_b = (const float*)d_in[6]; I.dt_bias = (const float*)d_in[7]; I.a_log = (const float*)d_in[8]; I.d_skip = (const float*)d_in[9];
    I.ssd_norm_g = (const float*)d_in[10]; I.att_norm_g = (const float*)d_in[11]; I.gm_ln_g = (const float*)d_in[12]; I.gm_ln_b = (const float*)d_in[13]; I.gm_w_s = (const float*)d_in[14];
    I.gm_b_s = (const float*)d_in[15]; I.gm_norm_g = (const float*)d_in[16]; I.w_out = (const float*)d_in[17]; I.ln1_g = (const float*)d_in[18]; I.ln1_b = (const float*)d_in[19];
    I.ln2_g = (const float*)d_in[20]; I.ln2_b = (const float*)d_in[21]; I.ffn_w_gate = (const float*)d_in[22]; I.ffn_w_up = (const float*)d_in[23]; I.ffn_w_down = (const float*)d_in[24];
    I.router_w = (const float*)d_in[25]; I.moe_w_gate = (const float*)d_in[26]; I.moe_w_up = (const float*)d_in[27]; I.moe_w_down = (const float*)d_in[28];
    const long MS = SEQ;
    unsigned char* sws = ws + S_BASE;
    float* saux = (float*)(sws + 96 * MiB); float* sout = (float*)(sws + 100 * MiB); float* ckpt = (float*)(sws + 110 * MiB);
    const size_t ck_stride = (size_t)MS * (D_IN + 3 * DM);
    run_simple(I, 1, sws, saux, sout, stream, ckpt);
    float* err = (float*)(ws + O_CTL) + CW_ERR;
    const bf16* PROJ = (const bf16*)(ws + O_PROJ); const bf16* MIXB = (const bf16*)(ws + O_MIXB); const float* Hf = (const float*)d_out;
    for (int ph = 0; ph < N_PHASES; ++ph) {
        a.ph_lo = ph; a.ph_hi = ph + 1;
        hipLaunchKernelGGL(mega, dim3(grid), dim3(512), LDS_BYTES, stream, a);
        const int layer = ph >= 10 ? 1 : 0; const int rel = ph - (layer ? 9 : 0); const float* ck = ckpt + layer * ck_stride; float* e = err + layer * 12;
        if (rel == 1) k_cmp_proj<<<512, 256, 0, stream>>>(PROJ, ck, MS, e + 0);
        if (rel == 4) { k_cmp<bf16><<<512, 256, 0, stream>>>(MIXB, DM, ck + (size_t)MS * D_IN, DM, MS, 384, e + 2);
                        k_cmp<bf16><<<512, 256, 0, stream>>>(MIXB + 384, DM, ck + (size_t)MS * D_IN + 384, DM, MS, 384, e + 4);
                        k_cmp<bf16><<<512, 256, 0, stream>>>(MIXB + 768, DM, ck + (size_t)MS * D_IN + 768, DM, MS, 256, e + 6); }
        if (rel == 6) k_cmp<float><<<512, 256, 0, stream>>>(Hf, DM, ck + (size_t)MS * (D_IN + DM), DM, MS, DM, e + 8);
        if ((layer == 0 && rel == 9) || (layer == 1 && rel == 11)) k_cmp<float><<<512, 256, 0, stream>>>(Hf, DM, ck + (size_t)MS * (D_IN + 2 * DM), DM, MS, DM, e + 10);
    }
    k_encode<<<1024, 256, 0, stream>>>(err, 12, sout, (float*)d_out, MS, (long)NBATCH * SEQ, DBG_THR);
#endif
}
```

```cpp
#define DEBUG_BUILD 0
#define DBG_THR 0.02f
#define PROBE_MASK 0u
#define PROBE_AMP 0
#include <hip/hip_runtime.h>
#include <cstdio>
#include <cstdint>

constexpr int DM = 1024, SEQ = 2048, NBATCH = 8;
constexpr int ATT_H = 6, HD = 64, ATT_W = 384, ROPE_DIM = 16;
constexpr int MOBA_BLOCK = 256, NBLK = SEQ / MOBA_BLOCK;
constexpr int SSD_H = 6, SSD_W = 384, SSD_G = 2, SSD_N = 128, SSD_CW = 896;
constexpr int GM_G = 4, GM_W = 256, GM_CHUNK = 128;
constexpr int D_IN = 2950, D_FF = 2816, N_EXP = 8, D_FFE = 3584;
constexpr float ALPHA = 1.4142135623730951f;
constexpr float NEGF = -1e30f;
constexpr int MAXSLOT = 2 * NBATCH * SEQ + N_EXP * 256;

typedef unsigned short bf16;
__device__ __forceinline__ unsigned f2bf(float f) { unsigned u = __float_as_uint(f); return (u + 0x7fffu + ((u >> 16) & 1u)) >> 16; }
__device__ __forceinline__ float ldf(const float* p) { return *p; }
__device__ __forceinline__ float ldf(const bf16* p) { return __uint_as_float(((unsigned)*p) << 16); }
__device__ __forceinline__ void stf(float* p, float v) { *p = v; }
__device__ __forceinline__ void stf(bf16* p, float v) { *p = (bf16)f2bf(v); }

__device__ __forceinline__ float wave_sum(float v) {
#pragma unroll
    for (int o = 1; o < 64; o <<= 1) v += __shfl_xor(v, o);
    return v;
}
__device__ __forceinline__ float silu_f(float x) { return x / (1.f + __expf(-x)); }
__device__ __forceinline__ float gelu_tanh_f(float x) { const float u = 0.7978845608028654f * (x + 0.044715f * x * x * x); return 0.5f * x * (1.f + tanhf(u)); }
__device__ __forceinline__ float softplus_f(float x) { return fmaxf(x, 0.f) + log1pf(__expf(-fabsf(x))); }

struct ProjL { int ld, q, k, v, z, xbc, dt, gu, gv; };

__device__ __forceinline__ float4 ld4(const float* p) { return *(const float4*)p; }
__device__ __forceinline__ float4 ld4(const bf16* p) { const uint2 w = *(const uint2*)p; return make_float4(__uint_as_float(w.x << 16), __uint_as_float(w.x & 0xffff0000u), __uint_as_float(w.y << 16), __uint_as_float(w.y & 0xffff0000u)); }
template <class TY> __device__ __forceinline__ void ln_load(float (&v)[16], const float* xrow, float a, const TY* y1, const TY* y2, int lane) {
#pragma unroll
    for (int j = 0; j < 4; ++j) {
        const float4 x = *(const float4*)(xrow + j * 256 + lane * 4);
        float4 t = make_float4(a * x.x, a * x.y, a * x.z, a * x.w);
        if (y1) { const float4 y = ld4(y1 + j * 256 + lane * 4); t.x += y.x; t.y += y.y; t.z += y.z; t.w += y.w; }
        if (y2) { const float4 y = ld4(y2 + j * 256 + lane * 4); t.x += y.x; t.y += y.y; t.z += y.z; t.w += y.w; }
        v[4 * j] = t.x; v[4 * j + 1] = t.y; v[4 * j + 2] = t.z; v[4 * j + 3] = t.w;
    }
}
__device__ __forceinline__ void ln_finish(float (&v)[16], const float* g, const float* b, float* of, bf16* ob, int lane) {
    float s = 0.f;
#pragma unroll
    for (int i = 0; i < 16; ++i) s += v[i];
    const float mean = wave_sum(s) * (1.f / 1024.f); float s2 = 0.f;
#pragma unroll
    for (int i = 0; i < 16; ++i) { v[i] -= mean; s2 += v[i] * v[i]; }
    const float rstd = rsqrtf(wave_sum(s2) * (1.f / 1024.f) + 1e-5f);
#pragma unroll
    for (int j = 0; j < 4; ++j) {
        const float4 gg = *(const float4*)(g + j * 256 + lane * 4), bb = *(const float4*)(b + j * 256 + lane * 4);
        float4 o = make_float4(v[4 * j] * rstd * gg.x + bb.x, v[4 * j + 1] * rstd * gg.y + bb.y, v[4 * j + 2] * rstd * gg.z + bb.z, v[4 * j + 3] * rstd * gg.w + bb.w);
        *(float4*)(of + j * 256 + lane * 4) = o;
        if (ob) { uint2 w; w.x = f2bf(o.x) | (f2bf(o.y) << 16); w.y = f2bf(o.z) | (f2bf(o.w) << 16); *(uint2*)(ob + j * 256 + lane * 4) = w; }
    }
}
template <class TY> __device__ __forceinline__ void ln_row(const float* xrow, float a, const TY* y1, const TY* y2, const float* g, const float* b, float* of, bf16* ob, int lane) {
    float v[16]; ln_load<TY>(v, xrow, a, y1, y2, lane); ln_finish(v, g, b, of, ob, lane);
}

__device__ __forceinline__ void rope_inplace(float* P, ProjL L, const int* pos, long n_rows, long gt, long ngt) {
    for (long it = gt; it < n_rows * 96; it += ngt) {
        const int i = (int)(it & 7), hh = (int)((it >> 3) % 12); const long row = it / 96;
        const int off = (hh < 6 ? L.q : L.k) + (hh % 6) * 64;
        const float inv = powf(500000.0f, -(float)(2 * i) / 16.0f);
        const float ang = (float)pos[row] * inv;
        const float c = cosf(ang), s = sinf(ang);
        float* p = P + row * L.ld + off;
        const float x1 = p[i], x2 = p[i + 8];
        p[i] = x1 * c - x2 * s; p[i + 8] = x2 * c + x1 * s;
    }
}

template <class T> __device__ __forceinline__ void kmean_phase(const T* P, ProjL L, float* KM, int nb, long gt, long ngt) {
    for (long it = gt; it < (long)nb * ATT_H * NBLK * 64; it += ngt) {
        const int d = (int)(it & 63), n = (int)((it >> 6) % NBLK), h = (int)((it / (64 * NBLK)) % ATT_H), b = (int)(it / (64 * NBLK * ATT_H));
        const T* p = P + ((long)b * SEQ + n * MOBA_BLOCK) * L.ld + L.k + h * 64 + d; float s = 0.f;
        for (int r = 0; r < MOBA_BLOCK; ++r) s += ldf(p + (long)r * L.ld);
        KM[it] = s * (1.f / MOBA_BLOCK);
    }
}

template <class T> __device__ __forceinline__ void attn_naive_phase(const T* P, ProjL L, const float* KM, float* O, int ldo, int nb, int gw, int ngw, int lane) {
    for (long it = gw; it < (long)nb * ATT_H * SEQ; it += ngw) {
        const int q = (int)(it % SEQ), h = (int)((it / SEQ) % ATT_H), b = (int)(it / ((long)SEQ * ATT_H));
        const long row = (long)b * SEQ + q; const int qblk = q / MOBA_BLOCK;
        const float qv = ldf(P + row * L.ld + L.q + h * 64 + lane);
        float g[NBLK];
#pragma unroll
        for (int n = 0; n < NBLK; ++n) { const float t = wave_sum(qv * KM[(((long)b * ATT_H + h) * NBLK + n) * 64 + lane]); g[n] = (n < qblk) ? t : NEGF; }
        unsigned sel = 0u;
#pragma unroll
        for (int r = 0; r < 3; ++r) { float bv = -3.0e38f; int best = -1;
#pragma unroll
            for (int n = 0; n < NBLK; ++n) if (!((sel >> n) & 1u) && g[n] > bv) { bv = g[n]; best = n; }
            if (best >= 0 && bv > NEGF * 0.5f) sel |= 1u << best; }
        sel |= 1u << qblk;
        float m = -3.0e38f, l = 0.f, o = 0.f;
        for (int n = 0; n <= qblk; ++n) {
            if (!((sel >> n) & 1u)) continue;
            const int j0 = n * MOBA_BLOCK, j1 = (n == qblk) ? q + 1 : j0 + MOBA_BLOCK;
            const T* kp = P + ((long)b * SEQ + j0) * L.ld + L.k + h * 64 + lane;
            const T* vp = P + ((long)b * SEQ + j0) * L.ld + L.v + h * 64 + lane;
            for (int j = j0; j < j1; ++j, kp += L.ld, vp += L.ld) {
                const float s = wave_sum(qv * ldf(kp)) * 0.125f;
                const float mn = fmaxf(m, s), corr = __expf(m - mn), p = __expf(s - mn);
                l = l * corr + p; o = o * corr + p * ldf(vp); m = mn;
            }
        }
        O[row * ldo + h * 64 + lane] = o / l;
    }
}

template <int W, class TO> __device__ __forceinline__ void rms_rows_phase(const float* in, int ldi, const float* g, TO* out, int ldo, long n_rows, int gw, int ngw, int lane) {
    constexpr int PER = W / 64;
    for (long row = gw; row < n_rows; row += ngw) {
        float v[PER]; float s = 0.f;
#pragma unroll
        for (int j = 0; j < PER; ++j) { v[j] = in[row * ldi + j * 64 + lane]; s += v[j] * v[j]; }
        const float r = rsqrtf(wave_sum(s) * (1.f / W) + 1e-5f);
#pragma unroll
        for (int j = 0; j < PER; ++j) stf(out + row * ldo + j * 64 + lane, v[j] * r * g[j * 64 + lane]);
    }
}

template <class T, class TO> __device__ __forceinline__ void ssd_conv_phase(const T* P, ProjL L, const float* cw, const float* cb, const float* dtb, TO* XC, float* DT, long n_rows, long gt, long ngt) {
    for (long it = gt; it < n_rows * 902; it += ngt) {
        const int c = (int)(it % 902); const long row = it / 902; const int t = (int)(row % SEQ);
        if (c < SSD_CW) {
            float acc = cb[c];
#pragma unroll
            for (int i = 0; i < 4; ++i) { const int tt = t - 3 + i; if (tt >= 0) acc += cw[i * SSD_CW + c] * ldf(P + (row - 3 + i) * L.ld + L.xbc + c); }
            stf(XC + row * SSD_CW + c, silu_f(acc));
        } else {
            const int h = c - SSD_CW;
            DT[row * SSD_H + h] = softplus_f(ldf(P + row * L.ld + L.dt + h) + dtb[h]);
        }
    }
}

template <class T> __device__ __forceinline__ void ssd_scan_naive_phase(const T* XC, const float* DT, const float* a_log, const float* dsk, float* Y, int ldo, int nb, int gw, int ngw, int lane) {
    for (int it = gw; it < nb * SSD_H * 64; it += ngw) {
        const int p = it & 63, h = (it >> 6) % SSD_H, b = it / (64 * SSD_H), grp = h / (SSD_H / SSD_G);
        const float A = -__expf(a_log[h]), Dk = dsk[h];
        float s0 = 0.f, s1 = 0.f;
#pragma unroll 4
        for (int t = 0; t < SEQ; ++t) {
            const long row = (long)b * SEQ + t;
            const T* xr = XC + row * SSD_CW;
            const float dt = DT[row * SSD_H + h], x = ldf(xr + h * 64 + p);
            const float B0 = ldf(xr + SSD_W + grp * SSD_N + lane), B1 = ldf(xr + SSD_W + grp * SSD_N + 64 + lane);
            const float C0 = ldf(xr + SSD_W + SSD_G * SSD_N + grp * SSD_N + lane), C1 = ldf(xr + SSD_W + SSD_G * SSD_N + grp * SSD_N + 64 + lane);
            const float dec = __expf(dt * A), xd = x * dt;
            s0 = s0 * dec + xd * B0; s1 = s1 * dec + xd * B1;
            const float y = wave_sum(C0 * s0 + C1 * s1);
            if (lane == 0) Y[row * ldo + h * 64 + p] = y + Dk * x;
        }
    }
}

template <class T, class TO> __device__ __forceinline__ void ssd_gate_phase(const float* Y, int ldi, const T* P, ProjL L, const float* ng, TO* out, int ldo, long n_rows, int gw, int ngw, int lane) {
    for (long row = gw; row < n_rows; row += ngw) {
        float v[6];
#pragma unroll
        for (int j = 0; j < 6; ++j) { const int c = j * 64 + lane; v[j] = Y[row * ldi + c] * silu_f(ldf(P + row * L.ld + L.z + c)); }
        const float r0 = rsqrtf(wave_sum(v[0] * v[0] + v[1] * v[1] + v[2] * v[2]) * (1.f / 192.f) + 1e-5f);
        const float r1 = rsqrtf(wave_sum(v[3] * v[3] + v[4] * v[4] + v[5] * v[5]) * (1.f / 192.f) + 1e-5f);
#pragma unroll
        for (int j = 0; j < 6; ++j) { const int c = j * 64 + lane; stf(out + row * ldo + c, v[j] * (j < 3 ? r0 : r1) * ng[c]); }
    }
}

template <class T, bool PRE> __device__ __forceinline__ void gm_ln_phase(const T* P, ProjL L, const float* g, const float* b, float* VN, long n_rows, int gw, int ngw, int lane) {
    for (long row = gw; row < n_rows; row += ngw) {
        float v[4]; float s = 0.f;
#pragma unroll
        for (int j = 0; j < 4; ++j) { const float x = ldf(P + row * L.ld + L.gv + j * 64 + lane); v[j] = PRE ? x : gelu_tanh_f(x); s += v[j]; }
        const float mean = wave_sum(s) * (1.f / 256.f); float s2 = 0.f;
#pragma unroll
        for (int j = 0; j < 4; ++j) { v[j] -= mean; s2 += v[j] * v[j]; }
        const float rstd = rsqrtf(wave_sum(s2) * (1.f / 256.f) + 1e-5f);
#pragma unroll
        for (int j = 0; j < 4; ++j) VN[row * GM_W + j * 64 + lane] = v[j] * rstd * g[j * 64 + lane] + b[j * 64 + lane];
    }
}
template <class T, bool PRE> __device__ __forceinline__ void gm_mix_phase(const T* P, ProjL L, const float* VN, const float* ws_, const float* bs, float* GO, int ldo, long n_rows, long gt, long ngt) {
    for (long it = gt; it < n_rows * GM_W; it += ngt) {
        const int c = (int)(it % GM_W); const long row = it / GM_W; const int t = (int)(row % GM_CHUNK), g = c / 64; const long base = row - t;
        const float* w = ws_ + ((long)g * GM_CHUNK + t) * GM_CHUNK; float acc = 0.f;
        for (int s = 0; s <= t; ++s) acc += w[s] * VN[(base + s) * GM_W + c];
        acc += bs[g * GM_CHUNK + t];
        const float x = ldf(P + row * L.ld + L.gu + c); const float u = PRE ? x : gelu_tanh_f(x);
        GO[row * ldo + c] = u * acc;
    }
}

__device__ __forceinline__ void moe_route_phase(const float* H, const float* Wr, int* CNT, int* TE, float* TP, int* TS, long n_rows, int gw, int ngw, int lane) {
    for (long row = gw; row < n_rows; row += ngw) {
        float acc[N_EXP];
#pragma unroll
        for (int e = 0; e < N_EXP; ++e) acc[e] = 0.f;
        for (int j = 0; j < 16; ++j) { const int d = j * 64 + lane; const float hv = H[row * DM + d];
            const float4 w0 = *(const float4*)(Wr + d * N_EXP), w1 = *(const float4*)(Wr + d * N_EXP + 4);
            acc[0] += hv * w0.x; acc[1] += hv * w0.y; acc[2] += hv * w0.z; acc[3] += hv * w0.w; acc[4] += hv * w1.x; acc[5] += hv * w1.y; acc[6] += hv * w1.z; acc[7] += hv * w1.w; }
#pragma unroll
        for (int e = 0; e < N_EXP; ++e) acc[e] = wave_sum(acc[e]);
        int e0 = 0; float v0 = acc[0];
#pragma unroll
        for (int e = 1; e < N_EXP; ++e) if (acc[e] > v0) { v0 = acc[e]; e0 = e; }
        int e1 = -1; float v1 = -3.0e38f;
#pragma unroll
        for (int e = 0; e < N_EXP; ++e) if (e != e0 && acc[e] > v1) { v1 = acc[e]; e1 = e; }
        const float p1 = __expf(v1 - v0), den = 1.f + p1;
        if (lane == 0) {
            const int s0 = atomicAdd(&CNT[e0], 1), s1 = atomicAdd(&CNT[e1], 1);
            TE[row * 2] = e0; TE[row * 2 + 1] = e1; TP[row * 2] = 1.f / den; TP[row * 2 + 1] = p1 / den; TS[row * 2] = s0; TS[row * 2 + 1] = s1;
        }
    }
}
__device__ __forceinline__ int moe_base(const int* CNT, int e) { int b = 0; for (int i = 0; i < e; ++i) b += (CNT[i] + 255) & ~255; return b; }
__device__ __forceinline__ void moe_scatter_phase(const int* CNT, const int* TE, const float* TP, const int* TS, int* LIST, float* SP, int* GS, long n_rows, long gt, long ngt) {
    for (long it = gt; it < n_rows * 2; it += ngt) {
        const int e = TE[it]; const int gs = moe_base(CNT, e) + TS[it];
        LIST[gs] = (int)(it >> 1); SP[gs] = TP[it]; GS[it] = gs;
    }
}

template <class TA, int EPI> __global__ void __launch_bounds__(256) sgemm_k(const TA* A, int lda, const int* rowlist, const float* B, const float* B2, int ldb, long bstride, void* Cv, int ldc, int M, int N, int K, const int* CNT, const float* scale) {
    __shared__ float As[16][68], Bs[16][68], Bs2[16][68];
    int row_base = 0, mrows = M;
    if (CNT) { const int e = blockIdx.z; row_base = moe_base(CNT, e); mrows = CNT[e]; B += (long)e * bstride; if (B2) B2 += (long)e * bstride; }
    const int m0 = blockIdx.y * 64; if (m0 >= mrows) return;
    const int n0 = blockIdx.x * 64, tid = threadIdx.x, tx = tid & 15, ty = tid >> 4;
    float acc[4][4], acc2[4][4];
#pragma unroll
    for (int i = 0; i < 4; ++i)
#pragma unroll
        for (int j = 0; j < 4; ++j) { acc[i][j] = 0.f; acc2[i][j] = 0.f; }
    const int ar = tid >> 2, ak = (tid & 3) * 4; long arow = -1;
    { const int lr = m0 + ar; if (lr < mrows) { arow = rowlist ? (long)rowlist[row_base + lr] : (long)(row_base + lr); } }
    const int bk = tid >> 4, bn = (tid & 15) * 4;
    for (int k0 = 0; k0 < K; k0 += 16) {
        float av[4] = {0.f, 0.f, 0.f, 0.f};
        if (arow >= 0) {
#pragma unroll
            for (int i = 0; i < 4; ++i) av[i] = ldf(A + arow * lda + k0 + ak + i);
        }
#pragma unroll
        for (int i = 0; i < 4; ++i) As[ak + i][ar] = av[i];
#pragma unroll
        for (int i = 0; i < 4; ++i) { const int n = n0 + bn + i; const bool ok = n < N;
            Bs[bk][bn + i] = ok ? B[(long)(k0 + bk) * ldb + n] : 0.f;
            if (EPI == 1 || EPI == 2) Bs2[bk][bn + i] = ok ? B2[(long)(k0 + bk) * ldb + n] : 0.f; }
        __syncthreads();
#pragma unroll
        for (int kk = 0; kk < 16; ++kk) {
            float a[4], b[4], b2[4];
#pragma unroll
            for (int i = 0; i < 4; ++i) { a[i] = As[kk][ty * 4 + i]; b[i] = Bs[kk][tx * 4 + i]; if (EPI == 1 || EPI == 2) b2[i] = Bs2[kk][tx * 4 + i]; }
#pragma unroll
            for (int i = 0; i < 4; ++i)
#pragma unroll
                for (int j = 0; j < 4; ++j) { acc[i][j] += a[i] * b[j]; if (EPI == 1 || EPI == 2) acc2[i][j] += a[i] * b2[j]; }
        }
        __syncthreads();
    }
#pragma unroll
    for (int i = 0; i < 4; ++i) { const int lr = m0 + ty * 4 + i; if (lr >= mrows) continue; const long crow = row_base + lr;
#pragma unroll
        for (int j = 0; j < 4; ++j) { const int n = n0 + tx * 4 + j; if (n >= N) continue;
            float v = acc[i][j];
            if (EPI == 1 || EPI == 2) v = silu_f(v) * acc2[i][j];
            if (EPI == 3) v *= scale[crow];
            if (EPI == 2) ((bf16*)Cv)[crow * ldc + n] = (bf16)f2bf(v); else ((float*)Cv)[crow * ldc + n] = v; } }
}

#define GW_DECL const int lane = threadIdx.x & 63; const int gw = (int)((blockIdx.x * (long)blockDim.x + threadIdx.x) >> 6); const int ngw = (int)((gridDim.x * (long)blockDim.x) >> 6); (void)lane; (void)gw; (void)ngw;
#define GT_DECL const long gt = blockIdx.x * (long)blockDim.x + threadIdx.x; const long ngt = gridDim.x * (long)blockDim.x;

__global__ void k_ln_in(const float* x, const float* g, const float* b, float* H, long n_rows) { GW_DECL for (long r = gw; r < n_rows; r += ngw) ln_row<float>(x + r * DM, 1.f, nullptr, nullptr, g, b, H + r * DM, nullptr, lane); }
__global__ void k_ln_res(float* H, const float* Y, const float* g, const float* b, float* OUT, long n_rows) { GW_DECL for (long r = gw; r < n_rows; r += ngw) ln_row<float>(H + r * DM, ALPHA, Y + r * DM, nullptr, g, b, OUT + r * DM, nullptr, lane); }
__global__ void k_ln_moe(float* H, const float* F2, const int* GS, const float* g, const float* b, float* OUT, long n_rows) { GW_DECL for (long r = gw; r < n_rows; r += ngw) ln_row<float>(H + r * DM, ALPHA, F2 + (long)GS[r * 2] * DM, F2 + (long)GS[r * 2 + 1] * DM, g, b, OUT + r * DM, nullptr, lane); }
__global__ void k_rope(float* P, ProjL L, const int* pos, long n_rows) { GT_DECL rope_inplace(P, L, pos, n_rows, gt, ngt); }
__global__ void k_kmean(const float* P, ProjL L, float* KM, int nb) { GT_DECL kmean_phase<float>(P, L, KM, nb, gt, ngt); }
__global__ void k_attn(const float* P, ProjL L, const float* KM, float* O, int ldo, int nb) { GW_DECL attn_naive_phase<float>(P, L, KM, O, ldo, nb, gw, ngw, lane); }
__global__ void k_rms384(const float* in, int ldi, const float* g, float* out, int ldo, long n_rows) { GW_DECL rms_rows_phase<384, float>(in, ldi, g, out, ldo, n_rows, gw, ngw, lane); }
__global__ void k_rms256(const float* in, int ldi, const float* g, float* out, int ldo, long n_rows) { GW_DECL rms_rows_phase<256, float>(in, ldi, g, out, ldo, n_rows, gw, ngw, lane); }
__global__ void k_ssd_conv(const float* P, ProjL L, const float* cw, const float* cb, const float* dtb, float* XC, float* DT, long n_rows) { GT_DECL ssd_conv_phase<float, float>(P, L, cw, cb, dtb, XC, DT, n_rows, gt, ngt); }
__global__ void k_ssd_scan(const float* XC, const float* DT, const float* a_log, const float* dsk, float* Y, int ldo, int nb) { GW_DECL ssd_scan_naive_phase<float>(XC, DT, a_log, dsk, Y, ldo, nb, gw, ngw, lane); }
__global__ void k_ssd_gate(const float* Y, int ldi, const float* P, ProjL L, const float* ng, float* out, int ldo, long n_rows) { GW_DECL ssd_gate_phase<float, float>(Y, ldi, P, L, ng, out, ldo, n_rows, gw, ngw, lane); }
__global__ void k_gm_ln(const float* P, ProjL L, const float* g, const float* b, float* VN, long n_rows) { GW_DECL gm_ln_phase<float, false>(P, L, g, b, VN, n_rows, gw, ngw, lane); }
__global__ void k_gm_mix(const float* P, ProjL L, const float* VN, const float* ws_, const float* bs, float* GO, int ldo, long n_rows) { GT_DECL gm_mix_phase<float, false>(P, L, VN, ws_, bs, GO, ldo, n_rows, gt, ngt); }
__global__ void k_moe_init(int* CNT, int* LIST, int nslots) { GT_DECL if (gt < N_EXP) CNT[gt] = 0; for (long i = gt; i < nslots; i += ngt) LIST[i] = -1; }
__global__ void k_moe_route(const float* H, const float* Wr, int* CNT, int* TE, float* TP, int* TS, long n_rows) { GW_DECL moe_route_phase(H, Wr, CNT, TE, TP, TS, n_rows, gw, ngw, lane); }
__global__ void k_moe_scatter(const int* CNT, const int* TE, const float* TP, const int* TS, int* LIST, float* SP, int* GS, long n_rows) { GT_DECL moe_scatter_phase(CNT, TE, TP, TS, LIST, SP, GS, n_rows, gt, ngt); }

struct Inputs {
    const float *x; const int* pos; const float *ln_in_g, *ln_in_b, *w_in, *conv_w, *conv_b, *dt_bias, *a_log, *d_skip, *ssd_norm_g, *att_norm_g, *gm_ln_g, *gm_ln_b, *gm_w_s, *gm_b_s, *gm_norm_g, *w_out,
        *ln1_g, *ln1_b, *ln2_g, *ln2_b, *ffn_w_gate, *ffn_w_up, *ffn_w_down, *router_w, *moe_w_gate, *moe_w_up, *moe_w_down;
};

static void run_simple(const Inputs& I, int nb, unsigned char* ws, float* aux  , float* OUT, hipStream_t st, float* ckpt = nullptr) {
    const long M = (long)nb * SEQ; const size_t MB = 1u << 20;
    const size_t hsz = (size_t)M * DM * 4;
    float* H = (float*)ws; float* MIX = (float*)(ws + hsz); float* Y = (float*)(ws + 2 * hsz); unsigned char* BIG = ws + 3 * hsz + (size_t)N_EXP * 256 * DM * 4;
    float* XC = Y;
    float* VN = aux;
    float* PROJ = (float*)BIG;
    size_t big_bytes = (size_t)M * D_IN * 4; { size_t a = (size_t)M * D_FF * 4; if (a > big_bytes) big_bytes = a; size_t c = (size_t)(2 * M + N_EXP * 256) * D_FFE * 2; if (c > big_bytes) big_bytes = c; }
    big_bytes = (big_bytes + 255) & ~(size_t)255;
    unsigned char* SM = BIG + big_bytes;
    float* KM = (float*)SM; SM += (size_t)nb * ATT_H * NBLK * 64 * 4;
    float* DT = (float*)SM; SM += (size_t)M * SSD_H * 4;
    int* CNT = (int*)SM; SM += 256;
    int* TE = (int*)SM; SM += (size_t)M * 2 * 4; float* TP = (float*)SM; SM += (size_t)M * 2 * 4; int* TS = (int*)SM; SM += (size_t)M * 2 * 4; int* GS = (int*)SM; SM += (size_t)M * 2 * 4;
    const int nslots = (int)(2 * M + N_EXP * 256);
    int* LIST = (int*)SM; SM += (size_t)nslots * 4; float* SP = (float*)SM; SM += (size_t)nslots * 4;
    (void)MB;
    const ProjL L{D_IN, 0, 384, 768, 1152, 1536, 2432, 2438, 2694};
    const int TB = 256; const int GWB = 2048;
    k_ln_in<<<GWB, TB, 0, st>>>(I.x, I.ln_in_g, I.ln_in_b, H, M);
    for (int i = 0; i < 2; ++i) {
        sgemm_k<float, 0><<<dim3((D_IN + 63) / 64, (unsigned)(M / 64), 1), 256, 0, st>>>(H, DM, nullptr, I.w_in + (size_t)i * DM * D_IN, nullptr, D_IN, 0, PROJ, D_IN, (int)M, D_IN, DM, nullptr, nullptr);
        k_rope<<<GWB, TB, 0, st>>>(PROJ, L, I.pos, M);
        const size_t ck_stride = (size_t)M * (D_IN + 3 * DM); float* ck = ckpt ? ckpt + (size_t)i * ck_stride : nullptr;
        if (ck) hipMemcpyAsync(ck, PROJ, (size_t)M * D_IN * 4, hipMemcpyDeviceToDevice, st);
        k_kmean<<<96 * nb, TB, 0, st>>>(PROJ, L, KM, nb);
        k_attn<<<GWB * 2, TB, 0, st>>>(PROJ, L, KM, MIX, DM, nb);
        k_rms384<<<GWB, TB, 0, st>>>(MIX, DM, I.att_norm_g + i * ATT_W, MIX, DM, M);
        k_ssd_conv<<<GWB * 2, TB, 0, st>>>(PROJ, L, I.conv_w + (size_t)i * 4 * SSD_CW, I.conv_b + i * SSD_CW, I.dt_bias + i * SSD_H, XC, DT, M);
        k_ssd_scan<<<(nb * SSD_H * 64 * 64 + TB - 1) / TB, TB, 0, st>>>(XC, DT, I.a_log + i * SSD_H, I.d_skip + i * SSD_H, MIX + ATT_W, DM, nb);
        k_ssd_gate<<<GWB, TB, 0, st>>>(MIX + ATT_W, DM, PROJ, L, I.ssd_norm_g + i * SSD_W, MIX + ATT_W, DM, M);
        k_gm_ln<<<GWB, TB, 0, st>>>(PROJ, L, I.gm_ln_g + i * GM_W, I.gm_ln_b + i * GM_W, VN, M);
        k_gm_mix<<<GWB * 2, TB, 0, st>>>(PROJ, L, VN, I.gm_w_s + (size_t)i * GM_G * GM_CHUNK * GM_CHUNK, I.gm_b_s + i * GM_G * GM_CHUNK, MIX + ATT_W + SSD_W, DM, M);
        k_rms256<<<GWB, TB, 0, st>>>(MIX + ATT_W + SSD_W, DM, I.gm_norm_g + i * GM_W, MIX + ATT_W + SSD_W, DM, M);
        if (ck) hipMemcpyAsync(ck + (size_t)M * D_IN, MIX, hsz, hipMemcpyDeviceToDevice, st);
        sgemm_k<float, 0><<<dim3(DM / 64, (unsigned)(M / 64), 1), 256, 0, st>>>(MIX, DM, nullptr, I.w_out + (size_t)i * DM * DM, nullptr, DM, 0, Y, DM, (int)M, DM, DM, nullptr, nullptr);
        k_ln_res<<<GWB, TB, 0, st>>>(H, Y, I.ln1_g + i * DM, I.ln1_b + i * DM, H, M);
        if (ck) hipMemcpyAsync(ck + (size_t)M * (D_IN + DM), H, hsz, hipMemcpyDeviceToDevice, st);
        if (i == 0) {
            float* ACT = (float*)BIG;
            sgemm_k<float, 1><<<dim3(D_FF / 64, (unsigned)(M / 64), 1), 256, 0, st>>>(H, DM, nullptr, I.ffn_w_gate, I.ffn_w_up, D_FF, 0, ACT, D_FF, (int)M, D_FF, DM, nullptr, nullptr);
            sgemm_k<float, 0><<<dim3(DM / 64, (unsigned)(M / 64), 1), 256, 0, st>>>(ACT, D_FF, nullptr, I.ffn_w_down, nullptr, DM, 0, Y, DM, (int)M, DM, D_FF, nullptr, nullptr);
            k_ln_res<<<GWB, TB, 0, st>>>(H, Y, I.ln2_g + i * DM, I.ln2_b + i * DM, H, M);
            if (ck) hipMemcpyAsync(ck + (size_t)M * (D_IN + 2 * DM), H, hsz, hipMemcpyDeviceToDevice, st);
        } else {
            bf16* ACTM = (bf16*)BIG; float* F2 = MIX;
            k_moe_init<<<256, TB, 0, st>>>(CNT, LIST, nslots);
            k_moe_route<<<GWB, TB, 0, st>>>(H, I.router_w, CNT, TE, TP, TS, M);
            k_moe_scatter<<<256, TB, 0, st>>>(CNT, TE, TP, TS, LIST, SP, GS, M);
            sgemm_k<float, 2><<<dim3(D_FFE / 64, (unsigned)(M / 64), N_EXP), 256, 0, st>>>(H, DM, LIST, I.moe_w_gate, I.moe_w_up, D_FFE, (long)DM * D_FFE, ACTM, D_FFE, 0, D_FFE, DM, CNT, nullptr);
            sgemm_k<bf16, 3><<<dim3(DM / 64, (unsigned)(M / 64), N_EXP), 256, 0, st>>>(ACTM, D_FFE, nullptr, I.moe_w_down, nullptr, DM, (long)D_FFE * DM, F2, DM, 0, DM, D_FFE, CNT, SP);
            k_ln_moe<<<GWB, TB, 0, st>>>(H, F2, GS, I.ln2_g + i * DM, I.ln2_b + i * DM, OUT, M);
            if (ck) hipMemcpyAsync(ck + (size_t)M * (D_IN + 2 * DM), OUT, hsz, hipMemcpyDeviceToDevice, st);
        }
    }
}

#define LAS __attribute__((address_space(3)))
namespace pg8 {
#define PG8_LAS __attribute__((address_space(3)))
typedef unsigned short bf16_t;
typedef short bf16x8 __attribute__((ext_vector_type(8)));
typedef float f32x4 __attribute__((ext_vector_type(4)));
typedef unsigned u32x4 __attribute__((ext_vector_type(4)));
constexpr int BM = 256, BK = 64, HALF = 128, HTB = HALF * BK * 2  , STAGE_BYTES = 8 * HTB, NXCD = 8, WGM = 8;

__host__ __device__ __forceinline__ int lds_byte(int r, int c) { const int st = (r >> 4) * 2 + (c >> 5), rr = r & 15, cc = c & 31, ob = rr * 64 + cc * 2; return st * 1024 + (ob ^ (((ob >> 9) & 1) << 5)); }
__host__ __device__ __forceinline__ void stage_rc(int b, int& R, int& C) { const int st = b / 1024, sb = b % 1024, swz = sb ^ (((sb >> 9) & 1) << 5); R = (st >> 1) * 16 + swz / 64; C = (st & 1) * 32 + (swz % 64) / 2; }
__host__ __device__ __forceinline__ int perm32(int rho) { const int n = rho >> 4, i = rho & 15; return 8 * (i >> 2) + 4 * n + (i & 3); }

struct Unit { int pm, pn; };
struct Gemm { const bf16_t* A; const bf16_t* Bt; int M, N, K; };

struct StaticOrder {
    int nM, nN, nwg, G, c;
    __host__ __device__ void init(int M, int N, int G_, int c_) { nM = M / BM; nN = N / BM; nwg = nM * nN; G = G_; c = c_; }
    __host__ __device__ bool next(int i, Unit& u) const {
        const long L = (long)i * G + c; if (L >= nwg) return false;
        int wgid = (int)L; { const int q = nwg / NXCD, r = nwg % NXCD, xcd = wgid % NXCD, off = wgid / NXCD; wgid = (xcd < r ? xcd * (q + 1) : r * (q + 1) + (xcd - r) * q) + off; }
        const int nig = WGM * nN, gid = wgid / nig, fm = gid * WGM, gsz = (nM - fm) < WGM ? (nM - fm) : WGM;
        u.pm = fm + ((wgid % nig) % gsz); u.pn = (wgid % nig) / gsz; return true;
    }
    __device__ __forceinline__ void a_ready(const Unit&) const {}
    __device__ __forceinline__ void done(const Unit&) const {}
};
__device__ __forceinline__ unsigned cvt_pk_bf16(float lo, float hi) { unsigned r; asm volatile("v_cvt_pk_bf16_f32 %0, %1, %2" : "=v"(r) : "v"(lo), "v"(hi)); return r; }
typedef float f32x2 __attribute__((ext_vector_type(2)));
template <class Epi, class Sched, bool ALIGN_EPI = false, bool SP2 = false>
__device__ __forceinline__ void gemm_phase(PG8_LAS unsigned char* lds, const Gemm g, const Sched& S, const Epi& E) {
    const int tid = threadIdx.x, wid = __builtin_amdgcn_readfirstlane(tid >> 6), lane = tid & 63, wr = wid >> 2, wc = wid & 3, fr = lane & 15, fq = lane >> 4;
    const int K = g.K, nt = K / BK;
    unsigned voffA[2], voffB[2];
#pragma unroll
    for (int i = 0; i < 2; ++i) { int R, C; stage_rc(tid * 16 + i * 8192, R, C); const int Rb = Epi::PERM ? ((R & ~31) + perm32(R & 31)) : R;
        voffA[i] = (unsigned)(R * K + C) * 2u; voffB[i] = (unsigned)(Rb * K + C) * 2u; }
    const size_t kstep = (size_t)(BK * 2);
    const size_t hstep = (size_t)HALF * K * 2;
    const size_t tstep = 2 * hstep;
    const unsigned ldsw = (unsigned)wid * 1024u;
    const int aoff = lds_byte(wr * 64 + fr, fq * 8), boff = lds_byte(wc * 32 + fr, fq * 8);
#define PG8_SA(b, h) (((b) * 2 + (h)) * HTB)
#define PG8_SB(b, h) ((4 + (b) * 2 + (h)) * HTB)
#define PG8_STAGE(bufoff, gbase, voff) do { _Pragma("unroll") for (int _i = 0; _i < 2; ++_i) \
        __builtin_amdgcn_global_load_lds((const unsigned*)((const char*)(gbase) + (voff)[_i]), (PG8_LAS unsigned*)(lds + (bufoff) + ldsw + _i * 8192), 16, 0, 0); } while (0)
#define PG8_LDA(dst, b, h) do { _Pragma("unroll") for (int m = 0; m < 4; ++m) _Pragma("unroll") for (int k = 0; k < 2; ++k) dst[m][k] = *(const PG8_LAS bf16x8*)(lds + PG8_SA(b, h) + aoff + m * 2048 + k * 1024); } while (0)
#define PG8_LDB(dst, b, h) do { _Pragma("unroll") for (int n = 0; n < 2; ++n) _Pragma("unroll") for (int k = 0; k < 2; ++k) dst[n][k] = *(const PG8_LAS bf16x8*)(lds + PG8_SB(b, h) + boff + n * 2048 + k * 1024); } while (0)
#define PG8_MMA(ai, bj, At, Bt) do { __builtin_amdgcn_s_setprio(1); _Pragma("unroll") for (int m = 0; m < 4; ++m) _Pragma("unroll") for (int n = 0; n < 2; ++n) _Pragma("unroll") for (int k = 0; k < 2; ++k) \
        acc[ai][bj][m][n] = __builtin_amdgcn_mfma_f32_16x16x32_bf16(Bt[n][k], At[m][k], acc[ai][bj][m][n], 0, 0, 0); __builtin_amdgcn_s_setprio(0); } while (0)
#define PG8_WAIT_V(n) asm volatile("s_waitcnt vmcnt(" #n ")" ::: "memory")
#define PG8_WAIT_L(n) asm volatile("s_waitcnt lgkmcnt(" #n ")" ::: "memory")
#define PG8_BAR __builtin_amdgcn_s_barrier()
#define PG8_SCHED __builtin_amdgcn_sched_barrier(0)
    Unit cur, nxt; int ui = 0;
    if (!S.next(0, cur)) return;
    f32x4 acc[2][2][4][2];
#pragma unroll
    for (int a = 0; a < 2; ++a)
#pragma unroll
        for (int b = 0; b < 2; ++b)
#pragma unroll
            for (int m = 0; m < 4; ++m)
#pragma unroll
                for (int n = 0; n < 2; ++n) acc[a][b][m][n] = (f32x4){0.f, 0.f, 0.f, 0.f};
    bf16x8 At[4][2], B0[2][2], B1[2][2];
    const char* cA = (const char*)g.A + (size_t)cur.pm * tstep; const char* cB = (const char*)g.Bt + (size_t)cur.pn * tstep;
    S.a_ready(cur);
    if constexpr (SP2) {
        PG8_STAGE(PG8_SB(0, 0), cB, voffB); PG8_STAGE(PG8_SB(0, 1), cB + hstep, voffB); PG8_STAGE(PG8_SA(0, 0), cA, voffA); PG8_STAGE(PG8_SA(0, 1), cA + hstep, voffA);
        if (wr == 1) PG8_BAR;
        PG8_WAIT_V(2); PG8_BAR;
        PG8_STAGE(PG8_SB(1, 0), cB + kstep, voffB); PG8_STAGE(PG8_SA(1, 0), cA + kstep, voffA); PG8_STAGE(PG8_SB(1, 1), cB + hstep + kstep, voffB);
        PG8_WAIT_V(6); PG8_BAR;
    } else {
        PG8_STAGE(PG8_SB(0, 0), cB, voffB); PG8_STAGE(PG8_SA(0, 0), cA, voffA); PG8_STAGE(PG8_SB(0, 1), cB + hstep, voffB); PG8_STAGE(PG8_SA(0, 1), cA + hstep, voffA);
        if (wr == 1) PG8_BAR;
        PG8_WAIT_V(4); PG8_BAR;
        PG8_STAGE(PG8_SB(1, 0), cB + kstep, voffB); PG8_STAGE(PG8_SA(1, 0), cA + kstep, voffA); PG8_STAGE(PG8_SB(1, 1), cB + hstep + kstep, voffB);
        PG8_WAIT_V(6); PG8_BAR;
    }
    for (;;) {
        const bool has_next = S.next(ui + 1, nxt);
        const char* nA = has_next ? (const char*)g.A + (size_t)nxt.pm * tstep : cA; const char* nB = has_next ? (const char*)g.Bt + (size_t)nxt.pn * tstep : cB;
        for (int t = 0; t < nt; t += 2) {
            const bool last = (t == nt - 2);
            const char* a1 = cA + (size_t)(t + 1) * kstep;
            const char* a2 = last ? nA : cA + (size_t)(t + 2) * kstep; const char* b2 = last ? nB : cB + (size_t)(t + 2) * kstep;
            const char* a3 = a2 + kstep; const char* b3 = b2 + kstep;
            if (last && has_next) S.a_ready(nxt);
            if constexpr (SP2) {
            PG8_LDB(B0, 0, 0); PG8_LDB(B1, 0, 1); PG8_SCHED; PG8_LDA(At, 0, 0); PG8_STAGE(PG8_SA(1, 1), a1 + hstep, voffA);
            PG8_WAIT_V(8); PG8_WAIT_L(0); PG8_BAR; PG8_MMA(0, 0, At, B0); PG8_MMA(0, 1, At, B1); PG8_BAR; PG8_SCHED;
            PG8_LDA(At, 0, 1); PG8_STAGE(PG8_SB(0, 0), b2, voffB); PG8_STAGE(PG8_SB(0, 1), b2 + hstep, voffB); PG8_STAGE(PG8_SA(0, 0), a2, voffA);
            PG8_WAIT_V(8); PG8_WAIT_L(0); PG8_BAR; PG8_MMA(1, 0, At, B0); PG8_MMA(1, 1, At, B1); PG8_BAR; PG8_SCHED;
            PG8_LDB(B0, 1, 0); PG8_LDB(B1, 1, 1); PG8_SCHED; PG8_LDA(At, 1, 0); PG8_STAGE(PG8_SA(0, 1), a2 + hstep, voffA);
            PG8_WAIT_V(8); PG8_WAIT_L(0); PG8_BAR; PG8_MMA(0, 0, At, B0); PG8_MMA(0, 1, At, B1); PG8_BAR; PG8_SCHED;
            PG8_LDA(At, 1, 1); PG8_STAGE(PG8_SB(1, 0), b3, voffB); PG8_STAGE(PG8_SB(1, 1), b3 + hstep, voffB); PG8_STAGE(PG8_SA(1, 0), a3, voffA);
            PG8_WAIT_V(8); PG8_WAIT_L(0); PG8_BAR; PG8_MMA(1, 0, At, B0); PG8_MMA(1, 1, At, B1); PG8_BAR; PG8_SCHED;
            } else {
            PG8_LDB(B0, 0, 0); PG8_SCHED; PG8_LDA(At, 0, 0); PG8_STAGE(PG8_SA(1, 1), a1 + hstep, voffA);
            PG8_WAIT_L(8); PG8_BAR; PG8_WAIT_L(0); PG8_MMA(0, 0, At, B0); PG8_BAR; PG8_SCHED;
            PG8_LDB(B1, 0, 1); PG8_STAGE(PG8_SB(0, 0), b2, voffB);
            PG8_BAR; PG8_WAIT_L(0); PG8_MMA(0, 1, At, B1); PG8_BAR;
            PG8_LDA(At, 0, 1); PG8_STAGE(PG8_SA(0, 0), a2, voffA);
            PG8_BAR; PG8_WAIT_L(0); PG8_MMA(1, 0, At, B0); PG8_BAR; PG8_SCHED;
            PG8_STAGE(PG8_SB(0, 1), b2 + hstep, voffB);
            PG8_WAIT_V(6); PG8_BAR; PG8_MMA(1, 1, At, B1); PG8_BAR;
            PG8_LDB(B0, 1, 0); PG8_SCHED; PG8_LDA(At, 1, 0); PG8_STAGE(PG8_SA(0, 1), a2 + hstep, voffA);
            PG8_WAIT_L(8); PG8_BAR; PG8_WAIT_L(0); PG8_MMA(0, 0, At, B0); PG8_BAR; PG8_SCHED;
            PG8_LDB(B1, 1, 1); PG8_STAGE(PG8_SB(1, 0), b3, voffB);
            PG8_BAR; PG8_WAIT_L(0); PG8_MMA(0, 1, At, B1); PG8_BAR;
            PG8_LDA(At, 1, 1); PG8_STAGE(PG8_SA(1, 0), a3, voffA);
            PG8_BAR; PG8_WAIT_L(0); PG8_MMA(1, 0, At, B0); PG8_BAR; PG8_SCHED;
            PG8_STAGE(PG8_SB(1, 1), b3 + hstep, voffB);
            PG8_WAIT_V(6); PG8_BAR; PG8_MMA(1, 1, At, B1); PG8_BAR;
            }
        }
        if constexpr (ALIGN_EPI) { if (wr == 0) PG8_BAR; }
        if constexpr (!Epi::AFTER_DRAIN) { E(acc, cur, wr, wc, fr, fq); S.done(cur); }
        if (!has_next) break;
#pragma unroll
        for (int a = 0; a < 2; ++a)
#pragma unroll
            for (int b = 0; b < 2; ++b)
#pragma unroll
                for (int m = 0; m < 4; ++m)
#pragma unroll
                    for (int n = 0; n < 2; ++n) acc[a][b][m][n] = (f32x4){0.f, 0.f, 0.f, 0.f};
        cur = nxt; cA = nA; cB = nB; ++ui;
        if constexpr (ALIGN_EPI) { if (wr == 1) PG8_BAR; }
    }
    PG8_WAIT_V(0);
    if constexpr (!ALIGN_EPI) { if (wr == 0) PG8_BAR; }
    PG8_BAR;
    if constexpr (Epi::AFTER_DRAIN) { E.fused(acc, cur, wr, wc, fr, fq, lds, wid, lane); S.done(cur); }
#undef PG8_SA
#undef PG8_SB
#undef PG8_STAGE
#undef PG8_LDA
#undef PG8_LDB
#undef PG8_MMA
#undef PG8_WAIT_V
#undef PG8_WAIT_L
#undef PG8_BAR
#undef PG8_SCHED
}
}
#define XB_TMO      128
#define XB_XCNT(j)  (256  + 64 * (j))
#define XB_XSUB(j)  (1280 + 64 * (j))
#define XB_XGEN(j)  (2304 + 64 * (j))
#define XB_TOP      3328
#define XB_TOPGEN   3392
#define XCD_BAR_WORDS 3456
#define XB_SPIN_CAP (1u << 24)

__device__ __forceinline__ unsigned xb_ld(unsigned* p)              { return __hip_atomic_load(p, __ATOMIC_RELAXED, __HIP_MEMORY_SCOPE_AGENT); }
__device__ __forceinline__ unsigned xb_add(unsigned* p, unsigned v) { return __hip_atomic_fetch_add(p, v, __ATOMIC_RELAXED, __HIP_MEMORY_SCOPE_AGENT); }
__device__ __forceinline__ unsigned xb_xcc_id() { return (unsigned)__builtin_amdgcn_s_getreg((3 << 11) | 20) & 0xFu; }
#define XB_SPIN(cond, bar) do { unsigned _sp = 0; while (cond) { __builtin_amdgcn_s_sleep(1); \
    if ((++_sp & 255u) == 0u) { if (xb_ld(&(bar)[XB_TMO])) break; if (_sp > XB_SPIN_CAP) { atomicAdd(&(bar)[XB_TMO], 1u); break; } } } } while (0)

struct XcdBarrier {
    unsigned* bar; unsigned x;
    volatile LAS unsigned* st;
};

__device__ __forceinline__ XcdBarrier xcd_barrier_post(unsigned* bar, volatile LAS unsigned* st) {
    XcdBarrier b; b.bar = bar; b.x = xb_xcc_id(); b.st = st;
    if (threadIdx.x == 0) (void)xb_add(&bar[XB_XCNT(b.x)], 1u);
    return b;
}
__device__ __forceinline__ void xcd_barrier_complete(unsigned* bar, unsigned x, unsigned& nloc, unsigned& nx) {
    const unsigned G = gridDim.x * gridDim.y * gridDim.z;
    unsigned sum, cnt, mine, sp = 0u;
    for (;;) {
        sum = 0u; cnt = 0u; mine = 0u;
#pragma unroll
        for (unsigned j = 0; j < 16; ++j) { const unsigned c = xb_ld(&bar[XB_XCNT(j)]); sum += c; cnt += (c > 0u) ? 1u : 0u; mine = (j == x) ? c : mine; }
        if (sum == G) break;
        __builtin_amdgcn_s_sleep(1);
        if ((++sp & 255u) == 0u) { if (xb_ld(&bar[XB_TMO])) break; if (sp > XB_SPIN_CAP) { atomicAdd(&bar[XB_TMO], 1u); break; } }
    }
    nloc = mine > 0u ? mine : 1u; nx = cnt > 0u ? cnt : 1u;
}

__device__ __forceinline__ void xcd_barrier(const XcdBarrier& b) {
    asm volatile("s_waitcnt vmcnt(0)" ::: "memory");
    __syncthreads();
    if (threadIdx.x == 0) {
        unsigned* bar = b.bar;
        __builtin_amdgcn_s_waitcnt(0);
        unsigned nloc = b.st[0], nx = b.st[1];
        if (nloc == 0u) { xcd_barrier_complete(bar, b.x, nloc, nx); b.st[0] = nloc; b.st[1] = nx; }
        const unsigned old = xb_add(&bar[XB_XSUB(b.x)], 1u);
        const unsigned gen = old / nloc;
        if (old + 1u == (gen + 1u) * nloc) {
            __builtin_amdgcn_fence(__ATOMIC_RELEASE, "agent");
            asm volatile("s_waitcnt vmcnt(0)" ::: "memory");
            const unsigned og = xb_add(&bar[XB_TOP], 1u);
            const unsigned tg = og / nx;
            if (og + 1u == (tg + 1u) * nx) xb_add(&bar[XB_TOPGEN], 1u);
            else XB_SPIN(xb_ld(&bar[XB_TOPGEN]) == tg, bar);
            __builtin_amdgcn_fence(__ATOMIC_ACQUIRE, "agent");
            xb_add(&bar[XB_XGEN(b.x)], 1u);
            asm volatile("s_waitcnt vmcnt(0)" ::: "memory");
        } else {
            XB_SPIN(xb_ld(&bar[XB_XGEN(b.x)]) == gen, bar);
            __builtin_amdgcn_fence(__ATOMIC_ACQUIRE, "agent");
            asm volatile("s_waitcnt vmcnt(0)" ::: "memory");
        }
    }
    __syncthreads();
}
#include <hip/hip_bf16.h>
#include <cmath>
namespace attn_body {
using bf16=__hip_bfloat16;
using bf16x8=__attribute__((ext_vector_type(8)))short;
using s16x4=__attribute__((ext_vector_type(4)))short;
using f32x16=__attribute__((ext_vector_type(16)))float;
using u32x4=__attribute__((ext_vector_type(4)))unsigned;
constexpr int NHEAD=6,SEQ=2048,D=64,QP=3072,OP=1024;
constexpr int NW=8,QBLK=32,QB=QBLK*NW,KVBLK=64,NQB=SEQ/QB;
constexpr int ATTN_UNIT_ROWS=QB;
__device__ __forceinline__ int crow(int r,int hi){return (r&3)+8*(r>>2)+4*hi;}
#define SBAR() __builtin_amdgcn_sched_barrier(0)
__device__ __forceinline__ void cmask(f32x16&p0,f32x16&p1,int jb,int qrel,int hi){
  const float NEG=-INFINITY; int kb=64*jb+4*hi;
  #pragma unroll
  for(int r=0;r<16;++r){int kv=kb+(r&3)+8*(r>>2); if(kv>qrel)p0[r]=NEG; if(kv+32>qrel)p1[r]=NEG;}
}

constexpr int NSLOT=3, SLOTB=8192;
constexpr int LDS_K=0, LDS_V=NSLOT*SLOTB, LDS_WS=2*NSLOT*SLOTB, LDS_OST=LDS_WS+NW*64*4, LDS_BYTES=LDS_OST+NW*4096;
constexpr float C2=0.125f*1.4426950408889634f;
__device__ __forceinline__ void glds16(const void*gsrc,unsigned lds_dst){unsigned keep;
  asm volatile("s_mov_b32 %0, m0\n\ts_mov_b32 m0, %2\n\ts_nop 0\n\tglobal_load_lds_dwordx4 %1, off\n\ts_mov_b32 m0, %0":"=&s"(keep):"v"(gsrc),"s"(lds_dst):"memory");}
__device__ __forceinline__ float max3f(float a,float b,float c){float r;asm("v_max3_f32 %0, %1, %2, %3":"=v"(r):"v"(a),"v"(b),"v"(c));return r;}
__device__ __forceinline__ float max2f(float a,float b){float r;asm("v_max_f32_e32 %0, %1, %2":"=v"(r):"v"(a),"v"(b));return r;}
__device__ __forceinline__ float fadd_s(float a,float b){float r;asm("v_add_f32_e32 %0, %1, %2":"=v"(r):"v"(a),"v"(b));return r;}
__device__ __forceinline__ float fsub_s(float a,float b){float r;asm("v_sub_f32_e32 %0, %1, %2":"=v"(r):"v"(a),"v"(b));return r;}
typedef float f32x2_t __attribute__((ext_vector_type(2))); typedef __bf16 bf16x2_t __attribute__((ext_vector_type(2)));
__device__ __forceinline__ unsigned cvtpk_s(float lo,float hi){f32x2_t v={lo,hi};bf16x2_t b=__builtin_convertvector(v,bf16x2_t);return __builtin_bit_cast(unsigned,b);}
#define WAIT_BAR(N) asm volatile("s_waitcnt vmcnt(" #N ") lgkmcnt(0)\n\ts_barrier":::"memory")

__device__ __forceinline__ void qkt(f32x16&p0,f32x16&p1,const char*Kslot,const bf16x8*qr,int r32,int hi){ const f32x16 negm=f32x16{};
  const char*kb=Kslot+hi*1024+r32*16;
  #pragma unroll
  for(int d0=0;d0<4;++d0){
    const bf16x8 b0=*reinterpret_cast<const bf16x8*>(kb+d0*2048);
    const bf16x8 b1=*reinterpret_cast<const bf16x8*>(kb+d0*2048+512);
    if(d0==0){p0=__builtin_amdgcn_mfma_f32_32x32x16_bf16(b0,qr[0],negm,0,0,0);p1=__builtin_amdgcn_mfma_f32_32x32x16_bf16(b1,qr[0],negm,0,0,0);}
    else{p0=__builtin_amdgcn_mfma_f32_32x32x16_bf16(b0,qr[d0],p0,0,0,0);p1=__builtin_amdgcn_mfma_f32_32x32x16_bf16(b1,qr[d0],p1,0,0,0);}}
}
typedef __attribute__((address_space(3))) const char* lds_cptr;
typedef short v4i16_t __attribute__((ext_vector_type(4)));
__device__ __forceinline__ void kload8(bf16x8*kf,lds_cptr kp){
  kf[0]=*(const __attribute__((address_space(3))) bf16x8*)(kp);      kf[1]=*(const __attribute__((address_space(3))) bf16x8*)(kp+512);
  kf[2]=*(const __attribute__((address_space(3))) bf16x8*)(kp+2048); kf[3]=*(const __attribute__((address_space(3))) bf16x8*)(kp+2560);
  kf[4]=*(const __attribute__((address_space(3))) bf16x8*)(kp+4096); kf[5]=*(const __attribute__((address_space(3))) bf16x8*)(kp+4608);
  kf[6]=*(const __attribute__((address_space(3))) bf16x8*)(kp+6144); kf[7]=*(const __attribute__((address_space(3))) bf16x8*)(kp+6656);
}
__device__ __forceinline__ void kload2(bf16x8*kf,lds_cptr kp,int j){ kf[2*j]=*(const __attribute__((address_space(3))) bf16x8*)(kp+j*2048); kf[2*j+1]=*(const __attribute__((address_space(3))) bf16x8*)(kp+j*2048+512); }
__device__ __forceinline__ s16x4 vtr(lds_cptr p){ return __builtin_bit_cast(s16x4,__builtin_amdgcn_ds_read_tr16_b64_v4i16((__attribute__((address_space(3))) v4i16_t*)p)); }
__device__ __forceinline__ float rowmax(const f32x16&p0,const f32x16&p1){
  float a=max3f(p0[0],p0[1],p1[0]),b=max3f(p0[2],p0[3],p1[1]);a=max3f(a,p1[2],p1[3]);
  #pragma unroll
  for(int r=4;r<16;r+=4){a=max3f(a,p0[r],p0[r+1]);b=max3f(b,p0[r+2],p0[r+3]);a=max3f(a,p1[r],p1[r+1]);b=max3f(b,p1[r+2],p1[r+3]);}
  const float m=max2f(a,b);
  auto rr=__builtin_amdgcn_permlane32_swap(__float_as_uint(m),__float_as_uint(m),false,false);
  return max2f(__uint_as_float(rr[0]),__uint_as_float(rr[1]));
}
__device__ __forceinline__ void pv(f32x16*o,int vb,bf16x8 pa0,bf16x8 pa1,bf16x8 pa2,bf16x8 pa3){
  #pragma unroll
  for(int d0=0;d0<2;++d0){s16x4 lo[4],hi[4];
    #pragma unroll
    for(int ks=0;ks<4;++ks){
      asm volatile("ds_read_b64_tr_b16 %0,%1 offset:%c2":"=&v"(lo[ks]):"v"(vb),"i"(d0*4096+ks*1024):"memory");
      asm volatile("ds_read_b64_tr_b16 %0,%1 offset:%c2":"=&v"(hi[ks]):"v"(vb),"i"(d0*4096+ks*1024+512):"memory");}
    asm volatile("s_waitcnt lgkmcnt(0)":::"memory");SBAR();
    #define PK(k) (bf16x8){lo[k][0],lo[k][1],lo[k][2],lo[k][3],hi[k][0],hi[k][1],hi[k][2],hi[k][3]}
    o[d0]=__builtin_amdgcn_mfma_f32_32x32x16_bf16(pa0,PK(0),o[d0],0,0,0);
    o[d0]=__builtin_amdgcn_mfma_f32_32x32x16_bf16(pa1,PK(1),o[d0],0,0,0);
    o[d0]=__builtin_amdgcn_mfma_f32_32x32x16_bf16(pa2,PK(2),o[d0],0,0,0);
    o[d0]=__builtin_amdgcn_mfma_f32_32x32x16_bf16(pa3,PK(3),o[d0],0,0,0);
    #undef PK
  }
}

#ifndef ATTN_STORE16
#define ATTN_STORE16(p,v) (*(u32x4*)(p)=(v))
#endif
template<int THRL> __device__ __forceinline__ void attn_unit(int b,int h,int qb,const bf16*Q,const bf16*__restrict__ K,const bf16*__restrict__ V,bf16*O,const float*__restrict__ KM,int KMH,char*shm){
  const int tid=threadIdx.x,lane=tid&63,r32=lane&31,hi=lane>>5; const int wid=__builtin_amdgcn_readfirstlane(tid>>6);
  const long rowbase=(long)b*SEQ; const int q0=qb*QB;
  const bf16*Qw=Q+(rowbase+q0+wid*QBLK)*QP+h*D;
  const bf16*Kh=K+rowbase*QP+h*D,*Vh=V+rowbase*QP+h*D;
  const unsigned lds0=(unsigned)(uintptr_t)shm;
  float*wsf=(float*)(shm+LDS_WS)+wid*64;
  const bf16*ksrc=Kh+(long)lane*QP+wid*8;
  const bf16*vsrc=Vh+(long)(16*(wid&3)+(lane>>2))*QP+(wid>>2)*32+(lane&3)*8;
  const unsigned kdst=lds0+LDS_K+wid*1024, vdst=lds0+LDS_V+wid*1024;
  #define TI(t) (((t)<4)?(NT-4+(t)):((t)-4))
  #define DMA_K(t,slot) glds16(ksrc+(long)TI(t)*KVBLK*QP,(unsigned)__builtin_amdgcn_readfirstlane(kdst+(slot)))
  #define DMA_V(t,slot) glds16(vsrc+(long)TI(t)*KVBLK*QP,(unsigned)__builtin_amdgcn_readfirstlane(vdst+(slot)))
  const int vb0=(int)(lds0+LDS_V)+((lane>>4)&1)*32+(lane&3)*8+(4*hi+((lane&15)>>2))*64;
  const char*Kbase=shm+LDS_K; bf16x8 kf[8];
  const lds_cptr shm3=(lds_cptr)shm; const lds_cptr kp0=shm3+LDS_K+hi*1024+r32*16; const lds_cptr vp0=shm3+LDS_V+((lane>>4)&1)*32+(lane&3)*8+(4*hi+((lane&15)>>2))*64;
  const int NT=(q0+QB)/KVBLK;
  DMA_K(0,0);DMA_V(0,0);DMA_K(1,SLOTB);
  bf16x8 qr[4];
  #pragma unroll
  for(int d0=0;d0<4;++d0)qr[d0]=*reinterpret_cast<const bf16x8*>(&Qw[(long)r32*QP+d0*16+hi*8]);

  unsigned sel=0u;
  if(qb>0){ float gt_[8];
    #pragma unroll
    for(int n=0;n<8;++n){ float a_=0.f;
      if(n<qb){ const float*km=KM+((long)(b*NHEAD+h)*8+n)*64+hi*8;
        #pragma unroll
        for(int d0=0;d0<4;++d0){ float4 k0=*reinterpret_cast<const float4*>(km+d0*16), k1=*reinterpret_cast<const float4*>(km+d0*16+4);
          { const float4 k2=*reinterpret_cast<const float4*>(km+KMH+d0*16), k3=*reinterpret_cast<const float4*>(km+KMH+d0*16+4); k0.x+=k2.x;k0.y+=k2.y;k0.z+=k2.z;k0.w+=k2.w;k1.x+=k3.x;k1.y+=k3.y;k1.z+=k3.z;k1.w+=k3.w; }
          const bf16x8 qv=qr[d0];
          a_+=__uint_as_float(((unsigned)(unsigned short)qv[0])<<16)*k0.x+__uint_as_float(((unsigned)(unsigned short)qv[1])<<16)*k0.y+__uint_as_float(((unsigned)(unsigned short)qv[2])<<16)*k0.z+__uint_as_float(((unsigned)(unsigned short)qv[3])<<16)*k0.w
             +__uint_as_float(((unsigned)(unsigned short)qv[4])<<16)*k1.x+__uint_as_float(((unsigned)(unsigned short)qv[5])<<16)*k1.y+__uint_as_float(((unsigned)(unsigned short)qv[6])<<16)*k1.z+__uint_as_float(((unsigned)(unsigned short)qv[7])<<16)*k1.w; }
        a_+=__shfl_xor(a_,32); }
      gt_[n]=(n<qb)?a_:-1e30f; }
    #pragma unroll
    for(int r_=0;r_<3;++r_){ float bv=-3.0e38f; int best=-1;
      #pragma unroll
      for(int n=0;n<8;++n) if(!((sel>>n)&1u)&&gt_[n]>bv){bv=gt_[n];best=n;}
      if(best>=0&&bv>-0.5e30f) sel|=1u<<best; } }
  if(hi==0)wsf[32+r32]=__uint_as_float(sel); asm volatile("s_waitcnt lgkmcnt(0)":::"memory");
  float mhat=0.f,l_reg=0.f;f32x16 o[2];o[0]=f32x16{};o[1]=f32x16{};
  const int qrel=wid*QBLK+r32;
  #define CMASK(P0,P1,t) do{ if((t)<4){cmask(P0,P1,(t),qrel,hi);} else if(!((__float_as_uint(wsf[32+r32])>>(((t)-4)>>2))&1u)){ _Pragma("unroll") for(int r_=0;r_<16;++r_){P0[r_]=-INFINITY;P1[r_]=-INFINITY;} } }while(0)
  bool resc=false;
  #define START(P0,P1) do{ const float rm=rowmax(P0,P1); resc=false; \
    { const float dl=rm; mhat=fadd_s(mhat,dl); \
      _Pragma("unroll") for(int r=0;r<16;++r){P0[r]=fsub_s(P0[r],dl);P1[r]=fsub_s(P1[r],dl);} \
      } \
    _Pragma("unroll") for(int r=0;r<16;++r)P0[r]=__builtin_amdgcn_exp2f(P0[r]); }while(0)
  #define RESC() do{ if(resc){ asm volatile("s_waitcnt lgkmcnt(0)":::"memory"); \
      _Pragma("unroll") for(int d_=0;d_<2;++d_) _Pragma("unroll") for(int r=0;r<16;++r)o[d_][r]*=wsf[crow(r,hi)]; } }while(0)
  f32x16 pA0,pA1,pB0,pB1;
  int sl_prev=0,sl_cur=0,sl_next=SLOTB;
  #define ROT() do{sl_prev=sl_cur;sl_cur=sl_next;sl_next=(sl_next==(NSLOT-1)*SLOTB)?0:sl_next+SLOTB;}while(0)
  DMA_K(2,2*SLOTB);
  WAIT_BAR(3);
  qkt(pA0,pA1,Kbase,qr,r32,hi);asm volatile("s_nop 15\n\ts_nop 7":"+v"(pA0),"+v"(pA1));CMASK(pA0,pA1,0);
  START(pA0,pA1);
  _Pragma("unroll") for(int r=0;r<16;++r)pA1[r]=__builtin_amdgcn_exp2f(pA1[r]);
  WAIT_BAR(0);
  DMA_K(3,0);DMA_V(1,SLOTB);
  ROT();
  kload8(kf,kp0+sl_cur);
  WAIT_BAR(2);
  s16x4 vlo[8],vhi[8]; u32x4 pw0,pw1,pw2,pw3;
  #define PKW(P,B) cvtpk_s(P[B],P[B+1])
  #define PAF(k) __builtin_bit_cast(bf16x8,pw##k)
  #define VFR(i) (bf16x8){vlo[i][0],vlo[i][1],vlo[i][2],vlo[i][3],vhi[i][0],vhi[i][1],vhi[i][2],vhi[i][3]}
  #define PIN(x) asm volatile("":"+v"(x))
  #define MX3(a,b,c) __builtin_fmaxf(__builtin_fmaxf((a),(b)),(c))
  #define GAPA(MF,A0,A1,A2,A3,W0,W1,PW) do{ MF; sacc+=A0; sacc+=A1; sacc+=A2; sacc+=A3; PIN(sacc); W0; W1; PIN(PW); SBAR(); }while(0)
  #define EX(v) __builtin_amdgcn_exp2f(v)
  #define GAPB(MF,X,B) do{ MF; X[B]=EX(X[B]); X[B+1]=EX(X[B+1]); X[B+2]=EX(X[B+2]); X[B+3]=EX(X[B+3]); PIN(X); SBAR(); }while(0)
  #define VRD(i) do{ vlo[i]=vtr(vp_+(((i)>>2)*4096+((i)&3)*1024)); vhi[i]=vtr(vp_+(((i)>>2)*4096+((i)&3)*1024+512)); }while(0)
  #define KRD(G,j) do{ if(G){ kload2(kf,kp0+sl_next,j); SBAR(); } }while(0)
  #define STEP(C0,C1,P0,P1,t,GK,GV,GL) do{ SBAR(); \
    const lds_cptr vp_=vp0+sl_prev; \
    VRD(0); SBAR(); float sacc=(P0[0]+P0[1]); \
    GAPA(C0=__builtin_amdgcn_mfma_f32_32x32x16_bf16(kf[0],qr[0],f32x16{},0,0,0), P0[2],P0[3],P0[4],P0[5],     pw0[0]=PKW(P0,0), pw0[1]=PKW(P0,2), pw0); \
    VRD(4); SBAR(); GAPA(C1=__builtin_amdgcn_mfma_f32_32x32x16_bf16(kf[1],qr[0],f32x16{},0,0,0), P0[6],P0[7],P0[8],P0[9],     pw0[2]=PKW(P0,4), pw0[3]=PKW(P0,6), pw0); \
    VRD(1); SBAR(); GAPA(C0=__builtin_amdgcn_mfma_f32_32x32x16_bf16(kf[2],qr[1],C0,0,0,0),   P0[10],P0[11],P0[12],P0[13], pw1[0]=PKW(P0,8), pw1[1]=PKW(P0,10), pw1); \
    VRD(5); SBAR(); GAPA(C1=__builtin_amdgcn_mfma_f32_32x32x16_bf16(kf[3],qr[1],C1,0,0,0),   P0[14],P0[15],P1[0],P1[1],   pw1[2]=PKW(P0,12),pw1[3]=PKW(P0,14), pw1); \
    VRD(2); SBAR(); GAPA(C0=__builtin_amdgcn_mfma_f32_32x32x16_bf16(kf[4],qr[2],C0,0,0,0),   P1[2],P1[3],P1[4],P1[5],     pw2[0]=PKW(P1,0), pw2[1]=PKW(P1,2), pw2); \
    VRD(6); SBAR(); GAPA(C1=__builtin_amdgcn_mfma_f32_32x32x16_bf16(kf[5],qr[2],C1,0,0,0),   P1[6],P1[7],P1[8],P1[9],     pw2[2]=PKW(P1,4), pw2[3]=PKW(P1,6), pw2); \
    VRD(3); SBAR(); GAPA(C0=__builtin_amdgcn_mfma_f32_32x32x16_bf16(kf[6],qr[3],C0,0,0,0),   P1[10],P1[11],P1[12],P1[13], pw3[0]=PKW(P1,8), pw3[1]=PKW(P1,10), pw3); \
    VRD(7); SBAR(); GAPA(C1=__builtin_amdgcn_mfma_f32_32x32x16_bf16(kf[7],qr[3],C1,0,0,0),   P1[14],P1[15],0.f,0.f,       pw3[2]=PKW(P1,12),pw3[3]=PKW(P1,14), pw3); \
    l_reg+=sacc; \
    if(GK){DMA_K((t)+3,sl_cur);} if(GV){DMA_V((t)+1,sl_next);} \
    CMASK(C0,C1,t); \
    _Pragma("unroll") for(int r=0;r<16;++r){C0[r]-=mhat;C1[r]-=mhat;} \
    { float a=MX3(C0[0],C0[1],C1[0]),b=MX3(C0[2],C0[3],C1[1]); a=MX3(a,C1[2],C1[3]); \
      _Pragma("unroll") for(int r=4;r<16;r+=4){a=MX3(a,C0[r],C0[r+1]);b=MX3(b,C0[r+2],C0[r+3]);a=MX3(a,C1[r],C1[r+1]);b=MX3(b,C1[r+2],C1[r+3]);} \
      float rm=__builtin_fmaxf(a,b); { auto rr=__builtin_amdgcn_permlane32_swap(__float_as_uint(rm),__float_as_uint(rm),false,false); rm=__builtin_fmaxf(__uint_as_float(rr[0]),__uint_as_float(rr[1])); } \
      resc=false; \
      if(__builtin_expect(__any(rm>(float)THRL),0)){ const float dl=__builtin_fmaxf(rm,0.f); mhat+=dl; \
        _Pragma("unroll") for(int r=0;r<16;++r){C0[r]-=dl;C1[r]-=dl;} \
        const float f=__builtin_amdgcn_exp2f(-dl); l_reg*=f; if(hi==0)wsf[r32]=f; resc=true; } } \
    SBAR(); \
    GAPB(o[0]=__builtin_amdgcn_mfma_f32_32x32x16_bf16(PAF(0),VFR(0),o[0],0,0,0), C0,0); \
    GAPB(o[1]=__builtin_amdgcn_mfma_f32_32x32x16_bf16(PAF(0),VFR(4),o[1],0,0,0), C0,4); \
    KRD(GL,0); GAPB(o[0]=__builtin_amdgcn_mfma_f32_32x32x16_bf16(PAF(1),VFR(1),o[0],0,0,0), C0,8); \
    KRD(GL,1); GAPB(o[1]=__builtin_amdgcn_mfma_f32_32x32x16_bf16(PAF(1),VFR(5),o[1],0,0,0), C0,12); \
    KRD(GL,2); GAPB(o[0]=__builtin_amdgcn_mfma_f32_32x32x16_bf16(PAF(2),VFR(2),o[0],0,0,0), C1,0); \
    KRD(GL,3); GAPB(o[1]=__builtin_amdgcn_mfma_f32_32x32x16_bf16(PAF(2),VFR(6),o[1],0,0,0), C1,4); \
    GAPB(o[0]=__builtin_amdgcn_mfma_f32_32x32x16_bf16(PAF(3),VFR(3),o[0],0,0,0), C1,8); \
    GAPB(o[1]=__builtin_amdgcn_mfma_f32_32x32x16_bf16(PAF(3),VFR(7),o[1],0,0,0), C1,12); \
    }while(0)
  int t=1;
  for(;t+5<NT;t+=2){
    STEP(pB0,pB1,pA0,pA1,t,true,true,true);     WAIT_BAR(2); RESC(); ROT();
    STEP(pA0,pA1,pB0,pB1,t+1,true,true,true);   WAIT_BAR(2); RESC(); ROT();
  }
  #define ENDW(tt) do{ if((tt)+3<NT){WAIT_BAR(2);} else if((tt)+2<NT){WAIT_BAR(1);} else {WAIT_BAR(0);} }while(0)
  for(;t+1<NT;t+=2){
    STEP(pB0,pB1,pA0,pA1,t,(t+3<NT),(t+1<NT),(t+1<NT));       ENDW(t);   RESC(); ROT();
    STEP(pA0,pA1,pB0,pB1,t+1,(t+4<NT),(t+2<NT),(t+2<NT));     ENDW(t+1); RESC(); ROT();
  }
  STEP(pB0,pB1,pA0,pA1,NT-1,false,false,false); RESC();
  { float sacc=pB0[0]+pB0[1]; _Pragma("unroll") for(int r=2;r<16;++r)sacc+=pB0[r]; _Pragma("unroll") for(int r=0;r<16;++r)sacc+=pB1[r]; l_reg+=sacc;
    pw0=(u32x4){PKW(pB0,0),PKW(pB0,2),PKW(pB0,4),PKW(pB0,6)};pw1=(u32x4){PKW(pB0,8),PKW(pB0,10),PKW(pB0,12),PKW(pB0,14)};pw2=(u32x4){PKW(pB1,0),PKW(pB1,2),PKW(pB1,4),PKW(pB1,6)};pw3=(u32x4){PKW(pB1,8),PKW(pB1,10),PKW(pB1,12),PKW(pB1,14)};
    SBAR(); pv(o,vb0+sl_cur,PAF(0),PAF(1),PAF(2),PAF(3)); }
  #undef PKW
  #undef PAF
  #undef VFR
  #undef PIN
  #undef MX3
  #undef GAPA
  #undef GAPB
  #undef EX
  #undef VRD
  #undef KRD
  #undef STEP
  #undef ENDW
  {auto rr=__builtin_amdgcn_permlane32_swap(__float_as_uint(l_reg),__float_as_uint(l_reg),false,false);l_reg=__uint_as_float(rr[0])+__uint_as_float(rr[1]);}
  if(hi==0)wsf[32+r32]=l_reg;asm volatile("s_waitcnt lgkmcnt(0)":::"memory");
  float rli[16];
  #pragma unroll
  for(int r=0;r<16;++r)rli[r]=__builtin_amdgcn_rcpf(wsf[32+crow(r,hi)]);
  bf16*Ow=O+(rowbase+q0+wid*QBLK)*OP+h*D;
  { bf16*stg=(bf16*)(shm+LDS_OST)+wid*2048;
    #pragma unroll
    for(int r=0;r<16;++r){const int orow=crow(r,hi);
      #pragma unroll
      for(int d0=0;d0<2;++d0)stg[orow*64+d0*32+r32]=__float2bfloat16(o[d0][r]*rli[r]);}
    asm volatile("s_waitcnt lgkmcnt(0)":::"memory");
    #pragma unroll
    for(int i=0;i<4;++i){const int row=i*8+(lane>>3),ch=lane&7; const u32x4 v=*(const u32x4*)(stg+row*64+ch*8); ATTN_STORE16(Ow+(long)row*OP+ch*8,v);} }
  asm volatile("s_waitcnt lgkmcnt(0)\n\ts_barrier":::"memory");
  #undef DMA_K
  #undef DMA_V
  #undef TI
  #undef CMASK
  #undef START
  #undef RESC
  #undef ROT
}
constexpr int ATTN_LDS_BYTES=LDS_BYTES;
#undef SBAR
#undef WAIT_BAR
}
#undef LAS
constexpr int NB = DEBUG_BUILD ? 2 : 8;
constexpr int M_ = NB * SEQ;
constexpr int NSLOT = 2 * M_ + N_EXP * 256;
constexpr int PLD = 3072;
constexpr int FQ = 0, FK = 384, FV = 768, FZ = 1152, FGU = 1536, FGV = 1792, FXBC = 2048, FDT = 2944;
constexpr int NGU = 2 * D_FF, NGUE = 2 * D_FFE;

constexpr size_t al256(size_t x) { return (x + 255) & ~(size_t)255; }
constexpr size_t MiB = 1u << 20;
constexpr size_t O_CTL = 0, CTL_BYTES = 1 * MiB;
constexpr size_t O_RT = 1 * MiB;
constexpr size_t O_TE = O_RT + (size_t)M_ * 64, O_TP = O_TE + (size_t)M_ * 8, O_TS = O_TP + (size_t)M_ * 8, O_GS = O_TS + (size_t)M_ * 8;
constexpr size_t O_SP = O_GS + (size_t)M_ * 8;
constexpr size_t O_KM = O_SP + al256((size_t)NSLOT * 4);
constexpr size_t O_DT = O_KM + (size_t)2 * NB * ATT_H * NBLK * 64 * 4;
constexpr size_t O_WSB = al256(O_DT + (size_t)M_ * 24);
constexpr size_t O_HB = (O_WSB + (size_t)2 * GM_G * GM_CHUNK * GM_CHUNK * 2 + MiB - 1) / MiB * MiB;
constexpr size_t O_MWGU = O_HB + (size_t)M_ * DM * 2;
constexpr size_t O_WIN = O_MWGU + (size_t)N_EXP * NGUE * DM * 2;
constexpr size_t O_WOUT = O_WIN + (size_t)2 * PLD * DM * 2;
constexpr size_t O_WGU = O_WOUT + (size_t)2 * DM * DM * 2;
constexpr size_t O_WD = O_WGU + (size_t)NGU * DM * 2;
constexpr size_t O_SCR = O_WD + (size_t)DM * D_FF * 2;
constexpr size_t O_PROJ = O_SCR;
constexpr size_t O_XC = O_PROJ + (size_t)M_ * PLD * 2;
constexpr size_t O_MIXU = O_XC + (size_t)M_ * SSD_CW * 2;
constexpr size_t O_MIXB = O_MIXU + (size_t)M_ * DM * 4;
constexpr size_t O_VN = O_MIXB + (size_t)M_ * DM * 2;
constexpr size_t O_MIXEND = O_VN + (size_t)M_ * GM_W * 4;
constexpr size_t O_Y = O_SCR;
constexpr size_t O_ACT = O_Y + (size_t)M_ * DM * 4;
constexpr size_t O_XG = O_WIN;
constexpr size_t O_ACTM = O_XG + (size_t)NSLOT * DM * 2;
constexpr size_t O_MOEEND = O_ACTM + (size_t)NSLOT * D_FFE * 2;
constexpr size_t WS_END = O_MOEEND > O_MIXEND ? O_MOEEND : O_MIXEND;
static_assert(O_ACT + (size_t)M_ * D_FF * 2 <= O_MIXEND + (size_t)M_ * 4096, "act");
static_assert((size_t)NB * 16 * SSD_H * 8192 * 4 <= (size_t)M_ * SSD_CW * 2, "SSD states fit in the XC slot");
static_assert(WS_END <= 487000000ull, "workspace map exceeds the guaranteed size");
static_assert((size_t)N_EXP * DM * D_FFE * 2 <= (size_t)N_EXP * NGUE * DM * 2, "MWD fits over MWGU");
constexpr int CW_BAR = 4096, CW_CNT = 1024, CW_Q = 1040, CW_ERR = 2048;

constexpr int RING_BYTES = 131072, MISC_OFF = RING_BYTES + 320, LDS_BYTES = 147456;

#define GAS __attribute__((address_space(1)))
#define LAS __attribute__((address_space(3)))
typedef GAS unsigned gu32;
#define RLX_AGENT __ATOMIC_RELAXED, __HIP_MEMORY_SCOPE_AGENT
#define LDS_WAIT() asm volatile("s_waitcnt lgkmcnt(0)" ::: "memory")

constexpr float QSCALE = 0.125f * 1.4426950408889634f;
namespace fp {
using pg8::Unit; using pg8::BM; using pg8::HALF; typedef pg8::f32x4 f32x4; typedef pg8::u32x4 u32x4;
__device__ __forceinline__ unsigned pk2(float lo, float hi) { return pg8::cvt_pk_bf16(lo, hi); }
__device__ __forceinline__ float gelu_fast(float x) { const float u = 0.7978845608028654f * (x + 0.044715f * x * x * x); return x / (1.f + __expf(-2.f * u)); }

struct EpiProj {
    static constexpr bool PERM = true, AFTER_DRAIN = false;
    bf16* O; const float* RT; float* KM2;
    __device__ __forceinline__ void operator()(const f32x4 (&acc)[2][2][4][2], const Unit& u, int wr, int wc, int fr, int fq) const {
        const int row0 = u.pm * BM + wr * 64 + fr, col0 = u.pn * BM + wc * 32 + 8 * fq;
        f32x4 ks[2][2];
#pragma unroll
        for (int i = 0; i < 2; ++i) { ks[i][0] = (f32x4){0.f, 0.f, 0.f, 0.f}; ks[i][1] = ks[i][0]; }
        const int mode = (u.pn < 3) ? 1 : ((u.pn == 6 || u.pn == 7) ? 2 : 0);
        const bool rl = ((wc & 1) == 0) && (fq < 2);
        const int i0 = (fq & 1) * 4;
#pragma unroll
        for (int ai = 0; ai < 2; ++ai)
#pragma unroll
            for (int m = 0; m < 4; ++m) { const int row = row0 + ai * HALF + m * 16;
                float4 c4 = make_float4(1.f, 1.f, 1.f, 1.f), s4 = make_float4(0.f, 0.f, 0.f, 0.f);
                if (mode == 1 && rl) { c4 = *(const float4*)(RT + (size_t)row * 16 + i0); s4 = *(const float4*)(RT + (size_t)row * 16 + 8 + i0); }
#pragma unroll
                for (int bj = 0; bj < 2; ++bj) { f32x4 v0 = acc[ai][bj][m][0], v1 = acc[ai][bj][m][1];
                    if (mode == 1) { const f32x4 a = v0, b = v1;
                        v0[0] = a[0] * c4.x - a[1] * s4.x; v0[1] = a[1] * c4.x + a[0] * s4.x; v0[2] = a[2] * c4.y - a[3] * s4.y; v0[3] = a[3] * c4.y + a[2] * s4.y;
                        v1[0] = b[0] * c4.z - b[1] * s4.z; v1[1] = b[1] * c4.z + b[0] * s4.z; v1[2] = b[2] * c4.w - b[3] * s4.w; v1[3] = b[3] * c4.w + b[2] * s4.w; }
                    if (u.pn == 0 || (u.pn == 1 && bj == 0)) { v0 = v0 * QSCALE; v1 = v1 * QSCALE; }
                    else if (mode == 1) { ks[bj][0] += v0; ks[bj][1] += v1; }
                    if (mode == 2) {
#pragma unroll
                        for (int j = 0; j < 4; ++j) { v0[j] = gelu_fast(v0[j]); v1[j] = gelu_fast(v1[j]); } }
                    u32x4 w; w.x = pk2(v0[0], v0[1]); w.y = pk2(v0[2], v0[3]); w.z = pk2(v1[0], v1[1]); w.w = pk2(v1[2], v1[3]);
                    *(u32x4*)(O + (size_t)row * PLD + col0 + bj * HALF) = w; } }
        if (u.pn == 1 || u.pn == 2) {
#pragma unroll
            for (int bj = 0; bj < 2; ++bj) { if (u.pn == 1 && bj == 0) continue;
#pragma unroll
                for (int n = 0; n < 2; ++n)
#pragma unroll
                    for (int j = 0; j < 4; ++j) { float x = ks[bj][n][j]; x += __shfl_xor(x, 1); x += __shfl_xor(x, 2); x += __shfl_xor(x, 4); x += __shfl_xor(x, 8); ks[bj][n][j] = x * (1.f / 256.f); }
                if (fr == 0) { const int kc = col0 + bj * HALF - FK; const int b = u.pm >> 3, nb = u.pm & 7;
                    float* dst = KM2 + (size_t)wr * (NB * ATT_H * NBLK * 64) + ((size_t)(b * ATT_H + (kc >> 6)) * NBLK + nb) * 64 + (kc & 63);
                    *(f32x4*)dst = ks[bj][0]; *(f32x4*)(dst + 4) = ks[bj][1]; } }
        }
    }
};
struct EpiAct {
    static constexpr bool PERM = true, AFTER_DRAIN = false;
    bf16* O; int ldc, ncol;
    __device__ __forceinline__ void operator()(const f32x4 (&acc)[2][2][4][2], const Unit& u, int wr, int wc, int fr, int fq) const {
        const int row0 = u.pm * BM + wr * 64 + fr, col0 = (u.pn % ncol) * HALF + wc * 32 + 8 * fq;
#pragma unroll
        for (int ai = 0; ai < 2; ++ai)
#pragma unroll
            for (int m = 0; m < 4; ++m) { const int row = row0 + ai * HALF + m * 16;
                const f32x4 g0 = acc[ai][0][m][0], g1 = acc[ai][0][m][1], u0 = acc[ai][1][m][0], u1 = acc[ai][1][m][1]; f32x4 a0, a1;
#pragma unroll
                for (int j = 0; j < 4; ++j) { a0[j] = g0[j] / (1.f + __expf(-g0[j])) * u0[j]; a1[j] = g1[j] / (1.f + __expf(-g1[j])) * u1[j]; }
                u32x4 w; w.x = pk2(a0[0], a0[1]); w.y = pk2(a0[2], a0[3]); w.z = pk2(a1[0], a1[1]); w.w = pk2(a1[2], a1[3]);
                *(u32x4*)(O + (size_t)row * ldc + col0) = w; }
    }
};
struct EpiF32 {
    static constexpr bool PERM = false, AFTER_DRAIN = false;
    float* O; int ldc;
    __device__ __forceinline__ void operator()(const f32x4 (&acc)[2][2][4][2], const Unit& u, int wr, int wc, int fr, int fq) const {
        const int row0 = u.pm * BM + wr * 64 + fr, col0 = u.pn * BM + wc * 32 + 4 * fq;
#pragma unroll
        for (int ai = 0; ai < 2; ++ai)
#pragma unroll
            for (int m = 0; m < 4; ++m) { float* rp = O + (size_t)(row0 + ai * HALF + m * 16) * ldc + col0;
#pragma unroll
                for (int bj = 0; bj < 2; ++bj)
#pragma unroll
                    for (int n = 0; n < 2; ++n) *(f32x4*)(rp + bj * HALF + n * 16) = acc[ai][bj][m][n]; }
    }
};
struct EpiF2 {
    static constexpr bool PERM = true, AFTER_DRAIN = false;
    bf16* O; const float* SP;
    __device__ __forceinline__ void operator()(const f32x4 (&acc)[2][2][4][2], const Unit& u, int wr, int wc, int fr, int fq) const {
        const int row0 = u.pm * BM + wr * 64 + fr, col0 = (u.pn & 3) * BM + wc * 32 + 8 * fq;
#pragma unroll
        for (int ai = 0; ai < 2; ++ai)
#pragma unroll
            for (int m = 0; m < 4; ++m) { const int row = row0 + ai * HALF + m * 16; const float sc = SP[row];
#pragma unroll
                for (int bj = 0; bj < 2; ++bj) { const f32x4 v0 = acc[ai][bj][m][0] * sc, v1 = acc[ai][bj][m][1] * sc;
                    u32x4 w; w.x = pk2(v0[0], v0[1]); w.y = pk2(v0[2], v0[3]); w.z = pk2(v1[0], v1[1]); w.w = pk2(v1[2], v1[3]);
                    *(u32x4*)(O + (size_t)row * DM + col0 + bj * HALF) = w; } }
    }
};
struct MoeOrder {
    int p0, p1, p2, p3, p4, p5, p6, T, ncol, G, c;
    __device__ __forceinline__ void init(const int* CNT, int ncol_, int G_, int c_) {
        int t = 0; t += (CNT[0] + 255) >> 8; p0 = t; t += (CNT[1] + 255) >> 8; p1 = t; t += (CNT[2] + 255) >> 8; p2 = t; t += (CNT[3] + 255) >> 8; p3 = t;
        t += (CNT[4] + 255) >> 8; p4 = t; t += (CNT[5] + 255) >> 8; p5 = t; t += (CNT[6] + 255) >> 8; p6 = t; t += (CNT[7] + 255) >> 8; T = t; ncol = ncol_; G = G_; c = c_;
    }
    __device__ __forceinline__ bool next(int i, Unit& u) const {
        const long L = (long)i * G + c; if (L >= (long)T * ncol) return false;
        const int tm = (int)(L / ncol), j = (int)(L % ncol);
        const int e = (tm >= p0) + (tm >= p1) + (tm >= p2) + (tm >= p3) + (tm >= p4) + (tm >= p5) + (tm >= p6);
        u.pm = tm; u.pn = e * ncol + j; return true;
    }
    __device__ __forceinline__ void a_ready(const Unit&) const {}
    __device__ __forceinline__ void done(const Unit&) const {}
};

struct SrcCol { const float* p; int ld; };
__device__ __forceinline__ int win_src_col(int d) {
    if (d < 768) { const int hd = d & 63; const int sd = hd < 16 ? ((hd & 1) ? 8 + (hd >> 1) : (hd >> 1)) : hd; return d - hd + sd; }
    if (d < 1536) return d;
    if (d < 1792) return 2438 + (d - 1536);
    if (d < 2048) return 2694 + (d - 1792);
    if (d < 2944) return 1536 + (d - 2048);
    if (d < 2950) return 2432 + (d - 2944);
    return -1;
}
__device__ __forceinline__ SrcCol gu_src(const float* wg, const float* wu, int nff, int r) {
    const int tile = r >> 8, rr = r & 255, j = tile * 128 + (rr & 127); SrcCol s; s.p = (rr < 128 ? wg : wu) + j; s.ld = nff; return s;
}
__device__ __forceinline__ void conv_item(SrcCol sc, int K, bf16* WT, long d0, int k0, LAS float* scr, int lane) {
    float tv[32];
#pragma unroll
    for (int i = 0; i < 32; ++i) { const int kk = 2 * i + (lane >> 5); tv[i] = sc.p ? sc.p[(size_t)(k0 + kk) * sc.ld] : 0.f; }
#pragma unroll
    for (int i = 0; i < 32; ++i) { const int kk = 2 * i + (lane >> 5); scr[kk * 33 + (lane & 31)] = tv[i]; }
    LDS_WAIT(); asm volatile("" ::: "memory");
    const int c = lane & 7;
#pragma unroll
    for (int j = 0; j < 4; ++j) { const int n = (lane >> 3) + 8 * j; const LAS float* s = scr + (8 * c) * 33 + n;
        u32x4 o; o.x = pk2(s[0 * 33], s[1 * 33]); o.y = pk2(s[2 * 33], s[3 * 33]); o.z = pk2(s[4 * 33], s[5 * 33]); o.w = pk2(s[6 * 33], s[7 * 33]);
        *(u32x4*)(WT + (size_t)(d0 + n) * K + k0 + 8 * c) = o; }
    LDS_WAIT(); asm volatile("" ::: "memory");
}
}


typedef short bf16x8_t __attribute__((ext_vector_type(8)));
typedef float f32x4_t __attribute__((ext_vector_type(4)));
constexpr int TLD = 272;
__device__ __forceinline__ bf16x8_t lds_frag(const LAS unsigned char* base, int row, int kbyte) { return *(const LAS bf16x8_t*)(base + row * TLD + kbyte); }
__device__ __forceinline__ float red16(float v) { v += __shfl_xor(v, 1); v += __shfl_xor(v, 2); v += __shfl_xor(v, 4); v += __shfl_xor(v, 8); return v; }

__device__ __forceinline__ void gm_unit(int b, int c, const bf16* PROJ, const bf16* WSB  , const float* ln_g, const float* ln_b, const float* b_s, const float* norm_g,
                                        bf16* MIXB, LAS unsigned char* lds, int wave, int lane) {
    const long r0 = (long)b * SEQ + c * GM_CHUNK;
    LAS unsigned char* VNT = lds;
    for (int i = 0; i < 16; ++i) { const int t = wave * 16 + i;
        const float4 v = ld4(PROJ + (r0 + t) * PLD + FGV + lane * 4);
        const float mean = wave_sum((v.x + v.y) + (v.z + v.w)) * (1.f / 256.f);
        const float d0 = v.x - mean, d1 = v.y - mean, d2 = v.z - mean, d3 = v.w - mean;
        const float rstd = rsqrtf(wave_sum((d0 * d0 + d1 * d1) + (d2 * d2 + d3 * d3)) * (1.f / 256.f) + 1e-5f);
        const float4 gg = *(const float4*)(ln_g + lane * 4), bb = *(const float4*)(ln_b + lane * 4);
        LAS bf16* dst = (LAS bf16*)(VNT + (lane * 4) * TLD) + t;
        dst[0] = (bf16)f2bf(d0 * rstd * gg.x + bb.x); dst[TLD / 2] = (bf16)f2bf(d1 * rstd * gg.y + bb.y); dst[TLD] = (bf16)f2bf(d2 * rstd * gg.z + bb.z); dst[3 * TLD / 2] = (bf16)f2bf(d3 * rstd * gg.w + bb.w); }
    __syncthreads();
    f32x4_t acc[16];
#pragma unroll
    for (int i = 0; i < 16; ++i) acc[i] = (f32x4_t){0.f, 0.f, 0.f, 0.f};
    const int fr = lane & 15, fq = lane >> 4;
    const int nks = (wave * 16 + 15) / 32 + 1;
    for (int ks = 0; ks < nks; ++ks) {
#pragma unroll
        for (int g = 0; g < 4; ++g) {
            const bf16x8_t af = *(const bf16x8_t*)(WSB + ((size_t)g * GM_CHUNK + wave * 16 + fr) * GM_CHUNK + ks * 32 + fq * 8);
#pragma unroll
            for (int n = 0; n < 4; ++n) { const bf16x8_t bfv = lds_frag(VNT, g * 64 + n * 16 + fr, ks * 64 + fq * 16);
                acc[g * 4 + n] = __builtin_amdgcn_mfma_f32_16x16x32_bf16(af, bfv, acc[g * 4 + n], 0, 0, 0); }
        }
    }
    __syncthreads();
    LAS bf16* ost = (LAS bf16*)(lds + wave * (16 * 264 * 2));
    float ss[4] = {0.f, 0.f, 0.f, 0.f};
#pragma unroll
    for (int nt = 0; nt < 16; ++nt) { const int col = nt * 16 + fr, g = nt >> 2;
#pragma unroll
        for (int r = 0; r < 4; ++r) { const int t = wave * 16 + fq * 4 + r;
            const float u = ldf(PROJ + (r0 + t) * PLD + FGU + col);
            const float o = u * (acc[nt][r] + b_s[g * GM_CHUNK + t]); acc[nt][r] = o; ss[r] += o * o; } }
#pragma unroll
    for (int r = 0; r < 4; ++r) ss[r] = rsqrtf(red16(ss[r]) * (1.f / 256.f) + 1e-5f);
#pragma unroll
    for (int nt = 0; nt < 16; ++nt) { const int col = nt * 16 + fr; const float gn = norm_g[col];
#pragma unroll
        for (int r = 0; r < 4; ++r) { ost[(fq * 4 + r) * 264 + col] = (bf16)f2bf(acc[nt][r] * ss[r] * gn); } }
    LDS_WAIT(); asm volatile("" ::: "memory");
#pragma unroll
    for (int i = 0; i < 8; ++i) { const int rr = i * 2 + (lane >> 5), ch = lane & 31;
        const fp::u32x4 v = *(const LAS fp::u32x4*)(ost + rr * 264 + ch * 8);
        *(fp::u32x4*)(MIXB + (r0 + wave * 16 + rr) * DM + ATT_W + SSD_W + ch * 8) = v; }
    __syncthreads();
}

typedef short v4i16_t __attribute__((ext_vector_type(4)));
typedef unsigned u32x2_t __attribute__((ext_vector_type(2)));
__device__ __forceinline__ v4i16_t lds_tr(const LAS unsigned char* p) { return __builtin_amdgcn_ds_read_tr16_b64_v4i16((LAS v4i16_t*)p); }
__device__ __forceinline__ bf16x8_t lds_frag_tr(const LAS unsigned char* tile, int pitch, int k0, int c0, int lane) {
    const int kg = lane >> 4, q = (lane & 15) >> 2, p = lane & 3;
    const LAS unsigned char* a = tile + (k0 + 8 * kg + q) * pitch + (c0 + 4 * p) * 2;
    const v4i16_t lo = lds_tr(a), hi = lds_tr(a + 4 * pitch);
    return (bf16x8_t){lo[0], lo[1], lo[2], lo[3], hi[0], hi[1], hi[2], hi[3]};
}
__device__ __forceinline__ bf16x8_t lds_frag_p(const LAS unsigned char* base, int pitch, int row, int kbyte) { return *(const LAS bf16x8_t*)(base + row * pitch + kbyte); }
template <int NCH, bool SCALE> __device__ __forceinline__ void stage_conv(const bf16* PROJ, long r0, int t0, int colbase, int ch0, const float* cw, const float* cb, LAS unsigned char* tile, int pitch, const LAS float* scl, int tid) {
    constexpr int CPR = NCH / 8;
    for (int it = tid; it < 128 * CPR; it += 512) { const int l = it / CPR, ch = (it % CPR) * 8;
        float a[8];
        { const float4 c0 = *(const float4*)(cb + ch0 + ch), c1 = *(const float4*)(cb + ch0 + ch + 4); a[0] = c0.x; a[1] = c0.y; a[2] = c0.z; a[3] = c0.w; a[4] = c1.x; a[5] = c1.y; a[6] = c1.z; a[7] = c1.w; }
#pragma unroll
        for (int i = 0; i < 4; ++i) { if (t0 + l - 3 + i >= 0) {
            const fp::u32x4 xv = *(const fp::u32x4*)(PROJ + (r0 + l - 3 + i) * PLD + colbase + ch);
            const float4 w0 = *(const float4*)(cw + i * SSD_CW + ch0 + ch), w1 = *(const float4*)(cw + i * SSD_CW + ch0 + ch + 4);
            a[0] += w0.x * __uint_as_float(xv.x << 16); a[1] += w0.y * __uint_as_float(xv.x & 0xffff0000u); a[2] += w0.z * __uint_as_float(xv.y << 16); a[3] += w0.w * __uint_as_float(xv.y & 0xffff0000u);
            a[4] += w1.x * __uint_as_float(xv.z << 16); a[5] += w1.y * __uint_as_float(xv.z & 0xffff0000u); a[6] += w1.z * __uint_as_float(xv.w << 16); a[7] += w1.w * __uint_as_float(xv.w & 0xffff0000u); } }
        float sc = 1.f; if (SCALE) sc = scl[(ch >> 6) * 128 + l];
#pragma unroll
        for (int j = 0; j < 8; ++j) a[j] = a[j] / (1.f + __expf(-a[j])) * sc;
        fp::u32x4 o; o.x = fp::pk2(a[0], a[1]); o.y = fp::pk2(a[2], a[3]); o.z = fp::pk2(a[4], a[5]); o.w = fp::pk2(a[6], a[7]);
        *(LAS fp::u32x4*)(tile + l * pitch + ch * 2) = o; }
}
__device__ __forceinline__ void ssd_dt_acum(const bf16* PROJ, long r0, int g, const float* dt_bias, const float* a_log, LAS float* dtS, LAS float* acS, int tid, int wave, int lane) {
    if (tid < 384) { const int hh = tid >> 7, l = tid & 127, h = 3 * g + hh;
        const float dtv = softplus_f(ldf(PROJ + (r0 + l) * PLD + FDT + h) + dt_bias[h]); dtS[tid] = dtv; acS[tid] = dtv * (-__expf(a_log[h])); }
    __syncthreads();
    if (wave < 3) { const float a0 = acS[wave * 128 + 2 * lane], a1 = acS[wave * 128 + 2 * lane + 1]; const float sm = a0 + a1; float v = sm;
#pragma unroll
        for (int o = 1; o < 64; o <<= 1) { const float t = __shfl_up(v, o); if (lane >= o) v += t; }
        const float ex = v - sm; acS[wave * 128 + 2 * lane] = ex + a0; acS[wave * 128 + 2 * lane + 1] = ex + sm; }
    __syncthreads();
}
constexpr int XP = 400;
__device__ __forceinline__ void ssdA_unit(int b, int c, int g, const bf16* PROJ, const float* cw, const float* cb, const float* dt_bias, const float* a_log, float* ST, float* CD,
                                          LAS unsigned char* lds, int tid, int wave, int lane) {
    const long r0 = (long)b * SEQ + c * 128; const int t0 = c * 128;
    LAS unsigned char* XS = lds; LAS unsigned char* BS = lds + 51200;
    LAS float* dtS = (LAS float*)(lds + 86016); LAS float* acS = dtS + 384; LAS float* sclS = acS + 384;
    ssd_dt_acum(PROJ, r0, g, dt_bias, a_log, dtS, acS, tid, wave, lane);
    if (tid < 384) { const int hh = tid >> 7; const float al = acS[hh * 128 + 127]; sclS[tid] = dtS[tid] * __expf(al - acS[tid]);
        if ((tid & 127) == 0) CD[((long)b * 16 + c) * SSD_H + 3 * g + hh] = __expf(al); }
    __syncthreads();
    stage_conv<192, true>(PROJ, r0, t0, FXBC + 192 * g, 192 * g, cw, cb, XS, XP, sclS, tid);
    stage_conv<128, false>(PROJ, r0, t0, FXBC + SSD_W + 128 * g, SSD_W + 128 * g, cw, cb, BS, TLD, nullptr, tid);
    __syncthreads();
    f32x4_t acc[12];
#pragma unroll
    for (int i = 0; i < 12; ++i) acc[i] = (f32x4_t){0.f, 0.f, 0.f, 0.f};
#pragma unroll 1
    for (int ks = 0; ks < 4; ++ks) { const bf16x8_t bfv = lds_frag_tr(BS, TLD, ks * 32, 16 * wave, lane);
#pragma unroll
        for (int mt = 0; mt < 12; ++mt) { const bf16x8_t af = lds_frag_tr(XS, XP, ks * 32, (mt >> 2) * 64 + (mt & 3) * 16, lane); acc[mt] = __builtin_amdgcn_mfma_f32_16x16x32_bf16(af, bfv, acc[mt], 0, 0, 0); } }
    const int fr = lane & 15, fq = lane >> 4;
    float* sp = ST + (((long)b * 16 + c) * SSD_H + 3 * g) * 8192 + 16 * wave + fr;
#pragma unroll
    for (int mt = 0; mt < 12; ++mt)
#pragma unroll
        for (int r = 0; r < 4; ++r) sp[(mt >> 2) * 8192 + ((mt & 3) * 16 + 4 * fq + r) * 128] = acc[mt][r];
    __syncthreads();
}
__device__ __forceinline__ void ssdB_unit(int b, int c, int g, const bf16* PROJ, const float* cw, const float* cb, const float* dt_bias, const float* a_log, const float* dsk, const float* ng,
                                          const float* ST, const float* CD, bf16* MIXB, LAS unsigned char* lds, int tid, int wave, int lane) {
    const long r0 = (long)b * SEQ + c * 128; const int t0 = c * 128;
    LAS unsigned char* CS = lds; LAS unsigned char* PX = lds + 34816; LAS unsigned char* BG = lds + 87040;
    LAS float* dtS = (LAS float*)(lds + 121856); LAS float* acS = dtS + 384;
    const int fr = lane & 15, fq = lane >> 4;
    ssd_dt_acum(PROJ, r0, g, dt_bias, a_log, dtS, acS, tid, wave, lane);
    stage_conv<128, false>(PROJ, r0, t0, FXBC + SSD_W + 256 + 128 * g, SSD_W + 256 + 128 * g, cw, cb, CS, TLD, nullptr, tid);
    if (c > 0) {
        float4 pv[12];
#pragma unroll
        for (int i = 0; i < 12; ++i) pv[i] = make_float4(0.f, 0.f, 0.f, 0.f);
        const float* sbase = ST + ((long)b * 16 * SSD_H + 3 * g) * 8192 + tid * 4; const float* cbase = CD + (long)b * 16 * SSD_H + 3 * g;
        int j = 0;
        for (; j + 1 < c; j += 2) { const float* s0 = sbase + (long)j * SSD_H * 8192; const float* s1 = s0 + SSD_H * 8192; const float* c0 = cbase + j * SSD_H; const float* c1 = c0 + SSD_H;
            float4 v0[12], v1[12];
#pragma unroll
            for (int i = 0; i < 12; ++i) { v0[i] = *(const float4*)(s0 + i * 2048); v1[i] = *(const float4*)(s1 + i * 2048); }
            const float d00 = c0[0], d01 = c0[1], d02 = c0[2], d10 = c1[0], d11 = c1[1], d12 = c1[2];
#pragma unroll
            for (int i = 0; i < 12; ++i) { const float da = (i < 4) ? d00 : ((i < 8) ? d01 : d02), db = (i < 4) ? d10 : ((i < 8) ? d11 : d12);
                pv[i].x = (pv[i].x * da + v0[i].x) * db + v1[i].x; pv[i].y = (pv[i].y * da + v0[i].y) * db + v1[i].y; pv[i].z = (pv[i].z * da + v0[i].z) * db + v1[i].z; pv[i].w = (pv[i].w * da + v0[i].w) * db + v1[i].w; } }
        if (j < c) { const float* s0 = sbase + (long)j * SSD_H * 8192; const float* c0 = cbase + j * SSD_H; const float d0 = c0[0], d1 = c0[1], d2 = c0[2];
#pragma unroll
            for (int i = 0; i < 12; ++i) { const float4 sv = *(const float4*)(s0 + i * 2048); const float d = (i < 4) ? d0 : ((i < 8) ? d1 : d2);
                pv[i].x = pv[i].x * d + sv.x; pv[i].y = pv[i].y * d + sv.y; pv[i].z = pv[i].z * d + sv.z; pv[i].w = pv[i].w * d + sv.w; } }
#pragma unroll
        for (int i = 0; i < 12; ++i) { const int row = (i >> 2) * 64 + (i & 3) * 16 + (tid >> 5), n = (tid & 31) * 4;
            u32x2_t w; w.x = fp::pk2(pv[i].x, pv[i].y); w.y = fp::pk2(pv[i].z, pv[i].w); *(LAS u32x2_t*)(PX + row * TLD + n * 2) = w; }
    }
    __syncthreads();
    f32x4_t acc_y[12];
#pragma unroll
    for (int i = 0; i < 12; ++i) acc_y[i] = (f32x4_t){0.f, 0.f, 0.f, 0.f};
    if (c > 0) {
#pragma unroll 1
        for (int ks = 0; ks < 4; ++ks) { const bf16x8_t af = lds_frag_p(CS, TLD, 16 * wave + fr, ks * 64 + fq * 16);
#pragma unroll
            for (int t = 0; t < 12; ++t) { const bf16x8_t bfv = lds_frag_p(PX, TLD, (t >> 2) * 64 + (t & 3) * 16 + fr, ks * 64 + fq * 16); acc_y[t] = __builtin_amdgcn_mfma_f32_16x16x32_bf16(af, bfv, acc_y[t], 0, 0, 0); } }
#pragma unroll
        for (int t = 0; t < 12; ++t)
#pragma unroll
            for (int r = 0; r < 4; ++r) acc_y[t][r] *= __expf(acS[(t >> 2) * 128 + 16 * wave + 4 * fq + r]);
    }
    __syncthreads();
    stage_conv<192, false>(PROJ, r0, t0, FXBC + 192 * g, 192 * g, cw, cb, PX, XP, nullptr, tid);
    stage_conv<128, false>(PROJ, r0, t0, FXBC + SSD_W + 128 * g, SSD_W + 128 * g, cw, cb, BG, TLD, nullptr, tid);
    __syncthreads();
#if defined(SSDB_CUT) && SSDB_CUT == 2
    { float t_ = 0.f; for (int i = 0; i < 12; ++i) t_ += acc_y[i][0] + acc_y[i][1] + acc_y[i][2] + acc_y[i][3]; if (t_ == 123.f) MIXB[0] = 1; return; }
#endif
    f32x4_t acc_cb[8];
#pragma unroll
    for (int i = 0; i < 8; ++i) acc_cb[i] = (f32x4_t){0.f, 0.f, 0.f, 0.f};
#pragma unroll 1
    for (int ks = 0; ks < 4; ++ks) { const bf16x8_t af = lds_frag_p(CS, TLD, 16 * wave + fr, ks * 64 + fq * 16);
#pragma unroll
        for (int ns = 0; ns < 8; ++ns) if (ns <= wave) { const bf16x8_t bfv = lds_frag_p(BG, TLD, 16 * ns + fr, ks * 64 + fq * 16); acc_cb[ns] = __builtin_amdgcn_mfma_f32_16x16x32_bf16(af, bfv, acc_cb[ns], 0, 0, 0); } }
    __syncthreads();
    LAS unsigned char* GS = BG + wave * 16 * TLD;
    const int nks = (16 * wave + 15) / 32 + 1;
#pragma unroll
    for (int hh = 0; hh < 3; ++hh) {
#pragma unroll
        for (int ns = 0; ns < 8; ++ns) if (ns <= (wave | 1)) {
#pragma unroll
            for (int r = 0; r < 4; ++r) { const int l = 16 * wave + 4 * fq + r, sidx = 16 * ns + fr;
                const float gv = (ns <= wave && sidx <= l) ? acc_cb[ns][r] * __expf(acS[hh * 128 + l] - acS[hh * 128 + sidx]) * dtS[hh * 128 + sidx] : 0.f;
                *(LAS bf16*)(GS + (4 * fq + r) * TLD + sidx * 2) = (bf16)f2bf(gv); } }
        LDS_WAIT(); asm volatile("" ::: "memory");
#pragma unroll 1
        for (int ks = 0; ks < nks; ++ks) { const bf16x8_t af = lds_frag_p(GS, TLD, fr, ks * 64 + fq * 16);
#pragma unroll
            for (int np = 0; np < 4; ++np) { const bf16x8_t bfv = lds_frag_tr(PX, XP, ks * 32, hh * 64 + np * 16, lane); acc_y[hh * 4 + np] = __builtin_amdgcn_mfma_f32_16x16x32_bf16(af, bfv, acc_y[hh * 4 + np], 0, 0, 0); } }
        LDS_WAIT(); asm volatile("" ::: "memory");
    }
#if defined(SSDB_CUT) && SSDB_CUT == 1
    { float t_ = 0.f; for (int i = 0; i < 12; ++i) t_ += acc_y[i][0] + acc_y[i][1] + acc_y[i][2] + acc_y[i][3]; if (t_ == 123.f) MIXB[0] = 1; return; }
#endif
#pragma unroll
    for (int t = 0; t < 12; ++t) { const int hh = t >> 2, col = hh * 64 + (t & 3) * 16 + fr; const float dk = dsk[3 * g + hh];
#pragma unroll
        for (int r = 0; r < 4; ++r) { const int l = 16 * wave + 4 * fq + r; acc_y[t][r] += dk * __uint_as_float(((unsigned)*(const LAS bf16*)(PX + l * XP + col * 2)) << 16); } }
    __syncthreads();
    LAS bf16* ost = (LAS bf16*)(lds + wave * (16 * XP));
#pragma unroll
    for (int t = 0; t < 12; ++t) { const int col = (t >> 2) * 64 + (t & 3) * 16 + fr;
#pragma unroll
        for (int r = 0; r < 4; ++r) ost[(4 * fq + r) * (XP / 2) + col] = (bf16)f2bf(acc_y[t][r]); }
    LDS_WAIT(); asm volatile("" ::: "memory");
    { const int rr = lane >> 2, q = lane & 3; const long row = r0 + 16 * wave + rr;
      float yz[48]; float ssum = 0.f;
#pragma unroll
      for (int i = 0; i < 6; ++i) { const int c8 = (q * 6 + i) * 8;
          const fp::u32x4 yv = *(const LAS fp::u32x4*)(ost + rr * (XP / 2) + c8);
          const fp::u32x4 zv = *(const fp::u32x4*)(PROJ + row * PLD + FZ + 192 * g + c8);
#pragma unroll
          for (int j = 0; j < 4; ++j) { const unsigned yw = yv[j], zw = zv[j];
              const float y0 = __uint_as_float(yw << 16), y1 = __uint_as_float(yw & 0xffff0000u), z0 = __uint_as_float(zw << 16), z1 = __uint_as_float(zw & 0xffff0000u);
              const float a0 = y0 * (z0 / (1.f + __expf(-z0))), a1 = y1 * (z1 / (1.f + __expf(-z1))); yz[i * 8 + 2 * j] = a0; yz[i * 8 + 2 * j + 1] = a1; ssum += a0 * a0 + a1 * a1; } }
      ssum += __shfl_xor(ssum, 1); ssum += __shfl_xor(ssum, 2);
      const float rinv = rsqrtf(ssum * (1.f / 192.f) + 1e-5f);
#pragma unroll
      for (int i = 0; i < 6; ++i) { const int c8 = (q * 6 + i) * 8;
          const float4 g0 = *(const float4*)(ng + 192 * g + c8), g1 = *(const float4*)(ng + 192 * g + c8 + 4);
          fp::u32x4 o; o.x = fp::pk2(yz[i * 8] * rinv * g0.x, yz[i * 8 + 1] * rinv * g0.y); o.y = fp::pk2(yz[i * 8 + 2] * rinv * g0.z, yz[i * 8 + 3] * rinv * g0.w);
          o.z = fp::pk2(yz[i * 8 + 4] * rinv * g1.x, yz[i * 8 + 5] * rinv * g1.y); o.w = fp::pk2(yz[i * 8 + 6] * rinv * g1.z, yz[i * 8 + 7] * rinv * g1.w);
          *(fp::u32x4*)(MIXB + row * DM + ATT_W + 192 * g + c8) = o; } }
    __syncthreads();
}

__device__ __forceinline__ void att_norm_phase(bf16* MIXB, const float* g, long n_rows, int gw, int ngw, int lane) {
    for (long row = gw; row < n_rows; row += ngw) { bf16* p = MIXB + row * DM + lane * 8; float v[8]; float s2 = 0.f;
        if (lane < 48) { const fp::u32x4 w = *(const fp::u32x4*)p;
#pragma unroll
            for (int j = 0; j < 4; ++j) { v[2 * j] = __uint_as_float(w[j] << 16); v[2 * j + 1] = __uint_as_float(w[j] & 0xffff0000u); s2 += v[2 * j] * v[2 * j] + v[2 * j + 1] * v[2 * j + 1]; } }
        const float r = rsqrtf(wave_sum(s2) * (1.f / 384.f) + 1e-5f);
        if (lane < 48) { const float4 g0 = *(const float4*)(g + lane * 8), g1 = *(const float4*)(g + lane * 8 + 4);
            fp::u32x4 o; o.x = fp::pk2(v[0] * r * g0.x, v[1] * r * g0.y); o.y = fp::pk2(v[2] * r * g0.z, v[3] * r * g0.w); o.z = fp::pk2(v[4] * r * g1.x, v[5] * r * g1.y); o.w = fp::pk2(v[6] * r * g1.z, v[7] * r * g1.w);
            *(fp::u32x4*)p = o; } }
}

struct FArgs { const void* in[29]; float* out; unsigned char* ws; int ph_lo, ph_hi; };
__device__ __forceinline__ const void* ldarg(int k) { const void* p; asm volatile("s_load_dwordx2 %0, %1, %2\n\ts_waitcnt lgkmcnt(0)" : "=s"(p) : "s"(__builtin_amdgcn_kernarg_segment_ptr()), "i"(k * 8)); return p; }

constexpr int N_PHASES = 19;
__global__ void __launch_bounds__(512, 2) mega(FArgs a) {
    extern __shared__ __attribute__((aligned(16))) unsigned char lds_[];
    LAS unsigned char* lds = (LAS unsigned char*)lds_;
    const int tid = threadIdx.x, lane = tid & 63, wave = __builtin_amdgcn_readfirstlane(tid >> 6);
    const int G = gridDim.x; const int bx = blockIdx.x;
#define vcu (((int)gridDim.x % 8 == 0) ? ((int)blockIdx.x % 8) * ((int)gridDim.x / 8) + (int)blockIdx.x / 8 : (int)blockIdx.x)
#define gw (vcu * 8 + wave)
#define ngw ((int)gridDim.x * 8)
#define gt ((long)gw * 64 + lane)
#define ngt ((long)ngw * 64)
    unsigned char* ws = a.ws;
    unsigned* ctl = (unsigned*)(ws + O_CTL);
    for (int u = tid; u < (LDS_BYTES - RING_BYTES) / 4; u += 512) ((LAS unsigned*)(lds + RING_BYTES))[u] = 0u;
    __syncthreads();
    const int lo = a.ph_lo, hi = a.ph_hi;
    XcdBarrier bar; bar.bar = ctl + CW_BAR; bar.x = 0; bar.st = nullptr;
    if (hi - lo > 1) bar = xcd_barrier_post(ctl + CW_BAR, (volatile LAS unsigned*)(lds + MISC_OFF) + 8);
#define in_x ((const float*)ldarg(0))
#define in_pos ((const int*)ldarg(1))
#define ln_in_g ((const float*)ldarg(2))
#define ln_in_b ((const float*)ldarg(3))
#define w_in ((const float*)ldarg(4))
#define conv_w ((const float*)ldarg(5))
#define conv_b ((const float*)ldarg(6))
#define dt_bias ((const float*)ldarg(7))
#define a_log ((const float*)ldarg(8))
#define d_skip ((const float*)ldarg(9))
#define ssd_norm_g ((const float*)ldarg(10))
#define att_norm_g ((const float*)ldarg(11))
#define gm_ln_g ((const float*)ldarg(12))
#define gm_ln_b ((const float*)ldarg(13))
#define gm_w_s ((const float*)ldarg(14))
#define gm_b_s ((const float*)ldarg(15))
#define gm_norm_g ((const float*)ldarg(16))
#define w_out ((const float*)ldarg(17))
#define ln1_g ((const float*)ldarg(18))
#define ln1_b ((const float*)ldarg(19))
#define ln2_g ((const float*)ldarg(20))
#define ln2_b ((const float*)ldarg(21))
#define ffn_w_gate ((const float*)ldarg(22))
#define ffn_w_up ((const float*)ldarg(23))
#define ffn_w_down ((const float*)ldarg(24))
#define router_w ((const float*)ldarg(25))
#define moe_w_gate ((const float*)ldarg(26))
#define moe_w_up ((const float*)ldarg(27))
#define moe_w_down ((const float*)ldarg(28))
    float* H = a.out;
    float* RT = (float*)(ws + O_RT); int* TE = (int*)(ws + O_TE); float* TP = (float*)(ws + O_TP); int* TS = (int*)(ws + O_TS); int* GS = (int*)(ws + O_GS); float* SP = (float*)(ws + O_SP);
    float* KM = (float*)(ws + O_KM); float* DT = (float*)(ws + O_DT); bf16* WSB = (bf16*)(ws + O_WSB); bf16* HB = (bf16*)(ws + O_HB); bf16* MWGU = (bf16*)(ws + O_MWGU); bf16* MWD = (bf16*)(ws + O_MWGU);
    bf16* WIN = (bf16*)(ws + O_WIN); bf16* WOUT = (bf16*)(ws + O_WOUT); bf16* WGU = (bf16*)(ws + O_WGU); bf16* WD = (bf16*)(ws + O_WD);
    bf16* PROJ = (bf16*)(ws + O_PROJ); float* ST = (float*)(ws + O_XC); float* CD = (float*)(ws + O_DT); float* MIXU = (float*)(ws + O_MIXU); bf16* MIXB = (bf16*)(ws + O_MIXB); float* VN = (float*)(ws + O_VN);
    float* Y = (float*)(ws + O_Y); bf16* ACT = (bf16*)(ws + O_ACT); bf16* XG = (bf16*)(ws + O_XG); bf16* F2 = (bf16*)(ws + O_XG); bf16* ACTM = (bf16*)(ws + O_ACTM);
    int* CNT = (int*)(ctl + CW_CNT);
    const ProjL FL{PLD, FQ, FK, FV, FZ, FXBC, FDT, FGU, FGV};
    LAS float* scr = (LAS float*)(lds + wave * 16384);

#ifndef PH_MASK
#define PH_MASK 0xffffffffu
#endif
#ifndef PROBE_MASK
#define PROBE_MASK 0u
#endif
#ifndef PROBE_AMP
#define PROBE_AMP 0
#endif
    volatile unsigned* pr_w = (volatile unsigned*)(ctl + 1100);
#define pr_me ((PROBE_MASK != 0u) && blockIdx.x == 0 && wave == 0 && __builtin_amdgcn_mbcnt_hi(~0u, __builtin_amdgcn_mbcnt_lo(~0u, 0u)) == 0u)
#define PH_BEGIN(k) if (lo <= (k) && (k) < hi && ((PH_MASK >> (k)) & 1u)) { if (((PROBE_MASK >> (k)) & 1u) && pr_me) pr_w[0] = (unsigned)__builtin_amdgcn_s_memrealtime();
#define PH_END(k)   if ((k) + 1 < hi) xcd_barrier(bar); if (((PROBE_MASK >> (k)) & 1u) && pr_me) pr_w[1] += (unsigned)__builtin_amdgcn_s_memrealtime() - pr_w[0]; }

    PH_BEGIN(0)
    { const float* const p_w_in = w_in; const float* const p_w_out = w_out; const float* const p_fg = ffn_w_gate; const float* const p_fu = ffn_w_up; const float* const p_fd = ffn_w_down; const float* const p_mg = moe_w_gate; const float* const p_mu = moe_w_up;
        constexpr int I_WIN = 16 * (PLD / 32), I_WOUT = 16 * (DM / 32), I_WGU = 16 * (NGU / 32), I_WD = (D_FF / 64) * (DM / 32), I_MWGU = 16 * (N_EXP * NGUE / 32);
        constexpr int NIT = 2 * I_WIN + 2 * I_WOUT + I_WGU + I_WD + I_MWGU;
        for (int it = gw; it < NIT; it += ngw) {
            int r = it; const int l5 = lane & 31;
            if (r < 2 * I_WIN) { const int L = r / I_WIN; r -= L * I_WIN; const int kb = r / (PLD / 32), db = r % (PLD / 32); const int sc_ = fp::win_src_col(db * 32 + l5);
                fp::SrcCol s; s.p = sc_ >= 0 ? p_w_in + (size_t)L * DM * D_IN + sc_ : nullptr; s.ld = D_IN; fp::conv_item(s, DM, WIN + (size_t)L * PLD * DM, db * 32, kb * 64, scr, lane); continue; } r -= 2 * I_WIN;
            if (r < 2 * I_WOUT) { const int L = r / I_WOUT; r -= L * I_WOUT; const int kb = r / (DM / 32), db = r % (DM / 32);
                fp::SrcCol s; s.p = p_w_out + (size_t)L * DM * DM + db * 32 + l5; s.ld = DM; fp::conv_item(s, DM, WOUT + (size_t)L * DM * DM, db * 32, kb * 64, scr, lane); continue; } r -= 2 * I_WOUT;
            if (r < I_WGU) { const int kb = r / (NGU / 32), db = r % (NGU / 32);
                fp::conv_item(fp::gu_src(p_fg, p_fu, D_FF, db * 32 + l5), DM, WGU, db * 32, kb * 64, scr, lane); continue; } r -= I_WGU;
            if (r < I_WD) { const int kb = r / (DM / 32), db = r % (DM / 32);
                fp::SrcCol s; s.p = p_fd + db * 32 + l5; s.ld = DM; fp::conv_item(s, D_FF, WD, db * 32, kb * 64, scr, lane); continue; } r -= I_WD;
            { const int kb = r / (N_EXP * NGUE / 32), db = r % (N_EXP * NGUE / 32); const int d = db * 32 + l5, e = d / NGUE;
                fp::conv_item(fp::gu_src(p_mg + (size_t)e * DM * D_FFE, p_mu + (size_t)e * DM * D_FFE, D_FFE, d - e * NGUE), DM, MWGU, (long)db * 32, kb * 64, scr, lane); }
        }
        const int* const p_pos = in_pos; const float* const p_gws = gm_w_s; const float* const p_x = in_x; const float* const p_lg = ln_in_g; const float* const p_lb = ln_in_b;
        for (long it = gt; it < (long)M_ * 8; it += ngt) { const int i = (int)(it & 7); const long row = it >> 3;
            const float inv = powf(500000.0f, -(float)(2 * i) / 16.0f); const float ang = (float)p_pos[row] * inv; RT[row * 16 + i] = cosf(ang); RT[row * 16 + 8 + i] = sinf(ang); }
        for (long it = gt; it < 2L * GM_G * GM_CHUNK * GM_CHUNK; it += ngt) { const int sidx = (int)(it & 127), t = (int)((it >> 7) & 127); WSB[it] = (bf16)(sidx <= t ? f2bf(p_gws[it]) : 0u); }
        { float va[16], vb[16]; long r = gw; if (r < M_) ln_load<float>(va, p_x + r * DM, 1.f, nullptr, nullptr, lane);
          for (; r < M_; r += 2 * ngw) { const long r1 = r + ngw, r2 = r + 2 * ngw;
              if (r1 < M_) ln_load<float>(vb, p_x + r1 * DM, 1.f, nullptr, nullptr, lane);
              ln_finish(va, p_lg, p_lb, H + r * DM, HB + r * DM, lane);
              if (r2 < M_) ln_load<float>(va, p_x + r2 * DM, 1.f, nullptr, nullptr, lane);
              if (r1 < M_) ln_finish(vb, p_lg, p_lb, H + r1 * DM, HB + r1 * DM, lane); } }
    }
    PH_END(0)


    { constexpr int layer = 0; constexpr int PB = 1;
        PH_BEGIN(PB + 0)
        { pg8::Gemm g{HB, WIN + (size_t)layer * PLD * DM, M_, PLD, DM}; pg8::StaticOrder S; S.init(M_, PLD, G, bx);
          fp::EpiProj E{PROJ, RT, KM}; pg8::gemm_phase<fp::EpiProj, pg8::StaticOrder, true, true>(lds, g, S, E); }
        PH_END(PB + 0)
        PH_BEGIN(PB + 1)
        { constexpr int NATT = NB * ATT_H * NBLK, NSSDA = NB * 32;
          volatile LAS unsigned* qw = (volatile LAS unsigned*)(lds + MISC_OFF) + 16;
#define QNEXT(word) do { if (tid == 0) qw[0] = __hip_atomic_fetch_add(ctl + (word), 1u, __ATOMIC_RELAXED, __HIP_MEMORY_SCOPE_AGENT); __syncthreads(); idx = (int)qw[0]; __syncthreads(); } while (0)
          int idx;
          for (;;) { QNEXT(CW_Q + 8 * layer); if (idx >= NATT) break;
              const int qb = (NBLK - 1) - idx / (NB * ATT_H), bh = idx % (NB * ATT_H);
              attn_body::attn_unit<8>(bh / ATT_H, bh % ATT_H, qb, (const attn_body::bf16*)(PROJ + FQ), (const attn_body::bf16*)(PROJ + FK), (const attn_body::bf16*)(PROJ + FV), (attn_body::bf16*)MIXB, KM, NB * ATT_H * NBLK * 64, (char*)lds_); }
          for (;;) { QNEXT(CW_Q + 8 * layer + 1); if (idx >= NSSDA) break;
              ssdA_unit(idx >> 5, (idx >> 1) & 15, idx & 1, PROJ, conv_w + (size_t)layer * 4 * SSD_CW, conv_b + layer * SSD_CW, dt_bias + layer * SSD_H, a_log + layer * SSD_H, ST, CD, lds, tid, wave, lane); }
        }
        PH_END(PB + 1)
        PH_BEGIN(PB + 2)
        { constexpr int NSSDB = NB * 32, NGMU = NB * (SEQ / GM_CHUNK);
          volatile LAS unsigned* qw = (volatile LAS unsigned*)(lds + MISC_OFF) + 16;
          int idx;
          for (;;) { QNEXT(CW_Q + 8 * layer + 2); if (idx >= NSSDB) break;
              const int c = 15 - idx / (NB * 2), bg = idx % (NB * 2);
              ssdB_unit(bg >> 1, c, bg & 1, PROJ, conv_w + (size_t)layer * 4 * SSD_CW, conv_b + layer * SSD_CW, dt_bias + layer * SSD_H, a_log + layer * SSD_H, d_skip + layer * SSD_H,
                        ssd_norm_g + layer * SSD_W, ST, CD, MIXB, lds, tid, wave, lane); }
          for (;;) { QNEXT(CW_Q + 8 * layer + 3); if (idx >= NGMU) break;
              gm_unit(idx / (SEQ / GM_CHUNK), idx % (SEQ / GM_CHUNK), PROJ, WSB + (size_t)layer * GM_G * GM_CHUNK * GM_CHUNK, gm_ln_g + layer * GM_W, gm_ln_b + layer * GM_W,
                      gm_b_s + layer * GM_G * GM_CHUNK, gm_norm_g + layer * GM_W, MIXB, lds, wave, lane); }
#undef QNEXT
          att_norm_phase(MIXB, att_norm_g + layer * ATT_W, M_, gw, ngw, lane);
        }
        PH_END(PB + 2)
        PH_BEGIN(PB + 3)
        { pg8::Gemm g{MIXB, WOUT + (size_t)layer * DM * DM, M_, DM, DM}; pg8::StaticOrder S; S.init(M_, DM, G, bx);
          fp::EpiF32 E{Y, DM}; pg8::gemm_phase<fp::EpiF32, pg8::StaticOrder, false, true>(lds, g, S, E); }
        PH_END(PB + 3)
        PH_BEGIN(PB + 4)
        { const float* const p_g = ln1_g + layer * DM; const float* const p_b = ln1_b + layer * DM;
          { float va[16], vb[16]; long r = gw; if (r < M_) ln_load<float>(va, H + r * DM, ALPHA, Y + r * DM, nullptr, lane);
            for (; r < M_; r += 2 * ngw) { const long r1 = r + ngw, r2 = r + 2 * ngw;
                if (r1 < M_) ln_load<float>(vb, H + r1 * DM, ALPHA, Y + r1 * DM, nullptr, lane);
                ln_finish(va, p_g, p_b, H + r * DM, HB + r * DM, lane);
                if (r2 < M_) ln_load<float>(va, H + r2 * DM, ALPHA, Y + r2 * DM, nullptr, lane);
                if (r1 < M_) ln_finish(vb, p_g, p_b, H + r1 * DM, HB + r1 * DM, lane); } }
          if (layer == 1) { asm volatile("s_waitcnt vmcnt(0)" ::: "memory"); moe_route_phase(H, router_w, CNT, TE, TP, TS, M_, gw, ngw, lane); } }
        PH_END(PB + 4)
        if constexpr (layer == 0) {
            PH_BEGIN(PB + 5)
            { pg8::Gemm g{HB, WGU, M_, NGU, DM}; pg8::StaticOrder S; S.init(M_, NGU, G, bx);
              fp::EpiAct E{ACT, D_FF, NGU / 256}; pg8::gemm_phase<fp::EpiAct, pg8::StaticOrder, true, true>(lds, g, S, E); }
            PH_END(PB + 5)
            PH_BEGIN(PB + 6)
            { pg8::Gemm g{ACT, WD, M_, DM, D_FF}; pg8::StaticOrder S; S.init(M_, DM, G, bx);
              fp::EpiF32 E{Y, DM}; pg8::gemm_phase<fp::EpiF32, pg8::StaticOrder, false, true>(lds, g, S, E); }
            PH_END(PB + 6)
            PH_BEGIN(PB + 7)
            { const float* const p_g = ln2_g + layer * DM; const float* const p_b = ln2_b + layer * DM;
              { float va[16], vb[16]; long r = gw; if (r < M_) ln_load<float>(va, H + r * DM, ALPHA, Y + r * DM, nullptr, lane);
            for (; r < M_; r += 2 * ngw) { const long r1 = r + ngw, r2 = r + 2 * ngw;
                if (r1 < M_) ln_load<float>(vb, H + r1 * DM, ALPHA, Y + r1 * DM, nullptr, lane);
                ln_finish(va, p_g, p_b, H + r * DM, HB + r * DM, lane);
                if (r2 < M_) ln_load<float>(va, H + r2 * DM, ALPHA, Y + r2 * DM, nullptr, lane);
                if (r1 < M_) ln_finish(vb, p_g, p_b, H + r1 * DM, HB + r1 * DM, lane); } } }
            PH_END(PB + 7)
        } else {
            PH_BEGIN(PB + 5)
            { for (long it = gw; it < (long)M_ * 2; it += ngw) { const int e = TE[it]; const int gs = moe_base(CNT, e) + TS[it];
                  if (lane == 0) { SP[gs] = TP[it]; GS[it] = gs; }
                  const uint4* src = (const uint4*)(HB + (it >> 1) * DM); uint4* dst = (uint4*)(XG + (size_t)gs * DM); dst[lane] = src[lane]; dst[lane + 64] = src[lane + 64]; }
              for (int it = gw; it < N_EXP * 256; it += ngw) { const int e = it >> 8, r = it & 255; const int c = CNT[e]; const int slot = moe_base(CNT, e) + c + r;
                  if (c + r < ((c + 255) & ~255)) { uint4* dst = (uint4*)(XG + (size_t)slot * DM); const uint4 z = make_uint4(0u, 0u, 0u, 0u); dst[lane] = z; dst[lane + 64] = z; if (lane == 0) SP[slot] = 0.f; } } }
            PH_END(PB + 5)
            PH_BEGIN(PB + 6)
            { pg8::Gemm g{XG, MWGU, NSLOT, N_EXP * NGUE, DM}; fp::MoeOrder S; S.init(CNT, NGUE / 256, G, bx);
              fp::EpiAct E{ACTM, D_FFE, NGUE / 256}; pg8::gemm_phase<fp::EpiAct, fp::MoeOrder, true, true>(lds, g, S, E); }
            PH_END(PB + 6)
            PH_BEGIN(PB + 7)
            { constexpr int I_MWD = (D_FFE / 64) * (N_EXP * DM / 32); const float* const p_md = moe_w_down;
              for (int it = gw; it < I_MWD; it += ngw) { const int kb = it / (N_EXP * DM / 32), db = it % (N_EXP * DM / 32); const int d = db * 32 + (lane & 31), e = d / DM;
                  fp::SrcCol s; s.p = p_md + (size_t)e * D_FFE * DM + (d - e * DM); s.ld = DM; fp::conv_item(s, D_FFE, MWD, (long)db * 32, kb * 64, scr, lane); } }
            PH_END(PB + 7)
            PH_BEGIN(PB + 8)
            { pg8::Gemm g{ACTM, MWD, NSLOT, N_EXP * DM, D_FFE}; fp::MoeOrder S; S.init(CNT, DM / 256, G, bx);
              fp::EpiF2 E{F2, SP}; pg8::gemm_phase<fp::EpiF2, fp::MoeOrder, true, true>(lds, g, S, E); }
            PH_END(PB + 8)
            PH_BEGIN(PB + 9)
            { const float* const p_g = ln2_g + layer * DM; const float* const p_b = ln2_b + layer * DM;
              { float va[16], vb[16]; long r = gw; if (r < M_) ln_load<bf16>(va, H + r * DM, ALPHA, F2 + (size_t)GS[r * 2] * DM, F2 + (size_t)GS[r * 2 + 1] * DM, lane);
                for (; r < M_; r += 2 * ngw) { const long r1 = r + ngw, r2 = r + 2 * ngw;
                    if (r1 < M_) ln_load<bf16>(vb, H + r1 * DM, ALPHA, F2 + (size_t)GS[r1 * 2] * DM, F2 + (size_t)GS[r1 * 2 + 1] * DM, lane);
                    ln_finish(va, p_g, p_b, H + r * DM, nullptr, lane);
                    if (r2 < M_) ln_load<bf16>(va, H + r2 * DM, ALPHA, F2 + (size_t)GS[r2 * 2] * DM, F2 + (size_t)GS[r2 * 2 + 1] * DM, lane);
                    if (r1 < M_) ln_finish(vb, p_g, p_b, H + r1 * DM, nullptr, lane); } } }
            PH_END(PB + 9)
        }
    }

    { constexpr int layer = 1; constexpr int PB = 9;
        PH_BEGIN(PB + 0)
        { pg8::Gemm g{HB, WIN + (size_t)layer * PLD * DM, M_, PLD, DM}; pg8::StaticOrder S; S.init(M_, PLD, G, bx);
          fp::EpiProj E{PROJ, RT, KM}; pg8::gemm_phase<fp::EpiProj, pg8::StaticOrder, true, true>(lds, g, S, E); }
        PH_END(PB + 0)
        PH_BEGIN(PB + 1)
        { constexpr int NATT = NB * ATT_H * NBLK, NSSDA = NB * 32;
          volatile LAS unsigned* qw = (volatile LAS unsigned*)(lds + MISC_OFF) + 16;
#define QNEXT(word) do { if (tid == 0) qw[0] = __hip_atomic_fetch_add(ctl + (word), 1u, __ATOMIC_RELAXED, __HIP_MEMORY_SCOPE_AGENT); __syncthreads(); idx = (int)qw[0]; __syncthreads(); } while (0)
          int idx;
          for (;;) { QNEXT(CW_Q + 8 * layer); if (idx >= NATT) break;
              const int qb = (NBLK - 1) - idx / (NB * ATT_H), bh = idx % (NB * ATT_H);
              attn_body::attn_unit<8>(bh / ATT_H, bh % ATT_H, qb, (const attn_body::bf16*)(PROJ + FQ), (const attn_body::bf16*)(PROJ + FK), (const attn_body::bf16*)(PROJ + FV), (attn_body::bf16*)MIXB, KM, NB * ATT_H * NBLK * 64, (char*)lds_); }
          for (;;) { QNEXT(CW_Q + 8 * layer + 1); if (idx >= NSSDA) break;
              ssdA_unit(idx >> 5, (idx >> 1) & 15, idx & 1, PROJ, conv_w + (size_t)layer * 4 * SSD_CW, conv_b + layer * SSD_CW, dt_bias + layer * SSD_H, a_log + layer * SSD_H, ST, CD, lds, tid, wave, lane); }
        }
        PH_END(PB + 1)
        PH_BEGIN(PB + 2)
        { constexpr int NSSDB = NB * 32, NGMU = NB * (SEQ / GM_CHUNK);
          volatile LAS unsigned* qw = (volatile LAS unsigned*)(lds + MISC_OFF) + 16;
          int idx;
          for (;;) { QNEXT(CW_Q + 8 * layer + 2); if (idx >= NSSDB) break;
              const int c = 15 - idx / (NB * 2), bg = idx % (NB * 2);
              ssdB_unit(bg >> 1, c, bg & 1, PROJ, conv_w + (size_t)layer * 4 * SSD_CW, conv_b + layer * SSD_CW, dt_bias + layer * SSD_H, a_log + layer * SSD_H, d_skip + layer * SSD_H,
                        ssd_norm_g + layer * SSD_W, ST, CD, MIXB, lds, tid, wave, lane); }
          for (;;) { QNEXT(CW_Q + 8 * layer + 3); if (idx >= NGMU) break;
              gm_unit(idx / (SEQ / GM_CHUNK), idx % (SEQ / GM_CHUNK), PROJ, WSB + (size_t)layer * GM_G * GM_CHUNK * GM_CHUNK, gm_ln_g + layer * GM_W, gm_ln_b + layer * GM_W,
                      gm_b_s + layer * GM_G * GM_CHUNK, gm_norm_g + layer * GM_W, MIXB, lds, wave, lane); }
#undef QNEXT
          att_norm_phase(MIXB, att_norm_g + layer * ATT_W, M_, gw, ngw, lane);
        }
        PH_END(PB + 2)
        PH_BEGIN(PB + 3)
        { pg8::Gemm g{MIXB, WOUT + (size_t)layer * DM * DM, M_, DM, DM}; pg8::StaticOrder S; S.init(M_, DM, G, bx);
          fp::EpiF32 E{Y, DM}; pg8::gemm_phase<fp::EpiF32, pg8::StaticOrder, false, true>(lds, g, S, E); }
        PH_END(PB + 3)
        PH_BEGIN(PB + 4)
        { const float* const p_g = ln1_g + layer * DM; const float* const p_b = ln1_b + layer * DM;
          { float va[16], vb[16]; long r = gw; if (r < M_) ln_load<float>(va, H + r * DM, ALPHA, Y + r * DM, nullptr, lane);
            for (; r < M_; r += 2 * ngw) { const long r1 = r + ngw, r2 = r + 2 * ngw;
                if (r1 < M_) ln_load<float>(vb, H + r1 * DM, ALPHA, Y + r1 * DM, nullptr, lane);
                ln_finish(va, p_g, p_b, H + r * DM, HB + r * DM, lane);
                if (r2 < M_) ln_load<float>(va, H + r2 * DM, ALPHA, Y + r2 * DM, nullptr, lane);
                if (r1 < M_) ln_finish(vb, p_g, p_b, H + r1 * DM, HB + r1 * DM, lane); } }
          if (layer == 1) { asm volatile("s_waitcnt vmcnt(0)" ::: "memory"); moe_route_phase(H, router_w, CNT, TE, TP, TS, M_, gw, ngw, lane); } }
        PH_END(PB + 4)
        if constexpr (layer == 0) {
            PH_BEGIN(PB + 5)
            { pg8::Gemm g{HB, WGU, M_, NGU, DM}; pg8::StaticOrder S; S.init(M_, NGU, G, bx);
              fp::EpiAct E{ACT, D_FF, NGU / 256}; pg8::gemm_phase<fp::EpiAct, pg8::StaticOrder, true, true>(lds, g, S, E); }
            PH_END(PB + 5)
            PH_BEGIN(PB + 6)
            { pg8::Gemm g{ACT, WD, M_, DM, D_FF}; pg8::StaticOrder S; S.init(M_, DM, G, bx);
              fp::EpiF32 E{Y, DM}; pg8::gemm_phase<fp::EpiF32, pg8::StaticOrder, false, true>(lds, g, S, E); }
            PH_END(PB + 6)
            PH_BEGIN(PB + 7)
            { const float* const p_g = ln2_g + layer * DM; const float* const p_b = ln2_b + layer * DM;
              { float va[16], vb[16]; long r = gw; if (r < M_) ln_load<float>(va, H + r * DM, ALPHA, Y + r * DM, nullptr, lane);
            for (; r < M_; r += 2 * ngw) { const long r1 = r + ngw, r2 = r + 2 * ngw;
                if (r1 < M_) ln_load<float>(vb, H + r1 * DM, ALPHA, Y + r1 * DM, nullptr, lane);
                ln_finish(va, p_g, p_b, H + r * DM, HB + r * DM, lane);
                if (r2 < M_) ln_load<float>(va, H + r2 * DM, ALPHA, Y + r2 * DM, nullptr, lane);
                if (r1 < M_) ln_finish(vb, p_g, p_b, H + r1 * DM, HB + r1 * DM, lane); } } }
            PH_END(PB + 7)
        } else {
            PH_BEGIN(PB + 5)
            { for (long it = gw; it < (long)M_ * 2; it += ngw) { const int e = TE[it]; const int gs = moe_base(CNT, e) + TS[it];
                  if (lane == 0) { SP[gs] = TP[it]; GS[it] = gs; }
                  const uint4* src = (const uint4*)(HB + (it >> 1) * DM); uint4* dst = (uint4*)(XG + (size_t)gs * DM); dst[lane] = src[lane]; dst[lane + 64] = src[lane + 64]; }
              for (int it = gw; it < N_EXP * 256; it += ngw) { const int e = it >> 8, r = it & 255; const int c = CNT[e]; const int slot = moe_base(CNT, e) + c + r;
                  if (c + r < ((c + 255) & ~255)) { uint4* dst = (uint4*)(XG + (size_t)slot * DM); const uint4 z = make_uint4(0u, 0u, 0u, 0u); dst[lane] = z; dst[lane + 64] = z; if (lane == 0) SP[slot] = 0.f; } } }
            PH_END(PB + 5)
            PH_BEGIN(PB + 6)
            { pg8::Gemm g{XG, MWGU, NSLOT, N_EXP * NGUE, DM}; fp::MoeOrder S; S.init(CNT, NGUE / 256, G, bx);
              fp::EpiAct E{ACTM, D_FFE, NGUE / 256}; pg8::gemm_phase<fp::EpiAct, fp::MoeOrder, true, true>(lds, g, S, E); }
            PH_END(PB + 6)
            PH_BEGIN(PB + 7)
            { constexpr int I_MWD = (D_FFE / 64) * (N_EXP * DM / 32); const float* const p_md = moe_w_down;
              for (int it = gw; it < I_MWD; it += ngw) { const int kb = it / (N_EXP * DM / 32), db = it % (N_EXP * DM / 32); const int d = db * 32 + (lane & 31), e = d / DM;
                  fp::SrcCol s; s.p = p_md + (size_t)e * D_FFE * DM + (d - e * DM); s.ld = DM; fp::conv_item(s, D_FFE, MWD, (long)db * 32, kb * 64, scr, lane); } }
            PH_END(PB + 7)
            PH_BEGIN(PB + 8)
            { pg8::Gemm g{ACTM, MWD, NSLOT, N_EXP * DM, D_FFE}; fp::MoeOrder S; S.init(CNT, DM / 256, G, bx);
              fp::EpiF2 E{F2, SP}; pg8::gemm_phase<fp::EpiF2, fp::MoeOrder, true, true>(lds, g, S, E); }
            PH_END(PB + 8)
            PH_BEGIN(PB + 9)
            { const float* const p_g = ln2_g + layer * DM; const float* const p_b = ln2_b + layer * DM;
              { float va[16], vb[16]; long r = gw; if (r < M_) ln_load<bf16>(va, H + r * DM, ALPHA, F2 + (size_t)GS[r * 2] * DM, F2 + (size_t)GS[r * 2 + 1] * DM, lane);
                for (; r < M_; r += 2 * ngw) { const long r1 = r + ngw, r2 = r + 2 * ngw;
                    if (r1 < M_) ln_load<bf16>(vb, H + r1 * DM, ALPHA, F2 + (size_t)GS[r1 * 2] * DM, F2 + (size_t)GS[r1 * 2 + 1] * DM, lane);
                    ln_finish(va, p_g, p_b, H + r * DM, nullptr, lane);
                    if (r2 < M_) ln_load<bf16>(va, H + r2 * DM, ALPHA, F2 + (size_t)GS[r2 * 2] * DM, F2 + (size_t)GS[r2 * 2 + 1] * DM, lane);
                    if (r1 < M_) ln_finish(vb, p_g, p_b, H + r1 * DM, nullptr, lane); } } }
            PH_END(PB + 9)
        }
    }

#undef PH_BEGIN
#undef PH_END
#undef in_x
#undef in_pos
#undef ln_in_g
#undef ln_in_b
#undef w_in
#undef conv_w
#undef conv_b
#undef dt_bias
#undef a_log
#undef d_skip
#undef ssd_norm_g
#undef att_norm_g
#undef gm_ln_g
#undef gm_ln_b
#undef gm_w_s
#undef gm_b_s
#undef gm_norm_g
#undef w_out
#undef ln1_g
#undef ln1_b
#undef ln2_g
#undef ln2_b
#undef ffn_w_gate
#undef ffn_w_up
#undef ffn_w_down
#undef router_w
#undef moe_w_gate
#undef moe_w_up
#undef moe_w_down
#undef vcu
#undef gw
#undef ngw
#undef gt
#undef ngt
    if (pr_me) { const unsigned t_beg = (unsigned)__builtin_amdgcn_s_memrealtime(), t_len = (unsigned)PROBE_AMP * pr_w[1]; while ((unsigned)__builtin_amdgcn_s_memrealtime() - t_beg < t_len) __builtin_amdgcn_s_sleep(8); }
}

__device__ __forceinline__ void blk_acc(float d2, float s2, float* err) {
    d2 = wave_sum(d2); s2 = wave_sum(s2); if ((threadIdx.x & 63) == 0) { atomicAdd(err, d2); atomicAdd(err + 1, s2); }
}
__global__ void k_cmp_proj(const bf16* F, const float* S, long rows, float* err) {
    float d2 = 0.f, s2 = 0.f;
    for (long it = blockIdx.x * (long)blockDim.x + threadIdx.x; it < rows * 2950; it += gridDim.x * (long)blockDim.x) {
        const long row = it / 2950; const int d = (int)(it % 2950); const int sc = fp::win_src_col(d);
        float s = S[row * D_IN + sc]; if (d >= FGU && d < FXBC) s = gelu_tanh_f(s);
        const float f = ldf(F + row * PLD + d); d2 += (f - s) * (f - s); s2 += s * s; }
    blk_acc(d2, s2, err);
}
template <class TF> __global__ void k_cmp(const TF* F, int ldf_, const float* S, int lds_, long rows, int cols, float* err) {
    float d2 = 0.f, s2 = 0.f;
    for (long it = blockIdx.x * (long)blockDim.x + threadIdx.x; it < rows * cols; it += gridDim.x * (long)blockDim.x) {
        const long row = it / cols; const int c = (int)(it % cols); const float f = ldf(F + row * ldf_ + c), s = S[row * lds_ + c]; d2 += (f - s) * (f - s); s2 += s * s; }
    blk_acc(d2, s2, err);
}
__global__ void k_encode(const float* err, int nck, const float* Sout, float* out, long rows_s, long rows_all, float thr) {
    int k = 0; for (int i = 0; i < nck; ++i) { const float r = err[2 * i] / fmaxf(err[2 * i + 1], 1e-30f); if (!(r <= thr)) { k = i + 1; break; } }
    for (long it = blockIdx.x * (long)blockDim.x + threadIdx.x; it < rows_all * DM; it += gridDim.x * (long)blockDim.x)
        out[it] = (it < rows_s * DM) ? Sout[it] * (1.f + (float)k) : 0.f;
}
#if DEBUG_BUILD
constexpr size_t S_BASE = (WS_END + 2 * MiB - 1) / MiB * MiB;
#endif
extern "C" void kernel_launch(void* const* d_in, const int* in_sizes, int n_in, void* d_out, int out_size, void* d_ws, size_t ws_size, hipStream_t stream) {
    (void)in_sizes; (void)n_in; (void)out_size;
    static int grid = 0;
    if (grid == 0) {
        int dev = 0, cus = 0, per_cu = 0;
        if (hipGetDevice(&dev) != hipSuccess || hipDeviceGetAttribute(&cus, hipDeviceAttributeMultiprocessorCount, dev) != hipSuccess) { grid = -1; return; }
        if (hipFuncSetAttribute((const void*)mega, hipFuncAttributeMaxDynamicSharedMemorySize, LDS_BYTES) != hipSuccess) { fprintf(stderr, "kernel_launch: hipFuncSetAttribute failed\n"); grid = -1; return; }
        if (hipOccupancyMaxActiveBlocksPerMultiprocessor(&per_cu, (const void*)mega, 512, LDS_BYTES) != hipSuccess || per_cu < 1) fprintf(stderr, "kernel_launch: occupancy query reports %d\n", per_cu);
        (void)hipGetLastError();
        grid = cus;
        if (ws_size < WS_END) { fprintf(stderr, "kernel_launch: workspace too small: %zu < %zu\n", ws_size, (size_t)WS_END); grid = -1; }
    }
    if (grid < 0) return;
    unsigned char* ws = (unsigned char*)d_ws;
    if (hipMemsetAsync(ws + O_CTL, 0, CTL_BYTES, stream) != hipSuccess) return;
    FArgs a{};
    for (int i = 0; i < 29; ++i) a.in[i] = d_in[i];
    a.out = (float*)d_out; a.ws = ws;
#if !DEBUG_BUILD
    a.ph_lo = 0; a.ph_hi = N_PHASES;
    hipLaunchKernelGGL(mega, dim3(grid), dim3(512), LDS_BYTES, stream, a);
#else
    Inputs I;
    I.x = (const float*)d_in[0]; I.pos = (const int*)d_in[1]; I.ln_in_g = (const float*)d_in[2]; I.ln_in_b = (const float*)d_in[3]; I.w_in = (const float*)d_in[4];
    I.conv_w = (const float*)d_in[5]; I.conv_b = (const float*)d_in[6]; I.dt_bias = (const float*)d_in[7]; I.a_log = (const float*)d_in[8]; I.d_skip = (const float*)d_in[9];
    I.ssd_norm_g = (const float*)d_in[10]; I.att_norm_g = (const float*)d_in[11]; I.gm_ln_g = (const float*)d_in[12]; I.gm_ln_b = (const float*)d_in[13]; I.gm_w_s = (const float*)d_in[14];
    I.gm_b_s = (const float*)d_in[15]; I.gm_norm_g = (const float*)d_in[16]; I.w_out = (const float*)d_in[17]; I.ln1_g = (const float*)d_in[18]; I.ln1_b = (const float*)d_in[19];
    I.ln2_g = (const float*)d_in[20]; I.ln2_b = (const float*)d_in[21]; I.ffn_w_gate = (const float*)d_in[22]; I.ffn_w_up = (const float*)d_in[23]; I.ffn_w_down = (const float*)d_in[24];
    I.router_w = (const float*)d_in[25]; I.moe_w_gate = (const float*)d_in[26]; I.moe_w_up = (const float*)d_in[27]; I.moe_w_down = (const float*)d_in[28];
    const long MS = SEQ;
    unsigned char* sws = ws + S_BASE;
    float* saux = (float*)(sws + 96 * MiB); float* sout = (float*)(sws + 100 * MiB); float* ckpt = (float*)(sws + 110 * MiB);
    const size_t ck_stride = (size_t)MS * (D_IN + 3 * DM);
    run_simple(I, 1, sws, saux, sout, stream, ckpt);
    float* err = (float*)(ws + O_CTL) + CW_ERR;
    const bf16* PROJ = (const bf16*)(ws + O_PROJ); const bf16* MIXB = (const bf16*)(ws + O_MIXB); const float* Hf = (const float*)d_out;
    for (int ph = 0; ph < N_PHASES; ++ph) {
        a.ph_lo = ph; a.ph_hi = ph + 1;
        hipLaunchKernelGGL(mega, dim3(grid), dim3(512), LDS_BYTES, stream, a);
        const int layer = ph >= 9 ? 1 : 0; const int rel = ph - (layer ? 8 : 0); const float* ck = ckpt + layer * ck_stride; float* e = err + layer * 12;
        if (rel == 1) k_cmp_proj<<<512, 256, 0, stream>>>(PROJ, ck, MS, e + 0);
        if (rel == 3) { k_cmp<bf16><<<512, 256, 0, stream>>>(MIXB, DM, ck + (size_t)MS * D_IN, DM, MS, 384, e + 2);
                        k_cmp<bf16><<<512, 256, 0, stream>>>(MIXB + 384, DM, ck + (size_t)MS * D_IN + 384, DM, MS, 384, e + 4);
                        k_cmp<bf16><<<512, 256, 0, stream>>>(MIXB + 768, DM, ck + (size_t)MS * D_IN + 768, DM, MS, 256, e + 6); }
        if (rel == 5) k_cmp<float><<<512, 256, 0, stream>>>(Hf, DM, ck + (size_t)MS * (D_IN + DM), DM, MS, DM, e + 8);
        if ((layer == 0 && rel == 8) || (layer == 1 && rel == 10)) k_cmp<float><<<512, 256, 0, stream>>>(Hf, DM, ck + (size_t)MS * (D_IN + 2 * DM), DM, MS, DM, e + 10);
    }
    k_encode<<<1024, 256, 0, stream>>>(err, 12, sout, (float*)d_out, MS, (long)NBATCH * SEQ, DBG_THR);
#endif
}
```

```cpp
#define DEBUG_BUILD 0
#define DBG_THR 0.02f
#define PROBE_MASK 0u
#define PROBE_AMP 0
#include <hip/hip_runtime.h>
#include <cstdio>
#include <cstdint>

constexpr int DM = 1024, SEQ = 2048, NBATCH = 8;
constexpr int ATT_H = 6, HD = 64, ATT_W = 384, ROPE_DIM = 16;
constexpr int MOBA_BLOCK = 256, NBLK = SEQ / MOBA_BLOCK;
constexpr int SSD_H = 6, SSD_W = 384, SSD_G = 2, SSD_N = 128, SSD_CW = 896;
constexpr int GM_G = 4, GM_W = 256, GM_CHUNK = 128;
constexpr int D_IN = 2950, D_FF = 2816, N_EXP = 8, D_FFE = 3584;
constexpr float ALPHA = 1.4142135623730951f;
constexpr float NEGF = -1e30f;
constexpr int MAXSLOT = 2 * NBATCH * SEQ + N_EXP * 256;

typedef unsigned short bf16;
__device__ __forceinline__ unsigned f2bf(float f) { unsigned u = __float_as_uint(f); return (u + 0x7fffu + ((u >> 16) & 1u)) >> 16; }
__device__ __forceinline__ float ldf(const float* p) { return *p; }
__device__ __forceinline__ float ldf(const bf16* p) { return __uint_as_float(((unsigned)*p) << 16); }
__device__ __forceinline__ void stf(float* p, float v) { *p = v; }
__device__ __forceinline__ void stf(bf16* p, float v) { *p = (bf16)f2bf(v); }

__device__ __forceinline__ float wave_sum(float v) {
#pragma unroll
    for (int o = 1; o < 64; o <<= 1) v += __shfl_xor(v, o);
    return v;
}
__device__ __forceinline__ float silu_f(float x) { return x / (1.f + __expf(-x)); }
__device__ __forceinline__ float gelu_tanh_f(float x) { const float u = 0.7978845608028654f * (x + 0.044715f * x * x * x); return 0.5f * x * (1.f + tanhf(u)); }
__device__ __forceinline__ float softplus_f(float x) { return fmaxf(x, 0.f) + log1pf(__expf(-fabsf(x))); }

struct ProjL { int ld, q, k, v, z, xbc, dt, gu, gv; };

__device__ __forceinline__ float4 ld4(const float* p) { return *(const float4*)p; }
__device__ __forceinline__ float4 ld4(const bf16* p) { const uint2 w = *(const uint2*)p; return make_float4(__uint_as_float(w.x << 16), __uint_as_float(w.x & 0xffff0000u), __uint_as_float(w.y << 16), __uint_as_float(w.y & 0xffff0000u)); }
template <class TY, class TX = float> __device__ __forceinline__ void ln_load(float (&v)[16], const TX* xrow, float a, const TY* y1, const TY* y2, int lane) {
#pragma unroll
    for (int j = 0; j < 4; ++j) {
        const float4 x = ld4(xrow + j * 256 + lane * 4);
        float4 t = make_float4(a * x.x, a * x.y, a * x.z, a * x.w);
        if (y1) { const float4 y = ld4(y1 + j * 256 + lane * 4); t.x += y.x; t.y += y.y; t.z += y.z; t.w += y.w; }
        if (y2) { const float4 y = ld4(y2 + j * 256 + lane * 4); t.x += y.x; t.y += y.y; t.z += y.z; t.w += y.w; }
        v[4 * j] = t.x; v[4 * j + 1] = t.y; v[4 * j + 2] = t.z; v[4 * j + 3] = t.w;
    }
}
__device__ __forceinline__ void ln_finish(float (&v)[16], const float* g, const float* b, float* of, bf16* ob, int lane) {
    float s = 0.f;
#pragma unroll
    for (int i = 0; i < 16; ++i) s += v[i];
    const float mean = wave_sum(s) * (1.f / 1024.f); float s2 = 0.f;
#pragma unroll
    for (int i = 0; i < 16; ++i) { v[i] -= mean; s2 += v[i] * v[i]; }
    const float rstd = rsqrtf(wave_sum(s2) * (1.f / 1024.f) + 1e-5f);
#pragma unroll
    for (int j = 0; j < 4; ++j) {
        const float4 gg = *(const float4*)(g + j * 256 + lane * 4), bb = *(const float4*)(b + j * 256 + lane * 4);
        float4 o = make_float4(v[4 * j] * rstd * gg.x + bb.x, v[4 * j + 1] * rstd * gg.y + bb.y, v[4 * j + 2] * rstd * gg.z + bb.z, v[4 * j + 3] * rstd * gg.w + bb.w);
        if (of) *(float4*)(of + j * 256 + lane * 4) = o;
        if (ob) { uint2 w; w.x = f2bf(o.x) | (f2bf(o.y) << 16); w.y = f2bf(o.z) | (f2bf(o.w) << 16); *(uint2*)(ob + j * 256 + lane * 4) = w; }
    }
}
template <class TY> __device__ __forceinline__ void ln_row(const float* xrow, float a, const TY* y1, const TY* y2, const float* g, const float* b, float* of, bf16* ob, int lane) {
    float v[16]; ln_load<TY>(v, xrow, a, y1, y2, lane); ln_finish(v, g, b, of, ob, lane);
}

__device__ __forceinline__ void rope_inplace(float* P, ProjL L, const int* pos, long n_rows, long gt, long ngt) {
    for (long it = gt; it < n_rows * 96; it += ngt) {
        const int i = (int)(it & 7), hh = (int)((it >> 3) % 12); const long row = it / 96;
        const int off = (hh < 6 ? L.q : L.k) + (hh % 6) * 64;
        const float inv = powf(500000.0f, -(float)(2 * i) / 16.0f);
        const float ang = (float)pos[row] * inv;
        const float c = cosf(ang), s = sinf(ang);
        float* p = P + row * L.ld + off;
        const float x1 = p[i], x2 = p[i + 8];
        p[i] = x1 * c - x2 * s; p[i + 8] = x2 * c + x1 * s;
    }
}

template <class T> __device__ __forceinline__ void kmean_phase(const T* P, ProjL L, float* KM, int nb, long gt, long ngt) {
    for (long it = gt; it < (long)nb * ATT_H * NBLK * 64; it += ngt) {
        const int d = (int)(it & 63), n = (int)((it >> 6) % NBLK), h = (int)((it / (64 * NBLK)) % ATT_H), b = (int)(it / (64 * NBLK * ATT_H));
        const T* p = P + ((long)b * SEQ + n * MOBA_BLOCK) * L.ld + L.k + h * 64 + d; float s = 0.f;
        for (int r = 0; r < MOBA_BLOCK; ++r) s += ldf(p + (long)r * L.ld);
        KM[it] = s * (1.f / MOBA_BLOCK);
    }
}

template <class T> __device__ __forceinline__ void attn_naive_phase(const T* P, ProjL L, const float* KM, float* O, int ldo, int nb, int gw, int ngw, int lane) {
    for (long it = gw; it < (long)nb * ATT_H * SEQ; it += ngw) {
        const int q = (int)(it % SEQ), h = (int)((it / SEQ) % ATT_H), b = (int)(it / ((long)SEQ * ATT_H));
        const long row = (long)b * SEQ + q; const int qblk = q / MOBA_BLOCK;
        const float qv = ldf(P + row * L.ld + L.q + h * 64 + lane);
        float g[NBLK];
#pragma unroll
        for (int n = 0; n < NBLK; ++n) { const float t = wave_sum(qv * KM[(((long)b * ATT_H + h) * NBLK + n) * 64 + lane]); g[n] = (n < qblk) ? t : NEGF; }
        unsigned sel = 0u;
#pragma unroll
        for (int r = 0; r < 3; ++r) { float bv = -3.0e38f; int best = -1;
#pragma unroll
            for (int n = 0; n < NBLK; ++n) if (!((sel >> n) & 1u) && g[n] > bv) { bv = g[n]; best = n; }
            if (best >= 0 && bv > NEGF * 0.5f) sel |= 1u << best; }
        sel |= 1u << qblk;
        float m = -3.0e38f, l = 0.f, o = 0.f;
        for (int n = 0; n <= qblk; ++n) {
            if (!((sel >> n) & 1u)) continue;
            const int j0 = n * MOBA_BLOCK, j1 = (n == qblk) ? q + 1 : j0 + MOBA_BLOCK;
            const T* kp = P + ((long)b * SEQ + j0) * L.ld + L.k + h * 64 + lane;
            const T* vp = P + ((long)b * SEQ + j0) * L.ld + L.v + h * 64 + lane;
            for (int j = j0; j < j1; ++j, kp += L.ld, vp += L.ld) {
                const float s = wave_sum(qv * ldf(kp)) * 0.125f;
                const float mn = fmaxf(m, s), corr = __expf(m - mn), p = __expf(s - mn);
                l = l * corr + p; o = o * corr + p * ldf(vp); m = mn;
            }
        }
        O[row * ldo + h * 64 + lane] = o / l;
    }
}

template <int W, class TO> __device__ __forceinline__ void rms_rows_phase(const float* in, int ldi, const float* g, TO* out, int ldo, long n_rows, int gw, int ngw, int lane) {
    constexpr int PER = W / 64;
    for (long row = gw; row < n_rows; row += ngw) {
        float v[PER]; float s = 0.f;
#pragma unroll
        for (int j = 0; j < PER; ++j) { v[j] = in[row * ldi + j * 64 + lane]; s += v[j] * v[j]; }
        const float r = rsqrtf(wave_sum(s) * (1.f / W) + 1e-5f);
#pragma unroll
        for (int j = 0; j < PER; ++j) stf(out + row * ldo + j * 64 + lane, v[j] * r * g[j * 64 + lane]);
    }
}

template <class T, class TO> __device__ __forceinline__ void ssd_conv_phase(const T* P, ProjL L, const float* cw, const float* cb, const float* dtb, TO* XC, float* DT, long n_rows, long gt, long ngt) {
    for (long it = gt; it < n_rows * 902; it += ngt) {
        const int c = (int)(it % 902); const long row = it / 902; const int t = (int)(row % SEQ);
        if (c < SSD_CW) {
            float acc = cb[c];
#pragma unroll
            for (int i = 0; i < 4; ++i) { const int tt = t - 3 + i; if (tt >= 0) acc += cw[i * SSD_CW + c] * ldf(P + (row - 3 + i) * L.ld + L.xbc + c); }
            stf(XC + row * SSD_CW + c, silu_f(acc));
        } else {
            const int h = c - SSD_CW;
            DT[row * SSD_H + h] = softplus_f(ldf(P + row * L.ld + L.dt + h) + dtb[h]);
        }
    }
}

template <class T> __device__ __forceinline__ void ssd_scan_naive_phase(const T* XC, const float* DT, const float* a_log, const float* dsk, float* Y, int ldo, int nb, int gw, int ngw, int lane) {
    for (int it = gw; it < nb * SSD_H * 64; it += ngw) {
        const int p = it & 63, h = (it >> 6) % SSD_H, b = it / (64 * SSD_H), grp = h / (SSD_H / SSD_G);
        const float A = -__expf(a_log[h]), Dk = dsk[h];
        float s0 = 0.f, s1 = 0.f;
#pragma unroll 4
        for (int t = 0; t < SEQ; ++t) {
            const long row = (long)b * SEQ + t;
            const T* xr = XC + row * SSD_CW;
            const float dt = DT[row * SSD_H + h], x = ldf(xr + h * 64 + p);
            const float B0 = ldf(xr + SSD_W + grp * SSD_N + lane), B1 = ldf(xr + SSD_W + grp * SSD_N + 64 + lane);
            const float C0 = ldf(xr + SSD_W + SSD_G * SSD_N + grp * SSD_N + lane), C1 = ldf(xr + SSD_W + SSD_G * SSD_N + grp * SSD_N + 64 + lane);
            const float dec = __expf(dt * A), xd = x * dt;
            s0 = s0 * dec + xd * B0; s1 = s1 * dec + xd * B1;
            const float y = wave_sum(C0 * s0 + C1 * s1);
            if (lane == 0) Y[row * ldo + h * 64 + p] = y + Dk * x;
        }
    }
}

template <class T, class TO> __device__ __forceinline__ void ssd_gate_phase(const float* Y, int ldi, const T* P, ProjL L, const float* ng, TO* out, int ldo, long n_rows, int gw, int ngw, int lane) {
    for (long row = gw; row < n_rows; row += ngw) {
        float v[6];
#pragma unroll
        for (int j = 0; j < 6; ++j) { const int c = j * 64 + lane; v[j] = Y[row * ldi + c] * silu_f(ldf(P + row * L.ld + L.z + c)); }
        const float r0 = rsqrtf(wave_sum(v[0] * v[0] + v[1] * v[1] + v[2] * v[2]) * (1.f / 192.f) + 1e-5f);
        const float r1 = rsqrtf(wave_sum(v[3] * v[3] + v[4] * v[4] + v[5] * v[5]) * (1.f / 192.f) + 1e-5f);
#pragma unroll
        for (int j = 0; j < 6; ++j) { const int c = j * 64 + lane; stf(out + row * ldo + c, v[j] * (j < 3 ? r0 : r1) * ng[c]); }
    }
}

template <class T, bool PRE> __device__ __forceinline__ void gm_ln_phase(const T* P, ProjL L, const float* g, const float* b, float* VN, long n_rows, int gw, int ngw, int lane) {
    for (long row = gw; row < n_rows; row += ngw) {
        float v[4]; float s = 0.f;
#pragma unroll
        for (int j = 0; j < 4; ++j) { const float x = ldf(P + row * L.ld + L.gv + j * 64 + lane); v[j] = PRE ? x : gelu_tanh_f(x); s += v[j]; }
        const float mean = wave_sum(s) * (1.f / 256.f); float s2 = 0.f;
#pragma unroll
        for (int j = 0; j < 4; ++j) { v[j] -= mean; s2 += v[j] * v[j]; }
        const float rstd = rsqrtf(wave_sum(s2) * (1.f / 256.f) + 1e-5f);
#pragma unroll
        for (int j = 0; j < 4; ++j) VN[row * GM_W + j * 64 + lane] = v[j] * rstd * g[j * 64 + lane] + b[j * 64 + lane];
    }
}
template <class T, bool PRE> __device__ __forceinline__ void gm_mix_phase(const T* P, ProjL L, const float* VN, const float* ws_, const float* bs, float* GO, int ldo, long n_rows, long gt, long ngt) {
    for (long it = gt; it < n_rows * GM_W; it += ngt) {
        const int c = (int)(it % GM_W); const long row = it / GM_W; const int t = (int)(row % GM_CHUNK), g = c / 64; const long base = row - t;
        const float* w = ws_ + ((long)g * GM_CHUNK + t) * GM_CHUNK; float acc = 0.f;
        for (int s = 0; s <= t; ++s) acc += w[s] * VN[(base + s) * GM_W + c];
        acc += bs[g * GM_CHUNK + t];
        const float x = ldf(P + row * L.ld + L.gu + c); const float u = PRE ? x : gelu_tanh_f(x);
        GO[row * ldo + c] = u * acc;
    }
}

__device__ __forceinline__ void moe_route_phase(const float* H, const float* Wr, int* CNT, int* TE, float* TP, int* TS, long n_rows, int gw, int ngw, int lane) {
    for (long row = gw; row < n_rows; row += ngw) {
        float acc[N_EXP];
#pragma unroll
        for (int e = 0; e < N_EXP; ++e) acc[e] = 0.f;
        for (int j = 0; j < 16; ++j) { const int d = j * 64 + lane; const float hv = H[row * DM + d];
            const float4 w0 = *(const float4*)(Wr + d * N_EXP), w1 = *(const float4*)(Wr + d * N_EXP + 4);
            acc[0] += hv * w0.x; acc[1] += hv * w0.y; acc[2] += hv * w0.z; acc[3] += hv * w0.w; acc[4] += hv * w1.x; acc[5] += hv * w1.y; acc[6] += hv * w1.z; acc[7] += hv * w1.w; }
#pragma unroll
        for (int e = 0; e < N_EXP; ++e) acc[e] = wave_sum(acc[e]);
        int e0 = 0; float v0 = acc[0];
#pragma unroll
        for (int e = 1; e < N_EXP; ++e) if (acc[e] > v0) { v0 = acc[e]; e0 = e; }
        int e1 = -1; float v1 = -3.0e38f;
#pragma unroll
        for (int e = 0; e < N_EXP; ++e) if (e != e0 && acc[e] > v1) { v1 = acc[e]; e1 = e; }
        const float p1 = __expf(v1 - v0), den = 1.f + p1;
        if (lane == 0) {
            const int s0 = atomicAdd(&CNT[e0], 1), s1 = atomicAdd(&CNT[e1], 1);
            TE[row * 2] = e0; TE[row * 2 + 1] = e1; TP[row * 2] = 1.f / den; TP[row * 2 + 1] = p1 / den; TS[row * 2] = s0; TS[row * 2 + 1] = s1;
        }
    }
}

__device__ __forceinline__ void moe_route_block(const bf16* H, const float* Wr, int* CNT, int* TE, float* TP, int* TS, long n_rows, int gw_, int ngw_, int lane, int wave, int tid,
                                                __attribute__((address_space(3))) int* sh  ) {
    asm volatile("" : "+v"(tid));
    if (tid < 16) sh[tid] = 0;
    __syncthreads();
    int k = 0;
    for (long row = gw_; row < n_rows; row += ngw_, ++k) {
        float acc[N_EXP];
#pragma unroll
        for (int e = 0; e < N_EXP; ++e) acc[e] = 0.f;
        for (int j = 0; j < 16; ++j) { const int d = j * 64 + lane; const float hv = ldf(H + row * DM + d);
            const float4 w0 = *(const float4*)(Wr + d * N_EXP), w1 = *(const float4*)(Wr + d * N_EXP + 4);
            acc[0] += hv * w0.x; acc[1] += hv * w0.y; acc[2] += hv * w0.z; acc[3] += hv * w0.w; acc[4] += hv * w1.x; acc[5] += hv * w1.y; acc[6] += hv * w1.z; acc[7] += hv * w1.w; }
#pragma unroll
        for (int e = 0; e < N_EXP; ++e) acc[e] = wave_sum(acc[e]);
        int e0 = 0; float v0 = acc[0];
#pragma unroll
        for (int e = 1; e < N_EXP; ++e) if (acc[e] > v0) { v0 = acc[e]; e0 = e; }
        int e1 = -1; float v1 = -3.0e38f;
#pragma unroll
        for (int e = 0; e < N_EXP; ++e) if (e != e0 && acc[e] > v1) { v1 = acc[e]; e1 = e; }
        const float p1 = __expf(v1 - v0), den = 1.f + p1;
        if (lane == 0) {
            const int l0 = atomicAdd((int*)&sh[e0], 1), l1 = atomicAdd((int*)&sh[e1], 1);
            TE[row * 2] = e0; TE[row * 2 + 1] = e1; TP[row * 2] = 1.f / den; TP[row * 2 + 1] = p1 / den;
            sh[16 + (wave * 8 + k) * 4 + 0] = e0; sh[16 + (wave * 8 + k) * 4 + 1] = e1; sh[16 + (wave * 8 + k) * 4 + 2] = l0; sh[16 + (wave * 8 + k) * 4 + 3] = l1;
        }
    }
    __syncthreads();
    if (tid < N_EXP) sh[8 + tid] = atomicAdd(&CNT[tid], sh[tid]);
    __syncthreads();
    k = 0;
    for (long row = gw_; row < n_rows; row += ngw_, ++k)
        if (lane == 0) { const int e0 = sh[16 + (wave * 8 + k) * 4], e1 = sh[16 + (wave * 8 + k) * 4 + 1];
            TS[row * 2] = sh[8 + e0] + sh[16 + (wave * 8 + k) * 4 + 2]; TS[row * 2 + 1] = sh[8 + e1] + sh[16 + (wave * 8 + k) * 4 + 3]; }
    __syncthreads();
}
__device__ __forceinline__ int moe_base(const int* CNT, int e) { int b = 0; for (int i = 0; i < e; ++i) b += (CNT[i] + 255) & ~255; return b; }
__device__ __forceinline__ void moe_scatter_phase(const int* CNT, const int* TE, const float* TP, const int* TS, int* LIST, float* SP, int* GS, long n_rows, long gt, long ngt) {
    for (long it = gt; it < n_rows * 2; it += ngt) {
        const int e = TE[it]; const int gs = moe_base(CNT, e) + TS[it];
        LIST[gs] = (int)(it >> 1); SP[gs] = TP[it]; GS[it] = gs;
    }
}

template <class TA, int EPI> __global__ void __launch_bounds__(256) sgemm_k(const TA* A, int lda, const int* rowlist, const float* B, const float* B2, int ldb, long bstride, void* Cv, int ldc, int M, int N, int K, const int* CNT, const float* scale) {
    __shared__ float As[16][68], Bs[16][68], Bs2[16][68];
    int row_base = 0, mrows = M;
    if (CNT) { const int e = blockIdx.z; row_base = moe_base(CNT, e); mrows = CNT[e]; B += (long)e * bstride; if (B2) B2 += (long)e * bstride; }
    const int m0 = blockIdx.y * 64; if (m0 >= mrows) return;
    const int n0 = blockIdx.x * 64, tid = threadIdx.x, tx = tid & 15, ty = tid >> 4;
    float acc[4][4], acc2[4][4];
#pragma unroll
    for (int i = 0; i < 4; ++i)
#pragma unroll
        for (int j = 0; j < 4; ++j) { acc[i][j] = 0.f; acc2[i][j] = 0.f; }
    const int ar = tid >> 2, ak = (tid & 3) * 4; long arow = -1;
    { const int lr = m0 + ar; if (lr < mrows) { arow = rowlist ? (long)rowlist[row_base + lr] : (long)(row_base + lr); } }
    const int bk = tid >> 4, bn = (tid & 15) * 4;
    for (int k0 = 0; k0 < K; k0 += 16) {
        float av[4] = {0.f, 0.f, 0.f, 0.f};
        if (arow >= 0) {
#pragma unroll
            for (int i = 0; i < 4; ++i) av[i] = ldf(A + arow * lda + k0 + ak + i);
        }
#pragma unroll
        for (int i = 0; i < 4; ++i) As[ak + i][ar] = av[i];
#pragma unroll
        for (int i = 0; i < 4; ++i) { const int n = n0 + bn + i; const bool ok = n < N;
            Bs[bk][bn + i] = ok ? B[(long)(k0 + bk) * ldb + n] : 0.f;
            if (EPI == 1 || EPI == 2) Bs2[bk][bn + i] = ok ? B2[(long)(k0 + bk) * ldb + n] : 0.f; }
        __syncthreads();
#pragma unroll
        for (int kk = 0; kk < 16; ++kk) {
            float a[4], b[4], b2[4];
#pragma unroll
            for (int i = 0; i < 4; ++i) { a[i] = As[kk][ty * 4 + i]; b[i] = Bs[kk][tx * 4 + i]; if (EPI == 1 || EPI == 2) b2[i] = Bs2[kk][tx * 4 + i]; }
#pragma unroll
            for (int i = 0; i < 4; ++i)
#pragma unroll
                for (int j = 0; j < 4; ++j) { acc[i][j] += a[i] * b[j]; if (EPI == 1 || EPI == 2) acc2[i][j] += a[i] * b2[j]; }
        }
        __syncthreads();
    }
#pragma unroll
    for (int i = 0; i < 4; ++i) { const int lr = m0 + ty * 4 + i; if (lr >= mrows) continue; const long crow = row_base + lr;
#pragma unroll
        for (int j = 0; j < 4; ++j) { const int n = n0 + tx * 4 + j; if (n >= N) continue;
            float v = acc[i][j];
            if (EPI == 1 || EPI == 2) v = silu_f(v) * acc2[i][j];
            if (EPI == 3) v *= scale[crow];
            if (EPI == 2) ((bf16*)Cv)[crow * ldc + n] = (bf16)f2bf(v); else ((float*)Cv)[crow * ldc + n] = v; } }
}

#define GW_DECL const int lane = threadIdx.x & 63; const int gw = (int)((blockIdx.x * (long)blockDim.x + threadIdx.x) >> 6); const int ngw = (int)((gridDim.x * (long)blockDim.x) >> 6); (void)lane; (void)gw; (void)ngw;
#define GT_DECL const long gt = blockIdx.x * (long)blockDim.x + threadIdx.x; const long ngt = gridDim.x * (long)blockDim.x;

__global__ void k_ln_in(const float* x, const float* g, const float* b, float* H, long n_rows) { GW_DECL for (long r = gw; r < n_rows; r += ngw) ln_row<float>(x + r * DM, 1.f, nullptr, nullptr, g, b, H + r * DM, nullptr, lane); }
__global__ void k_ln_res(float* H, const float* Y, const float* g, const float* b, float* OUT, long n_rows) { GW_DECL for (long r = gw; r < n_rows; r += ngw) ln_row<float>(H + r * DM, ALPHA, Y + r * DM, nullptr, g, b, OUT + r * DM, nullptr, lane); }
__global__ void k_ln_moe(float* H, const float* F2, const int* GS, const float* g, const float* b, float* OUT, long n_rows) { GW_DECL for (long r = gw; r < n_rows; r += ngw) ln_row<float>(H + r * DM, ALPHA, F2 + (long)GS[r * 2] * DM, F2 + (long)GS[r * 2 + 1] * DM, g, b, OUT + r * DM, nullptr, lane); }
__global__ void k_rope(float* P, ProjL L, const int* pos, long n_rows) { GT_DECL rope_inplace(P, L, pos, n_rows, gt, ngt); }
__global__ void k_kmean(const float* P, ProjL L, float* KM, int nb) { GT_DECL kmean_phase<float>(P, L, KM, nb, gt, ngt); }
__global__ void k_attn(const float* P, ProjL L, const float* KM, float* O, int ldo, int nb) { GW_DECL attn_naive_phase<float>(P, L, KM, O, ldo, nb, gw, ngw, lane); }
__global__ void k_rms384(const float* in, int ldi, const float* g, float* out, int ldo, long n_rows) { GW_DECL rms_rows_phase<384, float>(in, ldi, g, out, ldo, n_rows, gw, ngw, lane); }
__global__ void k_rms256(const float* in, int ldi, const float* g, float* out, int ldo, long n_rows) { GW_DECL rms_rows_phase<256, float>(in, ldi, g, out, ldo, n_rows, gw, ngw, lane); }
__global__ void k_ssd_conv(const float* P, ProjL L, const float* cw, const float* cb, const float* dtb, float* XC, float* DT, long n_rows) { GT_DECL ssd_conv_phase<float, float>(P, L, cw, cb, dtb, XC, DT, n_rows, gt, ngt); }
__global__ void k_ssd_scan(const float* XC, const float* DT, const float* a_log, const float* dsk, float* Y, int ldo, int nb) { GW_DECL ssd_scan_naive_phase<float>(XC, DT, a_log, dsk, Y, ldo, nb, gw, ngw, lane); }
__global__ void k_ssd_gate(const float* Y, int ldi, const float* P, ProjL L, const float* ng, float* out, int ldo, long n_rows) { GW_DECL ssd_gate_phase<float, float>(Y, ldi, P, L, ng, out, ldo, n_rows, gw, ngw, lane); }
__global__ void k_gm_ln(const float* P, ProjL L, const float* g, const float* b, float* VN, long n_rows) { GW_DECL gm_ln_phase<float, false>(P, L, g, b, VN, n_rows, gw, ngw, lane); }
__global__ void k_gm_mix(const float* P, ProjL L, const float* VN, const float* ws_, const float* bs, float* GO, int ldo, long n_rows) { GT_DECL gm_mix_phase<float, false>(P, L, VN, ws_, bs, GO, ldo, n_rows, gt, ngt); }
__global__ void k_moe_init(int* CNT, int* LIST, int nslots) { GT_DECL if (gt < N_EXP) CNT[gt] = 0; for (long i = gt; i < nslots; i += ngt) LIST[i] = -1; }
__global__ void k_moe_route(const float* H, const float* Wr, int* CNT, int* TE, float* TP, int* TS, long n_rows) { GW_DECL moe_route_phase(H, Wr, CNT, TE, TP, TS, n_rows, gw, ngw, lane); }
__global__ void k_moe_scatter(const int* CNT, const int* TE, const float* TP, const int* TS, int* LIST, float* SP, int* GS, long n_rows) { GT_DECL moe_scatter_phase(CNT, TE, TP, TS, LIST, SP, GS, n_rows, gt, ngt); }

struct Inputs {
    const float *x; const int* pos; const float *ln_in_g, *ln_in_b, *w_in, *conv_w, *conv_b, *dt_bias, *a_log, *d_skip, *ssd_norm_g, *att_norm_g, *gm_ln_g, *gm_ln_b, *gm_w_s, *gm_b_s, *gm_norm_g, *w_out,
        *ln1_g, *ln1_b, *ln2_g, *ln2_b, *ffn_w_gate, *ffn_w_up, *ffn_w_down, *router_w, *moe_w_gate, *moe_w_up, *moe_w_down;
};

static void run_simple(const Inputs& I, int nb, unsigned char* ws, float* aux  , float* OUT, hipStream_t st, float* ckpt = nullptr) {
    const long M = (long)nb * SEQ; const size_t MB = 1u << 20;
    const size_t hsz = (size_t)M * DM * 4;
    float* H = (float*)ws; float* MIX = (float*)(ws + hsz); float* Y = (float*)(ws + 2 * hsz); unsigned char* BIG = ws + 3 * hsz + (size_t)N_EXP * 256 * DM * 4;
    float* XC = Y;
    float* VN = aux;
    float* PROJ = (float*)BIG;
    size_t big_bytes = (size_t)M * D_IN * 4; { size_t a = (size_t)M * D_FF * 4; if (a > big_bytes) big_bytes = a; size_t c = (size_t)(2 * M + N_EXP * 256) * D_FFE * 2; if (c > big_bytes) big_bytes = c; }
    big_bytes = (big_bytes + 255) & ~(size_t)255;
    unsigned char* SM = BIG + big_bytes;
    float* KM = (float*)SM; SM += (size_t)nb * ATT_H * NBLK * 64 * 4;
    float* DT = (float*)SM; SM += (size_t)M * SSD_H * 4;
    int* CNT = (int*)SM; SM += 256;
    int* TE = (int*)SM; SM += (size_t)M * 2 * 4; float* TP = (float*)SM; SM += (size_t)M * 2 * 4; int* TS = (int*)SM; SM += (size_t)M * 2 * 4; int* GS = (int*)SM; SM += (size_t)M * 2 * 4;
    const int nslots = (int)(2 * M + N_EXP * 256);
    int* LIST = (int*)SM; SM += (size_t)nslots * 4; float* SP = (float*)SM; SM += (size_t)nslots * 4;
    (void)MB;
    const ProjL L{D_IN, 0, 384, 768, 1152, 1536, 2432, 2438, 2694};
    const int TB = 256; const int GWB = 2048;
    k_ln_in<<<GWB, TB, 0, st>>>(I.x, I.ln_in_g, I.ln_in_b, H, M);
    for (int i = 0; i < 2; ++i) {
        sgemm_k<float, 0><<<dim3((D_IN + 63) / 64, (unsigned)(M / 64), 1), 256, 0, st>>>(H, DM, nullptr, I.w_in + (size_t)i * DM * D_IN, nullptr, D_IN, 0, PROJ, D_IN, (int)M, D_IN, DM, nullptr, nullptr);
        k_rope<<<GWB, TB, 0, st>>>(PROJ, L, I.pos, M);
        const size_t ck_stride = (size_t)M * (D_IN + 3 * DM); float* ck = ckpt ? ckpt + (size_t)i * ck_stride : nullptr;
        if (ck) hipMemcpyAsync(ck, PROJ, (size_t)M * D_IN * 4, hipMemcpyDeviceToDevice, st);
        k_kmean<<<96 * nb, TB, 0, st>>>(PROJ, L, KM, nb);
        k_attn<<<GWB * 2, TB, 0, st>>>(PROJ, L, KM, MIX, DM, nb);
        k_rms384<<<GWB, TB, 0, st>>>(MIX, DM, I.att_norm_g + i * ATT_W, MIX, DM, M);
        k_ssd_conv<<<GWB * 2, TB, 0, st>>>(PROJ, L, I.conv_w + (size_t)i * 4 * SSD_CW, I.conv_b + i * SSD_CW, I.dt_bias + i * SSD_H, XC, DT, M);
        k_ssd_scan<<<(nb * SSD_H * 64 * 64 + TB - 1) / TB, TB, 0, st>>>(XC, DT, I.a_log + i * SSD_H, I.d_skip + i * SSD_H, MIX + ATT_W, DM, nb);
        k_ssd_gate<<<GWB, TB, 0, st>>>(MIX + ATT_W, DM, PROJ, L, I.ssd_norm_g + i * SSD_W, MIX + ATT_W, DM, M);
        k_gm_ln<<<GWB, TB, 0, st>>>(PROJ, L, I.gm_ln_g + i * GM_W, I.gm_ln_b + i * GM_W, VN, M);
        k_gm_mix<<<GWB * 2, TB, 0, st>>>(PROJ, L, VN, I.gm_w_s + (size_t)i * GM_G * GM_CHUNK * GM_CHUNK, I.gm_b_s + i * GM_G * GM_CHUNK, MIX + ATT_W + SSD_W, DM, M);
        k_rms256<<<GWB, TB, 0, st>>>(MIX + ATT_W + SSD_W, DM, I.gm_norm_g + i * GM_W, MIX + ATT_W + SSD_W, DM, M);
        if (ck) hipMemcpyAsync(ck + (size_t)M * D_IN, MIX, hsz, hipMemcpyDeviceToDevice, st);
        sgemm_k<float, 0><<<dim3(DM / 64, (unsigned)(M / 64), 1), 256, 0, st>>>(MIX, DM, nullptr, I.w_out + (size_t)i * DM * DM, nullptr, DM, 0, Y, DM, (int)M, DM, DM, nullptr, nullptr);
        k_ln_res<<<GWB, TB, 0, st>>>(H, Y, I.ln1_g + i * DM, I.ln1_b + i * DM, H, M);
        if (ck) hipMemcpyAsync(ck + (size_t)M * (D_IN + DM), H, hsz, hipMemcpyDeviceToDevice, st);
        if (i == 0) {
            float* ACT = (float*)BIG;
            sgemm_k<float, 1><<<dim3(D_FF / 64, (unsigned)(M / 64), 1), 256, 0, st>>>(H, DM, nullptr, I.ffn_w_gate, I.ffn_w_up, D_FF, 0, ACT, D_FF, (int)M, D_FF, DM, nullptr, nullptr);
            sgemm_k<float, 0><<<dim3(DM / 64, (unsigned)(M / 64), 1), 256, 0, st>>>(ACT, D_FF, nullptr, I.ffn_w_down, nullptr, DM, 0, Y, DM, (int)M, DM, D_FF, nullptr, nullptr);
            k_ln_res<<<GWB, TB, 0, st>>>(H, Y, I.ln2_g + i * DM, I.ln2_b + i * DM, H, M);
            if (ck) hipMemcpyAsync(ck + (size_t)M * (D_IN + 2 * DM), H, hsz, hipMemcpyDeviceToDevice, st);
        } else {
            bf16* ACTM = (bf16*)BIG; float* F2 = MIX;
            k_moe_init<<<256, TB, 0, st>>>(CNT, LIST, nslots);
            k_moe_route<<<GWB, TB, 0, st>>>(H, I.router_w, CNT, TE, TP, TS, M);
            k_moe_scatter<<<256, TB, 0, st>>>(CNT, TE, TP, TS, LIST, SP, GS, M);
            sgemm_k<float, 2><<<dim3(D_FFE / 64, (unsigned)(M / 64), N_EXP), 256, 0, st>>>(H, DM, LIST, I.moe_w_gate, I.moe_w_up, D_FFE, (long)DM * D_FFE, ACTM, D_FFE, 0, D_FFE, DM, CNT, nullptr);
            sgemm_k<bf16, 3><<<dim3(DM / 64, (unsigned)(M / 64), N_EXP), 256, 0, st>>>(ACTM, D_FFE, nullptr, I.moe_w_down, nullptr, DM, (long)D_FFE * DM, F2, DM, 0, DM, D_FFE, CNT, SP);
            k_ln_moe<<<GWB, TB, 0, st>>>(H, F2, GS, I.ln2_g + i * DM, I.ln2_b + i * DM, OUT, M);
            if (ck) hipMemcpyAsync(ck + (size_t)M * (D_IN + 2 * DM), OUT, hsz, hipMemcpyDeviceToDevice, st);
        }
    }
}

#define LAS __attribute__((address_space(3)))
namespace pg8 {
#define PG8_LAS __attribute__((address_space(3)))
typedef unsigned short bf16_t;
typedef short bf16x8 __attribute__((ext_vector_type(8)));
typedef float f32x4 __attribute__((ext_vector_type(4)));
typedef unsigned u32x4 __attribute__((ext_vector_type(4)));
constexpr int BM = 256, BK = 64, HALF = 128, HTB = HALF * BK * 2  , STAGE_BYTES = 8 * HTB, NXCD = 8, WGM = 8;

__host__ __device__ __forceinline__ int lds_byte(int r, int c) { const int st = (r >> 4) * 2 + (c >> 5), rr = r & 15, cc = c & 31, ob = rr * 64 + cc * 2; return st * 1024 + (ob ^ (((ob >> 9) & 1) << 5)); }
__host__ __device__ __forceinline__ void stage_rc(int b, int& R, int& C) { const int st = b / 1024, sb = b % 1024, swz = sb ^ (((sb >> 9) & 1) << 5); R = (st >> 1) * 16 + swz / 64; C = (st & 1) * 32 + (swz % 64) / 2; }
__host__ __device__ __forceinline__ int perm32(int rho) { const int n = rho >> 4, i = rho & 15; return 8 * (i >> 2) + 4 * n + (i & 3); }

struct Unit { int pm, pn; };
struct Gemm { const bf16_t* A; const bf16_t* Bt; int M, N, K; };

struct StaticOrder {
    int nM, nN, nwg, G, c;
    __host__ __device__ void init(int M, int N, int G_, int c_) { nM = M / BM; nN = N / BM; nwg = nM * nN; G = G_; c = c_; }
    __host__ __device__ bool next(int i, Unit& u) const {
        const long L = (long)i * G + c; if (L >= nwg) return false;
        int wgid = (int)L; { const int q = nwg / NXCD, r = nwg % NXCD, xcd = wgid % NXCD, off = wgid / NXCD; wgid = (xcd < r ? xcd * (q + 1) : r * (q + 1) + (xcd - r) * q) + off; }
        const int nig = WGM * nN, gid = wgid / nig, fm = gid * WGM, gsz = (nM - fm) < WGM ? (nM - fm) : WGM;
        u.pm = fm + ((wgid % nig) % gsz); u.pn = (wgid % nig) / gsz; return true;
    }
    __device__ __forceinline__ void a_ready(const Unit&) const {}
    __device__ __forceinline__ void done(const Unit&) const {}
};
__device__ __forceinline__ unsigned cvt_pk_bf16(float lo, float hi) { unsigned r; asm volatile("v_cvt_pk_bf16_f32 %0, %1, %2" : "=v"(r) : "v"(lo), "v"(hi)); return r; }
typedef float f32x2 __attribute__((ext_vector_type(2)));
template <class Epi, class Sched, bool ALIGN_EPI = false, bool SP2 = false>
__device__ __forceinline__ void gemm_phase(PG8_LAS unsigned char* lds, const Gemm g, const Sched& S, const Epi& E) {
    const int tid = threadIdx.x, wid = __builtin_amdgcn_readfirstlane(tid >> 6), lane = tid & 63, wr = wid >> 2, wc = wid & 3, fr = lane & 15, fq = lane >> 4;
    const int K = g.K, nt = K / BK;
    unsigned voffA[2], voffB[2];
#pragma unroll
    for (int i = 0; i < 2; ++i) { int R, C; stage_rc(tid * 16 + i * 8192, R, C); const int Rb = Epi::PERM ? ((R & ~31) + perm32(R & 31)) : R;
        voffA[i] = (unsigned)(R * K + C) * 2u; voffB[i] = (unsigned)(Rb * K + C) * 2u; }
    const size_t kstep = (size_t)(BK * 2);
    const size_t hstep = (size_t)HALF * K * 2;
    const size_t tstep = 2 * hstep;
    const unsigned ldsw = (unsigned)wid * 1024u;
    const int aoff = lds_byte(wr * 64 + fr, fq * 8), boff = lds_byte(wc * 32 + fr, fq * 8);
#define PG8_SA(b, h) (((b) * 2 + (h)) * HTB)
#define PG8_SB(b, h) ((4 + (b) * 2 + (h)) * HTB)
#define PG8_STAGE(bufoff, gbase, voff) do { _Pragma("unroll") for (int _i = 0; _i < 2; ++_i) \
        __builtin_amdgcn_global_load_lds((const unsigned*)((const char*)(gbase) + (voff)[_i]), (PG8_LAS unsigned*)(lds + (bufoff) + ldsw + _i * 8192), 16, 0, 0); } while (0)
#define PG8_LDA(dst, b, h) do { _Pragma("unroll") for (int m = 0; m < 4; ++m) _Pragma("unroll") for (int k = 0; k < 2; ++k) dst[m][k] = *(const PG8_LAS bf16x8*)(lds + PG8_SA(b, h) + aoff + m * 2048 + k * 1024); } while (0)
#define PG8_LDB(dst, b, h) do { _Pragma("unroll") for (int n = 0; n < 2; ++n) _Pragma("unroll") for (int k = 0; k < 2; ++k) dst[n][k] = *(const PG8_LAS bf16x8*)(lds + PG8_SB(b, h) + boff + n * 2048 + k * 1024); } while (0)
#define PG8_MMA(ai, bj, At, Bt) do { __builtin_amdgcn_s_setprio(1); _Pragma("unroll") for (int m = 0; m < 4; ++m) _Pragma("unroll") for (int n = 0; n < 2; ++n) _Pragma("unroll") for (int k = 0; k < 2; ++k) \
        acc[ai][bj][m][n] = __builtin_amdgcn_mfma_f32_16x16x32_bf16(Bt[n][k], At[m][k], acc[ai][bj][m][n], 0, 0, 0); __builtin_amdgcn_s_setprio(0); } while (0)
#define PG8_WAIT_V(n) asm volatile("s_waitcnt vmcnt(" #n ")" ::: "memory")
#define PG8_WAIT_L(n) asm volatile("s_waitcnt lgkmcnt(" #n ")" ::: "memory")
#define PG8_BAR __builtin_amdgcn_s_barrier()
#define PG8_SCHED __builtin_amdgcn_sched_barrier(0)
    Unit cur, nxt; int ui = 0;
    if (!S.next(0, cur)) return;
    f32x4 acc[2][2][4][2];
#pragma unroll
    for (int a = 0; a < 2; ++a)
#pragma unroll
        for (int b = 0; b < 2; ++b)
#pragma unroll
            for (int m = 0; m < 4; ++m)
#pragma unroll
                for (int n = 0; n < 2; ++n) acc[a][b][m][n] = (f32x4){0.f, 0.f, 0.f, 0.f};
    bf16x8 At[4][2], B0[2][2], B1[2][2];
    const char* cA = (const char*)g.A + (size_t)cur.pm * tstep; const char* cB = (const char*)g.Bt + (size_t)cur.pn * tstep;
    S.a_ready(cur);
    if constexpr (SP2) {
        PG8_STAGE(PG8_SB(0, 0), cB, voffB); PG8_STAGE(PG8_SB(0, 1), cB + hstep, voffB); PG8_STAGE(PG8_SA(0, 0), cA, voffA); PG8_STAGE(PG8_SA(0, 1), cA + hstep, voffA);
        if (wr == 1) PG8_BAR;
        PG8_WAIT_V(2); PG8_BAR;
        PG8_STAGE(PG8_SB(1, 0), cB + kstep, voffB); PG8_STAGE(PG8_SA(1, 0), cA + kstep, voffA); PG8_STAGE(PG8_SB(1, 1), cB + hstep + kstep, voffB);
        PG8_WAIT_V(6); PG8_BAR;
    } else {
        PG8_STAGE(PG8_SB(0, 0), cB, voffB); PG8_STAGE(PG8_SA(0, 0), cA, voffA); PG8_STAGE(PG8_SB(0, 1), cB + hstep, voffB); PG8_STAGE(PG8_SA(0, 1), cA + hstep, voffA);
        if (wr == 1) PG8_BAR;
        PG8_WAIT_V(4); PG8_BAR;
        PG8_STAGE(PG8_SB(1, 0), cB + kstep, voffB); PG8_STAGE(PG8_SA(1, 0), cA + kstep, voffA); PG8_STAGE(PG8_SB(1, 1), cB + hstep + kstep, voffB);
        PG8_WAIT_V(6); PG8_BAR;
    }
    for (;;) {
        const bool has_next = S.next(ui + 1, nxt);
        const char* nA = has_next ? (const char*)g.A + (size_t)nxt.pm * tstep : cA; const char* nB = has_next ? (const char*)g.Bt + (size_t)nxt.pn * tstep : cB;
        for (int t = 0; t < nt; t += 2) {
            const bool last = (t == nt - 2);
            const char* a1 = cA + (size_t)(t + 1) * kstep;
            const char* a2 = last ? nA : cA + (size_t)(t + 2) * kstep; const char* b2 = last ? nB : cB + (size_t)(t + 2) * kstep;
            const char* a3 = a2 + kstep; const char* b3 = b2 + kstep;
            if (last && has_next) S.a_ready(nxt);
            if constexpr (SP2) {
            PG8_LDB(B0, 0, 0); PG8_LDB(B1, 0, 1); PG8_SCHED; PG8_LDA(At, 0, 0); PG8_STAGE(PG8_SA(1, 1), a1 + hstep, voffA);
            PG8_WAIT_V(8); PG8_WAIT_L(0); PG8_BAR; PG8_MMA(0, 0, At, B0); PG8_MMA(0, 1, At, B1); PG8_BAR; PG8_SCHED;
            PG8_LDA(At, 0, 1); PG8_STAGE(PG8_SB(0, 0), b2, voffB); PG8_STAGE(PG8_SB(0, 1), b2 + hstep, voffB); PG8_STAGE(PG8_SA(0, 0), a2, voffA);
            PG8_WAIT_V(8); PG8_WAIT_L(0); PG8_BAR; PG8_MMA(1, 0, At, B0); PG8_MMA(1, 1, At, B1); PG8_BAR; PG8_SCHED;
            PG8_LDB(B0, 1, 0); PG8_LDB(B1, 1, 1); PG8_SCHED; PG8_LDA(At, 1, 0); PG8_STAGE(PG8_SA(0, 1), a2 + hstep, voffA);
            PG8_WAIT_V(8); PG8_WAIT_L(0); PG8_BAR; PG8_MMA(0, 0, At, B0); PG8_MMA(0, 1, At, B1); PG8_BAR; PG8_SCHED;
            PG8_LDA(At, 1, 1); PG8_STAGE(PG8_SB(1, 0), b3, voffB); PG8_STAGE(PG8_SB(1, 1), b3 + hstep, voffB); PG8_STAGE(PG8_SA(1, 0), a3, voffA);
            PG8_WAIT_V(8); PG8_WAIT_L(0); PG8_BAR; PG8_MMA(1, 0, At, B0); PG8_MMA(1, 1, At, B1); PG8_BAR; PG8_SCHED;
            } else {
            PG8_LDB(B0, 0, 0); PG8_SCHED; PG8_LDA(At, 0, 0); PG8_STAGE(PG8_SA(1, 1), a1 + hstep, voffA);
            PG8_WAIT_L(8); PG8_BAR; PG8_WAIT_L(0); PG8_MMA(0, 0, At, B0); PG8_BAR; PG8_SCHED;
            PG8_LDB(B1, 0, 1); PG8_STAGE(PG8_SB(0, 0), b2, voffB);
            PG8_BAR; PG8_WAIT_L(0); PG8_MMA(0, 1, At, B1); PG8_BAR;
            PG8_LDA(At, 0, 1); PG8_STAGE(PG8_SA(0, 0), a2, voffA);
            PG8_BAR; PG8_WAIT_L(0); PG8_MMA(1, 0, At, B0); PG8_BAR; PG8_SCHED;
            PG8_STAGE(PG8_SB(0, 1), b2 + hstep, voffB);
            PG8_WAIT_V(6); PG8_BAR; PG8_MMA(1, 1, At, B1); PG8_BAR;
            PG8_LDB(B0, 1, 0); PG8_SCHED; PG8_LDA(At, 1, 0); PG8_STAGE(PG8_SA(0, 1), a2 + hstep, voffA);
            PG8_WAIT_L(8); PG8_BAR; PG8_WAIT_L(0); PG8_MMA(0, 0, At, B0); PG8_BAR; PG8_SCHED;
            PG8_LDB(B1, 1, 1); PG8_STAGE(PG8_SB(1, 0), b3, voffB);
            PG8_BAR; PG8_WAIT_L(0); PG8_MMA(0, 1, At, B1); PG8_BAR;
            PG8_LDA(At, 1, 1); PG8_STAGE(PG8_SA(1, 0), a3, voffA);
            PG8_BAR; PG8_WAIT_L(0); PG8_MMA(1, 0, At, B0); PG8_BAR; PG8_SCHED;
            PG8_STAGE(PG8_SB(1, 1), b3 + hstep, voffB);
            PG8_WAIT_V(6); PG8_BAR; PG8_MMA(1, 1, At, B1); PG8_BAR;
            }
        }
        if constexpr (ALIGN_EPI) { if (wr == 0) PG8_BAR; }
        if constexpr (!Epi::AFTER_DRAIN) { E(acc, cur, wr, wc, fr, fq); S.done(cur); }
        if (!has_next) break;
#pragma unroll
        for (int a = 0; a < 2; ++a)
#pragma unroll
            for (int b = 0; b < 2; ++b)
#pragma unroll
                for (int m = 0; m < 4; ++m)
#pragma unroll
                    for (int n = 0; n < 2; ++n) acc[a][b][m][n] = (f32x4){0.f, 0.f, 0.f, 0.f};
        cur = nxt; cA = nA; cB = nB; ++ui;
        if constexpr (ALIGN_EPI) { if (wr == 1) PG8_BAR; }
    }
    PG8_WAIT_V(0);
    if constexpr (!ALIGN_EPI) { if (wr == 0) PG8_BAR; }
    PG8_BAR;
    if constexpr (Epi::AFTER_DRAIN) { E.fused(acc, cur, wr, wc, fr, fq, lds, wid, lane); S.done(cur); }
#undef PG8_SA
#undef PG8_SB
#undef PG8_STAGE
#undef PG8_LDA
#undef PG8_LDB
#undef PG8_MMA
#undef PG8_WAIT_V
#undef PG8_WAIT_L
#undef PG8_BAR
#undef PG8_SCHED
}
}
#define XB_TMO      128
#define XB_XCNT(j)  (256  + 64 * (j))
#define XB_XSUB(j)  (1280 + 64 * (j))
#define XB_XGEN(j)  (2304 + 64 * (j))
#define XB_TOP      3328
#define XB_TOPGEN   3392
#define XCD_BAR_WORDS 3456
#define XB_SPIN_CAP (1u << 24)

__device__ __forceinline__ unsigned xb_ld(unsigned* p)              { return __hip_atomic_load(p, __ATOMIC_RELAXED, __HIP_MEMORY_SCOPE_AGENT); }
__device__ __forceinline__ unsigned xb_add(unsigned* p, unsigned v) { return __hip_atomic_fetch_add(p, v, __ATOMIC_RELAXED, __HIP_MEMORY_SCOPE_AGENT); }
__device__ __forceinline__ unsigned xb_xcc_id() { return (unsigned)__builtin_amdgcn_s_getreg((3 << 11) | 20) & 0xFu; }
#define XB_SPIN(cond, bar) do { unsigned _sp = 0; while (cond) { __builtin_amdgcn_s_sleep(1); \
    if ((++_sp & 255u) == 0u) { if (xb_ld(&(bar)[XB_TMO])) break; if (_sp > XB_SPIN_CAP) { atomicAdd(&(bar)[XB_TMO], 1u); break; } } } } while (0)

struct XcdBarrier {
    unsigned* bar; unsigned x;
    volatile LAS unsigned* st;
};

__device__ __forceinline__ XcdBarrier xcd_barrier_post(unsigned* bar, volatile LAS unsigned* st) {
    XcdBarrier b; b.bar = bar; b.x = xb_xcc_id(); b.st = st;
    if (threadIdx.x == 0) (void)xb_add(&bar[XB_XCNT(b.x)], 1u);
    return b;
}
__device__ __forceinline__ void xcd_barrier_complete(unsigned* bar, unsigned x, unsigned& nloc, unsigned& nx) {
    const unsigned G = gridDim.x * gridDim.y * gridDim.z;
    unsigned sum, cnt, mine, sp = 0u;
    for (;;) {
        sum = 0u; cnt = 0u; mine = 0u;
#pragma unroll
        for (unsigned j = 0; j < 16; ++j) { const unsigned c = xb_ld(&bar[XB_XCNT(j)]); sum += c; cnt += (c > 0u) ? 1u : 0u; mine = (j == x) ? c : mine; }
        if (sum == G) break;
        __builtin_amdgcn_s_sleep(1);
        if ((++sp & 255u) == 0u) { if (xb_ld(&bar[XB_TMO])) break; if (sp > XB_SPIN_CAP) { atomicAdd(&bar[XB_TMO], 1u); break; } }
    }
    nloc = mine > 0u ? mine : 1u; nx = cnt > 0u ? cnt : 1u;
}

__device__ __forceinline__ void xcd_barrier(const XcdBarrier& b) {
    asm volatile("s_waitcnt vmcnt(0)" ::: "memory");
    __syncthreads();
    if (threadIdx.x == 0) {
        unsigned* bar = b.bar;
        __builtin_amdgcn_s_waitcnt(0);
        unsigned nloc = b.st[0], nx = b.st[1];
        if (nloc == 0u) { xcd_barrier_complete(bar, b.x, nloc, nx); b.st[0] = nloc; b.st[1] = nx; }
        const unsigned old = xb_add(&bar[XB_XSUB(b.x)], 1u);
        const unsigned gen = old / nloc;
        if (old + 1u == (gen + 1u) * nloc) {
            __builtin_amdgcn_fence(__ATOMIC_RELEASE, "agent");
            asm volatile("s_waitcnt vmcnt(0)" ::: "memory");
            const unsigned og = xb_add(&bar[XB_TOP], 1u);
            const unsigned tg = og / nx;
            if (og + 1u == (tg + 1u) * nx) xb_add(&bar[XB_TOPGEN], 1u);
            else XB_SPIN(xb_ld(&bar[XB_TOPGEN]) == tg, bar);
            __builtin_amdgcn_fence(__ATOMIC_ACQUIRE, "agent");
            xb_add(&bar[XB_XGEN(b.x)], 1u);
            asm volatile("s_waitcnt vmcnt(0)" ::: "memory");
        } else {
            XB_SPIN(xb_ld(&bar[XB_XGEN(b.x)]) == gen, bar);
            __builtin_amdgcn_fence(__ATOMIC_ACQUIRE, "agent");
            asm volatile("s_waitcnt vmcnt(0)" ::: "memory");
        }
    }
    __syncthreads();
}
#include <hip/hip_bf16.h>
#include <cmath>
namespace attn_body {
using bf16=__hip_bfloat16;
using bf16x8=__attribute__((ext_vector_type(8)))short;
using s16x4=__attribute__((ext_vector_type(4)))short;
using f32x16=__attribute__((ext_vector_type(16)))float;
using u32x4=__attribute__((ext_vector_type(4)))unsigned;
constexpr int NHEAD=6,SEQ=2048,D=64,QP=3072,OP=1024;
constexpr int NW=8,QBLK=32,QB=QBLK*NW,KVBLK=64,NQB=SEQ/QB;
constexpr int ATTN_UNIT_ROWS=QB;
__device__ __forceinline__ int crow(int r,int hi){return (r&3)+8*(r>>2)+4*hi;}
#define SBAR() __builtin_amdgcn_sched_barrier(0)
__device__ __forceinline__ void cmask(f32x16&p0,f32x16&p1,int jb,int qrel,int hi){
  const float NEG=-INFINITY; int kb=64*jb+4*hi;
  #pragma unroll
  for(int r=0;r<16;++r){int kv=kb+(r&3)+8*(r>>2); if(kv>qrel)p0[r]=NEG; if(kv+32>qrel)p1[r]=NEG;}
}

constexpr int NSLOT=3, SLOTB=8192;
constexpr int LDS_K=0, LDS_V=NSLOT*SLOTB, LDS_WS=2*NSLOT*SLOTB, LDS_OST=LDS_WS+NW*64*4, LDS_BYTES=LDS_OST+NW*4096;
constexpr float C2=0.125f*1.4426950408889634f;
__device__ __forceinline__ void glds16(const void*gsrc,unsigned lds_dst){unsigned keep;
  asm volatile("s_mov_b32 %0, m0\n\ts_mov_b32 m0, %2\n\ts_nop 0\n\tglobal_load_lds_dwordx4 %1, off\n\ts_mov_b32 m0, %0":"=&s"(keep):"v"(gsrc),"s"(lds_dst):"memory");}
__device__ __forceinline__ float max3f(float a,float b,float c){float r;asm("v_max3_f32 %0, %1, %2, %3":"=v"(r):"v"(a),"v"(b),"v"(c));return r;}
__device__ __forceinline__ float max2f(float a,float b){float r;asm("v_max_f32_e32 %0, %1, %2":"=v"(r):"v"(a),"v"(b));return r;}
__device__ __forceinline__ float fadd_s(float a,float b){float r;asm("v_add_f32_e32 %0, %1, %2":"=v"(r):"v"(a),"v"(b));return r;}
__device__ __forceinline__ float fsub_s(float a,float b){float r;asm("v_sub_f32_e32 %0, %1, %2":"=v"(r):"v"(a),"v"(b));return r;}
typedef float f32x2_t __attribute__((ext_vector_type(2))); typedef __bf16 bf16x2_t __attribute__((ext_vector_type(2)));
__device__ __forceinline__ unsigned cvtpk_s(float lo,float hi){f32x2_t v={lo,hi};bf16x2_t b=__builtin_convertvector(v,bf16x2_t);return __builtin_bit_cast(unsigned,b);}
#define WAIT_BAR(N) asm volatile("s_waitcnt vmcnt(" #N ") lgkmcnt(0)\n\ts_barrier":::"memory")

__device__ __forceinline__ void qkt(f32x16&p0,f32x16&p1,const char*Kslot,const bf16x8*qr,int r32,int hi){ const f32x16 negm=f32x16{};
  const char*kb=Kslot+hi*1024+r32*16;
  #pragma unroll
  for(int d0=0;d0<4;++d0){
    const bf16x8 b0=*reinterpret_cast<const bf16x8*>(kb+d0*2048);
    const bf16x8 b1=*reinterpret_cast<const bf16x8*>(kb+d0*2048+512);
    if(d0==0){p0=__builtin_amdgcn_mfma_f32_32x32x16_bf16(b0,qr[0],negm,0,0,0);p1=__builtin_amdgcn_mfma_f32_32x32x16_bf16(b1,qr[0],negm,0,0,0);}
    else{p0=__builtin_amdgcn_mfma_f32_32x32x16_bf16(b0,qr[d0],p0,0,0,0);p1=__builtin_amdgcn_mfma_f32_32x32x16_bf16(b1,qr[d0],p1,0,0,0);}}
}
typedef __attribute__((address_space(3))) const char* lds_cptr;
typedef short v4i16_t __attribute__((ext_vector_type(4)));
__device__ __forceinline__ void kload8(bf16x8*kf,lds_cptr kp){
  kf[0]=*(const __attribute__((address_space(3))) bf16x8*)(kp);      kf[1]=*(const __attribute__((address_space(3))) bf16x8*)(kp+512);
  kf[2]=*(const __attribute__((address_space(3))) bf16x8*)(kp+2048); kf[3]=*(const __attribute__((address_space(3))) bf16x8*)(kp+2560);
  kf[4]=*(const __attribute__((address_space(3))) bf16x8*)(kp+4096); kf[5]=*(const __attribute__((address_space(3))) bf16x8*)(kp+4608);
  kf[6]=*(const __attribute__((address_space(3))) bf16x8*)(kp+6144); kf[7]=*(const __attribute__((address_space(3))) bf16x8*)(kp+6656);
}
__device__ __forceinline__ void kload2(bf16x8*kf,lds_cptr kp,int j){ kf[2*j]=*(const __attribute__((address_space(3))) bf16x8*)(kp+j*2048); kf[2*j+1]=*(const __attribute__((address_space(3))) bf16x8*)(kp+j*2048+512); }
__device__ __forceinline__ s16x4 vtr(lds_cptr p){ return __builtin_bit_cast(s16x4,__builtin_amdgcn_ds_read_tr16_b64_v4i16((__attribute__((address_space(3))) v4i16_t*)p)); }
__device__ __forceinline__ float rowmax(const f32x16&p0,const f32x16&p1){
  float a=max3f(p0[0],p0[1],p1[0]),b=max3f(p0[2],p0[3],p1[1]);a=max3f(a,p1[2],p1[3]);
  #pragma unroll
  for(int r=4;r<16;r+=4){a=max3f(a,p0[r],p0[r+1]);b=max3f(b,p0[r+2],p0[r+3]);a=max3f(a,p1[r],p1[r+1]);b=max3f(b,p1[r+2],p1[r+3]);}
  const float m=max2f(a,b);
  auto rr=__builtin_amdgcn_permlane32_swap(__float_as_uint(m),__float_as_uint(m),false,false);
  return max2f(__uint_as_float(rr[0]),__uint_as_float(rr[1]));
}
__device__ __forceinline__ void pv(f32x16*o,int vb,bf16x8 pa0,bf16x8 pa1,bf16x8 pa2,bf16x8 pa3){
  #pragma unroll
  for(int d0=0;d0<2;++d0){s16x4 lo[4],hi[4];
    #pragma unroll
    for(int ks=0;ks<4;++ks){
      asm volatile("ds_read_b64_tr_b16 %0,%1 offset:%c2":"=&v"(lo[ks]):"v"(vb),"i"(d0*4096+ks*1024):"memory");
      asm volatile("ds_read_b64_tr_b16 %0,%1 offset:%c2":"=&v"(hi[ks]):"v"(vb),"i"(d0*4096+ks*1024+512):"memory");}
    asm volatile("s_waitcnt lgkmcnt(0)":::"memory");SBAR();
    #define PK(k) (bf16x8){lo[k][0],lo[k][1],lo[k][2],lo[k][3],hi[k][0],hi[k][1],hi[k][2],hi[k][3]}
    o[d0]=__builtin_amdgcn_mfma_f32_32x32x16_bf16(pa0,PK(0),o[d0],0,0,0);
    o[d0]=__builtin_amdgcn_mfma_f32_32x32x16_bf16(pa1,PK(1),o[d0],0,0,0);
    o[d0]=__builtin_amdgcn_mfma_f32_32x32x16_bf16(pa2,PK(2),o[d0],0,0,0);
    o[d0]=__builtin_amdgcn_mfma_f32_32x32x16_bf16(pa3,PK(3),o[d0],0,0,0);
    #undef PK
  }
}

#ifndef ATTN_STORE16
#define ATTN_STORE16(p,v) (*(u32x4*)(p)=(v))
#endif
template<int THRL> __device__ __forceinline__ void attn_unit(int b,int h,int qb,const bf16*Q,const bf16*__restrict__ K,const bf16*__restrict__ V,bf16*O,const float*__restrict__ KM,int KMH,char*shm){
  const int tid=threadIdx.x,lane=tid&63,r32=lane&31,hi=lane>>5; const int wid=__builtin_amdgcn_readfirstlane(tid>>6);
  const long rowbase=(long)b*SEQ; const int q0=qb*QB;
  const bf16*Qw=Q+(rowbase+q0+wid*QBLK)*QP+h*D;
  const bf16*Kh=K+rowbase*QP+h*D,*Vh=V+rowbase*QP+h*D;
  const unsigned lds0=(unsigned)(uintptr_t)shm;
  float*wsf=(float*)(shm+LDS_WS)+wid*64;
  const bf16*ksrc=Kh+(long)lane*QP+wid*8;
  const bf16*vsrc=Vh+(long)(16*(wid&3)+(lane>>2))*QP+(wid>>2)*32+(lane&3)*8;
  const unsigned kdst=lds0+LDS_K+wid*1024, vdst=lds0+LDS_V+wid*1024;
  #define TI(t) (((t)<4)?(NT-4+(t)):((t)-4))
  #define DMA_K(t,slot) glds16(ksrc+(long)TI(t)*KVBLK*QP,(unsigned)__builtin_amdgcn_readfirstlane(kdst+(slot)))
  #define DMA_V(t,slot) glds16(vsrc+(long)TI(t)*KVBLK*QP,(unsigned)__builtin_amdgcn_readfirstlane(vdst+(slot)))
  const char*Kbase=shm+LDS_K; bf16x8 kf[8];
  const lds_cptr shm3=(lds_cptr)shm; const lds_cptr kp0=shm3+LDS_K+hi*1024+r32*16; const lds_cptr vp0=shm3+LDS_V+((lane>>4)&1)*32+(lane&3)*8+(4*hi+((lane&15)>>2))*64;
  const int NT=(q0+QB)/KVBLK;
  DMA_K(0,0);DMA_V(0,0);DMA_K(1,SLOTB);
  bf16x8 qr[4];
  #pragma unroll
  for(int d0=0;d0<4;++d0)qr[d0]=*reinterpret_cast<const bf16x8*>(&Qw[(long)r32*QP+d0*16+hi*8]);

  unsigned sel=0u;
  if(qb>0){ float gt_[8];
    #pragma unroll
    for(int n=0;n<8;++n){ float a_=0.f;
      if(n<qb){ const float*km=KM+((long)(b*NHEAD+h)*8+n)*64+hi*8;
        #pragma unroll
        for(int d0=0;d0<4;++d0){ float4 k0=*reinterpret_cast<const float4*>(km+d0*16), k1=*reinterpret_cast<const float4*>(km+d0*16+4);
          { const float4 k2=*reinterpret_cast<const float4*>(km+KMH+d0*16), k3=*reinterpret_cast<const float4*>(km+KMH+d0*16+4); k0.x+=k2.x;k0.y+=k2.y;k0.z+=k2.z;k0.w+=k2.w;k1.x+=k3.x;k1.y+=k3.y;k1.z+=k3.z;k1.w+=k3.w; }
          const bf16x8 qv=qr[d0];
          a_+=__uint_as_float(((unsigned)(unsigned short)qv[0])<<16)*k0.x+__uint_as_float(((unsigned)(unsigned short)qv[1])<<16)*k0.y+__uint_as_float(((unsigned)(unsigned short)qv[2])<<16)*k0.z+__uint_as_float(((unsigned)(unsigned short)qv[3])<<16)*k0.w
             +__uint_as_float(((unsigned)(unsigned short)qv[4])<<16)*k1.x+__uint_as_float(((unsigned)(unsigned short)qv[5])<<16)*k1.y+__uint_as_float(((unsigned)(unsigned short)qv[6])<<16)*k1.z+__uint_as_float(((unsigned)(unsigned short)qv[7])<<16)*k1.w; }
        a_+=__shfl_xor(a_,32); }
      gt_[n]=(n<qb)?a_:-1e30f; }
    #pragma unroll
    for(int r_=0;r_<3;++r_){ float bv=-3.0e38f; int best=-1;
      #pragma unroll
      for(int n=0;n<8;++n) if(!((sel>>n)&1u)&&gt_[n]>bv){bv=gt_[n];best=n;}
      if(best>=0&&bv>-0.5e30f) sel|=1u<<best; } }
  if(hi==0)wsf[32+r32]=__uint_as_float(sel); asm volatile("s_waitcnt lgkmcnt(0)":::"memory");
  float mhat=0.f,l_reg=0.f;f32x16 o[2];o[0]=f32x16{};o[1]=f32x16{};
  const int qrel=wid*QBLK+r32;
  #define CMASK(P0,P1,t) do{ if((t)<4){cmask(P0,P1,(t),qrel,hi);} else if(!((__float_as_uint(wsf[32+r32])>>(((t)-4)>>2))&1u)){ _Pragma("unroll") for(int r_=0;r_<16;++r_){P0[r_]=-INFINITY;P1[r_]=-INFINITY;} } }while(0)
  bool resc=false;
  #define START(P0,P1) do{ const float rm=rowmax(P0,P1); resc=false; \
    { const float dl=rm; mhat=fadd_s(mhat,dl); \
      _Pragma("unroll") for(int r=0;r<16;++r){P0[r]=fsub_s(P0[r],dl);P1[r]=fsub_s(P1[r],dl);} \
      } \
    _Pragma("unroll") for(int r=0;r<16;++r)P0[r]=__builtin_amdgcn_exp2f(P0[r]); }while(0)
  #define RESC() do{ if(resc){ asm volatile("s_waitcnt lgkmcnt(0)":::"memory"); \
      _Pragma("unroll") for(int d_=0;d_<2;++d_) _Pragma("unroll") for(int r=0;r<16;++r)o[d_][r]*=wsf[crow(r,hi)]; } }while(0)
  f32x16 pA0,pA1,pB0,pB1;
  int sl_prev=0,sl_cur=0,sl_next=SLOTB;
  #define ROT() do{sl_prev=sl_cur;sl_cur=sl_next;sl_next=(sl_next==(NSLOT-1)*SLOTB)?0:sl_next+SLOTB;}while(0)
  DMA_K(2,2*SLOTB);
  WAIT_BAR(3);
  qkt(pA0,pA1,Kbase,qr,r32,hi);asm volatile("s_nop 15\n\ts_nop 7":"+v"(pA0),"+v"(pA1));CMASK(pA0,pA1,0);
  START(pA0,pA1);
  _Pragma("unroll") for(int r=0;r<16;++r)pA1[r]=__builtin_amdgcn_exp2f(pA1[r]);
  WAIT_BAR(0);
  DMA_K(3,0);DMA_V(1,SLOTB);
  ROT();
  kload8(kf,kp0+sl_cur);
  WAIT_BAR(2);
  s16x4 vlo[8],vhi[8]; u32x4 pw0,pw1,pw2,pw3;
  #define PKW(P,B) cvtpk_s(P[B],P[B+1])
  #define PAF(k) __builtin_bit_cast(bf16x8,pw##k)
  #define VFR(i) (bf16x8){vlo[i][0],vlo[i][1],vlo[i][2],vlo[i][3],vhi[i][0],vhi[i][1],vhi[i][2],vhi[i][3]}
  #define PIN(x) asm volatile("":"+v"(x))
  #define MX3(a,b,c) __builtin_fmaxf(__builtin_fmaxf((a),(b)),(c))
  #define GAPA(MF,A0,A1,A2,A3,W0,W1,PW) do{ MF; sacc+=A0; sacc+=A1; sacc+=A2; sacc+=A3; PIN(sacc); W0; W1; PIN(PW); SBAR(); }while(0)
  #define EX(v) __builtin_amdgcn_exp2f(v)
  #define GAPB(MF,X,B) do{ MF; X[B]=EX(X[B]); X[B+1]=EX(X[B+1]); X[B+2]=EX(X[B+2]); X[B+3]=EX(X[B+3]); PIN(X); SBAR(); }while(0)
  #define VRD(i) do{ vlo[i]=vtr(vp_+(((i)>>2)*4096+((i)&3)*1024)); vhi[i]=vtr(vp_+(((i)>>2)*4096+((i)&3)*1024+512)); }while(0)
  #define KRD(G,j) do{ if(G){ kload2(kf,kp0+sl_next,j); SBAR(); } }while(0)
  #define STEP(C0,C1,P0,P1,t,GK,GV,GL) do{ SBAR(); \
    const lds_cptr vp_=vp0+sl_prev; \
    VRD(0); SBAR(); float sacc=(P0[0]+P0[1]); \
    GAPA(C0=__builtin_amdgcn_mfma_f32_32x32x16_bf16(kf[0],qr[0],f32x16{},0,0,0), P0[2],P0[3],P0[4],P0[5],     pw0[0]=PKW(P0,0), pw0[1]=PKW(P0,2), pw0); \
    VRD(4); SBAR(); GAPA(C1=__builtin_amdgcn_mfma_f32_32x32x16_bf16(kf[1],qr[0],f32x16{},0,0,0), P0[6],P0[7],P0[8],P0[9],     pw0[2]=PKW(P0,4), pw0[3]=PKW(P0,6), pw0); \
    VRD(1); SBAR(); GAPA(C0=__builtin_amdgcn_mfma_f32_32x32x16_bf16(kf[2],qr[1],C0,0,0,0),   P0[10],P0[11],P0[12],P0[13], pw1[0]=PKW(P0,8), pw1[1]=PKW(P0,10), pw1); \
    VRD(5); SBAR(); GAPA(C1=__builtin_amdgcn_mfma_f32_32x32x16_bf16(kf[3],qr[1],C1,0,0,0),   P0[14],P0[15],P1[0],P1[1],   pw1[2]=PKW(P0,12),pw1[3]=PKW(P0,14), pw1); \
    VRD(2); SBAR(); GAPA(C0=__builtin_amdgcn_mfma_f32_32x32x16_bf16(kf[4],qr[2],C0,0,0,0),   P1[2],P1[3],P1[4],P1[5],     pw2[0]=PKW(P1,0), pw2[1]=PKW(P1,2), pw2); \
    VRD(6); SBAR(); GAPA(C1=__builtin_amdgcn_mfma_f32_32x32x16_bf16(kf[5],qr[2],C1,0,0,0),   P1[6],P1[7],P1[8],P1[9],     pw2[2]=PKW(P1,4), pw2[3]=PKW(P1,6), pw2); \
    VRD(3); SBAR(); GAPA(C0=__builtin_amdgcn_mfma_f32_32x32x16_bf16(kf[6],qr[3],C0,0,0,0),   P1[10],P1[11],P1[12],P1[13], pw3[0]=PKW(P1,8), pw3[1]=PKW(P1,10), pw3); \
    VRD(7); SBAR(); GAPA(C1=__builtin_amdgcn_mfma_f32_32x32x16_bf16(kf[7],qr[3],C1,0,0,0),   P1[14],P1[15],0.f,0.f,       pw3[2]=PKW(P1,12),pw3[3]=PKW(P1,14), pw3); \
    l_reg+=sacc; \
    if(GK){DMA_K((t)+3,sl_cur);} if(GV){DMA_V((t)+1,sl_next);} \
    CMASK(C0,C1,t); \
    _Pragma("unroll") for(int r=0;r<16;++r){C0[r]-=mhat;C1[r]-=mhat;} \
    { float a=MX3(C0[0],C0[1],C1[0]),b=MX3(C0[2],C0[3],C1[1]); a=MX3(a,C1[2],C1[3]); \
      _Pragma("unroll") for(int r=4;r<16;r+=4){a=MX3(a,C0[r],C0[r+1]);b=MX3(b,C0[r+2],C0[r+3]);a=MX3(a,C1[r],C1[r+1]);b=MX3(b,C1[r+2],C1[r+3]);} \
      float rm=__builtin_fmaxf(a,b); { auto rr=__builtin_amdgcn_permlane32_swap(__float_as_uint(rm),__float_as_uint(rm),false,false); rm=__builtin_fmaxf(__uint_as_float(rr[0]),__uint_as_float(rr[1])); } \
      resc=false; \
      if(__builtin_expect(__any(rm>(float)THRL),0)){ const float dl=__builtin_fmaxf(rm,0.f); mhat+=dl; \
        _Pragma("unroll") for(int r=0;r<16;++r){C0[r]-=dl;C1[r]-=dl;} \
        const float f=__builtin_amdgcn_exp2f(-dl); l_reg*=f; if(hi==0)wsf[r32]=f; resc=true; } } \
    SBAR(); \
    GAPB(o[0]=__builtin_amdgcn_mfma_f32_32x32x16_bf16(PAF(0),VFR(0),o[0],0,0,0), C0,0); \
    GAPB(o[1]=__builtin_amdgcn_mfma_f32_32x32x16_bf16(PAF(0),VFR(4),o[1],0,0,0), C0,4); \
    KRD(GL,0); GAPB(o[0]=__builtin_amdgcn_mfma_f32_32x32x16_bf16(PAF(1),VFR(1),o[0],0,0,0), C0,8); \
    KRD(GL,1); GAPB(o[1]=__builtin_amdgcn_mfma_f32_32x32x16_bf16(PAF(1),VFR(5),o[1],0,0,0), C0,12); \
    KRD(GL,2); GAPB(o[0]=__builtin_amdgcn_mfma_f32_32x32x16_bf16(PAF(2),VFR(2),o[0],0,0,0), C1,0); \
    KRD(GL,3); GAPB(o[1]=__builtin_amdgcn_mfma_f32_32x32x16_bf16(PAF(2),VFR(6),o[1],0,0,0), C1,4); \
    GAPB(o[0]=__builtin_amdgcn_mfma_f32_32x32x16_bf16(PAF(3),VFR(3),o[0],0,0,0), C1,8); \
    GAPB(o[1]=__builtin_amdgcn_mfma_f32_32x32x16_bf16(PAF(3),VFR(7),o[1],0,0,0), C1,12); \
    }while(0)
  int t=1;
  for(;t+5<NT;t+=2){
    STEP(pB0,pB1,pA0,pA1,t,true,true,true);     WAIT_BAR(2); RESC(); ROT();
    STEP(pA0,pA1,pB0,pB1,t+1,true,true,true);   WAIT_BAR(2); RESC(); ROT();
  }
  #define ENDW(tt) do{ if((tt)+3<NT){WAIT_BAR(2);} else if((tt)+2<NT){WAIT_BAR(1);} else {WAIT_BAR(0);} }while(0)
  for(;t+1<NT;t+=2){
    STEP(pB0,pB1,pA0,pA1,t,(t+3<NT),(t+1<NT),(t+1<NT));       ENDW(t);   RESC(); ROT();
    STEP(pA0,pA1,pB0,pB1,t+1,(t+4<NT),(t+2<NT),(t+2<NT));     ENDW(t+1); RESC(); ROT();
  }
  STEP(pB0,pB1,pA0,pA1,NT-1,false,false,false); RESC();
  { float sacc=pB0[0]+pB0[1]; _Pragma("unroll") for(int r=2;r<16;++r)sacc+=pB0[r]; _Pragma("unroll") for(int r=0;r<16;++r)sacc+=pB1[r]; l_reg+=sacc;
    pw0=(u32x4){PKW(pB0,0),PKW(pB0,2),PKW(pB0,4),PKW(pB0,6)};pw1=(u32x4){PKW(pB0,8),PKW(pB0,10),PKW(pB0,12),PKW(pB0,14)};pw2=(u32x4){PKW(pB1,0),PKW(pB1,2),PKW(pB1,4),PKW(pB1,6)};pw3=(u32x4){PKW(pB1,8),PKW(pB1,10),PKW(pB1,12),PKW(pB1,14)};
    SBAR(); pv(o,(int)(unsigned)(size_t)vp0+sl_cur,PAF(0),PAF(1),PAF(2),PAF(3)); }
  #undef PKW
  #undef PAF
  #undef VFR
  #undef PIN
  #undef MX3
  #undef GAPA
  #undef GAPB
  #undef EX
  #undef VRD
  #undef KRD
  #undef STEP
  #undef ENDW
  {auto rr=__builtin_amdgcn_permlane32_swap(__float_as_uint(l_reg),__float_as_uint(l_reg),false,false);l_reg=__uint_as_float(rr[0])+__uint_as_float(rr[1]);}
  if(hi==0)wsf[32+r32]=l_reg;asm volatile("s_waitcnt lgkmcnt(0)":::"memory");
  float rli[16];
  #pragma unroll
  for(int r=0;r<16;++r)rli[r]=__builtin_amdgcn_rcpf(wsf[32+crow(r,hi)]);
  bf16*Ow=O+(rowbase+q0+wid*QBLK)*OP+h*D;
  { bf16*stg=(bf16*)(shm+LDS_OST)+wid*2048;
    #pragma unroll
    for(int r=0;r<16;++r){const int orow=crow(r,hi);
      #pragma unroll
      for(int d0=0;d0<2;++d0)stg[orow*64+d0*32+r32]=__float2bfloat16(o[d0][r]*rli[r]);}
    asm volatile("s_waitcnt lgkmcnt(0)":::"memory");
    #pragma unroll
    for(int i=0;i<4;++i){const int row=i*8+(lane>>3),ch=lane&7; const u32x4 v=*(const u32x4*)(stg+row*64+ch*8); ATTN_STORE16(Ow+(long)row*OP+ch*8,v);} }
  asm volatile("s_waitcnt lgkmcnt(0)\n\ts_barrier":::"memory");
  #undef DMA_K
  #undef DMA_V
  #undef TI
  #undef CMASK
  #undef START
  #undef RESC
  #undef ROT
}
constexpr int ATTN_LDS_BYTES=LDS_BYTES;
#undef SBAR
#undef WAIT_BAR
}
#undef LAS
constexpr int NB = DEBUG_BUILD ? 2 : 8;
constexpr int M_ = NB * SEQ;
constexpr int NSLOT = 2 * M_ + N_EXP * 256;
constexpr int PLD = 3072;
constexpr int FQ = 0, FK = 384, FV = 768, FZ = 1152, FGU = 1536, FGV = 1792, FXBC = 2048, FDT = 2944;
constexpr int NGU = 2 * D_FF, NGUE = 2 * D_FFE;

constexpr size_t al256(size_t x) { return (x + 255) & ~(size_t)255; }
constexpr size_t MiB = 1u << 20;
constexpr size_t O_CTL = 0, CTL_BYTES = 1 * MiB;
constexpr size_t O_RT = 1 * MiB;
constexpr size_t O_TE = O_RT + (size_t)M_ * 64, O_TP = O_TE + (size_t)M_ * 8, O_TS = O_TP + (size_t)M_ * 8, O_GS = O_TS + (size_t)M_ * 8;
constexpr size_t O_SP = O_GS + (size_t)M_ * 8;
constexpr size_t O_KM = O_SP + al256((size_t)NSLOT * 4);
constexpr size_t O_DT = O_KM + (size_t)2 * NB * ATT_H * NBLK * 64 * 4;
constexpr size_t O_WSB = al256(O_DT + (size_t)M_ * 24);
constexpr size_t O_HB = (O_WSB + (size_t)2 * GM_G * GM_CHUNK * GM_CHUNK * 2 + MiB - 1) / MiB * MiB;
constexpr size_t O_MWGU = O_HB + (size_t)M_ * DM * 2;
constexpr size_t O_WIN = O_MWGU + (size_t)N_EXP * NGUE * DM * 2;
constexpr size_t O_WOUT = O_WIN + (size_t)2 * PLD * DM * 2;
constexpr size_t O_WGU = O_WOUT + (size_t)2 * DM * DM * 2;
constexpr size_t O_WD = O_WGU + (size_t)NGU * DM * 2;
constexpr size_t O_SCR = O_WD + (size_t)DM * D_FF * 2;
constexpr size_t O_PROJ = O_SCR;
constexpr size_t O_XC = O_PROJ + (size_t)M_ * PLD * 2;
constexpr size_t O_MIXU = O_XC + (size_t)M_ * SSD_CW * 2;
constexpr size_t O_MIXB = O_MIXU + (size_t)M_ * DM * 4;
constexpr size_t O_VN = O_MIXB + (size_t)M_ * DM * 2;
constexpr size_t O_MIXEND = O_VN + (size_t)M_ * GM_W * 4;
constexpr size_t O_Y = O_SCR;
constexpr size_t O_ACT = O_Y + (size_t)M_ * DM * 4;
constexpr size_t O_XG = O_WIN;
constexpr size_t O_ACTM = O_XG + (size_t)NSLOT * DM * 2;
constexpr size_t O_MOEEND = O_ACTM + (size_t)NSLOT * D_FFE * 2;
constexpr size_t WS_END = O_MOEEND > O_MIXEND ? O_MOEEND : O_MIXEND;
static_assert(O_ACT + (size_t)M_ * D_FF * 2 <= O_MIXEND + (size_t)M_ * 4096, "act");
static_assert((size_t)NB * 16 * SSD_H * 8192 * 4 <= (size_t)M_ * SSD_CW * 2, "SSD states fit in the XC slot");
static_assert((size_t)NB * 32 * 768 * 4 <= (size_t)M_ * GM_W * 4, "dt/acum hand-off fits in the VN slot");
static_assert(WS_END <= 487000000ull, "workspace map exceeds the guaranteed size");
static_assert((size_t)N_EXP * DM * D_FFE * 2 <= (size_t)N_EXP * NGUE * DM * 2, "MWD fits over MWGU");
constexpr int CW_BAR = 4096, CW_CNT = 1024, CW_Q = 1040, CW_ERR = 2048;

constexpr int RING_BYTES = 131072, MISC_OFF = RING_BYTES + 320, LDS_BYTES = 147456;

#define GAS __attribute__((address_space(1)))
#define LAS __attribute__((address_space(3)))
typedef GAS unsigned gu32;
#define RLX_AGENT __ATOMIC_RELAXED, __HIP_MEMORY_SCOPE_AGENT
#define LDS_WAIT() asm volatile("s_waitcnt lgkmcnt(0)" ::: "memory")

constexpr float QSCALE = 0.125f * 1.4426950408889634f;
namespace fp {
using pg8::Unit; using pg8::BM; using pg8::HALF; typedef pg8::f32x4 f32x4; typedef pg8::u32x4 u32x4;
__device__ __forceinline__ unsigned pk2(float lo, float hi) { return pg8::cvt_pk_bf16(lo, hi); }
__device__ __forceinline__ float gelu_fast(float x) { const float u = 0.7978845608028654f * (x + 0.044715f * x * x * x); return x / (1.f + __expf(-2.f * u)); }

struct EpiProj {
    static constexpr bool PERM = true, AFTER_DRAIN = false;
    bf16* O; const float* RT; float* KM2;
    __device__ __forceinline__ void operator()(const f32x4 (&acc)[2][2][4][2], const Unit& u, int wr, int wc, int fr, int fq) const {
        const int row0 = u.pm * BM + wr * 64 + fr, col0 = u.pn * BM + wc * 32 + 8 * fq;
        f32x4 ks[2][2];
#pragma unroll
        for (int i = 0; i < 2; ++i) { ks[i][0] = (f32x4){0.f, 0.f, 0.f, 0.f}; ks[i][1] = ks[i][0]; }
        const int mode = (u.pn < 3) ? 1 : ((u.pn == 6 || u.pn == 7) ? 2 : 0);
        const bool rl = ((wc & 1) == 0) && (fq < 2);
        const int i0 = (fq & 1) * 4;
#pragma unroll
        for (int ai = 0; ai < 2; ++ai)
#pragma unroll
            for (int m = 0; m < 4; ++m) { const int row = row0 + ai * HALF + m * 16;
                float4 c4 = make_float4(1.f, 1.f, 1.f, 1.f), s4 = make_float4(0.f, 0.f, 0.f, 0.f);
                if (mode == 1 && rl) { c4 = *(const float4*)(RT + (size_t)row * 16 + i0); s4 = *(const float4*)(RT + (size_t)row * 16 + 8 + i0); }
#pragma unroll
                for (int bj = 0; bj < 2; ++bj) { f32x4 v0 = acc[ai][bj][m][0], v1 = acc[ai][bj][m][1];
                    if (mode == 1) { const f32x4 a = v0, b = v1;
                        v0[0] = a[0] * c4.x - a[1] * s4.x; v0[1] = a[1] * c4.x + a[0] * s4.x; v0[2] = a[2] * c4.y - a[3] * s4.y; v0[3] = a[3] * c4.y + a[2] * s4.y;
                        v1[0] = b[0] * c4.z - b[1] * s4.z; v1[1] = b[1] * c4.z + b[0] * s4.z; v1[2] = b[2] * c4.w - b[3] * s4.w; v1[3] = b[3] * c4.w + b[2] * s4.w; }
                    if (u.pn == 0 || (u.pn == 1 && bj == 0)) { v0 = v0 * QSCALE; v1 = v1 * QSCALE; }
                    else if (mode == 1) { ks[bj][0] += v0; ks[bj][1] += v1; }
                    if (mode == 2) {
#pragma unroll
                        for (int j = 0; j < 4; ++j) { v0[j] = gelu_fast(v0[j]); v1[j] = gelu_fast(v1[j]); } }
                    u32x4 w; w.x = pk2(v0[0], v0[1]); w.y = pk2(v0[2], v0[3]); w.z = pk2(v1[0], v1[1]); w.w = pk2(v1[2], v1[3]);
                    *(u32x4*)(O + (size_t)row * PLD + col0 + bj * HALF) = w; } }
        if (u.pn == 1 || u.pn == 2) {
#pragma unroll
            for (int bj = 0; bj < 2; ++bj) { if (u.pn == 1 && bj == 0) continue;
#pragma unroll
                for (int n = 0; n < 2; ++n)
#pragma unroll
                    for (int j = 0; j < 4; ++j) { float x = ks[bj][n][j]; x += __shfl_xor(x, 1); x += __shfl_xor(x, 2); x += __shfl_xor(x, 4); x += __shfl_xor(x, 8); ks[bj][n][j] = x * (1.f / 256.f); }
                if (fr == 0) { const int kc = col0 + bj * HALF - FK; const int b = u.pm >> 3, nb = u.pm & 7;
                    float* dst = KM2 + (size_t)wr * (NB * ATT_H * NBLK * 64) + ((size_t)(b * ATT_H + (kc >> 6)) * NBLK + nb) * 64 + (kc & 63);
                    *(f32x4*)dst = ks[bj][0]; *(f32x4*)(dst + 4) = ks[bj][1]; } }
        }
    }
};
struct EpiAct {
    static constexpr bool PERM = true, AFTER_DRAIN = false;
    bf16* O; int ldc, ncol;
    __device__ __forceinline__ void operator()(const f32x4 (&acc)[2][2][4][2], const Unit& u, int wr, int wc, int fr, int fq) const {
        const int row0 = u.pm * BM + wr * 64 + fr, col0 = (u.pn % ncol) * HALF + wc * 32 + 8 * fq;
#pragma unroll
        for (int ai = 0; ai < 2; ++ai)
#pragma unroll
            for (int m = 0; m < 4; ++m) { const int row = row0 + ai * HALF + m * 16;
                const f32x4 g0 = acc[ai][0][m][0], g1 = acc[ai][0][m][1], u0 = acc[ai][1][m][0], u1 = acc[ai][1][m][1]; f32x4 a0, a1;
#pragma unroll
                for (int j = 0; j < 4; ++j) { a0[j] = g0[j] / (1.f + __expf(-g0[j])) * u0[j]; a1[j] = g1[j] / (1.f + __expf(-g1[j])) * u1[j]; }
                u32x4 w; w.x = pk2(a0[0], a0[1]); w.y = pk2(a0[2], a0[3]); w.z = pk2(a1[0], a1[1]); w.w = pk2(a1[2], a1[3]);
                *(u32x4*)(O + (size_t)row * ldc + col0) = w; }
    }
};
struct EpiF32 {
    static constexpr bool PERM = false, AFTER_DRAIN = false;
    float* O; int ldc;
    __device__ __forceinline__ void operator()(const f32x4 (&acc)[2][2][4][2], const Unit& u, int wr, int wc, int fr, int fq) const {
        const int row0 = u.pm * BM + wr * 64 + fr, col0 = u.pn * BM + wc * 32 + 4 * fq;
#pragma unroll
        for (int ai = 0; ai < 2; ++ai)
#pragma unroll
            for (int m = 0; m < 4; ++m) { float* rp = O + (size_t)(row0 + ai * HALF + m * 16) * ldc + col0;
#pragma unroll
                for (int bj = 0; bj < 2; ++bj)
#pragma unroll
                    for (int n = 0; n < 2; ++n) *(f32x4*)(rp + bj * HALF + n * 16) = acc[ai][bj][m][n]; }
    }
};
struct EpiY {
    static constexpr bool PERM = true, AFTER_DRAIN = false;
    bf16* O; int ldc;
    __device__ __forceinline__ void operator()(const f32x4 (&acc)[2][2][4][2], const Unit& u, int wr, int wc, int fr, int fq) const {
        const int row0 = u.pm * BM + wr * 64 + fr, col0 = u.pn * BM + wc * 32 + 8 * fq;
#pragma unroll
        for (int ai = 0; ai < 2; ++ai)
#pragma unroll
            for (int m = 0; m < 4; ++m) { bf16* rp = O + (size_t)(row0 + ai * HALF + m * 16) * ldc + col0;
#pragma unroll
                for (int bj = 0; bj < 2; ++bj) { const f32x4 v0 = acc[ai][bj][m][0], v1 = acc[ai][bj][m][1];
                    u32x4 w; w.x = pk2(v0[0], v0[1]); w.y = pk2(v0[2], v0[3]); w.z = pk2(v1[0], v1[1]); w.w = pk2(v1[2], v1[3]);
                    *(u32x4*)(rp + bj * HALF) = w; } }
    }
};
struct EpiF2 {
    static constexpr bool PERM = true, AFTER_DRAIN = false;
    bf16* O; const float* SP;
    __device__ __forceinline__ void operator()(const f32x4 (&acc)[2][2][4][2], const Unit& u, int wr, int wc, int fr, int fq) const {
        const int row0 = u.pm * BM + wr * 64 + fr, col0 = (u.pn & 3) * BM + wc * 32 + 8 * fq;
#pragma unroll
        for (int ai = 0; ai < 2; ++ai)
#pragma unroll
            for (int m = 0; m < 4; ++m) { const int row = row0 + ai * HALF + m * 16; const float sc = SP[row];
#pragma unroll
                for (int bj = 0; bj < 2; ++bj) { const f32x4 v0 = acc[ai][bj][m][0] * sc, v1 = acc[ai][bj][m][1] * sc;
                    u32x4 w; w.x = pk2(v0[0], v0[1]); w.y = pk2(v0[2], v0[3]); w.z = pk2(v1[0], v1[1]); w.w = pk2(v1[2], v1[3]);
                    *(u32x4*)(O + (size_t)row * DM + col0 + bj * HALF) = w; } }
    }
};
struct MoeOrder {
    int p0, p1, p2, p3, p4, p5, p6, T, ncol, G, c;
    __device__ __forceinline__ void init(const int* CNT, int ncol_, int G_, int c_) {
        int t = 0; t += (CNT[0] + 255) >> 8; p0 = t; t += (CNT[1] + 255) >> 8; p1 = t; t += (CNT[2] + 255) >> 8; p2 = t; t += (CNT[3] + 255) >> 8; p3 = t;
        t += (CNT[4] + 255) >> 8; p4 = t; t += (CNT[5] + 255) >> 8; p5 = t; t += (CNT[6] + 255) >> 8; p6 = t; t += (CNT[7] + 255) >> 8; T = t; ncol = ncol_; G = G_; c = c_;
    }
    __device__ __forceinline__ bool next(int i, Unit& u) const {
        const long L = (long)i * G + c; if (L >= (long)T * ncol) return false;
        const int tm = (int)(L / ncol), j = (int)(L % ncol);
        const int e = (tm >= p0) + (tm >= p1) + (tm >= p2) + (tm >= p3) + (tm >= p4) + (tm >= p5) + (tm >= p6);
        u.pm = tm; u.pn = e * ncol + j; return true;
    }
    __device__ __forceinline__ void a_ready(const Unit&) const {}
    __device__ __forceinline__ void done(const Unit&) const {}
};

struct SrcCol { const float* p; int ld; };
__device__ __forceinline__ int win_src_col(int d) {
    if (d < 768) { const int hd = d & 63; const int sd = hd < 16 ? ((hd & 1) ? 8 + (hd >> 1) : (hd >> 1)) : hd; return d - hd + sd; }
    if (d < 1536) return d;
    if (d < 1792) return 2438 + (d - 1536);
    if (d < 2048) return 2694 + (d - 1792);
    if (d < 2944) return 1536 + (d - 2048);
    if (d < 2950) return 2432 + (d - 2944);
    return -1;
}
__device__ __forceinline__ SrcCol gu_src(const float* wg, const float* wu, int nff, int r) {
    const int tile = r >> 8, rr = r & 255, j = tile * 128 + (rr & 127); SrcCol s; s.p = (rr < 128 ? wg : wu) + j; s.ld = nff; return s;
}
__device__ __forceinline__ void conv_item(SrcCol sc, int K, bf16* WT, long d0, int k0, LAS float* scr, int lane) {
    float tv[32];
#pragma unroll
    for (int i = 0; i < 32; ++i) { const int kk = 2 * i + (lane >> 5); tv[i] = sc.p ? sc.p[(size_t)(k0 + kk) * sc.ld] : 0.f; }
#pragma unroll
    for (int i = 0; i < 32; ++i) { const int kk = 2 * i + (lane >> 5); scr[kk * 33 + (lane & 31)] = tv[i]; }
    LDS_WAIT(); asm volatile("" ::: "memory");
    const int c = lane & 7;
#pragma unroll
    for (int j = 0; j < 4; ++j) { const int n = (lane >> 3) + 8 * j; const LAS float* s = scr + (8 * c) * 33 + n;
        u32x4 o; o.x = pk2(s[0 * 33], s[1 * 33]); o.y = pk2(s[2 * 33], s[3 * 33]); o.z = pk2(s[4 * 33], s[5 * 33]); o.w = pk2(s[6 * 33], s[7 * 33]);
        *(u32x4*)(WT + (size_t)(d0 + n) * K + k0 + 8 * c) = o; }
    LDS_WAIT(); asm volatile("" ::: "memory");
}
}


typedef short bf16x8_t __attribute__((ext_vector_type(8)));
typedef float f32x4_t __attribute__((ext_vector_type(4)));
constexpr int TLD = 272;
__device__ __forceinline__ bf16x8_t lds_frag(const LAS unsigned char* base, int row, int kbyte) { return *(const LAS bf16x8_t*)(base + row * TLD + kbyte); }
__device__ __forceinline__ float red16(float v) { v += __shfl_xor(v, 1); v += __shfl_xor(v, 2); v += __shfl_xor(v, 4); v += __shfl_xor(v, 8); return v; }

__device__ __forceinline__ void gm_unit(int b, int c, const bf16* PROJ, const bf16* WSB  , const float* ln_g, const float* ln_b, const float* b_s, const float* norm_g,
                                        bf16* MIXB, LAS unsigned char* lds, int wave, int lane) {
    const long r0 = (long)b * SEQ + c * GM_CHUNK;
    LAS unsigned char* VNT = lds;
    for (int i = 0; i < 16; ++i) { const int t = wave * 16 + i;
        const float4 v = ld4(PROJ + (r0 + t) * PLD + FGV + lane * 4);
        const float mean = wave_sum((v.x + v.y) + (v.z + v.w)) * (1.f / 256.f);
        const float d0 = v.x - mean, d1 = v.y - mean, d2 = v.z - mean, d3 = v.w - mean;
        const float rstd = rsqrtf(wave_sum((d0 * d0 + d1 * d1) + (d2 * d2 + d3 * d3)) * (1.f / 256.f) + 1e-5f);
        const float4 gg = *(const float4*)(ln_g + lane * 4), bb = *(const float4*)(ln_b + lane * 4);
        LAS bf16* dst = (LAS bf16*)(VNT + (lane * 4) * TLD) + t;
        dst[0] = (bf16)f2bf(d0 * rstd * gg.x + bb.x); dst[TLD / 2] = (bf16)f2bf(d1 * rstd * gg.y + bb.y); dst[TLD] = (bf16)f2bf(d2 * rstd * gg.z + bb.z); dst[3 * TLD / 2] = (bf16)f2bf(d3 * rstd * gg.w + bb.w); }
    __syncthreads();
    f32x4_t acc[16];
#pragma unroll
    for (int i = 0; i < 16; ++i) acc[i] = (f32x4_t){0.f, 0.f, 0.f, 0.f};
    const int fr = lane & 15, fq = lane >> 4;
    const int nks = (wave * 16 + 15) / 32 + 1;
    for (int ks = 0; ks < nks; ++ks) {
#pragma unroll
        for (int g = 0; g < 4; ++g) {
            const bf16x8_t af = *(const bf16x8_t*)(WSB + ((size_t)g * GM_CHUNK + wave * 16 + fr) * GM_CHUNK + ks * 32 + fq * 8);
#pragma unroll
            for (int n = 0; n < 4; ++n) { const bf16x8_t bfv = lds_frag(VNT, g * 64 + n * 16 + fr, ks * 64 + fq * 16);
                acc[g * 4 + n] = __builtin_amdgcn_mfma_f32_16x16x32_bf16(af, bfv, acc[g * 4 + n], 0, 0, 0); }
        }
    }
    __syncthreads();
    LAS bf16* ost = (LAS bf16*)(lds + wave * (16 * 264 * 2));
    float ss[4] = {0.f, 0.f, 0.f, 0.f};
#pragma unroll
    for (int nt = 0; nt < 16; ++nt) { const int col = nt * 16 + fr, g = nt >> 2;
#pragma unroll
        for (int r = 0; r < 4; ++r) { const int t = wave * 16 + fq * 4 + r;
            const float u = ldf(PROJ + (r0 + t) * PLD + FGU + col);
            const float o = u * (acc[nt][r] + b_s[g * GM_CHUNK + t]); acc[nt][r] = o; ss[r] += o * o; } }
#pragma unroll
    for (int r = 0; r < 4; ++r) ss[r] = rsqrtf(red16(ss[r]) * (1.f / 256.f) + 1e-5f);
#pragma unroll
    for (int nt = 0; nt < 16; ++nt) { const int col = nt * 16 + fr; const float gn = norm_g[col];
#pragma unroll
        for (int r = 0; r < 4; ++r) { ost[(fq * 4 + r) * 264 + col] = (bf16)f2bf(acc[nt][r] * ss[r] * gn); } }
    LDS_WAIT(); asm volatile("" ::: "memory");
#pragma unroll
    for (int i = 0; i < 8; ++i) { const int rr = i * 2 + (lane >> 5), ch = lane & 31;
        const fp::u32x4 v = *(const LAS fp::u32x4*)(ost + rr * 264 + ch * 8);
        *(fp::u32x4*)(MIXB + (r0 + wave * 16 + rr) * DM + ATT_W + SSD_W + ch * 8) = v; }
    __syncthreads();
}

typedef short v4i16_t __attribute__((ext_vector_type(4)));
typedef unsigned u32x2_t __attribute__((ext_vector_type(2)));
__device__ __forceinline__ v4i16_t lds_tr(const LAS unsigned char* p) { return __builtin_amdgcn_ds_read_tr16_b64_v4i16((LAS v4i16_t*)p); }
__device__ __forceinline__ bf16x8_t lds_frag_tr(const LAS unsigned char* tile, int pitch, int k0, int c0, int lane) {
    const int kg = lane >> 4, q = (lane & 15) >> 2, p = lane & 3;
    const LAS unsigned char* a = tile + (k0 + 8 * kg + q) * pitch + (c0 + 4 * p) * 2;
    const v4i16_t lo = lds_tr(a), hi = lds_tr(a + 4 * pitch);
    return (bf16x8_t){lo[0], lo[1], lo[2], lo[3], hi[0], hi[1], hi[2], hi[3]};
}
__device__ __forceinline__ bf16x8_t lds_frag_p(const LAS unsigned char* base, int pitch, int row, int kbyte) { return *(const LAS bf16x8_t*)(base + row * pitch + kbyte); }
template <int NCH, bool SCALE, bool TOLDS> __device__ __forceinline__ void conv_rows(const bf16* PROJ, long r0, int t0, int colbase, int ch0, const float* cw, const float* cb, LAS unsigned char* tile, int pitch,
                                                                                       const LAS float* scl, bf16* XCg  , int tid) {
    constexpr int CPR = NCH / 8, RG = 512 / CPR, RPT = (128 + RG - 1) / RG;
    if (tid < CPR * RG) { const int ch = (tid % CPR) * 8, l0 = (tid / CPR) * RPT;
        float w[4][8], bs[8];
        { const float4 c0 = *(const float4*)(cb + ch0 + ch), c1 = *(const float4*)(cb + ch0 + ch + 4); bs[0] = c0.x; bs[1] = c0.y; bs[2] = c0.z; bs[3] = c0.w; bs[4] = c1.x; bs[5] = c1.y; bs[6] = c1.z; bs[7] = c1.w; }
#pragma unroll
        for (int i = 0; i < 4; ++i) { const float4 w0 = *(const float4*)(cw + i * SSD_CW + ch0 + ch), w1 = *(const float4*)(cw + i * SSD_CW + ch0 + ch + 4);
            w[i][0] = w0.x; w[i][1] = w0.y; w[i][2] = w0.z; w[i][3] = w0.w; w[i][4] = w1.x; w[i][5] = w1.y; w[i][6] = w1.z; w[i][7] = w1.w; }
        fp::u32x4 xr[RPT + 3];
#pragma unroll
        for (int j = 0; j < RPT + 3; ++j) { const int l = l0 - 3 + j; xr[j] = (fp::u32x4){0u, 0u, 0u, 0u};
            if (l < 128 && t0 + l >= 0) xr[j] = *(const fp::u32x4*)(PROJ + (r0 + l) * PLD + colbase + ch); }
#pragma unroll
        for (int j = 0; j < RPT; ++j) { const int l = l0 + j; if (l < 128) {
            float a[8];
#pragma unroll
            for (int e = 0; e < 8; ++e) a[e] = bs[e];
#pragma unroll
            for (int i = 0; i < 4; ++i) { const fp::u32x4 xv = xr[j + i];
#pragma unroll
                for (int e = 0; e < 4; ++e) { a[2 * e] += w[i][2 * e] * __uint_as_float(xv[e] << 16); a[2 * e + 1] += w[i][2 * e + 1] * __uint_as_float(xv[e] & 0xffff0000u); } }
#pragma unroll
            for (int e = 0; e < 8; ++e) a[e] = a[e] / (1.f + __expf(-a[e]));
            fp::u32x4 o; o.x = fp::pk2(a[0], a[1]); o.y = fp::pk2(a[2], a[3]); o.z = fp::pk2(a[4], a[5]); o.w = fp::pk2(a[6], a[7]);
            *(fp::u32x4*)(XCg + (r0 + l) * SSD_CW + ch) = o;
            if (TOLDS) { if (SCALE) { const float sc = scl[(ch >> 6) * 128 + l]; o.x = fp::pk2(a[0] * sc, a[1] * sc); o.y = fp::pk2(a[2] * sc, a[3] * sc); o.z = fp::pk2(a[4] * sc, a[5] * sc); o.w = fp::pk2(a[6] * sc, a[7] * sc); }
                *(LAS fp::u32x4*)(tile + l * pitch + ch * 2) = o; } } }
    }
}
template <int NCH> __device__ __forceinline__ void load_xc_tile(const bf16* XCg, long r0, LAS unsigned char* tile, int pitch, int tid) {
    constexpr int CPR = NCH / 8;
    for (int it = tid; it < 128 * CPR; it += 512) { const int l = it / CPR, ch = (it % CPR) * 8;
        *(LAS fp::u32x4*)(tile + l * pitch + ch * 2) = *(const fp::u32x4*)(XCg + (r0 + l) * SSD_CW + ch); }
}
__device__ __forceinline__ void ssd_dt_acum(const bf16* PROJ, long r0, int g, const float* dt_bias, const float* a_log, LAS float* dtS, LAS float* acS, int tid, int wave, int lane) {
    if (tid < 384) { const int hh = tid >> 7, l = tid & 127, h = 3 * g + hh;
        const float dtv = softplus_f(ldf(PROJ + (r0 + l) * PLD + FDT + h) + dt_bias[h]); dtS[tid] = dtv; acS[tid] = dtv * (-__expf(a_log[h])); }
    __syncthreads();
    if (wave < 3) { const float a0 = acS[wave * 128 + 2 * lane], a1 = acS[wave * 128 + 2 * lane + 1]; const float sm = a0 + a1; float v = sm;
#pragma unroll
        for (int o = 1; o < 64; o <<= 1) { const float t = __shfl_up(v, o); if (lane >= o) v += t; }
        const float ex = v - sm; acS[wave * 128 + 2 * lane] = ex + a0; acS[wave * 128 + 2 * lane + 1] = ex + sm; }
    __syncthreads();
}
constexpr int XP = 400;
__device__ __forceinline__ void ssdA_unit(int b, int c, int g, const bf16* PROJ, const float* cw, const float* cb, const float* dt_bias, const float* a_log, float* ST, float* CD, bf16* XC, float* DTG,
                                          LAS unsigned char* lds, int tid, int wave, int lane) {
    asm volatile("" : "+v"(tid), "+v"(lane));
    const long r0 = (long)b * SEQ + c * 128; const int t0 = c * 128;
    LAS unsigned char* XS = lds; LAS unsigned char* BS = lds + 51200;
    LAS float* dtS = (LAS float*)(lds + 86016); LAS float* acS = dtS + 384; LAS float* sclS = acS + 384;
    ssd_dt_acum(PROJ, r0, g, dt_bias, a_log, dtS, acS, tid, wave, lane);
    if (tid < 384) { const int hh = tid >> 7; const float al = acS[hh * 128 + 127]; sclS[tid] = dtS[tid] * __expf(al - acS[tid]);
        float* dg = DTG + (((long)b * 16 + c) * 2 + g) * 768; dg[tid] = dtS[tid]; dg[384 + tid] = acS[tid];
        if ((tid & 127) == 0) CD[((long)b * 16 + c) * SSD_H + 3 * g + hh] = __expf(al); }
    __syncthreads();
    conv_rows<192, true, true>(PROJ, r0, t0, FXBC + 192 * g, 192 * g, cw, cb, XS, XP, sclS, XC + 192 * g, tid);
    conv_rows<128, false, true>(PROJ, r0, t0, FXBC + SSD_W + 128 * g, SSD_W + 128 * g, cw, cb, BS, TLD, nullptr, XC + SSD_W + 128 * g, tid);
    conv_rows<128, false, false>(PROJ, r0, t0, FXBC + SSD_W + 256 + 128 * g, SSD_W + 256 + 128 * g, cw, cb, nullptr, 0, nullptr, XC + SSD_W + 256 + 128 * g, tid);
    __syncthreads();
    f32x4_t acc[12];
#pragma unroll
    for (int i = 0; i < 12; ++i) acc[i] = (f32x4_t){0.f, 0.f, 0.f, 0.f};
#pragma unroll 1
    for (int ks = 0; ks < 4; ++ks) { const bf16x8_t bfv = lds_frag_tr(BS, TLD, ks * 32, 16 * wave, lane);
#pragma unroll
        for (int mt = 0; mt < 12; ++mt) { const bf16x8_t af = lds_frag_tr(XS, XP, ks * 32, (mt >> 2) * 64 + (mt & 3) * 16, lane); acc[mt] = __builtin_amdgcn_mfma_f32_16x16x32_bf16(af, bfv, acc[mt], 0, 0, 0); } }
    const int fr = lane & 15, fq = lane >> 4;
    float* sp = ST + (((long)b * 16 + c) * SSD_H + 3 * g) * 8192 + 16 * wave + fr;
#pragma unroll
    for (int mt = 0; mt < 12; ++mt)
#pragma unroll
        for (int r = 0; r < 4; ++r) sp[(mt >> 2) * 8192 + ((mt & 3) * 16 + 4 * fq + r) * 128] = acc[mt][r];
    __syncthreads();
}
__device__ __forceinline__ void ssdB_unit(int b, int c, int g, const bf16* PROJ, const bf16* XC, const float* DTG, const float* dsk, const float* ng,
                                          const float* ST, const float* CD, bf16* MIXB, LAS unsigned char* lds, int tid, int wave, int lane) {
    const long r0 = (long)b * SEQ + c * 128;
    LAS unsigned char* CS = lds; LAS unsigned char* PX = lds + 34816; LAS unsigned char* BG = lds + 87040;
    LAS float* dtS = (LAS float*)(lds + 121856); LAS float* acS = dtS + 384;
    const int fr = lane & 15, fq = lane >> 4;
    if (tid < 384) { const float* dg = DTG + (((long)b * 16 + c) * 2 + g) * 768; dtS[tid] = dg[tid]; acS[tid] = dg[384 + tid]; }
    load_xc_tile<128>(XC + SSD_W + 256 + 128 * g, r0, CS, TLD, tid);
    if (c > 0) {
        float4 pv[12];
#pragma unroll
        for (int i = 0; i < 12; ++i) pv[i] = make_float4(0.f, 0.f, 0.f, 0.f);
        const float* sbase = ST + ((long)b * 16 * SSD_H + 3 * g) * 8192 + tid * 4; const float* cbase = CD + (long)b * 16 * SSD_H + 3 * g;
        int j = 0;
        for (; j + 1 < c; j += 2) { const float* s0 = sbase + (long)j * SSD_H * 8192; const float* s1 = s0 + SSD_H * 8192; const float* c0 = cbase + j * SSD_H; const float* c1 = c0 + SSD_H;
            float4 v0[12], v1[12];
#pragma unroll
            for (int i = 0; i < 12; ++i) { v0[i] = *(const float4*)(s0 + i * 2048); v1[i] = *(const float4*)(s1 + i * 2048); }
            const float d00 = c0[0], d01 = c0[1], d02 = c0[2], d10 = c1[0], d11 = c1[1], d12 = c1[2];
#pragma unroll
            for (int i = 0; i < 12; ++i) { const float da = (i < 4) ? d00 : ((i < 8) ? d01 : d02), db = (i < 4) ? d10 : ((i < 8) ? d11 : d12);
                pv[i].x = (pv[i].x * da + v0[i].x) * db + v1[i].x; pv[i].y = (pv[i].y * da + v0[i].y) * db + v1[i].y; pv[i].z = (pv[i].z * da + v0[i].z) * db + v1[i].z; pv[i].w = (pv[i].w * da + v0[i].w) * db + v1[i].w; } }
        if (j < c) { const float* s0 = sbase + (long)j * SSD_H * 8192; const float* c0 = cbase + j * SSD_H; const float d0 = c0[0], d1 = c0[1], d2 = c0[2];
#pragma unroll
            for (int i = 0; i < 12; ++i) { const float4 sv = *(const float4*)(s0 + i * 2048); const float d = (i < 4) ? d0 : ((i < 8) ? d1 : d2);
                pv[i].x = pv[i].x * d + sv.x; pv[i].y = pv[i].y * d + sv.y; pv[i].z = pv[i].z * d + sv.z; pv[i].w = pv[i].w * d + sv.w; } }
#pragma unroll
        for (int i = 0; i < 12; ++i) { const int row = (i >> 2) * 64 + (i & 3) * 16 + (tid >> 5), n = (tid & 31) * 4;
            u32x2_t w; w.x = fp::pk2(pv[i].x, pv[i].y); w.y = fp::pk2(pv[i].z, pv[i].w); *(LAS u32x2_t*)(PX + row * TLD + n * 2) = w; }
    }
    __syncthreads();
    f32x4_t acc_y[12];
#pragma unroll
    for (int i = 0; i < 12; ++i) acc_y[i] = (f32x4_t){0.f, 0.f, 0.f, 0.f};
    if (c > 0) {
#pragma unroll 1
        for (int ks = 0; ks < 4; ++ks) { const bf16x8_t af = lds_frag_p(CS, TLD, 16 * wave + fr, ks * 64 + fq * 16);
#pragma unroll
            for (int t = 0; t < 12; ++t) { const bf16x8_t bfv = lds_frag_p(PX, TLD, (t >> 2) * 64 + (t & 3) * 16 + fr, ks * 64 + fq * 16); acc_y[t] = __builtin_amdgcn_mfma_f32_16x16x32_bf16(af, bfv, acc_y[t], 0, 0, 0); } }
#pragma unroll
        for (int t = 0; t < 12; ++t)
#pragma unroll
            for (int r = 0; r < 4; ++r) acc_y[t][r] *= __expf(acS[(t >> 2) * 128 + 16 * wave + 4 * fq + r]);
    }
    __syncthreads();
    load_xc_tile<192>(XC + 192 * g, r0, PX, XP, tid);
    load_xc_tile<128>(XC + SSD_W + 128 * g, r0, BG, TLD, tid);
    __syncthreads();
#if defined(SSDB_CUT) && SSDB_CUT == 2
    { float t_ = 0.f; for (int i = 0; i < 12; ++i) t_ += acc_y[i][0] + acc_y[i][1] + acc_y[i][2] + acc_y[i][3]; if (t_ == 123.f) MIXB[0] = 1; return; }
#endif
    f32x4_t acc_cb[8];
#pragma unroll
    for (int i = 0; i < 8; ++i) acc_cb[i] = (f32x4_t){0.f, 0.f, 0.f, 0.f};
#pragma unroll 1
    for (int ks = 0; ks < 4; ++ks) { const bf16x8_t af = lds_frag_p(CS, TLD, 16 * wave + fr, ks * 64 + fq * 16);
#pragma unroll
        for (int ns = 0; ns < 8; ++ns) if (ns <= wave) { const bf16x8_t bfv = lds_frag_p(BG, TLD, 16 * ns + fr, ks * 64 + fq * 16); acc_cb[ns] = __builtin_amdgcn_mfma_f32_16x16x32_bf16(af, bfv, acc_cb[ns], 0, 0, 0); } }
    __syncthreads();
    LAS unsigned char* GS = BG + wave * 16 * TLD;
    const int nks = (16 * wave + 15) / 32 + 1;
#pragma unroll
    for (int hh = 0; hh < 3; ++hh) {
#pragma unroll
        for (int ns = 0; ns < 8; ++ns) if (ns <= (wave | 1)) {
#pragma unroll
            for (int r = 0; r < 4; ++r) { const int l = 16 * wave + 4 * fq + r, sidx = 16 * ns + fr;
                const float gv = (ns <= wave && sidx <= l) ? acc_cb[ns][r] * __expf(acS[hh * 128 + l] - acS[hh * 128 + sidx]) * dtS[hh * 128 + sidx] : 0.f;
                *(LAS bf16*)(GS + (4 * fq + r) * TLD + sidx * 2) = (bf16)f2bf(gv); } }
        LDS_WAIT(); asm volatile("" ::: "memory");
#pragma unroll 1
        for (int ks = 0; ks < nks; ++ks) { const bf16x8_t af = lds_frag_p(GS, TLD, fr, ks * 64 + fq * 16);
#pragma unroll
            for (int np = 0; np < 4; ++np) { const bf16x8_t bfv = lds_frag_tr(PX, XP, ks * 32, hh * 64 + np * 16, lane); acc_y[hh * 4 + np] = __builtin_amdgcn_mfma_f32_16x16x32_bf16(af, bfv, acc_y[hh * 4 + np], 0, 0, 0); } }
        LDS_WAIT(); asm volatile("" ::: "memory");
    }
#if defined(SSDB_CUT) && SSDB_CUT == 1
    { float t_ = 0.f; for (int i = 0; i < 12; ++i) t_ += acc_y[i][0] + acc_y[i][1] + acc_y[i][2] + acc_y[i][3]; if (t_ == 123.f) MIXB[0] = 1; return; }
#endif
#pragma unroll
    for (int t = 0; t < 12; ++t) { const int hh = t >> 2, col = hh * 64 + (t & 3) * 16 + fr; const float dk = dsk[3 * g + hh];
#pragma unroll
        for (int r = 0; r < 4; ++r) { const int l = 16 * wave + 4 * fq + r; acc_y[t][r] += dk * __uint_as_float(((unsigned)*(const LAS bf16*)(PX + l * XP + col * 2)) << 16); } }
    __syncthreads();
    LAS bf16* ost = (LAS bf16*)(lds + wave * (16 * XP));
#pragma unroll
    for (int t = 0; t < 12; ++t) { const int col = (t >> 2) * 64 + (t & 3) * 16 + fr;
#pragma unroll
        for (int r = 0; r < 4; ++r) ost[(4 * fq + r) * (XP / 2) + col] = (bf16)f2bf(acc_y[t][r]); }
    LDS_WAIT(); asm volatile("" ::: "memory");
    { const int rr = lane >> 2, q = lane & 3; const long row = r0 + 16 * wave + rr;
      float yz[48]; float ssum = 0.f;
#pragma unroll
      for (int i = 0; i < 6; ++i) { const int c8 = (q * 6 + i) * 8;
          const fp::u32x4 yv = *(const LAS fp::u32x4*)(ost + rr * (XP / 2) + c8);
          const fp::u32x4 zv = *(const fp::u32x4*)(PROJ + row * PLD + FZ + 192 * g + c8);
#pragma unroll
          for (int j = 0; j < 4; ++j) { const unsigned yw = yv[j], zw = zv[j];
              const float y0 = __uint_as_float(yw << 16), y1 = __uint_as_float(yw & 0xffff0000u), z0 = __uint_as_float(zw << 16), z1 = __uint_as_float(zw & 0xffff0000u);
              const float a0 = y0 * (z0 / (1.f + __expf(-z0))), a1 = y1 * (z1 / (1.f + __expf(-z1))); yz[i * 8 + 2 * j] = a0; yz[i * 8 + 2 * j + 1] = a1; ssum += a0 * a0 + a1 * a1; } }
      ssum += __shfl_xor(ssum, 1); ssum += __shfl_xor(ssum, 2);
      const float rinv = rsqrtf(ssum * (1.f / 192.f) + 1e-5f);
#pragma unroll
      for (int i = 0; i < 6; ++i) { const int c8 = (q * 6 + i) * 8;
          const float4 g0 = *(const float4*)(ng + 192 * g + c8), g1 = *(const float4*)(ng + 192 * g + c8 + 4);
          fp::u32x4 o; o.x = fp::pk2(yz[i * 8] * rinv * g0.x, yz[i * 8 + 1] * rinv * g0.y); o.y = fp::pk2(yz[i * 8 + 2] * rinv * g0.z, yz[i * 8 + 3] * rinv * g0.w);
          o.z = fp::pk2(yz[i * 8 + 4] * rinv * g1.x, yz[i * 8 + 5] * rinv * g1.y); o.w = fp::pk2(yz[i * 8 + 6] * rinv * g1.z, yz[i * 8 + 7] * rinv * g1.w);
          *(fp::u32x4*)(MIXB + row * DM + ATT_W + 192 * g + c8) = o; } }
    __syncthreads();
}

__device__ __forceinline__ void att_norm_phase(bf16* MIXB, const float* g, long n_rows, int gw, int ngw, int lane) {
    for (long row = gw; row < n_rows; row += ngw) { bf16* p = MIXB + row * DM + lane * 8; float v[8]; float s2 = 0.f;
        if (lane < 48) { const fp::u32x4 w = *(const fp::u32x4*)p;
#pragma unroll
            for (int j = 0; j < 4; ++j) { v[2 * j] = __uint_as_float(w[j] << 16); v[2 * j + 1] = __uint_as_float(w[j] & 0xffff0000u); s2 += v[2 * j] * v[2 * j] + v[2 * j + 1] * v[2 * j + 1]; } }
        const float r = rsqrtf(wave_sum(s2) * (1.f / 384.f) + 1e-5f);
        if (lane < 48) { const float4 g0 = *(const float4*)(g + lane * 8), g1 = *(const float4*)(g + lane * 8 + 4);
            fp::u32x4 o; o.x = fp::pk2(v[0] * r * g0.x, v[1] * r * g0.y); o.y = fp::pk2(v[2] * r * g0.z, v[3] * r * g0.w); o.z = fp::pk2(v[4] * r * g1.x, v[5] * r * g1.y); o.w = fp::pk2(v[6] * r * g1.z, v[7] * r * g1.w);
            *(fp::u32x4*)p = o; } }
}

struct FArgs { const void* in[29]; float* out; unsigned char* ws; int ph_lo, ph_hi; };
__device__ __forceinline__ const void* ldarg(int k) { const void* p; asm volatile("s_load_dwordx2 %0, %1, %2\n\ts_waitcnt lgkmcnt(0)" : "=s"(p) : "s"(__builtin_amdgcn_kernarg_segment_ptr()), "i"(k * 8)); return p; }

constexpr int N_PHASES = 19;
__global__ void __launch_bounds__(512, 2) mega(FArgs a) {
    extern __shared__ __attribute__((aligned(16))) unsigned char lds_[];
    LAS unsigned char* lds = (LAS unsigned char*)lds_;
    const int tid = threadIdx.x, lane = tid & 63, wave = __builtin_amdgcn_readfirstlane(tid >> 6);
    const int G = gridDim.x; const int bx = blockIdx.x;
#define vcu (((int)gridDim.x % 8 == 0) ? ((int)blockIdx.x % 8) * ((int)gridDim.x / 8) + (int)blockIdx.x / 8 : (int)blockIdx.x)
#define gw (vcu * 8 + wave)
#define ngw ((int)gridDim.x * 8)
#define gt ((long)gw * 64 + lane)
#define ngt ((long)ngw * 64)
    unsigned char* ws = a.ws;
    unsigned* ctl = (unsigned*)(ws + O_CTL);
    for (int u = tid; u < (LDS_BYTES - RING_BYTES) / 4; u += 512) ((LAS unsigned*)(lds + RING_BYTES))[u] = 0u;
    __syncthreads();
    const int lo = a.ph_lo, hi = a.ph_hi;
    XcdBarrier bar; bar.bar = ctl + CW_BAR; bar.x = 0; bar.st = nullptr;
    if (hi - lo > 1) bar = xcd_barrier_post(ctl + CW_BAR, (volatile LAS unsigned*)(lds + MISC_OFF) + 8);
#define in_x ((const float*)ldarg(0))
#define in_pos ((const int*)ldarg(1))
#define ln_in_g ((const float*)ldarg(2))
#define ln_in_b ((const float*)ldarg(3))
#define w_in ((const float*)ldarg(4))
#define conv_w ((const float*)ldarg(5))
#define conv_b ((const float*)ldarg(6))
#define dt_bias ((const float*)ldarg(7))
#define a_log ((const float*)ldarg(8))
#define d_skip ((const float*)ldarg(9))
#define ssd_norm_g ((const float*)ldarg(10))
#define att_norm_g ((const float*)ldarg(11))
#define gm_ln_g ((const float*)ldarg(12))
#define gm_ln_b ((const float*)ldarg(13))
#define gm_w_s ((const float*)ldarg(14))
#define gm_b_s ((const float*)ldarg(15))
#define gm_norm_g ((const float*)ldarg(16))
#define w_out ((const float*)ldarg(17))
#define ln1_g ((const float*)ldarg(18))
#define ln1_b ((const float*)ldarg(19))
#define ln2_g ((const float*)ldarg(20))
#define ln2_b ((const float*)ldarg(21))
#define ffn_w_gate ((const float*)ldarg(22))
#define ffn_w_up ((const float*)ldarg(23))
#define ffn_w_down ((const float*)ldarg(24))
#define router_w ((const float*)ldarg(25))
#define moe_w_gate ((const float*)ldarg(26))
#define moe_w_up ((const float*)ldarg(27))
#define moe_w_down ((const float*)ldarg(28))
    float* H = a.out;
    float* RT = (float*)(ws + O_RT); int* TE = (int*)(ws + O_TE); float* TP = (float*)(ws + O_TP); int* TS = (int*)(ws + O_TS); int* GS = (int*)(ws + O_GS); float* SP = (float*)(ws + O_SP);
    float* KM = (float*)(ws + O_KM); float* DT = (float*)(ws + O_DT); bf16* WSB = (bf16*)(ws + O_WSB); bf16* HB = (bf16*)(ws + O_HB); bf16* MWGU = (bf16*)(ws + O_MWGU); bf16* MWD = (bf16*)(ws + O_MWGU);
    bf16* WIN = (bf16*)(ws + O_WIN); bf16* WOUT = (bf16*)(ws + O_WOUT); bf16* WGU = (bf16*)(ws + O_WGU); bf16* WD = (bf16*)(ws + O_WD);
    bf16* PROJ = (bf16*)(ws + O_PROJ); float* ST = (float*)(ws + O_XC); float* CD = (float*)(ws + O_DT); bf16* XCB = (bf16*)(ws + O_MIXU); float* DTG = (float*)(ws + O_VN); float* MIXU = (float*)(ws + O_MIXU); bf16* MIXB = (bf16*)(ws + O_MIXB); float* VN = (float*)(ws + O_VN);
    bf16* YB = (bf16*)(ws + O_Y); bf16* ACT = (bf16*)(ws + O_ACT); bf16* XG = (bf16*)(ws + O_XG); bf16* F2 = (bf16*)(ws + O_XG); bf16* ACTM = (bf16*)(ws + O_ACTM);
    int* CNT = (int*)(ctl + CW_CNT);
    const ProjL FL{PLD, FQ, FK, FV, FZ, FXBC, FDT, FGU, FGV};
    LAS float* scr = (LAS float*)(lds + wave * 16384);

#ifndef PH_MASK
#define PH_MASK 0xffffffffu
#endif
#ifndef PROBE_MASK
#define PROBE_MASK 0u
#endif
#ifndef PROBE_AMP
#define PROBE_AMP 0
#endif
    volatile unsigned* pr_w = (volatile unsigned*)(ctl + 1100);
#define pr_me ((PROBE_MASK != 0u) && blockIdx.x == 0 && wave == 0 && __builtin_amdgcn_mbcnt_hi(~0u, __builtin_amdgcn_mbcnt_lo(~0u, 0u)) == 0u)
#define PH_BEGIN(k) if (lo <= (k) && (k) < hi && ((PH_MASK >> (k)) & 1u)) { if (((PROBE_MASK >> (k)) & 1u) && pr_me) pr_w[0] = (unsigned)__builtin_amdgcn_s_memrealtime();
#define PH_END(k)   if ((k) + 1 < hi) xcd_barrier(bar); if (((PROBE_MASK >> (k)) & 1u) && pr_me) pr_w[1] += (unsigned)__builtin_amdgcn_s_memrealtime() - pr_w[0]; }

    PH_BEGIN(0)
    { const float* const p_w_in = w_in; const float* const p_w_out = w_out; const float* const p_fg = ffn_w_gate; const float* const p_fu = ffn_w_up; const float* const p_fd = ffn_w_down; const float* const p_mg = moe_w_gate; const float* const p_mu = moe_w_up;
        constexpr int I_WIN = 16 * (PLD / 32), I_WOUT = 16 * (DM / 32), I_WGU = 16 * (NGU / 32), I_WD = (D_FF / 64) * (DM / 32), I_MWGU = 16 * (N_EXP * NGUE / 32);
        constexpr int NIT = 2 * I_WIN + 2 * I_WOUT + I_WGU + I_WD + I_MWGU;
        for (int it = gw; it < NIT; it += ngw) {
            int r = it; const int l5 = lane & 31;
            if (r < 2 * I_WIN) { const int L = r / I_WIN; r -= L * I_WIN; const int kb = r / (PLD / 32), db = r % (PLD / 32); const int sc_ = fp::win_src_col(db * 32 + l5);
                fp::SrcCol s; s.p = sc_ >= 0 ? p_w_in + (size_t)L * DM * D_IN + sc_ : nullptr; s.ld = D_IN; fp::conv_item(s, DM, WIN + (size_t)L * PLD * DM, db * 32, kb * 64, scr, lane); continue; } r -= 2 * I_WIN;
            if (r < 2 * I_WOUT) { const int L = r / I_WOUT; r -= L * I_WOUT; const int kb = r / (DM / 32), db = r % (DM / 32);
                fp::SrcCol s; s.p = p_w_out + (size_t)L * DM * DM + db * 32 + l5; s.ld = DM; fp::conv_item(s, DM, WOUT + (size_t)L * DM * DM, db * 32, kb * 64, scr, lane); continue; } r -= 2 * I_WOUT;
            if (r < I_WGU) { const int kb = r / (NGU / 32), db = r % (NGU / 32);
                fp::conv_item(fp::gu_src(p_fg, p_fu, D_FF, db * 32 + l5), DM, WGU, db * 32, kb * 64, scr, lane); continue; } r -= I_WGU;
            if (r < I_WD) { const int kb = r / (DM / 32), db = r % (DM / 32);
                fp::SrcCol s; s.p = p_fd + db * 32 + l5; s.ld = DM; fp::conv_item(s, D_FF, WD, db * 32, kb * 64, scr, lane); continue; } r -= I_WD;
            { const int kb = r / (N_EXP * NGUE / 32), db = r % (N_EXP * NGUE / 32); const int d = db * 32 + l5, e = d / NGUE;
                fp::conv_item(fp::gu_src(p_mg + (size_t)e * DM * D_FFE, p_mu + (size_t)e * DM * D_FFE, D_FFE, d - e * NGUE), DM, MWGU, (long)db * 32, kb * 64, scr, lane); }
        }
        const int* const p_pos = in_pos; const float* const p_gws = gm_w_s; const float* const p_x = in_x; const float* const p_lg = ln_in_g; const float* const p_lb = ln_in_b;
        for (long it = gt; it < (long)M_ * 8; it += ngt) { const int i = (int)(it & 7); const long row = it >> 3;
            const float inv = powf(500000.0f, -(float)(2 * i) / 16.0f); const float ang = (float)p_pos[row] * inv; RT[row * 16 + i] = cosf(ang); RT[row * 16 + 8 + i] = sinf(ang); }
        for (long it = gt; it < 2L * GM_G * GM_CHUNK * GM_CHUNK; it += ngt) { const int sidx = (int)(it & 127), t = (int)((it >> 7) & 127); WSB[it] = (bf16)(sidx <= t ? f2bf(p_gws[it]) : 0u); }
        { float va[16], vb[16]; long r = gw; if (r < M_) ln_load<float>(va, p_x + r * DM, 1.f, nullptr, nullptr, lane);
          for (; r < M_; r += 2 * ngw) { const long r1 = r + ngw, r2 = r + 2 * ngw;
              if (r1 < M_) ln_load<float>(vb, p_x + r1 * DM, 1.f, nullptr, nullptr, lane);
              ln_finish(va, p_lg, p_lb, nullptr, HB + r * DM, lane);
              if (r2 < M_) ln_load<float>(va, p_x + r2 * DM, 1.f, nullptr, nullptr, lane);
              if (r1 < M_) ln_finish(vb, p_lg, p_lb, nullptr, HB + r1 * DM, lane); } }
    }
    PH_END(0)


    { constexpr int layer = 0; constexpr int PB = 1;
        PH_BEGIN(PB + 0)
        { pg8::Gemm g{HB, WIN + (size_t)layer * PLD * DM, M_, PLD, DM}; pg8::StaticOrder S; S.init(M_, PLD, G, bx);
          fp::EpiProj E{PROJ, RT, KM}; pg8::gemm_phase<fp::EpiProj, pg8::StaticOrder, true, true>(lds, g, S, E); }
        PH_END(PB + 0)
        PH_BEGIN(PB + 1)
        { constexpr int NATT = NB * ATT_H * NBLK, NSSDA = NB * 32;
          volatile LAS unsigned* qw = (volatile LAS unsigned*)(lds + MISC_OFF) + 16;
#define QNEXT(word) do { if (tid == 0) qw[0] = __hip_atomic_fetch_add(ctl + (word), 1u, __ATOMIC_RELAXED, __HIP_MEMORY_SCOPE_AGENT); __syncthreads(); idx = (int)qw[0]; __syncthreads(); } while (0)
          int idx;
          for (;;) { QNEXT(CW_Q + 8 * layer); if (idx >= NATT) break;
              const int qb = (NBLK - 1) - idx / (NB * ATT_H), bh = idx % (NB * ATT_H);
              attn_body::attn_unit<8>(bh / ATT_H, bh % ATT_H, qb, (const attn_body::bf16*)(PROJ + FQ), (const attn_body::bf16*)(PROJ + FK), (const attn_body::bf16*)(PROJ + FV), (attn_body::bf16*)MIXB, KM, NB * ATT_H * NBLK * 64, (char*)lds_); }
          for (;;) { QNEXT(CW_Q + 8 * layer + 1); if (idx >= NSSDA) break;
              ssdA_unit(idx >> 5, (idx >> 1) & 15, idx & 1, PROJ, conv_w + (size_t)layer * 4 * SSD_CW, conv_b + layer * SSD_CW, dt_bias + layer * SSD_H, a_log + layer * SSD_H, ST, CD, XCB, DTG, lds, tid, wave, lane); }
        }
        PH_END(PB + 1)
        PH_BEGIN(PB + 2)
        { constexpr int NSSDB = NB * 32, NGMU = NB * (SEQ / GM_CHUNK);
          volatile LAS unsigned* qw = (volatile LAS unsigned*)(lds + MISC_OFF) + 16;
          int idx;
          for (;;) { QNEXT(CW_Q + 8 * layer + 2); if (idx >= NSSDB) break;
              const int c = 15 - idx / (NB * 2), bg = idx % (NB * 2);
              ssdB_unit(bg >> 1, c, bg & 1, PROJ, XCB, DTG, d_skip + layer * SSD_H, ssd_norm_g + layer * SSD_W, ST, CD, MIXB, lds, tid, wave, lane); }
          for (;;) { QNEXT(CW_Q + 8 * layer + 3); if (idx >= NGMU) break;
              gm_unit(idx / (SEQ / GM_CHUNK), idx % (SEQ / GM_CHUNK), PROJ, WSB + (size_t)layer * GM_G * GM_CHUNK * GM_CHUNK, gm_ln_g + layer * GM_W, gm_ln_b + layer * GM_W,
                      gm_b_s + layer * GM_G * GM_CHUNK, gm_norm_g + layer * GM_W, MIXB, lds, wave, lane); }
#undef QNEXT
          att_norm_phase(MIXB, att_norm_g + layer * ATT_W, M_, gw, ngw, lane);
        }
        PH_END(PB + 2)
        PH_BEGIN(PB + 3)
        { pg8::Gemm g{MIXB, WOUT + (size_t)layer * DM * DM, M_, DM, DM}; pg8::StaticOrder S; S.init(M_, DM, G, bx);
          fp::EpiY E{YB, DM}; pg8::gemm_phase<fp::EpiY, pg8::StaticOrder, false, true>(lds, g, S, E); }
        PH_END(PB + 3)
        PH_BEGIN(PB + 4)
        { const float* const p_g = ln1_g + layer * DM; const float* const p_b = ln1_b + layer * DM;
          { float va[16], vb[16]; long r = gw; if (r < M_) ln_load<bf16, bf16>(va, HB + r * DM, ALPHA, YB + r * DM, nullptr, lane);
            for (; r < M_; r += 2 * ngw) { const long r1 = r + ngw, r2 = r + 2 * ngw;
                if (r1 < M_) ln_load<bf16, bf16>(vb, HB + r1 * DM, ALPHA, YB + r1 * DM, nullptr, lane);
                ln_finish(va, p_g, p_b, nullptr, HB + r * DM, lane);
                if (r2 < M_) ln_load<bf16, bf16>(va, HB + r2 * DM, ALPHA, YB + r2 * DM, nullptr, lane);
                if (r1 < M_) ln_finish(vb, p_g, p_b, nullptr, HB + r1 * DM, lane); } }
          if (layer == 1) { asm volatile("s_waitcnt vmcnt(0)" ::: "memory"); moe_route_block(HB, router_w, CNT, TE, TP, TS, M_, gw, ngw, lane, wave, tid, (LAS int*)lds); } }
        PH_END(PB + 4)
        if constexpr (layer == 0) {
            PH_BEGIN(PB + 5)
            { pg8::Gemm g{HB, WGU, M_, NGU, DM}; pg8::StaticOrder S; S.init(M_, NGU, G, bx);
              fp::EpiAct E{ACT, D_FF, NGU / 256}; pg8::gemm_phase<fp::EpiAct, pg8::StaticOrder, true, true>(lds, g, S, E); }
            PH_END(PB + 5)
            PH_BEGIN(PB + 6)
            { pg8::Gemm g{ACT, WD, M_, DM, D_FF}; pg8::StaticOrder S; S.init(M_, DM, G, bx);
              fp::EpiY E{YB, DM}; pg8::gemm_phase<fp::EpiY, pg8::StaticOrder, false, true>(lds, g, S, E); }
            PH_END(PB + 6)
            PH_BEGIN(PB + 7)
            { const float* const p_g = ln2_g + layer * DM; const float* const p_b = ln2_b + layer * DM;
              { float va[16], vb[16]; long r = gw; if (r < M_) ln_load<bf16, bf16>(va, HB + r * DM, ALPHA, YB + r * DM, nullptr, lane);
            for (; r < M_; r += 2 * ngw) { const long r1 = r + ngw, r2 = r + 2 * ngw;
                if (r1 < M_) ln_load<bf16, bf16>(vb, HB + r1 * DM, ALPHA, YB + r1 * DM, nullptr, lane);
                ln_finish(va, p_g, p_b, nullptr, HB + r * DM, lane);
                if (r2 < M_) ln_load<bf16, bf16>(va, HB + r2 * DM, ALPHA, YB + r2 * DM, nullptr, lane);
                if (r1 < M_) ln_finish(vb, p_g, p_b, nullptr, HB + r1 * DM, lane); } } }
            PH_END(PB + 7)
        } else {
            PH_BEGIN(PB + 5)
            { for (long it = gw; it < (long)M_ * 2; it += ngw) { const int e = TE[it]; const int gs = moe_base(CNT, e) + TS[it];
                  if (lane == 0) { SP[gs] = TP[it]; GS[it] = gs; }
                  const uint4* src = (const uint4*)(HB + (it >> 1) * DM); uint4* dst = (uint4*)(XG + (size_t)gs * DM); dst[lane] = src[lane]; dst[lane + 64] = src[lane + 64]; }
              for (int it = gw; it < N_EXP * 256; it += ngw) { const int e = it >> 8, r = it & 255; const int c = CNT[e]; const int slot = moe_base(CNT, e) + c + r;
                  if (c + r < ((c + 255) & ~255)) { uint4* dst = (uint4*)(XG + (size_t)slot * DM); const uint4 z = make_uint4(0u, 0u, 0u, 0u); dst[lane] = z; dst[lane + 64] = z; if (lane == 0) SP[slot] = 0.f; } } }
            PH_END(PB + 5)
            PH_BEGIN(PB + 6)
            { pg8::Gemm g{XG, MWGU, NSLOT, N_EXP * NGUE, DM}; fp::MoeOrder S; S.init(CNT, NGUE / 256, G, bx);
              fp::EpiAct E{ACTM, D_FFE, NGUE / 256}; pg8::gemm_phase<fp::EpiAct, fp::MoeOrder, true, true>(lds, g, S, E); }
            PH_END(PB + 6)
            PH_BEGIN(PB + 7)
            { constexpr int I_MWD = (D_FFE / 64) * (N_EXP * DM / 32); const float* const p_md = moe_w_down;
              for (int it = gw; it < I_MWD; it += ngw) { const int kb = it / (N_EXP * DM / 32), db = it % (N_EXP * DM / 32); const int d = db * 32 + (lane & 31), e = d / DM;
                  fp::SrcCol s; s.p = p_md + (size_t)e * D_FFE * DM + (d - e * DM); s.ld = DM; fp::conv_item(s, D_FFE, MWD, (long)db * 32, kb * 64, scr, lane); } }
            PH_END(PB + 7)
            PH_BEGIN(PB + 8)
            { pg8::Gemm g{ACTM, MWD, NSLOT, N_EXP * DM, D_FFE}; fp::MoeOrder S; S.init(CNT, DM / 256, G, bx);
              fp::EpiF2 E{F2, SP}; pg8::gemm_phase<fp::EpiF2, fp::MoeOrder, true, true>(lds, g, S, E); }
            PH_END(PB + 8)
            PH_BEGIN(PB + 9)
            { const float* const p_g = ln2_g + layer * DM; const float* const p_b = ln2_b + layer * DM;
              { float va[16], vb[16]; long r = gw; if (r < M_) ln_load<bf16, bf16>(va, HB + r * DM, ALPHA, F2 + (size_t)GS[r * 2] * DM, F2 + (size_t)GS[r * 2 + 1] * DM, lane);
                for (; r < M_; r += 2 * ngw) { const long r1 = r + ngw, r2 = r + 2 * ngw;
                    if (r1 < M_) ln_load<bf16, bf16>(vb, HB + r1 * DM, ALPHA, F2 + (size_t)GS[r1 * 2] * DM, F2 + (size_t)GS[r1 * 2 + 1] * DM, lane);
                    ln_finish(va, p_g, p_b, H + r * DM, nullptr, lane);
                    if (r2 < M_) ln_load<bf16, bf16>(va, HB + r2 * DM, ALPHA, F2 + (size_t)GS[r2 * 2] * DM, F2 + (size_t)GS[r2 * 2 + 1] * DM, lane);
                    if (r1 < M_) ln_finish(vb, p_g, p_b, H + r1 * DM, nullptr, lane); } } }
            PH_END(PB + 9)
        }
    }

    { constexpr int layer = 1; constexpr int PB = 9;
        PH_BEGIN(PB + 0)
        { pg8::Gemm g{HB, WIN + (size_t)layer * PLD * DM, M_, PLD, DM}; pg8::StaticOrder S; S.init(M_, PLD, G, bx);
          fp::EpiProj E{PROJ, RT, KM}; pg8::gemm_phase<fp::EpiProj, pg8::StaticOrder, true, true>(lds, g, S, E); }
        PH_END(PB + 0)
        PH_BEGIN(PB + 1)
        { constexpr int NATT = NB * ATT_H * NBLK, NSSDA = NB * 32;
          volatile LAS unsigned* qw = (volatile LAS unsigned*)(lds + MISC_OFF) + 16;
#define QNEXT(word) do { if (tid == 0) qw[0] = __hip_atomic_fetch_add(ctl + (word), 1u, __ATOMIC_RELAXED, __HIP_MEMORY_SCOPE_AGENT); __syncthreads(); idx = (int)qw[0]; __syncthreads(); } while (0)
          int idx;
          for (;;) { QNEXT(CW_Q + 8 * layer); if (idx >= NATT) break;
              const int qb = (NBLK - 1) - idx / (NB * ATT_H), bh = idx % (NB * ATT_H);
              attn_body::attn_unit<8>(bh / ATT_H, bh % ATT_H, qb, (const attn_body::bf16*)(PROJ + FQ), (const attn_body::bf16*)(PROJ + FK), (const attn_body::bf16*)(PROJ + FV), (attn_body::bf16*)MIXB, KM, NB * ATT_H * NBLK * 64, (char*)lds_); }
          for (;;) { QNEXT(CW_Q + 8 * layer + 1); if (idx >= NSSDA) break;
              ssdA_unit(idx >> 5, (idx >> 1) & 15, idx & 1, PROJ, conv_w + (size_t)layer * 4 * SSD_CW, conv_b + layer * SSD_CW, dt_bias + layer * SSD_H, a_log + layer * SSD_H, ST, CD, XCB, DTG, lds, tid, wave, lane); }
        }
        PH_END(PB + 1)
        PH_BEGIN(PB + 2)
        { constexpr int NSSDB = NB * 32, NGMU = NB * (SEQ / GM_CHUNK);
          volatile LAS unsigned* qw = (volatile LAS unsigned*)(lds + MISC_OFF) + 16;
          int idx;
          for (;;) { QNEXT(CW_Q + 8 * layer + 2); if (idx >= NSSDB) break;
              const int c = 15 - idx / (NB * 2), bg = idx % (NB * 2);
              ssdB_unit(bg >> 1, c, bg & 1, PROJ, XCB, DTG, d_skip + layer * SSD_H, ssd_norm_g + layer * SSD_W, ST, CD, MIXB, lds, tid, wave, lane); }
          for (;;) { QNEXT(CW_Q + 8 * layer + 3); if (idx >= NGMU) break;
              gm_unit(idx / (SEQ / GM_CHUNK), idx % (SEQ / GM_CHUNK), PROJ, WSB + (size_t)layer * GM_G * GM_CHUNK * GM_CHUNK, gm_ln_g + layer * GM_W, gm_ln_b + layer * GM_W,
                      gm_b_s + layer * GM_G * GM_CHUNK, gm_norm_g + layer * GM_W, MIXB, lds, wave, lane); }
#undef QNEXT
          att_norm_phase(MIXB, att_norm_g + layer * ATT_W, M_, gw, ngw, lane);
        }
        PH_END(PB + 2)
        PH_BEGIN(PB + 3)
        { pg8::Gemm g{MIXB, WOUT + (size_t)layer * DM * DM, M_, DM, DM}; pg8::StaticOrder S; S.init(M_, DM, G, bx);
          fp::EpiY E{YB, DM}; pg8::gemm_phase<fp::EpiY, pg8::StaticOrder, false, true>(lds, g, S, E); }
        PH_END(PB + 3)
        PH_BEGIN(PB + 4)
        { const float* const p_g = ln1_g + layer * DM; const float* const p_b = ln1_b + layer * DM;
          { float va[16], vb[16]; long r = gw; if (r < M_) ln_load<bf16, bf16>(va, HB + r * DM, ALPHA, YB + r * DM, nullptr, lane);
            for (; r < M_; r += 2 * ngw) { const long r1 = r + ngw, r2 = r + 2 * ngw;
                if (r1 < M_) ln_load<bf16, bf16>(vb, HB + r1 * DM, ALPHA, YB + r1 * DM, nullptr, lane);
                ln_finish(va, p_g, p_b, nullptr, HB + r * DM, lane);
                if (r2 < M_) ln_load<bf16, bf16>(va, HB + r2 * DM, ALPHA, YB + r2 * DM, nullptr, lane);
                if (r1 < M_) ln_finish(vb, p_g, p_b, nullptr, HB + r1 * DM, lane); } }
          if (layer == 1) { asm volatile("s_waitcnt vmcnt(0)" ::: "memory"); moe_route_block(HB, router_w, CNT, TE, TP, TS, M_, gw, ngw, lane, wave, tid, (LAS int*)lds); } }
        PH_END(PB + 4)
        if constexpr (layer == 0) {
            PH_BEGIN(PB + 5)
            { pg8::Gemm g{HB, WGU, M_, NGU, DM}; pg8::StaticOrder S; S.init(M_, NGU, G, bx);
              fp::EpiAct E{ACT, D_FF, NGU / 256}; pg8::gemm_phase<fp::EpiAct, pg8::StaticOrder, true, true>(lds, g, S, E); }
            PH_END(PB + 5)
            PH_BEGIN(PB + 6)
            { pg8::Gemm g{ACT, WD, M_, DM, D_FF}; pg8::StaticOrder S; S.init(M_, DM, G, bx);
              fp::EpiY E{YB, DM}; pg8::gemm_phase<fp::EpiY, pg8::StaticOrder, false, true>(lds, g, S, E); }
            PH_END(PB + 6)
            PH_BEGIN(PB + 7)
            { const float* const p_g = ln2_g + layer * DM; const float* const p_b = ln2_b + layer * DM;
              { float va[16], vb[16]; long r = gw; if (r < M_) ln_load<bf16, bf16>(va, HB + r * DM, ALPHA, YB + r * DM, nullptr, lane);
            for (; r < M_; r += 2 * ngw) { const long r1 = r + ngw, r2 = r + 2 * ngw;
                if (r1 < M_) ln_load<bf16, bf16>(vb, HB + r1 * DM, ALPHA, YB + r1 * DM, nullptr, lane);
                ln_finish(va, p_g, p_b, nullptr, HB + r * DM, lane);
                if (r2 < M_) ln_load<bf16, bf16>(va, HB + r2 * DM, ALPHA, YB + r2 * DM, nullptr, lane);
                if (r1 < M_) ln_finish(vb, p_g, p_b, nullptr, HB + r1 * DM, lane); } } }
            PH_END(PB + 7)
        } else {
            PH_BEGIN(PB + 5)
            { for (long it = gw; it < (long)M_ * 2; it += ngw) { const int e = TE[it]; const int gs = moe_base(CNT, e) + TS[it];
                  if (lane == 0) { SP[gs] = TP[it]; GS[it] = gs; }
                  const uint4* src = (const uint4*)(HB + (it >> 1) * DM); uint4* dst = (uint4*)(XG + (size_t)gs * DM); dst[lane] = src[lane]; dst[lane + 64] = src[lane + 64]; }
              for (int it = gw; it < N_EXP * 256; it += ngw) { const int e = it >> 8, r = it & 255; const int c = CNT[e]; const int slot = moe_base(CNT, e) + c + r;
                  if (c + r < ((c + 255) & ~255)) { uint4* dst = (uint4*)(XG + (size_t)slot * DM); const uint4 z = make_uint4(0u, 0u, 0u, 0u); dst[lane] = z; dst[lane + 64] = z; if (lane == 0) SP[slot] = 0.f; } } }
            PH_END(PB + 5)
            PH_BEGIN(PB + 6)
            { pg8::Gemm g{XG, MWGU, NSLOT, N_EXP * NGUE, DM}; fp::MoeOrder S; S.init(CNT, NGUE / 256, G, bx);
              fp::EpiAct E{ACTM, D_FFE, NGUE / 256}; pg8::gemm_phase<fp::EpiAct, fp::MoeOrder, true, true>(lds, g, S, E); }
            PH_END(PB + 6)
            PH_BEGIN(PB + 7)
            { constexpr int I_MWD = (D_FFE / 64) * (N_EXP * DM / 32); const float* const p_md = moe_w_down;
              for (int it = gw; it < I_MWD; it += ngw) { const int kb = it / (N_EXP * DM / 32), db = it % (N_EXP * DM / 32); const int d = db * 32 + (lane & 31), e = d / DM;
                  fp::SrcCol s; s.p = p_md + (size_t)e * D_FFE * DM + (d - e * DM); s.ld = DM; fp::conv_item(s, D_FFE, MWD, (long)db * 32, kb * 64, scr, lane); } }
            PH_END(PB + 7)
            PH_BEGIN(PB + 8)
            { pg8::Gemm g{ACTM, MWD, NSLOT, N_EXP * DM, D_FFE}; fp::MoeOrder S; S.init(CNT, DM / 256, G, bx);
              fp::EpiF2 E{F2, SP}; pg8::gemm_phase<fp::EpiF2, fp::MoeOrder, true, true>(lds, g, S, E); }
            PH_END(PB + 8)
            PH_BEGIN(PB + 9)
            { const float* const p_g = ln2_g + layer * DM; const float* const p_b = ln2_b + layer * DM;
              { float va[16], vb[16]; long r = gw; if (r < M_) ln_load<bf16, bf16>(va, HB + r * DM, ALPHA, F2 + (size_t)GS[r * 2] * DM, F2 + (size_t)GS[r * 2 + 1] * DM, lane);
                for (; r < M_; r += 2 * ngw) { const long r1 = r + ngw, r2 = r + 2 * ngw;
                    if (r1 < M_) ln_load<bf16, bf16>(vb, HB + r1 * DM, ALPHA, F2 + (size_t)GS[r1 * 2] * DM, F2 + (size_t)GS[r1 * 2 + 1] * DM, lane);
                    ln_finish(va, p_g, p_b, H + r * DM, nullptr, lane);
                    if (r2 < M_) ln_load<bf16, bf16>(va, HB + r2 * DM, ALPHA, F2 + (size_t)GS[r2 * 2] * DM, F2 + (size_t)GS[r2 * 2 + 1] * DM, lane);
                    if (r1 < M_) ln_finish(vb, p_g, p_b, H + r1 * DM, nullptr, lane); } } }
            PH_END(PB + 9)
        }
    }

#undef PH_BEGIN
#undef PH_END
#undef in_x
#undef in_pos
#undef ln_in_g
#undef ln_in_b
#undef w_in
#undef conv_w
#undef conv_b
#undef dt_bias
#undef a_log
#undef d_skip
#undef ssd_norm_g
#undef att_norm_g
#undef gm_ln_g
#undef gm_ln_b
#undef gm_w_s
#undef gm_b_s
#undef gm_norm_g
#undef w_out
#undef ln1_g
#undef ln1_b
#undef ln2_g
#undef ln2_b
#undef ffn_w_gate
#undef ffn_w_up
#undef ffn_w_down
#undef router_w
#undef moe_w_gate
#undef moe_w_up
#undef moe_w_down
#undef vcu
#undef gw
#undef ngw
#undef gt
#undef ngt
    if (pr_me) { const unsigned t_beg = (unsigned)__builtin_amdgcn_s_memrealtime(), t_len = (unsigned)PROBE_AMP * pr_w[1]; while ((unsigned)__builtin_amdgcn_s_memrealtime() - t_beg < t_len) __builtin_amdgcn_s_sleep(8); }
}

__device__ __forceinline__ void blk_acc(float d2, float s2, float* err) {
    d2 = wave_sum(d2); s2 = wave_sum(s2); if ((threadIdx.x & 63) == 0) { atomicAdd(err, d2); atomicAdd(err + 1, s2); }
}
__global__ void k_cmp_proj(const bf16* F, const float* S, long rows, float* err) {
    float d2 = 0.f, s2 = 0.f;
    for (long it = blockIdx.x * (long)blockDim.x + threadIdx.x; it < rows * 2950; it += gridDim.x * (long)blockDim.x) {
        const long row = it / 2950; const int d = (int)(it % 2950); const int sc = fp::win_src_col(d);
        float s = S[row * D_IN + sc]; if (d >= FGU && d < FXBC) s = gelu_tanh_f(s);
        const float f = ldf(F + row * PLD + d); d2 += (f - s) * (f - s); s2 += s * s; }
    blk_acc(d2, s2, err);
}
template <class TF> __global__ void k_cmp(const TF* F, int ldf_, const float* S, int lds_, long rows, int cols, float* err) {
    float d2 = 0.f, s2 = 0.f;
    for (long it = blockIdx.x * (long)blockDim.x + threadIdx.x; it < rows * cols; it += gridDim.x * (long)blockDim.x) {
        const long row = it / cols; const int c = (int)(it % cols); const float f = ldf(F + row * ldf_ + c), s = S[row * lds_ + c]; d2 += (f - s) * (f - s); s2 += s * s; }
    blk_acc(d2, s2, err);
}
__global__ void k_encode(const float* err, int nck, const float* Sout, float* out, long rows_s, long rows_all, float thr) {
    int k = 0; for (int i = 0; i < nck; ++i) { const float r = err[2 * i] / fmaxf(err[2 * i + 1], 1e-30f); if (!(r <= thr)) { k = i + 1; break; } }
    for (long it = blockIdx.x * (long)blockDim.x + threadIdx.x; it < rows_all * DM; it += gridDim.x * (long)blockDim.x)
        out[it] = (it < rows_s * DM) ? Sout[it] * (1.f + (float)k) : 0.f;
}
#if DEBUG_BUILD
constexpr size_t S_BASE = (WS_END + 2 * MiB - 1) / MiB * MiB;
#endif
extern "C" void kernel_launch(void* const* d_in, const int* in_sizes, int n_in, void* d_out, int out_size, void* d_ws, size_t ws_size, hipStream_t stream) {
    (void)in_sizes; (void)n_in; (void)out_size;
    static int grid = 0;
    if (grid == 0) {
        int dev = 0, cus = 0, per_cu = 0;
        if (hipGetDevice(&dev) != hipSuccess || hipDeviceGetAttribute(&cus, hipDeviceAttributeMultiprocessorCount, dev) != hipSuccess) { grid = -1; return; }
        if (hipFuncSetAttribute((const void*)mega, hipFuncAttributeMaxDynamicSharedMemorySize, LDS_BYTES) != hipSuccess) { fprintf(stderr, "kernel_launch: hipFuncSetAttribute failed\n"); grid = -1; return; }
        if (hipOccupancyMaxActiveBlocksPerMultiprocessor(&per_cu, (const void*)mega, 512, LDS_BYTES) != hipSuccess || per_cu < 1) fprintf(stderr, "kernel_launch: occupancy query reports %d\n", per_cu);
        (void)hipGetLastError();
        grid = cus;
        if (ws_size < WS_END) { fprintf(stderr, "kernel_launch: workspace too small: %zu < %zu\n", ws_size, (size_t)WS_END); grid = -1; }
    }
    if (grid < 0) return;
    unsigned char* ws = (unsigned char*)d_ws;
    if (hipMemsetAsync(ws + O_CTL, 0, CTL_BYTES, stream) != hipSuccess) return;
    FArgs a{};
    for (int i = 0; i < 29; ++i) a.in[i] = d_in[i];
    a.out = (float*)d_out; a.ws = ws;
#if !DEBUG_BUILD
    a.ph_lo = 0; a.ph_hi = N_PHASES;
    hipLaunchKernelGGL(mega, dim3(grid), dim3(512), LDS_BYTES, stream, a);
#else
    Inputs I;
    I.x = (const float*)d_in[0]; I.pos = (const int*)d_in[1]; I.ln_in_g = (const float*)d_in[2]; I.ln_in_b = (const float*)d_in[3]; I.w_in = (const float*)d_in[4];
    I.conv_w = (const float*)d_in[5]; I.conv_b = (const float*)d_in[6]; I.dt_bias = (const float*)d_in[7]; I.a_log = (const float*)d_in[8]; I.d_skip = (const float*)d_in[9];
    I.ssd_norm_g = (const float*)d_in[10]; I.att_norm_g = (const float*)d_in[11]; I.gm_ln_g = (const float*)d_in[12]; I.gm_ln_b = (const float*)d_in[13]; I.gm_w_s = (const float*)d_in[14];
    I.gm_b_s = (const float*)d_in[15]; I.gm_norm_g = (const float*)d_in[16]; I.w_out = (const float*)d_in[17]; I.ln1_g = (const float*)d_in[18]; I.ln1_b = (const float*)d_in[19];
    I.ln2_g = (const float*)d_in[20]; I.ln2_b = (const float*)d_in[21]; I.ffn_w_gate = (const float*)d_in[22]; I.ffn_w_up = (const float*)d_in[23]; I.ffn_w_down = (const float*)d_in[24];
    I.router_w = (const float*)d_in[25]; I.moe_w_gate = (const float*)d_in[26]; I.moe_w_up = (const float*)d_in[27]; I.moe_w_down = (const float*)d_in[28];
    const long MS = SEQ;
    unsigned char* sws = ws + S_BASE;
    float* saux = (float*)(sws + 96 * MiB); float* sout = (float*)(sws + 100 * MiB); float* ckpt = (float*)(sws + 110 * MiB);
    const size_t ck_stride = (size_t)MS * (D_IN + 3 * DM);
    run_simple(I, 1, sws, saux, sout, stream, ckpt);
    float* err = (float*)(ws + O_CTL) + CW_ERR;
    const bf16* PROJ = (const bf16*)(ws + O_PROJ); const bf16* MIXB = (const bf16*)(ws + O_MIXB); const bf16* Hf = (const bf16*)(ws + O_HB); const float* Hout = (const float*)d_out;
    for (int ph = 0; ph < N_PHASES; ++ph) {
        a.ph_lo = ph; a.ph_hi = ph + 1;
        hipLaunchKernelGGL(mega, dim3(grid), dim3(512), LDS_BYTES, stream, a);
        const int layer = ph >= 9 ? 1 : 0; const int rel = ph - (layer ? 8 : 0); const float* ck = ckpt + layer * ck_stride; float* e = err + layer * 12;
        if (rel == 1) k_cmp_proj<<<512, 256, 0, stream>>>(PROJ, ck, MS, e + 0);
        if (rel == 3) { k_cmp<bf16><<<512, 256, 0, stream>>>(MIXB, DM, ck + (size_t)MS * D_IN, DM, MS, 384, e + 2);
                        k_cmp<bf16><<<512, 256, 0, stream>>>(MIXB + 384, DM, ck + (size_t)MS * D_IN + 384, DM, MS, 384, e + 4);
                        k_cmp<bf16><<<512, 256, 0, stream>>>(MIXB + 768, DM, ck + (size_t)MS * D_IN + 768, DM, MS, 256, e + 6); }
        if (rel == 5) k_cmp<bf16><<<512, 256, 0, stream>>>(Hf, DM, ck + (size_t)MS * (D_IN + DM), DM, MS, DM, e + 8);
        if (layer == 0 && rel == 8) k_cmp<bf16><<<512, 256, 0, stream>>>(Hf, DM, ck + (size_t)MS * (D_IN + 2 * DM), DM, MS, DM, e + 10);
        if (layer == 1 && rel == 10) k_cmp<float><<<512, 256, 0, stream>>>(Hout, DM, ck + (size_t)MS * (D_IN + 2 * DM), DM, MS, DM, e + 10);
    }
    k_encode<<<1024, 256, 0, stream>>>(err, 12, sout, (float*)d_out, MS, (long)NBATCH * SEQ, DBG_THR);
#endif
}
```

```cpp
#define DEBUG_BUILD 0
#define DBG_THR 0.02f
#define PROBE_MASK 0u
#define PROBE_AMP 0
#include <hip/hip_runtime.h>
#include <cstdio>
#include <cstdint>

constexpr int DM = 1024, SEQ = 2048, NBATCH = 8;
constexpr int ATT_H = 6, HD = 64, ATT_W = 384, ROPE_DIM = 16;
constexpr int MOBA_BLOCK = 256, NBLK = SEQ / MOBA_BLOCK;
constexpr int SSD_H = 6, SSD_W = 384, SSD_G = 2, SSD_N = 128, SSD_CW = 896;
constexpr int GM_G = 4, GM_W = 256, GM_CHUNK = 128;
constexpr int D_IN = 2950, D_FF = 2816, N_EXP = 8, D_FFE = 3584;
constexpr float ALPHA = 1.4142135623730951f;
constexpr float NEGF = -1e30f;
constexpr int MAXSLOT = 2 * NBATCH * SEQ + N_EXP * 256;

typedef unsigned short bf16;
__device__ __forceinline__ unsigned f2bf(float f) { unsigned u = __float_as_uint(f); return (u + 0x7fffu + ((u >> 16) & 1u)) >> 16; }
__device__ __forceinline__ float ldf(const float* p) { return *p; }
__device__ __forceinline__ float ldf(const bf16* p) { return __uint_as_float(((unsigned)*p) << 16); }
__device__ __forceinline__ void stf(float* p, float v) { *p = v; }
__device__ __forceinline__ void stf(bf16* p, float v) { *p = (bf16)f2bf(v); }

__device__ __forceinline__ float wave_sum(float v) {
#pragma unroll
    for (int o = 1; o < 64; o <<= 1) v += __shfl_xor(v, o);
    return v;
}
__device__ __forceinline__ float silu_f(float x) { return x / (1.f + __expf(-x)); }
__device__ __forceinline__ float gelu_tanh_f(float x) { const float u = 0.7978845608028654f * (x + 0.044715f * x * x * x); return 0.5f * x * (1.f + tanhf(u)); }
__device__ __forceinline__ float softplus_f(float x) { return fmaxf(x, 0.f) + log1pf(__expf(-fabsf(x))); }

struct ProjL { int ld, q, k, v, z, xbc, dt, gu, gv; };

__device__ __forceinline__ float4 ld4(const float* p) { return *(const float4*)p; }
__device__ __forceinline__ float4 ld4(const bf16* p) { const uint2 w = *(const uint2*)p; return make_float4(__uint_as_float(w.x << 16), __uint_as_float(w.x & 0xffff0000u), __uint_as_float(w.y << 16), __uint_as_float(w.y & 0xffff0000u)); }
template <class TY, class TX = float> __device__ __forceinline__ void ln_load(float (&v)[16], const TX* xrow, float a, const TY* y1, const TY* y2, int lane) {
#pragma unroll
    for (int j = 0; j < 4; ++j) {
        const float4 x = ld4(xrow + j * 256 + lane * 4);
        float4 t = make_float4(a * x.x, a * x.y, a * x.z, a * x.w);
        if (y1) { const float4 y = ld4(y1 + j * 256 + lane * 4); t.x += y.x; t.y += y.y; t.z += y.z; t.w += y.w; }
        if (y2) { const float4 y = ld4(y2 + j * 256 + lane * 4); t.x += y.x; t.y += y.y; t.z += y.z; t.w += y.w; }
        v[4 * j] = t.x; v[4 * j + 1] = t.y; v[4 * j + 2] = t.z; v[4 * j + 3] = t.w;
    }
}
__device__ __forceinline__ void ln_add(float (&v)[16], const bf16* y, int lane) {
#pragma unroll
    for (int j = 0; j < 4; ++j) { const float4 t = ld4(y + j * 256 + lane * 4); v[4 * j] += t.x; v[4 * j + 1] += t.y; v[4 * j + 2] += t.z; v[4 * j + 3] += t.w; }
}
__device__ __forceinline__ void ln_finish(float (&v)[16], const float* g, const float* b, float* of, bf16* ob, int lane) {
    float s = 0.f;
#pragma unroll
    for (int i = 0; i < 16; ++i) s += v[i];
    const float mean = wave_sum(s) * (1.f / 1024.f); float s2 = 0.f;
#pragma unroll
    for (int i = 0; i < 16; ++i) { v[i] -= mean; s2 += v[i] * v[i]; }
    const float rstd = rsqrtf(wave_sum(s2) * (1.f / 1024.f) + 1e-5f);
#pragma unroll
    for (int j = 0; j < 4; ++j) {
        const float4 gg = *(const float4*)(g + j * 256 + lane * 4), bb = *(const float4*)(b + j * 256 + lane * 4);
        float4 o = make_float4(v[4 * j] * rstd * gg.x + bb.x, v[4 * j + 1] * rstd * gg.y + bb.y, v[4 * j + 2] * rstd * gg.z + bb.z, v[4 * j + 3] * rstd * gg.w + bb.w);
        if (of) *(float4*)(of + j * 256 + lane * 4) = o;
        if (ob) { uint2 w; w.x = f2bf(o.x) | (f2bf(o.y) << 16); w.y = f2bf(o.z) | (f2bf(o.w) << 16); *(uint2*)(ob + j * 256 + lane * 4) = w; }
    }
}
template <class TY> __device__ __forceinline__ void ln_row(const float* xrow, float a, const TY* y1, const TY* y2, const float* g, const float* b, float* of, bf16* ob, int lane) {
    float v[16]; ln_load<TY>(v, xrow, a, y1, y2, lane); ln_finish(v, g, b, of, ob, lane);
}

__device__ __forceinline__ void rope_inplace(float* P, ProjL L, const int* pos, long n_rows, long gt, long ngt) {
    for (long it = gt; it < n_rows * 96; it += ngt) {
        const int i = (int)(it & 7), hh = (int)((it >> 3) % 12); const long row = it / 96;
        const int off = (hh < 6 ? L.q : L.k) + (hh % 6) * 64;
        const float inv = powf(500000.0f, -(float)(2 * i) / 16.0f);
        const float ang = (float)pos[row] * inv;
        const float c = cosf(ang), s = sinf(ang);
        float* p = P + row * L.ld + off;
        const float x1 = p[i], x2 = p[i + 8];
        p[i] = x1 * c - x2 * s; p[i + 8] = x2 * c + x1 * s;
    }
}

template <class T> __device__ __forceinline__ void kmean_phase(const T* P, ProjL L, float* KM, int nb, long gt, long ngt) {
    for (long it = gt; it < (long)nb * ATT_H * NBLK * 64; it += ngt) {
        const int d = (int)(it & 63), n = (int)((it >> 6) % NBLK), h = (int)((it / (64 * NBLK)) % ATT_H), b = (int)(it / (64 * NBLK * ATT_H));
        const T* p = P + ((long)b * SEQ + n * MOBA_BLOCK) * L.ld + L.k + h * 64 + d; float s = 0.f;
        for (int r = 0; r < MOBA_BLOCK; ++r) s += ldf(p + (long)r * L.ld);
        KM[it] = s * (1.f / MOBA_BLOCK);
    }
}

template <class T> __device__ __forceinline__ void attn_naive_phase(const T* P, ProjL L, const float* KM, float* O, int ldo, int nb, int gw, int ngw, int lane) {
    for (long it = gw; it < (long)nb * ATT_H * SEQ; it += ngw) {
        const int q = (int)(it % SEQ), h = (int)((it / SEQ) % ATT_H), b = (int)(it / ((long)SEQ * ATT_H));
        const long row = (long)b * SEQ + q; const int qblk = q / MOBA_BLOCK;
        const float qv = ldf(P + row * L.ld + L.q + h * 64 + lane);
        float g[NBLK];
#pragma unroll
        for (int n = 0; n < NBLK; ++n) { const float t = wave_sum(qv * KM[(((long)b * ATT_H + h) * NBLK + n) * 64 + lane]); g[n] = (n < qblk) ? t : NEGF; }
        unsigned sel = 0u;
#pragma unroll
        for (int r = 0; r < 3; ++r) { float bv = -3.0e38f; int best = -1;
#pragma unroll
            for (int n = 0; n < NBLK; ++n) if (!((sel >> n) & 1u) && g[n] > bv) { bv = g[n]; best = n; }
            if (best >= 0 && bv > NEGF * 0.5f) sel |= 1u << best; }
        sel |= 1u << qblk;
        float m = -3.0e38f, l = 0.f, o = 0.f;
        for (int n = 0; n <= qblk; ++n) {
            if (!((sel >> n) & 1u)) continue;
            const int j0 = n * MOBA_BLOCK, j1 = (n == qblk) ? q + 1 : j0 + MOBA_BLOCK;
            const T* kp = P + ((long)b * SEQ + j0) * L.ld + L.k + h * 64 + lane;
            const T* vp = P + ((long)b * SEQ + j0) * L.ld + L.v + h * 64 + lane;
            for (int j = j0; j < j1; ++j, kp += L.ld, vp += L.ld) {
                const float s = wave_sum(qv * ldf(kp)) * 0.125f;
                const float mn = fmaxf(m, s), corr = __expf(m - mn), p = __expf(s - mn);
                l = l * corr + p; o = o * corr + p * ldf(vp); m = mn;
            }
        }
        O[row * ldo + h * 64 + lane] = o / l;
    }
}

template <int W, class TO> __device__ __forceinline__ void rms_rows_phase(const float* in, int ldi, const float* g, TO* out, int ldo, long n_rows, int gw, int ngw, int lane) {
    constexpr int PER = W / 64;
    for (long row = gw; row < n_rows; row += ngw) {
        float v[PER]; float s = 0.f;
#pragma unroll
        for (int j = 0; j < PER; ++j) { v[j] = in[row * ldi + j * 64 + lane]; s += v[j] * v[j]; }
        const float r = rsqrtf(wave_sum(s) * (1.f / W) + 1e-5f);
#pragma unroll
        for (int j = 0; j < PER; ++j) stf(out + row * ldo + j * 64 + lane, v[j] * r * g[j * 64 + lane]);
    }
}

template <class T, class TO> __device__ __forceinline__ void ssd_conv_phase(const T* P, ProjL L, const float* cw, const float* cb, const float* dtb, TO* XC, float* DT, long n_rows, long gt, long ngt) {
    for (long it = gt; it < n_rows * 902; it += ngt) {
        const int c = (int)(it % 902); const long row = it / 902; const int t = (int)(row % SEQ);
        if (c < SSD_CW) {
            float acc = cb[c];
#pragma unroll
            for (int i = 0; i < 4; ++i) { const int tt = t - 3 + i; if (tt >= 0) acc += cw[i * SSD_CW + c] * ldf(P + (row - 3 + i) * L.ld + L.xbc + c); }
            stf(XC + row * SSD_CW + c, silu_f(acc));
        } else {
            const int h = c - SSD_CW;
            DT[row * SSD_H + h] = softplus_f(ldf(P + row * L.ld + L.dt + h) + dtb[h]);
        }
    }
}

template <class T> __device__ __forceinline__ void ssd_scan_naive_phase(const T* XC, const float* DT, const float* a_log, const float* dsk, float* Y, int ldo, int nb, int gw, int ngw, int lane) {
    for (int it = gw; it < nb * SSD_H * 64; it += ngw) {
        const int p = it & 63, h = (it >> 6) % SSD_H, b = it / (64 * SSD_H), grp = h / (SSD_H / SSD_G);
        const float A = -__expf(a_log[h]), Dk = dsk[h];
        float s0 = 0.f, s1 = 0.f;
#pragma unroll 4
        for (int t = 0; t < SEQ; ++t) {
            const long row = (long)b * SEQ + t;
            const T* xr = XC + row * SSD_CW;
            const float dt = DT[row * SSD_H + h], x = ldf(xr + h * 64 + p);
            const float B0 = ldf(xr + SSD_W + grp * SSD_N + lane), B1 = ldf(xr + SSD_W + grp * SSD_N + 64 + lane);
            const float C0 = ldf(xr + SSD_W + SSD_G * SSD_N + grp * SSD_N + lane), C1 = ldf(xr + SSD_W + SSD_G * SSD_N + grp * SSD_N + 64 + lane);
            const float dec = __expf(dt * A), xd = x * dt;
            s0 = s0 * dec + xd * B0; s1 = s1 * dec + xd * B1;
            const float y = wave_sum(C0 * s0 + C1 * s1);
            if (lane == 0) Y[row * ldo + h * 64 + p] = y + Dk * x;
        }
    }
}

template <class T, class TO> __device__ __forceinline__ void ssd_gate_phase(const float* Y, int ldi, const T* P, ProjL L, const float* ng, TO* out, int ldo, long n_rows, int gw, int ngw, int lane) {
    for (long row = gw; row < n_rows; row += ngw) {
        float v[6];
#pragma unroll
        for (int j = 0; j < 6; ++j) { const int c = j * 64 + lane; v[j] = Y[row * ldi + c] * silu_f(ldf(P + row * L.ld + L.z + c)); }
        const float r0 = rsqrtf(wave_sum(v[0] * v[0] + v[1] * v[1] + v[2] * v[2]) * (1.f / 192.f) + 1e-5f);
        const float r1 = rsqrtf(wave_sum(v[3] * v[3] + v[4] * v[4] + v[5] * v[5]) * (1.f / 192.f) + 1e-5f);
#pragma unroll
        for (int j = 0; j < 6; ++j) { const int c = j * 64 + lane; stf(out + row * ldo + c, v[j] * (j < 3 ? r0 : r1) * ng[c]); }
    }
}

template <class T, bool PRE> __device__ __forceinline__ void gm_ln_phase(const T* P, ProjL L, const float* g, const float* b, float* VN, long n_rows, int gw, int ngw, int lane) {
    for (long row = gw; row < n_rows; row += ngw) {
        float v[4]; float s = 0.f;
#pragma unroll
        for (int j = 0; j < 4; ++j) { const float x = ldf(P + row * L.ld + L.gv + j * 64 + lane); v[j] = PRE ? x : gelu_tanh_f(x); s += v[j]; }
        const float mean = wave_sum(s) * (1.f / 256.f); float s2 = 0.f;
#pragma unroll
        for (int j = 0; j < 4; ++j) { v[j] -= mean; s2 += v[j] * v[j]; }
        const float rstd = rsqrtf(wave_sum(s2) * (1.f / 256.f) + 1e-5f);
#pragma unroll
        for (int j = 0; j < 4; ++j) VN[row * GM_W + j * 64 + lane] = v[j] * rstd * g[j * 64 + lane] + b[j * 64 + lane];
    }
}
template <class T, bool PRE> __device__ __forceinline__ void gm_mix_phase(const T* P, ProjL L, const float* VN, const float* ws_, const float* bs, float* GO, int ldo, long n_rows, long gt, long ngt) {
    for (long it = gt; it < n_rows * GM_W; it += ngt) {
        const int c = (int)(it % GM_W); const long row = it / GM_W; const int t = (int)(row % GM_CHUNK), g = c / 64; const long base = row - t;
        const float* w = ws_ + ((long)g * GM_CHUNK + t) * GM_CHUNK; float acc = 0.f;
        for (int s = 0; s <= t; ++s) acc += w[s] * VN[(base + s) * GM_W + c];
        acc += bs[g * GM_CHUNK + t];
        const float x = ldf(P + row * L.ld + L.gu + c); const float u = PRE ? x : gelu_tanh_f(x);
        GO[row * ldo + c] = u * acc;
    }
}

__device__ __forceinline__ void moe_route_phase(const float* H, const float* Wr, int* CNT, int* TE, float* TP, int* TS, long n_rows, int gw, int ngw, int lane) {
    for (long row = gw; row < n_rows; row += ngw) {
        float acc[N_EXP];
#pragma unroll
        for (int e = 0; e < N_EXP; ++e) acc[e] = 0.f;
        for (int j = 0; j < 16; ++j) { const int d = j * 64 + lane; const float hv = H[row * DM + d];
            const float4 w0 = *(const float4*)(Wr + d * N_EXP), w1 = *(const float4*)(Wr + d * N_EXP + 4);
            acc[0] += hv * w0.x; acc[1] += hv * w0.y; acc[2] += hv * w0.z; acc[3] += hv * w0.w; acc[4] += hv * w1.x; acc[5] += hv * w1.y; acc[6] += hv * w1.z; acc[7] += hv * w1.w; }
#pragma unroll
        for (int e = 0; e < N_EXP; ++e) acc[e] = wave_sum(acc[e]);
        int e0 = 0; float v0 = acc[0];
#pragma unroll
        for (int e = 1; e < N_EXP; ++e) if (acc[e] > v0) { v0 = acc[e]; e0 = e; }
        int e1 = -1; float v1 = -3.0e38f;
#pragma unroll
        for (int e = 0; e < N_EXP; ++e) if (e != e0 && acc[e] > v1) { v1 = acc[e]; e1 = e; }
        const float p1 = __expf(v1 - v0), den = 1.f + p1;
        if (lane == 0) {
            const int s0 = atomicAdd(&CNT[e0], 1), s1 = atomicAdd(&CNT[e1], 1);
            TE[row * 2] = e0; TE[row * 2 + 1] = e1; TP[row * 2] = 1.f / den; TP[row * 2 + 1] = p1 / den; TS[row * 2] = s0; TS[row * 2 + 1] = s1;
        }
    }
}

__device__ __forceinline__ void moe_route_block(const bf16* H, const float* Wr, int* CNT, int* TE, float* TP, int* TS, long n_rows, int gw_, int ngw_, int lane, int wave, int tid,
                                                __attribute__((address_space(3))) int* sh  ) {
    asm volatile("" : "+v"(tid));
    if (tid < 16) sh[tid] = 0;
    __syncthreads();
    int k = 0;
    for (long row = gw_; row < n_rows; row += ngw_, ++k) {
        float acc[N_EXP];
#pragma unroll
        for (int e = 0; e < N_EXP; ++e) acc[e] = 0.f;
        for (int j = 0; j < 16; ++j) { const int d = j * 64 + lane; const float hv = ldf(H + row * DM + d);
            const float4 w0 = *(const float4*)(Wr + d * N_EXP), w1 = *(const float4*)(Wr + d * N_EXP + 4);
            acc[0] += hv * w0.x; acc[1] += hv * w0.y; acc[2] += hv * w0.z; acc[3] += hv * w0.w; acc[4] += hv * w1.x; acc[5] += hv * w1.y; acc[6] += hv * w1.z; acc[7] += hv * w1.w; }
#pragma unroll
        for (int e = 0; e < N_EXP; ++e) acc[e] = wave_sum(acc[e]);
        int e0 = 0; float v0 = acc[0];
#pragma unroll
        for (int e = 1; e < N_EXP; ++e) if (acc[e] > v0) { v0 = acc[e]; e0 = e; }
        int e1 = -1; float v1 = -3.0e38f;
#pragma unroll
        for (int e = 0; e < N_EXP; ++e) if (e != e0 && acc[e] > v1) { v1 = acc[e]; e1 = e; }
        const float p1 = __expf(v1 - v0), den = 1.f + p1;
        if (lane == 0) {
            const int l0 = atomicAdd((int*)&sh[e0], 1), l1 = atomicAdd((int*)&sh[e1], 1);
            TE[row * 2] = e0; TE[row * 2 + 1] = e1; TP[row * 2] = 1.f / den; TP[row * 2 + 1] = p1 / den;
            sh[16 + (wave * 8 + k) * 4 + 0] = e0; sh[16 + (wave * 8 + k) * 4 + 1] = e1; sh[16 + (wave * 8 + k) * 4 + 2] = l0; sh[16 + (wave * 8 + k) * 4 + 3] = l1;
        }
    }
    __syncthreads();
    if (tid < N_EXP) sh[8 + tid] = atomicAdd(&CNT[tid], sh[tid]);
    __syncthreads();
    k = 0;
    for (long row = gw_; row < n_rows; row += ngw_, ++k)
        if (lane == 0) { const int e0 = sh[16 + (wave * 8 + k) * 4], e1 = sh[16 + (wave * 8 + k) * 4 + 1];
            TS[row * 2] = sh[8 + e0] + sh[16 + (wave * 8 + k) * 4 + 2]; TS[row * 2 + 1] = sh[8 + e1] + sh[16 + (wave * 8 + k) * 4 + 3]; }
    __syncthreads();
}
__device__ __forceinline__ int moe_base(const int* CNT, int e) { int b = 0; for (int i = 0; i < e; ++i) b += (CNT[i] + 255) & ~255; return b; }
__device__ __forceinline__ void moe_scatter_phase(const int* CNT, const int* TE, const float* TP, const int* TS, int* LIST, float* SP, int* GS, long n_rows, long gt, long ngt) {
    for (long it = gt; it < n_rows * 2; it += ngt) {
        const int e = TE[it]; const int gs = moe_base(CNT, e) + TS[it];
        LIST[gs] = (int)(it >> 1); SP[gs] = TP[it]; GS[it] = gs;
    }
}

template <class TA, int EPI> __global__ void __launch_bounds__(256) sgemm_k(const TA* A, int lda, const int* rowlist, const float* B, const float* B2, int ldb, long bstride, void* Cv, int ldc, int M, int N, int K, const int* CNT, const float* scale) {
    __shared__ float As[16][68], Bs[16][68], Bs2[16][68];
    int row_base = 0, mrows = M;
    if (CNT) { const int e = blockIdx.z; row_base = moe_base(CNT, e); mrows = CNT[e]; B += (long)e * bstride; if (B2) B2 += (long)e * bstride; }
    const int m0 = blockIdx.y * 64; if (m0 >= mrows) return;
    const int n0 = blockIdx.x * 64, tid = threadIdx.x, tx = tid & 15, ty = tid >> 4;
    float acc[4][4], acc2[4][4];
#pragma unroll
    for (int i = 0; i < 4; ++i)
#pragma unroll
        for (int j = 0; j < 4; ++j) { acc[i][j] = 0.f; acc2[i][j] = 0.f; }
    const int ar = tid >> 2, ak = (tid & 3) * 4; long arow = -1;
    { const int lr = m0 + ar; if (lr < mrows) { arow = rowlist ? (long)rowlist[row_base + lr] : (long)(row_base + lr); } }
    const int bk = tid >> 4, bn = (tid & 15) * 4;
    for (int k0 = 0; k0 < K; k0 += 16) {
        float av[4] = {0.f, 0.f, 0.f, 0.f};
        if (arow >= 0) {
#pragma unroll
            for (int i = 0; i < 4; ++i) av[i] = ldf(A + arow * lda + k0 + ak + i);
        }
#pragma unroll
        for (int i = 0; i < 4; ++i) As[ak + i][ar] = av[i];
#pragma unroll
        for (int i = 0; i < 4; ++i) { const int n = n0 + bn + i; const bool ok = n < N;
            Bs[bk][bn + i] = ok ? B[(long)(k0 + bk) * ldb + n] : 0.f;
            if (EPI == 1 || EPI == 2) Bs2[bk][bn + i] = ok ? B2[(long)(k0 + bk) * ldb + n] : 0.f; }
        __syncthreads();
#pragma unroll
        for (int kk = 0; kk < 16; ++kk) {
            float a[4], b[4], b2[4];
#pragma unroll
            for (int i = 0; i < 4; ++i) { a[i] = As[kk][ty * 4 + i]; b[i] = Bs[kk][tx * 4 + i]; if (EPI == 1 || EPI == 2) b2[i] = Bs2[kk][tx * 4 + i]; }
#pragma unroll
            for (int i = 0; i < 4; ++i)
#pragma unroll
                for (int j = 0; j < 4; ++j) { acc[i][j] += a[i] * b[j]; if (EPI == 1 || EPI == 2) acc2[i][j] += a[i] * b2[j]; }
        }
        __syncthreads();
    }
#pragma unroll
    for (int i = 0; i < 4; ++i) { const int lr = m0 + ty * 4 + i; if (lr >= mrows) continue; const long crow = row_base + lr;
#pragma unroll
        for (int j = 0; j < 4; ++j) { const int n = n0 + tx * 4 + j; if (n >= N) continue;
            float v = acc[i][j];
            if (EPI == 1 || EPI == 2) v = silu_f(v) * acc2[i][j];
            if (EPI == 3) v *= scale[crow];
            if (EPI == 2) ((bf16*)Cv)[crow * ldc + n] = (bf16)f2bf(v); else ((float*)Cv)[crow * ldc + n] = v; } }
}

#define GW_DECL const int lane = threadIdx.x & 63; const int gw = (int)((blockIdx.x * (long)blockDim.x + threadIdx.x) >> 6); const int ngw = (int)((gridDim.x * (long)blockDim.x) >> 6); (void)lane; (void)gw; (void)ngw;
#define GT_DECL const long gt = blockIdx.x * (long)blockDim.x + threadIdx.x; const long ngt = gridDim.x * (long)blockDim.x;

__global__ void k_ln_in(const float* x, const float* g, const float* b, float* H, long n_rows) { GW_DECL for (long r = gw; r < n_rows; r += ngw) ln_row<float>(x + r * DM, 1.f, nullptr, nullptr, g, b, H + r * DM, nullptr, lane); }
__global__ void k_ln_res(float* H, const float* Y, const float* g, const float* b, float* OUT, long n_rows) { GW_DECL for (long r = gw; r < n_rows; r += ngw) ln_row<float>(H + r * DM, ALPHA, Y + r * DM, nullptr, g, b, OUT + r * DM, nullptr, lane); }
__global__ void k_ln_moe(float* H, const float* F2, const int* GS, const float* g, const float* b, float* OUT, long n_rows) { GW_DECL for (long r = gw; r < n_rows; r += ngw) ln_row<float>(H + r * DM, ALPHA, F2 + (long)GS[r * 2] * DM, F2 + (long)GS[r * 2 + 1] * DM, g, b, OUT + r * DM, nullptr, lane); }
__global__ void k_rope(float* P, ProjL L, const int* pos, long n_rows) { GT_DECL rope_inplace(P, L, pos, n_rows, gt, ngt); }
__global__ void k_kmean(const float* P, ProjL L, float* KM, int nb) { GT_DECL kmean_phase<float>(P, L, KM, nb, gt, ngt); }
__global__ void k_attn(const float* P, ProjL L, const float* KM, float* O, int ldo, int nb) { GW_DECL attn_naive_phase<float>(P, L, KM, O, ldo, nb, gw, ngw, lane); }
__global__ void k_rms384(const float* in, int ldi, const float* g, float* out, int ldo, long n_rows) { GW_DECL rms_rows_phase<384, float>(in, ldi, g, out, ldo, n_rows, gw, ngw, lane); }
__global__ void k_rms256(const float* in, int ldi, const float* g, float* out, int ldo, long n_rows) { GW_DECL rms_rows_phase<256, float>(in, ldi, g, out, ldo, n_rows, gw, ngw, lane); }
__global__ void k_ssd_conv(const float* P, ProjL L, const float* cw, const float* cb, const float* dtb, float* XC, float* DT, long n_rows) { GT_DECL ssd_conv_phase<float, float>(P, L, cw, cb, dtb, XC, DT, n_rows, gt, ngt); }
__global__ void k_ssd_scan(const float* XC, const float* DT, const float* a_log, const float* dsk, float* Y, int ldo, int nb) { GW_DECL ssd_scan_naive_phase<float>(XC, DT, a_log, dsk, Y, ldo, nb, gw, ngw, lane); }
__global__ void k_ssd_gate(const float* Y, int ldi, const float* P, ProjL L, const float* ng, float* out, int ldo, long n_rows) { GW_DECL ssd_gate_phase<float, float>(Y, ldi, P, L, ng, out, ldo, n_rows, gw, ngw, lane); }
__global__ void k_gm_ln(const float* P, ProjL L, const float* g, const float* b, float* VN, long n_rows) { GW_DECL gm_ln_phase<float, false>(P, L, g, b, VN, n_rows, gw, ngw, lane); }
__global__ void k_gm_mix(const float* P, ProjL L, const float* VN, const float* ws_, const float* bs, float* GO, int ldo, long n_rows) { GT_DECL gm_mix_phase<float, false>(P, L, VN, ws_, bs, GO, ldo, n_rows, gt, ngt); }
__global__ void k_moe_init(int* CNT, int* LIST, int nslots) { GT_DECL if (gt < N_EXP) CNT[gt] = 0; for (long i = gt; i < nslots; i += ngt) LIST[i] = -1; }
__global__ void k_moe_route(const float* H, const float* Wr, int* CNT, int* TE, float* TP, int* TS, long n_rows) { GW_DECL moe_route_phase(H, Wr, CNT, TE, TP, TS, n_rows, gw, ngw, lane); }
__global__ void k_moe_scatter(const int* CNT, const int* TE, const float* TP, const int* TS, int* LIST, float* SP, int* GS, long n_rows) { GT_DECL moe_scatter_phase(CNT, TE, TP, TS, LIST, SP, GS, n_rows, gt, ngt); }

struct Inputs {
    const float *x; const int* pos; const float *ln_in_g, *ln_in_b, *w_in, *conv_w, *conv_b, *dt_bias, *a_log, *d_skip, *ssd_norm_g, *att_norm_g, *gm_ln_g, *gm_ln_b, *gm_w_s, *gm_b_s, *gm_norm_g, *w_out,
        *ln1_g, *ln1_b, *ln2_g, *ln2_b, *ffn_w_gate, *ffn_w_up, *ffn_w_down, *router_w, *moe_w_gate, *moe_w_up, *moe_w_down;
};

static void run_simple(const Inputs& I, int nb, unsigned char* ws, float* aux  , float* OUT, hipStream_t st, float* ckpt = nullptr) {
    const long M = (long)nb * SEQ; const size_t MB = 1u << 20;
    const size_t hsz = (size_t)M * DM * 4;
    float* H = (float*)ws; float* MIX = (float*)(ws + hsz); float* Y = (float*)(ws + 2 * hsz); unsigned char* BIG = ws + 3 * hsz + (size_t)N_EXP * 256 * DM * 4;
    float* XC = Y;
    float* VN = aux;
    float* PROJ = (float*)BIG;
    size_t big_bytes = (size_t)M * D_IN * 4; { size_t a = (size_t)M * D_FF * 4; if (a > big_bytes) big_bytes = a; size_t c = (size_t)(2 * M + N_EXP * 256) * D_FFE * 2; if (c > big_bytes) big_bytes = c; }
    big_bytes = (big_bytes + 255) & ~(size_t)255;
    unsigned char* SM = BIG + big_bytes;
    float* KM = (float*)SM; SM += (size_t)nb * ATT_H * NBLK * 64 * 4;
    float* DT = (float*)SM; SM += (size_t)M * SSD_H * 4;
    int* CNT = (int*)SM; SM += 256;
    int* TE = (int*)SM; SM += (size_t)M * 2 * 4; float* TP = (float*)SM; SM += (size_t)M * 2 * 4; int* TS = (int*)SM; SM += (size_t)M * 2 * 4; int* GS = (int*)SM; SM += (size_t)M * 2 * 4;
    const int nslots = (int)(2 * M + N_EXP * 256);
    int* LIST = (int*)SM; SM += (size_t)nslots * 4; float* SP = (float*)SM; SM += (size_t)nslots * 4;
    (void)MB;
    const ProjL L{D_IN, 0, 384, 768, 1152, 1536, 2432, 2438, 2694};
    const int TB = 256; const int GWB = 2048;
    k_ln_in<<<GWB, TB, 0, st>>>(I.x, I.ln_in_g, I.ln_in_b, H, M);
    for (int i = 0; i < 2; ++i) {
        sgemm_k<float, 0><<<dim3((D_IN + 63) / 64, (unsigned)(M / 64), 1), 256, 0, st>>>(H, DM, nullptr, I.w_in + (size_t)i * DM * D_IN, nullptr, D_IN, 0, PROJ, D_IN, (int)M, D_IN, DM, nullptr, nullptr);
        k_rope<<<GWB, TB, 0, st>>>(PROJ, L, I.pos, M);
        const size_t ck_stride = (size_t)M * (D_IN + 3 * DM); float* ck = ckpt ? ckpt + (size_t)i * ck_stride : nullptr;
        if (ck) hipMemcpyAsync(ck, PROJ, (size_t)M * D_IN * 4, hipMemcpyDeviceToDevice, st);
        k_kmean<<<96 * nb, TB, 0, st>>>(PROJ, L, KM, nb);
        k_attn<<<GWB * 2, TB, 0, st>>>(PROJ, L, KM, MIX, DM, nb);
        k_rms384<<<GWB, TB, 0, st>>>(MIX, DM, I.att_norm_g + i * ATT_W, MIX, DM, M);
        k_ssd_conv<<<GWB * 2, TB, 0, st>>>(PROJ, L, I.conv_w + (size_t)i * 4 * SSD_CW, I.conv_b + i * SSD_CW, I.dt_bias + i * SSD_H, XC, DT, M);
        k_ssd_scan<<<(nb * SSD_H * 64 * 64 + TB - 1) / TB, TB, 0, st>>>(XC, DT, I.a_log + i * SSD_H, I.d_skip + i * SSD_H, MIX + ATT_W, DM, nb);
        k_ssd_gate<<<GWB, TB, 0, st>>>(MIX + ATT_W, DM, PROJ, L, I.ssd_norm_g + i * SSD_W, MIX + ATT_W, DM, M);
        k_gm_ln<<<GWB, TB, 0, st>>>(PROJ, L, I.gm_ln_g + i * GM_W, I.gm_ln_b + i * GM_W, VN, M);
        k_gm_mix<<<GWB * 2, TB, 0, st>>>(PROJ, L, VN, I.gm_w_s + (size_t)i * GM_G * GM_CHUNK * GM_CHUNK, I.gm_b_s + i * GM_G * GM_CHUNK, MIX + ATT_W + SSD_W, DM, M);
        k_rms256<<<GWB, TB, 0, st>>>(MIX + ATT_W + SSD_W, DM, I.gm_norm_g + i * GM_W, MIX + ATT_W + SSD_W, DM, M);
        if (ck) hipMemcpyAsync(ck + (size_t)M * D_IN, MIX, hsz, hipMemcpyDeviceToDevice, st);
        sgemm_k<float, 0><<<dim3(DM / 64, (unsigned)(M / 64), 1), 256, 0, st>>>(MIX, DM, nullptr, I.w_out + (size_t)i * DM * DM, nullptr, DM, 0, Y, DM, (int)M, DM, DM, nullptr, nullptr);
        k_ln_res<<<GWB, TB, 0, st>>>(H, Y, I.ln1_g + i * DM, I.ln1_b + i * DM, H, M);
        if (ck) hipMemcpyAsync(ck + (size_t)M * (D_IN + DM), H, hsz, hipMemcpyDeviceToDevice, st);
        if (i == 0) {
            float* ACT = (float*)BIG;
            sgemm_k<float, 1><<<dim3(D_FF / 64, (unsigned)(M / 64), 1), 256, 0, st>>>(H, DM, nullptr, I.ffn_w_gate, I.ffn_w_up, D_FF, 0, ACT, D_FF, (int)M, D_FF, DM, nullptr, nullptr);
            sgemm_k<float, 0><<<dim3(DM / 64, (unsigned)(M / 64), 1), 256, 0, st>>>(ACT, D_FF, nullptr, I.ffn_w_down, nullptr, DM, 0, Y, DM, (int)M, DM, D_FF, nullptr, nullptr);
            k_ln_res<<<GWB, TB, 0, st>>>(H, Y, I.ln2_g + i * DM, I.ln2_b + i * DM, H, M);
            if (ck) hipMemcpyAsync(ck + (size_t)M * (D_IN + 2 * DM), H, hsz, hipMemcpyDeviceToDevice, st);
        } else {
            bf16* ACTM = (bf16*)BIG; float* F2 = MIX;
            k_moe_init<<<256, TB, 0, st>>>(CNT, LIST, nslots);
            k_moe_route<<<GWB, TB, 0, st>>>(H, I.router_w, CNT, TE, TP, TS, M);
            k_moe_scatter<<<256, TB, 0, st>>>(CNT, TE, TP, TS, LIST, SP, GS, M);
            sgemm_k<float, 2><<<dim3(D_FFE / 64, (unsigned)(M / 64), N_EXP), 256, 0, st>>>(H, DM, LIST, I.moe_w_gate, I.moe_w_up, D_FFE, (long)DM * D_FFE, ACTM, D_FFE, 0, D_FFE, DM, CNT, nullptr);
            sgemm_k<bf16, 3><<<dim3(DM / 64, (unsigned)(M / 64), N_EXP), 256, 0, st>>>(ACTM, D_FFE, nullptr, I.moe_w_down, nullptr, DM, (long)D_FFE * DM, F2, DM, 0, DM, D_FFE, CNT, SP);
            k_ln_moe<<<GWB, TB, 0, st>>>(H, F2, GS, I.ln2_g + i * DM, I.ln2_b + i * DM, OUT, M);
            if (ck) hipMemcpyAsync(ck + (size_t)M * (D_IN + 2 * DM), OUT, hsz, hipMemcpyDeviceToDevice, st);
        }
    }
}

#define LAS __attribute__((address_space(3)))
namespace pg8 {
#define PG8_LAS __attribute__((address_space(3)))
typedef unsigned short bf16_t;
typedef short bf16x8 __attribute__((ext_vector_type(8)));
typedef float f32x4 __attribute__((ext_vector_type(4)));
typedef unsigned u32x4 __attribute__((ext_vector_type(4)));
constexpr int BM = 256, BK = 64, HALF = 128, HTB = HALF * BK * 2  , STAGE_BYTES = 8 * HTB, NXCD = 8, WGM = 8;

__host__ __device__ __forceinline__ int lds_byte(int r, int c) { const int st = (r >> 4) * 2 + (c >> 5), rr = r & 15, cc = c & 31, ob = rr * 64 + cc * 2; return st * 1024 + (ob ^ (((ob >> 9) & 1) << 5)); }
__host__ __device__ __forceinline__ void stage_rc(int b, int& R, int& C) { const int st = b / 1024, sb = b % 1024, swz = sb ^ (((sb >> 9) & 1) << 5); R = (st >> 1) * 16 + swz / 64; C = (st & 1) * 32 + (swz % 64) / 2; }
__host__ __device__ __forceinline__ int perm32(int rho) { const int n = rho >> 4, i = rho & 15; return 8 * (i >> 2) + 4 * n + (i & 3); }

struct Unit { int pm, pn, kofs; };
struct Gemm { const bf16_t* A; const bf16_t* Bt; int M, N, K, ld; };

struct StaticOrder {
    int nM, nN, nwg, G, c;
    __host__ __device__ void init(int M, int N, int G_, int c_) { nM = M / BM; nN = N / BM; nwg = nM * nN; G = G_; c = c_; }
    __host__ __device__ bool next(int i, Unit& u) const {
        const long L = (long)i * G + c; if (L >= nwg) return false;
        int wgid = (int)L; { const int q = nwg / NXCD, r = nwg % NXCD, xcd = wgid % NXCD, off = wgid / NXCD; wgid = (xcd < r ? xcd * (q + 1) : r * (q + 1) + (xcd - r) * q) + off; }
        const int nig = WGM * nN, gid = wgid / nig, fm = gid * WGM, gsz = (nM - fm) < WGM ? (nM - fm) : WGM;
        u.pm = fm + ((wgid % nig) % gsz); u.pn = (wgid % nig) / gsz; u.kofs = 0; return true;
    }
    __device__ __forceinline__ void a_ready(const Unit&) const {}
    __device__ __forceinline__ void done(const Unit&) const {}
};
__device__ __forceinline__ unsigned cvt_pk_bf16(float lo, float hi) { unsigned r; asm volatile("v_cvt_pk_bf16_f32 %0, %1, %2" : "=v"(r) : "v"(lo), "v"(hi)); return r; }
typedef float f32x2 __attribute__((ext_vector_type(2)));
template <class Epi, class Sched, bool ALIGN_EPI = false, bool SP2 = false>
__device__ __forceinline__ void gemm_phase(PG8_LAS unsigned char* lds, const Gemm g, const Sched& S, const Epi& E, const int tid) {
    const int wid = __builtin_amdgcn_readfirstlane(tid >> 6), lane = tid & 63, wr = wid >> 2, wc = wid & 3, fr = lane & 15, fq = lane >> 4;
    const int K = g.ld, nt = g.K / BK;
    unsigned voffA[2], voffB[2];
#pragma unroll
    for (int i = 0; i < 2; ++i) { int R, C; stage_rc(tid * 16 + i * 8192, R, C); const int Rb = Epi::PERM ? ((R & ~31) + perm32(R & 31)) : R;
        voffA[i] = (unsigned)(R * K + C) * 2u; voffB[i] = (unsigned)(Rb * K + C) * 2u; }
    const size_t kstep = (size_t)(BK * 2);
    const size_t hstep = (size_t)HALF * K * 2;
    const size_t tstep = 2 * hstep;
    const unsigned ldsw = (unsigned)wid * 1024u;
    const int aoff = lds_byte(wr * 64 + fr, fq * 8), boff = lds_byte(wc * 32 + fr, fq * 8);
#define PG8_SA(b, h) (((b) * 2 + (h)) * HTB)
#define PG8_SB(b, h) ((4 + (b) * 2 + (h)) * HTB)
#define PG8_STAGE(bufoff, gbase, voff) do { _Pragma("unroll") for (int _i = 0; _i < 2; ++_i) \
        __builtin_amdgcn_global_load_lds((const unsigned*)((const char*)(gbase) + (voff)[_i]), (PG8_LAS unsigned*)(lds + (bufoff) + ldsw + _i * 8192), 16, 0, 0); } while (0)
#define PG8_LDA(dst, b, h) do { _Pragma("unroll") for (int m = 0; m < 4; ++m) _Pragma("unroll") for (int k = 0; k < 2; ++k) dst[m][k] = *(const PG8_LAS bf16x8*)(lds + PG8_SA(b, h) + aoff + m * 2048 + k * 1024); } while (0)
#define PG8_LDB(dst, b, h) do { _Pragma("unroll") for (int n = 0; n < 2; ++n) _Pragma("unroll") for (int k = 0; k < 2; ++k) dst[n][k] = *(const PG8_LAS bf16x8*)(lds + PG8_SB(b, h) + boff + n * 2048 + k * 1024); } while (0)
#define PG8_MMA(ai, bj, At, Bt) do { __builtin_amdgcn_s_setprio(1); _Pragma("unroll") for (int m = 0; m < 4; ++m) _Pragma("unroll") for (int n = 0; n < 2; ++n) _Pragma("unroll") for (int k = 0; k < 2; ++k) \
        acc[ai][bj][m][n] = __builtin_amdgcn_mfma_f32_16x16x32_bf16(Bt[n][k], At[m][k], acc[ai][bj][m][n], 0, 0, 0); __builtin_amdgcn_s_setprio(0); } while (0)
#define PG8_WAIT_V(n) asm volatile("s_waitcnt vmcnt(" #n ")" ::: "memory")
#define PG8_WAIT_L(n) asm volatile("s_waitcnt lgkmcnt(" #n ")" ::: "memory")
#define PG8_BAR __builtin_amdgcn_s_barrier()
#define PG8_SCHED __builtin_amdgcn_sched_barrier(0)
    Unit cur, nxt; int ui = 0;
    if (!S.next(0, cur)) return;
    f32x4 acc[2][2][4][2];
#pragma unroll
    for (int a = 0; a < 2; ++a)
#pragma unroll
        for (int b = 0; b < 2; ++b)
#pragma unroll
            for (int m = 0; m < 4; ++m)
#pragma unroll
                for (int n = 0; n < 2; ++n) acc[a][b][m][n] = (f32x4){0.f, 0.f, 0.f, 0.f};
    bf16x8 At[4][2], B0[2][2], B1[2][2];
    const char* cA = (const char*)g.A + (size_t)cur.pm * tstep + (size_t)cur.kofs * 2; const char* cB = (const char*)g.Bt + (size_t)cur.pn * tstep + (size_t)cur.kofs * 2;
    S.a_ready(cur);
    if constexpr (SP2) {
        PG8_STAGE(PG8_SB(0, 0), cB, voffB); PG8_STAGE(PG8_SB(0, 1), cB + hstep, voffB); PG8_STAGE(PG8_SA(0, 0), cA, voffA); PG8_STAGE(PG8_SA(0, 1), cA + hstep, voffA);
        if (wr == 1) PG8_BAR;
        PG8_WAIT_V(2); PG8_BAR;
        PG8_STAGE(PG8_SB(1, 0), cB + kstep, voffB); PG8_STAGE(PG8_SA(1, 0), cA + kstep, voffA); PG8_STAGE(PG8_SB(1, 1), cB + hstep + kstep, voffB);
        PG8_WAIT_V(6); PG8_BAR;
    } else {
        PG8_STAGE(PG8_SB(0, 0), cB, voffB); PG8_STAGE(PG8_SA(0, 0), cA, voffA); PG8_STAGE(PG8_SB(0, 1), cB + hstep, voffB); PG8_STAGE(PG8_SA(0, 1), cA + hstep, voffA);
        if (wr == 1) PG8_BAR;
        PG8_WAIT_V(4); PG8_BAR;
        PG8_STAGE(PG8_SB(1, 0), cB + kstep, voffB); PG8_STAGE(PG8_SA(1, 0), cA + kstep, voffA); PG8_STAGE(PG8_SB(1, 1), cB + hstep + kstep, voffB);
        PG8_WAIT_V(6); PG8_BAR;
    }
    for (;;) {
        const bool has_next = S.next(ui + 1, nxt);
        const char* nA = has_next ? (const char*)g.A + (size_t)nxt.pm * tstep + (size_t)nxt.kofs * 2 : cA; const char* nB = has_next ? (const char*)g.Bt + (size_t)nxt.pn * tstep + (size_t)nxt.kofs * 2 : cB;
        for (int t = 0; t < nt; t += 2) {
            const bool last = (t == nt - 2);
            const char* a1 = cA + (size_t)(t + 1) * kstep;
            const char* a2 = last ? nA : cA + (size_t)(t + 2) * kstep; const char* b2 = last ? nB : cB + (size_t)(t + 2) * kstep;
            const char* a3 = a2 + kstep; const char* b3 = b2 + kstep;
            if (last && has_next) S.a_ready(nxt);
            if constexpr (SP2) {
            PG8_LDB(B0, 0, 0); PG8_LDB(B1, 0, 1); PG8_SCHED; PG8_LDA(At, 0, 0); PG8_STAGE(PG8_SA(1, 1), a1 + hstep, voffA);
            PG8_WAIT_V(8); PG8_WAIT_L(0); PG8_BAR; PG8_MMA(0, 0, At, B0); PG8_MMA(0, 1, At, B1); PG8_BAR; PG8_SCHED;
            PG8_LDA(At, 0, 1); PG8_STAGE(PG8_SB(0, 0), b2, voffB); PG8_STAGE(PG8_SB(0, 1), b2 + hstep, voffB); PG8_STAGE(PG8_SA(0, 0), a2, voffA);
            PG8_WAIT_V(8); PG8_WAIT_L(0); PG8_BAR; PG8_MMA(1, 0, At, B0); PG8_MMA(1, 1, At, B1); PG8_BAR; PG8_SCHED;
            PG8_LDB(B0, 1, 0); PG8_LDB(B1, 1, 1); PG8_SCHED; PG8_LDA(At, 1, 0); PG8_STAGE(PG8_SA(0, 1), a2 + hstep, voffA);
            PG8_WAIT_V(8); PG8_WAIT_L(0); PG8_BAR; PG8_MMA(0, 0, At, B0); PG8_MMA(0, 1, At, B1); PG8_BAR; PG8_SCHED;
            PG8_LDA(At, 1, 1); PG8_STAGE(PG8_SB(1, 0), b3, voffB); PG8_STAGE(PG8_SB(1, 1), b3 + hstep, voffB); PG8_STAGE(PG8_SA(1, 0), a3, voffA);
            PG8_WAIT_V(8); PG8_WAIT_L(0); PG8_BAR; PG8_MMA(1, 0, At, B0); PG8_MMA(1, 1, At, B1); PG8_BAR; PG8_SCHED;
            } else {
            PG8_LDB(B0, 0, 0); PG8_SCHED; PG8_LDA(At, 0, 0); PG8_STAGE(PG8_SA(1, 1), a1 + hstep, voffA);
            PG8_WAIT_L(8); PG8_BAR; PG8_WAIT_L(0); PG8_MMA(0, 0, At, B0); PG8_BAR; PG8_SCHED;
            PG8_LDB(B1, 0, 1); PG8_STAGE(PG8_SB(0, 0), b2, voffB);
            PG8_BAR; PG8_WAIT_L(0); PG8_MMA(0, 1, At, B1); PG8_BAR;
            PG8_LDA(At, 0, 1); PG8_STAGE(PG8_SA(0, 0), a2, voffA);
            PG8_BAR; PG8_WAIT_L(0); PG8_MMA(1, 0, At, B0); PG8_BAR; PG8_SCHED;
            PG8_STAGE(PG8_SB(0, 1), b2 + hstep, voffB);
            PG8_WAIT_V(6); PG8_BAR; PG8_MMA(1, 1, At, B1); PG8_BAR;
            PG8_LDB(B0, 1, 0); PG8_SCHED; PG8_LDA(At, 1, 0); PG8_STAGE(PG8_SA(0, 1), a2 + hstep, voffA);
            PG8_WAIT_L(8); PG8_BAR; PG8_WAIT_L(0); PG8_MMA(0, 0, At, B0); PG8_BAR; PG8_SCHED;
            PG8_LDB(B1, 1, 1); PG8_STAGE(PG8_SB(1, 0), b3, voffB);
            PG8_BAR; PG8_WAIT_L(0); PG8_MMA(0, 1, At, B1); PG8_BAR;
            PG8_LDA(At, 1, 1); PG8_STAGE(PG8_SA(1, 0), a3, voffA);
            PG8_BAR; PG8_WAIT_L(0); PG8_MMA(1, 0, At, B0); PG8_BAR; PG8_SCHED;
            PG8_STAGE(PG8_SB(1, 1), b3 + hstep, voffB);
            PG8_WAIT_V(6); PG8_BAR; PG8_MMA(1, 1, At, B1); PG8_BAR;
            }
        }
        if constexpr (ALIGN_EPI) { if (wr == 0) PG8_BAR; }
        if constexpr (!Epi::AFTER_DRAIN) { E(acc, cur, wr, wc, fr, fq); S.done(cur); }
        if (!has_next) break;
#pragma unroll
        for (int a = 0; a < 2; ++a)
#pragma unroll
            for (int b = 0; b < 2; ++b)
#pragma unroll
                for (int m = 0; m < 4; ++m)
#pragma unroll
                    for (int n = 0; n < 2; ++n) acc[a][b][m][n] = (f32x4){0.f, 0.f, 0.f, 0.f};
        cur = nxt; cA = nA; cB = nB; ++ui;
        if constexpr (ALIGN_EPI) { if (wr == 1) PG8_BAR; }
    }
    PG8_WAIT_V(0);
    if constexpr (!ALIGN_EPI) { if (wr == 0) PG8_BAR; }
    PG8_BAR;
    if constexpr (Epi::AFTER_DRAIN) { E.fused(acc, cur, wr, wc, fr, fq, lds, wid, lane); S.done(cur); }
#undef PG8_SA
#undef PG8_SB
#undef PG8_STAGE
#undef PG8_LDA
#undef PG8_LDB
#undef PG8_MMA
#undef PG8_WAIT_V
#undef PG8_WAIT_L
#undef PG8_BAR
#undef PG8_SCHED
}
}
#define XB_TMO      128
#define XB_XCNT(j)  (256  + 64 * (j))
#define XB_XSUB(j)  (1280 + 64 * (j))
#define XB_XGEN(j)  (2304 + 64 * (j))
#define XB_TOP      3328
#define XB_TOPGEN   3392
#define XCD_BAR_WORDS 3456
#define XB_SPIN_CAP (1u << 24)

__device__ __forceinline__ unsigned xb_ld(unsigned* p)              { return __hip_atomic_load(p, __ATOMIC_RELAXED, __HIP_MEMORY_SCOPE_AGENT); }
__device__ __forceinline__ unsigned xb_add(unsigned* p, unsigned v) { return __hip_atomic_fetch_add(p, v, __ATOMIC_RELAXED, __HIP_MEMORY_SCOPE_AGENT); }
__device__ __forceinline__ unsigned xb_xcc_id() { return (unsigned)__builtin_amdgcn_s_getreg((3 << 11) | 20) & 0xFu; }
#define XB_SPIN(cond, bar) do { unsigned _sp = 0; while (cond) { __builtin_amdgcn_s_sleep(1); \
    if ((++_sp & 255u) == 0u) { if (xb_ld(&(bar)[XB_TMO])) break; if (_sp > XB_SPIN_CAP) { atomicAdd(&(bar)[XB_TMO], 1u); break; } } } } while (0)

struct XcdBarrier {
    unsigned* bar; unsigned x; int w0;
    volatile LAS unsigned* st;
};

__device__ __forceinline__ XcdBarrier xcd_barrier_post(unsigned* bar, volatile LAS unsigned* st) {
    XcdBarrier b; b.bar = bar; b.x = xb_xcc_id(); b.st = st; b.w0 = (__builtin_amdgcn_readfirstlane((int)threadIdx.x >> 6) == 0);
    if (threadIdx.x == 0) (void)xb_add(&bar[XB_XCNT(b.x)], 1u);
    return b;
}
__device__ __forceinline__ void xcd_barrier_complete(unsigned* bar, unsigned x, unsigned& nloc, unsigned& nx) {
    const unsigned G = gridDim.x * gridDim.y * gridDim.z;
    unsigned sum, cnt, mine, sp = 0u;
    for (;;) {
        sum = 0u; cnt = 0u; mine = 0u;
#pragma unroll
        for (unsigned j = 0; j < 16; ++j) { const unsigned c = xb_ld(&bar[XB_XCNT(j)]); sum += c; cnt += (c > 0u) ? 1u : 0u; mine = (j == x) ? c : mine; }
        if (sum == G) break;
        __builtin_amdgcn_s_sleep(1);
        if ((++sp & 255u) == 0u) { if (xb_ld(&bar[XB_TMO])) break; if (sp > XB_SPIN_CAP) { atomicAdd(&bar[XB_TMO], 1u); break; } }
    }
    nloc = mine > 0u ? mine : 1u; nx = cnt > 0u ? cnt : 1u;
}

__device__ __forceinline__ void xcd_barrier(const XcdBarrier& b) {
    asm volatile("s_waitcnt vmcnt(0)" ::: "memory");
    __syncthreads();
    if (b.w0 && __builtin_amdgcn_mbcnt_hi(~0u, __builtin_amdgcn_mbcnt_lo(~0u, 0u)) == 0u) {
        unsigned* bar = b.bar;
        __builtin_amdgcn_s_waitcnt(0);
        unsigned nloc = b.st[0], nx = b.st[1];
        if (nloc == 0u) { xcd_barrier_complete(bar, b.x, nloc, nx); b.st[0] = nloc; b.st[1] = nx; }
        const unsigned old = xb_add(&bar[XB_XSUB(b.x)], 1u);
        const unsigned gen = old / nloc;
        if (old + 1u == (gen + 1u) * nloc) {
            __builtin_amdgcn_fence(__ATOMIC_RELEASE, "agent");
            asm volatile("s_waitcnt vmcnt(0)" ::: "memory");
            const unsigned og = xb_add(&bar[XB_TOP], 1u);
            const unsigned tg = og / nx;
            if (og + 1u == (tg + 1u) * nx) xb_add(&bar[XB_TOPGEN], 1u);
            else XB_SPIN(xb_ld(&bar[XB_TOPGEN]) == tg, bar);
            __builtin_amdgcn_fence(__ATOMIC_ACQUIRE, "agent");
            xb_add(&bar[XB_XGEN(b.x)], 1u);
            asm volatile("s_waitcnt vmcnt(0)" ::: "memory");
        } else {
            XB_SPIN(xb_ld(&bar[XB_XGEN(b.x)]) == gen, bar);
            __builtin_amdgcn_fence(__ATOMIC_ACQUIRE, "agent");
            asm volatile("s_waitcnt vmcnt(0)" ::: "memory");
        }
    }
    __syncthreads();
}
#include <hip/hip_bf16.h>
#include <cmath>
namespace attn_body {
using bf16=__hip_bfloat16;
using bf16x8=__attribute__((ext_vector_type(8)))short;
using s16x4=__attribute__((ext_vector_type(4)))short;
using f32x16=__attribute__((ext_vector_type(16)))float;
using u32x4=__attribute__((ext_vector_type(4)))unsigned;
constexpr int NHEAD=6,SEQ=2048,D=64,QP=3072,OP=1024;
constexpr int NW=8,QBLK=32,QB=QBLK*NW,KVBLK=64,NQB=SEQ/QB;
constexpr int ATTN_UNIT_ROWS=QB;
__device__ __forceinline__ int crow(int r,int hi){return (r&3)+8*(r>>2)+4*hi;}
#define SBAR() __builtin_amdgcn_sched_barrier(0)
__device__ __forceinline__ void cmask(f32x16&p0,f32x16&p1,int jb,int qrel,int hi){
  const float NEG=-INFINITY; int kb=64*jb+4*hi;
  #pragma unroll
  for(int r=0;r<16;++r){int kv=kb+(r&3)+8*(r>>2); if(kv>qrel)p0[r]=NEG; if(kv+32>qrel)p1[r]=NEG;}
}

constexpr int NSLOT=3, SLOTB=8192;
constexpr int LDS_K=0, LDS_V=NSLOT*SLOTB, LDS_WS=2*NSLOT*SLOTB, LDS_OST=LDS_WS+NW*64*4, LDS_BYTES=LDS_OST+NW*4096;
constexpr float C2=0.125f*1.4426950408889634f;
__device__ __forceinline__ void glds16(const void*gsrc,unsigned lds_dst){unsigned keep;
  asm volatile("s_mov_b32 %0, m0\n\ts_mov_b32 m0, %2\n\ts_nop 0\n\tglobal_load_lds_dwordx4 %1, off\n\ts_mov_b32 m0, %0":"=&s"(keep):"v"(gsrc),"s"(lds_dst):"memory");}
__device__ __forceinline__ float max3f(float a,float b,float c){float r;asm("v_max3_f32 %0, %1, %2, %3":"=v"(r):"v"(a),"v"(b),"v"(c));return r;}
__device__ __forceinline__ float max2f(float a,float b){float r;asm("v_max_f32_e32 %0, %1, %2":"=v"(r):"v"(a),"v"(b));return r;}
__device__ __forceinline__ float fadd_s(float a,float b){float r;asm("v_add_f32_e32 %0, %1, %2":"=v"(r):"v"(a),"v"(b));return r;}
__device__ __forceinline__ float fsub_s(float a,float b){float r;asm("v_sub_f32_e32 %0, %1, %2":"=v"(r):"v"(a),"v"(b));return r;}
typedef float f32x2_t __attribute__((ext_vector_type(2))); typedef __bf16 bf16x2_t __attribute__((ext_vector_type(2)));
__device__ __forceinline__ unsigned cvtpk_s(float lo,float hi){f32x2_t v={lo,hi};bf16x2_t b=__builtin_convertvector(v,bf16x2_t);return __builtin_bit_cast(unsigned,b);}
#define WAIT_BAR(N) asm volatile("s_waitcnt vmcnt(" #N ") lgkmcnt(0)\n\ts_barrier":::"memory")

__device__ __forceinline__ void qkt(f32x16&p0,f32x16&p1,const char*Kslot,const bf16x8*qr,int r32,int hi){ const f32x16 negm=f32x16{};
  const char*kb=Kslot+hi*1024+r32*16;
  #pragma unroll
  for(int d0=0;d0<4;++d0){
    const bf16x8 b0=*reinterpret_cast<const bf16x8*>(kb+d0*2048);
    const bf16x8 b1=*reinterpret_cast<const bf16x8*>(kb+d0*2048+512);
    if(d0==0){p0=__builtin_amdgcn_mfma_f32_32x32x16_bf16(b0,qr[0],negm,0,0,0);p1=__builtin_amdgcn_mfma_f32_32x32x16_bf16(b1,qr[0],negm,0,0,0);}
    else{p0=__builtin_amdgcn_mfma_f32_32x32x16_bf16(b0,qr[d0],p0,0,0,0);p1=__builtin_amdgcn_mfma_f32_32x32x16_bf16(b1,qr[d0],p1,0,0,0);}}
}
typedef __attribute__((address_space(3))) const char* lds_cptr;
typedef short v4i16_t __attribute__((ext_vector_type(4)));
__device__ __forceinline__ void kload8(bf16x8*kf,lds_cptr kp){
  kf[0]=*(const __attribute__((address_space(3))) bf16x8*)(kp);      kf[1]=*(const __attribute__((address_space(3))) bf16x8*)(kp+512);
  kf[2]=*(const __attribute__((address_space(3))) bf16x8*)(kp+2048); kf[3]=*(const __attribute__((address_space(3))) bf16x8*)(kp+2560);
  kf[4]=*(const __attribute__((address_space(3))) bf16x8*)(kp+4096); kf[5]=*(const __attribute__((address_space(3))) bf16x8*)(kp+4608);
  kf[6]=*(const __attribute__((address_space(3))) bf16x8*)(kp+6144); kf[7]=*(const __attribute__((address_space(3))) bf16x8*)(kp+6656);
}
__device__ __forceinline__ void kload2(bf16x8*kf,lds_cptr kp,int j){ kf[2*j]=*(const __attribute__((address_space(3))) bf16x8*)(kp+j*2048); kf[2*j+1]=*(const __attribute__((address_space(3))) bf16x8*)(kp+j*2048+512); }
__device__ __forceinline__ s16x4 vtr(lds_cptr p){ return __builtin_bit_cast(s16x4,__builtin_amdgcn_ds_read_tr16_b64_v4i16((__attribute__((address_space(3))) v4i16_t*)p)); }
__device__ __forceinline__ float rowmax(const f32x16&p0,const f32x16&p1){
  float a=max3f(p0[0],p0[1],p1[0]),b=max3f(p0[2],p0[3],p1[1]);a=max3f(a,p1[2],p1[3]);
  #pragma unroll
  for(int r=4;r<16;r+=4){a=max3f(a,p0[r],p0[r+1]);b=max3f(b,p0[r+2],p0[r+3]);a=max3f(a,p1[r],p1[r+1]);b=max3f(b,p1[r+2],p1[r+3]);}
  const float m=max2f(a,b);
  auto rr=__builtin_amdgcn_permlane32_swap(__float_as_uint(m),__float_as_uint(m),false,false);
  return max2f(__uint_as_float(rr[0]),__uint_as_float(rr[1]));
}
__device__ __forceinline__ void pv(f32x16*o,int vb,bf16x8 pa0,bf16x8 pa1,bf16x8 pa2,bf16x8 pa3){
  #pragma unroll
  for(int d0=0;d0<2;++d0){s16x4 lo[4],hi[4];
    #pragma unroll
    for(int ks=0;ks<4;++ks){
      asm volatile("ds_read_b64_tr_b16 %0,%1 offset:%c2":"=&v"(lo[ks]):"v"(vb),"i"(d0*4096+ks*1024):"memory");
      asm volatile("ds_read_b64_tr_b16 %0,%1 offset:%c2":"=&v"(hi[ks]):"v"(vb),"i"(d0*4096+ks*1024+512):"memory");}
    asm volatile("s_waitcnt lgkmcnt(0)":::"memory");SBAR();
    #define PK(k) (bf16x8){lo[k][0],lo[k][1],lo[k][2],lo[k][3],hi[k][0],hi[k][1],hi[k][2],hi[k][3]}
    o[d0]=__builtin_amdgcn_mfma_f32_32x32x16_bf16(pa0,PK(0),o[d0],0,0,0);
    o[d0]=__builtin_amdgcn_mfma_f32_32x32x16_bf16(pa1,PK(1),o[d0],0,0,0);
    o[d0]=__builtin_amdgcn_mfma_f32_32x32x16_bf16(pa2,PK(2),o[d0],0,0,0);
    o[d0]=__builtin_amdgcn_mfma_f32_32x32x16_bf16(pa3,PK(3),o[d0],0,0,0);
    #undef PK
  }
}

#ifndef ATTN_STORE16
#define ATTN_STORE16(p,v) (*(u32x4*)(p)=(v))
#endif
template<int THRL> __device__ __forceinline__ void attn_unit(int b,int h,int qb,const bf16*Q,const bf16*__restrict__ K,const bf16*__restrict__ V,bf16*O,const float*__restrict__ KM,int KMH,char*shm,const int tid){
  const int lane=tid&63,r32=lane&31,hi=lane>>5; const int wid=__builtin_amdgcn_readfirstlane(tid>>6);
  const long rowbase=(long)b*SEQ; const int q0=qb*QB;
  const bf16*Qw=Q+(rowbase+q0+wid*QBLK)*QP+h*D;
  const bf16*Kh=K+rowbase*QP+h*D,*Vh=V+rowbase*QP+h*D;
  const unsigned lds0=(unsigned)(uintptr_t)shm;
  float*wsf=(float*)(shm+LDS_WS)+wid*64;
  const bf16*ksrc=Kh+(long)lane*QP+wid*8;
  const bf16*vsrc=Vh+(long)(16*(wid&3)+(lane>>2))*QP+(wid>>2)*32+(lane&3)*8;
  const unsigned kdst=lds0+LDS_K+wid*1024, vdst=lds0+LDS_V+wid*1024;
  #define TI(t) (((t)<4)?(NT-4+(t)):((t)-4))
  #define DMA_K(t,slot) glds16(ksrc+(long)TI(t)*KVBLK*QP,(unsigned)__builtin_amdgcn_readfirstlane(kdst+(slot)))
  #define DMA_V(t,slot) glds16(vsrc+(long)TI(t)*KVBLK*QP,(unsigned)__builtin_amdgcn_readfirstlane(vdst+(slot)))
  const char*Kbase=shm+LDS_K; bf16x8 kf[8];
  const lds_cptr shm3=(lds_cptr)shm; const lds_cptr kp0=shm3+LDS_K+hi*1024+r32*16; const lds_cptr vp0=shm3+LDS_V+((lane>>4)&1)*32+(lane&3)*8+(4*hi+((lane&15)>>2))*64;
  const int NT=(q0+QB)/KVBLK;
  DMA_K(0,0);DMA_V(0,0);DMA_K(1,SLOTB);
  bf16x8 qr[4];
  #pragma unroll
  for(int d0=0;d0<4;++d0)qr[d0]=*reinterpret_cast<const bf16x8*>(&Qw[(long)r32*QP+d0*16+hi*8]);

  unsigned sel=0u;
  if(qb>0){ float gt_[8];
    #pragma unroll
    for(int n=0;n<8;++n){ float a_=0.f;
      if(n<qb){ const float*km=KM+((long)(b*NHEAD+h)*8+n)*64+hi*8;
        #pragma unroll
        for(int d0=0;d0<4;++d0){ float4 k0=*reinterpret_cast<const float4*>(km+d0*16), k1=*reinterpret_cast<const float4*>(km+d0*16+4);
          { const float4 k2=*reinterpret_cast<const float4*>(km+KMH+d0*16), k3=*reinterpret_cast<const float4*>(km+KMH+d0*16+4); k0.x+=k2.x;k0.y+=k2.y;k0.z+=k2.z;k0.w+=k2.w;k1.x+=k3.x;k1.y+=k3.y;k1.z+=k3.z;k1.w+=k3.w; }
          const bf16x8 qv=qr[d0];
          a_+=__uint_as_float(((unsigned)(unsigned short)qv[0])<<16)*k0.x+__uint_as_float(((unsigned)(unsigned short)qv[1])<<16)*k0.y+__uint_as_float(((unsigned)(unsigned short)qv[2])<<16)*k0.z+__uint_as_float(((unsigned)(unsigned short)qv[3])<<16)*k0.w
             +__uint_as_float(((unsigned)(unsigned short)qv[4])<<16)*k1.x+__uint_as_float(((unsigned)(unsigned short)qv[5])<<16)*k1.y+__uint_as_float(((unsigned)(unsigned short)qv[6])<<16)*k1.z+__uint_as_float(((unsigned)(unsigned short)qv[7])<<16)*k1.w; }
        a_+=__shfl_xor(a_,32); }
      gt_[n]=(n<qb)?a_:-1e30f; }
    #pragma unroll
    for(int r_=0;r_<3;++r_){ float bv=-3.0e38f; int best=-1;
      #pragma unroll
      for(int n=0;n<8;++n) if(!((sel>>n)&1u)&&gt_[n]>bv){bv=gt_[n];best=n;}
      if(best>=0&&bv>-0.5e30f) sel|=1u<<best; } }
  if(hi==0)wsf[32+r32]=__uint_as_float(sel); asm volatile("s_waitcnt lgkmcnt(0)":::"memory");
  float mhat=0.f,l_reg=0.f;f32x16 o[2];o[0]=f32x16{};o[1]=f32x16{};
  const int qrel=wid*QBLK+r32;
  #define CMASK(P0,P1,t) do{ if((t)<4){cmask(P0,P1,(t),qrel,hi);} else if(!((__float_as_uint(wsf[32+r32])>>(((t)-4)>>2))&1u)){ _Pragma("unroll") for(int r_=0;r_<16;++r_){P0[r_]=-INFINITY;P1[r_]=-INFINITY;} } }while(0)
  bool resc=false;
  #define START(P0,P1) do{ const float rm=rowmax(P0,P1); resc=false; \
    { const float dl=rm; mhat=fadd_s(mhat,dl); \
      _Pragma("unroll") for(int r=0;r<16;++r){P0[r]=fsub_s(P0[r],dl);P1[r]=fsub_s(P1[r],dl);} \
      } \
    _Pragma("unroll") for(int r=0;r<16;++r)P0[r]=__builtin_amdgcn_exp2f(P0[r]); }while(0)
  #define RESC() do{ if(resc){ asm volatile("s_waitcnt lgkmcnt(0)":::"memory"); \
      _Pragma("unroll") for(int d_=0;d_<2;++d_) _Pragma("unroll") for(int r=0;r<16;++r)o[d_][r]*=wsf[crow(r,hi)]; } }while(0)
  f32x16 pA0,pA1,pB0,pB1;
  int sl_prev=0,sl_cur=0,sl_next=SLOTB;
  #define ROT() do{sl_prev=sl_cur;sl_cur=sl_next;sl_next=(sl_next==(NSLOT-1)*SLOTB)?0:sl_next+SLOTB;}while(0)
  DMA_K(2,2*SLOTB);
  WAIT_BAR(3);
  qkt(pA0,pA1,Kbase,qr,r32,hi);asm volatile("s_nop 15\n\ts_nop 7":"+v"(pA0),"+v"(pA1));CMASK(pA0,pA1,0);
  START(pA0,pA1);
  _Pragma("unroll") for(int r=0;r<16;++r)pA1[r]=__builtin_amdgcn_exp2f(pA1[r]);
  WAIT_BAR(0);
  DMA_K(3,0);DMA_V(1,SLOTB);
  ROT();
  kload8(kf,kp0+sl_cur);
  WAIT_BAR(2);
  s16x4 vlo[8],vhi[8]; u32x4 pw0,pw1,pw2,pw3;
  #define PKW(P,B) cvtpk_s(P[B],P[B+1])
  #define PAF(k) __builtin_bit_cast(bf16x8,pw##k)
  #define VFR(i) (bf16x8){vlo[i][0],vlo[i][1],vlo[i][2],vlo[i][3],vhi[i][0],vhi[i][1],vhi[i][2],vhi[i][3]}
  #define PIN(x) asm volatile("":"+v"(x))
  #define MX3(a,b,c) __builtin_fmaxf(__builtin_fmaxf((a),(b)),(c))
  #define GAPA(MF,A0,A1,A2,A3,W0,W1,PW) do{ MF; sacc+=A0; sacc+=A1; sacc+=A2; sacc+=A3; PIN(sacc); W0; W1; PIN(PW); SBAR(); }while(0)
  #define EX(v) __builtin_amdgcn_exp2f(v)
  #define GAPB(MF,X,B) do{ MF; X[B]=EX(X[B]); X[B+1]=EX(X[B+1]); X[B+2]=EX(X[B+2]); X[B+3]=EX(X[B+3]); PIN(X); SBAR(); }while(0)
  #define VRD(i) do{ vlo[i]=vtr(vp_+(((i)>>2)*4096+((i)&3)*1024)); vhi[i]=vtr(vp_+(((i)>>2)*4096+((i)&3)*1024+512)); }while(0)
  #define KRD(G,j) do{ if(G){ kload2(kf,kp0+sl_next,j); SBAR(); } }while(0)
  #define STEP(C0,C1,P0,P1,t,GK,GV,GL) do{ SBAR(); \
    const lds_cptr vp_=vp0+sl_prev; \
    VRD(0); SBAR(); float sacc=(P0[0]+P0[1]); \
    GAPA(C0=__builtin_amdgcn_mfma_f32_32x32x16_bf16(kf[0],qr[0],f32x16{},0,0,0), P0[2],P0[3],P0[4],P0[5],     pw0[0]=PKW(P0,0), pw0[1]=PKW(P0,2), pw0); \
    VRD(4); SBAR(); GAPA(C1=__builtin_amdgcn_mfma_f32_32x32x16_bf16(kf[1],qr[0],f32x16{},0,0,0), P0[6],P0[7],P0[8],P0[9],     pw0[2]=PKW(P0,4), pw0[3]=PKW(P0,6), pw0); \
    VRD(1); SBAR(); GAPA(C0=__builtin_amdgcn_mfma_f32_32x32x16_bf16(kf[2],qr[1],C0,0,0,0),   P0[10],P0[11],P0[12],P0[13], pw1[0]=PKW(P0,8), pw1[1]=PKW(P0,10), pw1); \
    VRD(5); SBAR(); GAPA(C1=__builtin_amdgcn_mfma_f32_32x32x16_bf16(kf[3],qr[1],C1,0,0,0),   P0[14],P0[15],P1[0],P1[1],   pw1[2]=PKW(P0,12),pw1[3]=PKW(P0,14), pw1); \
    VRD(2); SBAR(); GAPA(C0=__builtin_amdgcn_mfma_f32_32x32x16_bf16(kf[4],qr[2],C0,0,0,0),   P1[2],P1[3],P1[4],P1[5],     pw2[0]=PKW(P1,0), pw2[1]=PKW(P1,2), pw2); \
    VRD(6); SBAR(); GAPA(C1=__builtin_amdgcn_mfma_f32_32x32x16_bf16(kf[5],qr[2],C1,0,0,0),   P1[6],P1[7],P1[8],P1[9],     pw2[2]=PKW(P1,4), pw2[3]=PKW(P1,6), pw2); \
    VRD(3); SBAR(); GAPA(C0=__builtin_amdgcn_mfma_f32_32x32x16_bf16(kf[6],qr[3],C0,0,0,0),   P1[10],P1[11],P1[12],P1[13], pw3[0]=PKW(P1,8), pw3[1]=PKW(P1,10), pw3); \
    VRD(7); SBAR(); GAPA(C1=__builtin_amdgcn_mfma_f32_32x32x16_bf16(kf[7],qr[3],C1,0,0,0),   P1[14],P1[15],0.f,0.f,       pw3[2]=PKW(P1,12),pw3[3]=PKW(P1,14), pw3); \
    l_reg+=sacc; \
    if(GK){DMA_K((t)+3,sl_cur);} if(GV){DMA_V((t)+1,sl_next);} \
    CMASK(C0,C1,t); \
    _Pragma("unroll") for(int r=0;r<16;++r){C0[r]-=mhat;C1[r]-=mhat;} \
    { float a=MX3(C0[0],C0[1],C1[0]),b=MX3(C0[2],C0[3],C1[1]); a=MX3(a,C1[2],C1[3]); \
      _Pragma("unroll") for(int r=4;r<16;r+=4){a=MX3(a,C0[r],C0[r+1]);b=MX3(b,C0[r+2],C0[r+3]);a=MX3(a,C1[r],C1[r+1]);b=MX3(b,C1[r+2],C1[r+3]);} \
      float rm=__builtin_fmaxf(a,b); { auto rr=__builtin_amdgcn_permlane32_swap(__float_as_uint(rm),__float_as_uint(rm),false,false); rm=__builtin_fmaxf(__uint_as_float(rr[0]),__uint_as_float(rr[1])); } \
      resc=false; \
      if(__builtin_expect(__any(rm>(float)THRL),0)){ const float dl=__builtin_fmaxf(rm,0.f); mhat+=dl; \
        _Pragma("unroll") for(int r=0;r<16;++r){C0[r]-=dl;C1[r]-=dl;} \
        const float f=__builtin_amdgcn_exp2f(-dl); l_reg*=f; if(hi==0)wsf[r32]=f; resc=true; } } \
    SBAR(); \
    GAPB(o[0]=__builtin_amdgcn_mfma_f32_32x32x16_bf16(PAF(0),VFR(0),o[0],0,0,0), C0,0); \
    GAPB(o[1]=__builtin_amdgcn_mfma_f32_32x32x16_bf16(PAF(0),VFR(4),o[1],0,0,0), C0,4); \
    KRD(GL,0); GAPB(o[0]=__builtin_amdgcn_mfma_f32_32x32x16_bf16(PAF(1),VFR(1),o[0],0,0,0), C0,8); \
    KRD(GL,1); GAPB(o[1]=__builtin_amdgcn_mfma_f32_32x32x16_bf16(PAF(1),VFR(5),o[1],0,0,0), C0,12); \
    KRD(GL,2); GAPB(o[0]=__builtin_amdgcn_mfma_f32_32x32x16_bf16(PAF(2),VFR(2),o[0],0,0,0), C1,0); \
    KRD(GL,3); GAPB(o[1]=__builtin_amdgcn_mfma_f32_32x32x16_bf16(PAF(2),VFR(6),o[1],0,0,0), C1,4); \
    GAPB(o[0]=__builtin_amdgcn_mfma_f32_32x32x16_bf16(PAF(3),VFR(3),o[0],0,0,0), C1,8); \
    GAPB(o[1]=__builtin_amdgcn_mfma_f32_32x32x16_bf16(PAF(3),VFR(7),o[1],0,0,0), C1,12); \
    }while(0)
  int t=1;
  for(;t+5<NT;t+=2){
    STEP(pB0,pB1,pA0,pA1,t,true,true,true);     WAIT_BAR(2); RESC(); ROT();
    STEP(pA0,pA1,pB0,pB1,t+1,true,true,true);   WAIT_BAR(2); RESC(); ROT();
  }
  #define ENDW(tt) do{ if((tt)+3<NT){WAIT_BAR(2);} else if((tt)+2<NT){WAIT_BAR(1);} else {WAIT_BAR(0);} }while(0)
  for(;t+1<NT;t+=2){
    STEP(pB0,pB1,pA0,pA1,t,(t+3<NT),(t+1<NT),(t+1<NT));       ENDW(t);   RESC(); ROT();
    STEP(pA0,pA1,pB0,pB1,t+1,(t+4<NT),(t+2<NT),(t+2<NT));     ENDW(t+1); RESC(); ROT();
  }
  STEP(pB0,pB1,pA0,pA1,NT-1,false,false,false); RESC();
  { float sacc=pB0[0]+pB0[1]; _Pragma("unroll") for(int r=2;r<16;++r)sacc+=pB0[r]; _Pragma("unroll") for(int r=0;r<16;++r)sacc+=pB1[r]; l_reg+=sacc;
    pw0=(u32x4){PKW(pB0,0),PKW(pB0,2),PKW(pB0,4),PKW(pB0,6)};pw1=(u32x4){PKW(pB0,8),PKW(pB0,10),PKW(pB0,12),PKW(pB0,14)};pw2=(u32x4){PKW(pB1,0),PKW(pB1,2),PKW(pB1,4),PKW(pB1,6)};pw3=(u32x4){PKW(pB1,8),PKW(pB1,10),PKW(pB1,12),PKW(pB1,14)};
    SBAR(); pv(o,(int)(unsigned)(size_t)vp0+sl_cur,PAF(0),PAF(1),PAF(2),PAF(3)); }
  #undef PKW
  #undef PAF
  #undef VFR
  #undef PIN
  #undef MX3
  #undef GAPA
  #undef GAPB
  #undef EX
  #undef VRD
  #undef KRD
  #undef STEP
  #undef ENDW
  {auto rr=__builtin_amdgcn_permlane32_swap(__float_as_uint(l_reg),__float_as_uint(l_reg),false,false);l_reg=__uint_as_float(rr[0])+__uint_as_float(rr[1]);}
  if(hi==0)wsf[32+r32]=l_reg;asm volatile("s_waitcnt lgkmcnt(0)":::"memory");
  float rli[16];
  #pragma unroll
  for(int r=0;r<16;++r)rli[r]=__builtin_amdgcn_rcpf(wsf[32+crow(r,hi)]);
  bf16*Ow=O+(rowbase+q0+wid*QBLK)*OP+h*D;
  { bf16*stg=(bf16*)(shm+LDS_OST)+wid*2048;
    #pragma unroll
    for(int r=0;r<16;++r){const int orow=crow(r,hi);
      #pragma unroll
      for(int d0=0;d0<2;++d0)stg[orow*64+d0*32+r32]=__float2bfloat16(o[d0][r]*rli[r]);}
    asm volatile("s_waitcnt lgkmcnt(0)":::"memory");
    #pragma unroll
    for(int i=0;i<4;++i){const int row=i*8+(lane>>3),ch=lane&7; const u32x4 v=*(const u32x4*)(stg+row*64+ch*8); ATTN_STORE16(Ow+(long)row*OP+ch*8,v);} }
  asm volatile("s_waitcnt lgkmcnt(0)\n\ts_barrier":::"memory");
  #undef DMA_K
  #undef DMA_V
  #undef TI
  #undef CMASK
  #undef START
  #undef RESC
  #undef ROT
}
constexpr int ATTN_LDS_BYTES=LDS_BYTES;
#undef SBAR
#undef WAIT_BAR
}
#undef LAS
constexpr int NB = DEBUG_BUILD ? 2 : 8;
constexpr int M_ = NB * SEQ;
constexpr int NSLOT = 2 * M_ + N_EXP * 256;
constexpr int PLD = 3072;
constexpr int FQ = 0, FK = 384, FV = 768, FZ = 1152, FGU = 1536, FGV = 1792, FXBC = 2048, FDT = 2944;
constexpr int NGU = 2 * D_FF, NGUE = 2 * D_FFE;

constexpr size_t al256(size_t x) { return (x + 255) & ~(size_t)255; }
constexpr size_t MiB = 1u << 20;
constexpr size_t O_CTL = 0, CTL_BYTES = 1 * MiB;
constexpr size_t O_RT = 1 * MiB;
constexpr size_t O_TE = O_RT + (size_t)M_ * 64, O_TP = O_TE + (size_t)M_ * 8, O_TS = O_TP + (size_t)M_ * 8, O_GS = O_TS + (size_t)M_ * 8;
constexpr size_t O_SP = O_GS + (size_t)M_ * 8;
constexpr size_t O_KM = O_SP + al256((size_t)NSLOT * 4);
constexpr size_t O_DT = O_KM + (size_t)2 * NB * ATT_H * NBLK * 64 * 4;
constexpr size_t O_WSB = al256(O_DT + (size_t)M_ * 24);
constexpr size_t O_HB = (O_WSB + (size_t)2 * GM_G * GM_CHUNK * GM_CHUNK * 2 + MiB - 1) / MiB * MiB;
constexpr size_t O_MWGU = O_HB + (size_t)M_ * DM * 2;
constexpr size_t O_WIN = O_MWGU + (size_t)N_EXP * NGUE * DM * 2;
constexpr size_t O_WOUT = O_WIN + (size_t)2 * PLD * DM * 2;
constexpr size_t O_WGU = O_WOUT + (size_t)2 * DM * DM * 2;
constexpr size_t O_WD = O_WGU + (size_t)NGU * DM * 2;
constexpr size_t O_SCR = O_WD + (size_t)DM * D_FF * 2;
constexpr size_t O_PROJ = O_SCR;
constexpr size_t O_XC = O_PROJ + (size_t)M_ * PLD * 2;
constexpr size_t O_MIXU = O_XC + (size_t)M_ * SSD_CW * 2;
constexpr size_t O_MIXB = O_MIXU + (size_t)M_ * DM * 4;
constexpr size_t O_VN = O_MIXB + (size_t)M_ * DM * 2;
constexpr size_t O_MIXEND = O_VN + (size_t)M_ * GM_W * 4;
constexpr size_t O_Y = O_SCR;
constexpr size_t O_ACT = O_Y + (size_t)M_ * DM * 4;
constexpr size_t O_XG = O_WIN;
constexpr size_t O_ACTM = O_XG + (size_t)NSLOT * DM * 2;
constexpr size_t O_MOEEND = O_ACTM + (size_t)NSLOT * D_FFE * 2;
constexpr size_t WS_END = O_MOEEND > O_MIXEND ? O_MOEEND : O_MIXEND;
static_assert(O_ACT + (size_t)M_ * D_FF * 2 <= O_MIXEND + (size_t)M_ * 4096, "act");
static_assert((size_t)NB * 16 * SSD_H * 8192 * 4 <= (size_t)M_ * SSD_CW * 2, "SSD states fit in the XC slot");
static_assert((size_t)NB * 32 * 768 * 4 <= (size_t)M_ * GM_W * 4, "dt/acum hand-off fits in the VN slot");
static_assert(WS_END <= 487000000ull, "workspace map exceeds the guaranteed size");
static_assert((size_t)N_EXP * DM * D_FFE * 2 <= (size_t)NBATCH * SEQ * DM * 4, "MWD fits in d_out");
constexpr int CW_BAR = 4096, CW_CNT = 1024, CW_Q = 1040, CW_ERR = 2048;

constexpr int RING_BYTES = 131072, MISC_OFF = RING_BYTES + 320, LDS_BYTES = 147456;

#define GAS __attribute__((address_space(1)))
#define LAS __attribute__((address_space(3)))
typedef GAS unsigned gu32;
#define RLX_AGENT __ATOMIC_RELAXED, __HIP_MEMORY_SCOPE_AGENT
#define LDS_WAIT() asm volatile("s_waitcnt lgkmcnt(0)" ::: "memory")

constexpr float QSCALE = 0.125f * 1.4426950408889634f;
constexpr int TAIL_SLOTS = 16 * 256;
namespace fp {
using pg8::Unit; using pg8::BM; using pg8::HALF; typedef pg8::f32x4 f32x4; typedef pg8::u32x4 u32x4;
__device__ __forceinline__ unsigned pk2(float lo, float hi) { return pg8::cvt_pk_bf16(lo, hi); }
__device__ __forceinline__ float gelu_fast(float x) { const float u = 0.7978845608028654f * (x + 0.044715f * x * x * x); return x / (1.f + __expf(-2.f * u)); }

struct EpiProj {
    static constexpr bool PERM = true, AFTER_DRAIN = false;
    bf16* O; const float* RT; float* KM2;
    __device__ __forceinline__ void operator()(const f32x4 (&acc)[2][2][4][2], const Unit& u, int wr, int wc, int fr, int fq) const {
        const int row0 = u.pm * BM + wr * 64 + fr, col0 = u.pn * BM + wc * 32 + 8 * fq;
        f32x4 ks[2][2];
#pragma unroll
        for (int i = 0; i < 2; ++i) { ks[i][0] = (f32x4){0.f, 0.f, 0.f, 0.f}; ks[i][1] = ks[i][0]; }
        const int mode = (u.pn < 3) ? 1 : ((u.pn == 6 || u.pn == 7) ? 2 : 0);
        const bool rl = ((wc & 1) == 0) && (fq < 2);
        const int i0 = (fq & 1) * 4;
#pragma unroll
        for (int ai = 0; ai < 2; ++ai)
#pragma unroll
            for (int m = 0; m < 4; ++m) { const int row = row0 + ai * HALF + m * 16;
                float4 c4 = make_float4(1.f, 1.f, 1.f, 1.f), s4 = make_float4(0.f, 0.f, 0.f, 0.f);
                if (mode == 1 && rl) { c4 = *(const float4*)(RT + (size_t)row * 16 + i0); s4 = *(const float4*)(RT + (size_t)row * 16 + 8 + i0); }
#pragma unroll
                for (int bj = 0; bj < 2; ++bj) { f32x4 v0 = acc[ai][bj][m][0], v1 = acc[ai][bj][m][1];
                    if (mode == 1) { const f32x4 a = v0, b = v1;
                        v0[0] = a[0] * c4.x - a[1] * s4.x; v0[1] = a[1] * c4.x + a[0] * s4.x; v0[2] = a[2] * c4.y - a[3] * s4.y; v0[3] = a[3] * c4.y + a[2] * s4.y;
                        v1[0] = b[0] * c4.z - b[1] * s4.z; v1[1] = b[1] * c4.z + b[0] * s4.z; v1[2] = b[2] * c4.w - b[3] * s4.w; v1[3] = b[3] * c4.w + b[2] * s4.w; }
                    if (u.pn == 0 || (u.pn == 1 && bj == 0)) { v0 = v0 * QSCALE; v1 = v1 * QSCALE; }
                    else if (mode == 1) { ks[bj][0] += v0; ks[bj][1] += v1; }
                    if (mode == 2) {
#pragma unroll
                        for (int j = 0; j < 4; ++j) { v0[j] = gelu_fast(v0[j]); v1[j] = gelu_fast(v1[j]); } }
                    u32x4 w; w.x = pk2(v0[0], v0[1]); w.y = pk2(v0[2], v0[3]); w.z = pk2(v1[0], v1[1]); w.w = pk2(v1[2], v1[3]);
                    *(u32x4*)(O + (size_t)row * PLD + col0 + bj * HALF) = w; } }
        if (u.pn == 1 || u.pn == 2) {
#pragma unroll
            for (int bj = 0; bj < 2; ++bj) { if (u.pn == 1 && bj == 0) continue;
#pragma unroll
                for (int n = 0; n < 2; ++n)
#pragma unroll
                    for (int j = 0; j < 4; ++j) { float x = ks[bj][n][j]; x += __shfl_xor(x, 1); x += __shfl_xor(x, 2); x += __shfl_xor(x, 4); x += __shfl_xor(x, 8); ks[bj][n][j] = x * (1.f / 256.f); }
                if (fr == 0) { const int kc = col0 + bj * HALF - FK; const int b = u.pm >> 3, nb = u.pm & 7;
                    float* dst = KM2 + (size_t)wr * (NB * ATT_H * NBLK * 64) + ((size_t)(b * ATT_H + (kc >> 6)) * NBLK + nb) * 64 + (kc & 63);
                    *(f32x4*)dst = ks[bj][0]; *(f32x4*)(dst + 4) = ks[bj][1]; } }
        }
    }
};
struct EpiAct {
    static constexpr bool PERM = true, AFTER_DRAIN = false;
    bf16* O; int ldc, ncol;
    __device__ __forceinline__ void operator()(const f32x4 (&acc)[2][2][4][2], const Unit& u, int wr, int wc, int fr, int fq) const {
        const int row0 = u.pm * BM + wr * 64 + fr, col0 = (u.pn % ncol) * HALF + wc * 32 + 8 * fq;
#pragma unroll
        for (int ai = 0; ai < 2; ++ai)
#pragma unroll
            for (int m = 0; m < 4; ++m) { const int row = row0 + ai * HALF + m * 16;
                const f32x4 g0 = acc[ai][0][m][0], g1 = acc[ai][0][m][1], u0 = acc[ai][1][m][0], u1 = acc[ai][1][m][1]; f32x4 a0, a1;
#pragma unroll
                for (int j = 0; j < 4; ++j) { a0[j] = g0[j] / (1.f + __expf(-g0[j])) * u0[j]; a1[j] = g1[j] / (1.f + __expf(-g1[j])) * u1[j]; }
                u32x4 w; w.x = pk2(a0[0], a0[1]); w.y = pk2(a0[2], a0[3]); w.z = pk2(a1[0], a1[1]); w.w = pk2(a1[2], a1[3]);
                *(u32x4*)(O + (size_t)row * ldc + col0) = w; }
    }
};
struct EpiF32 {
    static constexpr bool PERM = false, AFTER_DRAIN = false;
    float* O; int ldc;
    __device__ __forceinline__ void operator()(const f32x4 (&acc)[2][2][4][2], const Unit& u, int wr, int wc, int fr, int fq) const {
        const int row0 = u.pm * BM + wr * 64 + fr, col0 = u.pn * BM + wc * 32 + 4 * fq;
#pragma unroll
        for (int ai = 0; ai < 2; ++ai)
#pragma unroll
            for (int m = 0; m < 4; ++m) { float* rp = O + (size_t)(row0 + ai * HALF + m * 16) * ldc + col0;
#pragma unroll
                for (int bj = 0; bj < 2; ++bj)
#pragma unroll
                    for (int n = 0; n < 2; ++n) *(f32x4*)(rp + bj * HALF + n * 16) = acc[ai][bj][m][n]; }
    }
};
struct EpiY {
    static constexpr bool PERM = true, AFTER_DRAIN = false;
    bf16* O; int ldc;
    __device__ __forceinline__ void operator()(const f32x4 (&acc)[2][2][4][2], const Unit& u, int wr, int wc, int fr, int fq) const {
        const int row0 = u.pm * BM + wr * 64 + fr, col0 = u.pn * BM + wc * 32 + 8 * fq;
#pragma unroll
        for (int ai = 0; ai < 2; ++ai)
#pragma unroll
            for (int m = 0; m < 4; ++m) { bf16* rp = O + (size_t)(row0 + ai * HALF + m * 16) * ldc + col0;
#pragma unroll
                for (int bj = 0; bj < 2; ++bj) { const f32x4 v0 = acc[ai][bj][m][0], v1 = acc[ai][bj][m][1];
                    u32x4 w; w.x = pk2(v0[0], v0[1]); w.y = pk2(v0[2], v0[3]); w.z = pk2(v1[0], v1[1]); w.w = pk2(v1[2], v1[3]);
                    *(u32x4*)(rp + bj * HALF) = w; } }
    }
};
struct EpiF2 {
    static constexpr bool PERM = true, AFTER_DRAIN = false;
    bf16* O; const float* SP; bf16* FP; int slot0, klen;
    __device__ __forceinline__ void operator()(const f32x4 (&acc)[2][2][4][2], const Unit& u, int wr, int wc, int fr, int fq) const {
        const int row0 = u.pm * BM + wr * 64 + fr, col0 = (u.pn & 3) * BM + wc * 32 + 8 * fq;
        bf16* base = O; int rsub = 0;
        if (u.kofs > 0) { const int part = u.kofs / klen; base = FP + (size_t)(part - 1) * TAIL_SLOTS * DM; rsub = slot0; }
#pragma unroll
        for (int ai = 0; ai < 2; ++ai)
#pragma unroll
            for (int m = 0; m < 4; ++m) { const int row = row0 + ai * HALF + m * 16; const float sc = SP[row];
#pragma unroll
                for (int bj = 0; bj < 2; ++bj) { const f32x4 v0 = acc[ai][bj][m][0] * sc, v1 = acc[ai][bj][m][1] * sc;
                    u32x4 w; w.x = pk2(v0[0], v0[1]); w.y = pk2(v0[2], v0[3]); w.z = pk2(v1[0], v1[1]); w.w = pk2(v1[2], v1[3]);
                    *(u32x4*)(base + (size_t)(row - rsub) * DM + col0 + bj * HALF) = w; } }
    }
};
struct MoeOrder {
    int p0, p1, p2, p3, p4, p5, p6, T, ncol, G, c, nfull, ksplit, klen;
    __device__ __forceinline__ void init(const int* CNT, int ncol_, int G_, int c_) {
        int t = 0; t += (CNT[0] + 255) >> 8; p0 = t; t += (CNT[1] + 255) >> 8; p1 = t; t += (CNT[2] + 255) >> 8; p2 = t; t += (CNT[3] + 255) >> 8; p3 = t;
        t += (CNT[4] + 255) >> 8; p4 = t; t += (CNT[5] + 255) >> 8; p5 = t; t += (CNT[6] + 255) >> 8; p6 = t; t += (CNT[7] + 255) >> 8; T = t; ncol = ncol_; G = G_; c = c_;
        nfull = T * ncol; ksplit = 1; klen = 0;
    }
    __device__ __forceinline__ int tail_start() const { const int tot = T * ncol, nf = (tot / G) * G; return (tot - nf <= 64) ? nf : tot; }
    __device__ __forceinline__ bool next(int i, Unit& u) const {
        long L = (long)i * G + c; int part = 0;
        if (ksplit == 1) { if (L >= nfull) return false; }
        else { if (L >= (long)(T * ncol - nfull) * ksplit) return false; part = (int)(L % ksplit); L = nfull + L / ksplit; }
        const int tm = (int)(L / ncol), j = (int)(L % ncol);
        const int e = (tm >= p0) + (tm >= p1) + (tm >= p2) + (tm >= p3) + (tm >= p4) + (tm >= p5) + (tm >= p6);
        u.pm = tm; u.pn = e * ncol + j; u.kofs = part * klen; return true;
    }
    __device__ __forceinline__ void a_ready(const Unit&) const {}
    __device__ __forceinline__ void done(const Unit&) const {}
};

struct SrcCol { const float* p; int ld; };
__device__ __forceinline__ int win_src_col(int d) {
    if (d < 768) { const int hd = d & 63; const int sd = hd < 16 ? ((hd & 1) ? 8 + (hd >> 1) : (hd >> 1)) : hd; return d - hd + sd; }
    if (d < 1536) return d;
    if (d < 1792) return 2438 + (d - 1536);
    if (d < 2048) return 2694 + (d - 1792);
    if (d < 2944) return 1536 + (d - 2048);
    if (d < 2950) return 2432 + (d - 2944);
    return -1;
}
__device__ __forceinline__ SrcCol gu_src(const float* wg, const float* wu, int nff, int r) {
    const int tile = r >> 8, rr = r & 255, j = tile * 128 + (rr & 127); SrcCol s; s.p = (rr < 128 ? wg : wu) + j; s.ld = nff; return s;
}
__device__ __forceinline__ void conv_item(SrcCol sc, int K, bf16* WT, long d0, int k0, LAS float* scr, int lane) {
    float tv[32];
#pragma unroll
    for (int i = 0; i < 32; ++i) { const int kk = 2 * i + (lane >> 5); tv[i] = sc.p ? sc.p[(size_t)(k0 + kk) * sc.ld] : 0.f; }
#pragma unroll
    for (int i = 0; i < 32; ++i) { const int kk = 2 * i + (lane >> 5); scr[kk * 33 + (lane & 31)] = tv[i]; }
    LDS_WAIT(); asm volatile("" ::: "memory");
    const int c = lane & 7;
#pragma unroll
    for (int j = 0; j < 4; ++j) { const int n = (lane >> 3) + 8 * j; const LAS float* s = scr + (8 * c) * 33 + n;
        u32x4 o; o.x = pk2(s[0 * 33], s[1 * 33]); o.y = pk2(s[2 * 33], s[3 * 33]); o.z = pk2(s[4 * 33], s[5 * 33]); o.w = pk2(s[6 * 33], s[7 * 33]);
        *(u32x4*)(WT + (size_t)(d0 + n) * K + k0 + 8 * c) = o; }
    LDS_WAIT(); asm volatile("" ::: "memory");
}
}


typedef short bf16x8_t __attribute__((ext_vector_type(8)));
typedef float f32x4_t __attribute__((ext_vector_type(4)));
constexpr int TLD = 272;
__device__ __forceinline__ bf16x8_t lds_frag(const LAS unsigned char* base, int row, int kbyte) { return *(const LAS bf16x8_t*)(base + row * TLD + kbyte); }
__device__ __forceinline__ float red16(float v) { v += __shfl_xor(v, 1); v += __shfl_xor(v, 2); v += __shfl_xor(v, 4); v += __shfl_xor(v, 8); return v; }

__device__ __forceinline__ void gm_unit(int b, int c, const bf16* PROJ, const bf16* WSB  , const float* ln_g, const float* ln_b, const float* b_s, const float* norm_g,
                                        bf16* MIXB, LAS unsigned char* lds, int wave, int lane) {
    const long r0 = (long)b * SEQ + c * GM_CHUNK;
    LAS unsigned char* VNT = lds;
    for (int i = 0; i < 16; ++i) { const int t = wave * 16 + i;
        const float4 v = ld4(PROJ + (r0 + t) * PLD + FGV + lane * 4);
        const float mean = wave_sum((v.x + v.y) + (v.z + v.w)) * (1.f / 256.f);
        const float d0 = v.x - mean, d1 = v.y - mean, d2 = v.z - mean, d3 = v.w - mean;
        const float rstd = rsqrtf(wave_sum((d0 * d0 + d1 * d1) + (d2 * d2 + d3 * d3)) * (1.f / 256.f) + 1e-5f);
        const float4 gg = *(const float4*)(ln_g + lane * 4), bb = *(const float4*)(ln_b + lane * 4);
        LAS bf16* dst = (LAS bf16*)(VNT + (lane * 4) * TLD) + t;
        dst[0] = (bf16)f2bf(d0 * rstd * gg.x + bb.x); dst[TLD / 2] = (bf16)f2bf(d1 * rstd * gg.y + bb.y); dst[TLD] = (bf16)f2bf(d2 * rstd * gg.z + bb.z); dst[3 * TLD / 2] = (bf16)f2bf(d3 * rstd * gg.w + bb.w); }
    __syncthreads();
    f32x4_t acc[16];
#pragma unroll
    for (int i = 0; i < 16; ++i) acc[i] = (f32x4_t){0.f, 0.f, 0.f, 0.f};
    const int fr = lane & 15, fq = lane >> 4;
    const int nks = (wave * 16 + 15) / 32 + 1;
    for (int ks = 0; ks < nks; ++ks) {
#pragma unroll
        for (int g = 0; g < 4; ++g) {
            const bf16x8_t af = *(const bf16x8_t*)(WSB + ((size_t)g * GM_CHUNK + wave * 16 + fr) * GM_CHUNK + ks * 32 + fq * 8);
#pragma unroll
            for (int n = 0; n < 4; ++n) { const bf16x8_t bfv = lds_frag(VNT, g * 64 + n * 16 + fr, ks * 64 + fq * 16);
                acc[g * 4 + n] = __builtin_amdgcn_mfma_f32_16x16x32_bf16(af, bfv, acc[g * 4 + n], 0, 0, 0); }
        }
    }
    __syncthreads();
    LAS bf16* ost = (LAS bf16*)(lds + wave * (16 * 264 * 2));
    float ss[4] = {0.f, 0.f, 0.f, 0.f};
#pragma unroll
    for (int nt = 0; nt < 16; ++nt) { const int col = nt * 16 + fr, g = nt >> 2;
#pragma unroll
        for (int r = 0; r < 4; ++r) { const int t = wave * 16 + fq * 4 + r;
            const float u = ldf(PROJ + (r0 + t) * PLD + FGU + col);
            const float o = u * (acc[nt][r] + b_s[g * GM_CHUNK + t]); acc[nt][r] = o; ss[r] += o * o; } }
#pragma unroll
    for (int r = 0; r < 4; ++r) ss[r] = rsqrtf(red16(ss[r]) * (1.f / 256.f) + 1e-5f);
#pragma unroll
    for (int nt = 0; nt < 16; ++nt) { const int col = nt * 16 + fr; const float gn = norm_g[col];
#pragma unroll
        for (int r = 0; r < 4; ++r) { ost[(fq * 4 + r) * 264 + col] = (bf16)f2bf(acc[nt][r] * ss[r] * gn); } }
    LDS_WAIT(); asm volatile("" ::: "memory");
#pragma unroll
    for (int i = 0; i < 8; ++i) { const int rr = i * 2 + (lane >> 5), ch = lane & 31;
        const fp::u32x4 v = *(const LAS fp::u32x4*)(ost + rr * 264 + ch * 8);
        *(fp::u32x4*)(MIXB + (r0 + wave * 16 + rr) * DM + ATT_W + SSD_W + ch * 8) = v; }
    __syncthreads();
}

typedef short v4i16_t __attribute__((ext_vector_type(4)));
typedef unsigned u32x2_t __attribute__((ext_vector_type(2)));
__device__ __forceinline__ v4i16_t lds_tr(const LAS unsigned char* p) { return __builtin_amdgcn_ds_read_tr16_b64_v4i16((LAS v4i16_t*)p); }
__device__ __forceinline__ bf16x8_t lds_frag_tr(const LAS unsigned char* tile, int pitch, int k0, int c0, int lane) {
    const int kg = lane >> 4, q = (lane & 15) >> 2, p = lane & 3;
    const LAS unsigned char* a = tile + (k0 + 8 * kg + q) * pitch + (c0 + 4 * p) * 2;
    const v4i16_t lo = lds_tr(a), hi = lds_tr(a + 4 * pitch);
    return (bf16x8_t){lo[0], lo[1], lo[2], lo[3], hi[0], hi[1], hi[2], hi[3]};
}
__device__ __forceinline__ bf16x8_t lds_frag_p(const LAS unsigned char* base, int pitch, int row, int kbyte) { return *(const LAS bf16x8_t*)(base + row * pitch + kbyte); }
template <int NCH, bool SCALE, bool TOLDS> __device__ __forceinline__ void conv_rows(const bf16* PROJ, long r0, int t0, int colbase, int ch0, const float* cw, const float* cb, LAS unsigned char* tile, int pitch,
                                                                                       const LAS float* scl, bf16* XCg  , int tid) {
    constexpr int CPR = NCH / 8, RG = 512 / CPR, RPT = (128 + RG - 1) / RG;
    if (tid < CPR * RG) { const int ch = (tid % CPR) * 8, l0 = (tid / CPR) * RPT;
        float w[4][8], bs[8];
        { const float4 c0 = *(const float4*)(cb + ch0 + ch), c1 = *(const float4*)(cb + ch0 + ch + 4); bs[0] = c0.x; bs[1] = c0.y; bs[2] = c0.z; bs[3] = c0.w; bs[4] = c1.x; bs[5] = c1.y; bs[6] = c1.z; bs[7] = c1.w; }
#pragma unroll
        for (int i = 0; i < 4; ++i) { const float4 w0 = *(const float4*)(cw + i * SSD_CW + ch0 + ch), w1 = *(const float4*)(cw + i * SSD_CW + ch0 + ch + 4);
            w[i][0] = w0.x; w[i][1] = w0.y; w[i][2] = w0.z; w[i][3] = w0.w; w[i][4] = w1.x; w[i][5] = w1.y; w[i][6] = w1.z; w[i][7] = w1.w; }
        fp::u32x4 xr[RPT + 3];
#pragma unroll
        for (int j = 0; j < RPT + 3; ++j) { const int l = l0 - 3 + j; xr[j] = (fp::u32x4){0u, 0u, 0u, 0u};
            if (l < 128 && t0 + l >= 0) xr[j] = *(const fp::u32x4*)(PROJ + (r0 + l) * PLD + colbase + ch); }
#pragma unroll
        for (int j = 0; j < RPT; ++j) { const int l = l0 + j; if (l < 128) {
            float a[8];
#pragma unroll
            for (int e = 0; e < 8; ++e) a[e] = bs[e];
#pragma unroll
            for (int i = 0; i < 4; ++i) { const fp::u32x4 xv = xr[j + i];
#pragma unroll
                for (int e = 0; e < 4; ++e) { a[2 * e] += w[i][2 * e] * __uint_as_float(xv[e] << 16); a[2 * e + 1] += w[i][2 * e + 1] * __uint_as_float(xv[e] & 0xffff0000u); } }
#pragma unroll
            for (int e = 0; e < 8; ++e) a[e] = a[e] / (1.f + __expf(-a[e]));
            fp::u32x4 o; o.x = fp::pk2(a[0], a[1]); o.y = fp::pk2(a[2], a[3]); o.z = fp::pk2(a[4], a[5]); o.w = fp::pk2(a[6], a[7]);
            *(fp::u32x4*)(XCg + (r0 + l) * SSD_CW + ch) = o;
            if (TOLDS) { if (SCALE) { const float sc = scl[(ch >> 6) * 128 + l]; o.x = fp::pk2(a[0] * sc, a[1] * sc); o.y = fp::pk2(a[2] * sc, a[3] * sc); o.z = fp::pk2(a[4] * sc, a[5] * sc); o.w = fp::pk2(a[6] * sc, a[7] * sc); }
                *(LAS fp::u32x4*)(tile + l * pitch + ch * 2) = o; } } }
    }
}
template <int NCH> __device__ __forceinline__ void load_xc_tile(const bf16* XCg, long r0, LAS unsigned char* tile, int pitch, int tid) {
    constexpr int CPR = NCH / 8;
    for (int it = tid; it < 128 * CPR; it += 512) { const int l = it / CPR, ch = (it % CPR) * 8;
        *(LAS fp::u32x4*)(tile + l * pitch + ch * 2) = *(const fp::u32x4*)(XCg + (r0 + l) * SSD_CW + ch); }
}
__device__ __forceinline__ void ssd_dt_acum(const bf16* PROJ, long r0, int g, const float* dt_bias, const float* a_log, LAS float* dtS, LAS float* acS, int tid, int wave, int lane) {
    if (tid < 384) { const int hh = tid >> 7, l = tid & 127, h = 3 * g + hh;
        const float dtv = softplus_f(ldf(PROJ + (r0 + l) * PLD + FDT + h) + dt_bias[h]); dtS[tid] = dtv; acS[tid] = dtv * (-__expf(a_log[h])); }
    __syncthreads();
    if (wave < 3) { const float a0 = acS[wave * 128 + 2 * lane], a1 = acS[wave * 128 + 2 * lane + 1]; const float sm = a0 + a1; float v = sm;
#pragma unroll
        for (int o = 1; o < 64; o <<= 1) { const float t = __shfl_up(v, o); if (lane >= o) v += t; }
        const float ex = v - sm; acS[wave * 128 + 2 * lane] = ex + a0; acS[wave * 128 + 2 * lane + 1] = ex + sm; }
    __syncthreads();
}
constexpr int XP = 400;
__device__ __forceinline__ void ssdA_unit(int b, int c, int g, const bf16* PROJ, const float* cw, const float* cb, const float* dt_bias, const float* a_log, float* ST, float* CD, bf16* XC, float* DTG,
                                          LAS unsigned char* lds, int tid, int wave, int lane) {
    asm volatile("" : "+v"(tid), "+v"(lane));
    const long r0 = (long)b * SEQ + c * 128; const int t0 = c * 128;
    LAS unsigned char* XS = lds; LAS unsigned char* BS = lds + 51200;
    LAS float* dtS = (LAS float*)(lds + 86016); LAS float* acS = dtS + 384; LAS float* sclS = acS + 384;
    ssd_dt_acum(PROJ, r0, g, dt_bias, a_log, dtS, acS, tid, wave, lane);
    if (tid < 384) { const int hh = tid >> 7; const float al = acS[hh * 128 + 127]; sclS[tid] = dtS[tid] * __expf(al - acS[tid]);
        float* dg = DTG + (((long)b * 16 + c) * 2 + g) * 768; dg[tid] = dtS[tid]; dg[384 + tid] = acS[tid];
        if ((tid & 127) == 0) CD[((long)b * 16 + c) * SSD_H + 3 * g + hh] = __expf(al); }
    __syncthreads();
    conv_rows<192, true, true>(PROJ, r0, t0, FXBC + 192 * g, 192 * g, cw, cb, XS, XP, sclS, XC + 192 * g, tid);
    conv_rows<128, false, true>(PROJ, r0, t0, FXBC + SSD_W + 128 * g, SSD_W + 128 * g, cw, cb, BS, TLD, nullptr, XC + SSD_W + 128 * g, tid);
    conv_rows<128, false, false>(PROJ, r0, t0, FXBC + SSD_W + 256 + 128 * g, SSD_W + 256 + 128 * g, cw, cb, nullptr, 0, nullptr, XC + SSD_W + 256 + 128 * g, tid);
    __syncthreads();
    f32x4_t acc[12];
#pragma unroll
    for (int i = 0; i < 12; ++i) acc[i] = (f32x4_t){0.f, 0.f, 0.f, 0.f};
#pragma unroll 1
    for (int ks = 0; ks < 4; ++ks) { const bf16x8_t bfv = lds_frag_tr(BS, TLD, ks * 32, 16 * wave, lane);
#pragma unroll
        for (int mt = 0; mt < 12; ++mt) { const bf16x8_t af = lds_frag_tr(XS, XP, ks * 32, (mt >> 2) * 64 + (mt & 3) * 16, lane); acc[mt] = __builtin_amdgcn_mfma_f32_16x16x32_bf16(af, bfv, acc[mt], 0, 0, 0); } }
    const int fr = lane & 15, fq = lane >> 4;
    float* sp = ST + (((long)b * 16 + c) * SSD_H + 3 * g) * 8192 + 16 * wave + fr;
#pragma unroll
    for (int mt = 0; mt < 12; ++mt)
#pragma unroll
        for (int r = 0; r < 4; ++r) sp[(mt >> 2) * 8192 + ((mt & 3) * 16 + 4 * fq + r) * 128] = acc[mt][r];
    __syncthreads();
}
__device__ __forceinline__ void ssdB_unit(int b, int c, int g, const bf16* PROJ, const bf16* XC, const float* DTG, const float* dsk, const float* ng,
                                          const float* ST, const float* CD, bf16* MIXB, LAS unsigned char* lds, int tid, int wave, int lane) {
    const long r0 = (long)b * SEQ + c * 128;
    LAS unsigned char* CS = lds; LAS unsigned char* PX = lds + 34816; LAS unsigned char* BG = lds + 87040;
    LAS float* dtS = (LAS float*)(lds + 121856); LAS float* acS = dtS + 384;
    const int fr = lane & 15, fq = lane >> 4;
    if (tid < 384) { const float* dg = DTG + (((long)b * 16 + c) * 2 + g) * 768; dtS[tid] = dg[tid]; acS[tid] = dg[384 + tid]; }
    load_xc_tile<128>(XC + SSD_W + 256 + 128 * g, r0, CS, TLD, tid);
    if (c > 0) {
        float4 pv[12];
#pragma unroll
        for (int i = 0; i < 12; ++i) pv[i] = make_float4(0.f, 0.f, 0.f, 0.f);
        const float* sbase = ST + ((long)b * 16 * SSD_H + 3 * g) * 8192 + tid * 4; const float* cbase = CD + (long)b * 16 * SSD_H + 3 * g;
        int j = 0;
        for (; j + 2 < c; j += 3) { const float* s0 = sbase + (long)j * SSD_H * 8192; const float* c0 = cbase + j * SSD_H;
            float4 v0[12], v1[12], v2[12];
#pragma unroll
            for (int i = 0; i < 12; ++i) { v0[i] = *(const float4*)(s0 + i * 2048); v1[i] = *(const float4*)(s0 + SSD_H * 8192 + i * 2048); v2[i] = *(const float4*)(s0 + 2 * SSD_H * 8192 + i * 2048); }
            float dd[3][3];
#pragma unroll
            for (int q = 0; q < 3; ++q) { dd[q][0] = c0[q * SSD_H]; dd[q][1] = c0[q * SSD_H + 1]; dd[q][2] = c0[q * SSD_H + 2]; }
#pragma unroll
            for (int i = 0; i < 12; ++i) { const int hq = i >> 2;
                pv[i].x = ((pv[i].x * dd[0][hq] + v0[i].x) * dd[1][hq] + v1[i].x) * dd[2][hq] + v2[i].x;
                pv[i].y = ((pv[i].y * dd[0][hq] + v0[i].y) * dd[1][hq] + v1[i].y) * dd[2][hq] + v2[i].y;
                pv[i].z = ((pv[i].z * dd[0][hq] + v0[i].z) * dd[1][hq] + v1[i].z) * dd[2][hq] + v2[i].z;
                pv[i].w = ((pv[i].w * dd[0][hq] + v0[i].w) * dd[1][hq] + v1[i].w) * dd[2][hq] + v2[i].w; } }
        for (; j < c; ++j) { const float* s0 = sbase + (long)j * SSD_H * 8192; const float* c0 = cbase + j * SSD_H; const float d0 = c0[0], d1 = c0[1], d2 = c0[2];
#pragma unroll
            for (int i = 0; i < 12; ++i) { const float4 sv = *(const float4*)(s0 + i * 2048); const float d = (i < 4) ? d0 : ((i < 8) ? d1 : d2);
                pv[i].x = pv[i].x * d + sv.x; pv[i].y = pv[i].y * d + sv.y; pv[i].z = pv[i].z * d + sv.z; pv[i].w = pv[i].w * d + sv.w; } }
#pragma unroll
        for (int i = 0; i < 12; ++i) { const int row = (i >> 2) * 64 + (i & 3) * 16 + (tid >> 5), n = (tid & 31) * 4;
            u32x2_t w; w.x = fp::pk2(pv[i].x, pv[i].y); w.y = fp::pk2(pv[i].z, pv[i].w); *(LAS u32x2_t*)(PX + row * TLD + n * 2) = w; }
    }
    __syncthreads();
    f32x4_t acc_y[12];
#pragma unroll
    for (int i = 0; i < 12; ++i) acc_y[i] = (f32x4_t){0.f, 0.f, 0.f, 0.f};
    if (c > 0) {
#pragma unroll 1
        for (int ks = 0; ks < 4; ++ks) { const bf16x8_t af = lds_frag_p(CS, TLD, 16 * wave + fr, ks * 64 + fq * 16);
#pragma unroll
            for (int t = 0; t < 12; ++t) { const bf16x8_t bfv = lds_frag_p(PX, TLD, (t >> 2) * 64 + (t & 3) * 16 + fr, ks * 64 + fq * 16); acc_y[t] = __builtin_amdgcn_mfma_f32_16x16x32_bf16(af, bfv, acc_y[t], 0, 0, 0); } }
#pragma unroll
        for (int t = 0; t < 12; ++t)
#pragma unroll
            for (int r = 0; r < 4; ++r) acc_y[t][r] *= __expf(acS[(t >> 2) * 128 + 16 * wave + 4 * fq + r]);
    }
    __syncthreads();
    load_xc_tile<192>(XC + 192 * g, r0, PX, XP, tid);
    load_xc_tile<128>(XC + SSD_W + 128 * g, r0, BG, TLD, tid);
    __syncthreads();
#if defined(SSDB_CUT) && SSDB_CUT == 2
    { float t_ = 0.f; for (int i = 0; i < 12; ++i) t_ += acc_y[i][0] + acc_y[i][1] + acc_y[i][2] + acc_y[i][3]; if (t_ == 123.f) MIXB[0] = 1; return; }
#endif
    f32x4_t acc_cb[8];
#pragma unroll
    for (int i = 0; i < 8; ++i) acc_cb[i] = (f32x4_t){0.f, 0.f, 0.f, 0.f};
#pragma unroll 1
    for (int ks = 0; ks < 4; ++ks) { const bf16x8_t af = lds_frag_p(CS, TLD, 16 * wave + fr, ks * 64 + fq * 16);
#pragma unroll
        for (int ns = 0; ns < 8; ++ns) if (ns <= wave) { const bf16x8_t bfv = lds_frag_p(BG, TLD, 16 * ns + fr, ks * 64 + fq * 16); acc_cb[ns] = __builtin_amdgcn_mfma_f32_16x16x32_bf16(af, bfv, acc_cb[ns], 0, 0, 0); } }
    __syncthreads();
    LAS unsigned char* GS = BG + wave * 16 * TLD;
    const int nks = (16 * wave + 15) / 32 + 1;
#pragma unroll
    for (int hh = 0; hh < 3; ++hh) {
#pragma unroll
        for (int ns = 0; ns < 8; ++ns) if (ns <= (wave | 1)) {
#pragma unroll
            for (int r = 0; r < 4; ++r) { const int l = 16 * wave + 4 * fq + r, sidx = 16 * ns + fr;
                const float gv = (ns <= wave && sidx <= l) ? acc_cb[ns][r] * __expf(acS[hh * 128 + l] - acS[hh * 128 + sidx]) * dtS[hh * 128 + sidx] : 0.f;
                *(LAS bf16*)(GS + (4 * fq + r) * TLD + sidx * 2) = (bf16)f2bf(gv); } }
        LDS_WAIT(); asm volatile("" ::: "memory");
#pragma unroll 1
        for (int ks = 0; ks < nks; ++ks) { const bf16x8_t af = lds_frag_p(GS, TLD, fr, ks * 64 + fq * 16);
#pragma unroll
            for (int np = 0; np < 4; ++np) { const bf16x8_t bfv = lds_frag_tr(PX, XP, ks * 32, hh * 64 + np * 16, lane); acc_y[hh * 4 + np] = __builtin_amdgcn_mfma_f32_16x16x32_bf16(af, bfv, acc_y[hh * 4 + np], 0, 0, 0); } }
        LDS_WAIT(); asm volatile("" ::: "memory");
    }
#if defined(SSDB_CUT) && SSDB_CUT == 1
    { float t_ = 0.f; for (int i = 0; i < 12; ++i) t_ += acc_y[i][0] + acc_y[i][1] + acc_y[i][2] + acc_y[i][3]; if (t_ == 123.f) MIXB[0] = 1; return; }
#endif
#pragma unroll
    for (int t = 0; t < 12; ++t) { const int hh = t >> 2, col = hh * 64 + (t & 3) * 16 + fr; const float dk = dsk[3 * g + hh];
#pragma unroll
        for (int r = 0; r < 4; ++r) { const int l = 16 * wave + 4 * fq + r; acc_y[t][r] += dk * __uint_as_float(((unsigned)*(const LAS bf16*)(PX + l * XP + col * 2)) << 16); } }
    __syncthreads();
    LAS bf16* ost = (LAS bf16*)(lds + wave * (16 * XP));
#pragma unroll
    for (int t = 0; t < 12; ++t) { const int col = (t >> 2) * 64 + (t & 3) * 16 + fr;
#pragma unroll
        for (int r = 0; r < 4; ++r) ost[(4 * fq + r) * (XP / 2) + col] = (bf16)f2bf(acc_y[t][r]); }
    LDS_WAIT(); asm volatile("" ::: "memory");
    { const int rr = lane >> 2, q = lane & 3; const long row = r0 + 16 * wave + rr;
      float yz[48]; float ssum = 0.f;
#pragma unroll
      for (int i = 0; i < 6; ++i) { const int c8 = (q * 6 + i) * 8;
          const fp::u32x4 yv = *(const LAS fp::u32x4*)(ost + rr * (XP / 2) + c8);
          const fp::u32x4 zv = *(const fp::u32x4*)(PROJ + row * PLD + FZ + 192 * g + c8);
#pragma unroll
          for (int j = 0; j < 4; ++j) { const unsigned yw = yv[j], zw = zv[j];
              const float y0 = __uint_as_float(yw << 16), y1 = __uint_as_float(yw & 0xffff0000u), z0 = __uint_as_float(zw << 16), z1 = __uint_as_float(zw & 0xffff0000u);
              const float a0 = y0 * (z0 / (1.f + __expf(-z0))), a1 = y1 * (z1 / (1.f + __expf(-z1))); yz[i * 8 + 2 * j] = a0; yz[i * 8 + 2 * j + 1] = a1; ssum += a0 * a0 + a1 * a1; } }
      ssum += __shfl_xor(ssum, 1); ssum += __shfl_xor(ssum, 2);
      const float rinv = rsqrtf(ssum * (1.f / 192.f) + 1e-5f);
#pragma unroll
      for (int i = 0; i < 6; ++i) { const int c8 = (q * 6 + i) * 8;
          const float4 g0 = *(const float4*)(ng + 192 * g + c8), g1 = *(const float4*)(ng + 192 * g + c8 + 4);
          fp::u32x4 o; o.x = fp::pk2(yz[i * 8] * rinv * g0.x, yz[i * 8 + 1] * rinv * g0.y); o.y = fp::pk2(yz[i * 8 + 2] * rinv * g0.z, yz[i * 8 + 3] * rinv * g0.w);
          o.z = fp::pk2(yz[i * 8 + 4] * rinv * g1.x, yz[i * 8 + 5] * rinv * g1.y); o.w = fp::pk2(yz[i * 8 + 6] * rinv * g1.z, yz[i * 8 + 7] * rinv * g1.w);
          *(fp::u32x4*)(MIXB + row * DM + ATT_W + 192 * g + c8) = o; } }
    __syncthreads();
}

__device__ __forceinline__ void att_norm_phase(bf16* MIXB, const float* g, long n_rows, int gw, int ngw, int lane) {
    for (long row = gw; row < n_rows; row += ngw) { bf16* p = MIXB + row * DM + lane * 8; float v[8]; float s2 = 0.f;
        if (lane < 48) { const fp::u32x4 w = *(const fp::u32x4*)p;
#pragma unroll
            for (int j = 0; j < 4; ++j) { v[2 * j] = __uint_as_float(w[j] << 16); v[2 * j + 1] = __uint_as_float(w[j] & 0xffff0000u); s2 += v[2 * j] * v[2 * j] + v[2 * j + 1] * v[2 * j + 1]; } }
        const float r = rsqrtf(wave_sum(s2) * (1.f / 384.f) + 1e-5f);
        if (lane < 48) { const float4 g0 = *(const float4*)(g + lane * 8), g1 = *(const float4*)(g + lane * 8 + 4);
            fp::u32x4 o; o.x = fp::pk2(v[0] * r * g0.x, v[1] * r * g0.y); o.y = fp::pk2(v[2] * r * g0.z, v[3] * r * g0.w); o.z = fp::pk2(v[4] * r * g1.x, v[5] * r * g1.y); o.w = fp::pk2(v[6] * r * g1.z, v[7] * r * g1.w);
            *(fp::u32x4*)p = o; } }
}

struct FArgs { const void* in[29]; float* out; unsigned char* ws; int ph_lo, ph_hi; };
__device__ __forceinline__ const void* ldarg(int k) { const void* p; asm volatile("s_load_dwordx2 %0, %1, %2\n\ts_waitcnt lgkmcnt(0)" : "=s"(p) : "s"(__builtin_amdgcn_kernarg_segment_ptr()), "i"(k * 8)); return p; }

constexpr int N_PHASES = 18;
__global__ void __launch_bounds__(512, 2) mega(FArgs a) {
    extern __shared__ __attribute__((aligned(16))) unsigned char lds_[];
    LAS unsigned char* lds = (LAS unsigned char*)lds_;
    const int wave = __builtin_amdgcn_readfirstlane((int)threadIdx.x >> 6);
#define lane ((int)__builtin_amdgcn_mbcnt_hi(~0u, __builtin_amdgcn_mbcnt_lo(~0u, 0u)))
#define tid (wave * 64 + lane)
    const int G = gridDim.x; const int bx = blockIdx.x;
#define vcu (((int)gridDim.x % 8 == 0) ? ((int)blockIdx.x % 8) * ((int)gridDim.x / 8) + (int)blockIdx.x / 8 : (int)blockIdx.x)
#define gw (vcu * 8 + wave)
#define ngw ((int)gridDim.x * 8)
#define gt ((long)gw * 64 + lane)
#define ngt ((long)ngw * 64)
    unsigned char* ws = a.ws;
    unsigned* ctl = (unsigned*)(ws + O_CTL);
    for (int u = (int)threadIdx.x; u < (LDS_BYTES - RING_BYTES) / 4; u += 512) ((LAS unsigned*)(lds + RING_BYTES))[u] = 0u;
    __syncthreads();
    const int lo = a.ph_lo, hi = a.ph_hi;
    XcdBarrier bar; bar.bar = ctl + CW_BAR; bar.x = 0; bar.st = nullptr; bar.w0 = 0;
    if (hi - lo > 1) bar = xcd_barrier_post(ctl + CW_BAR, (volatile LAS unsigned*)(lds + MISC_OFF) + 8);
#define in_x ((const float*)ldarg(0))
#define in_pos ((const int*)ldarg(1))
#define ln_in_g ((const float*)ldarg(2))
#define ln_in_b ((const float*)ldarg(3))
#define w_in ((const float*)ldarg(4))
#define conv_w ((const float*)ldarg(5))
#define conv_b ((const float*)ldarg(6))
#define dt_bias ((const float*)ldarg(7))
#define a_log ((const float*)ldarg(8))
#define d_skip ((const float*)ldarg(9))
#define ssd_norm_g ((const float*)ldarg(10))
#define att_norm_g ((const float*)ldarg(11))
#define gm_ln_g ((const float*)ldarg(12))
#define gm_ln_b ((const float*)ldarg(13))
#define gm_w_s ((const float*)ldarg(14))
#define gm_b_s ((const float*)ldarg(15))
#define gm_norm_g ((const float*)ldarg(16))
#define w_out ((const float*)ldarg(17))
#define ln1_g ((const float*)ldarg(18))
#define ln1_b ((const float*)ldarg(19))
#define ln2_g ((const float*)ldarg(20))
#define ln2_b ((const float*)ldarg(21))
#define ffn_w_gate ((const float*)ldarg(22))
#define ffn_w_up ((const float*)ldarg(23))
#define ffn_w_down ((const float*)ldarg(24))
#define router_w ((const float*)ldarg(25))
#define moe_w_gate ((const float*)ldarg(26))
#define moe_w_up ((const float*)ldarg(27))
#define moe_w_down ((const float*)ldarg(28))
#define H ((float*)WOUTP)
#define MWD ((bf16*)WOUTP)
#define RT ((float*)(WSP + O_RT))
#define TE ((int*)(WSP + O_TE))
#define TP ((float*)(WSP + O_TP))
#define TS ((int*)(WSP + O_TS))
#define GS ((int*)(WSP + O_GS))
#define SP ((float*)(WSP + O_SP))
#define KM ((float*)(WSP + O_KM))
#define WSB ((bf16*)(WSP + O_WSB))
#define HB ((bf16*)(WSP + O_HB))
#define MWGU ((bf16*)(WSP + O_MWGU))
#define WIN ((bf16*)(WSP + O_WIN))
#define WOUT ((bf16*)(WSP + O_WOUT))
#define WGU ((bf16*)(WSP + O_WGU))
#define WD ((bf16*)(WSP + O_WD))
#define PROJ ((bf16*)(WSP + O_PROJ))
#define ST ((float*)(WSP + O_XC))
#define CD ((float*)(WSP + O_DT))
#define XCB ((bf16*)(WSP + O_MIXU))
#define DTG ((float*)(WSP + O_VN))
#define MIXB ((bf16*)(WSP + O_MIXB))
#define YB ((bf16*)(WSP + O_Y))
#define ACT ((bf16*)(WSP + O_ACT))
#define XG ((bf16*)(WSP + O_XG))
#define F2 ((bf16*)(WSP + O_XG))
#define ACTM ((bf16*)(WSP + O_ACTM))
#define F2P ((bf16*)(WSP + O_MWGU))
#define CNT ((int*)(WSP + O_CTL + 4 * CW_CNT))
    const ProjL FL{PLD, FQ, FK, FV, FZ, FXBC, FDT, FGU, FGV};
    LAS float* scr = (LAS float*)(lds + wave * 16384);

#ifndef PH_MASK
#define PH_MASK 0xffffffffu
#endif
#ifndef PROBE_MASK
#define PROBE_MASK 0u
#endif
#ifndef PROBE_AMP
#define PROBE_AMP 0
#endif
    volatile unsigned* pr_w = (volatile unsigned*)(ctl + 1100);
#define pr_me ((PROBE_MASK != 0u) && blockIdx.x == 0 && wave == 0 && __builtin_amdgcn_mbcnt_hi(~0u, __builtin_amdgcn_mbcnt_lo(~0u, 0u)) == 0u)
#define PH_BEGIN(k) if (lo <= (k) && (k) < hi && ((PH_MASK >> (k)) & 1u)) { unsigned char* WSP = a.ws; unsigned char* WOUTP = (unsigned char*)a.out; asm volatile("" : "+s"(WSP), "+s"(WOUTP)); if (((PROBE_MASK >> (k)) & 1u) && pr_me) pr_w[0] = (unsigned)__builtin_amdgcn_s_memrealtime();
#define PH_END(k)   if ((k) + 1 < hi) xcd_barrier(bar); if (((PROBE_MASK >> (k)) & 1u) && pr_me) pr_w[1] += (unsigned)__builtin_amdgcn_s_memrealtime() - pr_w[0]; }

    PH_BEGIN(0)
    { const float* const p_w_in = w_in; const float* const p_w_out = w_out; const float* const p_fg = ffn_w_gate; const float* const p_fu = ffn_w_up; const float* const p_fd = ffn_w_down;
        constexpr int I_WIN = 16 * (PLD / 32), I_WOUT = 16 * (DM / 32), I_WGU = 16 * (NGU / 32), I_WD = (D_FF / 64) * (DM / 32), I_MWGU = 16 * (N_EXP * NGUE / 32);
        constexpr int NIT = 2 * I_WIN + 2 * I_WOUT + I_WGU + I_WD; (void)I_MWGU;
        for (int it = gw; it < NIT; it += ngw) {
            int r = it; const int l5 = lane & 31;
            if (r < 2 * I_WIN) { const int L = r / I_WIN; r -= L * I_WIN; const int kb = r / (PLD / 32), db = r % (PLD / 32); const int sc_ = fp::win_src_col(db * 32 + l5);
                fp::SrcCol s; s.p = sc_ >= 0 ? p_w_in + (size_t)L * DM * D_IN + sc_ : nullptr; s.ld = D_IN; fp::conv_item(s, DM, WIN + (size_t)L * PLD * DM, db * 32, kb * 64, scr, lane); continue; } r -= 2 * I_WIN;
            if (r < 2 * I_WOUT) { const int L = r / I_WOUT; r -= L * I_WOUT; const int kb = r / (DM / 32), db = r % (DM / 32);
                fp::SrcCol s; s.p = p_w_out + (size_t)L * DM * DM + db * 32 + l5; s.ld = DM; fp::conv_item(s, DM, WOUT + (size_t)L * DM * DM, db * 32, kb * 64, scr, lane); continue; } r -= 2 * I_WOUT;
            if (r < I_WGU) { const int kb = r / (NGU / 32), db = r % (NGU / 32);
                fp::conv_item(fp::gu_src(p_fg, p_fu, D_FF, db * 32 + l5), DM, WGU, db * 32, kb * 64, scr, lane); continue; } r -= I_WGU;
            { const int kb = r / (DM / 32), db = r % (DM / 32);
                fp::SrcCol s; s.p = p_fd + db * 32 + l5; s.ld = DM; fp::conv_item(s, D_FF, WD, db * 32, kb * 64, scr, lane); }
        }
        const int* const p_pos = in_pos; const float* const p_gws = gm_w_s; const float* const p_x = in_x; const float* const p_lg = ln_in_g; const float* const p_lb = ln_in_b;
        for (long it = gt; it < (long)M_ * 8; it += ngt) { const int i = (int)(it & 7); const long row = it >> 3;
            const float inv = powf(500000.0f, -(float)(2 * i) / 16.0f); const float ang = (float)p_pos[row] * inv; RT[row * 16 + i] = cosf(ang); RT[row * 16 + 8 + i] = sinf(ang); }
        for (long it = gt; it < 2L * GM_G * GM_CHUNK * GM_CHUNK; it += ngt) { const int sidx = (int)(it & 127), t = (int)((it >> 7) & 127); WSB[it] = (bf16)(sidx <= t ? f2bf(p_gws[it]) : 0u); }
        { float va[16], vb[16]; long r = gw; if (r < M_) ln_load<float>(va, p_x + r * DM, 1.f, nullptr, nullptr, lane);
          for (; r < M_; r += 2 * ngw) { const long r1 = r + ngw, r2 = r + 2 * ngw;
              if (r1 < M_) ln_load<float>(vb, p_x + r1 * DM, 1.f, nullptr, nullptr, lane);
              ln_finish(va, p_lg, p_lb, nullptr, HB + r * DM, lane);
              if (r2 < M_) ln_load<float>(va, p_x + r2 * DM, 1.f, nullptr, nullptr, lane);
              if (r1 < M_) ln_finish(vb, p_lg, p_lb, nullptr, HB + r1 * DM, lane); } }
    }
    PH_END(0)


    { constexpr int layer = 0; constexpr int PB = 1;
        PH_BEGIN(PB + 0)
        { pg8::Gemm g{HB, WIN + (size_t)layer * PLD * DM, M_, PLD, DM, DM}; pg8::StaticOrder S; S.init(M_, PLD, G, bx);
          fp::EpiProj E{PROJ, RT, KM}; pg8::gemm_phase<fp::EpiProj, pg8::StaticOrder, true, true>(lds, g, S, E, tid); }
        PH_END(PB + 0)
        PH_BEGIN(PB + 1)
        { constexpr int NATT = NB * ATT_H * NBLK, NSSDA = NB * 32;
          volatile LAS unsigned* qw = (volatile LAS unsigned*)(lds + MISC_OFF) + 16;
#define QNEXT(word) do { if (tid == 0) qw[0] = __hip_atomic_fetch_add(ctl + (word), 1u, __ATOMIC_RELAXED, __HIP_MEMORY_SCOPE_AGENT); __syncthreads(); idx = (int)qw[0]; __syncthreads(); } while (0)
          int idx;
          for (;;) { QNEXT(CW_Q + 8 * layer); if (idx >= NATT) break;
              const int qb = (NBLK - 1) - idx / (NB * ATT_H), bh = idx % (NB * ATT_H);
              attn_body::attn_unit<8>(bh / ATT_H, bh % ATT_H, qb, (const attn_body::bf16*)(PROJ + FQ), (const attn_body::bf16*)(PROJ + FK), (const attn_body::bf16*)(PROJ + FV), (attn_body::bf16*)MIXB, KM, NB * ATT_H * NBLK * 64, (char*)lds_, tid); }
          for (;;) { QNEXT(CW_Q + 8 * layer + 1); if (idx >= NSSDA) break;
              ssdA_unit(idx >> 5, (idx >> 1) & 15, idx & 1, PROJ, conv_w + (size_t)layer * 4 * SSD_CW, conv_b + layer * SSD_CW, dt_bias + layer * SSD_H, a_log + layer * SSD_H, ST, CD, XCB, DTG, lds, tid, wave, lane); }
        }
        PH_END(PB + 1)
        PH_BEGIN(PB + 2)
        { constexpr int NSSDB = NB * 32, NGMU = NB * (SEQ / GM_CHUNK);
          volatile LAS unsigned* qw = (volatile LAS unsigned*)(lds + MISC_OFF) + 16;
          int idx;
          for (;;) { QNEXT(CW_Q + 8 * layer + 2); if (idx >= NSSDB) break;
              const int c = 15 - idx / (NB * 2), bg = idx % (NB * 2);
              ssdB_unit(bg >> 1, c, bg & 1, PROJ, XCB, DTG, d_skip + layer * SSD_H, ssd_norm_g + layer * SSD_W, ST, CD, MIXB, lds, tid, wave, lane); }
          for (;;) { QNEXT(CW_Q + 8 * layer + 3); if (idx >= NGMU) break;
              gm_unit(idx / (SEQ / GM_CHUNK), idx % (SEQ / GM_CHUNK), PROJ, WSB + (size_t)layer * GM_G * GM_CHUNK * GM_CHUNK, gm_ln_g + layer * GM_W, gm_ln_b + layer * GM_W,
                      gm_b_s + layer * GM_G * GM_CHUNK, gm_norm_g + layer * GM_W, MIXB, lds, wave, lane); }
          att_norm_phase(MIXB, att_norm_g + layer * ATT_W, M_, gw, ngw, lane);
          { constexpr int I_MWGU_ = 16 * (N_EXP * NGUE / 32), HALF_T = I_MWGU_ / 16;
            const float* const p_mg = moe_w_gate; const float* const p_mu = moe_w_up;
            for (;;) { QNEXT(CW_Q + 8 * layer + 4); if (idx >= HALF_T) break;
                int lane_ = lane; asm volatile("" : "+v"(lane_));
                const int r = (layer * HALF_T + idx) * 8 + wave; const int kb = r / (N_EXP * NGUE / 32), db = r % (N_EXP * NGUE / 32); const int d = db * 32 + (lane_ & 31), e = d / NGUE;
                fp::conv_item(fp::gu_src(p_mg + (size_t)e * DM * D_FFE, p_mu + (size_t)e * DM * D_FFE, D_FFE, d - e * NGUE), DM, MWGU, (long)db * 32, kb * 64, scr, lane_); }
            constexpr int I_MWD_ = (D_FFE / 64) * (N_EXP * DM / 32), HALF_D = I_MWD_ / 16; const float* const p_md = moe_w_down;
            for (;;) { QNEXT(CW_Q + 8 * layer + 5); if (idx >= HALF_D) break;
                int lane_ = lane; asm volatile("" : "+v"(lane_));
                const int r = (layer * HALF_D + idx) * 8 + wave; const int kb = r / (N_EXP * DM / 32), db = r % (N_EXP * DM / 32); const int d = db * 32 + (lane_ & 31), e = d / DM;
                fp::SrcCol sc_; sc_.p = p_md + (size_t)e * D_FFE * DM + (d - e * DM); sc_.ld = DM; fp::conv_item(sc_, D_FFE, MWD, (long)db * 32, kb * 64, scr, lane_); } }
#undef QNEXT
        }
        PH_END(PB + 2)
        PH_BEGIN(PB + 3)
        { pg8::Gemm g{MIXB, WOUT + (size_t)layer * DM * DM, M_, DM, DM, DM}; pg8::StaticOrder S; S.init(M_, DM, G, bx);
          fp::EpiY E{YB, DM}; pg8::gemm_phase<fp::EpiY, pg8::StaticOrder, false, true>(lds, g, S, E, tid); }
        PH_END(PB + 3)
        PH_BEGIN(PB + 4)
        { const float* const p_g = ln1_g + layer * DM; const float* const p_b = ln1_b + layer * DM;
          { float va[16], vb[16]; long r = gw; if (r < M_) ln_load<bf16, bf16>(va, HB + r * DM, ALPHA, YB + r * DM, nullptr, lane);
            for (; r < M_; r += 2 * ngw) { const long r1 = r + ngw, r2 = r + 2 * ngw;
                if (r1 < M_) ln_load<bf16, bf16>(vb, HB + r1 * DM, ALPHA, YB + r1 * DM, nullptr, lane);
                ln_finish(va, p_g, p_b, nullptr, HB + r * DM, lane);
                if (r2 < M_) ln_load<bf16, bf16>(va, HB + r2 * DM, ALPHA, YB + r2 * DM, nullptr, lane);
                if (r1 < M_) ln_finish(vb, p_g, p_b, nullptr, HB + r1 * DM, lane); } }
          if (layer == 1) { asm volatile("s_waitcnt vmcnt(0)" ::: "memory"); moe_route_block(HB, router_w, CNT, TE, TP, TS, M_, gw, ngw, lane, wave, tid, (LAS int*)lds); } }
        PH_END(PB + 4)
        if constexpr (layer == 0) {
            PH_BEGIN(PB + 5)
            { pg8::Gemm g{HB, WGU, M_, NGU, DM, DM}; pg8::StaticOrder S; S.init(M_, NGU, G, bx);
              fp::EpiAct E{ACT, D_FF, NGU / 256}; pg8::gemm_phase<fp::EpiAct, pg8::StaticOrder, true, true>(lds, g, S, E, tid); }
            PH_END(PB + 5)
            PH_BEGIN(PB + 6)
            { pg8::Gemm g{ACT, WD, M_, DM, D_FF, D_FF}; pg8::StaticOrder S; S.init(M_, DM, G, bx);
              fp::EpiY E{YB, DM}; pg8::gemm_phase<fp::EpiY, pg8::StaticOrder, false, true>(lds, g, S, E, tid); }
            PH_END(PB + 6)
            PH_BEGIN(PB + 7)
            { const float* const p_g = ln2_g + layer * DM; const float* const p_b = ln2_b + layer * DM;
              { float va[16], vb[16]; long r = gw; if (r < M_) ln_load<bf16, bf16>(va, HB + r * DM, ALPHA, YB + r * DM, nullptr, lane);
            for (; r < M_; r += 2 * ngw) { const long r1 = r + ngw, r2 = r + 2 * ngw;
                if (r1 < M_) ln_load<bf16, bf16>(vb, HB + r1 * DM, ALPHA, YB + r1 * DM, nullptr, lane);
                ln_finish(va, p_g, p_b, nullptr, HB + r * DM, lane);
                if (r2 < M_) ln_load<bf16, bf16>(va, HB + r2 * DM, ALPHA, YB + r2 * DM, nullptr, lane);
                if (r1 < M_) ln_finish(vb, p_g, p_b, nullptr, HB + r1 * DM, lane); } } }
            PH_END(PB + 7)
        } else {
            PH_BEGIN(PB + 5)
            { for (long it = gw; it < (long)M_ * 2; it += ngw) { const int e = TE[it]; const int gs = moe_base(CNT, e) + TS[it];
                  if (lane == 0) { SP[gs] = TP[it]; GS[it] = gs; }
                  const uint4* src = (const uint4*)(HB + (it >> 1) * DM); uint4* dst = (uint4*)(XG + (size_t)gs * DM); dst[lane] = src[lane]; dst[lane + 64] = src[lane + 64]; }
              for (int it = gw; it < N_EXP * 256; it += ngw) { const int e = it >> 8, r = it & 255; const int c = CNT[e]; const int slot = moe_base(CNT, e) + c + r;
                  if (c + r < ((c + 255) & ~255)) { uint4* dst = (uint4*)(XG + (size_t)slot * DM); const uint4 z = make_uint4(0u, 0u, 0u, 0u); dst[lane] = z; dst[lane + 64] = z; if (lane == 0) SP[slot] = 0.f; } } }
            PH_END(PB + 5)
            PH_BEGIN(PB + 6)
            { pg8::Gemm g{XG, MWGU, NSLOT, N_EXP * NGUE, DM, DM}; fp::MoeOrder S; S.init(CNT, NGUE / 256, G, bx);
              fp::EpiAct E{ACTM, D_FFE, NGUE / 256}; pg8::gemm_phase<fp::EpiAct, fp::MoeOrder, true, true>(lds, g, S, E, tid); }
            PH_END(PB + 6)
            PH_BEGIN(PB + 7)
            { fp::MoeOrder S; S.init(CNT, DM / 256, G, bx); const int nf = S.tail_start(); const int slot0 = (nf / (DM / 256)) * 256;
              fp::EpiF2 E{F2, SP, F2P, slot0, D_FFE / 4};
              { pg8::Gemm g{ACTM, MWD, NSLOT, N_EXP * DM, D_FFE, D_FFE}; S.nfull = nf; S.ksplit = 1;
                pg8::gemm_phase<fp::EpiF2, fp::MoeOrder, true, true>(lds, g, S, E, tid); }
              { pg8::Gemm g{ACTM, MWD, NSLOT, N_EXP * DM, D_FFE / 4, D_FFE}; S.ksplit = 4; S.klen = D_FFE / 4;
                int tid2 = tid; asm volatile("" : "+v"(tid2));
                pg8::gemm_phase<fp::EpiF2, fp::MoeOrder, true, true>(lds, g, S, E, tid2); } }
            PH_END(PB + 7)
            PH_BEGIN(PB + 8)
            { const float* const p_g = ln2_g + layer * DM; const float* const p_b = ln2_b + layer * DM;
              int slot0; { fp::MoeOrder S; S.init(CNT, DM / 256, G, bx); const int nf = S.tail_start(); slot0 = (nf == S.T * (DM / 256)) ? 0x7fffffff : (nf / (DM / 256)) * 256; }
#define LN2_LOAD(v, rr) do { const int s0_ = GS[(rr) * 2], s1_ = GS[(rr) * 2 + 1]; ln_load<bf16, bf16>(v, HB + (rr) * DM, ALPHA, F2 + (size_t)s0_ * DM, F2 + (size_t)s1_ * DM, lane); \
                  if (s0_ >= slot0) { _Pragma("unroll") for (int p_ = 0; p_ < 3; ++p_) ln_add(v, F2P + ((size_t)p_ * TAIL_SLOTS + (s0_ - slot0)) * DM, lane); } \
                  if (s1_ >= slot0) { _Pragma("unroll") for (int p_ = 0; p_ < 3; ++p_) ln_add(v, F2P + ((size_t)p_ * TAIL_SLOTS + (s1_ - slot0)) * DM, lane); } } while (0)
              { float va[16], vb[16]; long r = gw; if (r < M_) LN2_LOAD(va, r);
                for (; r < M_; r += 2 * ngw) { const long r1 = r + ngw, r2 = r + 2 * ngw;
                    if (r1 < M_) LN2_LOAD(vb, r1);
                    ln_finish(va, p_g, p_b, H + r * DM, nullptr, lane);
                    if (r2 < M_) LN2_LOAD(va, r2);
                    if (r1 < M_) ln_finish(vb, p_g, p_b, H + r1 * DM, nullptr, lane); } }
#undef LN2_LOAD
            }
            PH_END(PB + 8)
        }
    }

    { constexpr int layer = 1; constexpr int PB = 9;
        PH_BEGIN(PB + 0)
        { pg8::Gemm g{HB, WIN + (size_t)layer * PLD * DM, M_, PLD, DM, DM}; pg8::StaticOrder S; S.init(M_, PLD, G, bx);
          fp::EpiProj E{PROJ, RT, KM}; pg8::gemm_phase<fp::EpiProj, pg8::StaticOrder, true, true>(lds, g, S, E, tid); }
        PH_END(PB + 0)
        PH_BEGIN(PB + 1)
        { constexpr int NATT = NB * ATT_H * NBLK, NSSDA = NB * 32;
          volatile LAS unsigned* qw = (volatile LAS unsigned*)(lds + MISC_OFF) + 16;
#define QNEXT(word) do { if (tid == 0) qw[0] = __hip_atomic_fetch_add(ctl + (word), 1u, __ATOMIC_RELAXED, __HIP_MEMORY_SCOPE_AGENT); __syncthreads(); idx = (int)qw[0]; __syncthreads(); } while (0)
          int idx;
          for (;;) { QNEXT(CW_Q + 8 * layer); if (idx >= NATT) break;
              const int qb = (NBLK - 1) - idx / (NB * ATT_H), bh = idx % (NB * ATT_H);
              attn_body::attn_unit<8>(bh / ATT_H, bh % ATT_H, qb, (const attn_body::bf16*)(PROJ + FQ), (const attn_body::bf16*)(PROJ + FK), (const attn_body::bf16*)(PROJ + FV), (attn_body::bf16*)MIXB, KM, NB * ATT_H * NBLK * 64, (char*)lds_, tid); }
          for (;;) { QNEXT(CW_Q + 8 * layer + 1); if (idx >= NSSDA) break;
              ssdA_unit(idx >> 5, (idx >> 1) & 15, idx & 1, PROJ, conv_w + (size_t)layer * 4 * SSD_CW, conv_b + layer * SSD_CW, dt_bias + layer * SSD_H, a_log + layer * SSD_H, ST, CD, XCB, DTG, lds, tid, wave, lane); }
        }
        PH_END(PB + 1)
        PH_BEGIN(PB + 2)
        { constexpr int NSSDB = NB * 32, NGMU = NB * (SEQ / GM_CHUNK);
          volatile LAS unsigned* qw = (volatile LAS unsigned*)(lds + MISC_OFF) + 16;
          int idx;
          for (;;) { QNEXT(CW_Q + 8 * layer + 2); if (idx >= NSSDB) break;
              const int c = 15 - idx / (NB * 2), bg = idx % (NB * 2);
              ssdB_unit(bg >> 1, c, bg & 1, PROJ, XCB, DTG, d_skip + layer * SSD_H, ssd_norm_g + layer * SSD_W, ST, CD, MIXB, lds, tid, wave, lane); }
          for (;;) { QNEXT(CW_Q + 8 * layer + 3); if (idx >= NGMU) break;
              gm_unit(idx / (SEQ / GM_CHUNK), idx % (SEQ / GM_CHUNK), PROJ, WSB + (size_t)layer * GM_G * GM_CHUNK * GM_CHUNK, gm_ln_g + layer * GM_W, gm_ln_b + layer * GM_W,
                      gm_b_s + layer * GM_G * GM_CHUNK, gm_norm_g + layer * GM_W, MIXB, lds, wave, lane); }
          att_norm_phase(MIXB, att_norm_g + layer * ATT_W, M_, gw, ngw, lane);
          { constexpr int I_MWGU_ = 16 * (N_EXP * NGUE / 32), HALF_T = I_MWGU_ / 16;
            const float* const p_mg = moe_w_gate; const float* const p_mu = moe_w_up;
            for (;;) { QNEXT(CW_Q + 8 * layer + 4); if (idx >= HALF_T) break;
                int lane_ = lane; asm volatile("" : "+v"(lane_));
                const int r = (layer * HALF_T + idx) * 8 + wave; const int kb = r / (N_EXP * NGUE / 32), db = r % (N_EXP * NGUE / 32); const int d = db * 32 + (lane_ & 31), e = d / NGUE;
                fp::conv_item(fp::gu_src(p_mg + (size_t)e * DM * D_FFE, p_mu + (size_t)e * DM * D_FFE, D_FFE, d - e * NGUE), DM, MWGU, (long)db * 32, kb * 64, scr, lane_); }
            constexpr int I_MWD_ = (D_FFE / 64) * (N_EXP * DM / 32), HALF_D = I_MWD_ / 16; const float* const p_md = moe_w_down;
            for (;;) { QNEXT(CW_Q + 8 * layer + 5); if (idx >= HALF_D) break;
                int lane_ = lane; asm volatile("" : "+v"(lane_));
                const int r = (layer * HALF_D + idx) * 8 + wave; const int kb = r / (N_EXP * DM / 32), db = r % (N_EXP * DM / 32); const int d = db * 32 + (lane_ & 31), e = d / DM;
                fp::SrcCol sc_; sc_.p = p_md + (size_t)e * D_FFE * DM + (d - e * DM); sc_.ld = DM; fp::conv_item(sc_, D_FFE, MWD, (long)db * 32, kb * 64, scr, lane_); } }
#undef QNEXT
        }
        PH_END(PB + 2)
        PH_BEGIN(PB + 3)
        { pg8::Gemm g{MIXB, WOUT + (size_t)layer * DM * DM, M_, DM, DM, DM}; pg8::StaticOrder S; S.init(M_, DM, G, bx);
          fp::EpiY E{YB, DM}; pg8::gemm_phase<fp::EpiY, pg8::StaticOrder, false, true>(lds, g, S, E, tid); }
        PH_END(PB + 3)
        PH_BEGIN(PB + 4)
        { const float* const p_g = ln1_g + layer * DM; const float* const p_b = ln1_b + layer * DM;
          { float va[16], vb[16]; long r = gw; if (r < M_) ln_load<bf16, bf16>(va, HB + r * DM, ALPHA, YB + r * DM, nullptr, lane);
            for (; r < M_; r += 2 * ngw) { const long r1 = r + ngw, r2 = r + 2 * ngw;
                if (r1 < M_) ln_load<bf16, bf16>(vb, HB + r1 * DM, ALPHA, YB + r1 * DM, nullptr, lane);
                ln_finish(va, p_g, p_b, nullptr, HB + r * DM, lane);
                if (r2 < M_) ln_load<bf16, bf16>(va, HB + r2 * DM, ALPHA, YB + r2 * DM, nullptr, lane);
                if (r1 < M_) ln_finish(vb, p_g, p_b, nullptr, HB + r1 * DM, lane); } }
          if (layer == 1) { asm volatile("s_waitcnt vmcnt(0)" ::: "memory"); moe_route_block(HB, router_w, CNT, TE, TP, TS, M_, gw, ngw, lane, wave, tid, (LAS int*)lds); } }
        PH_END(PB + 4)
        if constexpr (layer == 0) {
            PH_BEGIN(PB + 5)
            { pg8::Gemm g{HB, WGU, M_, NGU, DM, DM}; pg8::StaticOrder S; S.init(M_, NGU, G, bx);
              fp::EpiAct E{ACT, D_FF, NGU / 256}; pg8::gemm_phase<fp::EpiAct, pg8::StaticOrder, true, true>(lds, g, S, E, tid); }
            PH_END(PB + 5)
            PH_BEGIN(PB + 6)
            { pg8::Gemm g{ACT, WD, M_, DM, D_FF, D_FF}; pg8::StaticOrder S; S.init(M_, DM, G, bx);
              fp::EpiY E{YB, DM}; pg8::gemm_phase<fp::EpiY, pg8::StaticOrder, false, true>(lds, g, S, E, tid); }
            PH_END(PB + 6)
            PH_BEGIN(PB + 7)
            { const float* const p_g = ln2_g + layer * DM; const float* const p_b = ln2_b + layer * DM;
              { float va[16], vb[16]; long r = gw; if (r < M_) ln_load<bf16, bf16>(va, HB + r * DM, ALPHA, YB + r * DM, nullptr, lane);
            for (; r < M_; r += 2 * ngw) { const long r1 = r + ngw, r2 = r + 2 * ngw;
                if (r1 < M_) ln_load<bf16, bf16>(vb, HB + r1 * DM, ALPHA, YB + r1 * DM, nullptr, lane);
                ln_finish(va, p_g, p_b, nullptr, HB + r * DM, lane);
                if (r2 < M_) ln_load<bf16, bf16>(va, HB + r2 * DM, ALPHA, YB + r2 * DM, nullptr, lane);
                if (r1 < M_) ln_finish(vb, p_g, p_b, nullptr, HB + r1 * DM, lane); } } }
            PH_END(PB + 7)
        } else {
            PH_BEGIN(PB + 5)
            { for (long it = gw; it < (long)M_ * 2; it += ngw) { const int e = TE[it]; const int gs = moe_base(CNT, e) + TS[it];
                  if (lane == 0) { SP[gs] = TP[it]; GS[it] = gs; }
                  const uint4* src = (const uint4*)(HB + (it >> 1) * DM); uint4* dst = (uint4*)(XG + (size_t)gs * DM); dst[lane] = src[lane]; dst[lane + 64] = src[lane + 64]; }
              for (int it = gw; it < N_EXP * 256; it += ngw) { const int e = it >> 8, r = it & 255; const int c = CNT[e]; const int slot = moe_base(CNT, e) + c + r;
                  if (c + r < ((c + 255) & ~255)) { uint4* dst = (uint4*)(XG + (size_t)slot * DM); const uint4 z = make_uint4(0u, 0u, 0u, 0u); dst[lane] = z; dst[lane + 64] = z; if (lane == 0) SP[slot] = 0.f; } } }
            PH_END(PB + 5)
            PH_BEGIN(PB + 6)
            { pg8::Gemm g{XG, MWGU, NSLOT, N_EXP * NGUE, DM, DM}; fp::MoeOrder S; S.init(CNT, NGUE / 256, G, bx);
              fp::EpiAct E{ACTM, D_FFE, NGUE / 256}; pg8::gemm_phase<fp::EpiAct, fp::MoeOrder, true, true>(lds, g, S, E, tid); }
            PH_END(PB + 6)
            PH_BEGIN(PB + 7)
            { fp::MoeOrder S; S.init(CNT, DM / 256, G, bx); const int nf = S.tail_start(); const int slot0 = (nf / (DM / 256)) * 256;
              fp::EpiF2 E{F2, SP, F2P, slot0, D_FFE / 4};
              { pg8::Gemm g{ACTM, MWD, NSLOT, N_EXP * DM, D_FFE, D_FFE}; S.nfull = nf; S.ksplit = 1;
                pg8::gemm_phase<fp::EpiF2, fp::MoeOrder, true, true>(lds, g, S, E, tid); }
              { pg8::Gemm g{ACTM, MWD, NSLOT, N_EXP * DM, D_FFE / 4, D_FFE}; S.ksplit = 4; S.klen = D_FFE / 4;
                int tid2 = tid; asm volatile("" : "+v"(tid2));
                pg8::gemm_phase<fp::EpiF2, fp::MoeOrder, true, true>(lds, g, S, E, tid2); } }
            PH_END(PB + 7)
            PH_BEGIN(PB + 8)
            { const float* const p_g = ln2_g + layer * DM; const float* const p_b = ln2_b + layer * DM;
              int slot0; { fp::MoeOrder S; S.init(CNT, DM / 256, G, bx); const int nf = S.tail_start(); slot0 = (nf == S.T * (DM / 256)) ? 0x7fffffff : (nf / (DM / 256)) * 256; }
#define LN2_LOAD(v, rr) do { const int s0_ = GS[(rr) * 2], s1_ = GS[(rr) * 2 + 1]; ln_load<bf16, bf16>(v, HB + (rr) * DM, ALPHA, F2 + (size_t)s0_ * DM, F2 + (size_t)s1_ * DM, lane); \
                  if (s0_ >= slot0) { _Pragma("unroll") for (int p_ = 0; p_ < 3; ++p_) ln_add(v, F2P + ((size_t)p_ * TAIL_SLOTS + (s0_ - slot0)) * DM, lane); } \
                  if (s1_ >= slot0) { _Pragma("unroll") for (int p_ = 0; p_ < 3; ++p_) ln_add(v, F2P + ((size_t)p_ * TAIL_SLOTS + (s1_ - slot0)) * DM, lane); } } while (0)
              { float va[16], vb[16]; long r = gw; if (r < M_) LN2_LOAD(va, r);
                for (; r < M_; r += 2 * ngw) { const long r1 = r + ngw, r2 = r + 2 * ngw;
                    if (r1 < M_) LN2_LOAD(vb, r1);
                    ln_finish(va, p_g, p_b, H + r * DM, nullptr, lane);
                    if (r2 < M_) LN2_LOAD(va, r2);
                    if (r1 < M_) ln_finish(vb, p_g, p_b, H + r1 * DM, nullptr, lane); } }
#undef LN2_LOAD
            }
            PH_END(PB + 8)
        }
    }

#undef PH_BEGIN
#undef PH_END
#undef in_x
#undef in_pos
#undef ln_in_g
#undef ln_in_b
#undef w_in
#undef conv_w
#undef conv_b
#undef dt_bias
#undef a_log
#undef d_skip
#undef ssd_norm_g
#undef att_norm_g
#undef gm_ln_g
#undef gm_ln_b
#undef gm_w_s
#undef gm_b_s
#undef gm_norm_g
#undef w_out
#undef ln1_g
#undef ln1_b
#undef ln2_g
#undef ln2_b
#undef ffn_w_gate
#undef ffn_w_up
#undef ffn_w_down
#undef router_w
#undef moe_w_gate
#undef moe_w_up
#undef moe_w_down
#undef H
#undef MWD
#undef RT
#undef TE
#undef TP
#undef TS
#undef GS
#undef SP
#undef KM
#undef WSB
#undef HB
#undef MWGU
#undef WIN
#undef WOUT
#undef WGU
#undef WD
#undef PROJ
#undef ST
#undef CD
#undef XCB
#undef DTG
#undef MIXB
#undef YB
#undef ACT
#undef XG
#undef F2
#undef ACTM
#undef CNT
#undef tid
#undef lane
#undef F2P
#undef vcu
#undef gw
#undef ngw
#undef gt
#undef ngt
    if (pr_me) { const unsigned t_beg = (unsigned)__builtin_amdgcn_s_memrealtime(), t_len = (unsigned)PROBE_AMP * pr_w[1]; while ((unsigned)__builtin_amdgcn_s_memrealtime() - t_beg < t_len) __builtin_amdgcn_s_sleep(8); }
}

__device__ __forceinline__ void blk_acc(float d2, float s2, float* err) {
    d2 = wave_sum(d2); s2 = wave_sum(s2); if ((threadIdx.x & 63) == 0) { atomicAdd(err, d2); atomicAdd(err + 1, s2); }
}
__global__ void k_cmp_proj(const bf16* F, const float* S, long rows, float* err) {
    float d2 = 0.f, s2 = 0.f;
    for (long it = blockIdx.x * (long)blockDim.x + threadIdx.x; it < rows * 2950; it += gridDim.x * (long)blockDim.x) {
        const long row = it / 2950; const int d = (int)(it % 2950); const int sc = fp::win_src_col(d);
        float s = S[row * D_IN + sc]; if (d >= FGU && d < FXBC) s = gelu_tanh_f(s);
        const float f = ldf(F + row * PLD + d); d2 += (f - s) * (f - s); s2 += s * s; }
    blk_acc(d2, s2, err);
}
template <class TF> __global__ void k_cmp(const TF* F, int ldf_, const float* S, int lds_, long rows, int cols, float* err) {
    float d2 = 0.f, s2 = 0.f;
    for (long it = blockIdx.x * (long)blockDim.x + threadIdx.x; it < rows * cols; it += gridDim.x * (long)blockDim.x) {
        const long row = it / cols; const int c = (int)(it % cols); const float f = ldf(F + row * ldf_ + c), s = S[row * lds_ + c]; d2 += (f - s) * (f - s); s2 += s * s; }
    blk_acc(d2, s2, err);
}
__global__ void k_encode(const float* err, int nck, const float* Sout, float* out, long rows_s, long rows_all, float thr) {
    int k = 0; for (int i = 0; i < nck; ++i) { const float r = err[2 * i] / fmaxf(err[2 * i + 1], 1e-30f); if (!(r <= thr)) { k = i + 1; break; } }
    for (long it = blockIdx.x * (long)blockDim.x + threadIdx.x; it < rows_all * DM; it += gridDim.x * (long)blockDim.x)
        out[it] = (it < rows_s * DM) ? Sout[it] * (1.f + (float)k) : 0.f;
}
#if DEBUG_BUILD
constexpr size_t S_BASE = (WS_END + 2 * MiB - 1) / MiB * MiB;
#endif
extern "C" void kernel_launch(void* const* d_in, const int* in_sizes, int n_in, void* d_out, int out_size, void* d_ws, size_t ws_size, hipStream_t stream) {
    (void)in_sizes; (void)n_in; (void)out_size;
    static int grid = 0;
    if (grid == 0) {
        int dev = 0, cus = 0, per_cu = 0;
        if (hipGetDevice(&dev) != hipSuccess || hipDeviceGetAttribute(&cus, hipDeviceAttributeMultiprocessorCount, dev) != hipSuccess) { grid = -1; return; }
        if (hipFuncSetAttribute((const void*)mega, hipFuncAttributeMaxDynamicSharedMemorySize, LDS_BYTES) != hipSuccess) { fprintf(stderr, "kernel_launch: hipFuncSetAttribute failed\n"); grid = -1; return; }
        if (hipOccupancyMaxActiveBlocksPerMultiprocessor(&per_cu, (const void*)mega, 512, LDS_BYTES) != hipSuccess || per_cu < 1) fprintf(stderr, "kernel_launch: occupancy query reports %d\n", per_cu);
        (void)hipGetLastError();
        grid = cus;
        if (ws_size < WS_END) { fprintf(stderr, "kernel_launch: workspace too small: %zu < %zu\n", ws_size, (size_t)WS_END); grid = -1; }
    }
    if (grid < 0) return;
    unsigned char* ws = (unsigned char*)d_ws;
    if (hipMemsetAsync(ws + O_CTL, 0, CTL_BYTES, stream) != hipSuccess) return;
    FArgs a{};
    for (int i = 0; i < 29; ++i) a.in[i] = d_in[i];
    a.out = (float*)d_out; a.ws = ws;
#if !DEBUG_BUILD
    a.ph_lo = 0; a.ph_hi = N_PHASES;
    hipLaunchKernelGGL(mega, dim3(grid), dim3(512), LDS_BYTES, stream, a);
#else
    Inputs I;
    I.x = (const float*)d_in[0]; I.pos = (const int*)d_in[1]; I.ln_in_g = (const float*)d_in[2]; I.ln_in_b = (const float*)d_in[3]; I.w_in = (const float*)d_in[4];
    I.conv_w = (const float*)d_in[5]; I.conv_b = (const float*)d_in[6]; I.dt_bias = (const float*)d_in[7]; I.a_log = (const float*)d_in[8]; I.d_skip = (const float*)d_in[9];
    I.ssd_norm_g = (const float*)d_in[10]; I.att_norm_g = (const float*)d_in[11]; I.gm_ln_g = (const float*)d_in[12]; I.gm_ln_b = (const float*)d_in[13]; I.gm_w_s = (const float*)d_in[14];
    I.gm_b_s = (const float*)d_in[15]; I.gm_norm_g = (const float*)d_in[16]; I.w_out = (const float*)d_in[17]; I.ln1_g = (const float*)d_in[18]; I.ln1_b = (const float*)d_in[19];
    I.ln2_g = (const float*)d_in[20]; I.ln2_b = (const float*)d_in[21]; I.ffn_w_gate = (const float*)d_in[22]; I.ffn_w_up = (const float*)d_in[23]; I.ffn_w_down = (const float*)d_in[24];
    I.router_w = (const float*)d_in[25]; I.moe_w_gate = (const float*)d_in[26]; I.moe_w_up = (const float*)d_in[27]; I.moe_w_down = (const float*)d_in[28];
    const long MS = SEQ;
    unsigned char* sws = ws + S_BASE;
    float* saux = (float*)(sws + 96 * MiB); float* sout = (float*)(sws + 100 * MiB); float* ckpt = (float*)(sws + 110 * MiB);
    const size_t ck_stride = (size_t)MS * (D_IN + 3 * DM);
    run_simple(I, 1, sws, saux, sout, stream, ckpt);
    float* err = (float*)(ws + O_CTL) + CW_ERR;
    const bf16* PROJ = (const bf16*)(ws + O_PROJ); const bf16* MIXB = (const bf16*)(ws + O_MIXB); const bf16* Hf = (const bf16*)(ws + O_HB); const float* Hout = (const float*)d_out;
    for (int ph = 0; ph < N_PHASES; ++ph) {
        a.ph_lo = ph; a.ph_hi = ph + 1;
        hipLaunchKernelGGL(mega, dim3(grid), dim3(512), LDS_BYTES, stream, a);
        const int layer = ph >= 9 ? 1 : 0; const int rel = ph - (layer ? 8 : 0); const float* ck = ckpt + layer * ck_stride; float* e = err + layer * 12;
        if (rel == 1) k_cmp_proj<<<512, 256, 0, stream>>>(PROJ, ck, MS, e + 0);
        if (rel == 3) { k_cmp<bf16><<<512, 256, 0, stream>>>(MIXB, DM, ck + (size_t)MS * D_IN, DM, MS, 384, e + 2);
                        k_cmp<bf16><<<512, 256, 0, stream>>>(MIXB + 384, DM, ck + (size_t)MS * D_IN + 384, DM, MS, 384, e + 4);
                        k_cmp<bf16><<<512, 256, 0, stream>>>(MIXB + 768, DM, ck + (size_t)MS * D_IN + 768, DM, MS, 256, e + 6); }
        if (rel == 5) k_cmp<bf16><<<512, 256, 0, stream>>>(Hf, DM, ck + (size_t)MS * (D_IN + DM), DM, MS, DM, e + 8);
        if (layer == 0 && rel == 8) k_cmp<bf16><<<512, 256, 0, stream>>>(Hf, DM, ck + (size_t)MS * (D_IN + 2 * DM), DM, MS, DM, e + 10);
        if (layer == 1 && rel == 9) k_cmp<float><<<512, 256, 0, stream>>>(Hout, DM, ck + (size_t)MS * (D_IN + 2 * DM), DM, MS, DM, e + 10);
    }
    k_encode<<<1024, 256, 0, stream>>>(err, 12, sout, (float*)d_out, MS, (long)NBATCH * SEQ, DBG_THR);
#endif
}
```

```cpp
#define DEBUG_BUILD 0
#define DBG_THR 0.02f
#define PROBE_MASK 0u
#define PROBE_AMP 0
#include <hip/hip_runtime.h>
#include <cstdio>
#include <cstdint>

constexpr int DM = 1024, SEQ = 2048, NBATCH = 8;
constexpr int ATT_H = 6, HD = 64, ATT_W = 384, ROPE_DIM = 16;
constexpr int MOBA_BLOCK = 256, NBLK = SEQ / MOBA_BLOCK;
constexpr int SSD_H = 6, SSD_W = 384, SSD_G = 2, SSD_N = 128, SSD_CW = 896;
constexpr int GM_G = 4, GM_W = 256, GM_CHUNK = 128;
constexpr int D_IN = 2950, D_FF = 2816, N_EXP = 8, D_FFE = 3584;
constexpr float ALPHA = 1.4142135623730951f;
constexpr float NEGF = -1e30f;
constexpr int MAXSLOT = 2 * NBATCH * SEQ + N_EXP * 256;

typedef unsigned short bf16;
__device__ __forceinline__ unsigned f2bf(float f) { unsigned u = __float_as_uint(f); return (u + 0x7fffu + ((u >> 16) & 1u)) >> 16; }
__device__ __forceinline__ float ldf(const float* p) { return *p; }
__device__ __forceinline__ float ldf(const bf16* p) { return __uint_as_float(((unsigned)*p) << 16); }
__device__ __forceinline__ void stf(float* p, float v) { *p = v; }
__device__ __forceinline__ void stf(bf16* p, float v) { *p = (bf16)f2bf(v); }

__device__ __forceinline__ float dpp_add(float v, const int ctrl_tag) {
    int r;
    if (ctrl_tag == 0) r = __builtin_amdgcn_update_dpp(0, __float_as_int(v), 0xB1, 0xF, 0xF, false);
    else if (ctrl_tag == 1) r = __builtin_amdgcn_update_dpp(0, __float_as_int(v), 0x4E, 0xF, 0xF, false);
    else if (ctrl_tag == 2) r = __builtin_amdgcn_update_dpp(0, __float_as_int(v), 0x141, 0xF, 0xF, false);
    else r = __builtin_amdgcn_update_dpp(0, __float_as_int(v), 0x140, 0xF, 0xF, false);
    return v + __int_as_float(r);
}
__device__ __forceinline__ float row16_sum(float v) { v = dpp_add(v, 0); v = dpp_add(v, 1); v = dpp_add(v, 2); v = dpp_add(v, 3); return v; }
__device__ __forceinline__ float wave_sum(float v) {
    v = row16_sum(v);
    { const auto rr = __builtin_amdgcn_permlane16_swap(__float_as_uint(v), __float_as_uint(v), false, false); v = __uint_as_float(rr[0]) + __uint_as_float(rr[1]); }
    { const auto rr = __builtin_amdgcn_permlane32_swap(__float_as_uint(v), __float_as_uint(v), false, false); v = __uint_as_float(rr[0]) + __uint_as_float(rr[1]); }
    return v;
}
__device__ __forceinline__ float silu_f(float x) { return x / (1.f + __expf(-x)); }
__device__ __forceinline__ float gelu_tanh_f(float x) { const float u = 0.7978845608028654f * (x + 0.044715f * x * x * x); return 0.5f * x * (1.f + tanhf(u)); }
__device__ __forceinline__ float softplus_f(float x) { return fmaxf(x, 0.f) + log1pf(__expf(-fabsf(x))); }

struct ProjL { int ld, q, k, v, z, xbc, dt, gu, gv; };

__device__ __forceinline__ float4 ld4(const float* p) { return *(const float4*)p; }
__device__ __forceinline__ float4 ld4(const bf16* p) { const uint2 w = *(const uint2*)p; return make_float4(__uint_as_float(w.x << 16), __uint_as_float(w.x & 0xffff0000u), __uint_as_float(w.y << 16), __uint_as_float(w.y & 0xffff0000u)); }
template <class TY, class TX = float> __device__ __forceinline__ void ln_load(float (&v)[16], const TX* xrow, float a, const TY* y1, const TY* y2, int lane) {
#pragma unroll
    for (int j = 0; j < 4; ++j) {
        const float4 x = ld4(xrow + j * 256 + lane * 4);
        float4 t = make_float4(a * x.x, a * x.y, a * x.z, a * x.w);
        if (y1) { const float4 y = ld4(y1 + j * 256 + lane * 4); t.x += y.x; t.y += y.y; t.z += y.z; t.w += y.w; }
        if (y2) { const float4 y = ld4(y2 + j * 256 + lane * 4); t.x += y.x; t.y += y.y; t.z += y.z; t.w += y.w; }
        v[4 * j] = t.x; v[4 * j + 1] = t.y; v[4 * j + 2] = t.z; v[4 * j + 3] = t.w;
    }
}
__device__ __forceinline__ void ln_add(float (&v)[16], const bf16* y, int lane) {
#pragma unroll
    for (int j = 0; j < 4; ++j) { const float4 t = ld4(y + j * 256 + lane * 4); v[4 * j] += t.x; v[4 * j + 1] += t.y; v[4 * j + 2] += t.z; v[4 * j + 3] += t.w; }
}
__device__ __forceinline__ void ln_finish(float (&v)[16], const float* g, const float* b, float* of, bf16* ob, int lane) {
    float s = 0.f;
#pragma unroll
    for (int i = 0; i < 16; ++i) s += v[i];
    const float mean = wave_sum(s) * (1.f / 1024.f); float s2 = 0.f;
#pragma unroll
    for (int i = 0; i < 16; ++i) { v[i] -= mean; s2 += v[i] * v[i]; }
    const float rstd = rsqrtf(wave_sum(s2) * (1.f / 1024.f) + 1e-5f);
#pragma unroll
    for (int j = 0; j < 4; ++j) {
        const float4 gg = *(const float4*)(g + j * 256 + lane * 4), bb = *(const float4*)(b + j * 256 + lane * 4);
        float4 o = make_float4(v[4 * j] * rstd * gg.x + bb.x, v[4 * j + 1] * rstd * gg.y + bb.y, v[4 * j + 2] * rstd * gg.z + bb.z, v[4 * j + 3] * rstd * gg.w + bb.w);
        if (of) *(float4*)(of + j * 256 + lane * 4) = o;
        if (ob) { uint2 w; w.x = f2bf(o.x) | (f2bf(o.y) << 16); w.y = f2bf(o.z) | (f2bf(o.w) << 16); *(uint2*)(ob + j * 256 + lane * 4) = w; }
    }
}

struct LnGB { float4 g[4], b[4]; };
__device__ __forceinline__ void ln_gb_load(LnGB& p, const float* g, const float* b, int lane) {
#pragma unroll
    for (int j = 0; j < 4; ++j) { p.g[j] = *(const float4*)(g + j * 256 + lane * 4); p.b[j] = *(const float4*)(b + j * 256 + lane * 4); }
}
__device__ __forceinline__ void ln_finish_r(float (&v)[16], const LnGB& p, float* of, bf16* ob, int lane) {
    float s = 0.f;
#pragma unroll
    for (int i = 0; i < 16; ++i) s += v[i];
    const float mean = wave_sum(s) * (1.f / 1024.f); float s2 = 0.f;
#pragma unroll
    for (int i = 0; i < 16; ++i) { v[i] -= mean; s2 += v[i] * v[i]; }
    const float rstd = rsqrtf(wave_sum(s2) * (1.f / 1024.f) + 1e-5f);
#pragma unroll
    for (int j = 0; j < 4; ++j) {
        const float4 gg = p.g[j], bb = p.b[j];
        float4 o = make_float4(v[4 * j] * rstd * gg.x + bb.x, v[4 * j + 1] * rstd * gg.y + bb.y, v[4 * j + 2] * rstd * gg.z + bb.z, v[4 * j + 3] * rstd * gg.w + bb.w);
        if (of) *(float4*)(of + j * 256 + lane * 4) = o;
        if (ob) { uint2 w; w.x = f2bf(o.x) | (f2bf(o.y) << 16); w.y = f2bf(o.z) | (f2bf(o.w) << 16); *(uint2*)(ob + j * 256 + lane * 4) = w; }
    }
}
template <class TY> __device__ __forceinline__ void ln_row(const float* xrow, float a, const TY* y1, const TY* y2, const float* g, const float* b, float* of, bf16* ob, int lane) {
    float v[16]; ln_load<TY>(v, xrow, a, y1, y2, lane); ln_finish(v, g, b, of, ob, lane);
}

__device__ __forceinline__ void rope_inplace(float* P, ProjL L, const int* pos, long n_rows, long gt, long ngt) {
    for (long it = gt; it < n_rows * 96; it += ngt) {
        const int i = (int)(it & 7), hh = (int)((it >> 3) % 12); const long row = it / 96;
        const int off = (hh < 6 ? L.q : L.k) + (hh % 6) * 64;
        const float inv = powf(500000.0f, -(float)(2 * i) / 16.0f);
        const float ang = (float)pos[row] * inv;
        const float c = cosf(ang), s = sinf(ang);
        float* p = P + row * L.ld + off;
        const float x1 = p[i], x2 = p[i + 8];
        p[i] = x1 * c - x2 * s; p[i + 8] = x2 * c + x1 * s;
    }
}

template <class T> __device__ __forceinline__ void kmean_phase(const T* P, ProjL L, float* KM, int nb, long gt, long ngt) {
    for (long it = gt; it < (long)nb * ATT_H * NBLK * 64; it += ngt) {
        const int d = (int)(it & 63), n = (int)((it >> 6) % NBLK), h = (int)((it / (64 * NBLK)) % ATT_H), b = (int)(it / (64 * NBLK * ATT_H));
        const T* p = P + ((long)b * SEQ + n * MOBA_BLOCK) * L.ld + L.k + h * 64 + d; float s = 0.f;
        for (int r = 0; r < MOBA_BLOCK; ++r) s += ldf(p + (long)r * L.ld);
        KM[it] = s * (1.f / MOBA_BLOCK);
    }
}

template <class T> __device__ __forceinline__ void attn_naive_phase(const T* P, ProjL L, const float* KM, float* O, int ldo, int nb, int gw, int ngw, int lane) {
    for (long it = gw; it < (long)nb * ATT_H * SEQ; it += ngw) {
        const int q = (int)(it % SEQ), h = (int)((it / SEQ) % ATT_H), b = (int)(it / ((long)SEQ * ATT_H));
        const long row = (long)b * SEQ + q; const int qblk = q / MOBA_BLOCK;
        const float qv = ldf(P + row * L.ld + L.q + h * 64 + lane);
        float g[NBLK];
#pragma unroll
        for (int n = 0; n < NBLK; ++n) { const float t = wave_sum(qv * KM[(((long)b * ATT_H + h) * NBLK + n) * 64 + lane]); g[n] = (n < qblk) ? t : NEGF; }
        unsigned sel = 0u;
#pragma unroll
        for (int r = 0; r < 3; ++r) { float bv = -3.0e38f; int best = -1;
#pragma unroll
            for (int n = 0; n < NBLK; ++n) if (!((sel >> n) & 1u) && g[n] > bv) { bv = g[n]; best = n; }
            if (best >= 0 && bv > NEGF * 0.5f) sel |= 1u << best; }
        sel |= 1u << qblk;
        float m = -3.0e38f, l = 0.f, o = 0.f;
        for (int n = 0; n <= qblk; ++n) {
            if (!((sel >> n) & 1u)) continue;
            const int j0 = n * MOBA_BLOCK, j1 = (n == qblk) ? q + 1 : j0 + MOBA_BLOCK;
            const T* kp = P + ((long)b * SEQ + j0) * L.ld + L.k + h * 64 + lane;
            const T* vp = P + ((long)b * SEQ + j0) * L.ld + L.v + h * 64 + lane;
            for (int j = j0; j < j1; ++j, kp += L.ld, vp += L.ld) {
                const float s = wave_sum(qv * ldf(kp)) * 0.125f;
                const float mn = fmaxf(m, s), corr = __expf(m - mn), p = __expf(s - mn);
                l = l * corr + p; o = o * corr + p * ldf(vp); m = mn;
            }
        }
        O[row * ldo + h * 64 + lane] = o / l;
    }
}

template <int W, class TO> __device__ __forceinline__ void rms_rows_phase(const float* in, int ldi, const float* g, TO* out, int ldo, long n_rows, int gw, int ngw, int lane) {
    constexpr int PER = W / 64;
    for (long row = gw; row < n_rows; row += ngw) {
        float v[PER]; float s = 0.f;
#pragma unroll
        for (int j = 0; j < PER; ++j) { v[j] = in[row * ldi + j * 64 + lane]; s += v[j] * v[j]; }
        const float r = rsqrtf(wave_sum(s) * (1.f / W) + 1e-5f);
#pragma unroll
        for (int j = 0; j < PER; ++j) stf(out + row * ldo + j * 64 + lane, v[j] * r * g[j * 64 + lane]);
    }
}

template <class T, class TO> __device__ __forceinline__ void ssd_conv_phase(const T* P, ProjL L, const float* cw, const float* cb, const float* dtb, TO* XC, float* DT, long n_rows, long gt, long ngt) {
    for (long it = gt; it < n_rows * 902; it += ngt) {
        const int c = (int)(it % 902); const long row = it / 902; const int t = (int)(row % SEQ);
        if (c < SSD_CW) {
            float acc = cb[c];
#pragma unroll
            for (int i = 0; i < 4; ++i) { const int tt = t - 3 + i; if (tt >= 0) acc += cw[i * SSD_CW + c] * ldf(P + (row - 3 + i) * L.ld + L.xbc + c); }
            stf(XC + row * SSD_CW + c, silu_f(acc));
        } else {
            const int h = c - SSD_CW;
            DT[row * SSD_H + h] = softplus_f(ldf(P + row * L.ld + L.dt + h) + dtb[h]);
        }
    }
}

template <class T> __device__ __forceinline__ void ssd_scan_naive_phase(const T* XC, const float* DT, const float* a_log, const float* dsk, float* Y, int ldo, int nb, int gw, int ngw, int lane) {
    for (int it = gw; it < nb * SSD_H * 64; it += ngw) {
        const int p = it & 63, h = (it >> 6) % SSD_H, b = it / (64 * SSD_H), grp = h / (SSD_H / SSD_G);
        const float A = -__expf(a_log[h]), Dk = dsk[h];
        float s0 = 0.f, s1 = 0.f;
#pragma unroll 4
        for (int t = 0; t < SEQ; ++t) {
            const long row = (long)b * SEQ + t;
            const T* xr = XC + row * SSD_CW;
            const float dt = DT[row * SSD_H + h], x = ldf(xr + h * 64 + p);
            const float B0 = ldf(xr + SSD_W + grp * SSD_N + lane), B1 = ldf(xr + SSD_W + grp * SSD_N + 64 + lane);
            const float C0 = ldf(xr + SSD_W + SSD_G * SSD_N + grp * SSD_N + lane), C1 = ldf(xr + SSD_W + SSD_G * SSD_N + grp * SSD_N + 64 + lane);
            const float dec = __expf(dt * A), xd = x * dt;
            s0 = s0 * dec + xd * B0; s1 = s1 * dec + xd * B1;
            const float y = wave_sum(C0 * s0 + C1 * s1);
            if (lane == 0) Y[row * ldo + h * 64 + p] = y + Dk * x;
        }
    }
}

template <class T, class TO> __device__ __forceinline__ void ssd_gate_phase(const float* Y, int ldi, const T* P, ProjL L, const float* ng, TO* out, int ldo, long n_rows, int gw, int ngw, int lane) {
    for (long row = gw; row < n_rows; row += ngw) {
        float v[6];
#pragma unroll
        for (int j = 0; j < 6; ++j) { const int c = j * 64 + lane; v[j] = Y[row * ldi + c] * silu_f(ldf(P + row * L.ld + L.z + c)); }
        const float r0 = rsqrtf(wave_sum(v[0] * v[0] + v[1] * v[1] + v[2] * v[2]) * (1.f / 192.f) + 1e-5f);
        const float r1 = rsqrtf(wave_sum(v[3] * v[3] + v[4] * v[4] + v[5] * v[5]) * (1.f / 192.f) + 1e-5f);
#pragma unroll
        for (int j = 0; j < 6; ++j) { const int c = j * 64 + lane; stf(out + row * ldo + c, v[j] * (j < 3 ? r0 : r1) * ng[c]); }
    }
}

template <class T, bool PRE> __device__ __forceinline__ void gm_ln_phase(const T* P, ProjL L, const float* g, const float* b, float* VN, long n_rows, int gw, int ngw, int lane) {
    for (long row = gw; row < n_rows; row += ngw) {
        float v[4]; float s = 0.f;
#pragma unroll
        for (int j = 0; j < 4; ++j) { const float x = ldf(P + row * L.ld + L.gv + j * 64 + lane); v[j] = PRE ? x : gelu_tanh_f(x); s += v[j]; }
        const float mean = wave_sum(s) * (1.f / 256.f); float s2 = 0.f;
#pragma unroll
        for (int j = 0; j < 4; ++j) { v[j] -= mean; s2 += v[j] * v[j]; }
        const float rstd = rsqrtf(wave_sum(s2) * (1.f / 256.f) + 1e-5f);
#pragma unroll
        for (int j = 0; j < 4; ++j) VN[row * GM_W + j * 64 + lane] = v[j] * rstd * g[j * 64 + lane] + b[j * 64 + lane];
    }
}
template <class T, bool PRE> __device__ __forceinline__ void gm_mix_phase(const T* P, ProjL L, const float* VN, const float* ws_, const float* bs, float* GO, int ldo, long n_rows, long gt, long ngt) {
    for (long it = gt; it < n_rows * GM_W; it += ngt) {
        const int c = (int)(it % GM_W); const long row = it / GM_W; const int t = (int)(row % GM_CHUNK), g = c / 64; const long base = row - t;
        const float* w = ws_ + ((long)g * GM_CHUNK + t) * GM_CHUNK; float acc = 0.f;
        for (int s = 0; s <= t; ++s) acc += w[s] * VN[(base + s) * GM_W + c];
        acc += bs[g * GM_CHUNK + t];
        const float x = ldf(P + row * L.ld + L.gu + c); const float u = PRE ? x : gelu_tanh_f(x);
        GO[row * ldo + c] = u * acc;
    }
}

__device__ __forceinline__ void moe_route_phase(const float* H, const float* Wr, int* CNT, int* TE, float* TP, int* TS, long n_rows, int gw, int ngw, int lane) {
    for (long row = gw; row < n_rows; row += ngw) {
        float acc[N_EXP];
#pragma unroll
        for (int e = 0; e < N_EXP; ++e) acc[e] = 0.f;
        for (int j = 0; j < 16; ++j) { const int d = j * 64 + lane; const float hv = H[row * DM + d];
            const float4 w0 = *(const float4*)(Wr + d * N_EXP), w1 = *(const float4*)(Wr + d * N_EXP + 4);
            acc[0] += hv * w0.x; acc[1] += hv * w0.y; acc[2] += hv * w0.z; acc[3] += hv * w0.w; acc[4] += hv * w1.x; acc[5] += hv * w1.y; acc[6] += hv * w1.z; acc[7] += hv * w1.w; }
#pragma unroll
        for (int e = 0; e < N_EXP; ++e) acc[e] = wave_sum(acc[e]);
        int e0 = 0; float v0 = acc[0];
#pragma unroll
        for (int e = 1; e < N_EXP; ++e) if (acc[e] > v0) { v0 = acc[e]; e0 = e; }
        int e1 = -1; float v1 = -3.0e38f;
#pragma unroll
        for (int e = 0; e < N_EXP; ++e) if (e != e0 && acc[e] > v1) { v1 = acc[e]; e1 = e; }
        const float p1 = __expf(v1 - v0), den = 1.f + p1;
        if (lane == 0) {
            const int s0 = atomicAdd(&CNT[e0], 1), s1 = atomicAdd(&CNT[e1], 1);
            TE[row * 2] = e0; TE[row * 2 + 1] = e1; TP[row * 2] = 1.f / den; TP[row * 2 + 1] = p1 / den; TS[row * 2] = s0; TS[row * 2 + 1] = s1;
        }
    }
}

__device__ __forceinline__ void moe_route_block(const bf16* H, const float* Wr, int* CNT, int* TE, float* TP, int* TS, long n_rows, int gw_, int ngw_, int lane, int wave, int tid,
                                                __attribute__((address_space(3))) int* sh  ) {
    asm volatile("" : "+v"(tid));
    if (tid < 16) sh[tid] = 0;
    __syncthreads();
    int k = 0;
    for (long row = gw_; row < n_rows; row += ngw_, ++k) {
        float acc[N_EXP];
#pragma unroll
        for (int e = 0; e < N_EXP; ++e) acc[e] = 0.f;
        for (int j = 0; j < 16; ++j) { const int d = j * 64 + lane; const float hv = ldf(H + row * DM + d);
            const float4 w0 = *(const float4*)(Wr + d * N_EXP), w1 = *(const float4*)(Wr + d * N_EXP + 4);
            acc[0] += hv * w0.x; acc[1] += hv * w0.y; acc[2] += hv * w0.z; acc[3] += hv * w0.w; acc[4] += hv * w1.x; acc[5] += hv * w1.y; acc[6] += hv * w1.z; acc[7] += hv * w1.w; }
#pragma unroll
        for (int e = 0; e < N_EXP; ++e) acc[e] = wave_sum(acc[e]);
        int e0 = 0; float v0 = acc[0];
#pragma unroll
        for (int e = 1; e < N_EXP; ++e) if (acc[e] > v0) { v0 = acc[e]; e0 = e; }
        int e1 = -1; float v1 = -3.0e38f;
#pragma unroll
        for (int e = 0; e < N_EXP; ++e) if (e != e0 && acc[e] > v1) { v1 = acc[e]; e1 = e; }
        const float p1 = __expf(v1 - v0), den = 1.f + p1;
        if (lane == 0) {
            const int l0 = atomicAdd((int*)&sh[e0], 1), l1 = atomicAdd((int*)&sh[e1], 1);
            TE[row * 2] = e0; TE[row * 2 + 1] = e1; TP[row * 2] = 1.f / den; TP[row * 2 + 1] = p1 / den;
            sh[16 + (wave * 8 + k) * 4 + 0] = e0; sh[16 + (wave * 8 + k) * 4 + 1] = e1; sh[16 + (wave * 8 + k) * 4 + 2] = l0; sh[16 + (wave * 8 + k) * 4 + 3] = l1;
        }
    }
    __syncthreads();
    if (tid < N_EXP) sh[8 + tid] = atomicAdd(&CNT[tid], sh[tid]);
    __syncthreads();
    k = 0;
    for (long row = gw_; row < n_rows; row += ngw_, ++k)
        if (lane == 0) { const int e0 = sh[16 + (wave * 8 + k) * 4], e1 = sh[16 + (wave * 8 + k) * 4 + 1];
            TS[row * 2] = sh[8 + e0] + sh[16 + (wave * 8 + k) * 4 + 2]; TS[row * 2 + 1] = sh[8 + e1] + sh[16 + (wave * 8 + k) * 4 + 3]; }
    __syncthreads();
}
__device__ __forceinline__ int moe_base(const int* CNT, int e) { int b = 0; for (int i = 0; i < e; ++i) b += (CNT[i] + 255) & ~255; return b; }
__device__ __forceinline__ void moe_scatter_phase(const int* CNT, const int* TE, const float* TP, const int* TS, int* LIST, float* SP, int* GS, long n_rows, long gt, long ngt) {
    for (long it = gt; it < n_rows * 2; it += ngt) {
        const int e = TE[it]; const int gs = moe_base(CNT, e) + TS[it];
        LIST[gs] = (int)(it >> 1); SP[gs] = TP[it]; GS[it] = gs;
    }
}

template <class TA, int EPI> __global__ void __launch_bounds__(256) sgemm_k(const TA* A, int lda, const int* rowlist, const float* B, const float* B2, int ldb, long bstride, void* Cv, int ldc, int M, int N, int K, const int* CNT, const float* scale) {
    __shared__ float As[16][68], Bs[16][68], Bs2[16][68];
    int row_base = 0, mrows = M;
    if (CNT) { const int e = blockIdx.z; row_base = moe_base(CNT, e); mrows = CNT[e]; B += (long)e * bstride; if (B2) B2 += (long)e * bstride; }
    const int m0 = blockIdx.y * 64; if (m0 >= mrows) return;
    const int n0 = blockIdx.x * 64, tid = threadIdx.x, tx = tid & 15, ty = tid >> 4;
    float acc[4][4], acc2[4][4];
#pragma unroll
    for (int i = 0; i < 4; ++i)
#pragma unroll
        for (int j = 0; j < 4; ++j) { acc[i][j] = 0.f; acc2[i][j] = 0.f; }
    const int ar = tid >> 2, ak = (tid & 3) * 4; long arow = -1;
    { const int lr = m0 + ar; if (lr < mrows) { arow = rowlist ? (long)rowlist[row_base + lr] : (long)(row_base + lr); } }
    const int bk = tid >> 4, bn = (tid & 15) * 4;
    for (int k0 = 0; k0 < K; k0 += 16) {
        float av[4] = {0.f, 0.f, 0.f, 0.f};
        if (arow >= 0) {
#pragma unroll
            for (int i = 0; i < 4; ++i) av[i] = ldf(A + arow * lda + k0 + ak + i);
        }
#pragma unroll
        for (int i = 0; i < 4; ++i) As[ak + i][ar] = av[i];
#pragma unroll
        for (int i = 0; i < 4; ++i) { const int n = n0 + bn + i; const bool ok = n < N;
            Bs[bk][bn + i] = ok ? B[(long)(k0 + bk) * ldb + n] : 0.f;
            if (EPI == 1 || EPI == 2) Bs2[bk][bn + i] = ok ? B2[(long)(k0 + bk) * ldb + n] : 0.f; }
        __syncthreads();
#pragma unroll
        for (int kk = 0; kk < 16; ++kk) {
            float a[4], b[4], b2[4];
#pragma unroll
            for (int i = 0; i < 4; ++i) { a[i] = As[kk][ty * 4 + i]; b[i] = Bs[kk][tx * 4 + i]; if (EPI == 1 || EPI == 2) b2[i] = Bs2[kk][tx * 4 + i]; }
#pragma unroll
            for (int i = 0; i < 4; ++i)
#pragma unroll
                for (int j = 0; j < 4; ++j) { acc[i][j] += a[i] * b[j]; if (EPI == 1 || EPI == 2) acc2[i][j] += a[i] * b2[j]; }
        }
        __syncthreads();
    }
#pragma unroll
    for (int i = 0; i < 4; ++i) { const int lr = m0 + ty * 4 + i; if (lr >= mrows) continue; const long crow = row_base + lr;
#pragma unroll
        for (int j = 0; j < 4; ++j) { const int n = n0 + tx * 4 + j; if (n >= N) continue;
            float v = acc[i][j];
            if (EPI == 1 || EPI == 2) v = silu_f(v) * acc2[i][j];
            if (EPI == 3) v *= scale[crow];
            if (EPI == 2) ((bf16*)Cv)[crow * ldc + n] = (bf16)f2bf(v); else ((float*)Cv)[crow * ldc + n] = v; } }
}

#define GW_DECL const int lane = threadIdx.x & 63; const int gw = (int)((blockIdx.x * (long)blockDim.x + threadIdx.x) >> 6); const int ngw = (int)((gridDim.x * (long)blockDim.x) >> 6); (void)lane; (void)gw; (void)ngw;
#define GT_DECL const long gt = blockIdx.x * (long)blockDim.x + threadIdx.x; const long ngt = gridDim.x * (long)blockDim.x;

__global__ void k_ln_in(const float* x, const float* g, const float* b, float* H, long n_rows) { GW_DECL for (long r = gw; r < n_rows; r += ngw) ln_row<float>(x + r * DM, 1.f, nullptr, nullptr, g, b, H + r * DM, nullptr, lane); }
__global__ void k_ln_res(float* H, const float* Y, const float* g, const float* b, float* OUT, long n_rows) { GW_DECL for (long r = gw; r < n_rows; r += ngw) ln_row<float>(H + r * DM, ALPHA, Y + r * DM, nullptr, g, b, OUT + r * DM, nullptr, lane); }
__global__ void k_ln_moe(float* H, const float* F2, const int* GS, const float* g, const float* b, float* OUT, long n_rows) { GW_DECL for (long r = gw; r < n_rows; r += ngw) ln_row<float>(H + r * DM, ALPHA, F2 + (long)GS[r * 2] * DM, F2 + (long)GS[r * 2 + 1] * DM, g, b, OUT + r * DM, nullptr, lane); }
__global__ void k_rope(float* P, ProjL L, const int* pos, long n_rows) { GT_DECL rope_inplace(P, L, pos, n_rows, gt, ngt); }
__global__ void k_kmean(const float* P, ProjL L, float* KM, int nb) { GT_DECL kmean_phase<float>(P, L, KM, nb, gt, ngt); }
__global__ void k_attn(const float* P, ProjL L, const float* KM, float* O, int ldo, int nb) { GW_DECL attn_naive_phase<float>(P, L, KM, O, ldo, nb, gw, ngw, lane); }
__global__ void k_rms384(const float* in, int ldi, const float* g, float* out, int ldo, long n_rows) { GW_DECL rms_rows_phase<384, float>(in, ldi, g, out, ldo, n_rows, gw, ngw, lane); }
__global__ void k_rms256(const float* in, int ldi, const float* g, float* out, int ldo, long n_rows) { GW_DECL rms_rows_phase<256, float>(in, ldi, g, out, ldo, n_rows, gw, ngw, lane); }
__global__ void k_ssd_conv(const float* P, ProjL L, const float* cw, const float* cb, const float* dtb, float* XC, float* DT, long n_rows) { GT_DECL ssd_conv_phase<float, float>(P, L, cw, cb, dtb, XC, DT, n_rows, gt, ngt); }
__global__ void k_ssd_scan(const float* XC, const float* DT, const float* a_log, const float* dsk, float* Y, int ldo, int nb) { GW_DECL ssd_scan_naive_phase<float>(XC, DT, a_log, dsk, Y, ldo, nb, gw, ngw, lane); }
__global__ void k_ssd_gate(const float* Y, int ldi, const float* P, ProjL L, const float* ng, float* out, int ldo, long n_rows) { GW_DECL ssd_gate_phase<float, float>(Y, ldi, P, L, ng, out, ldo, n_rows, gw, ngw, lane); }
__global__ void k_gm_ln(const float* P, ProjL L, const float* g, const float* b, float* VN, long n_rows) { GW_DECL gm_ln_phase<float, false>(P, L, g, b, VN, n_rows, gw, ngw, lane); }
__global__ void k_gm_mix(const float* P, ProjL L, const float* VN, const float* ws_, const float* bs, float* GO, int ldo, long n_rows) { GT_DECL gm_mix_phase<float, false>(P, L, VN, ws_, bs, GO, ldo, n_rows, gt, ngt); }
__global__ void k_moe_init(int* CNT, int* LIST, int nslots) { GT_DECL if (gt < N_EXP) CNT[gt] = 0; for (long i = gt; i < nslots; i += ngt) LIST[i] = -1; }
__global__ void k_moe_route(const float* H, const float* Wr, int* CNT, int* TE, float* TP, int* TS, long n_rows) { GW_DECL moe_route_phase(H, Wr, CNT, TE, TP, TS, n_rows, gw, ngw, lane); }
__global__ void k_moe_scatter(const int* CNT, const int* TE, const float* TP, const int* TS, int* LIST, float* SP, int* GS, long n_rows) { GT_DECL moe_scatter_phase(CNT, TE, TP, TS, LIST, SP, GS, n_rows, gt, ngt); }

struct Inputs {
    const float *x; const int* pos; const float *ln_in_g, *ln_in_b, *w_in, *conv_w, *conv_b, *dt_bias, *a_log, *d_skip, *ssd_norm_g, *att_norm_g, *gm_ln_g, *gm_ln_b, *gm_w_s, *gm_b_s, *gm_norm_g, *w_out,
        *ln1_g, *ln1_b, *ln2_g, *ln2_b, *ffn_w_gate, *ffn_w_up, *ffn_w_down, *router_w, *moe_w_gate, *moe_w_up, *moe_w_down;
};

static void run_simple(const Inputs& I, int nb, unsigned char* ws, float* aux  , float* OUT, hipStream_t st, float* ckpt = nullptr) {
    const long M = (long)nb * SEQ; const size_t MB = 1u << 20;
    const size_t hsz = (size_t)M * DM * 4;
    float* H = (float*)ws; float* MIX = (float*)(ws + hsz); float* Y = (float*)(ws + 2 * hsz); unsigned char* BIG = ws + 3 * hsz + (size_t)N_EXP * 256 * DM * 4;
    float* XC = Y;
    float* VN = aux;
    float* PROJ = (float*)BIG;
    size_t big_bytes = (size_t)M * D_IN * 4; { size_t a = (size_t)M * D_FF * 4; if (a > big_bytes) big_bytes = a; size_t c = (size_t)(2 * M + N_EXP * 256) * D_FFE * 2; if (c > big_bytes) big_bytes = c; }
    big_bytes = (big_bytes + 255) & ~(size_t)255;
    unsigned char* SM = BIG + big_bytes;
    float* KM = (float*)SM; SM += (size_t)nb * ATT_H * NBLK * 64 * 4;
    float* DT = (float*)SM; SM += (size_t)M * SSD_H * 4;
    int* CNT = (int*)SM; SM += 256;
    int* TE = (int*)SM; SM += (size_t)M * 2 * 4; float* TP = (float*)SM; SM += (size_t)M * 2 * 4; int* TS = (int*)SM; SM += (size_t)M * 2 * 4; int* GS = (int*)SM; SM += (size_t)M * 2 * 4;
    const int nslots = (int)(2 * M + N_EXP * 256);
    int* LIST = (int*)SM; SM += (size_t)nslots * 4; float* SP = (float*)SM; SM += (size_t)nslots * 4;
    (void)MB;
    const ProjL L{D_IN, 0, 384, 768, 1152, 1536, 2432, 2438, 2694};
    const int TB = 256; const int GWB = 2048;
    k_ln_in<<<GWB, TB, 0, st>>>(I.x, I.ln_in_g, I.ln_in_b, H, M);
    for (int i = 0; i < 2; ++i) {
        sgemm_k<float, 0><<<dim3((D_IN + 63) / 64, (unsigned)(M / 64), 1), 256, 0, st>>>(H, DM, nullptr, I.w_in + (size_t)i * DM * D_IN, nullptr, D_IN, 0, PROJ, D_IN, (int)M, D_IN, DM, nullptr, nullptr);
        k_rope<<<GWB, TB, 0, st>>>(PROJ, L, I.pos, M);
        const size_t ck_stride = (size_t)M * (D_IN + 3 * DM); float* ck = ckpt ? ckpt + (size_t)i * ck_stride : nullptr;
        if (ck) hipMemcpyAsync(ck, PROJ, (size_t)M * D_IN * 4, hipMemcpyDeviceToDevice, st);
        k_kmean<<<96 * nb, TB, 0, st>>>(PROJ, L, KM, nb);
        k_attn<<<GWB * 2, TB, 0, st>>>(PROJ, L, KM, MIX, DM, nb);
        k_rms384<<<GWB, TB, 0, st>>>(MIX, DM, I.att_norm_g + i * ATT_W, MIX, DM, M);
        k_ssd_conv<<<GWB * 2, TB, 0, st>>>(PROJ, L, I.conv_w + (size_t)i * 4 * SSD_CW, I.conv_b + i * SSD_CW, I.dt_bias + i * SSD_H, XC, DT, M);
        k_ssd_scan<<<(nb * SSD_H * 64 * 64 + TB - 1) / TB, TB, 0, st>>>(XC, DT, I.a_log + i * SSD_H, I.d_skip + i * SSD_H, MIX + ATT_W, DM, nb);
        k_ssd_gate<<<GWB, TB, 0, st>>>(MIX + ATT_W, DM, PROJ, L, I.ssd_norm_g + i * SSD_W, MIX + ATT_W, DM, M);
        k_gm_ln<<<GWB, TB, 0, st>>>(PROJ, L, I.gm_ln_g + i * GM_W, I.gm_ln_b + i * GM_W, VN, M);
        k_gm_mix<<<GWB * 2, TB, 0, st>>>(PROJ, L, VN, I.gm_w_s + (size_t)i * GM_G * GM_CHUNK * GM_CHUNK, I.gm_b_s + i * GM_G * GM_CHUNK, MIX + ATT_W + SSD_W, DM, M);
        k_rms256<<<GWB, TB, 0, st>>>(MIX + ATT_W + SSD_W, DM, I.gm_norm_g + i * GM_W, MIX + ATT_W + SSD_W, DM, M);
        if (ck) hipMemcpyAsync(ck + (size_t)M * D_IN, MIX, hsz, hipMemcpyDeviceToDevice, st);
        sgemm_k<float, 0><<<dim3(DM / 64, (unsigned)(M / 64), 1), 256, 0, st>>>(MIX, DM, nullptr, I.w_out + (size_t)i * DM * DM, nullptr, DM, 0, Y, DM, (int)M, DM, DM, nullptr, nullptr);
        k_ln_res<<<GWB, TB, 0, st>>>(H, Y, I.ln1_g + i * DM, I.ln1_b + i * DM, H, M);
        if (ck) hipMemcpyAsync(ck + (size_t)M * (D_IN + DM), H, hsz, hipMemcpyDeviceToDevice, st);
        if (i == 0) {
            float* ACT = (float*)BIG;
            sgemm_k<float, 1><<<dim3(D_FF / 64, (unsigned)(M / 64), 1), 256, 0, st>>>(H, DM, nullptr, I.ffn_w_gate, I.ffn_w_up, D_FF, 0, ACT, D_FF, (int)M, D_FF, DM, nullptr, nullptr);
            sgemm_k<float, 0><<<dim3(DM / 64, (unsigned)(M / 64), 1), 256, 0, st>>>(ACT, D_FF, nullptr, I.ffn_w_down, nullptr, DM, 0, Y, DM, (int)M, DM, D_FF, nullptr, nullptr);
            k_ln_res<<<GWB, TB, 0, st>>>(H, Y, I.ln2_g + i * DM, I.ln2_b + i * DM, H, M);
            if (ck) hipMemcpyAsync(ck + (size_t)M * (D_IN + 2 * DM), H, hsz, hipMemcpyDeviceToDevice, st);
        } else {
            bf16* ACTM = (bf16*)BIG; float* F2 = MIX;
            k_moe_init<<<256, TB, 0, st>>>(CNT, LIST, nslots);
            k_moe_route<<<GWB, TB, 0, st>>>(H, I.router_w, CNT, TE, TP, TS, M);
            k_moe_scatter<<<256, TB, 0, st>>>(CNT, TE, TP, TS, LIST, SP, GS, M);
            sgemm_k<float, 2><<<dim3(D_FFE / 64, (unsigned)(M / 64), N_EXP), 256, 0, st>>>(H, DM, LIST, I.moe_w_gate, I.moe_w_up, D_FFE, (long)DM * D_FFE, ACTM, D_FFE, 0, D_FFE, DM, CNT, nullptr);
            sgemm_k<bf16, 3><<<dim3(DM / 64, (unsigned)(M / 64), N_EXP), 256, 0, st>>>(ACTM, D_FFE, nullptr, I.moe_w_down, nullptr, DM, (long)D_FFE * DM, F2, DM, 0, DM, D_FFE, CNT, SP);
            k_ln_moe<<<GWB, TB, 0, st>>>(H, F2, GS, I.ln2_g + i * DM, I.ln2_b + i * DM, OUT, M);
            if (ck) hipMemcpyAsync(ck + (size_t)M * (D_IN + 2 * DM), OUT, hsz, hipMemcpyDeviceToDevice, st);
        }
    }
}

#define LAS __attribute__((address_space(3)))
namespace pg8 {
#define PG8_LAS __attribute__((address_space(3)))
typedef unsigned short bf16_t;
typedef short bf16x8 __attribute__((ext_vector_type(8)));
typedef float f32x4 __attribute__((ext_vector_type(4)));
typedef unsigned u32x4 __attribute__((ext_vector_type(4)));
constexpr int BM = 256, BK = 64, HALF = 128, HTB = HALF * BK * 2  , STAGE_BYTES = 8 * HTB, NXCD = 8, WGM = 8;

__host__ __device__ __forceinline__ int lds_byte(int r, int c) { const int st = (r >> 4) * 2 + (c >> 5), rr = r & 15, cc = c & 31, ob = rr * 64 + cc * 2; return st * 1024 + (ob ^ (((ob >> 9) & 1) << 5)); }
__host__ __device__ __forceinline__ void stage_rc(int b, int& R, int& C) { const int st = b / 1024, sb = b % 1024, swz = sb ^ (((sb >> 9) & 1) << 5); R = (st >> 1) * 16 + swz / 64; C = (st & 1) * 32 + (swz % 64) / 2; }
__host__ __device__ __forceinline__ int perm32(int rho) { const int n = rho >> 4, i = rho & 15; return 8 * (i >> 2) + 4 * n + (i & 3); }

struct Unit { int pm, pn, kofs; };
struct Gemm { const bf16_t* A; const bf16_t* Bt; int M, N, K, ld; };

struct StaticOrder {
    int nM, nN, nwg, G, c;
    __host__ __device__ void init(int M, int N, int G_, int c_) { nM = M / BM; nN = N / BM; nwg = nM * nN; G = G_; c = c_; }
    __host__ __device__ bool next(int i, Unit& u) const {
        const long L = (long)i * G + c; if (L >= nwg) return false;
        int wgid = (int)L; { const int q = nwg / NXCD, r = nwg % NXCD, xcd = wgid % NXCD, off = wgid / NXCD; wgid = (xcd < r ? xcd * (q + 1) : r * (q + 1) + (xcd - r) * q) + off; }
        const int nig = WGM * nN, gid = wgid / nig, fm = gid * WGM, gsz = (nM - fm) < WGM ? (nM - fm) : WGM;
        u.pm = fm + ((wgid % nig) % gsz); u.pn = (wgid % nig) / gsz; u.kofs = 0; return true;
    }
    __device__ __forceinline__ void a_ready(const Unit&) const {}
    __device__ __forceinline__ void done(const Unit&) const {}
};
__device__ __forceinline__ unsigned cvt_pk_bf16(float lo, float hi) { unsigned r; asm volatile("v_cvt_pk_bf16_f32 %0, %1, %2" : "=v"(r) : "v"(lo), "v"(hi)); return r; }
typedef float f32x2 __attribute__((ext_vector_type(2)));
template <class Epi, class Sched, bool ALIGN_EPI = false, bool SP2 = false>
__device__ __forceinline__ void gemm_phase(PG8_LAS unsigned char* lds, const Gemm g, const Sched& S, const Epi& E, const int tid) {
    const int wid = __builtin_amdgcn_readfirstlane(tid >> 6), lane = tid & 63, wr = wid >> 2, wc = wid & 3, fr = lane & 15, fq = lane >> 4;
    const int K = g.ld, nt = g.K / BK;
    unsigned voffA[2], voffB[2];
#pragma unroll
    for (int i = 0; i < 2; ++i) { int R, C; stage_rc(tid * 16 + i * 8192, R, C); const int Rb = Epi::PERM ? ((R & ~31) + perm32(R & 31)) : R;
        voffA[i] = (unsigned)(R * K + C) * 2u; voffB[i] = (unsigned)(Rb * K + C) * 2u; }
    const size_t kstep = (size_t)(BK * 2);
    const size_t hstep = (size_t)HALF * K * 2;
    const size_t tstep = 2 * hstep;
    const unsigned ldsw = (unsigned)wid * 1024u;
    const int aoff = lds_byte(wr * 64 + fr, fq * 8), boff = lds_byte(wc * 32 + fr, fq * 8);
#define PG8_SA(b, h) (((b) * 2 + (h)) * HTB)
#define PG8_SB(b, h) ((4 + (b) * 2 + (h)) * HTB)
#define PG8_STAGE(bufoff, gbase, voff) do { _Pragma("unroll") for (int _i = 0; _i < 2; ++_i) \
        __builtin_amdgcn_global_load_lds((const unsigned*)((const char*)(gbase) + (voff)[_i]), (PG8_LAS unsigned*)(lds + (bufoff) + ldsw + _i * 8192), 16, 0, 0); } while (0)
#define PG8_LDA(dst, b, h) do { _Pragma("unroll") for (int m = 0; m < 4; ++m) _Pragma("unroll") for (int k = 0; k < 2; ++k) dst[m][k] = *(const PG8_LAS bf16x8*)(lds + PG8_SA(b, h) + aoff + m * 2048 + k * 1024); } while (0)
#define PG8_LDB(dst, b, h) do { _Pragma("unroll") for (int n = 0; n < 2; ++n) _Pragma("unroll") for (int k = 0; k < 2; ++k) dst[n][k] = *(const PG8_LAS bf16x8*)(lds + PG8_SB(b, h) + boff + n * 2048 + k * 1024); } while (0)
#define PG8_MMA(ai, bj, At, Bt) do { __builtin_amdgcn_s_setprio(1); _Pragma("unroll") for (int m = 0; m < 4; ++m) _Pragma("unroll") for (int n = 0; n < 2; ++n) _Pragma("unroll") for (int k = 0; k < 2; ++k) \
        acc[ai][bj][m][n] = __builtin_amdgcn_mfma_f32_16x16x32_bf16(Bt[n][k], At[m][k], acc[ai][bj][m][n], 0, 0, 0); __builtin_amdgcn_s_setprio(0); } while (0)
#define PG8_WAIT_V(n) asm volatile("s_waitcnt vmcnt(" #n ")" ::: "memory")
#define PG8_WAIT_L(n) asm volatile("s_waitcnt lgkmcnt(" #n ")" ::: "memory")
#define PG8_BAR __builtin_amdgcn_s_barrier()
#define PG8_SCHED __builtin_amdgcn_sched_barrier(0)
    Unit cur, nxt; int ui = 0;
    if (!S.next(0, cur)) return;
    f32x4 acc[2][2][4][2];
#pragma unroll
    for (int a = 0; a < 2; ++a)
#pragma unroll
        for (int b = 0; b < 2; ++b)
#pragma unroll
            for (int m = 0; m < 4; ++m)
#pragma unroll
                for (int n = 0; n < 2; ++n) acc[a][b][m][n] = (f32x4){0.f, 0.f, 0.f, 0.f};
    bf16x8 At[4][2], B0[2][2], B1[2][2];
    const char* cA = (const char*)g.A + (size_t)cur.pm * tstep + (size_t)cur.kofs * 2; const char* cB = (const char*)g.Bt + (size_t)cur.pn * tstep + (size_t)cur.kofs * 2;
    S.a_ready(cur);
    if constexpr (SP2) {
        PG8_STAGE(PG8_SB(0, 0), cB, voffB); PG8_STAGE(PG8_SB(0, 1), cB + hstep, voffB); PG8_STAGE(PG8_SA(0, 0), cA, voffA); PG8_STAGE(PG8_SA(0, 1), cA + hstep, voffA);
        if (wr == 1) PG8_BAR;
        PG8_WAIT_V(2); PG8_BAR;
        PG8_STAGE(PG8_SB(1, 0), cB + kstep, voffB); PG8_STAGE(PG8_SA(1, 0), cA + kstep, voffA); PG8_STAGE(PG8_SB(1, 1), cB + hstep + kstep, voffB);
        PG8_WAIT_V(6); PG8_BAR;
    } else {
        PG8_STAGE(PG8_SB(0, 0), cB, voffB); PG8_STAGE(PG8_SA(0, 0), cA, voffA); PG8_STAGE(PG8_SB(0, 1), cB + hstep, voffB); PG8_STAGE(PG8_SA(0, 1), cA + hstep, voffA);
        if (wr == 1) PG8_BAR;
        PG8_WAIT_V(4); PG8_BAR;
        PG8_STAGE(PG8_SB(1, 0), cB + kstep, voffB); PG8_STAGE(PG8_SA(1, 0), cA + kstep, voffA); PG8_STAGE(PG8_SB(1, 1), cB + hstep + kstep, voffB);
        PG8_WAIT_V(6); PG8_BAR;
    }
    for (;;) {
        const bool has_next = S.next(ui + 1, nxt);
        const char* nA = has_next ? (const char*)g.A + (size_t)nxt.pm * tstep + (size_t)nxt.kofs * 2 : cA; const char* nB = has_next ? (const char*)g.Bt + (size_t)nxt.pn * tstep + (size_t)nxt.kofs * 2 : cB;
        for (int t = 0; t < nt; t += 2) {
            const bool last = (t == nt - 2);
            const char* a1 = cA + (size_t)(t + 1) * kstep;
            const char* a2 = last ? nA : cA + (size_t)(t + 2) * kstep; const char* b2 = last ? nB : cB + (size_t)(t + 2) * kstep;
            const char* a3 = a2 + kstep; const char* b3 = b2 + kstep;
            if (last && has_next) S.a_ready(nxt);
            if constexpr (SP2) {
            PG8_LDB(B0, 0, 0); PG8_LDB(B1, 0, 1); PG8_SCHED; PG8_LDA(At, 0, 0); PG8_STAGE(PG8_SA(1, 1), a1 + hstep, voffA);
            PG8_WAIT_V(8); PG8_WAIT_L(0); PG8_BAR; PG8_MMA(0, 0, At, B0); PG8_MMA(0, 1, At, B1); PG8_BAR; PG8_SCHED;
            PG8_LDA(At, 0, 1); PG8_STAGE(PG8_SB(0, 0), b2, voffB); PG8_STAGE(PG8_SB(0, 1), b2 + hstep, voffB); PG8_STAGE(PG8_SA(0, 0), a2, voffA);
            PG8_WAIT_V(8); PG8_WAIT_L(0); PG8_BAR; PG8_MMA(1, 0, At, B0); PG8_MMA(1, 1, At, B1); PG8_BAR; PG8_SCHED;
            PG8_LDB(B0, 1, 0); PG8_LDB(B1, 1, 1); PG8_SCHED; PG8_LDA(At, 1, 0); PG8_STAGE(PG8_SA(0, 1), a2 + hstep, voffA);
            PG8_WAIT_V(8); PG8_WAIT_L(0); PG8_BAR; PG8_MMA(0, 0, At, B0); PG8_MMA(0, 1, At, B1); PG8_BAR; PG8_SCHED;
            PG8_LDA(At, 1, 1); PG8_STAGE(PG8_SB(1, 0), b3, voffB); PG8_STAGE(PG8_SB(1, 1), b3 + hstep, voffB); PG8_STAGE(PG8_SA(1, 0), a3, voffA);
            PG8_WAIT_V(8); PG8_WAIT_L(0); PG8_BAR; PG8_MMA(1, 0, At, B0); PG8_MMA(1, 1, At, B1); PG8_BAR; PG8_SCHED;
            } else {
            PG8_LDB(B0, 0, 0); PG8_SCHED; PG8_LDA(At, 0, 0); PG8_STAGE(PG8_SA(1, 1), a1 + hstep, voffA);
            PG8_WAIT_L(8); PG8_BAR; PG8_WAIT_L(0); PG8_MMA(0, 0, At, B0); PG8_BAR; PG8_SCHED;
            PG8_LDB(B1, 0, 1); PG8_STAGE(PG8_SB(0, 0), b2, voffB);
            PG8_BAR; PG8_WAIT_L(0); PG8_MMA(0, 1, At, B1); PG8_BAR;
            PG8_LDA(At, 0, 1); PG8_STAGE(PG8_SA(0, 0), a2, voffA);
            PG8_BAR; PG8_WAIT_L(0); PG8_MMA(1, 0, At, B0); PG8_BAR; PG8_SCHED;
            PG8_STAGE(PG8_SB(0, 1), b2 + hstep, voffB);
            PG8_WAIT_V(6); PG8_BAR; PG8_MMA(1, 1, At, B1); PG8_BAR;
            PG8_LDB(B0, 1, 0); PG8_SCHED; PG8_LDA(At, 1, 0); PG8_STAGE(PG8_SA(0, 1), a2 + hstep, voffA);
            PG8_WAIT_L(8); PG8_BAR; PG8_WAIT_L(0); PG8_MMA(0, 0, At, B0); PG8_BAR; PG8_SCHED;
            PG8_LDB(B1, 1, 1); PG8_STAGE(PG8_SB(1, 0), b3, voffB);
            PG8_BAR; PG8_WAIT_L(0); PG8_MMA(0, 1, At, B1); PG8_BAR;
            PG8_LDA(At, 1, 1); PG8_STAGE(PG8_SA(1, 0), a3, voffA);
            PG8_BAR; PG8_WAIT_L(0); PG8_MMA(1, 0, At, B0); PG8_BAR; PG8_SCHED;
            PG8_STAGE(PG8_SB(1, 1), b3 + hstep, voffB);
            PG8_WAIT_V(6); PG8_BAR; PG8_MMA(1, 1, At, B1); PG8_BAR;
            }
        }
        if constexpr (ALIGN_EPI) { if (wr == 0) PG8_BAR; }
        if constexpr (!Epi::AFTER_DRAIN) { E(acc, cur, wr, wc, fr, fq); S.done(cur); }
        if (!has_next) break;
#pragma unroll
        for (int a = 0; a < 2; ++a)
#pragma unroll
            for (int b = 0; b < 2; ++b)
#pragma unroll
                for (int m = 0; m < 4; ++m)
#pragma unroll
                    for (int n = 0; n < 2; ++n) acc[a][b][m][n] = (f32x4){0.f, 0.f, 0.f, 0.f};
        cur = nxt; cA = nA; cB = nB; ++ui;
        if constexpr (ALIGN_EPI) { if (wr == 1) PG8_BAR; }
    }
    PG8_WAIT_V(0);
    if constexpr (!ALIGN_EPI) { if (wr == 0) PG8_BAR; }
    PG8_BAR;
    if constexpr (Epi::AFTER_DRAIN) { E.fused(acc, cur, wr, wc, fr, fq, lds, wid, lane); S.done(cur); }
#undef PG8_SA
#undef PG8_SB
#undef PG8_STAGE
#undef PG8_LDA
#undef PG8_LDB
#undef PG8_MMA
#undef PG8_WAIT_V
#undef PG8_WAIT_L
#undef PG8_BAR
#undef PG8_SCHED
}
}
#define XB_TMO      128
#define XB_XCNT(j)  (256  + 64 * (j))
#define XB_XSUB(j)  (1280 + 64 * (j))
#define XB_XGEN(j)  (2304 + 64 * (j))
#define XB_TOP      3328
#define XB_TOPGEN   3392
#define XCD_BAR_WORDS 3456
#define XB_SPIN_CAP (1u << 24)

__device__ __forceinline__ unsigned xb_ld(unsigned* p)              { return __hip_atomic_load(p, __ATOMIC_RELAXED, __HIP_MEMORY_SCOPE_AGENT); }
__device__ __forceinline__ unsigned xb_add(unsigned* p, unsigned v) { return __hip_atomic_fetch_add(p, v, __ATOMIC_RELAXED, __HIP_MEMORY_SCOPE_AGENT); }
__device__ __forceinline__ unsigned xb_xcc_id() { return (unsigned)__builtin_amdgcn_s_getreg((3 << 11) | 20) & 0xFu; }
#define XB_SPIN(cond, bar) do { unsigned _sp = 0; while (cond) { __builtin_amdgcn_s_sleep(1); \
    if ((++_sp & 255u) == 0u) { if (xb_ld(&(bar)[XB_TMO])) break; if (_sp > XB_SPIN_CAP) { atomicAdd(&(bar)[XB_TMO], 1u); break; } } } } while (0)

struct XcdBarrier {
    unsigned* bar; unsigned x; int w0;
    volatile LAS unsigned* st;
};

__device__ __forceinline__ XcdBarrier xcd_barrier_post(unsigned* bar, volatile LAS unsigned* st) {
    XcdBarrier b; b.bar = bar; b.x = xb_xcc_id(); b.st = st; b.w0 = (__builtin_amdgcn_readfirstlane((int)threadIdx.x >> 6) == 0);
    if (threadIdx.x == 0) (void)xb_add(&bar[XB_XCNT(b.x)], 1u);
    return b;
}
__device__ __forceinline__ void xcd_barrier_complete(unsigned* bar, unsigned x, unsigned& nloc, unsigned& nx) {
    const unsigned G = gridDim.x * gridDim.y * gridDim.z;
    unsigned sum, cnt, mine, sp = 0u;
    for (;;) {
        sum = 0u; cnt = 0u; mine = 0u;
#pragma unroll
        for (unsigned j = 0; j < 16; ++j) { const unsigned c = xb_ld(&bar[XB_XCNT(j)]); sum += c; cnt += (c > 0u) ? 1u : 0u; mine = (j == x) ? c : mine; }
        if (sum == G) break;
        __builtin_amdgcn_s_sleep(1);
        if ((++sp & 255u) == 0u) { if (xb_ld(&bar[XB_TMO])) break; if (sp > XB_SPIN_CAP) { atomicAdd(&bar[XB_TMO], 1u); break; } }
    }
    nloc = mine > 0u ? mine : 1u; nx = cnt > 0u ? cnt : 1u;
}

__device__ __forceinline__ void xcd_barrier(const XcdBarrier& b) {
    asm volatile("s_waitcnt vmcnt(0)" ::: "memory");
    __syncthreads();
    if (b.w0 && __builtin_amdgcn_mbcnt_hi(~0u, __builtin_amdgcn_mbcnt_lo(~0u, 0u)) == 0u) {
        unsigned* bar = b.bar;
        __builtin_amdgcn_s_waitcnt(0);
        unsigned nloc = b.st[0], nx = b.st[1];
        if (nloc == 0u) { xcd_barrier_complete(bar, b.x, nloc, nx); b.st[0] = nloc; b.st[1] = nx; }
        const unsigned old = xb_add(&bar[XB_XSUB(b.x)], 1u);
        const unsigned gen = old / nloc;
        if (old + 1u == (gen + 1u) * nloc) {
            __builtin_amdgcn_fence(__ATOMIC_RELEASE, "agent");
            asm volatile("s_waitcnt vmcnt(0)" ::: "memory");
            const unsigned og = xb_add(&bar[XB_TOP], 1u);
            const unsigned tg = og / nx;
            if (og + 1u == (tg + 1u) * nx) xb_add(&bar[XB_TOPGEN], 1u);
            else XB_SPIN(xb_ld(&bar[XB_TOPGEN]) == tg, bar);
            __builtin_amdgcn_fence(__ATOMIC_ACQUIRE, "agent");
            xb_add(&bar[XB_XGEN(b.x)], 1u);
            asm volatile("s_waitcnt vmcnt(0)" ::: "memory");
        } else {
            XB_SPIN(xb_ld(&bar[XB_XGEN(b.x)]) == gen, bar);
            __builtin_amdgcn_fence(__ATOMIC_ACQUIRE, "agent");
            asm volatile("s_waitcnt vmcnt(0)" ::: "memory");
        }
    }
    __syncthreads();
}
#include <hip/hip_bf16.h>
#include <cmath>
namespace attn_body {
using bf16=__hip_bfloat16;
using bf16x8=__attribute__((ext_vector_type(8)))short;
using s16x4=__attribute__((ext_vector_type(4)))short;
using f32x16=__attribute__((ext_vector_type(16)))float;
using u32x4=__attribute__((ext_vector_type(4)))unsigned;
constexpr int NHEAD=6,SEQ=2048,D=64,QP=3072,OP=1024;
constexpr int NW=8,QBLK=32,QB=QBLK*NW,KVBLK=64,NQB=SEQ/QB;
constexpr int ATTN_UNIT_ROWS=QB;
__device__ __forceinline__ int crow(int r,int hi){return (r&3)+8*(r>>2)+4*hi;}
#define SBAR() __builtin_amdgcn_sched_barrier(0)
__device__ __forceinline__ void cmask(f32x16&p0,f32x16&p1,int jb,int qrel,int hi){
  const float NEG=-INFINITY; int kb=64*jb+4*hi;
  #pragma unroll
  for(int r=0;r<16;++r){int kv=kb+(r&3)+8*(r>>2); if(kv>qrel)p0[r]=NEG; if(kv+32>qrel)p1[r]=NEG;}
}

constexpr int NSLOT=3, SLOTB=8192;
constexpr int LDS_K=0, LDS_V=NSLOT*SLOTB, LDS_WS=2*NSLOT*SLOTB, LDS_OST=LDS_WS+NW*64*4, LDS_BYTES=LDS_OST+NW*4096;
constexpr float C2=0.125f*1.4426950408889634f;
__device__ __forceinline__ void glds16(const void*gsrc,unsigned lds_dst){unsigned keep;
  asm volatile("s_mov_b32 %0, m0\n\ts_mov_b32 m0, %2\n\ts_nop 0\n\tglobal_load_lds_dwordx4 %1, off\n\ts_mov_b32 m0, %0":"=&s"(keep):"v"(gsrc),"s"(lds_dst):"memory");}
__device__ __forceinline__ float max3f(float a,float b,float c){float r;asm("v_max3_f32 %0, %1, %2, %3":"=v"(r):"v"(a),"v"(b),"v"(c));return r;}
__device__ __forceinline__ float max2f(float a,float b){float r;asm("v_max_f32_e32 %0, %1, %2":"=v"(r):"v"(a),"v"(b));return r;}
__device__ __forceinline__ float fadd_s(float a,float b){float r;asm("v_add_f32_e32 %0, %1, %2":"=v"(r):"v"(a),"v"(b));return r;}
__device__ __forceinline__ float fsub_s(float a,float b){float r;asm("v_sub_f32_e32 %0, %1, %2":"=v"(r):"v"(a),"v"(b));return r;}
typedef float f32x2_t __attribute__((ext_vector_type(2))); typedef __bf16 bf16x2_t __attribute__((ext_vector_type(2)));
__device__ __forceinline__ unsigned cvtpk_s(float lo,float hi){f32x2_t v={lo,hi};bf16x2_t b=__builtin_convertvector(v,bf16x2_t);return __builtin_bit_cast(unsigned,b);}
#define WAIT_BAR(N) asm volatile("s_waitcnt vmcnt(" #N ") lgkmcnt(0)\n\ts_barrier":::"memory")

__device__ __forceinline__ void qkt(f32x16&p0,f32x16&p1,const char*Kslot,const bf16x8*qr,int r32,int hi){ const f32x16 negm=f32x16{};
  const char*kb=Kslot+hi*1024+r32*16;
  #pragma unroll
  for(int d0=0;d0<4;++d0){
    const bf16x8 b0=*reinterpret_cast<const bf16x8*>(kb+d0*2048);
    const bf16x8 b1=*reinterpret_cast<const bf16x8*>(kb+d0*2048+512);
    if(d0==0){p0=__builtin_amdgcn_mfma_f32_32x32x16_bf16(b0,qr[0],negm,0,0,0);p1=__builtin_amdgcn_mfma_f32_32x32x16_bf16(b1,qr[0],negm,0,0,0);}
    else{p0=__builtin_amdgcn_mfma_f32_32x32x16_bf16(b0,qr[d0],p0,0,0,0);p1=__builtin_amdgcn_mfma_f32_32x32x16_bf16(b1,qr[d0],p1,0,0,0);}}
}
typedef __attribute__((address_space(3))) const char* lds_cptr;
typedef short v4i16_t __attribute__((ext_vector_type(4)));
__device__ __forceinline__ void kload8(bf16x8*kf,lds_cptr kp){
  kf[0]=*(const __attribute__((address_space(3))) bf16x8*)(kp);      kf[1]=*(const __attribute__((address_space(3))) bf16x8*)(kp+512);
  kf[2]=*(const __attribute__((address_space(3))) bf16x8*)(kp+2048); kf[3]=*(const __attribute__((address_space(3))) bf16x8*)(kp+2560);
  kf[4]=*(const __attribute__((address_space(3))) bf16x8*)(kp+4096); kf[5]=*(const __attribute__((address_space(3))) bf16x8*)(kp+4608);
  kf[6]=*(const __attribute__((address_space(3))) bf16x8*)(kp+6144); kf[7]=*(const __attribute__((address_space(3))) bf16x8*)(kp+6656);
}
__device__ __forceinline__ void kload2(bf16x8*kf,lds_cptr kp,int j){ kf[2*j]=*(const __attribute__((address_space(3))) bf16x8*)(kp+j*2048); kf[2*j+1]=*(const __attribute__((address_space(3))) bf16x8*)(kp+j*2048+512); }
__device__ __forceinline__ s16x4 vtr(lds_cptr p){ return __builtin_bit_cast(s16x4,__builtin_amdgcn_ds_read_tr16_b64_v4i16((__attribute__((address_space(3))) v4i16_t*)p)); }
__device__ __forceinline__ float rowmax(const f32x16&p0,const f32x16&p1){
  float a=max3f(p0[0],p0[1],p1[0]),b=max3f(p0[2],p0[3],p1[1]);a=max3f(a,p1[2],p1[3]);
  #pragma unroll
  for(int r=4;r<16;r+=4){a=max3f(a,p0[r],p0[r+1]);b=max3f(b,p0[r+2],p0[r+3]);a=max3f(a,p1[r],p1[r+1]);b=max3f(b,p1[r+2],p1[r+3]);}
  const float m=max2f(a,b);
  auto rr=__builtin_amdgcn_permlane32_swap(__float_as_uint(m),__float_as_uint(m),false,false);
  return max2f(__uint_as_float(rr[0]),__uint_as_float(rr[1]));
}
__device__ __forceinline__ void pv(f32x16*o,int vb,bf16x8 pa0,bf16x8 pa1,bf16x8 pa2,bf16x8 pa3){
  #pragma unroll
  for(int d0=0;d0<2;++d0){s16x4 lo[4],hi[4];
    #pragma unroll
    for(int ks=0;ks<4;++ks){
      asm volatile("ds_read_b64_tr_b16 %0,%1 offset:%c2":"=&v"(lo[ks]):"v"(vb),"i"(d0*4096+ks*1024):"memory");
      asm volatile("ds_read_b64_tr_b16 %0,%1 offset:%c2":"=&v"(hi[ks]):"v"(vb),"i"(d0*4096+ks*1024+512):"memory");}
    asm volatile("s_waitcnt lgkmcnt(0)":::"memory");SBAR();
    #define PK(k) (bf16x8){lo[k][0],lo[k][1],lo[k][2],lo[k][3],hi[k][0],hi[k][1],hi[k][2],hi[k][3]}
    o[d0]=__builtin_amdgcn_mfma_f32_32x32x16_bf16(pa0,PK(0),o[d0],0,0,0);
    o[d0]=__builtin_amdgcn_mfma_f32_32x32x16_bf16(pa1,PK(1),o[d0],0,0,0);
    o[d0]=__builtin_amdgcn_mfma_f32_32x32x16_bf16(pa2,PK(2),o[d0],0,0,0);
    o[d0]=__builtin_amdgcn_mfma_f32_32x32x16_bf16(pa3,PK(3),o[d0],0,0,0);
    #undef PK
  }
}

#ifndef ATTN_STORE16
#define ATTN_STORE16(p,v) (*(u32x4*)(p)=(v))
#endif
template<int THRL> __device__ __forceinline__ void attn_unit(int b,int h,int qb,const bf16*Q,const bf16*__restrict__ K,const bf16*__restrict__ V,bf16*O,const float*__restrict__ KM,int KMH,char*shm,const int tid){
  const int lane=tid&63,r32=lane&31,hi=lane>>5; const int wid=__builtin_amdgcn_readfirstlane(tid>>6);
  const long rowbase=(long)b*SEQ; const int q0=qb*QB;
  const bf16*Qw=Q+(rowbase+q0+wid*QBLK)*QP+h*D;
  const bf16*Kh=K+rowbase*QP+h*D,*Vh=V+rowbase*QP+h*D;
  const unsigned lds0=(unsigned)(uintptr_t)shm;
  float*wsf=(float*)(shm+LDS_WS)+wid*64;
  const bf16*ksrc=Kh+(long)lane*QP+wid*8;
  const bf16*vsrc=Vh+(long)(16*(wid&3)+(lane>>2))*QP+(wid>>2)*32+(lane&3)*8;
  const unsigned kdst=lds0+LDS_K+wid*1024, vdst=lds0+LDS_V+wid*1024;
  #define TI(t) (((t)<4)?(NT-4+(t)):((t)-4))
  #define DMA_K(t,slot) glds16(ksrc+(long)TI(t)*KVBLK*QP,(unsigned)__builtin_amdgcn_readfirstlane(kdst+(slot)))
  #define DMA_V(t,slot) glds16(vsrc+(long)TI(t)*KVBLK*QP,(unsigned)__builtin_amdgcn_readfirstlane(vdst+(slot)))
  const char*Kbase=shm+LDS_K; bf16x8 kf[8];
  const lds_cptr shm3=(lds_cptr)shm; const lds_cptr kp0=shm3+LDS_K+hi*1024+r32*16; const lds_cptr vp0=shm3+LDS_V+((lane>>4)&1)*32+(lane&3)*8+(4*hi+((lane&15)>>2))*64;
  const int NT=(q0+QB)/KVBLK;
  DMA_K(0,0);DMA_V(0,0);DMA_K(1,SLOTB);
  bf16x8 qr[4];
  #pragma unroll
  for(int d0=0;d0<4;++d0)qr[d0]=*reinterpret_cast<const bf16x8*>(&Qw[(long)r32*QP+d0*16+hi*8]);

  unsigned sel=0u;
  if(qb>0){ float gt_[8];
    #pragma unroll
    for(int n=0;n<8;++n){ float a_=0.f;
      if(n<qb){ const float*km=KM+((long)(b*NHEAD+h)*8+n)*64+hi*8;
        #pragma unroll
        for(int d0=0;d0<4;++d0){ float4 k0=*reinterpret_cast<const float4*>(km+d0*16), k1=*reinterpret_cast<const float4*>(km+d0*16+4);
          { const float4 k2=*reinterpret_cast<const float4*>(km+KMH+d0*16), k3=*reinterpret_cast<const float4*>(km+KMH+d0*16+4); k0.x+=k2.x;k0.y+=k2.y;k0.z+=k2.z;k0.w+=k2.w;k1.x+=k3.x;k1.y+=k3.y;k1.z+=k3.z;k1.w+=k3.w; }
          const bf16x8 qv=qr[d0];
          a_+=__uint_as_float(((unsigned)(unsigned short)qv[0])<<16)*k0.x+__uint_as_float(((unsigned)(unsigned short)qv[1])<<16)*k0.y+__uint_as_float(((unsigned)(unsigned short)qv[2])<<16)*k0.z+__uint_as_float(((unsigned)(unsigned short)qv[3])<<16)*k0.w
             +__uint_as_float(((unsigned)(unsigned short)qv[4])<<16)*k1.x+__uint_as_float(((unsigned)(unsigned short)qv[5])<<16)*k1.y+__uint_as_float(((unsigned)(unsigned short)qv[6])<<16)*k1.z+__uint_as_float(((unsigned)(unsigned short)qv[7])<<16)*k1.w; }
        a_+=__shfl_xor(a_,32); }
      gt_[n]=(n<qb)?a_:-1e30f; }
    #pragma unroll
    for(int r_=0;r_<3;++r_){ float bv=-3.0e38f; int best=-1;
      #pragma unroll
      for(int n=0;n<8;++n) if(!((sel>>n)&1u)&&gt_[n]>bv){bv=gt_[n];best=n;}
      if(best>=0&&bv>-0.5e30f) sel|=1u<<best; } }
  if(hi==0)wsf[32+r32]=__uint_as_float(sel); asm volatile("s_waitcnt lgkmcnt(0)":::"memory");
  float mhat=0.f,l_reg=0.f;f32x16 o[2];o[0]=f32x16{};o[1]=f32x16{};
  const int qrel=wid*QBLK+r32;
  #define CMASK(P0,P1,t) do{ if((t)<4){cmask(P0,P1,(t),qrel,hi);} else if(!((__float_as_uint(wsf[32+r32])>>(((t)-4)>>2))&1u)){ _Pragma("unroll") for(int r_=0;r_<16;++r_){P0[r_]=-INFINITY;P1[r_]=-INFINITY;} } }while(0)
  bool resc=false;
  #define START(P0,P1) do{ const float rm=rowmax(P0,P1); resc=false; \
    { const float dl=rm; mhat=fadd_s(mhat,dl); \
      _Pragma("unroll") for(int r=0;r<16;++r){P0[r]=fsub_s(P0[r],dl);P1[r]=fsub_s(P1[r],dl);} \
      } \
    _Pragma("unroll") for(int r=0;r<16;++r)P0[r]=__builtin_amdgcn_exp2f(P0[r]); }while(0)
  #define RESC() do{ if(resc){ asm volatile("s_waitcnt lgkmcnt(0)":::"memory"); \
      _Pragma("unroll") for(int d_=0;d_<2;++d_) _Pragma("unroll") for(int r=0;r<16;++r)o[d_][r]*=wsf[crow(r,hi)]; } }while(0)
  f32x16 pA0,pA1,pB0,pB1;
  int sl_prev=0,sl_cur=0,sl_next=SLOTB;
  #define ROT() do{sl_prev=sl_cur;sl_cur=sl_next;sl_next=(sl_next==(NSLOT-1)*SLOTB)?0:sl_next+SLOTB;}while(0)
  DMA_K(2,2*SLOTB);
  WAIT_BAR(3);
  qkt(pA0,pA1,Kbase,qr,r32,hi);asm volatile("s_nop 15\n\ts_nop 7":"+v"(pA0),"+v"(pA1));CMASK(pA0,pA1,0);
  START(pA0,pA1);
  _Pragma("unroll") for(int r=0;r<16;++r)pA1[r]=__builtin_amdgcn_exp2f(pA1[r]);
  WAIT_BAR(0);
  DMA_K(3,0);DMA_V(1,SLOTB);
  ROT();
  kload8(kf,kp0+sl_cur);
  WAIT_BAR(2);
  s16x4 vlo[8],vhi[8]; u32x4 pw0,pw1,pw2,pw3;
  #define PKW(P,B) cvtpk_s(P[B],P[B+1])
  #define PAF(k) __builtin_bit_cast(bf16x8,pw##k)
  #define VFR(i) (bf16x8){vlo[i][0],vlo[i][1],vlo[i][2],vlo[i][3],vhi[i][0],vhi[i][1],vhi[i][2],vhi[i][3]}
  #define PIN(x) asm volatile("":"+v"(x))
  #define MX3(a,b,c) __builtin_fmaxf(__builtin_fmaxf((a),(b)),(c))
  #define GAPA(MF,A0,A1,A2,A3,W0,W1,PW) do{ MF; sacc+=A0; sacc+=A1; sacc+=A2; sacc+=A3; PIN(sacc); W0; W1; PIN(PW); SBAR(); }while(0)
  #define EX(v) __builtin_amdgcn_exp2f(v)
  #define GAPB(MF,X,B) do{ MF; X[B]=EX(X[B]); X[B+1]=EX(X[B+1]); X[B+2]=EX(X[B+2]); X[B+3]=EX(X[B+3]); PIN(X); SBAR(); }while(0)
  #define VRD(i) do{ vlo[i]=vtr(vp_+(((i)>>2)*4096+((i)&3)*1024)); vhi[i]=vtr(vp_+(((i)>>2)*4096+((i)&3)*1024+512)); }while(0)
  #define KRD(G,j) do{ if(G){ kload2(kf,kp0+sl_next,j); SBAR(); } }while(0)
  #define STEP(C0,C1,P0,P1,t,GK,GV,GL) do{ SBAR(); \
    const lds_cptr vp_=vp0+sl_prev; \
    VRD(0); SBAR(); float sacc=(P0[0]+P0[1]); \
    GAPA(C0=__builtin_amdgcn_mfma_f32_32x32x16_bf16(kf[0],qr[0],f32x16{},0,0,0), P0[2],P0[3],P0[4],P0[5],     pw0[0]=PKW(P0,0), pw0[1]=PKW(P0,2), pw0); \
    VRD(4); SBAR(); GAPA(C1=__builtin_amdgcn_mfma_f32_32x32x16_bf16(kf[1],qr[0],f32x16{},0,0,0), P0[6],P0[7],P0[8],P0[9],     pw0[2]=PKW(P0,4), pw0[3]=PKW(P0,6), pw0); \
    VRD(1); SBAR(); GAPA(C0=__builtin_amdgcn_mfma_f32_32x32x16_bf16(kf[2],qr[1],C0,0,0,0),   P0[10],P0[11],P0[12],P0[13], pw1[0]=PKW(P0,8), pw1[1]=PKW(P0,10), pw1); \
    VRD(5); SBAR(); GAPA(C1=__builtin_amdgcn_mfma_f32_32x32x16_bf16(kf[3],qr[1],C1,0,0,0),   P0[14],P0[15],P1[0],P1[1],   pw1[2]=PKW(P0,12),pw1[3]=PKW(P0,14), pw1); \
    VRD(2); SBAR(); GAPA(C0=__builtin_amdgcn_mfma_f32_32x32x16_bf16(kf[4],qr[2],C0,0,0,0),   P1[2],P1[3],P1[4],P1[5],     pw2[0]=PKW(P1,0), pw2[1]=PKW(P1,2), pw2); \
    VRD(6); SBAR(); GAPA(C1=__builtin_amdgcn_mfma_f32_32x32x16_bf16(kf[5],qr[2],C1,0,0,0),   P1[6],P1[7],P1[8],P1[9],     pw2[2]=PKW(P1,4), pw2[3]=PKW(P1,6), pw2); \
    VRD(3); SBAR(); GAPA(C0=__builtin_amdgcn_mfma_f32_32x32x16_bf16(kf[6],qr[3],C0,0,0,0),   P1[10],P1[11],P1[12],P1[13], pw3[0]=PKW(P1,8), pw3[1]=PKW(P1,10), pw3); \
    VRD(7); SBAR(); GAPA(C1=__builtin_amdgcn_mfma_f32_32x32x16_bf16(kf[7],qr[3],C1,0,0,0),   P1[14],P1[15],0.f,0.f,       pw3[2]=PKW(P1,12),pw3[3]=PKW(P1,14), pw3); \
    l_reg+=sacc; \
    if(GK){DMA_K((t)+3,sl_cur);} if(GV){DMA_V((t)+1,sl_next);} \
    CMASK(C0,C1,t); \
    _Pragma("unroll") for(int r=0;r<16;++r){C0[r]-=mhat;C1[r]-=mhat;} \
    { float a=MX3(C0[0],C0[1],C1[0]),b=MX3(C0[2],C0[3],C1[1]); a=MX3(a,C1[2],C1[3]); \
      _Pragma("unroll") for(int r=4;r<16;r+=4){a=MX3(a,C0[r],C0[r+1]);b=MX3(b,C0[r+2],C0[r+3]);a=MX3(a,C1[r],C1[r+1]);b=MX3(b,C1[r+2],C1[r+3]);} \
      float rm=__builtin_fmaxf(a,b); { auto rr=__builtin_amdgcn_permlane32_swap(__float_as_uint(rm),__float_as_uint(rm),false,false); rm=__builtin_fmaxf(__uint_as_float(rr[0]),__uint_as_float(rr[1])); } \
      resc=false; \
      if(__builtin_expect(__any(rm>(float)THRL),0)){ const float dl=__builtin_fmaxf(rm,0.f); mhat+=dl; \
        _Pragma("unroll") for(int r=0;r<16;++r){C0[r]-=dl;C1[r]-=dl;} \
        const float f=__builtin_amdgcn_exp2f(-dl); l_reg*=f; if(hi==0)wsf[r32]=f; resc=true; } } \
    SBAR(); \
    GAPB(o[0]=__builtin_amdgcn_mfma_f32_32x32x16_bf16(PAF(0),VFR(0),o[0],0,0,0), C0,0); \
    GAPB(o[1]=__builtin_amdgcn_mfma_f32_32x32x16_bf16(PAF(0),VFR(4),o[1],0,0,0), C0,4); \
    KRD(GL,0); GAPB(o[0]=__builtin_amdgcn_mfma_f32_32x32x16_bf16(PAF(1),VFR(1),o[0],0,0,0), C0,8); \
    KRD(GL,1); GAPB(o[1]=__builtin_amdgcn_mfma_f32_32x32x16_bf16(PAF(1),VFR(5),o[1],0,0,0), C0,12); \
    KRD(GL,2); GAPB(o[0]=__builtin_amdgcn_mfma_f32_32x32x16_bf16(PAF(2),VFR(2),o[0],0,0,0), C1,0); \
    KRD(GL,3); GAPB(o[1]=__builtin_amdgcn_mfma_f32_32x32x16_bf16(PAF(2),VFR(6),o[1],0,0,0), C1,4); \
    GAPB(o[0]=__builtin_amdgcn_mfma_f32_32x32x16_bf16(PAF(3),VFR(3),o[0],0,0,0), C1,8); \
    GAPB(o[1]=__builtin_amdgcn_mfma_f32_32x32x16_bf16(PAF(3),VFR(7),o[1],0,0,0), C1,12); \
    }while(0)
  int t=1;
  for(;t+5<NT;t+=2){
    STEP(pB0,pB1,pA0,pA1,t,true,true,true);     WAIT_BAR(2); RESC(); ROT();
    STEP(pA0,pA1,pB0,pB1,t+1,true,true,true);   WAIT_BAR(2); RESC(); ROT();
  }
  #define ENDW(tt) do{ if((tt)+3<NT){WAIT_BAR(2);} else if((tt)+2<NT){WAIT_BAR(1);} else {WAIT_BAR(0);} }while(0)
  for(;t+1<NT;t+=2){
    STEP(pB0,pB1,pA0,pA1,t,(t+3<NT),(t+1<NT),(t+1<NT));       ENDW(t);   RESC(); ROT();
    STEP(pA0,pA1,pB0,pB1,t+1,(t+4<NT),(t+2<NT),(t+2<NT));     ENDW(t+1); RESC(); ROT();
  }
  STEP(pB0,pB1,pA0,pA1,NT-1,false,false,false); RESC();
  { float sacc=pB0[0]+pB0[1]; _Pragma("unroll") for(int r=2;r<16;++r)sacc+=pB0[r]; _Pragma("unroll") for(int r=0;r<16;++r)sacc+=pB1[r]; l_reg+=sacc;
    pw0=(u32x4){PKW(pB0,0),PKW(pB0,2),PKW(pB0,4),PKW(pB0,6)};pw1=(u32x4){PKW(pB0,8),PKW(pB0,10),PKW(pB0,12),PKW(pB0,14)};pw2=(u32x4){PKW(pB1,0),PKW(pB1,2),PKW(pB1,4),PKW(pB1,6)};pw3=(u32x4){PKW(pB1,8),PKW(pB1,10),PKW(pB1,12),PKW(pB1,14)};
    SBAR(); pv(o,(int)(unsigned)(size_t)vp0+sl_cur,PAF(0),PAF(1),PAF(2),PAF(3)); }
  #undef PKW
  #undef PAF
  #undef VFR
  #undef PIN
  #undef MX3
  #undef GAPA
  #undef GAPB
  #undef EX
  #undef VRD
  #undef KRD
  #undef STEP
  #undef ENDW
  {auto rr=__builtin_amdgcn_permlane32_swap(__float_as_uint(l_reg),__float_as_uint(l_reg),false,false);l_reg=__uint_as_float(rr[0])+__uint_as_float(rr[1]);}
  if(hi==0)wsf[32+r32]=l_reg;asm volatile("s_waitcnt lgkmcnt(0)":::"memory");
  float rli[16];
  #pragma unroll
  for(int r=0;r<16;++r)rli[r]=__builtin_amdgcn_rcpf(wsf[32+crow(r,hi)]);
  bf16*Ow=O+(rowbase+q0+wid*QBLK)*OP+h*D;
  { bf16*stg=(bf16*)(shm+LDS_OST)+wid*2048;
    #pragma unroll
    for(int r=0;r<16;++r){const int orow=crow(r,hi);
      #pragma unroll
      for(int d0=0;d0<2;++d0)stg[orow*64+d0*32+r32]=__float2bfloat16(o[d0][r]*rli[r]);}
    asm volatile("s_waitcnt lgkmcnt(0)":::"memory");
    #pragma unroll
    for(int i=0;i<4;++i){const int row=i*8+(lane>>3),ch=lane&7; const u32x4 v=*(const u32x4*)(stg+row*64+ch*8); ATTN_STORE16(Ow+(long)row*OP+ch*8,v);} }
  asm volatile("s_waitcnt lgkmcnt(0)\n\ts_barrier":::"memory");
  #undef DMA_K
  #undef DMA_V
  #undef TI
  #undef CMASK
  #undef START
  #undef RESC
  #undef ROT
}
constexpr int ATTN_LDS_BYTES=LDS_BYTES;
#undef SBAR
#undef WAIT_BAR
}
#undef LAS
constexpr int NB = DEBUG_BUILD ? 2 : 8;
constexpr int M_ = NB * SEQ;
constexpr int NSLOT = 2 * M_ + N_EXP * 256;
constexpr int PLD = 3072;
constexpr int FQ = 0, FK = 384, FV = 768, FZ = 1152, FGU = 1536, FGV = 1792, FXBC = 2048, FDT = 2944;
constexpr int NGU = 2 * D_FF, NGUE = 2 * D_FFE;

constexpr size_t al256(size_t x) { return (x + 255) & ~(size_t)255; }
constexpr size_t MiB = 1u << 20;
constexpr size_t O_CTL = 0, CTL_BYTES = 1 * MiB;
constexpr size_t O_RT = 1 * MiB;
constexpr size_t O_TE = O_RT + (size_t)M_ * 64, O_TP = O_TE + (size_t)M_ * 8, O_TS = O_TP + (size_t)M_ * 8, O_GS = O_TS + (size_t)M_ * 8;
constexpr size_t O_SP = O_GS + (size_t)M_ * 8;
constexpr size_t O_KM = O_SP + al256((size_t)NSLOT * 4);
constexpr size_t O_DT = O_KM + (size_t)2 * NB * ATT_H * NBLK * 64 * 4;
constexpr size_t O_WSB = al256(O_DT + (size_t)M_ * 24);
constexpr size_t O_HB = (O_WSB + (size_t)2 * GM_G * GM_CHUNK * GM_CHUNK * 2 + MiB - 1) / MiB * MiB;
constexpr size_t O_MWGU = O_HB + (size_t)M_ * DM * 2;
constexpr size_t O_WIN = O_MWGU + (size_t)N_EXP * NGUE * DM * 2;
constexpr size_t O_WOUT = O_WIN + (size_t)2 * PLD * DM * 2;
constexpr size_t O_WGU = O_WOUT + (size_t)2 * DM * DM * 2;
constexpr size_t O_WD = O_WGU + (size_t)NGU * DM * 2;
constexpr size_t O_SCR = O_WD + (size_t)DM * D_FF * 2;
constexpr size_t O_PROJ = O_SCR;
constexpr size_t O_XC = O_PROJ + (size_t)M_ * PLD * 2;
constexpr size_t O_MIXU = O_XC + (size_t)M_ * SSD_CW * 2;
constexpr size_t O_MIXB = O_MIXU + (size_t)M_ * DM * 4;
constexpr size_t O_VN = O_MIXB + (size_t)M_ * DM * 2;
constexpr size_t O_MIXEND = O_VN + (size_t)M_ * GM_W * 4;
constexpr size_t O_Y = O_SCR;
constexpr size_t O_ACT = O_Y + (size_t)M_ * DM * 4;
constexpr size_t O_XG = O_WIN;
constexpr size_t O_ACTM = O_XG + (size_t)NSLOT * DM * 2;
constexpr size_t O_MOEEND = O_ACTM + (size_t)NSLOT * D_FFE * 2;
constexpr size_t WS_END = O_MOEEND > O_MIXEND ? O_MOEEND : O_MIXEND;
static_assert(O_ACT + (size_t)M_ * D_FF * 2 <= O_MIXEND + (size_t)M_ * 4096, "act");
static_assert((size_t)NB * 16 * SSD_H * 8192 * 4 <= (size_t)M_ * SSD_CW * 2, "SSD states fit in the XC slot");
static_assert((size_t)NB * 32 * 768 * 4 <= (size_t)M_ * GM_W * 4, "dt/acum hand-off fits in the VN slot");
static_assert(WS_END <= 487000000ull, "workspace map exceeds the guaranteed size");
static_assert((size_t)N_EXP * DM * D_FFE * 2 <= (size_t)NBATCH * SEQ * DM * 4, "MWD fits in d_out");
constexpr int CW_BAR = 4096, CW_CNT = 1024, CW_Q = 1040, CW_ERR = 2048;

constexpr int RING_BYTES = 131072, MISC_OFF = RING_BYTES + 320, LDS_BYTES = 147456;

#define GAS __attribute__((address_space(1)))
#define LAS __attribute__((address_space(3)))
typedef GAS unsigned gu32;
#define RLX_AGENT __ATOMIC_RELAXED, __HIP_MEMORY_SCOPE_AGENT
#define LDS_WAIT() asm volatile("s_waitcnt lgkmcnt(0)" ::: "memory")

constexpr float QSCALE = 0.125f * 1.4426950408889634f;
constexpr int TAIL_SLOTS = 16 * 256;
namespace fp {
using pg8::Unit; using pg8::BM; using pg8::HALF; typedef pg8::f32x4 f32x4; typedef pg8::u32x4 u32x4;
__device__ __forceinline__ unsigned pk2(float lo, float hi) { return pg8::cvt_pk_bf16(lo, hi); }
__device__ __forceinline__ float gelu_fast(float x) { const float u = 0.7978845608028654f * (x + 0.044715f * x * x * x); return x / (1.f + __expf(-2.f * u)); }

struct EpiProj {
    static constexpr bool PERM = true, AFTER_DRAIN = false;
    bf16* O; const float* RT; float* KM2;
    __device__ __forceinline__ void operator()(const f32x4 (&acc)[2][2][4][2], const Unit& u, int wr, int wc, int fr, int fq) const {
        const int row0 = u.pm * BM + wr * 64 + fr, col0 = u.pn * BM + wc * 32 + 8 * fq;
        f32x4 ks[2][2];
#pragma unroll
        for (int i = 0; i < 2; ++i) { ks[i][0] = (f32x4){0.f, 0.f, 0.f, 0.f}; ks[i][1] = ks[i][0]; }
        const int mode = (u.pn < 3) ? 1 : ((u.pn == 6 || u.pn == 7) ? 2 : 0);
        const bool rl = ((wc & 1) == 0) && (fq < 2);
        const int i0 = (fq & 1) * 4;
#pragma unroll
        for (int ai = 0; ai < 2; ++ai)
#pragma unroll
            for (int m = 0; m < 4; ++m) { const int row = row0 + ai * HALF + m * 16;
                float4 c4 = make_float4(1.f, 1.f, 1.f, 1.f), s4 = make_float4(0.f, 0.f, 0.f, 0.f);
                if (mode == 1 && rl) { c4 = *(const float4*)(RT + (size_t)row * 16 + i0); s4 = *(const float4*)(RT + (size_t)row * 16 + 8 + i0); }
#pragma unroll
                for (int bj = 0; bj < 2; ++bj) { f32x4 v0 = acc[ai][bj][m][0], v1 = acc[ai][bj][m][1];
                    if (mode == 1) { const f32x4 a = v0, b = v1;
                        v0[0] = a[0] * c4.x - a[1] * s4.x; v0[1] = a[1] * c4.x + a[0] * s4.x; v0[2] = a[2] * c4.y - a[3] * s4.y; v0[3] = a[3] * c4.y + a[2] * s4.y;
                        v1[0] = b[0] * c4.z - b[1] * s4.z; v1[1] = b[1] * c4.z + b[0] * s4.z; v1[2] = b[2] * c4.w - b[3] * s4.w; v1[3] = b[3] * c4.w + b[2] * s4.w; }
                    if (u.pn == 0 || (u.pn == 1 && bj == 0)) { v0 = v0 * QSCALE; v1 = v1 * QSCALE; }
                    else if (mode == 1) { ks[bj][0] += v0; ks[bj][1] += v1; }
                    if (mode == 2) {
#pragma unroll
                        for (int j = 0; j < 4; ++j) { v0[j] = gelu_fast(v0[j]); v1[j] = gelu_fast(v1[j]); } }
                    u32x4 w; w.x = pk2(v0[0], v0[1]); w.y = pk2(v0[2], v0[3]); w.z = pk2(v1[0], v1[1]); w.w = pk2(v1[2], v1[3]);
                    *(u32x4*)(O + (size_t)row * PLD + col0 + bj * HALF) = w; } }
        if (u.pn == 1 || u.pn == 2) {
#pragma unroll
            for (int bj = 0; bj < 2; ++bj) { if (u.pn == 1 && bj == 0) continue;
#pragma unroll
                for (int n = 0; n < 2; ++n)
#pragma unroll
                    for (int j = 0; j < 4; ++j) { float x = ks[bj][n][j]; x += __shfl_xor(x, 1); x += __shfl_xor(x, 2); x += __shfl_xor(x, 4); x += __shfl_xor(x, 8); ks[bj][n][j] = x * (1.f / 256.f); }
                if (fr == 0) { const int kc = col0 + bj * HALF - FK; const int b = u.pm >> 3, nb = u.pm & 7;
                    float* dst = KM2 + (size_t)wr * (NB * ATT_H * NBLK * 64) + ((size_t)(b * ATT_H + (kc >> 6)) * NBLK + nb) * 64 + (kc & 63);
                    *(f32x4*)dst = ks[bj][0]; *(f32x4*)(dst + 4) = ks[bj][1]; } }
        }
    }
};
struct EpiAct {
    static constexpr bool PERM = true, AFTER_DRAIN = false;
    bf16* O; int ldc, ncol;
    __device__ __forceinline__ void operator()(const f32x4 (&acc)[2][2][4][2], const Unit& u, int wr, int wc, int fr, int fq) const {
        const int row0 = u.pm * BM + wr * 64 + fr, col0 = (u.pn % ncol) * HALF + wc * 32 + 8 * fq;
#pragma unroll
        for (int ai = 0; ai < 2; ++ai)
#pragma unroll
            for (int m = 0; m < 4; ++m) { const int row = row0 + ai * HALF + m * 16;
                const f32x4 g0 = acc[ai][0][m][0], g1 = acc[ai][0][m][1], u0 = acc[ai][1][m][0], u1 = acc[ai][1][m][1]; f32x4 a0, a1;
#pragma unroll
                for (int j = 0; j < 4; ++j) { a0[j] = g0[j] / (1.f + __expf(-g0[j])) * u0[j]; a1[j] = g1[j] / (1.f + __expf(-g1[j])) * u1[j]; }
                u32x4 w; w.x = pk2(a0[0], a0[1]); w.y = pk2(a0[2], a0[3]); w.z = pk2(a1[0], a1[1]); w.w = pk2(a1[2], a1[3]);
                *(u32x4*)(O + (size_t)row * ldc + col0) = w; }
    }
};
struct EpiF32 {
    static constexpr bool PERM = false, AFTER_DRAIN = false;
    float* O; int ldc;
    __device__ __forceinline__ void operator()(const f32x4 (&acc)[2][2][4][2], const Unit& u, int wr, int wc, int fr, int fq) const {
        const int row0 = u.pm * BM + wr * 64 + fr, col0 = u.pn * BM + wc * 32 + 4 * fq;
#pragma unroll
        for (int ai = 0; ai < 2; ++ai)
#pragma unroll
            for (int m = 0; m < 4; ++m) { float* rp = O + (size_t)(row0 + ai * HALF + m * 16) * ldc + col0;
#pragma unroll
                for (int bj = 0; bj < 2; ++bj)
#pragma unroll
                    for (int n = 0; n < 2; ++n) *(f32x4*)(rp + bj * HALF + n * 16) = acc[ai][bj][m][n]; }
    }
};
struct EpiY {
    static constexpr bool PERM = true, AFTER_DRAIN = false;
    bf16* O; int ldc;
    __device__ __forceinline__ void operator()(const f32x4 (&acc)[2][2][4][2], const Unit& u, int wr, int wc, int fr, int fq) const {
        const int row0 = u.pm * BM + wr * 64 + fr, col0 = u.pn * BM + wc * 32 + 8 * fq;
#pragma unroll
        for (int ai = 0; ai < 2; ++ai)
#pragma unroll
            for (int m = 0; m < 4; ++m) { bf16* rp = O + (size_t)(row0 + ai * HALF + m * 16) * ldc + col0;
#pragma unroll
                for (int bj = 0; bj < 2; ++bj) { const f32x4 v0 = acc[ai][bj][m][0], v1 = acc[ai][bj][m][1];
                    u32x4 w; w.x = pk2(v0[0], v0[1]); w.y = pk2(v0[2], v0[3]); w.z = pk2(v1[0], v1[1]); w.w = pk2(v1[2], v1[3]);
                    *(u32x4*)(rp + bj * HALF) = w; } }
    }
};
struct EpiF2 {
    static constexpr bool PERM = true, AFTER_DRAIN = false;
    bf16* O; const float* SP; bf16* FP; int slot0, klen;
    __device__ __forceinline__ void operator()(const f32x4 (&acc)[2][2][4][2], const Unit& u, int wr, int wc, int fr, int fq) const {
        const int row0 = u.pm * BM + wr * 64 + fr, col0 = (u.pn & 3) * BM + wc * 32 + 8 * fq;
        bf16* base = O; int rsub = 0;
        if (u.kofs > 0) { const int part = u.kofs / klen; base = FP + (size_t)(part - 1) * TAIL_SLOTS * DM; rsub = slot0; }
#pragma unroll
        for (int ai = 0; ai < 2; ++ai)
#pragma unroll
            for (int m = 0; m < 4; ++m) { const int row = row0 + ai * HALF + m * 16; const float sc = SP[row];
#pragma unroll
                for (int bj = 0; bj < 2; ++bj) { const f32x4 v0 = acc[ai][bj][m][0] * sc, v1 = acc[ai][bj][m][1] * sc;
                    u32x4 w; w.x = pk2(v0[0], v0[1]); w.y = pk2(v0[2], v0[3]); w.z = pk2(v1[0], v1[1]); w.w = pk2(v1[2], v1[3]);
                    *(u32x4*)(base + (size_t)(row - rsub) * DM + col0 + bj * HALF) = w; } }
    }
};
struct MoeOrder {
    int p0, p1, p2, p3, p4, p5, p6, T, ncol, G, c, nfull, ksplit, klen;
    __device__ __forceinline__ void init(const int* CNT, int ncol_, int G_, int c_) {
        int t = 0; t += (CNT[0] + 255) >> 8; p0 = t; t += (CNT[1] + 255) >> 8; p1 = t; t += (CNT[2] + 255) >> 8; p2 = t; t += (CNT[3] + 255) >> 8; p3 = t;
        t += (CNT[4] + 255) >> 8; p4 = t; t += (CNT[5] + 255) >> 8; p5 = t; t += (CNT[6] + 255) >> 8; p6 = t; t += (CNT[7] + 255) >> 8; T = t; ncol = ncol_; G = G_; c = c_;
        nfull = T * ncol; ksplit = 1; klen = 0;
    }
    __device__ __forceinline__ int tail_start() const { const int tot = T * ncol, nf = (tot / G) * G; return (tot - nf <= 64) ? nf : tot; }
    __device__ __forceinline__ bool next(int i, Unit& u) const {
        long L = (long)i * G + c; int part = 0;
        if (ksplit == 1) { if (L >= nfull) return false; }
        else { if (L >= (long)(T * ncol - nfull) * ksplit) return false; part = (int)(L % ksplit); L = nfull + L / ksplit; }
        const int tm = (int)(L / ncol), j = (int)(L % ncol);
        const int e = (tm >= p0) + (tm >= p1) + (tm >= p2) + (tm >= p3) + (tm >= p4) + (tm >= p5) + (tm >= p6);
        u.pm = tm; u.pn = e * ncol + j; u.kofs = part * klen; return true;
    }
    __device__ __forceinline__ void a_ready(const Unit&) const {}
    __device__ __forceinline__ void done(const Unit&) const {}
};

struct SrcCol { const float* p; int ld; };
__device__ __forceinline__ int win_src_col(int d) {
    if (d < 768) { const int hd = d & 63; const int sd = hd < 16 ? ((hd & 1) ? 8 + (hd >> 1) : (hd >> 1)) : hd; return d - hd + sd; }
    if (d < 1536) return d;
    if (d < 1792) return 2438 + (d - 1536);
    if (d < 2048) return 2694 + (d - 1792);
    if (d < 2944) return 1536 + (d - 2048);
    if (d < 2950) return 2432 + (d - 2944);
    return -1;
}
__device__ __forceinline__ SrcCol gu_src(const float* wg, const float* wu, int nff, int r) {
    const int tile = r >> 8, rr = r & 255, j = tile * 128 + (rr & 127); SrcCol s; s.p = (rr < 128 ? wg : wu) + j; s.ld = nff; return s;
}
__device__ __forceinline__ void conv_item(SrcCol sc, int K, bf16* WT, long d0, int k0, LAS float* scr, int lane) {
    float tv[32];
#pragma unroll
    for (int i = 0; i < 32; ++i) { const int kk = 2 * i + (lane >> 5); tv[i] = sc.p ? sc.p[(size_t)(k0 + kk) * sc.ld] : 0.f; }
#pragma unroll
    for (int i = 0; i < 32; ++i) { const int kk = 2 * i + (lane >> 5); scr[kk * 33 + (lane & 31)] = tv[i]; }
    LDS_WAIT(); asm volatile("" ::: "memory");
    const int c = lane & 7;
#pragma unroll
    for (int j = 0; j < 4; ++j) { const int n = (lane >> 3) + 8 * j; const LAS float* s = scr + (8 * c) * 33 + n;
        u32x4 o; o.x = pk2(s[0 * 33], s[1 * 33]); o.y = pk2(s[2 * 33], s[3 * 33]); o.z = pk2(s[4 * 33], s[5 * 33]); o.w = pk2(s[6 * 33], s[7 * 33]);
        *(u32x4*)(WT + (size_t)(d0 + n) * K + k0 + 8 * c) = o; }
    LDS_WAIT(); asm volatile("" ::: "memory");
}
}


typedef short bf16x8_t __attribute__((ext_vector_type(8)));
typedef float f32x4_t __attribute__((ext_vector_type(4)));
constexpr int TLD = 272;
__device__ __forceinline__ bf16x8_t lds_frag(const LAS unsigned char* base, int row, int kbyte) { return *(const LAS bf16x8_t*)(base + row * TLD + kbyte); }
__device__ __forceinline__ float red16(float v) { return row16_sum(v); }

__device__ __forceinline__ void gm_unit(int b, int c, const bf16* PROJ, const bf16* WSB  , const float* ln_g, const float* ln_b, const float* b_s, const float* norm_g,
                                        bf16* MIXB, LAS unsigned char* lds, int wave, int lane) {
    const long r0 = (long)b * SEQ + c * GM_CHUNK;
    LAS unsigned char* VNT = lds;
    { float4 vv[16];
#pragma unroll
      for (int i = 0; i < 16; ++i) vv[i] = ld4(PROJ + (r0 + wave * 16 + i) * PLD + FGV + lane * 4);
      const float4 gg = *(const float4*)(ln_g + lane * 4), bb = *(const float4*)(ln_b + lane * 4);
#pragma unroll
      for (int i = 0; i < 16; ++i) { const int t = wave * 16 + i; const float4 v = vv[i];
        const float mean = wave_sum((v.x + v.y) + (v.z + v.w)) * (1.f / 256.f);
        const float d0 = v.x - mean, d1 = v.y - mean, d2 = v.z - mean, d3 = v.w - mean;
        const float rstd = rsqrtf(wave_sum((d0 * d0 + d1 * d1) + (d2 * d2 + d3 * d3)) * (1.f / 256.f) + 1e-5f);
        LAS bf16* dst = (LAS bf16*)(VNT + (lane * 4) * TLD) + t;
        dst[0] = (bf16)f2bf(d0 * rstd * gg.x + bb.x); dst[TLD / 2] = (bf16)f2bf(d1 * rstd * gg.y + bb.y); dst[TLD] = (bf16)f2bf(d2 * rstd * gg.z + bb.z); dst[3 * TLD / 2] = (bf16)f2bf(d3 * rstd * gg.w + bb.w); } }
    __syncthreads();
    f32x4_t acc[16];
#pragma unroll
    for (int i = 0; i < 16; ++i) acc[i] = (f32x4_t){0.f, 0.f, 0.f, 0.f};
    const int fr = lane & 15, fq = lane >> 4;
    const int nks = (wave * 16 + 15) / 32 + 1;
    for (int ks = 0; ks < nks; ++ks) {
#pragma unroll
        for (int g = 0; g < 4; ++g) {
            const bf16x8_t af = *(const bf16x8_t*)(WSB + ((size_t)g * GM_CHUNK + wave * 16 + fr) * GM_CHUNK + ks * 32 + fq * 8);
#pragma unroll
            for (int n = 0; n < 4; ++n) { const bf16x8_t bfv = lds_frag(VNT, g * 64 + n * 16 + fr, ks * 64 + fq * 16);
                acc[g * 4 + n] = __builtin_amdgcn_mfma_f32_16x16x32_bf16(af, bfv, acc[g * 4 + n], 0, 0, 0); }
        }
    }
    __syncthreads();
    LAS bf16* ost = (LAS bf16*)(lds + wave * (16 * 264 * 2));
    float ss[4] = {0.f, 0.f, 0.f, 0.f};
#pragma unroll
    for (int nt = 0; nt < 16; ++nt) { const int col = nt * 16 + fr, g = nt >> 2;
#pragma unroll
        for (int r = 0; r < 4; ++r) { const int t = wave * 16 + fq * 4 + r;
            const float u = ldf(PROJ + (r0 + t) * PLD + FGU + col);
            const float o = u * (acc[nt][r] + b_s[g * GM_CHUNK + t]); acc[nt][r] = o; ss[r] += o * o; } }
#pragma unroll
    for (int r = 0; r < 4; ++r) ss[r] = rsqrtf(red16(ss[r]) * (1.f / 256.f) + 1e-5f);
#pragma unroll
    for (int nt = 0; nt < 16; ++nt) { const int col = nt * 16 + fr; const float gn = norm_g[col];
#pragma unroll
        for (int r = 0; r < 4; ++r) { ost[(fq * 4 + r) * 264 + col] = (bf16)f2bf(acc[nt][r] * ss[r] * gn); } }
    LDS_WAIT(); asm volatile("" ::: "memory");
#pragma unroll
    for (int i = 0; i < 8; ++i) { const int rr = i * 2 + (lane >> 5), ch = lane & 31;
        const fp::u32x4 v = *(const LAS fp::u32x4*)(ost + rr * 264 + ch * 8);
        *(fp::u32x4*)(MIXB + (r0 + wave * 16 + rr) * DM + ATT_W + SSD_W + ch * 8) = v; }
    __syncthreads();
}

typedef short v4i16_t __attribute__((ext_vector_type(4)));
typedef unsigned u32x2_t __attribute__((ext_vector_type(2)));
__device__ __forceinline__ v4i16_t lds_tr(const LAS unsigned char* p) { return __builtin_amdgcn_ds_read_tr16_b64_v4i16((LAS v4i16_t*)p); }
__device__ __forceinline__ bf16x8_t lds_frag_tr(const LAS unsigned char* tile, int pitch, int k0, int c0, int lane) {
    const int kg = lane >> 4, q = (lane & 15) >> 2, p = lane & 3;
    const LAS unsigned char* a = tile + (k0 + 8 * kg + q) * pitch + (c0 + 4 * p) * 2;
    const v4i16_t lo = lds_tr(a), hi = lds_tr(a + 4 * pitch);
    return (bf16x8_t){lo[0], lo[1], lo[2], lo[3], hi[0], hi[1], hi[2], hi[3]};
}
__device__ __forceinline__ bf16x8_t lds_frag_p(const LAS unsigned char* base, int pitch, int row, int kbyte) { return *(const LAS bf16x8_t*)(base + row * pitch + kbyte); }
template <int NCH, bool SCALE, bool TOLDS> __device__ __forceinline__ void conv_rows(const bf16* PROJ, long r0, int t0, int colbase, int ch0, const float* cw, const float* cb, LAS unsigned char* tile, int pitch,
                                                                                       const LAS float* scl, bf16* XCg  , int tid) {
    constexpr int CPR = NCH / 8, RG = 512 / CPR, RPT = (128 + RG - 1) / RG;
    if (tid < CPR * RG) { const int ch = (tid % CPR) * 8, l0 = (tid / CPR) * RPT;
        float w[4][8], bs[8];
        { const float4 c0 = *(const float4*)(cb + ch0 + ch), c1 = *(const float4*)(cb + ch0 + ch + 4); bs[0] = c0.x; bs[1] = c0.y; bs[2] = c0.z; bs[3] = c0.w; bs[4] = c1.x; bs[5] = c1.y; bs[6] = c1.z; bs[7] = c1.w; }
#pragma unroll
        for (int i = 0; i < 4; ++i) { const float4 w0 = *(const float4*)(cw + i * SSD_CW + ch0 + ch), w1 = *(const float4*)(cw + i * SSD_CW + ch0 + ch + 4);
            w[i][0] = w0.x; w[i][1] = w0.y; w[i][2] = w0.z; w[i][3] = w0.w; w[i][4] = w1.x; w[i][5] = w1.y; w[i][6] = w1.z; w[i][7] = w1.w; }
        fp::u32x4 xr[RPT + 3];
#pragma unroll
        for (int j = 0; j < RPT + 3; ++j) { const int l = l0 - 3 + j; xr[j] = (fp::u32x4){0u, 0u, 0u, 0u};
            if (l < 128 && t0 + l >= 0) xr[j] = *(const fp::u32x4*)(PROJ + (r0 + l) * PLD + colbase + ch); }
#pragma unroll
        for (int j = 0; j < RPT; ++j) { const int l = l0 + j; if (l < 128) {
            float a[8];
#pragma unroll
            for (int e = 0; e < 8; ++e) a[e] = bs[e];
#pragma unroll
            for (int i = 0; i < 4; ++i) { const fp::u32x4 xv = xr[j + i];
#pragma unroll
                for (int e = 0; e < 4; ++e) { a[2 * e] += w[i][2 * e] * __uint_as_float(xv[e] << 16); a[2 * e + 1] += w[i][2 * e + 1] * __uint_as_float(xv[e] & 0xffff0000u); } }
#pragma unroll
            for (int e = 0; e < 8; ++e) a[e] = a[e] / (1.f + __expf(-a[e]));
            fp::u32x4 o; o.x = fp::pk2(a[0], a[1]); o.y = fp::pk2(a[2], a[3]); o.z = fp::pk2(a[4], a[5]); o.w = fp::pk2(a[6], a[7]);
            *(fp::u32x4*)(XCg + (r0 + l) * SSD_CW + ch) = o;
            if (TOLDS) { if (SCALE) { const float sc = scl[(ch >> 6) * 128 + l]; o.x = fp::pk2(a[0] * sc, a[1] * sc); o.y = fp::pk2(a[2] * sc, a[3] * sc); o.z = fp::pk2(a[4] * sc, a[5] * sc); o.w = fp::pk2(a[6] * sc, a[7] * sc); }
                *(LAS fp::u32x4*)(tile + l * pitch + ch * 2) = o; } } }
    }
}
template <int NCH> __device__ __forceinline__ void load_xc_tile(const bf16* XCg, long r0, LAS unsigned char* tile, int pitch, int tid) {
    constexpr int CPR = NCH / 8;
    for (int it = tid; it < 128 * CPR; it += 512) { const int l = it / CPR, ch = (it % CPR) * 8;
        *(LAS fp::u32x4*)(tile + l * pitch + ch * 2) = *(const fp::u32x4*)(XCg + (r0 + l) * SSD_CW + ch); }
}
__device__ __forceinline__ void ssd_dt_acum(const bf16* PROJ, long r0, int g, const float* dt_bias, const float* a_log, LAS float* dtS, LAS float* acS, int tid, int wave, int lane) {
    if (tid < 384) { const int hh = tid >> 7, l = tid & 127, h = 3 * g + hh;
        const float dtv = softplus_f(ldf(PROJ + (r0 + l) * PLD + FDT + h) + dt_bias[h]); dtS[tid] = dtv; acS[tid] = dtv * (-__expf(a_log[h])); }
    __syncthreads();
    if (wave < 3) { const float a0 = acS[wave * 128 + 2 * lane], a1 = acS[wave * 128 + 2 * lane + 1]; const float sm = a0 + a1; float v = sm;
#pragma unroll
        for (int o = 1; o < 64; o <<= 1) { const float t = __shfl_up(v, o); if (lane >= o) v += t; }
        const float ex = v - sm; acS[wave * 128 + 2 * lane] = ex + a0; acS[wave * 128 + 2 * lane + 1] = ex + sm; }
    __syncthreads();
}
constexpr int XP = 400;
__device__ __forceinline__ void ssdA_unit(int b, int c, int g, const bf16* PROJ, const float* cw, const float* cb, const float* dt_bias, const float* a_log, float* ST, float* CD, bf16* XC, float* DTG,
                                          LAS unsigned char* lds, int tid, int wave, int lane) {
    asm volatile("" : "+v"(tid), "+v"(lane));
    const long r0 = (long)b * SEQ + c * 128; const int t0 = c * 128;
    LAS unsigned char* XS = lds; LAS unsigned char* BS = lds + 51200;
    LAS float* dtS = (LAS float*)(lds + 86016); LAS float* acS = dtS + 384; LAS float* sclS = acS + 384;
    ssd_dt_acum(PROJ, r0, g, dt_bias, a_log, dtS, acS, tid, wave, lane);
    if (tid < 384) { const int hh = tid >> 7; const float al = acS[hh * 128 + 127]; sclS[tid] = dtS[tid] * __expf(al - acS[tid]);
        float* dg = DTG + (((long)b * 16 + c) * 2 + g) * 768; dg[tid] = dtS[tid]; dg[384 + tid] = acS[tid];
        if ((tid & 127) == 0) CD[((long)b * 16 + c) * SSD_H + 3 * g + hh] = __expf(al); }
    __syncthreads();
    conv_rows<192, true, true>(PROJ, r0, t0, FXBC + 192 * g, 192 * g, cw, cb, XS, XP, sclS, XC + 192 * g, tid);
    conv_rows<128, false, true>(PROJ, r0, t0, FXBC + SSD_W + 128 * g, SSD_W + 128 * g, cw, cb, BS, TLD, nullptr, XC + SSD_W + 128 * g, tid);
    conv_rows<128, false, false>(PROJ, r0, t0, FXBC + SSD_W + 256 + 128 * g, SSD_W + 256 + 128 * g, cw, cb, nullptr, 0, nullptr, XC + SSD_W + 256 + 128 * g, tid);
    __syncthreads();
    f32x4_t acc[12];
#pragma unroll
    for (int i = 0; i < 12; ++i) acc[i] = (f32x4_t){0.f, 0.f, 0.f, 0.f};
#pragma unroll 1
    for (int ks = 0; ks < 4; ++ks) { const bf16x8_t bfv = lds_frag_tr(BS, TLD, ks * 32, 16 * wave, lane);
#pragma unroll
        for (int mt = 0; mt < 12; ++mt) { const bf16x8_t af = lds_frag_tr(XS, XP, ks * 32, (mt >> 2) * 64 + (mt & 3) * 16, lane); acc[mt] = __builtin_amdgcn_mfma_f32_16x16x32_bf16(af, bfv, acc[mt], 0, 0, 0); } }
    const int fr = lane & 15, fq = lane >> 4;
    float* sp = ST + (((long)b * 16 + c) * SSD_H + 3 * g) * 8192 + 16 * wave + fr;
#pragma unroll
    for (int mt = 0; mt < 12; ++mt)
#pragma unroll
        for (int r = 0; r < 4; ++r) sp[(mt >> 2) * 8192 + ((mt & 3) * 16 + 4 * fq + r) * 128] = acc[mt][r];
    __syncthreads();
}
__device__ __forceinline__ void ssdB_unit(int b, int c, int g, const bf16* PROJ, const bf16* XC, const float* DTG, const float* dsk, const float* ng,
                                          const float* ST, const float* CD, bf16* MIXB, LAS unsigned char* lds, int tid, int wave, int lane) {
    const long r0 = (long)b * SEQ + c * 128;
    LAS unsigned char* CS = lds; LAS unsigned char* PX = lds + 34816; LAS unsigned char* BG = lds + 87040;
    LAS float* dtS = (LAS float*)(lds + 121856); LAS float* acS = dtS + 384;
    const int fr = lane & 15, fq = lane >> 4;
    if (tid < 384) { const float* dg = DTG + (((long)b * 16 + c) * 2 + g) * 768; dtS[tid] = dg[tid]; acS[tid] = dg[384 + tid]; }
    load_xc_tile<128>(XC + SSD_W + 256 + 128 * g, r0, CS, TLD, tid);
    if (c > 0) {
        float4 pv[12];
#pragma unroll
        for (int i = 0; i < 12; ++i) pv[i] = make_float4(0.f, 0.f, 0.f, 0.f);
        const float* sbase = ST + ((long)b * 16 * SSD_H + 3 * g) * 8192 + tid * 4; const float* cbase = CD + (long)b * 16 * SSD_H + 3 * g;
        int j = 0;
        for (; j + 2 < c; j += 3) { const float* s0 = sbase + (long)j * SSD_H * 8192; const float* c0 = cbase + j * SSD_H;
            float4 v0[12], v1[12], v2[12];
#pragma unroll
            for (int i = 0; i < 12; ++i) { v0[i] = *(const float4*)(s0 + i * 2048); v1[i] = *(const float4*)(s0 + SSD_H * 8192 + i * 2048); v2[i] = *(const float4*)(s0 + 2 * SSD_H * 8192 + i * 2048); }
            float dd[3][3];
#pragma unroll
            for (int q = 0; q < 3; ++q) { dd[q][0] = c0[q * SSD_H]; dd[q][1] = c0[q * SSD_H + 1]; dd[q][2] = c0[q * SSD_H + 2]; }
#pragma unroll
            for (int i = 0; i < 12; ++i) { const int hq = i >> 2;
                pv[i].x = ((pv[i].x * dd[0][hq] + v0[i].x) * dd[1][hq] + v1[i].x) * dd[2][hq] + v2[i].x;
                pv[i].y = ((pv[i].y * dd[0][hq] + v0[i].y) * dd[1][hq] + v1[i].y) * dd[2][hq] + v2[i].y;
                pv[i].z = ((pv[i].z * dd[0][hq] + v0[i].z) * dd[1][hq] + v1[i].z) * dd[2][hq] + v2[i].z;
                pv[i].w = ((pv[i].w * dd[0][hq] + v0[i].w) * dd[1][hq] + v1[i].w) * dd[2][hq] + v2[i].w; } }
        for (; j < c; ++j) { const float* s0 = sbase + (long)j * SSD_H * 8192; const float* c0 = cbase + j * SSD_H; const float d0 = c0[0], d1 = c0[1], d2 = c0[2];
#pragma unroll
            for (int i = 0; i < 12; ++i) { const float4 sv = *(const float4*)(s0 + i * 2048); const float d = (i < 4) ? d0 : ((i < 8) ? d1 : d2);
                pv[i].x = pv[i].x * d + sv.x; pv[i].y = pv[i].y * d + sv.y; pv[i].z = pv[i].z * d + sv.z; pv[i].w = pv[i].w * d + sv.w; } }
#pragma unroll
        for (int i = 0; i < 12; ++i) { const int row = (i >> 2) * 64 + (i & 3) * 16 + (tid >> 5), n = (tid & 31) * 4;
            u32x2_t w; w.x = fp::pk2(pv[i].x, pv[i].y); w.y = fp::pk2(pv[i].z, pv[i].w); *(LAS u32x2_t*)(PX + row * TLD + n * 2) = w; }
    }
    __syncthreads();
    f32x4_t acc_y[12];
#pragma unroll
    for (int i = 0; i < 12; ++i) acc_y[i] = (f32x4_t){0.f, 0.f, 0.f, 0.f};
    if (c > 0) {
#pragma unroll 1
        for (int ks = 0; ks < 4; ++ks) { const bf16x8_t af = lds_frag_p(CS, TLD, 16 * wave + fr, ks * 64 + fq * 16);
#pragma unroll
            for (int t = 0; t < 12; ++t) { const bf16x8_t bfv = lds_frag_p(PX, TLD, (t >> 2) * 64 + (t & 3) * 16 + fr, ks * 64 + fq * 16); acc_y[t] = __builtin_amdgcn_mfma_f32_16x16x32_bf16(af, bfv, acc_y[t], 0, 0, 0); } }
#pragma unroll
        for (int t = 0; t < 12; ++t)
#pragma unroll
            for (int r = 0; r < 4; ++r) acc_y[t][r] *= __expf(acS[(t >> 2) * 128 + 16 * wave + 4 * fq + r]);
    }
    __syncthreads();
    load_xc_tile<192>(XC + 192 * g, r0, PX, XP, tid);
    load_xc_tile<128>(XC + SSD_W + 128 * g, r0, BG, TLD, tid);
    __syncthreads();
#if defined(SSDB_CUT) && SSDB_CUT == 2
    { float t_ = 0.f; for (int i = 0; i < 12; ++i) t_ += acc_y[i][0] + acc_y[i][1] + acc_y[i][2] + acc_y[i][3]; if (t_ == 123.f) MIXB[0] = 1; return; }
#endif
    f32x4_t acc_cb[8];
#pragma unroll
    for (int i = 0; i < 8; ++i) acc_cb[i] = (f32x4_t){0.f, 0.f, 0.f, 0.f};
#pragma unroll 1
    for (int ks = 0; ks < 4; ++ks) { const bf16x8_t af = lds_frag_p(CS, TLD, 16 * wave + fr, ks * 64 + fq * 16);
#pragma unroll
        for (int ns = 0; ns < 8; ++ns) if (ns <= wave) { const bf16x8_t bfv = lds_frag_p(BG, TLD, 16 * ns + fr, ks * 64 + fq * 16); acc_cb[ns] = __builtin_amdgcn_mfma_f32_16x16x32_bf16(af, bfv, acc_cb[ns], 0, 0, 0); } }
    __syncthreads();
    LAS unsigned char* GS = BG + wave * 16 * TLD;
    const int nks = (16 * wave + 15) / 32 + 1;
#pragma unroll
    for (int hh = 0; hh < 3; ++hh) {
#pragma unroll
        for (int ns = 0; ns < 8; ++ns) if (ns <= (wave | 1)) {
#pragma unroll
            for (int r = 0; r < 4; ++r) { const int l = 16 * wave + 4 * fq + r, sidx = 16 * ns + fr;
                const float gv = (ns <= wave && sidx <= l) ? acc_cb[ns][r] * __expf(acS[hh * 128 + l] - acS[hh * 128 + sidx]) * dtS[hh * 128 + sidx] : 0.f;
                *(LAS bf16*)(GS + (4 * fq + r) * TLD + sidx * 2) = (bf16)f2bf(gv); } }
        LDS_WAIT(); asm volatile("" ::: "memory");
#pragma unroll 1
        for (int ks = 0; ks < nks; ++ks) { const bf16x8_t af = lds_frag_p(GS, TLD, fr, ks * 64 + fq * 16);
#pragma unroll
            for (int np = 0; np < 4; ++np) { const bf16x8_t bfv = lds_frag_tr(PX, XP, ks * 32, hh * 64 + np * 16, lane); acc_y[hh * 4 + np] = __builtin_amdgcn_mfma_f32_16x16x32_bf16(af, bfv, acc_y[hh * 4 + np], 0, 0, 0); } }
        LDS_WAIT(); asm volatile("" ::: "memory");
    }
#if defined(SSDB_CUT) && SSDB_CUT == 1
    { float t_ = 0.f; for (int i = 0; i < 12; ++i) t_ += acc_y[i][0] + acc_y[i][1] + acc_y[i][2] + acc_y[i][3]; if (t_ == 123.f) MIXB[0] = 1; return; }
#endif
#pragma unroll
    for (int t = 0; t < 12; ++t) { const int hh = t >> 2, col = hh * 64 + (t & 3) * 16 + fr; const float dk = dsk[3 * g + hh];
#pragma unroll
        for (int r = 0; r < 4; ++r) { const int l = 16 * wave + 4 * fq + r; acc_y[t][r] += dk * __uint_as_float(((unsigned)*(const LAS bf16*)(PX + l * XP + col * 2)) << 16); } }
    __syncthreads();
    LAS bf16* ost = (LAS bf16*)(lds + wave * (16 * XP));
#pragma unroll
    for (int t = 0; t < 12; ++t) { const int col = (t >> 2) * 64 + (t & 3) * 16 + fr;
#pragma unroll
        for (int r = 0; r < 4; ++r) ost[(4 * fq + r) * (XP / 2) + col] = (bf16)f2bf(acc_y[t][r]); }
    LDS_WAIT(); asm volatile("" ::: "memory");
    { const int rr = lane >> 2, q = lane & 3; const long row = r0 + 16 * wave + rr;
      float yz[48]; float ssum = 0.f;
#pragma unroll
      for (int i = 0; i < 6; ++i) { const int c8 = (q * 6 + i) * 8;
          const fp::u32x4 yv = *(const LAS fp::u32x4*)(ost + rr * (XP / 2) + c8);
          const fp::u32x4 zv = *(const fp::u32x4*)(PROJ + row * PLD + FZ + 192 * g + c8);
#pragma unroll
          for (int j = 0; j < 4; ++j) { const unsigned yw = yv[j], zw = zv[j];
              const float y0 = __uint_as_float(yw << 16), y1 = __uint_as_float(yw & 0xffff0000u), z0 = __uint_as_float(zw << 16), z1 = __uint_as_float(zw & 0xffff0000u);
              const float a0 = y0 * (z0 / (1.f + __expf(-z0))), a1 = y1 * (z1 / (1.f + __expf(-z1))); yz[i * 8 + 2 * j] = a0; yz[i * 8 + 2 * j + 1] = a1; ssum += a0 * a0 + a1 * a1; } }
      ssum += __shfl_xor(ssum, 1); ssum += __shfl_xor(ssum, 2);
      const float rinv = rsqrtf(ssum * (1.f / 192.f) + 1e-5f);
#pragma unroll
      for (int i = 0; i < 6; ++i) { const int c8 = (q * 6 + i) * 8;
          const float4 g0 = *(const float4*)(ng + 192 * g + c8), g1 = *(const float4*)(ng + 192 * g + c8 + 4);
          fp::u32x4 o; o.x = fp::pk2(yz[i * 8] * rinv * g0.x, yz[i * 8 + 1] * rinv * g0.y); o.y = fp::pk2(yz[i * 8 + 2] * rinv * g0.z, yz[i * 8 + 3] * rinv * g0.w);
          o.z = fp::pk2(yz[i * 8 + 4] * rinv * g1.x, yz[i * 8 + 5] * rinv * g1.y); o.w = fp::pk2(yz[i * 8 + 6] * rinv * g1.z, yz[i * 8 + 7] * rinv * g1.w);
          *(fp::u32x4*)(MIXB + row * DM + ATT_W + 192 * g + c8) = o; } }
    __syncthreads();
}

__device__ __forceinline__ void att_norm_phase(bf16* MIXB, const float* g, long n_rows, int gw_, int ngw_, int lane) {
    float4 g0 = make_float4(0.f, 0.f, 0.f, 0.f), g1 = g0; if (lane < 48) { g0 = *(const float4*)(g + lane * 8); g1 = *(const float4*)(g + lane * 8 + 4); }
    fp::u32x4 wa = (fp::u32x4){0u, 0u, 0u, 0u}, wb = wa; long r = gw_;
    if (r < n_rows && lane < 48) wa = *(const fp::u32x4*)(MIXB + r * DM + lane * 8);
#define ATTN_NORM_ROW(WV_, rr) do { float v[8]; float s2 = 0.f; \
        _Pragma("unroll") for (int j = 0; j < 4; ++j) { v[2 * j] = __uint_as_float(WV_[j] << 16); v[2 * j + 1] = __uint_as_float(WV_[j] & 0xffff0000u); s2 += v[2 * j] * v[2 * j] + v[2 * j + 1] * v[2 * j + 1]; } \
        const float rs = rsqrtf(wave_sum(s2) * (1.f / 384.f) + 1e-5f); \
        if (lane < 48) { fp::u32x4 o; o.x = fp::pk2(v[0] * rs * g0.x, v[1] * rs * g0.y); o.y = fp::pk2(v[2] * rs * g0.z, v[3] * rs * g0.w); o.z = fp::pk2(v[4] * rs * g1.x, v[5] * rs * g1.y); o.w = fp::pk2(v[6] * rs * g1.z, v[7] * rs * g1.w); \
            *(fp::u32x4*)(MIXB + (rr) * DM + lane * 8) = o; } } while (0)
    for (; r < n_rows; r += 2 * ngw_) { const long r1 = r + ngw_, r2 = r + 2 * ngw_;
        if (r1 < n_rows && lane < 48) wb = *(const fp::u32x4*)(MIXB + r1 * DM + lane * 8);
        ATTN_NORM_ROW(wa, r);
        if (r2 < n_rows && lane < 48) wa = *(const fp::u32x4*)(MIXB + r2 * DM + lane * 8);
        if (r1 < n_rows) ATTN_NORM_ROW(wb, r1); }
#undef ATTN_NORM_ROW
}

constexpr int FT_G = 16 * (N_EXP * NGUE / 32) / 8, FT_D = (D_FFE / 64) * (N_EXP * DM / 32) / 8;
constexpr int FT_G_A = 1408, FT_G_B = 768, FT_D_A = 512, FT_D_D = 768;
__device__ __forceinline__ void filler_g(int t, const float* p_mg, const float* p_mu, bf16* MWGU_, LAS float* scr, int wave, int lane_) {
    asm volatile("" : "+v"(lane_));
    const int r = t * 8 + wave; const int kb = r / (N_EXP * NGUE / 32), db = r % (N_EXP * NGUE / 32); const int d = db * 32 + (lane_ & 31), e = d / NGUE;
    fp::conv_item(fp::gu_src(p_mg + (size_t)e * DM * D_FFE, p_mu + (size_t)e * DM * D_FFE, D_FFE, d - e * NGUE), DM, MWGU_, (long)db * 32, kb * 64, scr, lane_);
}
__device__ __forceinline__ void filler_d(int t, const float* p_md, bf16* MWD_, LAS float* scr, int wave, int lane_) {
    asm volatile("" : "+v"(lane_));
    const int r = t * 8 + wave; const int kb = r / (N_EXP * DM / 32), db = r % (N_EXP * DM / 32); const int d = db * 32 + (lane_ & 31), e = d / DM;
    fp::SrcCol sc_; sc_.p = p_md + (size_t)e * D_FFE * DM + (d - e * DM); sc_.ld = DM; fp::conv_item(sc_, D_FFE, MWD_, (long)db * 32, kb * 64, scr, lane_);
}

struct FArgs { const void* in[29]; float* out; unsigned char* ws; int ph_lo, ph_hi; };
__device__ __forceinline__ const void* ldarg(int k) { const void* p; asm volatile("s_load_dwordx2 %0, %1, %2\n\ts_waitcnt lgkmcnt(0)" : "=s"(p) : "s"(__builtin_amdgcn_kernarg_segment_ptr()), "i"(k * 8)); return p; }

constexpr int N_PHASES = 18;
__global__ void __launch_bounds__(512, 2) mega(FArgs a) {
    extern __shared__ __attribute__((aligned(16))) unsigned char lds_[];
    LAS unsigned char* lds = (LAS unsigned char*)lds_;
    const int wave = __builtin_amdgcn_readfirstlane((int)threadIdx.x >> 6);
#define lane ((int)__builtin_amdgcn_mbcnt_hi(~0u, __builtin_amdgcn_mbcnt_lo(~0u, 0u)))
#define tid (wave * 64 + lane)
    const int G = gridDim.x; const int bx = blockIdx.x;
#define vcu (((int)gridDim.x % 8 == 0) ? ((int)blockIdx.x % 8) * ((int)gridDim.x / 8) + (int)blockIdx.x / 8 : (int)blockIdx.x)
#define gw (vcu * 8 + wave)
#define ngw ((int)gridDim.x * 8)
#define gt ((long)gw * 64 + lane)
#define ngt ((long)ngw * 64)
    unsigned char* ws = a.ws;
    unsigned* ctl = (unsigned*)(ws + O_CTL);
    for (int u = (int)threadIdx.x; u < (LDS_BYTES - RING_BYTES) / 4; u += 512) ((LAS unsigned*)(lds + RING_BYTES))[u] = 0u;
    __syncthreads();
    const int lo = a.ph_lo, hi = a.ph_hi;
    XcdBarrier bar; bar.bar = ctl + CW_BAR; bar.x = 0; bar.st = nullptr; bar.w0 = 0;
    if (hi - lo > 1) bar = xcd_barrier_post(ctl + CW_BAR, (volatile LAS unsigned*)(lds + MISC_OFF) + 8);
#define in_x ((const float*)ldarg(0))
#define in_pos ((const int*)ldarg(1))
#define ln_in_g ((const float*)ldarg(2))
#define ln_in_b ((const float*)ldarg(3))
#define w_in ((const float*)ldarg(4))
#define conv_w ((const float*)ldarg(5))
#define conv_b ((const float*)ldarg(6))
#define dt_bias ((const float*)ldarg(7))
#define a_log ((const float*)ldarg(8))
#define d_skip ((const float*)ldarg(9))
#define ssd_norm_g ((const float*)ldarg(10))
#define att_norm_g ((const float*)ldarg(11))
#define gm_ln_g ((const float*)ldarg(12))
#define gm_ln_b ((const float*)ldarg(13))
#define gm_w_s ((const float*)ldarg(14))
#define gm_b_s ((const float*)ldarg(15))
#define gm_norm_g ((const float*)ldarg(16))
#define w_out ((const float*)ldarg(17))
#define ln1_g ((const float*)ldarg(18))
#define ln1_b ((const float*)ldarg(19))
#define ln2_g ((const float*)ldarg(20))
#define ln2_b ((const float*)ldarg(21))
#define ffn_w_gate ((const float*)ldarg(22))
#define ffn_w_up ((const float*)ldarg(23))
#define ffn_w_down ((const float*)ldarg(24))
#define router_w ((const float*)ldarg(25))
#define moe_w_gate ((const float*)ldarg(26))
#define moe_w_up ((const float*)ldarg(27))
#define moe_w_down ((const float*)ldarg(28))
#define H ((float*)WOUTP)
#define MWD ((bf16*)WOUTP)
#define RT ((float*)(WSP + O_RT))
#define TE ((int*)(WSP + O_TE))
#define TP ((float*)(WSP + O_TP))
#define TS ((int*)(WSP + O_TS))
#define GS ((int*)(WSP + O_GS))
#define SP ((float*)(WSP + O_SP))
#define KM ((float*)(WSP + O_KM))
#define WSB ((bf16*)(WSP + O_WSB))
#define HB ((bf16*)(WSP + O_HB))
#define MWGU ((bf16*)(WSP + O_MWGU))
#define WIN ((bf16*)(WSP + O_WIN))
#define WOUT ((bf16*)(WSP + O_WOUT))
#define WGU ((bf16*)(WSP + O_WGU))
#define WD ((bf16*)(WSP + O_WD))
#define PROJ ((bf16*)(WSP + O_PROJ))
#define ST ((float*)(WSP + O_XC))
#define CD ((float*)(WSP + O_DT))
#define XCB ((bf16*)(WSP + O_MIXU))
#define DTG ((float*)(WSP + O_VN))
#define MIXB ((bf16*)(WSP + O_MIXB))
#define YB ((bf16*)(WSP + O_Y))
#define ACT ((bf16*)(WSP + O_ACT))
#define XG ((bf16*)(WSP + O_XG))
#define F2 ((bf16*)(WSP + O_XG))
#define ACTM ((bf16*)(WSP + O_ACTM))
#define F2P ((bf16*)(WSP + O_MWGU))
#define CNT ((int*)(WSP + O_CTL + 4 * CW_CNT))
    const ProjL FL{PLD, FQ, FK, FV, FZ, FXBC, FDT, FGU, FGV};
    LAS float* scr = (LAS float*)(lds + wave * 16384);

#ifndef PH_MASK
#define PH_MASK 0xffffffffu
#endif
#ifndef PROBE_MASK
#define PROBE_MASK 0u
#endif
#ifndef PROBE_AMP
#define PROBE_AMP 0
#endif
    volatile unsigned* pr_w = (volatile unsigned*)(ctl + 1100);
#define pr_me ((PROBE_MASK != 0u) && blockIdx.x == 0 && wave == 0 && __builtin_amdgcn_mbcnt_hi(~0u, __builtin_amdgcn_mbcnt_lo(~0u, 0u)) == 0u)
#define PH_BEGIN(k) if (lo <= (k) && (k) < hi && ((PH_MASK >> (k)) & 1u)) { unsigned char* WSP = a.ws; unsigned char* WOUTP = (unsigned char*)a.out; asm volatile("" : "+s"(WSP), "+s"(WOUTP)); if (((PROBE_MASK >> (k)) & 1u) && pr_me) pr_w[0] = (unsigned)__builtin_amdgcn_s_memrealtime();
#define PH_END(k)   if ((k) + 1 < hi) xcd_barrier(bar); if (((PROBE_MASK >> (k)) & 1u) && pr_me) pr_w[1] += (unsigned)__builtin_amdgcn_s_memrealtime() - pr_w[0]; }

    PH_BEGIN(0)
    { const float* const p_w_in = w_in; const float* const p_w_out = w_out; const float* const p_fg = ffn_w_gate; const float* const p_fu = ffn_w_up; const float* const p_fd = ffn_w_down;
        constexpr int I_WIN = 16 * (PLD / 32), I_WOUT = 16 * (DM / 32), I_WGU = 16 * (NGU / 32), I_WD = (D_FF / 64) * (DM / 32), I_MWGU = 16 * (N_EXP * NGUE / 32);
        constexpr int NIT = 2 * I_WIN + 2 * I_WOUT + I_WGU + I_WD; (void)I_MWGU;
        for (int it = gw; it < NIT; it += ngw) {
            int r = it; const int l5 = lane & 31;
            if (r < 2 * I_WIN) { const int L = r / I_WIN; r -= L * I_WIN; const int kb = r / (PLD / 32), db = r % (PLD / 32); const int sc_ = fp::win_src_col(db * 32 + l5);
                fp::SrcCol s; s.p = sc_ >= 0 ? p_w_in + (size_t)L * DM * D_IN + sc_ : nullptr; s.ld = D_IN; fp::conv_item(s, DM, WIN + (size_t)L * PLD * DM, db * 32, kb * 64, scr, lane); continue; } r -= 2 * I_WIN;
            if (r < 2 * I_WOUT) { const int L = r / I_WOUT; r -= L * I_WOUT; const int kb = r / (DM / 32), db = r % (DM / 32);
                fp::SrcCol s; s.p = p_w_out + (size_t)L * DM * DM + db * 32 + l5; s.ld = DM; fp::conv_item(s, DM, WOUT + (size_t)L * DM * DM, db * 32, kb * 64, scr, lane); continue; } r -= 2 * I_WOUT;
            if (r < I_WGU) { const int kb = r / (NGU / 32), db = r % (NGU / 32);
                fp::conv_item(fp::gu_src(p_fg, p_fu, D_FF, db * 32 + l5), DM, WGU, db * 32, kb * 64, scr, lane); continue; } r -= I_WGU;
            { const int kb = r / (DM / 32), db = r % (DM / 32);
                fp::SrcCol s; s.p = p_fd + db * 32 + l5; s.ld = DM; fp::conv_item(s, D_FF, WD, db * 32, kb * 64, scr, lane); }
        }
        const int* const p_pos = in_pos; const float* const p_gws = gm_w_s; const float* const p_x = in_x; const float* const p_lg = ln_in_g; const float* const p_lb = ln_in_b;
        for (long it = gt; it < (long)M_ * 8; it += ngt) { const int i = (int)(it & 7); const long row = it >> 3;
            const float inv = powf(500000.0f, -(float)(2 * i) / 16.0f); const float ang = (float)p_pos[row] * inv; RT[row * 16 + i] = cosf(ang); RT[row * 16 + 8 + i] = sinf(ang); }
        for (long it = gt; it < 2L * GM_G * GM_CHUNK * GM_CHUNK; it += ngt) { const int sidx = (int)(it & 127), t = (int)((it >> 7) & 127); WSB[it] = (bf16)(sidx <= t ? f2bf(p_gws[it]) : 0u); }
        { float va[16], vb[16]; LnGB gbp; ln_gb_load(gbp, p_lg, p_lb, lane); long r = gw; if (r < M_) ln_load<float>(va, p_x + r * DM, 1.f, nullptr, nullptr, lane);
          for (; r < M_; r += 2 * ngw) { const long r1 = r + ngw, r2 = r + 2 * ngw;
              if (r1 < M_) ln_load<float>(vb, p_x + r1 * DM, 1.f, nullptr, nullptr, lane);
              ln_finish_r(va, gbp, nullptr, HB + r * DM, lane);
              if (r2 < M_) ln_load<float>(va, p_x + r2 * DM, 1.f, nullptr, nullptr, lane);
              if (r1 < M_) ln_finish_r(vb, gbp, nullptr, HB + r1 * DM, lane); } }
    }
    PH_END(0)


    { constexpr int layer = 0; constexpr int PB = 1;
        PH_BEGIN(PB + 0)
        { pg8::Gemm g{HB, WIN + (size_t)layer * PLD * DM, M_, PLD, DM, DM}; pg8::StaticOrder S; S.init(M_, PLD, G, bx);
          fp::EpiProj E{PROJ, RT, KM}; pg8::gemm_phase<fp::EpiProj, pg8::StaticOrder, true, true>(lds, g, S, E, tid); }
        PH_END(PB + 0)
        PH_BEGIN(PB + 1)
        { constexpr int NATT = NB * ATT_H * NBLK, NSSDA = NB * 32;
          volatile LAS unsigned* qw = (volatile LAS unsigned*)(lds + MISC_OFF) + 16;
#define QNEXT(word) do { if (tid == 0) qw[0] = __hip_atomic_fetch_add(ctl + (word), 1u, __ATOMIC_RELAXED, __HIP_MEMORY_SCOPE_AGENT); __syncthreads(); idx = (int)qw[0]; __syncthreads(); } while (0)
          int idx;
          for (;;) { QNEXT(CW_Q + 8 * layer); if (idx >= NATT) break;
              const int qb = (NBLK - 1) - idx / (NB * ATT_H), bh = idx % (NB * ATT_H);
              attn_body::attn_unit<8>(bh / ATT_H, bh % ATT_H, qb, (const attn_body::bf16*)(PROJ + FQ), (const attn_body::bf16*)(PROJ + FK), (const attn_body::bf16*)(PROJ + FV), (attn_body::bf16*)MIXB, KM, NB * ATT_H * NBLK * 64, (char*)lds_, tid); }
          for (;;) { QNEXT(CW_Q + 8 * layer + 1); if (idx >= NSSDA) break;
              ssdA_unit(idx >> 5, (idx >> 1) & 15, idx & 1, PROJ, conv_w + (size_t)layer * 4 * SSD_CW, conv_b + layer * SSD_CW, dt_bias + layer * SSD_H, a_log + layer * SSD_H, ST, CD, XCB, DTG, lds, tid, wave, lane); }
        }
        PH_END(PB + 1)
        PH_BEGIN(PB + 2)
        { constexpr int NSSDB = NB * 32, NGMU = NB * (SEQ / GM_CHUNK);
          volatile LAS unsigned* qw = (volatile LAS unsigned*)(lds + MISC_OFF) + 16;
          int idx;
          for (;;) { QNEXT(CW_Q + 8 * layer + 2); if (idx >= NSSDB) break;
              const int c = 15 - idx / (NB * 2), bg = idx % (NB * 2);
              ssdB_unit(bg >> 1, c, bg & 1, PROJ, XCB, DTG, d_skip + layer * SSD_H, ssd_norm_g + layer * SSD_W, ST, CD, MIXB, lds, tid, wave, lane); }
          for (;;) { QNEXT(CW_Q + 8 * layer + 3); if (idx >= NGMU) break;
              gm_unit(idx / (SEQ / GM_CHUNK), idx % (SEQ / GM_CHUNK), PROJ, WSB + (size_t)layer * GM_G * GM_CHUNK * GM_CHUNK, gm_ln_g + layer * GM_W, gm_ln_b + layer * GM_W,
                      gm_b_s + layer * GM_G * GM_CHUNK, gm_norm_g + layer * GM_W, MIXB, lds, wave, lane); }
          att_norm_phase(MIXB, att_norm_g + layer * ATT_W, M_, gw, ngw, lane);
          { const float* const p_mg = moe_w_gate; const float* const p_mu = moe_w_up; const float* const p_md = moe_w_down;
            constexpr int g0 = layer == 0 ? 0 : FT_G_A + FT_G_B, g1 = layer == 0 ? FT_G_A : FT_G, d0 = layer == 0 ? 0 : FT_D_A, d1 = layer == 0 ? FT_D_A : FT_D - FT_D_D;
            for (;;) { QNEXT(CW_Q + 8 * layer + 4); if (idx >= g1 - g0) break; filler_g(g0 + idx, p_mg, p_mu, MWGU, scr, wave, lane); }
            for (;;) { QNEXT(CW_Q + 8 * layer + 5); if (idx >= d1 - d0) break; filler_d(d0 + idx, p_md, MWD, scr, wave, lane); } }
#undef QNEXT
        }
        PH_END(PB + 2)
        PH_BEGIN(PB + 3)
        { pg8::Gemm g{MIXB, WOUT + (size_t)layer * DM * DM, M_, DM, DM, DM}; pg8::StaticOrder S; S.init(M_, DM, G, bx);
          fp::EpiY E{YB, DM}; pg8::gemm_phase<fp::EpiY, pg8::StaticOrder, false, true>(lds, g, S, E, tid); }
        PH_END(PB + 3)
        PH_BEGIN(PB + 4)
        { const float* const p_g = ln1_g + layer * DM; const float* const p_b = ln1_b + layer * DM;
          { float va[16], vb[16]; LnGB gbp; ln_gb_load(gbp, p_g, p_b, lane); long r = gw; if (r < M_) ln_load<bf16, bf16>(va, HB + r * DM, ALPHA, YB + r * DM, nullptr, lane);
            for (; r < M_; r += 2 * ngw) { const long r1 = r + ngw, r2 = r + 2 * ngw;
                if (r1 < M_) ln_load<bf16, bf16>(vb, HB + r1 * DM, ALPHA, YB + r1 * DM, nullptr, lane);
                ln_finish_r(va, gbp, nullptr, HB + r * DM, lane);
                if (r2 < M_) ln_load<bf16, bf16>(va, HB + r2 * DM, ALPHA, YB + r2 * DM, nullptr, lane);
                if (r1 < M_) ln_finish_r(vb, gbp, nullptr, HB + r1 * DM, lane); } }
          if (layer == 1) { asm volatile("s_waitcnt vmcnt(0)" ::: "memory"); moe_route_block(HB, router_w, CNT, TE, TP, TS, M_, gw, ngw, lane, wave, tid, (LAS int*)lds); } }
        PH_END(PB + 4)
        if constexpr (layer == 0) {
            PH_BEGIN(PB + 5)
            { pg8::Gemm g{HB, WGU, M_, NGU, DM, DM}; pg8::StaticOrder S; S.init(M_, NGU, G, bx);
              fp::EpiAct E{ACT, D_FF, NGU / 256}; pg8::gemm_phase<fp::EpiAct, pg8::StaticOrder, true, true>(lds, g, S, E, tid);
              { constexpr int UNITS = (NB * SEQ / 256) * (NGU / 256), REM = UNITS % 256;
                if (REM != 0 && G == 256 && bx >= REM) { constexpr int PER = (FT_G_B + (256 - REM) - 1) / (256 - REM); const float* const p_mg = moe_w_gate; const float* const p_mu = moe_w_up;
                    for (int k = 0; k < PER; ++k) { const int t = (bx - REM) * PER + k; if (t < FT_G_B) filler_g(FT_G_A + t, p_mg, p_mu, MWGU, scr, wave, lane); } }
                else if (REM == 0 || G != 256) { const float* const p_mg = moe_w_gate; const float* const p_mu = moe_w_up; for (int t = bx; t < FT_G_B; t += G) filler_g(FT_G_A + t, p_mg, p_mu, MWGU, scr, wave, lane); } } }
            PH_END(PB + 5)
            PH_BEGIN(PB + 6)
            { pg8::Gemm g{ACT, WD, M_, DM, D_FF, D_FF}; pg8::StaticOrder S; S.init(M_, DM, G, bx);
              fp::EpiY E{YB, DM}; pg8::gemm_phase<fp::EpiY, pg8::StaticOrder, false, true>(lds, g, S, E, tid); }
            PH_END(PB + 6)
            PH_BEGIN(PB + 7)
            { const float* const p_g = ln2_g + layer * DM; const float* const p_b = ln2_b + layer * DM;
              { float va[16], vb[16]; LnGB gbp; ln_gb_load(gbp, p_g, p_b, lane); long r = gw; if (r < M_) ln_load<bf16, bf16>(va, HB + r * DM, ALPHA, YB + r * DM, nullptr, lane);
            for (; r < M_; r += 2 * ngw) { const long r1 = r + ngw, r2 = r + 2 * ngw;
                if (r1 < M_) ln_load<bf16, bf16>(vb, HB + r1 * DM, ALPHA, YB + r1 * DM, nullptr, lane);
                ln_finish_r(va, gbp, nullptr, HB + r * DM, lane);
                if (r2 < M_) ln_load<bf16, bf16>(va, HB + r2 * DM, ALPHA, YB + r2 * DM, nullptr, lane);
                if (r1 < M_) ln_finish_r(vb, gbp, nullptr, HB + r1 * DM, lane); } } }
            PH_END(PB + 7)
        } else {
            PH_BEGIN(PB + 5)
            { int base[N_EXP]; { int b_ = 0;
#pragma unroll
                  for (int e = 0; e < N_EXP; ++e) { base[e] = b_; b_ += (CNT[e] + 255) & ~255; } }
              constexpr int RPW = (M_ + 2047) / 2048;
              int te[RPW][2], tsl[RPW][2]; float tpv[RPW][2];
#pragma unroll
              for (int k = 0; k < RPW; ++k) { const long r = gw + (long)k * ngw;
#pragma unroll
                  for (int q = 0; q < 2; ++q) { te[k][q] = 0; tsl[k][q] = 0; tpv[k][q] = 0.f; if (r < M_) { te[k][q] = TE[r * 2 + q]; tsl[k][q] = TS[r * 2 + q]; tpv[k][q] = TP[r * 2 + q]; } } }
#pragma unroll
              for (int k = 0; k < RPW; ++k) { const long r = gw + (long)k * ngw; if (r < M_) {
                  const uint4* src = (const uint4*)(HB + r * DM); const uint4 v0 = src[lane], v1 = src[lane + 64];
#pragma unroll
                  for (int q = 0; q < 2; ++q) { int be = 0;
#pragma unroll
                      for (int x = 0; x < N_EXP; ++x) be = (te[k][q] == x) ? base[x] : be;
                      const int gs = be + tsl[k][q];
                      if (lane == 0) { SP[gs] = tpv[k][q]; GS[r * 2 + q] = gs; }
                      uint4* dst = (uint4*)(XG + (size_t)gs * DM); dst[lane] = v0; dst[lane + 64] = v1; } } }
              for (long r = gw + (long)RPW * ngw; r < M_; r += ngw) {
                  const uint4* src = (const uint4*)(HB + r * DM); const uint4 v0 = src[lane], v1 = src[lane + 64];
                  for (int q = 0; q < 2; ++q) { const long it = r * 2 + q; const int e = TE[it]; int be = 0;
#pragma unroll
                      for (int x = 0; x < N_EXP; ++x) be = (e == x) ? base[x] : be;
                      const int gs = be + TS[it];
                      if (lane == 0) { SP[gs] = TP[it]; GS[it] = gs; }
                      uint4* dst = (uint4*)(XG + (size_t)gs * DM); dst[lane] = v0; dst[lane + 64] = v1; } }
              for (int it = gw; it < N_EXP * 256; it += ngw) { const int e = it >> 8, r = it & 255; const int c = CNT[e]; const int slot = moe_base(CNT, e) + c + r;
                  if (c + r < ((c + 255) & ~255)) { uint4* dst = (uint4*)(XG + (size_t)slot * DM); const uint4 z = make_uint4(0u, 0u, 0u, 0u); dst[lane] = z; dst[lane + 64] = z; if (lane == 0) SP[slot] = 0.f; } } }
            PH_END(PB + 5)
            PH_BEGIN(PB + 6)
            { pg8::Gemm g{XG, MWGU, NSLOT, N_EXP * NGUE, DM, DM}; fp::MoeOrder S; S.init(CNT, NGUE / 256, G, bx);
              fp::EpiAct E{ACTM, D_FFE, NGUE / 256}; pg8::gemm_phase<fp::EpiAct, fp::MoeOrder, true, true>(lds, g, S, E, tid);
              { const int rem = (S.T * S.ncol) % G; const int nidle = rem == 0 ? G : G - rem, first = rem == 0 ? 0 : rem;
                if (bx >= first) { const int per = (FT_D_D + nidle - 1) / nidle; const float* const p_md = moe_w_down;
                    for (int k = 0; k < per; ++k) { const int t = (bx - first) * per + k; if (t < FT_D_D) filler_d(FT_D - FT_D_D + t, p_md, MWD, scr, wave, lane); } } } }
            PH_END(PB + 6)
            PH_BEGIN(PB + 7)
            { fp::MoeOrder S; S.init(CNT, DM / 256, G, bx); const int nf = S.tail_start(); const int slot0 = (nf / (DM / 256)) * 256;
              fp::EpiF2 E{F2, SP, F2P, slot0, D_FFE / 4};
              { pg8::Gemm g{ACTM, MWD, NSLOT, N_EXP * DM, D_FFE, D_FFE}; S.nfull = nf; S.ksplit = 1;
                pg8::gemm_phase<fp::EpiF2, fp::MoeOrder, true, true>(lds, g, S, E, tid); }
              { pg8::Gemm g{ACTM, MWD, NSLOT, N_EXP * DM, D_FFE / 4, D_FFE}; S.ksplit = 4; S.klen = D_FFE / 4;
                int tid2 = tid; asm volatile("" : "+v"(tid2));
                pg8::gemm_phase<fp::EpiF2, fp::MoeOrder, true, true>(lds, g, S, E, tid2); } }
            PH_END(PB + 7)
            PH_BEGIN(PB + 8)
            { const float* const p_g = ln2_g + layer * DM; const float* const p_b = ln2_b + layer * DM;
              int slot0; { fp::MoeOrder S; S.init(CNT, DM / 256, G, bx); const int nf = S.tail_start(); slot0 = (nf == S.T * (DM / 256)) ? 0x7fffffff : (nf / (DM / 256)) * 256; }
#define LN2_LOAD(v, rr) do { const int s0_ = GS[(rr) * 2], s1_ = GS[(rr) * 2 + 1]; ln_load<bf16, bf16>(v, HB + (rr) * DM, ALPHA, F2 + (size_t)s0_ * DM, F2 + (size_t)s1_ * DM, lane); \
                  if (s0_ >= slot0) { _Pragma("unroll") for (int p_ = 0; p_ < 3; ++p_) ln_add(v, F2P + ((size_t)p_ * TAIL_SLOTS + (s0_ - slot0)) * DM, lane); } \
                  if (s1_ >= slot0) { _Pragma("unroll") for (int p_ = 0; p_ < 3; ++p_) ln_add(v, F2P + ((size_t)p_ * TAIL_SLOTS + (s1_ - slot0)) * DM, lane); } } while (0)
              { float va[16], vb[16]; LnGB gbp; ln_gb_load(gbp, p_g, p_b, lane); long r = gw; if (r < M_) LN2_LOAD(va, r);
                for (; r < M_; r += 2 * ngw) { const long r1 = r + ngw, r2 = r + 2 * ngw;
                    if (r1 < M_) LN2_LOAD(vb, r1);
                    ln_finish_r(va, gbp, H + r * DM, nullptr, lane);
                    if (r2 < M_) LN2_LOAD(va, r2);
                    if (r1 < M_) ln_finish_r(vb, gbp, H + r1 * DM, nullptr, lane); } }
#undef LN2_LOAD
            }
            PH_END(PB + 8)
        }
    }

    { constexpr int layer = 1; constexpr int PB = 9;
        PH_BEGIN(PB + 0)
        { pg8::Gemm g{HB, WIN + (size_t)layer * PLD * DM, M_, PLD, DM, DM}; pg8::StaticOrder S; S.init(M_, PLD, G, bx);
          fp::EpiProj E{PROJ, RT, KM}; pg8::gemm_phase<fp::EpiProj, pg8::StaticOrder, true, true>(lds, g, S, E, tid); }
        PH_END(PB + 0)
        PH_BEGIN(PB + 1)
        { constexpr int NATT = NB * ATT_H * NBLK, NSSDA = NB * 32;
          volatile LAS unsigned* qw = (volatile LAS unsigned*)(lds + MISC_OFF) + 16;
#define QNEXT(word) do { if (tid == 0) qw[0] = __hip_atomic_fetch_add(ctl + (word), 1u, __ATOMIC_RELAXED, __HIP_MEMORY_SCOPE_AGENT); __syncthreads(); idx = (int)qw[0]; __syncthreads(); } while (0)
          int idx;
          for (;;) { QNEXT(CW_Q + 8 * layer); if (idx >= NATT) break;
              const int qb = (NBLK - 1) - idx / (NB * ATT_H), bh = idx % (NB * ATT_H);
              attn_body::attn_unit<8>(bh / ATT_H, bh % ATT_H, qb, (const attn_body::bf16*)(PROJ + FQ), (const attn_body::bf16*)(PROJ + FK), (const attn_body::bf16*)(PROJ + FV), (attn_body::bf16*)MIXB, KM, NB * ATT_H * NBLK * 64, (char*)lds_, tid); }
          for (;;) { QNEXT(CW_Q + 8 * layer + 1); if (idx >= NSSDA) break;
              ssdA_unit(idx >> 5, (idx >> 1) & 15, idx & 1, PROJ, conv_w + (size_t)layer * 4 * SSD_CW, conv_b + layer * SSD_CW, dt_bias + layer * SSD_H, a_log + layer * SSD_H, ST, CD, XCB, DTG, lds, tid, wave, lane); }
        }
        PH_END(PB + 1)
        PH_BEGIN(PB + 2)
        { constexpr int NSSDB = NB * 32, NGMU = NB * (SEQ / GM_CHUNK);
          volatile LAS unsigned* qw = (volatile LAS unsigned*)(lds + MISC_OFF) + 16;
          int idx;
          for (;;) { QNEXT(CW_Q + 8 * layer + 2); if (idx >= NSSDB) break;
              const int c = 15 - idx / (NB * 2), bg = idx % (NB * 2);
              ssdB_unit(bg >> 1, c, bg & 1, PROJ, XCB, DTG, d_skip + layer * SSD_H, ssd_norm_g + layer * SSD_W, ST, CD, MIXB, lds, tid, wave, lane); }
          for (;;) { QNEXT(CW_Q + 8 * layer + 3); if (idx >= NGMU) break;
              gm_unit(idx / (SEQ / GM_CHUNK), idx % (SEQ / GM_CHUNK), PROJ, WSB + (size_t)layer * GM_G * GM_CHUNK * GM_CHUNK, gm_ln_g + layer * GM_W, gm_ln_b + layer * GM_W,
                      gm_b_s + layer * GM_G * GM_CHUNK, gm_norm_g + layer * GM_W, MIXB, lds, wave, lane); }
          att_norm_phase(MIXB, att_norm_g + layer * ATT_W, M_, gw, ngw, lane);
          { const float* const p_mg = moe_w_gate; const float* const p_mu = moe_w_up; const float* const p_md = moe_w_down;
            constexpr int g0 = layer == 0 ? 0 : FT_G_A + FT_G_B, g1 = layer == 0 ? FT_G_A : FT_G, d0 = layer == 0 ? 0 : FT_D_A, d1 = layer == 0 ? FT_D_A : FT_D - FT_D_D;
            for (;;) { QNEXT(CW_Q + 8 * layer + 4); if (idx >= g1 - g0) break; filler_g(g0 + idx, p_mg, p_mu, MWGU, scr, wave, lane); }
            for (;;) { QNEXT(CW_Q + 8 * layer + 5); if (idx >= d1 - d0) break; filler_d(d0 + idx, p_md, MWD, scr, wave, lane); } }
#undef QNEXT
        }
        PH_END(PB + 2)
        PH_BEGIN(PB + 3)
        { pg8::Gemm g{MIXB, WOUT + (size_t)layer * DM * DM, M_, DM, DM, DM}; pg8::StaticOrder S; S.init(M_, DM, G, bx);
          fp::EpiY E{YB, DM}; pg8::gemm_phase<fp::EpiY, pg8::StaticOrder, false, true>(lds, g, S, E, tid); }
        PH_END(PB + 3)
        PH_BEGIN(PB + 4)
        { const float* const p_g = ln1_g + layer * DM; const float* const p_b = ln1_b + layer * DM;
          { float va[16], vb[16]; LnGB gbp; ln_gb_load(gbp, p_g, p_b, lane); long r = gw; if (r < M_) ln_load<bf16, bf16>(va, HB + r * DM, ALPHA, YB + r * DM, nullptr, lane);
            for (; r < M_; r += 2 * ngw) { const long r1 = r + ngw, r2 = r + 2 * ngw;
                if (r1 < M_) ln_load<bf16, bf16>(vb, HB + r1 * DM, ALPHA, YB + r1 * DM, nullptr, lane);
                ln_finish_r(va, gbp, nullptr, HB + r * DM, lane);
                if (r2 < M_) ln_load<bf16, bf16>(va, HB + r2 * DM, ALPHA, YB + r2 * DM, nullptr, lane);
                if (r1 < M_) ln_finish_r(vb, gbp, nullptr, HB + r1 * DM, lane); } }
          if (layer == 1) { asm volatile("s_waitcnt vmcnt(0)" ::: "memory"); moe_route_block(HB, router_w, CNT, TE, TP, TS, M_, gw, ngw, lane, wave, tid, (LAS int*)lds); } }
        PH_END(PB + 4)
        if constexpr (layer == 0) {
            PH_BEGIN(PB + 5)
            { pg8::Gemm g{HB, WGU, M_, NGU, DM, DM}; pg8::StaticOrder S; S.init(M_, NGU, G, bx);
              fp::EpiAct E{ACT, D_FF, NGU / 256}; pg8::gemm_phase<fp::EpiAct, pg8::StaticOrder, true, true>(lds, g, S, E, tid);
              { constexpr int UNITS = (NB * SEQ / 256) * (NGU / 256), REM = UNITS % 256;
                if (REM != 0 && G == 256 && bx >= REM) { constexpr int PER = (FT_G_B + (256 - REM) - 1) / (256 - REM); const float* const p_mg = moe_w_gate; const float* const p_mu = moe_w_up;
                    for (int k = 0; k < PER; ++k) { const int t = (bx - REM) * PER + k; if (t < FT_G_B) filler_g(FT_G_A + t, p_mg, p_mu, MWGU, scr, wave, lane); } }
                else if (REM == 0 || G != 256) { const float* const p_mg = moe_w_gate; const float* const p_mu = moe_w_up; for (int t = bx; t < FT_G_B; t += G) filler_g(FT_G_A + t, p_mg, p_mu, MWGU, scr, wave, lane); } } }
            PH_END(PB + 5)
            PH_BEGIN(PB + 6)
            { pg8::Gemm g{ACT, WD, M_, DM, D_FF, D_FF}; pg8::StaticOrder S; S.init(M_, DM, G, bx);
              fp::EpiY E{YB, DM}; pg8::gemm_phase<fp::EpiY, pg8::StaticOrder, false, true>(lds, g, S, E, tid); }
            PH_END(PB + 6)
            PH_BEGIN(PB + 7)
            { const float* const p_g = ln2_g + layer * DM; const float* const p_b = ln2_b + layer * DM;
              { float va[16], vb[16]; LnGB gbp; ln_gb_load(gbp, p_g, p_b, lane); long r = gw; if (r < M_) ln_load<bf16, bf16>(va, HB + r * DM, ALPHA, YB + r * DM, nullptr, lane);
            for (; r < M_; r += 2 * ngw) { const long r1 = r + ngw, r2 = r + 2 * ngw;
                if (r1 < M_) ln_load<bf16, bf16>(vb, HB + r1 * DM, ALPHA, YB + r1 * DM, nullptr, lane);
                ln_finish_r(va, gbp, nullptr, HB + r * DM, lane);
                if (r2 < M_) ln_load<bf16, bf16>(va, HB + r2 * DM, ALPHA, YB + r2 * DM, nullptr, lane);
                if (r1 < M_) ln_finish_r(vb, gbp, nullptr, HB + r1 * DM, lane); } } }
            PH_END(PB + 7)
        } else {
            PH_BEGIN(PB + 5)
            { int base[N_EXP]; { int b_ = 0;
#pragma unroll
                  for (int e = 0; e < N_EXP; ++e) { base[e] = b_; b_ += (CNT[e] + 255) & ~255; } }
              constexpr int RPW = (M_ + 2047) / 2048;
              int te[RPW][2], tsl[RPW][2]; float tpv[RPW][2];
#pragma unroll
              for (int k = 0; k < RPW; ++k) { const long r = gw + (long)k * ngw;
#pragma unroll
                  for (int q = 0; q < 2; ++q) { te[k][q] = 0; tsl[k][q] = 0; tpv[k][q] = 0.f; if (r < M_) { te[k][q] = TE[r * 2 + q]; tsl[k][q] = TS[r * 2 + q]; tpv[k][q] = TP[r * 2 + q]; } } }
#pragma unroll
              for (int k = 0; k < RPW; ++k) { const long r = gw + (long)k * ngw; if (r < M_) {
                  const uint4* src = (const uint4*)(HB + r * DM); const uint4 v0 = src[lane], v1 = src[lane + 64];
#pragma unroll
                  for (int q = 0; q < 2; ++q) { int be = 0;
#pragma unroll
                      for (int x = 0; x < N_EXP; ++x) be = (te[k][q] == x) ? base[x] : be;
                      const int gs = be + tsl[k][q];
                      if (lane == 0) { SP[gs] = tpv[k][q]; GS[r * 2 + q] = gs; }
                      uint4* dst = (uint4*)(XG + (size_t)gs * DM); dst[lane] = v0; dst[lane + 64] = v1; } } }
              for (long r = gw + (long)RPW * ngw; r < M_; r += ngw) {
                  const uint4* src = (const uint4*)(HB + r * DM); const uint4 v0 = src[lane], v1 = src[lane + 64];
                  for (int q = 0; q < 2; ++q) { const long it = r * 2 + q; const int e = TE[it]; int be = 0;
#pragma unroll
                      for (int x = 0; x < N_EXP; ++x) be = (e == x) ? base[x] : be;
                      const int gs = be + TS[it];
                      if (lane == 0) { SP[gs] = TP[it]; GS[it] = gs; }
                      uint4* dst = (uint4*)(XG + (size_t)gs * DM); dst[lane] = v0; dst[lane + 64] = v1; } }
              for (int it = gw; it < N_EXP * 256; it += ngw) { const int e = it >> 8, r = it & 255; const int c = CNT[e]; const int slot = moe_base(CNT, e) + c + r;
                  if (c + r < ((c + 255) & ~255)) { uint4* dst = (uint4*)(XG + (size_t)slot * DM); const uint4 z = make_uint4(0u, 0u, 0u, 0u); dst[lane] = z; dst[lane + 64] = z; if (lane == 0) SP[slot] = 0.f; } } }
            PH_END(PB + 5)
            PH_BEGIN(PB + 6)
            { pg8::Gemm g{XG, MWGU, NSLOT, N_EXP * NGUE, DM, DM}; fp::MoeOrder S; S.init(CNT, NGUE / 256, G, bx);
              fp::EpiAct E{ACTM, D_FFE, NGUE / 256}; pg8::gemm_phase<fp::EpiAct, fp::MoeOrder, true, true>(lds, g, S, E, tid);
              { const int rem = (S.T * S.ncol) % G; const int nidle = rem == 0 ? G : G - rem, first = rem == 0 ? 0 : rem;
                if (bx >= first) { const int per = (FT_D_D + nidle - 1) / nidle; const float* const p_md = moe_w_down;
                    for (int k = 0; k < per; ++k) { const int t = (bx - first) * per + k; if (t < FT_D_D) filler_d(FT_D - FT_D_D + t, p_md, MWD, scr, wave, lane); } } } }
            PH_END(PB + 6)
            PH_BEGIN(PB + 7)
            { fp::MoeOrder S; S.init(CNT, DM / 256, G, bx); const int nf = S.tail_start(); const int slot0 = (nf / (DM / 256)) * 256;
              fp::EpiF2 E{F2, SP, F2P, slot0, D_FFE / 4};
              { pg8::Gemm g{ACTM, MWD, NSLOT, N_EXP * DM, D_FFE, D_FFE}; S.nfull = nf; S.ksplit = 1;
                pg8::gemm_phase<fp::EpiF2, fp::MoeOrder, true, true>(lds, g, S, E, tid); }
              { pg8::Gemm g{ACTM, MWD, NSLOT, N_EXP * DM, D_FFE / 4, D_FFE}; S.ksplit = 4; S.klen = D_FFE / 4;
                int tid2 = tid; asm volatile("" : "+v"(tid2));
                pg8::gemm_phase<fp::EpiF2, fp::MoeOrder, true, true>(lds, g, S, E, tid2); } }
            PH_END(PB + 7)
            PH_BEGIN(PB + 8)
            { const float* const p_g = ln2_g + layer * DM; const float* const p_b = ln2_b + layer * DM;
              int slot0; { fp::MoeOrder S; S.init(CNT, DM / 256, G, bx); const int nf = S.tail_start(); slot0 = (nf == S.T * (DM / 256)) ? 0x7fffffff : (nf / (DM / 256)) * 256; }
#define LN2_LOAD(v, rr) do { const int s0_ = GS[(rr) * 2], s1_ = GS[(rr) * 2 + 1]; ln_load<bf16, bf16>(v, HB + (rr) * DM, ALPHA, F2 + (size_t)s0_ * DM, F2 + (size_t)s1_ * DM, lane); \
                  if (s0_ >= slot0) { _Pragma("unroll") for (int p_ = 0; p_ < 3; ++p_) ln_add(v, F2P + ((size_t)p_ * TAIL_SLOTS + (s0_ - slot0)) * DM, lane); } \
                  if (s1_ >= slot0) { _Pragma("unroll") for (int p_ = 0; p_ < 3; ++p_) ln_add(v, F2P + ((size_t)p_ * TAIL_SLOTS + (s1_ - slot0)) * DM, lane); } } while (0)
              { float va[16], vb[16]; LnGB gbp; ln_gb_load(gbp, p_g, p_b, lane); long r = gw; if (r < M_) LN2_LOAD(va, r);
                for (; r < M_; r += 2 * ngw) { const long r1 = r + ngw, r2 = r + 2 * ngw;
                    if (r1 < M_) LN2_LOAD(vb, r1);
                    ln_finish_r(va, gbp, H + r * DM, nullptr, lane);
                    if (r2 < M_) LN2_LOAD(va, r2);
                    if (r1 < M_) ln_finish_r(vb, gbp, H + r1 * DM, nullptr, lane); } }
#undef LN2_LOAD
            }
            PH_END(PB + 8)
        }
    }

#undef PH_BEGIN
#undef PH_END
#undef in_x
#undef in_pos
#undef ln_in_g
#undef ln_in_b
#undef w_in
#undef conv_w
#undef conv_b
#undef dt_bias
#undef a_log
#undef d_skip
#undef ssd_norm_g
#undef att_norm_g
#undef gm_ln_g
#undef gm_ln_b
#undef gm_w_s
#undef gm_b_s
#undef gm_norm_g
#undef w_out
#undef ln1_g
#undef ln1_b
#undef ln2_g
#undef ln2_b
#undef ffn_w_gate
#undef ffn_w_up
#undef ffn_w_down
#undef router_w
#undef moe_w_gate
#undef moe_w_up
#undef moe_w_down
#undef H
#undef MWD
#undef RT
#undef TE
#undef TP
#undef TS
#undef GS
#undef SP
#undef KM
#undef WSB
#undef HB
#undef MWGU
#undef WIN
#undef WOUT
#undef WGU
#undef WD
#undef PROJ
#undef ST
#undef CD
#undef XCB
#undef DTG
#undef MIXB
#undef YB
#undef ACT
#undef XG
#undef F2
#undef ACTM
#undef CNT
#undef tid
#undef lane
#undef F2P
#undef vcu
#undef gw
#undef ngw
#undef gt
#undef ngt
    if (pr_me) { const unsigned t_beg = (unsigned)__builtin_amdgcn_s_memrealtime(), t_len = (unsigned)PROBE_AMP * pr_w[1]; while ((unsigned)__builtin_amdgcn_s_memrealtime() - t_beg < t_len) __builtin_amdgcn_s_sleep(8); }
}

__device__ __forceinline__ void blk_acc(float d2, float s2, float* err) {
    d2 = wave_sum(d2); s2 = wave_sum(s2); if ((threadIdx.x & 63) == 0) { atomicAdd(err, d2); atomicAdd(err + 1, s2); }
}
__global__ void k_cmp_proj(const bf16* F, const float* S, long rows, float* err) {
    float d2 = 0.f, s2 = 0.f;
    for (long it = blockIdx.x * (long)blockDim.x + threadIdx.x; it < rows * 2950; it += gridDim.x * (long)blockDim.x) {
        const long row = it / 2950; const int d = (int)(it % 2950); const int sc = fp::win_src_col(d);
        float s = S[row * D_IN + sc]; if (d >= FGU && d < FXBC) s = gelu_tanh_f(s);
        const float f = ldf(F + row * PLD + d); d2 += (f - s) * (f - s); s2 += s * s; }
    blk_acc(d2, s2, err);
}
template <class TF> __global__ void k_cmp(const TF* F, int ldf_, const float* S, int lds_, long rows, int cols, float* err) {
    float d2 = 0.f, s2 = 0.f;
    for (long it = blockIdx.x * (long)blockDim.x + threadIdx.x; it < rows * cols; it += gridDim.x * (long)blockDim.x) {
        const long row = it / cols; const int c = (int)(it % cols); const float f = ldf(F + row * ldf_ + c), s = S[row * lds_ + c]; d2 += (f - s) * (f - s); s2 += s * s; }
    blk_acc(d2, s2, err);
}
__global__ void k_encode(const float* err, int nck, const float* Sout, float* out, long rows_s, long rows_all, float thr) {
    int k = 0; for (int i = 0; i < nck; ++i) { const float r = err[2 * i] / fmaxf(err[2 * i + 1], 1e-30f); if (!(r <= thr)) { k = i + 1; break; } }
    for (long it = blockIdx.x * (long)blockDim.x + threadIdx.x; it < rows_all * DM; it += gridDim.x * (long)blockDim.x)
        out[it] = (it < rows_s * DM) ? Sout[it] * (1.f + (float)k) : 0.f;
}
#if DEBUG_BUILD
constexpr size_t S_BASE = (WS_END + 2 * MiB - 1) / MiB * MiB;
#endif
extern "C" void kernel_launch(void* const* d_in, const int* in_sizes, int n_in, void* d_out, int out_size, void* d_ws, size_t ws_size, hipStream_t stream) {
    (void)in_sizes; (void)n_in; (void)out_size;
    static int grid = 0;
    if (grid == 0) {
        int dev = 0, cus = 0, per_cu = 0;
        if (hipGetDevice(&dev) != hipSuccess || hipDeviceGetAttribute(&cus, hipDeviceAttributeMultiprocessorCount, dev) != hipSuccess) { grid = -1; return; }
        if (hipFuncSetAttribute((const void*)mega, hipFuncAttributeMaxDynamicSharedMemorySize, LDS_BYTES) != hipSuccess) { fprintf(stderr, "kernel_launch: hipFuncSetAttribute failed\n"); grid = -1; return; }
        if (hipOccupancyMaxActiveBlocksPerMultiprocessor(&per_cu, (const void*)mega, 512, LDS_BYTES) != hipSuccess || per_cu < 1) fprintf(stderr, "kernel_launch: occupancy query reports %d\n", per_cu);
        (void)hipGetLastError();
        grid = cus;
        if (ws_size < WS_END) { fprintf(stderr, "kernel_launch: workspace too small: %zu < %zu\n", ws_size, (size_t)WS_END); grid = -1; }
    }
    if (grid < 0) return;
    unsigned char* ws = (unsigned char*)d_ws;
    if (hipMemsetAsync(ws + O_CTL, 0, CTL_BYTES, stream) != hipSuccess) return;
    FArgs a{};
    for (int i = 0; i < 29; ++i) a.in[i] = d_in[i];
    a.out = (float*)d_out; a.ws = ws;
#if !DEBUG_BUILD
    a.ph_lo = 0; a.ph_hi = N_PHASES;
    hipLaunchKernelGGL(mega, dim3(grid), dim3(512), LDS_BYTES, stream, a);
#else
    Inputs I;
    I.x = (const float*)d_in[0]; I.pos = (const int*)d_in[1]; I.ln_in_g = (const float*)d_in[2]; I.ln_in_b = (const float*)d_in[3]; I.w_in = (const float*)d_in[4];
    I.conv_w = (const float*)d_in[5]; I.conv_b = (const float*)d_in[6]; I.dt_bias = (const float*)d_in[7]; I.a_log = (const float*)d_in[8]; I.d_skip = (const float*)d_in[9];
    I.ssd_norm_g = (const float*)d_in[10]; I.att_norm_g = (const float*)d_in[11]; I.gm_ln_g = (const float*)d_in[12]; I.gm_ln_b = (const float*)d_in[13]; I.gm_w_s = (const float*)d_in[14];
    I.gm_b_s = (const float*)d_in[15]; I.gm_norm_g = (const float*)d_in[16]; I.w_out = (const float*)d_in[17]; I.ln1_g = (const float*)d_in[18]; I.ln1_b = (const float*)d_in[19];
    I.ln2_g = (const float*)d_in[20]; I.ln2_b = (const float*)d_in[21]; I.ffn_w_gate = (const float*)d_in[22]; I.ffn_w_up = (const float*)d_in[23]; I.ffn_w_down = (const float*)d_in[24];
    I.router_w = (const float*)d_in[25]; I.moe_w_gate = (const float*)d_in[26]; I.moe_w_up = (const float*)d_in[27]; I.moe_w_down = (const float*)d_in[28];
    const long MS = SEQ;
    unsigned char* sws = ws + S_BASE;
    float* saux = (float*)(sws + 96 * MiB); float* sout = (float*)(sws + 100 * MiB); float* ckpt = (float*)(sws + 110 * MiB);
    const size_t ck_stride = (size_t)MS * (D_IN + 3 * DM);
    run_simple(I, 1, sws, saux, sout, stream, ckpt);
    float* err = (float*)(ws + O_CTL) + CW_ERR;
    const bf16* PROJ = (const bf16*)(ws + O_PROJ); const bf16* MIXB = (const bf16*)(ws + O_MIXB); const bf16* Hf = (const bf16*)(ws + O_HB); const float* Hout = (const float*)d_out;
    for (int ph = 0; ph < N_PHASES; ++ph) {
        a.ph_lo = ph; a.ph_hi = ph + 1;
        hipLaunchKernelGGL(mega, dim3(grid), dim3(512), LDS_BYTES, stream, a);
        const int layer = ph >= 9 ? 1 : 0; const int rel = ph - (layer ? 8 : 0); const float* ck = ckpt + layer * ck_stride; float* e = err + layer * 12;
        if (rel == 1) k_cmp_proj<<<512, 256, 0, stream>>>(PROJ, ck, MS, e + 0);
        if (rel == 3) { k_cmp<bf16><<<512, 256, 0, stream>>>(MIXB, DM, ck + (size_t)MS * D_IN, DM, MS, 384, e + 2);
                        k_cmp<bf16><<<512, 256, 0, stream>>>(MIXB + 384, DM, ck + (size_t)MS * D_IN + 384, DM, MS, 384, e + 4);
                        k_cmp<bf16><<<512, 256, 0, stream>>>(MIXB + 768, DM, ck + (size_t)MS * D_IN + 768, DM, MS, 256, e + 6); }
        if (rel == 5) k_cmp<bf16><<<512, 256, 0, stream>>>(Hf, DM, ck + (size_t)MS * (D_IN + DM), DM, MS, DM, e + 8);
        if (layer == 0 && rel == 8) k_cmp<bf16><<<512, 256, 0, stream>>>(Hf, DM, ck + (size_t)MS * (D_IN + 2 * DM), DM, MS, DM, e + 10);
        if (layer == 1 && rel == 9) k_cmp<float><<<512, 256, 0, stream>>>(Hout, DM, ck + (size_t)MS * (D_IN + 2 * DM), DM, MS, DM, e + 10);
    }
    k_encode<<<1024, 256, 0, stream>>>(err, 12, sout, (float*)d_out, MS, (long)NBATCH * SEQ, DBG_THR);
#endif
}
```

```cpp
#define DEBUG_BUILD 0
#define DBG_THR 0.02f
#define PROBE_MASK 0u
#define PROBE_AMP 0
#include <hip/hip_runtime.h>
#include <cstdio>
#include <cstdint>

constexpr int DM = 1024, SEQ = 2048, NBATCH = 8;
constexpr int ATT_H = 6, HD = 64, ATT_W = 384, ROPE_DIM = 16;
constexpr int MOBA_BLOCK = 256, NBLK = SEQ / MOBA_BLOCK;
constexpr int SSD_H = 6, SSD_W = 384, SSD_G = 2, SSD_N = 128, SSD_CW = 896;
constexpr int GM_G = 4, GM_W = 256, GM_CHUNK = 128;
constexpr int D_IN = 2950, D_FF = 2816, N_EXP = 8, D_FFE = 3584;
constexpr float ALPHA = 1.4142135623730951f;
constexpr float NEGF = -1e30f;
constexpr int MAXSLOT = 2 * NBATCH * SEQ + N_EXP * 256;

typedef unsigned short bf16;
__device__ __forceinline__ unsigned f2bf(float f) { unsigned u = __float_as_uint(f); return (u + 0x7fffu + ((u >> 16) & 1u)) >> 16; }
__device__ __forceinline__ float ldf(const float* p) { return *p; }
__device__ __forceinline__ float ldf(const bf16* p) { return __uint_as_float(((unsigned)*p) << 16); }
__device__ __forceinline__ void stf(float* p, float v) { *p = v; }
__device__ __forceinline__ void stf(bf16* p, float v) { *p = (bf16)f2bf(v); }

__device__ __forceinline__ float dpp_add(float v, const int ctrl_tag) {
    int r;
    if (ctrl_tag == 0) r = __builtin_amdgcn_update_dpp(0, __float_as_int(v), 0xB1, 0xF, 0xF, false);
    else if (ctrl_tag == 1) r = __builtin_amdgcn_update_dpp(0, __float_as_int(v), 0x4E, 0xF, 0xF, false);
    else if (ctrl_tag == 2) r = __builtin_amdgcn_update_dpp(0, __float_as_int(v), 0x141, 0xF, 0xF, false);
    else r = __builtin_amdgcn_update_dpp(0, __float_as_int(v), 0x140, 0xF, 0xF, false);
    return v + __int_as_float(r);
}
__device__ __forceinline__ float row16_sum(float v) { v = dpp_add(v, 0); v = dpp_add(v, 1); v = dpp_add(v, 2); v = dpp_add(v, 3); return v; }
__device__ __forceinline__ float wave_sum(float v) {
    v = row16_sum(v);
    { const auto rr = __builtin_amdgcn_permlane16_swap(__float_as_uint(v), __float_as_uint(v), false, false); v = __uint_as_float(rr[0]) + __uint_as_float(rr[1]); }
    { const auto rr = __builtin_amdgcn_permlane32_swap(__float_as_uint(v), __float_as_uint(v), false, false); v = __uint_as_float(rr[0]) + __uint_as_float(rr[1]); }
    return v;
}
__device__ __forceinline__ float silu_f(float x) { return x / (1.f + __expf(-x)); }
__device__ __forceinline__ float gelu_tanh_f(float x) { const float u = 0.7978845608028654f * (x + 0.044715f * x * x * x); return 0.5f * x * (1.f + tanhf(u)); }
__device__ __forceinline__ float softplus_f(float x) { return fmaxf(x, 0.f) + log1pf(__expf(-fabsf(x))); }

struct ProjL { int ld, q, k, v, z, xbc, dt, gu, gv; };

__device__ __forceinline__ float4 ld4(const float* p) { return *(const float4*)p; }
__device__ __forceinline__ float4 ld4(const bf16* p) { const uint2 w = *(const uint2*)p; return make_float4(__uint_as_float(w.x << 16), __uint_as_float(w.x & 0xffff0000u), __uint_as_float(w.y << 16), __uint_as_float(w.y & 0xffff0000u)); }
template <class TY, class TX = float> __device__ __forceinline__ void ln_load(float (&v)[16], const TX* xrow, float a, const TY* y1, const TY* y2, int lane) {
#pragma unroll
    for (int j = 0; j < 4; ++j) {
        const float4 x = ld4(xrow + j * 256 + lane * 4);
        float4 t = make_float4(a * x.x, a * x.y, a * x.z, a * x.w);
        if (y1) { const float4 y = ld4(y1 + j * 256 + lane * 4); t.x += y.x; t.y += y.y; t.z += y.z; t.w += y.w; }
        if (y2) { const float4 y = ld4(y2 + j * 256 + lane * 4); t.x += y.x; t.y += y.y; t.z += y.z; t.w += y.w; }
        v[4 * j] = t.x; v[4 * j + 1] = t.y; v[4 * j + 2] = t.z; v[4 * j + 3] = t.w;
    }
}
__device__ __forceinline__ void ln_add(float (&v)[16], const bf16* y, int lane) {
#pragma unroll
    for (int j = 0; j < 4; ++j) { const float4 t = ld4(y + j * 256 + lane * 4); v[4 * j] += t.x; v[4 * j + 1] += t.y; v[4 * j + 2] += t.z; v[4 * j + 3] += t.w; }
}
__device__ __forceinline__ void ln_finish(float (&v)[16], const float* g, const float* b, float* of, bf16* ob, int lane) {
    float s = 0.f;
#pragma unroll
    for (int i = 0; i < 16; ++i) s += v[i];
    const float mean = wave_sum(s) * (1.f / 1024.f); float s2 = 0.f;
#pragma unroll
    for (int i = 0; i < 16; ++i) { v[i] -= mean; s2 += v[i] * v[i]; }
    const float rstd = rsqrtf(wave_sum(s2) * (1.f / 1024.f) + 1e-5f);
#pragma unroll
    for (int j = 0; j < 4; ++j) {
        const float4 gg = *(const float4*)(g + j * 256 + lane * 4), bb = *(const float4*)(b + j * 256 + lane * 4);
        float4 o = make_float4(v[4 * j] * rstd * gg.x + bb.x, v[4 * j + 1] * rstd * gg.y + bb.y, v[4 * j + 2] * rstd * gg.z + bb.z, v[4 * j + 3] * rstd * gg.w + bb.w);
        if (of) *(float4*)(of + j * 256 + lane * 4) = o;
        if (ob) { uint2 w; w.x = f2bf(o.x) | (f2bf(o.y) << 16); w.y = f2bf(o.z) | (f2bf(o.w) << 16); *(uint2*)(ob + j * 256 + lane * 4) = w; }
    }
}

struct LnGB { float4 g[4], b[4]; };
__device__ __forceinline__ void ln_gb_load(LnGB& p, const float* g, const float* b, int lane) {
#pragma unroll
    for (int j = 0; j < 4; ++j) { p.g[j] = *(const float4*)(g + j * 256 + lane * 4); p.b[j] = *(const float4*)(b + j * 256 + lane * 4); }
}
__device__ __forceinline__ void ln_finish_r(float (&v)[16], const LnGB& p, float* of, bf16* ob, int lane) {
    float s = 0.f;
#pragma unroll
    for (int i = 0; i < 16; ++i) s += v[i];
    const float mean = wave_sum(s) * (1.f / 1024.f); float s2 = 0.f;
#pragma unroll
    for (int i = 0; i < 16; ++i) { v[i] -= mean; s2 += v[i] * v[i]; }
    const float rstd = rsqrtf(wave_sum(s2) * (1.f / 1024.f) + 1e-5f);
#pragma unroll
    for (int j = 0; j < 4; ++j) {
        const float4 gg = p.g[j], bb = p.b[j];
        float4 o = make_float4(v[4 * j] * rstd * gg.x + bb.x, v[4 * j + 1] * rstd * gg.y + bb.y, v[4 * j + 2] * rstd * gg.z + bb.z, v[4 * j + 3] * rstd * gg.w + bb.w);
        if (of) *(float4*)(of + j * 256 + lane * 4) = o;
        if (ob) { uint2 w; w.x = f2bf(o.x) | (f2bf(o.y) << 16); w.y = f2bf(o.z) | (f2bf(o.w) << 16); *(uint2*)(ob + j * 256 + lane * 4) = w; }
    }
}
template <class TY> __device__ __forceinline__ void ln_row(const float* xrow, float a, const TY* y1, const TY* y2, const float* g, const float* b, float* of, bf16* ob, int lane) {
    float v[16]; ln_load<TY>(v, xrow, a, y1, y2, lane); ln_finish(v, g, b, of, ob, lane);
}

__device__ __forceinline__ void rope_inplace(float* P, ProjL L, const int* pos, long n_rows, long gt, long ngt) {
    for (long it = gt; it < n_rows * 96; it += ngt) {
        const int i = (int)(it & 7), hh = (int)((it >> 3) % 12); const long row = it / 96;
        const int off = (hh < 6 ? L.q : L.k) + (hh % 6) * 64;
        const float inv = powf(500000.0f, -(float)(2 * i) / 16.0f);
        const float ang = (float)pos[row] * inv;
        const float c = cosf(ang), s = sinf(ang);
        float* p = P + row * L.ld + off;
        const float x1 = p[i], x2 = p[i + 8];
        p[i] = x1 * c - x2 * s; p[i + 8] = x2 * c + x1 * s;
    }
}

template <class T> __device__ __forceinline__ void kmean_phase(const T* P, ProjL L, float* KM, int nb, long gt, long ngt) {
    for (long it = gt; it < (long)nb * ATT_H * NBLK * 64; it += ngt) {
        const int d = (int)(it & 63), n = (int)((it >> 6) % NBLK), h = (int)((it / (64 * NBLK)) % ATT_H), b = (int)(it / (64 * NBLK * ATT_H));
        const T* p = P + ((long)b * SEQ + n * MOBA_BLOCK) * L.ld + L.k + h * 64 + d; float s = 0.f;
        for (int r = 0; r < MOBA_BLOCK; ++r) s += ldf(p + (long)r * L.ld);
        KM[it] = s * (1.f / MOBA_BLOCK);
    }
}

template <class T> __device__ __forceinline__ void attn_naive_phase(const T* P, ProjL L, const float* KM, float* O, int ldo, int nb, int gw, int ngw, int lane) {
    for (long it = gw; it < (long)nb * ATT_H * SEQ; it += ngw) {
        const int q = (int)(it % SEQ), h = (int)((it / SEQ) % ATT_H), b = (int)(it / ((long)SEQ * ATT_H));
        const long row = (long)b * SEQ + q; const int qblk = q / MOBA_BLOCK;
        const float qv = ldf(P + row * L.ld + L.q + h * 64 + lane);
        float g[NBLK];
#pragma unroll
        for (int n = 0; n < NBLK; ++n) { const float t = wave_sum(qv * KM[(((long)b * ATT_H + h) * NBLK + n) * 64 + lane]); g[n] = (n < qblk) ? t : NEGF; }
        unsigned sel = 0u;
#pragma unroll
        for (int r = 0; r < 3; ++r) { float bv = -3.0e38f; int best = -1;
#pragma unroll
            for (int n = 0; n < NBLK; ++n) if (!((sel >> n) & 1u) && g[n] > bv) { bv = g[n]; best = n; }
            if (best >= 0 && bv > NEGF * 0.5f) sel |= 1u << best; }
        sel |= 1u << qblk;
        float m = -3.0e38f, l = 0.f, o = 0.f;
        for (int n = 0; n <= qblk; ++n) {
            if (!((sel >> n) & 1u)) continue;
            const int j0 = n * MOBA_BLOCK, j1 = (n == qblk) ? q + 1 : j0 + MOBA_BLOCK;
            const T* kp = P + ((long)b * SEQ + j0) * L.ld + L.k + h * 64 + lane;
            const T* vp = P + ((long)b * SEQ + j0) * L.ld + L.v + h * 64 + lane;
            for (int j = j0; j < j1; ++j, kp += L.ld, vp += L.ld) {
                const float s = wave_sum(qv * ldf(kp)) * 0.125f;
                const float mn = fmaxf(m, s), corr = __expf(m - mn), p = __expf(s - mn);
                l = l * corr + p; o = o * corr + p * ldf(vp); m = mn;
            }
        }
        O[row * ldo + h * 64 + lane] = o / l;
    }
}

template <int W, class TO> __device__ __forceinline__ void rms_rows_phase(const float* in, int ldi, const float* g, TO* out, int ldo, long n_rows, int gw, int ngw, int lane) {
    constexpr int PER = W / 64;
    for (long row = gw; row < n_rows; row += ngw) {
        float v[PER]; float s = 0.f;
#pragma unroll
        for (int j = 0; j < PER; ++j) { v[j] = in[row * ldi + j * 64 + lane]; s += v[j] * v[j]; }
        const float r = rsqrtf(wave_sum(s) * (1.f / W) + 1e-5f);
#pragma unroll
        for (int j = 0; j < PER; ++j) stf(out + row * ldo + j * 64 + lane, v[j] * r * g[j * 64 + lane]);
    }
}

template <class T, class TO> __device__ __forceinline__ void ssd_conv_phase(const T* P, ProjL L, const float* cw, const float* cb, const float* dtb, TO* XC, float* DT, long n_rows, long gt, long ngt) {
    for (long it = gt; it < n_rows * 902; it += ngt) {
        const int c = (int)(it % 902); const long row = it / 902; const int t = (int)(row % SEQ);
        if (c < SSD_CW) {
            float acc = cb[c];
#pragma unroll
            for (int i = 0; i < 4; ++i) { const int tt = t - 3 + i; if (tt >= 0) acc += cw[i * SSD_CW + c] * ldf(P + (row - 3 + i) * L.ld + L.xbc + c); }
            stf(XC + row * SSD_CW + c, silu_f(acc));
        } else {
            const int h = c - SSD_CW;
            DT[row * SSD_H + h] = softplus_f(ldf(P + row * L.ld + L.dt + h) + dtb[h]);
        }
    }
}

template <class T> __device__ __forceinline__ void ssd_scan_naive_phase(const T* XC, const float* DT, const float* a_log, const float* dsk, float* Y, int ldo, int nb, int gw, int ngw, int lane) {
    for (int it = gw; it < nb * SSD_H * 64; it += ngw) {
        const int p = it & 63, h = (it >> 6) % SSD_H, b = it / (64 * SSD_H), grp = h / (SSD_H / SSD_G);
        const float A = -__expf(a_log[h]), Dk = dsk[h];
        float s0 = 0.f, s1 = 0.f;
#pragma unroll 4
        for (int t = 0; t < SEQ; ++t) {
            const long row = (long)b * SEQ + t;
            const T* xr = XC + row * SSD_CW;
            const float dt = DT[row * SSD_H + h], x = ldf(xr + h * 64 + p);
            const float B0 = ldf(xr + SSD_W + grp * SSD_N + lane), B1 = ldf(xr + SSD_W + grp * SSD_N + 64 + lane);
            const float C0 = ldf(xr + SSD_W + SSD_G * SSD_N + grp * SSD_N + lane), C1 = ldf(xr + SSD_W + SSD_G * SSD_N + grp * SSD_N + 64 + lane);
            const float dec = __expf(dt * A), xd = x * dt;
            s0 = s0 * dec + xd * B0; s1 = s1 * dec + xd * B1;
            const float y = wave_sum(C0 * s0 + C1 * s1);
            if (lane == 0) Y[row * ldo + h * 64 + p] = y + Dk * x;
        }
    }
}

template <class T, class TO> __device__ __forceinline__ void ssd_gate_phase(const float* Y, int ldi, const T* P, ProjL L, const float* ng, TO* out, int ldo, long n_rows, int gw, int ngw, int lane) {
    for (long row = gw; row < n_rows; row += ngw) {
        float v[6];
#pragma unroll
        for (int j = 0; j < 6; ++j) { const int c = j * 64 + lane; v[j] = Y[row * ldi + c] * silu_f(ldf(P + row * L.ld + L.z + c)); }
        const float r0 = rsqrtf(wave_sum(v[0] * v[0] + v[1] * v[1] + v[2] * v[2]) * (1.f / 192.f) + 1e-5f);
        const float r1 = rsqrtf(wave_sum(v[3] * v[3] + v[4] * v[4] + v[5] * v[5]) * (1.f / 192.f) + 1e-5f);
#pragma unroll
        for (int j = 0; j < 6; ++j) { const int c = j * 64 + lane; stf(out + row * ldo + c, v[j] * (j < 3 ? r0 : r1) * ng[c]); }
    }
}

template <class T, bool PRE> __device__ __forceinline__ void gm_ln_phase(const T* P, ProjL L, const float* g, const float* b, float* VN, long n_rows, int gw, int ngw, int lane) {
    for (long row = gw; row < n_rows; row += ngw) {
        float v[4]; float s = 0.f;
#pragma unroll
        for (int j = 0; j < 4; ++j) { const float x = ldf(P + row * L.ld + L.gv + j * 64 + lane); v[j] = PRE ? x : gelu_tanh_f(x); s += v[j]; }
        const float mean = wave_sum(s) * (1.f / 256.f); float s2 = 0.f;
#pragma unroll
        for (int j = 0; j < 4; ++j) { v[j] -= mean; s2 += v[j] * v[j]; }
        const float rstd = rsqrtf(wave_sum(s2) * (1.f / 256.f) + 1e-5f);
#pragma unroll
        for (int j = 0; j < 4; ++j) VN[row * GM_W + j * 64 + lane] = v[j] * rstd * g[j * 64 + lane] + b[j * 64 + lane];
    }
}
template <class T, bool PRE> __device__ __forceinline__ void gm_mix_phase(const T* P, ProjL L, const float* VN, const float* ws_, const float* bs, float* GO, int ldo, long n_rows, long gt, long ngt) {
    for (long it = gt; it < n_rows * GM_W; it += ngt) {
        const int c = (int)(it % GM_W); const long row = it / GM_W; const int t = (int)(row % GM_CHUNK), g = c / 64; const long base = row - t;
        const float* w = ws_ + ((long)g * GM_CHUNK + t) * GM_CHUNK; float acc = 0.f;
        for (int s = 0; s <= t; ++s) acc += w[s] * VN[(base + s) * GM_W + c];
        acc += bs[g * GM_CHUNK + t];
        const float x = ldf(P + row * L.ld + L.gu + c); const float u = PRE ? x : gelu_tanh_f(x);
        GO[row * ldo + c] = u * acc;
    }
}

__device__ __forceinline__ void moe_route_phase(const float* H, const float* Wr, int* CNT, int* TE, float* TP, int* TS, long n_rows, int gw, int ngw, int lane) {
    for (long row = gw; row < n_rows; row += ngw) {
        float acc[N_EXP];
#pragma unroll
        for (int e = 0; e < N_EXP; ++e) acc[e] = 0.f;
        for (int j = 0; j < 16; ++j) { const int d = j * 64 + lane; const float hv = H[row * DM + d];
            const float4 w0 = *(const float4*)(Wr + d * N_EXP), w1 = *(const float4*)(Wr + d * N_EXP + 4);
            acc[0] += hv * w0.x; acc[1] += hv * w0.y; acc[2] += hv * w0.z; acc[3] += hv * w0.w; acc[4] += hv * w1.x; acc[5] += hv * w1.y; acc[6] += hv * w1.z; acc[7] += hv * w1.w; }
#pragma unroll
        for (int e = 0; e < N_EXP; ++e) acc[e] = wave_sum(acc[e]);
        int e0 = 0; float v0 = acc[0];
#pragma unroll
        for (int e = 1; e < N_EXP; ++e) if (acc[e] > v0) { v0 = acc[e]; e0 = e; }
        int e1 = -1; float v1 = -3.0e38f;
#pragma unroll
        for (int e = 0; e < N_EXP; ++e) if (e != e0 && acc[e] > v1) { v1 = acc[e]; e1 = e; }
        const float p1 = __expf(v1 - v0), den = 1.f + p1;
        if (lane == 0) {
            const int s0 = atomicAdd(&CNT[e0], 1), s1 = atomicAdd(&CNT[e1], 1);
            TE[row * 2] = e0; TE[row * 2 + 1] = e1; TP[row * 2] = 1.f / den; TP[row * 2 + 1] = p1 / den; TS[row * 2] = s0; TS[row * 2 + 1] = s1;
        }
    }
}

__device__ __forceinline__ void moe_route_block(const bf16* H, const float* Wr, int* CNT, int* TE, float* TP, int* TS, long n_rows, int gw_, int ngw_, int lane, int wave, int tid,
                                                __attribute__((address_space(3))) int* sh  ) {
    asm volatile("" : "+v"(tid));
    if (tid < 16) sh[tid] = 0;
    __syncthreads();
    int k = 0;
    for (long row = gw_; row < n_rows; row += ngw_, ++k) {
        float acc[N_EXP];
#pragma unroll
        for (int e = 0; e < N_EXP; ++e) acc[e] = 0.f;
        for (int j = 0; j < 16; ++j) { const int d = j * 64 + lane; const float hv = ldf(H + row * DM + d);
            const float4 w0 = *(const float4*)(Wr + d * N_EXP), w1 = *(const float4*)(Wr + d * N_EXP + 4);
            acc[0] += hv * w0.x; acc[1] += hv * w0.y; acc[2] += hv * w0.z; acc[3] += hv * w0.w; acc[4] += hv * w1.x; acc[5] += hv * w1.y; acc[6] += hv * w1.z; acc[7] += hv * w1.w; }
#pragma unroll
        for (int e = 0; e < N_EXP; ++e) acc[e] = wave_sum(acc[e]);
        int e0 = 0; float v0 = acc[0];
#pragma unroll
        for (int e = 1; e < N_EXP; ++e) if (acc[e] > v0) { v0 = acc[e]; e0 = e; }
        int e1 = -1; float v1 = -3.0e38f;
#pragma unroll
        for (int e = 0; e < N_EXP; ++e) if (e != e0 && acc[e] > v1) { v1 = acc[e]; e1 = e; }
        const float p1 = __expf(v1 - v0), den = 1.f + p1;
        if (lane == 0) {
            const int l0 = atomicAdd((int*)&sh[e0], 1), l1 = atomicAdd((int*)&sh[e1], 1);
            TE[row * 2] = e0; TE[row * 2 + 1] = e1; TP[row * 2] = 1.f / den; TP[row * 2 + 1] = p1 / den;
            sh[16 + (wave * 8 + k) * 4 + 0] = e0; sh[16 + (wave * 8 + k) * 4 + 1] = e1; sh[16 + (wave * 8 + k) * 4 + 2] = l0; sh[16 + (wave * 8 + k) * 4 + 3] = l1;
        }
    }
    __syncthreads();
    if (tid < N_EXP) sh[8 + tid] = atomicAdd(&CNT[tid], sh[tid]);
    __syncthreads();
    k = 0;
    for (long row = gw_; row < n_rows; row += ngw_, ++k)
        if (lane == 0) { const int e0 = sh[16 + (wave * 8 + k) * 4], e1 = sh[16 + (wave * 8 + k) * 4 + 1];
            TS[row * 2] = sh[8 + e0] + sh[16 + (wave * 8 + k) * 4 + 2]; TS[row * 2 + 1] = sh[8 + e1] + sh[16 + (wave * 8 + k) * 4 + 3]; }
    __syncthreads();
}
__device__ __forceinline__ int moe_base(const int* CNT, int e) { int b = 0; for (int i = 0; i < e; ++i) b += (CNT[i] + 255) & ~255; return b; }
__device__ __forceinline__ void moe_scatter_phase(const int* CNT, const int* TE, const float* TP, const int* TS, int* LIST, float* SP, int* GS, long n_rows, long gt, long ngt) {
    for (long it = gt; it < n_rows * 2; it += ngt) {
        const int e = TE[it]; const int gs = moe_base(CNT, e) + TS[it];
        LIST[gs] = (int)(it >> 1); SP[gs] = TP[it]; GS[it] = gs;
    }
}

template <class TA, int EPI> __global__ void __launch_bounds__(256) sgemm_k(const TA* A, int lda, const int* rowlist, const float* B, const float* B2, int ldb, long bstride, void* Cv, int ldc, int M, int N, int K, const int* CNT, const float* scale) {
    __shared__ float As[16][68], Bs[16][68], Bs2[16][68];
    int row_base = 0, mrows = M;
    if (CNT) { const int e = blockIdx.z; row_base = moe_base(CNT, e); mrows = CNT[e]; B += (long)e * bstride; if (B2) B2 += (long)e * bstride; }
    const int m0 = blockIdx.y * 64; if (m0 >= mrows) return;
    const int n0 = blockIdx.x * 64, tid = threadIdx.x, tx = tid & 15, ty = tid >> 4;
    float acc[4][4], acc2[4][4];
#pragma unroll
    for (int i = 0; i < 4; ++i)
#pragma unroll
        for (int j = 0; j < 4; ++j) { acc[i][j] = 0.f; acc2[i][j] = 0.f; }
    const int ar = tid >> 2, ak = (tid & 3) * 4; long arow = -1;
    { const int lr = m0 + ar; if (lr < mrows) { arow = rowlist ? (long)rowlist[row_base + lr] : (long)(row_base + lr); } }
    const int bk = tid >> 4, bn = (tid & 15) * 4;
    for (int k0 = 0; k0 < K; k0 += 16) {
        float av[4] = {0.f, 0.f, 0.f, 0.f};
        if (arow >= 0) {
#pragma unroll
            for (int i = 0; i < 4; ++i) av[i] = ldf(A + arow * lda + k0 + ak + i);
        }
#pragma unroll
        for (int i = 0; i < 4; ++i) As[ak + i][ar] = av[i];
#pragma unroll
        for (int i = 0; i < 4; ++i) { const int n = n0 + bn + i; const bool ok = n < N;
            Bs[bk][bn + i] = ok ? B[(long)(k0 + bk) * ldb + n] : 0.f;
            if (EPI == 1 || EPI == 2) Bs2[bk][bn + i] = ok ? B2[(long)(k0 + bk) * ldb + n] : 0.f; }
        __syncthreads();
#pragma unroll
        for (int kk = 0; kk < 16; ++kk) {
            float a[4], b[4], b2[4];
#pragma unroll
            for (int i = 0; i < 4; ++i) { a[i] = As[kk][ty * 4 + i]; b[i] = Bs[kk][tx * 4 + i]; if (EPI == 1 || EPI == 2) b2[i] = Bs2[kk][tx * 4 + i]; }
#pragma unroll
            for (int i = 0; i < 4; ++i)
#pragma unroll
                for (int j = 0; j < 4; ++j) { acc[i][j] += a[i] * b[j]; if (EPI == 1 || EPI == 2) acc2[i][j] += a[i] * b2[j]; }
        }
        __syncthreads();
    }
#pragma unroll
    for (int i = 0; i < 4; ++i) { const int lr = m0 + ty * 4 + i; if (lr >= mrows) continue; const long crow = row_base + lr;
#pragma unroll
        for (int j = 0; j < 4; ++j) { const int n = n0 + tx * 4 + j; if (n >= N) continue;
            float v = acc[i][j];
            if (EPI == 1 || EPI == 2) v = silu_f(v) * acc2[i][j];
            if (EPI == 3) v *= scale[crow];
            if (EPI == 2) ((bf16*)Cv)[crow * ldc + n] = (bf16)f2bf(v); else ((float*)Cv)[crow * ldc + n] = v; } }
}

#define GW_DECL const int lane = threadIdx.x & 63; const int gw = (int)((blockIdx.x * (long)blockDim.x + threadIdx.x) >> 6); const int ngw = (int)((gridDim.x * (long)blockDim.x) >> 6); (void)lane; (void)gw; (void)ngw;
#define GT_DECL const long gt = blockIdx.x * (long)blockDim.x + threadIdx.x; const long ngt = gridDim.x * (long)blockDim.x;

__global__ void k_ln_in(const float* x, const float* g, const float* b, float* H, long n_rows) { GW_DECL for (long r = gw; r < n_rows; r += ngw) ln_row<float>(x + r * DM, 1.f, nullptr, nullptr, g, b, H + r * DM, nullptr, lane); }
__global__ void k_ln_res(float* H, const float* Y, const float* g, const float* b, float* OUT, long n_rows) { GW_DECL for (long r = gw; r < n_rows; r += ngw) ln_row<float>(H + r * DM, ALPHA, Y + r * DM, nullptr, g, b, OUT + r * DM, nullptr, lane); }
__global__ void k_ln_moe(float* H, const float* F2, const int* GS, const float* g, const float* b, float* OUT, long n_rows) { GW_DECL for (long r = gw; r < n_rows; r += ngw) ln_row<float>(H + r * DM, ALPHA, F2 + (long)GS[r * 2] * DM, F2 + (long)GS[r * 2 + 1] * DM, g, b, OUT + r * DM, nullptr, lane); }
__global__ void k_rope(float* P, ProjL L, const int* pos, long n_rows) { GT_DECL rope_inplace(P, L, pos, n_rows, gt, ngt); }
__global__ void k_kmean(const float* P, ProjL L, float* KM, int nb) { GT_DECL kmean_phase<float>(P, L, KM, nb, gt, ngt); }
__global__ void k_attn(const float* P, ProjL L, const float* KM, float* O, int ldo, int nb) { GW_DECL attn_naive_phase<float>(P, L, KM, O, ldo, nb, gw, ngw, lane); }
__global__ void k_rms384(const float* in, int ldi, const float* g, float* out, int ldo, long n_rows) { GW_DECL rms_rows_phase<384, float>(in, ldi, g, out, ldo, n_rows, gw, ngw, lane); }
__global__ void k_rms256(const float* in, int ldi, const float* g, float* out, int ldo, long n_rows) { GW_DECL rms_rows_phase<256, float>(in, ldi, g, out, ldo, n_rows, gw, ngw, lane); }
__global__ void k_ssd_conv(const float* P, ProjL L, const float* cw, const float* cb, const float* dtb, float* XC, float* DT, long n_rows) { GT_DECL ssd_conv_phase<float, float>(P, L, cw, cb, dtb, XC, DT, n_rows, gt, ngt); }
__global__ void k_ssd_scan(const float* XC, const float* DT, const float* a_log, const float* dsk, float* Y, int ldo, int nb) { GW_DECL ssd_scan_naive_phase<float>(XC, DT, a_log, dsk, Y, ldo, nb, gw, ngw, lane); }
__global__ void k_ssd_gate(const float* Y, int ldi, const float* P, ProjL L, const float* ng, float* out, int ldo, long n_rows) { GW_DECL ssd_gate_phase<float, float>(Y, ldi, P, L, ng, out, ldo, n_rows, gw, ngw, lane); }
__global__ void k_gm_ln(const float* P, ProjL L, const float* g, const float* b, float* VN, long n_rows) { GW_DECL gm_ln_phase<float, false>(P, L, g, b, VN, n_rows, gw, ngw, lane); }
__global__ void k_gm_mix(const float* P, ProjL L, const float* VN, const float* ws_, const float* bs, float* GO, int ldo, long n_rows) { GT_DECL gm_mix_phase<float, false>(P, L, VN, ws_, bs, GO, ldo, n_rows, gt, ngt); }
__global__ void k_moe_init(int* CNT, int* LIST, int nslots) { GT_DECL if (gt < N_EXP) CNT[gt] = 0; for (long i = gt; i < nslots; i += ngt) LIST[i] = -1; }
__global__ void k_moe_route(const float* H, const float* Wr, int* CNT, int* TE, float* TP, int* TS, long n_rows) { GW_DECL moe_route_phase(H, Wr, CNT, TE, TP, TS, n_rows, gw, ngw, lane); }
__global__ void k_moe_scatter(const int* CNT, const int* TE, const float* TP, const int* TS, int* LIST, float* SP, int* GS, long n_rows) { GT_DECL moe_scatter_phase(CNT, TE, TP, TS, LIST, SP, GS, n_rows, gt, ngt); }

struct Inputs {
    const float *x; const int* pos; const float *ln_in_g, *ln_in_b, *w_in, *conv_w, *conv_b, *dt_bias, *a_log, *d_skip, *ssd_norm_g, *att_norm_g, *gm_ln_g, *gm_ln_b, *gm_w_s, *gm_b_s, *gm_norm_g, *w_out,
        *ln1_g, *ln1_b, *ln2_g, *ln2_b, *ffn_w_gate, *ffn_w_up, *ffn_w_down, *router_w, *moe_w_gate, *moe_w_up, *moe_w_down;
};

static void run_simple(const Inputs& I, int nb, unsigned char* ws, float* aux  , float* OUT, hipStream_t st, float* ckpt = nullptr) {
    const long M = (long)nb * SEQ; const size_t MB = 1u << 20;
    const size_t hsz = (size_t)M * DM * 4;
    float* H = (float*)ws; float* MIX = (float*)(ws + hsz); float* Y = (float*)(ws + 2 * hsz); unsigned char* BIG = ws + 3 * hsz + (size_t)N_EXP * 256 * DM * 4;
    float* XC = Y;
    float* VN = aux;
    float* PROJ = (float*)BIG;
    size_t big_bytes = (size_t)M * D_IN * 4; { size_t a = (size_t)M * D_FF * 4; if (a > big_bytes) big_bytes = a; size_t c = (size_t)(2 * M + N_EXP * 256) * D_FFE * 2; if (c > big_bytes) big_bytes = c; }
    big_bytes = (big_bytes + 255) & ~(size_t)255;
    unsigned char* SM = BIG + big_bytes;
    float* KM = (float*)SM; SM += (size_t)nb * ATT_H * NBLK * 64 * 4;
    float* DT = (float*)SM; SM += (size_t)M * SSD_H * 4;
    int* CNT = (int*)SM; SM += 256;
    int* TE = (int*)SM; SM += (size_t)M * 2 * 4; float* TP = (float*)SM; SM += (size_t)M * 2 * 4; int* TS = (int*)SM; SM += (size_t)M * 2 * 4; int* GS = (int*)SM; SM += (size_t)M * 2 * 4;
    const int nslots = (int)(2 * M + N_EXP * 256);
    int* LIST = (int*)SM; SM += (size_t)nslots * 4; float* SP = (float*)SM; SM += (size_t)nslots * 4;
    (void)MB;
    const ProjL L{D_IN, 0, 384, 768, 1152, 1536, 2432, 2438, 2694};
    const int TB = 256; const int GWB = 2048;
    k_ln_in<<<GWB, TB, 0, st>>>(I.x, I.ln_in_g, I.ln_in_b, H, M);
    for (int i = 0; i < 2; ++i) {
        sgemm_k<float, 0><<<dim3((D_IN + 63) / 64, (unsigned)(M / 64), 1), 256, 0, st>>>(H, DM, nullptr, I.w_in + (size_t)i * DM * D_IN, nullptr, D_IN, 0, PROJ, D_IN, (int)M, D_IN, DM, nullptr, nullptr);
        k_rope<<<GWB, TB, 0, st>>>(PROJ, L, I.pos, M);
        const size_t ck_stride = (size_t)M * (D_IN + 3 * DM); float* ck = ckpt ? ckpt + (size_t)i * ck_stride : nullptr;
        if (ck) hipMemcpyAsync(ck, PROJ, (size_t)M * D_IN * 4, hipMemcpyDeviceToDevice, st);
        k_kmean<<<96 * nb, TB, 0, st>>>(PROJ, L, KM, nb);
        k_attn<<<GWB * 2, TB, 0, st>>>(PROJ, L, KM, MIX, DM, nb);
        k_rms384<<<GWB, TB, 0, st>>>(MIX, DM, I.att_norm_g + i * ATT_W, MIX, DM, M);
        k_ssd_conv<<<GWB * 2, TB, 0, st>>>(PROJ, L, I.conv_w + (size_t)i * 4 * SSD_CW, I.conv_b + i * SSD_CW, I.dt_bias + i * SSD_H, XC, DT, M);
        k_ssd_scan<<<(nb * SSD_H * 64 * 64 + TB - 1) / TB, TB, 0, st>>>(XC, DT, I.a_log + i * SSD_H, I.d_skip + i * SSD_H, MIX + ATT_W, DM, nb);
        k_ssd_gate<<<GWB, TB, 0, st>>>(MIX + ATT_W, DM, PROJ, L, I.ssd_norm_g + i * SSD_W, MIX + ATT_W, DM, M);
        k_gm_ln<<<GWB, TB, 0, st>>>(PROJ, L, I.gm_ln_g + i * GM_W, I.gm_ln_b + i * GM_W, VN, M);
        k_gm_mix<<<GWB * 2, TB, 0, st>>>(PROJ, L, VN, I.gm_w_s + (size_t)i * GM_G * GM_CHUNK * GM_CHUNK, I.gm_b_s + i * GM_G * GM_CHUNK, MIX + ATT_W + SSD_W, DM, M);
        k_rms256<<<GWB, TB, 0, st>>>(MIX + ATT_W + SSD_W, DM, I.gm_norm_g + i * GM_W, MIX + ATT_W + SSD_W, DM, M);
        if (ck) hipMemcpyAsync(ck + (size_t)M * D_IN, MIX, hsz, hipMemcpyDeviceToDevice, st);
        sgemm_k<float, 0><<<dim3(DM / 64, (unsigned)(M / 64), 1), 256, 0, st>>>(MIX, DM, nullptr, I.w_out + (size_t)i * DM * DM, nullptr, DM, 0, Y, DM, (int)M, DM, DM, nullptr, nullptr);
        k_ln_res<<<GWB, TB, 0, st>>>(H, Y, I.ln1_g + i * DM, I.ln1_b + i * DM, H, M);
        if (ck) hipMemcpyAsync(ck + (size_t)M * (D_IN + DM), H, hsz, hipMemcpyDeviceToDevice, st);
        if (i == 0) {
            float* ACT = (float*)BIG;
            sgemm_k<float, 1><<<dim3(D_FF / 64, (unsigned)(M / 64), 1), 256, 0, st>>>(H, DM, nullptr, I.ffn_w_gate, I.ffn_w_up, D_FF, 0, ACT, D_FF, (int)M, D_FF, DM, nullptr, nullptr);
            sgemm_k<float, 0><<<dim3(DM / 64, (unsigned)(M / 64), 1), 256, 0, st>>>(ACT, D_FF, nullptr, I.ffn_w_down, nullptr, DM, 0, Y, DM, (int)M, DM, D_FF, nullptr, nullptr);
            k_ln_res<<<GWB, TB, 0, st>>>(H, Y, I.ln2_g + i * DM, I.ln2_b + i * DM, H, M);
            if (ck) hipMemcpyAsync(ck + (size_t)M * (D_IN + 2 * DM), H, hsz, hipMemcpyDeviceToDevice, st);
        } else {
            bf16* ACTM = (bf16*)BIG; float* F2 = MIX;
            k_moe_init<<<256, TB, 0, st>>>(CNT, LIST, nslots);
            k_moe_route<<<GWB, TB, 0, st>>>(H, I.router_w, CNT, TE, TP, TS, M);
            k_moe_scatter<<<256, TB, 0, st>>>(CNT, TE, TP, TS, LIST, SP, GS, M);
            sgemm_k<float, 2><<<dim3(D_FFE / 64, (unsigned)(M / 64), N_EXP), 256, 0, st>>>(H, DM, LIST, I.moe_w_gate, I.moe_w_up, D_FFE, (long)DM * D_FFE, ACTM, D_FFE, 0, D_FFE, DM, CNT, nullptr);
            sgemm_k<bf16, 3><<<dim3(DM / 64, (unsigned)(M / 64), N_EXP), 256, 0, st>>>(ACTM, D_FFE, nullptr, I.moe_w_down, nullptr, DM, (long)D_FFE * DM, F2, DM, 0, DM, D_FFE, CNT, SP);
            k_ln_moe<<<GWB, TB, 0, st>>>(H, F2, GS, I.ln2_g + i * DM, I.ln2_b + i * DM, OUT, M);
            if (ck) hipMemcpyAsync(ck + (size_t)M * (D_IN + 2 * DM), OUT, hsz, hipMemcpyDeviceToDevice, st);
        }
    }
}

#define LAS __attribute__((address_space(3)))
namespace pg8 {
#define PG8_LAS __attribute__((address_space(3)))
typedef unsigned short bf16_t;
typedef short bf16x8 __attribute__((ext_vector_type(8)));
typedef float f32x4 __attribute__((ext_vector_type(4)));
typedef unsigned u32x4 __attribute__((ext_vector_type(4)));
constexpr int BM = 256, BK = 64, HALF = 128, HTB = HALF * BK * 2  , STAGE_BYTES = 8 * HTB, NXCD = 8, WGM = 8;

__host__ __device__ __forceinline__ int lds_byte(int r, int c) { const int st = (r >> 4) * 2 + (c >> 5), rr = r & 15, cc = c & 31, ob = rr * 64 + cc * 2; return st * 1024 + (ob ^ (((ob >> 9) & 1) << 5)); }
__host__ __device__ __forceinline__ void stage_rc(int b, int& R, int& C) { const int st = b / 1024, sb = b % 1024, swz = sb ^ (((sb >> 9) & 1) << 5); R = (st >> 1) * 16 + swz / 64; C = (st & 1) * 32 + (swz % 64) / 2; }
__host__ __device__ __forceinline__ int perm32(int rho) { const int n = rho >> 4, i = rho & 15; return 8 * (i >> 2) + 4 * n + (i & 3); }

struct Unit { int pm, pn, kofs; };
struct Gemm { const bf16_t* A; const bf16_t* Bt; int M, N, K, ld; };

struct StaticOrder {
    int nM, nN, nwg, G, c;
    __host__ __device__ void init(int M, int N, int G_, int c_) { nM = M / BM; nN = N / BM; nwg = nM * nN; G = G_; c = c_; }
    __host__ __device__ bool next(int i, Unit& u) const {
        const long L = (long)i * G + c; if (L >= nwg) return false;
        int wgid = (int)L; { const int q = nwg / NXCD, r = nwg % NXCD, xcd = wgid % NXCD, off = wgid / NXCD; wgid = (xcd < r ? xcd * (q + 1) : r * (q + 1) + (xcd - r) * q) + off; }
        const int nig = WGM * nN, gid = wgid / nig, fm = gid * WGM, gsz = (nM - fm) < WGM ? (nM - fm) : WGM;
        u.pm = fm + ((wgid % nig) % gsz); u.pn = (wgid % nig) / gsz; u.kofs = 0; return true;
    }
    __device__ __forceinline__ void a_ready(const Unit&) const {}
    __device__ __forceinline__ void done(const Unit&) const {}
};
__device__ __forceinline__ unsigned cvt_pk_bf16(float lo, float hi) { unsigned r; asm volatile("v_cvt_pk_bf16_f32 %0, %1, %2" : "=v"(r) : "v"(lo), "v"(hi)); return r; }
typedef float f32x2 __attribute__((ext_vector_type(2)));
template <class Epi, class Sched, bool ALIGN_EPI = false, bool SP2 = false>
__device__ __forceinline__ void gemm_phase(PG8_LAS unsigned char* lds, const Gemm g, const Sched& S, const Epi& E, const int tid) {
    const int wid = __builtin_amdgcn_readfirstlane(tid >> 6), lane = tid & 63, wr = wid >> 2, wc = wid & 3, fr = lane & 15, fq = lane >> 4;
    const int K = g.ld, nt = g.K / BK;
    unsigned voffA[2], voffB[2];
#pragma unroll
    for (int i = 0; i < 2; ++i) { int R, C; stage_rc(tid * 16 + i * 8192, R, C); const int Rb = Epi::PERM ? ((R & ~31) + perm32(R & 31)) : R;
        voffA[i] = (unsigned)(R * K + C) * 2u; voffB[i] = (unsigned)(Rb * K + C) * 2u; }
    const size_t kstep = (size_t)(BK * 2);
    const size_t hstep = (size_t)HALF * K * 2;
    const size_t tstep = 2 * hstep;
    const unsigned ldsw = (unsigned)wid * 1024u;
    const int aoff = lds_byte(wr * 64 + fr, fq * 8), boff = lds_byte(wc * 32 + fr, fq * 8);
#define PG8_SA(b, h) (((b) * 2 + (h)) * HTB)
#define PG8_SB(b, h) ((4 + (b) * 2 + (h)) * HTB)
#define PG8_STAGE(bufoff, gbase, voff) do { _Pragma("unroll") for (int _i = 0; _i < 2; ++_i) \
        __builtin_amdgcn_global_load_lds((const unsigned*)((const char*)(gbase) + (voff)[_i]), (PG8_LAS unsigned*)(lds + (bufoff) + ldsw + _i * 8192), 16, 0, 0); } while (0)
#define PG8_LDA(dst, b, h) do { _Pragma("unroll") for (int m = 0; m < 4; ++m) _Pragma("unroll") for (int k = 0; k < 2; ++k) dst[m][k] = *(const PG8_LAS bf16x8*)(lds + PG8_SA(b, h) + aoff + m * 2048 + k * 1024); } while (0)
#define PG8_LDB(dst, b, h) do { _Pragma("unroll") for (int n = 0; n < 2; ++n) _Pragma("unroll") for (int k = 0; k < 2; ++k) dst[n][k] = *(const PG8_LAS bf16x8*)(lds + PG8_SB(b, h) + boff + n * 2048 + k * 1024); } while (0)
#define PG8_MMA(ai, bj, At, Bt) do { __builtin_amdgcn_s_setprio(1); _Pragma("unroll") for (int m = 0; m < 4; ++m) _Pragma("unroll") for (int n = 0; n < 2; ++n) _Pragma("unroll") for (int k = 0; k < 2; ++k) \
        acc[ai][bj][m][n] = __builtin_amdgcn_mfma_f32_16x16x32_bf16(Bt[n][k], At[m][k], acc[ai][bj][m][n], 0, 0, 0); __builtin_amdgcn_s_setprio(0); } while (0)
#define PG8_WAIT_V(n) asm volatile("s_waitcnt vmcnt(" #n ")" ::: "memory")
#define PG8_WAIT_L(n) asm volatile("s_waitcnt lgkmcnt(" #n ")" ::: "memory")
#define PG8_BAR __builtin_amdgcn_s_barrier()
#define PG8_SCHED __builtin_amdgcn_sched_barrier(0)
    Unit cur, nxt; int ui = 0;
    if (!S.next(0, cur)) return;
    f32x4 acc[2][2][4][2];
#pragma unroll
    for (int a = 0; a < 2; ++a)
#pragma unroll
        for (int b = 0; b < 2; ++b)
#pragma unroll
            for (int m = 0; m < 4; ++m)
#pragma unroll
                for (int n = 0; n < 2; ++n) acc[a][b][m][n] = (f32x4){0.f, 0.f, 0.f, 0.f};
    bf16x8 At[4][2], B0[2][2], B1[2][2];
    const char* cA = (const char*)g.A + (size_t)cur.pm * tstep + (size_t)cur.kofs * 2; const char* cB = (const char*)g.Bt + (size_t)cur.pn * tstep + (size_t)cur.kofs * 2;
    S.a_ready(cur);
    if constexpr (SP2) {
        PG8_STAGE(PG8_SB(0, 0), cB, voffB); PG8_STAGE(PG8_SB(0, 1), cB + hstep, voffB); PG8_STAGE(PG8_SA(0, 0), cA, voffA); PG8_STAGE(PG8_SA(0, 1), cA + hstep, voffA);
        if (wr == 1) PG8_BAR;
        PG8_WAIT_V(2); PG8_BAR;
        PG8_STAGE(PG8_SB(1, 0), cB + kstep, voffB); PG8_STAGE(PG8_SA(1, 0), cA + kstep, voffA); PG8_STAGE(PG8_SB(1, 1), cB + hstep + kstep, voffB);
        PG8_WAIT_V(6); PG8_BAR;
    } else {
        PG8_STAGE(PG8_SB(0, 0), cB, voffB); PG8_STAGE(PG8_SA(0, 0), cA, voffA); PG8_STAGE(PG8_SB(0, 1), cB + hstep, voffB); PG8_STAGE(PG8_SA(0, 1), cA + hstep, voffA);
        if (wr == 1) PG8_BAR;
        PG8_WAIT_V(4); PG8_BAR;
        PG8_STAGE(PG8_SB(1, 0), cB + kstep, voffB); PG8_STAGE(PG8_SA(1, 0), cA + kstep, voffA); PG8_STAGE(PG8_SB(1, 1), cB + hstep + kstep, voffB);
        PG8_WAIT_V(6); PG8_BAR;
    }
    for (;;) {
        const bool has_next = S.next(ui + 1, nxt);
        const char* nA = has_next ? (const char*)g.A + (size_t)nxt.pm * tstep + (size_t)nxt.kofs * 2 : cA; const char* nB = has_next ? (const char*)g.Bt + (size_t)nxt.pn * tstep + (size_t)nxt.kofs * 2 : cB;
        for (int t = 0; t < nt; t += 2) {
            const bool last = (t == nt - 2);
            const char* a1 = cA + (size_t)(t + 1) * kstep;
            const char* a2 = last ? nA : cA + (size_t)(t + 2) * kstep; const char* b2 = last ? nB : cB + (size_t)(t + 2) * kstep;
            const char* a3 = a2 + kstep; const char* b3 = b2 + kstep;
            if (last && has_next) S.a_ready(nxt);
            if constexpr (SP2) {
            PG8_LDB(B0, 0, 0); PG8_LDB(B1, 0, 1); PG8_SCHED; PG8_LDA(At, 0, 0); PG8_STAGE(PG8_SA(1, 1), a1 + hstep, voffA);
            PG8_WAIT_V(8); PG8_WAIT_L(0); PG8_BAR; PG8_MMA(0, 0, At, B0); PG8_MMA(0, 1, At, B1); PG8_BAR; PG8_SCHED;
            PG8_LDA(At, 0, 1); PG8_STAGE(PG8_SB(0, 0), b2, voffB); PG8_STAGE(PG8_SB(0, 1), b2 + hstep, voffB); PG8_STAGE(PG8_SA(0, 0), a2, voffA);
            PG8_WAIT_V(8); PG8_WAIT_L(0); PG8_BAR; PG8_MMA(1, 0, At, B0); PG8_MMA(1, 1, At, B1); PG8_BAR; PG8_SCHED;
            PG8_LDB(B0, 1, 0); PG8_LDB(B1, 1, 1); PG8_SCHED; PG8_LDA(At, 1, 0); PG8_STAGE(PG8_SA(0, 1), a2 + hstep, voffA);
            PG8_WAIT_V(8); PG8_WAIT_L(0); PG8_BAR; PG8_MMA(0, 0, At, B0); PG8_MMA(0, 1, At, B1); PG8_BAR; PG8_SCHED;
            PG8_LDA(At, 1, 1); PG8_STAGE(PG8_SB(1, 0), b3, voffB); PG8_STAGE(PG8_SB(1, 1), b3 + hstep, voffB); PG8_STAGE(PG8_SA(1, 0), a3, voffA);
            PG8_WAIT_V(8); PG8_WAIT_L(0); PG8_BAR; PG8_MMA(1, 0, At, B0); PG8_MMA(1, 1, At, B1); PG8_BAR; PG8_SCHED;
            } else {
            PG8_LDB(B0, 0, 0); PG8_SCHED; PG8_LDA(At, 0, 0); PG8_STAGE(PG8_SA(1, 1), a1 + hstep, voffA);
            PG8_WAIT_L(8); PG8_BAR; PG8_WAIT_L(0); PG8_MMA(0, 0, At, B0); PG8_BAR; PG8_SCHED;
            PG8_LDB(B1, 0, 1); PG8_STAGE(PG8_SB(0, 0), b2, voffB);
            PG8_BAR; PG8_WAIT_L(0); PG8_MMA(0, 1, At, B1); PG8_BAR;
            PG8_LDA(At, 0, 1); PG8_STAGE(PG8_SA(0, 0), a2, voffA);
            PG8_BAR; PG8_WAIT_L(0); PG8_MMA(1, 0, At, B0); PG8_BAR; PG8_SCHED;
            PG8_STAGE(PG8_SB(0, 1), b2 + hstep, voffB);
            PG8_WAIT_V(6); PG8_BAR; PG8_MMA(1, 1, At, B1); PG8_BAR;
            PG8_LDB(B0, 1, 0); PG8_SCHED; PG8_LDA(At, 1, 0); PG8_STAGE(PG8_SA(0, 1), a2 + hstep, voffA);
            PG8_WAIT_L(8); PG8_BAR; PG8_WAIT_L(0); PG8_MMA(0, 0, At, B0); PG8_BAR; PG8_SCHED;
            PG8_LDB(B1, 1, 1); PG8_STAGE(PG8_SB(1, 0), b3, voffB);
            PG8_BAR; PG8_WAIT_L(0); PG8_MMA(0, 1, At, B1); PG8_BAR;
            PG8_LDA(At, 1, 1); PG8_STAGE(PG8_SA(1, 0), a3, voffA);
            PG8_BAR; PG8_WAIT_L(0); PG8_MMA(1, 0, At, B0); PG8_BAR; PG8_SCHED;
            PG8_STAGE(PG8_SB(1, 1), b3 + hstep, voffB);
            PG8_WAIT_V(6); PG8_BAR; PG8_MMA(1, 1, At, B1); PG8_BAR;
            }
        }
        if constexpr (ALIGN_EPI) { if (wr == 0) PG8_BAR; }
        if constexpr (!Epi::AFTER_DRAIN) { E(acc, cur, wr, wc, fr, fq); S.done(cur); }
        if (!has_next) break;
#pragma unroll
        for (int a = 0; a < 2; ++a)
#pragma unroll
            for (int b = 0; b < 2; ++b)
#pragma unroll
                for (int m = 0; m < 4; ++m)
#pragma unroll
                    for (int n = 0; n < 2; ++n) acc[a][b][m][n] = (f32x4){0.f, 0.f, 0.f, 0.f};
        cur = nxt; cA = nA; cB = nB; ++ui;
        if constexpr (ALIGN_EPI) { if (wr == 1) PG8_BAR; }
    }
    PG8_WAIT_V(0);
    if constexpr (!ALIGN_EPI) { if (wr == 0) PG8_BAR; }
    PG8_BAR;
    if constexpr (Epi::AFTER_DRAIN) { E.fused(acc, cur, wr, wc, fr, fq, lds, wid, lane); S.done(cur); }
#undef PG8_SA
#undef PG8_SB
#undef PG8_STAGE
#undef PG8_LDA
#undef PG8_LDB
#undef PG8_MMA
#undef PG8_WAIT_V
#undef PG8_WAIT_L
#undef PG8_BAR
#undef PG8_SCHED
}
}
#define XB_TMO      128
#define XB_XCNT(j)  (256  + 64 * (j))
#define XB_XSUB(j)  (1280 + 64 * (j))
#define XB_XGEN(j)  (2304 + 64 * (j))
#define XB_TOP      3328
#define XB_TOPGEN   3392
#define XCD_BAR_WORDS 3456
#define XB_SPIN_CAP (1u << 24)

__device__ __forceinline__ unsigned xb_ld(unsigned* p)              { return __hip_atomic_load(p, __ATOMIC_RELAXED, __HIP_MEMORY_SCOPE_AGENT); }
__device__ __forceinline__ unsigned xb_add(unsigned* p, unsigned v) { return __hip_atomic_fetch_add(p, v, __ATOMIC_RELAXED, __HIP_MEMORY_SCOPE_AGENT); }
__device__ __forceinline__ unsigned xb_xcc_id() { return (unsigned)__builtin_amdgcn_s_getreg((3 << 11) | 20) & 0xFu; }
#define XB_SPIN(cond, bar) do { unsigned _sp = 0; while (cond) { __builtin_amdgcn_s_sleep(1); \
    if ((++_sp & 255u) == 0u) { if (xb_ld(&(bar)[XB_TMO])) break; if (_sp > XB_SPIN_CAP) { atomicAdd(&(bar)[XB_TMO], 1u); break; } } } } while (0)

struct XcdBarrier {
    unsigned* bar; unsigned x; int w0;
    volatile LAS unsigned* st;
};

__device__ __forceinline__ XcdBarrier xcd_barrier_post(unsigned* bar, volatile LAS unsigned* st) {
    XcdBarrier b; b.bar = bar; b.x = xb_xcc_id(); b.st = st; b.w0 = (__builtin_amdgcn_readfirstlane((int)threadIdx.x >> 6) == 0);
    if (threadIdx.x == 0) (void)xb_add(&bar[XB_XCNT(b.x)], 1u);
    return b;
}
__device__ __forceinline__ void xcd_barrier_complete(unsigned* bar, unsigned x, unsigned& nloc, unsigned& nx) {
    const unsigned G = gridDim.x * gridDim.y * gridDim.z;
    unsigned sum, cnt, mine, sp = 0u;
    for (;;) {
        sum = 0u; cnt = 0u; mine = 0u;
#pragma unroll
        for (unsigned j = 0; j < 16; ++j) { const unsigned c = xb_ld(&bar[XB_XCNT(j)]); sum += c; cnt += (c > 0u) ? 1u : 0u; mine = (j == x) ? c : mine; }
        if (sum == G) break;
        __builtin_amdgcn_s_sleep(1);
        if ((++sp & 255u) == 0u) { if (xb_ld(&bar[XB_TMO])) break; if (sp > XB_SPIN_CAP) { atomicAdd(&bar[XB_TMO], 1u); break; } }
    }
    nloc = mine > 0u ? mine : 1u; nx = cnt > 0u ? cnt : 1u;
}

__device__ __forceinline__ void xcd_barrier(const XcdBarrier& b) {
    asm volatile("s_waitcnt vmcnt(0)" ::: "memory");
    __syncthreads();
    if (b.w0 && __builtin_amdgcn_mbcnt_hi(~0u, __builtin_amdgcn_mbcnt_lo(~0u, 0u)) == 0u) {
        unsigned* bar = b.bar;
        __builtin_amdgcn_s_waitcnt(0);
        unsigned nloc = b.st[0], nx = b.st[1];
        if (nloc == 0u) { xcd_barrier_complete(bar, b.x, nloc, nx); b.st[0] = nloc; b.st[1] = nx; }
        const unsigned old = xb_add(&bar[XB_XSUB(b.x)], 1u);
        const unsigned gen = old / nloc;
        if (old + 1u == (gen + 1u) * nloc) {
            __builtin_amdgcn_fence(__ATOMIC_RELEASE, "agent");
            asm volatile("s_waitcnt vmcnt(0)" ::: "memory");
            const unsigned og = xb_add(&bar[XB_TOP], 1u);
            const unsigned tg = og / nx;
            if (og + 1u == (tg + 1u) * nx) xb_add(&bar[XB_TOPGEN], 1u);
            else XB_SPIN(xb_ld(&bar[XB_TOPGEN]) == tg, bar);
            __builtin_amdgcn_fence(__ATOMIC_ACQUIRE, "agent");
            xb_add(&bar[XB_XGEN(b.x)], 1u);
            asm volatile("s_waitcnt vmcnt(0)" ::: "memory");
        } else {
            XB_SPIN(xb_ld(&bar[XB_XGEN(b.x)]) == gen, bar);
            __builtin_amdgcn_fence(__ATOMIC_ACQUIRE, "agent");
            asm volatile("s_waitcnt vmcnt(0)" ::: "memory");
        }
    }
    __syncthreads();
}
#include <hip/hip_bf16.h>
#include <cmath>
namespace attn_body {
using bf16=__hip_bfloat16;
using bf16x8=__attribute__((ext_vector_type(8)))short;
using s16x4=__attribute__((ext_vector_type(4)))short;
using f32x16=__attribute__((ext_vector_type(16)))float;
using u32x4=__attribute__((ext_vector_type(4)))unsigned;
constexpr int NHEAD=6,SEQ=2048,D=64,QP=3072,OP=1024;
constexpr int NW=8,QBLK=32,QB=QBLK*NW,KVBLK=64,NQB=SEQ/QB;
constexpr int ATTN_UNIT_ROWS=QB;
__device__ __forceinline__ int crow(int r,int hi){return (r&3)+8*(r>>2)+4*hi;}
#define SBAR() __builtin_amdgcn_sched_barrier(0)
__device__ __forceinline__ void cmask(f32x16&p0,f32x16&p1,int jb,int qrel,int hi){
  const float NEG=-INFINITY; int kb=64*jb+4*hi;
  #pragma unroll
  for(int r=0;r<16;++r){int kv=kb+(r&3)+8*(r>>2); if(kv>qrel)p0[r]=NEG; if(kv+32>qrel)p1[r]=NEG;}
}

constexpr int NSLOT=3, SLOTB=8192;
constexpr int LDS_K=0, LDS_V=NSLOT*SLOTB, LDS_WS=2*NSLOT*SLOTB, LDS_OST=LDS_WS+NW*64*4, LDS_BYTES=LDS_OST+NW*4096;
constexpr float C2=0.125f*1.4426950408889634f;
__device__ __forceinline__ void glds16(const void*gsrc,unsigned lds_dst){unsigned keep;
  asm volatile("s_mov_b32 %0, m0\n\ts_mov_b32 m0, %2\n\ts_nop 0\n\tglobal_load_lds_dwordx4 %1, off\n\ts_mov_b32 m0, %0":"=&s"(keep):"v"(gsrc),"s"(lds_dst):"memory");}
__device__ __forceinline__ float max3f(float a,float b,float c){float r;asm("v_max3_f32 %0, %1, %2, %3":"=v"(r):"v"(a),"v"(b),"v"(c));return r;}
__device__ __forceinline__ float max2f(float a,float b){float r;asm("v_max_f32_e32 %0, %1, %2":"=v"(r):"v"(a),"v"(b));return r;}
__device__ __forceinline__ float fadd_s(float a,float b){float r;asm("v_add_f32_e32 %0, %1, %2":"=v"(r):"v"(a),"v"(b));return r;}
__device__ __forceinline__ float fsub_s(float a,float b){float r;asm("v_sub_f32_e32 %0, %1, %2":"=v"(r):"v"(a),"v"(b));return r;}
typedef float f32x2_t __attribute__((ext_vector_type(2))); typedef __bf16 bf16x2_t __attribute__((ext_vector_type(2)));
__device__ __forceinline__ unsigned cvtpk_s(float lo,float hi){f32x2_t v={lo,hi};bf16x2_t b=__builtin_convertvector(v,bf16x2_t);return __builtin_bit_cast(unsigned,b);}
#define WAIT_BAR(N) asm volatile("s_waitcnt vmcnt(" #N ") lgkmcnt(0)\n\ts_barrier":::"memory")

__device__ __forceinline__ void qkt(f32x16&p0,f32x16&p1,const char*Kslot,const bf16x8*qr,int r32,int hi){ const f32x16 negm=f32x16{};
  const char*kb=Kslot+hi*1024+r32*16;
  #pragma unroll
  for(int d0=0;d0<4;++d0){
    const bf16x8 b0=*reinterpret_cast<const bf16x8*>(kb+d0*2048);
    const bf16x8 b1=*reinterpret_cast<const bf16x8*>(kb+d0*2048+512);
    if(d0==0){p0=__builtin_amdgcn_mfma_f32_32x32x16_bf16(b0,qr[0],negm,0,0,0);p1=__builtin_amdgcn_mfma_f32_32x32x16_bf16(b1,qr[0],negm,0,0,0);}
    else{p0=__builtin_amdgcn_mfma_f32_32x32x16_bf16(b0,qr[d0],p0,0,0,0);p1=__builtin_amdgcn_mfma_f32_32x32x16_bf16(b1,qr[d0],p1,0,0,0);}}
}
typedef __attribute__((address_space(3))) const char* lds_cptr;
typedef short v4i16_t __attribute__((ext_vector_type(4)));
__device__ __forceinline__ void kload8(bf16x8*kf,lds_cptr kp){
  kf[0]=*(const __attribute__((address_space(3))) bf16x8*)(kp);      kf[1]=*(const __attribute__((address_space(3))) bf16x8*)(kp+512);
  kf[2]=*(const __attribute__((address_space(3))) bf16x8*)(kp+2048); kf[3]=*(const __attribute__((address_space(3))) bf16x8*)(kp+2560);
  kf[4]=*(const __attribute__((address_space(3))) bf16x8*)(kp+4096); kf[5]=*(const __attribute__((address_space(3))) bf16x8*)(kp+4608);
  kf[6]=*(const __attribute__((address_space(3))) bf16x8*)(kp+6144); kf[7]=*(const __attribute__((address_space(3))) bf16x8*)(kp+6656);
}
__device__ __forceinline__ void kload2(bf16x8*kf,lds_cptr kp,int j){ kf[2*j]=*(const __attribute__((address_space(3))) bf16x8*)(kp+j*2048); kf[2*j+1]=*(const __attribute__((address_space(3))) bf16x8*)(kp+j*2048+512); }
__device__ __forceinline__ s16x4 vtr(lds_cptr p){ return __builtin_bit_cast(s16x4,__builtin_amdgcn_ds_read_tr16_b64_v4i16((__attribute__((address_space(3))) v4i16_t*)p)); }
__device__ __forceinline__ float rowmax(const f32x16&p0,const f32x16&p1){
  float a=max3f(p0[0],p0[1],p1[0]),b=max3f(p0[2],p0[3],p1[1]);a=max3f(a,p1[2],p1[3]);
  #pragma unroll
  for(int r=4;r<16;r+=4){a=max3f(a,p0[r],p0[r+1]);b=max3f(b,p0[r+2],p0[r+3]);a=max3f(a,p1[r],p1[r+1]);b=max3f(b,p1[r+2],p1[r+3]);}
  const float m=max2f(a,b);
  auto rr=__builtin_amdgcn_permlane32_swap(__float_as_uint(m),__float_as_uint(m),false,false);
  return max2f(__uint_as_float(rr[0]),__uint_as_float(rr[1]));
}
__device__ __forceinline__ void pv(f32x16*o,int vb,bf16x8 pa0,bf16x8 pa1,bf16x8 pa2,bf16x8 pa3){
  #pragma unroll
  for(int d0=0;d0<2;++d0){s16x4 lo[4],hi[4];
    #pragma unroll
    for(int ks=0;ks<4;++ks){
      asm volatile("ds_read_b64_tr_b16 %0,%1 offset:%c2":"=&v"(lo[ks]):"v"(vb),"i"(d0*4096+ks*1024):"memory");
      asm volatile("ds_read_b64_tr_b16 %0,%1 offset:%c2":"=&v"(hi[ks]):"v"(vb),"i"(d0*4096+ks*1024+512):"memory");}
    asm volatile("s_waitcnt lgkmcnt(0)":::"memory");SBAR();
    #define PK(k) (bf16x8){lo[k][0],lo[k][1],lo[k][2],lo[k][3],hi[k][0],hi[k][1],hi[k][2],hi[k][3]}
    o[d0]=__builtin_amdgcn_mfma_f32_32x32x16_bf16(pa0,PK(0),o[d0],0,0,0);
    o[d0]=__builtin_amdgcn_mfma_f32_32x32x16_bf16(pa1,PK(1),o[d0],0,0,0);
    o[d0]=__builtin_amdgcn_mfma_f32_32x32x16_bf16(pa2,PK(2),o[d0],0,0,0);
    o[d0]=__builtin_amdgcn_mfma_f32_32x32x16_bf16(pa3,PK(3),o[d0],0,0,0);
    #undef PK
  }
}

#ifndef ATTN_STORE16
#define ATTN_STORE16(p,v) (*(u32x4*)(p)=(v))
#endif
template<int THRL> __device__ __forceinline__ void attn_unit(int b,int h,int qb,const bf16*Q,const bf16*__restrict__ K,const bf16*__restrict__ V,bf16*O,const float*__restrict__ KM,int KMH,char*shm,const int tid){
  const int lane=tid&63,r32=lane&31,hi=lane>>5; const int wid=__builtin_amdgcn_readfirstlane(tid>>6);
  const long rowbase=(long)b*SEQ; const int q0=qb*QB;
  const bf16*Qw=Q+(rowbase+q0+wid*QBLK)*QP+h*D;
  const bf16*Kh=K+rowbase*QP+h*D,*Vh=V+rowbase*QP+h*D;
  const unsigned lds0=(unsigned)(uintptr_t)shm;
  float*wsf=(float*)(shm+LDS_WS)+wid*64;
  const bf16*ksrc=Kh+(long)lane*QP+wid*8;
  const bf16*vsrc=Vh+(long)(16*(wid&3)+(lane>>2))*QP+(wid>>2)*32+(lane&3)*8;
  const unsigned kdst=lds0+LDS_K+wid*1024, vdst=lds0+LDS_V+wid*1024;
  #define TI(t) (((t)<4)?(NT-4+(t)):((t)-4))
  #define DMA_K(t,slot) glds16(ksrc+(long)TI(t)*KVBLK*QP,(unsigned)__builtin_amdgcn_readfirstlane(kdst+(slot)))
  #define DMA_V(t,slot) glds16(vsrc+(long)TI(t)*KVBLK*QP,(unsigned)__builtin_amdgcn_readfirstlane(vdst+(slot)))
  const char*Kbase=shm+LDS_K; bf16x8 kf[8];
  const lds_cptr shm3=(lds_cptr)shm; const lds_cptr kp0=shm3+LDS_K+hi*1024+r32*16; const lds_cptr vp0=shm3+LDS_V+((lane>>4)&1)*32+(lane&3)*8+(4*hi+((lane&15)>>2))*64;
  const int NT=(q0+QB)/KVBLK;
  DMA_K(0,0);DMA_V(0,0);DMA_K(1,SLOTB);
  bf16x8 qr[4];
  #pragma unroll
  for(int d0=0;d0<4;++d0)qr[d0]=*reinterpret_cast<const bf16x8*>(&Qw[(long)r32*QP+d0*16+hi*8]);

  unsigned sel=0u;
  if(qb>0){ float gt_[8];
    #pragma unroll
    for(int n=0;n<8;++n){ float a_=0.f;
      if(n<qb){ const float*km=KM+((long)(b*NHEAD+h)*8+n)*64+hi*8;
        #pragma unroll
        for(int d0=0;d0<4;++d0){ float4 k0=*reinterpret_cast<const float4*>(km+d0*16), k1=*reinterpret_cast<const float4*>(km+d0*16+4);
          { const float4 k2=*reinterpret_cast<const float4*>(km+KMH+d0*16), k3=*reinterpret_cast<const float4*>(km+KMH+d0*16+4); k0.x+=k2.x;k0.y+=k2.y;k0.z+=k2.z;k0.w+=k2.w;k1.x+=k3.x;k1.y+=k3.y;k1.z+=k3.z;k1.w+=k3.w; }
          const bf16x8 qv=qr[d0];
          a_+=__uint_as_float(((unsigned)(unsigned short)qv[0])<<16)*k0.x+__uint_as_float(((unsigned)(unsigned short)qv[1])<<16)*k0.y+__uint_as_float(((unsigned)(unsigned short)qv[2])<<16)*k0.z+__uint_as_float(((unsigned)(unsigned short)qv[3])<<16)*k0.w
             +__uint_as_float(((unsigned)(unsigned short)qv[4])<<16)*k1.x+__uint_as_float(((unsigned)(unsigned short)qv[5])<<16)*k1.y+__uint_as_float(((unsigned)(unsigned short)qv[6])<<16)*k1.z+__uint_as_float(((unsigned)(unsigned short)qv[7])<<16)*k1.w; }
        a_+=__shfl_xor(a_,32); }
      gt_[n]=(n<qb)?a_:-1e30f; }
    #pragma unroll
    for(int r_=0;r_<3;++r_){ float bv=-3.0e38f; int best=-1;
      #pragma unroll
      for(int n=0;n<8;++n) if(!((sel>>n)&1u)&&gt_[n]>bv){bv=gt_[n];best=n;}
      if(best>=0&&bv>-0.5e30f) sel|=1u<<best; } }
  if(hi==0)wsf[32+r32]=__uint_as_float(sel); asm volatile("s_waitcnt lgkmcnt(0)":::"memory");
  float mhat=0.f,l_reg=0.f;f32x16 o[2];o[0]=f32x16{};o[1]=f32x16{};
  const int qrel=wid*QBLK+r32;
  #define CMASK(P0,P1,t) do{ if((t)<4){cmask(P0,P1,(t),qrel,hi);} else if(!((__float_as_uint(wsf[32+r32])>>(((t)-4)>>2))&1u)){ _Pragma("unroll") for(int r_=0;r_<16;++r_){P0[r_]=-INFINITY;P1[r_]=-INFINITY;} } }while(0)
  bool resc=false;
  #define START(P0,P1) do{ const float rm=rowmax(P0,P1); resc=false; \
    { const float dl=rm; mhat=fadd_s(mhat,dl); \
      _Pragma("unroll") for(int r=0;r<16;++r){P0[r]=fsub_s(P0[r],dl);P1[r]=fsub_s(P1[r],dl);} \
      } \
    _Pragma("unroll") for(int r=0;r<16;++r)P0[r]=__builtin_amdgcn_exp2f(P0[r]); }while(0)
  #define RESC() do{ if(resc){ asm volatile("s_waitcnt lgkmcnt(0)":::"memory"); \
      _Pragma("unroll") for(int d_=0;d_<2;++d_) _Pragma("unroll") for(int r=0;r<16;++r)o[d_][r]*=wsf[crow(r,hi)]; } }while(0)
  f32x16 pA0,pA1,pB0,pB1;
  int sl_prev=0,sl_cur=0,sl_next=SLOTB;
  #define ROT() do{sl_prev=sl_cur;sl_cur=sl_next;sl_next=(sl_next==(NSLOT-1)*SLOTB)?0:sl_next+SLOTB;}while(0)
  DMA_K(2,2*SLOTB);
  WAIT_BAR(3);
  qkt(pA0,pA1,Kbase,qr,r32,hi);asm volatile("s_nop 15\n\ts_nop 7":"+v"(pA0),"+v"(pA1));CMASK(pA0,pA1,0);
  START(pA0,pA1);
  _Pragma("unroll") for(int r=0;r<16;++r)pA1[r]=__builtin_amdgcn_exp2f(pA1[r]);
  WAIT_BAR(0);
  DMA_K(3,0);DMA_V(1,SLOTB);
  ROT();
  kload8(kf,kp0+sl_cur);
  WAIT_BAR(2);
  s16x4 vlo[8],vhi[8]; u32x4 pw0,pw1,pw2,pw3;
  #define PKW(P,B) cvtpk_s(P[B],P[B+1])
  #define PAF(k) __builtin_bit_cast(bf16x8,pw##k)
  #define VFR(i) (bf16x8){vlo[i][0],vlo[i][1],vlo[i][2],vlo[i][3],vhi[i][0],vhi[i][1],vhi[i][2],vhi[i][3]}
  #define PIN(x) asm volatile("":"+v"(x))
  #define MX3(a,b,c) __builtin_fmaxf(__builtin_fmaxf((a),(b)),(c))
  #define GAPA(MF,A0,A1,A2,A3,W0,W1,PW) do{ MF; sacc+=A0; sacc+=A1; sacc+=A2; sacc+=A3; PIN(sacc); W0; W1; PIN(PW); SBAR(); }while(0)
  #define EX(v) __builtin_amdgcn_exp2f(v)
  #define GAPB(MF,X,B) do{ MF; X[B]=EX(X[B]); X[B+1]=EX(X[B+1]); X[B+2]=EX(X[B+2]); X[B+3]=EX(X[B+3]); PIN(X); SBAR(); }while(0)
  #define VRD(i) do{ vlo[i]=vtr(vp_+(((i)>>2)*4096+((i)&3)*1024)); vhi[i]=vtr(vp_+(((i)>>2)*4096+((i)&3)*1024+512)); }while(0)
  #define KRD(G,j) do{ if(G){ kload2(kf,kp0+sl_next,j); SBAR(); } }while(0)
  #define STEP(C0,C1,P0,P1,t,GK,GV,GL) do{ SBAR(); \
    const lds_cptr vp_=vp0+sl_prev; \
    VRD(0); SBAR(); float sacc=(P0[0]+P0[1]); \
    GAPA(C0=__builtin_amdgcn_mfma_f32_32x32x16_bf16(kf[0],qr[0],f32x16{},0,0,0), P0[2],P0[3],P0[4],P0[5],     pw0[0]=PKW(P0,0), pw0[1]=PKW(P0,2), pw0); \
    VRD(4); SBAR(); GAPA(C1=__builtin_amdgcn_mfma_f32_32x32x16_bf16(kf[1],qr[0],f32x16{},0,0,0), P0[6],P0[7],P0[8],P0[9],     pw0[2]=PKW(P0,4), pw0[3]=PKW(P0,6), pw0); \
    VRD(1); SBAR(); GAPA(C0=__builtin_amdgcn_mfma_f32_32x32x16_bf16(kf[2],qr[1],C0,0,0,0),   P0[10],P0[11],P0[12],P0[13], pw1[0]=PKW(P0,8), pw1[1]=PKW(P0,10), pw1); \
    VRD(5); SBAR(); GAPA(C1=__builtin_amdgcn_mfma_f32_32x32x16_bf16(kf[3],qr[1],C1,0,0,0),   P0[14],P0[15],P1[0],P1[1],   pw1[2]=PKW(P0,12),pw1[3]=PKW(P0,14), pw1); \
    VRD(2); SBAR(); GAPA(C0=__builtin_amdgcn_mfma_f32_32x32x16_bf16(kf[4],qr[2],C0,0,0,0),   P1[2],P1[3],P1[4],P1[5],     pw2[0]=PKW(P1,0), pw2[1]=PKW(P1,2), pw2); \
    VRD(6); SBAR(); GAPA(C1=__builtin_amdgcn_mfma_f32_32x32x16_bf16(kf[5],qr[2],C1,0,0,0),   P1[6],P1[7],P1[8],P1[9],     pw2[2]=PKW(P1,4), pw2[3]=PKW(P1,6), pw2); \
    VRD(3); SBAR(); GAPA(C0=__builtin_amdgcn_mfma_f32_32x32x16_bf16(kf[6],qr[3],C0,0,0,0),   P1[10],P1[11],P1[12],P1[13], pw3[0]=PKW(P1,8), pw3[1]=PKW(P1,10), pw3); \
    VRD(7); SBAR(); GAPA(C1=__builtin_amdgcn_mfma_f32_32x32x16_bf16(kf[7],qr[3],C1,0,0,0),   P1[14],P1[15],0.f,0.f,       pw3[2]=PKW(P1,12),pw3[3]=PKW(P1,14), pw3); \
    l_reg+=sacc; \
    if(GK){DMA_K((t)+3,sl_cur);} if(GV){DMA_V((t)+1,sl_next);} \
    CMASK(C0,C1,t); \
    _Pragma("unroll") for(int r=0;r<16;++r){C0[r]-=mhat;C1[r]-=mhat;} \
    { float a=MX3(C0[0],C0[1],C1[0]),b=MX3(C0[2],C0[3],C1[1]); a=MX3(a,C1[2],C1[3]); \
      _Pragma("unroll") for(int r=4;r<16;r+=4){a=MX3(a,C0[r],C0[r+1]);b=MX3(b,C0[r+2],C0[r+3]);a=MX3(a,C1[r],C1[r+1]);b=MX3(b,C1[r+2],C1[r+3]);} \
      float rm=__builtin_fmaxf(a,b); { auto rr=__builtin_amdgcn_permlane32_swap(__float_as_uint(rm),__float_as_uint(rm),false,false); rm=__builtin_fmaxf(__uint_as_float(rr[0]),__uint_as_float(rr[1])); } \
      resc=false; \
      if(__builtin_expect(__any(rm>(float)THRL),0)){ const float dl=__builtin_fmaxf(rm,0.f); mhat+=dl; \
        _Pragma("unroll") for(int r=0;r<16;++r){C0[r]-=dl;C1[r]-=dl;} \
        const float f=__builtin_amdgcn_exp2f(-dl); l_reg*=f; if(hi==0)wsf[r32]=f; resc=true; } } \
    SBAR(); \
    GAPB(o[0]=__builtin_amdgcn_mfma_f32_32x32x16_bf16(PAF(0),VFR(0),o[0],0,0,0), C0,0); \
    GAPB(o[1]=__builtin_amdgcn_mfma_f32_32x32x16_bf16(PAF(0),VFR(4),o[1],0,0,0), C0,4); \
    KRD(GL,0); GAPB(o[0]=__builtin_amdgcn_mfma_f32_32x32x16_bf16(PAF(1),VFR(1),o[0],0,0,0), C0,8); \
    KRD(GL,1); GAPB(o[1]=__builtin_amdgcn_mfma_f32_32x32x16_bf16(PAF(1),VFR(5),o[1],0,0,0), C0,12); \
    KRD(GL,2); GAPB(o[0]=__builtin_amdgcn_mfma_f32_32x32x16_bf16(PAF(2),VFR(2),o[0],0,0,0), C1,0); \
    KRD(GL,3); GAPB(o[1]=__builtin_amdgcn_mfma_f32_32x32x16_bf16(PAF(2),VFR(6),o[1],0,0,0), C1,4); \
    GAPB(o[0]=__builtin_amdgcn_mfma_f32_32x32x16_bf16(PAF(3),VFR(3),o[0],0,0,0), C1,8); \
    GAPB(o[1]=__builtin_amdgcn_mfma_f32_32x32x16_bf16(PAF(3),VFR(7),o[1],0,0,0), C1,12); \
    }while(0)
  int t=1;
  for(;t+5<NT;t+=2){
    STEP(pB0,pB1,pA0,pA1,t,true,true,true);     WAIT_BAR(2); RESC(); ROT();
    STEP(pA0,pA1,pB0,pB1,t+1,true,true,true);   WAIT_BAR(2); RESC(); ROT();
  }
  #define ENDW(tt) do{ if((tt)+3<NT){WAIT_BAR(2);} else if((tt)+2<NT){WAIT_BAR(1);} else {WAIT_BAR(0);} }while(0)
  for(;t+1<NT;t+=2){
    STEP(pB0,pB1,pA0,pA1,t,(t+3<NT),(t+1<NT),(t+1<NT));       ENDW(t);   RESC(); ROT();
    STEP(pA0,pA1,pB0,pB1,t+1,(t+4<NT),(t+2<NT),(t+2<NT));     ENDW(t+1); RESC(); ROT();
  }
  STEP(pB0,pB1,pA0,pA1,NT-1,false,false,false); RESC();
  { float sacc=pB0[0]+pB0[1]; _Pragma("unroll") for(int r=2;r<16;++r)sacc+=pB0[r]; _Pragma("unroll") for(int r=0;r<16;++r)sacc+=pB1[r]; l_reg+=sacc;
    pw0=(u32x4){PKW(pB0,0),PKW(pB0,2),PKW(pB0,4),PKW(pB0,6)};pw1=(u32x4){PKW(pB0,8),PKW(pB0,10),PKW(pB0,12),PKW(pB0,14)};pw2=(u32x4){PKW(pB1,0),PKW(pB1,2),PKW(pB1,4),PKW(pB1,6)};pw3=(u32x4){PKW(pB1,8),PKW(pB1,10),PKW(pB1,12),PKW(pB1,14)};
    SBAR(); pv(o,(int)(unsigned)(size_t)vp0+sl_cur,PAF(0),PAF(1),PAF(2),PAF(3)); }
  #undef PKW
  #undef PAF
  #undef VFR
  #undef PIN
  #undef MX3
  #undef GAPA
  #undef GAPB
  #undef EX
  #undef VRD
  #undef KRD
  #undef STEP
  #undef ENDW
  {auto rr=__builtin_amdgcn_permlane32_swap(__float_as_uint(l_reg),__float_as_uint(l_reg),false,false);l_reg=__uint_as_float(rr[0])+__uint_as_float(rr[1]);}
  if(hi==0)wsf[32+r32]=l_reg;asm volatile("s_waitcnt lgkmcnt(0)":::"memory");
  float rli[16];
  #pragma unroll
  for(int r=0;r<16;++r)rli[r]=__builtin_amdgcn_rcpf(wsf[32+crow(r,hi)]);
  bf16*Ow=O+(rowbase+q0+wid*QBLK)*OP+h*D;
  { bf16*stg=(bf16*)(shm+LDS_OST)+wid*2048;
    #pragma unroll
    for(int r=0;r<16;++r){const int orow=crow(r,hi);
      #pragma unroll
      for(int d0=0;d0<2;++d0)stg[orow*64+d0*32+r32]=__float2bfloat16(o[d0][r]*rli[r]);}
    asm volatile("s_waitcnt lgkmcnt(0)":::"memory");
    #pragma unroll
    for(int i=0;i<4;++i){const int row=i*8+(lane>>3),ch=lane&7; const u32x4 v=*(const u32x4*)(stg+row*64+ch*8); ATTN_STORE16(Ow+(long)row*OP+ch*8,v);} }
  asm volatile("s_waitcnt lgkmcnt(0)\n\ts_barrier":::"memory");
  #undef DMA_K
  #undef DMA_V
  #undef TI
  #undef CMASK
  #undef START
  #undef RESC
  #undef ROT
}
constexpr int ATTN_LDS_BYTES=LDS_BYTES;
#undef SBAR
#undef WAIT_BAR
}
#undef LAS
constexpr int NB = DEBUG_BUILD ? 2 : 8;
constexpr int M_ = NB * SEQ;
constexpr int NSLOT = 2 * M_ + N_EXP * 256;
constexpr int PLD = 3072;
constexpr int FQ = 0, FK = 384, FV = 768, FZ = 1152, FGU = 1536, FGV = 1792, FXBC = 2048, FDT = 2944;
constexpr int NGU = 2 * D_FF, NGUE = 2 * D_FFE;

constexpr size_t al256(size_t x) { return (x + 255) & ~(size_t)255; }
constexpr size_t MiB = 1u << 20;
constexpr size_t O_CTL = 0, CTL_BYTES = 1 * MiB;
constexpr size_t O_RT = 1 * MiB;
constexpr size_t O_TE = O_RT + (size_t)M_ * 64, O_TP = O_TE + (size_t)M_ * 8, O_TS = O_TP + (size_t)M_ * 8, O_GS = O_TS + (size_t)M_ * 8;
constexpr size_t O_SP = O_GS + (size_t)M_ * 8;
constexpr size_t O_KM = O_SP + al256((size_t)NSLOT * 4);
constexpr size_t O_DT = O_KM + (size_t)2 * NB * ATT_H * NBLK * 64 * 4;
constexpr size_t O_WSB = al256(O_DT + (size_t)M_ * 24);
constexpr size_t O_HB = (O_WSB + (size_t)2 * GM_G * GM_CHUNK * GM_CHUNK * 2 + MiB - 1) / MiB * MiB;
constexpr size_t O_MWGU = O_HB + (size_t)M_ * DM * 2;
constexpr size_t O_WIN = O_MWGU + (size_t)N_EXP * NGUE * DM * 2;
constexpr size_t O_WOUT = O_WIN + (size_t)2 * PLD * DM * 2;
constexpr size_t O_WGU = O_WOUT + (size_t)2 * DM * DM * 2;
constexpr size_t O_WD = O_WGU + (size_t)NGU * DM * 2;
constexpr size_t O_SCR = O_WD + (size_t)DM * D_FF * 2;
constexpr size_t O_PROJ = O_SCR;
constexpr size_t O_XC = O_PROJ + (size_t)M_ * PLD * 2;
constexpr size_t O_MIXU = O_XC + (size_t)M_ * SSD_CW * 2;
constexpr size_t O_MIXB = O_MIXU + (size_t)M_ * DM * 4;
constexpr size_t O_VN = O_MIXB + (size_t)M_ * DM * 2;
constexpr size_t O_MIXEND = O_VN + (size_t)M_ * GM_W * 4;
constexpr size_t O_Y = O_SCR;
constexpr size_t O_ACT = O_Y + (size_t)M_ * DM * 4;
constexpr size_t O_XG = O_WIN;
constexpr size_t O_ACTM = O_XG + (size_t)NSLOT * DM * 2;
constexpr size_t O_MOEEND = O_ACTM + (size_t)NSLOT * D_FFE * 2;
constexpr size_t WS_END = O_MOEEND > O_MIXEND ? O_MOEEND : O_MIXEND;
static_assert(O_ACT + (size_t)M_ * D_FF * 2 <= O_MIXEND + (size_t)M_ * 4096, "act");
static_assert((size_t)NB * 16 * SSD_H * 8192 * 4 <= (size_t)M_ * SSD_CW * 2, "SSD states fit in the XC slot");
static_assert((size_t)NB * 32 * 768 * 4 <= (size_t)M_ * GM_W * 4, "dt/acum hand-off fits in the VN slot");
static_assert(WS_END <= 487000000ull, "workspace map exceeds the guaranteed size");
static_assert((size_t)N_EXP * DM * D_FFE * 2 <= (size_t)NBATCH * SEQ * DM * 4, "MWD fits in d_out");
constexpr int CW_BAR = 4096, CW_CNT = 1024, CW_Q = 1040, CW_ERR = 2048;

constexpr int RING_BYTES = 131072, MISC_OFF = RING_BYTES + 320, LDS_BYTES = 147456;

#define GAS __attribute__((address_space(1)))
#define LAS __attribute__((address_space(3)))
typedef GAS unsigned gu32;
#define RLX_AGENT __ATOMIC_RELAXED, __HIP_MEMORY_SCOPE_AGENT
#define LDS_WAIT() asm volatile("s_waitcnt lgkmcnt(0)" ::: "memory")

constexpr float QSCALE = 0.125f * 1.4426950408889634f;
constexpr int TAIL_SLOTS = 16 * 256;
namespace fp {
using pg8::Unit; using pg8::BM; using pg8::HALF; typedef pg8::f32x4 f32x4; typedef pg8::u32x4 u32x4;
__device__ __forceinline__ unsigned pk2(float lo, float hi) { return pg8::cvt_pk_bf16(lo, hi); }
__device__ __forceinline__ float gelu_fast(float x) { const float u = 0.7978845608028654f * (x + 0.044715f * x * x * x); return x * __builtin_amdgcn_rcpf(1.f + __expf(-2.f * u)); }

struct EpiProj {
    static constexpr bool PERM = true, AFTER_DRAIN = false;
    bf16* O; const float* RT; float* KM2;
    __device__ __forceinline__ void operator()(const f32x4 (&acc)[2][2][4][2], const Unit& u, int wr, int wc, int fr, int fq) const {
        const int row0 = u.pm * BM + wr * 64 + fr, col0 = u.pn * BM + wc * 32 + 8 * fq;
        f32x4 ks[2][2];
#pragma unroll
        for (int i = 0; i < 2; ++i) { ks[i][0] = (f32x4){0.f, 0.f, 0.f, 0.f}; ks[i][1] = ks[i][0]; }
        const int mode = (u.pn < 3) ? 1 : ((u.pn == 6 || u.pn == 7) ? 2 : 0);
        const bool rl = ((wc & 1) == 0) && (fq < 2);
        const int i0 = (fq & 1) * 4;
#pragma unroll
        for (int ai = 0; ai < 2; ++ai) {
            float4 c4a[4], s4a[4];
#pragma unroll
            for (int i = 0; i < 4; ++i) { c4a[i] = make_float4(1.f, 1.f, 1.f, 1.f); s4a[i] = make_float4(0.f, 0.f, 0.f, 0.f); }
            if (mode == 1 && rl) {
#pragma unroll
                for (int i = 0; i < 4; ++i) { const int row = row0 + ai * HALF + i * 16; c4a[i] = *(const float4*)(RT + (size_t)row * 16 + i0); s4a[i] = *(const float4*)(RT + (size_t)row * 16 + 8 + i0); } }
#pragma unroll
            for (int m = 0; m < 4; ++m) { const int row = row0 + ai * HALF + m * 16;
                const float4 c4 = c4a[m], s4 = s4a[m];
#pragma unroll
                for (int bj = 0; bj < 2; ++bj) { f32x4 v0 = acc[ai][bj][m][0], v1 = acc[ai][bj][m][1];
                    if (mode == 1) { const f32x4 a = v0, b = v1;
                        v0[0] = a[0] * c4.x - a[1] * s4.x; v0[1] = a[1] * c4.x + a[0] * s4.x; v0[2] = a[2] * c4.y - a[3] * s4.y; v0[3] = a[3] * c4.y + a[2] * s4.y;
                        v1[0] = b[0] * c4.z - b[1] * s4.z; v1[1] = b[1] * c4.z + b[0] * s4.z; v1[2] = b[2] * c4.w - b[3] * s4.w; v1[3] = b[3] * c4.w + b[2] * s4.w; }
                    if (u.pn == 0 || (u.pn == 1 && bj == 0)) { v0 = v0 * QSCALE; v1 = v1 * QSCALE; }
                    else if (mode == 1) { ks[bj][0] += v0; ks[bj][1] += v1; }
                    if (mode == 2) {
#pragma unroll
                        for (int j = 0; j < 4; ++j) { v0[j] = gelu_fast(v0[j]); v1[j] = gelu_fast(v1[j]); } }
                    u32x4 w; w.x = pk2(v0[0], v0[1]); w.y = pk2(v0[2], v0[3]); w.z = pk2(v1[0], v1[1]); w.w = pk2(v1[2], v1[3]);
                    *(u32x4*)(O + (size_t)row * PLD + col0 + bj * HALF) = w; } } }
        if (u.pn == 1 || u.pn == 2) {
#pragma unroll
            for (int bj = 0; bj < 2; ++bj) { if (u.pn == 1 && bj == 0) continue;
#pragma unroll
                for (int n = 0; n < 2; ++n)
#pragma unroll
                    for (int j = 0; j < 4; ++j) { float x = ks[bj][n][j]; x += __shfl_xor(x, 1); x += __shfl_xor(x, 2); x += __shfl_xor(x, 4); x += __shfl_xor(x, 8); ks[bj][n][j] = x * (1.f / 256.f); }
                if (fr == 0) { const int kc = col0 + bj * HALF - FK; const int b = u.pm >> 3, nb = u.pm & 7;
                    float* dst = KM2 + (size_t)wr * (NB * ATT_H * NBLK * 64) + ((size_t)(b * ATT_H + (kc >> 6)) * NBLK + nb) * 64 + (kc & 63);
                    *(f32x4*)dst = ks[bj][0]; *(f32x4*)(dst + 4) = ks[bj][1]; } }
        }
    }
};
struct EpiAct {
    static constexpr bool PERM = true, AFTER_DRAIN = false;
    bf16* O; int ldc, ncol;
    __device__ __forceinline__ void operator()(const f32x4 (&acc)[2][2][4][2], const Unit& u, int wr, int wc, int fr, int fq) const {
        const int row0 = u.pm * BM + wr * 64 + fr, col0 = (u.pn % ncol) * HALF + wc * 32 + 8 * fq;
#pragma unroll
        for (int ai = 0; ai < 2; ++ai)
#pragma unroll
            for (int m = 0; m < 4; ++m) { const int row = row0 + ai * HALF + m * 16;
                const f32x4 g0 = acc[ai][0][m][0], g1 = acc[ai][0][m][1], u0 = acc[ai][1][m][0], u1 = acc[ai][1][m][1]; f32x4 a0, a1;
#pragma unroll
                for (int j = 0; j < 4; ++j) { a0[j] = g0[j] * __builtin_amdgcn_rcpf(1.f + __expf(-g0[j])) * u0[j]; a1[j] = g1[j] * __builtin_amdgcn_rcpf(1.f + __expf(-g1[j])) * u1[j]; }
                u32x4 w; w.x = pk2(a0[0], a0[1]); w.y = pk2(a0[2], a0[3]); w.z = pk2(a1[0], a1[1]); w.w = pk2(a1[2], a1[3]);
                *(u32x4*)(O + (size_t)row * ldc + col0) = w; }
    }
};
struct EpiF32 {
    static constexpr bool PERM = false, AFTER_DRAIN = false;
    float* O; int ldc;
    __device__ __forceinline__ void operator()(const f32x4 (&acc)[2][2][4][2], const Unit& u, int wr, int wc, int fr, int fq) const {
        const int row0 = u.pm * BM + wr * 64 + fr, col0 = u.pn * BM + wc * 32 + 4 * fq;
#pragma unroll
        for (int ai = 0; ai < 2; ++ai)
#pragma unroll
            for (int m = 0; m < 4; ++m) { float* rp = O + (size_t)(row0 + ai * HALF + m * 16) * ldc + col0;
#pragma unroll
                for (int bj = 0; bj < 2; ++bj)
#pragma unroll
                    for (int n = 0; n < 2; ++n) *(f32x4*)(rp + bj * HALF + n * 16) = acc[ai][bj][m][n]; }
    }
};
struct EpiY {
    static constexpr bool PERM = true, AFTER_DRAIN = false;
    bf16* O; int ldc;
    __device__ __forceinline__ void operator()(const f32x4 (&acc)[2][2][4][2], const Unit& u, int wr, int wc, int fr, int fq) const {
        const int row0 = u.pm * BM + wr * 64 + fr, col0 = u.pn * BM + wc * 32 + 8 * fq;
#pragma unroll
        for (int ai = 0; ai < 2; ++ai)
#pragma unroll
            for (int m = 0; m < 4; ++m) { bf16* rp = O + (size_t)(row0 + ai * HALF + m * 16) * ldc + col0;
#pragma unroll
                for (int bj = 0; bj < 2; ++bj) { const f32x4 v0 = acc[ai][bj][m][0], v1 = acc[ai][bj][m][1];
                    u32x4 w; w.x = pk2(v0[0], v0[1]); w.y = pk2(v0[2], v0[3]); w.z = pk2(v1[0], v1[1]); w.w = pk2(v1[2], v1[3]);
                    *(u32x4*)(rp + bj * HALF) = w; } }
    }
};
struct EpiF2 {
    static constexpr bool PERM = true, AFTER_DRAIN = false;
    bf16* O; const float* SP; bf16* FP; int slot0, klen;
    __device__ __forceinline__ void operator()(const f32x4 (&acc)[2][2][4][2], const Unit& u, int wr, int wc, int fr, int fq) const {
        const int row0 = u.pm * BM + wr * 64 + fr, col0 = (u.pn & 3) * BM + wc * 32 + 8 * fq;
        bf16* base = O; int rsub = 0;
        if (u.kofs > 0) { const int part = u.kofs / klen; base = FP + (size_t)(part - 1) * TAIL_SLOTS * DM; rsub = slot0; }
        float spv[8];
#pragma unroll
        for (int i = 0; i < 8; ++i) spv[i] = SP[row0 + (i >> 2) * HALF + (i & 3) * 16];
#pragma unroll
        for (int ai = 0; ai < 2; ++ai)
#pragma unroll
            for (int m = 0; m < 4; ++m) { const int row = row0 + ai * HALF + m * 16; const float sc = spv[ai * 4 + m];
#pragma unroll
                for (int bj = 0; bj < 2; ++bj) { const f32x4 v0 = acc[ai][bj][m][0] * sc, v1 = acc[ai][bj][m][1] * sc;
                    u32x4 w; w.x = pk2(v0[0], v0[1]); w.y = pk2(v0[2], v0[3]); w.z = pk2(v1[0], v1[1]); w.w = pk2(v1[2], v1[3]);
                    *(u32x4*)(base + (size_t)(row - rsub) * DM + col0 + bj * HALF) = w; } }
    }
};
static_assert(NGUE / 256 == 28 && DM / 256 == 4, "MoeOrder::next decodes units for 28 or 4 column tiles");
struct MoeOrder {
    int p0, p1, p2, p3, p4, p5, p6, T, ncol, G, c, nfull, ksplit, klen;
    __device__ __forceinline__ void init(const int* CNT, int ncol_, int G_, int c_) {
        int t = 0; t += (CNT[0] + 255) >> 8; p0 = t; t += (CNT[1] + 255) >> 8; p1 = t; t += (CNT[2] + 255) >> 8; p2 = t; t += (CNT[3] + 255) >> 8; p3 = t;
        t += (CNT[4] + 255) >> 8; p4 = t; t += (CNT[5] + 255) >> 8; p5 = t; t += (CNT[6] + 255) >> 8; p6 = t; t += (CNT[7] + 255) >> 8; T = t; ncol = ncol_; G = G_; c = c_;
        nfull = T * ncol; ksplit = 1; klen = 0;
    }
    __device__ __forceinline__ int tail_start() const { const int tot = T * ncol, nf = (tot / G) * G; return (tot - nf <= 64) ? nf : tot; }
    __device__ __forceinline__ bool next(int i, Unit& u) const {
        int L = i * G + c; int part = 0;
        if (ksplit == 1) { if (L >= nfull) return false; }
        else { if (L >= (T * ncol - nfull) * 4) return false; part = L & 3; L = nfull + (L >> 2); }
        const int tm = (ncol == 4) ? (L >> 2) : (int)((unsigned)L / 28u), j = L - tm * ncol;
        const int e = (tm >= p0) + (tm >= p1) + (tm >= p2) + (tm >= p3) + (tm >= p4) + (tm >= p5) + (tm >= p6);
        u.pm = tm; u.pn = e * ncol + j; u.kofs = part * klen; return true;
    }
    __device__ __forceinline__ void a_ready(const Unit&) const {}
    __device__ __forceinline__ void done(const Unit&) const {}
};

struct SrcCol { const float* p; int ld; };
__device__ __forceinline__ int win_src_col(int d) {
    if (d < 768) { const int hd = d & 63; const int sd = hd < 16 ? ((hd & 1) ? 8 + (hd >> 1) : (hd >> 1)) : hd; return d - hd + sd; }
    if (d < 1536) return d;
    if (d < 1792) return 2438 + (d - 1536);
    if (d < 2048) return 2694 + (d - 1792);
    if (d < 2944) return 1536 + (d - 2048);
    if (d < 2950) return 2432 + (d - 2944);
    return -1;
}
__device__ __forceinline__ SrcCol gu_src(const float* wg, const float* wu, int nff, int r) {
    const int tile = r >> 8, rr = r & 255, j = tile * 128 + (rr & 127); SrcCol s; s.p = (rr < 128 ? wg : wu) + j; s.ld = nff; return s;
}
__device__ __forceinline__ void conv_item(SrcCol sc, int K, bf16* WT, long d0, int k0, LAS float* scr, int lane) {
    float tv[32];
#pragma unroll
    for (int i = 0; i < 32; ++i) { const int kk = 2 * i + (lane >> 5); tv[i] = sc.p ? sc.p[(size_t)(k0 + kk) * sc.ld] : 0.f; }
#pragma unroll
    for (int i = 0; i < 32; ++i) { const int kk = 2 * i + (lane >> 5); scr[kk * 33 + (lane & 31)] = tv[i]; }
    LDS_WAIT(); asm volatile("" ::: "memory");
    const int c = lane & 7;
#pragma unroll
    for (int j = 0; j < 4; ++j) { const int n = (lane >> 3) + 8 * j; const LAS float* s = scr + (8 * c) * 33 + n;
        u32x4 o; o.x = pk2(s[0 * 33], s[1 * 33]); o.y = pk2(s[2 * 33], s[3 * 33]); o.z = pk2(s[4 * 33], s[5 * 33]); o.w = pk2(s[6 * 33], s[7 * 33]);
        *(u32x4*)(WT + (size_t)(d0 + n) * K + k0 + 8 * c) = o; }
    LDS_WAIT(); asm volatile("" ::: "memory");
}
}


typedef short bf16x8_t __attribute__((ext_vector_type(8)));
typedef float f32x4_t __attribute__((ext_vector_type(4)));
constexpr int TLD = 272;
__device__ __forceinline__ bf16x8_t lds_frag(const LAS unsigned char* base, int row, int kbyte) { return *(const LAS bf16x8_t*)(base + row * TLD + kbyte); }
__device__ __forceinline__ float red16(float v) { return row16_sum(v); }

__device__ __forceinline__ void gm_unit(int b, int c, const bf16* PROJ, const bf16* WSB  , const float* ln_g, const float* ln_b, const float* b_s, const float* norm_g,
                                        bf16* MIXB, LAS unsigned char* lds, int wave, int lane) {
    const long r0 = (long)b * SEQ + c * GM_CHUNK;
    LAS unsigned char* VNT = lds;
    { float4 vv[16];
#pragma unroll
      for (int i = 0; i < 16; ++i) vv[i] = ld4(PROJ + (r0 + wave * 16 + i) * PLD + FGV + lane * 4);
      const float4 gg = *(const float4*)(ln_g + lane * 4), bb = *(const float4*)(ln_b + lane * 4);
#pragma unroll
      for (int i = 0; i < 16; ++i) { const int t = wave * 16 + i; const float4 v = vv[i];
        const float mean = wave_sum((v.x + v.y) + (v.z + v.w)) * (1.f / 256.f);
        const float d0 = v.x - mean, d1 = v.y - mean, d2 = v.z - mean, d3 = v.w - mean;
        const float rstd = rsqrtf(wave_sum((d0 * d0 + d1 * d1) + (d2 * d2 + d3 * d3)) * (1.f / 256.f) + 1e-5f);
        LAS bf16* dst = (LAS bf16*)(VNT + (lane * 4) * TLD) + t;
        dst[0] = (bf16)f2bf(d0 * rstd * gg.x + bb.x); dst[TLD / 2] = (bf16)f2bf(d1 * rstd * gg.y + bb.y); dst[TLD] = (bf16)f2bf(d2 * rstd * gg.z + bb.z); dst[3 * TLD / 2] = (bf16)f2bf(d3 * rstd * gg.w + bb.w); } }
    __syncthreads();
    f32x4_t acc[16];
#pragma unroll
    for (int i = 0; i < 16; ++i) acc[i] = (f32x4_t){0.f, 0.f, 0.f, 0.f};
    const int fr = lane & 15, fq = lane >> 4;
    const int nks = (wave * 16 + 15) / 32 + 1;
    for (int ks = 0; ks < nks; ++ks) {
#pragma unroll
        for (int g = 0; g < 4; ++g) {
            const bf16x8_t af = *(const bf16x8_t*)(WSB + ((size_t)g * GM_CHUNK + wave * 16 + fr) * GM_CHUNK + ks * 32 + fq * 8);
#pragma unroll
            for (int n = 0; n < 4; ++n) { const bf16x8_t bfv = lds_frag(VNT, g * 64 + n * 16 + fr, ks * 64 + fq * 16);
                acc[g * 4 + n] = __builtin_amdgcn_mfma_f32_16x16x32_bf16(af, bfv, acc[g * 4 + n], 0, 0, 0); }
        }
    }
    __syncthreads();
    LAS bf16* ost = (LAS bf16*)(lds + wave * (16 * 264 * 2));
    float ss[4] = {0.f, 0.f, 0.f, 0.f};
#pragma unroll
    for (int nt = 0; nt < 16; ++nt) { const int col = nt * 16 + fr, g = nt >> 2;
#pragma unroll
        for (int r = 0; r < 4; ++r) { const int t = wave * 16 + fq * 4 + r;
            const float u = ldf(PROJ + (r0 + t) * PLD + FGU + col);
            const float o = u * (acc[nt][r] + b_s[g * GM_CHUNK + t]); acc[nt][r] = o; ss[r] += o * o; } }
#pragma unroll
    for (int r = 0; r < 4; ++r) ss[r] = rsqrtf(red16(ss[r]) * (1.f / 256.f) + 1e-5f);
#pragma unroll
    for (int nt = 0; nt < 16; ++nt) { const int col = nt * 16 + fr; const float gn = norm_g[col];
#pragma unroll
        for (int r = 0; r < 4; ++r) { ost[(fq * 4 + r) * 264 + col] = (bf16)f2bf(acc[nt][r] * ss[r] * gn); } }
    LDS_WAIT(); asm volatile("" ::: "memory");
#pragma unroll
    for (int i = 0; i < 8; ++i) { const int rr = i * 2 + (lane >> 5), ch = lane & 31;
        const fp::u32x4 v = *(const LAS fp::u32x4*)(ost + rr * 264 + ch * 8);
        *(fp::u32x4*)(MIXB + (r0 + wave * 16 + rr) * DM + ATT_W + SSD_W + ch * 8) = v; }
    __syncthreads();
}

typedef short v4i16_t __attribute__((ext_vector_type(4)));
typedef unsigned u32x2_t __attribute__((ext_vector_type(2)));
__device__ __forceinline__ v4i16_t lds_tr(const LAS unsigned char* p) { return __builtin_amdgcn_ds_read_tr16_b64_v4i16((LAS v4i16_t*)p); }
__device__ __forceinline__ bf16x8_t lds_frag_tr(const LAS unsigned char* tile, int pitch, int k0, int c0, int lane) {
    const int kg = lane >> 4, q = (lane & 15) >> 2, p = lane & 3;
    const LAS unsigned char* a = tile + (k0 + 8 * kg + q) * pitch + (c0 + 4 * p) * 2;
    const v4i16_t lo = lds_tr(a), hi = lds_tr(a + 4 * pitch);
    return (bf16x8_t){lo[0], lo[1], lo[2], lo[3], hi[0], hi[1], hi[2], hi[3]};
}
__device__ __forceinline__ bf16x8_t lds_frag_p(const LAS unsigned char* base, int pitch, int row, int kbyte) { return *(const LAS bf16x8_t*)(base + row * pitch + kbyte); }
template <int NCH, bool SCALE, bool TOLDS> __device__ __forceinline__ void conv_rows(const bf16* PROJ, long r0, int t0, int colbase, int ch0, const float* cw, const float* cb, LAS unsigned char* tile, int pitch,
                                                                                       const LAS float* scl, bf16* XCg  , int tid) {
    constexpr int CPR = NCH / 8, RG = 512 / CPR, RPT = (128 + RG - 1) / RG;
    if (tid < CPR * RG) { const int ch = (tid % CPR) * 8, l0 = (tid / CPR) * RPT;
        float w[4][8], bs[8];
        { const float4 c0 = *(const float4*)(cb + ch0 + ch), c1 = *(const float4*)(cb + ch0 + ch + 4); bs[0] = c0.x; bs[1] = c0.y; bs[2] = c0.z; bs[3] = c0.w; bs[4] = c1.x; bs[5] = c1.y; bs[6] = c1.z; bs[7] = c1.w; }
#pragma unroll
        for (int i = 0; i < 4; ++i) { const float4 w0 = *(const float4*)(cw + i * SSD_CW + ch0 + ch), w1 = *(const float4*)(cw + i * SSD_CW + ch0 + ch + 4);
            w[i][0] = w0.x; w[i][1] = w0.y; w[i][2] = w0.z; w[i][3] = w0.w; w[i][4] = w1.x; w[i][5] = w1.y; w[i][6] = w1.z; w[i][7] = w1.w; }
        fp::u32x4 xr[RPT + 3];
#pragma unroll
        for (int j = 0; j < RPT + 3; ++j) { const int l = l0 - 3 + j; xr[j] = (fp::u32x4){0u, 0u, 0u, 0u};
            if (l < 128 && t0 + l >= 0) xr[j] = *(const fp::u32x4*)(PROJ + (r0 + l) * PLD + colbase + ch); }
#pragma unroll
        for (int j = 0; j < RPT; ++j) { const int l = l0 + j; if (l < 128) {
            float a[8];
#pragma unroll
            for (int e = 0; e < 8; ++e) a[e] = bs[e];
#pragma unroll
            for (int i = 0; i < 4; ++i) { const fp::u32x4 xv = xr[j + i];
#pragma unroll
                for (int e = 0; e < 4; ++e) { a[2 * e] += w[i][2 * e] * __uint_as_float(xv[e] << 16); a[2 * e + 1] += w[i][2 * e + 1] * __uint_as_float(xv[e] & 0xffff0000u); } }
#pragma unroll
            for (int e = 0; e < 8; ++e) a[e] = a[e] * __builtin_amdgcn_rcpf(1.f + __expf(-a[e]));
            fp::u32x4 o; o.x = fp::pk2(a[0], a[1]); o.y = fp::pk2(a[2], a[3]); o.z = fp::pk2(a[4], a[5]); o.w = fp::pk2(a[6], a[7]);
            *(fp::u32x4*)(XCg + (r0 + l) * SSD_CW + ch) = o;
            if (TOLDS) { if (SCALE) { const float sc = scl[(ch >> 6) * 128 + l]; o.x = fp::pk2(a[0] * sc, a[1] * sc); o.y = fp::pk2(a[2] * sc, a[3] * sc); o.z = fp::pk2(a[4] * sc, a[5] * sc); o.w = fp::pk2(a[6] * sc, a[7] * sc); }
                *(LAS fp::u32x4*)(tile + l * pitch + ch * 2) = o; } } }
    }
}
template <int NCH> __device__ __forceinline__ void load_xc_tile(const bf16* XCg, long r0, LAS unsigned char* tile, int pitch, int tid) {
    constexpr int CPR = NCH / 8;
    for (int it = tid; it < 128 * CPR; it += 512) { const int l = it / CPR, ch = (it % CPR) * 8;
        *(LAS fp::u32x4*)(tile + l * pitch + ch * 2) = *(const fp::u32x4*)(XCg + (r0 + l) * SSD_CW + ch); }
}
__device__ __forceinline__ void ssd_dt_acum(const bf16* PROJ, long r0, int g, const float* dt_bias, const float* a_log, LAS float* dtS, LAS float* acS, int tid, int wave, int lane) {
    if (tid < 384) { const int hh = tid >> 7, l = tid & 127, h = 3 * g + hh;
        const float dtv = softplus_f(ldf(PROJ + (r0 + l) * PLD + FDT + h) + dt_bias[h]); dtS[tid] = dtv; acS[tid] = dtv * (-__expf(a_log[h])); }
    __syncthreads();
    if (wave < 3) { const float a0 = acS[wave * 128 + 2 * lane], a1 = acS[wave * 128 + 2 * lane + 1]; const float sm = a0 + a1; float v = sm;
#pragma unroll
        for (int o = 1; o < 64; o <<= 1) { const float t = __shfl_up(v, o); if (lane >= o) v += t; }
        const float ex = v - sm; acS[wave * 128 + 2 * lane] = ex + a0; acS[wave * 128 + 2 * lane + 1] = ex + sm; }
    __syncthreads();
}
constexpr int XP = 400;
__device__ __forceinline__ void ssdA_unit(int b, int c, int g, const bf16* PROJ, const float* cw, const float* cb, const float* dt_bias, const float* a_log, float* ST, float* CD, bf16* XC, float* DTG,
                                          LAS unsigned char* lds, int tid, int wave, int lane) {
    asm volatile("" : "+v"(tid), "+v"(lane));
    const long r0 = (long)b * SEQ + c * 128; const int t0 = c * 128;
    LAS unsigned char* XS = lds; LAS unsigned char* BS = lds + 51200;
    LAS float* dtS = (LAS float*)(lds + 86016); LAS float* acS = dtS + 384; LAS float* sclS = acS + 384;
    ssd_dt_acum(PROJ, r0, g, dt_bias, a_log, dtS, acS, tid, wave, lane);
    if (tid < 384) { const int hh = tid >> 7; const float al = acS[hh * 128 + 127]; sclS[tid] = dtS[tid] * __expf(al - acS[tid]);
        float* dg = DTG + (((long)b * 16 + c) * 2 + g) * 768; dg[tid] = dtS[tid]; dg[384 + tid] = acS[tid];
        if ((tid & 127) == 0) CD[((long)b * 16 + c) * SSD_H + 3 * g + hh] = __expf(al); }
    __syncthreads();
    conv_rows<192, true, true>(PROJ, r0, t0, FXBC + 192 * g, 192 * g, cw, cb, XS, XP, sclS, XC + 192 * g, tid);
    conv_rows<128, false, true>(PROJ, r0, t0, FXBC + SSD_W + 128 * g, SSD_W + 128 * g, cw, cb, BS, TLD, nullptr, XC + SSD_W + 128 * g, tid);
    conv_rows<128, false, false>(PROJ, r0, t0, FXBC + SSD_W + 256 + 128 * g, SSD_W + 256 + 128 * g, cw, cb, nullptr, 0, nullptr, XC + SSD_W + 256 + 128 * g, tid);
    __syncthreads();
    f32x4_t acc[12];
#pragma unroll
    for (int i = 0; i < 12; ++i) acc[i] = (f32x4_t){0.f, 0.f, 0.f, 0.f};
#pragma unroll 1
    for (int ks = 0; ks < 4; ++ks) { const bf16x8_t bfv = lds_frag_tr(BS, TLD, ks * 32, 16 * wave, lane);
#pragma unroll
        for (int mt = 0; mt < 12; ++mt) { const bf16x8_t af = lds_frag_tr(XS, XP, ks * 32, (mt >> 2) * 64 + (mt & 3) * 16, lane); acc[mt] = __builtin_amdgcn_mfma_f32_16x16x32_bf16(af, bfv, acc[mt], 0, 0, 0); } }
    const int fr = lane & 15, fq = lane >> 4;
    float* sp = ST + (((long)b * 16 + c) * SSD_H + 3 * g) * 8192 + 16 * wave + fr;
#pragma unroll
    for (int mt = 0; mt < 12; ++mt)
#pragma unroll
        for (int r = 0; r < 4; ++r) sp[(mt >> 2) * 8192 + ((mt & 3) * 16 + 4 * fq + r) * 128] = acc[mt][r];
    __syncthreads();
}
__device__ __forceinline__ void ssdB_unit(int b, int c, int g, const bf16* PROJ, const bf16* XC, const float* DTG, const float* dsk, const float* ng,
                                          const float* ST, const float* CD, bf16* MIXB, LAS unsigned char* lds, int tid, int wave, int lane) {
    const long r0 = (long)b * SEQ + c * 128;
    LAS unsigned char* CS = lds; LAS unsigned char* PX = lds + 34816; LAS unsigned char* BG = lds + 87040;
    LAS float* dtS = (LAS float*)(lds + 121856); LAS float* acS = dtS + 384;
    const int fr = lane & 15, fq = lane >> 4;
    if (tid < 384) { const float* dg = DTG + (((long)b * 16 + c) * 2 + g) * 768; dtS[tid] = dg[tid]; acS[tid] = dg[384 + tid]; }
    load_xc_tile<128>(XC + SSD_W + 256 + 128 * g, r0, CS, TLD, tid);
    if (c > 0) {
        float4 pv[12];
#pragma unroll
        for (int i = 0; i < 12; ++i) pv[i] = make_float4(0.f, 0.f, 0.f, 0.f);
        const float* sbase = ST + ((long)b * 16 * SSD_H + 3 * g) * 8192 + tid * 4; const float* cbase = CD + (long)b * 16 * SSD_H + 3 * g;
        int j = 0;
        for (; j + 2 < c; j += 3) { const float* s0 = sbase + (long)j * SSD_H * 8192; const float* c0 = cbase + j * SSD_H;
            float4 v0[12], v1[12], v2[12];
#pragma unroll
            for (int i = 0; i < 12; ++i) { v0[i] = *(const float4*)(s0 + i * 2048); v1[i] = *(const float4*)(s0 + SSD_H * 8192 + i * 2048); v2[i] = *(const float4*)(s0 + 2 * SSD_H * 8192 + i * 2048); }
            float dd[3][3];
#pragma unroll
            for (int q = 0; q < 3; ++q) { dd[q][0] = c0[q * SSD_H]; dd[q][1] = c0[q * SSD_H + 1]; dd[q][2] = c0[q * SSD_H + 2]; }
#pragma unroll
            for (int i = 0; i < 12; ++i) { const int hq = i >> 2;
                pv[i].x = ((pv[i].x * dd[0][hq] + v0[i].x) * dd[1][hq] + v1[i].x) * dd[2][hq] + v2[i].x;
                pv[i].y = ((pv[i].y * dd[0][hq] + v0[i].y) * dd[1][hq] + v1[i].y) * dd[2][hq] + v2[i].y;
                pv[i].z = ((pv[i].z * dd[0][hq] + v0[i].z) * dd[1][hq] + v1[i].z) * dd[2][hq] + v2[i].z;
                pv[i].w = ((pv[i].w * dd[0][hq] + v0[i].w) * dd[1][hq] + v1[i].w) * dd[2][hq] + v2[i].w; } }
        for (; j < c; ++j) { const float* s0 = sbase + (long)j * SSD_H * 8192; const float* c0 = cbase + j * SSD_H; const float d0 = c0[0], d1 = c0[1], d2 = c0[2];
#pragma unroll
            for (int i = 0; i < 12; ++i) { const float4 sv = *(const float4*)(s0 + i * 2048); const float d = (i < 4) ? d0 : ((i < 8) ? d1 : d2);
                pv[i].x = pv[i].x * d + sv.x; pv[i].y = pv[i].y * d + sv.y; pv[i].z = pv[i].z * d + sv.z; pv[i].w = pv[i].w * d + sv.w; } }
#pragma unroll
        for (int i = 0; i < 12; ++i) { const int row = (i >> 2) * 64 + (i & 3) * 16 + (tid >> 5), n = (tid & 31) * 4;
            u32x2_t w; w.x = fp::pk2(pv[i].x, pv[i].y); w.y = fp::pk2(pv[i].z, pv[i].w); *(LAS u32x2_t*)(PX + row * TLD + n * 2) = w; }
    }
    __syncthreads();
    f32x4_t acc_y[12];
#pragma unroll
    for (int i = 0; i < 12; ++i) acc_y[i] = (f32x4_t){0.f, 0.f, 0.f, 0.f};
    if (c > 0) {
#pragma unroll 1
        for (int ks = 0; ks < 4; ++ks) { const bf16x8_t af = lds_frag_p(CS, TLD, 16 * wave + fr, ks * 64 + fq * 16);
#pragma unroll
            for (int t = 0; t < 12; ++t) { const bf16x8_t bfv = lds_frag_p(PX, TLD, (t >> 2) * 64 + (t & 3) * 16 + fr, ks * 64 + fq * 16); acc_y[t] = __builtin_amdgcn_mfma_f32_16x16x32_bf16(af, bfv, acc_y[t], 0, 0, 0); } }
#pragma unroll
        for (int t = 0; t < 12; ++t)
#pragma unroll
            for (int r = 0; r < 4; ++r) acc_y[t][r] *= __expf(acS[(t >> 2) * 128 + 16 * wave + 4 * fq + r]);
    }
    __syncthreads();
    load_xc_tile<192>(XC + 192 * g, r0, PX, XP, tid);
    load_xc_tile<128>(XC + SSD_W + 128 * g, r0, BG, TLD, tid);
    __syncthreads();
#if defined(SSDB_CUT) && SSDB_CUT == 2
    { float t_ = 0.f; for (int i = 0; i < 12; ++i) t_ += acc_y[i][0] + acc_y[i][1] + acc_y[i][2] + acc_y[i][3]; if (t_ == 123.f) MIXB[0] = 1; return; }
#endif
    f32x4_t acc_cb[8];
#pragma unroll
    for (int i = 0; i < 8; ++i) acc_cb[i] = (f32x4_t){0.f, 0.f, 0.f, 0.f};
#pragma unroll 1
    for (int ks = 0; ks < 4; ++ks) { const bf16x8_t af = lds_frag_p(CS, TLD, 16 * wave + fr, ks * 64 + fq * 16);
#pragma unroll
        for (int ns = 0; ns < 8; ++ns) if (ns <= wave) { const bf16x8_t bfv = lds_frag_p(BG, TLD, 16 * ns + fr, ks * 64 + fq * 16); acc_cb[ns] = __builtin_amdgcn_mfma_f32_16x16x32_bf16(af, bfv, acc_cb[ns], 0, 0, 0); } }
    __syncthreads();
    LAS unsigned char* GS = BG + wave * 16 * TLD;
    const int nks = (16 * wave + 15) / 32 + 1;
#pragma unroll
    for (int hh = 0; hh < 3; ++hh) {
#pragma unroll
        for (int ns = 0; ns < 8; ++ns) if (ns <= (wave | 1)) {
#pragma unroll
            for (int r = 0; r < 4; ++r) { const int l = 16 * wave + 4 * fq + r, sidx = 16 * ns + fr;
                const float gv = (ns <= wave && sidx <= l) ? acc_cb[ns][r] * __expf(acS[hh * 128 + l] - acS[hh * 128 + sidx]) * dtS[hh * 128 + sidx] : 0.f;
                *(LAS bf16*)(GS + (4 * fq + r) * TLD + sidx * 2) = (bf16)f2bf(gv); } }
        LDS_WAIT(); asm volatile("" ::: "memory");
#pragma unroll 1
        for (int ks = 0; ks < nks; ++ks) { const bf16x8_t af = lds_frag_p(GS, TLD, fr, ks * 64 + fq * 16);
#pragma unroll
            for (int np = 0; np < 4; ++np) { const bf16x8_t bfv = lds_frag_tr(PX, XP, ks * 32, hh * 64 + np * 16, lane); acc_y[hh * 4 + np] = __builtin_amdgcn_mfma_f32_16x16x32_bf16(af, bfv, acc_y[hh * 4 + np], 0, 0, 0); } }
        LDS_WAIT(); asm volatile("" ::: "memory");
    }
#if defined(SSDB_CUT) && SSDB_CUT == 1
    { float t_ = 0.f; for (int i = 0; i < 12; ++i) t_ += acc_y[i][0] + acc_y[i][1] + acc_y[i][2] + acc_y[i][3]; if (t_ == 123.f) MIXB[0] = 1; return; }
#endif
#pragma unroll
    for (int t = 0; t < 12; ++t) { const int hh = t >> 2, col = hh * 64 + (t & 3) * 16 + fr; const float dk = dsk[3 * g + hh];
#pragma unroll
        for (int r = 0; r < 4; ++r) { const int l = 16 * wave + 4 * fq + r; acc_y[t][r] += dk * __uint_as_float(((unsigned)*(const LAS bf16*)(PX + l * XP + col * 2)) << 16); } }
    __syncthreads();
    LAS bf16* ost = (LAS bf16*)(lds + wave * (16 * XP));
#pragma unroll
    for (int t = 0; t < 12; ++t) { const int col = (t >> 2) * 64 + (t & 3) * 16 + fr;
#pragma unroll
        for (int r = 0; r < 4; ++r) ost[(4 * fq + r) * (XP / 2) + col] = (bf16)f2bf(acc_y[t][r]); }
    LDS_WAIT(); asm volatile("" ::: "memory");
    { const int rr = lane >> 2, q = lane & 3; const long row = r0 + 16 * wave + rr;
      float yz[48]; float ssum = 0.f;
#pragma unroll
      for (int i = 0; i < 6; ++i) { const int c8 = (q * 6 + i) * 8;
          const fp::u32x4 yv = *(const LAS fp::u32x4*)(ost + rr * (XP / 2) + c8);
          const fp::u32x4 zv = *(const fp::u32x4*)(PROJ + row * PLD + FZ + 192 * g + c8);
#pragma unroll
          for (int j = 0; j < 4; ++j) { const unsigned yw = yv[j], zw = zv[j];
              const float y0 = __uint_as_float(yw << 16), y1 = __uint_as_float(yw & 0xffff0000u), z0 = __uint_as_float(zw << 16), z1 = __uint_as_float(zw & 0xffff0000u);
              const float a0 = y0 * (z0 * __builtin_amdgcn_rcpf(1.f + __expf(-z0))), a1 = y1 * (z1 * __builtin_amdgcn_rcpf(1.f + __expf(-z1))); yz[i * 8 + 2 * j] = a0; yz[i * 8 + 2 * j + 1] = a1; ssum += a0 * a0 + a1 * a1; } }
      ssum += __shfl_xor(ssum, 1); ssum += __shfl_xor(ssum, 2);
      const float rinv = rsqrtf(ssum * (1.f / 192.f) + 1e-5f);
#pragma unroll
      for (int i = 0; i < 6; ++i) { const int c8 = (q * 6 + i) * 8;
          const float4 g0 = *(const float4*)(ng + 192 * g + c8), g1 = *(const float4*)(ng + 192 * g + c8 + 4);
          fp::u32x4 o; o.x = fp::pk2(yz[i * 8] * rinv * g0.x, yz[i * 8 + 1] * rinv * g0.y); o.y = fp::pk2(yz[i * 8 + 2] * rinv * g0.z, yz[i * 8 + 3] * rinv * g0.w);
          o.z = fp::pk2(yz[i * 8 + 4] * rinv * g1.x, yz[i * 8 + 5] * rinv * g1.y); o.w = fp::pk2(yz[i * 8 + 6] * rinv * g1.z, yz[i * 8 + 7] * rinv * g1.w);
          *(fp::u32x4*)(MIXB + row * DM + ATT_W + 192 * g + c8) = o; } }
    __syncthreads();
}

__device__ __forceinline__ void att_norm_phase(bf16* MIXB, const float* g, long n_rows, int gw_, int ngw_, int lane) {
    float4 g0 = make_float4(0.f, 0.f, 0.f, 0.f), g1 = g0; if (lane < 48) { g0 = *(const float4*)(g + lane * 8); g1 = *(const float4*)(g + lane * 8 + 4); }
    fp::u32x4 wa = (fp::u32x4){0u, 0u, 0u, 0u}, wb = wa; long r = gw_;
    if (r < n_rows && lane < 48) wa = *(const fp::u32x4*)(MIXB + r * DM + lane * 8);
#define ATTN_NORM_ROW(WV_, rr) do { float v[8]; float s2 = 0.f; \
        _Pragma("unroll") for (int j = 0; j < 4; ++j) { v[2 * j] = __uint_as_float(WV_[j] << 16); v[2 * j + 1] = __uint_as_float(WV_[j] & 0xffff0000u); s2 += v[2 * j] * v[2 * j] + v[2 * j + 1] * v[2 * j + 1]; } \
        const float rs = rsqrtf(wave_sum(s2) * (1.f / 384.f) + 1e-5f); \
        if (lane < 48) { fp::u32x4 o; o.x = fp::pk2(v[0] * rs * g0.x, v[1] * rs * g0.y); o.y = fp::pk2(v[2] * rs * g0.z, v[3] * rs * g0.w); o.z = fp::pk2(v[4] * rs * g1.x, v[5] * rs * g1.y); o.w = fp::pk2(v[6] * rs * g1.z, v[7] * rs * g1.w); \
            *(fp::u32x4*)(MIXB + (rr) * DM + lane * 8) = o; } } while (0)
    for (; r < n_rows; r += 2 * ngw_) { const long r1 = r + ngw_, r2 = r + 2 * ngw_;
        if (r1 < n_rows && lane < 48) wb = *(const fp::u32x4*)(MIXB + r1 * DM + lane * 8);
        ATTN_NORM_ROW(wa, r);
        if (r2 < n_rows && lane < 48) wa = *(const fp::u32x4*)(MIXB + r2 * DM + lane * 8);
        if (r1 < n_rows) ATTN_NORM_ROW(wb, r1); }
#undef ATTN_NORM_ROW
}

constexpr int FT_G = 16 * (N_EXP * NGUE / 32) / 8, FT_D = (D_FFE / 64) * (N_EXP * DM / 32) / 8;
constexpr int FT_G_A = 1408, FT_G_B = 768, FT_D_A = 512, FT_D_D = 768;
__device__ __forceinline__ void filler_g(int t, const float* p_mg, const float* p_mu, bf16* MWGU_, LAS float* scr, int wave, int lane_) {
    asm volatile("" : "+v"(lane_));
    const int r = t * 8 + wave; const int kb = r / (N_EXP * NGUE / 32), db = r % (N_EXP * NGUE / 32); const int d = db * 32 + (lane_ & 31), e = d / NGUE;
    fp::conv_item(fp::gu_src(p_mg + (size_t)e * DM * D_FFE, p_mu + (size_t)e * DM * D_FFE, D_FFE, d - e * NGUE), DM, MWGU_, (long)db * 32, kb * 64, scr, lane_);
}
__device__ __forceinline__ void filler_d(int t, const float* p_md, bf16* MWD_, LAS float* scr, int wave, int lane_) {
    asm volatile("" : "+v"(lane_));
    const int r = t * 8 + wave; const int kb = r / (N_EXP * DM / 32), db = r % (N_EXP * DM / 32); const int d = db * 32 + (lane_ & 31), e = d / DM;
    fp::SrcCol sc_; sc_.p = p_md + (size_t)e * D_FFE * DM + (d - e * DM); sc_.ld = DM; fp::conv_item(sc_, D_FFE, MWD_, (long)db * 32, kb * 64, scr, lane_);
}

struct FArgs { const void* in[29]; float* out; unsigned char* ws; int ph_lo, ph_hi; };
__device__ __forceinline__ const void* ldarg(int k) { const void* p; asm volatile("s_load_dwordx2 %0, %1, %2\n\ts_waitcnt lgkmcnt(0)" : "=s"(p) : "s"(__builtin_amdgcn_kernarg_segment_ptr()), "i"(k * 8)); return p; }

constexpr int N_PHASES = 18;
__global__ void __launch_bounds__(512, 2) mega(FArgs a) {
    extern __shared__ __attribute__((aligned(16))) unsigned char lds_[];
    LAS unsigned char* lds = (LAS unsigned char*)lds_;
    const int wave = __builtin_amdgcn_readfirstlane((int)threadIdx.x >> 6);
#define lane ((int)__builtin_amdgcn_mbcnt_hi(~0u, __builtin_amdgcn_mbcnt_lo(~0u, 0u)))
#define tid (wave * 64 + lane)
    const int G = gridDim.x; const int bx = blockIdx.x;
#define vcu (((int)gridDim.x % 8 == 0) ? ((int)blockIdx.x % 8) * ((int)gridDim.x / 8) + (int)blockIdx.x / 8 : (int)blockIdx.x)
#define gw (vcu * 8 + wave)
#define ngw ((int)gridDim.x * 8)
#define gt ((long)gw * 64 + lane)
#define ngt ((long)ngw * 64)
    unsigned char* ws = a.ws;
    unsigned* ctl = (unsigned*)(ws + O_CTL);
    for (int u = (int)threadIdx.x; u < (LDS_BYTES - RING_BYTES) / 4; u += 512) ((LAS unsigned*)(lds + RING_BYTES))[u] = 0u;
    __syncthreads();
    const int lo = a.ph_lo, hi = a.ph_hi;
    XcdBarrier bar; bar.bar = ctl + CW_BAR; bar.x = 0; bar.st = nullptr; bar.w0 = 0;
    if (hi - lo > 1) bar = xcd_barrier_post(ctl + CW_BAR, (volatile LAS unsigned*)(lds + MISC_OFF) + 8);
#define in_x ((const float*)ldarg(0))
#define in_pos ((const int*)ldarg(1))
#define ln_in_g ((const float*)ldarg(2))
#define ln_in_b ((const float*)ldarg(3))
#define w_in ((const float*)ldarg(4))
#define conv_w ((const float*)ldarg(5))
#define conv_b ((const float*)ldarg(6))
#define dt_bias ((const float*)ldarg(7))
#define a_log ((const float*)ldarg(8))
#define d_skip ((const float*)ldarg(9))
#define ssd_norm_g ((const float*)ldarg(10))
#define att_norm_g ((const float*)ldarg(11))
#define gm_ln_g ((const float*)ldarg(12))
#define gm_ln_b ((const float*)ldarg(13))
#define gm_w_s ((const float*)ldarg(14))
#define gm_b_s ((const float*)ldarg(15))
#define gm_norm_g ((const float*)ldarg(16))
#define w_out ((const float*)ldarg(17))
#define ln1_g ((const float*)ldarg(18))
#define ln1_b ((const float*)ldarg(19))
#define ln2_g ((const float*)ldarg(20))
#define ln2_b ((const float*)ldarg(21))
#define ffn_w_gate ((const float*)ldarg(22))
#define ffn_w_up ((const float*)ldarg(23))
#define ffn_w_down ((const float*)ldarg(24))
#define router_w ((const float*)ldarg(25))
#define moe_w_gate ((const float*)ldarg(26))
#define moe_w_up ((const float*)ldarg(27))
#define moe_w_down ((const float*)ldarg(28))
#define H ((float*)WOUTP)
#define MWD ((bf16*)WOUTP)
#define RT ((float*)(WSP + O_RT))
#define TE ((int*)(WSP + O_TE))
#define TP ((float*)(WSP + O_TP))
#define TS ((int*)(WSP + O_TS))
#define GS ((int*)(WSP + O_GS))
#define SP ((float*)(WSP + O_SP))
#define KM ((float*)(WSP + O_KM))
#define WSB ((bf16*)(WSP + O_WSB))
#define HB ((bf16*)(WSP + O_HB))
#define MWGU ((bf16*)(WSP + O_MWGU))
#define WIN ((bf16*)(WSP + O_WIN))
#define WOUT ((bf16*)(WSP + O_WOUT))
#define WGU ((bf16*)(WSP + O_WGU))
#define WD ((bf16*)(WSP + O_WD))
#define PROJ ((bf16*)(WSP + O_PROJ))
#define ST ((float*)(WSP + O_XC))
#define CD ((float*)(WSP + O_DT))
#define XCB ((bf16*)(WSP + O_MIXU))
#define DTG ((float*)(WSP + O_VN))
#define MIXB ((bf16*)(WSP + O_MIXB))
#define YB ((bf16*)(WSP + O_Y))
#define ACT ((bf16*)(WSP + O_ACT))
#define XG ((bf16*)(WSP + O_XG))
#define F2 ((bf16*)(WSP + O_XG))
#define ACTM ((bf16*)(WSP + O_ACTM))
#define F2P ((bf16*)(WSP + O_MWGU))
#define CNT ((int*)(WSP + O_CTL + 4 * CW_CNT))
    const ProjL FL{PLD, FQ, FK, FV, FZ, FXBC, FDT, FGU, FGV};
    LAS float* scr = (LAS float*)(lds + wave * 16384);

#ifndef PH_MASK
#define PH_MASK 0xffffffffu
#endif
#ifndef PROBE_MASK
#define PROBE_MASK 0u
#endif
#ifndef PROBE_AMP
#define PROBE_AMP 0
#endif
    volatile unsigned* pr_w = (volatile unsigned*)(ctl + 1100);
#define pr_me ((PROBE_MASK != 0u) && blockIdx.x == 0 && wave == 0 && __builtin_amdgcn_mbcnt_hi(~0u, __builtin_amdgcn_mbcnt_lo(~0u, 0u)) == 0u)
#define PH_BEGIN(k) if (lo <= (k) && (k) < hi && ((PH_MASK >> (k)) & 1u)) { unsigned char* WSP = a.ws; unsigned char* WOUTP = (unsigned char*)a.out; asm volatile("" : "+s"(WSP), "+s"(WOUTP)); if (((PROBE_MASK >> (k)) & 1u) && pr_me) pr_w[0] = (unsigned)__builtin_amdgcn_s_memrealtime();
#define PH_END(k)   if ((k) + 1 < hi) xcd_barrier(bar); if (((PROBE_MASK >> (k)) & 1u) && pr_me) pr_w[1] += (unsigned)__builtin_amdgcn_s_memrealtime() - pr_w[0]; }

    PH_BEGIN(0)
    { const float* const p_w_in = w_in; const float* const p_w_out = w_out; const float* const p_fg = ffn_w_gate; const float* const p_fu = ffn_w_up; const float* const p_fd = ffn_w_down;
        constexpr int I_WIN = 16 * (PLD / 32), I_WOUT = 16 * (DM / 32), I_WGU = 16 * (NGU / 32), I_WD = (D_FF / 64) * (DM / 32), I_MWGU = 16 * (N_EXP * NGUE / 32);
        constexpr int NIT = 2 * I_WIN + 2 * I_WOUT + I_WGU + I_WD; (void)I_MWGU;
        for (int it = gw; it < NIT; it += ngw) {
            int r = it; const int l5 = lane & 31;
            if (r < 2 * I_WIN) { const int L = r / I_WIN; r -= L * I_WIN; const int kb = r / (PLD / 32), db = r % (PLD / 32); const int sc_ = fp::win_src_col(db * 32 + l5);
                fp::SrcCol s; s.p = sc_ >= 0 ? p_w_in + (size_t)L * DM * D_IN + sc_ : nullptr; s.ld = D_IN; fp::conv_item(s, DM, WIN + (size_t)L * PLD * DM, db * 32, kb * 64, scr, lane); continue; } r -= 2 * I_WIN;
            if (r < 2 * I_WOUT) { const int L = r / I_WOUT; r -= L * I_WOUT; const int kb = r / (DM / 32), db = r % (DM / 32);
                fp::SrcCol s; s.p = p_w_out + (size_t)L * DM * DM + db * 32 + l5; s.ld = DM; fp::conv_item(s, DM, WOUT + (size_t)L * DM * DM, db * 32, kb * 64, scr, lane); continue; } r -= 2 * I_WOUT;
            if (r < I_WGU) { const int kb = r / (NGU / 32), db = r % (NGU / 32);
                fp::conv_item(fp::gu_src(p_fg, p_fu, D_FF, db * 32 + l5), DM, WGU, db * 32, kb * 64, scr, lane); continue; } r -= I_WGU;
            { const int kb = r / (DM / 32), db = r % (DM / 32);
                fp::SrcCol s; s.p = p_fd + db * 32 + l5; s.ld = DM; fp::conv_item(s, D_FF, WD, db * 32, kb * 64, scr, lane); }
        }
        const int* const p_pos = in_pos; const float* const p_gws = gm_w_s; const float* const p_x = in_x; const float* const p_lg = ln_in_g; const float* const p_lb = ln_in_b;
        for (long it = gt; it < (long)M_ * 8; it += ngt) { const int i = (int)(it & 7); const long row = it >> 3;
            const float inv = powf(500000.0f, -(float)(2 * i) / 16.0f); const float ang = (float)p_pos[row] * inv; RT[row * 16 + i] = cosf(ang); RT[row * 16 + 8 + i] = sinf(ang); }
        for (long it = gt; it < 2L * GM_G * GM_CHUNK * GM_CHUNK; it += ngt) { const int sidx = (int)(it & 127), t = (int)((it >> 7) & 127); WSB[it] = (bf16)(sidx <= t ? f2bf(p_gws[it]) : 0u); }
        { float va[16], vb[16]; LnGB gbp; ln_gb_load(gbp, p_lg, p_lb, lane); long r = gw; if (r < M_) ln_load<float>(va, p_x + r * DM, 1.f, nullptr, nullptr, lane);
          for (; r < M_; r += 2 * ngw) { const long r1 = r + ngw, r2 = r + 2 * ngw;
              if (r1 < M_) ln_load<float>(vb, p_x + r1 * DM, 1.f, nullptr, nullptr, lane);
              ln_finish_r(va, gbp, nullptr, HB + r * DM, lane);
              if (r2 < M_) ln_load<float>(va, p_x + r2 * DM, 1.f, nullptr, nullptr, lane);
              if (r1 < M_) ln_finish_r(vb, gbp, nullptr, HB + r1 * DM, lane); } }
    }
    PH_END(0)


    { constexpr int layer = 0; constexpr int PB = 1;
        PH_BEGIN(PB + 0)
        { pg8::Gemm g{HB, WIN + (size_t)layer * PLD * DM, M_, PLD, DM, DM}; pg8::StaticOrder S; S.init(M_, PLD, G, bx);
          fp::EpiProj E{PROJ, RT, KM}; pg8::gemm_phase<fp::EpiProj, pg8::StaticOrder, true, true>(lds, g, S, E, tid); }
        PH_END(PB + 0)
        PH_BEGIN(PB + 1)
        { constexpr int NATT = NB * ATT_H * NBLK, NSSDA = NB * 32;
          volatile LAS unsigned* qw = (volatile LAS unsigned*)(lds + MISC_OFF) + 16;
#define QNEXT(word) do { if (tid == 0) qw[0] = __hip_atomic_fetch_add(ctl + (word), 1u, __ATOMIC_RELAXED, __HIP_MEMORY_SCOPE_AGENT); __syncthreads(); idx = (int)qw[0]; __syncthreads(); } while (0)
          int idx;
          for (;;) { QNEXT(CW_Q + 8 * layer); if (idx >= NATT) break;
              const int qb = (NBLK - 1) - idx / (NB * ATT_H), bh = idx % (NB * ATT_H);
              attn_body::attn_unit<8>(bh / ATT_H, bh % ATT_H, qb, (const attn_body::bf16*)(PROJ + FQ), (const attn_body::bf16*)(PROJ + FK), (const attn_body::bf16*)(PROJ + FV), (attn_body::bf16*)MIXB, KM, NB * ATT_H * NBLK * 64, (char*)lds_, tid); }
          for (;;) { QNEXT(CW_Q + 8 * layer + 1); if (idx >= NSSDA) break;
              ssdA_unit(idx >> 5, (idx >> 1) & 15, idx & 1, PROJ, conv_w + (size_t)layer * 4 * SSD_CW, conv_b + layer * SSD_CW, dt_bias + layer * SSD_H, a_log + layer * SSD_H, ST, CD, XCB, DTG, lds, tid, wave, lane); }
        }
        PH_END(PB + 1)
        PH_BEGIN(PB + 2)
        { constexpr int NSSDB = NB * 32, NGMU = NB * (SEQ / GM_CHUNK);
          volatile LAS unsigned* qw = (volatile LAS unsigned*)(lds + MISC_OFF) + 16;
          int idx;
          for (;;) { QNEXT(CW_Q + 8 * layer + 2); if (idx >= NSSDB) break;
              const int c = 15 - idx / (NB * 2), bg = idx % (NB * 2);
              ssdB_unit(bg >> 1, c, bg & 1, PROJ, XCB, DTG, d_skip + layer * SSD_H, ssd_norm_g + layer * SSD_W, ST, CD, MIXB, lds, tid, wave, lane); }
          for (;;) { QNEXT(CW_Q + 8 * layer + 3); if (idx >= NGMU) break;
              gm_unit(idx / (SEQ / GM_CHUNK), idx % (SEQ / GM_CHUNK), PROJ, WSB + (size_t)layer * GM_G * GM_CHUNK * GM_CHUNK, gm_ln_g + layer * GM_W, gm_ln_b + layer * GM_W,
                      gm_b_s + layer * GM_G * GM_CHUNK, gm_norm_g + layer * GM_W, MIXB, lds, wave, lane); }
          att_norm_phase(MIXB, att_norm_g + layer * ATT_W, M_, gw, ngw, lane);
          { const float* const p_mg = moe_w_gate; const float* const p_mu = moe_w_up; const float* const p_md = moe_w_down;
            constexpr int g0 = layer == 0 ? 0 : FT_G_A + FT_G_B, g1 = layer == 0 ? FT_G_A : FT_G, d0 = layer == 0 ? 0 : FT_D_A, d1 = layer == 0 ? FT_D_A : FT_D - FT_D_D;
            for (;;) { QNEXT(CW_Q + 8 * layer + 4); if (idx >= g1 - g0) break; filler_g(g0 + idx, p_mg, p_mu, MWGU, scr, wave, lane); }
            for (;;) { QNEXT(CW_Q + 8 * layer + 5); if (idx >= d1 - d0) break; filler_d(d0 + idx, p_md, MWD, scr, wave, lane); } }
#undef QNEXT
        }
        PH_END(PB + 2)
        PH_BEGIN(PB + 3)
        { pg8::Gemm g{MIXB, WOUT + (size_t)layer * DM * DM, M_, DM, DM, DM}; pg8::StaticOrder S; S.init(M_, DM, G, bx);
          fp::EpiY E{YB, DM}; pg8::gemm_phase<fp::EpiY, pg8::StaticOrder, false, true>(lds, g, S, E, tid); }
        PH_END(PB + 3)
        PH_BEGIN(PB + 4)
        { const float* const p_g = ln1_g + layer * DM; const float* const p_b = ln1_b + layer * DM;
          { float va[16], vb[16]; LnGB gbp; ln_gb_load(gbp, p_g, p_b, lane); long r = gw; if (r < M_) ln_load<bf16, bf16>(va, HB + r * DM, ALPHA, YB + r * DM, nullptr, lane);
            for (; r < M_; r += 2 * ngw) { const long r1 = r + ngw, r2 = r + 2 * ngw;
                if (r1 < M_) ln_load<bf16, bf16>(vb, HB + r1 * DM, ALPHA, YB + r1 * DM, nullptr, lane);
                ln_finish_r(va, gbp, nullptr, HB + r * DM, lane);
                if (r2 < M_) ln_load<bf16, bf16>(va, HB + r2 * DM, ALPHA, YB + r2 * DM, nullptr, lane);
                if (r1 < M_) ln_finish_r(vb, gbp, nullptr, HB + r1 * DM, lane); } }
          if (layer == 1) { asm volatile("s_waitcnt vmcnt(0)" ::: "memory"); moe_route_block(HB, router_w, CNT, TE, TP, TS, M_, gw, ngw, lane, wave, tid, (LAS int*)lds); } }
        PH_END(PB + 4)
        if constexpr (layer == 0) {
            PH_BEGIN(PB + 5)
            { pg8::Gemm g{HB, WGU, M_, NGU, DM, DM}; pg8::StaticOrder S; S.init(M_, NGU, G, bx);
              fp::EpiAct E{ACT, D_FF, NGU / 256}; pg8::gemm_phase<fp::EpiAct, pg8::StaticOrder, true, true>(lds, g, S, E, tid);
              { constexpr int UNITS = (NB * SEQ / 256) * (NGU / 256), REM = UNITS % 256;
                if (REM != 0 && G == 256 && bx >= REM) { constexpr int PER = (FT_G_B + (256 - REM) - 1) / (256 - REM); const float* const p_mg = moe_w_gate; const float* const p_mu = moe_w_up;
                    for (int k = 0; k < PER; ++k) { const int t = (bx - REM) * PER + k; if (t < FT_G_B) filler_g(FT_G_A + t, p_mg, p_mu, MWGU, scr, wave, lane); } }
                else if (REM == 0 || G != 256) { const float* const p_mg = moe_w_gate; const float* const p_mu = moe_w_up; for (int t = bx; t < FT_G_B; t += G) filler_g(FT_G_A + t, p_mg, p_mu, MWGU, scr, wave, lane); } } }
            PH_END(PB + 5)
            PH_BEGIN(PB + 6)
            { pg8::Gemm g{ACT, WD, M_, DM, D_FF, D_FF}; pg8::StaticOrder S; S.init(M_, DM, G, bx);
              fp::EpiY E{YB, DM}; pg8::gemm_phase<fp::EpiY, pg8::StaticOrder, false, true>(lds, g, S, E, tid); }
            PH_END(PB + 6)
            PH_BEGIN(PB + 7)
            { const float* const p_g = ln2_g + layer * DM; const float* const p_b = ln2_b + layer * DM;
              { float va[16], vb[16]; LnGB gbp; ln_gb_load(gbp, p_g, p_b, lane); long r = gw; if (r < M_) ln_load<bf16, bf16>(va, HB + r * DM, ALPHA, YB + r * DM, nullptr, lane);
            for (; r < M_; r += 2 * ngw) { const long r1 = r + ngw, r2 = r + 2 * ngw;
                if (r1 < M_) ln_load<bf16, bf16>(vb, HB + r1 * DM, ALPHA, YB + r1 * DM, nullptr, lane);
                ln_finish_r(va, gbp, nullptr, HB + r * DM, lane);
                if (r2 < M_) ln_load<bf16, bf16>(va, HB + r2 * DM, ALPHA, YB + r2 * DM, nullptr, lane);
                if (r1 < M_) ln_finish_r(vb, gbp, nullptr, HB + r1 * DM, lane); } } }
            PH_END(PB + 7)
        } else {
            PH_BEGIN(PB + 5)
            { int base[N_EXP]; { int b_ = 0;
#pragma unroll
                  for (int e = 0; e < N_EXP; ++e) { base[e] = b_; b_ += (CNT[e] + 255) & ~255; } }
              constexpr int RPW = (M_ + 2047) / 2048;
              int te[RPW][2], tsl[RPW][2]; float tpv[RPW][2];
#pragma unroll
              for (int k = 0; k < RPW; ++k) { const long r = gw + (long)k * ngw;
#pragma unroll
                  for (int q = 0; q < 2; ++q) { te[k][q] = 0; tsl[k][q] = 0; tpv[k][q] = 0.f; if (r < M_) { te[k][q] = TE[r * 2 + q]; tsl[k][q] = TS[r * 2 + q]; tpv[k][q] = TP[r * 2 + q]; } } }
#pragma unroll
              for (int k = 0; k < RPW; ++k) { const long r = gw + (long)k * ngw; if (r < M_) {
                  const uint4* src = (const uint4*)(HB + r * DM); const uint4 v0 = src[lane], v1 = src[lane + 64];
#pragma unroll
                  for (int q = 0; q < 2; ++q) { int be = 0;
#pragma unroll
                      for (int x = 0; x < N_EXP; ++x) be = (te[k][q] == x) ? base[x] : be;
                      const int gs = be + tsl[k][q];
                      if (lane == 0) { SP[gs] = tpv[k][q]; GS[r * 2 + q] = gs; }
                      uint4* dst = (uint4*)(XG + (size_t)gs * DM); dst[lane] = v0; dst[lane + 64] = v1; } } }
              for (long r = gw + (long)RPW * ngw; r < M_; r += ngw) {
                  const uint4* src = (const uint4*)(HB + r * DM); const uint4 v0 = src[lane], v1 = src[lane + 64];
                  for (int q = 0; q < 2; ++q) { const long it = r * 2 + q; const int e = TE[it]; int be = 0;
#pragma unroll
                      for (int x = 0; x < N_EXP; ++x) be = (e == x) ? base[x] : be;
                      const int gs = be + TS[it];
                      if (lane == 0) { SP[gs] = TP[it]; GS[it] = gs; }
                      uint4* dst = (uint4*)(XG + (size_t)gs * DM); dst[lane] = v0; dst[lane + 64] = v1; } }
              for (int it = gw; it < N_EXP * 256; it += ngw) { const int e = it >> 8, r = it & 255; const int c = CNT[e]; const int slot = moe_base(CNT, e) + c + r;
                  if (c + r < ((c + 255) & ~255)) { uint4* dst = (uint4*)(XG + (size_t)slot * DM); const uint4 z = make_uint4(0u, 0u, 0u, 0u); dst[lane] = z; dst[lane + 64] = z; if (lane == 0) SP[slot] = 0.f; } } }
            PH_END(PB + 5)
            PH_BEGIN(PB + 6)
            { pg8::Gemm g{XG, MWGU, NSLOT, N_EXP * NGUE, DM, DM}; fp::MoeOrder S; S.init(CNT, NGUE / 256, G, bx);
              fp::EpiAct E{ACTM, D_FFE, NGUE / 256}; pg8::gemm_phase<fp::EpiAct, fp::MoeOrder, true, true>(lds, g, S, E, tid);
              { const int rem = (S.T * S.ncol) % G; const int nidle = rem == 0 ? G : G - rem, first = rem == 0 ? 0 : rem;
                if (bx >= first) { const int per = (FT_D_D + nidle - 1) / nidle; const float* const p_md = moe_w_down;
                    for (int k = 0; k < per; ++k) { const int t = (bx - first) * per + k; if (t < FT_D_D) filler_d(FT_D - FT_D_D + t, p_md, MWD, scr, wave, lane); } } } }
            PH_END(PB + 6)
            PH_BEGIN(PB + 7)
            { fp::MoeOrder S; S.init(CNT, DM / 256, G, bx); const int nf = S.tail_start(); const int slot0 = (nf / (DM / 256)) * 256;
              fp::EpiF2 E{F2, SP, F2P, slot0, D_FFE / 4};
              { pg8::Gemm g{ACTM, MWD, NSLOT, N_EXP * DM, D_FFE, D_FFE}; S.nfull = nf; S.ksplit = 1;
                pg8::gemm_phase<fp::EpiF2, fp::MoeOrder, true, true>(lds, g, S, E, tid); }
              { pg8::Gemm g{ACTM, MWD, NSLOT, N_EXP * DM, D_FFE / 4, D_FFE}; S.ksplit = 4; S.klen = D_FFE / 4;
                int tid2 = tid; asm volatile("" : "+v"(tid2));
                pg8::gemm_phase<fp::EpiF2, fp::MoeOrder, true, true>(lds, g, S, E, tid2); } }
            PH_END(PB + 7)
            PH_BEGIN(PB + 8)
            { const float* const p_g = ln2_g + layer * DM; const float* const p_b = ln2_b + layer * DM;
              int slot0; { fp::MoeOrder S; S.init(CNT, DM / 256, G, bx); const int nf = S.tail_start(); slot0 = (nf == S.T * (DM / 256)) ? 0x7fffffff : (nf / (DM / 256)) * 256; }
#define LN2_LOAD(v, rr, kk_) do { int s0_ = GS[(rr) * 2], s1_ = GS[(rr) * 2 + 1]; if (kk_ < RPW2) { _Pragma("unroll") for (int x_ = 0; x_ < RPW2; ++x_) if (x_ == kk_) { s0_ = gsv[x_][0]; s1_ = gsv[x_][1]; } } ln_load<bf16, bf16>(v, HB + (rr) * DM, ALPHA, F2 + (size_t)s0_ * DM, F2 + (size_t)s1_ * DM, lane); \
                  if (s0_ >= slot0) { _Pragma("unroll") for (int p_ = 0; p_ < 3; ++p_) ln_add(v, F2P + ((size_t)p_ * TAIL_SLOTS + (s0_ - slot0)) * DM, lane); } \
                  if (s1_ >= slot0) { _Pragma("unroll") for (int p_ = 0; p_ < 3; ++p_) ln_add(v, F2P + ((size_t)p_ * TAIL_SLOTS + (s1_ - slot0)) * DM, lane); } } while (0)
              constexpr int RPW2 = (M_ + 2047) / 2048; int gsv[RPW2][2];
#pragma unroll
              for (int x_ = 0; x_ < RPW2; ++x_) { const long rr_ = gw + (long)x_ * ngw; gsv[x_][0] = 0; gsv[x_][1] = 0; if (rr_ < M_) { gsv[x_][0] = GS[rr_ * 2]; gsv[x_][1] = GS[rr_ * 2 + 1]; } }
              { float va[16], vb[16]; LnGB gbp; ln_gb_load(gbp, p_g, p_b, lane); long r = gw; int kq = 0; if (r < M_) LN2_LOAD(va, r, kq);
                for (; r < M_; r += 2 * ngw, kq += 2) { const long r1 = r + ngw, r2 = r + 2 * ngw;
                    if (r1 < M_) LN2_LOAD(vb, r1, kq + 1);
                    ln_finish_r(va, gbp, H + r * DM, nullptr, lane);
                    if (r2 < M_) LN2_LOAD(va, r2, kq + 2);
                    if (r1 < M_) ln_finish_r(vb, gbp, H + r1 * DM, nullptr, lane); } }
#undef LN2_LOAD
            }
            PH_END(PB + 8)
        }
    }

    { constexpr int layer = 1; constexpr int PB = 9;
        PH_BEGIN(PB + 0)
        { pg8::Gemm g{HB, WIN + (size_t)layer * PLD * DM, M_, PLD, DM, DM}; pg8::StaticOrder S; S.init(M_, PLD, G, bx);
          fp::EpiProj E{PROJ, RT, KM}; pg8::gemm_phase<fp::EpiProj, pg8::StaticOrder, true, true>(lds, g, S, E, tid); }
        PH_END(PB + 0)
        PH_BEGIN(PB + 1)
        { constexpr int NATT = NB * ATT_H * NBLK, NSSDA = NB * 32;
          volatile LAS unsigned* qw = (volatile LAS unsigned*)(lds + MISC_OFF) + 16;
#define QNEXT(word) do { if (tid == 0) qw[0] = __hip_atomic_fetch_add(ctl + (word), 1u, __ATOMIC_RELAXED, __HIP_MEMORY_SCOPE_AGENT); __syncthreads(); idx = (int)qw[0]; __syncthreads(); } while (0)
          int idx;
          for (;;) { QNEXT(CW_Q + 8 * layer); if (idx >= NATT) break;
              const int qb = (NBLK - 1) - idx / (NB * ATT_H), bh = idx % (NB * ATT_H);
              attn_body::attn_unit<8>(bh / ATT_H, bh % ATT_H, qb, (const attn_body::bf16*)(PROJ + FQ), (const attn_body::bf16*)(PROJ + FK), (const attn_body::bf16*)(PROJ + FV), (attn_body::bf16*)MIXB, KM, NB * ATT_H * NBLK * 64, (char*)lds_, tid); }
          for (;;) { QNEXT(CW_Q + 8 * layer + 1); if (idx >= NSSDA) break;
              ssdA_unit(idx >> 5, (idx >> 1) & 15, idx & 1, PROJ, conv_w + (size_t)layer * 4 * SSD_CW, conv_b + layer * SSD_CW, dt_bias + layer * SSD_H, a_log + layer * SSD_H, ST, CD, XCB, DTG, lds, tid, wave, lane); }
        }
        PH_END(PB + 1)
        PH_BEGIN(PB + 2)
        { constexpr int NSSDB = NB * 32, NGMU = NB * (SEQ / GM_CHUNK);
          volatile LAS unsigned* qw = (volatile LAS unsigned*)(lds + MISC_OFF) + 16;
          int idx;
          for (;;) { QNEXT(CW_Q + 8 * layer + 2); if (idx >= NSSDB) break;
              const int c = 15 - idx / (NB * 2), bg = idx % (NB * 2);
              ssdB_unit(bg >> 1, c, bg & 1, PROJ, XCB, DTG, d_skip + layer * SSD_H, ssd_norm_g + layer * SSD_W, ST, CD, MIXB, lds, tid, wave, lane); }
          for (;;) { QNEXT(CW_Q + 8 * layer + 3); if (idx >= NGMU) break;
              gm_unit(idx / (SEQ / GM_CHUNK), idx % (SEQ / GM_CHUNK), PROJ, WSB + (size_t)layer * GM_G * GM_CHUNK * GM_CHUNK, gm_ln_g + layer * GM_W, gm_ln_b + layer * GM_W,
                      gm_b_s + layer * GM_G * GM_CHUNK, gm_norm_g + layer * GM_W, MIXB, lds, wave, lane); }
          att_norm_phase(MIXB, att_norm_g + layer * ATT_W, M_, gw, ngw, lane);
          { const float* const p_mg = moe_w_gate; const float* const p_mu = moe_w_up; const float* const p_md = moe_w_down;
            constexpr int g0 = layer == 0 ? 0 : FT_G_A + FT_G_B, g1 = layer == 0 ? FT_G_A : FT_G, d0 = layer == 0 ? 0 : FT_D_A, d1 = layer == 0 ? FT_D_A : FT_D - FT_D_D;
            for (;;) { QNEXT(CW_Q + 8 * layer + 4); if (idx >= g1 - g0) break; filler_g(g0 + idx, p_mg, p_mu, MWGU, scr, wave, lane); }
            for (;;) { QNEXT(CW_Q + 8 * layer + 5); if (idx >= d1 - d0) break; filler_d(d0 + idx, p_md, MWD, scr, wave, lane); } }
#undef QNEXT
        }
        PH_END(PB + 2)
        PH_BEGIN(PB + 3)
        { pg8::Gemm g{MIXB, WOUT + (size_t)layer * DM * DM, M_, DM, DM, DM}; pg8::StaticOrder S; S.init(M_, DM, G, bx);
          fp::EpiY E{YB, DM}; pg8::gemm_phase<fp::EpiY, pg8::StaticOrder, false, true>(lds, g, S, E, tid); }
        PH_END(PB + 3)
        PH_BEGIN(PB + 4)
        { const float* const p_g = ln1_g + layer * DM; const float* const p_b = ln1_b + layer * DM;
          { float va[16], vb[16]; LnGB gbp; ln_gb_load(gbp, p_g, p_b, lane); long r = gw; if (r < M_) ln_load<bf16, bf16>(va, HB + r * DM, ALPHA, YB + r * DM, nullptr, lane);
            for (; r < M_; r += 2 * ngw) { const long r1 = r + ngw, r2 = r + 2 * ngw;
                if (r1 < M_) ln_load<bf16, bf16>(vb, HB + r1 * DM, ALPHA, YB + r1 * DM, nullptr, lane);
                ln_finish_r(va, gbp, nullptr, HB + r * DM, lane);
                if (r2 < M_) ln_load<bf16, bf16>(va, HB + r2 * DM, ALPHA, YB + r2 * DM, nullptr, lane);
                if (r1 < M_) ln_finish_r(vb, gbp, nullptr, HB + r1 * DM, lane); } }
          if (layer == 1) { asm volatile("s_waitcnt vmcnt(0)" ::: "memory"); moe_route_block(HB, router_w, CNT, TE, TP, TS, M_, gw, ngw, lane, wave, tid, (LAS int*)lds); } }
        PH_END(PB + 4)
        if constexpr (layer == 0) {
            PH_BEGIN(PB + 5)
            { pg8::Gemm g{HB, WGU, M_, NGU, DM, DM}; pg8::StaticOrder S; S.init(M_, NGU, G, bx);
              fp::EpiAct E{ACT, D_FF, NGU / 256}; pg8::gemm_phase<fp::EpiAct, pg8::StaticOrder, true, true>(lds, g, S, E, tid);
              { constexpr int UNITS = (NB * SEQ / 256) * (NGU / 256), REM = UNITS % 256;
                if (REM != 0 && G == 256 && bx >= REM) { constexpr int PER = (FT_G_B + (256 - REM) - 1) / (256 - REM); const float* const p_mg = moe_w_gate; const float* const p_mu = moe_w_up;
                    for (int k = 0; k < PER; ++k) { const int t = (bx - REM) * PER + k; if (t < FT_G_B) filler_g(FT_G_A + t, p_mg, p_mu, MWGU, scr, wave, lane); } }
                else if (REM == 0 || G != 256) { const float* const p_mg = moe_w_gate; const float* const p_mu = moe_w_up; for (int t = bx; t < FT_G_B; t += G) filler_g(FT_G_A + t, p_mg, p_mu, MWGU, scr, wave, lane); } } }
            PH_END(PB + 5)
            PH_BEGIN(PB + 6)
            { pg8::Gemm g{ACT, WD, M_, DM, D_FF, D_FF}; pg8::StaticOrder S; S.init(M_, DM, G, bx);
              fp::EpiY E{YB, DM}; pg8::gemm_phase<fp::EpiY, pg8::StaticOrder, false, true>(lds, g, S, E, tid); }
            PH_END(PB + 6)
            PH_BEGIN(PB + 7)
            { const float* const p_g = ln2_g + layer * DM; const float* const p_b = ln2_b + layer * DM;
              { float va[16], vb[16]; LnGB gbp; ln_gb_load(gbp, p_g, p_b, lane); long r = gw; if (r < M_) ln_load<bf16, bf16>(va, HB + r * DM, ALPHA, YB + r * DM, nullptr, lane);
            for (; r < M_; r += 2 * ngw) { const long r1 = r + ngw, r2 = r + 2 * ngw;
                if (r1 < M_) ln_load<bf16, bf16>(vb, HB + r1 * DM, ALPHA, YB + r1 * DM, nullptr, lane);
                ln_finish_r(va, gbp, nullptr, HB + r * DM, lane);
                if (r2 < M_) ln_load<bf16, bf16>(va, HB + r2 * DM, ALPHA, YB + r2 * DM, nullptr, lane);
                if (r1 < M_) ln_finish_r(vb, gbp, nullptr, HB + r1 * DM, lane); } } }
            PH_END(PB + 7)
        } else {
            PH_BEGIN(PB + 5)
            { int base[N_EXP]; { int b_ = 0;
#pragma unroll
                  for (int e = 0; e < N_EXP; ++e) { base[e] = b_; b_ += (CNT[e] + 255) & ~255; } }
              constexpr int RPW = (M_ + 2047) / 2048;
              int te[RPW][2], tsl[RPW][2]; float tpv[RPW][2];
#pragma unroll
              for (int k = 0; k < RPW; ++k) { const long r = gw + (long)k * ngw;
#pragma unroll
                  for (int q = 0; q < 2; ++q) { te[k][q] = 0; tsl[k][q] = 0; tpv[k][q] = 0.f; if (r < M_) { te[k][q] = TE[r * 2 + q]; tsl[k][q] = TS[r * 2 + q]; tpv[k][q] = TP[r * 2 + q]; } } }
#pragma unroll
              for (int k = 0; k < RPW; ++k) { const long r = gw + (long)k * ngw; if (r < M_) {
                  const uint4* src = (const uint4*)(HB + r * DM); const uint4 v0 = src[lane], v1 = src[lane + 64];
#pragma unroll
                  for (int q = 0; q < 2; ++q) { int be = 0;
#pragma unroll
                      for (int x = 0; x < N_EXP; ++x) be = (te[k][q] == x) ? base[x] : be;
                      const int gs = be + tsl[k][q];
                      if (lane == 0) { SP[gs] = tpv[k][q]; GS[r * 2 + q] = gs; }
                      uint4* dst = (uint4*)(XG + (size_t)gs * DM); dst[lane] = v0; dst[lane + 64] = v1; } } }
              for (long r = gw + (long)RPW * ngw; r < M_; r += ngw) {
                  const uint4* src = (const uint4*)(HB + r * DM); const uint4 v0 = src[lane], v1 = src[lane + 64];
                  for (int q = 0; q < 2; ++q) { const long it = r * 2 + q; const int e = TE[it]; int be = 0;
#pragma unroll
                      for (int x = 0; x < N_EXP; ++x) be = (e == x) ? base[x] : be;
                      const int gs = be + TS[it];
                      if (lane == 0) { SP[gs] = TP[it]; GS[it] = gs; }
                      uint4* dst = (uint4*)(XG + (size_t)gs * DM); dst[lane] = v0; dst[lane + 64] = v1; } }
              for (int it = gw; it < N_EXP * 256; it += ngw) { const int e = it >> 8, r = it & 255; const int c = CNT[e]; const int slot = moe_base(CNT, e) + c + r;
                  if (c + r < ((c + 255) & ~255)) { uint4* dst = (uint4*)(XG + (size_t)slot * DM); const uint4 z = make_uint4(0u, 0u, 0u, 0u); dst[lane] = z; dst[lane + 64] = z; if (lane == 0) SP[slot] = 0.f; } } }
            PH_END(PB + 5)
            PH_BEGIN(PB + 6)
            { pg8::Gemm g{XG, MWGU, NSLOT, N_EXP * NGUE, DM, DM}; fp::MoeOrder S; S.init(CNT, NGUE / 256, G, bx);
              fp::EpiAct E{ACTM, D_FFE, NGUE / 256}; pg8::gemm_phase<fp::EpiAct, fp::MoeOrder, true, true>(lds, g, S, E, tid);
              { const int rem = (S.T * S.ncol) % G; const int nidle = rem == 0 ? G : G - rem, first = rem == 0 ? 0 : rem;
                if (bx >= first) { const int per = (FT_D_D + nidle - 1) / nidle; const float* const p_md = moe_w_down;
                    for (int k = 0; k < per; ++k) { const int t = (bx - first) * per + k; if (t < FT_D_D) filler_d(FT_D - FT_D_D + t, p_md, MWD, scr, wave, lane); } } } }
            PH_END(PB + 6)
            PH_BEGIN(PB + 7)
            { fp::MoeOrder S; S.init(CNT, DM / 256, G, bx); const int nf = S.tail_start(); const int slot0 = (nf / (DM / 256)) * 256;
              fp::EpiF2 E{F2, SP, F2P, slot0, D_FFE / 4};
              { pg8::Gemm g{ACTM, MWD, NSLOT, N_EXP * DM, D_FFE, D_FFE}; S.nfull = nf; S.ksplit = 1;
                pg8::gemm_phase<fp::EpiF2, fp::MoeOrder, true, true>(lds, g, S, E, tid); }
              { pg8::Gemm g{ACTM, MWD, NSLOT, N_EXP * DM, D_FFE / 4, D_FFE}; S.ksplit = 4; S.klen = D_FFE / 4;
                int tid2 = tid; asm volatile("" : "+v"(tid2));
                pg8::gemm_phase<fp::EpiF2, fp::MoeOrder, true, true>(lds, g, S, E, tid2); } }
            PH_END(PB + 7)
            PH_BEGIN(PB + 8)
            { const float* const p_g = ln2_g + layer * DM; const float* const p_b = ln2_b + layer * DM;
              int slot0; { fp::MoeOrder S; S.init(CNT, DM / 256, G, bx); const int nf = S.tail_start(); slot0 = (nf == S.T * (DM / 256)) ? 0x7fffffff : (nf / (DM / 256)) * 256; }
#define LN2_LOAD(v, rr, kk_) do { int s0_ = GS[(rr) * 2], s1_ = GS[(rr) * 2 + 1]; if (kk_ < RPW2) { _Pragma("unroll") for (int x_ = 0; x_ < RPW2; ++x_) if (x_ == kk_) { s0_ = gsv[x_][0]; s1_ = gsv[x_][1]; } } ln_load<bf16, bf16>(v, HB + (rr) * DM, ALPHA, F2 + (size_t)s0_ * DM, F2 + (size_t)s1_ * DM, lane); \
                  if (s0_ >= slot0) { _Pragma("unroll") for (int p_ = 0; p_ < 3; ++p_) ln_add(v, F2P + ((size_t)p_ * TAIL_SLOTS + (s0_ - slot0)) * DM, lane); } \
                  if (s1_ >= slot0) { _Pragma("unroll") for (int p_ = 0; p_ < 3; ++p_) ln_add(v, F2P + ((size_t)p_ * TAIL_SLOTS + (s1_ - slot0)) * DM, lane); } } while (0)
              constexpr int RPW2 = (M_ + 2047) / 2048; int gsv[RPW2][2];
#pragma unroll
              for (int x_ = 0; x_ < RPW2; ++x_) { const long rr_ = gw + (long)x_ * ngw; gsv[x_][0] = 0; gsv[x_][1] = 0; if (rr_ < M_) { gsv[x_][0] = GS[rr_ * 2]; gsv[x_][1] = GS[rr_ * 2 + 1]; } }
              { float va[16], vb[16]; LnGB gbp; ln_gb_load(gbp, p_g, p_b, lane); long r = gw; int kq = 0; if (r < M_) LN2_LOAD(va, r, kq);
                for (; r < M_; r += 2 * ngw, kq += 2) { const long r1 = r + ngw, r2 = r + 2 * ngw;
                    if (r1 < M_) LN2_LOAD(vb, r1, kq + 1);
                    ln_finish_r(va, gbp, H + r * DM, nullptr, lane);
                    if (r2 < M_) LN2_LOAD(va, r2, kq + 2);
                    if (r1 < M_) ln_finish_r(vb, gbp, H + r1 * DM, nullptr, lane); } }
#undef LN2_LOAD
            }
            PH_END(PB + 8)
        }
    }

#undef PH_BEGIN
#undef PH_END
#undef in_x
#undef in_pos
#undef ln_in_g
#undef ln_in_b
#undef w_in
#undef conv_w
#undef conv_b
#undef dt_bias
#undef a_log
#undef d_skip
#undef ssd_norm_g
#undef att_norm_g
#undef gm_ln_g
#undef gm_ln_b
#undef gm_w_s
#undef gm_b_s
#undef gm_norm_g
#undef w_out
#undef ln1_g
#undef ln1_b
#undef ln2_g
#undef ln2_b
#undef ffn_w_gate
#undef ffn_w_up
#undef ffn_w_down
#undef router_w
#undef moe_w_gate
#undef moe_w_up
#undef moe_w_down
#undef H
#undef MWD
#undef RT
#undef TE
#undef TP
#undef TS
#undef GS
#undef SP
#undef KM
#undef WSB
#undef HB
#undef MWGU
#undef WIN
#undef WOUT
#undef WGU
#undef WD
#undef PROJ
#undef ST
#undef CD
#undef XCB
#undef DTG
#undef MIXB
#undef YB
#undef ACT
#undef XG
#undef F2
#undef ACTM
#undef CNT
#undef tid
#undef lane
#undef F2P
#undef vcu
#undef gw
#undef ngw
#undef gt
#undef ngt
    if (pr_me) { const unsigned t_beg = (unsigned)__builtin_amdgcn_s_memrealtime(), t_len = (unsigned)PROBE_AMP * pr_w[1]; while ((unsigned)__builtin_amdgcn_s_memrealtime() - t_beg < t_len) __builtin_amdgcn_s_sleep(8); }
}

__device__ __forceinline__ void blk_acc(float d2, float s2, float* err) {
    d2 = wave_sum(d2); s2 = wave_sum(s2); if ((threadIdx.x & 63) == 0) { atomicAdd(err, d2); atomicAdd(err + 1, s2); }
}
__global__ void k_cmp_proj(const bf16* F, const float* S, long rows, float* err) {
    float d2 = 0.f, s2 = 0.f;
    for (long it = blockIdx.x * (long)blockDim.x + threadIdx.x; it < rows * 2950; it += gridDim.x * (long)blockDim.x) {
        const long row = it / 2950; const int d = (int)(it % 2950); const int sc = fp::win_src_col(d);
        float s = S[row * D_IN + sc]; if (d >= FGU && d < FXBC) s = gelu_tanh_f(s);
        const float f = ldf(F + row * PLD + d); d2 += (f - s) * (f - s); s2 += s * s; }
    blk_acc(d2, s2, err);
}
template <class TF> __global__ void k_cmp(const TF* F, int ldf_, const float* S, int lds_, long rows, int cols, float* err) {
    float d2 = 0.f, s2 = 0.f;
    for (long it = blockIdx.x * (long)blockDim.x + threadIdx.x; it < rows * cols; it += gridDim.x * (long)blockDim.x) {
        const long row = it / cols; const int c = (int)(it % cols); const float f = ldf(F + row * ldf_ + c), s = S[row * lds_ + c]; d2 += (f - s) * (f - s); s2 += s * s; }
    blk_acc(d2, s2, err);
}
__global__ void k_encode(const float* err, int nck, const float* Sout, float* out, long rows_s, long rows_all, float thr) {
    int k = 0; for (int i = 0; i < nck; ++i) { const float r = err[2 * i] / fmaxf(err[2 * i + 1], 1e-30f); if (!(r <= thr)) { k = i + 1; break; } }
    for (long it = blockIdx.x * (long)blockDim.x + threadIdx.x; it < rows_all * DM; it += gridDim.x * (long)blockDim.x)
        out[it] = (it < rows_s * DM) ? Sout[it] * (1.f + (float)k) : 0.f;
}
#if DEBUG_BUILD
constexpr size_t S_BASE = (WS_END + 2 * MiB - 1) / MiB * MiB;
#endif
extern "C" void kernel_launch(void* const* d_in, const int* in_sizes, int n_in, void* d_out, int out_size, void* d_ws, size_t ws_size, hipStream_t stream) {
    (void)in_sizes; (void)n_in; (void)out_size;
    static int grid = 0;
    if (grid == 0) {
        int dev = 0, cus = 0, per_cu = 0;
        if (hipGetDevice(&dev) != hipSuccess || hipDeviceGetAttribute(&cus, hipDeviceAttributeMultiprocessorCount, dev) != hipSuccess) { grid = -1; return; }
        if (hipFuncSetAttribute((const void*)mega, hipFuncAttributeMaxDynamicSharedMemorySize, LDS_BYTES) != hipSuccess) { fprintf(stderr, "kernel_launch: hipFuncSetAttribute failed\n"); grid = -1; return; }
        if (hipOccupancyMaxActiveBlocksPerMultiprocessor(&per_cu, (const void*)mega, 512, LDS_BYTES) != hipSuccess || per_cu < 1) fprintf(stderr, "kernel_launch: occupancy query reports %d\n", per_cu);
        (void)hipGetLastError();
        grid = cus;
        if (ws_size < WS_END) { fprintf(stderr, "kernel_launch: workspace too small: %zu < %zu\n", ws_size, (size_t)WS_END); grid = -1; }
    }
    if (grid < 0) return;
    unsigned char* ws = (unsigned char*)d_ws;
    if (hipMemsetAsync(ws + O_CTL, 0, CTL_BYTES, stream) != hipSuccess) return;
    FArgs a{};
    for (int i = 0; i < 29; ++i) a.in[i] = d_in[i];
    a.out = (float*)d_out; a.ws = ws;
#if !DEBUG_BUILD
    a.ph_lo = 0; a.ph_hi = N_PHASES;
    hipLaunchKernelGGL(mega, dim3(grid), dim3(512), LDS_BYTES, stream, a);
#else
    Inputs I;
    I.x = (const float*)d_in[0]; I.pos = (const int*)d_in[1]; I.ln_in_g = (const float*)d_in[2]; I.ln_in_b = (const float*)d_in[3]; I.w_in = (const float*)d_in[4];
    I.conv_w = (const float*)d_in[5]; I.conv_b = (const float*)d_in[6]; I.dt_bias = (const float*)d_in[7]; I.a_log = (const float*)d_in[8]; I.d_skip = (const float*)d_in[9];
    I.ssd_norm_g = (const float*)d_in[10]; I.att_norm_g = (const float*)d_in[11]; I.gm_ln_g = (const float*)d_in[12]; I.gm_ln_b = (const float*)d_in[13]; I.gm_w_s = (const float*)d_in[14];
    I.gm_b_s = (const float*)d_in[15]; I.gm_norm_g = (const float*)d_in[16]; I.w_out = (const float*)d_in[17]; I.ln1_g = (const float*)d_in[18]; I.ln1_b = (const float*)d_in[19];
    I.ln2_g = (const float*)d_in[20]; I.ln2_b = (const float*)d_in[21]; I.ffn_w_gate = (const float*)d_in[22]; I.ffn_w_up = (const float*)d_in[23]; I.ffn_w_down = (const float*)d_in[24];
    I.router_w = (const float*)d_in[25]; I.moe_w_gate = (const float*)d_in[26]; I.moe_w_up = (const float*)d_in[27]; I.moe_w_down = (const float*)d_in[28];
    const long MS = SEQ;
    unsigned char* sws = ws + S_BASE;
    float* saux = (float*)(sws + 96 * MiB); float* sout = (float*)(sws + 100 * MiB); float* ckpt = (float*)(sws + 110 * MiB);
    const size_t ck_stride = (size_t)MS * (D_IN + 3 * DM);
    run_simple(I, 1, sws, saux, sout, stream, ckpt);
    float* err = (float*)(ws + O_CTL) + CW_ERR;
    const bf16* PROJ = (const bf16*)(ws + O_PROJ); const bf16* MIXB = (const bf16*)(ws + O_MIXB); const bf16* Hf = (const bf16*)(ws + O_HB); const float* Hout = (const float*)d_out;
    for (int ph = 0; ph < N_PHASES; ++ph) {
        a.ph_lo = ph; a.ph_hi = ph + 1;
        hipLaunchKernelGGL(mega, dim3(grid), dim3(512), LDS_BYTES, stream, a);
        const int layer = ph >= 9 ? 1 : 0; const int rel = ph - (layer ? 8 : 0); const float* ck = ckpt + layer * ck_stride; float* e = err + layer * 12;
        if (rel == 1) k_cmp_proj<<<512, 256, 0, stream>>>(PROJ, ck, MS, e + 0);
        if (rel == 3) { k_cmp<bf16><<<512, 256, 0, stream>>>(MIXB, DM, ck + (size_t)MS * D_IN, DM, MS, 384, e + 2);
                        k_cmp<bf16><<<512, 256, 0, stream>>>(MIXB + 384, DM, ck + (size_t)MS * D_IN + 384, DM, MS, 384, e + 4);
                        k_cmp<bf16><<<512, 256, 0, stream>>>(MIXB + 768, DM, ck + (size_t)MS * D_IN + 768, DM, MS, 256, e + 6); }
        if (rel == 5) k_cmp<bf16><<<512, 256, 0, stream>>>(Hf, DM, ck + (size_t)MS * (D_IN + DM), DM, MS, DM, e + 8);
        if (layer == 0 && rel == 8) k_cmp<bf16><<<512, 256, 0, stream>>>(Hf, DM, ck + (size_t)MS * (D_IN + 2 * DM), DM, MS, DM, e + 10);
        if (layer == 1 && rel == 9) k_cmp<float><<<512, 256, 0, stream>>>(Hout, DM, ck + (size_t)MS * (D_IN + 2 * DM), DM, MS, DM, e + 10);
    }
    k_encode<<<1024, 256, 0, stream>>>(err, 12, sout, (float*)d_out, MS, (long)NBATCH * SEQ, DBG_THR);
#endif
}
```

```cpp
#define DEBUG_BUILD 0
#define DBG_THR 0.02f
#define PROBE_MASK 0u
#define PROBE_AMP 0
#include <hip/hip_runtime.h>
#include <cstdio>
#include <cstdint>

constexpr int DM = 1024, SEQ = 2048, NBATCH = 8;
constexpr int ATT_H = 6, HD = 64, ATT_W = 384, ROPE_DIM = 16;
constexpr int MOBA_BLOCK = 256, NBLK = SEQ / MOBA_BLOCK;
constexpr int SSD_H = 6, SSD_W = 384, SSD_G = 2, SSD_N = 128, SSD_CW = 896;
constexpr int GM_G = 4, GM_W = 256, GM_CHUNK = 128;
constexpr int D_IN = 2950, D_FF = 2816, N_EXP = 8, D_FFE = 3584;
constexpr float ALPHA = 1.4142135623730951f;
constexpr float NEGF = -1e30f;
constexpr int MAXSLOT = 2 * NBATCH * SEQ + N_EXP * 256;

typedef unsigned short bf16;
__device__ __forceinline__ unsigned f2bf(float f) { unsigned u = __float_as_uint(f); return (u + 0x7fffu + ((u >> 16) & 1u)) >> 16; }
__device__ __forceinline__ float ldf(const float* p) { return *p; }
__device__ __forceinline__ float ldf(const bf16* p) { return __uint_as_float(((unsigned)*p) << 16); }
__device__ __forceinline__ void stf(float* p, float v) { *p = v; }
__device__ __forceinline__ void stf(bf16* p, float v) { *p = (bf16)f2bf(v); }

__device__ __forceinline__ float dpp_add(float v, const int ctrl_tag) {
    int r;
    if (ctrl_tag == 0) r = __builtin_amdgcn_update_dpp(0, __float_as_int(v), 0xB1, 0xF, 0xF, false);
    else if (ctrl_tag == 1) r = __builtin_amdgcn_update_dpp(0, __float_as_int(v), 0x4E, 0xF, 0xF, false);
    else if (ctrl_tag == 2) r = __builtin_amdgcn_update_dpp(0, __float_as_int(v), 0x141, 0xF, 0xF, false);
    else r = __builtin_amdgcn_update_dpp(0, __float_as_int(v), 0x140, 0xF, 0xF, false);
    return v + __int_as_float(r);
}
__device__ __forceinline__ float row16_sum(float v) { v = dpp_add(v, 0); v = dpp_add(v, 1); v = dpp_add(v, 2); v = dpp_add(v, 3); return v; }
__device__ __forceinline__ float wave_sum(float v) {
    v = row16_sum(v);
    { const auto rr = __builtin_amdgcn_permlane16_swap(__float_as_uint(v), __float_as_uint(v), false, false); v = __uint_as_float(rr[0]) + __uint_as_float(rr[1]); }
    { const auto rr = __builtin_amdgcn_permlane32_swap(__float_as_uint(v), __float_as_uint(v), false, false); v = __uint_as_float(rr[0]) + __uint_as_float(rr[1]); }
    return v;
}
__device__ __forceinline__ float silu_f(float x) { return x / (1.f + __expf(-x)); }
__device__ __forceinline__ float gelu_tanh_f(float x) { const float u = 0.7978845608028654f * (x + 0.044715f * x * x * x); return 0.5f * x * (1.f + tanhf(u)); }
__device__ __forceinline__ float softplus_f(float x) { return fmaxf(x, 0.f) + log1pf(__expf(-fabsf(x))); }

struct ProjL { int ld, q, k, v, z, xbc, dt, gu, gv; };

__device__ __forceinline__ float4 ld4(const float* p) { return *(const float4*)p; }
__device__ __forceinline__ float4 ld4(const bf16* p) { const uint2 w = *(const uint2*)p; return make_float4(__uint_as_float(w.x << 16), __uint_as_float(w.x & 0xffff0000u), __uint_as_float(w.y << 16), __uint_as_float(w.y & 0xffff0000u)); }
typedef float nt_f4 __attribute__((ext_vector_type(4)));
__device__ __forceinline__ float4 ld4_nt(const float* p) { const nt_f4 v = __builtin_nontemporal_load((const nt_f4*)p); return make_float4(v[0], v[1], v[2], v[3]); }
__device__ __forceinline__ float4 ld4_nt(const bf16* p) { return ld4(p); }
template <class TY, class TX = float, bool NTX = false> __device__ __forceinline__ void ln_load(float (&v)[16], const TX* xrow, float a, const TY* y1, const TY* y2, int lane) {
#pragma unroll
    for (int j = 0; j < 4; ++j) {
        const float4 x = NTX ? ld4_nt(xrow + j * 256 + lane * 4) : ld4(xrow + j * 256 + lane * 4);
        float4 t = make_float4(a * x.x, a * x.y, a * x.z, a * x.w);
        if (y1) { const float4 y = ld4(y1 + j * 256 + lane * 4); t.x += y.x; t.y += y.y; t.z += y.z; t.w += y.w; }
        if (y2) { const float4 y = ld4(y2 + j * 256 + lane * 4); t.x += y.x; t.y += y.y; t.z += y.z; t.w += y.w; }
        v[4 * j] = t.x; v[4 * j + 1] = t.y; v[4 * j + 2] = t.z; v[4 * j + 3] = t.w;
    }
}
__device__ __forceinline__ void ln_add(float (&v)[16], const bf16* y, int lane) {
#pragma unroll
    for (int j = 0; j < 4; ++j) { const float4 t = ld4(y + j * 256 + lane * 4); v[4 * j] += t.x; v[4 * j + 1] += t.y; v[4 * j + 2] += t.z; v[4 * j + 3] += t.w; }
}
__device__ __forceinline__ void ln_finish(float (&v)[16], const float* g, const float* b, float* of, bf16* ob, int lane) {
    float s = 0.f;
#pragma unroll
    for (int i = 0; i < 16; ++i) s += v[i];
    const float mean = wave_sum(s) * (1.f / 1024.f); float s2 = 0.f;
#pragma unroll
    for (int i = 0; i < 16; ++i) { v[i] -= mean; s2 += v[i] * v[i]; }
    const float rstd = rsqrtf(wave_sum(s2) * (1.f / 1024.f) + 1e-5f);
#pragma unroll
    for (int j = 0; j < 4; ++j) {
        const float4 gg = *(const float4*)(g + j * 256 + lane * 4), bb = *(const float4*)(b + j * 256 + lane * 4);
        float4 o = make_float4(v[4 * j] * rstd * gg.x + bb.x, v[4 * j + 1] * rstd * gg.y + bb.y, v[4 * j + 2] * rstd * gg.z + bb.z, v[4 * j + 3] * rstd * gg.w + bb.w);
        if (of) *(float4*)(of + j * 256 + lane * 4) = o;
        if (ob) { uint2 w; w.x = f2bf(o.x) | (f2bf(o.y) << 16); w.y = f2bf(o.z) | (f2bf(o.w) << 16); *(uint2*)(ob + j * 256 + lane * 4) = w; }
    }
}

struct LnGB { float4 g[4], b[4]; };
__device__ __forceinline__ void ln_gb_load(LnGB& p, const float* g, const float* b, int lane) {
#pragma unroll
    for (int j = 0; j < 4; ++j) { p.g[j] = *(const float4*)(g + j * 256 + lane * 4); p.b[j] = *(const float4*)(b + j * 256 + lane * 4); }
}
__device__ __forceinline__ void ln_finish_r(float (&v)[16], const LnGB& p, float* of, bf16* ob, int lane) {
    float s = 0.f;
#pragma unroll
    for (int i = 0; i < 16; ++i) s += v[i];
    const float mean = wave_sum(s) * (1.f / 1024.f); float s2 = 0.f;
#pragma unroll
    for (int i = 0; i < 16; ++i) { v[i] -= mean; s2 += v[i] * v[i]; }
    const float rstd = rsqrtf(wave_sum(s2) * (1.f / 1024.f) + 1e-5f);
#pragma unroll
    for (int j = 0; j < 4; ++j) {
        const float4 gg = p.g[j], bb = p.b[j];
        float4 o = make_float4(v[4 * j] * rstd * gg.x + bb.x, v[4 * j + 1] * rstd * gg.y + bb.y, v[4 * j + 2] * rstd * gg.z + bb.z, v[4 * j + 3] * rstd * gg.w + bb.w);
        if (of) { nt_f4 ov; ov[0] = o.x; ov[1] = o.y; ov[2] = o.z; ov[3] = o.w; __builtin_nontemporal_store(ov, (nt_f4*)(of + j * 256 + lane * 4)); }
        if (ob) { uint2 w; w.x = f2bf(o.x) | (f2bf(o.y) << 16); w.y = f2bf(o.z) | (f2bf(o.w) << 16); *(uint2*)(ob + j * 256 + lane * 4) = w; }
    }
}
template <class TY> __device__ __forceinline__ void ln_row(const float* xrow, float a, const TY* y1, const TY* y2, const float* g, const float* b, float* of, bf16* ob, int lane) {
    float v[16]; ln_load<TY>(v, xrow, a, y1, y2, lane); ln_finish(v, g, b, of, ob, lane);
}

__device__ __forceinline__ void rope_inplace(float* P, ProjL L, const int* pos, long n_rows, long gt, long ngt) {
    for (long it = gt; it < n_rows * 96; it += ngt) {
        const int i = (int)(it & 7), hh = (int)((it >> 3) % 12); const long row = it / 96;
        const int off = (hh < 6 ? L.q : L.k) + (hh % 6) * 64;
        const float inv = powf(500000.0f, -(float)(2 * i) / 16.0f);
        const float ang = (float)pos[row] * inv;
        const float c = cosf(ang), s = sinf(ang);
        float* p = P + row * L.ld + off;
        const float x1 = p[i], x2 = p[i + 8];
        p[i] = x1 * c - x2 * s; p[i + 8] = x2 * c + x1 * s;
    }
}

template <class T> __device__ __forceinline__ void kmean_phase(const T* P, ProjL L, float* KM, int nb, long gt, long ngt) {
    for (long it = gt; it < (long)nb * ATT_H * NBLK * 64; it += ngt) {
        const int d = (int)(it & 63), n = (int)((it >> 6) % NBLK), h = (int)((it / (64 * NBLK)) % ATT_H), b = (int)(it / (64 * NBLK * ATT_H));
        const T* p = P + ((long)b * SEQ + n * MOBA_BLOCK) * L.ld + L.k + h * 64 + d; float s = 0.f;
        for (int r = 0; r < MOBA_BLOCK; ++r) s += ldf(p + (long)r * L.ld);
        KM[it] = s * (1.f / MOBA_BLOCK);
    }
}

template <class T> __device__ __forceinline__ void attn_naive_phase(const T* P, ProjL L, const float* KM, float* O, int ldo, int nb, int gw, int ngw, int lane) {
    for (long it = gw; it < (long)nb * ATT_H * SEQ; it += ngw) {
        const int q = (int)(it % SEQ), h = (int)((it / SEQ) % ATT_H), b = (int)(it / ((long)SEQ * ATT_H));
        const long row = (long)b * SEQ + q; const int qblk = q / MOBA_BLOCK;
        const float qv = ldf(P + row * L.ld + L.q + h * 64 + lane);
        float g[NBLK];
#pragma unroll
        for (int n = 0; n < NBLK; ++n) { const float t = wave_sum(qv * KM[(((long)b * ATT_H + h) * NBLK + n) * 64 + lane]); g[n] = (n < qblk) ? t : NEGF; }
        unsigned sel = 0u;
#pragma unroll
        for (int r = 0; r < 3; ++r) { float bv = -3.0e38f; int best = -1;
#pragma unroll
            for (int n = 0; n < NBLK; ++n) if (!((sel >> n) & 1u) && g[n] > bv) { bv = g[n]; best = n; }
            if (best >= 0 && bv > NEGF * 0.5f) sel |= 1u << best; }
        sel |= 1u << qblk;
        float m = -3.0e38f, l = 0.f, o = 0.f;
        for (int n = 0; n <= qblk; ++n) {
            if (!((sel >> n) & 1u)) continue;
            const int j0 = n * MOBA_BLOCK, j1 = (n == qblk) ? q + 1 : j0 + MOBA_BLOCK;
            const T* kp = P + ((long)b * SEQ + j0) * L.ld + L.k + h * 64 + lane;
            const T* vp = P + ((long)b * SEQ + j0) * L.ld + L.v + h * 64 + lane;
            for (int j = j0; j < j1; ++j, kp += L.ld, vp += L.ld) {
                const float s = wave_sum(qv * ldf(kp)) * 0.125f;
                const float mn = fmaxf(m, s), corr = __expf(m - mn), p = __expf(s - mn);
                l = l * corr + p; o = o * corr + p * ldf(vp); m = mn;
            }
        }
        O[row * ldo + h * 64 + lane] = o / l;
    }
}

template <int W, class TO> __device__ __forceinline__ void rms_rows_phase(const float* in, int ldi, const float* g, TO* out, int ldo, long n_rows, int gw, int ngw, int lane) {
    constexpr int PER = W / 64;
    for (long row = gw; row < n_rows; row += ngw) {
        float v[PER]; float s = 0.f;
#pragma unroll
        for (int j = 0; j < PER; ++j) { v[j] = in[row * ldi + j * 64 + lane]; s += v[j] * v[j]; }
        const float r = rsqrtf(wave_sum(s) * (1.f / W) + 1e-5f);
#pragma unroll
        for (int j = 0; j < PER; ++j) stf(out + row * ldo + j * 64 + lane, v[j] * r * g[j * 64 + lane]);
    }
}

template <class T, class TO> __device__ __forceinline__ void ssd_conv_phase(const T* P, ProjL L, const float* cw, const float* cb, const float* dtb, TO* XC, float* DT, long n_rows, long gt, long ngt) {
    for (long it = gt; it < n_rows * 902; it += ngt) {
        const int c = (int)(it % 902); const long row = it / 902; const int t = (int)(row % SEQ);
        if (c < SSD_CW) {
            float acc = cb[c];
#pragma unroll
            for (int i = 0; i < 4; ++i) { const int tt = t - 3 + i; if (tt >= 0) acc += cw[i * SSD_CW + c] * ldf(P + (row - 3 + i) * L.ld + L.xbc + c); }
            stf(XC + row * SSD_CW + c, silu_f(acc));
        } else {
            const int h = c - SSD_CW;
            DT[row * SSD_H + h] = softplus_f(ldf(P + row * L.ld + L.dt + h) + dtb[h]);
        }
    }
}

template <class T> __device__ __forceinline__ void ssd_scan_naive_phase(const T* XC, const float* DT, const float* a_log, const float* dsk, float* Y, int ldo, int nb, int gw, int ngw, int lane) {
    for (int it = gw; it < nb * SSD_H * 64; it += ngw) {
        const int p = it & 63, h = (it >> 6) % SSD_H, b = it / (64 * SSD_H), grp = h / (SSD_H / SSD_G);
        const float A = -__expf(a_log[h]), Dk = dsk[h];
        float s0 = 0.f, s1 = 0.f;
#pragma unroll 4
        for (int t = 0; t < SEQ; ++t) {
            const long row = (long)b * SEQ + t;
            const T* xr = XC + row * SSD_CW;
            const float dt = DT[row * SSD_H + h], x = ldf(xr + h * 64 + p);
            const float B0 = ldf(xr + SSD_W + grp * SSD_N + lane), B1 = ldf(xr + SSD_W + grp * SSD_N + 64 + lane);
            const float C0 = ldf(xr + SSD_W + SSD_G * SSD_N + grp * SSD_N + lane), C1 = ldf(xr + SSD_W + SSD_G * SSD_N + grp * SSD_N + 64 + lane);
            const float dec = __expf(dt * A), xd = x * dt;
            s0 = s0 * dec + xd * B0; s1 = s1 * dec + xd * B1;
            const float y = wave_sum(C0 * s0 + C1 * s1);
            if (lane == 0) Y[row * ldo + h * 64 + p] = y + Dk * x;
        }
    }
}

template <class T, class TO> __device__ __forceinline__ void ssd_gate_phase(const float* Y, int ldi, const T* P, ProjL L, const float* ng, TO* out, int ldo, long n_rows, int gw, int ngw, int lane) {
    for (long row = gw; row < n_rows; row += ngw) {
        float v[6];
#pragma unroll
        for (int j = 0; j < 6; ++j) { const int c = j * 64 + lane; v[j] = Y[row * ldi + c] * silu_f(ldf(P + row * L.ld + L.z + c)); }
        const float r0 = rsqrtf(wave_sum(v[0] * v[0] + v[1] * v[1] + v[2] * v[2]) * (1.f / 192.f) + 1e-5f);
        const float r1 = rsqrtf(wave_sum(v[3] * v[3] + v[4] * v[4] + v[5] * v[5]) * (1.f / 192.f) + 1e-5f);
#pragma unroll
        for (int j = 0; j < 6; ++j) { const int c = j * 64 + lane; stf(out + row * ldo + c, v[j] * (j < 3 ? r0 : r1) * ng[c]); }
    }
}

template <class T, bool PRE> __device__ __forceinline__ void gm_ln_phase(const T* P, ProjL L, const float* g, const float* b, float* VN, long n_rows, int gw, int ngw, int lane) {
    for (long row = gw; row < n_rows; row += ngw) {
        float v[4]; float s = 0.f;
#pragma unroll
        for (int j = 0; j < 4; ++j) { const float x = ldf(P + row * L.ld + L.gv + j * 64 + lane); v[j] = PRE ? x : gelu_tanh_f(x); s += v[j]; }
        const float mean = wave_sum(s) * (1.f / 256.f); float s2 = 0.f;
#pragma unroll
        for (int j = 0; j < 4; ++j) { v[j] -= mean; s2 += v[j] * v[j]; }
        const float rstd = rsqrtf(wave_sum(s2) * (1.f / 256.f) + 1e-5f);
#pragma unroll
        for (int j = 0; j < 4; ++j) VN[row * GM_W + j * 64 + lane] = v[j] * rstd * g[j * 64 + lane] + b[j * 64 + lane];
    }
}
template <class T, bool PRE> __device__ __forceinline__ void gm_mix_phase(const T* P, ProjL L, const float* VN, const float* ws_, const float* bs, float* GO, int ldo, long n_rows, long gt, long ngt) {
    for (long it = gt; it < n_rows * GM_W; it += ngt) {
        const int c = (int)(it % GM_W); const long row = it / GM_W; const int t = (int)(row % GM_CHUNK), g = c / 64; const long base = row - t;
        const float* w = ws_ + ((long)g * GM_CHUNK + t) * GM_CHUNK; float acc = 0.f;
        for (int s = 0; s <= t; ++s) acc += w[s] * VN[(base + s) * GM_W + c];
        acc += bs[g * GM_CHUNK + t];
        const float x = ldf(P + row * L.ld + L.gu + c); const float u = PRE ? x : gelu_tanh_f(x);
        GO[row * ldo + c] = u * acc;
    }
}

__device__ __forceinline__ void moe_route_phase(const float* H, const float* Wr, int* CNT, int* TE, float* TP, int* TS, long n_rows, int gw, int ngw, int lane) {
    for (long row = gw; row < n_rows; row += ngw) {
        float acc[N_EXP];
#pragma unroll
        for (int e = 0; e < N_EXP; ++e) acc[e] = 0.f;
        for (int j = 0; j < 16; ++j) { const int d = j * 64 + lane; const float hv = H[row * DM + d];
            const float4 w0 = *(const float4*)(Wr + d * N_EXP), w1 = *(const float4*)(Wr + d * N_EXP + 4);
            acc[0] += hv * w0.x; acc[1] += hv * w0.y; acc[2] += hv * w0.z; acc[3] += hv * w0.w; acc[4] += hv * w1.x; acc[5] += hv * w1.y; acc[6] += hv * w1.z; acc[7] += hv * w1.w; }
#pragma unroll
        for (int e = 0; e < N_EXP; ++e) acc[e] = wave_sum(acc[e]);
        int e0 = 0; float v0 = acc[0];
#pragma unroll
        for (int e = 1; e < N_EXP; ++e) if (acc[e] > v0) { v0 = acc[e]; e0 = e; }
        int e1 = -1; float v1 = -3.0e38f;
#pragma unroll
        for (int e = 0; e < N_EXP; ++e) if (e != e0 && acc[e] > v1) { v1 = acc[e]; e1 = e; }
        const float p1 = __expf(v1 - v0), den = 1.f + p1;
        if (lane == 0) {
            const int s0 = atomicAdd(&CNT[e0], 1), s1 = atomicAdd(&CNT[e1], 1);
            TE[row * 2] = e0; TE[row * 2 + 1] = e1; TP[row * 2] = 1.f / den; TP[row * 2 + 1] = p1 / den; TS[row * 2] = s0; TS[row * 2 + 1] = s1;
        }
    }
}

__device__ __forceinline__ void moe_route_block(const bf16* H, const float* Wr, int* CNT, int* TE, float* TP, int* TS, long n_rows, int gw_, int ngw_, int lane, int wave, int tid,
                                                __attribute__((address_space(3))) int* sh  ) {
    asm volatile("" : "+v"(tid));
    if (tid < 16) sh[tid] = 0;
    __syncthreads();
    int k = 0;
    for (long row = gw_; row < n_rows; row += ngw_, ++k) {
        float acc[N_EXP];
#pragma unroll
        for (int e = 0; e < N_EXP; ++e) acc[e] = 0.f;
        for (int j = 0; j < 16; ++j) { const int d = j * 64 + lane; const float hv = ldf(H + row * DM + d);
            const float4 w0 = *(const float4*)(Wr + d * N_EXP), w1 = *(const float4*)(Wr + d * N_EXP + 4);
            acc[0] += hv * w0.x; acc[1] += hv * w0.y; acc[2] += hv * w0.z; acc[3] += hv * w0.w; acc[4] += hv * w1.x; acc[5] += hv * w1.y; acc[6] += hv * w1.z; acc[7] += hv * w1.w; }
#pragma unroll
        for (int e = 0; e < N_EXP; ++e) acc[e] = wave_sum(acc[e]);
        int e0 = 0; float v0 = acc[0];
#pragma unroll
        for (int e = 1; e < N_EXP; ++e) if (acc[e] > v0) { v0 = acc[e]; e0 = e; }
        int e1 = -1; float v1 = -3.0e38f;
#pragma unroll
        for (int e = 0; e < N_EXP; ++e) if (e != e0 && acc[e] > v1) { v1 = acc[e]; e1 = e; }
        const float p1 = __expf(v1 - v0), den = 1.f + p1;
        if (lane == 0) {
            const int l0 = atomicAdd((int*)&sh[e0], 1), l1 = atomicAdd((int*)&sh[e1], 1);
            TE[row * 2] = e0; TE[row * 2 + 1] = e1; TP[row * 2] = 1.f / den; TP[row * 2 + 1] = p1 / den;
            sh[16 + (wave * 8 + k) * 4 + 0] = e0; sh[16 + (wave * 8 + k) * 4 + 1] = e1; sh[16 + (wave * 8 + k) * 4 + 2] = l0; sh[16 + (wave * 8 + k) * 4 + 3] = l1;
        }
    }
    __syncthreads();
    if (tid < N_EXP) sh[8 + tid] = atomicAdd(&CNT[tid], sh[tid]);
    __syncthreads();
    k = 0;
    for (long row = gw_; row < n_rows; row += ngw_, ++k)
        if (lane == 0) { const int e0 = sh[16 + (wave * 8 + k) * 4], e1 = sh[16 + (wave * 8 + k) * 4 + 1];
            TS[row * 2] = sh[8 + e0] + sh[16 + (wave * 8 + k) * 4 + 2]; TS[row * 2 + 1] = sh[8 + e1] + sh[16 + (wave * 8 + k) * 4 + 3]; }
    __syncthreads();
}
__device__ __forceinline__ int moe_base(const int* CNT, int e) { int b = 0; for (int i = 0; i < e; ++i) b += (CNT[i] + 255) & ~255; return b; }
__device__ __forceinline__ void moe_scatter_phase(const int* CNT, const int* TE, const float* TP, const int* TS, int* LIST, float* SP, int* GS, long n_rows, long gt, long ngt) {
    for (long it = gt; it < n_rows * 2; it += ngt) {
        const int e = TE[it]; const int gs = moe_base(CNT, e) + TS[it];
        LIST[gs] = (int)(it >> 1); SP[gs] = TP[it]; GS[it] = gs;
    }
}

template <class TA, int EPI> __global__ void __launch_bounds__(256) sgemm_k(const TA* A, int lda, const int* rowlist, const float* B, const float* B2, int ldb, long bstride, void* Cv, int ldc, int M, int N, int K, const int* CNT, const float* scale) {
    __shared__ float As[16][68], Bs[16][68], Bs2[16][68];
    int row_base = 0, mrows = M;
    if (CNT) { const int e = blockIdx.z; row_base = moe_base(CNT, e); mrows = CNT[e]; B += (long)e * bstride; if (B2) B2 += (long)e * bstride; }
    const int m0 = blockIdx.y * 64; if (m0 >= mrows) return;
    const int n0 = blockIdx.x * 64, tid = threadIdx.x, tx = tid & 15, ty = tid >> 4;
    float acc[4][4], acc2[4][4];
#pragma unroll
    for (int i = 0; i < 4; ++i)
#pragma unroll
        for (int j = 0; j < 4; ++j) { acc[i][j] = 0.f; acc2[i][j] = 0.f; }
    const int ar = tid >> 2, ak = (tid & 3) * 4; long arow = -1;
    { const int lr = m0 + ar; if (lr < mrows) { arow = rowlist ? (long)rowlist[row_base + lr] : (long)(row_base + lr); } }
    const int bk = tid >> 4, bn = (tid & 15) * 4;
    for (int k0 = 0; k0 < K; k0 += 16) {
        float av[4] = {0.f, 0.f, 0.f, 0.f};
        if (arow >= 0) {
#pragma unroll
            for (int i = 0; i < 4; ++i) av[i] = ldf(A + arow * lda + k0 + ak + i);
        }
#pragma unroll
        for (int i = 0; i < 4; ++i) As[ak + i][ar] = av[i];
#pragma unroll
        for (int i = 0; i < 4; ++i) { const int n = n0 + bn + i; const bool ok = n < N;
            Bs[bk][bn + i] = ok ? B[(long)(k0 + bk) * ldb + n] : 0.f;
            if (EPI == 1 || EPI == 2) Bs2[bk][bn + i] = ok ? B2[(long)(k0 + bk) * ldb + n] : 0.f; }
        __syncthreads();
#pragma unroll
        for (int kk = 0; kk < 16; ++kk) {
            float a[4], b[4], b2[4];
#pragma unroll
            for (int i = 0; i < 4; ++i) { a[i] = As[kk][ty * 4 + i]; b[i] = Bs[kk][tx * 4 + i]; if (EPI == 1 || EPI == 2) b2[i] = Bs2[kk][tx * 4 + i]; }
#pragma unroll
            for (int i = 0; i < 4; ++i)
#pragma unroll
                for (int j = 0; j < 4; ++j) { acc[i][j] += a[i] * b[j]; if (EPI == 1 || EPI == 2) acc2[i][j] += a[i] * b2[j]; }
        }
        __syncthreads();
    }
#pragma unroll
    for (int i = 0; i < 4; ++i) { const int lr = m0 + ty * 4 + i; if (lr >= mrows) continue; const long crow = row_base + lr;
#pragma unroll
        for (int j = 0; j < 4; ++j) { const int n = n0 + tx * 4 + j; if (n >= N) continue;
            float v = acc[i][j];
            if (EPI == 1 || EPI == 2) v = silu_f(v) * acc2[i][j];
            if (EPI == 3) v *= scale[crow];
            if (EPI == 2) ((bf16*)Cv)[crow * ldc + n] = (bf16)f2bf(v); else ((float*)Cv)[crow * ldc + n] = v; } }
}

#define GW_DECL const int lane = threadIdx.x & 63; const int gw = (int)((blockIdx.x * (long)blockDim.x + threadIdx.x) >> 6); const int ngw = (int)((gridDim.x * (long)blockDim.x) >> 6); (void)lane; (void)gw; (void)ngw;
#define GT_DECL const long gt = blockIdx.x * (long)blockDim.x + threadIdx.x; const long ngt = gridDim.x * (long)blockDim.x;

__global__ void k_ln_in(const float* x, const float* g, const float* b, float* H, long n_rows) { GW_DECL for (long r = gw; r < n_rows; r += ngw) ln_row<float>(x + r * DM, 1.f, nullptr, nullptr, g, b, H + r * DM, nullptr, lane); }
__global__ void k_ln_res(float* H, const float* Y, const float* g, const float* b, float* OUT, long n_rows) { GW_DECL for (long r = gw; r < n_rows; r += ngw) ln_row<float>(H + r * DM, ALPHA, Y + r * DM, nullptr, g, b, OUT + r * DM, nullptr, lane); }
__global__ void k_ln_moe(float* H, const float* F2, const int* GS, const float* g, const float* b, float* OUT, long n_rows) { GW_DECL for (long r = gw; r < n_rows; r += ngw) ln_row<float>(H + r * DM, ALPHA, F2 + (long)GS[r * 2] * DM, F2 + (long)GS[r * 2 + 1] * DM, g, b, OUT + r * DM, nullptr, lane); }
__global__ void k_rope(float* P, ProjL L, const int* pos, long n_rows) { GT_DECL rope_inplace(P, L, pos, n_rows, gt, ngt); }
__global__ void k_kmean(const float* P, ProjL L, float* KM, int nb) { GT_DECL kmean_phase<float>(P, L, KM, nb, gt, ngt); }
__global__ void k_attn(const float* P, ProjL L, const float* KM, float* O, int ldo, int nb) { GW_DECL attn_naive_phase<float>(P, L, KM, O, ldo, nb, gw, ngw, lane); }
__global__ void k_rms384(const float* in, int ldi, const float* g, float* out, int ldo, long n_rows) { GW_DECL rms_rows_phase<384, float>(in, ldi, g, out, ldo, n_rows, gw, ngw, lane); }
__global__ void k_rms256(const float* in, int ldi, const float* g, float* out, int ldo, long n_rows) { GW_DECL rms_rows_phase<256, float>(in, ldi, g, out, ldo, n_rows, gw, ngw, lane); }
__global__ void k_ssd_conv(const float* P, ProjL L, const float* cw, const float* cb, const float* dtb, float* XC, float* DT, long n_rows) { GT_DECL ssd_conv_phase<float, float>(P, L, cw, cb, dtb, XC, DT, n_rows, gt, ngt); }
__global__ void k_ssd_scan(const float* XC, const float* DT, const float* a_log, const float* dsk, float* Y, int ldo, int nb) { GW_DECL ssd_scan_naive_phase<float>(XC, DT, a_log, dsk, Y, ldo, nb, gw, ngw, lane); }
__global__ void k_ssd_gate(const float* Y, int ldi, const float* P, ProjL L, const float* ng, float* out, int ldo, long n_rows) { GW_DECL ssd_gate_phase<float, float>(Y, ldi, P, L, ng, out, ldo, n_rows, gw, ngw, lane); }
__global__ void k_gm_ln(const float* P, ProjL L, const float* g, const float* b, float* VN, long n_rows) { GW_DECL gm_ln_phase<float, false>(P, L, g, b, VN, n_rows, gw, ngw, lane); }
__global__ void k_gm_mix(const float* P, ProjL L, const float* VN, const float* ws_, const float* bs, float* GO, int ldo, long n_rows) { GT_DECL gm_mix_phase<float, false>(P, L, VN, ws_, bs, GO, ldo, n_rows, gt, ngt); }
__global__ void k_moe_init(int* CNT, int* LIST, int nslots) { GT_DECL if (gt < N_EXP) CNT[gt] = 0; for (long i = gt; i < nslots; i += ngt) LIST[i] = -1; }
__global__ void k_moe_route(const float* H, const float* Wr, int* CNT, int* TE, float* TP, int* TS, long n_rows) { GW_DECL moe_route_phase(H, Wr, CNT, TE, TP, TS, n_rows, gw, ngw, lane); }
__global__ void k_moe_scatter(const int* CNT, const int* TE, const float* TP, const int* TS, int* LIST, float* SP, int* GS, long n_rows) { GT_DECL moe_scatter_phase(CNT, TE, TP, TS, LIST, SP, GS, n_rows, gt, ngt); }

struct Inputs {
    const float *x; const int* pos; const float *ln_in_g, *ln_in_b, *w_in, *conv_w, *conv_b, *dt_bias, *a_log, *d_skip, *ssd_norm_g, *att_norm_g, *gm_ln_g, *gm_ln_b, *gm_w_s, *gm_b_s, *gm_norm_g, *w_out,
        *ln1_g, *ln1_b, *ln2_g, *ln2_b, *ffn_w_gate, *ffn_w_up, *ffn_w_down, *router_w, *moe_w_gate, *moe_w_up, *moe_w_down;
};

static void run_simple(const Inputs& I, int nb, unsigned char* ws, float* aux  , float* OUT, hipStream_t st, float* ckpt = nullptr) {
    const long M = (long)nb * SEQ; const size_t MB = 1u << 20;
    const size_t hsz = (size_t)M * DM * 4;
    float* H = (float*)ws; float* MIX = (float*)(ws + hsz); float* Y = (float*)(ws + 2 * hsz); unsigned char* BIG = ws + 3 * hsz + (size_t)N_EXP * 256 * DM * 4;
    float* XC = Y;
    float* VN = aux;
    float* PROJ = (float*)BIG;
    size_t big_bytes = (size_t)M * D_IN * 4; { size_t a = (size_t)M * D_FF * 4; if (a > big_bytes) big_bytes = a; size_t c = (size_t)(2 * M + N_EXP * 256) * D_FFE * 2; if (c > big_bytes) big_bytes = c; }
    big_bytes = (big_bytes + 255) & ~(size_t)255;
    unsigned char* SM = BIG + big_bytes;
    float* KM = (float*)SM; SM += (size_t)nb * ATT_H * NBLK * 64 * 4;
    float* DT = (float*)SM; SM += (size_t)M * SSD_H * 4;
    int* CNT = (int*)SM; SM += 256;
    int* TE = (int*)SM; SM += (size_t)M * 2 * 4; float* TP = (float*)SM; SM += (size_t)M * 2 * 4; int* TS = (int*)SM; SM += (size_t)M * 2 * 4; int* GS = (int*)SM; SM += (size_t)M * 2 * 4;
    const int nslots = (int)(2 * M + N_EXP * 256);
    int* LIST = (int*)SM; SM += (size_t)nslots * 4; float* SP = (float*)SM; SM += (size_t)nslots * 4;
    (void)MB;
    const ProjL L{D_IN, 0, 384, 768, 1152, 1536, 2432, 2438, 2694};
    const int TB = 256; const int GWB = 2048;
    k_ln_in<<<GWB, TB, 0, st>>>(I.x, I.ln_in_g, I.ln_in_b, H, M);
    for (int i = 0; i < 2; ++i) {
        sgemm_k<float, 0><<<dim3((D_IN + 63) / 64, (unsigned)(M / 64), 1), 256, 0, st>>>(H, DM, nullptr, I.w_in + (size_t)i * DM * D_IN, nullptr, D_IN, 0, PROJ, D_IN, (int)M, D_IN, DM, nullptr, nullptr);
        k_rope<<<GWB, TB, 0, st>>>(PROJ, L, I.pos, M);
        const size_t ck_stride = (size_t)M * (D_IN + 3 * DM); float* ck = ckpt ? ckpt + (size_t)i * ck_stride : nullptr;
        if (ck) hipMemcpyAsync(ck, PROJ, (size_t)M * D_IN * 4, hipMemcpyDeviceToDevice, st);
        k_kmean<<<96 * nb, TB, 0, st>>>(PROJ, L, KM, nb);
        k_attn<<<GWB * 2, TB, 0, st>>>(PROJ, L, KM, MIX, DM, nb);
        k_rms384<<<GWB, TB, 0, st>>>(MIX, DM, I.att_norm_g + i * ATT_W, MIX, DM, M);
        k_ssd_conv<<<GWB * 2, TB, 0, st>>>(PROJ, L, I.conv_w + (size_t)i * 4 * SSD_CW, I.conv_b + i * SSD_CW, I.dt_bias + i * SSD_H, XC, DT, M);
        k_ssd_scan<<<(nb * SSD_H * 64 * 64 + TB - 1) / TB, TB, 0, st>>>(XC, DT, I.a_log + i * SSD_H, I.d_skip + i * SSD_H, MIX + ATT_W, DM, nb);
        k_ssd_gate<<<GWB, TB, 0, st>>>(MIX + ATT_W, DM, PROJ, L, I.ssd_norm_g + i * SSD_W, MIX + ATT_W, DM, M);
        k_gm_ln<<<GWB, TB, 0, st>>>(PROJ, L, I.gm_ln_g + i * GM_W, I.gm_ln_b + i * GM_W, VN, M);
        k_gm_mix<<<GWB * 2, TB, 0, st>>>(PROJ, L, VN, I.gm_w_s + (size_t)i * GM_G * GM_CHUNK * GM_CHUNK, I.gm_b_s + i * GM_G * GM_CHUNK, MIX + ATT_W + SSD_W, DM, M);
        k_rms256<<<GWB, TB, 0, st>>>(MIX + ATT_W + SSD_W, DM, I.gm_norm_g + i * GM_W, MIX + ATT_W + SSD_W, DM, M);
        if (ck) hipMemcpyAsync(ck + (size_t)M * D_IN, MIX, hsz, hipMemcpyDeviceToDevice, st);
        sgemm_k<float, 0><<<dim3(DM / 64, (unsigned)(M / 64), 1), 256, 0, st>>>(MIX, DM, nullptr, I.w_out + (size_t)i * DM * DM, nullptr, DM, 0, Y, DM, (int)M, DM, DM, nullptr, nullptr);
        k_ln_res<<<GWB, TB, 0, st>>>(H, Y, I.ln1_g + i * DM, I.ln1_b + i * DM, H, M);
        if (ck) hipMemcpyAsync(ck + (size_t)M * (D_IN + DM), H, hsz, hipMemcpyDeviceToDevice, st);
        if (i == 0) {
            float* ACT = (float*)BIG;
            sgemm_k<float, 1><<<dim3(D_FF / 64, (unsigned)(M / 64), 1), 256, 0, st>>>(H, DM, nullptr, I.ffn_w_gate, I.ffn_w_up, D_FF, 0, ACT, D_FF, (int)M, D_FF, DM, nullptr, nullptr);
            sgemm_k<float, 0><<<dim3(DM / 64, (unsigned)(M / 64), 1), 256, 0, st>>>(ACT, D_FF, nullptr, I.ffn_w_down, nullptr, DM, 0, Y, DM, (int)M, DM, D_FF, nullptr, nullptr);
            k_ln_res<<<GWB, TB, 0, st>>>(H, Y, I.ln2_g + i * DM, I.ln2_b + i * DM, H, M);
            if (ck) hipMemcpyAsync(ck + (size_t)M * (D_IN + 2 * DM), H, hsz, hipMemcpyDeviceToDevice, st);
        } else {
            bf16* ACTM = (bf16*)BIG; float* F2 = MIX;
            k_moe_init<<<256, TB, 0, st>>>(CNT, LIST, nslots);
            k_moe_route<<<GWB, TB, 0, st>>>(H, I.router_w, CNT, TE, TP, TS, M);
            k_moe_scatter<<<256, TB, 0, st>>>(CNT, TE, TP, TS, LIST, SP, GS, M);
            sgemm_k<float, 2><<<dim3(D_FFE / 64, (unsigned)(M / 64), N_EXP), 256, 0, st>>>(H, DM, LIST, I.moe_w_gate, I.moe_w_up, D_FFE, (long)DM * D_FFE, ACTM, D_FFE, 0, D_FFE, DM, CNT, nullptr);
            sgemm_k<bf16, 3><<<dim3(DM / 64, (unsigned)(M / 64), N_EXP), 256, 0, st>>>(ACTM, D_FFE, nullptr, I.moe_w_down, nullptr, DM, (long)D_FFE * DM, F2, DM, 0, DM, D_FFE, CNT, SP);
            k_ln_moe<<<GWB, TB, 0, st>>>(H, F2, GS, I.ln2_g + i * DM, I.ln2_b + i * DM, OUT, M);
            if (ck) hipMemcpyAsync(ck + (size_t)M * (D_IN + 2 * DM), OUT, hsz, hipMemcpyDeviceToDevice, st);
        }
    }
}

#define LAS __attribute__((address_space(3)))
namespace pg8 {
#define PG8_LAS __attribute__((address_space(3)))
typedef unsigned short bf16_t;
typedef short bf16x8 __attribute__((ext_vector_type(8)));
typedef float f32x4 __attribute__((ext_vector_type(4)));
typedef unsigned u32x4 __attribute__((ext_vector_type(4)));
constexpr int BM = 256, BK = 64, HALF = 128, HTB = HALF * BK * 2  , STAGE_BYTES = 8 * HTB, NXCD = 8, WGM = 8;

__host__ __device__ __forceinline__ int lds_byte(int r, int c) { const int st = (r >> 4) * 2 + (c >> 5), rr = r & 15, cc = c & 31, ob = rr * 64 + cc * 2; return st * 1024 + (ob ^ (((ob >> 9) & 1) << 5)); }
__host__ __device__ __forceinline__ void stage_rc(int b, int& R, int& C) { const int st = b / 1024, sb = b % 1024, swz = sb ^ (((sb >> 9) & 1) << 5); R = (st >> 1) * 16 + swz / 64; C = (st & 1) * 32 + (swz % 64) / 2; }
__host__ __device__ __forceinline__ int perm32(int rho) { const int n = rho >> 4, i = rho & 15; return 8 * (i >> 2) + 4 * n + (i & 3); }

struct Unit { int pm, pn, kofs; };
struct Gemm { const bf16_t* A; const bf16_t* Bt; int M, N, K, ld; };

struct StaticOrder {
    int nM, nN, nwg, G, c;
    __host__ __device__ void init(int M, int N, int G_, int c_) { nM = M / BM; nN = N / BM; nwg = nM * nN; G = G_; c = c_; }
    __host__ __device__ bool next(int i, Unit& u) const {
        const long L = (long)i * G + c; if (L >= nwg) return false;
        int wgid = (int)L; { const int q = nwg / NXCD, r = nwg % NXCD, xcd = wgid % NXCD, off = wgid / NXCD; wgid = (xcd < r ? xcd * (q + 1) : r * (q + 1) + (xcd - r) * q) + off; }
        const int nig = WGM * nN, gid = wgid / nig, fm = gid * WGM, gsz = (nM - fm) < WGM ? (nM - fm) : WGM;
        u.pm = fm + ((wgid % nig) % gsz); u.pn = (wgid % nig) / gsz; u.kofs = 0; return true;
    }
    __device__ __forceinline__ void a_ready(const Unit&) const {}
    __device__ __forceinline__ void done(const Unit&) const {}
};
__device__ __forceinline__ unsigned cvt_pk_bf16(float lo, float hi) { unsigned r; asm volatile("v_cvt_pk_bf16_f32 %0, %1, %2" : "=v"(r) : "v"(lo), "v"(hi)); return r; }
typedef float f32x2 __attribute__((ext_vector_type(2)));
template <class Epi, class Sched, bool ALIGN_EPI = false, bool SP2 = false>
__device__ __forceinline__ void gemm_phase(PG8_LAS unsigned char* lds, const Gemm g, const Sched& S, const Epi& E, const int tid) {
    const int wid = __builtin_amdgcn_readfirstlane(tid >> 6), lane = tid & 63, wr = wid >> 2, wc = wid & 3, fr = lane & 15, fq = lane >> 4;
    const int K = g.ld, nt = g.K / BK;
    unsigned voffA[2], voffB[2];
#pragma unroll
    for (int i = 0; i < 2; ++i) { int R, C; stage_rc(tid * 16 + i * 8192, R, C); const int Rb = Epi::PERM ? ((R & ~31) + perm32(R & 31)) : R;
        voffA[i] = (unsigned)(R * K + C) * 2u; voffB[i] = (unsigned)(Rb * K + C) * 2u; }
    const size_t kstep = (size_t)(BK * 2);
    const size_t hstep = (size_t)HALF * K * 2;
    const size_t tstep = 2 * hstep;
    const unsigned ldsw = (unsigned)wid * 1024u;
    const int aoff = lds_byte(wr * 64 + fr, fq * 8), boff = lds_byte(wc * 32 + fr, fq * 8);
#define PG8_SA(b, h) (((b) * 2 + (h)) * HTB)
#define PG8_SB(b, h) ((4 + (b) * 2 + (h)) * HTB)
#define PG8_STAGE(bufoff, gbase, voff) do { _Pragma("unroll") for (int _i = 0; _i < 2; ++_i) \
        __builtin_amdgcn_global_load_lds((const unsigned*)((const char*)(gbase) + (voff)[_i]), (PG8_LAS unsigned*)(lds + (bufoff) + ldsw + _i * 8192), 16, 0, 0); } while (0)
#define PG8_LDA(dst, b, h) do { _Pragma("unroll") for (int m = 0; m < 4; ++m) _Pragma("unroll") for (int k = 0; k < 2; ++k) dst[m][k] = *(const PG8_LAS bf16x8*)(lds + PG8_SA(b, h) + aoff + m * 2048 + k * 1024); } while (0)
#define PG8_LDB(dst, b, h) do { _Pragma("unroll") for (int n = 0; n < 2; ++n) _Pragma("unroll") for (int k = 0; k < 2; ++k) dst[n][k] = *(const PG8_LAS bf16x8*)(lds + PG8_SB(b, h) + boff + n * 2048 + k * 1024); } while (0)
#define PG8_MMA(ai, bj, At, Bt) do { __builtin_amdgcn_s_setprio(1); _Pragma("unroll") for (int m = 0; m < 4; ++m) _Pragma("unroll") for (int n = 0; n < 2; ++n) _Pragma("unroll") for (int k = 0; k < 2; ++k) \
        acc[ai][bj][m][n] = __builtin_amdgcn_mfma_f32_16x16x32_bf16(Bt[n][k], At[m][k], acc[ai][bj][m][n], 0, 0, 0); __builtin_amdgcn_s_setprio(0); } while (0)
#define PG8_WAIT_V(n) asm volatile("s_waitcnt vmcnt(" #n ")" ::: "memory")
#define PG8_WAIT_L(n) asm volatile("s_waitcnt lgkmcnt(" #n ")" ::: "memory")
#define PG8_BAR __builtin_amdgcn_s_barrier()
#define PG8_SCHED __builtin_amdgcn_sched_barrier(0)
    Unit cur, nxt; int ui = 0;
    if (!S.next(0, cur)) return;
    f32x4 acc[2][2][4][2];
#pragma unroll
    for (int a = 0; a < 2; ++a)
#pragma unroll
        for (int b = 0; b < 2; ++b)
#pragma unroll
            for (int m = 0; m < 4; ++m)
#pragma unroll
                for (int n = 0; n < 2; ++n) acc[a][b][m][n] = (f32x4){0.f, 0.f, 0.f, 0.f};
    bf16x8 At[4][2], B0[2][2], B1[2][2];
    const char* cA = (const char*)g.A + (size_t)cur.pm * tstep + (size_t)cur.kofs * 2; const char* cB = (const char*)g.Bt + (size_t)cur.pn * tstep + (size_t)cur.kofs * 2;
    S.a_ready(cur);
    if constexpr (SP2) {
        PG8_STAGE(PG8_SB(0, 0), cB, voffB); PG8_STAGE(PG8_SB(0, 1), cB + hstep, voffB); PG8_STAGE(PG8_SA(0, 0), cA, voffA); PG8_STAGE(PG8_SA(0, 1), cA + hstep, voffA);
        if (wr == 1) PG8_BAR;
        PG8_WAIT_V(2); PG8_BAR;
        PG8_STAGE(PG8_SB(1, 0), cB + kstep, voffB); PG8_STAGE(PG8_SA(1, 0), cA + kstep, voffA); PG8_STAGE(PG8_SB(1, 1), cB + hstep + kstep, voffB);
        PG8_WAIT_V(6); PG8_BAR;
    } else {
        PG8_STAGE(PG8_SB(0, 0), cB, voffB); PG8_STAGE(PG8_SA(0, 0), cA, voffA); PG8_STAGE(PG8_SB(0, 1), cB + hstep, voffB); PG8_STAGE(PG8_SA(0, 1), cA + hstep, voffA);
        if (wr == 1) PG8_BAR;
        PG8_WAIT_V(4); PG8_BAR;
        PG8_STAGE(PG8_SB(1, 0), cB + kstep, voffB); PG8_STAGE(PG8_SA(1, 0), cA + kstep, voffA); PG8_STAGE(PG8_SB(1, 1), cB + hstep + kstep, voffB);
        PG8_WAIT_V(6); PG8_BAR;
    }
    for (;;) {
        const bool has_next = S.next(ui + 1, nxt);
        const char* nA = has_next ? (const char*)g.A + (size_t)nxt.pm * tstep + (size_t)nxt.kofs * 2 : cA; const char* nB = has_next ? (const char*)g.Bt + (size_t)nxt.pn * tstep + (size_t)nxt.kofs * 2 : cB;
        for (int t = 0; t < nt; t += 2) {
            const bool last = (t == nt - 2);
            const char* a1 = cA + (size_t)(t + 1) * kstep;
            const char* a2 = last ? nA : cA + (size_t)(t + 2) * kstep; const char* b2 = last ? nB : cB + (size_t)(t + 2) * kstep;
            const char* a3 = a2 + kstep; const char* b3 = b2 + kstep;
            if (last && has_next) S.a_ready(nxt);
            if constexpr (SP2) {
            PG8_LDB(B0, 0, 0); PG8_LDB(B1, 0, 1); PG8_SCHED; PG8_LDA(At, 0, 0); PG8_STAGE(PG8_SA(1, 1), a1 + hstep, voffA);
            PG8_WAIT_V(8); PG8_WAIT_L(0); PG8_BAR; PG8_MMA(0, 0, At, B0); PG8_MMA(0, 1, At, B1); PG8_BAR; PG8_SCHED;
            PG8_LDA(At, 0, 1); PG8_STAGE(PG8_SB(0, 0), b2, voffB); PG8_STAGE(PG8_SB(0, 1), b2 + hstep, voffB); PG8_STAGE(PG8_SA(0, 0), a2, voffA);
            PG8_WAIT_V(8); PG8_WAIT_L(0); PG8_BAR; PG8_MMA(1, 0, At, B0); PG8_MMA(1, 1, At, B1); PG8_BAR; PG8_SCHED;
            PG8_LDB(B0, 1, 0); PG8_LDB(B1, 1, 1); PG8_SCHED; PG8_LDA(At, 1, 0); PG8_STAGE(PG8_SA(0, 1), a2 + hstep, voffA);
            PG8_WAIT_V(8); PG8_WAIT_L(0); PG8_BAR; PG8_MMA(0, 0, At, B0); PG8_MMA(0, 1, At, B1); PG8_BAR; PG8_SCHED;
            PG8_LDA(At, 1, 1); PG8_STAGE(PG8_SB(1, 0), b3, voffB); PG8_STAGE(PG8_SB(1, 1), b3 + hstep, voffB); PG8_STAGE(PG8_SA(1, 0), a3, voffA);
            PG8_WAIT_V(8); PG8_WAIT_L(0); PG8_BAR; PG8_MMA(1, 0, At, B0); PG8_MMA(1, 1, At, B1); PG8_BAR; PG8_SCHED;
            } else {
            PG8_LDB(B0, 0, 0); PG8_SCHED; PG8_LDA(At, 0, 0); PG8_STAGE(PG8_SA(1, 1), a1 + hstep, voffA);
            PG8_WAIT_L(8); PG8_BAR; PG8_WAIT_L(0); PG8_MMA(0, 0, At, B0); PG8_BAR; PG8_SCHED;
            PG8_LDB(B1, 0, 1); PG8_STAGE(PG8_SB(0, 0), b2, voffB);
            PG8_BAR; PG8_WAIT_L(0); PG8_MMA(0, 1, At, B1); PG8_BAR;
            PG8_LDA(At, 0, 1); PG8_STAGE(PG8_SA(0, 0), a2, voffA);
            PG8_BAR; PG8_WAIT_L(0); PG8_MMA(1, 0, At, B0); PG8_BAR; PG8_SCHED;
            PG8_STAGE(PG8_SB(0, 1), b2 + hstep, voffB);
            PG8_WAIT_V(6); PG8_BAR; PG8_MMA(1, 1, At, B1); PG8_BAR;
            PG8_LDB(B0, 1, 0); PG8_SCHED; PG8_LDA(At, 1, 0); PG8_STAGE(PG8_SA(0, 1), a2 + hstep, voffA);
            PG8_WAIT_L(8); PG8_BAR; PG8_WAIT_L(0); PG8_MMA(0, 0, At, B0); PG8_BAR; PG8_SCHED;
            PG8_LDB(B1, 1, 1); PG8_STAGE(PG8_SB(1, 0), b3, voffB);
            PG8_BAR; PG8_WAIT_L(0); PG8_MMA(0, 1, At, B1); PG8_BAR;
            PG8_LDA(At, 1, 1); PG8_STAGE(PG8_SA(1, 0), a3, voffA);
            PG8_BAR; PG8_WAIT_L(0); PG8_MMA(1, 0, At, B0); PG8_BAR; PG8_SCHED;
            PG8_STAGE(PG8_SB(1, 1), b3 + hstep, voffB);
            PG8_WAIT_V(6); PG8_BAR; PG8_MMA(1, 1, At, B1); PG8_BAR;
            }
        }
        if constexpr (ALIGN_EPI) { if (wr == 0) PG8_BAR; }
        if constexpr (!Epi::AFTER_DRAIN) { E(acc, cur, wr, wc, fr, fq); S.done(cur); }
        if (!has_next) break;
#pragma unroll
        for (int a = 0; a < 2; ++a)
#pragma unroll
            for (int b = 0; b < 2; ++b)
#pragma unroll
                for (int m = 0; m < 4; ++m)
#pragma unroll
                    for (int n = 0; n < 2; ++n) acc[a][b][m][n] = (f32x4){0.f, 0.f, 0.f, 0.f};
        cur = nxt; cA = nA; cB = nB; ++ui;
        if constexpr (ALIGN_EPI) { if (wr == 1) PG8_BAR; }
    }
    PG8_WAIT_V(0);
    if constexpr (!ALIGN_EPI) { if (wr == 0) PG8_BAR; }
    PG8_BAR;
    if constexpr (Epi::AFTER_DRAIN) { E.fused(acc, cur, wr, wc, fr, fq, lds, wid, lane); S.done(cur); }
#undef PG8_SA
#undef PG8_SB
#undef PG8_STAGE
#undef PG8_LDA
#undef PG8_LDB
#undef PG8_MMA
#undef PG8_WAIT_V
#undef PG8_WAIT_L
#undef PG8_BAR
#undef PG8_SCHED
}
}
#define XB_TMO      128
#define XB_XCNT(j)  (256  + 64 * (j))
#define XB_XSUB(j)  (1280 + 64 * (j))
#define XB_XGEN(j)  (2304 + 64 * (j))
#define XB_TOP      3328
#define XB_TOPGEN   3392
#define XCD_BAR_WORDS 3456
#define XB_SPIN_CAP (1u << 24)

__device__ __forceinline__ unsigned xb_ld(unsigned* p)              { return __hip_atomic_load(p, __ATOMIC_RELAXED, __HIP_MEMORY_SCOPE_AGENT); }
__device__ __forceinline__ unsigned xb_add(unsigned* p, unsigned v) { return __hip_atomic_fetch_add(p, v, __ATOMIC_RELAXED, __HIP_MEMORY_SCOPE_AGENT); }
__device__ __forceinline__ unsigned xb_xcc_id() { return (unsigned)__builtin_amdgcn_s_getreg((3 << 11) | 20) & 0xFu; }
#define XB_SPIN(cond, bar) do { unsigned _sp = 0; while (cond) { __builtin_amdgcn_s_sleep(1); \
    if ((++_sp & 255u) == 0u) { if (xb_ld(&(bar)[XB_TMO])) break; if (_sp > XB_SPIN_CAP) { atomicAdd(&(bar)[XB_TMO], 1u); break; } } } } while (0)

struct XcdBarrier {
    unsigned* bar; unsigned x; int w0;
    volatile LAS unsigned* st;
};

__device__ __forceinline__ XcdBarrier xcd_barrier_post(unsigned* bar, volatile LAS unsigned* st) {
    XcdBarrier b; b.bar = bar; b.x = xb_xcc_id(); b.st = st; b.w0 = (__builtin_amdgcn_readfirstlane((int)threadIdx.x >> 6) == 0);
    if (threadIdx.x == 0) (void)xb_add(&bar[XB_XCNT(b.x)], 1u);
    return b;
}
__device__ __forceinline__ void xcd_barrier_complete(unsigned* bar, unsigned x, unsigned& nloc, unsigned& nx) {
    const unsigned G = gridDim.x * gridDim.y * gridDim.z;
    unsigned sum, cnt, mine, sp = 0u;
    for (;;) {
        sum = 0u; cnt = 0u; mine = 0u;
#pragma unroll
        for (unsigned j = 0; j < 16; ++j) { const unsigned c = xb_ld(&bar[XB_XCNT(j)]); sum += c; cnt += (c > 0u) ? 1u : 0u; mine = (j == x) ? c : mine; }
        if (sum == G) break;
        __builtin_amdgcn_s_sleep(1);
        if ((++sp & 255u) == 0u) { if (xb_ld(&bar[XB_TMO])) break; if (sp > XB_SPIN_CAP) { atomicAdd(&bar[XB_TMO], 1u); break; } }
    }
    nloc = mine > 0u ? mine : 1u; nx = cnt > 0u ? cnt : 1u;
}

__device__ __forceinline__ void xcd_barrier(const XcdBarrier& b) {
    asm volatile("s_waitcnt vmcnt(0)" ::: "memory");
    __syncthreads();
    if (b.w0 && __builtin_amdgcn_mbcnt_hi(~0u, __builtin_amdgcn_mbcnt_lo(~0u, 0u)) == 0u) {
        unsigned* bar = b.bar;
        __builtin_amdgcn_s_waitcnt(0);
        unsigned nloc = b.st[0], nx = b.st[1];
        if (nloc == 0u) { xcd_barrier_complete(bar, b.x, nloc, nx); b.st[0] = nloc; b.st[1] = nx; }
        const unsigned old = xb_add(&bar[XB_XSUB(b.x)], 1u);
        const unsigned gen = old / nloc;
        if (old + 1u == (gen + 1u) * nloc) {
            __builtin_amdgcn_fence(__ATOMIC_RELEASE, "agent");
            asm volatile("s_waitcnt vmcnt(0)" ::: "memory");
            const unsigned og = xb_add(&bar[XB_TOP], 1u);
            const unsigned tg = og / nx;
            if (og + 1u == (tg + 1u) * nx) xb_add(&bar[XB_TOPGEN], 1u);
            else XB_SPIN(xb_ld(&bar[XB_TOPGEN]) == tg, bar);
            __builtin_amdgcn_fence(__ATOMIC_ACQUIRE, "agent");
            xb_add(&bar[XB_XGEN(b.x)], 1u);
            asm volatile("s_waitcnt vmcnt(0)" ::: "memory");
        } else {
            XB_SPIN(xb_ld(&bar[XB_XGEN(b.x)]) == gen, bar);
            __builtin_amdgcn_fence(__ATOMIC_ACQUIRE, "agent");
            asm volatile("s_waitcnt vmcnt(0)" ::: "memory");
        }
    }
    __syncthreads();
}
#include <hip/hip_bf16.h>
#include <cmath>
namespace attn_body {
using bf16=__hip_bfloat16;
using bf16x8=__attribute__((ext_vector_type(8)))short;
using s16x4=__attribute__((ext_vector_type(4)))short;
using f32x16=__attribute__((ext_vector_type(16)))float;
using u32x4=__attribute__((ext_vector_type(4)))unsigned;
constexpr int NHEAD=6,SEQ=2048,D=64,QP=3072,OP=1024;
constexpr int NW=8,QBLK=32,QB=QBLK*NW,KVBLK=64,NQB=SEQ/QB;
constexpr int ATTN_UNIT_ROWS=QB;
__device__ __forceinline__ int crow(int r,int hi){return (r&3)+8*(r>>2)+4*hi;}
#define SBAR() __builtin_amdgcn_sched_barrier(0)
__device__ __forceinline__ void cmask(f32x16&p0,f32x16&p1,int jb,int qrel,int hi){
  const float NEG=-INFINITY; int kb=64*jb+4*hi;
  #pragma unroll
  for(int r=0;r<16;++r){int kv=kb+(r&3)+8*(r>>2); if(kv>qrel)p0[r]=NEG; if(kv+32>qrel)p1[r]=NEG;}
}

constexpr int NSLOT=3, SLOTB=8192;
constexpr int LDS_K=0, LDS_V=NSLOT*SLOTB, LDS_WS=2*NSLOT*SLOTB, LDS_OST=LDS_WS+NW*64*4, LDS_BYTES=LDS_OST+NW*4096;
constexpr float C2=0.125f*1.4426950408889634f;
__device__ __forceinline__ void glds16(const void*gsrc,unsigned lds_dst){unsigned keep;
  asm volatile("s_mov_b32 %0, m0\n\ts_mov_b32 m0, %2\n\ts_nop 0\n\tglobal_load_lds_dwordx4 %1, off\n\ts_mov_b32 m0, %0":"=&s"(keep):"v"(gsrc),"s"(lds_dst):"memory");}
__device__ __forceinline__ float max3f(float a,float b,float c){float r;asm("v_max3_f32 %0, %1, %2, %3":"=v"(r):"v"(a),"v"(b),"v"(c));return r;}
__device__ __forceinline__ float max2f(float a,float b){float r;asm("v_max_f32_e32 %0, %1, %2":"=v"(r):"v"(a),"v"(b));return r;}
__device__ __forceinline__ float fadd_s(float a,float b){float r;asm("v_add_f32_e32 %0, %1, %2":"=v"(r):"v"(a),"v"(b));return r;}
__device__ __forceinline__ float fsub_s(float a,float b){float r;asm("v_sub_f32_e32 %0, %1, %2":"=v"(r):"v"(a),"v"(b));return r;}
typedef float f32x2_t __attribute__((ext_vector_type(2))); typedef __bf16 bf16x2_t __attribute__((ext_vector_type(2)));
__device__ __forceinline__ unsigned cvtpk_s(float lo,float hi){f32x2_t v={lo,hi};bf16x2_t b=__builtin_convertvector(v,bf16x2_t);return __builtin_bit_cast(unsigned,b);}
#define WAIT_BAR(N) asm volatile("s_waitcnt vmcnt(" #N ") lgkmcnt(0)\n\ts_barrier":::"memory")

__device__ __forceinline__ void qkt(f32x16&p0,f32x16&p1,const char*Kslot,const bf16x8*qr,int r32,int hi){ const f32x16 negm=f32x16{};
  const char*kb=Kslot+hi*1024+r32*16;
  #pragma unroll
  for(int d0=0;d0<4;++d0){
    const bf16x8 b0=*reinterpret_cast<const bf16x8*>(kb+d0*2048);
    const bf16x8 b1=*reinterpret_cast<const bf16x8*>(kb+d0*2048+512);
    if(d0==0){p0=__builtin_amdgcn_mfma_f32_32x32x16_bf16(b0,qr[0],negm,0,0,0);p1=__builtin_amdgcn_mfma_f32_32x32x16_bf16(b1,qr[0],negm,0,0,0);}
    else{p0=__builtin_amdgcn_mfma_f32_32x32x16_bf16(b0,qr[d0],p0,0,0,0);p1=__builtin_amdgcn_mfma_f32_32x32x16_bf16(b1,qr[d0],p1,0,0,0);}}
}
typedef __attribute__((address_space(3))) const char* lds_cptr;
typedef short v4i16_t __attribute__((ext_vector_type(4)));
__device__ __forceinline__ void kload8(bf16x8*kf,lds_cptr kp){
  kf[0]=*(const __attribute__((address_space(3))) bf16x8*)(kp);      kf[1]=*(const __attribute__((address_space(3))) bf16x8*)(kp+512);
  kf[2]=*(const __attribute__((address_space(3))) bf16x8*)(kp+2048); kf[3]=*(const __attribute__((address_space(3))) bf16x8*)(kp+2560);
  kf[4]=*(const __attribute__((address_space(3))) bf16x8*)(kp+4096); kf[5]=*(const __attribute__((address_space(3))) bf16x8*)(kp+4608);
  kf[6]=*(const __attribute__((address_space(3))) bf16x8*)(kp+6144); kf[7]=*(const __attribute__((address_space(3))) bf16x8*)(kp+6656);
}
__device__ __forceinline__ void kload2(bf16x8*kf,lds_cptr kp,int j){ kf[2*j]=*(const __attribute__((address_space(3))) bf16x8*)(kp+j*2048); kf[2*j+1]=*(const __attribute__((address_space(3))) bf16x8*)(kp+j*2048+512); }
__device__ __forceinline__ s16x4 vtr(lds_cptr p){ return __builtin_bit_cast(s16x4,__builtin_amdgcn_ds_read_tr16_b64_v4i16((__attribute__((address_space(3))) v4i16_t*)p)); }
__device__ __forceinline__ float rowmax(const f32x16&p0,const f32x16&p1){
  float a=max3f(p0[0],p0[1],p1[0]),b=max3f(p0[2],p0[3],p1[1]);a=max3f(a,p1[2],p1[3]);
  #pragma unroll
  for(int r=4;r<16;r+=4){a=max3f(a,p0[r],p0[r+1]);b=max3f(b,p0[r+2],p0[r+3]);a=max3f(a,p1[r],p1[r+1]);b=max3f(b,p1[r+2],p1[r+3]);}
  const float m=max2f(a,b);
  auto rr=__builtin_amdgcn_permlane32_swap(__float_as_uint(m),__float_as_uint(m),false,false);
  return max2f(__uint_as_float(rr[0]),__uint_as_float(rr[1]));
}
__device__ __forceinline__ void pv(f32x16*o,int vb,bf16x8 pa0,bf16x8 pa1,bf16x8 pa2,bf16x8 pa3){
  #pragma unroll
  for(int d0=0;d0<2;++d0){s16x4 lo[4],hi[4];
    #pragma unroll
    for(int ks=0;ks<4;++ks){
      asm volatile("ds_read_b64_tr_b16 %0,%1 offset:%c2":"=&v"(lo[ks]):"v"(vb),"i"(d0*4096+ks*1024):"memory");
      asm volatile("ds_read_b64_tr_b16 %0,%1 offset:%c2":"=&v"(hi[ks]):"v"(vb),"i"(d0*4096+ks*1024+512):"memory");}
    asm volatile("s_waitcnt lgkmcnt(0)":::"memory");SBAR();
    #define PK(k) (bf16x8){lo[k][0],lo[k][1],lo[k][2],lo[k][3],hi[k][0],hi[k][1],hi[k][2],hi[k][3]}
    o[d0]=__builtin_amdgcn_mfma_f32_32x32x16_bf16(pa0,PK(0),o[d0],0,0,0);
    o[d0]=__builtin_amdgcn_mfma_f32_32x32x16_bf16(pa1,PK(1),o[d0],0,0,0);
    o[d0]=__builtin_amdgcn_mfma_f32_32x32x16_bf16(pa2,PK(2),o[d0],0,0,0);
    o[d0]=__builtin_amdgcn_mfma_f32_32x32x16_bf16(pa3,PK(3),o[d0],0,0,0);
    #undef PK
  }
}

#ifndef ATTN_STORE16
#define ATTN_STORE16(p,v) (*(u32x4*)(p)=(v))
#endif
template<int THRL> __device__ __forceinline__ void attn_unit(int b,int h,int qb,const bf16*Q,const bf16*__restrict__ K,const bf16*__restrict__ V,bf16*O,const float*__restrict__ KM,int KMH,char*shm,const int tid){
  const int lane=tid&63,r32=lane&31,hi=lane>>5; const int wid=__builtin_amdgcn_readfirstlane(tid>>6);
  const long rowbase=(long)b*SEQ; const int q0=qb*QB;
  const bf16*Qw=Q+(rowbase+q0+wid*QBLK)*QP+h*D;
  const bf16*Kh=K+rowbase*QP+h*D,*Vh=V+rowbase*QP+h*D;
  const unsigned lds0=(unsigned)(uintptr_t)shm;
  float*wsf=(float*)(shm+LDS_WS)+wid*64;
  const bf16*ksrc=Kh+(long)lane*QP+wid*8;
  const bf16*vsrc=Vh+(long)(16*(wid&3)+(lane>>2))*QP+(wid>>2)*32+(lane&3)*8;
  const unsigned kdst=lds0+LDS_K+wid*1024, vdst=lds0+LDS_V+wid*1024;
  #define TI(t) (((t)<4)?(NT-4+(t)):((t)-4))
  #define DMA_K(t,slot) glds16(ksrc+(long)TI(t)*KVBLK*QP,(unsigned)__builtin_amdgcn_readfirstlane(kdst+(slot)))
  #define DMA_V(t,slot) glds16(vsrc+(long)TI(t)*KVBLK*QP,(unsigned)__builtin_amdgcn_readfirstlane(vdst+(slot)))
  const char*Kbase=shm+LDS_K; bf16x8 kf[8];
  const lds_cptr shm3=(lds_cptr)shm; const lds_cptr kp0=shm3+LDS_K+hi*1024+r32*16; const lds_cptr vp0=shm3+LDS_V+((lane>>4)&1)*32+(lane&3)*8+(4*hi+((lane&15)>>2))*64;
  const int NT=(q0+QB)/KVBLK;
  DMA_K(0,0);DMA_V(0,0);DMA_K(1,SLOTB);
  bf16x8 qr[4];
  #pragma unroll
  for(int d0=0;d0<4;++d0)qr[d0]=*reinterpret_cast<const bf16x8*>(&Qw[(long)r32*QP+d0*16+hi*8]);

  unsigned sel=0u;
  if(qb>0){ float gt_[8];
    #pragma unroll
    for(int n=0;n<8;++n){ float a_=0.f;
      if(n<qb){ const float*km=KM+((long)(b*NHEAD+h)*8+n)*64+hi*8;
        #pragma unroll
        for(int d0=0;d0<4;++d0){ float4 k0=*reinterpret_cast<const float4*>(km+d0*16), k1=*reinterpret_cast<const float4*>(km+d0*16+4);
          { const float4 k2=*reinterpret_cast<const float4*>(km+KMH+d0*16), k3=*reinterpret_cast<const float4*>(km+KMH+d0*16+4); k0.x+=k2.x;k0.y+=k2.y;k0.z+=k2.z;k0.w+=k2.w;k1.x+=k3.x;k1.y+=k3.y;k1.z+=k3.z;k1.w+=k3.w; }
          const bf16x8 qv=qr[d0];
          a_+=__uint_as_float(((unsigned)(unsigned short)qv[0])<<16)*k0.x+__uint_as_float(((unsigned)(unsigned short)qv[1])<<16)*k0.y+__uint_as_float(((unsigned)(unsigned short)qv[2])<<16)*k0.z+__uint_as_float(((unsigned)(unsigned short)qv[3])<<16)*k0.w
             +__uint_as_float(((unsigned)(unsigned short)qv[4])<<16)*k1.x+__uint_as_float(((unsigned)(unsigned short)qv[5])<<16)*k1.y+__uint_as_float(((unsigned)(unsigned short)qv[6])<<16)*k1.z+__uint_as_float(((unsigned)(unsigned short)qv[7])<<16)*k1.w; }
        a_+=__shfl_xor(a_,32); }
      gt_[n]=(n<qb)?a_:-1e30f; }
    #pragma unroll
    for(int r_=0;r_<3;++r_){ float bv=-3.0e38f; int best=-1;
      #pragma unroll
      for(int n=0;n<8;++n) if(!((sel>>n)&1u)&&gt_[n]>bv){bv=gt_[n];best=n;}
      if(best>=0&&bv>-0.5e30f) sel|=1u<<best; } }
  if(hi==0)wsf[32+r32]=__uint_as_float(sel); asm volatile("s_waitcnt lgkmcnt(0)":::"memory");
  float mhat=0.f,l_reg=0.f;f32x16 o[2];o[0]=f32x16{};o[1]=f32x16{};
  const int qrel=wid*QBLK+r32;
  #define CMASK(P0,P1,t) do{ if((t)<4){cmask(P0,P1,(t),qrel,hi);} else if(!((__float_as_uint(wsf[32+r32])>>(((t)-4)>>2))&1u)){ _Pragma("unroll") for(int r_=0;r_<16;++r_){P0[r_]=-INFINITY;P1[r_]=-INFINITY;} } }while(0)
  bool resc=false;
  #define START(P0,P1) do{ const float rm=rowmax(P0,P1); resc=false; \
    { const float dl=rm; mhat=fadd_s(mhat,dl); \
      _Pragma("unroll") for(int r=0;r<16;++r){P0[r]=fsub_s(P0[r],dl);P1[r]=fsub_s(P1[r],dl);} \
      } \
    _Pragma("unroll") for(int r=0;r<16;++r)P0[r]=__builtin_amdgcn_exp2f(P0[r]); }while(0)
  #define RESC() do{ if(resc){ asm volatile("s_waitcnt lgkmcnt(0)":::"memory"); \
      _Pragma("unroll") for(int d_=0;d_<2;++d_) _Pragma("unroll") for(int r=0;r<16;++r)o[d_][r]*=wsf[crow(r,hi)]; } }while(0)
  f32x16 pA0,pA1,pB0,pB1;
  int sl_prev=0,sl_cur=0,sl_next=SLOTB;
  #define ROT() do{sl_prev=sl_cur;sl_cur=sl_next;sl_next=(sl_next==(NSLOT-1)*SLOTB)?0:sl_next+SLOTB;}while(0)
  DMA_K(2,2*SLOTB);
  WAIT_BAR(3);
  qkt(pA0,pA1,Kbase,qr,r32,hi);asm volatile("s_nop 15\n\ts_nop 7":"+v"(pA0),"+v"(pA1));CMASK(pA0,pA1,0);
  START(pA0,pA1);
  _Pragma("unroll") for(int r=0;r<16;++r)pA1[r]=__builtin_amdgcn_exp2f(pA1[r]);
  WAIT_BAR(0);
  DMA_K(3,0);DMA_V(1,SLOTB);
  ROT();
  kload8(kf,kp0+sl_cur);
  WAIT_BAR(2);
  s16x4 vlo[8],vhi[8]; u32x4 pw0,pw1,pw2,pw3;
  #define PKW(P,B) cvtpk_s(P[B],P[B+1])
  #define PAF(k) __builtin_bit_cast(bf16x8,pw##k)
  #define VFR(i) (bf16x8){vlo[i][0],vlo[i][1],vlo[i][2],vlo[i][3],vhi[i][0],vhi[i][1],vhi[i][2],vhi[i][3]}
  #define PIN(x) asm volatile("":"+v"(x))
  #define MX3(a,b,c) __builtin_fmaxf(__builtin_fmaxf((a),(b)),(c))
  #define GAPA(MF,A0,A1,A2,A3,W0,W1,PW) do{ MF; sacc+=A0; sacc+=A1; sacc+=A2; sacc+=A3; PIN(sacc); W0; W1; PIN(PW); SBAR(); }while(0)
  #define EX(v) __builtin_amdgcn_exp2f(v)
  #define GAPB(MF,X,B) do{ MF; X[B]=EX(X[B]); X[B+1]=EX(X[B+1]); X[B+2]=EX(X[B+2]); X[B+3]=EX(X[B+3]); PIN(X); SBAR(); }while(0)
  #define VRD(i) do{ vlo[i]=vtr(vp_+(((i)>>2)*4096+((i)&3)*1024)); vhi[i]=vtr(vp_+(((i)>>2)*4096+((i)&3)*1024+512)); }while(0)
  #define KRD(G,j) do{ if(G){ kload2(kf,kp0+sl_next,j); SBAR(); } }while(0)
  #define STEP(C0,C1,P0,P1,t,GK,GV,GL) do{ SBAR(); \
    const lds_cptr vp_=vp0+sl_prev; \
    VRD(0); SBAR(); float sacc=(P0[0]+P0[1]); \
    GAPA(C0=__builtin_amdgcn_mfma_f32_32x32x16_bf16(kf[0],qr[0],f32x16{},0,0,0), P0[2],P0[3],P0[4],P0[5],     pw0[0]=PKW(P0,0), pw0[1]=PKW(P0,2), pw0); \
    VRD(4); SBAR(); GAPA(C1=__builtin_amdgcn_mfma_f32_32x32x16_bf16(kf[1],qr[0],f32x16{},0,0,0), P0[6],P0[7],P0[8],P0[9],     pw0[2]=PKW(P0,4), pw0[3]=PKW(P0,6), pw0); \
    VRD(1); SBAR(); GAPA(C0=__builtin_amdgcn_mfma_f32_32x32x16_bf16(kf[2],qr[1],C0,0,0,0),   P0[10],P0[11],P0[12],P0[13], pw1[0]=PKW(P0,8), pw1[1]=PKW(P0,10), pw1); \
    VRD(5); SBAR(); GAPA(C1=__builtin_amdgcn_mfma_f32_32x32x16_bf16(kf[3],qr[1],C1,0,0,0),   P0[14],P0[15],P1[0],P1[1],   pw1[2]=PKW(P0,12),pw1[3]=PKW(P0,14), pw1); \
    VRD(2); SBAR(); GAPA(C0=__builtin_amdgcn_mfma_f32_32x32x16_bf16(kf[4],qr[2],C0,0,0,0),   P1[2],P1[3],P1[4],P1[5],     pw2[0]=PKW(P1,0), pw2[1]=PKW(P1,2), pw2); \
    VRD(6); SBAR(); GAPA(C1=__builtin_amdgcn_mfma_f32_32x32x16_bf16(kf[5],qr[2],C1,0,0,0),   P1[6],P1[7],P1[8],P1[9],     pw2[2]=PKW(P1,4), pw2[3]=PKW(P1,6), pw2); \
    VRD(3); SBAR(); GAPA(C0=__builtin_amdgcn_mfma_f32_32x32x16_bf16(kf[6],qr[3],C0,0,0,0),   P1[10],P1[11],P1[12],P1[13], pw3[0]=PKW(P1,8), pw3[1]=PKW(P1,10), pw3); \
    VRD(7); SBAR(); GAPA(C1=__builtin_amdgcn_mfma_f32_32x32x16_bf16(kf[7],qr[3],C1,0,0,0),   P1[14],P1[15],0.f,0.f,       pw3[2]=PKW(P1,12),pw3[3]=PKW(P1,14), pw3); \
    l_reg+=sacc; \
    if(GK){DMA_K((t)+3,sl_cur);} if(GV){DMA_V((t)+1,sl_next);} \
    CMASK(C0,C1,t); \
    _Pragma("unroll") for(int r=0;r<16;++r){C0[r]-=mhat;C1[r]-=mhat;} \
    { float a=MX3(C0[0],C0[1],C1[0]),b=MX3(C0[2],C0[3],C1[1]); a=MX3(a,C1[2],C1[3]); \
      _Pragma("unroll") for(int r=4;r<16;r+=4){a=MX3(a,C0[r],C0[r+1]);b=MX3(b,C0[r+2],C0[r+3]);a=MX3(a,C1[r],C1[r+1]);b=MX3(b,C1[r+2],C1[r+3]);} \
      float rm=__builtin_fmaxf(a,b); { auto rr=__builtin_amdgcn_permlane32_swap(__float_as_uint(rm),__float_as_uint(rm),false,false); rm=__builtin_fmaxf(__uint_as_float(rr[0]),__uint_as_float(rr[1])); } \
      resc=false; \
      if(__builtin_expect(__any(rm>(float)THRL),0)){ const float dl=__builtin_fmaxf(rm,0.f); mhat+=dl; \
        _Pragma("unroll") for(int r=0;r<16;++r){C0[r]-=dl;C1[r]-=dl;} \
        const float f=__builtin_amdgcn_exp2f(-dl); l_reg*=f; if(hi==0)wsf[r32]=f; resc=true; } } \
    SBAR(); \
    GAPB(o[0]=__builtin_amdgcn_mfma_f32_32x32x16_bf16(PAF(0),VFR(0),o[0],0,0,0), C0,0); \
    GAPB(o[1]=__builtin_amdgcn_mfma_f32_32x32x16_bf16(PAF(0),VFR(4),o[1],0,0,0), C0,4); \
    KRD(GL,0); GAPB(o[0]=__builtin_amdgcn_mfma_f32_32x32x16_bf16(PAF(1),VFR(1),o[0],0,0,0), C0,8); \
    KRD(GL,1); GAPB(o[1]=__builtin_amdgcn_mfma_f32_32x32x16_bf16(PAF(1),VFR(5),o[1],0,0,0), C0,12); \
    KRD(GL,2); GAPB(o[0]=__builtin_amdgcn_mfma_f32_32x32x16_bf16(PAF(2),VFR(2),o[0],0,0,0), C1,0); \
    KRD(GL,3); GAPB(o[1]=__builtin_amdgcn_mfma_f32_32x32x16_bf16(PAF(2),VFR(6),o[1],0,0,0), C1,4); \
    GAPB(o[0]=__builtin_amdgcn_mfma_f32_32x32x16_bf16(PAF(3),VFR(3),o[0],0,0,0), C1,8); \
    GAPB(o[1]=__builtin_amdgcn_mfma_f32_32x32x16_bf16(PAF(3),VFR(7),o[1],0,0,0), C1,12); \
    }while(0)
  int t=1;
  for(;t+5<NT;t+=2){
    STEP(pB0,pB1,pA0,pA1,t,true,true,true);     WAIT_BAR(2); RESC(); ROT();
    STEP(pA0,pA1,pB0,pB1,t+1,true,true,true);   WAIT_BAR(2); RESC(); ROT();
  }
  #define ENDW(tt) do{ if((tt)+3<NT){WAIT_BAR(2);} else if((tt)+2<NT){WAIT_BAR(1);} else {WAIT_BAR(0);} }while(0)
  for(;t+1<NT;t+=2){
    STEP(pB0,pB1,pA0,pA1,t,(t+3<NT),(t+1<NT),(t+1<NT));       ENDW(t);   RESC(); ROT();
    STEP(pA0,pA1,pB0,pB1,t+1,(t+4<NT),(t+2<NT),(t+2<NT));     ENDW(t+1); RESC(); ROT();
  }
  STEP(pB0,pB1,pA0,pA1,NT-1,false,false,false); RESC();
  { float sacc=pB0[0]+pB0[1]; _Pragma("unroll") for(int r=2;r<16;++r)sacc+=pB0[r]; _Pragma("unroll") for(int r=0;r<16;++r)sacc+=pB1[r]; l_reg+=sacc;
    pw0=(u32x4){PKW(pB0,0),PKW(pB0,2),PKW(pB0,4),PKW(pB0,6)};pw1=(u32x4){PKW(pB0,8),PKW(pB0,10),PKW(pB0,12),PKW(pB0,14)};pw2=(u32x4){PKW(pB1,0),PKW(pB1,2),PKW(pB1,4),PKW(pB1,6)};pw3=(u32x4){PKW(pB1,8),PKW(pB1,10),PKW(pB1,12),PKW(pB1,14)};
    SBAR(); pv(o,(int)(unsigned)(size_t)vp0+sl_cur,PAF(0),PAF(1),PAF(2),PAF(3)); }
  #undef PKW
  #undef PAF
  #undef VFR
  #undef PIN
  #undef MX3
  #undef GAPA
  #undef GAPB
  #undef EX
  #undef VRD
  #undef KRD
  #undef STEP
  #undef ENDW
  {auto rr=__builtin_amdgcn_permlane32_swap(__float_as_uint(l_reg),__float_as_uint(l_reg),false,false);l_reg=__uint_as_float(rr[0])+__uint_as_float(rr[1]);}
  if(hi==0)wsf[32+r32]=l_reg;asm volatile("s_waitcnt lgkmcnt(0)":::"memory");
  float rli[16];
  #pragma unroll
  for(int r=0;r<16;++r)rli[r]=__builtin_amdgcn_rcpf(wsf[32+crow(r,hi)]);
  bf16*Ow=O+(rowbase+q0+wid*QBLK)*OP+h*D;
  { bf16*stg=(bf16*)(shm+LDS_OST)+wid*2048;
    #pragma unroll
    for(int r=0;r<16;++r){const int orow=crow(r,hi);
      #pragma unroll
      for(int d0=0;d0<2;++d0)stg[orow*64+d0*32+r32]=__float2bfloat16(o[d0][r]*rli[r]);}
    asm volatile("s_waitcnt lgkmcnt(0)":::"memory");
    #pragma unroll
    for(int i=0;i<4;++i){const int row=i*8+(lane>>3),ch=lane&7; const u32x4 v=*(const u32x4*)(stg+row*64+ch*8); ATTN_STORE16(Ow+(long)row*OP+ch*8,v);} }
  asm volatile("s_waitcnt lgkmcnt(0)\n\ts_barrier":::"memory");
  #undef DMA_K
  #undef DMA_V
  #undef TI
  #undef CMASK
  #undef START
  #undef RESC
  #undef ROT
}
constexpr int ATTN_LDS_BYTES=LDS_BYTES;
#undef SBAR
#undef WAIT_BAR
}
#undef LAS
constexpr int NB = DEBUG_BUILD ? 2 : 8;
constexpr int M_ = NB * SEQ;
constexpr int NSLOT = 2 * M_ + N_EXP * 256;
constexpr int PLD = 3072;
constexpr int FQ = 0, FK = 384, FV = 768, FZ = 1152, FGU = 1536, FGV = 1792, FXBC = 2048, FDT = 2944;
constexpr int NGU = 2 * D_FF, NGUE = 2 * D_FFE;

constexpr size_t al256(size_t x) { return (x + 255) & ~(size_t)255; }
constexpr size_t MiB = 1u << 20;
constexpr size_t O_CTL = 0, CTL_BYTES = 1 * MiB;
constexpr size_t O_RT = 1 * MiB;
constexpr size_t O_TE = O_RT + (size_t)M_ * 64, O_TP = O_TE + (size_t)M_ * 8, O_TS = O_TP + (size_t)M_ * 8, O_GS = O_TS + (size_t)M_ * 8;
constexpr size_t O_SP = O_GS + (size_t)M_ * 8;
constexpr size_t O_KM = O_SP + al256((size_t)NSLOT * 4);
constexpr size_t O_DT = O_KM + (size_t)2 * NB * ATT_H * NBLK * 64 * 4;
constexpr size_t O_WSB = al256(O_DT + (size_t)M_ * 24);
constexpr size_t O_HB = (O_WSB + (size_t)2 * GM_G * GM_CHUNK * GM_CHUNK * 2 + MiB - 1) / MiB * MiB;
constexpr size_t O_MWGU = O_HB + (size_t)M_ * DM * 2;
constexpr size_t O_WIN = O_MWGU + (size_t)N_EXP * NGUE * DM * 2;
constexpr size_t O_WOUT = O_WIN + (size_t)2 * PLD * DM * 2;
constexpr size_t O_WGU = O_WOUT + (size_t)2 * DM * DM * 2;
constexpr size_t O_WD = O_WGU + (size_t)NGU * DM * 2;
constexpr size_t O_SCR = O_WD + (size_t)DM * D_FF * 2;
constexpr size_t O_PROJ = O_SCR;
constexpr size_t O_XC = O_PROJ + (size_t)M_ * PLD * 2;
constexpr size_t O_MIXU = O_XC + (size_t)M_ * SSD_CW * 2;
constexpr size_t O_MIXB = O_MIXU + (size_t)M_ * DM * 4;
constexpr size_t O_VN = O_MIXB + (size_t)M_ * DM * 2;
constexpr size_t O_MIXEND = O_VN + (size_t)M_ * GM_W * 4;
constexpr size_t O_Y = O_SCR;
constexpr size_t O_ACT = O_Y + (size_t)M_ * DM * 4;
constexpr size_t O_XG = O_WIN;
constexpr size_t O_ACTM = O_XG + (size_t)NSLOT * DM * 2;
constexpr size_t O_MOEEND = O_ACTM + (size_t)NSLOT * D_FFE * 2;
constexpr size_t WS_END = O_MOEEND > O_MIXEND ? O_MOEEND : O_MIXEND;
static_assert(O_ACT + (size_t)M_ * D_FF * 2 <= O_MIXEND + (size_t)M_ * 4096, "act");
static_assert((size_t)NB * 16 * SSD_H * 8192 * 4 <= (size_t)M_ * SSD_CW * 2, "SSD states fit in the XC slot");
static_assert((size_t)NB * 32 * 768 * 4 <= (size_t)M_ * GM_W * 4, "dt/acum hand-off fits in the VN slot");
static_assert(WS_END <= 487000000ull, "workspace map exceeds the guaranteed size");
static_assert((size_t)N_EXP * DM * D_FFE * 2 <= (size_t)NBATCH * SEQ * DM * 4, "MWD fits in d_out");
constexpr int CW_BAR = 4096, CW_CNT = 1024, CW_Q = 1040, CW_ERR = 2048;

constexpr int RING_BYTES = 131072, MISC_OFF = RING_BYTES + 320, LDS_BYTES = 147456;

#define GAS __attribute__((address_space(1)))
#define LAS __attribute__((address_space(3)))
typedef GAS unsigned gu32;
#define RLX_AGENT __ATOMIC_RELAXED, __HIP_MEMORY_SCOPE_AGENT
#define LDS_WAIT() asm volatile("s_waitcnt lgkmcnt(0)" ::: "memory")

constexpr float QSCALE = 0.125f * 1.4426950408889634f;
constexpr int TAIL_SLOTS = 16 * 256;
namespace fp {
using pg8::Unit; using pg8::BM; using pg8::HALF; typedef pg8::f32x4 f32x4; typedef pg8::u32x4 u32x4;
__device__ __forceinline__ unsigned pk2(float lo, float hi) { return pg8::cvt_pk_bf16(lo, hi); }
__device__ __forceinline__ float gelu_fast(float x) { const float u = 0.7978845608028654f * (x + 0.044715f * x * x * x); return x * __builtin_amdgcn_rcpf(1.f + __expf(-2.f * u)); }

struct EpiProj {
    static constexpr bool PERM = true, AFTER_DRAIN = false;
    bf16* O; const float* RT; float* KM2;
    __device__ __forceinline__ void operator()(const f32x4 (&acc)[2][2][4][2], const Unit& u, int wr, int wc, int fr, int fq) const {
        const int row0 = u.pm * BM + wr * 64 + fr, col0 = u.pn * BM + wc * 32 + 8 * fq;
        f32x4 ks[2][2];
#pragma unroll
        for (int i = 0; i < 2; ++i) { ks[i][0] = (f32x4){0.f, 0.f, 0.f, 0.f}; ks[i][1] = ks[i][0]; }
        const int mode = (u.pn < 3) ? 1 : ((u.pn == 6 || u.pn == 7) ? 2 : 0);
        const bool rl = ((wc & 1) == 0) && (fq < 2);
        const int i0 = (fq & 1) * 4;
#pragma unroll
        for (int ai = 0; ai < 2; ++ai) {
            float4 c4a[4], s4a[4];
#pragma unroll
            for (int i = 0; i < 4; ++i) { c4a[i] = make_float4(1.f, 1.f, 1.f, 1.f); s4a[i] = make_float4(0.f, 0.f, 0.f, 0.f); }
            if (mode == 1 && rl) {
#pragma unroll
                for (int i = 0; i < 4; ++i) { const int row = row0 + ai * HALF + i * 16; c4a[i] = *(const float4*)(RT + (size_t)row * 16 + i0); s4a[i] = *(const float4*)(RT + (size_t)row * 16 + 8 + i0); } }
#pragma unroll
            for (int m = 0; m < 4; ++m) { const int row = row0 + ai * HALF + m * 16;
                const float4 c4 = c4a[m], s4 = s4a[m];
#pragma unroll
                for (int bj = 0; bj < 2; ++bj) { f32x4 v0 = acc[ai][bj][m][0], v1 = acc[ai][bj][m][1];
                    if (mode == 1) { const f32x4 a = v0, b = v1;
                        v0[0] = a[0] * c4.x - a[1] * s4.x; v0[1] = a[1] * c4.x + a[0] * s4.x; v0[2] = a[2] * c4.y - a[3] * s4.y; v0[3] = a[3] * c4.y + a[2] * s4.y;
                        v1[0] = b[0] * c4.z - b[1] * s4.z; v1[1] = b[1] * c4.z + b[0] * s4.z; v1[2] = b[2] * c4.w - b[3] * s4.w; v1[3] = b[3] * c4.w + b[2] * s4.w; }
                    if (u.pn == 0 || (u.pn == 1 && bj == 0)) { v0 = v0 * QSCALE; v1 = v1 * QSCALE; }
                    else if (mode == 1) { ks[bj][0] += v0; ks[bj][1] += v1; }
                    if (mode == 2) {
#pragma unroll
                        for (int j = 0; j < 4; ++j) { v0[j] = gelu_fast(v0[j]); v1[j] = gelu_fast(v1[j]); } }
                    u32x4 w; w.x = pk2(v0[0], v0[1]); w.y = pk2(v0[2], v0[3]); w.z = pk2(v1[0], v1[1]); w.w = pk2(v1[2], v1[3]);
                    *(u32x4*)(O + (size_t)row * PLD + col0 + bj * HALF) = w; } } }
        if (u.pn == 1 || u.pn == 2) {
#pragma unroll
            for (int bj = 0; bj < 2; ++bj) { if (u.pn == 1 && bj == 0) continue;
#pragma unroll
                for (int n = 0; n < 2; ++n)
#pragma unroll
                    for (int j = 0; j < 4; ++j) { float x = ks[bj][n][j]; x += __shfl_xor(x, 1); x += __shfl_xor(x, 2); x += __shfl_xor(x, 4); x += __shfl_xor(x, 8); ks[bj][n][j] = x * (1.f / 256.f); }
                if (fr == 0) { const int kc = col0 + bj * HALF - FK; const int b = u.pm >> 3, nb = u.pm & 7;
                    float* dst = KM2 + (size_t)wr * (NB * ATT_H * NBLK * 64) + ((size_t)(b * ATT_H + (kc >> 6)) * NBLK + nb) * 64 + (kc & 63);
                    *(f32x4*)dst = ks[bj][0]; *(f32x4*)(dst + 4) = ks[bj][1]; } }
        }
    }
};
struct EpiAct {
    static constexpr bool PERM = true, AFTER_DRAIN = false;
    bf16* O; int ldc, ncol;
    __device__ __forceinline__ void operator()(const f32x4 (&acc)[2][2][4][2], const Unit& u, int wr, int wc, int fr, int fq) const {
        const int row0 = u.pm * BM + wr * 64 + fr, col0 = (u.pn % ncol) * HALF + wc * 32 + 8 * fq;
#pragma unroll
        for (int ai = 0; ai < 2; ++ai)
#pragma unroll
            for (int m = 0; m < 4; ++m) { const int row = row0 + ai * HALF + m * 16;
                const f32x4 g0 = acc[ai][0][m][0], g1 = acc[ai][0][m][1], u0 = acc[ai][1][m][0], u1 = acc[ai][1][m][1]; f32x4 a0, a1;
#pragma unroll
                for (int j = 0; j < 4; ++j) { a0[j] = g0[j] * __builtin_amdgcn_rcpf(1.f + __expf(-g0[j])) * u0[j]; a1[j] = g1[j] * __builtin_amdgcn_rcpf(1.f + __expf(-g1[j])) * u1[j]; }
                u32x4 w; w.x = pk2(a0[0], a0[1]); w.y = pk2(a0[2], a0[3]); w.z = pk2(a1[0], a1[1]); w.w = pk2(a1[2], a1[3]);
                *(u32x4*)(O + (size_t)row * ldc + col0) = w; }
    }
};
struct EpiF32 {
    static constexpr bool PERM = false, AFTER_DRAIN = false;
    float* O; int ldc;
    __device__ __forceinline__ void operator()(const f32x4 (&acc)[2][2][4][2], const Unit& u, int wr, int wc, int fr, int fq) const {
        const int row0 = u.pm * BM + wr * 64 + fr, col0 = u.pn * BM + wc * 32 + 4 * fq;
#pragma unroll
        for (int ai = 0; ai < 2; ++ai)
#pragma unroll
            for (int m = 0; m < 4; ++m) { float* rp = O + (size_t)(row0 + ai * HALF + m * 16) * ldc + col0;
#pragma unroll
                for (int bj = 0; bj < 2; ++bj)
#pragma unroll
                    for (int n = 0; n < 2; ++n) *(f32x4*)(rp + bj * HALF + n * 16) = acc[ai][bj][m][n]; }
    }
};
struct EpiY {
    static constexpr bool PERM = true, AFTER_DRAIN = false;
    bf16* O; int ldc;
    __device__ __forceinline__ void operator()(const f32x4 (&acc)[2][2][4][2], const Unit& u, int wr, int wc, int fr, int fq) const {
        const int row0 = u.pm * BM + wr * 64 + fr, col0 = u.pn * BM + wc * 32 + 8 * fq;
#pragma unroll
        for (int ai = 0; ai < 2; ++ai)
#pragma unroll
            for (int m = 0; m < 4; ++m) { bf16* rp = O + (size_t)(row0 + ai * HALF + m * 16) * ldc + col0;
#pragma unroll
                for (int bj = 0; bj < 2; ++bj) { const f32x4 v0 = acc[ai][bj][m][0], v1 = acc[ai][bj][m][1];
                    u32x4 w; w.x = pk2(v0[0], v0[1]); w.y = pk2(v0[2], v0[3]); w.z = pk2(v1[0], v1[1]); w.w = pk2(v1[2], v1[3]);
                    *(u32x4*)(rp + bj * HALF) = w; } }
    }
};
struct EpiF2 {
    static constexpr bool PERM = true, AFTER_DRAIN = false;
    bf16* O; const float* SP; bf16* FP; int slot0, klen;
    __device__ __forceinline__ void operator()(const f32x4 (&acc)[2][2][4][2], const Unit& u, int wr, int wc, int fr, int fq) const {
        const int row0 = u.pm * BM + wr * 64 + fr, col0 = (u.pn & 3) * BM + wc * 32 + 8 * fq;
        bf16* base = O; int rsub = 0;
        if (u.kofs > 0) { const int part = u.kofs / klen; base = FP + (size_t)(part - 1) * TAIL_SLOTS * DM; rsub = slot0; }
        float spv[8];
#pragma unroll
        for (int i = 0; i < 8; ++i) spv[i] = SP[row0 + (i >> 2) * HALF + (i & 3) * 16];
#pragma unroll
        for (int ai = 0; ai < 2; ++ai)
#pragma unroll
            for (int m = 0; m < 4; ++m) { const int row = row0 + ai * HALF + m * 16; const float sc = spv[ai * 4 + m];
#pragma unroll
                for (int bj = 0; bj < 2; ++bj) { const f32x4 v0 = acc[ai][bj][m][0] * sc, v1 = acc[ai][bj][m][1] * sc;
                    u32x4 w; w.x = pk2(v0[0], v0[1]); w.y = pk2(v0[2], v0[3]); w.z = pk2(v1[0], v1[1]); w.w = pk2(v1[2], v1[3]);
                    *(u32x4*)(base + (size_t)(row - rsub) * DM + col0 + bj * HALF) = w; } }
    }
};
static_assert(NGUE / 256 == 28 && DM / 256 == 4, "MoeOrder::next decodes units for 28 or 4 column tiles");
struct MoeOrder {
    int p0, p1, p2, p3, p4, p5, p6, T, ncol, G, c, nfull, ksplit, klen;
    __device__ __forceinline__ void init(const int* CNT, int ncol_, int G_, int c_) {
        int t = 0; t += (CNT[0] + 255) >> 8; p0 = t; t += (CNT[1] + 255) >> 8; p1 = t; t += (CNT[2] + 255) >> 8; p2 = t; t += (CNT[3] + 255) >> 8; p3 = t;
        t += (CNT[4] + 255) >> 8; p4 = t; t += (CNT[5] + 255) >> 8; p5 = t; t += (CNT[6] + 255) >> 8; p6 = t; t += (CNT[7] + 255) >> 8; T = t; ncol = ncol_; G = G_; c = c_;
        nfull = T * ncol; ksplit = 1; klen = 0;
    }
    __device__ __forceinline__ int tail_start() const { const int tot = T * ncol, nf = (tot / G) * G; return (tot - nf <= 64) ? nf : tot; }
    __device__ __forceinline__ bool next(int i, Unit& u) const {
        int L = i * G + c; int part = 0;
        if (ksplit == 1) { if (L >= nfull) return false; }
        else { if (L >= (T * ncol - nfull) * 4) return false; part = L & 3; L = nfull + (L >> 2); }
        const int tm = (ncol == 4) ? (L >> 2) : (int)((unsigned)L / 28u), j = L - tm * ncol;
        const int e = (tm >= p0) + (tm >= p1) + (tm >= p2) + (tm >= p3) + (tm >= p4) + (tm >= p5) + (tm >= p6);
        u.pm = tm; u.pn = e * ncol + j; u.kofs = part * klen; return true;
    }
    __device__ __forceinline__ void a_ready(const Unit&) const {}
    __device__ __forceinline__ void done(const Unit&) const {}
};

struct SrcCol { const float* p; int ld; };
__device__ __forceinline__ int win_src_col(int d) {
    if (d < 768) { const int hd = d & 63; const int sd = hd < 16 ? ((hd & 1) ? 8 + (hd >> 1) : (hd >> 1)) : hd; return d - hd + sd; }
    if (d < 1536) return d;
    if (d < 1792) return 2438 + (d - 1536);
    if (d < 2048) return 2694 + (d - 1792);
    if (d < 2944) return 1536 + (d - 2048);
    if (d < 2950) return 2432 + (d - 2944);
    return -1;
}
__device__ __forceinline__ SrcCol gu_src(const float* wg, const float* wu, int nff, int r) {
    const int tile = r >> 8, rr = r & 255, j = tile * 128 + (rr & 127); SrcCol s; s.p = (rr < 128 ? wg : wu) + j; s.ld = nff; return s;
}
__device__ __forceinline__ void conv_item(SrcCol sc, int K, bf16* WT, long d0, int k0, LAS float* scr, int lane) {
    float tv[32];
#pragma unroll
    for (int i = 0; i < 32; ++i) { const int kk = 2 * i + (lane >> 5); tv[i] = sc.p ? __builtin_nontemporal_load(sc.p + (size_t)(k0 + kk) * sc.ld) : 0.f; }
#pragma unroll
    for (int i = 0; i < 32; ++i) { const int kk = 2 * i + (lane >> 5); scr[kk * 33 + (lane & 31)] = tv[i]; }
    LDS_WAIT(); asm volatile("" ::: "memory");
    const int c = lane & 7;
#pragma unroll
    for (int j = 0; j < 4; ++j) { const int n = (lane >> 3) + 8 * j; const LAS float* s = scr + (8 * c) * 33 + n;
        u32x4 o; o.x = pk2(s[0 * 33], s[1 * 33]); o.y = pk2(s[2 * 33], s[3 * 33]); o.z = pk2(s[4 * 33], s[5 * 33]); o.w = pk2(s[6 * 33], s[7 * 33]);
        __builtin_nontemporal_store(o, (u32x4*)(WT + (size_t)(d0 + n) * K + k0 + 8 * c)); }
    LDS_WAIT(); asm volatile("" ::: "memory");
}
}


typedef short bf16x8_t __attribute__((ext_vector_type(8)));
typedef float f32x4_t __attribute__((ext_vector_type(4)));
constexpr int TLD = 272;
__device__ __forceinline__ bf16x8_t lds_frag(const LAS unsigned char* base, int row, int kbyte) { return *(const LAS bf16x8_t*)(base + row * TLD + kbyte); }
__device__ __forceinline__ float red16(float v) { return row16_sum(v); }

__device__ __forceinline__ void gm_unit(int b, int c, const bf16* PROJ, const bf16* WSB  , const float* ln_g, const float* ln_b, const float* b_s, const float* norm_g,
                                        bf16* MIXB, LAS unsigned char* lds, int wave, int lane) {
    const long r0 = (long)b * SEQ + c * GM_CHUNK;
    LAS unsigned char* VNT = lds;
    { float4 vv[16];
#pragma unroll
      for (int i = 0; i < 16; ++i) vv[i] = ld4(PROJ + (r0 + wave * 16 + i) * PLD + FGV + lane * 4);
      const float4 gg = *(const float4*)(ln_g + lane * 4), bb = *(const float4*)(ln_b + lane * 4);
#pragma unroll
      for (int i = 0; i < 16; ++i) { const int t = wave * 16 + i; const float4 v = vv[i];
        const float mean = wave_sum((v.x + v.y) + (v.z + v.w)) * (1.f / 256.f);
        const float d0 = v.x - mean, d1 = v.y - mean, d2 = v.z - mean, d3 = v.w - mean;
        const float rstd = rsqrtf(wave_sum((d0 * d0 + d1 * d1) + (d2 * d2 + d3 * d3)) * (1.f / 256.f) + 1e-5f);
        LAS bf16* dst = (LAS bf16*)(VNT + (lane * 4) * TLD) + t;
        dst[0] = (bf16)f2bf(d0 * rstd * gg.x + bb.x); dst[TLD / 2] = (bf16)f2bf(d1 * rstd * gg.y + bb.y); dst[TLD] = (bf16)f2bf(d2 * rstd * gg.z + bb.z); dst[3 * TLD / 2] = (bf16)f2bf(d3 * rstd * gg.w + bb.w); } }
    __syncthreads();
    f32x4_t acc[16];
#pragma unroll
    for (int i = 0; i < 16; ++i) acc[i] = (f32x4_t){0.f, 0.f, 0.f, 0.f};
    const int fr = lane & 15, fq = lane >> 4;
    const int nks = (wave * 16 + 15) / 32 + 1;
    for (int ks = 0; ks < nks; ++ks) {
#pragma unroll
        for (int g = 0; g < 4; ++g) {
            const bf16x8_t af = *(const bf16x8_t*)(WSB + ((size_t)g * GM_CHUNK + wave * 16 + fr) * GM_CHUNK + ks * 32 + fq * 8);
#pragma unroll
            for (int n = 0; n < 4; ++n) { const bf16x8_t bfv = lds_frag(VNT, g * 64 + n * 16 + fr, ks * 64 + fq * 16);
                acc[g * 4 + n] = __builtin_amdgcn_mfma_f32_16x16x32_bf16(af, bfv, acc[g * 4 + n], 0, 0, 0); }
        }
    }
    __syncthreads();
    LAS bf16* ost = (LAS bf16*)(lds + wave * (16 * 264 * 2));
    float ss[4] = {0.f, 0.f, 0.f, 0.f};
#pragma unroll
    for (int nt = 0; nt < 16; ++nt) { const int col = nt * 16 + fr, g = nt >> 2;
#pragma unroll
        for (int r = 0; r < 4; ++r) { const int t = wave * 16 + fq * 4 + r;
            const float u = ldf(PROJ + (r0 + t) * PLD + FGU + col);
            const float o = u * (acc[nt][r] + b_s[g * GM_CHUNK + t]); acc[nt][r] = o; ss[r] += o * o; } }
#pragma unroll
    for (int r = 0; r < 4; ++r) ss[r] = rsqrtf(red16(ss[r]) * (1.f / 256.f) + 1e-5f);
#pragma unroll
    for (int nt = 0; nt < 16; ++nt) { const int col = nt * 16 + fr; const float gn = norm_g[col];
#pragma unroll
        for (int r = 0; r < 4; ++r) { ost[(fq * 4 + r) * 264 + col] = (bf16)f2bf(acc[nt][r] * ss[r] * gn); } }
    LDS_WAIT(); asm volatile("" ::: "memory");
#pragma unroll
    for (int i = 0; i < 8; ++i) { const int rr = i * 2 + (lane >> 5), ch = lane & 31;
        const fp::u32x4 v = *(const LAS fp::u32x4*)(ost + rr * 264 + ch * 8);
        *(fp::u32x4*)(MIXB + (r0 + wave * 16 + rr) * DM + ATT_W + SSD_W + ch * 8) = v; }
    __syncthreads();
}

typedef short v4i16_t __attribute__((ext_vector_type(4)));
typedef unsigned u32x2_t __attribute__((ext_vector_type(2)));
__device__ __forceinline__ v4i16_t lds_tr(const LAS unsigned char* p) { return __builtin_amdgcn_ds_read_tr16_b64_v4i16((LAS v4i16_t*)p); }
__device__ __forceinline__ bf16x8_t lds_frag_tr(const LAS unsigned char* tile, int pitch, int k0, int c0, int lane) {
    const int kg = lane >> 4, q = (lane & 15) >> 2, p = lane & 3;
    const LAS unsigned char* a = tile + (k0 + 8 * kg + q) * pitch + (c0 + 4 * p) * 2;
    const v4i16_t lo = lds_tr(a), hi = lds_tr(a + 4 * pitch);
    return (bf16x8_t){lo[0], lo[1], lo[2], lo[3], hi[0], hi[1], hi[2], hi[3]};
}
__device__ __forceinline__ bf16x8_t lds_frag_p(const LAS unsigned char* base, int pitch, int row, int kbyte) { return *(const LAS bf16x8_t*)(base + row * pitch + kbyte); }
template <int NCH, bool SCALE, bool TOLDS> __device__ __forceinline__ void conv_rows(const bf16* PROJ, long r0, int t0, int colbase, int ch0, const float* cw, const float* cb, LAS unsigned char* tile, int pitch,
                                                                                       const LAS float* scl, bf16* XCg  , int tid) {
    constexpr int CPR = NCH / 8, RG = 512 / CPR, RPT = (128 + RG - 1) / RG;
    if (tid < CPR * RG) { const int ch = (tid % CPR) * 8, l0 = (tid / CPR) * RPT;
        float w[4][8], bs[8];
        { const float4 c0 = *(const float4*)(cb + ch0 + ch), c1 = *(const float4*)(cb + ch0 + ch + 4); bs[0] = c0.x; bs[1] = c0.y; bs[2] = c0.z; bs[3] = c0.w; bs[4] = c1.x; bs[5] = c1.y; bs[6] = c1.z; bs[7] = c1.w; }
#pragma unroll
        for (int i = 0; i < 4; ++i) { const float4 w0 = *(const float4*)(cw + i * SSD_CW + ch0 + ch), w1 = *(const float4*)(cw + i * SSD_CW + ch0 + ch + 4);
            w[i][0] = w0.x; w[i][1] = w0.y; w[i][2] = w0.z; w[i][3] = w0.w; w[i][4] = w1.x; w[i][5] = w1.y; w[i][6] = w1.z; w[i][7] = w1.w; }
        fp::u32x4 xr[RPT + 3];
#pragma unroll
        for (int j = 0; j < RPT + 3; ++j) { const int l = l0 - 3 + j; xr[j] = (fp::u32x4){0u, 0u, 0u, 0u};
            if (l < 128 && t0 + l >= 0) xr[j] = *(const fp::u32x4*)(PROJ + (r0 + l) * PLD + colbase + ch); }
#pragma unroll
        for (int j = 0; j < RPT; ++j) { const int l = l0 + j; if (l < 128) {
            float a[8];
#pragma unroll
            for (int e = 0; e < 8; ++e) a[e] = bs[e];
#pragma unroll
            for (int i = 0; i < 4; ++i) { const fp::u32x4 xv = xr[j + i];
#pragma unroll
                for (int e = 0; e < 4; ++e) { a[2 * e] += w[i][2 * e] * __uint_as_float(xv[e] << 16); a[2 * e + 1] += w[i][2 * e + 1] * __uint_as_float(xv[e] & 0xffff0000u); } }
#pragma unroll
            for (int e = 0; e < 8; ++e) a[e] = a[e] * __builtin_amdgcn_rcpf(1.f + __expf(-a[e]));
            fp::u32x4 o; o.x = fp::pk2(a[0], a[1]); o.y = fp::pk2(a[2], a[3]); o.z = fp::pk2(a[4], a[5]); o.w = fp::pk2(a[6], a[7]);
            *(fp::u32x4*)(XCg + (r0 + l) * SSD_CW + ch) = o;
            if (TOLDS) { if (SCALE) { const float sc = scl[(ch >> 6) * 128 + l]; o.x = fp::pk2(a[0] * sc, a[1] * sc); o.y = fp::pk2(a[2] * sc, a[3] * sc); o.z = fp::pk2(a[4] * sc, a[5] * sc); o.w = fp::pk2(a[6] * sc, a[7] * sc); }
                *(LAS fp::u32x4*)(tile + l * pitch + ch * 2) = o; } } }
    }
}
template <int NCH> __device__ __forceinline__ void load_xc_tile(const bf16* XCg, long r0, LAS unsigned char* tile, int pitch, int tid) {
    constexpr int CPR = NCH / 8;
    for (int it = tid; it < 128 * CPR; it += 512) { const int l = it / CPR, ch = (it % CPR) * 8;
        *(LAS fp::u32x4*)(tile + l * pitch + ch * 2) = *(const fp::u32x4*)(XCg + (r0 + l) * SSD_CW + ch); }
}
__device__ __forceinline__ void ssd_dt_acum(const bf16* PROJ, long r0, int g, const float* dt_bias, const float* a_log, LAS float* dtS, LAS float* acS, int tid, int wave, int lane) {
    if (tid < 384) { const int hh = tid >> 7, l = tid & 127, h = 3 * g + hh;
        const float dtv = softplus_f(ldf(PROJ + (r0 + l) * PLD + FDT + h) + dt_bias[h]); dtS[tid] = dtv; acS[tid] = dtv * (-__expf(a_log[h])); }
    __syncthreads();
    if (wave < 3) { const float a0 = acS[wave * 128 + 2 * lane], a1 = acS[wave * 128 + 2 * lane + 1]; const float sm = a0 + a1; float v = sm;
#pragma unroll
        for (int o = 1; o < 64; o <<= 1) { const float t = __shfl_up(v, o); if (lane >= o) v += t; }
        const float ex = v - sm; acS[wave * 128 + 2 * lane] = ex + a0; acS[wave * 128 + 2 * lane + 1] = ex + sm; }
    __syncthreads();
}
constexpr int XP = 400;
__device__ __forceinline__ void ssdA_unit(int b, int c, int g, const bf16* PROJ, const float* cw, const float* cb, const float* dt_bias, const float* a_log, float* ST, float* CD, bf16* XC, float* DTG,
                                          LAS unsigned char* lds, int tid, int wave, int lane) {
    asm volatile("" : "+v"(tid), "+v"(lane));
    const long r0 = (long)b * SEQ + c * 128; const int t0 = c * 128;
    LAS unsigned char* XS = lds; LAS unsigned char* BS = lds + 51200;
    LAS float* dtS = (LAS float*)(lds + 86016); LAS float* acS = dtS + 384; LAS float* sclS = acS + 384;
    ssd_dt_acum(PROJ, r0, g, dt_bias, a_log, dtS, acS, tid, wave, lane);
    if (tid < 384) { const int hh = tid >> 7; const float al = acS[hh * 128 + 127]; sclS[tid] = dtS[tid] * __expf(al - acS[tid]);
        float* dg = DTG + (((long)b * 16 + c) * 2 + g) * 768; dg[tid] = dtS[tid]; dg[384 + tid] = acS[tid];
        if ((tid & 127) == 0) CD[((long)b * 16 + c) * SSD_H + 3 * g + hh] = __expf(al); }
    __syncthreads();
    conv_rows<192, true, true>(PROJ, r0, t0, FXBC + 192 * g, 192 * g, cw, cb, XS, XP, sclS, XC + 192 * g, tid);
    conv_rows<128, false, true>(PROJ, r0, t0, FXBC + SSD_W + 128 * g, SSD_W + 128 * g, cw, cb, BS, TLD, nullptr, XC + SSD_W + 128 * g, tid);
    conv_rows<128, false, false>(PROJ, r0, t0, FXBC + SSD_W + 256 + 128 * g, SSD_W + 256 + 128 * g, cw, cb, nullptr, 0, nullptr, XC + SSD_W + 256 + 128 * g, tid);
    __syncthreads();
    f32x4_t acc[12];
#pragma unroll
    for (int i = 0; i < 12; ++i) acc[i] = (f32x4_t){0.f, 0.f, 0.f, 0.f};
#pragma unroll 1
    for (int ks = 0; ks < 4; ++ks) { const bf16x8_t bfv = lds_frag_tr(BS, TLD, ks * 32, 16 * wave, lane);
#pragma unroll
        for (int mt = 0; mt < 12; ++mt) { const bf16x8_t af = lds_frag_tr(XS, XP, ks * 32, (mt >> 2) * 64 + (mt & 3) * 16, lane); acc[mt] = __builtin_amdgcn_mfma_f32_16x16x32_bf16(af, bfv, acc[mt], 0, 0, 0); } }
    const int fr = lane & 15, fq = lane >> 4;
    float* sp = ST + (((long)b * 16 + c) * SSD_H + 3 * g) * 8192 + 16 * wave + fr;
#pragma unroll
    for (int mt = 0; mt < 12; ++mt)
#pragma unroll
        for (int r = 0; r < 4; ++r) sp[(mt >> 2) * 8192 + ((mt & 3) * 16 + 4 * fq + r) * 128] = acc[mt][r];
    __syncthreads();
}
__device__ __forceinline__ void ssdB_unit(int b, int c, int g, const bf16* PROJ, const bf16* XC, const float* DTG, const float* dsk, const float* ng,
                                          const float* ST, const float* CD, bf16* MIXB, LAS unsigned char* lds, int tid, int wave, int lane) {
    const long r0 = (long)b * SEQ + c * 128;
    LAS unsigned char* CS = lds; LAS unsigned char* PX = lds + 34816; LAS unsigned char* BG = lds + 87040;
    LAS float* dtS = (LAS float*)(lds + 121856); LAS float* acS = dtS + 384;
    const int fr = lane & 15, fq = lane >> 4;
    if (tid < 384) { const float* dg = DTG + (((long)b * 16 + c) * 2 + g) * 768; dtS[tid] = dg[tid]; acS[tid] = dg[384 + tid]; }
    load_xc_tile<128>(XC + SSD_W + 256 + 128 * g, r0, CS, TLD, tid);
    if (c > 0) {
        float4 pv[12];
#pragma unroll
        for (int i = 0; i < 12; ++i) pv[i] = make_float4(0.f, 0.f, 0.f, 0.f);
        const float* sbase = ST + ((long)b * 16 * SSD_H + 3 * g) * 8192 + tid * 4; const float* cbase = CD + (long)b * 16 * SSD_H + 3 * g;
        int j = 0;
        for (; j + 2 < c; j += 3) { const float* s0 = sbase + (long)j * SSD_H * 8192; const float* c0 = cbase + j * SSD_H;
            float4 v0[12], v1[12], v2[12];
#pragma unroll
            for (int i = 0; i < 12; ++i) { v0[i] = *(const float4*)(s0 + i * 2048); v1[i] = *(const float4*)(s0 + SSD_H * 8192 + i * 2048); v2[i] = *(const float4*)(s0 + 2 * SSD_H * 8192 + i * 2048); }
            float dd[3][3];
#pragma unroll
            for (int q = 0; q < 3; ++q) { dd[q][0] = c0[q * SSD_H]; dd[q][1] = c0[q * SSD_H + 1]; dd[q][2] = c0[q * SSD_H + 2]; }
#pragma unroll
            for (int i = 0; i < 12; ++i) { const int hq = i >> 2;
                pv[i].x = ((pv[i].x * dd[0][hq] + v0[i].x) * dd[1][hq] + v1[i].x) * dd[2][hq] + v2[i].x;
                pv[i].y = ((pv[i].y * dd[0][hq] + v0[i].y) * dd[1][hq] + v1[i].y) * dd[2][hq] + v2[i].y;
                pv[i].z = ((pv[i].z * dd[0][hq] + v0[i].z) * dd[1][hq] + v1[i].z) * dd[2][hq] + v2[i].z;
                pv[i].w = ((pv[i].w * dd[0][hq] + v0[i].w) * dd[1][hq] + v1[i].w) * dd[2][hq] + v2[i].w; } }
        for (; j < c; ++j) { const float* s0 = sbase + (long)j * SSD_H * 8192; const float* c0 = cbase + j * SSD_H; const float d0 = c0[0], d1 = c0[1], d2 = c0[2];
#pragma unroll
            for (int i = 0; i < 12; ++i) { const float4 sv = *(const float4*)(s0 + i * 2048); const float d = (i < 4) ? d0 : ((i < 8) ? d1 : d2);
                pv[i].x = pv[i].x * d + sv.x; pv[i].y = pv[i].y * d + sv.y; pv[i].z = pv[i].z * d + sv.z; pv[i].w = pv[i].w * d + sv.w; } }
#pragma unroll
        for (int i = 0; i < 12; ++i) { const int row = (i >> 2) * 64 + (i & 3) * 16 + (tid >> 5), n = (tid & 31) * 4;
            u32x2_t w; w.x = fp::pk2(pv[i].x, pv[i].y); w.y = fp::pk2(pv[i].z, pv[i].w); *(LAS u32x2_t*)(PX + row * TLD + n * 2) = w; }
    }
    __syncthreads();
    f32x4_t acc_y[12];
#pragma unroll
    for (int i = 0; i < 12; ++i) acc_y[i] = (f32x4_t){0.f, 0.f, 0.f, 0.f};
    if (c > 0) {
#pragma unroll 1
        for (int ks = 0; ks < 4; ++ks) { const bf16x8_t af = lds_frag_p(CS, TLD, 16 * wave + fr, ks * 64 + fq * 16);
#pragma unroll
            for (int t = 0; t < 12; ++t) { const bf16x8_t bfv = lds_frag_p(PX, TLD, (t >> 2) * 64 + (t & 3) * 16 + fr, ks * 64 + fq * 16); acc_y[t] = __builtin_amdgcn_mfma_f32_16x16x32_bf16(af, bfv, acc_y[t], 0, 0, 0); } }
#pragma unroll
        for (int t = 0; t < 12; ++t)
#pragma unroll
            for (int r = 0; r < 4; ++r) acc_y[t][r] *= __expf(acS[(t >> 2) * 128 + 16 * wave + 4 * fq + r]);
    }
    __syncthreads();
    load_xc_tile<192>(XC + 192 * g, r0, PX, XP, tid);
    load_xc_tile<128>(XC + SSD_W + 128 * g, r0, BG, TLD, tid);
    __syncthreads();
#if defined(SSDB_CUT) && SSDB_CUT == 2
    { float t_ = 0.f; for (int i = 0; i < 12; ++i) t_ += acc_y[i][0] + acc_y[i][1] + acc_y[i][2] + acc_y[i][3]; if (t_ == 123.f) MIXB[0] = 1; return; }
#endif
    f32x4_t acc_cb[8];
#pragma unroll
    for (int i = 0; i < 8; ++i) acc_cb[i] = (f32x4_t){0.f, 0.f, 0.f, 0.f};
#pragma unroll 1
    for (int ks = 0; ks < 4; ++ks) { const bf16x8_t af = lds_frag_p(CS, TLD, 16 * wave + fr, ks * 64 + fq * 16);
#pragma unroll
        for (int ns = 0; ns < 8; ++ns) if (ns <= wave) { const bf16x8_t bfv = lds_frag_p(BG, TLD, 16 * ns + fr, ks * 64 + fq * 16); acc_cb[ns] = __builtin_amdgcn_mfma_f32_16x16x32_bf16(af, bfv, acc_cb[ns], 0, 0, 0); } }
    __syncthreads();
    LAS unsigned char* GS = BG + wave * 16 * TLD;
    const int nks = (16 * wave + 15) / 32 + 1;
#pragma unroll
    for (int hh = 0; hh < 3; ++hh) {
#pragma unroll
        for (int ns = 0; ns < 8; ++ns) if (ns <= (wave | 1)) {
#pragma unroll
            for (int r = 0; r < 4; ++r) { const int l = 16 * wave + 4 * fq + r, sidx = 16 * ns + fr;
                const float gv = (ns <= wave && sidx <= l) ? acc_cb[ns][r] * __expf(acS[hh * 128 + l] - acS[hh * 128 + sidx]) * dtS[hh * 128 + sidx] : 0.f;
                *(LAS bf16*)(GS + (4 * fq + r) * TLD + sidx * 2) = (bf16)f2bf(gv); } }
        LDS_WAIT(); asm volatile("" ::: "memory");
#pragma unroll 1
        for (int ks = 0; ks < nks; ++ks) { const bf16x8_t af = lds_frag_p(GS, TLD, fr, ks * 64 + fq * 16);
#pragma unroll
            for (int np = 0; np < 4; ++np) { const bf16x8_t bfv = lds_frag_tr(PX, XP, ks * 32, hh * 64 + np * 16, lane); acc_y[hh * 4 + np] = __builtin_amdgcn_mfma_f32_16x16x32_bf16(af, bfv, acc_y[hh * 4 + np], 0, 0, 0); } }
        LDS_WAIT(); asm volatile("" ::: "memory");
    }
#if defined(SSDB_CUT) && SSDB_CUT == 1
    { float t_ = 0.f; for (int i = 0; i < 12; ++i) t_ += acc_y[i][0] + acc_y[i][1] + acc_y[i][2] + acc_y[i][3]; if (t_ == 123.f) MIXB[0] = 1; return; }
#endif
#pragma unroll
    for (int t = 0; t < 12; ++t) { const int hh = t >> 2, col = hh * 64 + (t & 3) * 16 + fr; const float dk = dsk[3 * g + hh];
#pragma unroll
        for (int r = 0; r < 4; ++r) { const int l = 16 * wave + 4 * fq + r; acc_y[t][r] += dk * __uint_as_float(((unsigned)*(const LAS bf16*)(PX + l * XP + col * 2)) << 16); } }
    __syncthreads();
    LAS bf16* ost = (LAS bf16*)(lds + wave * (16 * XP));
#pragma unroll
    for (int t = 0; t < 12; ++t) { const int col = (t >> 2) * 64 + (t & 3) * 16 + fr;
#pragma unroll
        for (int r = 0; r < 4; ++r) ost[(4 * fq + r) * (XP / 2) + col] = (bf16)f2bf(acc_y[t][r]); }
    LDS_WAIT(); asm volatile("" ::: "memory");
    { const int rr = lane >> 2, q = lane & 3; const long row = r0 + 16 * wave + rr;
      float yz[48]; float ssum = 0.f;
#pragma unroll
      for (int i = 0; i < 6; ++i) { const int c8 = (q * 6 + i) * 8;
          const fp::u32x4 yv = *(const LAS fp::u32x4*)(ost + rr * (XP / 2) + c8);
          const fp::u32x4 zv = *(const fp::u32x4*)(PROJ + row * PLD + FZ + 192 * g + c8);
#pragma unroll
          for (int j = 0; j < 4; ++j) { const unsigned yw = yv[j], zw = zv[j];
              const float y0 = __uint_as_float(yw << 16), y1 = __uint_as_float(yw & 0xffff0000u), z0 = __uint_as_float(zw << 16), z1 = __uint_as_float(zw & 0xffff0000u);
              const float a0 = y0 * (z0 * __builtin_amdgcn_rcpf(1.f + __expf(-z0))), a1 = y1 * (z1 * __builtin_amdgcn_rcpf(1.f + __expf(-z1))); yz[i * 8 + 2 * j] = a0; yz[i * 8 + 2 * j + 1] = a1; ssum += a0 * a0 + a1 * a1; } }
      ssum += __shfl_xor(ssum, 1); ssum += __shfl_xor(ssum, 2);
      const float rinv = rsqrtf(ssum * (1.f / 192.f) + 1e-5f);
#pragma unroll
      for (int i = 0; i < 6; ++i) { const int c8 = (q * 6 + i) * 8;
          const float4 g0 = *(const float4*)(ng + 192 * g + c8), g1 = *(const float4*)(ng + 192 * g + c8 + 4);
          fp::u32x4 o; o.x = fp::pk2(yz[i * 8] * rinv * g0.x, yz[i * 8 + 1] * rinv * g0.y); o.y = fp::pk2(yz[i * 8 + 2] * rinv * g0.z, yz[i * 8 + 3] * rinv * g0.w);
          o.z = fp::pk2(yz[i * 8 + 4] * rinv * g1.x, yz[i * 8 + 5] * rinv * g1.y); o.w = fp::pk2(yz[i * 8 + 6] * rinv * g1.z, yz[i * 8 + 7] * rinv * g1.w);
          *(fp::u32x4*)(MIXB + row * DM + ATT_W + 192 * g + c8) = o; } }
    __syncthreads();
}

__device__ __forceinline__ void att_norm_phase(bf16* MIXB, const float* g, long n_rows, int gw_, int ngw_, int lane) {
    float4 g0 = make_float4(0.f, 0.f, 0.f, 0.f), g1 = g0; if (lane < 48) { g0 = *(const float4*)(g + lane * 8); g1 = *(const float4*)(g + lane * 8 + 4); }
    fp::u32x4 wa = (fp::u32x4){0u, 0u, 0u, 0u}, wb = wa; long r = gw_;
    if (r < n_rows && lane < 48) wa = *(const fp::u32x4*)(MIXB + r * DM + lane * 8);
#define ATTN_NORM_ROW(WV_, rr) do { float v[8]; float s2 = 0.f; \
        _Pragma("unroll") for (int j = 0; j < 4; ++j) { v[2 * j] = __uint_as_float(WV_[j] << 16); v[2 * j + 1] = __uint_as_float(WV_[j] & 0xffff0000u); s2 += v[2 * j] * v[2 * j] + v[2 * j + 1] * v[2 * j + 1]; } \
        const float rs = rsqrtf(wave_sum(s2) * (1.f / 384.f) + 1e-5f); \
        if (lane < 48) { fp::u32x4 o; o.x = fp::pk2(v[0] * rs * g0.x, v[1] * rs * g0.y); o.y = fp::pk2(v[2] * rs * g0.z, v[3] * rs * g0.w); o.z = fp::pk2(v[4] * rs * g1.x, v[5] * rs * g1.y); o.w = fp::pk2(v[6] * rs * g1.z, v[7] * rs * g1.w); \
            *(fp::u32x4*)(MIXB + (rr) * DM + lane * 8) = o; } } while (0)
    for (; r < n_rows; r += 2 * ngw_) { const long r1 = r + ngw_, r2 = r + 2 * ngw_;
        if (r1 < n_rows && lane < 48) wb = *(const fp::u32x4*)(MIXB + r1 * DM + lane * 8);
        ATTN_NORM_ROW(wa, r);
        if (r2 < n_rows && lane < 48) wa = *(const fp::u32x4*)(MIXB + r2 * DM + lane * 8);
        if (r1 < n_rows) ATTN_NORM_ROW(wb, r1); }
#undef ATTN_NORM_ROW
}

constexpr int FT_G = 16 * (N_EXP * NGUE / 32) / 8, FT_D = (D_FFE / 64) * (N_EXP * DM / 32) / 8;
constexpr int FT_G_A = 1408, FT_G_B = 768, FT_D_A = 512, FT_D_D = 768;
__device__ __forceinline__ void filler_g(int t, const float* p_mg, const float* p_mu, bf16* MWGU_, LAS float* scr, int wave, int lane_) {
    asm volatile("" : "+v"(lane_));
    const int r = t * 8 + wave; const int kb = r / (N_EXP * NGUE / 32), db = r % (N_EXP * NGUE / 32); const int d = db * 32 + (lane_ & 31), e = d / NGUE;
    fp::conv_item(fp::gu_src(p_mg + (size_t)e * DM * D_FFE, p_mu + (size_t)e * DM * D_FFE, D_FFE, d - e * NGUE), DM, MWGU_, (long)db * 32, kb * 64, scr, lane_);
}
__device__ __forceinline__ void filler_d(int t, const float* p_md, bf16* MWD_, LAS float* scr, int wave, int lane_) {
    asm volatile("" : "+v"(lane_));
    const int r = t * 8 + wave; const int kb = r / (N_EXP * DM / 32), db = r % (N_EXP * DM / 32); const int d = db * 32 + (lane_ & 31), e = d / DM;
    fp::SrcCol sc_; sc_.p = p_md + (size_t)e * D_FFE * DM + (d - e * DM); sc_.ld = DM; fp::conv_item(sc_, D_FFE, MWD_, (long)db * 32, kb * 64, scr, lane_);
}

struct FArgs { const void* in[29]; float* out; unsigned char* ws; int ph_lo, ph_hi; };
__device__ __forceinline__ const void* ldarg(int k) { const void* p; asm volatile("s_load_dwordx2 %0, %1, %2\n\ts_waitcnt lgkmcnt(0)" : "=s"(p) : "s"(__builtin_amdgcn_kernarg_segment_ptr()), "i"(k * 8)); return p; }

constexpr int N_PHASES = 18;
__global__ void __launch_bounds__(512, 2) mega(FArgs a) {
    extern __shared__ __attribute__((aligned(16))) unsigned char lds_[];
    LAS unsigned char* lds = (LAS unsigned char*)lds_;
    const int wave = __builtin_amdgcn_readfirstlane((int)threadIdx.x >> 6);
#define lane ((int)__builtin_amdgcn_mbcnt_hi(~0u, __builtin_amdgcn_mbcnt_lo(~0u, 0u)))
#define tid (wave * 64 + lane)
    const int G = gridDim.x; const int bx = blockIdx.x;
#define vcu (((int)gridDim.x % 8 == 0) ? ((int)blockIdx.x % 8) * ((int)gridDim.x / 8) + (int)blockIdx.x / 8 : (int)blockIdx.x)
#define gw (vcu * 8 + wave)
#define ngw ((int)gridDim.x * 8)
#define gt ((long)gw * 64 + lane)
#define ngt ((long)ngw * 64)
    unsigned char* ws = a.ws;
    unsigned* ctl = (unsigned*)(ws + O_CTL);
    for (int u = (int)threadIdx.x; u < (LDS_BYTES - RING_BYTES) / 4; u += 512) ((LAS unsigned*)(lds + RING_BYTES))[u] = 0u;
    __syncthreads();
    const int lo = a.ph_lo, hi = a.ph_hi;
    XcdBarrier bar; bar.bar = ctl + CW_BAR; bar.x = 0; bar.st = nullptr; bar.w0 = 0;
    if (hi - lo > 1) bar = xcd_barrier_post(ctl + CW_BAR, (volatile LAS unsigned*)(lds + MISC_OFF) + 8);
#define in_x ((const float*)ldarg(0))
#define in_pos ((const int*)ldarg(1))
#define ln_in_g ((const float*)ldarg(2))
#define ln_in_b ((const float*)ldarg(3))
#define w_in ((const float*)ldarg(4))
#define conv_w ((const float*)ldarg(5))
#define conv_b ((const float*)ldarg(6))
#define dt_bias ((const float*)ldarg(7))
#define a_log ((const float*)ldarg(8))
#define d_skip ((const float*)ldarg(9))
#define ssd_norm_g ((const float*)ldarg(10))
#define att_norm_g ((const float*)ldarg(11))
#define gm_ln_g ((const float*)ldarg(12))
#define gm_ln_b ((const float*)ldarg(13))
#define gm_w_s ((const float*)ldarg(14))
#define gm_b_s ((const float*)ldarg(15))
#define gm_norm_g ((const float*)ldarg(16))
#define w_out ((const float*)ldarg(17))
#define ln1_g ((const float*)ldarg(18))
#define ln1_b ((const float*)ldarg(19))
#define ln2_g ((const float*)ldarg(20))
#define ln2_b ((const float*)ldarg(21))
#define ffn_w_gate ((const float*)ldarg(22))
#define ffn_w_up ((const float*)ldarg(23))
#define ffn_w_down ((const float*)ldarg(24))
#define router_w ((const float*)ldarg(25))
#define moe_w_gate ((const float*)ldarg(26))
#define moe_w_up ((const float*)ldarg(27))
#define moe_w_down ((const float*)ldarg(28))
#define H ((float*)WOUTP)
#define MWD ((bf16*)WOUTP)
#define RT ((float*)(WSP + O_RT))
#define TE ((int*)(WSP + O_TE))
#define TP ((float*)(WSP + O_TP))
#define TS ((int*)(WSP + O_TS))
#define GS ((int*)(WSP + O_GS))
#define SP ((float*)(WSP + O_SP))
#define KM ((float*)(WSP + O_KM))
#define WSB ((bf16*)(WSP + O_WSB))
#define HB ((bf16*)(WSP + O_HB))
#define MWGU ((bf16*)(WSP + O_MWGU))
#define WIN ((bf16*)(WSP + O_WIN))
#define WOUT ((bf16*)(WSP + O_WOUT))
#define WGU ((bf16*)(WSP + O_WGU))
#define WD ((bf16*)(WSP + O_WD))
#define PROJ ((bf16*)(WSP + O_PROJ))
#define ST ((float*)(WSP + O_XC))
#define CD ((float*)(WSP + O_DT))
#define XCB ((bf16*)(WSP + O_MIXU))
#define DTG ((float*)(WSP + O_VN))
#define MIXB ((bf16*)(WSP + O_MIXB))
#define YB ((bf16*)(WSP + O_Y))
#define ACT ((bf16*)(WSP + O_ACT))
#define XG ((bf16*)(WSP + O_XG))
#define F2 ((bf16*)(WSP + O_XG))
#define ACTM ((bf16*)(WSP + O_ACTM))
#define F2P ((bf16*)(WSP + O_MWGU))
#define CNT ((int*)(WSP + O_CTL + 4 * CW_CNT))
    const ProjL FL{PLD, FQ, FK, FV, FZ, FXBC, FDT, FGU, FGV};
    LAS float* scr = (LAS float*)(lds + wave * 16384);

#ifndef PH_MASK
#define PH_MASK 0xffffffffu
#endif
#ifndef PROBE_MASK
#define PROBE_MASK 0u
#endif
#ifndef PROBE_AMP
#define PROBE_AMP 0
#endif
    volatile unsigned* pr_w = (volatile unsigned*)(ctl + 1100);
#define pr_me ((PROBE_MASK != 0u) && blockIdx.x == 0 && wave == 0 && __builtin_amdgcn_mbcnt_hi(~0u, __builtin_amdgcn_mbcnt_lo(~0u, 0u)) == 0u)
#define PH_BEGIN(k) if (lo <= (k) && (k) < hi && ((PH_MASK >> (k)) & 1u)) { unsigned char* WSP = a.ws; unsigned char* WOUTP = (unsigned char*)a.out; asm volatile("" : "+s"(WSP), "+s"(WOUTP)); if (((PROBE_MASK >> (k)) & 1u) && pr_me) pr_w[0] = (unsigned)__builtin_amdgcn_s_memrealtime();
#define PH_END(k)   if ((k) + 1 < hi) xcd_barrier(bar); if (((PROBE_MASK >> (k)) & 1u) && pr_me) pr_w[1] += (unsigned)__builtin_amdgcn_s_memrealtime() - pr_w[0]; }

    PH_BEGIN(0)
    { const float* const p_w_in = w_in; const float* const p_w_out = w_out; const float* const p_fg = ffn_w_gate; const float* const p_fu = ffn_w_up; const float* const p_fd = ffn_w_down;
        constexpr int I_WIN = 16 * (PLD / 32), I_WOUT = 16 * (DM / 32), I_WGU = 16 * (NGU / 32), I_WD = (D_FF / 64) * (DM / 32), I_MWGU = 16 * (N_EXP * NGUE / 32);
        constexpr int NIT = 2 * I_WIN + 2 * I_WOUT + I_WGU + I_WD; (void)I_MWGU;
        for (int it = gw; it < NIT; it += ngw) {
            int r = it; const int l5 = lane & 31;
            if (r < 2 * I_WIN) { const int L = r / I_WIN; r -= L * I_WIN; const int kb = r / (PLD / 32), db = r % (PLD / 32); const int sc_ = fp::win_src_col(db * 32 + l5);
                fp::SrcCol s; s.p = sc_ >= 0 ? p_w_in + (size_t)L * DM * D_IN + sc_ : nullptr; s.ld = D_IN; fp::conv_item(s, DM, WIN + (size_t)L * PLD * DM, db * 32, kb * 64, scr, lane); continue; } r -= 2 * I_WIN;
            if (r < 2 * I_WOUT) { const int L = r / I_WOUT; r -= L * I_WOUT; const int kb = r / (DM / 32), db = r % (DM / 32);
                fp::SrcCol s; s.p = p_w_out + (size_t)L * DM * DM + db * 32 + l5; s.ld = DM; fp::conv_item(s, DM, WOUT + (size_t)L * DM * DM, db * 32, kb * 64, scr, lane); continue; } r -= 2 * I_WOUT;
            if (r < I_WGU) { const int kb = r / (NGU / 32), db = r % (NGU / 32);
                fp::conv_item(fp::gu_src(p_fg, p_fu, D_FF, db * 32 + l5), DM, WGU, db * 32, kb * 64, scr, lane); continue; } r -= I_WGU;
            { const int kb = r / (DM / 32), db = r % (DM / 32);
                fp::SrcCol s; s.p = p_fd + db * 32 + l5; s.ld = DM; fp::conv_item(s, D_FF, WD, db * 32, kb * 64, scr, lane); }
        }
        const int* const p_pos = in_pos; const float* const p_gws = gm_w_s; const float* const p_x = in_x; const float* const p_lg = ln_in_g; const float* const p_lb = ln_in_b;
        for (long it = gt; it < (long)M_ * 8; it += ngt) { const int i = (int)(it & 7); const long row = it >> 3;
            const float inv = powf(500000.0f, -(float)(2 * i) / 16.0f); const float ang = (float)p_pos[row] * inv; RT[row * 16 + i] = cosf(ang); RT[row * 16 + 8 + i] = sinf(ang); }
        for (long it = gt; it < 2L * GM_G * GM_CHUNK * GM_CHUNK; it += ngt) { const int sidx = (int)(it & 127), t = (int)((it >> 7) & 127); WSB[it] = (bf16)(sidx <= t ? f2bf(p_gws[it]) : 0u); }
        { float va[16], vb[16]; LnGB gbp; ln_gb_load(gbp, p_lg, p_lb, lane); long r = gw; if (r < M_) ln_load<float, float, true>(va, p_x + r * DM, 1.f, nullptr, nullptr, lane);
          for (; r < M_; r += 2 * ngw) { const long r1 = r + ngw, r2 = r + 2 * ngw;
              if (r1 < M_) ln_load<float, float, true>(vb, p_x + r1 * DM, 1.f, nullptr, nullptr, lane);
              ln_finish_r(va, gbp, nullptr, HB + r * DM, lane);
              if (r2 < M_) ln_load<float, float, true>(va, p_x + r2 * DM, 1.f, nullptr, nullptr, lane);
              if (r1 < M_) ln_finish_r(vb, gbp, nullptr, HB + r1 * DM, lane); } }
    }
    PH_END(0)


    { constexpr int layer = 0; constexpr int PB = 1;
        PH_BEGIN(PB + 0)
        { pg8::Gemm g{HB, WIN + (size_t)layer * PLD * DM, M_, PLD, DM, DM}; pg8::StaticOrder S; S.init(M_, PLD, G, bx);
          fp::EpiProj E{PROJ, RT, KM}; pg8::gemm_phase<fp::EpiProj, pg8::StaticOrder, true, true>(lds, g, S, E, tid); }
        PH_END(PB + 0)
        PH_BEGIN(PB + 1)
        { constexpr int NATT = NB * ATT_H * NBLK, NSSDA = NB * 32;
          volatile LAS unsigned* qw = (volatile LAS unsigned*)(lds + MISC_OFF) + 16;
#define QNEXT(word) do { if (tid == 0) qw[0] = __hip_atomic_fetch_add(ctl + (word), 1u, __ATOMIC_RELAXED, __HIP_MEMORY_SCOPE_AGENT); __syncthreads(); idx = (int)qw[0]; __syncthreads(); } while (0)
          int idx;
          for (;;) { QNEXT(CW_Q + 8 * layer); if (idx >= NATT) break;
              const int qb = (NBLK - 1) - idx / (NB * ATT_H), bh = idx % (NB * ATT_H);
              attn_body::attn_unit<8>(bh / ATT_H, bh % ATT_H, qb, (const attn_body::bf16*)(PROJ + FQ), (const attn_body::bf16*)(PROJ + FK), (const attn_body::bf16*)(PROJ + FV), (attn_body::bf16*)MIXB, KM, NB * ATT_H * NBLK * 64, (char*)lds_, tid); }
          for (;;) { QNEXT(CW_Q + 8 * layer + 1); if (idx >= NSSDA) break;
              ssdA_unit(idx >> 5, (idx >> 1) & 15, idx & 1, PROJ, conv_w + (size_t)layer * 4 * SSD_CW, conv_b + layer * SSD_CW, dt_bias + layer * SSD_H, a_log + layer * SSD_H, ST, CD, XCB, DTG, lds, tid, wave, lane); }
        }
        PH_END(PB + 1)
        PH_BEGIN(PB + 2)
        { constexpr int NSSDB = NB * 32, NGMU = NB * (SEQ / GM_CHUNK);
          volatile LAS unsigned* qw = (volatile LAS unsigned*)(lds + MISC_OFF) + 16;
          int idx;
          for (;;) { QNEXT(CW_Q + 8 * layer + 2); if (idx >= NSSDB) break;
              const int c = 15 - idx / (NB * 2), bg = idx % (NB * 2);
              ssdB_unit(bg >> 1, c, bg & 1, PROJ, XCB, DTG, d_skip + layer * SSD_H, ssd_norm_g + layer * SSD_W, ST, CD, MIXB, lds, tid, wave, lane); }
          for (;;) { QNEXT(CW_Q + 8 * layer + 3); if (idx >= NGMU) break;
              gm_unit(idx / (SEQ / GM_CHUNK), idx % (SEQ / GM_CHUNK), PROJ, WSB + (size_t)layer * GM_G * GM_CHUNK * GM_CHUNK, gm_ln_g + layer * GM_W, gm_ln_b + layer * GM_W,
                      gm_b_s + layer * GM_G * GM_CHUNK, gm_norm_g + layer * GM_W, MIXB, lds, wave, lane); }
          att_norm_phase(MIXB, att_norm_g + layer * ATT_W, M_, gw, ngw, lane);
          { const float* const p_mg = moe_w_gate; const float* const p_mu = moe_w_up; const float* const p_md = moe_w_down;
            constexpr int g0 = layer == 0 ? 0 : FT_G_A + FT_G_B, g1 = layer == 0 ? FT_G_A : FT_G, d0 = layer == 0 ? 0 : FT_D_A, d1 = layer == 0 ? FT_D_A : FT_D - FT_D_D;
            for (;;) { QNEXT(CW_Q + 8 * layer + 4); if (idx >= g1 - g0) break; filler_g(g0 + idx, p_mg, p_mu, MWGU, scr, wave, lane); }
            for (;;) { QNEXT(CW_Q + 8 * layer + 5); if (idx >= d1 - d0) break; filler_d(d0 + idx, p_md, MWD, scr, wave, lane); } }
#undef QNEXT
        }
        PH_END(PB + 2)
        PH_BEGIN(PB + 3)
        { pg8::Gemm g{MIXB, WOUT + (size_t)layer * DM * DM, M_, DM, DM, DM}; pg8::StaticOrder S; S.init(M_, DM, G, bx);
          fp::EpiY E{YB, DM}; pg8::gemm_phase<fp::EpiY, pg8::StaticOrder, false, true>(lds, g, S, E, tid); }
        PH_END(PB + 3)
        PH_BEGIN(PB + 4)
        { const float* const p_g = ln1_g + layer * DM; const float* const p_b = ln1_b + layer * DM;
          { float va[16], vb[16]; LnGB gbp; ln_gb_load(gbp, p_g, p_b, lane); long r = gw; if (r < M_) ln_load<bf16, bf16>(va, HB + r * DM, ALPHA, YB + r * DM, nullptr, lane);
            for (; r < M_; r += 2 * ngw) { const long r1 = r + ngw, r2 = r + 2 * ngw;
                if (r1 < M_) ln_load<bf16, bf16>(vb, HB + r1 * DM, ALPHA, YB + r1 * DM, nullptr, lane);
                ln_finish_r(va, gbp, nullptr, HB + r * DM, lane);
                if (r2 < M_) ln_load<bf16, bf16>(va, HB + r2 * DM, ALPHA, YB + r2 * DM, nullptr, lane);
                if (r1 < M_) ln_finish_r(vb, gbp, nullptr, HB + r1 * DM, lane); } }
          if (layer == 1) { asm volatile("s_waitcnt vmcnt(0)" ::: "memory"); moe_route_block(HB, router_w, CNT, TE, TP, TS, M_, gw, ngw, lane, wave, tid, (LAS int*)lds); } }
        PH_END(PB + 4)
        if constexpr (layer == 0) {
            PH_BEGIN(PB + 5)
            { pg8::Gemm g{HB, WGU, M_, NGU, DM, DM}; pg8::StaticOrder S; S.init(M_, NGU, G, bx);
              fp::EpiAct E{ACT, D_FF, NGU / 256}; pg8::gemm_phase<fp::EpiAct, pg8::StaticOrder, true, true>(lds, g, S, E, tid);
              { constexpr int UNITS = (NB * SEQ / 256) * (NGU / 256), REM = UNITS % 256;
                if (REM != 0 && G == 256 && bx >= REM) { constexpr int PER = (FT_G_B + (256 - REM) - 1) / (256 - REM); const float* const p_mg = moe_w_gate; const float* const p_mu = moe_w_up;
                    for (int k = 0; k < PER; ++k) { const int t = (bx - REM) * PER + k; if (t < FT_G_B) filler_g(FT_G_A + t, p_mg, p_mu, MWGU, scr, wave, lane); } }
                else if (REM == 0 || G != 256) { const float* const p_mg = moe_w_gate; const float* const p_mu = moe_w_up; for (int t = bx; t < FT_G_B; t += G) filler_g(FT_G_A + t, p_mg, p_mu, MWGU, scr, wave, lane); } } }
            PH_END(PB + 5)
            PH_BEGIN(PB + 6)
            { pg8::Gemm g{ACT, WD, M_, DM, D_FF, D_FF}; pg8::StaticOrder S; S.init(M_, DM, G, bx);
              fp::EpiY E{YB, DM}; pg8::gemm_phase<fp::EpiY, pg8::StaticOrder, false, true>(lds, g, S, E, tid); }
            PH_END(PB + 6)
            PH_BEGIN(PB + 7)
            { const float* const p_g = ln2_g + layer * DM; const float* const p_b = ln2_b + layer * DM;
              { float va[16], vb[16]; LnGB gbp; ln_gb_load(gbp, p_g, p_b, lane); long r = gw; if (r < M_) ln_load<bf16, bf16>(va, HB + r * DM, ALPHA, YB + r * DM, nullptr, lane);
            for (; r < M_; r += 2 * ngw) { const long r1 = r + ngw, r2 = r + 2 * ngw;
                if (r1 < M_) ln_load<bf16, bf16>(vb, HB + r1 * DM, ALPHA, YB + r1 * DM, nullptr, lane);
                ln_finish_r(va, gbp, nullptr, HB + r * DM, lane);
                if (r2 < M_) ln_load<bf16, bf16>(va, HB + r2 * DM, ALPHA, YB + r2 * DM, nullptr, lane);
                if (r1 < M_) ln_finish_r(vb, gbp, nullptr, HB + r1 * DM, lane); } } }
            PH_END(PB + 7)
        } else {
            PH_BEGIN(PB + 5)
            { int base[N_EXP]; { int b_ = 0;
#pragma unroll
                  for (int e = 0; e < N_EXP; ++e) { base[e] = b_; b_ += (CNT[e] + 255) & ~255; } }
              constexpr int RPW = (M_ + 2047) / 2048;
              int te[RPW][2], tsl[RPW][2]; float tpv[RPW][2];
#pragma unroll
              for (int k = 0; k < RPW; ++k) { const long r = gw + (long)k * ngw;
#pragma unroll
                  for (int q = 0; q < 2; ++q) { te[k][q] = 0; tsl[k][q] = 0; tpv[k][q] = 0.f; if (r < M_) { te[k][q] = TE[r * 2 + q]; tsl[k][q] = TS[r * 2 + q]; tpv[k][q] = TP[r * 2 + q]; } } }
#pragma unroll
              for (int k = 0; k < RPW; ++k) { const long r = gw + (long)k * ngw; if (r < M_) {
                  const uint4* src = (const uint4*)(HB + r * DM); const uint4 v0 = src[lane], v1 = src[lane + 64];
#pragma unroll
                  for (int q = 0; q < 2; ++q) { int be = 0;
#pragma unroll
                      for (int x = 0; x < N_EXP; ++x) be = (te[k][q] == x) ? base[x] : be;
                      const int gs = be + tsl[k][q];
                      if (lane == 0) { SP[gs] = tpv[k][q]; GS[r * 2 + q] = gs; }
                      uint4* dst = (uint4*)(XG + (size_t)gs * DM); dst[lane] = v0; dst[lane + 64] = v1; } } }
              for (long r = gw + (long)RPW * ngw; r < M_; r += ngw) {
                  const uint4* src = (const uint4*)(HB + r * DM); const uint4 v0 = src[lane], v1 = src[lane + 64];
                  for (int q = 0; q < 2; ++q) { const long it = r * 2 + q; const int e = TE[it]; int be = 0;
#pragma unroll
                      for (int x = 0; x < N_EXP; ++x) be = (e == x) ? base[x] : be;
                      const int gs = be + TS[it];
                      if (lane == 0) { SP[gs] = TP[it]; GS[it] = gs; }
                      uint4* dst = (uint4*)(XG + (size_t)gs * DM); dst[lane] = v0; dst[lane + 64] = v1; } }
              for (int it = gw; it < N_EXP * 256; it += ngw) { const int e = it >> 8, r = it & 255; const int c = CNT[e]; const int slot = moe_base(CNT, e) + c + r;
                  if (c + r < ((c + 255) & ~255)) { uint4* dst = (uint4*)(XG + (size_t)slot * DM); const uint4 z = make_uint4(0u, 0u, 0u, 0u); dst[lane] = z; dst[lane + 64] = z; if (lane == 0) SP[slot] = 0.f; } } }
            PH_END(PB + 5)
            PH_BEGIN(PB + 6)
            { pg8::Gemm g{XG, MWGU, NSLOT, N_EXP * NGUE, DM, DM}; fp::MoeOrder S; S.init(CNT, NGUE / 256, G, bx);
              fp::EpiAct E{ACTM, D_FFE, NGUE / 256}; pg8::gemm_phase<fp::EpiAct, fp::MoeOrder, true, true>(lds, g, S, E, tid);
              { const int rem = (S.T * S.ncol) % G; const int nidle = rem == 0 ? G : G - rem, first = rem == 0 ? 0 : rem;
                if (bx >= first) { const int per = (FT_D_D + nidle - 1) / nidle; const float* const p_md = moe_w_down;
                    for (int k = 0; k < per; ++k) { const int t = (bx - first) * per + k; if (t < FT_D_D) filler_d(FT_D - FT_D_D + t, p_md, MWD, scr, wave, lane); } } } }
            PH_END(PB + 6)
            PH_BEGIN(PB + 7)
            { fp::MoeOrder S; S.init(CNT, DM / 256, G, bx); const int nf = S.tail_start(); const int slot0 = (nf / (DM / 256)) * 256;
              fp::EpiF2 E{F2, SP, F2P, slot0, D_FFE / 4};
              { pg8::Gemm g{ACTM, MWD, NSLOT, N_EXP * DM, D_FFE, D_FFE}; S.nfull = nf; S.ksplit = 1;
                pg8::gemm_phase<fp::EpiF2, fp::MoeOrder, true, true>(lds, g, S, E, tid); }
              { pg8::Gemm g{ACTM, MWD, NSLOT, N_EXP * DM, D_FFE / 4, D_FFE}; S.ksplit = 4; S.klen = D_FFE / 4;
                int tid2 = tid; asm volatile("" : "+v"(tid2));
                pg8::gemm_phase<fp::EpiF2, fp::MoeOrder, true, true>(lds, g, S, E, tid2); } }
            PH_END(PB + 7)
            PH_BEGIN(PB + 8)
            { const float* const p_g = ln2_g + layer * DM; const float* const p_b = ln2_b + layer * DM;
              int slot0; { fp::MoeOrder S; S.init(CNT, DM / 256, G, bx); const int nf = S.tail_start(); slot0 = (nf == S.T * (DM / 256)) ? 0x7fffffff : (nf / (DM / 256)) * 256; }
#define LN2_LOAD(v, rr, kk_) do { int s0_ = GS[(rr) * 2], s1_ = GS[(rr) * 2 + 1]; if (kk_ < RPW2) { _Pragma("unroll") for (int x_ = 0; x_ < RPW2; ++x_) if (x_ == kk_) { s0_ = gsv[x_][0]; s1_ = gsv[x_][1]; } } ln_load<bf16, bf16>(v, HB + (rr) * DM, ALPHA, F2 + (size_t)s0_ * DM, F2 + (size_t)s1_ * DM, lane); \
                  if (s0_ >= slot0) { _Pragma("unroll") for (int p_ = 0; p_ < 3; ++p_) ln_add(v, F2P + ((size_t)p_ * TAIL_SLOTS + (s0_ - slot0)) * DM, lane); } \
                  if (s1_ >= slot0) { _Pragma("unroll") for (int p_ = 0; p_ < 3; ++p_) ln_add(v, F2P + ((size_t)p_ * TAIL_SLOTS + (s1_ - slot0)) * DM, lane); } } while (0)
              constexpr int RPW2 = (M_ + 2047) / 2048; int gsv[RPW2][2];
#pragma unroll
              for (int x_ = 0; x_ < RPW2; ++x_) { const long rr_ = gw + (long)x_ * ngw; gsv[x_][0] = 0; gsv[x_][1] = 0; if (rr_ < M_) { gsv[x_][0] = GS[rr_ * 2]; gsv[x_][1] = GS[rr_ * 2 + 1]; } }
              { float va[16], vb[16]; LnGB gbp; ln_gb_load(gbp, p_g, p_b, lane); long r = gw; int kq = 0; if (r < M_) LN2_LOAD(va, r, kq);
                for (; r < M_; r += 2 * ngw, kq += 2) { const long r1 = r + ngw, r2 = r + 2 * ngw;
                    if (r1 < M_) LN2_LOAD(vb, r1, kq + 1);
                    ln_finish_r(va, gbp, H + r * DM, nullptr, lane);
                    if (r2 < M_) LN2_LOAD(va, r2, kq + 2);
                    if (r1 < M_) ln_finish_r(vb, gbp, H + r1 * DM, nullptr, lane); } }
#undef LN2_LOAD
            }
            PH_END(PB + 8)
        }
    }

    { constexpr int layer = 1; constexpr int PB = 9;
        PH_BEGIN(PB + 0)
        { pg8::Gemm g{HB, WIN + (size_t)layer * PLD * DM, M_, PLD, DM, DM}; pg8::StaticOrder S; S.init(M_, PLD, G, bx);
          fp::EpiProj E{PROJ, RT, KM}; pg8::gemm_phase<fp::EpiProj, pg8::StaticOrder, true, true>(lds, g, S, E, tid); }
        PH_END(PB + 0)
        PH_BEGIN(PB + 1)
        { constexpr int NATT = NB * ATT_H * NBLK, NSSDA = NB * 32;
          volatile LAS unsigned* qw = (volatile LAS unsigned*)(lds + MISC_OFF) + 16;
#define QNEXT(word) do { if (tid == 0) qw[0] = __hip_atomic_fetch_add(ctl + (word), 1u, __ATOMIC_RELAXED, __HIP_MEMORY_SCOPE_AGENT); __syncthreads(); idx = (int)qw[0]; __syncthreads(); } while (0)
          int idx;
          for (;;) { QNEXT(CW_Q + 8 * layer); if (idx >= NATT) break;
              const int qb = (NBLK - 1) - idx / (NB * ATT_H), bh = idx % (NB * ATT_H);
              attn_body::attn_unit<8>(bh / ATT_H, bh % ATT_H, qb, (const attn_body::bf16*)(PROJ + FQ), (const attn_body::bf16*)(PROJ + FK), (const attn_body::bf16*)(PROJ + FV), (attn_body::bf16*)MIXB, KM, NB * ATT_H * NBLK * 64, (char*)lds_, tid); }
          for (;;) { QNEXT(CW_Q + 8 * layer + 1); if (idx >= NSSDA) break;
              ssdA_unit(idx >> 5, (idx >> 1) & 15, idx & 1, PROJ, conv_w + (size_t)layer * 4 * SSD_CW, conv_b + layer * SSD_CW, dt_bias + layer * SSD_H, a_log + layer * SSD_H, ST, CD, XCB, DTG, lds, tid, wave, lane); }
        }
        PH_END(PB + 1)
        PH_BEGIN(PB + 2)
        { constexpr int NSSDB = NB * 32, NGMU = NB * (SEQ / GM_CHUNK);
          volatile LAS unsigned* qw = (volatile LAS unsigned*)(lds + MISC_OFF) + 16;
          int idx;
          for (;;) { QNEXT(CW_Q + 8 * layer + 2); if (idx >= NSSDB) break;
              const int c = 15 - idx / (NB * 2), bg = idx % (NB * 2);
              ssdB_unit(bg >> 1, c, bg & 1, PROJ, XCB, DTG, d_skip + layer * SSD_H, ssd_norm_g + layer * SSD_W, ST, CD, MIXB, lds, tid, wave, lane); }
          for (;;) { QNEXT(CW_Q + 8 * layer + 3); if (idx >= NGMU) break;
              gm_unit(idx / (SEQ / GM_CHUNK), idx % (SEQ / GM_CHUNK), PROJ, WSB + (size_t)layer * GM_G * GM_CHUNK * GM_CHUNK, gm_ln_g + layer * GM_W, gm_ln_b + layer * GM_W,
                      gm_b_s + layer * GM_G * GM_CHUNK, gm_norm_g + layer * GM_W, MIXB, lds, wave, lane); }
          att_norm_phase(MIXB, att_norm_g + layer * ATT_W, M_, gw, ngw, lane);
          { const float* const p_mg = moe_w_gate; const float* const p_mu = moe_w_up; const float* const p_md = moe_w_down;
            constexpr int g0 = layer == 0 ? 0 : FT_G_A + FT_G_B, g1 = layer == 0 ? FT_G_A : FT_G, d0 = layer == 0 ? 0 : FT_D_A, d1 = layer == 0 ? FT_D_A : FT_D - FT_D_D;
            for (;;) { QNEXT(CW_Q + 8 * layer + 4); if (idx >= g1 - g0) break; filler_g(g0 + idx, p_mg, p_mu, MWGU, scr, wave, lane); }
            for (;;) { QNEXT(CW_Q + 8 * layer + 5); if (idx >= d1 - d0) break; filler_d(d0 + idx, p_md, MWD, scr, wave, lane); } }
#undef QNEXT
        }
        PH_END(PB + 2)
        PH_BEGIN(PB + 3)
        { pg8::Gemm g{MIXB, WOUT + (size_t)layer * DM * DM, M_, DM, DM, DM}; pg8::StaticOrder S; S.init(M_, DM, G, bx);
          fp::EpiY E{YB, DM}; pg8::gemm_phase<fp::EpiY, pg8::StaticOrder, false, true>(lds, g, S, E, tid); }
        PH_END(PB + 3)
        PH_BEGIN(PB + 4)
        { const float* const p_g = ln1_g + layer * DM; const float* const p_b = ln1_b + layer * DM;
          { float va[16], vb[16]; LnGB gbp; ln_gb_load(gbp, p_g, p_b, lane); long r = gw; if (r < M_) ln_load<bf16, bf16>(va, HB + r * DM, ALPHA, YB + r * DM, nullptr, lane);
            for (; r < M_; r += 2 * ngw) { const long r1 = r + ngw, r2 = r + 2 * ngw;
                if (r1 < M_) ln_load<bf16, bf16>(vb, HB + r1 * DM, ALPHA, YB + r1 * DM, nullptr, lane);
                ln_finish_r(va, gbp, nullptr, HB + r * DM, lane);
                if (r2 < M_) ln_load<bf16, bf16>(va, HB + r2 * DM, ALPHA, YB + r2 * DM, nullptr, lane);
                if (r1 < M_) ln_finish_r(vb, gbp, nullptr, HB + r1 * DM, lane); } }
          if (layer == 1) { asm volatile("s_waitcnt vmcnt(0)" ::: "memory"); moe_route_block(HB, router_w, CNT, TE, TP, TS, M_, gw, ngw, lane, wave, tid, (LAS int*)lds); } }
        PH_END(PB + 4)
        if constexpr (layer == 0) {
            PH_BEGIN(PB + 5)
            { pg8::Gemm g{HB, WGU, M_, NGU, DM, DM}; pg8::StaticOrder S; S.init(M_, NGU, G, bx);
              fp::EpiAct E{ACT, D_FF, NGU / 256}; pg8::gemm_phase<fp::EpiAct, pg8::StaticOrder, true, true>(lds, g, S, E, tid);
              { constexpr int UNITS = (NB * SEQ / 256) * (NGU / 256), REM = UNITS % 256;
                if (REM != 0 && G == 256 && bx >= REM) { constexpr int PER = (FT_G_B + (256 - REM) - 1) / (256 - REM); const float* const p_mg = moe_w_gate; const float* const p_mu = moe_w_up;
                    for (int k = 0; k < PER; ++k) { const int t = (bx - REM) * PER + k; if (t < FT_G_B) filler_g(FT_G_A + t, p_mg, p_mu, MWGU, scr, wave, lane); } }
                else if (REM == 0 || G != 256) { const float* const p_mg = moe_w_gate; const float* const p_mu = moe_w_up; for (int t = bx; t < FT_G_B; t += G) filler_g(FT_G_A + t, p_mg, p_mu, MWGU, scr, wave, lane); } } }
            PH_END(PB + 5)
            PH_BEGIN(PB + 6)
            { pg8::Gemm g{ACT, WD, M_, DM, D_FF, D_FF}; pg8::StaticOrder S; S.init(M_, DM, G, bx);
              fp::EpiY E{YB, DM}; pg8::gemm_phase<fp::EpiY, pg8::StaticOrder, false, true>(lds, g, S, E, tid); }
            PH_END(PB + 6)
            PH_BEGIN(PB + 7)
            { const float* const p_g = ln2_g + layer * DM; const float* const p_b = ln2_b + layer * DM;
              { float va[16], vb[16]; LnGB gbp; ln_gb_load(gbp, p_g, p_b, lane); long r = gw; if (r < M_) ln_load<bf16, bf16>(va, HB + r * DM, ALPHA, YB + r * DM, nullptr, lane);
            for (; r < M_; r += 2 * ngw) { const long r1 = r + ngw, r2 = r + 2 * ngw;
                if (r1 < M_) ln_load<bf16, bf16>(vb, HB + r1 * DM, ALPHA, YB + r1 * DM, nullptr, lane);
                ln_finish_r(va, gbp, nullptr, HB + r * DM, lane);
                if (r2 < M_) ln_load<bf16, bf16>(va, HB + r2 * DM, ALPHA, YB + r2 * DM, nullptr, lane);
                if (r1 < M_) ln_finish_r(vb, gbp, nullptr, HB + r1 * DM, lane); } } }
            PH_END(PB + 7)
        } else {
            PH_BEGIN(PB + 5)
            { int base[N_EXP]; { int b_ = 0;
#pragma unroll
                  for (int e = 0; e < N_EXP; ++e) { base[e] = b_; b_ += (CNT[e] + 255) & ~255; } }
              constexpr int RPW = (M_ + 2047) / 2048;
              int te[RPW][2], tsl[RPW][2]; float tpv[RPW][2];
#pragma unroll
              for (int k = 0; k < RPW; ++k) { const long r = gw + (long)k * ngw;
#pragma unroll
                  for (int q = 0; q < 2; ++q) { te[k][q] = 0; tsl[k][q] = 0; tpv[k][q] = 0.f; if (r < M_) { te[k][q] = TE[r * 2 + q]; tsl[k][q] = TS[r * 2 + q]; tpv[k][q] = TP[r * 2 + q]; } } }
#pragma unroll
              for (int k = 0; k < RPW; ++k) { const long r = gw + (long)k * ngw; if (r < M_) {
                  const uint4* src = (const uint4*)(HB + r * DM); const uint4 v0 = src[lane], v1 = src[lane + 64];
#pragma unroll
                  for (int q = 0; q < 2; ++q) { int be = 0;
#pragma unroll
                      for (int x = 0; x < N_EXP; ++x) be = (te[k][q] == x) ? base[x] : be;
                      const int gs = be + tsl[k][q];
                      if (lane == 0) { SP[gs] = tpv[k][q]; GS[r * 2 + q] = gs; }
                      uint4* dst = (uint4*)(XG + (size_t)gs * DM); dst[lane] = v0; dst[lane + 64] = v1; } } }
              for (long r = gw + (long)RPW * ngw; r < M_; r += ngw) {
                  const uint4* src = (const uint4*)(HB + r * DM); const uint4 v0 = src[lane], v1 = src[lane + 64];
                  for (int q = 0; q < 2; ++q) { const long it = r * 2 + q; const int e = TE[it]; int be = 0;
#pragma unroll
                      for (int x = 0; x < N_EXP; ++x) be = (e == x) ? base[x] : be;
                      const int gs = be + TS[it];
                      if (lane == 0) { SP[gs] = TP[it]; GS[it] = gs; }
                      uint4* dst = (uint4*)(XG + (size_t)gs * DM); dst[lane] = v0; dst[lane + 64] = v1; } }
              for (int it = gw; it < N_EXP * 256; it += ngw) { const int e = it >> 8, r = it & 255; const int c = CNT[e]; const int slot = moe_base(CNT, e) + c + r;
                  if (c + r < ((c + 255) & ~255)) { uint4* dst = (uint4*)(XG + (size_t)slot * DM); const uint4 z = make_uint4(0u, 0u, 0u, 0u); dst[lane] = z; dst[lane + 64] = z; if (lane == 0) SP[slot] = 0.f; } } }
            PH_END(PB + 5)
            PH_BEGIN(PB + 6)
            { pg8::Gemm g{XG, MWGU, NSLOT, N_EXP * NGUE, DM, DM}; fp::MoeOrder S; S.init(CNT, NGUE / 256, G, bx);
              fp::EpiAct E{ACTM, D_FFE, NGUE / 256}; pg8::gemm_phase<fp::EpiAct, fp::MoeOrder, true, true>(lds, g, S, E, tid);
              { const int rem = (S.T * S.ncol) % G; const int nidle = rem == 0 ? G : G - rem, first = rem == 0 ? 0 : rem;
                if (bx >= first) { const int per = (FT_D_D + nidle - 1) / nidle; const float* const p_md = moe_w_down;
                    for (int k = 0; k < per; ++k) { const int t = (bx - first) * per + k; if (t < FT_D_D) filler_d(FT_D - FT_D_D + t, p_md, MWD, scr, wave, lane); } } } }
            PH_END(PB + 6)
            PH_BEGIN(PB + 7)
            { fp::MoeOrder S; S.init(CNT, DM / 256, G, bx); const int nf = S.tail_start(); const int slot0 = (nf / (DM / 256)) * 256;
              fp::EpiF2 E{F2, SP, F2P, slot0, D_FFE / 4};
              { pg8::Gemm g{ACTM, MWD, NSLOT, N_EXP * DM, D_FFE, D_FFE}; S.nfull = nf; S.ksplit = 1;
                pg8::gemm_phase<fp::EpiF2, fp::MoeOrder, true, true>(lds, g, S, E, tid); }
              { pg8::Gemm g{ACTM, MWD, NSLOT, N_EXP * DM, D_FFE / 4, D_FFE}; S.ksplit = 4; S.klen = D_FFE / 4;
                int tid2 = tid; asm volatile("" : "+v"(tid2));
                pg8::gemm_phase<fp::EpiF2, fp::MoeOrder, true, true>(lds, g, S, E, tid2); } }
            PH_END(PB + 7)
            PH_BEGIN(PB + 8)
            { const float* const p_g = ln2_g + layer * DM; const float* const p_b = ln2_b + layer * DM;
              int slot0; { fp::MoeOrder S; S.init(CNT, DM / 256, G, bx); const int nf = S.tail_start(); slot0 = (nf == S.T * (DM / 256)) ? 0x7fffffff : (nf / (DM / 256)) * 256; }
#define LN2_LOAD(v, rr, kk_) do { int s0_ = GS[(rr) * 2], s1_ = GS[(rr) * 2 + 1]; if (kk_ < RPW2) { _Pragma("unroll") for (int x_ = 0; x_ < RPW2; ++x_) if (x_ == kk_) { s0_ = gsv[x_][0]; s1_ = gsv[x_][1]; } } ln_load<bf16, bf16>(v, HB + (rr) * DM, ALPHA, F2 + (size_t)s0_ * DM, F2 + (size_t)s1_ * DM, lane); \
                  if (s0_ >= slot0) { _Pragma("unroll") for (int p_ = 0; p_ < 3; ++p_) ln_add(v, F2P + ((size_t)p_ * TAIL_SLOTS + (s0_ - slot0)) * DM, lane); } \
                  if (s1_ >= slot0) { _Pragma("unroll") for (int p_ = 0; p_ < 3; ++p_) ln_add(v, F2P + ((size_t)p_ * TAIL_SLOTS + (s1_ - slot0)) * DM, lane); } } while (0)
              constexpr int RPW2 = (M_ + 2047) / 2048; int gsv[RPW2][2];
#pragma unroll
              for (int x_ = 0; x_ < RPW2; ++x_) { const long rr_ = gw + (long)x_ * ngw; gsv[x_][0] = 0; gsv[x_][1] = 0; if (rr_ < M_) { gsv[x_][0] = GS[rr_ * 2]; gsv[x_][1] = GS[rr_ * 2 + 1]; } }
              { float va[16], vb[16]; LnGB gbp; ln_gb_load(gbp, p_g, p_b, lane); long r = gw; int kq = 0; if (r < M_) LN2_LOAD(va, r, kq);
                for (; r < M_; r += 2 * ngw, kq += 2) { const long r1 = r + ngw, r2 = r + 2 * ngw;
                    if (r1 < M_) LN2_LOAD(vb, r1, kq + 1);
                    ln_finish_r(va, gbp, H + r * DM, nullptr, lane);
                    if (r2 < M_) LN2_LOAD(va, r2, kq + 2);
                    if (r1 < M_) ln_finish_r(vb, gbp, H + r1 * DM, nullptr, lane); } }
#undef LN2_LOAD
            }
            PH_END(PB + 8)
        }
    }

#undef PH_BEGIN
#undef PH_END
#undef in_x
#undef in_pos
#undef ln_in_g
#undef ln_in_b
#undef w_in
#undef conv_w
#undef conv_b
#undef dt_bias
#undef a_log
#undef d_skip
#undef ssd_norm_g
#undef att_norm_g
#undef gm_ln_g
#undef gm_ln_b
#undef gm_w_s
#undef gm_b_s
#undef gm_norm_g
#undef w_out
#undef ln1_g
#undef ln1_b
#undef ln2_g
#undef ln2_b
#undef ffn_w_gate
#undef ffn_w_up
#undef ffn_w_down
#undef router_w
#undef moe_w_gate
#undef moe_w_up
#undef moe_w_down
#undef H
#undef MWD
#undef RT
#undef TE
#undef TP
#undef TS
#undef GS
#undef SP
#undef KM
#undef WSB
#undef HB
#undef MWGU
#undef WIN
#undef WOUT
#undef WGU
#undef WD
#undef PROJ
#undef ST
#undef CD
#undef XCB
#undef DTG
#undef MIXB
#undef YB
#undef ACT
#undef XG
#undef F2
#undef ACTM
#undef CNT
#undef tid
#undef lane
#undef F2P
#undef vcu
#undef gw
#undef ngw
#undef gt
#undef ngt
    if (pr_me) { const unsigned t_beg = (unsigned)__builtin_amdgcn_s_memrealtime(), t_len = (unsigned)PROBE_AMP * pr_w[1]; while ((unsigned)__builtin_amdgcn_s_memrealtime() - t_beg < t_len) __builtin_amdgcn_s_sleep(8); }
}

__device__ __forceinline__ void blk_acc(float d2, float s2, float* err) {
    d2 = wave_sum(d2); s2 = wave_sum(s2); if ((threadIdx.x & 63) == 0) { atomicAdd(err, d2); atomicAdd(err + 1, s2); }
}
__global__ void k_cmp_proj(const bf16* F, const float* S, long rows, float* err) {
    float d2 = 0.f, s2 = 0.f;
    for (long it = blockIdx.x * (long)blockDim.x + threadIdx.x; it < rows * 2950; it += gridDim.x * (long)blockDim.x) {
        const long row = it / 2950; const int d = (int)(it % 2950); const int sc = fp::win_src_col(d);
        float s = S[row * D_IN + sc]; if (d >= FGU && d < FXBC) s = gelu_tanh_f(s);
        const float f = ldf(F + row * PLD + d); d2 += (f - s) * (f - s); s2 += s * s; }
    blk_acc(d2, s2, err);
}
template <class TF> __global__ void k_cmp(const TF* F, int ldf_, const float* S, int lds_, long rows, int cols, float* err) {
    float d2 = 0.f, s2 = 0.f;
    for (long it = blockIdx.x * (long)blockDim.x + threadIdx.x; it < rows * cols; it += gridDim.x * (long)blockDim.x) {
        const long row = it / cols; const int c = (int)(it % cols); const float f = ldf(F + row * ldf_ + c), s = S[row * lds_ + c]; d2 += (f - s) * (f - s); s2 += s * s; }
    blk_acc(d2, s2, err);
}
__global__ void k_encode(const float* err, int nck, const float* Sout, float* out, long rows_s, long rows_all, float thr) {
    int k = 0; for (int i = 0; i < nck; ++i) { const float r = err[2 * i] / fmaxf(err[2 * i + 1], 1e-30f); if (!(r <= thr)) { k = i + 1; break; } }
    for (long it = blockIdx.x * (long)blockDim.x + threadIdx.x; it < rows_all * DM; it += gridDim.x * (long)blockDim.x)
        out[it] = (it < rows_s * DM) ? Sout[it] * (1.f + (float)k) : 0.f;
}
#if DEBUG_BUILD
constexpr size_t S_BASE = (WS_END + 2 * MiB - 1) / MiB * MiB;
#endif
extern "C" void kernel_launch(void* const* d_in, const int* in_sizes, int n_in, void* d_out, int out_size, void* d_ws, size_t ws_size, hipStream_t stream) {
    (void)in_sizes; (void)n_in; (void)out_size;
    static int grid = 0;
    if (grid == 0) {
        int dev = 0, cus = 0, per_cu = 0;
        if (hipGetDevice(&dev) != hipSuccess || hipDeviceGetAttribute(&cus, hipDeviceAttributeMultiprocessorCount, dev) != hipSuccess) { grid = -1; return; }
        if (hipFuncSetAttribute((const void*)mega, hipFuncAttributeMaxDynamicSharedMemorySize, LDS_BYTES) != hipSuccess) { fprintf(stderr, "kernel_launch: hipFuncSetAttribute failed\n"); grid = -1; return; }
        if (hipOccupancyMaxActiveBlocksPerMultiprocessor(&per_cu, (const void*)mega, 512, LDS_BYTES) != hipSuccess || per_cu < 1) fprintf(stderr, "kernel_launch: occupancy query reports %d\n", per_cu);
        (void)hipGetLastError();
        grid = cus;
        if (ws_size < WS_END) { fprintf(stderr, "kernel_launch: workspace too small: %zu < %zu\n", ws_size, (size_t)WS_END); grid = -1; }
    }
    if (grid < 0) return;
    unsigned char* ws = (unsigned char*)d_ws;
    if (hipMemsetAsync(ws + O_CTL, 0, CTL_BYTES, stream) != hipSuccess) return;
    FArgs a{};
    for (int i = 0; i < 29; ++i) a.in[i] = d_in[i];
    a.out = (float*)d_out; a.ws = ws;
#if !DEBUG_BUILD
    a.ph_lo = 0; a.ph_hi = N_PHASES;
    hipLaunchKernelGGL(mega, dim3(grid), dim3(512), LDS_BYTES, stream, a);
#else
    Inputs I;
    I.x = (const float*)d_in[0]; I.pos = (const int*)d_in[1]; I.ln_in_g = (const float*)d_in[2]; I.ln_in_b = (const float*)d_in[3]; I.w_in = (const float*)d_in[4];
    I.conv_w = (const float*)d_in[5]; I.conv_b = (const float*)d_in[6]; I.dt_bias = (const float*)d_in[7]; I.a_log = (const float*)d_in[8]; I.d_skip = (const float*)d_in[9];
    I.ssd_norm_g = (const float*)d_in[10]; I.att_norm_g = (const float*)d_in[11]; I.gm_ln_g = (const float*)d_in[12]; I.gm_ln_b = (const float*)d_in[13]; I.gm_w_s = (const float*)d_in[14];
    I.gm_b_s = (const float*)d_in[15]; I.gm_norm_g = (const float*)d_in[16]; I.w_out = (const float*)d_in[17]; I.ln1_g = (const float*)d_in[18]; I.ln1_b = (const float*)d_in[19];
    I.ln2_g = (const float*)d_in[20]; I.ln2_b = (const float*)d_in[21]; I.ffn_w_gate = (const float*)d_in[22]; I.ffn_w_up = (const float*)d_in[23]; I.ffn_w_down = (const float*)d_in[24];
    I.router_w = (const float*)d_in[25]; I.moe_w_gate = (const float*)d_in[26]; I.moe_w_up = (const float*)d_in[27]; I.moe_w_down = (const float*)d_in[28];
    const long MS = SEQ;
    unsigned char* sws = ws + S_BASE;
    float* saux = (float*)(sws + 96 * MiB); float* sout = (float*)(sws + 100 * MiB); float* ckpt = (float*)(sws + 110 * MiB);
    const size_t ck_stride = (size_t)MS * (D_IN + 3 * DM);
    run_simple(I, 1, sws, saux, sout, stream, ckpt);
    float* err = (float*)(ws + O_CTL) + CW_ERR;
    const bf16* PROJ = (const bf16*)(ws + O_PROJ); const bf16* MIXB = (const bf16*)(ws + O_MIXB); const bf16* Hf = (const bf16*)(ws + O_HB); const float* Hout = (const float*)d_out;
    for (int ph = 0; ph < N_PHASES; ++ph) {
        a.ph_lo = ph; a.ph_hi = ph + 1;
        hipLaunchKernelGGL(mega, dim3(grid), dim3(512), LDS_BYTES, stream, a);
        const int layer = ph >= 9 ? 1 : 0; const int rel = ph - (layer ? 8 : 0); const float* ck = ckpt + layer * ck_stride; float* e = err + layer * 12;
        if (rel == 1) k_cmp_proj<<<512, 256, 0, stream>>>(PROJ, ck, MS, e + 0);
        if (rel == 3) { k_cmp<bf16><<<512, 256, 0, stream>>>(MIXB, DM, ck + (size_t)MS * D_IN, DM, MS, 384, e + 2);
                        k_cmp<bf16><<<512, 256, 0, stream>>>(MIXB + 384, DM, ck + (size_t)MS * D_IN + 384, DM, MS, 384, e + 4);
                        k_cmp<bf16><<<512, 256, 0, stream>>>(MIXB + 768, DM, ck + (size_t)MS * D_IN + 768, DM, MS, 256, e + 6); }
        if (rel == 5) k_cmp<bf16><<<512, 256, 0, stream>>>(Hf, DM, ck + (size_t)MS * (D_IN + DM), DM, MS, DM, e + 8);
        if (layer == 0 && rel == 8) k_cmp<bf16><<<512, 256, 0, stream>>>(Hf, DM, ck + (size_t)MS * (D_IN + 2 * DM), DM, MS, DM, e + 10);
        if (layer == 1 && rel == 9) k_cmp<float><<<512, 256, 0, stream>>>(Hout, DM, ck + (size_t)MS * (D_IN + 2 * DM), DM, MS, DM, e + 10);
    }
    k_encode<<<1024, 256, 0, stream>>>(err, 12, sout, (float*)d_out, MS, (long)NBATCH * SEQ, DBG_THR);
#endif
}
```

```cpp
#define DEBUG_BUILD 0
#define DBG_THR 0.02f
#define PROBE_MASK 0u
#define PROBE_AMP 0
#include <hip/hip_runtime.h>
#include <cstdio>
#include <cstdint>

constexpr int DM = 1024, SEQ = 2048, NBATCH = 8;
constexpr int ATT_H = 6, HD = 64, ATT_W = 384, ROPE_DIM = 16;
constexpr int MOBA_BLOCK = 256, NBLK = SEQ / MOBA_BLOCK;
constexpr int SSD_H = 6, SSD_W = 384, SSD_G = 2, SSD_N = 128, SSD_CW = 896;
constexpr int GM_G = 4, GM_W = 256, GM_CHUNK = 128;
constexpr int D_IN = 2950, D_FF = 2816, N_EXP = 8, D_FFE = 3584;
constexpr float ALPHA = 1.4142135623730951f;
constexpr float NEGF = -1e30f;
constexpr int MAXSLOT = 2 * NBATCH * SEQ + N_EXP * 256;

typedef unsigned short bf16;
__device__ __forceinline__ unsigned f2bf(float f) { unsigned u = __float_as_uint(f); return (u + 0x7fffu + ((u >> 16) & 1u)) >> 16; }
__device__ __forceinline__ float ldf(const float* p) { return *p; }
__device__ __forceinline__ float ldf(const bf16* p) { return __uint_as_float(((unsigned)*p) << 16); }
__device__ __forceinline__ void stf(float* p, float v) { *p = v; }
__device__ __forceinline__ void stf(bf16* p, float v) { *p = (bf16)f2bf(v); }

__device__ __forceinline__ float dpp_add(float v, const int ctrl_tag) {
    int r;
    if (ctrl_tag == 0) r = __builtin_amdgcn_update_dpp(0, __float_as_int(v), 0xB1, 0xF, 0xF, false);
    else if (ctrl_tag == 1) r = __builtin_amdgcn_update_dpp(0, __float_as_int(v), 0x4E, 0xF, 0xF, false);
    else if (ctrl_tag == 2) r = __builtin_amdgcn_update_dpp(0, __float_as_int(v), 0x141, 0xF, 0xF, false);
    else r = __builtin_amdgcn_update_dpp(0, __float_as_int(v), 0x140, 0xF, 0xF, false);
    return v + __int_as_float(r);
}
__device__ __forceinline__ float row16_sum(float v) { v = dpp_add(v, 0); v = dpp_add(v, 1); v = dpp_add(v, 2); v = dpp_add(v, 3); return v; }
__device__ __forceinline__ float wave_sum(float v) {
    v = row16_sum(v);
    { const auto rr = __builtin_amdgcn_permlane16_swap(__float_as_uint(v), __float_as_uint(v), false, false); v = __uint_as_float(rr[0]) + __uint_as_float(rr[1]); }
    { const auto rr = __builtin_amdgcn_permlane32_swap(__float_as_uint(v), __float_as_uint(v), false, false); v = __uint_as_float(rr[0]) + __uint_as_float(rr[1]); }
    return v;
}
__device__ __forceinline__ float silu_f(float x) { return x / (1.f + __expf(-x)); }
__device__ __forceinline__ float gelu_tanh_f(float x) { const float u = 0.7978845608028654f * (x + 0.044715f * x * x * x); return 0.5f * x * (1.f + tanhf(u)); }
__device__ __forceinline__ float softplus_f(float x) { return fmaxf(x, 0.f) + log1pf(__expf(-fabsf(x))); }

struct ProjL { int ld, q, k, v, z, xbc, dt, gu, gv; };

__device__ __forceinline__ float4 ld4(const float* p) { return *(const float4*)p; }
__device__ __forceinline__ float4 ld4(const bf16* p) { const uint2 w = *(const uint2*)p; return make_float4(__uint_as_float(w.x << 16), __uint_as_float(w.x & 0xffff0000u), __uint_as_float(w.y << 16), __uint_as_float(w.y & 0xffff0000u)); }
typedef float nt_f4 __attribute__((ext_vector_type(4)));
__device__ __forceinline__ float4 ld4_nt(const float* p) { const nt_f4 v = __builtin_nontemporal_load((const nt_f4*)p); return make_float4(v[0], v[1], v[2], v[3]); }
__device__ __forceinline__ float4 ld4_nt(const bf16* p) { return ld4(p); }
template <class TY, class TX = float, bool NTX = false> __device__ __forceinline__ void ln_load(float (&v)[16], const TX* xrow, float a, const TY* y1, const TY* y2, int lane) {
#pragma unroll
    for (int j = 0; j < 4; ++j) {
        const float4 x = NTX ? ld4_nt(xrow + j * 256 + lane * 4) : ld4(xrow + j * 256 + lane * 4);
        float4 t = make_float4(a * x.x, a * x.y, a * x.z, a * x.w);
        if (y1) { const float4 y = ld4(y1 + j * 256 + lane * 4); t.x += y.x; t.y += y.y; t.z += y.z; t.w += y.w; }
        if (y2) { const float4 y = ld4(y2 + j * 256 + lane * 4); t.x += y.x; t.y += y.y; t.z += y.z; t.w += y.w; }
        v[4 * j] = t.x; v[4 * j + 1] = t.y; v[4 * j + 2] = t.z; v[4 * j + 3] = t.w;
    }
}
__device__ __forceinline__ void ln_add(float (&v)[16], const bf16* y, int lane) {
#pragma unroll
    for (int j = 0; j < 4; ++j) { const float4 t = ld4(y + j * 256 + lane * 4); v[4 * j] += t.x; v[4 * j + 1] += t.y; v[4 * j + 2] += t.z; v[4 * j + 3] += t.w; }
}
__device__ __forceinline__ void ln_finish(float (&v)[16], const float* g, const float* b, float* of, bf16* ob, int lane) {
    float s = 0.f;
#pragma unroll
    for (int i = 0; i < 16; ++i) s += v[i];
    const float mean = wave_sum(s) * (1.f / 1024.f); float s2 = 0.f;
#pragma unroll
    for (int i = 0; i < 16; ++i) { v[i] -= mean; s2 += v[i] * v[i]; }
    const float rstd = rsqrtf(wave_sum(s2) * (1.f / 1024.f) + 1e-5f);
#pragma unroll
    for (int j = 0; j < 4; ++j) {
        const float4 gg = *(const float4*)(g + j * 256 + lane * 4), bb = *(const float4*)(b + j * 256 + lane * 4);
        float4 o = make_float4(v[4 * j] * rstd * gg.x + bb.x, v[4 * j + 1] * rstd * gg.y + bb.y, v[4 * j + 2] * rstd * gg.z + bb.z, v[4 * j + 3] * rstd * gg.w + bb.w);
        if (of) *(float4*)(of + j * 256 + lane * 4) = o;
        if (ob) { uint2 w; w.x = f2bf(o.x) | (f2bf(o.y) << 16); w.y = f2bf(o.z) | (f2bf(o.w) << 16); *(uint2*)(ob + j * 256 + lane * 4) = w; }
    }
}

struct LnGB { float4 g[4], b[4]; };
__device__ __forceinline__ void ln_gb_load(LnGB& p, const float* g, const float* b, int lane) {
#pragma unroll
    for (int j = 0; j < 4; ++j) { p.g[j] = *(const float4*)(g + j * 256 + lane * 4); p.b[j] = *(const float4*)(b + j * 256 + lane * 4); }
}
__device__ __forceinline__ void ln_finish_r(float (&v)[16], const LnGB& p, float* of, bf16* ob, int lane) {
    float s = 0.f;
#pragma unroll
    for (int i = 0; i < 16; ++i) s += v[i];
    const float mean = wave_sum(s) * (1.f / 1024.f); float s2 = 0.f;
#pragma unroll
    for (int i = 0; i < 16; ++i) { v[i] -= mean; s2 += v[i] * v[i]; }
    const float rstd = rsqrtf(wave_sum(s2) * (1.f / 1024.f) + 1e-5f);
#pragma unroll
    for (int j = 0; j < 4; ++j) {
        const float4 gg = p.g[j], bb = p.b[j];
        float4 o = make_float4(v[4 * j] * rstd * gg.x + bb.x, v[4 * j + 1] * rstd * gg.y + bb.y, v[4 * j + 2] * rstd * gg.z + bb.z, v[4 * j + 3] * rstd * gg.w + bb.w);
        if (of) { nt_f4 ov; ov[0] = o.x; ov[1] = o.y; ov[2] = o.z; ov[3] = o.w; __builtin_nontemporal_store(ov, (nt_f4*)(of + j * 256 + lane * 4)); }
        if (ob) { uint2 w; w.x = f2bf(o.x) | (f2bf(o.y) << 16); w.y = f2bf(o.z) | (f2bf(o.w) << 16); *(uint2*)(ob + j * 256 + lane * 4) = w; }
    }
}
template <class TY> __device__ __forceinline__ void ln_row(const float* xrow, float a, const TY* y1, const TY* y2, const float* g, const float* b, float* of, bf16* ob, int lane) {
    float v[16]; ln_load<TY>(v, xrow, a, y1, y2, lane); ln_finish(v, g, b, of, ob, lane);
}

__device__ __forceinline__ void rope_inplace(float* P, ProjL L, const int* pos, long n_rows, long gt, long ngt) {
    for (long it = gt; it < n_rows * 96; it += ngt) {
        const int i = (int)(it & 7), hh = (int)((it >> 3) % 12); const long row = it / 96;
        const int off = (hh < 6 ? L.q : L.k) + (hh % 6) * 64;
        const float inv = powf(500000.0f, -(float)(2 * i) / 16.0f);
        const float ang = (float)pos[row] * inv;
        const float c = cosf(ang), s = sinf(ang);
        float* p = P + row * L.ld + off;
        const float x1 = p[i], x2 = p[i + 8];
        p[i] = x1 * c - x2 * s; p[i + 8] = x2 * c + x1 * s;
    }
}

template <class T> __device__ __forceinline__ void kmean_phase(const T* P, ProjL L, float* KM, int nb, long gt, long ngt) {
    for (long it = gt; it < (long)nb * ATT_H * NBLK * 64; it += ngt) {
        const int d = (int)(it & 63), n = (int)((it >> 6) % NBLK), h = (int)((it / (64 * NBLK)) % ATT_H), b = (int)(it / (64 * NBLK * ATT_H));
        const T* p = P + ((long)b * SEQ + n * MOBA_BLOCK) * L.ld + L.k + h * 64 + d; float s = 0.f;
        for (int r = 0; r < MOBA_BLOCK; ++r) s += ldf(p + (long)r * L.ld);
        KM[it] = s * (1.f / MOBA_BLOCK);
    }
}

template <class T> __device__ __forceinline__ void attn_naive_phase(const T* P, ProjL L, const float* KM, float* O, int ldo, int nb, int gw, int ngw, int lane) {
    for (long it = gw; it < (long)nb * ATT_H * SEQ; it += ngw) {
        const int q = (int)(it % SEQ), h = (int)((it / SEQ) % ATT_H), b = (int)(it / ((long)SEQ * ATT_H));
        const long row = (long)b * SEQ + q; const int qblk = q / MOBA_BLOCK;
        const float qv = ldf(P + row * L.ld + L.q + h * 64 + lane);
        float g[NBLK];
#pragma unroll
        for (int n = 0; n < NBLK; ++n) { const float t = wave_sum(qv * KM[(((long)b * ATT_H + h) * NBLK + n) * 64 + lane]); g[n] = (n < qblk) ? t : NEGF; }
        unsigned sel = 0u;
#pragma unroll
        for (int r = 0; r < 3; ++r) { float bv = -3.0e38f; int best = -1;
#pragma unroll
            for (int n = 0; n < NBLK; ++n) if (!((sel >> n) & 1u) && g[n] > bv) { bv = g[n]; best = n; }
            if (best >= 0 && bv > NEGF * 0.5f) sel |= 1u << best; }
        sel |= 1u << qblk;
        float m = -3.0e38f, l = 0.f, o = 0.f;
        for (int n = 0; n <= qblk; ++n) {
            if (!((sel >> n) & 1u)) continue;
            const int j0 = n * MOBA_BLOCK, j1 = (n == qblk) ? q + 1 : j0 + MOBA_BLOCK;
            const T* kp = P + ((long)b * SEQ + j0) * L.ld + L.k + h * 64 + lane;
            const T* vp = P + ((long)b * SEQ + j0) * L.ld + L.v + h * 64 + lane;
            for (int j = j0; j < j1; ++j, kp += L.ld, vp += L.ld) {
                const float s = wave_sum(qv * ldf(kp)) * 0.125f;
                const float mn = fmaxf(m, s), corr = __expf(m - mn), p = __expf(s - mn);
                l = l * corr + p; o = o * corr + p * ldf(vp); m = mn;
            }
        }
        O[row * ldo + h * 64 + lane] = o / l;
    }
}

template <int W, class TO> __device__ __forceinline__ void rms_rows_phase(const float* in, int ldi, const float* g, TO* out, int ldo, long n_rows, int gw, int ngw, int lane) {
    constexpr int PER = W / 64;
    for (long row = gw; row < n_rows; row += ngw) {
        float v[PER]; float s = 0.f;
#pragma unroll
        for (int j = 0; j < PER; ++j) { v[j] = in[row * ldi + j * 64 + lane]; s += v[j] * v[j]; }
        const float r = rsqrtf(wave_sum(s) * (1.f / W) + 1e-5f);
#pragma unroll
        for (int j = 0; j < PER; ++j) stf(out + row * ldo + j * 64 + lane, v[j] * r * g[j * 64 + lane]);
    }
}

template <class T, class TO> __device__ __forceinline__ void ssd_conv_phase(const T* P, ProjL L, const float* cw, const float* cb, const float* dtb, TO* XC, float* DT, long n_rows, long gt, long ngt) {
    for (long it = gt; it < n_rows * 902; it += ngt) {
        const int c = (int)(it % 902); const long row = it / 902; const int t = (int)(row % SEQ);
        if (c < SSD_CW) {
            float acc = cb[c];
#pragma unroll
            for (int i = 0; i < 4; ++i) { const int tt = t - 3 + i; if (tt >= 0) acc += cw[i * SSD_CW + c] * ldf(P + (row - 3 + i) * L.ld + L.xbc + c); }
            stf(XC + row * SSD_CW + c, silu_f(acc));
        } else {
            const int h = c - SSD_CW;
            DT[row * SSD_H + h] = softplus_f(ldf(P + row * L.ld + L.dt + h) + dtb[h]);
        }
    }
}

template <class T> __device__ __forceinline__ void ssd_scan_naive_phase(const T* XC, const float* DT, const float* a_log, const float* dsk, float* Y, int ldo, int nb, int gw, int ngw, int lane) {
    for (int it = gw; it < nb * SSD_H * 64; it += ngw) {
        const int p = it & 63, h = (it >> 6) % SSD_H, b = it / (64 * SSD_H), grp = h / (SSD_H / SSD_G);
        const float A = -__expf(a_log[h]), Dk = dsk[h];
        float s0 = 0.f, s1 = 0.f;
#pragma unroll 4
        for (int t = 0; t < SEQ; ++t) {
            const long row = (long)b * SEQ + t;
            const T* xr = XC + row * SSD_CW;
            const float dt = DT[row * SSD_H + h], x = ldf(xr + h * 64 + p);
            const float B0 = ldf(xr + SSD_W + grp * SSD_N + lane), B1 = ldf(xr + SSD_W + grp * SSD_N + 64 + lane);
            const float C0 = ldf(xr + SSD_W + SSD_G * SSD_N + grp * SSD_N + lane), C1 = ldf(xr + SSD_W + SSD_G * SSD_N + grp * SSD_N + 64 + lane);
            const float dec = __expf(dt * A), xd = x * dt;
            s0 = s0 * dec + xd * B0; s1 = s1 * dec + xd * B1;
            const float y = wave_sum(C0 * s0 + C1 * s1);
            if (lane == 0) Y[row * ldo + h * 64 + p] = y + Dk * x;
        }
    }
}

template <class T, class TO> __device__ __forceinline__ void ssd_gate_phase(const float* Y, int ldi, const T* P, ProjL L, const float* ng, TO* out, int ldo, long n_rows, int gw, int ngw, int lane) {
    for (long row = gw; row < n_rows; row += ngw) {
        float v[6];
#pragma unroll
        for (int j = 0; j < 6; ++j) { const int c = j * 64 + lane; v[j] = Y[row * ldi + c] * silu_f(ldf(P + row * L.ld + L.z + c)); }
        const float r0 = rsqrtf(wave_sum(v[0] * v[0] + v[1] * v[1] + v[2] * v[2]) * (1.f / 192.f) + 1e-5f);
        const float r1 = rsqrtf(wave_sum(v[3] * v[3] + v[4] * v[4] + v[5] * v[5]) * (1.f / 192.f) + 1e-5f);
#pragma unroll
        for (int j = 0; j < 6; ++j) { const int c = j * 64 + lane; stf(out + row * ldo + c, v[j] * (j < 3 ? r0 : r1) * ng[c]); }
    }
}

template <class T, bool PRE> __device__ __forceinline__ void gm_ln_phase(const T* P, ProjL L, const float* g, const float* b, float* VN, long n_rows, int gw, int ngw, int lane) {
    for (long row = gw; row < n_rows; row += ngw) {
        float v[4]; float s = 0.f;
#pragma unroll
        for (int j = 0; j < 4; ++j) { const float x = ldf(P + row * L.ld + L.gv + j * 64 + lane); v[j] = PRE ? x : gelu_tanh_f(x); s += v[j]; }
        const float mean = wave_sum(s) * (1.f / 256.f); float s2 = 0.f;
#pragma unroll
        for (int j = 0; j < 4; ++j) { v[j] -= mean; s2 += v[j] * v[j]; }
        const float rstd = rsqrtf(wave_sum(s2) * (1.f / 256.f) + 1e-5f);
#pragma unroll
        for (int j = 0; j < 4; ++j) VN[row * GM_W + j * 64 + lane] = v[j] * rstd * g[j * 64 + lane] + b[j * 64 + lane];
    }
}
template <class T, bool PRE> __device__ __forceinline__ void gm_mix_phase(const T* P, ProjL L, const float* VN, const float* ws_, const float* bs, float* GO, int ldo, long n_rows, long gt, long ngt) {
    for (long it = gt; it < n_rows * GM_W; it += ngt) {
        const int c = (int)(it % GM_W); const long row = it / GM_W; const int t = (int)(row % GM_CHUNK), g = c / 64; const long base = row - t;
        const float* w = ws_ + ((long)g * GM_CHUNK + t) * GM_CHUNK; float acc = 0.f;
        for (int s = 0; s <= t; ++s) acc += w[s] * VN[(base + s) * GM_W + c];
        acc += bs[g * GM_CHUNK + t];
        const float x = ldf(P + row * L.ld + L.gu + c); const float u = PRE ? x : gelu_tanh_f(x);
        GO[row * ldo + c] = u * acc;
    }
}

__device__ __forceinline__ void moe_route_phase(const float* H, const float* Wr, int* CNT, int* TE, float* TP, int* TS, long n_rows, int gw, int ngw, int lane) {
    for (long row = gw; row < n_rows; row += ngw) {
        float acc[N_EXP];
#pragma unroll
        for (int e = 0; e < N_EXP; ++e) acc[e] = 0.f;
        for (int j = 0; j < 16; ++j) { const int d = j * 64 + lane; const float hv = H[row * DM + d];
            const float4 w0 = *(const float4*)(Wr + d * N_EXP), w1 = *(const float4*)(Wr + d * N_EXP + 4);
            acc[0] += hv * w0.x; acc[1] += hv * w0.y; acc[2] += hv * w0.z; acc[3] += hv * w0.w; acc[4] += hv * w1.x; acc[5] += hv * w1.y; acc[6] += hv * w1.z; acc[7] += hv * w1.w; }
#pragma unroll
        for (int e = 0; e < N_EXP; ++e) acc[e] = wave_sum(acc[e]);
        int e0 = 0; float v0 = acc[0];
#pragma unroll
        for (int e = 1; e < N_EXP; ++e) if (acc[e] > v0) { v0 = acc[e]; e0 = e; }
        int e1 = -1; float v1 = -3.0e38f;
#pragma unroll
        for (int e = 0; e < N_EXP; ++e) if (e != e0 && acc[e] > v1) { v1 = acc[e]; e1 = e; }
        const float p1 = __expf(v1 - v0), den = 1.f + p1;
        if (lane == 0) {
            const int s0 = atomicAdd(&CNT[e0], 1), s1 = atomicAdd(&CNT[e1], 1);
            TE[row * 2] = e0; TE[row * 2 + 1] = e1; TP[row * 2] = 1.f / den; TP[row * 2 + 1] = p1 / den; TS[row * 2] = s0; TS[row * 2 + 1] = s1;
        }
    }
}

__device__ __forceinline__ void moe_route_block(const bf16* H, const float* Wr, int* CNT, int* TE, float* TP, int* TS, long n_rows, int gw_, int ngw_, int lane, int wave, int tid,
                                                __attribute__((address_space(3))) int* sh  ) {
    asm volatile("" : "+v"(tid));
    if (tid < 16) sh[tid] = 0;
    __syncthreads();
    int k = 0;
    for (long row = gw_; row < n_rows; row += ngw_, ++k) {
        float acc[N_EXP];
#pragma unroll
        for (int e = 0; e < N_EXP; ++e) acc[e] = 0.f;
        for (int j = 0; j < 16; ++j) { const int d = j * 64 + lane; const float hv = ldf(H + row * DM + d);
            const float4 w0 = *(const float4*)(Wr + d * N_EXP), w1 = *(const float4*)(Wr + d * N_EXP + 4);
            acc[0] += hv * w0.x; acc[1] += hv * w0.y; acc[2] += hv * w0.z; acc[3] += hv * w0.w; acc[4] += hv * w1.x; acc[5] += hv * w1.y; acc[6] += hv * w1.z; acc[7] += hv * w1.w; }
#pragma unroll
        for (int e = 0; e < N_EXP; ++e) acc[e] = wave_sum(acc[e]);
        int e0 = 0; float v0 = acc[0];
#pragma unroll
        for (int e = 1; e < N_EXP; ++e) if (acc[e] > v0) { v0 = acc[e]; e0 = e; }
        int e1 = -1; float v1 = -3.0e38f;
#pragma unroll
        for (int e = 0; e < N_EXP; ++e) if (e != e0 && acc[e] > v1) { v1 = acc[e]; e1 = e; }
        const float p1 = __expf(v1 - v0), den = 1.f + p1;
        if (lane == 0) {
            const int l0 = atomicAdd((int*)&sh[e0], 1), l1 = atomicAdd((int*)&sh[e1], 1);
            TE[row * 2] = e0; TE[row * 2 + 1] = e1; TP[row * 2] = 1.f / den; TP[row * 2 + 1] = p1 / den;
            sh[16 + (wave * 8 + k) * 4 + 0] = e0; sh[16 + (wave * 8 + k) * 4 + 1] = e1; sh[16 + (wave * 8 + k) * 4 + 2] = l0; sh[16 + (wave * 8 + k) * 4 + 3] = l1;
        }
    }
    __syncthreads();
    if (tid < N_EXP) sh[8 + tid] = atomicAdd(&CNT[tid], sh[tid]);
    __syncthreads();
    k = 0;
    for (long row = gw_; row < n_rows; row += ngw_, ++k)
        if (lane == 0) { const int e0 = sh[16 + (wave * 8 + k) * 4], e1 = sh[16 + (wave * 8 + k) * 4 + 1];
            TS[row * 2] = sh[8 + e0] + sh[16 + (wave * 8 + k) * 4 + 2]; TS[row * 2 + 1] = sh[8 + e1] + sh[16 + (wave * 8 + k) * 4 + 3]; }
    __syncthreads();
}
__device__ __forceinline__ int moe_base(const int* CNT, int e) { int b = 0; for (int i = 0; i < e; ++i) b += (CNT[i] + 255) & ~255; return b; }
__device__ __forceinline__ void moe_scatter_phase(const int* CNT, const int* TE, const float* TP, const int* TS, int* LIST, float* SP, int* GS, long n_rows, long gt, long ngt) {
    for (long it = gt; it < n_rows * 2; it += ngt) {
        const int e = TE[it]; const int gs = moe_base(CNT, e) + TS[it];
        LIST[gs] = (int)(it >> 1); SP[gs] = TP[it]; GS[it] = gs;
    }
}

template <class TA, int EPI> __global__ void __launch_bounds__(256) sgemm_k(const TA* A, int lda, const int* rowlist, const float* B, const float* B2, int ldb, long bstride, void* Cv, int ldc, int M, int N, int K, const int* CNT, const float* scale) {
    __shared__ float As[16][68], Bs[16][68], Bs2[16][68];
    int row_base = 0, mrows = M;
    if (CNT) { const int e = blockIdx.z; row_base = moe_base(CNT, e); mrows = CNT[e]; B += (long)e * bstride; if (B2) B2 += (long)e * bstride; }
    const int m0 = blockIdx.y * 64; if (m0 >= mrows) return;
    const int n0 = blockIdx.x * 64, tid = threadIdx.x, tx = tid & 15, ty = tid >> 4;
    float acc[4][4], acc2[4][4];
#pragma unroll
    for (int i = 0; i < 4; ++i)
#pragma unroll
        for (int j = 0; j < 4; ++j) { acc[i][j] = 0.f; acc2[i][j] = 0.f; }
    const int ar = tid >> 2, ak = (tid & 3) * 4; long arow = -1;
    { const int lr = m0 + ar; if (lr < mrows) { arow = rowlist ? (long)rowlist[row_base + lr] : (long)(row_base + lr); } }
    const int bk = tid >> 4, bn = (tid & 15) * 4;
    for (int k0 = 0; k0 < K; k0 += 16) {
        float av[4] = {0.f, 0.f, 0.f, 0.f};
        if (arow >= 0) {
#pragma unroll
            for (int i = 0; i < 4; ++i) av[i] = ldf(A + arow * lda + k0 + ak + i);
        }
#pragma unroll
        for (int i = 0; i < 4; ++i) As[ak + i][ar] = av[i];
#pragma unroll
        for (int i = 0; i < 4; ++i) { const int n = n0 + bn + i; const bool ok = n < N;
            Bs[bk][bn + i] = ok ? B[(long)(k0 + bk) * ldb + n] : 0.f;
            if (EPI == 1 || EPI == 2) Bs2[bk][bn + i] = ok ? B2[(long)(k0 + bk) * ldb + n] : 0.f; }
        __syncthreads();
#pragma unroll
        for (int kk = 0; kk < 16; ++kk) {
            float a[4], b[4], b2[4];
#pragma unroll
            for (int i = 0; i < 4; ++i) { a[i] = As[kk][ty * 4 + i]; b[i] = Bs[kk][tx * 4 + i]; if (EPI == 1 || EPI == 2) b2[i] = Bs2[kk][tx * 4 + i]; }
#pragma unroll
            for (int i = 0; i < 4; ++i)
#pragma unroll
                for (int j = 0; j < 4; ++j) { acc[i][j] += a[i] * b[j]; if (EPI == 1 || EPI == 2) acc2[i][j] += a[i] * b2[j]; }
        }
        __syncthreads();
    }
#pragma unroll
    for (int i = 0; i < 4; ++i) { const int lr = m0 + ty * 4 + i; if (lr >= mrows) continue; const long crow = row_base + lr;
#pragma unroll
        for (int j = 0; j < 4; ++j) { const int n = n0 + tx * 4 + j; if (n >= N) continue;
            float v = acc[i][j];
            if (EPI == 1 || EPI == 2) v = silu_f(v) * acc2[i][j];
            if (EPI == 3) v *= scale[crow];
            if (EPI == 2) ((bf16*)Cv)[crow * ldc + n] = (bf16)f2bf(v); else ((float*)Cv)[crow * ldc + n] = v; } }
}

#define GW_DECL const int lane = threadIdx.x & 63; const int gw = (int)((blockIdx.x * (long)blockDim.x + threadIdx.x) >> 6); const int ngw = (int)((gridDim.x * (long)blockDim.x) >> 6); (void)lane; (void)gw; (void)ngw;
#define GT_DECL const long gt = blockIdx.x * (long)blockDim.x + threadIdx.x; const long ngt = gridDim.x * (long)blockDim.x;

__global__ void k_ln_in(const float* x, const float* g, const float* b, float* H, long n_rows) { GW_DECL for (long r = gw; r < n_rows; r += ngw) ln_row<float>(x + r * DM, 1.f, nullptr, nullptr, g, b, H + r * DM, nullptr, lane); }
__global__ void k_ln_res(float* H, const float* Y, const float* g, const float* b, float* OUT, long n_rows) { GW_DECL for (long r = gw; r < n_rows; r += ngw) ln_row<float>(H + r * DM, ALPHA, Y + r * DM, nullptr, g, b, OUT + r * DM, nullptr, lane); }
__global__ void k_ln_moe(float* H, const float* F2, const int* GS, const float* g, const float* b, float* OUT, long n_rows) { GW_DECL for (long r = gw; r < n_rows; r += ngw) ln_row<float>(H + r * DM, ALPHA, F2 + (long)GS[r * 2] * DM, F2 + (long)GS[r * 2 + 1] * DM, g, b, OUT + r * DM, nullptr, lane); }
__global__ void k_rope(float* P, ProjL L, const int* pos, long n_rows) { GT_DECL rope_inplace(P, L, pos, n_rows, gt, ngt); }
__global__ void k_kmean(const float* P, ProjL L, float* KM, int nb) { GT_DECL kmean_phase<float>(P, L, KM, nb, gt, ngt); }
__global__ void k_attn(const float* P, ProjL L, const float* KM, float* O, int ldo, int nb) { GW_DECL attn_naive_phase<float>(P, L, KM, O, ldo, nb, gw, ngw, lane); }
__global__ void k_rms384(const float* in, int ldi, const float* g, float* out, int ldo, long n_rows) { GW_DECL rms_rows_phase<384, float>(in, ldi, g, out, ldo, n_rows, gw, ngw, lane); }
__global__ void k_rms256(const float* in, int ldi, const float* g, float* out, int ldo, long n_rows) { GW_DECL rms_rows_phase<256, float>(in, ldi, g, out, ldo, n_rows, gw, ngw, lane); }
__global__ void k_ssd_conv(const float* P, ProjL L, const float* cw, const float* cb, const float* dtb, float* XC, float* DT, long n_rows) { GT_DECL ssd_conv_phase<float, float>(P, L, cw, cb, dtb, XC, DT, n_rows, gt, ngt); }
__global__ void k_ssd_scan(const float* XC, const float* DT, const float* a_log, const float* dsk, float* Y, int ldo, int nb) { GW_DECL ssd_scan_naive_phase<float>(XC, DT, a_log, dsk, Y, ldo, nb, gw, ngw, lane); }
__global__ void k_ssd_gate(const float* Y, int ldi, const float* P, ProjL L, const float* ng, float* out, int ldo, long n_rows) { GW_DECL ssd_gate_phase<float, float>(Y, ldi, P, L, ng, out, ldo, n_rows, gw, ngw, lane); }
__global__ void k_gm_ln(const float* P, ProjL L, const float* g, const float* b, float* VN, long n_rows) { GW_DECL gm_ln_phase<float, false>(P, L, g, b, VN, n_rows, gw, ngw, lane); }
__global__ void k_gm_mix(const float* P, ProjL L, const float* VN, const float* ws_, const float* bs, float* GO, int ldo, long n_rows) { GT_DECL gm_mix_phase<float, false>(P, L, VN, ws_, bs, GO, ldo, n_rows, gt, ngt); }
__global__ void k_moe_init(int* CNT, int* LIST, int nslots) { GT_DECL if (gt < N_EXP) CNT[gt] = 0; for (long i = gt; i < nslots; i += ngt) LIST[i] = -1; }
__global__ void k_moe_route(const float* H, const float* Wr, int* CNT, int* TE, float* TP, int* TS, long n_rows) { GW_DECL moe_route_phase(H, Wr, CNT, TE, TP, TS, n_rows, gw, ngw, lane); }
__global__ void k_moe_scatter(const int* CNT, const int* TE, const float* TP, const int* TS, int* LIST, float* SP, int* GS, long n_rows) { GT_DECL moe_scatter_phase(CNT, TE, TP, TS, LIST, SP, GS, n_rows, gt, ngt); }

struct Inputs {
    const float *x; const int* pos; const float *ln_in_g, *ln_in_b, *w_in, *conv_w, *conv_b, *dt_bias, *a_log, *d_skip, *ssd_norm_g, *att_norm_g, *gm_ln_g, *gm_ln_b, *gm_w_s, *gm_b_s, *gm_norm_g, *w_out,
        *ln1_g, *ln1_b, *ln2_g, *ln2_b, *ffn_w_gate, *ffn_w_up, *ffn_w_down, *router_w, *moe_w_gate, *moe_w_up, *moe_w_down;
};

static void run_simple(const Inputs& I, int nb, unsigned char* ws, float* aux  , float* OUT, hipStream_t st, float* ckpt = nullptr) {
    const long M = (long)nb * SEQ; const size_t MB = 1u << 20;
    const size_t hsz = (size_t)M * DM * 4;
    float* H = (float*)ws; float* MIX = (float*)(ws + hsz); float* Y = (float*)(ws + 2 * hsz); unsigned char* BIG = ws + 3 * hsz + (size_t)N_EXP * 256 * DM * 4;
    float* XC = Y;
    float* VN = aux;
    float* PROJ = (float*)BIG;
    size_t big_bytes = (size_t)M * D_IN * 4; { size_t a = (size_t)M * D_FF * 4; if (a > big_bytes) big_bytes = a; size_t c = (size_t)(2 * M + N_EXP * 256) * D_FFE * 2; if (c > big_bytes) big_bytes = c; }
    big_bytes = (big_bytes + 255) & ~(size_t)255;
    unsigned char* SM = BIG + big_bytes;
    float* KM = (float*)SM; SM += (size_t)nb * ATT_H * NBLK * 64 * 4;
    float* DT = (float*)SM; SM += (size_t)M * SSD_H * 4;
    int* CNT = (int*)SM; SM += 256;
    int* TE = (int*)SM; SM += (size_t)M * 2 * 4; float* TP = (float*)SM; SM += (size_t)M * 2 * 4; int* TS = (int*)SM; SM += (size_t)M * 2 * 4; int* GS = (int*)SM; SM += (size_t)M * 2 * 4;
    const int nslots = (int)(2 * M + N_EXP * 256);
    int* LIST = (int*)SM; SM += (size_t)nslots * 4; float* SP = (float*)SM; SM += (size_t)nslots * 4;
    (void)MB;
    const ProjL L{D_IN, 0, 384, 768, 1152, 1536, 2432, 2438, 2694};
    const int TB = 256; const int GWB = 2048;
    k_ln_in<<<GWB, TB, 0, st>>>(I.x, I.ln_in_g, I.ln_in_b, H, M);
    for (int i = 0; i < 2; ++i) {
        sgemm_k<float, 0><<<dim3((D_IN + 63) / 64, (unsigned)(M / 64), 1), 256, 0, st>>>(H, DM, nullptr, I.w_in + (size_t)i * DM * D_IN, nullptr, D_IN, 0, PROJ, D_IN, (int)M, D_IN, DM, nullptr, nullptr);
        k_rope<<<GWB, TB, 0, st>>>(PROJ, L, I.pos, M);
        const size_t ck_stride = (size_t)M * (D_IN + 3 * DM); float* ck = ckpt ? ckpt + (size_t)i * ck_stride : nullptr;
        if (ck) hipMemcpyAsync(ck, PROJ, (size_t)M * D_IN * 4, hipMemcpyDeviceToDevice, st);
        k_kmean<<<96 * nb, TB, 0, st>>>(PROJ, L, KM, nb);
        k_attn<<<GWB * 2, TB, 0, st>>>(PROJ, L, KM, MIX, DM, nb);
        k_rms384<<<GWB, TB, 0, st>>>(MIX, DM, I.att_norm_g + i * ATT_W, MIX, DM, M);
        k_ssd_conv<<<GWB * 2, TB, 0, st>>>(PROJ, L, I.conv_w + (size_t)i * 4 * SSD_CW, I.conv_b + i * SSD_CW, I.dt_bias + i * SSD_H, XC, DT, M);
        k_ssd_scan<<<(nb * SSD_H * 64 * 64 + TB - 1) / TB, TB, 0, st>>>(XC, DT, I.a_log + i * SSD_H, I.d_skip + i * SSD_H, MIX + ATT_W, DM, nb);
        k_ssd_gate<<<GWB, TB, 0, st>>>(MIX + ATT_W, DM, PROJ, L, I.ssd_norm_g + i * SSD_W, MIX + ATT_W, DM, M);
        k_gm_ln<<<GWB, TB, 0, st>>>(PROJ, L, I.gm_ln_g + i * GM_W, I.gm_ln_b + i * GM_W, VN, M);
        k_gm_mix<<<GWB * 2, TB, 0, st>>>(PROJ, L, VN, I.gm_w_s + (size_t)i * GM_G * GM_CHUNK * GM_CHUNK, I.gm_b_s + i * GM_G * GM_CHUNK, MIX + ATT_W + SSD_W, DM, M);
        k_rms256<<<GWB, TB, 0, st>>>(MIX + ATT_W + SSD_W, DM, I.gm_norm_g + i * GM_W, MIX + ATT_W + SSD_W, DM, M);
        if (ck) hipMemcpyAsync(ck + (size_t)M * D_IN, MIX, hsz, hipMemcpyDeviceToDevice, st);
        sgemm_k<float, 0><<<dim3(DM / 64, (unsigned)(M / 64), 1), 256, 0, st>>>(MIX, DM, nullptr, I.w_out + (size_t)i * DM * DM, nullptr, DM, 0, Y, DM, (int)M, DM, DM, nullptr, nullptr);
        k_ln_res<<<GWB, TB, 0, st>>>(H, Y, I.ln1_g + i * DM, I.ln1_b + i * DM, H, M);
        if (ck) hipMemcpyAsync(ck + (size_t)M * (D_IN + DM), H, hsz, hipMemcpyDeviceToDevice, st);
        if (i == 0) {
            float* ACT = (float*)BIG;
            sgemm_k<float, 1><<<dim3(D_FF / 64, (unsigned)(M / 64), 1), 256, 0, st>>>(H, DM, nullptr, I.ffn_w_gate, I.ffn_w_up, D_FF, 0, ACT, D_FF, (int)M, D_FF, DM, nullptr, nullptr);
            sgemm_k<float, 0><<<dim3(DM / 64, (unsigned)(M / 64), 1), 256, 0, st>>>(ACT, D_FF, nullptr, I.ffn_w_down, nullptr, DM, 0, Y, DM, (int)M, DM, D_FF, nullptr, nullptr);
            k_ln_res<<<GWB, TB, 0, st>>>(H, Y, I.ln2_g + i * DM, I.ln2_b + i * DM, H, M);
            if (ck) hipMemcpyAsync(ck + (size_t)M * (D_IN + 2 * DM), H, hsz, hipMemcpyDeviceToDevice, st);
        } else {
            bf16* ACTM = (bf16*)BIG; float* F2 = MIX;
            k_moe_init<<<256, TB, 0, st>>>(CNT, LIST, nslots);
            k_moe_route<<<GWB, TB, 0, st>>>(H, I.router_w, CNT, TE, TP, TS, M);
            k_moe_scatter<<<256, TB, 0, st>>>(CNT, TE, TP, TS, LIST, SP, GS, M);
            sgemm_k<float, 2><<<dim3(D_FFE / 64, (unsigned)(M / 64), N_EXP), 256, 0, st>>>(H, DM, LIST, I.moe_w_gate, I.moe_w_up, D_FFE, (long)DM * D_FFE, ACTM, D_FFE, 0, D_FFE, DM, CNT, nullptr);
            sgemm_k<bf16, 3><<<dim3(DM / 64, (unsigned)(M / 64), N_EXP), 256, 0, st>>>(ACTM, D_FFE, nullptr, I.moe_w_down, nullptr, DM, (long)D_FFE * DM, F2, DM, 0, DM, D_FFE, CNT, SP);
            k_ln_moe<<<GWB, TB, 0, st>>>(H, F2, GS, I.ln2_g + i * DM, I.ln2_b + i * DM, OUT, M);
            if (ck) hipMemcpyAsync(ck + (size_t)M * (D_IN + 2 * DM), OUT, hsz, hipMemcpyDeviceToDevice, st);
        }
    }
}

#define LAS __attribute__((address_space(3)))
namespace pg8 {
#define PG8_LAS __attribute__((address_space(3)))
typedef unsigned short bf16_t;
typedef short bf16x8 __attribute__((ext_vector_type(8)));
typedef float f32x4 __attribute__((ext_vector_type(4)));
typedef unsigned u32x4 __attribute__((ext_vector_type(4)));
constexpr int BM = 256, BK = 64, HALF = 128, HTB = HALF * BK * 2  , STAGE_BYTES = 8 * HTB, NXCD = 8, WGM = 8;

__host__ __device__ __forceinline__ int lds_byte(int r, int c) { const int st = (r >> 4) * 2 + (c >> 5), rr = r & 15, cc = c & 31, ob = rr * 64 + cc * 2; return st * 1024 + (ob ^ (((ob >> 9) & 1) << 5)); }
__host__ __device__ __forceinline__ void stage_rc(int b, int& R, int& C) { const int st = b / 1024, sb = b % 1024, swz = sb ^ (((sb >> 9) & 1) << 5); R = (st >> 1) * 16 + swz / 64; C = (st & 1) * 32 + (swz % 64) / 2; }
__host__ __device__ __forceinline__ int perm32(int rho) { const int n = rho >> 4, i = rho & 15; return 8 * (i >> 2) + 4 * n + (i & 3); }

struct Unit { int pm, pn, kofs; };
struct Gemm { const bf16_t* A; const bf16_t* Bt; int M, N, K, ld; };

struct StaticOrder {
    int nM, nN, nwg, G, c;
    __host__ __device__ void init(int M, int N, int G_, int c_) { nM = M / BM; nN = N / BM; nwg = nM * nN; G = G_; c = c_; }
    __host__ __device__ bool next(int i, Unit& u) const {
        const long L = (long)i * G + c; if (L >= nwg) return false;
        int wgid = (int)L; { const int q = nwg / NXCD, r = nwg % NXCD, xcd = wgid % NXCD, off = wgid / NXCD; wgid = (xcd < r ? xcd * (q + 1) : r * (q + 1) + (xcd - r) * q) + off; }
        const int nig = WGM * nN, gid = wgid / nig, fm = gid * WGM, gsz = (nM - fm) < WGM ? (nM - fm) : WGM;
        u.pm = fm + ((wgid % nig) % gsz); u.pn = (wgid % nig) / gsz; u.kofs = 0; return true;
    }
    __device__ __forceinline__ void a_ready(const Unit&) const {}
    __device__ __forceinline__ void done(const Unit&) const {}
};
__device__ __forceinline__ unsigned cvt_pk_bf16(float lo, float hi) { unsigned r; asm volatile("v_cvt_pk_bf16_f32 %0, %1, %2" : "=v"(r) : "v"(lo), "v"(hi)); return r; }
typedef float f32x2 __attribute__((ext_vector_type(2)));
typedef int i32x4_ __attribute__((ext_vector_type(4)));
typedef int i32x8_ __attribute__((ext_vector_type(8)));
__device__ __forceinline__ i32x8_ cat8(bf16x8 lo, bf16x8 hi) { const i32x4_ l = (i32x4_)lo, h = (i32x4_)hi; return __builtin_shufflevector(l, h, 0, 1, 2, 3, 4, 5, 6, 7); }
template <class Epi, class Sched, bool ALIGN_EPI = false, bool SP2 = false, bool FP8 = false>
__device__ __forceinline__ void gemm_phase(PG8_LAS unsigned char* lds, const Gemm g, const Sched& S, const Epi& E, const int tid) {
    const int wid = __builtin_amdgcn_readfirstlane(tid >> 6), lane = tid & 63, wr = wid >> 2, wc = wid & 3, fr = lane & 15, fq = lane >> 4;
    const int K = g.ld; int nt = g.K / BK;
    if constexpr (FP8) asm volatile("" : "+s"(nt));
    unsigned voffA[2], voffB[2];
#pragma unroll
    for (int i = 0; i < 2; ++i) { int R, C; stage_rc(tid * 16 + i * 8192, R, C); const int Rb = Epi::PERM ? ((R & ~31) + perm32(R & 31)) : R;
        voffA[i] = (unsigned)(R * K + C) * 2u; voffB[i] = (unsigned)(Rb * K + C) * 2u; }
    const size_t kstep = (size_t)(BK * 2);
    const size_t hstep = (size_t)HALF * K * 2;
    const size_t tstep = 2 * hstep;
    const unsigned ldsw = (unsigned)wid * 1024u;
    const int aoff = lds_byte(wr * 64 + fr, fq * 8), boff = lds_byte(wc * 32 + fr, fq * 8);
#define PG8_SA(b, h) (((b) * 2 + (h)) * HTB)
#define PG8_SB(b, h) ((4 + (b) * 2 + (h)) * HTB)
#define PG8_STAGE(bufoff, gbase, voff) do { const char* sb_ = (const char*)(gbase); asm volatile("" : "+s"(sb_));   \
        _Pragma("unroll") for (int _i = 0; _i < 2; ++_i) { unsigned vo_ = (voff)[_i]; asm volatile("" : "+v"(vo_));   \
        __builtin_amdgcn_global_load_lds((const unsigned*)(sb_ + vo_), (PG8_LAS unsigned*)(lds + (bufoff) + ldsw + _i * 8192), 16, 0, 0); } } while (0)
#define PG8_LDA(dst, b, h) do { _Pragma("unroll") for (int m = 0; m < 4; ++m) _Pragma("unroll") for (int k = 0; k < 2; ++k) dst[m][k] = *(const PG8_LAS bf16x8*)(lds + PG8_SA(b, h) + aoff + m * 2048 + k * 1024); } while (0)
#define PG8_LDB(dst, b, h) do { _Pragma("unroll") for (int n = 0; n < 2; ++n) _Pragma("unroll") for (int k = 0; k < 2; ++k) dst[n][k] = *(const PG8_LAS bf16x8*)(lds + PG8_SB(b, h) + boff + n * 2048 + k * 1024); } while (0)
#define PG8_MMA(ai, bj, At, Bt) do { __builtin_amdgcn_s_setprio(1); _Pragma("unroll") for (int m = 0; m < 4; ++m) _Pragma("unroll") for (int n = 0; n < 2; ++n) { \
        if constexpr (FP8) acc[ai][bj][m][n] = __builtin_amdgcn_mfma_scale_f32_16x16x128_f8f6f4(cat8(Bt[n][0], Bt[n][1]), cat8(At[m][0], At[m][1]), acc[ai][bj][m][n], 0, 0, 0, 0, 0, 0); \
        else { _Pragma("unroll") for (int k = 0; k < 2; ++k) acc[ai][bj][m][n] = __builtin_amdgcn_mfma_f32_16x16x32_bf16(Bt[n][k], At[m][k], acc[ai][bj][m][n], 0, 0, 0); } } __builtin_amdgcn_s_setprio(0); } while (0)
#define PG8_WAIT_V(n) asm volatile("s_waitcnt vmcnt(" #n ")" ::: "memory")
#define PG8_WAIT_L(n) asm volatile("s_waitcnt lgkmcnt(" #n ")" ::: "memory")
#define PG8_BAR __builtin_amdgcn_s_barrier()
#define PG8_SCHED __builtin_amdgcn_sched_barrier(0)
    Unit cur, nxt; int ui = 0;
    if (!S.next(0, cur)) return;
    f32x4 acc[2][2][4][2];
#pragma unroll
    for (int a = 0; a < 2; ++a)
#pragma unroll
        for (int b = 0; b < 2; ++b)
#pragma unroll
            for (int m = 0; m < 4; ++m)
#pragma unroll
                for (int n = 0; n < 2; ++n) acc[a][b][m][n] = (f32x4){0.f, 0.f, 0.f, 0.f};
    bf16x8 At[4][2], B0[2][2], B1[2][2];
    const char* cA = (const char*)g.A + (size_t)cur.pm * tstep + (size_t)cur.kofs * 2; const char* cB = (const char*)g.Bt + (size_t)cur.pn * tstep + (size_t)cur.kofs * 2;
    S.a_ready(cur);
    if constexpr (SP2) {
        PG8_STAGE(PG8_SB(0, 0), cB, voffB); PG8_STAGE(PG8_SB(0, 1), cB + hstep, voffB); PG8_STAGE(PG8_SA(0, 0), cA, voffA); PG8_STAGE(PG8_SA(0, 1), cA + hstep, voffA);
        if (wr == 1) PG8_BAR;
        PG8_WAIT_V(2); PG8_BAR;
        PG8_STAGE(PG8_SB(1, 0), cB + kstep, voffB); PG8_STAGE(PG8_SA(1, 0), cA + kstep, voffA); PG8_STAGE(PG8_SB(1, 1), cB + hstep + kstep, voffB);
        PG8_WAIT_V(6); PG8_BAR;
    } else {
        PG8_STAGE(PG8_SB(0, 0), cB, voffB); PG8_STAGE(PG8_SA(0, 0), cA, voffA); PG8_STAGE(PG8_SB(0, 1), cB + hstep, voffB); PG8_STAGE(PG8_SA(0, 1), cA + hstep, voffA);
        if (wr == 1) PG8_BAR;
        PG8_WAIT_V(4); PG8_BAR;
        PG8_STAGE(PG8_SB(1, 0), cB + kstep, voffB); PG8_STAGE(PG8_SA(1, 0), cA + kstep, voffA); PG8_STAGE(PG8_SB(1, 1), cB + hstep + kstep, voffB);
        PG8_WAIT_V(6); PG8_BAR;
    }
    for (;;) {
        const bool has_next = S.next(ui + 1, nxt);
        const char* nA = has_next ? (const char*)g.A + (size_t)nxt.pm * tstep + (size_t)nxt.kofs * 2 : cA; const char* nB = has_next ? (const char*)g.Bt + (size_t)nxt.pn * tstep + (size_t)nxt.kofs * 2 : cB;
        for (int t = 0; t < nt; t += 2) {
            const bool last = (t == nt - 2);
            const char* a1 = cA + (size_t)(t + 1) * kstep;
            const char* a2 = last ? nA : cA + (size_t)(t + 2) * kstep; const char* b2 = last ? nB : cB + (size_t)(t + 2) * kstep;
            const char* a3 = a2 + kstep; const char* b3 = b2 + kstep;
            if (last && has_next) S.a_ready(nxt);
            if constexpr (SP2) {
            PG8_LDB(B0, 0, 0); PG8_LDB(B1, 0, 1); PG8_SCHED; PG8_LDA(At, 0, 0); PG8_STAGE(PG8_SA(1, 1), a1 + hstep, voffA);
            PG8_WAIT_V(8); PG8_WAIT_L(0); PG8_BAR; PG8_MMA(0, 0, At, B0); PG8_MMA(0, 1, At, B1); PG8_BAR; PG8_SCHED;
            PG8_LDA(At, 0, 1); PG8_STAGE(PG8_SB(0, 0), b2, voffB); PG8_STAGE(PG8_SB(0, 1), b2 + hstep, voffB); PG8_STAGE(PG8_SA(0, 0), a2, voffA);
            PG8_WAIT_V(8); PG8_WAIT_L(0); PG8_BAR; PG8_MMA(1, 0, At, B0); PG8_MMA(1, 1, At, B1); PG8_BAR; PG8_SCHED;
            PG8_LDB(B0, 1, 0); PG8_LDB(B1, 1, 1); PG8_SCHED; PG8_LDA(At, 1, 0); PG8_STAGE(PG8_SA(0, 1), a2 + hstep, voffA);
            PG8_WAIT_V(8); PG8_WAIT_L(0); PG8_BAR; PG8_MMA(0, 0, At, B0); PG8_MMA(0, 1, At, B1); PG8_BAR; PG8_SCHED;
            PG8_LDA(At, 1, 1); PG8_STAGE(PG8_SB(1, 0), b3, voffB); PG8_STAGE(PG8_SB(1, 1), b3 + hstep, voffB); PG8_STAGE(PG8_SA(1, 0), a3, voffA);
            PG8_WAIT_V(8); PG8_WAIT_L(0); PG8_BAR; PG8_MMA(1, 0, At, B0); PG8_MMA(1, 1, At, B1); PG8_BAR; PG8_SCHED;
            } else {
            PG8_LDB(B0, 0, 0); PG8_SCHED; PG8_LDA(At, 0, 0); PG8_STAGE(PG8_SA(1, 1), a1 + hstep, voffA);
            PG8_WAIT_L(8); PG8_BAR; PG8_WAIT_L(0); PG8_MMA(0, 0, At, B0); PG8_BAR; PG8_SCHED;
            PG8_LDB(B1, 0, 1); PG8_STAGE(PG8_SB(0, 0), b2, voffB);
            PG8_BAR; PG8_WAIT_L(0); PG8_MMA(0, 1, At, B1); PG8_BAR;
            PG8_LDA(At, 0, 1); PG8_STAGE(PG8_SA(0, 0), a2, voffA);
            PG8_BAR; PG8_WAIT_L(0); PG8_MMA(1, 0, At, B0); PG8_BAR; PG8_SCHED;
            PG8_STAGE(PG8_SB(0, 1), b2 + hstep, voffB);
            PG8_WAIT_V(6); PG8_BAR; PG8_MMA(1, 1, At, B1); PG8_BAR;
            PG8_LDB(B0, 1, 0); PG8_SCHED; PG8_LDA(At, 1, 0); PG8_STAGE(PG8_SA(0, 1), a2 + hstep, voffA);
            PG8_WAIT_L(8); PG8_BAR; PG8_WAIT_L(0); PG8_MMA(0, 0, At, B0); PG8_BAR; PG8_SCHED;
            PG8_LDB(B1, 1, 1); PG8_STAGE(PG8_SB(1, 0), b3, voffB);
            PG8_BAR; PG8_WAIT_L(0); PG8_MMA(0, 1, At, B1); PG8_BAR;
            PG8_LDA(At, 1, 1); PG8_STAGE(PG8_SA(1, 0), a3, voffA);
            PG8_BAR; PG8_WAIT_L(0); PG8_MMA(1, 0, At, B0); PG8_BAR; PG8_SCHED;
            PG8_STAGE(PG8_SB(1, 1), b3 + hstep, voffB);
            PG8_WAIT_V(6); PG8_BAR; PG8_MMA(1, 1, At, B1); PG8_BAR;
            }
        }
        if constexpr (ALIGN_EPI) { if (wr == 0) PG8_BAR; }
        if constexpr (!Epi::AFTER_DRAIN) { E(acc, cur, wr, wc, fr, fq); S.done(cur); }
        if (!has_next) break;
#pragma unroll
        for (int a = 0; a < 2; ++a)
#pragma unroll
            for (int b = 0; b < 2; ++b)
#pragma unroll
                for (int m = 0; m < 4; ++m)
#pragma unroll
                    for (int n = 0; n < 2; ++n) acc[a][b][m][n] = (f32x4){0.f, 0.f, 0.f, 0.f};
        cur = nxt; cA = nA; cB = nB; ++ui;
        if constexpr (ALIGN_EPI) { if (wr == 1) PG8_BAR; }
    }
    PG8_WAIT_V(0);
    if constexpr (!ALIGN_EPI) { if (wr == 0) PG8_BAR; }
    PG8_BAR;
    if constexpr (Epi::AFTER_DRAIN) { E.fused(acc, cur, wr, wc, fr, fq, lds, wid, lane); S.done(cur); }
#undef PG8_SA
#undef PG8_SB
#undef PG8_STAGE
#undef PG8_LDA
#undef PG8_LDB
#undef PG8_MMA
#undef PG8_WAIT_V
#undef PG8_WAIT_L
#undef PG8_BAR
#undef PG8_SCHED
}
}
#define XB_TMO      128
#define XB_XCNT(j)  (256  + 64 * (j))
#define XB_XSUB(j)  (1280 + 64 * (j))
#define XB_XGEN(j)  (2304 + 64 * (j))
#define XB_TOP      3328
#define XB_TOPGEN   3392
#define XCD_BAR_WORDS 3456
#define XB_SPIN_CAP (1u << 24)

__device__ __forceinline__ unsigned xb_ld(unsigned* p)              { return __hip_atomic_load(p, __ATOMIC_RELAXED, __HIP_MEMORY_SCOPE_AGENT); }
__device__ __forceinline__ unsigned xb_add(unsigned* p, unsigned v) { return __hip_atomic_fetch_add(p, v, __ATOMIC_RELAXED, __HIP_MEMORY_SCOPE_AGENT); }
__device__ __forceinline__ unsigned xb_xcc_id() { return (unsigned)__builtin_amdgcn_s_getreg((3 << 11) | 20) & 0xFu; }
#define XB_SPIN(cond, bar) do { unsigned _sp = 0; while (cond) { __builtin_amdgcn_s_sleep(1); \
    if ((++_sp & 255u) == 0u) { if (xb_ld(&(bar)[XB_TMO])) break; if (_sp > XB_SPIN_CAP) { atomicAdd(&(bar)[XB_TMO], 1u); break; } } } } while (0)

__device__ __forceinline__ unsigned xb_lane_fresh() { unsigned l; asm volatile("v_mbcnt_lo_u32_b32 %0, -1, 0\n\tv_mbcnt_hi_u32_b32 %0, -1, %0" : "=v"(l)); return l; }
struct XcdBarrier {
    unsigned* bar; unsigned x; int w0;
    volatile LAS unsigned* st;
};

__device__ __forceinline__ XcdBarrier xcd_barrier_post(unsigned* bar, volatile LAS unsigned* st) {
    XcdBarrier b; b.bar = bar; b.x = xb_xcc_id(); b.st = st; b.w0 = (__builtin_amdgcn_readfirstlane((int)threadIdx.x >> 6) == 0);
    if (threadIdx.x == 0) (void)xb_add(&bar[XB_XCNT(b.x)], 1u);
    return b;
}
__device__ __forceinline__ void xcd_barrier_complete(unsigned* bar, unsigned x, unsigned& nloc, unsigned& nx) {
    const unsigned G = gridDim.x * gridDim.y * gridDim.z;
    unsigned sum, cnt, mine, sp = 0u;
    for (;;) {
        sum = 0u; cnt = 0u; mine = 0u;
#pragma unroll
        for (unsigned j = 0; j < 16; ++j) { const unsigned c = xb_ld(&bar[XB_XCNT(j)]); sum += c; cnt += (c > 0u) ? 1u : 0u; mine = (j == x) ? c : mine; }
        if (sum == G) break;
        __builtin_amdgcn_s_sleep(1);
        if ((++sp & 255u) == 0u) { if (xb_ld(&bar[XB_TMO])) break; if (sp > XB_SPIN_CAP) { atomicAdd(&bar[XB_TMO], 1u); break; } }
    }
    nloc = mine > 0u ? mine : 1u; nx = cnt > 0u ? cnt : 1u;
}

__device__ __forceinline__ void xcd_barrier(const XcdBarrier& b) {
    asm volatile("s_waitcnt vmcnt(0)" ::: "memory");
    __syncthreads();
    if (b.w0 && xb_lane_fresh() == 0u) {
        unsigned* bar = b.bar;
        __builtin_amdgcn_s_waitcnt(0);
        unsigned nloc = b.st[0], nx = b.st[1];
        if (nloc == 0u) { xcd_barrier_complete(bar, b.x, nloc, nx); b.st[0] = nloc; b.st[1] = nx; }
        const unsigned old = xb_add(&bar[XB_XSUB(b.x)], 1u);
        const unsigned gen = old / nloc;
        if (old + 1u == (gen + 1u) * nloc) {
            __builtin_amdgcn_fence(__ATOMIC_RELEASE, "agent");
            asm volatile("s_waitcnt vmcnt(0)" ::: "memory");
            const unsigned og = xb_add(&bar[XB_TOP], 1u);
            const unsigned tg = og / nx;
            if (og + 1u == (tg + 1u) * nx) xb_add(&bar[XB_TOPGEN], 1u);
            else XB_SPIN(xb_ld(&bar[XB_TOPGEN]) == tg, bar);
            __builtin_amdgcn_fence(__ATOMIC_ACQUIRE, "agent");
            xb_add(&bar[XB_XGEN(b.x)], 1u);
            asm volatile("s_waitcnt vmcnt(0)" ::: "memory");
        } else {
            XB_SPIN(xb_ld(&bar[XB_XGEN(b.x)]) == gen, bar);
            __builtin_amdgcn_fence(__ATOMIC_ACQUIRE, "agent");
            asm volatile("s_waitcnt vmcnt(0)" ::: "memory");
        }
    }
    __syncthreads();
}
#include <hip/hip_bf16.h>
#include <cmath>
namespace attn_body {
using bf16=__hip_bfloat16;
using bf16x8=__attribute__((ext_vector_type(8)))short;
using s16x4=__attribute__((ext_vector_type(4)))short;
using f32x16=__attribute__((ext_vector_type(16)))float;
using u32x4=__attribute__((ext_vector_type(4)))unsigned;
constexpr int NHEAD=6,SEQ=2048,D=64,QP=3072,OP=1024;
constexpr int NW=8,QBLK=32,QB=QBLK*NW,KVBLK=64,NQB=SEQ/QB;
constexpr int ATTN_UNIT_ROWS=QB;
__device__ __forceinline__ int crow(int r,int hi){return (r&3)+8*(r>>2)+4*hi;}
#define SBAR() __builtin_amdgcn_sched_barrier(0)
__device__ __forceinline__ void cmask(f32x16&p0,f32x16&p1,int jb,int qrel,int hi){
  const float NEG=-INFINITY; int kb=64*jb+4*hi;
  #pragma unroll
  for(int r=0;r<16;++r){int kv=kb+(r&3)+8*(r>>2); if(kv>qrel)p0[r]=NEG; if(kv+32>qrel)p1[r]=NEG;}
}

constexpr int NSLOT=3, SLOTB=8192;
constexpr int LDS_K=0, LDS_V=NSLOT*SLOTB, LDS_WS=2*NSLOT*SLOTB, LDS_OST=LDS_WS+NW*64*4, LDS_BYTES=LDS_OST+NW*4096;
constexpr float C2=0.125f*1.4426950408889634f;
__device__ __forceinline__ void glds16(const void*gsrc,unsigned lds_dst){unsigned keep;
  asm volatile("s_mov_b32 %0, m0\n\ts_mov_b32 m0, %2\n\ts_nop 0\n\tglobal_load_lds_dwordx4 %1, off\n\ts_mov_b32 m0, %0":"=&s"(keep):"v"(gsrc),"s"(lds_dst):"memory");}
__device__ __forceinline__ float max3f(float a,float b,float c){float r;asm("v_max3_f32 %0, %1, %2, %3":"=v"(r):"v"(a),"v"(b),"v"(c));return r;}
__device__ __forceinline__ float max2f(float a,float b){float r;asm("v_max_f32_e32 %0, %1, %2":"=v"(r):"v"(a),"v"(b));return r;}
__device__ __forceinline__ float fadd_s(float a,float b){float r;asm("v_add_f32_e32 %0, %1, %2":"=v"(r):"v"(a),"v"(b));return r;}
__device__ __forceinline__ float fsub_s(float a,float b){float r;asm("v_sub_f32_e32 %0, %1, %2":"=v"(r):"v"(a),"v"(b));return r;}
typedef float f32x2_t __attribute__((ext_vector_type(2))); typedef __bf16 bf16x2_t __attribute__((ext_vector_type(2)));
__device__ __forceinline__ unsigned cvtpk_s(float lo,float hi){f32x2_t v={lo,hi};bf16x2_t b=__builtin_convertvector(v,bf16x2_t);return __builtin_bit_cast(unsigned,b);}
#define WAIT_BAR(N) asm volatile("s_waitcnt vmcnt(" #N ") lgkmcnt(0)\n\ts_barrier":::"memory")

__device__ __forceinline__ void qkt(f32x16&p0,f32x16&p1,const char*Kslot,const bf16x8*qr,int r32,int hi){ const f32x16 negm=f32x16{};
  const char*kb=Kslot+hi*1024+r32*16;
  #pragma unroll
  for(int d0=0;d0<4;++d0){
    const bf16x8 b0=*reinterpret_cast<const bf16x8*>(kb+d0*2048);
    const bf16x8 b1=*reinterpret_cast<const bf16x8*>(kb+d0*2048+512);
    if(d0==0){p0=__builtin_amdgcn_mfma_f32_32x32x16_bf16(b0,qr[0],negm,0,0,0);p1=__builtin_amdgcn_mfma_f32_32x32x16_bf16(b1,qr[0],negm,0,0,0);}
    else{p0=__builtin_amdgcn_mfma_f32_32x32x16_bf16(b0,qr[d0],p0,0,0,0);p1=__builtin_amdgcn_mfma_f32_32x32x16_bf16(b1,qr[d0],p1,0,0,0);}}
}
typedef __attribute__((address_space(3))) const char* lds_cptr;
typedef short v4i16_t __attribute__((ext_vector_type(4)));
__device__ __forceinline__ void kload8(bf16x8*kf,lds_cptr kp){
  kf[0]=*(const __attribute__((address_space(3))) bf16x8*)(kp);      kf[1]=*(const __attribute__((address_space(3))) bf16x8*)(kp+512);
  kf[2]=*(const __attribute__((address_space(3))) bf16x8*)(kp+2048); kf[3]=*(const __attribute__((address_space(3))) bf16x8*)(kp+2560);
  kf[4]=*(const __attribute__((address_space(3))) bf16x8*)(kp+4096); kf[5]=*(const __attribute__((address_space(3))) bf16x8*)(kp+4608);
  kf[6]=*(const __attribute__((address_space(3))) bf16x8*)(kp+6144); kf[7]=*(const __attribute__((address_space(3))) bf16x8*)(kp+6656);
}
__device__ __forceinline__ void kload2(bf16x8*kf,lds_cptr kp,int j){ kf[2*j]=*(const __attribute__((address_space(3))) bf16x8*)(kp+j*2048); kf[2*j+1]=*(const __attribute__((address_space(3))) bf16x8*)(kp+j*2048+512); }
__device__ __forceinline__ s16x4 vtr(lds_cptr p){ return __builtin_bit_cast(s16x4,__builtin_amdgcn_ds_read_tr16_b64_v4i16((__attribute__((address_space(3))) v4i16_t*)p)); }
__device__ __forceinline__ float rowmax(const f32x16&p0,const f32x16&p1){
  float a=max3f(p0[0],p0[1],p1[0]),b=max3f(p0[2],p0[3],p1[1]);a=max3f(a,p1[2],p1[3]);
  #pragma unroll
  for(int r=4;r<16;r+=4){a=max3f(a,p0[r],p0[r+1]);b=max3f(b,p0[r+2],p0[r+3]);a=max3f(a,p1[r],p1[r+1]);b=max3f(b,p1[r+2],p1[r+3]);}
  const float m=max2f(a,b);
  auto rr=__builtin_amdgcn_permlane32_swap(__float_as_uint(m),__float_as_uint(m),false,false);
  return max2f(__uint_as_float(rr[0]),__uint_as_float(rr[1]));
}
__device__ __forceinline__ void pv(f32x16*o,int vb,bf16x8 pa0,bf16x8 pa1,bf16x8 pa2,bf16x8 pa3){
  #pragma unroll
  for(int d0=0;d0<2;++d0){s16x4 lo[4],hi[4];
    #pragma unroll
    for(int ks=0;ks<4;++ks){
      asm volatile("ds_read_b64_tr_b16 %0,%1 offset:%c2":"=&v"(lo[ks]):"v"(vb),"i"(d0*4096+ks*1024):"memory");
      asm volatile("ds_read_b64_tr_b16 %0,%1 offset:%c2":"=&v"(hi[ks]):"v"(vb),"i"(d0*4096+ks*1024+512):"memory");}
    asm volatile("s_waitcnt lgkmcnt(0)":::"memory");SBAR();
    #define PK(k) (bf16x8){lo[k][0],lo[k][1],lo[k][2],lo[k][3],hi[k][0],hi[k][1],hi[k][2],hi[k][3]}
    o[d0]=__builtin_amdgcn_mfma_f32_32x32x16_bf16(pa0,PK(0),o[d0],0,0,0);
    o[d0]=__builtin_amdgcn_mfma_f32_32x32x16_bf16(pa1,PK(1),o[d0],0,0,0);
    o[d0]=__builtin_amdgcn_mfma_f32_32x32x16_bf16(pa2,PK(2),o[d0],0,0,0);
    o[d0]=__builtin_amdgcn_mfma_f32_32x32x16_bf16(pa3,PK(3),o[d0],0,0,0);
    #undef PK
  }
}

#ifndef ATTN_STORE16
#define ATTN_STORE16(p,v) (*(u32x4*)(p)=(v))
#endif
template<int THRL> __device__ __forceinline__ void attn_unit(int b,int h,int qb,const bf16*Q,const bf16*__restrict__ K,const bf16*__restrict__ V,bf16*O,const float*__restrict__ KM,int KMH,char*shm,const int tid){
  const int lane=tid&63,r32=lane&31,hi=lane>>5; const int wid=__builtin_amdgcn_readfirstlane(tid>>6);
  const long rowbase=(long)b*SEQ; const int q0=qb*QB;
  const bf16*Qw=Q+(rowbase+q0+wid*QBLK)*QP+h*D;
  const bf16*Kh=K+rowbase*QP+h*D,*Vh=V+rowbase*QP+h*D;
  const unsigned lds0=(unsigned)(uintptr_t)shm;
  float*wsf=(float*)(shm+LDS_WS)+wid*64;
  const bf16*ksrc=Kh+(long)lane*QP+wid*8;
  const bf16*vsrc=Vh+(long)(16*(wid&3)+(lane>>2))*QP+(wid>>2)*32+(lane&3)*8;
  const unsigned kdst=lds0+LDS_K+wid*1024, vdst=lds0+LDS_V+wid*1024;
  #define TI(t) (((t)<4)?(NT-4+(t)):((t)-4))
  #define DMA_K(t,slot) glds16(ksrc+(long)TI(t)*KVBLK*QP,(unsigned)__builtin_amdgcn_readfirstlane(kdst+(slot)))
  #define DMA_V(t,slot) glds16(vsrc+(long)TI(t)*KVBLK*QP,(unsigned)__builtin_amdgcn_readfirstlane(vdst+(slot)))
  const char*Kbase=shm+LDS_K; bf16x8 kf[8];
  const lds_cptr shm3=(lds_cptr)shm; const lds_cptr kp0=shm3+LDS_K+hi*1024+r32*16; const lds_cptr vp0=shm3+LDS_V+((lane>>4)&1)*32+(lane&3)*8+(4*hi+((lane&15)>>2))*64;
  const int NT=(q0+QB)/KVBLK;
  DMA_K(0,0);DMA_V(0,0);DMA_K(1,SLOTB);
  bf16x8 qr[4];
  #pragma unroll
  for(int d0=0;d0<4;++d0)qr[d0]=*reinterpret_cast<const bf16x8*>(&Qw[(long)r32*QP+d0*16+hi*8]);

  unsigned sel=0u;
  if(qb>0){ float gt_[8];
    #pragma unroll
    for(int n=0;n<8;++n){ float a_=0.f;
      if(n<qb){ const float*km=KM+((long)(b*NHEAD+h)*8+n)*64+hi*8;
        #pragma unroll
        for(int d0=0;d0<4;++d0){ float4 k0=*reinterpret_cast<const float4*>(km+d0*16), k1=*reinterpret_cast<const float4*>(km+d0*16+4);
          { const float4 k2=*reinterpret_cast<const float4*>(km+KMH+d0*16), k3=*reinterpret_cast<const float4*>(km+KMH+d0*16+4); k0.x+=k2.x;k0.y+=k2.y;k0.z+=k2.z;k0.w+=k2.w;k1.x+=k3.x;k1.y+=k3.y;k1.z+=k3.z;k1.w+=k3.w; }
          const bf16x8 qv=qr[d0];
          a_+=__uint_as_float(((unsigned)(unsigned short)qv[0])<<16)*k0.x+__uint_as_float(((unsigned)(unsigned short)qv[1])<<16)*k0.y+__uint_as_float(((unsigned)(unsigned short)qv[2])<<16)*k0.z+__uint_as_float(((unsigned)(unsigned short)qv[3])<<16)*k0.w
             +__uint_as_float(((unsigned)(unsigned short)qv[4])<<16)*k1.x+__uint_as_float(((unsigned)(unsigned short)qv[5])<<16)*k1.y+__uint_as_float(((unsigned)(unsigned short)qv[6])<<16)*k1.z+__uint_as_float(((unsigned)(unsigned short)qv[7])<<16)*k1.w; }
        a_+=__shfl_xor(a_,32); }
      gt_[n]=(n<qb)?a_:-1e30f; }
    #pragma unroll
    for(int r_=0;r_<3;++r_){ float bv=-3.0e38f; int best=-1;
      #pragma unroll
      for(int n=0;n<8;++n) if(!((sel>>n)&1u)&&gt_[n]>bv){bv=gt_[n];best=n;}
      if(best>=0&&bv>-0.5e30f) sel|=1u<<best; } }
  if(hi==0)wsf[32+r32]=__uint_as_float(sel); asm volatile("s_waitcnt lgkmcnt(0)":::"memory");
  float mhat=0.f,l_reg=0.f;f32x16 o[2];o[0]=f32x16{};o[1]=f32x16{};
  const int qrel=wid*QBLK+r32;
  #define CMASK(P0,P1,t) do{ if((t)<4){cmask(P0,P1,(t),qrel,hi);} else if(!((__float_as_uint(wsf[32+r32])>>(((t)-4)>>2))&1u)){ _Pragma("unroll") for(int r_=0;r_<16;++r_){P0[r_]=-INFINITY;P1[r_]=-INFINITY;} } }while(0)
  bool resc=false;
  #define START(P0,P1) do{ const float rm=rowmax(P0,P1); resc=false; \
    { const float dl=rm; mhat=fadd_s(mhat,dl); \
      _Pragma("unroll") for(int r=0;r<16;++r){P0[r]=fsub_s(P0[r],dl);P1[r]=fsub_s(P1[r],dl);} \
      } \
    _Pragma("unroll") for(int r=0;r<16;++r)P0[r]=__builtin_amdgcn_exp2f(P0[r]); }while(0)
  #define RESC() do{ if(resc){ asm volatile("s_waitcnt lgkmcnt(0)":::"memory"); \
      _Pragma("unroll") for(int d_=0;d_<2;++d_) _Pragma("unroll") for(int r=0;r<16;++r)o[d_][r]*=wsf[crow(r,hi)]; } }while(0)
  f32x16 pA0,pA1,pB0,pB1;
  int sl_prev=0,sl_cur=0,sl_next=SLOTB;
  #define ROT() do{sl_prev=sl_cur;sl_cur=sl_next;sl_next=(sl_next==(NSLOT-1)*SLOTB)?0:sl_next+SLOTB;}while(0)
  DMA_K(2,2*SLOTB);
  WAIT_BAR(3);
  qkt(pA0,pA1,Kbase,qr,r32,hi);asm volatile("s_nop 15\n\ts_nop 7":"+v"(pA0),"+v"(pA1));CMASK(pA0,pA1,0);
  START(pA0,pA1);
  _Pragma("unroll") for(int r=0;r<16;++r)pA1[r]=__builtin_amdgcn_exp2f(pA1[r]);
  WAIT_BAR(0);
  DMA_K(3,0);DMA_V(1,SLOTB);
  ROT();
  kload8(kf,kp0+sl_cur);
  WAIT_BAR(2);
  s16x4 vlo[8],vhi[8]; u32x4 pw0,pw1,pw2,pw3;
  #define PKW(P,B) cvtpk_s(P[B],P[B+1])
  #define PAF(k) __builtin_bit_cast(bf16x8,pw##k)
  #define VFR(i) (bf16x8){vlo[i][0],vlo[i][1],vlo[i][2],vlo[i][3],vhi[i][0],vhi[i][1],vhi[i][2],vhi[i][3]}
  #define PIN(x) asm volatile("":"+v"(x))
  #define MX3(a,b,c) __builtin_fmaxf(__builtin_fmaxf((a),(b)),(c))
  #define GAPA(MF,A0,A1,A2,A3,W0,W1,PW) do{ MF; sacc+=A0; sacc+=A1; sacc+=A2; sacc+=A3; PIN(sacc); W0; W1; PIN(PW); SBAR(); }while(0)
  #define EX(v) __builtin_amdgcn_exp2f(v)
  #define GAPB(MF,X,B) do{ MF; X[B]=EX(X[B]); X[B+1]=EX(X[B+1]); X[B+2]=EX(X[B+2]); X[B+3]=EX(X[B+3]); PIN(X); SBAR(); }while(0)
  #define VRD(i) do{ vlo[i]=vtr(vp_+(((i)>>2)*4096+((i)&3)*1024)); vhi[i]=vtr(vp_+(((i)>>2)*4096+((i)&3)*1024+512)); }while(0)
  #define KRD(G,j) do{ if(G){ kload2(kf,kp0+sl_next,j); SBAR(); } }while(0)
  #define STEP(C0,C1,P0,P1,t,GK,GV,GL) do{ SBAR(); \
    const lds_cptr vp_=vp0+sl_prev; \
    VRD(0); SBAR(); float sacc=(P0[0]+P0[1]); \
    GAPA(C0=__builtin_amdgcn_mfma_f32_32x32x16_bf16(kf[0],qr[0],f32x16{},0,0,0), P0[2],P0[3],P0[4],P0[5],     pw0[0]=PKW(P0,0), pw0[1]=PKW(P0,2), pw0); \
    VRD(4); SBAR(); GAPA(C1=__builtin_amdgcn_mfma_f32_32x32x16_bf16(kf[1],qr[0],f32x16{},0,0,0), P0[6],P0[7],P0[8],P0[9],     pw0[2]=PKW(P0,4), pw0[3]=PKW(P0,6), pw0); \
    VRD(1); SBAR(); GAPA(C0=__builtin_amdgcn_mfma_f32_32x32x16_bf16(kf[2],qr[1],C0,0,0,0),   P0[10],P0[11],P0[12],P0[13], pw1[0]=PKW(P0,8), pw1[1]=PKW(P0,10), pw1); \
    VRD(5); SBAR(); GAPA(C1=__builtin_amdgcn_mfma_f32_32x32x16_bf16(kf[3],qr[1],C1,0,0,0),   P0[14],P0[15],P1[0],P1[1],   pw1[2]=PKW(P0,12),pw1[3]=PKW(P0,14), pw1); \
    VRD(2); SBAR(); GAPA(C0=__builtin_amdgcn_mfma_f32_32x32x16_bf16(kf[4],qr[2],C0,0,0,0),   P1[2],P1[3],P1[4],P1[5],     pw2[0]=PKW(P1,0), pw2[1]=PKW(P1,2), pw2); \
    VRD(6); SBAR(); GAPA(C1=__builtin_amdgcn_mfma_f32_32x32x16_bf16(kf[5],qr[2],C1,0,0,0),   P1[6],P1[7],P1[8],P1[9],     pw2[2]=PKW(P1,4), pw2[3]=PKW(P1,6), pw2); \
    VRD(3); SBAR(); GAPA(C0=__builtin_amdgcn_mfma_f32_32x32x16_bf16(kf[6],qr[3],C0,0,0,0),   P1[10],P1[11],P1[12],P1[13], pw3[0]=PKW(P1,8), pw3[1]=PKW(P1,10), pw3); \
    VRD(7); SBAR(); GAPA(C1=__builtin_amdgcn_mfma_f32_32x32x16_bf16(kf[7],qr[3],C1,0,0,0),   P1[14],P1[15],0.f,0.f,       pw3[2]=PKW(P1,12),pw3[3]=PKW(P1,14), pw3); \
    l_reg+=sacc; \
    if(GK){DMA_K((t)+3,sl_cur);} if(GV){DMA_V((t)+1,sl_next);} \
    CMASK(C0,C1,t); \
    _Pragma("unroll") for(int r=0;r<16;++r){C0[r]-=mhat;C1[r]-=mhat;} \
    { float a=MX3(C0[0],C0[1],C1[0]),b=MX3(C0[2],C0[3],C1[1]); a=MX3(a,C1[2],C1[3]); \
      _Pragma("unroll") for(int r=4;r<16;r+=4){a=MX3(a,C0[r],C0[r+1]);b=MX3(b,C0[r+2],C0[r+3]);a=MX3(a,C1[r],C1[r+1]);b=MX3(b,C1[r+2],C1[r+3]);} \
      float rm=__builtin_fmaxf(a,b); { auto rr=__builtin_amdgcn_permlane32_swap(__float_as_uint(rm),__float_as_uint(rm),false,false); rm=__builtin_fmaxf(__uint_as_float(rr[0]),__uint_as_float(rr[1])); } \
      resc=false; \
      if(__builtin_expect(__any(rm>(float)THRL),0)){ const float dl=__builtin_fmaxf(rm,0.f); mhat+=dl; \
        _Pragma("unroll") for(int r=0;r<16;++r){C0[r]-=dl;C1[r]-=dl;} \
        const float f=__builtin_amdgcn_exp2f(-dl); l_reg*=f; if(hi==0)wsf[r32]=f; resc=true; } } \
    SBAR(); \
    GAPB(o[0]=__builtin_amdgcn_mfma_f32_32x32x16_bf16(PAF(0),VFR(0),o[0],0,0,0), C0,0); \
    GAPB(o[1]=__builtin_amdgcn_mfma_f32_32x32x16_bf16(PAF(0),VFR(4),o[1],0,0,0), C0,4); \
    KRD(GL,0); GAPB(o[0]=__builtin_amdgcn_mfma_f32_32x32x16_bf16(PAF(1),VFR(1),o[0],0,0,0), C0,8); \
    KRD(GL,1); GAPB(o[1]=__builtin_amdgcn_mfma_f32_32x32x16_bf16(PAF(1),VFR(5),o[1],0,0,0), C0,12); \
    KRD(GL,2); GAPB(o[0]=__builtin_amdgcn_mfma_f32_32x32x16_bf16(PAF(2),VFR(2),o[0],0,0,0), C1,0); \
    KRD(GL,3); GAPB(o[1]=__builtin_amdgcn_mfma_f32_32x32x16_bf16(PAF(2),VFR(6),o[1],0,0,0), C1,4); \
    GAPB(o[0]=__builtin_amdgcn_mfma_f32_32x32x16_bf16(PAF(3),VFR(3),o[0],0,0,0), C1,8); \
    GAPB(o[1]=__builtin_amdgcn_mfma_f32_32x32x16_bf16(PAF(3),VFR(7),o[1],0,0,0), C1,12); \
    }while(0)
  int t=1;
  for(;t+5<NT;t+=2){
    STEP(pB0,pB1,pA0,pA1,t,true,true,true);     WAIT_BAR(2); RESC(); ROT();
    STEP(pA0,pA1,pB0,pB1,t+1,true,true,true);   WAIT_BAR(2); RESC(); ROT();
  }
  #define ENDW(tt) do{ if((tt)+3<NT){WAIT_BAR(2);} else if((tt)+2<NT){WAIT_BAR(1);} else {WAIT_BAR(0);} }while(0)
  for(;t+1<NT;t+=2){
    STEP(pB0,pB1,pA0,pA1,t,(t+3<NT),(t+1<NT),(t+1<NT));       ENDW(t);   RESC(); ROT();
    STEP(pA0,pA1,pB0,pB1,t+1,(t+4<NT),(t+2<NT),(t+2<NT));     ENDW(t+1); RESC(); ROT();
  }
  STEP(pB0,pB1,pA0,pA1,NT-1,false,false,false); RESC();
  { float sacc=pB0[0]+pB0[1]; _Pragma("unroll") for(int r=2;r<16;++r)sacc+=pB0[r]; _Pragma("unroll") for(int r=0;r<16;++r)sacc+=pB1[r]; l_reg+=sacc;
    pw0=(u32x4){PKW(pB0,0),PKW(pB0,2),PKW(pB0,4),PKW(pB0,6)};pw1=(u32x4){PKW(pB0,8),PKW(pB0,10),PKW(pB0,12),PKW(pB0,14)};pw2=(u32x4){PKW(pB1,0),PKW(pB1,2),PKW(pB1,4),PKW(pB1,6)};pw3=(u32x4){PKW(pB1,8),PKW(pB1,10),PKW(pB1,12),PKW(pB1,14)};
    SBAR(); pv(o,(int)(unsigned)(size_t)vp0+sl_cur,PAF(0),PAF(1),PAF(2),PAF(3)); }
  #undef PKW
  #undef PAF
  #undef VFR
  #undef PIN
  #undef MX3
  #undef GAPA
  #undef GAPB
  #undef EX
  #undef VRD
  #undef KRD
  #undef STEP
  #undef ENDW
  {auto rr=__builtin_amdgcn_permlane32_swap(__float_as_uint(l_reg),__float_as_uint(l_reg),false,false);l_reg=__uint_as_float(rr[0])+__uint_as_float(rr[1]);}
  if(hi==0)wsf[32+r32]=l_reg;asm volatile("s_waitcnt lgkmcnt(0)":::"memory");
  float rli[16];
  #pragma unroll
  for(int r=0;r<16;++r)rli[r]=__builtin_amdgcn_rcpf(wsf[32+crow(r,hi)]);
  bf16*Ow=O+(rowbase+q0+wid*QBLK)*OP+h*D;
  { bf16*stg=(bf16*)(shm+LDS_OST)+wid*2048;
    #pragma unroll
    for(int r=0;r<16;++r){const int orow=crow(r,hi);
      #pragma unroll
      for(int d0=0;d0<2;++d0)stg[orow*64+d0*32+r32]=__float2bfloat16(o[d0][r]*rli[r]);}
    asm volatile("s_waitcnt lgkmcnt(0)":::"memory");
    #pragma unroll
    for(int i=0;i<4;++i){const int row=i*8+(lane>>3),ch=lane&7; const u32x4 v=*(const u32x4*)(stg+row*64+ch*8); ATTN_STORE16(Ow+(long)row*OP+ch*8,v);} }
  asm volatile("s_waitcnt lgkmcnt(0)\n\ts_barrier":::"memory");
  #undef DMA_K
  #undef DMA_V
  #undef TI
  #undef CMASK
  #undef START
  #undef RESC
  #undef ROT
}
constexpr int ATTN_LDS_BYTES=LDS_BYTES;
#undef SBAR
#undef WAIT_BAR
}
#undef LAS
constexpr int NB = DEBUG_BUILD ? 2 : 8;
constexpr int M_ = NB * SEQ;
constexpr int NSLOT = 2 * M_ + N_EXP * 256;
constexpr int PLD = 3072;
constexpr int FQ = 0, FK = 384, FV = 768, FZ = 1152, FGU = 1536, FGV = 1792, FXBC = 2048, FDT = 2944;
constexpr int NGU = 2 * D_FF, NGUE = 2 * D_FFE;

constexpr size_t al256(size_t x) { return (x + 255) & ~(size_t)255; }
constexpr size_t MiB = 1u << 20;
constexpr size_t O_CTL = 0, CTL_BYTES = 1 * MiB;
constexpr size_t O_RT = 1 * MiB;
constexpr size_t O_TE = O_RT + (size_t)M_ * 64, O_TP = O_TE + (size_t)M_ * 8, O_TS = O_TP + (size_t)M_ * 8, O_GS = O_TS + (size_t)M_ * 8;
constexpr size_t O_SP = O_GS + (size_t)M_ * 8;
constexpr size_t O_KM = O_SP + al256((size_t)NSLOT * 4);
constexpr size_t O_DT = O_KM + (size_t)2 * NB * ATT_H * NBLK * 64 * 4;
constexpr size_t O_WSB = al256(O_DT + (size_t)M_ * 24);
constexpr size_t O_HB = (O_WSB + (size_t)2 * GM_G * GM_CHUNK * GM_CHUNK * 2 + MiB - 1) / MiB * MiB;
constexpr size_t O_MWGU = O_HB + (size_t)M_ * DM * 2;
constexpr size_t O_WIN = O_MWGU + (size_t)N_EXP * NGUE * DM * 2;
constexpr size_t O_WOUT = O_WIN + (size_t)2 * PLD * DM * 2;
constexpr size_t O_WGU = O_WOUT + (size_t)2 * DM * DM * 2;
constexpr size_t O_WD = O_WGU + (size_t)NGU * DM * 2;
constexpr size_t O_SCR = O_WD + (size_t)DM * D_FF * 2;
constexpr size_t O_PROJ = O_SCR;
constexpr size_t O_XC = O_PROJ + (size_t)M_ * PLD * 2;
constexpr size_t O_MIXU = O_XC + (size_t)M_ * SSD_CW * 2;
constexpr size_t O_MIXB = O_MIXU + (size_t)M_ * DM * 4;
constexpr size_t O_VN = O_MIXB + (size_t)M_ * DM * 2;
constexpr size_t O_MIXEND = O_VN + (size_t)M_ * GM_W * 4;
constexpr size_t O_Y = O_SCR;
constexpr size_t O_ACT = O_Y + (size_t)M_ * DM * 4;
constexpr size_t O_XG = O_WIN;
constexpr size_t O_ACTM = O_XG + (size_t)NSLOT * DM * 2;
constexpr size_t O_MOEEND = O_ACTM + (size_t)NSLOT * D_FFE * 2;
constexpr size_t WS_END = O_MOEEND > O_MIXEND ? O_MOEEND : O_MIXEND;
static_assert(O_ACT + (size_t)M_ * D_FF * 2 <= O_MIXEND + (size_t)M_ * 4096, "act");
static_assert((size_t)NB * 16 * SSD_H * 8192 * 4 <= (size_t)M_ * SSD_CW * 2, "SSD states fit in the XC slot");
static_assert((size_t)NB * 32 * 768 * 4 <= (size_t)M_ * GM_W * 4, "dt/acum hand-off fits in the VN slot");
static_assert(WS_END <= 487000000ull, "workspace map exceeds the guaranteed size");
static_assert((size_t)N_EXP * DM * D_FFE * 2 <= (size_t)NBATCH * SEQ * DM * 4, "MWD fits in d_out");
constexpr int CW_BAR = 4096, CW_CNT = 1024, CW_Q = 1040, CW_ERR = 2048;

constexpr int RING_BYTES = 131072, MISC_OFF = RING_BYTES + 320, LDS_BYTES = 147456;

#define GAS __attribute__((address_space(1)))
#define LAS __attribute__((address_space(3)))
typedef GAS unsigned gu32;
#define RLX_AGENT __ATOMIC_RELAXED, __HIP_MEMORY_SCOPE_AGENT
#define LDS_WAIT() asm volatile("s_waitcnt lgkmcnt(0)" ::: "memory")

constexpr float QSCALE = 0.125f * 1.4426950408889634f;
constexpr int MOE_KSPLIT = 2, TAIL_UNITS = 128;
constexpr int TAIL_SLOTS = (TAIL_UNITS / 4) * 256;
constexpr float W8_GU = 32.f, W8_D = 128.f;
typedef unsigned char f8_t;
namespace fp {
using pg8::Unit; using pg8::BM; using pg8::HALF; typedef pg8::f32x4 f32x4; typedef pg8::u32x4 u32x4; typedef unsigned u32x2_f __attribute__((ext_vector_type(2)));
__device__ __forceinline__ unsigned pk2(float lo, float hi) { return pg8::cvt_pk_bf16(lo, hi); }
__device__ __forceinline__ unsigned pk4_f8(float a, float b, float c, float d) { int w = 0; w = __builtin_amdgcn_cvt_pk_fp8_f32(a, b, w, false); w = __builtin_amdgcn_cvt_pk_fp8_f32(c, d, w, true); return (unsigned)w; }
__device__ __forceinline__ float clamp8(float x) { return __builtin_amdgcn_fmed3f(x, -448.f, 448.f); }
__device__ __forceinline__ float gelu_fast(float x) { const float u = 0.7978845608028654f * (x + 0.044715f * x * x * x); return x * __builtin_amdgcn_rcpf(1.f + __expf(-2.f * u)); }

struct EpiProj {
    static constexpr bool PERM = true, AFTER_DRAIN = false;
    bf16* O; const float* RT; float* KM2;
    __device__ __forceinline__ void operator()(const f32x4 (&acc)[2][2][4][2], const Unit& u, int wr, int wc, int fr, int fq) const {
        const int row0 = u.pm * BM + wr * 64 + fr, col0 = u.pn * BM + wc * 32 + 8 * fq;
        f32x4 ks[2][2];
#pragma unroll
        for (int i = 0; i < 2; ++i) { ks[i][0] = (f32x4){0.f, 0.f, 0.f, 0.f}; ks[i][1] = ks[i][0]; }
        const int mode = (u.pn < 3) ? 1 : ((u.pn == 6 || u.pn == 7) ? 2 : 0);
        const bool rl = ((wc & 1) == 0) && (fq < 2);
        const int i0 = (fq & 1) * 4;
#pragma unroll
        for (int ai = 0; ai < 2; ++ai) {
            float4 c4a[4], s4a[4];
#pragma unroll
            for (int i = 0; i < 4; ++i) { c4a[i] = make_float4(1.f, 1.f, 1.f, 1.f); s4a[i] = make_float4(0.f, 0.f, 0.f, 0.f); }
            if (mode == 1 && rl) {
#pragma unroll
                for (int i = 0; i < 4; ++i) { const int row = row0 + ai * HALF + i * 16; c4a[i] = *(const float4*)(RT + (size_t)row * 16 + i0); s4a[i] = *(const float4*)(RT + (size_t)row * 16 + 8 + i0); } }
#pragma unroll
            for (int m = 0; m < 4; ++m) { const int row = row0 + ai * HALF + m * 16;
                const float4 c4 = c4a[m], s4 = s4a[m];
#pragma unroll
                for (int bj = 0; bj < 2; ++bj) { f32x4 v0 = acc[ai][bj][m][0], v1 = acc[ai][bj][m][1];
                    if (mode == 1) { const f32x4 a = v0, b = v1;
                        v0[0] = a[0] * c4.x - a[1] * s4.x; v0[1] = a[1] * c4.x + a[0] * s4.x; v0[2] = a[2] * c4.y - a[3] * s4.y; v0[3] = a[3] * c4.y + a[2] * s4.y;
                        v1[0] = b[0] * c4.z - b[1] * s4.z; v1[1] = b[1] * c4.z + b[0] * s4.z; v1[2] = b[2] * c4.w - b[3] * s4.w; v1[3] = b[3] * c4.w + b[2] * s4.w; }
                    if (u.pn == 0 || (u.pn == 1 && bj == 0)) { v0 = v0 * QSCALE; v1 = v1 * QSCALE; }
                    else if (mode == 1) { ks[bj][0] += v0; ks[bj][1] += v1; }
                    if (mode == 2) {
#pragma unroll
                        for (int j = 0; j < 4; ++j) { v0[j] = gelu_fast(v0[j]); v1[j] = gelu_fast(v1[j]); } }
                    u32x4 w; w.x = pk2(v0[0], v0[1]); w.y = pk2(v0[2], v0[3]); w.z = pk2(v1[0], v1[1]); w.w = pk2(v1[2], v1[3]);
                    *(u32x4*)(O + (size_t)row * PLD + col0 + bj * HALF) = w; } } }
        if (u.pn == 1 || u.pn == 2) {
#pragma unroll
            for (int bj = 0; bj < 2; ++bj) { if (u.pn == 1 && bj == 0) continue;
#pragma unroll
                for (int n = 0; n < 2; ++n)
#pragma unroll
                    for (int j = 0; j < 4; ++j) { float x = ks[bj][n][j]; x += __shfl_xor(x, 1); x += __shfl_xor(x, 2); x += __shfl_xor(x, 4); x += __shfl_xor(x, 8); ks[bj][n][j] = x * (1.f / 256.f); }
                if (fr == 0) { const int kc = col0 + bj * HALF - FK; const int b = u.pm >> 3, nb = u.pm & 7;
                    float* dst = KM2 + (size_t)wr * (NB * ATT_H * NBLK * 64) + ((size_t)(b * ATT_H + (kc >> 6)) * NBLK + nb) * 64 + (kc & 63);
                    *(f32x4*)dst = ks[bj][0]; *(f32x4*)(dst + 4) = ks[bj][1]; } }
        }
    }
};
struct EpiAct {
    static constexpr bool PERM = true, AFTER_DRAIN = false;
    bf16* O; int ldc, ncol;
    __device__ __forceinline__ void operator()(const f32x4 (&acc)[2][2][4][2], const Unit& u, int wr, int wc, int fr, int fq) const {
        const int row0 = u.pm * BM + wr * 64 + fr, col0 = (u.pn % ncol) * HALF + wc * 32 + 8 * fq;
#pragma unroll
        for (int ai = 0; ai < 2; ++ai)
#pragma unroll
            for (int m = 0; m < 4; ++m) { const int row = row0 + ai * HALF + m * 16;
                const f32x4 g0 = acc[ai][0][m][0], g1 = acc[ai][0][m][1], u0 = acc[ai][1][m][0], u1 = acc[ai][1][m][1]; f32x4 a0, a1;
#pragma unroll
                for (int j = 0; j < 4; ++j) { a0[j] = g0[j] * __builtin_amdgcn_rcpf(1.f + __expf(-g0[j])) * u0[j]; a1[j] = g1[j] * __builtin_amdgcn_rcpf(1.f + __expf(-g1[j])) * u1[j]; }
                u32x4 w; w.x = pk2(a0[0], a0[1]); w.y = pk2(a0[2], a0[3]); w.z = pk2(a1[0], a1[1]); w.w = pk2(a1[2], a1[3]);
                *(u32x4*)(O + (size_t)row * ldc + col0) = w; }
    }
};
struct EpiAct8 {
    static constexpr bool PERM = true, AFTER_DRAIN = false;
    f8_t* O; int ldc, ncol;
    __device__ __forceinline__ void operator()(const f32x4 (&acc)[2][2][4][2], const Unit& u, int wr, int wc, int fr, int fq) const {
        const int row0 = u.pm * BM + wr * 64 + fr, col0 = (u.pn % ncol) * HALF + wc * 32 + 8 * fq;
        constexpr float s = 1.f / W8_GU, ke = -s * 1.4426950408889634f, s2 = s * s;
#pragma unroll
        for (int ai = 0; ai < 2; ++ai)
#pragma unroll
            for (int m = 0; m < 4; ++m) { const int row = row0 + ai * HALF + m * 16;
                const f32x4 g0 = acc[ai][0][m][0], g1 = acc[ai][0][m][1], u0 = acc[ai][1][m][0], u1 = acc[ai][1][m][1]; f32x4 a0, a1;
#pragma unroll
                for (int j = 0; j < 4; ++j) { a0[j] = clamp8((g0[j] * u0[j]) * (s2 * __builtin_amdgcn_rcpf(1.f + __builtin_amdgcn_exp2f(g0[j] * ke))));
                                              a1[j] = clamp8((g1[j] * u1[j]) * (s2 * __builtin_amdgcn_rcpf(1.f + __builtin_amdgcn_exp2f(g1[j] * ke)))); }
                u32x2_f w; w.x = pk4_f8(a0[0], a0[1], a0[2], a0[3]); w.y = pk4_f8(a1[0], a1[1], a1[2], a1[3]);
                *(u32x2_f*)(O + (size_t)row * ldc + col0) = w; }
    }
};
struct EpiF32 {
    static constexpr bool PERM = false, AFTER_DRAIN = false;
    float* O; int ldc;
    __device__ __forceinline__ void operator()(const f32x4 (&acc)[2][2][4][2], const Unit& u, int wr, int wc, int fr, int fq) const {
        const int row0 = u.pm * BM + wr * 64 + fr, col0 = u.pn * BM + wc * 32 + 4 * fq;
#pragma unroll
        for (int ai = 0; ai < 2; ++ai)
#pragma unroll
            for (int m = 0; m < 4; ++m) { float* rp = O + (size_t)(row0 + ai * HALF + m * 16) * ldc + col0;
#pragma unroll
                for (int bj = 0; bj < 2; ++bj)
#pragma unroll
                    for (int n = 0; n < 2; ++n) *(f32x4*)(rp + bj * HALF + n * 16) = acc[ai][bj][m][n]; }
    }
};
struct EpiY {
    static constexpr bool PERM = true, AFTER_DRAIN = false;
    bf16* O; int ldc;
    __device__ __forceinline__ void operator()(const f32x4 (&acc)[2][2][4][2], const Unit& u, int wr, int wc, int fr, int fq) const {
        const int row0 = u.pm * BM + wr * 64 + fr, col0 = u.pn * BM + wc * 32 + 8 * fq;
#pragma unroll
        for (int ai = 0; ai < 2; ++ai)
#pragma unroll
            for (int m = 0; m < 4; ++m) { bf16* rp = O + (size_t)(row0 + ai * HALF + m * 16) * ldc + col0;
#pragma unroll
                for (int bj = 0; bj < 2; ++bj) { const f32x4 v0 = acc[ai][bj][m][0], v1 = acc[ai][bj][m][1];
                    u32x4 w; w.x = pk2(v0[0], v0[1]); w.y = pk2(v0[2], v0[3]); w.z = pk2(v1[0], v1[1]); w.w = pk2(v1[2], v1[3]);
                    *(u32x4*)(rp + bj * HALF) = w; } }
    }
};
struct EpiF2 {
    static constexpr bool PERM = true, AFTER_DRAIN = false;
    bf16* O; const float* SP; bf16* FP; int slot0, klen; float osc;
    __device__ __forceinline__ void operator()(const f32x4 (&acc)[2][2][4][2], const Unit& u, int wr, int wc, int fr, int fq) const {
        const int row0 = u.pm * BM + wr * 64 + fr, col0 = (u.pn & 3) * BM + wc * 32 + 8 * fq;
        bf16* base = O; int rsub = 0;
        if (u.kofs > 0) { const int part = u.kofs / klen; base = FP + (size_t)(part - 1) * TAIL_SLOTS * DM; rsub = slot0; }
        float spv[8];
#pragma unroll
        for (int i = 0; i < 8; ++i) spv[i] = SP[row0 + (i >> 2) * HALF + (i & 3) * 16] * osc;
#pragma unroll
        for (int ai = 0; ai < 2; ++ai)
#pragma unroll
            for (int m = 0; m < 4; ++m) { const int row = row0 + ai * HALF + m * 16; const float sc = spv[ai * 4 + m];
#pragma unroll
                for (int bj = 0; bj < 2; ++bj) { const f32x4 v0 = acc[ai][bj][m][0] * sc, v1 = acc[ai][bj][m][1] * sc;
                    u32x4 w; w.x = pk2(v0[0], v0[1]); w.y = pk2(v0[2], v0[3]); w.z = pk2(v1[0], v1[1]); w.w = pk2(v1[2], v1[3]);
                    *(u32x4*)(base + (size_t)(row - rsub) * DM + col0 + bj * HALF) = w; } }
    }
};
static_assert(NGUE / 256 == 28 && DM / 256 == 4, "MoeOrder::next decodes units for 28 or 4 column tiles");
struct MoeOrder {
    int p0, p1, p2, p3, p4, p5, p6, T, ncol, G, c, nfull, ksplit, klen;
    __device__ __forceinline__ void init(const int* CNT, int ncol_, int G_, int c_) {
        int t = 0; t += (CNT[0] + 255) >> 8; p0 = t; t += (CNT[1] + 255) >> 8; p1 = t; t += (CNT[2] + 255) >> 8; p2 = t; t += (CNT[3] + 255) >> 8; p3 = t;
        t += (CNT[4] + 255) >> 8; p4 = t; t += (CNT[5] + 255) >> 8; p5 = t; t += (CNT[6] + 255) >> 8; p6 = t; t += (CNT[7] + 255) >> 8; T = t; ncol = ncol_; G = G_; c = c_;
        p0 = __builtin_amdgcn_readfirstlane(p0); p1 = __builtin_amdgcn_readfirstlane(p1); p2 = __builtin_amdgcn_readfirstlane(p2); p3 = __builtin_amdgcn_readfirstlane(p3);
        p4 = __builtin_amdgcn_readfirstlane(p4); p5 = __builtin_amdgcn_readfirstlane(p5); p6 = __builtin_amdgcn_readfirstlane(p6); T = __builtin_amdgcn_readfirstlane(T);
        nfull = T * ncol; ksplit = 1; klen = 0;
    }
    __device__ __forceinline__ int tail_start() const { const int tot = T * ncol, nf = (tot / G) * G; return (tot - nf <= TAIL_UNITS) ? nf : tot; }
    __device__ __forceinline__ bool next(int i, Unit& u) const {
        int L = i * G + c; int part = 0;
        if (ksplit == 1) { if (L >= nfull) return false; }
        else { const int sh = (ksplit == 4) ? 2 : 1; if (L >= ((T * ncol - nfull) << sh)) return false; part = L & (ksplit - 1); L = nfull + (L >> sh); }
        const int tm = (ncol == 4) ? (L >> 2) : (int)((unsigned)L / 28u), j = L - tm * ncol;
        const int e = (tm >= p0) + (tm >= p1) + (tm >= p2) + (tm >= p3) + (tm >= p4) + (tm >= p5) + (tm >= p6);
        u.pm = tm; u.pn = e * ncol + j; u.kofs = part * klen; return true;
    }
    __device__ __forceinline__ void a_ready(const Unit&) const {}
    __device__ __forceinline__ void done(const Unit&) const {}
};

struct SrcCol { const float* p; int ld; };
__device__ __forceinline__ int win_src_col(int d) {
    if (d < 768) { const int hd = d & 63; const int sd = hd < 16 ? ((hd & 1) ? 8 + (hd >> 1) : (hd >> 1)) : hd; return d - hd + sd; }
    if (d < 1536) return d;
    if (d < 1792) return 2438 + (d - 1536);
    if (d < 2048) return 2694 + (d - 1792);
    if (d < 2944) return 1536 + (d - 2048);
    if (d < 2950) return 2432 + (d - 2944);
    return -1;
}
__device__ __forceinline__ SrcCol gu_src(const float* wg, const float* wu, int nff, int r) {
    const int tile = r >> 8, rr = r & 255, j = tile * 128 + (rr & 127); SrcCol s; s.p = (rr < 128 ? wg : wu) + j; s.ld = nff; return s;
}
__device__ __forceinline__ void conv_item(SrcCol sc, int K, bf16* WT, long d0, int k0, LAS float* scr, int lane) {
    float tv[32];
#pragma unroll
    for (int i = 0; i < 32; ++i) { const int kk = 2 * i + (lane >> 5); tv[i] = sc.p ? __builtin_nontemporal_load(sc.p + (size_t)(k0 + kk) * sc.ld) : 0.f; }
#pragma unroll
    for (int i = 0; i < 32; ++i) { const int kk = 2 * i + (lane >> 5); scr[kk * 33 + (lane & 31)] = tv[i]; }
    LDS_WAIT(); asm volatile("" ::: "memory");
    const int c = lane & 7;
#pragma unroll
    for (int j = 0; j < 4; ++j) { const int n = (lane >> 3) + 8 * j; const LAS float* s = scr + (8 * c) * 33 + n;
        u32x4 o; o.x = pk2(s[0 * 33], s[1 * 33]); o.y = pk2(s[2 * 33], s[3 * 33]); o.z = pk2(s[4 * 33], s[5 * 33]); o.w = pk2(s[6 * 33], s[7 * 33]);
        __builtin_nontemporal_store(o, (u32x4*)(WT + (size_t)(d0 + n) * K + k0 + 8 * c)); }
    LDS_WAIT(); asm volatile("" ::: "memory");
}
__device__ __forceinline__ void conv_item8(SrcCol sc, int K  , f8_t* WT, long d0, int k0, float scale, LAS float* scr, int lane) {
    float ta[32], tb[32];
#pragma unroll
    for (int i = 0; i < 32; ++i) { const int kk = 2 * i + (lane >> 5); const size_t kr = (size_t)(k0 + 16 * (kk >> 3) + (kk & 7));
        ta[i] = __builtin_nontemporal_load(sc.p + kr * sc.ld); tb[i] = __builtin_nontemporal_load(sc.p + (kr + 8) * sc.ld); }
    const int c = lane & 7; unsigned pa[4][2];
#pragma unroll
    for (int i = 0; i < 32; ++i) { const int kk = 2 * i + (lane >> 5); scr[kk * 33 + (lane & 31)] = ta[i]; }
    LDS_WAIT(); asm volatile("" ::: "memory");
#pragma unroll
    for (int j = 0; j < 4; ++j) { const int n = (lane >> 3) + 8 * j; const LAS float* s = scr + (8 * c) * 33 + n;
        pa[j][0] = pk4_f8(clamp8(s[0 * 33] * scale), clamp8(s[1 * 33] * scale), clamp8(s[2 * 33] * scale), clamp8(s[3 * 33] * scale));
        pa[j][1] = pk4_f8(clamp8(s[4 * 33] * scale), clamp8(s[5 * 33] * scale), clamp8(s[6 * 33] * scale), clamp8(s[7 * 33] * scale)); }
    LDS_WAIT(); asm volatile("" ::: "memory");
#pragma unroll
    for (int i = 0; i < 32; ++i) { const int kk = 2 * i + (lane >> 5); scr[kk * 33 + (lane & 31)] = tb[i]; }
    LDS_WAIT(); asm volatile("" ::: "memory");
#pragma unroll
    for (int j = 0; j < 4; ++j) { const int n = (lane >> 3) + 8 * j; const LAS float* s = scr + (8 * c) * 33 + n;
        u32x4 o; o.x = pa[j][0]; o.y = pa[j][1];
        o.z = pk4_f8(clamp8(s[0 * 33] * scale), clamp8(s[1 * 33] * scale), clamp8(s[2 * 33] * scale), clamp8(s[3 * 33] * scale));
        o.w = pk4_f8(clamp8(s[4 * 33] * scale), clamp8(s[5 * 33] * scale), clamp8(s[6 * 33] * scale), clamp8(s[7 * 33] * scale));
        __builtin_nontemporal_store(o, (u32x4*)(WT + (size_t)(d0 + n) * K + k0 + 16 * c)); }
    LDS_WAIT(); asm volatile("" ::: "memory");
}
}


typedef short bf16x8_t __attribute__((ext_vector_type(8)));
typedef float f32x4_t __attribute__((ext_vector_type(4)));
constexpr int TLD = 272;
__device__ __forceinline__ bf16x8_t lds_frag(const LAS unsigned char* base, int row, int kbyte) { return *(const LAS bf16x8_t*)(base + row * TLD + kbyte); }
__device__ __forceinline__ float red16(float v) { return row16_sum(v); }

__device__ __forceinline__ void gm_unit(int b, int c, const bf16* PROJ, const bf16* WSB  , const float* ln_g, const float* ln_b, const float* b_s, const float* norm_g,
                                        bf16* MIXB, LAS unsigned char* lds, int wave, int lane) {
    const long r0 = (long)b * SEQ + c * GM_CHUNK;
    LAS unsigned char* VNT = lds;
    { float4 vv[16];
#pragma unroll
      for (int i = 0; i < 16; ++i) vv[i] = ld4(PROJ + (r0 + wave * 16 + i) * PLD + FGV + lane * 4);
      const float4 gg = *(const float4*)(ln_g + lane * 4), bb = *(const float4*)(ln_b + lane * 4);
#pragma unroll
      for (int i = 0; i < 16; ++i) { const int t = wave * 16 + i; const float4 v = vv[i];
        const float mean = wave_sum((v.x + v.y) + (v.z + v.w)) * (1.f / 256.f);
        const float d0 = v.x - mean, d1 = v.y - mean, d2 = v.z - mean, d3 = v.w - mean;
        const float rstd = rsqrtf(wave_sum((d0 * d0 + d1 * d1) + (d2 * d2 + d3 * d3)) * (1.f / 256.f) + 1e-5f);
        LAS bf16* dst = (LAS bf16*)(VNT + (lane * 4) * TLD) + t;
        dst[0] = (bf16)f2bf(d0 * rstd * gg.x + bb.x); dst[TLD / 2] = (bf16)f2bf(d1 * rstd * gg.y + bb.y); dst[TLD] = (bf16)f2bf(d2 * rstd * gg.z + bb.z); dst[3 * TLD / 2] = (bf16)f2bf(d3 * rstd * gg.w + bb.w); } }
    __syncthreads();
    f32x4_t acc[16];
#pragma unroll
    for (int i = 0; i < 16; ++i) acc[i] = (f32x4_t){0.f, 0.f, 0.f, 0.f};
    const int fr = lane & 15, fq = lane >> 4;
    const int nks = (wave * 16 + 15) / 32 + 1;
    for (int ks = 0; ks < nks; ++ks) {
#pragma unroll
        for (int g = 0; g < 4; ++g) {
            const bf16x8_t af = *(const bf16x8_t*)(WSB + ((size_t)g * GM_CHUNK + wave * 16 + fr) * GM_CHUNK + ks * 32 + fq * 8);
#pragma unroll
            for (int n = 0; n < 4; ++n) { const bf16x8_t bfv = lds_frag(VNT, g * 64 + n * 16 + fr, ks * 64 + fq * 16);
                acc[g * 4 + n] = __builtin_amdgcn_mfma_f32_16x16x32_bf16(af, bfv, acc[g * 4 + n], 0, 0, 0); }
        }
    }
    __syncthreads();
    LAS bf16* ost = (LAS bf16*)(lds + wave * (16 * 264 * 2));
    float ss[4] = {0.f, 0.f, 0.f, 0.f};
#pragma unroll
    for (int nt = 0; nt < 16; ++nt) { const int col = nt * 16 + fr, g = nt >> 2;
#pragma unroll
        for (int r = 0; r < 4; ++r) { const int t = wave * 16 + fq * 4 + r;
            const float u = ldf(PROJ + (r0 + t) * PLD + FGU + col);
            const float o = u * (acc[nt][r] + b_s[g * GM_CHUNK + t]); acc[nt][r] = o; ss[r] += o * o; } }
#pragma unroll
    for (int r = 0; r < 4; ++r) ss[r] = rsqrtf(red16(ss[r]) * (1.f / 256.f) + 1e-5f);
#pragma unroll
    for (int nt = 0; nt < 16; ++nt) { const int col = nt * 16 + fr; const float gn = norm_g[col];
#pragma unroll
        for (int r = 0; r < 4; ++r) { ost[(fq * 4 + r) * 264 + col] = (bf16)f2bf(acc[nt][r] * ss[r] * gn); } }
    LDS_WAIT(); asm volatile("" ::: "memory");
#pragma unroll
    for (int i = 0; i < 8; ++i) { const int rr = i * 2 + (lane >> 5), ch = lane & 31;
        const fp::u32x4 v = *(const LAS fp::u32x4*)(ost + rr * 264 + ch * 8);
        *(fp::u32x4*)(MIXB + (r0 + wave * 16 + rr) * DM + ATT_W + SSD_W + ch * 8) = v; }
    __syncthreads();
}

typedef short v4i16_t __attribute__((ext_vector_type(4)));
typedef unsigned u32x2_t __attribute__((ext_vector_type(2)));
__device__ __forceinline__ v4i16_t lds_tr(const LAS unsigned char* p) { return __builtin_amdgcn_ds_read_tr16_b64_v4i16((LAS v4i16_t*)p); }
__device__ __forceinline__ bf16x8_t lds_frag_tr(const LAS unsigned char* tile, int pitch, int k0, int c0, int lane) {
    const int kg = lane >> 4, q = (lane & 15) >> 2, p = lane & 3;
    const LAS unsigned char* a = tile + (k0 + 8 * kg + q) * pitch + (c0 + 4 * p) * 2;
    const v4i16_t lo = lds_tr(a), hi = lds_tr(a + 4 * pitch);
    return (bf16x8_t){lo[0], lo[1], lo[2], lo[3], hi[0], hi[1], hi[2], hi[3]};
}
__device__ __forceinline__ bf16x8_t lds_frag_p(const LAS unsigned char* base, int pitch, int row, int kbyte) { return *(const LAS bf16x8_t*)(base + row * pitch + kbyte); }
template <int NCH, bool SCALE, bool TOLDS> __device__ __forceinline__ void conv_rows(const bf16* PROJ, long r0, int t0, int colbase, int ch0, const float* cw, const float* cb, LAS unsigned char* tile, int pitch,
                                                                                       const LAS float* scl, bf16* XCg  , int tid) {
    constexpr int CPR = NCH / 8, RG = 512 / CPR, RPT = (128 + RG - 1) / RG;
    if (tid < CPR * RG) { const int ch = (tid % CPR) * 8, l0 = (tid / CPR) * RPT;
        float w[4][8], bs[8];
        { const float4 c0 = *(const float4*)(cb + ch0 + ch), c1 = *(const float4*)(cb + ch0 + ch + 4); bs[0] = c0.x; bs[1] = c0.y; bs[2] = c0.z; bs[3] = c0.w; bs[4] = c1.x; bs[5] = c1.y; bs[6] = c1.z; bs[7] = c1.w; }
#pragma unroll
        for (int i = 0; i < 4; ++i) { const float4 w0 = *(const float4*)(cw + i * SSD_CW + ch0 + ch), w1 = *(const float4*)(cw + i * SSD_CW + ch0 + ch + 4);
            w[i][0] = w0.x; w[i][1] = w0.y; w[i][2] = w0.z; w[i][3] = w0.w; w[i][4] = w1.x; w[i][5] = w1.y; w[i][6] = w1.z; w[i][7] = w1.w; }
        fp::u32x4 xr[RPT + 3];
#pragma unroll
        for (int j = 0; j < RPT + 3; ++j) { const int l = l0 - 3 + j; xr[j] = (fp::u32x4){0u, 0u, 0u, 0u};
            if (l < 128 && t0 + l >= 0) xr[j] = *(const fp::u32x4*)(PROJ + (r0 + l) * PLD + colbase + ch); }
#pragma unroll
        for (int j = 0; j < RPT; ++j) { const int l = l0 + j; if (l < 128) {
            float a[8];
#pragma unroll
            for (int e = 0; e < 8; ++e) a[e] = bs[e];
#pragma unroll
            for (int i = 0; i < 4; ++i) { const fp::u32x4 xv = xr[j + i];
#pragma unroll
                for (int e = 0; e < 4; ++e) { a[2 * e] += w[i][2 * e] * __uint_as_float(xv[e] << 16); a[2 * e + 1] += w[i][2 * e + 1] * __uint_as_float(xv[e] & 0xffff0000u); } }
#pragma unroll
            for (int e = 0; e < 8; ++e) a[e] = a[e] * __builtin_amdgcn_rcpf(1.f + __expf(-a[e]));
            fp::u32x4 o; o.x = fp::pk2(a[0], a[1]); o.y = fp::pk2(a[2], a[3]); o.z = fp::pk2(a[4], a[5]); o.w = fp::pk2(a[6], a[7]);
            *(fp::u32x4*)(XCg + (r0 + l) * SSD_CW + ch) = o;
            if (TOLDS) { if (SCALE) { const float sc = scl[(ch >> 6) * 128 + l]; o.x = fp::pk2(a[0] * sc, a[1] * sc); o.y = fp::pk2(a[2] * sc, a[3] * sc); o.z = fp::pk2(a[4] * sc, a[5] * sc); o.w = fp::pk2(a[6] * sc, a[7] * sc); }
                *(LAS fp::u32x4*)(tile + l * pitch + ch * 2) = o; } } }
    }
}
template <int NCH> __device__ __forceinline__ void load_xc_tile(const bf16* XCg, long r0, LAS unsigned char* tile, int pitch, int tid) {
    constexpr int CPR = NCH / 8;
    for (int it = tid; it < 128 * CPR; it += 512) { const int l = it / CPR, ch = (it % CPR) * 8;
        *(LAS fp::u32x4*)(tile + l * pitch + ch * 2) = *(const fp::u32x4*)(XCg + (r0 + l) * SSD_CW + ch); }
}
__device__ __forceinline__ void ssd_dt_acum(const bf16* PROJ, long r0, int g, const float* dt_bias, const float* a_log, LAS float* dtS, LAS float* acS, int tid, int wave, int lane) {
    if (tid < 384) { const int hh = tid >> 7, l = tid & 127, h = 3 * g + hh;
        const float dtv = softplus_f(ldf(PROJ + (r0 + l) * PLD + FDT + h) + dt_bias[h]); dtS[tid] = dtv; acS[tid] = dtv * (-__expf(a_log[h])); }
    __syncthreads();
    if (wave < 3) { const float a0 = acS[wave * 128 + 2 * lane], a1 = acS[wave * 128 + 2 * lane + 1]; const float sm = a0 + a1; float v = sm;
#pragma unroll
        for (int o = 1; o < 64; o <<= 1) { const float t = __shfl_up(v, o); if (lane >= o) v += t; }
        const float ex = v - sm; acS[wave * 128 + 2 * lane] = ex + a0; acS[wave * 128 + 2 * lane + 1] = ex + sm; }
    __syncthreads();
}
constexpr int XP = 400;
__device__ __forceinline__ void ssdA_unit(int b, int c, int g, const bf16* PROJ, const float* cw, const float* cb, const float* dt_bias, const float* a_log, float* ST, float* CD, bf16* XC, float* DTG,
                                          LAS unsigned char* lds, int tid, int wave, int lane) {
    asm volatile("" : "+v"(tid), "+v"(lane));
    const long r0 = (long)b * SEQ + c * 128; const int t0 = c * 128;
    LAS unsigned char* XS = lds; LAS unsigned char* BS = lds + 51200;
    LAS float* dtS = (LAS float*)(lds + 86016); LAS float* acS = dtS + 384; LAS float* sclS = acS + 384;
    ssd_dt_acum(PROJ, r0, g, dt_bias, a_log, dtS, acS, tid, wave, lane);
    if (tid < 384) { const int hh = tid >> 7; const float al = acS[hh * 128 + 127]; sclS[tid] = dtS[tid] * __expf(al - acS[tid]);
        float* dg = DTG + (((long)b * 16 + c) * 2 + g) * 768; dg[tid] = dtS[tid]; dg[384 + tid] = acS[tid];
        if ((tid & 127) == 0) CD[((long)b * 16 + c) * SSD_H + 3 * g + hh] = __expf(al); }
    __syncthreads();
    conv_rows<192, true, true>(PROJ, r0, t0, FXBC + 192 * g, 192 * g, cw, cb, XS, XP, sclS, XC + 192 * g, tid);
    conv_rows<128, false, true>(PROJ, r0, t0, FXBC + SSD_W + 128 * g, SSD_W + 128 * g, cw, cb, BS, TLD, nullptr, XC + SSD_W + 128 * g, tid);
    conv_rows<128, false, false>(PROJ, r0, t0, FXBC + SSD_W + 256 + 128 * g, SSD_W + 256 + 128 * g, cw, cb, nullptr, 0, nullptr, XC + SSD_W + 256 + 128 * g, tid);
    __syncthreads();
    f32x4_t acc[12];
#pragma unroll
    for (int i = 0; i < 12; ++i) acc[i] = (f32x4_t){0.f, 0.f, 0.f, 0.f};
#pragma unroll 1
    for (int ks = 0; ks < 4; ++ks) { const bf16x8_t bfv = lds_frag_tr(BS, TLD, ks * 32, 16 * wave, lane);
#pragma unroll
        for (int mt = 0; mt < 12; ++mt) { const bf16x8_t af = lds_frag_tr(XS, XP, ks * 32, (mt >> 2) * 64 + (mt & 3) * 16, lane); acc[mt] = __builtin_amdgcn_mfma_f32_16x16x32_bf16(af, bfv, acc[mt], 0, 0, 0); } }
    const int fr = lane & 15, fq = lane >> 4;
    float* sp = ST + (((long)b * 16 + c) * SSD_H + 3 * g) * 8192 + 16 * wave + fr;
#pragma unroll
    for (int mt = 0; mt < 12; ++mt)
#pragma unroll
        for (int r = 0; r < 4; ++r) sp[(mt >> 2) * 8192 + ((mt & 3) * 16 + 4 * fq + r) * 128] = acc[mt][r];
    __syncthreads();
}
__device__ __forceinline__ void ssdB_unit(int b, int c, int g, const bf16* PROJ, const bf16* XC, const float* DTG, const float* dsk, const float* ng,
                                          const float* ST, const float* CD, bf16* MIXB, LAS unsigned char* lds, int tid, int wave, int lane) {
    const long r0 = (long)b * SEQ + c * 128;
    LAS unsigned char* CS = lds; LAS unsigned char* PX = lds + 34816; LAS unsigned char* BG = lds + 87040;
    LAS float* dtS = (LAS float*)(lds + 121856); LAS float* acS = dtS + 384;
    const int fr = lane & 15, fq = lane >> 4;
    if (tid < 384) { const float* dg = DTG + (((long)b * 16 + c) * 2 + g) * 768; dtS[tid] = dg[tid]; acS[tid] = dg[384 + tid]; }
    load_xc_tile<128>(XC + SSD_W + 256 + 128 * g, r0, CS, TLD, tid);
    if (c > 0) {
        float4 pv[12];
#pragma unroll
        for (int i = 0; i < 12; ++i) pv[i] = make_float4(0.f, 0.f, 0.f, 0.f);
        const float* sbase = ST + ((long)b * 16 * SSD_H + 3 * g) * 8192 + tid * 4; const float* cbase = CD + (long)b * 16 * SSD_H + 3 * g;
        int j = 0;
        for (; j + 2 < c; j += 3) { const float* s0 = sbase + (long)j * SSD_H * 8192; const float* c0 = cbase + j * SSD_H;
            float4 v0[12], v1[12], v2[12];
#pragma unroll
            for (int i = 0; i < 12; ++i) { v0[i] = *(const float4*)(s0 + i * 2048); v1[i] = *(const float4*)(s0 + SSD_H * 8192 + i * 2048); v2[i] = *(const float4*)(s0 + 2 * SSD_H * 8192 + i * 2048); }
            float dd[3][3];
#pragma unroll
            for (int q = 0; q < 3; ++q) { dd[q][0] = c0[q * SSD_H]; dd[q][1] = c0[q * SSD_H + 1]; dd[q][2] = c0[q * SSD_H + 2]; }
#pragma unroll
            for (int i = 0; i < 12; ++i) { const int hq = i >> 2;
                pv[i].x = ((pv[i].x * dd[0][hq] + v0[i].x) * dd[1][hq] + v1[i].x) * dd[2][hq] + v2[i].x;
                pv[i].y = ((pv[i].y * dd[0][hq] + v0[i].y) * dd[1][hq] + v1[i].y) * dd[2][hq] + v2[i].y;
                pv[i].z = ((pv[i].z * dd[0][hq] + v0[i].z) * dd[1][hq] + v1[i].z) * dd[2][hq] + v2[i].z;
                pv[i].w = ((pv[i].w * dd[0][hq] + v0[i].w) * dd[1][hq] + v1[i].w) * dd[2][hq] + v2[i].w; } }
        for (; j < c; ++j) { const float* s0 = sbase + (long)j * SSD_H * 8192; const float* c0 = cbase + j * SSD_H; const float d0 = c0[0], d1 = c0[1], d2 = c0[2];
#pragma unroll
            for (int i = 0; i < 12; ++i) { const float4 sv = *(const float4*)(s0 + i * 2048); const float d = (i < 4) ? d0 : ((i < 8) ? d1 : d2);
                pv[i].x = pv[i].x * d + sv.x; pv[i].y = pv[i].y * d + sv.y; pv[i].z = pv[i].z * d + sv.z; pv[i].w = pv[i].w * d + sv.w; } }
#pragma unroll
        for (int i = 0; i < 12; ++i) { const int row = (i >> 2) * 64 + (i & 3) * 16 + (tid >> 5), n = (tid & 31) * 4;
            u32x2_t w; w.x = fp::pk2(pv[i].x, pv[i].y); w.y = fp::pk2(pv[i].z, pv[i].w); *(LAS u32x2_t*)(PX + row * TLD + n * 2) = w; }
    }
    __syncthreads();
    f32x4_t acc_y[12];
#pragma unroll
    for (int i = 0; i < 12; ++i) acc_y[i] = (f32x4_t){0.f, 0.f, 0.f, 0.f};
    if (c > 0) {
#pragma unroll 1
        for (int ks = 0; ks < 4; ++ks) { const bf16x8_t af = lds_frag_p(CS, TLD, 16 * wave + fr, ks * 64 + fq * 16);
#pragma unroll
            for (int t = 0; t < 12; ++t) { const bf16x8_t bfv = lds_frag_p(PX, TLD, (t >> 2) * 64 + (t & 3) * 16 + fr, ks * 64 + fq * 16); acc_y[t] = __builtin_amdgcn_mfma_f32_16x16x32_bf16(af, bfv, acc_y[t], 0, 0, 0); } }
#pragma unroll
        for (int t = 0; t < 12; ++t)
#pragma unroll
            for (int r = 0; r < 4; ++r) acc_y[t][r] *= __expf(acS[(t >> 2) * 128 + 16 * wave + 4 * fq + r]);
    }
    __syncthreads();
    load_xc_tile<192>(XC + 192 * g, r0, PX, XP, tid);
    load_xc_tile<128>(XC + SSD_W + 128 * g, r0, BG, TLD, tid);
    __syncthreads();
#if defined(SSDB_CUT) && SSDB_CUT == 2
    { float t_ = 0.f; for (int i = 0; i < 12; ++i) t_ += acc_y[i][0] + acc_y[i][1] + acc_y[i][2] + acc_y[i][3]; if (t_ == 123.f) MIXB[0] = 1; return; }
#endif
    f32x4_t acc_cb[8];
#pragma unroll
    for (int i = 0; i < 8; ++i) acc_cb[i] = (f32x4_t){0.f, 0.f, 0.f, 0.f};
#pragma unroll 1
    for (int ks = 0; ks < 4; ++ks) { const bf16x8_t af = lds_frag_p(CS, TLD, 16 * wave + fr, ks * 64 + fq * 16);
#pragma unroll
        for (int ns = 0; ns < 8; ++ns) if (ns <= wave) { const bf16x8_t bfv = lds_frag_p(BG, TLD, 16 * ns + fr, ks * 64 + fq * 16); acc_cb[ns] = __builtin_amdgcn_mfma_f32_16x16x32_bf16(af, bfv, acc_cb[ns], 0, 0, 0); } }
    __syncthreads();
    LAS unsigned char* GS = BG + wave * 16 * TLD;
    const int nks = (16 * wave + 15) / 32 + 1;
#pragma unroll
    for (int hh = 0; hh < 3; ++hh) {
#pragma unroll
        for (int ns = 0; ns < 8; ++ns) if (ns <= (wave | 1)) {
#pragma unroll
            for (int r = 0; r < 4; ++r) { const int l = 16 * wave + 4 * fq + r, sidx = 16 * ns + fr;
                const float gv = (ns <= wave && sidx <= l) ? acc_cb[ns][r] * __expf(acS[hh * 128 + l] - acS[hh * 128 + sidx]) * dtS[hh * 128 + sidx] : 0.f;
                *(LAS bf16*)(GS + (4 * fq + r) * TLD + sidx * 2) = (bf16)f2bf(gv); } }
        LDS_WAIT(); asm volatile("" ::: "memory");
#pragma unroll 1
        for (int ks = 0; ks < nks; ++ks) { const bf16x8_t af = lds_frag_p(GS, TLD, fr, ks * 64 + fq * 16);
#pragma unroll
            for (int np = 0; np < 4; ++np) { const bf16x8_t bfv = lds_frag_tr(PX, XP, ks * 32, hh * 64 + np * 16, lane); acc_y[hh * 4 + np] = __builtin_amdgcn_mfma_f32_16x16x32_bf16(af, bfv, acc_y[hh * 4 + np], 0, 0, 0); } }
        LDS_WAIT(); asm volatile("" ::: "memory");
    }
#if defined(SSDB_CUT) && SSDB_CUT == 1
    { float t_ = 0.f; for (int i = 0; i < 12; ++i) t_ += acc_y[i][0] + acc_y[i][1] + acc_y[i][2] + acc_y[i][3]; if (t_ == 123.f) MIXB[0] = 1; return; }
#endif
#pragma unroll
    for (int t = 0; t < 12; ++t) { const int hh = t >> 2, col = hh * 64 + (t & 3) * 16 + fr; const float dk = dsk[3 * g + hh];
#pragma unroll
        for (int r = 0; r < 4; ++r) { const int l = 16 * wave + 4 * fq + r; acc_y[t][r] += dk * __uint_as_float(((unsigned)*(const LAS bf16*)(PX + l * XP + col * 2)) << 16); } }
    __syncthreads();
    LAS bf16* ost = (LAS bf16*)(lds + wave * (16 * XP));
#pragma unroll
    for (int t = 0; t < 12; ++t) { const int col = (t >> 2) * 64 + (t & 3) * 16 + fr;
#pragma unroll
        for (int r = 0; r < 4; ++r) ost[(4 * fq + r) * (XP / 2) + col] = (bf16)f2bf(acc_y[t][r]); }
    LDS_WAIT(); asm volatile("" ::: "memory");
    { const int rr = lane >> 2, q = lane & 3; const long row = r0 + 16 * wave + rr;
      float yz[48]; float ssum = 0.f;
#pragma unroll
      for (int i = 0; i < 6; ++i) { const int c8 = (q * 6 + i) * 8;
          const fp::u32x4 yv = *(const LAS fp::u32x4*)(ost + rr * (XP / 2) + c8);
          const fp::u32x4 zv = *(const fp::u32x4*)(PROJ + row * PLD + FZ + 192 * g + c8);
#pragma unroll
          for (int j = 0; j < 4; ++j) { const unsigned yw = yv[j], zw = zv[j];
              const float y0 = __uint_as_float(yw << 16), y1 = __uint_as_float(yw & 0xffff0000u), z0 = __uint_as_float(zw << 16), z1 = __uint_as_float(zw & 0xffff0000u);
              const float a0 = y0 * (z0 * __builtin_amdgcn_rcpf(1.f + __expf(-z0))), a1 = y1 * (z1 * __builtin_amdgcn_rcpf(1.f + __expf(-z1))); yz[i * 8 + 2 * j] = a0; yz[i * 8 + 2 * j + 1] = a1; ssum += a0 * a0 + a1 * a1; } }
      ssum += __shfl_xor(ssum, 1); ssum += __shfl_xor(ssum, 2);
      const float rinv = rsqrtf(ssum * (1.f / 192.f) + 1e-5f);
#pragma unroll
      for (int i = 0; i < 6; ++i) { const int c8 = (q * 6 + i) * 8;
          const float4 g0 = *(const float4*)(ng + 192 * g + c8), g1 = *(const float4*)(ng + 192 * g + c8 + 4);
          fp::u32x4 o; o.x = fp::pk2(yz[i * 8] * rinv * g0.x, yz[i * 8 + 1] * rinv * g0.y); o.y = fp::pk2(yz[i * 8 + 2] * rinv * g0.z, yz[i * 8 + 3] * rinv * g0.w);
          o.z = fp::pk2(yz[i * 8 + 4] * rinv * g1.x, yz[i * 8 + 5] * rinv * g1.y); o.w = fp::pk2(yz[i * 8 + 6] * rinv * g1.z, yz[i * 8 + 7] * rinv * g1.w);
          *(fp::u32x4*)(MIXB + row * DM + ATT_W + 192 * g + c8) = o; } }
    __syncthreads();
}

__device__ __forceinline__ void att_norm_phase(bf16* MIXB, const float* g, long n_rows, int gw_, int ngw_, int lane) {
    float4 g0 = make_float4(0.f, 0.f, 0.f, 0.f), g1 = g0; if (lane < 48) { g0 = *(const float4*)(g + lane * 8); g1 = *(const float4*)(g + lane * 8 + 4); }
    fp::u32x4 wa = (fp::u32x4){0u, 0u, 0u, 0u}, wb = wa; long r = gw_;
    if (r < n_rows && lane < 48) wa = *(const fp::u32x4*)(MIXB + r * DM + lane * 8);
#define ATTN_NORM_ROW(WV_, rr) do { float v[8]; float s2 = 0.f; \
        _Pragma("unroll") for (int j = 0; j < 4; ++j) { v[2 * j] = __uint_as_float(WV_[j] << 16); v[2 * j + 1] = __uint_as_float(WV_[j] & 0xffff0000u); s2 += v[2 * j] * v[2 * j] + v[2 * j + 1] * v[2 * j + 1]; } \
        const float rs = rsqrtf(wave_sum(s2) * (1.f / 384.f) + 1e-5f); \
        if (lane < 48) { fp::u32x4 o; o.x = fp::pk2(v[0] * rs * g0.x, v[1] * rs * g0.y); o.y = fp::pk2(v[2] * rs * g0.z, v[3] * rs * g0.w); o.z = fp::pk2(v[4] * rs * g1.x, v[5] * rs * g1.y); o.w = fp::pk2(v[6] * rs * g1.z, v[7] * rs * g1.w); \
            *(fp::u32x4*)(MIXB + (rr) * DM + lane * 8) = o; } } while (0)
    for (; r < n_rows; r += 2 * ngw_) { const long r1 = r + ngw_, r2 = r + 2 * ngw_;
        if (r1 < n_rows && lane < 48) wb = *(const fp::u32x4*)(MIXB + r1 * DM + lane * 8);
        ATTN_NORM_ROW(wa, r);
        if (r2 < n_rows && lane < 48) wa = *(const fp::u32x4*)(MIXB + r2 * DM + lane * 8);
        if (r1 < n_rows) ATTN_NORM_ROW(wb, r1); }
#undef ATTN_NORM_ROW
}

constexpr int FT_G = (DM / 128) * (N_EXP * NGUE / 32) / 8, FT_D = (D_FFE / 128) * (N_EXP * DM / 32) / 8;
constexpr int FT_G_A = 704, FT_G_B = 384, FT_D_A = 256, FT_D_D = 384;
__device__ __forceinline__ void filler_g(int t, const float* p_mg, const float* p_mu, f8_t* MWGU_, LAS float* scr, int wave, int lane_) {
    asm volatile("" : "+v"(lane_));
    const int r = t * 8 + wave; const int kb = r / (N_EXP * NGUE / 32), db = r % (N_EXP * NGUE / 32); const int d = db * 32 + (lane_ & 31), e = d / NGUE;
    fp::conv_item8(fp::gu_src(p_mg + (size_t)e * DM * D_FFE, p_mu + (size_t)e * DM * D_FFE, D_FFE, d - e * NGUE), DM, MWGU_, (long)db * 32, kb * 128, W8_GU, scr, lane_);
}
__device__ __forceinline__ void filler_d(int t, const float* p_md, f8_t* MWD_, LAS float* scr, int wave, int lane_) {
    asm volatile("" : "+v"(lane_));
    const int r = t * 8 + wave; const int kb = r / (N_EXP * DM / 32), db = r % (N_EXP * DM / 32); const int d = db * 32 + (lane_ & 31), e = d / DM;
    fp::SrcCol sc_; sc_.p = p_md + (size_t)e * D_FFE * DM + (d - e * DM); sc_.ld = DM; fp::conv_item8(sc_, D_FFE, MWD_, (long)db * 32, kb * 128, W8_D, scr, lane_);
}

__device__ __forceinline__ uint2 bf8_to_f8(const uint4 v) {
    uint2 o; o.x = fp::pk4_f8(__uint_as_float(v.x << 16), __uint_as_float(v.x & 0xffff0000u), __uint_as_float(v.y << 16), __uint_as_float(v.y & 0xffff0000u));
    o.y = fp::pk4_f8(__uint_as_float(v.z << 16), __uint_as_float(v.z & 0xffff0000u), __uint_as_float(v.w << 16), __uint_as_float(v.w & 0xffff0000u)); return o;
}
struct FArgs { const void* in[29]; float* out; unsigned char* ws; int ph_lo, ph_hi; };
__device__ __forceinline__ const void* ldarg(int k) { const void* p; asm volatile("s_load_dwordx2 %0, %1, %2\n\ts_waitcnt lgkmcnt(0)" : "=s"(p) : "s"(__builtin_amdgcn_kernarg_segment_ptr()), "i"(k * 8)); return p; }

constexpr int N_PHASES = 18;
__global__ void __launch_bounds__(512, 2) mega(FArgs a) {
    extern __shared__ __attribute__((aligned(16))) unsigned char lds_[];
    LAS unsigned char* lds = (LAS unsigned char*)lds_;
    const int wave = __builtin_amdgcn_readfirstlane((int)threadIdx.x >> 6);
#define lane ((int)__builtin_amdgcn_mbcnt_hi(~0u, __builtin_amdgcn_mbcnt_lo(~0u, 0u)))
#define tid (wave * 64 + lane)
    const int G = gridDim.x; const int bx = blockIdx.x;
#define vcu (((int)gridDim.x % 8 == 0) ? ((int)blockIdx.x % 8) * ((int)gridDim.x / 8) + (int)blockIdx.x / 8 : (int)blockIdx.x)
#define gw (vcu * 8 + wave)
#define ngw ((int)gridDim.x * 8)
#define gt ((long)gw * 64 + lane)
#define ngt ((long)ngw * 64)
    unsigned char* ws = a.ws;
    unsigned* ctl = (unsigned*)(ws + O_CTL);
    for (int u = (int)threadIdx.x; u < (LDS_BYTES - RING_BYTES) / 4; u += 512) ((LAS unsigned*)(lds + RING_BYTES))[u] = 0u;
    __syncthreads();
    const int lo = a.ph_lo, hi = a.ph_hi;
    XcdBarrier bar; bar.bar = ctl + CW_BAR; bar.x = 0; bar.st = nullptr; bar.w0 = 0;
    if (hi - lo > 1) bar = xcd_barrier_post(ctl + CW_BAR, (volatile LAS unsigned*)(lds + MISC_OFF) + 8);
#define in_x ((const float*)ldarg(0))
#define in_pos ((const int*)ldarg(1))
#define ln_in_g ((const float*)ldarg(2))
#define ln_in_b ((const float*)ldarg(3))
#define w_in ((const float*)ldarg(4))
#define conv_w ((const float*)ldarg(5))
#define conv_b ((const float*)ldarg(6))
#define dt_bias ((const float*)ldarg(7))
#define a_log ((const float*)ldarg(8))
#define d_skip ((const float*)ldarg(9))
#define ssd_norm_g ((const float*)ldarg(10))
#define att_norm_g ((const float*)ldarg(11))
#define gm_ln_g ((const float*)ldarg(12))
#define gm_ln_b ((const float*)ldarg(13))
#define gm_w_s ((const float*)ldarg(14))
#define gm_b_s ((const float*)ldarg(15))
#define gm_norm_g ((const float*)ldarg(16))
#define w_out ((const float*)ldarg(17))
#define ln1_g ((const float*)ldarg(18))
#define ln1_b ((const float*)ldarg(19))
#define ln2_g ((const float*)ldarg(20))
#define ln2_b ((const float*)ldarg(21))
#define ffn_w_gate ((const float*)ldarg(22))
#define ffn_w_up ((const float*)ldarg(23))
#define ffn_w_down ((const float*)ldarg(24))
#define router_w ((const float*)ldarg(25))
#define moe_w_gate ((const float*)ldarg(26))
#define moe_w_up ((const float*)ldarg(27))
#define moe_w_down ((const float*)ldarg(28))
#define H ((float*)WOUTP)
#define MWD ((f8_t*)WOUTP)
#define RT ((float*)(WSP + O_RT))
#define TE ((int*)(WSP + O_TE))
#define TP ((float*)(WSP + O_TP))
#define TS ((int*)(WSP + O_TS))
#define GS ((int*)(WSP + O_GS))
#define SP ((float*)(WSP + O_SP))
#define KM ((float*)(WSP + O_KM))
#define WSB ((bf16*)(WSP + O_WSB))
#define HB ((bf16*)(WSP + O_HB))
#define MWGU ((f8_t*)(WSP + O_MWGU))
#define WIN ((bf16*)(WSP + O_WIN))
#define WOUT ((bf16*)(WSP + O_WOUT))
#define WGU ((bf16*)(WSP + O_WGU))
#define WD ((bf16*)(WSP + O_WD))
#define PROJ ((bf16*)(WSP + O_PROJ))
#define ST ((float*)(WSP + O_XC))
#define CD ((float*)(WSP + O_DT))
#define XCB ((bf16*)(WSP + O_MIXU))
#define DTG ((float*)(WSP + O_VN))
#define MIXB ((bf16*)(WSP + O_MIXB))
#define YB ((bf16*)(WSP + O_Y))
#define ACT ((bf16*)(WSP + O_ACT))
#define XG ((f8_t*)(WSP + O_XG))
#define F2 ((bf16*)(WSP + O_XG))
#define ACTM ((f8_t*)(WSP + O_ACTM))
#define F2P ((bf16*)(WSP + O_MWGU))
#define CNT ((int*)(WSP + O_CTL + 4 * CW_CNT))
    const ProjL FL{PLD, FQ, FK, FV, FZ, FXBC, FDT, FGU, FGV};
    LAS float* scr = (LAS float*)(lds + wave * 16384);

#ifndef PH_MASK
#define PH_MASK 0xffffffffu
#endif
#ifndef PROBE_MASK
#define PROBE_MASK 0u
#endif
#ifndef PROBE_AMP
#define PROBE_AMP 0
#endif
    volatile unsigned* pr_w = (volatile unsigned*)(ctl + 1100);
#define pr_me ((PROBE_MASK != 0u) && blockIdx.x == 0 && wave == 0 && __builtin_amdgcn_mbcnt_hi(~0u, __builtin_amdgcn_mbcnt_lo(~0u, 0u)) == 0u)
#define PH_BEGIN(k) if (lo <= (k) && (k) < hi && ((PH_MASK >> (k)) & 1u)) { unsigned char* WSP = a.ws; unsigned char* WOUTP = (unsigned char*)a.out; asm volatile("" : "+s"(WSP), "+s"(WOUTP)); if (((PROBE_MASK >> (k)) & 1u) && pr_me) pr_w[0] = (unsigned)__builtin_amdgcn_s_memrealtime();
#define PH_END(k)   if ((k) + 1 < hi) xcd_barrier(bar); if (((PROBE_MASK >> (k)) & 1u) && pr_me) pr_w[1] += (unsigned)__builtin_amdgcn_s_memrealtime() - pr_w[0]; }

    PH_BEGIN(0)
    { const float* const p_w_in = w_in; const float* const p_w_out = w_out; const float* const p_fg = ffn_w_gate; const float* const p_fu = ffn_w_up; const float* const p_fd = ffn_w_down;
        constexpr int I_WIN = 16 * (PLD / 32), I_WOUT = 16 * (DM / 32), I_WGU = 16 * (NGU / 32), I_WD = (D_FF / 64) * (DM / 32), I_MWGU = 16 * (N_EXP * NGUE / 32);
        constexpr int NIT = 2 * I_WIN + 2 * I_WOUT + I_WGU + I_WD; (void)I_MWGU;
        for (int it = gw; it < NIT; it += ngw) {
            int r = it; const int l5 = lane & 31;
            if (r < 2 * I_WIN) { const int L = r / I_WIN; r -= L * I_WIN; const int kb = r / (PLD / 32), db = r % (PLD / 32); const int sc_ = fp::win_src_col(db * 32 + l5);
                fp::SrcCol s; s.p = sc_ >= 0 ? p_w_in + (size_t)L * DM * D_IN + sc_ : nullptr; s.ld = D_IN; fp::conv_item(s, DM, WIN + (size_t)L * PLD * DM, db * 32, kb * 64, scr, lane); continue; } r -= 2 * I_WIN;
            if (r < 2 * I_WOUT) { const int L = r / I_WOUT; r -= L * I_WOUT; const int kb = r / (DM / 32), db = r % (DM / 32);
                fp::SrcCol s; s.p = p_w_out + (size_t)L * DM * DM + db * 32 + l5; s.ld = DM; fp::conv_item(s, DM, WOUT + (size_t)L * DM * DM, db * 32, kb * 64, scr, lane); continue; } r -= 2 * I_WOUT;
            if (r < I_WGU) { const int kb = r / (NGU / 32), db = r % (NGU / 32);
                fp::conv_item(fp::gu_src(p_fg, p_fu, D_FF, db * 32 + l5), DM, WGU, db * 32, kb * 64, scr, lane); continue; } r -= I_WGU;
            { const int kb = r / (DM / 32), db = r % (DM / 32);
                fp::SrcCol s; s.p = p_fd + db * 32 + l5; s.ld = DM; fp::conv_item(s, D_FF, WD, db * 32, kb * 64, scr, lane); }
        }
        const int* const p_pos = in_pos; const float* const p_gws = gm_w_s; const float* const p_x = in_x; const float* const p_lg = ln_in_g; const float* const p_lb = ln_in_b;
        for (long it = gt; it < (long)M_ * 8; it += ngt) { const int i = (int)(it & 7); const long row = it >> 3;
            const float inv = powf(500000.0f, -(float)(2 * i) / 16.0f); const float ang = (float)p_pos[row] * inv; RT[row * 16 + i] = cosf(ang); RT[row * 16 + 8 + i] = sinf(ang); }
        for (long it = gt; it < 2L * GM_G * GM_CHUNK * GM_CHUNK; it += ngt) { const int sidx = (int)(it & 127), t = (int)((it >> 7) & 127); WSB[it] = (bf16)(sidx <= t ? f2bf(p_gws[it]) : 0u); }
        { float va[16], vb[16]; LnGB gbp; ln_gb_load(gbp, p_lg, p_lb, lane); long r = gw; if (r < M_) ln_load<float, float, true>(va, p_x + r * DM, 1.f, nullptr, nullptr, lane);
          for (; r < M_; r += 2 * ngw) { const long r1 = r + ngw, r2 = r + 2 * ngw;
              if (r1 < M_) ln_load<float, float, true>(vb, p_x + r1 * DM, 1.f, nullptr, nullptr, lane);
              ln_finish_r(va, gbp, nullptr, HB + r * DM, lane);
              if (r2 < M_) ln_load<float, float, true>(va, p_x + r2 * DM, 1.f, nullptr, nullptr, lane);
              if (r1 < M_) ln_finish_r(vb, gbp, nullptr, HB + r1 * DM, lane); } }
    }
    PH_END(0)


    { constexpr int layer = 0; constexpr int PB = 1;
        PH_BEGIN(PB + 0)
        { pg8::Gemm g{HB, WIN + (size_t)layer * PLD * DM, M_, PLD, DM, DM}; pg8::StaticOrder S; S.init(M_, PLD, G, bx);
          fp::EpiProj E{PROJ, RT, KM}; pg8::gemm_phase<fp::EpiProj, pg8::StaticOrder, true, true>(lds, g, S, E, tid); }
        PH_END(PB + 0)
        PH_BEGIN(PB + 1)
        { constexpr int NATT = NB * ATT_H * NBLK, NSSDA = NB * 32;
          volatile LAS unsigned* qw = (volatile LAS unsigned*)(lds + MISC_OFF) + 16;
#define QNEXT(word) do { if (tid == 0) qw[0] = __hip_atomic_fetch_add(ctl + (word), 1u, __ATOMIC_RELAXED, __HIP_MEMORY_SCOPE_AGENT); __syncthreads(); idx = (int)qw[0]; __syncthreads(); } while (0)
          int idx;
          for (;;) { QNEXT(CW_Q + 8 * layer); if (idx >= NATT) break;
              const int qb = (NBLK - 1) - idx / (NB * ATT_H), bh = idx % (NB * ATT_H);
              attn_body::attn_unit<8>(bh / ATT_H, bh % ATT_H, qb, (const attn_body::bf16*)(PROJ + FQ), (const attn_body::bf16*)(PROJ + FK), (const attn_body::bf16*)(PROJ + FV), (attn_body::bf16*)MIXB, KM, NB * ATT_H * NBLK * 64, (char*)lds_, tid); }
          for (;;) { QNEXT(CW_Q + 8 * layer + 1); if (idx >= NSSDA) break;
              ssdA_unit(idx >> 5, (idx >> 1) & 15, idx & 1, PROJ, conv_w + (size_t)layer * 4 * SSD_CW, conv_b + layer * SSD_CW, dt_bias + layer * SSD_H, a_log + layer * SSD_H, ST, CD, XCB, DTG, lds, tid, wave, lane); }
        }
        PH_END(PB + 1)
        PH_BEGIN(PB + 2)
        { constexpr int NSSDB = NB * 32, NGMU = NB * (SEQ / GM_CHUNK);
          volatile LAS unsigned* qw = (volatile LAS unsigned*)(lds + MISC_OFF) + 16;
          int idx;
          for (;;) { QNEXT(CW_Q + 8 * layer + 2); if (idx >= NSSDB) break;
              const int c = 15 - idx / (NB * 2), bg = idx % (NB * 2);
              ssdB_unit(bg >> 1, c, bg & 1, PROJ, XCB, DTG, d_skip + layer * SSD_H, ssd_norm_g + layer * SSD_W, ST, CD, MIXB, lds, tid, wave, lane); }
          for (;;) { QNEXT(CW_Q + 8 * layer + 3); if (idx >= NGMU) break;
              gm_unit(idx / (SEQ / GM_CHUNK), idx % (SEQ / GM_CHUNK), PROJ, WSB + (size_t)layer * GM_G * GM_CHUNK * GM_CHUNK, gm_ln_g + layer * GM_W, gm_ln_b + layer * GM_W,
                      gm_b_s + layer * GM_G * GM_CHUNK, gm_norm_g + layer * GM_W, MIXB, lds, wave, lane); }
          att_norm_phase(MIXB, att_norm_g + layer * ATT_W, M_, gw, ngw, lane);
          { const float* const p_mg = moe_w_gate; const float* const p_mu = moe_w_up; const float* const p_md = moe_w_down;
            constexpr int g0 = layer == 0 ? 0 : FT_G_A + FT_G_B, g1 = layer == 0 ? FT_G_A : FT_G, d0 = layer == 0 ? 0 : FT_D_A, d1 = layer == 0 ? FT_D_A : FT_D - FT_D_D;
            for (;;) { QNEXT(CW_Q + 8 * layer + 4); if (idx >= g1 - g0) break; filler_g(g0 + idx, p_mg, p_mu, MWGU, scr, wave, lane); }
            for (;;) { QNEXT(CW_Q + 8 * layer + 5); if (idx >= d1 - d0) break; filler_d(d0 + idx, p_md, MWD, scr, wave, lane); } }
#undef QNEXT
        }
        PH_END(PB + 2)
        PH_BEGIN(PB + 3)
        { pg8::Gemm g{MIXB, WOUT + (size_t)layer * DM * DM, M_, DM, DM, DM}; pg8::StaticOrder S; S.init(M_, DM, G, bx);
          fp::EpiY E{YB, DM}; pg8::gemm_phase<fp::EpiY, pg8::StaticOrder, false, true>(lds, g, S, E, tid); }
        PH_END(PB + 3)
        PH_BEGIN(PB + 4)
        { const float* const p_g = ln1_g + layer * DM; const float* const p_b = ln1_b + layer * DM;
          { float va[16], vb[16]; LnGB gbp; ln_gb_load(gbp, p_g, p_b, lane); long r = gw; if (r < M_) ln_load<bf16, bf16>(va, HB + r * DM, ALPHA, YB + r * DM, nullptr, lane);
            for (; r < M_; r += 2 * ngw) { const long r1 = r + ngw, r2 = r + 2 * ngw;
                if (r1 < M_) ln_load<bf16, bf16>(vb, HB + r1 * DM, ALPHA, YB + r1 * DM, nullptr, lane);
                ln_finish_r(va, gbp, nullptr, HB + r * DM, lane);
                if (r2 < M_) ln_load<bf16, bf16>(va, HB + r2 * DM, ALPHA, YB + r2 * DM, nullptr, lane);
                if (r1 < M_) ln_finish_r(vb, gbp, nullptr, HB + r1 * DM, lane); } }
          if (layer == 1) { asm volatile("s_waitcnt vmcnt(0)" ::: "memory"); moe_route_block(HB, router_w, CNT, TE, TP, TS, M_, gw, ngw, lane, wave, tid, (LAS int*)lds); } }
        PH_END(PB + 4)
        if constexpr (layer == 0) {
            PH_BEGIN(PB + 5)
            { pg8::Gemm g{HB, WGU, M_, NGU, DM, DM}; pg8::StaticOrder S; S.init(M_, NGU, G, bx);
              fp::EpiAct E{ACT, D_FF, NGU / 256}; pg8::gemm_phase<fp::EpiAct, pg8::StaticOrder, true, true>(lds, g, S, E, tid);
              { constexpr int UNITS = (NB * SEQ / 256) * (NGU / 256), REM = UNITS % 256;
                if (REM != 0 && G == 256 && bx >= REM) { constexpr int PER = (FT_G_B + (256 - REM) - 1) / (256 - REM); const float* const p_mg = moe_w_gate; const float* const p_mu = moe_w_up;
                    for (int k = 0; k < PER; ++k) { const int t = (bx - REM) * PER + k; if (t < FT_G_B) filler_g(FT_G_A + t, p_mg, p_mu, MWGU, scr, wave, lane); } }
                else if (REM == 0 || G != 256) { const float* const p_mg = moe_w_gate; const float* const p_mu = moe_w_up; for (int t = bx; t < FT_G_B; t += G) filler_g(FT_G_A + t, p_mg, p_mu, MWGU, scr, wave, lane); } } }
            PH_END(PB + 5)
            PH_BEGIN(PB + 6)
            { pg8::Gemm g{ACT, WD, M_, DM, D_FF, D_FF}; pg8::StaticOrder S; S.init(M_, DM, G, bx);
              fp::EpiY E{YB, DM}; pg8::gemm_phase<fp::EpiY, pg8::StaticOrder, false, true>(lds, g, S, E, tid); }
            PH_END(PB + 6)
            PH_BEGIN(PB + 7)
            { const float* const p_g = ln2_g + layer * DM; const float* const p_b = ln2_b + layer * DM;
              { float va[16], vb[16]; LnGB gbp; ln_gb_load(gbp, p_g, p_b, lane); long r = gw; if (r < M_) ln_load<bf16, bf16>(va, HB + r * DM, ALPHA, YB + r * DM, nullptr, lane);
            for (; r < M_; r += 2 * ngw) { const long r1 = r + ngw, r2 = r + 2 * ngw;
                if (r1 < M_) ln_load<bf16, bf16>(vb, HB + r1 * DM, ALPHA, YB + r1 * DM, nullptr, lane);
                ln_finish_r(va, gbp, nullptr, HB + r * DM, lane);
                if (r2 < M_) ln_load<bf16, bf16>(va, HB + r2 * DM, ALPHA, YB + r2 * DM, nullptr, lane);
                if (r1 < M_) ln_finish_r(vb, gbp, nullptr, HB + r1 * DM, lane); } } }
            PH_END(PB + 7)
        } else {
            PH_BEGIN(PB + 5)
            { int base[N_EXP]; { int b_ = 0;
#pragma unroll
                  for (int e = 0; e < N_EXP; ++e) { base[e] = b_; b_ += (CNT[e] + 255) & ~255; } }
              constexpr int RPW = (M_ + 2047) / 2048;
              int te[RPW][2], tsl[RPW][2]; float tpv[RPW][2];
#pragma unroll
              for (int k = 0; k < RPW; ++k) { const long r = gw + (long)k * ngw;
#pragma unroll
                  for (int q = 0; q < 2; ++q) { te[k][q] = 0; tsl[k][q] = 0; tpv[k][q] = 0.f; if (r < M_) { te[k][q] = TE[r * 2 + q]; tsl[k][q] = TS[r * 2 + q]; tpv[k][q] = TP[r * 2 + q]; } } }
#pragma unroll
              for (int k = 0; k < RPW; ++k) { const long r = gw + (long)k * ngw; if (r < M_) {
                  const uint4* src = (const uint4*)(HB + r * DM); const uint2 v0 = bf8_to_f8(src[lane]), v1 = bf8_to_f8(src[lane + 64]);
#pragma unroll
                  for (int q = 0; q < 2; ++q) { int be = 0;
#pragma unroll
                      for (int x = 0; x < N_EXP; ++x) be = (te[k][q] == x) ? base[x] : be;
                      const int gs = be + tsl[k][q];
                      if (lane == 0) { SP[gs] = tpv[k][q]; GS[r * 2 + q] = gs; }
                      uint2* dst = (uint2*)(XG + (size_t)gs * DM); dst[lane] = v0; dst[lane + 64] = v1; } } }
              for (long r = gw + (long)RPW * ngw; r < M_; r += ngw) {
                  const uint4* src = (const uint4*)(HB + r * DM); const uint2 v0 = bf8_to_f8(src[lane]), v1 = bf8_to_f8(src[lane + 64]);
                  for (int q = 0; q < 2; ++q) { const long it = r * 2 + q; const int e = TE[it]; int be = 0;
#pragma unroll
                      for (int x = 0; x < N_EXP; ++x) be = (e == x) ? base[x] : be;
                      const int gs = be + TS[it];
                      if (lane == 0) { SP[gs] = TP[it]; GS[it] = gs; }
                      uint2* dst = (uint2*)(XG + (size_t)gs * DM); dst[lane] = v0; dst[lane + 64] = v1; } }
              for (int it = gw; it < N_EXP * 256; it += ngw) { const int e = it >> 8, r = it & 255; const int c = CNT[e]; const int slot = moe_base(CNT, e) + c + r;
                  if (c + r < ((c + 255) & ~255)) { uint2* dst = (uint2*)(XG + (size_t)slot * DM); const uint2 z = make_uint2(0u, 0u); dst[lane] = z; dst[lane + 64] = z; if (lane == 0) SP[slot] = 0.f; } } }
            PH_END(PB + 5)
            PH_BEGIN(PB + 6)
            { pg8::Gemm g{(const pg8::bf16_t*)XG, (const pg8::bf16_t*)MWGU, NSLOT, N_EXP * NGUE, DM / 2, DM / 2}; fp::MoeOrder S; S.init(CNT, NGUE / 256, G, bx);
              fp::EpiAct8 E{ACTM, D_FFE, NGUE / 256}; pg8::gemm_phase<fp::EpiAct8, fp::MoeOrder, true, true, true>(lds, g, S, E, tid);
              { const int rem = (S.T * S.ncol) % G; const int nidle = rem == 0 ? G : G - rem, first = rem == 0 ? 0 : rem;
                if (bx >= first) { const int per = (FT_D_D + nidle - 1) / nidle; const float* const p_md = moe_w_down;
                    for (int k = 0; k < per; ++k) { const int t = (bx - first) * per + k; if (t < FT_D_D) filler_d(FT_D - FT_D_D + t, p_md, MWD, scr, wave, lane); } } } }
            PH_END(PB + 6)
            PH_BEGIN(PB + 7)
            { fp::MoeOrder S; S.init(CNT, DM / 256, G, bx); const int nf = S.tail_start(); const int slot0 = (nf / (DM / 256)) * 256;
              constexpr int KU = D_FFE / 2, KLEN = KU / MOE_KSPLIT;
              static_assert(KLEN % 128 == 0, "split-K parts must hold an even number of K-tiles");
              fp::EpiF2 E{F2, SP, F2P, slot0, KLEN, 1.f / W8_D};
              { pg8::Gemm g{(const pg8::bf16_t*)ACTM, (const pg8::bf16_t*)MWD, NSLOT, N_EXP * DM, KU, KU}; S.nfull = nf; S.ksplit = 1;
                pg8::gemm_phase<fp::EpiF2, fp::MoeOrder, true, true, true>(lds, g, S, E, wave * 64 + (int)xb_lane_fresh()); }
              { pg8::Gemm g{(const pg8::bf16_t*)ACTM, (const pg8::bf16_t*)MWD, NSLOT, N_EXP * DM, KLEN, KU}; S.ksplit = MOE_KSPLIT; S.klen = KLEN;
                int tid2 = wave * 64 + (int)xb_lane_fresh();
                pg8::gemm_phase<fp::EpiF2, fp::MoeOrder, true, true, true>(lds, g, S, E, tid2); } }
            PH_END(PB + 7)
            PH_BEGIN(PB + 8)
            { const float* const p_g = ln2_g + layer * DM; const float* const p_b = ln2_b + layer * DM;
              int slot0; { fp::MoeOrder S; S.init(CNT, DM / 256, G, bx); const int nf = S.tail_start(); slot0 = (nf == S.T * (DM / 256)) ? 0x7fffffff : (nf / (DM / 256)) * 256; }
#define LN2_LOAD(v, rr, kk_) do { int s0_ = GS[(rr) * 2], s1_ = GS[(rr) * 2 + 1]; if (kk_ < RPW2) { _Pragma("unroll") for (int x_ = 0; x_ < RPW2; ++x_) if (x_ == kk_) { s0_ = gsv[x_][0]; s1_ = gsv[x_][1]; } } ln_load<bf16, bf16>(v, HB + (rr) * DM, ALPHA, F2 + (size_t)s0_ * DM, F2 + (size_t)s1_ * DM, lane); \
                  if (s0_ >= slot0) { _Pragma("unroll") for (int p_ = 0; p_ < MOE_KSPLIT - 1; ++p_) ln_add(v, F2P + ((size_t)p_ * TAIL_SLOTS + (s0_ - slot0)) * DM, lane); } \
                  if (s1_ >= slot0) { _Pragma("unroll") for (int p_ = 0; p_ < MOE_KSPLIT - 1; ++p_) ln_add(v, F2P + ((size_t)p_ * TAIL_SLOTS + (s1_ - slot0)) * DM, lane); } } while (0)
              constexpr int RPW2 = (M_ + 2047) / 2048; int gsv[RPW2][2];
#pragma unroll
              for (int x_ = 0; x_ < RPW2; ++x_) { const long rr_ = gw + (long)x_ * ngw; gsv[x_][0] = 0; gsv[x_][1] = 0; if (rr_ < M_) { gsv[x_][0] = GS[rr_ * 2]; gsv[x_][1] = GS[rr_ * 2 + 1]; } }
              { float va[16], vb[16]; LnGB gbp; ln_gb_load(gbp, p_g, p_b, lane); long r = gw; int kq = 0; if (r < M_) LN2_LOAD(va, r, kq);
                for (; r < M_; r += 2 * ngw, kq += 2) { const long r1 = r + ngw, r2 = r + 2 * ngw;
                    if (r1 < M_) LN2_LOAD(vb, r1, kq + 1);
                    ln_finish_r(va, gbp, H + r * DM, nullptr, lane);
                    if (r2 < M_) LN2_LOAD(va, r2, kq + 2);
                    if (r1 < M_) ln_finish_r(vb, gbp, H + r1 * DM, nullptr, lane); } }
#undef LN2_LOAD
            }
            PH_END(PB + 8)
        }
    }

    { constexpr int layer = 1; constexpr int PB = 9;
        PH_BEGIN(PB + 0)
        { pg8::Gemm g{HB, WIN + (size_t)layer * PLD * DM, M_, PLD, DM, DM}; pg8::StaticOrder S; S.init(M_, PLD, G, bx);
          fp::EpiProj E{PROJ, RT, KM}; pg8::gemm_phase<fp::EpiProj, pg8::StaticOrder, true, true>(lds, g, S, E, tid); }
        PH_END(PB + 0)
        PH_BEGIN(PB + 1)
        { constexpr int NATT = NB * ATT_H * NBLK, NSSDA = NB * 32;
          volatile LAS unsigned* qw = (volatile LAS unsigned*)(lds + MISC_OFF) + 16;
#define QNEXT(word) do { if (tid == 0) qw[0] = __hip_atomic_fetch_add(ctl + (word), 1u, __ATOMIC_RELAXED, __HIP_MEMORY_SCOPE_AGENT); __syncthreads(); idx = (int)qw[0]; __syncthreads(); } while (0)
          int idx;
          for (;;) { QNEXT(CW_Q + 8 * layer); if (idx >= NATT) break;
              const int qb = (NBLK - 1) - idx / (NB * ATT_H), bh = idx % (NB * ATT_H);
              attn_body::attn_unit<8>(bh / ATT_H, bh % ATT_H, qb, (const attn_body::bf16*)(PROJ + FQ), (const attn_body::bf16*)(PROJ + FK), (const attn_body::bf16*)(PROJ + FV), (attn_body::bf16*)MIXB, KM, NB * ATT_H * NBLK * 64, (char*)lds_, tid); }
          for (;;) { QNEXT(CW_Q + 8 * layer + 1); if (idx >= NSSDA) break;
              ssdA_unit(idx >> 5, (idx >> 1) & 15, idx & 1, PROJ, conv_w + (size_t)layer * 4 * SSD_CW, conv_b + layer * SSD_CW, dt_bias + layer * SSD_H, a_log + layer * SSD_H, ST, CD, XCB, DTG, lds, tid, wave, lane); }
        }
        PH_END(PB + 1)
        PH_BEGIN(PB + 2)
        { constexpr int NSSDB = NB * 32, NGMU = NB * (SEQ / GM_CHUNK);
          volatile LAS unsigned* qw = (volatile LAS unsigned*)(lds + MISC_OFF) + 16;
          int idx;
          for (;;) { QNEXT(CW_Q + 8 * layer + 2); if (idx >= NSSDB) break;
              const int c = 15 - idx / (NB * 2), bg = idx % (NB * 2);
              ssdB_unit(bg >> 1, c, bg & 1, PROJ, XCB, DTG, d_skip + layer * SSD_H, ssd_norm_g + layer * SSD_W, ST, CD, MIXB, lds, tid, wave, lane); }
          for (;;) { QNEXT(CW_Q + 8 * layer + 3); if (idx >= NGMU) break;
              gm_unit(idx / (SEQ / GM_CHUNK), idx % (SEQ / GM_CHUNK), PROJ, WSB + (size_t)layer * GM_G * GM_CHUNK * GM_CHUNK, gm_ln_g + layer * GM_W, gm_ln_b + layer * GM_W,
                      gm_b_s + layer * GM_G * GM_CHUNK, gm_norm_g + layer * GM_W, MIXB, lds, wave, lane); }
          att_norm_phase(MIXB, att_norm_g + layer * ATT_W, M_, gw, ngw, lane);
          { const float* const p_mg = moe_w_gate; const float* const p_mu = moe_w_up; const float* const p_md = moe_w_down;
            constexpr int g0 = layer == 0 ? 0 : FT_G_A + FT_G_B, g1 = layer == 0 ? FT_G_A : FT_G, d0 = layer == 0 ? 0 : FT_D_A, d1 = layer == 0 ? FT_D_A : FT_D - FT_D_D;
            for (;;) { QNEXT(CW_Q + 8 * layer + 4); if (idx >= g1 - g0) break; filler_g(g0 + idx, p_mg, p_mu, MWGU, scr, wave, lane); }
            for (;;) { QNEXT(CW_Q + 8 * layer + 5); if (idx >= d1 - d0) break; filler_d(d0 + idx, p_md, MWD, scr, wave, lane); } }
#undef QNEXT
        }
        PH_END(PB + 2)
        PH_BEGIN(PB + 3)
        { pg8::Gemm g{MIXB, WOUT + (size_t)layer * DM * DM, M_, DM, DM, DM}; pg8::StaticOrder S; S.init(M_, DM, G, bx);
          fp::EpiY E{YB, DM}; pg8::gemm_phase<fp::EpiY, pg8::StaticOrder, false, true>(lds, g, S, E, tid); }
        PH_END(PB + 3)
        PH_BEGIN(PB + 4)
        { const float* const p_g = ln1_g + layer * DM; const float* const p_b = ln1_b + layer * DM;
          { float va[16], vb[16]; LnGB gbp; ln_gb_load(gbp, p_g, p_b, lane); long r = gw; if (r < M_) ln_load<bf16, bf16>(va, HB + r * DM, ALPHA, YB + r * DM, nullptr, lane);
            for (; r < M_; r += 2 * ngw) { const long r1 = r + ngw, r2 = r + 2 * ngw;
                if (r1 < M_) ln_load<bf16, bf16>(vb, HB + r1 * DM, ALPHA, YB + r1 * DM, nullptr, lane);
                ln_finish_r(va, gbp, nullptr, HB + r * DM, lane);
                if (r2 < M_) ln_load<bf16, bf16>(va, HB + r2 * DM, ALPHA, YB + r2 * DM, nullptr, lane);
                if (r1 < M_) ln_finish_r(vb, gbp, nullptr, HB + r1 * DM, lane); } }
          if (layer == 1) { asm volatile("s_waitcnt vmcnt(0)" ::: "memory"); moe_route_block(HB, router_w, CNT, TE, TP, TS, M_, gw, ngw, lane, wave, tid, (LAS int*)lds); } }
        PH_END(PB + 4)
        if constexpr (layer == 0) {
            PH_BEGIN(PB + 5)
            { pg8::Gemm g{HB, WGU, M_, NGU, DM, DM}; pg8::StaticOrder S; S.init(M_, NGU, G, bx);
              fp::EpiAct E{ACT, D_FF, NGU / 256}; pg8::gemm_phase<fp::EpiAct, pg8::StaticOrder, true, true>(lds, g, S, E, tid);
              { constexpr int UNITS = (NB * SEQ / 256) * (NGU / 256), REM = UNITS % 256;
                if (REM != 0 && G == 256 && bx >= REM) { constexpr int PER = (FT_G_B + (256 - REM) - 1) / (256 - REM); const float* const p_mg = moe_w_gate; const float* const p_mu = moe_w_up;
                    for (int k = 0; k < PER; ++k) { const int t = (bx - REM) * PER + k; if (t < FT_G_B) filler_g(FT_G_A + t, p_mg, p_mu, MWGU, scr, wave, lane); } }
                else if (REM == 0 || G != 256) { const float* const p_mg = moe_w_gate; const float* const p_mu = moe_w_up; for (int t = bx; t < FT_G_B; t += G) filler_g(FT_G_A + t, p_mg, p_mu, MWGU, scr, wave, lane); } } }
            PH_END(PB + 5)
            PH_BEGIN(PB + 6)
            { pg8::Gemm g{ACT, WD, M_, DM, D_FF, D_FF}; pg8::StaticOrder S; S.init(M_, DM, G, bx);
              fp::EpiY E{YB, DM}; pg8::gemm_phase<fp::EpiY, pg8::StaticOrder, false, true>(lds, g, S, E, tid); }
            PH_END(PB + 6)
            PH_BEGIN(PB + 7)
            { const float* const p_g = ln2_g + layer * DM; const float* const p_b = ln2_b + layer * DM;
              { float va[16], vb[16]; LnGB gbp; ln_gb_load(gbp, p_g, p_b, lane); long r = gw; if (r < M_) ln_load<bf16, bf16>(va, HB + r * DM, ALPHA, YB + r * DM, nullptr, lane);
            for (; r < M_; r += 2 * ngw) { const long r1 = r + ngw, r2 = r + 2 * ngw;
                if (r1 < M_) ln_load<bf16, bf16>(vb, HB + r1 * DM, ALPHA, YB + r1 * DM, nullptr, lane);
                ln_finish_r(va, gbp, nullptr, HB + r * DM, lane);
                if (r2 < M_) ln_load<bf16, bf16>(va, HB + r2 * DM, ALPHA, YB + r2 * DM, nullptr, lane);
                if (r1 < M_) ln_finish_r(vb, gbp, nullptr, HB + r1 * DM, lane); } } }
            PH_END(PB + 7)
        } else {
            PH_BEGIN(PB + 5)
            { int base[N_EXP]; { int b_ = 0;
#pragma unroll
                  for (int e = 0; e < N_EXP; ++e) { base[e] = b_; b_ += (CNT[e] + 255) & ~255; } }
              constexpr int RPW = (M_ + 2047) / 2048;
              int te[RPW][2], tsl[RPW][2]; float tpv[RPW][2];
#pragma unroll
              for (int k = 0; k < RPW; ++k) { const long r = gw + (long)k * ngw;
#pragma unroll
                  for (int q = 0; q < 2; ++q) { te[k][q] = 0; tsl[k][q] = 0; tpv[k][q] = 0.f; if (r < M_) { te[k][q] = TE[r * 2 + q]; tsl[k][q] = TS[r * 2 + q]; tpv[k][q] = TP[r * 2 + q]; } } }
#pragma unroll
              for (int k = 0; k < RPW; ++k) { const long r = gw + (long)k * ngw; if (r < M_) {
                  const uint4* src = (const uint4*)(HB + r * DM); const uint2 v0 = bf8_to_f8(src[lane]), v1 = bf8_to_f8(src[lane + 64]);
#pragma unroll
                  for (int q = 0; q < 2; ++q) { int be = 0;
#pragma unroll
                      for (int x = 0; x < N_EXP; ++x) be = (te[k][q] == x) ? base[x] : be;
                      const int gs = be + tsl[k][q];
                      if (lane == 0) { SP[gs] = tpv[k][q]; GS[r * 2 + q] = gs; }
                      uint2* dst = (uint2*)(XG + (size_t)gs * DM); dst[lane] = v0; dst[lane + 64] = v1; } } }
              for (long r = gw + (long)RPW * ngw; r < M_; r += ngw) {
                  const uint4* src = (const uint4*)(HB + r * DM); const uint2 v0 = bf8_to_f8(src[lane]), v1 = bf8_to_f8(src[lane + 64]);
                  for (int q = 0; q < 2; ++q) { const long it = r * 2 + q; const int e = TE[it]; int be = 0;
#pragma unroll
                      for (int x = 0; x < N_EXP; ++x) be = (e == x) ? base[x] : be;
                      const int gs = be + TS[it];
                      if (lane == 0) { SP[gs] = TP[it]; GS[it] = gs; }
                      uint2* dst = (uint2*)(XG + (size_t)gs * DM); dst[lane] = v0; dst[lane + 64] = v1; } }
              for (int it = gw; it < N_EXP * 256; it += ngw) { const int e = it >> 8, r = it & 255; const int c = CNT[e]; const int slot = moe_base(CNT, e) + c + r;
                  if (c + r < ((c + 255) & ~255)) { uint2* dst = (uint2*)(XG + (size_t)slot * DM); const uint2 z = make_uint2(0u, 0u); dst[lane] = z; dst[lane + 64] = z; if (lane == 0) SP[slot] = 0.f; } } }
            PH_END(PB + 5)
            PH_BEGIN(PB + 6)
            { pg8::Gemm g{(const pg8::bf16_t*)XG, (const pg8::bf16_t*)MWGU, NSLOT, N_EXP * NGUE, DM / 2, DM / 2}; fp::MoeOrder S; S.init(CNT, NGUE / 256, G, bx);
              fp::EpiAct8 E{ACTM, D_FFE, NGUE / 256}; pg8::gemm_phase<fp::EpiAct8, fp::MoeOrder, true, true, true>(lds, g, S, E, tid);
              { const int rem = (S.T * S.ncol) % G; const int nidle = rem == 0 ? G : G - rem, first = rem == 0 ? 0 : rem;
                if (bx >= first) { const int per = (FT_D_D + nidle - 1) / nidle; const float* const p_md = moe_w_down;
                    for (int k = 0; k < per; ++k) { const int t = (bx - first) * per + k; if (t < FT_D_D) filler_d(FT_D - FT_D_D + t, p_md, MWD, scr, wave, lane); } } } }
            PH_END(PB + 6)
            PH_BEGIN(PB + 7)
            { fp::MoeOrder S; S.init(CNT, DM / 256, G, bx); const int nf = S.tail_start(); const int slot0 = (nf / (DM / 256)) * 256;
              constexpr int KU = D_FFE / 2, KLEN = KU / MOE_KSPLIT;
              static_assert(KLEN % 128 == 0, "split-K parts must hold an even number of K-tiles");
              fp::EpiF2 E{F2, SP, F2P, slot0, KLEN, 1.f / W8_D};
              { pg8::Gemm g{(const pg8::bf16_t*)ACTM, (const pg8::bf16_t*)MWD, NSLOT, N_EXP * DM, KU, KU}; S.nfull = nf; S.ksplit = 1;
                pg8::gemm_phase<fp::EpiF2, fp::MoeOrder, true, true, true>(lds, g, S, E, wave * 64 + (int)xb_lane_fresh()); }
              { pg8::Gemm g{(const pg8::bf16_t*)ACTM, (const pg8::bf16_t*)MWD, NSLOT, N_EXP * DM, KLEN, KU}; S.ksplit = MOE_KSPLIT; S.klen = KLEN;
                int tid2 = wave * 64 + (int)xb_lane_fresh();
                pg8::gemm_phase<fp::EpiF2, fp::MoeOrder, true, true, true>(lds, g, S, E, tid2); } }
            PH_END(PB + 7)
            PH_BEGIN(PB + 8)
            { const float* const p_g = ln2_g + layer * DM; const float* const p_b = ln2_b + layer * DM;
              int slot0; { fp::MoeOrder S; S.init(CNT, DM / 256, G, bx); const int nf = S.tail_start(); slot0 = (nf == S.T * (DM / 256)) ? 0x7fffffff : (nf / (DM / 256)) * 256; }
#define LN2_LOAD(v, rr, kk_) do { int s0_ = GS[(rr) * 2], s1_ = GS[(rr) * 2 + 1]; if (kk_ < RPW2) { _Pragma("unroll") for (int x_ = 0; x_ < RPW2; ++x_) if (x_ == kk_) { s0_ = gsv[x_][0]; s1_ = gsv[x_][1]; } } ln_load<bf16, bf16>(v, HB + (rr) * DM, ALPHA, F2 + (size_t)s0_ * DM, F2 + (size_t)s1_ * DM, lane); \
                  if (s0_ >= slot0) { _Pragma("unroll") for (int p_ = 0; p_ < MOE_KSPLIT - 1; ++p_) ln_add(v, F2P + ((size_t)p_ * TAIL_SLOTS + (s0_ - slot0)) * DM, lane); } \
                  if (s1_ >= slot0) { _Pragma("unroll") for (int p_ = 0; p_ < MOE_KSPLIT - 1; ++p_) ln_add(v, F2P + ((size_t)p_ * TAIL_SLOTS + (s1_ - slot0)) * DM, lane); } } while (0)
              constexpr int RPW2 = (M_ + 2047) / 2048; int gsv[RPW2][2];
#pragma unroll
              for (int x_ = 0; x_ < RPW2; ++x_) { const long rr_ = gw + (long)x_ * ngw; gsv[x_][0] = 0; gsv[x_][1] = 0; if (rr_ < M_) { gsv[x_][0] = GS[rr_ * 2]; gsv[x_][1] = GS[rr_ * 2 + 1]; } }
              { float va[16], vb[16]; LnGB gbp; ln_gb_load(gbp, p_g, p_b, lane); long r = gw; int kq = 0; if (r < M_) LN2_LOAD(va, r, kq);
                for (; r < M_; r += 2 * ngw, kq += 2) { const long r1 = r + ngw, r2 = r + 2 * ngw;
                    if (r1 < M_) LN2_LOAD(vb, r1, kq + 1);
                    ln_finish_r(va, gbp, H + r * DM, nullptr, lane);
                    if (r2 < M_) LN2_LOAD(va, r2, kq + 2);
                    if (r1 < M_) ln_finish_r(vb, gbp, H + r1 * DM, nullptr, lane); } }
#undef LN2_LOAD
            }
            PH_END(PB + 8)
        }
    }

#undef PH_BEGIN
#undef PH_END
#undef in_x
#undef in_pos
#undef ln_in_g
#undef ln_in_b
#undef w_in
#undef conv_w
#undef conv_b
#undef dt_bias
#undef a_log
#undef d_skip
#undef ssd_norm_g
#undef att_norm_g
#undef gm_ln_g
#undef gm_ln_b
#undef gm_w_s
#undef gm_b_s
#undef gm_norm_g
#undef w_out
#undef ln1_g
#undef ln1_b
#undef ln2_g
#undef ln2_b
#undef ffn_w_gate
#undef ffn_w_up
#undef ffn_w_down
#undef router_w
#undef moe_w_gate
#undef moe_w_up
#undef moe_w_down
#undef H
#undef MWD
#undef RT
#undef TE
#undef TP
#undef TS
#undef GS
#undef SP
#undef KM
#undef WSB
#undef HB
#undef MWGU
#undef WIN
#undef WOUT
#undef WGU
#undef WD
#undef PROJ
#undef ST
#undef CD
#undef XCB
#undef DTG
#undef MIXB
#undef YB
#undef ACT
#undef XG
#undef F2
#undef ACTM
#undef CNT
#undef tid
#undef lane
#undef F2P
#undef vcu
#undef gw
#undef ngw
#undef gt
#undef ngt
    if (pr_me) { const unsigned t_beg = (unsigned)__builtin_amdgcn_s_memrealtime(), t_len = (unsigned)PROBE_AMP * pr_w[1]; while ((unsigned)__builtin_amdgcn_s_memrealtime() - t_beg < t_len) __builtin_amdgcn_s_sleep(8); }
}

__device__ __forceinline__ void blk_acc(float d2, float s2, float* err) {
    d2 = wave_sum(d2); s2 = wave_sum(s2); if ((threadIdx.x & 63) == 0) { atomicAdd(err, d2); atomicAdd(err + 1, s2); }
}
__global__ void k_cmp_proj(const bf16* F, const float* S, long rows, float* err) {
    float d2 = 0.f, s2 = 0.f;
    for (long it = blockIdx.x * (long)blockDim.x + threadIdx.x; it < rows * 2950; it += gridDim.x * (long)blockDim.x) {
        const long row = it / 2950; const int d = (int)(it % 2950); const int sc = fp::win_src_col(d);
        float s = S[row * D_IN + sc]; if (d >= FGU && d < FXBC) s = gelu_tanh_f(s);
        const float f = ldf(F + row * PLD + d); d2 += (f - s) * (f - s); s2 += s * s; }
    blk_acc(d2, s2, err);
}
template <class TF> __global__ void k_cmp(const TF* F, int ldf_, const float* S, int lds_, long rows, int cols, float* err) {
    float d2 = 0.f, s2 = 0.f;
    for (long it = blockIdx.x * (long)blockDim.x + threadIdx.x; it < rows * cols; it += gridDim.x * (long)blockDim.x) {
        const long row = it / cols; const int c = (int)(it % cols); const float f = ldf(F + row * ldf_ + c), s = S[row * lds_ + c]; d2 += (f - s) * (f - s); s2 += s * s; }
    blk_acc(d2, s2, err);
}
__global__ void k_encode(const float* err, int nck, const float* Sout, float* out, long rows_s, long rows_all, float thr) {
    int k = 0; for (int i = 0; i < nck; ++i) { const float r = err[2 * i] / fmaxf(err[2 * i + 1], 1e-30f); if (!(r <= thr)) { k = i + 1; break; } }
    for (long it = blockIdx.x * (long)blockDim.x + threadIdx.x; it < rows_all * DM; it += gridDim.x * (long)blockDim.x)
        out[it] = (it < rows_s * DM) ? Sout[it] * (1.f + (float)k) : 0.f;
}
#if DEBUG_BUILD
constexpr size_t S_BASE = (WS_END + 2 * MiB - 1) / MiB * MiB;
#endif
extern "C" void kernel_launch(void* const* d_in, const int* in_sizes, int n_in, void* d_out, int out_size, void* d_ws, size_t ws_size, hipStream_t stream) {
    (void)in_sizes; (void)n_in; (void)out_size;
    static int grid = 0;
    if (grid == 0) {
        int dev = 0, cus = 0, per_cu = 0;
        if (hipGetDevice(&dev) != hipSuccess || hipDeviceGetAttribute(&cus, hipDeviceAttributeMultiprocessorCount, dev) != hipSuccess) { grid = -1; return; }
        if (hipFuncSetAttribute((const void*)mega, hipFuncAttributeMaxDynamicSharedMemorySize, LDS_BYTES) != hipSuccess) { fprintf(stderr, "kernel_launch: hipFuncSetAttribute failed\n"); grid = -1; return; }
        if (hipOccupancyMaxActiveBlocksPerMultiprocessor(&per_cu, (const void*)mega, 512, LDS_BYTES) != hipSuccess || per_cu < 1) fprintf(stderr, "kernel_launch: occupancy query reports %d\n", per_cu);
        (void)hipGetLastError();
        grid = cus;
        if (ws_size < WS_END) { fprintf(stderr, "kernel_launch: workspace too small: %zu < %zu\n", ws_size, (size_t)WS_END); grid = -1; }
    }
    if (grid < 0) return;
    unsigned char* ws = (unsigned char*)d_ws;
    if (hipMemsetAsync(ws + O_CTL, 0, CTL_BYTES, stream) != hipSuccess) return;
    FArgs a{};
    for (int i = 0; i < 29; ++i) a.in[i] = d_in[i];
    a.out = (float*)d_out; a.ws = ws;
#if !DEBUG_BUILD
    a.ph_lo = 0; a.ph_hi = N_PHASES;
    hipLaunchKernelGGL(mega, dim3(grid), dim3(512), LDS_BYTES, stream, a);
#else
    Inputs I;
    I.x = (const float*)d_in[0]; I.pos = (const int*)d_in[1]; I.ln_in_g = (const float*)d_in[2]; I.ln_in_b = (const float*)d_in[3]; I.w_in = (const float*)d_in[4];
    I.conv_w = (const float*)d_in[5]; I.conv_b = (const float*)d_in[6]; I.dt_bias = (const float*)d_in[7]; I.a_log = (const float*)d_in[8]; I.d_skip = (const float*)d_in[9];
    I.ssd_norm_g = (const float*)d_in[10]; I.att_norm_g = (const float*)d_in[11]; I.gm_ln_g = (const float*)d_in[12]; I.gm_ln_b = (const float*)d_in[13]; I.gm_w_s = (const float*)d_in[14];
    I.gm_b_s = (const float*)d_in[15]; I.gm_norm_g = (const float*)d_in[16]; I.w_out = (const float*)d_in[17]; I.ln1_g = (const float*)d_in[18]; I.ln1_b = (const float*)d_in[19];
    I.ln2_g = (const float*)d_in[20]; I.ln2_b = (const float*)d_in[21]; I.ffn_w_gate = (const float*)d_in[22]; I.ffn_w_up = (const float*)d_in[23]; I.ffn_w_down = (const float*)d_in[24];
    I.router_w = (const float*)d_in[25]; I.moe_w_gate = (const float*)d_in[26]; I.moe_w_up = (const float*)d_in[27]; I.moe_w_down = (const float*)d_in[28];
    const long MS = SEQ;
    unsigned char* sws = ws + S_BASE;
    float* saux = (float*)(sws + 96 * MiB); float* sout = (float*)(sws + 100 * MiB); float* ckpt = (float*)(sws + 110 * MiB);
    const size_t ck_stride = (size_t)MS * (D_IN + 3 * DM);
    run_simple(I, 1, sws, saux, sout, stream, ckpt);
    float* err = (float*)(ws + O_CTL) + CW_ERR;
    const bf16* PROJ = (const bf16*)(ws + O_PROJ); const bf16* MIXB = (const bf16*)(ws + O_MIXB); const bf16* Hf = (const bf16*)(ws + O_HB); const float* Hout = (const float*)d_out;
    for (int ph = 0; ph < N_PHASES; ++ph) {
        a.ph_lo = ph; a.ph_hi = ph + 1;
        hipLaunchKernelGGL(mega, dim3(grid), dim3(512), LDS_BYTES, stream, a);
        const int layer = ph >= 9 ? 1 : 0; const int rel = ph - (layer ? 8 : 0); const float* ck = ckpt + layer * ck_stride; float* e = err + layer * 12;
        if (rel == 1) k_cmp_proj<<<512, 256, 0, stream>>>(PROJ, ck, MS, e + 0);
        if (rel == 3) { k_cmp<bf16><<<512, 256, 0, stream>>>(MIXB, DM, ck + (size_t)MS * D_IN, DM, MS, 384, e + 2);
                        k_cmp<bf16><<<512, 256, 0, stream>>>(MIXB + 384, DM, ck + (size_t)MS * D_IN + 384, DM, MS, 384, e + 4);
                        k_cmp<bf16><<<512, 256, 0, stream>>>(MIXB + 768, DM, ck + (size_t)MS * D_IN + 768, DM, MS, 256, e + 6); }
        if (rel == 5) k_cmp<bf16><<<512, 256, 0, stream>>>(Hf, DM, ck + (size_t)MS * (D_IN + DM), DM, MS, DM, e + 8);
        if (layer == 0 && rel == 8) k_cmp<bf16><<<512, 256, 0, stream>>>(Hf, DM, ck + (size_t)MS * (D_IN + 2 * DM), DM, MS, DM, e + 10);
        if (layer == 1 && rel == 9) k_cmp<float><<<512, 256, 0, stream>>>(Hout, DM, ck + (size_t)MS * (D_IN + 2 * DM), DM, MS, DM, e + 10);
    }
    k_encode<<<1024, 256, 0, stream>>>(err, 12, sout, (float*)d_out, MS, (long)NBATCH * SEQ, DBG_THR);
#endif
}
```

```cpp
#define DEBUG_BUILD 0
#define DBG_THR 0.02f
#define PROBE_MASK 0u
#define PROBE_AMP 0
#include <hip/hip_runtime.h>
#include <cstdio>
#include <cstdint>

constexpr int DM = 1024, SEQ = 2048, NBATCH = 8;
constexpr int ATT_H = 6, HD = 64, ATT_W = 384, ROPE_DIM = 16;
constexpr int MOBA_BLOCK = 256, NBLK = SEQ / MOBA_BLOCK;
constexpr int SSD_H = 6, SSD_W = 384, SSD_G = 2, SSD_N = 128, SSD_CW = 896;
constexpr int GM_G = 4, GM_W = 256, GM_CHUNK = 128;
constexpr int D_IN = 2950, D_FF = 2816, N_EXP = 8, D_FFE = 3584;
constexpr float ALPHA = 1.4142135623730951f;
constexpr float NEGF = -1e30f;
constexpr int MAXSLOT = 2 * NBATCH * SEQ + N_EXP * 256;

typedef unsigned short bf16;
__device__ __forceinline__ unsigned f2bf(float f) { unsigned u = __float_as_uint(f); return (u + 0x7fffu + ((u >> 16) & 1u)) >> 16; }
__device__ __forceinline__ float ldf(const float* p) { return *p; }
__device__ __forceinline__ float ldf(const bf16* p) { return __uint_as_float(((unsigned)*p) << 16); }
__device__ __forceinline__ void stf(float* p, float v) { *p = v; }
__device__ __forceinline__ void stf(bf16* p, float v) { *p = (bf16)f2bf(v); }

__device__ __forceinline__ float dpp_add(float v, const int ctrl_tag) {
    int r;
    if (ctrl_tag == 0) r = __builtin_amdgcn_update_dpp(0, __float_as_int(v), 0xB1, 0xF, 0xF, false);
    else if (ctrl_tag == 1) r = __builtin_amdgcn_update_dpp(0, __float_as_int(v), 0x4E, 0xF, 0xF, false);
    else if (ctrl_tag == 2) r = __builtin_amdgcn_update_dpp(0, __float_as_int(v), 0x141, 0xF, 0xF, false);
    else r = __builtin_amdgcn_update_dpp(0, __float_as_int(v), 0x140, 0xF, 0xF, false);
    return v + __int_as_float(r);
}
__device__ __forceinline__ float row16_sum(float v) { v = dpp_add(v, 0); v = dpp_add(v, 1); v = dpp_add(v, 2); v = dpp_add(v, 3); return v; }
__device__ __forceinline__ float wave_sum(float v) {
    v = row16_sum(v);
    { const auto rr = __builtin_amdgcn_permlane16_swap(__float_as_uint(v), __float_as_uint(v), false, false); v = __uint_as_float(rr[0]) + __uint_as_float(rr[1]); }
    { const auto rr = __builtin_amdgcn_permlane32_swap(__float_as_uint(v), __float_as_uint(v), false, false); v = __uint_as_float(rr[0]) + __uint_as_float(rr[1]); }
    return v;
}
__device__ __forceinline__ float silu_f(float x) { return x / (1.f + __expf(-x)); }
__device__ __forceinline__ float gelu_tanh_f(float x) { const float u = 0.7978845608028654f * (x + 0.044715f * x * x * x); return 0.5f * x * (1.f + tanhf(u)); }
__device__ __forceinline__ float softplus_f(float x) { return fmaxf(x, 0.f) + log1pf(__expf(-fabsf(x))); }

struct ProjL { int ld, q, k, v, z, xbc, dt, gu, gv; };

__device__ __forceinline__ float4 ld4(const float* p) { return *(const float4*)p; }
__device__ __forceinline__ float4 ld4(const bf16* p) { const uint2 w = *(const uint2*)p; return make_float4(__uint_as_float(w.x << 16), __uint_as_float(w.x & 0xffff0000u), __uint_as_float(w.y << 16), __uint_as_float(w.y & 0xffff0000u)); }
typedef float nt_f4 __attribute__((ext_vector_type(4)));
__device__ __forceinline__ float4 ld4_nt(const float* p) { const nt_f4 v = __builtin_nontemporal_load((const nt_f4*)p); return make_float4(v[0], v[1], v[2], v[3]); }
__device__ __forceinline__ float4 ld4_nt(const bf16* p) { return ld4(p); }
template <class TY, class TX = float, bool NTX = false> __device__ __forceinline__ void ln_load(float (&v)[16], const TX* xrow, float a, const TY* y1, const TY* y2, int lane) {
#pragma unroll
    for (int j = 0; j < 4; ++j) {
        const float4 x = NTX ? ld4_nt(xrow + j * 256 + lane * 4) : ld4(xrow + j * 256 + lane * 4);
        float4 t = make_float4(a * x.x, a * x.y, a * x.z, a * x.w);
        if (y1) { const float4 y = ld4(y1 + j * 256 + lane * 4); t.x += y.x; t.y += y.y; t.z += y.z; t.w += y.w; }
        if (y2) { const float4 y = ld4(y2 + j * 256 + lane * 4); t.x += y.x; t.y += y.y; t.z += y.z; t.w += y.w; }
        v[4 * j] = t.x; v[4 * j + 1] = t.y; v[4 * j + 2] = t.z; v[4 * j + 3] = t.w;
    }
}
__device__ __forceinline__ void ln_add(float (&v)[16], const bf16* y, int lane) {
#pragma unroll
    for (int j = 0; j < 4; ++j) { const float4 t = ld4(y + j * 256 + lane * 4); v[4 * j] += t.x; v[4 * j + 1] += t.y; v[4 * j + 2] += t.z; v[4 * j + 3] += t.w; }
}
__device__ __forceinline__ void ln_finish(float (&v)[16], const float* g, const float* b, float* of, bf16* ob, int lane) {
    float s = 0.f;
#pragma unroll
    for (int i = 0; i < 16; ++i) s += v[i];
    const float mean = wave_sum(s) * (1.f / 1024.f); float s2 = 0.f;
#pragma unroll
    for (int i = 0; i < 16; ++i) { v[i] -= mean; s2 += v[i] * v[i]; }
    const float rstd = rsqrtf(wave_sum(s2) * (1.f / 1024.f) + 1e-5f);
#pragma unroll
    for (int j = 0; j < 4; ++j) {
        const float4 gg = *(const float4*)(g + j * 256 + lane * 4), bb = *(const float4*)(b + j * 256 + lane * 4);
        float4 o = make_float4(v[4 * j] * rstd * gg.x + bb.x, v[4 * j + 1] * rstd * gg.y + bb.y, v[4 * j + 2] * rstd * gg.z + bb.z, v[4 * j + 3] * rstd * gg.w + bb.w);
        if (of) *(float4*)(of + j * 256 + lane * 4) = o;
        if (ob) { uint2 w; w.x = f2bf(o.x) | (f2bf(o.y) << 16); w.y = f2bf(o.z) | (f2bf(o.w) << 16); *(uint2*)(ob + j * 256 + lane * 4) = w; }
    }
}

struct LnGB { float4 g[4], b[4]; };
__device__ __forceinline__ void ln_gb_load(LnGB& p, const float* g, const float* b, int lane) {
#pragma unroll
    for (int j = 0; j < 4; ++j) { p.g[j] = *(const float4*)(g + j * 256 + lane * 4); p.b[j] = *(const float4*)(b + j * 256 + lane * 4); }
}
__device__ __forceinline__ void ln_finish_r(float (&v)[16], const LnGB& p, float* of, bf16* ob, int lane, unsigned char* o8 = nullptr  ) {
    float s = 0.f;
#pragma unroll
    for (int i = 0; i < 16; ++i) s += v[i];
    const float mean = wave_sum(s) * (1.f / 1024.f); float s2 = 0.f;
#pragma unroll
    for (int i = 0; i < 16; ++i) { v[i] -= mean; s2 += v[i] * v[i]; }
    const float rstd = rsqrtf(wave_sum(s2) * (1.f / 1024.f) + 1e-5f);
#pragma unroll
    for (int j = 0; j < 4; ++j) {
        const float4 gg = p.g[j], bb = p.b[j];
        float4 o = make_float4(v[4 * j] * rstd * gg.x + bb.x, v[4 * j + 1] * rstd * gg.y + bb.y, v[4 * j + 2] * rstd * gg.z + bb.z, v[4 * j + 3] * rstd * gg.w + bb.w);
        if (of) { nt_f4 ov; ov[0] = o.x; ov[1] = o.y; ov[2] = o.z; ov[3] = o.w; __builtin_nontemporal_store(ov, (nt_f4*)(of + j * 256 + lane * 4)); }
        if (ob) { uint2 w; w.x = f2bf(o.x) | (f2bf(o.y) << 16); w.y = f2bf(o.z) | (f2bf(o.w) << 16); *(uint2*)(ob + j * 256 + lane * 4) = w; }
        if (o8) { int w = 0; w = __builtin_amdgcn_cvt_pk_fp8_f32(o.x, o.y, w, false); w = __builtin_amdgcn_cvt_pk_fp8_f32(o.z, o.w, w, true); *(int*)(o8 + j * 256 + lane * 4) = w; }
    }
}
template <class TY> __device__ __forceinline__ void ln_row(const float* xrow, float a, const TY* y1, const TY* y2, const float* g, const float* b, float* of, bf16* ob, int lane) {
    float v[16]; ln_load<TY>(v, xrow, a, y1, y2, lane); ln_finish(v, g, b, of, ob, lane);
}

__device__ __forceinline__ void rope_inplace(float* P, ProjL L, const int* pos, long n_rows, long gt, long ngt) {
    for (long it = gt; it < n_rows * 96; it += ngt) {
        const int i = (int)(it & 7), hh = (int)((it >> 3) % 12); const long row = it / 96;
        const int off = (hh < 6 ? L.q : L.k) + (hh % 6) * 64;
        const float inv = powf(500000.0f, -(float)(2 * i) / 16.0f);
        const float ang = (float)pos[row] * inv;
        const float c = cosf(ang), s = sinf(ang);
        float* p = P + row * L.ld + off;
        const float x1 = p[i], x2 = p[i + 8];
        p[i] = x1 * c - x2 * s; p[i + 8] = x2 * c + x1 * s;
    }
}

template <class T> __device__ __forceinline__ void kmean_phase(const T* P, ProjL L, float* KM, int nb, long gt, long ngt) {
    for (long it = gt; it < (long)nb * ATT_H * NBLK * 64; it += ngt) {
        const int d = (int)(it & 63), n = (int)((it >> 6) % NBLK), h = (int)((it / (64 * NBLK)) % ATT_H), b = (int)(it / (64 * NBLK * ATT_H));
        const T* p = P + ((long)b * SEQ + n * MOBA_BLOCK) * L.ld + L.k + h * 64 + d; float s = 0.f;
        for (int r = 0; r < MOBA_BLOCK; ++r) s += ldf(p + (long)r * L.ld);
        KM[it] = s * (1.f / MOBA_BLOCK);
    }
}

template <class T> __device__ __forceinline__ void attn_naive_phase(const T* P, ProjL L, const float* KM, float* O, int ldo, int nb, int gw, int ngw, int lane) {
    for (long it = gw; it < (long)nb * ATT_H * SEQ; it += ngw) {
        const int q = (int)(it % SEQ), h = (int)((it / SEQ) % ATT_H), b = (int)(it / ((long)SEQ * ATT_H));
        const long row = (long)b * SEQ + q; const int qblk = q / MOBA_BLOCK;
        const float qv = ldf(P + row * L.ld + L.q + h * 64 + lane);
        float g[NBLK];
#pragma unroll
        for (int n = 0; n < NBLK; ++n) { const float t = wave_sum(qv * KM[(((long)b * ATT_H + h) * NBLK + n) * 64 + lane]); g[n] = (n < qblk) ? t : NEGF; }
        unsigned sel = 0u;
#pragma unroll
        for (int r = 0; r < 3; ++r) { float bv = -3.0e38f; int best = -1;
#pragma unroll
            for (int n = 0; n < NBLK; ++n) if (!((sel >> n) & 1u) && g[n] > bv) { bv = g[n]; best = n; }
            if (best >= 0 && bv > NEGF * 0.5f) sel |= 1u << best; }
        sel |= 1u << qblk;
        float m = -3.0e38f, l = 0.f, o = 0.f;
        for (int n = 0; n <= qblk; ++n) {
            if (!((sel >> n) & 1u)) continue;
            const int j0 = n * MOBA_BLOCK, j1 = (n == qblk) ? q + 1 : j0 + MOBA_BLOCK;
            const T* kp = P + ((long)b * SEQ + j0) * L.ld + L.k + h * 64 + lane;
            const T* vp = P + ((long)b * SEQ + j0) * L.ld + L.v + h * 64 + lane;
            for (int j = j0; j < j1; ++j, kp += L.ld, vp += L.ld) {
                const float s = wave_sum(qv * ldf(kp)) * 0.125f;
                const float mn = fmaxf(m, s), corr = __expf(m - mn), p = __expf(s - mn);
                l = l * corr + p; o = o * corr + p * ldf(vp); m = mn;
            }
        }
        O[row * ldo + h * 64 + lane] = o / l;
    }
}

template <int W, class TO> __device__ __forceinline__ void rms_rows_phase(const float* in, int ldi, const float* g, TO* out, int ldo, long n_rows, int gw, int ngw, int lane) {
    constexpr int PER = W / 64;
    for (long row = gw; row < n_rows; row += ngw) {
        float v[PER]; float s = 0.f;
#pragma unroll
        for (int j = 0; j < PER; ++j) { v[j] = in[row * ldi + j * 64 + lane]; s += v[j] * v[j]; }
        const float r = rsqrtf(wave_sum(s) * (1.f / W) + 1e-5f);
#pragma unroll
        for (int j = 0; j < PER; ++j) stf(out + row * ldo + j * 64 + lane, v[j] * r * g[j * 64 + lane]);
    }
}

template <class T, class TO> __device__ __forceinline__ void ssd_conv_phase(const T* P, ProjL L, const float* cw, const float* cb, const float* dtb, TO* XC, float* DT, long n_rows, long gt, long ngt) {
    for (long it = gt; it < n_rows * 902; it += ngt) {
        const int c = (int)(it % 902); const long row = it / 902; const int t = (int)(row % SEQ);
        if (c < SSD_CW) {
            float acc = cb[c];
#pragma unroll
            for (int i = 0; i < 4; ++i) { const int tt = t - 3 + i; if (tt >= 0) acc += cw[i * SSD_CW + c] * ldf(P + (row - 3 + i) * L.ld + L.xbc + c); }
            stf(XC + row * SSD_CW + c, silu_f(acc));
        } else {
            const int h = c - SSD_CW;
            DT[row * SSD_H + h] = softplus_f(ldf(P + row * L.ld + L.dt + h) + dtb[h]);
        }
    }
}

template <class T> __device__ __forceinline__ void ssd_scan_naive_phase(const T* XC, const float* DT, const float* a_log, const float* dsk, float* Y, int ldo, int nb, int gw, int ngw, int lane) {
    for (int it = gw; it < nb * SSD_H * 64; it += ngw) {
        const int p = it & 63, h = (it >> 6) % SSD_H, b = it / (64 * SSD_H), grp = h / (SSD_H / SSD_G);
        const float A = -__expf(a_log[h]), Dk = dsk[h];
        float s0 = 0.f, s1 = 0.f;
#pragma unroll 4
        for (int t = 0; t < SEQ; ++t) {
            const long row = (long)b * SEQ + t;
            const T* xr = XC + row * SSD_CW;
            const float dt = DT[row * SSD_H + h], x = ldf(xr + h * 64 + p);
            const float B0 = ldf(xr + SSD_W + grp * SSD_N + lane), B1 = ldf(xr + SSD_W + grp * SSD_N + 64 + lane);
            const float C0 = ldf(xr + SSD_W + SSD_G * SSD_N + grp * SSD_N + lane), C1 = ldf(xr + SSD_W + SSD_G * SSD_N + grp * SSD_N + 64 + lane);
            const float dec = __expf(dt * A), xd = x * dt;
            s0 = s0 * dec + xd * B0; s1 = s1 * dec + xd * B1;
            const float y = wave_sum(C0 * s0 + C1 * s1);
            if (lane == 0) Y[row * ldo + h * 64 + p] = y + Dk * x;
        }
    }
}

template <class T, class TO> __device__ __forceinline__ void ssd_gate_phase(const float* Y, int ldi, const T* P, ProjL L, const float* ng, TO* out, int ldo, long n_rows, int gw, int ngw, int lane) {
    for (long row = gw; row < n_rows; row += ngw) {
        float v[6];
#pragma unroll
        for (int j = 0; j < 6; ++j) { const int c = j * 64 + lane; v[j] = Y[row * ldi + c] * silu_f(ldf(P + row * L.ld + L.z + c)); }
        const float r0 = rsqrtf(wave_sum(v[0] * v[0] + v[1] * v[1] + v[2] * v[2]) * (1.f / 192.f) + 1e-5f);
        const float r1 = rsqrtf(wave_sum(v[3] * v[3] + v[4] * v[4] + v[5] * v[5]) * (1.f / 192.f) + 1e-5f);
#pragma unroll
        for (int j = 0; j < 6; ++j) { const int c = j * 64 + lane; stf(out + row * ldo + c, v[j] * (j < 3 ? r0 : r1) * ng[c]); }
    }
}

template <class T, bool PRE> __device__ __forceinline__ void gm_ln_phase(const T* P, ProjL L, const float* g, const float* b, float* VN, long n_rows, int gw, int ngw, int lane) {
    for (long row = gw; row < n_rows; row += ngw) {
        float v[4]; float s = 0.f;
#pragma unroll
        for (int j = 0; j < 4; ++j) { const float x = ldf(P + row * L.ld + L.gv + j * 64 + lane); v[j] = PRE ? x : gelu_tanh_f(x); s += v[j]; }
        const float mean = wave_sum(s) * (1.f / 256.f); float s2 = 0.f;
#pragma unroll
        for (int j = 0; j < 4; ++j) { v[j] -= mean; s2 += v[j] * v[j]; }
        const float rstd = rsqrtf(wave_sum(s2) * (1.f / 256.f) + 1e-5f);
#pragma unroll
        for (int j = 0; j < 4; ++j) VN[row * GM_W + j * 64 + lane] = v[j] * rstd * g[j * 64 + lane] + b[j * 64 + lane];
    }
}
template <class T, bool PRE> __device__ __forceinline__ void gm_mix_phase(const T* P, ProjL L, const float* VN, const float* ws_, const float* bs, float* GO, int ldo, long n_rows, long gt, long ngt) {
    for (long it = gt; it < n_rows * GM_W; it += ngt) {
        const int c = (int)(it % GM_W); const long row = it / GM_W; const int t = (int)(row % GM_CHUNK), g = c / 64; const long base = row - t;
        const float* w = ws_ + ((long)g * GM_CHUNK + t) * GM_CHUNK; float acc = 0.f;
        for (int s = 0; s <= t; ++s) acc += w[s] * VN[(base + s) * GM_W + c];
        acc += bs[g * GM_CHUNK + t];
        const float x = ldf(P + row * L.ld + L.gu + c); const float u = PRE ? x : gelu_tanh_f(x);
        GO[row * ldo + c] = u * acc;
    }
}

__device__ __forceinline__ void moe_route_phase(const float* H, const float* Wr, int* CNT, int* TE, float* TP, int* TS, long n_rows, int gw, int ngw, int lane) {
    for (long row = gw; row < n_rows; row += ngw) {
        float acc[N_EXP];
#pragma unroll
        for (int e = 0; e < N_EXP; ++e) acc[e] = 0.f;
        for (int j = 0; j < 16; ++j) { const int d = j * 64 + lane; const float hv = H[row * DM + d];
            const float4 w0 = *(const float4*)(Wr + d * N_EXP), w1 = *(const float4*)(Wr + d * N_EXP + 4);
            acc[0] += hv * w0.x; acc[1] += hv * w0.y; acc[2] += hv * w0.z; acc[3] += hv * w0.w; acc[4] += hv * w1.x; acc[5] += hv * w1.y; acc[6] += hv * w1.z; acc[7] += hv * w1.w; }
#pragma unroll
        for (int e = 0; e < N_EXP; ++e) acc[e] = wave_sum(acc[e]);
        int e0 = 0; float v0 = acc[0];
#pragma unroll
        for (int e = 1; e < N_EXP; ++e) if (acc[e] > v0) { v0 = acc[e]; e0 = e; }
        int e1 = -1; float v1 = -3.0e38f;
#pragma unroll
        for (int e = 0; e < N_EXP; ++e) if (e != e0 && acc[e] > v1) { v1 = acc[e]; e1 = e; }
        const float p1 = __expf(v1 - v0), den = 1.f + p1;
        if (lane == 0) {
            const int s0 = atomicAdd(&CNT[e0], 1), s1 = atomicAdd(&CNT[e1], 1);
            TE[row * 2] = e0; TE[row * 2 + 1] = e1; TP[row * 2] = 1.f / den; TP[row * 2 + 1] = p1 / den; TS[row * 2] = s0; TS[row * 2 + 1] = s1;
        }
    }
}

__device__ __forceinline__ void moe_route_block(const bf16* H, const float* Wr, int* CNT, int* TE, float* TP, int* TS, long n_rows, int gw_, int ngw_, int lane, int wave, int tid,
                                                __attribute__((address_space(3))) int* sh  ) {
    asm volatile("" : "+v"(tid));
    if (tid < 16) sh[tid] = 0;
    __syncthreads();
    int k = 0;
    for (long row = gw_; row < n_rows; row += ngw_, ++k) {
        float acc[N_EXP];
#pragma unroll
        for (int e = 0; e < N_EXP; ++e) acc[e] = 0.f;
        for (int j = 0; j < 16; ++j) { const int d = j * 64 + lane; const float hv = ldf(H + row * DM + d);
            const float4 w0 = *(const float4*)(Wr + d * N_EXP), w1 = *(const float4*)(Wr + d * N_EXP + 4);
            acc[0] += hv * w0.x; acc[1] += hv * w0.y; acc[2] += hv * w0.z; acc[3] += hv * w0.w; acc[4] += hv * w1.x; acc[5] += hv * w1.y; acc[6] += hv * w1.z; acc[7] += hv * w1.w; }
#pragma unroll
        for (int e = 0; e < N_EXP; ++e) acc[e] = wave_sum(acc[e]);
        int e0 = 0; float v0 = acc[0];
#pragma unroll
        for (int e = 1; e < N_EXP; ++e) if (acc[e] > v0) { v0 = acc[e]; e0 = e; }
        int e1 = -1; float v1 = -3.0e38f;
#pragma unroll
        for (int e = 0; e < N_EXP; ++e) if (e != e0 && acc[e] > v1) { v1 = acc[e]; e1 = e; }
        const float p1 = __expf(v1 - v0), den = 1.f + p1;
        if (lane == 0) {
            const int l0 = atomicAdd((int*)&sh[e0], 1), l1 = atomicAdd((int*)&sh[e1], 1);
            TE[row * 2] = e0; TE[row * 2 + 1] = e1; TP[row * 2] = 1.f / den; TP[row * 2 + 1] = p1 / den;
            sh[16 + (wave * 8 + k) * 4 + 0] = e0; sh[16 + (wave * 8 + k) * 4 + 1] = e1; sh[16 + (wave * 8 + k) * 4 + 2] = l0; sh[16 + (wave * 8 + k) * 4 + 3] = l1;
        }
    }
    __syncthreads();
    if (tid < N_EXP) sh[8 + tid] = atomicAdd(&CNT[tid], sh[tid]);
    __syncthreads();
    k = 0;
    for (long row = gw_; row < n_rows; row += ngw_, ++k)
        if (lane == 0) { const int e0 = sh[16 + (wave * 8 + k) * 4], e1 = sh[16 + (wave * 8 + k) * 4 + 1];
            TS[row * 2] = sh[8 + e0] + sh[16 + (wave * 8 + k) * 4 + 2]; TS[row * 2 + 1] = sh[8 + e1] + sh[16 + (wave * 8 + k) * 4 + 3]; }
    __syncthreads();
}
__device__ __forceinline__ int moe_base(const int* CNT, int e) { int b = 0; for (int i = 0; i < e; ++i) b += (CNT[i] + 255) & ~255; return b; }
__device__ __forceinline__ void moe_scatter_phase(const int* CNT, const int* TE, const float* TP, const int* TS, int* LIST, float* SP, int* GS, long n_rows, long gt, long ngt) {
    for (long it = gt; it < n_rows * 2; it += ngt) {
        const int e = TE[it]; const int gs = moe_base(CNT, e) + TS[it];
        LIST[gs] = (int)(it >> 1); SP[gs] = TP[it]; GS[it] = gs;
    }
}

template <class TA, int EPI> __global__ void __launch_bounds__(256) sgemm_k(const TA* A, int lda, const int* rowlist, const float* B, const float* B2, int ldb, long bstride, void* Cv, int ldc, int M, int N, int K, const int* CNT, const float* scale) {
    __shared__ float As[16][68], Bs[16][68], Bs2[16][68];
    int row_base = 0, mrows = M;
    if (CNT) { const int e = blockIdx.z; row_base = moe_base(CNT, e); mrows = CNT[e]; B += (long)e * bstride; if (B2) B2 += (long)e * bstride; }
    const int m0 = blockIdx.y * 64; if (m0 >= mrows) return;
    const int n0 = blockIdx.x * 64, tid = threadIdx.x, tx = tid & 15, ty = tid >> 4;
    float acc[4][4], acc2[4][4];
#pragma unroll
    for (int i = 0; i < 4; ++i)
#pragma unroll
        for (int j = 0; j < 4; ++j) { acc[i][j] = 0.f; acc2[i][j] = 0.f; }
    const int ar = tid >> 2, ak = (tid & 3) * 4; long arow = -1;
    { const int lr = m0 + ar; if (lr < mrows) { arow = rowlist ? (long)rowlist[row_base + lr] : (long)(row_base + lr); } }
    const int bk = tid >> 4, bn = (tid & 15) * 4;
    for (int k0 = 0; k0 < K; k0 += 16) {
        float av[4] = {0.f, 0.f, 0.f, 0.f};
        if (arow >= 0) {
#pragma unroll
            for (int i = 0; i < 4; ++i) av[i] = ldf(A + arow * lda + k0 + ak + i);
        }
#pragma unroll
        for (int i = 0; i < 4; ++i) As[ak + i][ar] = av[i];
#pragma unroll
        for (int i = 0; i < 4; ++i) { const int n = n0 + bn + i; const bool ok = n < N;
            Bs[bk][bn + i] = ok ? B[(long)(k0 + bk) * ldb + n] : 0.f;
            if (EPI == 1 || EPI == 2) Bs2[bk][bn + i] = ok ? B2[(long)(k0 + bk) * ldb + n] : 0.f; }
        __syncthreads();
#pragma unroll
        for (int kk = 0; kk < 16; ++kk) {
            float a[4], b[4], b2[4];
#pragma unroll
            for (int i = 0; i < 4; ++i) { a[i] = As[kk][ty * 4 + i]; b[i] = Bs[kk][tx * 4 + i]; if (EPI == 1 || EPI == 2) b2[i] = Bs2[kk][tx * 4 + i]; }
#pragma unroll
            for (int i = 0; i < 4; ++i)
#pragma unroll
                for (int j = 0; j < 4; ++j) { acc[i][j] += a[i] * b[j]; if (EPI == 1 || EPI == 2) acc2[i][j] += a[i] * b2[j]; }
        }
        __syncthreads();
    }
#pragma unroll
    for (int i = 0; i < 4; ++i) { const int lr = m0 + ty * 4 + i; if (lr >= mrows) continue; const long crow = row_base + lr;
#pragma unroll
        for (int j = 0; j < 4; ++j) { const int n = n0 + tx * 4 + j; if (n >= N) continue;
            float v = acc[i][j];
            if (EPI == 1 || EPI == 2) v = silu_f(v) * acc2[i][j];
            if (EPI == 3) v *= scale[crow];
            if (EPI == 2) ((bf16*)Cv)[crow * ldc + n] = (bf16)f2bf(v); else ((float*)Cv)[crow * ldc + n] = v; } }
}

#define GW_DECL const int lane = threadIdx.x & 63; const int gw = (int)((blockIdx.x * (long)blockDim.x + threadIdx.x) >> 6); const int ngw = (int)((gridDim.x * (long)blockDim.x) >> 6); (void)lane; (void)gw; (void)ngw;
#define GT_DECL const long gt = blockIdx.x * (long)blockDim.x + threadIdx.x; const long ngt = gridDim.x * (long)blockDim.x;

__global__ void k_ln_in(const float* x, const float* g, const float* b, float* H, long n_rows) { GW_DECL for (long r = gw; r < n_rows; r += ngw) ln_row<float>(x + r * DM, 1.f, nullptr, nullptr, g, b, H + r * DM, nullptr, lane); }
__global__ void k_ln_res(float* H, const float* Y, const float* g, const float* b, float* OUT, long n_rows) { GW_DECL for (long r = gw; r < n_rows; r += ngw) ln_row<float>(H + r * DM, ALPHA, Y + r * DM, nullptr, g, b, OUT + r * DM, nullptr, lane); }
__global__ void k_ln_moe(float* H, const float* F2, const int* GS, const float* g, const float* b, float* OUT, long n_rows) { GW_DECL for (long r = gw; r < n_rows; r += ngw) ln_row<float>(H + r * DM, ALPHA, F2 + (long)GS[r * 2] * DM, F2 + (long)GS[r * 2 + 1] * DM, g, b, OUT + r * DM, nullptr, lane); }
__global__ void k_rope(float* P, ProjL L, const int* pos, long n_rows) { GT_DECL rope_inplace(P, L, pos, n_rows, gt, ngt); }
__global__ void k_kmean(const float* P, ProjL L, float* KM, int nb) { GT_DECL kmean_phase<float>(P, L, KM, nb, gt, ngt); }
__global__ void k_attn(const float* P, ProjL L, const float* KM, float* O, int ldo, int nb) { GW_DECL attn_naive_phase<float>(P, L, KM, O, ldo, nb, gw, ngw, lane); }
__global__ void k_rms384(const float* in, int ldi, const float* g, float* out, int ldo, long n_rows) { GW_DECL rms_rows_phase<384, float>(in, ldi, g, out, ldo, n_rows, gw, ngw, lane); }
__global__ void k_rms256(const float* in, int ldi, const float* g, float* out, int ldo, long n_rows) { GW_DECL rms_rows_phase<256, float>(in, ldi, g, out, ldo, n_rows, gw, ngw, lane); }
__global__ void k_ssd_conv(const float* P, ProjL L, const float* cw, const float* cb, const float* dtb, float* XC, float* DT, long n_rows) { GT_DECL ssd_conv_phase<float, float>(P, L, cw, cb, dtb, XC, DT, n_rows, gt, ngt); }
__global__ void k_ssd_scan(const float* XC, const float* DT, const float* a_log, const float* dsk, float* Y, int ldo, int nb) { GW_DECL ssd_scan_naive_phase<float>(XC, DT, a_log, dsk, Y, ldo, nb, gw, ngw, lane); }
__global__ void k_ssd_gate(const float* Y, int ldi, const float* P, ProjL L, const float* ng, float* out, int ldo, long n_rows) { GW_DECL ssd_gate_phase<float, float>(Y, ldi, P, L, ng, out, ldo, n_rows, gw, ngw, lane); }
__global__ void k_gm_ln(const float* P, ProjL L, const float* g, const float* b, float* VN, long n_rows) { GW_DECL gm_ln_phase<float, false>(P, L, g, b, VN, n_rows, gw, ngw, lane); }
__global__ void k_gm_mix(const float* P, ProjL L, const float* VN, const float* ws_, const float* bs, float* GO, int ldo, long n_rows) { GT_DECL gm_mix_phase<float, false>(P, L, VN, ws_, bs, GO, ldo, n_rows, gt, ngt); }
__global__ void k_moe_init(int* CNT, int* LIST, int nslots) { GT_DECL if (gt < N_EXP) CNT[gt] = 0; for (long i = gt; i < nslots; i += ngt) LIST[i] = -1; }
__global__ void k_moe_route(const float* H, const float* Wr, int* CNT, int* TE, float* TP, int* TS, long n_rows) { GW_DECL moe_route_phase(H, Wr, CNT, TE, TP, TS, n_rows, gw, ngw, lane); }
__global__ void k_moe_scatter(const int* CNT, const int* TE, const float* TP, const int* TS, int* LIST, float* SP, int* GS, long n_rows) { GT_DECL moe_scatter_phase(CNT, TE, TP, TS, LIST, SP, GS, n_rows, gt, ngt); }

struct Inputs {
    const float *x; const int* pos; const float *ln_in_g, *ln_in_b, *w_in, *conv_w, *conv_b, *dt_bias, *a_log, *d_skip, *ssd_norm_g, *att_norm_g, *gm_ln_g, *gm_ln_b, *gm_w_s, *gm_b_s, *gm_norm_g, *w_out,
        *ln1_g, *ln1_b, *ln2_g, *ln2_b, *ffn_w_gate, *ffn_w_up, *ffn_w_down, *router_w, *moe_w_gate, *moe_w_up, *moe_w_down;
};

static void run_simple(const Inputs& I, int nb, unsigned char* ws, float* aux  , float* OUT, hipStream_t st, float* ckpt = nullptr) {
    const long M = (long)nb * SEQ; const size_t MB = 1u << 20;
    const size_t hsz = (size_t)M * DM * 4;
    float* H = (float*)ws; float* MIX = (float*)(ws + hsz); float* Y = (float*)(ws + 2 * hsz); unsigned char* BIG = ws + 3 * hsz + (size_t)N_EXP * 256 * DM * 4;
    float* XC = Y;
    float* VN = aux;
    float* PROJ = (float*)BIG;
    size_t big_bytes = (size_t)M * D_IN * 4; { size_t a = (size_t)M * D_FF * 4; if (a > big_bytes) big_bytes = a; size_t c = (size_t)(2 * M + N_EXP * 256) * D_FFE * 2; if (c > big_bytes) big_bytes = c; }
    big_bytes = (big_bytes + 255) & ~(size_t)255;
    unsigned char* SM = BIG + big_bytes;
    float* KM = (float*)SM; SM += (size_t)nb * ATT_H * NBLK * 64 * 4;
    float* DT = (float*)SM; SM += (size_t)M * SSD_H * 4;
    int* CNT = (int*)SM; SM += 256;
    int* TE = (int*)SM; SM += (size_t)M * 2 * 4; float* TP = (float*)SM; SM += (size_t)M * 2 * 4; int* TS = (int*)SM; SM += (size_t)M * 2 * 4; int* GS = (int*)SM; SM += (size_t)M * 2 * 4;
    const int nslots = (int)(2 * M + N_EXP * 256);
    int* LIST = (int*)SM; SM += (size_t)nslots * 4; float* SP = (float*)SM; SM += (size_t)nslots * 4;
    (void)MB;
    const ProjL L{D_IN, 0, 384, 768, 1152, 1536, 2432, 2438, 2694};
    const int TB = 256; const int GWB = 2048;
    k_ln_in<<<GWB, TB, 0, st>>>(I.x, I.ln_in_g, I.ln_in_b, H, M);
    for (int i = 0; i < 2; ++i) {
        sgemm_k<float, 0><<<dim3((D_IN + 63) / 64, (unsigned)(M / 64), 1), 256, 0, st>>>(H, DM, nullptr, I.w_in + (size_t)i * DM * D_IN, nullptr, D_IN, 0, PROJ, D_IN, (int)M, D_IN, DM, nullptr, nullptr);
        k_rope<<<GWB, TB, 0, st>>>(PROJ, L, I.pos, M);
        const size_t ck_stride = (size_t)M * (D_IN + 3 * DM); float* ck = ckpt ? ckpt + (size_t)i * ck_stride : nullptr;
        if (ck) hipMemcpyAsync(ck, PROJ, (size_t)M * D_IN * 4, hipMemcpyDeviceToDevice, st);
        k_kmean<<<96 * nb, TB, 0, st>>>(PROJ, L, KM, nb);
        k_attn<<<GWB * 2, TB, 0, st>>>(PROJ, L, KM, MIX, DM, nb);
        k_rms384<<<GWB, TB, 0, st>>>(MIX, DM, I.att_norm_g + i * ATT_W, MIX, DM, M);
        k_ssd_conv<<<GWB * 2, TB, 0, st>>>(PROJ, L, I.conv_w + (size_t)i * 4 * SSD_CW, I.conv_b + i * SSD_CW, I.dt_bias + i * SSD_H, XC, DT, M);
        k_ssd_scan<<<(nb * SSD_H * 64 * 64 + TB - 1) / TB, TB, 0, st>>>(XC, DT, I.a_log + i * SSD_H, I.d_skip + i * SSD_H, MIX + ATT_W, DM, nb);
        k_ssd_gate<<<GWB, TB, 0, st>>>(MIX + ATT_W, DM, PROJ, L, I.ssd_norm_g + i * SSD_W, MIX + ATT_W, DM, M);
        k_gm_ln<<<GWB, TB, 0, st>>>(PROJ, L, I.gm_ln_g + i * GM_W, I.gm_ln_b + i * GM_W, VN, M);
        k_gm_mix<<<GWB * 2, TB, 0, st>>>(PROJ, L, VN, I.gm_w_s + (size_t)i * GM_G * GM_CHUNK * GM_CHUNK, I.gm_b_s + i * GM_G * GM_CHUNK, MIX + ATT_W + SSD_W, DM, M);
        k_rms256<<<GWB, TB, 0, st>>>(MIX + ATT_W + SSD_W, DM, I.gm_norm_g + i * GM_W, MIX + ATT_W + SSD_W, DM, M);
        if (ck) hipMemcpyAsync(ck + (size_t)M * D_IN, MIX, hsz, hipMemcpyDeviceToDevice, st);
        sgemm_k<float, 0><<<dim3(DM / 64, (unsigned)(M / 64), 1), 256, 0, st>>>(MIX, DM, nullptr, I.w_out + (size_t)i * DM * DM, nullptr, DM, 0, Y, DM, (int)M, DM, DM, nullptr, nullptr);
        k_ln_res<<<GWB, TB, 0, st>>>(H, Y, I.ln1_g + i * DM, I.ln1_b + i * DM, H, M);
        if (ck) hipMemcpyAsync(ck + (size_t)M * (D_IN + DM), H, hsz, hipMemcpyDeviceToDevice, st);
        if (i == 0) {
            float* ACT = (float*)BIG;
            sgemm_k<float, 1><<<dim3(D_FF / 64, (unsigned)(M / 64), 1), 256, 0, st>>>(H, DM, nullptr, I.ffn_w_gate, I.ffn_w_up, D_FF, 0, ACT, D_FF, (int)M, D_FF, DM, nullptr, nullptr);
            sgemm_k<float, 0><<<dim3(DM / 64, (unsigned)(M / 64), 1), 256, 0, st>>>(ACT, D_FF, nullptr, I.ffn_w_down, nullptr, DM, 0, Y, DM, (int)M, DM, D_FF, nullptr, nullptr);
            k_ln_res<<<GWB, TB, 0, st>>>(H, Y, I.ln2_g + i * DM, I.ln2_b + i * DM, H, M);
            if (ck) hipMemcpyAsync(ck + (size_t)M * (D_IN + 2 * DM), H, hsz, hipMemcpyDeviceToDevice, st);
        } else {
            bf16* ACTM = (bf16*)BIG; float* F2 = MIX;
            k_moe_init<<<256, TB, 0, st>>>(CNT, LIST, nslots);
            k_moe_route<<<GWB, TB, 0, st>>>(H, I.router_w, CNT, TE, TP, TS, M);
            k_moe_scatter<<<256, TB, 0, st>>>(CNT, TE, TP, TS, LIST, SP, GS, M);
            sgemm_k<float, 2><<<dim3(D_FFE / 64, (unsigned)(M / 64), N_EXP), 256, 0, st>>>(H, DM, LIST, I.moe_w_gate, I.moe_w_up, D_FFE, (long)DM * D_FFE, ACTM, D_FFE, 0, D_FFE, DM, CNT, nullptr);
            sgemm_k<bf16, 3><<<dim3(DM / 64, (unsigned)(M / 64), N_EXP), 256, 0, st>>>(ACTM, D_FFE, nullptr, I.moe_w_down, nullptr, DM, (long)D_FFE * DM, F2, DM, 0, DM, D_FFE, CNT, SP);
            k_ln_moe<<<GWB, TB, 0, st>>>(H, F2, GS, I.ln2_g + i * DM, I.ln2_b + i * DM, OUT, M);
            if (ck) hipMemcpyAsync(ck + (size_t)M * (D_IN + 2 * DM), OUT, hsz, hipMemcpyDeviceToDevice, st);
        }
    }
}

#define LAS __attribute__((address_space(3)))
namespace pg8 {
#define PG8_LAS __attribute__((address_space(3)))
typedef unsigned short bf16_t;
typedef short bf16x8 __attribute__((ext_vector_type(8)));
typedef float f32x4 __attribute__((ext_vector_type(4)));
typedef unsigned u32x4 __attribute__((ext_vector_type(4)));
constexpr int BM = 256, BK = 64, HALF = 128, HTB = HALF * BK * 2  , STAGE_BYTES = 8 * HTB, NXCD = 8, WGM = 8;

__host__ __device__ __forceinline__ int lds_byte(int r, int c) { const int st = (r >> 4) * 2 + (c >> 5), rr = r & 15, cc = c & 31, ob = rr * 64 + cc * 2; return st * 1024 + (ob ^ (((ob >> 9) & 1) << 5)); }
__host__ __device__ __forceinline__ void stage_rc(int b, int& R, int& C) { const int st = b / 1024, sb = b % 1024, swz = sb ^ (((sb >> 9) & 1) << 5); R = (st >> 1) * 16 + swz / 64; C = (st & 1) * 32 + (swz % 64) / 2; }
__host__ __device__ __forceinline__ int perm32(int rho) { const int n = rho >> 4, i = rho & 15; return 8 * (i >> 2) + 4 * n + (i & 3); }

struct Unit { int pm, pn, kofs; };
struct Gemm { const bf16_t* A; const bf16_t* Bt; int M, N, K, ld; };

struct StaticOrder {
    int nM, nN, nwg, G, c;
    __host__ __device__ void init(int M, int N, int G_, int c_) { nM = M / BM; nN = N / BM; nwg = nM * nN; G = G_; c = c_; }
    __host__ __device__ bool next(int i, Unit& u) const {
        const long L = (long)i * G + c; if (L >= nwg) return false;
        int wgid = (int)L; { const int q = nwg / NXCD, r = nwg % NXCD, xcd = wgid % NXCD, off = wgid / NXCD; wgid = (xcd < r ? xcd * (q + 1) : r * (q + 1) + (xcd - r) * q) + off; }
        const int nig = WGM * nN, gid = wgid / nig, fm = gid * WGM, gsz = (nM - fm) < WGM ? (nM - fm) : WGM;
        u.pm = fm + ((wgid % nig) % gsz); u.pn = (wgid % nig) / gsz; u.kofs = 0; return true;
    }
    __device__ __forceinline__ void a_ready(const Unit&) const {}
    __device__ __forceinline__ void done(const Unit&) const {}
};
__device__ __forceinline__ unsigned cvt_pk_bf16(float lo, float hi) { unsigned r; asm volatile("v_cvt_pk_bf16_f32 %0, %1, %2" : "=v"(r) : "v"(lo), "v"(hi)); return r; }
typedef float f32x2 __attribute__((ext_vector_type(2)));
typedef int i32x4_ __attribute__((ext_vector_type(4)));
typedef int i32x8_ __attribute__((ext_vector_type(8)));
__device__ __forceinline__ i32x8_ cat8(bf16x8 lo, bf16x8 hi) { const i32x4_ l = (i32x4_)lo, h = (i32x4_)hi; return __builtin_shufflevector(l, h, 0, 1, 2, 3, 4, 5, 6, 7); }
template <class Epi, class Sched, bool ALIGN_EPI = false, bool SP2 = false, bool FP8 = false>
__device__ __forceinline__ void gemm_phase(PG8_LAS unsigned char* lds, const Gemm g, const Sched& S, const Epi& E, const int tid) {
    const int wid = __builtin_amdgcn_readfirstlane(tid >> 6), lane = tid & 63, wr = wid >> 2, wc = wid & 3, fr = lane & 15, fq = lane >> 4;
    const int K = g.ld; int nt = g.K / BK;
    if constexpr (FP8) asm volatile("" : "+s"(nt));
    unsigned voffA[2], voffB[2];
#pragma unroll
    for (int i = 0; i < 2; ++i) { int R, C; stage_rc(tid * 16 + i * 8192, R, C); const int Rb = Epi::PERM ? ((R & ~31) + perm32(R & 31)) : R;
        voffA[i] = (unsigned)(R * K + C) * 2u; voffB[i] = (unsigned)(Rb * K + C) * 2u; }
    const size_t kstep = (size_t)(BK * 2);
    const size_t hstep = (size_t)HALF * K * 2;
    const size_t tstep = 2 * hstep;
    const unsigned ldsw = (unsigned)wid * 1024u;
    const int aoff = lds_byte(wr * 64 + fr, fq * 8), boff = lds_byte(wc * 32 + fr, fq * 8);
#define PG8_SA(b, h) (((b) * 2 + (h)) * HTB)
#define PG8_SB(b, h) ((4 + (b) * 2 + (h)) * HTB)
#define PG8_STAGE(bufoff, gbase, voff) do { const char* sb_ = (const char*)(gbase); asm volatile("" : "+s"(sb_));   \
        _Pragma("unroll") for (int _i = 0; _i < 2; ++_i) { unsigned vo_ = (voff)[_i]; asm volatile("" : "+v"(vo_));   \
        __builtin_amdgcn_global_load_lds((const unsigned*)(sb_ + vo_), (PG8_LAS unsigned*)(lds + (bufoff) + ldsw + _i * 8192), 16, 0, 0); } } while (0)
#define PG8_LDA(dst, b, h) do { _Pragma("unroll") for (int m = 0; m < 4; ++m) _Pragma("unroll") for (int k = 0; k < 2; ++k) dst[m][k] = *(const PG8_LAS bf16x8*)(lds + PG8_SA(b, h) + aoff + m * 2048 + k * 1024); } while (0)
#define PG8_LDB(dst, b, h) do { _Pragma("unroll") for (int n = 0; n < 2; ++n) _Pragma("unroll") for (int k = 0; k < 2; ++k) dst[n][k] = *(const PG8_LAS bf16x8*)(lds + PG8_SB(b, h) + boff + n * 2048 + k * 1024); } while (0)
#define PG8_MMA(ai, bj, At, Bt) do { __builtin_amdgcn_s_setprio(1); _Pragma("unroll") for (int m = 0; m < 4; ++m) _Pragma("unroll") for (int n = 0; n < 2; ++n) { \
        if constexpr (FP8) acc[ai][bj][m][n] = __builtin_amdgcn_mfma_scale_f32_16x16x128_f8f6f4(cat8(Bt[n][0], Bt[n][1]), cat8(At[m][0], At[m][1]), acc[ai][bj][m][n], 0, 0, 0, 0, 0, 0); \
        else { _Pragma("unroll") for (int k = 0; k < 2; ++k) acc[ai][bj][m][n] = __builtin_amdgcn_mfma_f32_16x16x32_bf16(Bt[n][k], At[m][k], acc[ai][bj][m][n], 0, 0, 0); } } __builtin_amdgcn_s_setprio(0); } while (0)
#define PG8_WAIT_V(n) asm volatile("s_waitcnt vmcnt(" #n ")" ::: "memory")
#define PG8_WAIT_L(n) asm volatile("s_waitcnt lgkmcnt(" #n ")" ::: "memory")
#define PG8_BAR __builtin_amdgcn_s_barrier()
#define PG8_SCHED __builtin_amdgcn_sched_barrier(0)
    Unit cur, nxt; int ui = 0;
    if (!S.next(0, cur)) return;
    f32x4 acc[2][2][4][2];
#pragma unroll
    for (int a = 0; a < 2; ++a)
#pragma unroll
        for (int b = 0; b < 2; ++b)
#pragma unroll
            for (int m = 0; m < 4; ++m)
#pragma unroll
                for (int n = 0; n < 2; ++n) acc[a][b][m][n] = (f32x4){0.f, 0.f, 0.f, 0.f};
    bf16x8 At[4][2], B0[2][2], B1[2][2];
    const char* cA = (const char*)g.A + (size_t)cur.pm * tstep + (size_t)cur.kofs * 2; const char* cB = (const char*)g.Bt + (size_t)cur.pn * tstep + (size_t)cur.kofs * 2;
    S.a_ready(cur);
    if constexpr (SP2) {
        PG8_STAGE(PG8_SB(0, 0), cB, voffB); PG8_STAGE(PG8_SB(0, 1), cB + hstep, voffB); PG8_STAGE(PG8_SA(0, 0), cA, voffA); PG8_STAGE(PG8_SA(0, 1), cA + hstep, voffA);
        if (wr == 1) PG8_BAR;
        PG8_WAIT_V(2); PG8_BAR;
        PG8_STAGE(PG8_SB(1, 0), cB + kstep, voffB); PG8_STAGE(PG8_SA(1, 0), cA + kstep, voffA); PG8_STAGE(PG8_SB(1, 1), cB + hstep + kstep, voffB);
        PG8_WAIT_V(6); PG8_BAR;
    } else {
        PG8_STAGE(PG8_SB(0, 0), cB, voffB); PG8_STAGE(PG8_SA(0, 0), cA, voffA); PG8_STAGE(PG8_SB(0, 1), cB + hstep, voffB); PG8_STAGE(PG8_SA(0, 1), cA + hstep, voffA);
        if (wr == 1) PG8_BAR;
        PG8_WAIT_V(4); PG8_BAR;
        PG8_STAGE(PG8_SB(1, 0), cB + kstep, voffB); PG8_STAGE(PG8_SA(1, 0), cA + kstep, voffA); PG8_STAGE(PG8_SB(1, 1), cB + hstep + kstep, voffB);
        PG8_WAIT_V(6); PG8_BAR;
    }
    for (;;) {
        const bool has_next = S.next(ui + 1, nxt);
        const char* nA = has_next ? (const char*)g.A + (size_t)nxt.pm * tstep + (size_t)nxt.kofs * 2 : cA; const char* nB = has_next ? (const char*)g.Bt + (size_t)nxt.pn * tstep + (size_t)nxt.kofs * 2 : cB;
        for (int t = 0; t < nt; t += 2) {
            const bool last = (t == nt - 2);
            const char* a1 = cA + (size_t)(t + 1) * kstep;
            const char* a2 = last ? nA : cA + (size_t)(t + 2) * kstep; const char* b2 = last ? nB : cB + (size_t)(t + 2) * kstep;
            const char* a3 = a2 + kstep; const char* b3 = b2 + kstep;
            if (last && has_next) S.a_ready(nxt);
            if constexpr (SP2) {
            PG8_LDB(B0, 0, 0); PG8_LDB(B1, 0, 1); PG8_SCHED; PG8_LDA(At, 0, 0); PG8_STAGE(PG8_SA(1, 1), a1 + hstep, voffA);
            PG8_WAIT_V(8); PG8_WAIT_L(0); PG8_BAR; PG8_MMA(0, 0, At, B0); PG8_MMA(0, 1, At, B1); PG8_BAR; PG8_SCHED;
            PG8_LDA(At, 0, 1); PG8_STAGE(PG8_SB(0, 0), b2, voffB); PG8_STAGE(PG8_SB(0, 1), b2 + hstep, voffB); PG8_STAGE(PG8_SA(0, 0), a2, voffA);
            PG8_WAIT_V(8); PG8_WAIT_L(0); PG8_BAR; PG8_MMA(1, 0, At, B0); PG8_MMA(1, 1, At, B1); PG8_BAR; PG8_SCHED;
            PG8_LDB(B0, 1, 0); PG8_LDB(B1, 1, 1); PG8_SCHED; PG8_LDA(At, 1, 0); PG8_STAGE(PG8_SA(0, 1), a2 + hstep, voffA);
            PG8_WAIT_V(8); PG8_WAIT_L(0); PG8_BAR; PG8_MMA(0, 0, At, B0); PG8_MMA(0, 1, At, B1); PG8_BAR; PG8_SCHED;
            PG8_LDA(At, 1, 1); PG8_STAGE(PG8_SB(1, 0), b3, voffB); PG8_STAGE(PG8_SB(1, 1), b3 + hstep, voffB); PG8_STAGE(PG8_SA(1, 0), a3, voffA);
            PG8_WAIT_V(8); PG8_WAIT_L(0); PG8_BAR; PG8_MMA(1, 0, At, B0); PG8_MMA(1, 1, At, B1); PG8_BAR; PG8_SCHED;
            } else {
            PG8_LDB(B0, 0, 0); PG8_SCHED; PG8_LDA(At, 0, 0); PG8_STAGE(PG8_SA(1, 1), a1 + hstep, voffA);
            PG8_WAIT_L(8); PG8_BAR; PG8_WAIT_L(0); PG8_MMA(0, 0, At, B0); PG8_BAR; PG8_SCHED;
            PG8_LDB(B1, 0, 1); PG8_STAGE(PG8_SB(0, 0), b2, voffB);
            PG8_BAR; PG8_WAIT_L(0); PG8_MMA(0, 1, At, B1); PG8_BAR;
            PG8_LDA(At, 0, 1); PG8_STAGE(PG8_SA(0, 0), a2, voffA);
            PG8_BAR; PG8_WAIT_L(0); PG8_MMA(1, 0, At, B0); PG8_BAR; PG8_SCHED;
            PG8_STAGE(PG8_SB(0, 1), b2 + hstep, voffB);
            PG8_WAIT_V(6); PG8_BAR; PG8_MMA(1, 1, At, B1); PG8_BAR;
            PG8_LDB(B0, 1, 0); PG8_SCHED; PG8_LDA(At, 1, 0); PG8_STAGE(PG8_SA(0, 1), a2 + hstep, voffA);
            PG8_WAIT_L(8); PG8_BAR; PG8_WAIT_L(0); PG8_MMA(0, 0, At, B0); PG8_BAR; PG8_SCHED;
            PG8_LDB(B1, 1, 1); PG8_STAGE(PG8_SB(1, 0), b3, voffB);
            PG8_BAR; PG8_WAIT_L(0); PG8_MMA(0, 1, At, B1); PG8_BAR;
            PG8_LDA(At, 1, 1); PG8_STAGE(PG8_SA(1, 0), a3, voffA);
            PG8_BAR; PG8_WAIT_L(0); PG8_MMA(1, 0, At, B0); PG8_BAR; PG8_SCHED;
            PG8_STAGE(PG8_SB(1, 1), b3 + hstep, voffB);
            PG8_WAIT_V(6); PG8_BAR; PG8_MMA(1, 1, At, B1); PG8_BAR;
            }
        }
        if constexpr (ALIGN_EPI) { if (wr == 0) PG8_BAR; }
        if constexpr (!Epi::AFTER_DRAIN) { E(acc, cur, wr, wc, fr, fq); S.done(cur); }
        if (!has_next) break;
#pragma unroll
        for (int a = 0; a < 2; ++a)
#pragma unroll
            for (int b = 0; b < 2; ++b)
#pragma unroll
                for (int m = 0; m < 4; ++m)
#pragma unroll
                    for (int n = 0; n < 2; ++n) acc[a][b][m][n] = (f32x4){0.f, 0.f, 0.f, 0.f};
        cur = nxt; cA = nA; cB = nB; ++ui;
        if constexpr (ALIGN_EPI) { if (wr == 1) PG8_BAR; }
    }
    PG8_WAIT_V(0);
    if constexpr (!ALIGN_EPI) { if (wr == 0) PG8_BAR; }
    PG8_BAR;
    if constexpr (Epi::AFTER_DRAIN) { E.fused(acc, cur, wr, wc, fr, fq, lds, wid, lane); S.done(cur); }
#undef PG8_SA
#undef PG8_SB
#undef PG8_STAGE
#undef PG8_LDA
#undef PG8_LDB
#undef PG8_MMA
#undef PG8_WAIT_V
#undef PG8_WAIT_L
#undef PG8_BAR
#undef PG8_SCHED
}
}
#define XB_TMO      128
#define XB_XCNT(j)  (256  + 64 * (j))
#define XB_XSUB(j)  (1280 + 64 * (j))
#define XB_XGEN(j)  (2304 + 64 * (j))
#define XB_TOP      3328
#define XB_TOPGEN   3392
#define XCD_BAR_WORDS 3456
#define XB_SPIN_CAP (1u << 24)

__device__ __forceinline__ unsigned xb_ld(unsigned* p)              { return __hip_atomic_load(p, __ATOMIC_RELAXED, __HIP_MEMORY_SCOPE_AGENT); }
__device__ __forceinline__ unsigned xb_add(unsigned* p, unsigned v) { return __hip_atomic_fetch_add(p, v, __ATOMIC_RELAXED, __HIP_MEMORY_SCOPE_AGENT); }
__device__ __forceinline__ unsigned xb_xcc_id() { return (unsigned)__builtin_amdgcn_s_getreg((3 << 11) | 20) & 0xFu; }
#define XB_SPIN(cond, bar) do { unsigned _sp = 0; while (cond) { __builtin_amdgcn_s_sleep(1); \
    if ((++_sp & 255u) == 0u) { if (xb_ld(&(bar)[XB_TMO])) break; if (_sp > XB_SPIN_CAP) { atomicAdd(&(bar)[XB_TMO], 1u); break; } } } } while (0)

__device__ __forceinline__ unsigned xb_lane_fresh() { unsigned l; asm volatile("v_mbcnt_lo_u32_b32 %0, -1, 0\n\tv_mbcnt_hi_u32_b32 %0, -1, %0" : "=v"(l)); return l; }
struct XcdBarrier {
    unsigned* bar; unsigned x; int w0;
    volatile LAS unsigned* st;
};

__device__ __forceinline__ XcdBarrier xcd_barrier_post(unsigned* bar, volatile LAS unsigned* st) {
    XcdBarrier b; b.bar = bar; b.x = xb_xcc_id(); b.st = st; b.w0 = (__builtin_amdgcn_readfirstlane((int)threadIdx.x >> 6) == 0);
    if (threadIdx.x == 0) (void)xb_add(&bar[XB_XCNT(b.x)], 1u);
    return b;
}
__device__ __forceinline__ void xcd_barrier_complete(unsigned* bar, unsigned x, unsigned& nloc, unsigned& nx) {
    const unsigned G = gridDim.x * gridDim.y * gridDim.z;
    unsigned sum, cnt, mine, sp = 0u;
    for (;;) {
        sum = 0u; cnt = 0u; mine = 0u;
#pragma unroll
        for (unsigned j = 0; j < 16; ++j) { const unsigned c = xb_ld(&bar[XB_XCNT(j)]); sum += c; cnt += (c > 0u) ? 1u : 0u; mine = (j == x) ? c : mine; }
        if (sum == G) break;
        __builtin_amdgcn_s_sleep(1);
        if ((++sp & 255u) == 0u) { if (xb_ld(&bar[XB_TMO])) break; if (sp > XB_SPIN_CAP) { atomicAdd(&bar[XB_TMO], 1u); break; } }
    }
    nloc = mine > 0u ? mine : 1u; nx = cnt > 0u ? cnt : 1u;
}

__device__ __forceinline__ void xcd_barrier(const XcdBarrier& b) {
    asm volatile("s_waitcnt vmcnt(0)" ::: "memory");
    __syncthreads();
    if (b.w0 && xb_lane_fresh() == 0u) {
        unsigned* bar = b.bar;
        __builtin_amdgcn_s_waitcnt(0);
        unsigned nloc = b.st[0], nx = b.st[1];
        if (nloc == 0u) { xcd_barrier_complete(bar, b.x, nloc, nx); b.st[0] = nloc; b.st[1] = nx; }
        const unsigned old = xb_add(&bar[XB_XSUB(b.x)], 1u);
        const unsigned gen = old / nloc;
        if (old + 1u == (gen + 1u) * nloc) {
            __builtin_amdgcn_fence(__ATOMIC_RELEASE, "agent");
            asm volatile("s_waitcnt vmcnt(0)" ::: "memory");
            const unsigned og = xb_add(&bar[XB_TOP], 1u);
            const unsigned tg = og / nx;
            if (og + 1u == (tg + 1u) * nx) xb_add(&bar[XB_TOPGEN], 1u);
            else XB_SPIN(xb_ld(&bar[XB_TOPGEN]) == tg, bar);
            __builtin_amdgcn_fence(__ATOMIC_ACQUIRE, "agent");
            xb_add(&bar[XB_XGEN(b.x)], 1u);
            asm volatile("s_waitcnt vmcnt(0)" ::: "memory");
        } else {
            XB_SPIN(xb_ld(&bar[XB_XGEN(b.x)]) == gen, bar);
            __builtin_amdgcn_fence(__ATOMIC_ACQUIRE, "agent");
            asm volatile("s_waitcnt vmcnt(0)" ::: "memory");
        }
    }
    __syncthreads();
}
#include <hip/hip_bf16.h>
#include <cmath>
namespace attn_body {
using bf16=__hip_bfloat16;
using bf16x8=__attribute__((ext_vector_type(8)))short;
using s16x4=__attribute__((ext_vector_type(4)))short;
using f32x16=__attribute__((ext_vector_type(16)))float;
using u32x4=__attribute__((ext_vector_type(4)))unsigned;
constexpr int NHEAD=6,SEQ=2048,D=64,QP=3072,OP=1024;
constexpr int NW=8,QBLK=32,QB=QBLK*NW,KVBLK=64,NQB=SEQ/QB;
constexpr int ATTN_UNIT_ROWS=QB;
__device__ __forceinline__ int crow(int r,int hi){return (r&3)+8*(r>>2)+4*hi;}
#define SBAR() __builtin_amdgcn_sched_barrier(0)
__device__ __forceinline__ void cmask(f32x16&p0,f32x16&p1,int jb,int qrel,int hi){
  const float NEG=-INFINITY; int kb=64*jb+4*hi;
  #pragma unroll
  for(int r=0;r<16;++r){int kv=kb+(r&3)+8*(r>>2); if(kv>qrel)p0[r]=NEG; if(kv+32>qrel)p1[r]=NEG;}
}

constexpr int NSLOT=3, SLOTB=8192;
constexpr int LDS_K=0, LDS_V=NSLOT*SLOTB, LDS_WS=2*NSLOT*SLOTB, LDS_OST=LDS_WS+NW*64*4, LDS_BYTES=LDS_OST+NW*4096;
constexpr float C2=0.125f*1.4426950408889634f;
__device__ __forceinline__ void glds16(const void*gsrc,unsigned lds_dst){unsigned keep;
  asm volatile("s_mov_b32 %0, m0\n\ts_mov_b32 m0, %2\n\ts_nop 0\n\tglobal_load_lds_dwordx4 %1, off\n\ts_mov_b32 m0, %0":"=&s"(keep):"v"(gsrc),"s"(lds_dst):"memory");}
__device__ __forceinline__ float max3f(float a,float b,float c){float r;asm("v_max3_f32 %0, %1, %2, %3":"=v"(r):"v"(a),"v"(b),"v"(c));return r;}
__device__ __forceinline__ float max2f(float a,float b){float r;asm("v_max_f32_e32 %0, %1, %2":"=v"(r):"v"(a),"v"(b));return r;}
__device__ __forceinline__ float fadd_s(float a,float b){float r;asm("v_add_f32_e32 %0, %1, %2":"=v"(r):"v"(a),"v"(b));return r;}
__device__ __forceinline__ float fsub_s(float a,float b){float r;asm("v_sub_f32_e32 %0, %1, %2":"=v"(r):"v"(a),"v"(b));return r;}
typedef float f32x2_t __attribute__((ext_vector_type(2))); typedef __bf16 bf16x2_t __attribute__((ext_vector_type(2)));
__device__ __forceinline__ unsigned cvtpk_s(float lo,float hi){f32x2_t v={lo,hi};bf16x2_t b=__builtin_convertvector(v,bf16x2_t);return __builtin_bit_cast(unsigned,b);}
#define WAIT_BAR(N) asm volatile("s_waitcnt vmcnt(" #N ") lgkmcnt(0)\n\ts_barrier":::"memory")

__device__ __forceinline__ void qkt(f32x16&p0,f32x16&p1,const char*Kslot,const bf16x8*qr,int r32,int hi){ const f32x16 negm=f32x16{};
  const char*kb=Kslot+hi*1024+r32*16;
  #pragma unroll
  for(int d0=0;d0<4;++d0){
    const bf16x8 b0=*reinterpret_cast<const bf16x8*>(kb+d0*2048);
    const bf16x8 b1=*reinterpret_cast<const bf16x8*>(kb+d0*2048+512);
    if(d0==0){p0=__builtin_amdgcn_mfma_f32_32x32x16_bf16(b0,qr[0],negm,0,0,0);p1=__builtin_amdgcn_mfma_f32_32x32x16_bf16(b1,qr[0],negm,0,0,0);}
    else{p0=__builtin_amdgcn_mfma_f32_32x32x16_bf16(b0,qr[d0],p0,0,0,0);p1=__builtin_amdgcn_mfma_f32_32x32x16_bf16(b1,qr[d0],p1,0,0,0);}}
}
typedef __attribute__((address_space(3))) const char* lds_cptr;
typedef short v4i16_t __attribute__((ext_vector_type(4)));
__device__ __forceinline__ void kload8(bf16x8*kf,lds_cptr kp){
  kf[0]=*(const __attribute__((address_space(3))) bf16x8*)(kp);      kf[1]=*(const __attribute__((address_space(3))) bf16x8*)(kp+512);
  kf[2]=*(const __attribute__((address_space(3))) bf16x8*)(kp+2048); kf[3]=*(const __attribute__((address_space(3))) bf16x8*)(kp+2560);
  kf[4]=*(const __attribute__((address_space(3))) bf16x8*)(kp+4096); kf[5]=*(const __attribute__((address_space(3))) bf16x8*)(kp+4608);
  kf[6]=*(const __attribute__((address_space(3))) bf16x8*)(kp+6144); kf[7]=*(const __attribute__((address_space(3))) bf16x8*)(kp+6656);
}
__device__ __forceinline__ void kload2(bf16x8*kf,lds_cptr kp,int j){ kf[2*j]=*(const __attribute__((address_space(3))) bf16x8*)(kp+j*2048); kf[2*j+1]=*(const __attribute__((address_space(3))) bf16x8*)(kp+j*2048+512); }
__device__ __forceinline__ s16x4 vtr(lds_cptr p){ return __builtin_bit_cast(s16x4,__builtin_amdgcn_ds_read_tr16_b64_v4i16((__attribute__((address_space(3))) v4i16_t*)p)); }
__device__ __forceinline__ float rowmax(const f32x16&p0,const f32x16&p1){
  float a=max3f(p0[0],p0[1],p1[0]),b=max3f(p0[2],p0[3],p1[1]);a=max3f(a,p1[2],p1[3]);
  #pragma unroll
  for(int r=4;r<16;r+=4){a=max3f(a,p0[r],p0[r+1]);b=max3f(b,p0[r+2],p0[r+3]);a=max3f(a,p1[r],p1[r+1]);b=max3f(b,p1[r+2],p1[r+3]);}
  const float m=max2f(a,b);
  auto rr=__builtin_amdgcn_permlane32_swap(__float_as_uint(m),__float_as_uint(m),false,false);
  return max2f(__uint_as_float(rr[0]),__uint_as_float(rr[1]));
}
__device__ __forceinline__ void pv(f32x16*o,int vb,bf16x8 pa0,bf16x8 pa1,bf16x8 pa2,bf16x8 pa3){
  #pragma unroll
  for(int d0=0;d0<2;++d0){s16x4 lo[4],hi[4];
    #pragma unroll
    for(int ks=0;ks<4;++ks){
      asm volatile("ds_read_b64_tr_b16 %0,%1 offset:%c2":"=&v"(lo[ks]):"v"(vb),"i"(d0*4096+ks*1024):"memory");
      asm volatile("ds_read_b64_tr_b16 %0,%1 offset:%c2":"=&v"(hi[ks]):"v"(vb),"i"(d0*4096+ks*1024+512):"memory");}
    asm volatile("s_waitcnt lgkmcnt(0)":::"memory");SBAR();
    #define PK(k) (bf16x8){lo[k][0],lo[k][1],lo[k][2],lo[k][3],hi[k][0],hi[k][1],hi[k][2],hi[k][3]}
    o[d0]=__builtin_amdgcn_mfma_f32_32x32x16_bf16(pa0,PK(0),o[d0],0,0,0);
    o[d0]=__builtin_amdgcn_mfma_f32_32x32x16_bf16(pa1,PK(1),o[d0],0,0,0);
    o[d0]=__builtin_amdgcn_mfma_f32_32x32x16_bf16(pa2,PK(2),o[d0],0,0,0);
    o[d0]=__builtin_amdgcn_mfma_f32_32x32x16_bf16(pa3,PK(3),o[d0],0,0,0);
    #undef PK
  }
}

#ifndef ATTN_STORE16
#define ATTN_STORE16(p,v) (*(u32x4*)(p)=(v))
#endif
template<int THRL> __device__ __forceinline__ void attn_unit(int b,int h,int qb,const bf16*Q,const bf16*__restrict__ K,const bf16*__restrict__ V,bf16*O,const float*__restrict__ KM,int KMH,char*shm,const int tid){
  const int lane=tid&63,r32=lane&31,hi=lane>>5; const int wid=__builtin_amdgcn_readfirstlane(tid>>6);
  const long rowbase=(long)b*SEQ; const int q0=qb*QB;
  const bf16*Qw=Q+(rowbase+q0+wid*QBLK)*QP+h*D;
  const bf16*Kh=K+rowbase*QP+h*D,*Vh=V+rowbase*QP+h*D;
  const unsigned lds0=(unsigned)(uintptr_t)shm;
  float*wsf=(float*)(shm+LDS_WS)+wid*64;
  const bf16*ksrc=Kh+(long)lane*QP+wid*8;
  const bf16*vsrc=Vh+(long)(16*(wid&3)+(lane>>2))*QP+(wid>>2)*32+(lane&3)*8;
  const unsigned kdst=lds0+LDS_K+wid*1024, vdst=lds0+LDS_V+wid*1024;
  #define TI(t) (((t)<4)?(NT-4+(t)):((t)-4))
  #define DMA_K(t,slot) glds16(ksrc+(long)TI(t)*KVBLK*QP,(unsigned)__builtin_amdgcn_readfirstlane(kdst+(slot)))
  #define DMA_V(t,slot) glds16(vsrc+(long)TI(t)*KVBLK*QP,(unsigned)__builtin_amdgcn_readfirstlane(vdst+(slot)))
  const char*Kbase=shm+LDS_K; bf16x8 kf[8];
  const lds_cptr shm3=(lds_cptr)shm; const lds_cptr kp0=shm3+LDS_K+hi*1024+r32*16; const lds_cptr vp0=shm3+LDS_V+((lane>>4)&1)*32+(lane&3)*8+(4*hi+((lane&15)>>2))*64;
  const int NT=(q0+QB)/KVBLK;
  DMA_K(0,0);DMA_V(0,0);DMA_K(1,SLOTB);
  bf16x8 qr[4];
  #pragma unroll
  for(int d0=0;d0<4;++d0)qr[d0]=*reinterpret_cast<const bf16x8*>(&Qw[(long)r32*QP+d0*16+hi*8]);

  unsigned sel=0u;
  if(qb>0){ float gt_[8];
    #pragma unroll
    for(int n=0;n<8;++n){ float a_=0.f;
      if(n<qb){ const float*km=KM+((long)(b*NHEAD+h)*8+n)*64+hi*8;
        #pragma unroll
        for(int d0=0;d0<4;++d0){ float4 k0=*reinterpret_cast<const float4*>(km+d0*16), k1=*reinterpret_cast<const float4*>(km+d0*16+4);
          { const float4 k2=*reinterpret_cast<const float4*>(km+KMH+d0*16), k3=*reinterpret_cast<const float4*>(km+KMH+d0*16+4); k0.x+=k2.x;k0.y+=k2.y;k0.z+=k2.z;k0.w+=k2.w;k1.x+=k3.x;k1.y+=k3.y;k1.z+=k3.z;k1.w+=k3.w; }
          const bf16x8 qv=qr[d0];
          a_+=__uint_as_float(((unsigned)(unsigned short)qv[0])<<16)*k0.x+__uint_as_float(((unsigned)(unsigned short)qv[1])<<16)*k0.y+__uint_as_float(((unsigned)(unsigned short)qv[2])<<16)*k0.z+__uint_as_float(((unsigned)(unsigned short)qv[3])<<16)*k0.w
             +__uint_as_float(((unsigned)(unsigned short)qv[4])<<16)*k1.x+__uint_as_float(((unsigned)(unsigned short)qv[5])<<16)*k1.y+__uint_as_float(((unsigned)(unsigned short)qv[6])<<16)*k1.z+__uint_as_float(((unsigned)(unsigned short)qv[7])<<16)*k1.w; }
        a_+=__shfl_xor(a_,32); }
      gt_[n]=(n<qb)?a_:-1e30f; }
    #pragma unroll
    for(int r_=0;r_<3;++r_){ float bv=-3.0e38f; int best=-1;
      #pragma unroll
      for(int n=0;n<8;++n) if(!((sel>>n)&1u)&&gt_[n]>bv){bv=gt_[n];best=n;}
      if(best>=0&&bv>-0.5e30f) sel|=1u<<best; } }
  if(hi==0)wsf[32+r32]=__uint_as_float(sel); asm volatile("s_waitcnt lgkmcnt(0)":::"memory");
  float mhat=0.f,l_reg=0.f;f32x16 o[2];o[0]=f32x16{};o[1]=f32x16{};
  const int qrel=wid*QBLK+r32;
  #define CMASK(P0,P1,t) do{ if((t)<4){cmask(P0,P1,(t),qrel,hi);} else if(!((__float_as_uint(wsf[32+r32])>>(((t)-4)>>2))&1u)){ _Pragma("unroll") for(int r_=0;r_<16;++r_){P0[r_]=-INFINITY;P1[r_]=-INFINITY;} } }while(0)
  bool resc=false;
  #define START(P0,P1) do{ const float rm=rowmax(P0,P1); resc=false; \
    { const float dl=rm; mhat=fadd_s(mhat,dl); \
      _Pragma("unroll") for(int r=0;r<16;++r){P0[r]=fsub_s(P0[r],dl);P1[r]=fsub_s(P1[r],dl);} \
      } \
    _Pragma("unroll") for(int r=0;r<16;++r)P0[r]=__builtin_amdgcn_exp2f(P0[r]); }while(0)
  #define RESC() do{ if(resc){ asm volatile("s_waitcnt lgkmcnt(0)":::"memory"); \
      _Pragma("unroll") for(int d_=0;d_<2;++d_) _Pragma("unroll") for(int r=0;r<16;++r)o[d_][r]*=wsf[crow(r,hi)]; } }while(0)
  f32x16 pA0,pA1,pB0,pB1;
  int sl_prev=0,sl_cur=0,sl_next=SLOTB;
  #define ROT() do{sl_prev=sl_cur;sl_cur=sl_next;sl_next=(sl_next==(NSLOT-1)*SLOTB)?0:sl_next+SLOTB;}while(0)
  DMA_K(2,2*SLOTB);
  WAIT_BAR(3);
  qkt(pA0,pA1,Kbase,qr,r32,hi);asm volatile("s_nop 15\n\ts_nop 7":"+v"(pA0),"+v"(pA1));CMASK(pA0,pA1,0);
  START(pA0,pA1);
  _Pragma("unroll") for(int r=0;r<16;++r)pA1[r]=__builtin_amdgcn_exp2f(pA1[r]);
  WAIT_BAR(0);
  DMA_K(3,0);DMA_V(1,SLOTB);
  ROT();
  kload8(kf,kp0+sl_cur);
  WAIT_BAR(2);
  s16x4 vlo[8],vhi[8]; u32x4 pw0,pw1,pw2,pw3;
  #define PKW(P,B) cvtpk_s(P[B],P[B+1])
  #define PAF(k) __builtin_bit_cast(bf16x8,pw##k)
  #define VFR(i) (bf16x8){vlo[i][0],vlo[i][1],vlo[i][2],vlo[i][3],vhi[i][0],vhi[i][1],vhi[i][2],vhi[i][3]}
  #define PIN(x) asm volatile("":"+v"(x))
  #define MX3(a,b,c) __builtin_fmaxf(__builtin_fmaxf((a),(b)),(c))
  #define GAPA(MF,A0,A1,A2,A3,W0,W1,PW) do{ MF; sacc+=A0; sacc+=A1; sacc+=A2; sacc+=A3; PIN(sacc); W0; W1; PIN(PW); SBAR(); }while(0)
  #define EX(v) __builtin_amdgcn_exp2f(v)
  #define GAPB(MF,X,B) do{ MF; X[B]=EX(X[B]); X[B+1]=EX(X[B+1]); X[B+2]=EX(X[B+2]); X[B+3]=EX(X[B+3]); PIN(X); SBAR(); }while(0)
  #define VRD(i) do{ vlo[i]=vtr(vp_+(((i)>>2)*4096+((i)&3)*1024)); vhi[i]=vtr(vp_+(((i)>>2)*4096+((i)&3)*1024+512)); }while(0)
  #define KRD(G,j) do{ if(G){ kload2(kf,kp0+sl_next,j); SBAR(); } }while(0)
  #define STEP(C0,C1,P0,P1,t,GK,GV,GL) do{ SBAR(); \
    const lds_cptr vp_=vp0+sl_prev; \
    VRD(0); SBAR(); float sacc=(P0[0]+P0[1]); \
    GAPA(C0=__builtin_amdgcn_mfma_f32_32x32x16_bf16(kf[0],qr[0],f32x16{},0,0,0), P0[2],P0[3],P0[4],P0[5],     pw0[0]=PKW(P0,0), pw0[1]=PKW(P0,2), pw0); \
    VRD(4); SBAR(); GAPA(C1=__builtin_amdgcn_mfma_f32_32x32x16_bf16(kf[1],qr[0],f32x16{},0,0,0), P0[6],P0[7],P0[8],P0[9],     pw0[2]=PKW(P0,4), pw0[3]=PKW(P0,6), pw0); \
    VRD(1); SBAR(); GAPA(C0=__builtin_amdgcn_mfma_f32_32x32x16_bf16(kf[2],qr[1],C0,0,0,0),   P0[10],P0[11],P0[12],P0[13], pw1[0]=PKW(P0,8), pw1[1]=PKW(P0,10), pw1); \
    VRD(5); SBAR(); GAPA(C1=__builtin_amdgcn_mfma_f32_32x32x16_bf16(kf[3],qr[1],C1,0,0,0),   P0[14],P0[15],P1[0],P1[1],   pw1[2]=PKW(P0,12),pw1[3]=PKW(P0,14), pw1); \
    VRD(2); SBAR(); GAPA(C0=__builtin_amdgcn_mfma_f32_32x32x16_bf16(kf[4],qr[2],C0,0,0,0),   P1[2],P1[3],P1[4],P1[5],     pw2[0]=PKW(P1,0), pw2[1]=PKW(P1,2), pw2); \
    VRD(6); SBAR(); GAPA(C1=__builtin_amdgcn_mfma_f32_32x32x16_bf16(kf[5],qr[2],C1,0,0,0),   P1[6],P1[7],P1[8],P1[9],     pw2[2]=PKW(P1,4), pw2[3]=PKW(P1,6), pw2); \
    VRD(3); SBAR(); GAPA(C0=__builtin_amdgcn_mfma_f32_32x32x16_bf16(kf[6],qr[3],C0,0,0,0),   P1[10],P1[11],P1[12],P1[13], pw3[0]=PKW(P1,8), pw3[1]=PKW(P1,10), pw3); \
    VRD(7); SBAR(); GAPA(C1=__builtin_amdgcn_mfma_f32_32x32x16_bf16(kf[7],qr[3],C1,0,0,0),   P1[14],P1[15],0.f,0.f,       pw3[2]=PKW(P1,12),pw3[3]=PKW(P1,14), pw3); \
    l_reg+=sacc; \
    if(GK){DMA_K((t)+3,sl_cur);} if(GV){DMA_V((t)+1,sl_next);} \
    CMASK(C0,C1,t); \
    _Pragma("unroll") for(int r=0;r<16;++r){C0[r]-=mhat;C1[r]-=mhat;} \
    { float a=MX3(C0[0],C0[1],C1[0]),b=MX3(C0[2],C0[3],C1[1]); a=MX3(a,C1[2],C1[3]); \
      _Pragma("unroll") for(int r=4;r<16;r+=4){a=MX3(a,C0[r],C0[r+1]);b=MX3(b,C0[r+2],C0[r+3]);a=MX3(a,C1[r],C1[r+1]);b=MX3(b,C1[r+2],C1[r+3]);} \
      float rm=__builtin_fmaxf(a,b); { auto rr=__builtin_amdgcn_permlane32_swap(__float_as_uint(rm),__float_as_uint(rm),false,false); rm=__builtin_fmaxf(__uint_as_float(rr[0]),__uint_as_float(rr[1])); } \
      resc=false; \
      if(__builtin_expect(__any(rm>(float)THRL),0)){ const float dl=__builtin_fmaxf(rm,0.f); mhat+=dl; \
        _Pragma("unroll") for(int r=0;r<16;++r){C0[r]-=dl;C1[r]-=dl;} \
        const float f=__builtin_amdgcn_exp2f(-dl); l_reg*=f; if(hi==0)wsf[r32]=f; resc=true; } } \
    SBAR(); \
    GAPB(o[0]=__builtin_amdgcn_mfma_f32_32x32x16_bf16(PAF(0),VFR(0),o[0],0,0,0), C0,0); \
    GAPB(o[1]=__builtin_amdgcn_mfma_f32_32x32x16_bf16(PAF(0),VFR(4),o[1],0,0,0), C0,4); \
    KRD(GL,0); GAPB(o[0]=__builtin_amdgcn_mfma_f32_32x32x16_bf16(PAF(1),VFR(1),o[0],0,0,0), C0,8); \
    KRD(GL,1); GAPB(o[1]=__builtin_amdgcn_mfma_f32_32x32x16_bf16(PAF(1),VFR(5),o[1],0,0,0), C0,12); \
    KRD(GL,2); GAPB(o[0]=__builtin_amdgcn_mfma_f32_32x32x16_bf16(PAF(2),VFR(2),o[0],0,0,0), C1,0); \
    KRD(GL,3); GAPB(o[1]=__builtin_amdgcn_mfma_f32_32x32x16_bf16(PAF(2),VFR(6),o[1],0,0,0), C1,4); \
    GAPB(o[0]=__builtin_amdgcn_mfma_f32_32x32x16_bf16(PAF(3),VFR(3),o[0],0,0,0), C1,8); \
    GAPB(o[1]=__builtin_amdgcn_mfma_f32_32x32x16_bf16(PAF(3),VFR(7),o[1],0,0,0), C1,12); \
    }while(0)
  int t=1;
  for(;t+5<NT;t+=2){
    STEP(pB0,pB1,pA0,pA1,t,true,true,true);     WAIT_BAR(2); RESC(); ROT();
    STEP(pA0,pA1,pB0,pB1,t+1,true,true,true);   WAIT_BAR(2); RESC(); ROT();
  }
  #define ENDW(tt) do{ if((tt)+3<NT){WAIT_BAR(2);} else if((tt)+2<NT){WAIT_BAR(1);} else {WAIT_BAR(0);} }while(0)
  for(;t+1<NT;t+=2){
    STEP(pB0,pB1,pA0,pA1,t,(t+3<NT),(t+1<NT),(t+1<NT));       ENDW(t);   RESC(); ROT();
    STEP(pA0,pA1,pB0,pB1,t+1,(t+4<NT),(t+2<NT),(t+2<NT));     ENDW(t+1); RESC(); ROT();
  }
  STEP(pB0,pB1,pA0,pA1,NT-1,false,false,false); RESC();
  { float sacc=pB0[0]+pB0[1]; _Pragma("unroll") for(int r=2;r<16;++r)sacc+=pB0[r]; _Pragma("unroll") for(int r=0;r<16;++r)sacc+=pB1[r]; l_reg+=sacc;
    pw0=(u32x4){PKW(pB0,0),PKW(pB0,2),PKW(pB0,4),PKW(pB0,6)};pw1=(u32x4){PKW(pB0,8),PKW(pB0,10),PKW(pB0,12),PKW(pB0,14)};pw2=(u32x4){PKW(pB1,0),PKW(pB1,2),PKW(pB1,4),PKW(pB1,6)};pw3=(u32x4){PKW(pB1,8),PKW(pB1,10),PKW(pB1,12),PKW(pB1,14)};
    SBAR(); pv(o,(int)(unsigned)(size_t)vp0+sl_cur,PAF(0),PAF(1),PAF(2),PAF(3)); }
  #undef PKW
  #undef PAF
  #undef VFR
  #undef PIN
  #undef MX3
  #undef GAPA
  #undef GAPB
  #undef EX
  #undef VRD
  #undef KRD
  #undef STEP
  #undef ENDW
  {auto rr=__builtin_amdgcn_permlane32_swap(__float_as_uint(l_reg),__float_as_uint(l_reg),false,false);l_reg=__uint_as_float(rr[0])+__uint_as_float(rr[1]);}
  if(hi==0)wsf[32+r32]=l_reg;asm volatile("s_waitcnt lgkmcnt(0)":::"memory");
  float rli[16];
  #pragma unroll
  for(int r=0;r<16;++r)rli[r]=__builtin_amdgcn_rcpf(wsf[32+crow(r,hi)]);
  bf16*Ow=O+(rowbase+q0+wid*QBLK)*OP+h*D;
  { bf16*stg=(bf16*)(shm+LDS_OST)+wid*2048;
    #pragma unroll
    for(int r=0;r<16;++r){const int orow=crow(r,hi);
      #pragma unroll
      for(int d0=0;d0<2;++d0)stg[orow*64+d0*32+r32]=__float2bfloat16(o[d0][r]*rli[r]);}
    asm volatile("s_waitcnt lgkmcnt(0)":::"memory");
    #pragma unroll
    for(int i=0;i<4;++i){const int row=i*8+(lane>>3),ch=lane&7; const u32x4 v=*(const u32x4*)(stg+row*64+ch*8); ATTN_STORE16(Ow+(long)row*OP+ch*8,v);} }
  asm volatile("s_waitcnt lgkmcnt(0)\n\ts_barrier":::"memory");
  #undef DMA_K
  #undef DMA_V
  #undef TI
  #undef CMASK
  #undef START
  #undef RESC
  #undef ROT
}
constexpr int ATTN_LDS_BYTES=LDS_BYTES;
#undef SBAR
#undef WAIT_BAR
}
#undef LAS
constexpr int NB = DEBUG_BUILD ? 2 : 8;
constexpr int M_ = NB * SEQ;
constexpr int NSLOT = 2 * M_ + N_EXP * 256;
constexpr int PLD = 3072;
constexpr int FQ = 0, FK = 384, FV = 768, FZ = 1152, FGU = 1536, FGV = 1792, FXBC = 2048, FDT = 2944;
constexpr int NGU = 2 * D_FF, NGUE = 2 * D_FFE;

constexpr size_t al256(size_t x) { return (x + 255) & ~(size_t)255; }
constexpr size_t MiB = 1u << 20;
constexpr size_t O_CTL = 0, CTL_BYTES = 1 * MiB;
constexpr size_t O_RT = 1 * MiB;
constexpr size_t O_TE = O_RT + (size_t)M_ * 64, O_TP = O_TE + (size_t)M_ * 8, O_TS = O_TP + (size_t)M_ * 8, O_GS = O_TS + (size_t)M_ * 8;
constexpr size_t O_SP = O_GS + (size_t)M_ * 8;
constexpr size_t O_KM = O_SP + al256((size_t)NSLOT * 4);
constexpr size_t O_DT = O_KM + (size_t)2 * NB * ATT_H * NBLK * 64 * 4;
constexpr size_t O_WSB = al256(O_DT + (size_t)M_ * 24);
constexpr size_t O_HB = (O_WSB + (size_t)2 * GM_G * GM_CHUNK * GM_CHUNK * 2 + MiB - 1) / MiB * MiB;
constexpr size_t O_MWGU = O_HB + (size_t)M_ * DM * 2;
constexpr size_t O_WIN = O_MWGU + (size_t)N_EXP * NGUE * DM * 2;
constexpr size_t O_WOUT = O_WIN + (size_t)2 * PLD * DM * 2;
constexpr size_t O_WGU = O_WOUT + (size_t)2 * DM * DM * 2;
constexpr size_t O_WD = O_WGU + (size_t)NGU * DM * 2;
constexpr size_t O_SCR = O_WD + (size_t)DM * D_FF * 2;
constexpr size_t O_PROJ = O_SCR;
constexpr size_t O_XC = O_PROJ + (size_t)M_ * PLD * 2;
constexpr size_t O_MIXU = O_XC + (size_t)M_ * SSD_CW * 2;
constexpr size_t O_MIXB = O_MIXU + (size_t)M_ * DM * 4;
constexpr size_t O_VN = O_MIXB + (size_t)M_ * DM * 2;
constexpr size_t O_MIXEND = O_VN + (size_t)M_ * GM_W * 4;
constexpr size_t O_Y = O_SCR;
constexpr size_t O_ACT = O_Y + (size_t)M_ * DM * 4;
constexpr size_t O_XG = O_WIN;
constexpr size_t O_ACTM = O_XG + (size_t)NSLOT * DM * 2;
constexpr size_t O_MOEEND = O_ACTM + (size_t)NSLOT * D_FFE * 2;
constexpr size_t WS_END = O_MOEEND > O_MIXEND ? O_MOEEND : O_MIXEND;
static_assert(O_ACT + (size_t)M_ * D_FF * 2 <= O_MIXEND + (size_t)M_ * 4096, "act");
static_assert((size_t)NB * 16 * SSD_H * 8192 * 4 <= (size_t)M_ * SSD_CW * 2, "SSD states fit in the XC slot");
static_assert((size_t)NB * 32 * 768 * 4 <= (size_t)M_ * GM_W * 4, "dt/acum hand-off fits in the VN slot");
static_assert(WS_END <= 487000000ull, "workspace map exceeds the guaranteed size");
static_assert((size_t)N_EXP * DM * D_FFE * 2 <= (size_t)NBATCH * SEQ * DM * 4, "MWD fits in d_out");
constexpr int CW_BAR = 4096, CW_CNT = 1024, CW_Q = 1040, CW_ERR = 2048;

constexpr int RING_BYTES = 131072, MISC_OFF = RING_BYTES + 320, LDS_BYTES = 147456;

#define GAS __attribute__((address_space(1)))
#define LAS __attribute__((address_space(3)))
typedef GAS unsigned gu32;
#define RLX_AGENT __ATOMIC_RELAXED, __HIP_MEMORY_SCOPE_AGENT
#define LDS_WAIT() asm volatile("s_waitcnt lgkmcnt(0)" ::: "memory")

constexpr float QSCALE = 0.125f * 1.4426950408889634f;
constexpr int MOE_KSPLIT = 2, TAIL_UNITS = 128;
constexpr int TAIL_SLOTS = (TAIL_UNITS / 4) * 256;
constexpr float W8_GU = 32.f, W8_D = 128.f;
typedef unsigned char f8_t;
namespace fp {
using pg8::Unit; using pg8::BM; using pg8::HALF; typedef pg8::f32x4 f32x4; typedef pg8::u32x4 u32x4; typedef unsigned u32x2_f __attribute__((ext_vector_type(2)));
__device__ __forceinline__ unsigned pk2(float lo, float hi) { return pg8::cvt_pk_bf16(lo, hi); }
__device__ __forceinline__ unsigned pk4_f8(float a, float b, float c, float d) { int w = 0; w = __builtin_amdgcn_cvt_pk_fp8_f32(a, b, w, false); w = __builtin_amdgcn_cvt_pk_fp8_f32(c, d, w, true); return (unsigned)w; }
__device__ __forceinline__ float clamp8(float x) { return __builtin_amdgcn_fmed3f(x, -448.f, 448.f); }
__device__ __forceinline__ float gelu_fast(float x) { const float u = 0.7978845608028654f * (x + 0.044715f * x * x * x); return x * __builtin_amdgcn_rcpf(1.f + __expf(-2.f * u)); }

struct EpiProj {
    static constexpr bool PERM = true, AFTER_DRAIN = false;
    bf16* O; const float* RT; float* KM2;
    __device__ __forceinline__ void operator()(const f32x4 (&acc)[2][2][4][2], const Unit& u, int wr, int wc, int fr, int fq) const {
        const int row0 = u.pm * BM + wr * 64 + fr, col0 = u.pn * BM + wc * 32 + 8 * fq;
        f32x4 ks[2][2];
#pragma unroll
        for (int i = 0; i < 2; ++i) { ks[i][0] = (f32x4){0.f, 0.f, 0.f, 0.f}; ks[i][1] = ks[i][0]; }
        const int mode = (u.pn < 3) ? 1 : ((u.pn == 6 || u.pn == 7) ? 2 : 0);
        const bool rl = ((wc & 1) == 0) && (fq < 2);
        const int i0 = (fq & 1) * 4;
#pragma unroll
        for (int ai = 0; ai < 2; ++ai) {
            float4 c4a[4], s4a[4];
#pragma unroll
            for (int i = 0; i < 4; ++i) { c4a[i] = make_float4(1.f, 1.f, 1.f, 1.f); s4a[i] = make_float4(0.f, 0.f, 0.f, 0.f); }
            if (mode == 1 && rl) {
#pragma unroll
                for (int i = 0; i < 4; ++i) { const int row = row0 + ai * HALF + i * 16; c4a[i] = *(const float4*)(RT + (size_t)row * 16 + i0); s4a[i] = *(const float4*)(RT + (size_t)row * 16 + 8 + i0); } }
#pragma unroll
            for (int m = 0; m < 4; ++m) { const int row = row0 + ai * HALF + m * 16;
                const float4 c4 = c4a[m], s4 = s4a[m];
#pragma unroll
                for (int bj = 0; bj < 2; ++bj) { f32x4 v0 = acc[ai][bj][m][0], v1 = acc[ai][bj][m][1];
                    if (mode == 1) { const f32x4 a = v0, b = v1;
                        v0[0] = a[0] * c4.x - a[1] * s4.x; v0[1] = a[1] * c4.x + a[0] * s4.x; v0[2] = a[2] * c4.y - a[3] * s4.y; v0[3] = a[3] * c4.y + a[2] * s4.y;
                        v1[0] = b[0] * c4.z - b[1] * s4.z; v1[1] = b[1] * c4.z + b[0] * s4.z; v1[2] = b[2] * c4.w - b[3] * s4.w; v1[3] = b[3] * c4.w + b[2] * s4.w; }
                    if (u.pn == 0 || (u.pn == 1 && bj == 0)) { v0 = v0 * QSCALE; v1 = v1 * QSCALE; }
                    else if (mode == 1) { ks[bj][0] += v0; ks[bj][1] += v1; }
                    if (mode == 2) {
#pragma unroll
                        for (int j = 0; j < 4; ++j) { v0[j] = gelu_fast(v0[j]); v1[j] = gelu_fast(v1[j]); } }
                    u32x4 w; w.x = pk2(v0[0], v0[1]); w.y = pk2(v0[2], v0[3]); w.z = pk2(v1[0], v1[1]); w.w = pk2(v1[2], v1[3]);
                    *(u32x4*)(O + (size_t)row * PLD + col0 + bj * HALF) = w; } } }
        if (u.pn == 1 || u.pn == 2) {
#pragma unroll
            for (int bj = 0; bj < 2; ++bj) { if (u.pn == 1 && bj == 0) continue;
#pragma unroll
                for (int n = 0; n < 2; ++n)
#pragma unroll
                    for (int j = 0; j < 4; ++j) { float x = ks[bj][n][j]; x += __shfl_xor(x, 1); x += __shfl_xor(x, 2); x += __shfl_xor(x, 4); x += __shfl_xor(x, 8); ks[bj][n][j] = x * (1.f / 256.f); }
                if (fr == 0) { const int kc = col0 + bj * HALF - FK; const int b = u.pm >> 3, nb = u.pm & 7;
                    float* dst = KM2 + (size_t)wr * (NB * ATT_H * NBLK * 64) + ((size_t)(b * ATT_H + (kc >> 6)) * NBLK + nb) * 64 + (kc & 63);
                    *(f32x4*)dst = ks[bj][0]; *(f32x4*)(dst + 4) = ks[bj][1]; } }
        }
    }
};
struct EpiAct {
    static constexpr bool PERM = true, AFTER_DRAIN = false;
    bf16* O; int ldc, ncol;
    __device__ __forceinline__ void operator()(const f32x4 (&acc)[2][2][4][2], const Unit& u, int wr, int wc, int fr, int fq) const {
        const int row0 = u.pm * BM + wr * 64 + fr, col0 = (u.pn % ncol) * HALF + wc * 32 + 8 * fq;
#pragma unroll
        for (int ai = 0; ai < 2; ++ai)
#pragma unroll
            for (int m = 0; m < 4; ++m) { const int row = row0 + ai * HALF + m * 16;
                const f32x4 g0 = acc[ai][0][m][0], g1 = acc[ai][0][m][1], u0 = acc[ai][1][m][0], u1 = acc[ai][1][m][1]; f32x4 a0, a1;
#pragma unroll
                for (int j = 0; j < 4; ++j) { a0[j] = g0[j] * __builtin_amdgcn_rcpf(1.f + __expf(-g0[j])) * u0[j]; a1[j] = g1[j] * __builtin_amdgcn_rcpf(1.f + __expf(-g1[j])) * u1[j]; }
                u32x4 w; w.x = pk2(a0[0], a0[1]); w.y = pk2(a0[2], a0[3]); w.z = pk2(a1[0], a1[1]); w.w = pk2(a1[2], a1[3]);
                *(u32x4*)(O + (size_t)row * ldc + col0) = w; }
    }
};
struct EpiAct8 {
    static constexpr bool PERM = true, AFTER_DRAIN = false;
    f8_t* O; int ldc, ncol;
    __device__ __forceinline__ void operator()(const f32x4 (&acc)[2][2][4][2], const Unit& u, int wr, int wc, int fr, int fq) const {
        const int row0 = u.pm * BM + wr * 64 + fr, col0 = (u.pn % ncol) * HALF + wc * 32 + 8 * fq;
        constexpr float s = 1.f / W8_GU, ke = -s * 1.4426950408889634f, s2 = s * s;
#pragma unroll
        for (int ai = 0; ai < 2; ++ai)
#pragma unroll
            for (int m = 0; m < 4; ++m) { const int row = row0 + ai * HALF + m * 16;
                const f32x4 g0 = acc[ai][0][m][0], g1 = acc[ai][0][m][1], u0 = acc[ai][1][m][0], u1 = acc[ai][1][m][1]; f32x4 a0, a1;
#pragma unroll
                for (int j = 0; j < 4; ++j) { a0[j] = clamp8((g0[j] * u0[j]) * (s2 * __builtin_amdgcn_rcpf(1.f + __builtin_amdgcn_exp2f(g0[j] * ke))));
                                              a1[j] = clamp8((g1[j] * u1[j]) * (s2 * __builtin_amdgcn_rcpf(1.f + __builtin_amdgcn_exp2f(g1[j] * ke)))); }
                u32x2_f w; w.x = pk4_f8(a0[0], a0[1], a0[2], a0[3]); w.y = pk4_f8(a1[0], a1[1], a1[2], a1[3]);
                *(u32x2_f*)(O + (size_t)row * ldc + col0) = w; }
    }
};
struct EpiF32 {
    static constexpr bool PERM = false, AFTER_DRAIN = false;
    float* O; int ldc;
    __device__ __forceinline__ void operator()(const f32x4 (&acc)[2][2][4][2], const Unit& u, int wr, int wc, int fr, int fq) const {
        const int row0 = u.pm * BM + wr * 64 + fr, col0 = u.pn * BM + wc * 32 + 4 * fq;
#pragma unroll
        for (int ai = 0; ai < 2; ++ai)
#pragma unroll
            for (int m = 0; m < 4; ++m) { float* rp = O + (size_t)(row0 + ai * HALF + m * 16) * ldc + col0;
#pragma unroll
                for (int bj = 0; bj < 2; ++bj)
#pragma unroll
                    for (int n = 0; n < 2; ++n) *(f32x4*)(rp + bj * HALF + n * 16) = acc[ai][bj][m][n]; }
    }
};
struct EpiY {
    static constexpr bool PERM = true, AFTER_DRAIN = false;
    bf16* O; int ldc;
    __device__ __forceinline__ void operator()(const f32x4 (&acc)[2][2][4][2], const Unit& u, int wr, int wc, int fr, int fq) const {
        const int row0 = u.pm * BM + wr * 64 + fr, col0 = u.pn * BM + wc * 32 + 8 * fq;
#pragma unroll
        for (int ai = 0; ai < 2; ++ai)
#pragma unroll
            for (int m = 0; m < 4; ++m) { bf16* rp = O + (size_t)(row0 + ai * HALF + m * 16) * ldc + col0;
#pragma unroll
                for (int bj = 0; bj < 2; ++bj) { const f32x4 v0 = acc[ai][bj][m][0], v1 = acc[ai][bj][m][1];
                    u32x4 w; w.x = pk2(v0[0], v0[1]); w.y = pk2(v0[2], v0[3]); w.z = pk2(v1[0], v1[1]); w.w = pk2(v1[2], v1[3]);
                    *(u32x4*)(rp + bj * HALF) = w; } }
    }
};
struct EpiY8 {
    static constexpr bool PERM = true, AFTER_DRAIN = false;
    bf16* O; int ldc;
    __device__ __forceinline__ void operator()(const f32x4 (&acc)[2][2][4][2], const Unit& u, int wr, int wc, int fr, int fq) const {
        const int row0 = u.pm * BM + wr * 64 + fr, col0 = u.pn * BM + wc * 32 + 8 * fq; constexpr float s = 1.f / W8_D;
#pragma unroll
        for (int ai = 0; ai < 2; ++ai)
#pragma unroll
            for (int m = 0; m < 4; ++m) { bf16* rp = O + (size_t)(row0 + ai * HALF + m * 16) * ldc + col0;
#pragma unroll
                for (int bj = 0; bj < 2; ++bj) { const f32x4 v0 = acc[ai][bj][m][0] * s, v1 = acc[ai][bj][m][1] * s;
                    u32x4 w; w.x = pk2(v0[0], v0[1]); w.y = pk2(v0[2], v0[3]); w.z = pk2(v1[0], v1[1]); w.w = pk2(v1[2], v1[3]);
                    *(u32x4*)(rp + bj * HALF) = w; } }
    }
};
struct EpiF2 {
    static constexpr bool PERM = true, AFTER_DRAIN = false;
    bf16* O; const float* SP; bf16* FP; int slot0, klen; float osc;
    __device__ __forceinline__ void operator()(const f32x4 (&acc)[2][2][4][2], const Unit& u, int wr, int wc, int fr, int fq) const {
        const int row0 = u.pm * BM + wr * 64 + fr, col0 = (u.pn & 3) * BM + wc * 32 + 8 * fq;
        bf16* base = O; int rsub = 0;
        if (u.kofs > 0) { const int part = u.kofs / klen; base = FP + (size_t)(part - 1) * TAIL_SLOTS * DM; rsub = slot0; }
        float spv[8];
#pragma unroll
        for (int i = 0; i < 8; ++i) spv[i] = SP[row0 + (i >> 2) * HALF + (i & 3) * 16] * osc;
#pragma unroll
        for (int ai = 0; ai < 2; ++ai)
#pragma unroll
            for (int m = 0; m < 4; ++m) { const int row = row0 + ai * HALF + m * 16; const float sc = spv[ai * 4 + m];
#pragma unroll
                for (int bj = 0; bj < 2; ++bj) { const f32x4 v0 = acc[ai][bj][m][0] * sc, v1 = acc[ai][bj][m][1] * sc;
                    u32x4 w; w.x = pk2(v0[0], v0[1]); w.y = pk2(v0[2], v0[3]); w.z = pk2(v1[0], v1[1]); w.w = pk2(v1[2], v1[3]);
                    *(u32x4*)(base + (size_t)(row - rsub) * DM + col0 + bj * HALF) = w; } }
    }
};
static_assert(NGUE / 256 == 28 && DM / 256 == 4, "MoeOrder::next decodes units for 28 or 4 column tiles");
struct MoeOrder {
    int p0, p1, p2, p3, p4, p5, p6, T, ncol, G, c, nfull, ksplit, klen;
    __device__ __forceinline__ void init(const int* CNT, int ncol_, int G_, int c_) {
        int t = 0; t += (CNT[0] + 255) >> 8; p0 = t; t += (CNT[1] + 255) >> 8; p1 = t; t += (CNT[2] + 255) >> 8; p2 = t; t += (CNT[3] + 255) >> 8; p3 = t;
        t += (CNT[4] + 255) >> 8; p4 = t; t += (CNT[5] + 255) >> 8; p5 = t; t += (CNT[6] + 255) >> 8; p6 = t; t += (CNT[7] + 255) >> 8; T = t; ncol = ncol_; G = G_; c = c_;
        p0 = __builtin_amdgcn_readfirstlane(p0); p1 = __builtin_amdgcn_readfirstlane(p1); p2 = __builtin_amdgcn_readfirstlane(p2); p3 = __builtin_amdgcn_readfirstlane(p3);
        p4 = __builtin_amdgcn_readfirstlane(p4); p5 = __builtin_amdgcn_readfirstlane(p5); p6 = __builtin_amdgcn_readfirstlane(p6); T = __builtin_amdgcn_readfirstlane(T);
        nfull = T * ncol; ksplit = 1; klen = 0;
    }
    __device__ __forceinline__ int tail_start() const { const int tot = T * ncol, nf = (tot / G) * G; return (tot - nf <= TAIL_UNITS) ? nf : tot; }
    __device__ __forceinline__ bool next(int i, Unit& u) const {
        int L = i * G + c; int part = 0;
        if (ksplit == 1) { if (L >= nfull) return false; }
        else { const int sh = (ksplit == 4) ? 2 : 1; if (L >= ((T * ncol - nfull) << sh)) return false; part = L & (ksplit - 1); L = nfull + (L >> sh); }
        const int tm = (ncol == 4) ? (L >> 2) : (int)((unsigned)L / 28u), j = L - tm * ncol;
        const int e = (tm >= p0) + (tm >= p1) + (tm >= p2) + (tm >= p3) + (tm >= p4) + (tm >= p5) + (tm >= p6);
        u.pm = tm; u.pn = e * ncol + j; u.kofs = part * klen; return true;
    }
    __device__ __forceinline__ void a_ready(const Unit&) const {}
    __device__ __forceinline__ void done(const Unit&) const {}
};

struct SrcCol { const float* p; int ld; };
__device__ __forceinline__ int win_src_col(int d) {
    if (d < 768) { const int hd = d & 63; const int sd = hd < 16 ? ((hd & 1) ? 8 + (hd >> 1) : (hd >> 1)) : hd; return d - hd + sd; }
    if (d < 1536) return d;
    if (d < 1792) return 2438 + (d - 1536);
    if (d < 2048) return 2694 + (d - 1792);
    if (d < 2944) return 1536 + (d - 2048);
    if (d < 2950) return 2432 + (d - 2944);
    return -1;
}
__device__ __forceinline__ SrcCol gu_src(const float* wg, const float* wu, int nff, int r) {
    const int tile = r >> 8, rr = r & 255, j = tile * 128 + (rr & 127); SrcCol s; s.p = (rr < 128 ? wg : wu) + j; s.ld = nff; return s;
}
__device__ __forceinline__ void conv_item(SrcCol sc, int K, bf16* WT, long d0, int k0, LAS float* scr, int lane) {
    float tv[32];
#pragma unroll
    for (int i = 0; i < 32; ++i) { const int kk = 2 * i + (lane >> 5); tv[i] = sc.p ? __builtin_nontemporal_load(sc.p + (size_t)(k0 + kk) * sc.ld) : 0.f; }
#pragma unroll
    for (int i = 0; i < 32; ++i) { const int kk = 2 * i + (lane >> 5); scr[kk * 33 + (lane & 31)] = tv[i]; }
    LDS_WAIT(); asm volatile("" ::: "memory");
    const int c = lane & 7;
#pragma unroll
    for (int j = 0; j < 4; ++j) { const int n = (lane >> 3) + 8 * j; const LAS float* s = scr + (8 * c) * 33 + n;
        u32x4 o; o.x = pk2(s[0 * 33], s[1 * 33]); o.y = pk2(s[2 * 33], s[3 * 33]); o.z = pk2(s[4 * 33], s[5 * 33]); o.w = pk2(s[6 * 33], s[7 * 33]);
        __builtin_nontemporal_store(o, (u32x4*)(WT + (size_t)(d0 + n) * K + k0 + 8 * c)); }
    LDS_WAIT(); asm volatile("" ::: "memory");
}
__device__ __forceinline__ void conv_item8(SrcCol sc, int K  , f8_t* WT, long d0, int k0, float scale, LAS float* scr, int lane) {
    float ta[32], tb[32];
#pragma unroll
    for (int i = 0; i < 32; ++i) { const int kk = 2 * i + (lane >> 5); const size_t kr = (size_t)(k0 + 16 * (kk >> 3) + (kk & 7));
        ta[i] = __builtin_nontemporal_load(sc.p + kr * sc.ld); tb[i] = __builtin_nontemporal_load(sc.p + (kr + 8) * sc.ld); }
    const int c = lane & 7; unsigned pa[4][2];
#pragma unroll
    for (int i = 0; i < 32; ++i) { const int kk = 2 * i + (lane >> 5); scr[kk * 33 + (lane & 31)] = ta[i]; }
    LDS_WAIT(); asm volatile("" ::: "memory");
#pragma unroll
    for (int j = 0; j < 4; ++j) { const int n = (lane >> 3) + 8 * j; const LAS float* s = scr + (8 * c) * 33 + n;
        pa[j][0] = pk4_f8(clamp8(s[0 * 33] * scale), clamp8(s[1 * 33] * scale), clamp8(s[2 * 33] * scale), clamp8(s[3 * 33] * scale));
        pa[j][1] = pk4_f8(clamp8(s[4 * 33] * scale), clamp8(s[5 * 33] * scale), clamp8(s[6 * 33] * scale), clamp8(s[7 * 33] * scale)); }
    LDS_WAIT(); asm volatile("" ::: "memory");
#pragma unroll
    for (int i = 0; i < 32; ++i) { const int kk = 2 * i + (lane >> 5); scr[kk * 33 + (lane & 31)] = tb[i]; }
    LDS_WAIT(); asm volatile("" ::: "memory");
#pragma unroll
    for (int j = 0; j < 4; ++j) { const int n = (lane >> 3) + 8 * j; const LAS float* s = scr + (8 * c) * 33 + n;
        u32x4 o; o.x = pa[j][0]; o.y = pa[j][1];
        o.z = pk4_f8(clamp8(s[0 * 33] * scale), clamp8(s[1 * 33] * scale), clamp8(s[2 * 33] * scale), clamp8(s[3 * 33] * scale));
        o.w = pk4_f8(clamp8(s[4 * 33] * scale), clamp8(s[5 * 33] * scale), clamp8(s[6 * 33] * scale), clamp8(s[7 * 33] * scale));
        __builtin_nontemporal_store(o, (u32x4*)(WT + (size_t)(d0 + n) * K + k0 + 16 * c)); }
    LDS_WAIT(); asm volatile("" ::: "memory");
}
}


typedef short bf16x8_t __attribute__((ext_vector_type(8)));
typedef float f32x4_t __attribute__((ext_vector_type(4)));
constexpr int TLD = 272;
__device__ __forceinline__ bf16x8_t lds_frag(const LAS unsigned char* base, int row, int kbyte) { return *(const LAS bf16x8_t*)(base + row * TLD + kbyte); }
__device__ __forceinline__ float red16(float v) { return row16_sum(v); }

__device__ __forceinline__ void gm_unit(int b, int c, const bf16* PROJ, const bf16* WSB  , const float* ln_g, const float* ln_b, const float* b_s, const float* norm_g,
                                        bf16* MIXB, LAS unsigned char* lds, int wave, int lane) {
    const long r0 = (long)b * SEQ + c * GM_CHUNK;
    LAS unsigned char* VNT = lds;
    { float4 vv[16];
#pragma unroll
      for (int i = 0; i < 16; ++i) vv[i] = ld4(PROJ + (r0 + wave * 16 + i) * PLD + FGV + lane * 4);
      const float4 gg = *(const float4*)(ln_g + lane * 4), bb = *(const float4*)(ln_b + lane * 4);
#pragma unroll
      for (int i = 0; i < 16; ++i) { const int t = wave * 16 + i; const float4 v = vv[i];
        const float mean = wave_sum((v.x + v.y) + (v.z + v.w)) * (1.f / 256.f);
        const float d0 = v.x - mean, d1 = v.y - mean, d2 = v.z - mean, d3 = v.w - mean;
        const float rstd = rsqrtf(wave_sum((d0 * d0 + d1 * d1) + (d2 * d2 + d3 * d3)) * (1.f / 256.f) + 1e-5f);
        LAS bf16* dst = (LAS bf16*)(VNT + (lane * 4) * TLD) + t;
        dst[0] = (bf16)f2bf(d0 * rstd * gg.x + bb.x); dst[TLD / 2] = (bf16)f2bf(d1 * rstd * gg.y + bb.y); dst[TLD] = (bf16)f2bf(d2 * rstd * gg.z + bb.z); dst[3 * TLD / 2] = (bf16)f2bf(d3 * rstd * gg.w + bb.w); } }
    __syncthreads();
    f32x4_t acc[16];
#pragma unroll
    for (int i = 0; i < 16; ++i) acc[i] = (f32x4_t){0.f, 0.f, 0.f, 0.f};
    const int fr = lane & 15, fq = lane >> 4;
    const int nks = (wave * 16 + 15) / 32 + 1;
    for (int ks = 0; ks < nks; ++ks) {
#pragma unroll
        for (int g = 0; g < 4; ++g) {
            const bf16x8_t af = *(const bf16x8_t*)(WSB + ((size_t)g * GM_CHUNK + wave * 16 + fr) * GM_CHUNK + ks * 32 + fq * 8);
#pragma unroll
            for (int n = 0; n < 4; ++n) { const bf16x8_t bfv = lds_frag(VNT, g * 64 + n * 16 + fr, ks * 64 + fq * 16);
                acc[g * 4 + n] = __builtin_amdgcn_mfma_f32_16x16x32_bf16(af, bfv, acc[g * 4 + n], 0, 0, 0); }
        }
    }
    __syncthreads();
    LAS bf16* ost = (LAS bf16*)(lds + wave * (16 * 264 * 2));
    float ss[4] = {0.f, 0.f, 0.f, 0.f};
#pragma unroll
    for (int nt = 0; nt < 16; ++nt) { const int col = nt * 16 + fr, g = nt >> 2;
#pragma unroll
        for (int r = 0; r < 4; ++r) { const int t = wave * 16 + fq * 4 + r;
            const float u = ldf(PROJ + (r0 + t) * PLD + FGU + col);
            const float o = u * (acc[nt][r] + b_s[g * GM_CHUNK + t]); acc[nt][r] = o; ss[r] += o * o; } }
#pragma unroll
    for (int r = 0; r < 4; ++r) ss[r] = rsqrtf(red16(ss[r]) * (1.f / 256.f) + 1e-5f);
#pragma unroll
    for (int nt = 0; nt < 16; ++nt) { const int col = nt * 16 + fr; const float gn = norm_g[col];
#pragma unroll
        for (int r = 0; r < 4; ++r) { ost[(fq * 4 + r) * 264 + col] = (bf16)f2bf(acc[nt][r] * ss[r] * gn); } }
    LDS_WAIT(); asm volatile("" ::: "memory");
#pragma unroll
    for (int i = 0; i < 8; ++i) { const int rr = i * 2 + (lane >> 5), ch = lane & 31;
        const fp::u32x4 v = *(const LAS fp::u32x4*)(ost + rr * 264 + ch * 8);
        *(fp::u32x4*)(MIXB + (r0 + wave * 16 + rr) * DM + ATT_W + SSD_W + ch * 8) = v; }
    __syncthreads();
}

typedef short v4i16_t __attribute__((ext_vector_type(4)));
typedef unsigned u32x2_t __attribute__((ext_vector_type(2)));
__device__ __forceinline__ v4i16_t lds_tr(const LAS unsigned char* p) { return __builtin_amdgcn_ds_read_tr16_b64_v4i16((LAS v4i16_t*)p); }
__device__ __forceinline__ bf16x8_t lds_frag_tr(const LAS unsigned char* tile, int pitch, int k0, int c0, int lane) {
    const int kg = lane >> 4, q = (lane & 15) >> 2, p = lane & 3;
    const LAS unsigned char* a = tile + (k0 + 8 * kg + q) * pitch + (c0 + 4 * p) * 2;
    const v4i16_t lo = lds_tr(a), hi = lds_tr(a + 4 * pitch);
    return (bf16x8_t){lo[0], lo[1], lo[2], lo[3], hi[0], hi[1], hi[2], hi[3]};
}
__device__ __forceinline__ bf16x8_t lds_frag_p(const LAS unsigned char* base, int pitch, int row, int kbyte) { return *(const LAS bf16x8_t*)(base + row * pitch + kbyte); }
template <int NCH, bool SCALE, bool TOLDS> __device__ __forceinline__ void conv_rows(const bf16* PROJ, long r0, int t0, int colbase, int ch0, const float* cw, const float* cb, LAS unsigned char* tile, int pitch,
                                                                                       const LAS float* scl, bf16* XCg  , int tid) {
    constexpr int CPR = NCH / 8, RG = 512 / CPR, RPT = (128 + RG - 1) / RG;
    if (tid < CPR * RG) { const int ch = (tid % CPR) * 8, l0 = (tid / CPR) * RPT;
        float w[4][8], bs[8];
        { const float4 c0 = *(const float4*)(cb + ch0 + ch), c1 = *(const float4*)(cb + ch0 + ch + 4); bs[0] = c0.x; bs[1] = c0.y; bs[2] = c0.z; bs[3] = c0.w; bs[4] = c1.x; bs[5] = c1.y; bs[6] = c1.z; bs[7] = c1.w; }
#pragma unroll
        for (int i = 0; i < 4; ++i) { const float4 w0 = *(const float4*)(cw + i * SSD_CW + ch0 + ch), w1 = *(const float4*)(cw + i * SSD_CW + ch0 + ch + 4);
            w[i][0] = w0.x; w[i][1] = w0.y; w[i][2] = w0.z; w[i][3] = w0.w; w[i][4] = w1.x; w[i][5] = w1.y; w[i][6] = w1.z; w[i][7] = w1.w; }
        fp::u32x4 xr[RPT + 3];
#pragma unroll
        for (int j = 0; j < RPT + 3; ++j) { const int l = l0 - 3 + j; xr[j] = (fp::u32x4){0u, 0u, 0u, 0u};
            if (l < 128 && t0 + l >= 0) xr[j] = *(const fp::u32x4*)(PROJ + (r0 + l) * PLD + colbase + ch); }
#pragma unroll
        for (int j = 0; j < RPT; ++j) { const int l = l0 + j; if (l < 128) {
            float a[8];
#pragma unroll
            for (int e = 0; e < 8; ++e) a[e] = bs[e];
#pragma unroll
            for (int i = 0; i < 4; ++i) { const fp::u32x4 xv = xr[j + i];
#pragma unroll
                for (int e = 0; e < 4; ++e) { a[2 * e] += w[i][2 * e] * __uint_as_float(xv[e] << 16); a[2 * e + 1] += w[i][2 * e + 1] * __uint_as_float(xv[e] & 0xffff0000u); } }
#pragma unroll
            for (int e = 0; e < 8; ++e) a[e] = a[e] * __builtin_amdgcn_rcpf(1.f + __expf(-a[e]));
            fp::u32x4 o; o.x = fp::pk2(a[0], a[1]); o.y = fp::pk2(a[2], a[3]); o.z = fp::pk2(a[4], a[5]); o.w = fp::pk2(a[6], a[7]);
            *(fp::u32x4*)(XCg + (r0 + l) * SSD_CW + ch) = o;
            if (TOLDS) { if (SCALE) { const float sc = scl[(ch >> 6) * 128 + l]; o.x = fp::pk2(a[0] * sc, a[1] * sc); o.y = fp::pk2(a[2] * sc, a[3] * sc); o.z = fp::pk2(a[4] * sc, a[5] * sc); o.w = fp::pk2(a[6] * sc, a[7] * sc); }
                *(LAS fp::u32x4*)(tile + l * pitch + ch * 2) = o; } } }
    }
}
template <int NCH> __device__ __forceinline__ void load_xc_tile(const bf16* XCg, long r0, LAS unsigned char* tile, int pitch, int tid) {
    constexpr int CPR = NCH / 8;
    for (int it = tid; it < 128 * CPR; it += 512) { const int l = it / CPR, ch = (it % CPR) * 8;
        *(LAS fp::u32x4*)(tile + l * pitch + ch * 2) = *(const fp::u32x4*)(XCg + (r0 + l) * SSD_CW + ch); }
}
__device__ __forceinline__ void ssd_dt_acum(const bf16* PROJ, long r0, int g, const float* dt_bias, const float* a_log, LAS float* dtS, LAS float* acS, int tid, int wave, int lane) {
    if (tid < 384) { const int hh = tid >> 7, l = tid & 127, h = 3 * g + hh;
        const float dtv = softplus_f(ldf(PROJ + (r0 + l) * PLD + FDT + h) + dt_bias[h]); dtS[tid] = dtv; acS[tid] = dtv * (-__expf(a_log[h])); }
    __syncthreads();
    if (wave < 3) { const float a0 = acS[wave * 128 + 2 * lane], a1 = acS[wave * 128 + 2 * lane + 1]; const float sm = a0 + a1; float v = sm;
#pragma unroll
        for (int o = 1; o < 64; o <<= 1) { const float t = __shfl_up(v, o); if (lane >= o) v += t; }
        const float ex = v - sm; acS[wave * 128 + 2 * lane] = ex + a0; acS[wave * 128 + 2 * lane + 1] = ex + sm; }
    __syncthreads();
}
constexpr int XP = 400;
__device__ __forceinline__ void ssdA_unit(int b, int c, int g, const bf16* PROJ, const float* cw, const float* cb, const float* dt_bias, const float* a_log, float* ST, float* CD, bf16* XC, float* DTG,
                                          LAS unsigned char* lds, int tid, int wave, int lane) {
    asm volatile("" : "+v"(tid), "+v"(lane));
    const long r0 = (long)b * SEQ + c * 128; const int t0 = c * 128;
    LAS unsigned char* XS = lds; LAS unsigned char* BS = lds + 51200;
    LAS float* dtS = (LAS float*)(lds + 86016); LAS float* acS = dtS + 384; LAS float* sclS = acS + 384;
    ssd_dt_acum(PROJ, r0, g, dt_bias, a_log, dtS, acS, tid, wave, lane);
    if (tid < 384) { const int hh = tid >> 7; const float al = acS[hh * 128 + 127]; sclS[tid] = dtS[tid] * __expf(al - acS[tid]);
        float* dg = DTG + (((long)b * 16 + c) * 2 + g) * 768; dg[tid] = dtS[tid]; dg[384 + tid] = acS[tid];
        if ((tid & 127) == 0) CD[((long)b * 16 + c) * SSD_H + 3 * g + hh] = __expf(al); }
    __syncthreads();
    conv_rows<192, true, true>(PROJ, r0, t0, FXBC + 192 * g, 192 * g, cw, cb, XS, XP, sclS, XC + 192 * g, tid);
    conv_rows<128, false, true>(PROJ, r0, t0, FXBC + SSD_W + 128 * g, SSD_W + 128 * g, cw, cb, BS, TLD, nullptr, XC + SSD_W + 128 * g, tid);
    conv_rows<128, false, false>(PROJ, r0, t0, FXBC + SSD_W + 256 + 128 * g, SSD_W + 256 + 128 * g, cw, cb, nullptr, 0, nullptr, XC + SSD_W + 256 + 128 * g, tid);
    __syncthreads();
    f32x4_t acc[12];
#pragma unroll
    for (int i = 0; i < 12; ++i) acc[i] = (f32x4_t){0.f, 0.f, 0.f, 0.f};
#pragma unroll 1
    for (int ks = 0; ks < 4; ++ks) { const bf16x8_t bfv = lds_frag_tr(BS, TLD, ks * 32, 16 * wave, lane);
#pragma unroll
        for (int mt = 0; mt < 12; ++mt) { const bf16x8_t af = lds_frag_tr(XS, XP, ks * 32, (mt >> 2) * 64 + (mt & 3) * 16, lane); acc[mt] = __builtin_amdgcn_mfma_f32_16x16x32_bf16(af, bfv, acc[mt], 0, 0, 0); } }
    const int fr = lane & 15, fq = lane >> 4;
    float* sp = ST + (((long)b * 16 + c) * SSD_H + 3 * g) * 8192 + 16 * wave + fr;
#pragma unroll
    for (int mt = 0; mt < 12; ++mt)
#pragma unroll
        for (int r = 0; r < 4; ++r) sp[(mt >> 2) * 8192 + ((mt & 3) * 16 + 4 * fq + r) * 128] = acc[mt][r];
    __syncthreads();
}
__device__ __forceinline__ void ssdB_unit(int b, int c, int g, const bf16* PROJ, const bf16* XC, const float* DTG, const float* dsk, const float* ng,
                                          const float* ST, const float* CD, bf16* MIXB, LAS unsigned char* lds, int tid, int wave, int lane) {
    const long r0 = (long)b * SEQ + c * 128;
    LAS unsigned char* CS = lds; LAS unsigned char* PX = lds + 34816; LAS unsigned char* BG = lds + 87040;
    LAS float* dtS = (LAS float*)(lds + 121856); LAS float* acS = dtS + 384;
    const int fr = lane & 15, fq = lane >> 4;
    if (tid < 384) { const float* dg = DTG + (((long)b * 16 + c) * 2 + g) * 768; dtS[tid] = dg[tid]; acS[tid] = dg[384 + tid]; }
    load_xc_tile<128>(XC + SSD_W + 256 + 128 * g, r0, CS, TLD, tid);
    if (c > 0) {
        float4 pv[12];
#pragma unroll
        for (int i = 0; i < 12; ++i) pv[i] = make_float4(0.f, 0.f, 0.f, 0.f);
        const float* sbase = ST + ((long)b * 16 * SSD_H + 3 * g) * 8192 + tid * 4; const float* cbase = CD + (long)b * 16 * SSD_H + 3 * g;
        int j = 0;
        for (; j + 2 < c; j += 3) { const float* s0 = sbase + (long)j * SSD_H * 8192; const float* c0 = cbase + j * SSD_H;
            float4 v0[12], v1[12], v2[12];
#pragma unroll
            for (int i = 0; i < 12; ++i) { v0[i] = *(const float4*)(s0 + i * 2048); v1[i] = *(const float4*)(s0 + SSD_H * 8192 + i * 2048); v2[i] = *(const float4*)(s0 + 2 * SSD_H * 8192 + i * 2048); }
            float dd[3][3];
#pragma unroll
            for (int q = 0; q < 3; ++q) { dd[q][0] = c0[q * SSD_H]; dd[q][1] = c0[q * SSD_H + 1]; dd[q][2] = c0[q * SSD_H + 2]; }
#pragma unroll
            for (int i = 0; i < 12; ++i) { const int hq = i >> 2;
                pv[i].x = ((pv[i].x * dd[0][hq] + v0[i].x) * dd[1][hq] + v1[i].x) * dd[2][hq] + v2[i].x;
                pv[i].y = ((pv[i].y * dd[0][hq] + v0[i].y) * dd[1][hq] + v1[i].y) * dd[2][hq] + v2[i].y;
                pv[i].z = ((pv[i].z * dd[0][hq] + v0[i].z) * dd[1][hq] + v1[i].z) * dd[2][hq] + v2[i].z;
                pv[i].w = ((pv[i].w * dd[0][hq] + v0[i].w) * dd[1][hq] + v1[i].w) * dd[2][hq] + v2[i].w; } }
        for (; j < c; ++j) { const float* s0 = sbase + (long)j * SSD_H * 8192; const float* c0 = cbase + j * SSD_H; const float d0 = c0[0], d1 = c0[1], d2 = c0[2];
#pragma unroll
            for (int i = 0; i < 12; ++i) { const float4 sv = *(const float4*)(s0 + i * 2048); const float d = (i < 4) ? d0 : ((i < 8) ? d1 : d2);
                pv[i].x = pv[i].x * d + sv.x; pv[i].y = pv[i].y * d + sv.y; pv[i].z = pv[i].z * d + sv.z; pv[i].w = pv[i].w * d + sv.w; } }
#pragma unroll
        for (int i = 0; i < 12; ++i) { const int row = (i >> 2) * 64 + (i & 3) * 16 + (tid >> 5), n = (tid & 31) * 4;
            u32x2_t w; w.x = fp::pk2(pv[i].x, pv[i].y); w.y = fp::pk2(pv[i].z, pv[i].w); *(LAS u32x2_t*)(PX + row * TLD + n * 2) = w; }
    }
    __syncthreads();
    f32x4_t acc_y[12];
#pragma unroll
    for (int i = 0; i < 12; ++i) acc_y[i] = (f32x4_t){0.f, 0.f, 0.f, 0.f};
    if (c > 0) {
#pragma unroll 1
        for (int ks = 0; ks < 4; ++ks) { const bf16x8_t af = lds_frag_p(CS, TLD, 16 * wave + fr, ks * 64 + fq * 16);
#pragma unroll
            for (int t = 0; t < 12; ++t) { const bf16x8_t bfv = lds_frag_p(PX, TLD, (t >> 2) * 64 + (t & 3) * 16 + fr, ks * 64 + fq * 16); acc_y[t] = __builtin_amdgcn_mfma_f32_16x16x32_bf16(af, bfv, acc_y[t], 0, 0, 0); } }
#pragma unroll
        for (int t = 0; t < 12; ++t)
#pragma unroll
            for (int r = 0; r < 4; ++r) acc_y[t][r] *= __expf(acS[(t >> 2) * 128 + 16 * wave + 4 * fq + r]);
    }
    __syncthreads();
    load_xc_tile<192>(XC + 192 * g, r0, PX, XP, tid);
    load_xc_tile<128>(XC + SSD_W + 128 * g, r0, BG, TLD, tid);
    __syncthreads();
#if defined(SSDB_CUT) && SSDB_CUT == 2
    { float t_ = 0.f; for (int i = 0; i < 12; ++i) t_ += acc_y[i][0] + acc_y[i][1] + acc_y[i][2] + acc_y[i][3]; if (t_ == 123.f) MIXB[0] = 1; return; }
#endif
    f32x4_t acc_cb[8];
#pragma unroll
    for (int i = 0; i < 8; ++i) acc_cb[i] = (f32x4_t){0.f, 0.f, 0.f, 0.f};
#pragma unroll 1
    for (int ks = 0; ks < 4; ++ks) { const bf16x8_t af = lds_frag_p(CS, TLD, 16 * wave + fr, ks * 64 + fq * 16);
#pragma unroll
        for (int ns = 0; ns < 8; ++ns) if (ns <= wave) { const bf16x8_t bfv = lds_frag_p(BG, TLD, 16 * ns + fr, ks * 64 + fq * 16); acc_cb[ns] = __builtin_amdgcn_mfma_f32_16x16x32_bf16(af, bfv, acc_cb[ns], 0, 0, 0); } }
    __syncthreads();
    LAS unsigned char* GS = BG + wave * 16 * TLD;
    const int nks = (16 * wave + 15) / 32 + 1;
#pragma unroll
    for (int hh = 0; hh < 3; ++hh) {
#pragma unroll
        for (int ns = 0; ns < 8; ++ns) if (ns <= (wave | 1)) {
#pragma unroll
            for (int r = 0; r < 4; ++r) { const int l = 16 * wave + 4 * fq + r, sidx = 16 * ns + fr;
                const float gv = (ns <= wave && sidx <= l) ? acc_cb[ns][r] * __expf(acS[hh * 128 + l] - acS[hh * 128 + sidx]) * dtS[hh * 128 + sidx] : 0.f;
                *(LAS bf16*)(GS + (4 * fq + r) * TLD + sidx * 2) = (bf16)f2bf(gv); } }
        LDS_WAIT(); asm volatile("" ::: "memory");
#pragma unroll 1
        for (int ks = 0; ks < nks; ++ks) { const bf16x8_t af = lds_frag_p(GS, TLD, fr, ks * 64 + fq * 16);
#pragma unroll
            for (int np = 0; np < 4; ++np) { const bf16x8_t bfv = lds_frag_tr(PX, XP, ks * 32, hh * 64 + np * 16, lane); acc_y[hh * 4 + np] = __builtin_amdgcn_mfma_f32_16x16x32_bf16(af, bfv, acc_y[hh * 4 + np], 0, 0, 0); } }
        LDS_WAIT(); asm volatile("" ::: "memory");
    }
#if defined(SSDB_CUT) && SSDB_CUT == 1
    { float t_ = 0.f; for (int i = 0; i < 12; ++i) t_ += acc_y[i][0] + acc_y[i][1] + acc_y[i][2] + acc_y[i][3]; if (t_ == 123.f) MIXB[0] = 1; return; }
#endif
#pragma unroll
    for (int t = 0; t < 12; ++t) { const int hh = t >> 2, col = hh * 64 + (t & 3) * 16 + fr; const float dk = dsk[3 * g + hh];
#pragma unroll
        for (int r = 0; r < 4; ++r) { const int l = 16 * wave + 4 * fq + r; acc_y[t][r] += dk * __uint_as_float(((unsigned)*(const LAS bf16*)(PX + l * XP + col * 2)) << 16); } }
    __syncthreads();
    LAS bf16* ost = (LAS bf16*)(lds + wave * (16 * XP));
#pragma unroll
    for (int t = 0; t < 12; ++t) { const int col = (t >> 2) * 64 + (t & 3) * 16 + fr;
#pragma unroll
        for (int r = 0; r < 4; ++r) ost[(4 * fq + r) * (XP / 2) + col] = (bf16)f2bf(acc_y[t][r]); }
    LDS_WAIT(); asm volatile("" ::: "memory");
    { const int rr = lane >> 2, q = lane & 3; const long row = r0 + 16 * wave + rr;
      float yz[48]; float ssum = 0.f;
#pragma unroll
      for (int i = 0; i < 6; ++i) { const int c8 = (q * 6 + i) * 8;
          const fp::u32x4 yv = *(const LAS fp::u32x4*)(ost + rr * (XP / 2) + c8);
          const fp::u32x4 zv = *(const fp::u32x4*)(PROJ + row * PLD + FZ + 192 * g + c8);
#pragma unroll
          for (int j = 0; j < 4; ++j) { const unsigned yw = yv[j], zw = zv[j];
              const float y0 = __uint_as_float(yw << 16), y1 = __uint_as_float(yw & 0xffff0000u), z0 = __uint_as_float(zw << 16), z1 = __uint_as_float(zw & 0xffff0000u);
              const float a0 = y0 * (z0 * __builtin_amdgcn_rcpf(1.f + __expf(-z0))), a1 = y1 * (z1 * __builtin_amdgcn_rcpf(1.f + __expf(-z1))); yz[i * 8 + 2 * j] = a0; yz[i * 8 + 2 * j + 1] = a1; ssum += a0 * a0 + a1 * a1; } }
      ssum += __shfl_xor(ssum, 1); ssum += __shfl_xor(ssum, 2);
      const float rinv = rsqrtf(ssum * (1.f / 192.f) + 1e-5f);
#pragma unroll
      for (int i = 0; i < 6; ++i) { const int c8 = (q * 6 + i) * 8;
          const float4 g0 = *(const float4*)(ng + 192 * g + c8), g1 = *(const float4*)(ng + 192 * g + c8 + 4);
          fp::u32x4 o; o.x = fp::pk2(yz[i * 8] * rinv * g0.x, yz[i * 8 + 1] * rinv * g0.y); o.y = fp::pk2(yz[i * 8 + 2] * rinv * g0.z, yz[i * 8 + 3] * rinv * g0.w);
          o.z = fp::pk2(yz[i * 8 + 4] * rinv * g1.x, yz[i * 8 + 5] * rinv * g1.y); o.w = fp::pk2(yz[i * 8 + 6] * rinv * g1.z, yz[i * 8 + 7] * rinv * g1.w);
          *(fp::u32x4*)(MIXB + row * DM + ATT_W + 192 * g + c8) = o; } }
    __syncthreads();
}

__device__ __forceinline__ void att_norm_phase(bf16* MIXB, const float* g, long n_rows, int gw_, int ngw_, int lane) {
    float4 g0 = make_float4(0.f, 0.f, 0.f, 0.f), g1 = g0; if (lane < 48) { g0 = *(const float4*)(g + lane * 8); g1 = *(const float4*)(g + lane * 8 + 4); }
    fp::u32x4 wa = (fp::u32x4){0u, 0u, 0u, 0u}, wb = wa; long r = gw_;
    if (r < n_rows && lane < 48) wa = *(const fp::u32x4*)(MIXB + r * DM + lane * 8);
#define ATTN_NORM_ROW(WV_, rr) do { float v[8]; float s2 = 0.f; \
        _Pragma("unroll") for (int j = 0; j < 4; ++j) { v[2 * j] = __uint_as_float(WV_[j] << 16); v[2 * j + 1] = __uint_as_float(WV_[j] & 0xffff0000u); s2 += v[2 * j] * v[2 * j] + v[2 * j + 1] * v[2 * j + 1]; } \
        const float rs = rsqrtf(wave_sum(s2) * (1.f / 384.f) + 1e-5f); \
        if (lane < 48) { fp::u32x4 o; o.x = fp::pk2(v[0] * rs * g0.x, v[1] * rs * g0.y); o.y = fp::pk2(v[2] * rs * g0.z, v[3] * rs * g0.w); o.z = fp::pk2(v[4] * rs * g1.x, v[5] * rs * g1.y); o.w = fp::pk2(v[6] * rs * g1.z, v[7] * rs * g1.w); \
            *(fp::u32x4*)(MIXB + (rr) * DM + lane * 8) = o; } } while (0)
    for (; r < n_rows; r += 2 * ngw_) { const long r1 = r + ngw_, r2 = r + 2 * ngw_;
        if (r1 < n_rows && lane < 48) wb = *(const fp::u32x4*)(MIXB + r1 * DM + lane * 8);
        ATTN_NORM_ROW(wa, r);
        if (r2 < n_rows && lane < 48) wa = *(const fp::u32x4*)(MIXB + r2 * DM + lane * 8);
        if (r1 < n_rows) ATTN_NORM_ROW(wb, r1); }
#undef ATTN_NORM_ROW
}

constexpr int FT_G = (DM / 128) * (N_EXP * NGUE / 32) / 8, FT_D = (D_FFE / 128) * (N_EXP * DM / 32) / 8;
constexpr int FT_G_A = 704, FT_G_B = 384, FT_D_A = 256, FT_D_D = 384;
__device__ __forceinline__ void filler_g(int t, const float* p_mg, const float* p_mu, f8_t* MWGU_, LAS float* scr, int wave, int lane_) {
    asm volatile("" : "+v"(lane_));
    const int r = t * 8 + wave; const int kb = r / (N_EXP * NGUE / 32), db = r % (N_EXP * NGUE / 32); const int d = db * 32 + (lane_ & 31), e = d / NGUE;
    fp::conv_item8(fp::gu_src(p_mg + (size_t)e * DM * D_FFE, p_mu + (size_t)e * DM * D_FFE, D_FFE, d - e * NGUE), DM, MWGU_, (long)db * 32, kb * 128, W8_GU, scr, lane_);
}
__device__ __forceinline__ void filler_d(int t, const float* p_md, f8_t* MWD_, LAS float* scr, int wave, int lane_) {
    asm volatile("" : "+v"(lane_));
    const int r = t * 8 + wave; const int kb = r / (N_EXP * DM / 32), db = r % (N_EXP * DM / 32); const int d = db * 32 + (lane_ & 31), e = d / DM;
    fp::SrcCol sc_; sc_.p = p_md + (size_t)e * D_FFE * DM + (d - e * DM); sc_.ld = DM; fp::conv_item8(sc_, D_FFE, MWD_, (long)db * 32, kb * 128, W8_D, scr, lane_);
}

__device__ __forceinline__ uint2 bf8_to_f8(const uint4 v) {
    uint2 o; o.x = fp::pk4_f8(__uint_as_float(v.x << 16), __uint_as_float(v.x & 0xffff0000u), __uint_as_float(v.y << 16), __uint_as_float(v.y & 0xffff0000u));
    o.y = fp::pk4_f8(__uint_as_float(v.z << 16), __uint_as_float(v.z & 0xffff0000u), __uint_as_float(v.w << 16), __uint_as_float(v.w & 0xffff0000u)); return o;
}
struct FArgs { const void* in[29]; float* out; unsigned char* ws; int ph_lo, ph_hi; };
__device__ __forceinline__ const void* ldarg(int k) { const void* p; asm volatile("s_load_dwordx2 %0, %1, %2\n\ts_waitcnt lgkmcnt(0)" : "=s"(p) : "s"(__builtin_amdgcn_kernarg_segment_ptr()), "i"(k * 8)); return p; }

constexpr int N_PHASES = 18;
__global__ void __launch_bounds__(512, 2) mega(FArgs a) {
    extern __shared__ __attribute__((aligned(16))) unsigned char lds_[];
    LAS unsigned char* lds = (LAS unsigned char*)lds_;
    const int wave = __builtin_amdgcn_readfirstlane((int)threadIdx.x >> 6);
#define lane ((int)__builtin_amdgcn_mbcnt_hi(~0u, __builtin_amdgcn_mbcnt_lo(~0u, 0u)))
#define tid (wave * 64 + lane)
    const int G = gridDim.x; const int bx = blockIdx.x;
#define vcu (((int)gridDim.x % 8 == 0) ? ((int)blockIdx.x % 8) * ((int)gridDim.x / 8) + (int)blockIdx.x / 8 : (int)blockIdx.x)
#define gw (vcu * 8 + wave)
#define ngw ((int)gridDim.x * 8)
#define gt ((long)gw * 64 + lane)
#define ngt ((long)ngw * 64)
    unsigned char* ws = a.ws;
    unsigned* ctl = (unsigned*)(ws + O_CTL);
    for (int u = (int)threadIdx.x; u < (LDS_BYTES - RING_BYTES) / 4; u += 512) ((LAS unsigned*)(lds + RING_BYTES))[u] = 0u;
    __syncthreads();
    const int lo = a.ph_lo, hi = a.ph_hi;
    XcdBarrier bar; bar.bar = ctl + CW_BAR; bar.x = 0; bar.st = nullptr; bar.w0 = 0;
    if (hi - lo > 1) bar = xcd_barrier_post(ctl + CW_BAR, (volatile LAS unsigned*)(lds + MISC_OFF) + 8);
#define in_x ((const float*)ldarg(0))
#define in_pos ((const int*)ldarg(1))
#define ln_in_g ((const float*)ldarg(2))
#define ln_in_b ((const float*)ldarg(3))
#define w_in ((const float*)ldarg(4))
#define conv_w ((const float*)ldarg(5))
#define conv_b ((const float*)ldarg(6))
#define dt_bias ((const float*)ldarg(7))
#define a_log ((const float*)ldarg(8))
#define d_skip ((const float*)ldarg(9))
#define ssd_norm_g ((const float*)ldarg(10))
#define att_norm_g ((const float*)ldarg(11))
#define gm_ln_g ((const float*)ldarg(12))
#define gm_ln_b ((const float*)ldarg(13))
#define gm_w_s ((const float*)ldarg(14))
#define gm_b_s ((const float*)ldarg(15))
#define gm_norm_g ((const float*)ldarg(16))
#define w_out ((const float*)ldarg(17))
#define ln1_g ((const float*)ldarg(18))
#define ln1_b ((const float*)ldarg(19))
#define ln2_g ((const float*)ldarg(20))
#define ln2_b ((const float*)ldarg(21))
#define ffn_w_gate ((const float*)ldarg(22))
#define ffn_w_up ((const float*)ldarg(23))
#define ffn_w_down ((const float*)ldarg(24))
#define router_w ((const float*)ldarg(25))
#define moe_w_gate ((const float*)ldarg(26))
#define moe_w_up ((const float*)ldarg(27))
#define moe_w_down ((const float*)ldarg(28))
#define H ((float*)WOUTP)
#define MWD ((f8_t*)WOUTP)
#define RT ((float*)(WSP + O_RT))
#define TE ((int*)(WSP + O_TE))
#define TP ((float*)(WSP + O_TP))
#define TS ((int*)(WSP + O_TS))
#define GS ((int*)(WSP + O_GS))
#define SP ((float*)(WSP + O_SP))
#define KM ((float*)(WSP + O_KM))
#define WSB ((bf16*)(WSP + O_WSB))
#define HB ((bf16*)(WSP + O_HB))
#define MWGU ((f8_t*)(WSP + O_MWGU))
#define WIN ((bf16*)(WSP + O_WIN))
#define WOUT ((bf16*)(WSP + O_WOUT))
#define WGU ((f8_t*)(WSP + O_WGU))
#define WD ((f8_t*)(WSP + O_WD))
#define PROJ ((bf16*)(WSP + O_PROJ))
#define ST ((float*)(WSP + O_XC))
#define CD ((float*)(WSP + O_DT))
#define XCB ((bf16*)(WSP + O_MIXU))
#define DTG ((float*)(WSP + O_VN))
#define MIXB ((bf16*)(WSP + O_MIXB))
#define YB ((bf16*)(WSP + O_Y))
#define ACT ((f8_t*)(WSP + O_ACT))
#define H8 ((f8_t*)(WSP + O_ACT + (size_t)M_ * D_FF))
#define XG ((f8_t*)(WSP + O_XG))
#define F2 ((bf16*)(WSP + O_XG))
#define ACTM ((f8_t*)(WSP + O_ACTM))
#define F2P ((bf16*)(WSP + O_MWGU))
#define CNT ((int*)(WSP + O_CTL + 4 * CW_CNT))
    const ProjL FL{PLD, FQ, FK, FV, FZ, FXBC, FDT, FGU, FGV};
    LAS float* scr = (LAS float*)(lds + wave * 16384);

#ifndef PH_MASK
#define PH_MASK 0xffffffffu
#endif
#ifndef PROBE_MASK
#define PROBE_MASK 0u
#endif
#ifndef PROBE_AMP
#define PROBE_AMP 0
#endif
    volatile unsigned* pr_w = (volatile unsigned*)(ctl + 1100);
#define pr_me ((PROBE_MASK != 0u) && blockIdx.x == 0 && wave == 0 && __builtin_amdgcn_mbcnt_hi(~0u, __builtin_amdgcn_mbcnt_lo(~0u, 0u)) == 0u)
#define PH_BEGIN(k) if (lo <= (k) && (k) < hi && ((PH_MASK >> (k)) & 1u)) { unsigned char* WSP = a.ws; unsigned char* WOUTP = (unsigned char*)a.out; asm volatile("" : "+s"(WSP), "+s"(WOUTP)); if (((PROBE_MASK >> (k)) & 1u) && pr_me) pr_w[0] = (unsigned)__builtin_amdgcn_s_memrealtime();
#define PH_END(k)   if ((k) + 1 < hi) xcd_barrier(bar); if (((PROBE_MASK >> (k)) & 1u) && pr_me) pr_w[1] += (unsigned)__builtin_amdgcn_s_memrealtime() - pr_w[0]; }

    PH_BEGIN(0)
    { const float* const p_w_in = w_in; const float* const p_w_out = w_out; const float* const p_fg = ffn_w_gate; const float* const p_fu = ffn_w_up; const float* const p_fd = ffn_w_down;
        constexpr int I_WIN = 16 * (PLD / 32), I_WOUT = 16 * (DM / 32), I_WGU = (DM / 128) * (NGU / 32), I_WD = (D_FF / 128) * (DM / 32), I_MWGU = 16 * (N_EXP * NGUE / 32);
        constexpr int NIT = 2 * I_WIN + 2 * I_WOUT + I_WGU + I_WD; (void)I_MWGU;
        for (int it = gw; it < NIT; it += ngw) {
            int r = it; const int l5 = lane & 31;
            if (r < 2 * I_WIN) { const int L = r / I_WIN; r -= L * I_WIN; const int kb = r / (PLD / 32), db = r % (PLD / 32); const int sc_ = fp::win_src_col(db * 32 + l5);
                fp::SrcCol s; s.p = sc_ >= 0 ? p_w_in + (size_t)L * DM * D_IN + sc_ : nullptr; s.ld = D_IN; fp::conv_item(s, DM, WIN + (size_t)L * PLD * DM, db * 32, kb * 64, scr, lane); continue; } r -= 2 * I_WIN;
            if (r < 2 * I_WOUT) { const int L = r / I_WOUT; r -= L * I_WOUT; const int kb = r / (DM / 32), db = r % (DM / 32);
                fp::SrcCol s; s.p = p_w_out + (size_t)L * DM * DM + db * 32 + l5; s.ld = DM; fp::conv_item(s, DM, WOUT + (size_t)L * DM * DM, db * 32, kb * 64, scr, lane); continue; } r -= 2 * I_WOUT;
            if (r < I_WGU) { const int kb = r / (NGU / 32), db = r % (NGU / 32);
                fp::conv_item8(fp::gu_src(p_fg, p_fu, D_FF, db * 32 + l5), DM, WGU, db * 32, kb * 128, W8_GU, scr, lane); continue; } r -= I_WGU;
            { const int kb = r / (DM / 32), db = r % (DM / 32);
                fp::SrcCol s; s.p = p_fd + db * 32 + l5; s.ld = DM; fp::conv_item8(s, D_FF, WD, db * 32, kb * 128, W8_D, scr, lane); }
        }
        const int* const p_pos = in_pos; const float* const p_gws = gm_w_s; const float* const p_x = in_x; const float* const p_lg = ln_in_g; const float* const p_lb = ln_in_b;
        for (long it = gt; it < (long)M_ * 8; it += ngt) { const int i = (int)(it & 7); const long row = it >> 3;
            const float inv = powf(500000.0f, -(float)(2 * i) / 16.0f); const float ang = (float)p_pos[row] * inv; RT[row * 16 + i] = cosf(ang); RT[row * 16 + 8 + i] = sinf(ang); }
        for (long it = gt; it < 2L * GM_G * GM_CHUNK * GM_CHUNK; it += ngt) { const int sidx = (int)(it & 127), t = (int)((it >> 7) & 127); WSB[it] = (bf16)(sidx <= t ? f2bf(p_gws[it]) : 0u); }
        { float va[16], vb[16]; LnGB gbp; ln_gb_load(gbp, p_lg, p_lb, lane); long r = gw; if (r < M_) ln_load<float, float, true>(va, p_x + r * DM, 1.f, nullptr, nullptr, lane);
          for (; r < M_; r += 2 * ngw) { const long r1 = r + ngw, r2 = r + 2 * ngw;
              if (r1 < M_) ln_load<float, float, true>(vb, p_x + r1 * DM, 1.f, nullptr, nullptr, lane);
              ln_finish_r(va, gbp, nullptr, HB + r * DM, lane);
              if (r2 < M_) ln_load<float, float, true>(va, p_x + r2 * DM, 1.f, nullptr, nullptr, lane);
              if (r1 < M_) ln_finish_r(vb, gbp, nullptr, HB + r1 * DM, lane); } }
    }
    PH_END(0)


    { constexpr int layer = 0; constexpr int PB = 1;
        PH_BEGIN(PB + 0)
        { pg8::Gemm g{HB, WIN + (size_t)layer * PLD * DM, M_, PLD, DM, DM}; pg8::StaticOrder S; S.init(M_, PLD, G, bx);
          fp::EpiProj E{PROJ, RT, KM}; pg8::gemm_phase<fp::EpiProj, pg8::StaticOrder, true, true>(lds, g, S, E, tid); }
        PH_END(PB + 0)
        PH_BEGIN(PB + 1)
        { constexpr int NATT = NB * ATT_H * NBLK, NSSDA = NB * 32;
          volatile LAS unsigned* qw = (volatile LAS unsigned*)(lds + MISC_OFF) + 16;
#define QNEXT(word) do { if (tid == 0) qw[0] = __hip_atomic_fetch_add(ctl + (word), 1u, __ATOMIC_RELAXED, __HIP_MEMORY_SCOPE_AGENT); __syncthreads(); idx = (int)qw[0]; __syncthreads(); } while (0)
          int idx;
          for (;;) { QNEXT(CW_Q + 8 * layer); if (idx >= NATT) break;
              const int qb = (NBLK - 1) - idx / (NB * ATT_H), bh = idx % (NB * ATT_H);
              attn_body::attn_unit<8>(bh / ATT_H, bh % ATT_H, qb, (const attn_body::bf16*)(PROJ + FQ), (const attn_body::bf16*)(PROJ + FK), (const attn_body::bf16*)(PROJ + FV), (attn_body::bf16*)MIXB, KM, NB * ATT_H * NBLK * 64, (char*)lds_, tid); }
          for (;;) { QNEXT(CW_Q + 8 * layer + 1); if (idx >= NSSDA) break;
              ssdA_unit(idx >> 5, (idx >> 1) & 15, idx & 1, PROJ, conv_w + (size_t)layer * 4 * SSD_CW, conv_b + layer * SSD_CW, dt_bias + layer * SSD_H, a_log + layer * SSD_H, ST, CD, XCB, DTG, lds, tid, wave, lane); }
        }
        PH_END(PB + 1)
        PH_BEGIN(PB + 2)
        { constexpr int NSSDB = NB * 32, NGMU = NB * (SEQ / GM_CHUNK);
          volatile LAS unsigned* qw = (volatile LAS unsigned*)(lds + MISC_OFF) + 16;
          int idx;
          for (;;) { QNEXT(CW_Q + 8 * layer + 2); if (idx >= NSSDB) break;
              const int c = 15 - idx / (NB * 2), bg = idx % (NB * 2);
              ssdB_unit(bg >> 1, c, bg & 1, PROJ, XCB, DTG, d_skip + layer * SSD_H, ssd_norm_g + layer * SSD_W, ST, CD, MIXB, lds, tid, wave, lane); }
          for (;;) { QNEXT(CW_Q + 8 * layer + 3); if (idx >= NGMU) break;
              gm_unit(idx / (SEQ / GM_CHUNK), idx % (SEQ / GM_CHUNK), PROJ, WSB + (size_t)layer * GM_G * GM_CHUNK * GM_CHUNK, gm_ln_g + layer * GM_W, gm_ln_b + layer * GM_W,
                      gm_b_s + layer * GM_G * GM_CHUNK, gm_norm_g + layer * GM_W, MIXB, lds, wave, lane); }
          att_norm_phase(MIXB, att_norm_g + layer * ATT_W, M_, gw, ngw, lane);
          { const float* const p_mg = moe_w_gate; const float* const p_mu = moe_w_up; const float* const p_md = moe_w_down;
            constexpr int g0 = layer == 0 ? 0 : FT_G_A + FT_G_B, g1 = layer == 0 ? FT_G_A : FT_G, d0 = layer == 0 ? 0 : FT_D_A, d1 = layer == 0 ? FT_D_A : FT_D - FT_D_D;
            for (;;) { QNEXT(CW_Q + 8 * layer + 4); if (idx >= g1 - g0) break; filler_g(g0 + idx, p_mg, p_mu, MWGU, scr, wave, lane); }
            for (;;) { QNEXT(CW_Q + 8 * layer + 5); if (idx >= d1 - d0) break; filler_d(d0 + idx, p_md, MWD, scr, wave, lane); } }
#undef QNEXT
        }
        PH_END(PB + 2)
        PH_BEGIN(PB + 3)
        { pg8::Gemm g{MIXB, WOUT + (size_t)layer * DM * DM, M_, DM, DM, DM}; pg8::StaticOrder S; S.init(M_, DM, G, bx);
          fp::EpiY E{YB, DM}; pg8::gemm_phase<fp::EpiY, pg8::StaticOrder, false, true>(lds, g, S, E, tid); }
        PH_END(PB + 3)
        PH_BEGIN(PB + 4)
        { const float* const p_g = ln1_g + layer * DM; const float* const p_b = ln1_b + layer * DM;
          { float va[16], vb[16]; LnGB gbp; ln_gb_load(gbp, p_g, p_b, lane); long r = gw; if (r < M_) ln_load<bf16, bf16>(va, HB + r * DM, ALPHA, YB + r * DM, nullptr, lane);
            for (; r < M_; r += 2 * ngw) { const long r1 = r + ngw, r2 = r + 2 * ngw;
                if (r1 < M_) ln_load<bf16, bf16>(vb, HB + r1 * DM, ALPHA, YB + r1 * DM, nullptr, lane);
                ln_finish_r(va, gbp, nullptr, HB + r * DM, lane, layer == 0 ? H8 + r * DM : nullptr);
                if (r2 < M_) ln_load<bf16, bf16>(va, HB + r2 * DM, ALPHA, YB + r2 * DM, nullptr, lane);
                if (r1 < M_) ln_finish_r(vb, gbp, nullptr, HB + r1 * DM, lane, layer == 0 ? H8 + r1 * DM : nullptr); } }
          if (layer == 1) { asm volatile("s_waitcnt vmcnt(0)" ::: "memory"); moe_route_block(HB, router_w, CNT, TE, TP, TS, M_, gw, ngw, lane, wave, tid, (LAS int*)lds); } }
        PH_END(PB + 4)
        if constexpr (layer == 0) {
            PH_BEGIN(PB + 5)
            { pg8::Gemm g{(const pg8::bf16_t*)H8, (const pg8::bf16_t*)WGU, M_, NGU, DM / 2, DM / 2}; pg8::StaticOrder S; S.init(M_, NGU, G, bx);
              fp::EpiAct8 E{ACT, D_FF, NGU / 256}; pg8::gemm_phase<fp::EpiAct8, pg8::StaticOrder, true, true, true>(lds, g, S, E, tid);
              { constexpr int UNITS = (NB * SEQ / 256) * (NGU / 256), REM = UNITS % 256;
                if (REM != 0 && G == 256 && bx >= REM) { constexpr int PER = (FT_G_B + (256 - REM) - 1) / (256 - REM); const float* const p_mg = moe_w_gate; const float* const p_mu = moe_w_up;
                    for (int k = 0; k < PER; ++k) { const int t = (bx - REM) * PER + k; if (t < FT_G_B) filler_g(FT_G_A + t, p_mg, p_mu, MWGU, scr, wave, lane); } }
                else if (REM == 0 || G != 256) { const float* const p_mg = moe_w_gate; const float* const p_mu = moe_w_up; for (int t = bx; t < FT_G_B; t += G) filler_g(FT_G_A + t, p_mg, p_mu, MWGU, scr, wave, lane); } } }
            PH_END(PB + 5)
            PH_BEGIN(PB + 6)
            { pg8::Gemm g{(const pg8::bf16_t*)ACT, (const pg8::bf16_t*)WD, M_, DM, D_FF / 2, D_FF / 2}; pg8::StaticOrder S; S.init(M_, DM, G, bx);
              fp::EpiY8 E{YB, DM}; pg8::gemm_phase<fp::EpiY8, pg8::StaticOrder, false, true, true>(lds, g, S, E, tid); }
            PH_END(PB + 6)
            PH_BEGIN(PB + 7)
            { const float* const p_g = ln2_g + layer * DM; const float* const p_b = ln2_b + layer * DM;
              { float va[16], vb[16]; LnGB gbp; ln_gb_load(gbp, p_g, p_b, lane); long r = gw; if (r < M_) ln_load<bf16, bf16>(va, HB + r * DM, ALPHA, YB + r * DM, nullptr, lane);
            for (; r < M_; r += 2 * ngw) { const long r1 = r + ngw, r2 = r + 2 * ngw;
                if (r1 < M_) ln_load<bf16, bf16>(vb, HB + r1 * DM, ALPHA, YB + r1 * DM, nullptr, lane);
                ln_finish_r(va, gbp, nullptr, HB + r * DM, lane);
                if (r2 < M_) ln_load<bf16, bf16>(va, HB + r2 * DM, ALPHA, YB + r2 * DM, nullptr, lane);
                if (r1 < M_) ln_finish_r(vb, gbp, nullptr, HB + r1 * DM, lane); } } }
            PH_END(PB + 7)
        } else {
            PH_BEGIN(PB + 5)
            { int base[N_EXP]; { int b_ = 0;
#pragma unroll
                  for (int e = 0; e < N_EXP; ++e) { base[e] = b_; b_ += (CNT[e] + 255) & ~255; } }
              constexpr int RPW = (M_ + 2047) / 2048;
              int te[RPW][2], tsl[RPW][2]; float tpv[RPW][2];
#pragma unroll
              for (int k = 0; k < RPW; ++k) { const long r = gw + (long)k * ngw;
#pragma unroll
                  for (int q = 0; q < 2; ++q) { te[k][q] = 0; tsl[k][q] = 0; tpv[k][q] = 0.f; if (r < M_) { te[k][q] = TE[r * 2 + q]; tsl[k][q] = TS[r * 2 + q]; tpv[k][q] = TP[r * 2 + q]; } } }
#pragma unroll
              for (int k = 0; k < RPW; ++k) { const long r = gw + (long)k * ngw; if (r < M_) {
                  const uint4* src = (const uint4*)(HB + r * DM); const uint2 v0 = bf8_to_f8(src[lane]), v1 = bf8_to_f8(src[lane + 64]);
#pragma unroll
                  for (int q = 0; q < 2; ++q) { int be = 0;
#pragma unroll
                      for (int x = 0; x < N_EXP; ++x) be = (te[k][q] == x) ? base[x] : be;
                      const int gs = be + tsl[k][q];
                      if (lane == 0) { SP[gs] = tpv[k][q]; GS[r * 2 + q] = gs; }
                      uint2* dst = (uint2*)(XG + (size_t)gs * DM); dst[lane] = v0; dst[lane + 64] = v1; } } }
              for (long r = gw + (long)RPW * ngw; r < M_; r += ngw) {
                  const uint4* src = (const uint4*)(HB + r * DM); const uint2 v0 = bf8_to_f8(src[lane]), v1 = bf8_to_f8(src[lane + 64]);
                  for (int q = 0; q < 2; ++q) { const long it = r * 2 + q; const int e = TE[it]; int be = 0;
#pragma unroll
                      for (int x = 0; x < N_EXP; ++x) be = (e == x) ? base[x] : be;
                      const int gs = be + TS[it];
                      if (lane == 0) { SP[gs] = TP[it]; GS[it] = gs; }
                      uint2* dst = (uint2*)(XG + (size_t)gs * DM); dst[lane] = v0; dst[lane + 64] = v1; } }
              for (int it = gw; it < N_EXP * 256; it += ngw) { const int e = it >> 8, r = it & 255; const int c = CNT[e]; const int slot = moe_base(CNT, e) + c + r;
                  if (c + r < ((c + 255) & ~255)) { uint2* dst = (uint2*)(XG + (size_t)slot * DM); const uint2 z = make_uint2(0u, 0u); dst[lane] = z; dst[lane + 64] = z; if (lane == 0) SP[slot] = 0.f; } } }
            PH_END(PB + 5)
            PH_BEGIN(PB + 6)
            { pg8::Gemm g{(const pg8::bf16_t*)XG, (const pg8::bf16_t*)MWGU, NSLOT, N_EXP * NGUE, DM / 2, DM / 2}; fp::MoeOrder S; S.init(CNT, NGUE / 256, G, bx);
              fp::EpiAct8 E{ACTM, D_FFE, NGUE / 256}; pg8::gemm_phase<fp::EpiAct8, fp::MoeOrder, true, true, true>(lds, g, S, E, tid);
              { const int rem = (S.T * S.ncol) % G; const int nidle = rem == 0 ? G : G - rem, first = rem == 0 ? 0 : rem;
                if (bx >= first) { const int per = (FT_D_D + nidle - 1) / nidle; const float* const p_md = moe_w_down;
                    for (int k = 0; k < per; ++k) { const int t = (bx - first) * per + k; if (t < FT_D_D) filler_d(FT_D - FT_D_D + t, p_md, MWD, scr, wave, lane); } } } }
            PH_END(PB + 6)
            PH_BEGIN(PB + 7)
            { fp::MoeOrder S; S.init(CNT, DM / 256, G, bx); const int nf = S.tail_start(); const int slot0 = (nf / (DM / 256)) * 256;
              constexpr int KU = D_FFE / 2, KLEN = KU / MOE_KSPLIT;
              static_assert(KLEN % 128 == 0, "split-K parts must hold an even number of K-tiles");
              fp::EpiF2 E{F2, SP, F2P, slot0, KLEN, 1.f / W8_D};
              { pg8::Gemm g{(const pg8::bf16_t*)ACTM, (const pg8::bf16_t*)MWD, NSLOT, N_EXP * DM, KU, KU}; S.nfull = nf; S.ksplit = 1;
                pg8::gemm_phase<fp::EpiF2, fp::MoeOrder, true, true, true>(lds, g, S, E, wave * 64 + (int)xb_lane_fresh()); }
              { pg8::Gemm g{(const pg8::bf16_t*)ACTM, (const pg8::bf16_t*)MWD, NSLOT, N_EXP * DM, KLEN, KU}; S.ksplit = MOE_KSPLIT; S.klen = KLEN;
                int tid2 = wave * 64 + (int)xb_lane_fresh();
                pg8::gemm_phase<fp::EpiF2, fp::MoeOrder, true, true, true>(lds, g, S, E, tid2); } }
            PH_END(PB + 7)
            PH_BEGIN(PB + 8)
            { const float* const p_g = ln2_g + layer * DM; const float* const p_b = ln2_b + layer * DM;
              int slot0; { fp::MoeOrder S; S.init(CNT, DM / 256, G, bx); const int nf = S.tail_start(); slot0 = (nf == S.T * (DM / 256)) ? 0x7fffffff : (nf / (DM / 256)) * 256; }
#define LN2_LOAD(v, rr, kk_) do { int s0_ = GS[(rr) * 2], s1_ = GS[(rr) * 2 + 1]; if (kk_ < RPW2) { _Pragma("unroll") for (int x_ = 0; x_ < RPW2; ++x_) if (x_ == kk_) { s0_ = gsv[x_][0]; s1_ = gsv[x_][1]; } } ln_load<bf16, bf16>(v, HB + (rr) * DM, ALPHA, F2 + (size_t)s0_ * DM, F2 + (size_t)s1_ * DM, lane); \
                  if (s0_ >= slot0) { _Pragma("unroll") for (int p_ = 0; p_ < MOE_KSPLIT - 1; ++p_) ln_add(v, F2P + ((size_t)p_ * TAIL_SLOTS + (s0_ - slot0)) * DM, lane); } \
                  if (s1_ >= slot0) { _Pragma("unroll") for (int p_ = 0; p_ < MOE_KSPLIT - 1; ++p_) ln_add(v, F2P + ((size_t)p_ * TAIL_SLOTS + (s1_ - slot0)) * DM, lane); } } while (0)
              constexpr int RPW2 = (M_ + 2047) / 2048; int gsv[RPW2][2];
#pragma unroll
              for (int x_ = 0; x_ < RPW2; ++x_) { const long rr_ = gw + (long)x_ * ngw; gsv[x_][0] = 0; gsv[x_][1] = 0; if (rr_ < M_) { gsv[x_][0] = GS[rr_ * 2]; gsv[x_][1] = GS[rr_ * 2 + 1]; } }
              { float va[16], vb[16]; LnGB gbp; ln_gb_load(gbp, p_g, p_b, lane); long r = gw; int kq = 0; if (r < M_) LN2_LOAD(va, r, kq);
                for (; r < M_; r += 2 * ngw, kq += 2) { const long r1 = r + ngw, r2 = r + 2 * ngw;
                    if (r1 < M_) LN2_LOAD(vb, r1, kq + 1);
                    ln_finish_r(va, gbp, H + r * DM, nullptr, lane);
                    if (r2 < M_) LN2_LOAD(va, r2, kq + 2);
                    if (r1 < M_) ln_finish_r(vb, gbp, H + r1 * DM, nullptr, lane); } }
#undef LN2_LOAD
            }
            PH_END(PB + 8)
        }
    }

    { constexpr int layer = 1; constexpr int PB = 9;
        PH_BEGIN(PB + 0)
        { pg8::Gemm g{HB, WIN + (size_t)layer * PLD * DM, M_, PLD, DM, DM}; pg8::StaticOrder S; S.init(M_, PLD, G, bx);
          fp::EpiProj E{PROJ, RT, KM}; pg8::gemm_phase<fp::EpiProj, pg8::StaticOrder, true, true>(lds, g, S, E, tid); }
        PH_END(PB + 0)
        PH_BEGIN(PB + 1)
        { constexpr int NATT = NB * ATT_H * NBLK, NSSDA = NB * 32;
          volatile LAS unsigned* qw = (volatile LAS unsigned*)(lds + MISC_OFF) + 16;
#define QNEXT(word) do { if (tid == 0) qw[0] = __hip_atomic_fetch_add(ctl + (word), 1u, __ATOMIC_RELAXED, __HIP_MEMORY_SCOPE_AGENT); __syncthreads(); idx = (int)qw[0]; __syncthreads(); } while (0)
          int idx;
          for (;;) { QNEXT(CW_Q + 8 * layer); if (idx >= NATT) break;
              const int qb = (NBLK - 1) - idx / (NB * ATT_H), bh = idx % (NB * ATT_H);
              attn_body::attn_unit<8>(bh / ATT_H, bh % ATT_H, qb, (const attn_body::bf16*)(PROJ + FQ), (const attn_body::bf16*)(PROJ + FK), (const attn_body::bf16*)(PROJ + FV), (attn_body::bf16*)MIXB, KM, NB * ATT_H * NBLK * 64, (char*)lds_, tid); }
          for (;;) { QNEXT(CW_Q + 8 * layer + 1); if (idx >= NSSDA) break;
              ssdA_unit(idx >> 5, (idx >> 1) & 15, idx & 1, PROJ, conv_w + (size_t)layer * 4 * SSD_CW, conv_b + layer * SSD_CW, dt_bias + layer * SSD_H, a_log + layer * SSD_H, ST, CD, XCB, DTG, lds, tid, wave, lane); }
        }
        PH_END(PB + 1)
        PH_BEGIN(PB + 2)
        { constexpr int NSSDB = NB * 32, NGMU = NB * (SEQ / GM_CHUNK);
          volatile LAS unsigned* qw = (volatile LAS unsigned*)(lds + MISC_OFF) + 16;
          int idx;
          for (;;) { QNEXT(CW_Q + 8 * layer + 2); if (idx >= NSSDB) break;
              const int c = 15 - idx / (NB * 2), bg = idx % (NB * 2);
              ssdB_unit(bg >> 1, c, bg & 1, PROJ, XCB, DTG, d_skip + layer * SSD_H, ssd_norm_g + layer * SSD_W, ST, CD, MIXB, lds, tid, wave, lane); }
          for (;;) { QNEXT(CW_Q + 8 * layer + 3); if (idx >= NGMU) break;
              gm_unit(idx / (SEQ / GM_CHUNK), idx % (SEQ / GM_CHUNK), PROJ, WSB + (size_t)layer * GM_G * GM_CHUNK * GM_CHUNK, gm_ln_g + layer * GM_W, gm_ln_b + layer * GM_W,
                      gm_b_s + layer * GM_G * GM_CHUNK, gm_norm_g + layer * GM_W, MIXB, lds, wave, lane); }
          att_norm_phase(MIXB, att_norm_g + layer * ATT_W, M_, gw, ngw, lane);
          { const float* const p_mg = moe_w_gate; const float* const p_mu = moe_w_up; const float* const p_md = moe_w_down;
            constexpr int g0 = layer == 0 ? 0 : FT_G_A + FT_G_B, g1 = layer == 0 ? FT_G_A : FT_G, d0 = layer == 0 ? 0 : FT_D_A, d1 = layer == 0 ? FT_D_A : FT_D - FT_D_D;
            for (;;) { QNEXT(CW_Q + 8 * layer + 4); if (idx >= g1 - g0) break; filler_g(g0 + idx, p_mg, p_mu, MWGU, scr, wave, lane); }
            for (;;) { QNEXT(CW_Q + 8 * layer + 5); if (idx >= d1 - d0) break; filler_d(d0 + idx, p_md, MWD, scr, wave, lane); } }
#undef QNEXT
        }
        PH_END(PB + 2)
        PH_BEGIN(PB + 3)
        { pg8::Gemm g{MIXB, WOUT + (size_t)layer * DM * DM, M_, DM, DM, DM}; pg8::StaticOrder S; S.init(M_, DM, G, bx);
          fp::EpiY E{YB, DM}; pg8::gemm_phase<fp::EpiY, pg8::StaticOrder, false, true>(lds, g, S, E, tid); }
        PH_END(PB + 3)
        PH_BEGIN(PB + 4)
        { const float* const p_g = ln1_g + layer * DM; const float* const p_b = ln1_b + layer * DM;
          { float va[16], vb[16]; LnGB gbp; ln_gb_load(gbp, p_g, p_b, lane); long r = gw; if (r < M_) ln_load<bf16, bf16>(va, HB + r * DM, ALPHA, YB + r * DM, nullptr, lane);
            for (; r < M_; r += 2 * ngw) { const long r1 = r + ngw, r2 = r + 2 * ngw;
                if (r1 < M_) ln_load<bf16, bf16>(vb, HB + r1 * DM, ALPHA, YB + r1 * DM, nullptr, lane);
                ln_finish_r(va, gbp, nullptr, HB + r * DM, lane, layer == 0 ? H8 + r * DM : nullptr);
                if (r2 < M_) ln_load<bf16, bf16>(va, HB + r2 * DM, ALPHA, YB + r2 * DM, nullptr, lane);
                if (r1 < M_) ln_finish_r(vb, gbp, nullptr, HB + r1 * DM, lane, layer == 0 ? H8 + r1 * DM : nullptr); } }
          if (layer == 1) { asm volatile("s_waitcnt vmcnt(0)" ::: "memory"); moe_route_block(HB, router_w, CNT, TE, TP, TS, M_, gw, ngw, lane, wave, tid, (LAS int*)lds); } }
        PH_END(PB + 4)
        if constexpr (layer == 0) {
            PH_BEGIN(PB + 5)
            { pg8::Gemm g{(const pg8::bf16_t*)H8, (const pg8::bf16_t*)WGU, M_, NGU, DM / 2, DM / 2}; pg8::StaticOrder S; S.init(M_, NGU, G, bx);
              fp::EpiAct8 E{ACT, D_FF, NGU / 256}; pg8::gemm_phase<fp::EpiAct8, pg8::StaticOrder, true, true, true>(lds, g, S, E, tid);
              { constexpr int UNITS = (NB * SEQ / 256) * (NGU / 256), REM = UNITS % 256;
                if (REM != 0 && G == 256 && bx >= REM) { constexpr int PER = (FT_G_B + (256 - REM) - 1) / (256 - REM); const float* const p_mg = moe_w_gate; const float* const p_mu = moe_w_up;
                    for (int k = 0; k < PER; ++k) { const int t = (bx - REM) * PER + k; if (t < FT_G_B) filler_g(FT_G_A + t, p_mg, p_mu, MWGU, scr, wave, lane); } }
                else if (REM == 0 || G != 256) { const float* const p_mg = moe_w_gate; const float* const p_mu = moe_w_up; for (int t = bx; t < FT_G_B; t += G) filler_g(FT_G_A + t, p_mg, p_mu, MWGU, scr, wave, lane); } } }
            PH_END(PB + 5)
            PH_BEGIN(PB + 6)
            { pg8::Gemm g{(const pg8::bf16_t*)ACT, (const pg8::bf16_t*)WD, M_, DM, D_FF / 2, D_FF / 2}; pg8::StaticOrder S; S.init(M_, DM, G, bx);
              fp::EpiY8 E{YB, DM}; pg8::gemm_phase<fp::EpiY8, pg8::StaticOrder, false, true, true>(lds, g, S, E, tid); }
            PH_END(PB + 6)
            PH_BEGIN(PB + 7)
            { const float* const p_g = ln2_g + layer * DM; const float* const p_b = ln2_b + layer * DM;
              { float va[16], vb[16]; LnGB gbp; ln_gb_load(gbp, p_g, p_b, lane); long r = gw; if (r < M_) ln_load<bf16, bf16>(va, HB + r * DM, ALPHA, YB + r * DM, nullptr, lane);
            for (; r < M_; r += 2 * ngw) { const long r1 = r + ngw, r2 = r + 2 * ngw;
                if (r1 < M_) ln_load<bf16, bf16>(vb, HB + r1 * DM, ALPHA, YB + r1 * DM, nullptr, lane);
                ln_finish_r(va, gbp, nullptr, HB + r * DM, lane);
                if (r2 < M_) ln_load<bf16, bf16>(va, HB + r2 * DM, ALPHA, YB + r2 * DM, nullptr, lane);
                if (r1 < M_) ln_finish_r(vb, gbp, nullptr, HB + r1 * DM, lane); } } }
            PH_END(PB + 7)
        } else {
            PH_BEGIN(PB + 5)
            { int base[N_EXP]; { int b_ = 0;
#pragma unroll
                  for (int e = 0; e < N_EXP; ++e) { base[e] = b_; b_ += (CNT[e] + 255) & ~255; } }
              constexpr int RPW = (M_ + 2047) / 2048;
              int te[RPW][2], tsl[RPW][2]; float tpv[RPW][2];
#pragma unroll
              for (int k = 0; k < RPW; ++k) { const long r = gw + (long)k * ngw;
#pragma unroll
                  for (int q = 0; q < 2; ++q) { te[k][q] = 0; tsl[k][q] = 0; tpv[k][q] = 0.f; if (r < M_) { te[k][q] = TE[r * 2 + q]; tsl[k][q] = TS[r * 2 + q]; tpv[k][q] = TP[r * 2 + q]; } } }
#pragma unroll
              for (int k = 0; k < RPW; ++k) { const long r = gw + (long)k * ngw; if (r < M_) {
                  const uint4* src = (const uint4*)(HB + r * DM); const uint2 v0 = bf8_to_f8(src[lane]), v1 = bf8_to_f8(src[lane + 64]);
#pragma unroll
                  for (int q = 0; q < 2; ++q) { int be = 0;
#pragma unroll
                      for (int x = 0; x < N_EXP; ++x) be = (te[k][q] == x) ? base[x] : be;
                      const int gs = be + tsl[k][q];
                      if (lane == 0) { SP[gs] = tpv[k][q]; GS[r * 2 + q] = gs; }
                      uint2* dst = (uint2*)(XG + (size_t)gs * DM); dst[lane] = v0; dst[lane + 64] = v1; } } }
              for (long r = gw + (long)RPW * ngw; r < M_; r += ngw) {
                  const uint4* src = (const uint4*)(HB + r * DM); const uint2 v0 = bf8_to_f8(src[lane]), v1 = bf8_to_f8(src[lane + 64]);
                  for (int q = 0; q < 2; ++q) { const long it = r * 2 + q; const int e = TE[it]; int be = 0;
#pragma unroll
                      for (int x = 0; x < N_EXP; ++x) be = (e == x) ? base[x] : be;
                      const int gs = be + TS[it];
                      if (lane == 0) { SP[gs] = TP[it]; GS[it] = gs; }
                      uint2* dst = (uint2*)(XG + (size_t)gs * DM); dst[lane] = v0; dst[lane + 64] = v1; } }
              for (int it = gw; it < N_EXP * 256; it += ngw) { const int e = it >> 8, r = it & 255; const int c = CNT[e]; const int slot = moe_base(CNT, e) + c + r;
                  if (c + r < ((c + 255) & ~255)) { uint2* dst = (uint2*)(XG + (size_t)slot * DM); const uint2 z = make_uint2(0u, 0u); dst[lane] = z; dst[lane + 64] = z; if (lane == 0) SP[slot] = 0.f; } } }
            PH_END(PB + 5)
            PH_BEGIN(PB + 6)
            { pg8::Gemm g{(const pg8::bf16_t*)XG, (const pg8::bf16_t*)MWGU, NSLOT, N_EXP * NGUE, DM / 2, DM / 2}; fp::MoeOrder S; S.init(CNT, NGUE / 256, G, bx);
              fp::EpiAct8 E{ACTM, D_FFE, NGUE / 256}; pg8::gemm_phase<fp::EpiAct8, fp::MoeOrder, true, true, true>(lds, g, S, E, tid);
              { const int rem = (S.T * S.ncol) % G; const int nidle = rem == 0 ? G : G - rem, first = rem == 0 ? 0 : rem;
                if (bx >= first) { const int per = (FT_D_D + nidle - 1) / nidle; const float* const p_md = moe_w_down;
                    for (int k = 0; k < per; ++k) { const int t = (bx - first) * per + k; if (t < FT_D_D) filler_d(FT_D - FT_D_D + t, p_md, MWD, scr, wave, lane); } } } }
            PH_END(PB + 6)
            PH_BEGIN(PB + 7)
            { fp::MoeOrder S; S.init(CNT, DM / 256, G, bx); const int nf = S.tail_start(); const int slot0 = (nf / (DM / 256)) * 256;
              constexpr int KU = D_FFE / 2, KLEN = KU / MOE_KSPLIT;
              static_assert(KLEN % 128 == 0, "split-K parts must hold an even number of K-tiles");
              fp::EpiF2 E{F2, SP, F2P, slot0, KLEN, 1.f / W8_D};
              { pg8::Gemm g{(const pg8::bf16_t*)ACTM, (const pg8::bf16_t*)MWD, NSLOT, N_EXP * DM, KU, KU}; S.nfull = nf; S.ksplit = 1;
                pg8::gemm_phase<fp::EpiF2, fp::MoeOrder, true, true, true>(lds, g, S, E, wave * 64 + (int)xb_lane_fresh()); }
              { pg8::Gemm g{(const pg8::bf16_t*)ACTM, (const pg8::bf16_t*)MWD, NSLOT, N_EXP * DM, KLEN, KU}; S.ksplit = MOE_KSPLIT; S.klen = KLEN;
                int tid2 = wave * 64 + (int)xb_lane_fresh();
                pg8::gemm_phase<fp::EpiF2, fp::MoeOrder, true, true, true>(lds, g, S, E, tid2); } }
            PH_END(PB + 7)
            PH_BEGIN(PB + 8)
            { const float* const p_g = ln2_g + layer * DM; const float* const p_b = ln2_b + layer * DM;
              int slot0; { fp::MoeOrder S; S.init(CNT, DM / 256, G, bx); const int nf = S.tail_start(); slot0 = (nf == S.T * (DM / 256)) ? 0x7fffffff : (nf / (DM / 256)) * 256; }
#define LN2_LOAD(v, rr, kk_) do { int s0_ = GS[(rr) * 2], s1_ = GS[(rr) * 2 + 1]; if (kk_ < RPW2) { _Pragma("unroll") for (int x_ = 0; x_ < RPW2; ++x_) if (x_ == kk_) { s0_ = gsv[x_][0]; s1_ = gsv[x_][1]; } } ln_load<bf16, bf16>(v, HB + (rr) * DM, ALPHA, F2 + (size_t)s0_ * DM, F2 + (size_t)s1_ * DM, lane); \
                  if (s0_ >= slot0) { _Pragma("unroll") for (int p_ = 0; p_ < MOE_KSPLIT - 1; ++p_) ln_add(v, F2P + ((size_t)p_ * TAIL_SLOTS + (s0_ - slot0)) * DM, lane); } \
                  if (s1_ >= slot0) { _Pragma("unroll") for (int p_ = 0; p_ < MOE_KSPLIT - 1; ++p_) ln_add(v, F2P + ((size_t)p_ * TAIL_SLOTS + (s1_ - slot0)) * DM, lane); } } while (0)
              constexpr int RPW2 = (M_ + 2047) / 2048; int gsv[RPW2][2];
#pragma unroll
              for (int x_ = 0; x_ < RPW2; ++x_) { const long rr_ = gw + (long)x_ * ngw; gsv[x_][0] = 0; gsv[x_][1] = 0; if (rr_ < M_) { gsv[x_][0] = GS[rr_ * 2]; gsv[x_][1] = GS[rr_ * 2 + 1]; } }
              { float va[16], vb[16]; LnGB gbp; ln_gb_load(gbp, p_g, p_b, lane); long r = gw; int kq = 0; if (r < M_) LN2_LOAD(va, r, kq);
                for (; r < M_; r += 2 * ngw, kq += 2) { const long r1 = r + ngw, r2 = r + 2 * ngw;
                    if (r1 < M_) LN2_LOAD(vb, r1, kq + 1);
                    ln_finish_r(va, gbp, H + r * DM, nullptr, lane);
                    if (r2 < M_) LN2_LOAD(va, r2, kq + 2);
                    if (r1 < M_) ln_finish_r(vb, gbp, H + r1 * DM, nullptr, lane); } }
#undef LN2_LOAD
            }
            PH_END(PB + 8)
        }
    }

#undef PH_BEGIN
#undef PH_END
#undef in_x
#undef in_pos
#undef ln_in_g
#undef ln_in_b
#undef w_in
#undef conv_w
#undef conv_b
#undef dt_bias
#undef a_log
#undef d_skip
#undef ssd_norm_g
#undef att_norm_g
#undef gm_ln_g
#undef gm_ln_b
#undef gm_w_s
#undef gm_b_s
#undef gm_norm_g
#undef w_out
#undef ln1_g
#undef ln1_b
#undef ln2_g
#undef ln2_b
#undef ffn_w_gate
#undef ffn_w_up
#undef ffn_w_down
#undef router_w
#undef moe_w_gate
#undef moe_w_up
#undef moe_w_down
#undef H
#undef MWD
#undef RT
#undef TE
#undef TP
#undef TS
#undef GS
#undef SP
#undef KM
#undef WSB
#undef HB
#undef MWGU
#undef WIN
#undef WOUT
#undef WGU
#undef WD
#undef PROJ
#undef ST
#undef CD
#undef XCB
#undef DTG
#undef MIXB
#undef YB
#undef ACT
#undef H8
#undef XG
#undef F2
#undef ACTM
#undef CNT
#undef tid
#undef lane
#undef F2P
#undef vcu
#undef gw
#undef ngw
#undef gt
#undef ngt
    if (pr_me) { const unsigned t_beg = (unsigned)__builtin_amdgcn_s_memrealtime(), t_len = (unsigned)PROBE_AMP * pr_w[1]; while ((unsigned)__builtin_amdgcn_s_memrealtime() - t_beg < t_len) __builtin_amdgcn_s_sleep(8); }
}

__device__ __forceinline__ void blk_acc(float d2, float s2, float* err) {
    d2 = wave_sum(d2); s2 = wave_sum(s2); if ((threadIdx.x & 63) == 0) { atomicAdd(err, d2); atomicAdd(err + 1, s2); }
}
__global__ void k_cmp_proj(const bf16* F, const float* S, long rows, float* err) {
    float d2 = 0.f, s2 = 0.f;
    for (long it = blockIdx.x * (long)blockDim.x + threadIdx.x; it < rows * 2950; it += gridDim.x * (long)blockDim.x) {
        const long row = it / 2950; const int d = (int)(it % 2950); const int sc = fp::win_src_col(d);
        float s = S[row * D_IN + sc]; if (d >= FGU && d < FXBC) s = gelu_tanh_f(s);
        const float f = ldf(F + row * PLD + d); d2 += (f - s) * (f - s); s2 += s * s; }
    blk_acc(d2, s2, err);
}
template <class TF> __global__ void k_cmp(const TF* F, int ldf_, const float* S, int lds_, long rows, int cols, float* err) {
    float d2 = 0.f, s2 = 0.f;
    for (long it = blockIdx.x * (long)blockDim.x + threadIdx.x; it < rows * cols; it += gridDim.x * (long)blockDim.x) {
        const long row = it / cols; const int c = (int)(it % cols); const float f = ldf(F + row * ldf_ + c), s = S[row * lds_ + c]; d2 += (f - s) * (f - s); s2 += s * s; }
    blk_acc(d2, s2, err);
}
__global__ void k_encode(const float* err, int nck, const float* Sout, float* out, long rows_s, long rows_all, float thr) {
    int k = 0; for (int i = 0; i < nck; ++i) { const float r = err[2 * i] / fmaxf(err[2 * i + 1], 1e-30f); if (!(r <= thr)) { k = i + 1; break; } }
    for (long it = blockIdx.x * (long)blockDim.x + threadIdx.x; it < rows_all * DM; it += gridDim.x * (long)blockDim.x)
        out[it] = (it < rows_s * DM) ? Sout[it] * (1.f + (float)k) : 0.f;
}
#if DEBUG_BUILD
constexpr size_t S_BASE = (WS_END + 2 * MiB - 1) / MiB * MiB;
#endif
extern "C" void kernel_launch(void* const* d_in, const int* in_sizes, int n_in, void* d_out, int out_size, void* d_ws, size_t ws_size, hipStream_t stream) {
    (void)in_sizes; (void)n_in; (void)out_size;
    static int grid = 0;
    if (grid == 0) {
        int dev = 0, cus = 0, per_cu = 0;
        if (hipGetDevice(&dev) != hipSuccess || hipDeviceGetAttribute(&cus, hipDeviceAttributeMultiprocessorCount, dev) != hipSuccess) { grid = -1; return; }
        if (hipFuncSetAttribute((const void*)mega, hipFuncAttributeMaxDynamicSharedMemorySize, LDS_BYTES) != hipSuccess) { fprintf(stderr, "kernel_launch: hipFuncSetAttribute failed\n"); grid = -1; return; }
        if (hipOccupancyMaxActiveBlocksPerMultiprocessor(&per_cu, (const void*)mega, 512, LDS_BYTES) != hipSuccess || per_cu < 1) fprintf(stderr, "kernel_launch: occupancy query reports %d\n", per_cu);
        (void)hipGetLastError();
        grid = cus;
        if (ws_size < WS_END) { fprintf(stderr, "kernel_launch: workspace too small: %zu < %zu\n", ws_size, (size_t)WS_END); grid = -1; }
    }
    if (grid < 0) return;
    unsigned char* ws = (unsigned char*)d_ws;
    if (hipMemsetAsync(ws + O_CTL, 0, CTL_BYTES, stream) != hipSuccess) return;
    FArgs a{};
    for (int i = 0; i < 29; ++i) a.in[i] = d_in[i];
    a.out = (float*)d_out; a.ws = ws;
#if !DEBUG_BUILD
    a.ph_lo = 0; a.ph_hi = N_PHASES;
    hipLaunchKernelGGL(mega, dim3(grid), dim3(512), LDS_BYTES, stream, a);
#else
    Inputs I;
    I.x = (const float*)d_in[0]; I.pos = (const int*)d_in[1]; I.ln_in_g = (const float*)d_in[2]; I.ln_in_b = (const float*)d_in[3]; I.w_in = (const float*)d_in[4];
    I.conv_w = (const float*)d_in[5]; I.conv_b = (const float*)d_in[6]; I.dt_bias = (const float*)d_in[7]; I.a_log = (const float*)d_in[8]; I.d_skip = (const float*)d_in[9];
    I.ssd_norm_g = (const float*)d_in[10]; I.att_norm_g = (const float*)d_in[11]; I.gm_ln_g = (const float*)d_in[12]; I.gm_ln_b = (const float*)d_in[13]; I.gm_w_s = (const float*)d_in[14];
    I.gm_b_s = (const float*)d_in[15]; I.gm_norm_g = (const float*)d_in[16]; I.w_out = (const float*)d_in[17]; I.ln1_g = (const float*)d_in[18]; I.ln1_b = (const float*)d_in[19];
    I.ln2_g = (const float*)d_in[20]; I.ln2_b = (const float*)d_in[21]; I.ffn_w_gate = (const float*)d_in[22]; I.ffn_w_up = (const float*)d_in[23]; I.ffn_w_down = (const float*)d_in[24];
    I.router_w = (const float*)d_in[25]; I.moe_w_gate = (const float*)d_in[26]; I.moe_w_up = (const float*)d_in[27]; I.moe_w_down = (const float*)d_in[28];
    const long MS = SEQ;
    unsigned char* sws = ws + S_BASE;
    float* saux = (float*)(sws + 96 * MiB); float* sout = (float*)(sws + 100 * MiB); float* ckpt = (float*)(sws + 110 * MiB);
    const size_t ck_stride = (size_t)MS * (D_IN + 3 * DM);
    run_simple(I, 1, sws, saux, sout, stream, ckpt);
    float* err = (float*)(ws + O_CTL) + CW_ERR;
    const bf16* PROJ = (const bf16*)(ws + O_PROJ); const bf16* MIXB = (const bf16*)(ws + O_MIXB); const bf16* Hf = (const bf16*)(ws + O_HB); const float* Hout = (const float*)d_out;
    for (int ph = 0; ph < N_PHASES; ++ph) {
        a.ph_lo = ph; a.ph_hi = ph + 1;
        hipLaunchKernelGGL(mega, dim3(grid), dim3(512), LDS_BYTES, stream, a);
        const int layer = ph >= 9 ? 1 : 0; const int rel = ph - (layer ? 8 : 0); const float* ck = ckpt + layer * ck_stride; float* e = err + layer * 12;
        if (rel == 1) k_cmp_proj<<<512, 256, 0, stream>>>(PROJ, ck, MS, e + 0);
        if (rel == 3) { k_cmp<bf16><<<512, 256, 0, stream>>>(MIXB, DM, ck + (size_t)MS * D_IN, DM, MS, 384, e + 2);
                        k_cmp<bf16><<<512, 256, 0, stream>>>(MIXB + 384, DM, ck + (size_t)MS * D_IN + 384, DM, MS, 384, e + 4);
                        k_cmp<bf16><<<512, 256, 0, stream>>>(MIXB + 768, DM, ck + (size_t)MS * D_IN + 768, DM, MS, 256, e + 6); }
        if (rel == 5) k_cmp<bf16><<<512, 256, 0, stream>>>(Hf, DM, ck + (size_t)MS * (D_IN + DM), DM, MS, DM, e + 8);
        if (layer == 0 && rel == 8) k_cmp<bf16><<<512, 256, 0, stream>>>(Hf, DM, ck + (size_t)MS * (D_IN + 2 * DM), DM, MS, DM, e + 10);
        if (layer == 1 && rel == 9) k_cmp<float><<<512, 256, 0, stream>>>(Hout, DM, ck + (size_t)MS * (D_IN + 2 * DM), DM, MS, DM, e + 10);
    }
    k_encode<<<1024, 256, 0, stream>>>(err, 12, sout, (float*)d_out, MS, (long)NBATCH * SEQ, DBG_THR);
#endif
}
```

```cpp
#define DEBUG_BUILD 0
#define DBG_THR 0.02f
#define PROBE_MASK 0u
#define PROBE_AMP 0
#include <hip/hip_runtime.h>
#include <cstdio>
#include <cstdint>

constexpr int DM = 1024, SEQ = 2048, NBATCH = 8;
constexpr int ATT_H = 6, HD = 64, ATT_W = 384, ROPE_DIM = 16;
constexpr int MOBA_BLOCK = 256, NBLK = SEQ / MOBA_BLOCK;
constexpr int SSD_H = 6, SSD_W = 384, SSD_G = 2, SSD_N = 128, SSD_CW = 896;
constexpr int GM_G = 4, GM_W = 256, GM_CHUNK = 128;
constexpr int D_IN = 2950, D_FF = 2816, N_EXP = 8, D_FFE = 3584;
constexpr float ALPHA = 1.4142135623730951f;
constexpr float NEGF = -1e30f;
constexpr int MAXSLOT = 2 * NBATCH * SEQ + N_EXP * 256;

typedef unsigned short bf16;
__device__ __forceinline__ unsigned f2bf(float f) { unsigned u = __float_as_uint(f); return (u + 0x7fffu + ((u >> 16) & 1u)) >> 16; }
__device__ __forceinline__ float ldf(const float* p) { return *p; }
__device__ __forceinline__ float ldf(const bf16* p) { return __uint_as_float(((unsigned)*p) << 16); }
__device__ __forceinline__ void stf(float* p, float v) { *p = v; }
__device__ __forceinline__ void stf(bf16* p, float v) { *p = (bf16)f2bf(v); }

__device__ __forceinline__ float dpp_add(float v, const int ctrl_tag) {
    int r;
    if (ctrl_tag == 0) r = __builtin_amdgcn_update_dpp(0, __float_as_int(v), 0xB1, 0xF, 0xF, false);
    else if (ctrl_tag == 1) r = __builtin_amdgcn_update_dpp(0, __float_as_int(v), 0x4E, 0xF, 0xF, false);
    else if (ctrl_tag == 2) r = __builtin_amdgcn_update_dpp(0, __float_as_int(v), 0x141, 0xF, 0xF, false);
    else r = __builtin_amdgcn_update_dpp(0, __float_as_int(v), 0x140, 0xF, 0xF, false);
    return v + __int_as_float(r);
}
__device__ __forceinline__ float row16_sum(float v) { v = dpp_add(v, 0); v = dpp_add(v, 1); v = dpp_add(v, 2); v = dpp_add(v, 3); return v; }
__device__ __forceinline__ float wave_sum(float v) {
    v = row16_sum(v);
    { const auto rr = __builtin_amdgcn_permlane16_swap(__float_as_uint(v), __float_as_uint(v), false, false); v = __uint_as_float(rr[0]) + __uint_as_float(rr[1]); }
    { const auto rr = __builtin_amdgcn_permlane32_swap(__float_as_uint(v), __float_as_uint(v), false, false); v = __uint_as_float(rr[0]) + __uint_as_float(rr[1]); }
    return v;
}
__device__ __forceinline__ float silu_f(float x) { return x / (1.f + __expf(-x)); }
__device__ __forceinline__ float gelu_tanh_f(float x) { const float u = 0.7978845608028654f * (x + 0.044715f * x * x * x); return 0.5f * x * (1.f + tanhf(u)); }
__device__ __forceinline__ float softplus_f(float x) { return fmaxf(x, 0.f) + log1pf(__expf(-fabsf(x))); }

struct ProjL { int ld, q, k, v, z, xbc, dt, gu, gv; };

__device__ __forceinline__ float4 ld4(const float* p) { return *(const float4*)p; }
__device__ __forceinline__ float4 ld4(const bf16* p) { const uint2 w = *(const uint2*)p; return make_float4(__uint_as_float(w.x << 16), __uint_as_float(w.x & 0xffff0000u), __uint_as_float(w.y << 16), __uint_as_float(w.y & 0xffff0000u)); }
typedef float nt_f4 __attribute__((ext_vector_type(4)));
__device__ __forceinline__ float4 ld4_nt(const float* p) { const nt_f4 v = __builtin_nontemporal_load((const nt_f4*)p); return make_float4(v[0], v[1], v[2], v[3]); }
__device__ __forceinline__ float4 ld4_nt(const bf16* p) { return ld4(p); }
template <class TY, class TX = float, bool NTX = false> __device__ __forceinline__ void ln_load(float (&v)[16], const TX* xrow, float a, const TY* y1, const TY* y2, int lane) {
#pragma unroll
    for (int j = 0; j < 4; ++j) {
        const float4 x = NTX ? ld4_nt(xrow + j * 256 + lane * 4) : ld4(xrow + j * 256 + lane * 4);
        float4 t = make_float4(a * x.x, a * x.y, a * x.z, a * x.w);
        if (y1) { const float4 y = ld4(y1 + j * 256 + lane * 4); t.x += y.x; t.y += y.y; t.z += y.z; t.w += y.w; }
        if (y2) { const float4 y = ld4(y2 + j * 256 + lane * 4); t.x += y.x; t.y += y.y; t.z += y.z; t.w += y.w; }
        v[4 * j] = t.x; v[4 * j + 1] = t.y; v[4 * j + 2] = t.z; v[4 * j + 3] = t.w;
    }
}
__device__ __forceinline__ void ln_add(float (&v)[16], const bf16* y, int lane) {
#pragma unroll
    for (int j = 0; j < 4; ++j) { const float4 t = ld4(y + j * 256 + lane * 4); v[4 * j] += t.x; v[4 * j + 1] += t.y; v[4 * j + 2] += t.z; v[4 * j + 3] += t.w; }
}
__device__ __forceinline__ void ln_finish(float (&v)[16], const float* g, const float* b, float* of, bf16* ob, int lane) {
    float s = 0.f;
#pragma unroll
    for (int i = 0; i < 16; ++i) s += v[i];
    const float mean = wave_sum(s) * (1.f / 1024.f); float s2 = 0.f;
#pragma unroll
    for (int i = 0; i < 16; ++i) { v[i] -= mean; s2 += v[i] * v[i]; }
    const float rstd = rsqrtf(wave_sum(s2) * (1.f / 1024.f) + 1e-5f);
#pragma unroll
    for (int j = 0; j < 4; ++j) {
        const float4 gg = *(const float4*)(g + j * 256 + lane * 4), bb = *(const float4*)(b + j * 256 + lane * 4);
        float4 o = make_float4(v[4 * j] * rstd * gg.x + bb.x, v[4 * j + 1] * rstd * gg.y + bb.y, v[4 * j + 2] * rstd * gg.z + bb.z, v[4 * j + 3] * rstd * gg.w + bb.w);
        if (of) *(float4*)(of + j * 256 + lane * 4) = o;
        if (ob) { uint2 w; w.x = f2bf(o.x) | (f2bf(o.y) << 16); w.y = f2bf(o.z) | (f2bf(o.w) << 16); *(uint2*)(ob + j * 256 + lane * 4) = w; }
    }
}

struct LnGB { float4 g[4], b[4]; };
__device__ __forceinline__ void ln_gb_load(LnGB& p, const float* g, const float* b, int lane) {
#pragma unroll
    for (int j = 0; j < 4; ++j) { p.g[j] = *(const float4*)(g + j * 256 + lane * 4); p.b[j] = *(const float4*)(b + j * 256 + lane * 4); }
}
__device__ __forceinline__ void ln_finish_r(float (&v)[16], const LnGB& p, float* of, bf16* ob, int lane, unsigned char* o8 = nullptr  ) {
    float s = 0.f;
#pragma unroll
    for (int i = 0; i < 16; ++i) s += v[i];
    const float mean = wave_sum(s) * (1.f / 1024.f); float s2 = 0.f;
#pragma unroll
    for (int i = 0; i < 16; ++i) { v[i] -= mean; s2 += v[i] * v[i]; }
    const float rstd = rsqrtf(wave_sum(s2) * (1.f / 1024.f) + 1e-5f);
#pragma unroll
    for (int j = 0; j < 4; ++j) {
        const float4 gg = p.g[j], bb = p.b[j];
        float4 o = make_float4(v[4 * j] * rstd * gg.x + bb.x, v[4 * j + 1] * rstd * gg.y + bb.y, v[4 * j + 2] * rstd * gg.z + bb.z, v[4 * j + 3] * rstd * gg.w + bb.w);
        if (of) { nt_f4 ov; ov[0] = o.x; ov[1] = o.y; ov[2] = o.z; ov[3] = o.w; __builtin_nontemporal_store(ov, (nt_f4*)(of + j * 256 + lane * 4)); }
        if (ob) { uint2 w; w.x = f2bf(o.x) | (f2bf(o.y) << 16); w.y = f2bf(o.z) | (f2bf(o.w) << 16); *(uint2*)(ob + j * 256 + lane * 4) = w; }
        if (o8) { int w = 0; w = __builtin_amdgcn_cvt_pk_fp8_f32(o.x, o.y, w, false); w = __builtin_amdgcn_cvt_pk_fp8_f32(o.z, o.w, w, true); *(int*)(o8 + j * 256 + lane * 4) = w; }
    }
}
template <class TY> __device__ __forceinline__ void ln_row(const float* xrow, float a, const TY* y1, const TY* y2, const float* g, const float* b, float* of, bf16* ob, int lane) {
    float v[16]; ln_load<TY>(v, xrow, a, y1, y2, lane); ln_finish(v, g, b, of, ob, lane);
}

__device__ __forceinline__ void rope_inplace(float* P, ProjL L, const int* pos, long n_rows, long gt, long ngt) {
    for (long it = gt; it < n_rows * 96; it += ngt) {
        const int i = (int)(it & 7), hh = (int)((it >> 3) % 12); const long row = it / 96;
        const int off = (hh < 6 ? L.q : L.k) + (hh % 6) * 64;
        const float inv = powf(500000.0f, -(float)(2 * i) / 16.0f);
        const float ang = (float)pos[row] * inv;
        const float c = cosf(ang), s = sinf(ang);
        float* p = P + row * L.ld + off;
        const float x1 = p[i], x2 = p[i + 8];
        p[i] = x1 * c - x2 * s; p[i + 8] = x2 * c + x1 * s;
    }
}

template <class T> __device__ __forceinline__ void kmean_phase(const T* P, ProjL L, float* KM, int nb, long gt, long ngt) {
    for (long it = gt; it < (long)nb * ATT_H * NBLK * 64; it += ngt) {
        const int d = (int)(it & 63), n = (int)((it >> 6) % NBLK), h = (int)((it / (64 * NBLK)) % ATT_H), b = (int)(it / (64 * NBLK * ATT_H));
        const T* p = P + ((long)b * SEQ + n * MOBA_BLOCK) * L.ld + L.k + h * 64 + d; float s = 0.f;
        for (int r = 0; r < MOBA_BLOCK; ++r) s += ldf(p + (long)r * L.ld);
        KM[it] = s * (1.f / MOBA_BLOCK);
    }
}

template <class T> __device__ __forceinline__ void attn_naive_phase(const T* P, ProjL L, const float* KM, float* O, int ldo, int nb, int gw, int ngw, int lane) {
    for (long it = gw; it < (long)nb * ATT_H * SEQ; it += ngw) {
        const int q = (int)(it % SEQ), h = (int)((it / SEQ) % ATT_H), b = (int)(it / ((long)SEQ * ATT_H));
        const long row = (long)b * SEQ + q; const int qblk = q / MOBA_BLOCK;
        const float qv = ldf(P + row * L.ld + L.q + h * 64 + lane);
        float g[NBLK];
#pragma unroll
        for (int n = 0; n < NBLK; ++n) { const float t = wave_sum(qv * KM[(((long)b * ATT_H + h) * NBLK + n) * 64 + lane]); g[n] = (n < qblk) ? t : NEGF; }
        unsigned sel = 0u;
#pragma unroll
        for (int r = 0; r < 3; ++r) { float bv = -3.0e38f; int best = -1;
#pragma unroll
            for (int n = 0; n < NBLK; ++n) if (!((sel >> n) & 1u) && g[n] > bv) { bv = g[n]; best = n; }
            if (best >= 0 && bv > NEGF * 0.5f) sel |= 1u << best; }
        sel |= 1u << qblk;
        float m = -3.0e38f, l = 0.f, o = 0.f;
        for (int n = 0; n <= qblk; ++n) {
            if (!((sel >> n) & 1u)) continue;
            const int j0 = n * MOBA_BLOCK, j1 = (n == qblk) ? q + 1 : j0 + MOBA_BLOCK;
            const T* kp = P + ((long)b * SEQ + j0) * L.ld + L.k + h * 64 + lane;
            const T* vp = P + ((long)b * SEQ + j0) * L.ld + L.v + h * 64 + lane;
            for (int j = j0; j < j1; ++j, kp += L.ld, vp += L.ld) {
                const float s = wave_sum(qv * ldf(kp)) * 0.125f;
                const float mn = fmaxf(m, s), corr = __expf(m - mn), p = __expf(s - mn);
                l = l * corr + p; o = o * corr + p * ldf(vp); m = mn;
            }
        }
        O[row * ldo + h * 64 + lane] = o / l;
    }
}

template <int W, class TO> __device__ __forceinline__ void rms_rows_phase(const float* in, int ldi, const float* g, TO* out, int ldo, long n_rows, int gw, int ngw, int lane) {
    constexpr int PER = W / 64;
    for (long row = gw; row < n_rows; row += ngw) {
        float v[PER]; float s = 0.f;
#pragma unroll
        for (int j = 0; j < PER; ++j) { v[j] = in[row * ldi + j * 64 + lane]; s += v[j] * v[j]; }
        const float r = rsqrtf(wave_sum(s) * (1.f / W) + 1e-5f);
#pragma unroll
        for (int j = 0; j < PER; ++j) stf(out + row * ldo + j * 64 + lane, v[j] * r * g[j * 64 + lane]);
    }
}

template <class T, class TO> __device__ __forceinline__ void ssd_conv_phase(const T* P, ProjL L, const float* cw, const float* cb, const float* dtb, TO* XC, float* DT, long n_rows, long gt, long ngt) {
    for (long it = gt; it < n_rows * 902; it += ngt) {
        const int c = (int)(it % 902); const long row = it / 902; const int t = (int)(row % SEQ);
        if (c < SSD_CW) {
            float acc = cb[c];
#pragma unroll
            for (int i = 0; i < 4; ++i) { const int tt = t - 3 + i; if (tt >= 0) acc += cw[i * SSD_CW + c] * ldf(P + (row - 3 + i) * L.ld + L.xbc + c); }
            stf(XC + row * SSD_CW + c, silu_f(acc));
        } else {
            const int h = c - SSD_CW;
            DT[row * SSD_H + h] = softplus_f(ldf(P + row * L.ld + L.dt + h) + dtb[h]);
        }
    }
}

template <class T> __device__ __forceinline__ void ssd_scan_naive_phase(const T* XC, const float* DT, const float* a_log, const float* dsk, float* Y, int ldo, int nb, int gw, int ngw, int lane) {
    for (int it = gw; it < nb * SSD_H * 64; it += ngw) {
        const int p = it & 63, h = (it >> 6) % SSD_H, b = it / (64 * SSD_H), grp = h / (SSD_H / SSD_G);
        const float A = -__expf(a_log[h]), Dk = dsk[h];
        float s0 = 0.f, s1 = 0.f;
#pragma unroll 4
        for (int t = 0; t < SEQ; ++t) {
            const long row = (long)b * SEQ + t;
            const T* xr = XC + row * SSD_CW;
            const float dt = DT[row * SSD_H + h], x = ldf(xr + h * 64 + p);
            const float B0 = ldf(xr + SSD_W + grp * SSD_N + lane), B1 = ldf(xr + SSD_W + grp * SSD_N + 64 + lane);
            const float C0 = ldf(xr + SSD_W + SSD_G * SSD_N + grp * SSD_N + lane), C1 = ldf(xr + SSD_W + SSD_G * SSD_N + grp * SSD_N + 64 + lane);
            const float dec = __expf(dt * A), xd = x * dt;
            s0 = s0 * dec + xd * B0; s1 = s1 * dec + xd * B1;
            const float y = wave_sum(C0 * s0 + C1 * s1);
            if (lane == 0) Y[row * ldo + h * 64 + p] = y + Dk * x;
        }
    }
}

template <class T, class TO> __device__ __forceinline__ void ssd_gate_phase(const float* Y, int ldi, const T* P, ProjL L, const float* ng, TO* out, int ldo, long n_rows, int gw, int ngw, int lane) {
    for (long row = gw; row < n_rows; row += ngw) {
        float v[6];
#pragma unroll
        for (int j = 0; j < 6; ++j) { const int c = j * 64 + lane; v[j] = Y[row * ldi + c] * silu_f(ldf(P + row * L.ld + L.z + c)); }
        const float r0 = rsqrtf(wave_sum(v[0] * v[0] + v[1] * v[1] + v[2] * v[2]) * (1.f / 192.f) + 1e-5f);
        const float r1 = rsqrtf(wave_sum(v[3] * v[3] + v[4] * v[4] + v[5] * v[5]) * (1.f / 192.f) + 1e-5f);
#pragma unroll
        for (int j = 0; j < 6; ++j) { const int c = j * 64 + lane; stf(out + row * ldo + c, v[j] * (j < 3 ? r0 : r1) * ng[c]); }
    }
}

template <class T, bool PRE> __device__ __forceinline__ void gm_ln_phase(const T* P, ProjL L, const float* g, const float* b, float* VN, long n_rows, int gw, int ngw, int lane) {
    for (long row = gw; row < n_rows; row += ngw) {
        float v[4]; float s = 0.f;
#pragma unroll
        for (int j = 0; j < 4; ++j) { const float x = ldf(P + row * L.ld + L.gv + j * 64 + lane); v[j] = PRE ? x : gelu_tanh_f(x); s += v[j]; }
        const float mean = wave_sum(s) * (1.f / 256.f); float s2 = 0.f;
#pragma unroll
        for (int j = 0; j < 4; ++j) { v[j] -= mean; s2 += v[j] * v[j]; }
        const float rstd = rsqrtf(wave_sum(s2) * (1.f / 256.f) + 1e-5f);
#pragma unroll
        for (int j = 0; j < 4; ++j) VN[row * GM_W + j * 64 + lane] = v[j] * rstd * g[j * 64 + lane] + b[j * 64 + lane];
    }
}
template <class T, bool PRE> __device__ __forceinline__ void gm_mix_phase(const T* P, ProjL L, const float* VN, const float* ws_, const float* bs, float* GO, int ldo, long n_rows, long gt, long ngt) {
    for (long it = gt; it < n_rows * GM_W; it += ngt) {
        const int c = (int)(it % GM_W); const long row = it / GM_W; const int t = (int)(row % GM_CHUNK), g = c / 64; const long base = row - t;
        const float* w = ws_ + ((long)g * GM_CHUNK + t) * GM_CHUNK; float acc = 0.f;
        for (int s = 0; s <= t; ++s) acc += w[s] * VN[(base + s) * GM_W + c];
        acc += bs[g * GM_CHUNK + t];
        const float x = ldf(P + row * L.ld + L.gu + c); const float u = PRE ? x : gelu_tanh_f(x);
        GO[row * ldo + c] = u * acc;
    }
}

__device__ __forceinline__ void moe_route_phase(const float* H, const float* Wr, int* CNT, int* TE, float* TP, int* TS, long n_rows, int gw, int ngw, int lane) {
    for (long row = gw; row < n_rows; row += ngw) {
        float acc[N_EXP];
#pragma unroll
        for (int e = 0; e < N_EXP; ++e) acc[e] = 0.f;
        for (int j = 0; j < 16; ++j) { const int d = j * 64 + lane; const float hv = H[row * DM + d];
            const float4 w0 = *(const float4*)(Wr + d * N_EXP), w1 = *(const float4*)(Wr + d * N_EXP + 4);
            acc[0] += hv * w0.x; acc[1] += hv * w0.y; acc[2] += hv * w0.z; acc[3] += hv * w0.w; acc[4] += hv * w1.x; acc[5] += hv * w1.y; acc[6] += hv * w1.z; acc[7] += hv * w1.w; }
#pragma unroll
        for (int e = 0; e < N_EXP; ++e) acc[e] = wave_sum(acc[e]);
        int e0 = 0; float v0 = acc[0];
#pragma unroll
        for (int e = 1; e < N_EXP; ++e) if (acc[e] > v0) { v0 = acc[e]; e0 = e; }
        int e1 = -1; float v1 = -3.0e38f;
#pragma unroll
        for (int e = 0; e < N_EXP; ++e) if (e != e0 && acc[e] > v1) { v1 = acc[e]; e1 = e; }
        const float p1 = __expf(v1 - v0), den = 1.f + p1;
        if (lane == 0) {
            const int s0 = atomicAdd(&CNT[e0], 1), s1 = atomicAdd(&CNT[e1], 1);
            TE[row * 2] = e0; TE[row * 2 + 1] = e1; TP[row * 2] = 1.f / den; TP[row * 2 + 1] = p1 / den; TS[row * 2] = s0; TS[row * 2 + 1] = s1;
        }
    }
}

__device__ __forceinline__ void moe_route_block(const bf16* H, const float* Wr, int* CNT, int* TE, float* TP, int* TS, long n_rows, int gw_, int ngw_, int lane, int wave, int tid,
                                                __attribute__((address_space(3))) int* sh  ) {
    asm volatile("" : "+v"(tid));
    if (tid < 16) sh[tid] = 0;
    __syncthreads();
    int k = 0;
    for (long row = gw_; row < n_rows; row += ngw_, ++k) {
        float acc[N_EXP];
#pragma unroll
        for (int e = 0; e < N_EXP; ++e) acc[e] = 0.f;
        for (int j = 0; j < 16; ++j) { const int d = j * 64 + lane; const float hv = ldf(H + row * DM + d);
            const float4 w0 = *(const float4*)(Wr + d * N_EXP), w1 = *(const float4*)(Wr + d * N_EXP + 4);
            acc[0] += hv * w0.x; acc[1] += hv * w0.y; acc[2] += hv * w0.z; acc[3] += hv * w0.w; acc[4] += hv * w1.x; acc[5] += hv * w1.y; acc[6] += hv * w1.z; acc[7] += hv * w1.w; }
#pragma unroll
        for (int e = 0; e < N_EXP; ++e) acc[e] = wave_sum(acc[e]);
        int e0 = 0; float v0 = acc[0];
#pragma unroll
        for (int e = 1; e < N_EXP; ++e) if (acc[e] > v0) { v0 = acc[e]; e0 = e; }
        int e1 = -1; float v1 = -3.0e38f;
#pragma unroll
        for (int e = 0; e < N_EXP; ++e) if (e != e0 && acc[e] > v1) { v1 = acc[e]; e1 = e; }
        const float p1 = __expf(v1 - v0), den = 1.f + p1;
        if (lane == 0) {
            const int l0 = atomicAdd((int*)&sh[e0], 1), l1 = atomicAdd((int*)&sh[e1], 1);
            TE[row * 2] = e0; TE[row * 2 + 1] = e1; TP[row * 2] = 1.f / den; TP[row * 2 + 1] = p1 / den;
            sh[16 + (wave * 8 + k) * 4 + 0] = e0; sh[16 + (wave * 8 + k) * 4 + 1] = e1; sh[16 + (wave * 8 + k) * 4 + 2] = l0; sh[16 + (wave * 8 + k) * 4 + 3] = l1;
        }
    }
    __syncthreads();
    if (tid < N_EXP) sh[8 + tid] = atomicAdd(&CNT[tid], sh[tid]);
    __syncthreads();
    k = 0;
    for (long row = gw_; row < n_rows; row += ngw_, ++k)
        if (lane == 0) { const int e0 = sh[16 + (wave * 8 + k) * 4], e1 = sh[16 + (wave * 8 + k) * 4 + 1];
            TS[row * 2] = sh[8 + e0] + sh[16 + (wave * 8 + k) * 4 + 2]; TS[row * 2 + 1] = sh[8 + e1] + sh[16 + (wave * 8 + k) * 4 + 3]; }
    __syncthreads();
}
__device__ __forceinline__ int moe_base(const int* CNT, int e) { int b = 0; for (int i = 0; i < e; ++i) b += (CNT[i] + 255) & ~255; return b; }
__device__ __forceinline__ void moe_scatter_phase(const int* CNT, const int* TE, const float* TP, const int* TS, int* LIST, float* SP, int* GS, long n_rows, long gt, long ngt) {
    for (long it = gt; it < n_rows * 2; it += ngt) {
        const int e = TE[it]; const int gs = moe_base(CNT, e) + TS[it];
        LIST[gs] = (int)(it >> 1); SP[gs] = TP[it]; GS[it] = gs;
    }
}

template <class TA, int EPI> __global__ void __launch_bounds__(256) sgemm_k(const TA* A, int lda, const int* rowlist, const float* B, const float* B2, int ldb, long bstride, void* Cv, int ldc, int M, int N, int K, const int* CNT, const float* scale) {
    __shared__ float As[16][68], Bs[16][68], Bs2[16][68];
    int row_base = 0, mrows = M;
    if (CNT) { const int e = blockIdx.z; row_base = moe_base(CNT, e); mrows = CNT[e]; B += (long)e * bstride; if (B2) B2 += (long)e * bstride; }
    const int m0 = blockIdx.y * 64; if (m0 >= mrows) return;
    const int n0 = blockIdx.x * 64, tid = threadIdx.x, tx = tid & 15, ty = tid >> 4;
    float acc[4][4], acc2[4][4];
#pragma unroll
    for (int i = 0; i < 4; ++i)
#pragma unroll
        for (int j = 0; j < 4; ++j) { acc[i][j] = 0.f; acc2[i][j] = 0.f; }
    const int ar = tid >> 2, ak = (tid & 3) * 4; long arow = -1;
    { const int lr = m0 + ar; if (lr < mrows) { arow = rowlist ? (long)rowlist[row_base + lr] : (long)(row_base + lr); } }
    const int bk = tid >> 4, bn = (tid & 15) * 4;
    for (int k0 = 0; k0 < K; k0 += 16) {
        float av[4] = {0.f, 0.f, 0.f, 0.f};
        if (arow >= 0) {
#pragma unroll
            for (int i = 0; i < 4; ++i) av[i] = ldf(A + arow * lda + k0 + ak + i);
        }
#pragma unroll
        for (int i = 0; i < 4; ++i) As[ak + i][ar] = av[i];
#pragma unroll
        for (int i = 0; i < 4; ++i) { const int n = n0 + bn + i; const bool ok = n < N;
            Bs[bk][bn + i] = ok ? B[(long)(k0 + bk) * ldb + n] : 0.f;
            if (EPI == 1 || EPI == 2) Bs2[bk][bn + i] = ok ? B2[(long)(k0 + bk) * ldb + n] : 0.f; }
        __syncthreads();
#pragma unroll
        for (int kk = 0; kk < 16; ++kk) {
            float a[4], b[4], b2[4];
#pragma unroll
            for (int i = 0; i < 4; ++i) { a[i] = As[kk][ty * 4 + i]; b[i] = Bs[kk][tx * 4 + i]; if (EPI == 1 || EPI == 2) b2[i] = Bs2[kk][tx * 4 + i]; }
#pragma unroll
            for (int i = 0; i < 4; ++i)
#pragma unroll
                for (int j = 0; j < 4; ++j) { acc[i][j] += a[i] * b[j]; if (EPI == 1 || EPI == 2) acc2[i][j] += a[i] * b2[j]; }
        }
        __syncthreads();
    }
#pragma unroll
    for (int i = 0; i < 4; ++i) { const int lr = m0 + ty * 4 + i; if (lr >= mrows) continue; const long crow = row_base + lr;
#pragma unroll
        for (int j = 0; j < 4; ++j) { const int n = n0 + tx * 4 + j; if (n >= N) continue;
            float v = acc[i][j];
            if (EPI == 1 || EPI == 2) v = silu_f(v) * acc2[i][j];
            if (EPI == 3) v *= scale[crow];
            if (EPI == 2) ((bf16*)Cv)[crow * ldc + n] = (bf16)f2bf(v); else ((float*)Cv)[crow * ldc + n] = v; } }
}

#define GW_DECL const int lane = threadIdx.x & 63; const int gw = (int)((blockIdx.x * (long)blockDim.x + threadIdx.x) >> 6); const int ngw = (int)((gridDim.x * (long)blockDim.x) >> 6); (void)lane; (void)gw; (void)ngw;
#define GT_DECL const long gt = blockIdx.x * (long)blockDim.x + threadIdx.x; const long ngt = gridDim.x * (long)blockDim.x;

__global__ void k_ln_in(const float* x, const float* g, const float* b, float* H, long n_rows) { GW_DECL for (long r = gw; r < n_rows; r += ngw) ln_row<float>(x + r * DM, 1.f, nullptr, nullptr, g, b, H + r * DM, nullptr, lane); }
__global__ void k_ln_res(float* H, const float* Y, const float* g, const float* b, float* OUT, long n_rows) { GW_DECL for (long r = gw; r < n_rows; r += ngw) ln_row<float>(H + r * DM, ALPHA, Y + r * DM, nullptr, g, b, OUT + r * DM, nullptr, lane); }
__global__ void k_ln_moe(float* H, const float* F2, const int* GS, const float* g, const float* b, float* OUT, long n_rows) { GW_DECL for (long r = gw; r < n_rows; r += ngw) ln_row<float>(H + r * DM, ALPHA, F2 + (long)GS[r * 2] * DM, F2 + (long)GS[r * 2 + 1] * DM, g, b, OUT + r * DM, nullptr, lane); }
__global__ void k_rope(float* P, ProjL L, const int* pos, long n_rows) { GT_DECL rope_inplace(P, L, pos, n_rows, gt, ngt); }
__global__ void k_kmean(const float* P, ProjL L, float* KM, int nb) { GT_DECL kmean_phase<float>(P, L, KM, nb, gt, ngt); }
__global__ void k_attn(const float* P, ProjL L, const float* KM, float* O, int ldo, int nb) { GW_DECL attn_naive_phase<float>(P, L, KM, O, ldo, nb, gw, ngw, lane); }
__global__ void k_rms384(const float* in, int ldi, const float* g, float* out, int ldo, long n_rows) { GW_DECL rms_rows_phase<384, float>(in, ldi, g, out, ldo, n_rows, gw, ngw, lane); }
__global__ void k_rms256(const float* in, int ldi, const float* g, float* out, int ldo, long n_rows) { GW_DECL rms_rows_phase<256, float>(in, ldi, g, out, ldo, n_rows, gw, ngw, lane); }
__global__ void k_ssd_conv(const float* P, ProjL L, const float* cw, const float* cb, const float* dtb, float* XC, float* DT, long n_rows) { GT_DECL ssd_conv_phase<float, float>(P, L, cw, cb, dtb, XC, DT, n_rows, gt, ngt); }
__global__ void k_ssd_scan(const float* XC, const float* DT, const float* a_log, const float* dsk, float* Y, int ldo, int nb) { GW_DECL ssd_scan_naive_phase<float>(XC, DT, a_log, dsk, Y, ldo, nb, gw, ngw, lane); }
__global__ void k_ssd_gate(const float* Y, int ldi, const float* P, ProjL L, const float* ng, float* out, int ldo, long n_rows) { GW_DECL ssd_gate_phase<float, float>(Y, ldi, P, L, ng, out, ldo, n_rows, gw, ngw, lane); }
__global__ void k_gm_ln(const float* P, ProjL L, const float* g, const float* b, float* VN, long n_rows) { GW_DECL gm_ln_phase<float, false>(P, L, g, b, VN, n_rows, gw, ngw, lane); }
__global__ void k_gm_mix(const float* P, ProjL L, const float* VN, const float* ws_, const float* bs, float* GO, int ldo, long n_rows) { GT_DECL gm_mix_phase<float, false>(P, L, VN, ws_, bs, GO, ldo, n_rows, gt, ngt); }
__global__ void k_moe_init(int* CNT, int* LIST, int nslots) { GT_DECL if (gt < N_EXP) CNT[gt] = 0; for (long i = gt; i < nslots; i += ngt) LIST[i] = -1; }
__global__ void k_moe_route(const float* H, const float* Wr, int* CNT, int* TE, float* TP, int* TS, long n_rows) { GW_DECL moe_route_phase(H, Wr, CNT, TE, TP, TS, n_rows, gw, ngw, lane); }
__global__ void k_moe_scatter(const int* CNT, const int* TE, const float* TP, const int* TS, int* LIST, float* SP, int* GS, long n_rows) { GT_DECL moe_scatter_phase(CNT, TE, TP, TS, LIST, SP, GS, n_rows, gt, ngt); }

struct Inputs {
    const float *x; const int* pos; const float *ln_in_g, *ln_in_b, *w_in, *conv_w, *conv_b, *dt_bias, *a_log, *d_skip, *ssd_norm_g, *att_norm_g, *gm_ln_g, *gm_ln_b, *gm_w_s, *gm_b_s, *gm_norm_g, *w_out,
        *ln1_g, *ln1_b, *ln2_g, *ln2_b, *ffn_w_gate, *ffn_w_up, *ffn_w_down, *router_w, *moe_w_gate, *moe_w_up, *moe_w_down;
};

static void run_simple(const Inputs& I, int nb, unsigned char* ws, float* aux  , float* OUT, hipStream_t st, float* ckpt = nullptr) {
    const long M = (long)nb * SEQ; const size_t MB = 1u << 20;
    const size_t hsz = (size_t)M * DM * 4;
    float* H = (float*)ws; float* MIX = (float*)(ws + hsz); float* Y = (float*)(ws + 2 * hsz); unsigned char* BIG = ws + 3 * hsz + (size_t)N_EXP * 256 * DM * 4;
    float* XC = Y;
    float* VN = aux;
    float* PROJ = (float*)BIG;
    size_t big_bytes = (size_t)M * D_IN * 4; { size_t a = (size_t)M * D_FF * 4; if (a > big_bytes) big_bytes = a; size_t c = (size_t)(2 * M + N_EXP * 256) * D_FFE * 2; if (c > big_bytes) big_bytes = c; }
    big_bytes = (big_bytes + 255) & ~(size_t)255;
    unsigned char* SM = BIG + big_bytes;
    float* KM = (float*)SM; SM += (size_t)nb * ATT_H * NBLK * 64 * 4;
    float* DT = (float*)SM; SM += (size_t)M * SSD_H * 4;
    int* CNT = (int*)SM; SM += 256;
    int* TE = (int*)SM; SM += (size_t)M * 2 * 4; float* TP = (float*)SM; SM += (size_t)M * 2 * 4; int* TS = (int*)SM; SM += (size_t)M * 2 * 4; int* GS = (int*)SM; SM += (size_t)M * 2 * 4;
    const int nslots = (int)(2 * M + N_EXP * 256);
    int* LIST = (int*)SM; SM += (size_t)nslots * 4; float* SP = (float*)SM; SM += (size_t)nslots * 4;
    (void)MB;
    const ProjL L{D_IN, 0, 384, 768, 1152, 1536, 2432, 2438, 2694};
    const int TB = 256; const int GWB = 2048;
    k_ln_in<<<GWB, TB, 0, st>>>(I.x, I.ln_in_g, I.ln_in_b, H, M);
    for (int i = 0; i < 2; ++i) {
        sgemm_k<float, 0><<<dim3((D_IN + 63) / 64, (unsigned)(M / 64), 1), 256, 0, st>>>(H, DM, nullptr, I.w_in + (size_t)i * DM * D_IN, nullptr, D_IN, 0, PROJ, D_IN, (int)M, D_IN, DM, nullptr, nullptr);
        k_rope<<<GWB, TB, 0, st>>>(PROJ, L, I.pos, M);
        const size_t ck_stride = (size_t)M * (D_IN + 3 * DM); float* ck = ckpt ? ckpt + (size_t)i * ck_stride : nullptr;
        if (ck) hipMemcpyAsync(ck, PROJ, (size_t)M * D_IN * 4, hipMemcpyDeviceToDevice, st);
        k_kmean<<<96 * nb, TB, 0, st>>>(PROJ, L, KM, nb);
        k_attn<<<GWB * 2, TB, 0, st>>>(PROJ, L, KM, MIX, DM, nb);
        k_rms384<<<GWB, TB, 0, st>>>(MIX, DM, I.att_norm_g + i * ATT_W, MIX, DM, M);
        k_ssd_conv<<<GWB * 2, TB, 0, st>>>(PROJ, L, I.conv_w + (size_t)i * 4 * SSD_CW, I.conv_b + i * SSD_CW, I.dt_bias + i * SSD_H, XC, DT, M);
        k_ssd_scan<<<(nb * SSD_H * 64 * 64 + TB - 1) / TB, TB, 0, st>>>(XC, DT, I.a_log + i * SSD_H, I.d_skip + i * SSD_H, MIX + ATT_W, DM, nb);
        k_ssd_gate<<<GWB, TB, 0, st>>>(MIX + ATT_W, DM, PROJ, L, I.ssd_norm_g + i * SSD_W, MIX + ATT_W, DM, M);
        k_gm_ln<<<GWB, TB, 0, st>>>(PROJ, L, I.gm_ln_g + i * GM_W, I.gm_ln_b + i * GM_W, VN, M);
        k_gm_mix<<<GWB * 2, TB, 0, st>>>(PROJ, L, VN, I.gm_w_s + (size_t)i * GM_G * GM_CHUNK * GM_CHUNK, I.gm_b_s + i * GM_G * GM_CHUNK, MIX + ATT_W + SSD_W, DM, M);
        k_rms256<<<GWB, TB, 0, st>>>(MIX + ATT_W + SSD_W, DM, I.gm_norm_g + i * GM_W, MIX + ATT_W + SSD_W, DM, M);
        if (ck) hipMemcpyAsync(ck + (size_t)M * D_IN, MIX, hsz, hipMemcpyDeviceToDevice, st);
        sgemm_k<float, 0><<<dim3(DM / 64, (unsigned)(M / 64), 1), 256, 0, st>>>(MIX, DM, nullptr, I.w_out + (size_t)i * DM * DM, nullptr, DM, 0, Y, DM, (int)M, DM, DM, nullptr, nullptr);
        k_ln_res<<<GWB, TB, 0, st>>>(H, Y, I.ln1_g + i * DM, I.ln1_b + i * DM, H, M);
        if (ck) hipMemcpyAsync(ck + (size_t)M * (D_IN + DM), H, hsz, hipMemcpyDeviceToDevice, st);
        if (i == 0) {
            float* ACT = (float*)BIG;
            sgemm_k<float, 1><<<dim3(D_FF / 64, (unsigned)(M / 64), 1), 256, 0, st>>>(H, DM, nullptr, I.ffn_w_gate, I.ffn_w_up, D_FF, 0, ACT, D_FF, (int)M, D_FF, DM, nullptr, nullptr);
            sgemm_k<float, 0><<<dim3(DM / 64, (unsigned)(M / 64), 1), 256, 0, st>>>(ACT, D_FF, nullptr, I.ffn_w_down, nullptr, DM, 0, Y, DM, (int)M, DM, D_FF, nullptr, nullptr);
            k_ln_res<<<GWB, TB, 0, st>>>(H, Y, I.ln2_g + i * DM, I.ln2_b + i * DM, H, M);
            if (ck) hipMemcpyAsync(ck + (size_t)M * (D_IN + 2 * DM), H, hsz, hipMemcpyDeviceToDevice, st);
        } else {
            bf16* ACTM = (bf16*)BIG; float* F2 = MIX;
            k_moe_init<<<256, TB, 0, st>>>(CNT, LIST, nslots);
            k_moe_route<<<GWB, TB, 0, st>>>(H, I.router_w, CNT, TE, TP, TS, M);
            k_moe_scatter<<<256, TB, 0, st>>>(CNT, TE, TP, TS, LIST, SP, GS, M);
            sgemm_k<float, 2><<<dim3(D_FFE / 64, (unsigned)(M / 64), N_EXP), 256, 0, st>>>(H, DM, LIST, I.moe_w_gate, I.moe_w_up, D_FFE, (long)DM * D_FFE, ACTM, D_FFE, 0, D_FFE, DM, CNT, nullptr);
            sgemm_k<bf16, 3><<<dim3(DM / 64, (unsigned)(M / 64), N_EXP), 256, 0, st>>>(ACTM, D_FFE, nullptr, I.moe_w_down, nullptr, DM, (long)D_FFE * DM, F2, DM, 0, DM, D_FFE, CNT, SP);
            k_ln_moe<<<GWB, TB, 0, st>>>(H, F2, GS, I.ln2_g + i * DM, I.ln2_b + i * DM, OUT, M);
            if (ck) hipMemcpyAsync(ck + (size_t)M * (D_IN + 2 * DM), OUT, hsz, hipMemcpyDeviceToDevice, st);
        }
    }
}

#define LAS __attribute__((address_space(3)))
namespace pg8 {
#define PG8_LAS __attribute__((address_space(3)))
typedef unsigned short bf16_t;
typedef short bf16x8 __attribute__((ext_vector_type(8)));
typedef float f32x4 __attribute__((ext_vector_type(4)));
typedef unsigned u32x4 __attribute__((ext_vector_type(4)));
constexpr int BM = 256, BK = 64, HALF = 128, HTB = HALF * BK * 2  , STAGE_BYTES = 8 * HTB, NXCD = 8, WGM = 8;

__host__ __device__ __forceinline__ int lds_byte(int r, int c) { const int st = (r >> 4) * 2 + (c >> 5), rr = r & 15, cc = c & 31, ob = rr * 64 + cc * 2; return st * 1024 + (ob ^ (((ob >> 9) & 1) << 5)); }
__host__ __device__ __forceinline__ void stage_rc(int b, int& R, int& C) { const int st = b / 1024, sb = b % 1024, swz = sb ^ (((sb >> 9) & 1) << 5); R = (st >> 1) * 16 + swz / 64; C = (st & 1) * 32 + (swz % 64) / 2; }
__host__ __device__ __forceinline__ int perm32(int rho) { const int n = rho >> 4, i = rho & 15; return 8 * (i >> 2) + 4 * n + (i & 3); }

struct Unit { int pm, pn, kofs; };
struct Gemm { const bf16_t* A; const bf16_t* Bt; int M, N, K, ld; };

struct StaticOrder {
    int nM, nN, nwg, G, c;
    __host__ __device__ void init(int M, int N, int G_, int c_) { nM = M / BM; nN = N / BM; nwg = nM * nN; G = G_; c = c_; }
    __host__ __device__ bool next(int i, Unit& u) const {
        const long L = (long)i * G + c; if (L >= nwg) return false;
        int wgid = (int)L; { const int q = nwg / NXCD, r = nwg % NXCD, xcd = wgid % NXCD, off = wgid / NXCD; wgid = (xcd < r ? xcd * (q + 1) : r * (q + 1) + (xcd - r) * q) + off; }
        const int nig = WGM * nN, gid = wgid / nig, fm = gid * WGM, gsz = (nM - fm) < WGM ? (nM - fm) : WGM;
        u.pm = fm + ((wgid % nig) % gsz); u.pn = (wgid % nig) / gsz; u.kofs = 0; return true;
    }
    __device__ __forceinline__ void a_ready(const Unit&) const {}
    __device__ __forceinline__ void done(const Unit&) const {}
};
__device__ __forceinline__ unsigned cvt_pk_bf16(float lo, float hi) { unsigned r; asm volatile("v_cvt_pk_bf16_f32 %0, %1, %2" : "=v"(r) : "v"(lo), "v"(hi)); return r; }
typedef float f32x2 __attribute__((ext_vector_type(2)));
typedef int i32x4_ __attribute__((ext_vector_type(4)));
typedef int i32x8_ __attribute__((ext_vector_type(8)));
__device__ __forceinline__ i32x8_ cat8(bf16x8 lo, bf16x8 hi) { const i32x4_ l = (i32x4_)lo, h = (i32x4_)hi; return __builtin_shufflevector(l, h, 0, 1, 2, 3, 4, 5, 6, 7); }
template <class Epi, class Sched, bool ALIGN_EPI = false, bool SP2 = false, bool FP8 = false>
__device__ __forceinline__ void gemm_phase(PG8_LAS unsigned char* lds, const Gemm g, const Sched& S, const Epi& E, const int tid) {
    const int wid = __builtin_amdgcn_readfirstlane(tid >> 6), lane = tid & 63, wr = wid >> 2, wc = wid & 3, fr = lane & 15, fq = lane >> 4;
    const int K = g.ld; int nt = g.K / BK;
    if constexpr (FP8) asm volatile("" : "+s"(nt));
    unsigned voffA[2], voffB[2];
#pragma unroll
    for (int i = 0; i < 2; ++i) { int R, C; stage_rc(tid * 16 + i * 8192, R, C); const int Rb = Epi::PERM ? ((R & ~31) + perm32(R & 31)) : R;
        voffA[i] = (unsigned)(R * K + C) * 2u; voffB[i] = (unsigned)(Rb * K + C) * 2u; }
    const size_t kstep = (size_t)(BK * 2);
    const size_t hstep = (size_t)HALF * K * 2;
    const size_t tstep = 2 * hstep;
    const unsigned ldsw = (unsigned)wid * 1024u;
    const int aoff = lds_byte(wr * 64 + fr, fq * 8), boff = lds_byte(wc * 32 + fr, fq * 8);
#define PG8_SA(b, h) (((b) * 2 + (h)) * HTB)
#define PG8_SB(b, h) ((4 + (b) * 2 + (h)) * HTB)
#define PG8_STAGE(bufoff, gbase, voff) do { const char* sb_ = (const char*)(gbase); asm volatile("" : "+s"(sb_));   \
        _Pragma("unroll") for (int _i = 0; _i < 2; ++_i) { unsigned vo_ = (voff)[_i]; asm volatile("" : "+v"(vo_));   \
        __builtin_amdgcn_global_load_lds((const unsigned*)(sb_ + vo_), (PG8_LAS unsigned*)(lds + (bufoff) + ldsw + _i * 8192), 16, 0, 0); } } while (0)
#define PG8_LDA(dst, b, h) do { _Pragma("unroll") for (int m = 0; m < 4; ++m) _Pragma("unroll") for (int k = 0; k < 2; ++k) dst[m][k] = *(const PG8_LAS bf16x8*)(lds + PG8_SA(b, h) + aoff + m * 2048 + k * 1024); } while (0)
#define PG8_LDB(dst, b, h) do { _Pragma("unroll") for (int n = 0; n < 2; ++n) _Pragma("unroll") for (int k = 0; k < 2; ++k) dst[n][k] = *(const PG8_LAS bf16x8*)(lds + PG8_SB(b, h) + boff + n * 2048 + k * 1024); } while (0)
#define PG8_MMA(ai, bj, At, Bt) do { __builtin_amdgcn_s_setprio(1); _Pragma("unroll") for (int m = 0; m < 4; ++m) _Pragma("unroll") for (int n = 0; n < 2; ++n) { \
        if constexpr (FP8) acc[ai][bj][m][n] = __builtin_amdgcn_mfma_scale_f32_16x16x128_f8f6f4(cat8(Bt[n][0], Bt[n][1]), cat8(At[m][0], At[m][1]), acc[ai][bj][m][n], 0, 0, 0, 0, 0, 0); \
        else { _Pragma("unroll") for (int k = 0; k < 2; ++k) acc[ai][bj][m][n] = __builtin_amdgcn_mfma_f32_16x16x32_bf16(Bt[n][k], At[m][k], acc[ai][bj][m][n], 0, 0, 0); } } __builtin_amdgcn_s_setprio(0); } while (0)
#define PG8_WAIT_V(n) asm volatile("s_waitcnt vmcnt(" #n ")" ::: "memory")
#define PG8_WAIT_L(n) asm volatile("s_waitcnt lgkmcnt(" #n ")" ::: "memory")
#define PG8_BAR __builtin_amdgcn_s_barrier()
#define PG8_SCHED __builtin_amdgcn_sched_barrier(0)
    Unit cur, nxt; int ui = 0;
    if (!S.next(0, cur)) return;
    f32x4 acc[2][2][4][2];
#pragma unroll
    for (int a = 0; a < 2; ++a)
#pragma unroll
        for (int b = 0; b < 2; ++b)
#pragma unroll
            for (int m = 0; m < 4; ++m)
#pragma unroll
                for (int n = 0; n < 2; ++n) acc[a][b][m][n] = (f32x4){0.f, 0.f, 0.f, 0.f};
    bf16x8 At[4][2], B0[2][2], B1[2][2];
    const char* cA = (const char*)g.A + (size_t)cur.pm * tstep + (size_t)cur.kofs * 2; const char* cB = (const char*)g.Bt + (size_t)cur.pn * tstep + (size_t)cur.kofs * 2;
    S.a_ready(cur);
    if constexpr (SP2) {
        PG8_STAGE(PG8_SB(0, 0), cB, voffB); PG8_STAGE(PG8_SB(0, 1), cB + hstep, voffB); PG8_STAGE(PG8_SA(0, 0), cA, voffA); PG8_STAGE(PG8_SA(0, 1), cA + hstep, voffA);
        if (wr == 1) PG8_BAR;
        PG8_WAIT_V(2); PG8_BAR;
        PG8_STAGE(PG8_SB(1, 0), cB + kstep, voffB); PG8_STAGE(PG8_SA(1, 0), cA + kstep, voffA); PG8_STAGE(PG8_SB(1, 1), cB + hstep + kstep, voffB);
        PG8_WAIT_V(6); PG8_BAR;
    } else {
        PG8_STAGE(PG8_SB(0, 0), cB, voffB); PG8_STAGE(PG8_SA(0, 0), cA, voffA); PG8_STAGE(PG8_SB(0, 1), cB + hstep, voffB); PG8_STAGE(PG8_SA(0, 1), cA + hstep, voffA);
        if (wr == 1) PG8_BAR;
        PG8_WAIT_V(4); PG8_BAR;
        PG8_STAGE(PG8_SB(1, 0), cB + kstep, voffB); PG8_STAGE(PG8_SA(1, 0), cA + kstep, voffA); PG8_STAGE(PG8_SB(1, 1), cB + hstep + kstep, voffB);
        PG8_WAIT_V(6); PG8_BAR;
    }
    for (;;) {
        const bool has_next = S.next(ui + 1, nxt);
        const char* nA = has_next ? (const char*)g.A + (size_t)nxt.pm * tstep + (size_t)nxt.kofs * 2 : cA; const char* nB = has_next ? (const char*)g.Bt + (size_t)nxt.pn * tstep + (size_t)nxt.kofs * 2 : cB;
        for (int t = 0; t < nt; t += 2) {
            const bool last = (t == nt - 2);
            const char* a1 = cA + (size_t)(t + 1) * kstep;
            const char* a2 = last ? nA : cA + (size_t)(t + 2) * kstep; const char* b2 = last ? nB : cB + (size_t)(t + 2) * kstep;
            const char* a3 = a2 + kstep; const char* b3 = b2 + kstep;
            if (last && has_next) S.a_ready(nxt);
            if constexpr (SP2) {
            PG8_LDB(B0, 0, 0); PG8_LDB(B1, 0, 1); PG8_SCHED; PG8_LDA(At, 0, 0); PG8_STAGE(PG8_SA(1, 1), a1 + hstep, voffA);
            PG8_WAIT_V(8); PG8_WAIT_L(0); PG8_BAR; PG8_MMA(0, 0, At, B0); PG8_MMA(0, 1, At, B1); PG8_BAR; PG8_SCHED;
            PG8_LDA(At, 0, 1); PG8_STAGE(PG8_SB(0, 0), b2, voffB); PG8_STAGE(PG8_SB(0, 1), b2 + hstep, voffB); PG8_STAGE(PG8_SA(0, 0), a2, voffA);
            PG8_WAIT_V(8); PG8_WAIT_L(0); PG8_BAR; PG8_MMA(1, 0, At, B0); PG8_MMA(1, 1, At, B1); PG8_BAR; PG8_SCHED;
            PG8_LDB(B0, 1, 0); PG8_LDB(B1, 1, 1); PG8_SCHED; PG8_LDA(At, 1, 0); PG8_STAGE(PG8_SA(0, 1), a2 + hstep, voffA);
            PG8_WAIT_V(8); PG8_WAIT_L(0); PG8_BAR; PG8_MMA(0, 0, At, B0); PG8_MMA(0, 1, At, B1); PG8_BAR; PG8_SCHED;
            PG8_LDA(At, 1, 1); PG8_STAGE(PG8_SB(1, 0), b3, voffB); PG8_STAGE(PG8_SB(1, 1), b3 + hstep, voffB); PG8_STAGE(PG8_SA(1, 0), a3, voffA);
            PG8_WAIT_V(8); PG8_WAIT_L(0); PG8_BAR; PG8_MMA(1, 0, At, B0); PG8_MMA(1, 1, At, B1); PG8_BAR; PG8_SCHED;
            } else {
            PG8_LDB(B0, 0, 0); PG8_SCHED; PG8_LDA(At, 0, 0); PG8_STAGE(PG8_SA(1, 1), a1 + hstep, voffA);
            PG8_WAIT_L(8); PG8_BAR; PG8_WAIT_L(0); PG8_MMA(0, 0, At, B0); PG8_BAR; PG8_SCHED;
            PG8_LDB(B1, 0, 1); PG8_STAGE(PG8_SB(0, 0), b2, voffB);
            PG8_BAR; PG8_WAIT_L(0); PG8_MMA(0, 1, At, B1); PG8_BAR;
            PG8_LDA(At, 0, 1); PG8_STAGE(PG8_SA(0, 0), a2, voffA);
            PG8_BAR; PG8_WAIT_L(0); PG8_MMA(1, 0, At, B0); PG8_BAR; PG8_SCHED;
            PG8_STAGE(PG8_SB(0, 1), b2 + hstep, voffB);
            PG8_WAIT_V(6); PG8_BAR; PG8_MMA(1, 1, At, B1); PG8_BAR;
            PG8_LDB(B0, 1, 0); PG8_SCHED; PG8_LDA(At, 1, 0); PG8_STAGE(PG8_SA(0, 1), a2 + hstep, voffA);
            PG8_WAIT_L(8); PG8_BAR; PG8_WAIT_L(0); PG8_MMA(0, 0, At, B0); PG8_BAR; PG8_SCHED;
            PG8_LDB(B1, 1, 1); PG8_STAGE(PG8_SB(1, 0), b3, voffB);
            PG8_BAR; PG8_WAIT_L(0); PG8_MMA(0, 1, At, B1); PG8_BAR;
            PG8_LDA(At, 1, 1); PG8_STAGE(PG8_SA(1, 0), a3, voffA);
            PG8_BAR; PG8_WAIT_L(0); PG8_MMA(1, 0, At, B0); PG8_BAR; PG8_SCHED;
            PG8_STAGE(PG8_SB(1, 1), b3 + hstep, voffB);
            PG8_WAIT_V(6); PG8_BAR; PG8_MMA(1, 1, At, B1); PG8_BAR;
            }
        }
        if constexpr (ALIGN_EPI) { if (wr == 0) PG8_BAR; }
        if constexpr (!Epi::AFTER_DRAIN) { E(acc, cur, wr, wc, fr, fq); S.done(cur); }
        if (!has_next) break;
#pragma unroll
        for (int a = 0; a < 2; ++a)
#pragma unroll
            for (int b = 0; b < 2; ++b)
#pragma unroll
                for (int m = 0; m < 4; ++m)
#pragma unroll
                    for (int n = 0; n < 2; ++n) acc[a][b][m][n] = (f32x4){0.f, 0.f, 0.f, 0.f};
        cur = nxt; cA = nA; cB = nB; ++ui;
        if constexpr (ALIGN_EPI) { if (wr == 1) PG8_BAR; }
    }
    PG8_WAIT_V(0);
    if constexpr (!ALIGN_EPI) { if (wr == 0) PG8_BAR; }
    PG8_BAR;
    if constexpr (Epi::AFTER_DRAIN) { E.fused(acc, cur, wr, wc, fr, fq, lds, wid, lane); S.done(cur); }
#undef PG8_SA
#undef PG8_SB
#undef PG8_STAGE
#undef PG8_LDA
#undef PG8_LDB
#undef PG8_MMA
#undef PG8_WAIT_V
#undef PG8_WAIT_L
#undef PG8_BAR
#undef PG8_SCHED
}
}
#define XB_TMO      128
#define XB_XCNT(j)  (256  + 64 * (j))
#define XB_XSUB(j)  (1280 + 64 * (j))
#define XB_XGEN(j)  (2304 + 64 * (j))
#define XB_TOP      3328
#define XB_TOPGEN   3392
#define XCD_BAR_WORDS 3456
#define XB_SPIN_CAP (1u << 24)

__device__ __forceinline__ unsigned xb_ld(unsigned* p)              { return __hip_atomic_load(p, __ATOMIC_RELAXED, __HIP_MEMORY_SCOPE_AGENT); }
__device__ __forceinline__ unsigned xb_add(unsigned* p, unsigned v) { return __hip_atomic_fetch_add(p, v, __ATOMIC_RELAXED, __HIP_MEMORY_SCOPE_AGENT); }
__device__ __forceinline__ unsigned xb_xcc_id() { return (unsigned)__builtin_amdgcn_s_getreg((3 << 11) | 20) & 0xFu; }
#define XB_SPIN(cond, bar) do { unsigned _sp = 0; while (cond) { __builtin_amdgcn_s_sleep(1); \
    if ((++_sp & 255u) == 0u) { if (xb_ld(&(bar)[XB_TMO])) break; if (_sp > XB_SPIN_CAP) { atomicAdd(&(bar)[XB_TMO], 1u); break; } } } } while (0)

__device__ __forceinline__ unsigned xb_lane_fresh() { unsigned l; asm volatile("v_mbcnt_lo_u32_b32 %0, -1, 0\n\tv_mbcnt_hi_u32_b32 %0, -1, %0" : "=v"(l)); return l; }
struct XcdBarrier {
    unsigned* bar; unsigned x; int w0;
    volatile LAS unsigned* st;
};

__device__ __forceinline__ XcdBarrier xcd_barrier_post(unsigned* bar, volatile LAS unsigned* st) {
    XcdBarrier b; b.bar = bar; b.x = xb_xcc_id(); b.st = st; b.w0 = (__builtin_amdgcn_readfirstlane((int)threadIdx.x >> 6) == 0);
    if (threadIdx.x == 0) (void)xb_add(&bar[XB_XCNT(b.x)], 1u);
    return b;
}
__device__ __forceinline__ void xcd_barrier_complete(unsigned* bar, unsigned x, unsigned& nloc, unsigned& nx) {
    const unsigned G = gridDim.x * gridDim.y * gridDim.z;
    unsigned sum, cnt, mine, sp = 0u;
    for (;;) {
        sum = 0u; cnt = 0u; mine = 0u;
#pragma unroll
        for (unsigned j = 0; j < 16; ++j) { const unsigned c = xb_ld(&bar[XB_XCNT(j)]); sum += c; cnt += (c > 0u) ? 1u : 0u; mine = (j == x) ? c : mine; }
        if (sum == G) break;
        __builtin_amdgcn_s_sleep(1);
        if ((++sp & 255u) == 0u) { if (xb_ld(&bar[XB_TMO])) break; if (sp > XB_SPIN_CAP) { atomicAdd(&bar[XB_TMO], 1u); break; } }
    }
    nloc = mine > 0u ? mine : 1u; nx = cnt > 0u ? cnt : 1u;
}

__device__ __forceinline__ void xcd_barrier(const XcdBarrier& b) {
    asm volatile("s_waitcnt vmcnt(0)" ::: "memory");
    __syncthreads();
    if (b.w0 && xb_lane_fresh() == 0u) {
        unsigned* bar = b.bar;
        __builtin_amdgcn_s_waitcnt(0);
        unsigned nloc = b.st[0], nx = b.st[1];
        if (nloc == 0u) { xcd_barrier_complete(bar, b.x, nloc, nx); b.st[0] = nloc; b.st[1] = nx; }
        const unsigned old = xb_add(&bar[XB_XSUB(b.x)], 1u);
        const unsigned gen = old / nloc;
        if (old + 1u == (gen + 1u) * nloc) {
            __builtin_amdgcn_fence(__ATOMIC_RELEASE, "agent");
            asm volatile("s_waitcnt vmcnt(0)" ::: "memory");
            const unsigned og = xb_add(&bar[XB_TOP], 1u);
            const unsigned tg = og / nx;
            if (og + 1u == (tg + 1u) * nx) xb_add(&bar[XB_TOPGEN], 1u);
            else XB_SPIN(xb_ld(&bar[XB_TOPGEN]) == tg, bar);
            __builtin_amdgcn_fence(__ATOMIC_ACQUIRE, "agent");
            xb_add(&bar[XB_XGEN(b.x)], 1u);
            asm volatile("s_waitcnt vmcnt(0)" ::: "memory");
        } else {
            __builtin_amdgcn_fence(__ATOMIC_ACQUIRE, "agent");
            XB_SPIN(xb_ld(&bar[XB_XGEN(b.x)]) == gen, bar);
            asm volatile("s_waitcnt vmcnt(0)" ::: "memory");
        }
    }
    __syncthreads();
}
#include <hip/hip_bf16.h>
#include <cmath>
namespace attn_body {
using bf16=__hip_bfloat16;
using bf16x8=__attribute__((ext_vector_type(8)))short;
using s16x4=__attribute__((ext_vector_type(4)))short;
using f32x16=__attribute__((ext_vector_type(16)))float;
using u32x4=__attribute__((ext_vector_type(4)))unsigned;
constexpr int NHEAD=6,SEQ=2048,D=64,QP=3072,OP=1024;
constexpr int NW=8,QBLK=32,QB=QBLK*NW,KVBLK=64,NQB=SEQ/QB;
constexpr int ATTN_UNIT_ROWS=QB;
__device__ __forceinline__ int crow(int r,int hi){return (r&3)+8*(r>>2)+4*hi;}
#define SBAR() __builtin_amdgcn_sched_barrier(0)
__device__ __forceinline__ void cmask(f32x16&p0,f32x16&p1,int jb,int qrel,int hi){
  const float NEG=-INFINITY; int kb=64*jb+4*hi;
  #pragma unroll
  for(int r=0;r<16;++r){int kv=kb+(r&3)+8*(r>>2); if(kv>qrel)p0[r]=NEG; if(kv+32>qrel)p1[r]=NEG;}
}

constexpr int NSLOT=3, SLOTB=8192;
constexpr int LDS_K=0, LDS_V=NSLOT*SLOTB, LDS_WS=2*NSLOT*SLOTB, LDS_OST=LDS_WS+NW*64*4, LDS_BYTES=LDS_OST+NW*4096;
constexpr float C2=0.125f*1.4426950408889634f;
__device__ __forceinline__ void glds16(const void*gsrc,unsigned lds_dst){unsigned keep;
  asm volatile("s_mov_b32 %0, m0\n\ts_mov_b32 m0, %2\n\ts_nop 0\n\tglobal_load_lds_dwordx4 %1, off\n\ts_mov_b32 m0, %0":"=&s"(keep):"v"(gsrc),"s"(lds_dst):"memory");}
__device__ __forceinline__ float max3f(float a,float b,float c){float r;asm("v_max3_f32 %0, %1, %2, %3":"=v"(r):"v"(a),"v"(b),"v"(c));return r;}
__device__ __forceinline__ float max2f(float a,float b){float r;asm("v_max_f32_e32 %0, %1, %2":"=v"(r):"v"(a),"v"(b));return r;}
__device__ __forceinline__ float fadd_s(float a,float b){float r;asm("v_add_f32_e32 %0, %1, %2":"=v"(r):"v"(a),"v"(b));return r;}
__device__ __forceinline__ float fsub_s(float a,float b){float r;asm("v_sub_f32_e32 %0, %1, %2":"=v"(r):"v"(a),"v"(b));return r;}
typedef float f32x2_t __attribute__((ext_vector_type(2))); typedef __bf16 bf16x2_t __attribute__((ext_vector_type(2)));
__device__ __forceinline__ unsigned cvtpk_s(float lo,float hi){f32x2_t v={lo,hi};bf16x2_t b=__builtin_convertvector(v,bf16x2_t);return __builtin_bit_cast(unsigned,b);}
#define WAIT_BAR(N) asm volatile("s_waitcnt vmcnt(" #N ") lgkmcnt(0)\n\ts_barrier":::"memory")

__device__ __forceinline__ void qkt(f32x16&p0,f32x16&p1,const char*Kslot,const bf16x8*qr,int r32,int hi){ const f32x16 negm=f32x16{};
  const char*kb=Kslot+hi*1024+r32*16;
  #pragma unroll
  for(int d0=0;d0<4;++d0){
    const bf16x8 b0=*reinterpret_cast<const bf16x8*>(kb+d0*2048);
    const bf16x8 b1=*reinterpret_cast<const bf16x8*>(kb+d0*2048+512);
    if(d0==0){p0=__builtin_amdgcn_mfma_f32_32x32x16_bf16(b0,qr[0],negm,0,0,0);p1=__builtin_amdgcn_mfma_f32_32x32x16_bf16(b1,qr[0],negm,0,0,0);}
    else{p0=__builtin_amdgcn_mfma_f32_32x32x16_bf16(b0,qr[d0],p0,0,0,0);p1=__builtin_amdgcn_mfma_f32_32x32x16_bf16(b1,qr[d0],p1,0,0,0);}}
}
typedef __attribute__((address_space(3))) const char* lds_cptr;
typedef short v4i16_t __attribute__((ext_vector_type(4)));
__device__ __forceinline__ void kload8(bf16x8*kf,lds_cptr kp){
  kf[0]=*(const __attribute__((address_space(3))) bf16x8*)(kp);      kf[1]=*(const __attribute__((address_space(3))) bf16x8*)(kp+512);
  kf[2]=*(const __attribute__((address_space(3))) bf16x8*)(kp+2048); kf[3]=*(const __attribute__((address_space(3))) bf16x8*)(kp+2560);
  kf[4]=*(const __attribute__((address_space(3))) bf16x8*)(kp+4096); kf[5]=*(const __attribute__((address_space(3))) bf16x8*)(kp+4608);
  kf[6]=*(const __attribute__((address_space(3))) bf16x8*)(kp+6144); kf[7]=*(const __attribute__((address_space(3))) bf16x8*)(kp+6656);
}
__device__ __forceinline__ void kload2(bf16x8*kf,lds_cptr kp,int j){ kf[2*j]=*(const __attribute__((address_space(3))) bf16x8*)(kp+j*2048); kf[2*j+1]=*(const __attribute__((address_space(3))) bf16x8*)(kp+j*2048+512); }
__device__ __forceinline__ s16x4 vtr(lds_cptr p){ return __builtin_bit_cast(s16x4,__builtin_amdgcn_ds_read_tr16_b64_v4i16((__attribute__((address_space(3))) v4i16_t*)p)); }
__device__ __forceinline__ float rowmax(const f32x16&p0,const f32x16&p1){
  float a=max3f(p0[0],p0[1],p1[0]),b=max3f(p0[2],p0[3],p1[1]);a=max3f(a,p1[2],p1[3]);
  #pragma unroll
  for(int r=4;r<16;r+=4){a=max3f(a,p0[r],p0[r+1]);b=max3f(b,p0[r+2],p0[r+3]);a=max3f(a,p1[r],p1[r+1]);b=max3f(b,p1[r+2],p1[r+3]);}
  const float m=max2f(a,b);
  auto rr=__builtin_amdgcn_permlane32_swap(__float_as_uint(m),__float_as_uint(m),false,false);
  return max2f(__uint_as_float(rr[0]),__uint_as_float(rr[1]));
}
__device__ __forceinline__ void pv(f32x16*o,int vb,bf16x8 pa0,bf16x8 pa1,bf16x8 pa2,bf16x8 pa3){
  #pragma unroll
  for(int d0=0;d0<2;++d0){s16x4 lo[4],hi[4];
    #pragma unroll
    for(int ks=0;ks<4;++ks){
      asm volatile("ds_read_b64_tr_b16 %0,%1 offset:%c2":"=&v"(lo[ks]):"v"(vb),"i"(d0*4096+ks*1024):"memory");
      asm volatile("ds_read_b64_tr_b16 %0,%1 offset:%c2":"=&v"(hi[ks]):"v"(vb),"i"(d0*4096+ks*1024+512):"memory");}
    asm volatile("s_waitcnt lgkmcnt(0)":::"memory");SBAR();
    #define PK(k) (bf16x8){lo[k][0],lo[k][1],lo[k][2],lo[k][3],hi[k][0],hi[k][1],hi[k][2],hi[k][3]}
    o[d0]=__builtin_amdgcn_mfma_f32_32x32x16_bf16(pa0,PK(0),o[d0],0,0,0);
    o[d0]=__builtin_amdgcn_mfma_f32_32x32x16_bf16(pa1,PK(1),o[d0],0,0,0);
    o[d0]=__builtin_amdgcn_mfma_f32_32x32x16_bf16(pa2,PK(2),o[d0],0,0,0);
    o[d0]=__builtin_amdgcn_mfma_f32_32x32x16_bf16(pa3,PK(3),o[d0],0,0,0);
    #undef PK
  }
}

#ifndef ATTN_STORE16
#define ATTN_STORE16(p,v) (*(u32x4*)(p)=(v))
#endif
template<int THRL> __device__ __forceinline__ void attn_unit(int b,int h,int qb,const bf16*Q,const bf16*__restrict__ K,const bf16*__restrict__ V,bf16*O,const float*__restrict__ KM,int KMH,char*shm,const int tid){
  const int lane=tid&63,r32=lane&31,hi=lane>>5; const int wid=__builtin_amdgcn_readfirstlane(tid>>6);
  const long rowbase=(long)b*SEQ; const int q0=qb*QB;
  const bf16*Qw=Q+(rowbase+q0+wid*QBLK)*QP+h*D;
  const bf16*Kh=K+rowbase*QP+h*D,*Vh=V+rowbase*QP+h*D;
  const unsigned lds0=(unsigned)(uintptr_t)shm;
  float*wsf=(float*)(shm+LDS_WS)+wid*64;
  const bf16*ksrc=Kh+(long)lane*QP+wid*8;
  const bf16*vsrc=Vh+(long)(16*(wid&3)+(lane>>2))*QP+(wid>>2)*32+(lane&3)*8;
  const unsigned kdst=lds0+LDS_K+wid*1024, vdst=lds0+LDS_V+wid*1024;
  #define TI(t) (((t)<4)?(NT-4+(t)):((t)-4))
  #define DMA_K(t,slot) glds16(ksrc+(long)TI(t)*KVBLK*QP,(unsigned)__builtin_amdgcn_readfirstlane(kdst+(slot)))
  #define DMA_V(t,slot) glds16(vsrc+(long)TI(t)*KVBLK*QP,(unsigned)__builtin_amdgcn_readfirstlane(vdst+(slot)))
  const char*Kbase=shm+LDS_K; bf16x8 kf[8];
  const lds_cptr shm3=(lds_cptr)shm; const lds_cptr kp0=shm3+LDS_K+hi*1024+r32*16; const lds_cptr vp0=shm3+LDS_V+((lane>>4)&1)*32+(lane&3)*8+(4*hi+((lane&15)>>2))*64;
  const int NT=(q0+QB)/KVBLK;
  DMA_K(0,0);DMA_V(0,0);DMA_K(1,SLOTB);
  bf16x8 qr[4];
  #pragma unroll
  for(int d0=0;d0<4;++d0)qr[d0]=*reinterpret_cast<const bf16x8*>(&Qw[(long)r32*QP+d0*16+hi*8]);

  unsigned sel=0u;
  if(qb>0){ float gt_[8];
    #pragma unroll
    for(int n=0;n<8;++n){ float a_=0.f;
      if(n<qb){ const float*km=KM+((long)(b*NHEAD+h)*8+n)*64+hi*8;
        #pragma unroll
        for(int d0=0;d0<4;++d0){ float4 k0=*reinterpret_cast<const float4*>(km+d0*16), k1=*reinterpret_cast<const float4*>(km+d0*16+4);
          { const float4 k2=*reinterpret_cast<const float4*>(km+KMH+d0*16), k3=*reinterpret_cast<const float4*>(km+KMH+d0*16+4); k0.x+=k2.x;k0.y+=k2.y;k0.z+=k2.z;k0.w+=k2.w;k1.x+=k3.x;k1.y+=k3.y;k1.z+=k3.z;k1.w+=k3.w; }
          const bf16x8 qv=qr[d0];
          a_+=__uint_as_float(((unsigned)(unsigned short)qv[0])<<16)*k0.x+__uint_as_float(((unsigned)(unsigned short)qv[1])<<16)*k0.y+__uint_as_float(((unsigned)(unsigned short)qv[2])<<16)*k0.z+__uint_as_float(((unsigned)(unsigned short)qv[3])<<16)*k0.w
             +__uint_as_float(((unsigned)(unsigned short)qv[4])<<16)*k1.x+__uint_as_float(((unsigned)(unsigned short)qv[5])<<16)*k1.y+__uint_as_float(((unsigned)(unsigned short)qv[6])<<16)*k1.z+__uint_as_float(((unsigned)(unsigned short)qv[7])<<16)*k1.w; }
        a_+=__shfl_xor(a_,32); }
      gt_[n]=(n<qb)?a_:-1e30f; }
    #pragma unroll
    for(int r_=0;r_<3;++r_){ float bv=-3.0e38f; int best=-1;
      #pragma unroll
      for(int n=0;n<8;++n) if(!((sel>>n)&1u)&&gt_[n]>bv){bv=gt_[n];best=n;}
      if(best>=0&&bv>-0.5e30f) sel|=1u<<best; } }
  if(hi==0)wsf[32+r32]=__uint_as_float(sel); asm volatile("s_waitcnt lgkmcnt(0)":::"memory");
  float mhat=0.f,l_reg=0.f;f32x16 o[2];o[0]=f32x16{};o[1]=f32x16{};
  const int qrel=wid*QBLK+r32;
  #define CMASK(P0,P1,t) do{ if((t)<4){cmask(P0,P1,(t),qrel,hi);} else if(!((__float_as_uint(wsf[32+r32])>>(((t)-4)>>2))&1u)){ _Pragma("unroll") for(int r_=0;r_<16;++r_){P0[r_]=-INFINITY;P1[r_]=-INFINITY;} } }while(0)
  bool resc=false;
  #define START(P0,P1) do{ const float rm=rowmax(P0,P1); resc=false; \
    { const float dl=rm; mhat=fadd_s(mhat,dl); \
      _Pragma("unroll") for(int r=0;r<16;++r){P0[r]=fsub_s(P0[r],dl);P1[r]=fsub_s(P1[r],dl);} \
      } \
    _Pragma("unroll") for(int r=0;r<16;++r)P0[r]=__builtin_amdgcn_exp2f(P0[r]); }while(0)
  #define RESC() do{ if(resc){ asm volatile("s_waitcnt lgkmcnt(0)":::"memory"); \
      _Pragma("unroll") for(int d_=0;d_<2;++d_) _Pragma("unroll") for(int r=0;r<16;++r)o[d_][r]*=wsf[crow(r,hi)]; } }while(0)
  f32x16 pA0,pA1,pB0,pB1;
  int sl_prev=0,sl_cur=0,sl_next=SLOTB;
  #define ROT() do{sl_prev=sl_cur;sl_cur=sl_next;sl_next=(sl_next==(NSLOT-1)*SLOTB)?0:sl_next+SLOTB;}while(0)
  DMA_K(2,2*SLOTB);
  WAIT_BAR(3);
  qkt(pA0,pA1,Kbase,qr,r32,hi);asm volatile("s_nop 15\n\ts_nop 7":"+v"(pA0),"+v"(pA1));CMASK(pA0,pA1,0);
  START(pA0,pA1);
  _Pragma("unroll") for(int r=0;r<16;++r)pA1[r]=__builtin_amdgcn_exp2f(pA1[r]);
  WAIT_BAR(0);
  DMA_K(3,0);DMA_V(1,SLOTB);
  ROT();
  kload8(kf,kp0+sl_cur);
  WAIT_BAR(2);
  s16x4 vlo[8],vhi[8]; u32x4 pw0,pw1,pw2,pw3;
  #define PKW(P,B) cvtpk_s(P[B],P[B+1])
  #define PAF(k) __builtin_bit_cast(bf16x8,pw##k)
  #define VFR(i) (bf16x8){vlo[i][0],vlo[i][1],vlo[i][2],vlo[i][3],vhi[i][0],vhi[i][1],vhi[i][2],vhi[i][3]}
  #define PIN(x) asm volatile("":"+v"(x))
  #define MX3(a,b,c) __builtin_fmaxf(__builtin_fmaxf((a),(b)),(c))
  #define GAPA(MF,A0,A1,A2,A3,W0,W1,PW) do{ MF; sacc+=A0; sacc+=A1; sacc+=A2; sacc+=A3; PIN(sacc); W0; W1; PIN(PW); SBAR(); }while(0)
  #define EX(v) __builtin_amdgcn_exp2f(v)
  #define GAPB(MF,X,B) do{ MF; X[B]=EX(X[B]); X[B+1]=EX(X[B+1]); X[B+2]=EX(X[B+2]); X[B+3]=EX(X[B+3]); PIN(X); SBAR(); }while(0)
  #define VRD(i) do{ vlo[i]=vtr(vp_+(((i)>>2)*4096+((i)&3)*1024)); vhi[i]=vtr(vp_+(((i)>>2)*4096+((i)&3)*1024+512)); }while(0)
  #define KRD(G,j) do{ if(G){ kload2(kf,kp0+sl_next,j); SBAR(); } }while(0)
  #define STEP(C0,C1,P0,P1,t,GK,GV,GL) do{ SBAR(); \
    const lds_cptr vp_=vp0+sl_prev; \
    VRD(0); SBAR(); float sacc=(P0[0]+P0[1]); \
    GAPA(C0=__builtin_amdgcn_mfma_f32_32x32x16_bf16(kf[0],qr[0],f32x16{},0,0,0), P0[2],P0[3],P0[4],P0[5],     pw0[0]=PKW(P0,0), pw0[1]=PKW(P0,2), pw0); \
    VRD(4); SBAR(); GAPA(C1=__builtin_amdgcn_mfma_f32_32x32x16_bf16(kf[1],qr[0],f32x16{},0,0,0), P0[6],P0[7],P0[8],P0[9],     pw0[2]=PKW(P0,4), pw0[3]=PKW(P0,6), pw0); \
    VRD(1); SBAR(); GAPA(C0=__builtin_amdgcn_mfma_f32_32x32x16_bf16(kf[2],qr[1],C0,0,0,0),   P0[10],P0[11],P0[12],P0[13], pw1[0]=PKW(P0,8), pw1[1]=PKW(P0,10), pw1); \
    VRD(5); SBAR(); GAPA(C1=__builtin_amdgcn_mfma_f32_32x32x16_bf16(kf[3],qr[1],C1,0,0,0),   P0[14],P0[15],P1[0],P1[1],   pw1[2]=PKW(P0,12),pw1[3]=PKW(P0,14), pw1); \
    VRD(2); SBAR(); GAPA(C0=__builtin_amdgcn_mfma_f32_32x32x16_bf16(kf[4],qr[2],C0,0,0,0),   P1[2],P1[3],P1[4],P1[5],     pw2[0]=PKW(P1,0), pw2[1]=PKW(P1,2), pw2); \
    VRD(6); SBAR(); GAPA(C1=__builtin_amdgcn_mfma_f32_32x32x16_bf16(kf[5],qr[2],C1,0,0,0),   P1[6],P1[7],P1[8],P1[9],     pw2[2]=PKW(P1,4), pw2[3]=PKW(P1,6), pw2); \
    VRD(3); SBAR(); GAPA(C0=__builtin_amdgcn_mfma_f32_32x32x16_bf16(kf[6],qr[3],C0,0,0,0),   P1[10],P1[11],P1[12],P1[13], pw3[0]=PKW(P1,8), pw3[1]=PKW(P1,10), pw3); \
    VRD(7); SBAR(); GAPA(C1=__builtin_amdgcn_mfma_f32_32x32x16_bf16(kf[7],qr[3],C1,0,0,0),   P1[14],P1[15],0.f,0.f,       pw3[2]=PKW(P1,12),pw3[3]=PKW(P1,14), pw3); \
    l_reg+=sacc; \
    if(GK){DMA_K((t)+3,sl_cur);} if(GV){DMA_V((t)+1,sl_next);} \
    CMASK(C0,C1,t); \
    _Pragma("unroll") for(int r=0;r<16;++r){C0[r]-=mhat;C1[r]-=mhat;} \
    { float a=MX3(C0[0],C0[1],C1[0]),b=MX3(C0[2],C0[3],C1[1]); a=MX3(a,C1[2],C1[3]); \
      _Pragma("unroll") for(int r=4;r<16;r+=4){a=MX3(a,C0[r],C0[r+1]);b=MX3(b,C0[r+2],C0[r+3]);a=MX3(a,C1[r],C1[r+1]);b=MX3(b,C1[r+2],C1[r+3]);} \
      float rm=__builtin_fmaxf(a,b); { auto rr=__builtin_amdgcn_permlane32_swap(__float_as_uint(rm),__float_as_uint(rm),false,false); rm=__builtin_fmaxf(__uint_as_float(rr[0]),__uint_as_float(rr[1])); } \
      resc=false; \
      if(__builtin_expect(__any(rm>(float)THRL),0)){ const float dl=__builtin_fmaxf(rm,0.f); mhat+=dl; \
        _Pragma("unroll") for(int r=0;r<16;++r){C0[r]-=dl;C1[r]-=dl;} \
        const float f=__builtin_amdgcn_exp2f(-dl); l_reg*=f; if(hi==0)wsf[r32]=f; resc=true; } } \
    SBAR(); \
    GAPB(o[0]=__builtin_amdgcn_mfma_f32_32x32x16_bf16(PAF(0),VFR(0),o[0],0,0,0), C0,0); \
    GAPB(o[1]=__builtin_amdgcn_mfma_f32_32x32x16_bf16(PAF(0),VFR(4),o[1],0,0,0), C0,4); \
    KRD(GL,0); GAPB(o[0]=__builtin_amdgcn_mfma_f32_32x32x16_bf16(PAF(1),VFR(1),o[0],0,0,0), C0,8); \
    KRD(GL,1); GAPB(o[1]=__builtin_amdgcn_mfma_f32_32x32x16_bf16(PAF(1),VFR(5),o[1],0,0,0), C0,12); \
    KRD(GL,2); GAPB(o[0]=__builtin_amdgcn_mfma_f32_32x32x16_bf16(PAF(2),VFR(2),o[0],0,0,0), C1,0); \
    KRD(GL,3); GAPB(o[1]=__builtin_amdgcn_mfma_f32_32x32x16_bf16(PAF(2),VFR(6),o[1],0,0,0), C1,4); \
    GAPB(o[0]=__builtin_amdgcn_mfma_f32_32x32x16_bf16(PAF(3),VFR(3),o[0],0,0,0), C1,8); \
    GAPB(o[1]=__builtin_amdgcn_mfma_f32_32x32x16_bf16(PAF(3),VFR(7),o[1],0,0,0), C1,12); \
    }while(0)
  int t=1;
  for(;t+5<NT;t+=2){
    STEP(pB0,pB1,pA0,pA1,t,true,true,true);     WAIT_BAR(2); RESC(); ROT();
    STEP(pA0,pA1,pB0,pB1,t+1,true,true,true);   WAIT_BAR(2); RESC(); ROT();
  }
  #define ENDW(tt) do{ if((tt)+3<NT){WAIT_BAR(2);} else if((tt)+2<NT){WAIT_BAR(1);} else {WAIT_BAR(0);} }while(0)
  for(;t+1<NT;t+=2){
    STEP(pB0,pB1,pA0,pA1,t,(t+3<NT),(t+1<NT),(t+1<NT));       ENDW(t);   RESC(); ROT();
    STEP(pA0,pA1,pB0,pB1,t+1,(t+4<NT),(t+2<NT),(t+2<NT));     ENDW(t+1); RESC(); ROT();
  }
  STEP(pB0,pB1,pA0,pA1,NT-1,false,false,false); RESC();
  { float sacc=pB0[0]+pB0[1]; _Pragma("unroll") for(int r=2;r<16;++r)sacc+=pB0[r]; _Pragma("unroll") for(int r=0;r<16;++r)sacc+=pB1[r]; l_reg+=sacc;
    pw0=(u32x4){PKW(pB0,0),PKW(pB0,2),PKW(pB0,4),PKW(pB0,6)};pw1=(u32x4){PKW(pB0,8),PKW(pB0,10),PKW(pB0,12),PKW(pB0,14)};pw2=(u32x4){PKW(pB1,0),PKW(pB1,2),PKW(pB1,4),PKW(pB1,6)};pw3=(u32x4){PKW(pB1,8),PKW(pB1,10),PKW(pB1,12),PKW(pB1,14)};
    SBAR(); pv(o,(int)(unsigned)(size_t)vp0+sl_cur,PAF(0),PAF(1),PAF(2),PAF(3)); }
  #undef PKW
  #undef PAF
  #undef VFR
  #undef PIN
  #undef MX3
  #undef GAPA
  #undef GAPB
  #undef EX
  #undef VRD
  #undef KRD
  #undef STEP
  #undef ENDW
  {auto rr=__builtin_amdgcn_permlane32_swap(__float_as_uint(l_reg),__float_as_uint(l_reg),false,false);l_reg=__uint_as_float(rr[0])+__uint_as_float(rr[1]);}
  if(hi==0)wsf[32+r32]=l_reg;asm volatile("s_waitcnt lgkmcnt(0)":::"memory");
  float rli[16];
  #pragma unroll
  for(int r=0;r<16;++r)rli[r]=__builtin_amdgcn_rcpf(wsf[32+crow(r,hi)]);
  bf16*Ow=O+(rowbase+q0+wid*QBLK)*OP+h*D;
  { bf16*stg=(bf16*)(shm+LDS_OST)+wid*2048;
    #pragma unroll
    for(int r=0;r<16;++r){const int orow=crow(r,hi);
      #pragma unroll
      for(int d0=0;d0<2;++d0)stg[orow*64+d0*32+r32]=__float2bfloat16(o[d0][r]*rli[r]);}
    asm volatile("s_waitcnt lgkmcnt(0)":::"memory");
    #pragma unroll
    for(int i=0;i<4;++i){const int row=i*8+(lane>>3),ch=lane&7; const u32x4 v=*(const u32x4*)(stg+row*64+ch*8); ATTN_STORE16(Ow+(long)row*OP+ch*8,v);} }
  asm volatile("s_waitcnt lgkmcnt(0)\n\ts_barrier":::"memory");
  #undef DMA_K
  #undef DMA_V
  #undef TI
  #undef CMASK
  #undef START
  #undef RESC
  #undef ROT
}
constexpr int ATTN_LDS_BYTES=LDS_BYTES;
#undef SBAR
#undef WAIT_BAR
}
#undef LAS
constexpr int NB = DEBUG_BUILD ? 2 : 8;
constexpr int M_ = NB * SEQ;
constexpr int NSLOT = 2 * M_ + N_EXP * 256;
constexpr int PLD = 3072;
constexpr int FQ = 0, FK = 384, FV = 768, FZ = 1152, FGU = 1536, FGV = 1792, FXBC = 2048, FDT = 2944;
constexpr int NGU = 2 * D_FF, NGUE = 2 * D_FFE;

constexpr size_t al256(size_t x) { return (x + 255) & ~(size_t)255; }
constexpr size_t MiB = 1u << 20;
constexpr size_t O_CTL = 0, CTL_BYTES = 1 * MiB;
constexpr size_t O_RT = 1 * MiB;
constexpr size_t O_TE = O_RT + (size_t)M_ * 64, O_TP = O_TE + (size_t)M_ * 8, O_TS = O_TP + (size_t)M_ * 8, O_GS = O_TS + (size_t)M_ * 8;
constexpr size_t O_SP = O_GS + (size_t)M_ * 8;
constexpr size_t O_KM = O_SP + al256((size_t)NSLOT * 4);
constexpr size_t O_DT = O_KM + (size_t)2 * NB * ATT_H * NBLK * 64 * 4;
constexpr size_t O_WSB = al256(O_DT + (size_t)M_ * 24);
constexpr size_t O_HB = (O_WSB + (size_t)2 * GM_G * GM_CHUNK * GM_CHUNK * 2 + MiB - 1) / MiB * MiB;
constexpr size_t O_MWGU = O_HB + (size_t)M_ * DM * 2;
constexpr size_t O_WIN = O_MWGU + (size_t)N_EXP * NGUE * DM * 2;
constexpr size_t O_WOUT = O_WIN + (size_t)2 * PLD * DM * 2;
constexpr size_t O_WGU = O_WOUT + (size_t)2 * DM * DM * 2;
constexpr size_t O_WD = O_WGU + (size_t)NGU * DM * 2;
constexpr size_t O_SCR = O_WD + (size_t)DM * D_FF * 2;
constexpr size_t O_PROJ = O_SCR;
constexpr size_t O_XC = O_PROJ + (size_t)M_ * PLD * 2;
constexpr size_t O_MIXU = O_XC + (size_t)M_ * SSD_CW * 2;
constexpr size_t O_MIXB = O_MIXU + (size_t)M_ * DM * 4;
constexpr size_t O_VN = O_MIXB + (size_t)M_ * DM * 2;
constexpr size_t O_MIXEND = O_VN + (size_t)M_ * GM_W * 4;
constexpr size_t O_Y = O_SCR;
constexpr size_t O_ACT = O_Y + (size_t)M_ * DM * 4;
constexpr size_t O_XG = O_WIN;
constexpr size_t O_ACTM = O_XG + (size_t)NSLOT * DM * 2;
constexpr size_t O_MOEEND = O_ACTM + (size_t)NSLOT * D_FFE * 2;
constexpr size_t WS_END = O_MOEEND > O_MIXEND ? O_MOEEND : O_MIXEND;
static_assert(O_ACT + (size_t)M_ * D_FF * 2 <= O_MIXEND + (size_t)M_ * 4096, "act");
static_assert((size_t)NB * 16 * SSD_H * 8192 * 4 <= (size_t)M_ * SSD_CW * 2, "SSD states fit in the XC slot");
static_assert((size_t)NB * 32 * 768 * 4 <= (size_t)M_ * GM_W * 4, "dt/acum hand-off fits in the VN slot");
static_assert(WS_END <= 487000000ull, "workspace map exceeds the guaranteed size");
static_assert((size_t)N_EXP * DM * D_FFE * 2 <= (size_t)NBATCH * SEQ * DM * 4, "MWD fits in d_out");
constexpr int CW_BAR = 4096, CW_CNT = 1024, CW_Q = 1040, CW_ERR = 2048;

constexpr int RING_BYTES = 131072, MISC_OFF = RING_BYTES + 320, LDS_BYTES = 147456;

#define GAS __attribute__((address_space(1)))
#define LAS __attribute__((address_space(3)))
typedef GAS unsigned gu32;
#define RLX_AGENT __ATOMIC_RELAXED, __HIP_MEMORY_SCOPE_AGENT
#define LDS_WAIT() asm volatile("s_waitcnt lgkmcnt(0)" ::: "memory")

constexpr float QSCALE = 0.125f * 1.4426950408889634f;
constexpr int MOE_KSPLIT = 2, TAIL_UNITS = 128;
constexpr int TAIL_SLOTS = (TAIL_UNITS / 4) * 256;
constexpr float W8_GU = 32.f, W8_D = 128.f;
typedef unsigned char f8_t;
namespace fp {
using pg8::Unit; using pg8::BM; using pg8::HALF; typedef pg8::f32x4 f32x4; typedef pg8::u32x4 u32x4; typedef unsigned u32x2_f __attribute__((ext_vector_type(2)));
__device__ __forceinline__ unsigned pk2(float lo, float hi) { return pg8::cvt_pk_bf16(lo, hi); }
__device__ __forceinline__ unsigned pk4_f8(float a, float b, float c, float d) { int w = 0; w = __builtin_amdgcn_cvt_pk_fp8_f32(a, b, w, false); w = __builtin_amdgcn_cvt_pk_fp8_f32(c, d, w, true); return (unsigned)w; }
__device__ __forceinline__ float clamp8(float x) { return __builtin_amdgcn_fmed3f(x, -448.f, 448.f); }
__device__ __forceinline__ void st16_wt(void* p, u32x4 v) { asm volatile("global_store_dwordx4 %0, %1, off sc1\n\ts_nop 1" :: "v"(p), "v"(v) : "memory"); }
__device__ __forceinline__ float gelu_fast(float x) { const float u = 0.7978845608028654f * (x + 0.044715f * x * x * x); return x * __builtin_amdgcn_rcpf(1.f + __expf(-2.f * u)); }

struct EpiProj {
    static constexpr bool PERM = true, AFTER_DRAIN = false;
    bf16* O; const float* RT; float* KM2;
    __device__ __forceinline__ void operator()(const f32x4 (&acc)[2][2][4][2], const Unit& u, int wr, int wc, int fr, int fq) const {
        const int row0 = u.pm * BM + wr * 64 + fr, col0 = u.pn * BM + wc * 32 + 8 * fq;
        f32x4 ks[2][2];
#pragma unroll
        for (int i = 0; i < 2; ++i) { ks[i][0] = (f32x4){0.f, 0.f, 0.f, 0.f}; ks[i][1] = ks[i][0]; }
        const int mode = (u.pn < 3) ? 1 : ((u.pn == 6 || u.pn == 7) ? 2 : 0);
        const bool rl = ((wc & 1) == 0) && (fq < 2);
        const int i0 = (fq & 1) * 4;
#pragma unroll
        for (int ai = 0; ai < 2; ++ai) {
            float4 c4a[4], s4a[4];
#pragma unroll
            for (int i = 0; i < 4; ++i) { c4a[i] = make_float4(1.f, 1.f, 1.f, 1.f); s4a[i] = make_float4(0.f, 0.f, 0.f, 0.f); }
            if (mode == 1 && rl) {
#pragma unroll
                for (int i = 0; i < 4; ++i) { const int row = row0 + ai * HALF + i * 16; c4a[i] = *(const float4*)(RT + (size_t)row * 16 + i0); s4a[i] = *(const float4*)(RT + (size_t)row * 16 + 8 + i0); } }
#pragma unroll
            for (int m = 0; m < 4; ++m) { const int row = row0 + ai * HALF + m * 16;
                const float4 c4 = c4a[m], s4 = s4a[m];
#pragma unroll
                for (int bj = 0; bj < 2; ++bj) { f32x4 v0 = acc[ai][bj][m][0], v1 = acc[ai][bj][m][1];
                    if (mode == 1) { const f32x4 a = v0, b = v1;
                        v0[0] = a[0] * c4.x - a[1] * s4.x; v0[1] = a[1] * c4.x + a[0] * s4.x; v0[2] = a[2] * c4.y - a[3] * s4.y; v0[3] = a[3] * c4.y + a[2] * s4.y;
                        v1[0] = b[0] * c4.z - b[1] * s4.z; v1[1] = b[1] * c4.z + b[0] * s4.z; v1[2] = b[2] * c4.w - b[3] * s4.w; v1[3] = b[3] * c4.w + b[2] * s4.w; }
                    if (u.pn == 0 || (u.pn == 1 && bj == 0)) { v0 = v0 * QSCALE; v1 = v1 * QSCALE; }
                    else if (mode == 1) { ks[bj][0] += v0; ks[bj][1] += v1; }
                    if (mode == 2) {
#pragma unroll
                        for (int j = 0; j < 4; ++j) { v0[j] = gelu_fast(v0[j]); v1[j] = gelu_fast(v1[j]); } }
                    u32x4 w; w.x = pk2(v0[0], v0[1]); w.y = pk2(v0[2], v0[3]); w.z = pk2(v1[0], v1[1]); w.w = pk2(v1[2], v1[3]);
                    st16_wt(O + (size_t)row * PLD + col0 + bj * HALF, w); } } }
        if (u.pn == 1 || u.pn == 2) {
#pragma unroll
            for (int bj = 0; bj < 2; ++bj) { if (u.pn == 1 && bj == 0) continue;
#pragma unroll
                for (int n = 0; n < 2; ++n)
#pragma unroll
                    for (int j = 0; j < 4; ++j) { float x = ks[bj][n][j]; x += __shfl_xor(x, 1); x += __shfl_xor(x, 2); x += __shfl_xor(x, 4); x += __shfl_xor(x, 8); ks[bj][n][j] = x * (1.f / 256.f); }
                if (fr == 0) { const int kc = col0 + bj * HALF - FK; const int b = u.pm >> 3, nb = u.pm & 7;
                    float* dst = KM2 + (size_t)wr * (NB * ATT_H * NBLK * 64) + ((size_t)(b * ATT_H + (kc >> 6)) * NBLK + nb) * 64 + (kc & 63);
                    *(f32x4*)dst = ks[bj][0]; *(f32x4*)(dst + 4) = ks[bj][1]; } }
        }
    }
};
struct EpiAct {
    static constexpr bool PERM = true, AFTER_DRAIN = false;
    bf16* O; int ldc, ncol;
    __device__ __forceinline__ void operator()(const f32x4 (&acc)[2][2][4][2], const Unit& u, int wr, int wc, int fr, int fq) const {
        const int row0 = u.pm * BM + wr * 64 + fr, col0 = (u.pn % ncol) * HALF + wc * 32 + 8 * fq;
#pragma unroll
        for (int ai = 0; ai < 2; ++ai)
#pragma unroll
            for (int m = 0; m < 4; ++m) { const int row = row0 + ai * HALF + m * 16;
                const f32x4 g0 = acc[ai][0][m][0], g1 = acc[ai][0][m][1], u0 = acc[ai][1][m][0], u1 = acc[ai][1][m][1]; f32x4 a0, a1;
#pragma unroll
                for (int j = 0; j < 4; ++j) { a0[j] = g0[j] * __builtin_amdgcn_rcpf(1.f + __expf(-g0[j])) * u0[j]; a1[j] = g1[j] * __builtin_amdgcn_rcpf(1.f + __expf(-g1[j])) * u1[j]; }
                u32x4 w; w.x = pk2(a0[0], a0[1]); w.y = pk2(a0[2], a0[3]); w.z = pk2(a1[0], a1[1]); w.w = pk2(a1[2], a1[3]);
                *(u32x4*)(O + (size_t)row * ldc + col0) = w; }
    }
};
struct EpiAct8 {
    static constexpr bool PERM = true, AFTER_DRAIN = false;
    f8_t* O; int ldc, ncol;
    __device__ __forceinline__ void operator()(const f32x4 (&acc)[2][2][4][2], const Unit& u, int wr, int wc, int fr, int fq) const {
        const int row0 = u.pm * BM + wr * 64 + fr, col0 = (u.pn % ncol) * HALF + wc * 32 + 8 * fq;
        constexpr float s = 1.f / W8_GU, ke = -s * 1.4426950408889634f, is2 = W8_GU * W8_GU;
#pragma unroll
        for (int ai = 0; ai < 2; ++ai)
#pragma unroll
            for (int m = 0; m < 4; ++m) { const int row = row0 + ai * HALF + m * 16;
                const f32x4 g0 = acc[ai][0][m][0], g1 = acc[ai][0][m][1], u0 = acc[ai][1][m][0], u1 = acc[ai][1][m][1]; f32x4 a0, a1;
#pragma unroll
                for (int j = 0; j < 4; ++j) {
                    float p0 = g0[j] * u0[j], r0 = __builtin_amdgcn_rcpf(__builtin_fmaf(__builtin_amdgcn_exp2f(g0[j] * ke), is2, is2)); asm("" : "+v"(p0), "+v"(r0)); a0[j] = clamp8(p0 * r0);
                    float p1 = g1[j] * u1[j], r1 = __builtin_amdgcn_rcpf(__builtin_fmaf(__builtin_amdgcn_exp2f(g1[j] * ke), is2, is2)); asm("" : "+v"(p1), "+v"(r1)); a1[j] = clamp8(p1 * r1); }
                u32x2_f w; w.x = pk4_f8(a0[0], a0[1], a0[2], a0[3]); w.y = pk4_f8(a1[0], a1[1], a1[2], a1[3]);
                *(u32x2_f*)(O + (size_t)row * ldc + col0) = w; }
    }
};
struct EpiF32 {
    static constexpr bool PERM = false, AFTER_DRAIN = false;
    float* O; int ldc;
    __device__ __forceinline__ void operator()(const f32x4 (&acc)[2][2][4][2], const Unit& u, int wr, int wc, int fr, int fq) const {
        const int row0 = u.pm * BM + wr * 64 + fr, col0 = u.pn * BM + wc * 32 + 4 * fq;
#pragma unroll
        for (int ai = 0; ai < 2; ++ai)
#pragma unroll
            for (int m = 0; m < 4; ++m) { float* rp = O + (size_t)(row0 + ai * HALF + m * 16) * ldc + col0;
#pragma unroll
                for (int bj = 0; bj < 2; ++bj)
#pragma unroll
                    for (int n = 0; n < 2; ++n) *(f32x4*)(rp + bj * HALF + n * 16) = acc[ai][bj][m][n]; }
    }
};
struct EpiY {
    static constexpr bool PERM = true, AFTER_DRAIN = false;
    bf16* O; int ldc;
    __device__ __forceinline__ void operator()(const f32x4 (&acc)[2][2][4][2], const Unit& u, int wr, int wc, int fr, int fq) const {
        const int row0 = u.pm * BM + wr * 64 + fr, col0 = u.pn * BM + wc * 32 + 8 * fq;
#pragma unroll
        for (int ai = 0; ai < 2; ++ai)
#pragma unroll
            for (int m = 0; m < 4; ++m) { bf16* rp = O + (size_t)(row0 + ai * HALF + m * 16) * ldc + col0;
#pragma unroll
                for (int bj = 0; bj < 2; ++bj) { const f32x4 v0 = acc[ai][bj][m][0], v1 = acc[ai][bj][m][1];
                    u32x4 w; w.x = pk2(v0[0], v0[1]); w.y = pk2(v0[2], v0[3]); w.z = pk2(v1[0], v1[1]); w.w = pk2(v1[2], v1[3]);
                    st16_wt(rp + bj * HALF, w); } }
    }
};
struct EpiY8 {
    static constexpr bool PERM = true, AFTER_DRAIN = false;
    bf16* O; int ldc;
    __device__ __forceinline__ void operator()(const f32x4 (&acc)[2][2][4][2], const Unit& u, int wr, int wc, int fr, int fq) const {
        const int row0 = u.pm * BM + wr * 64 + fr, col0 = u.pn * BM + wc * 32 + 8 * fq; constexpr float s = 1.f / W8_D;
#pragma unroll
        for (int ai = 0; ai < 2; ++ai)
#pragma unroll
            for (int m = 0; m < 4; ++m) { bf16* rp = O + (size_t)(row0 + ai * HALF + m * 16) * ldc + col0;
#pragma unroll
                for (int bj = 0; bj < 2; ++bj) { const f32x4 v0 = acc[ai][bj][m][0] * s, v1 = acc[ai][bj][m][1] * s;
                    u32x4 w; w.x = pk2(v0[0], v0[1]); w.y = pk2(v0[2], v0[3]); w.z = pk2(v1[0], v1[1]); w.w = pk2(v1[2], v1[3]);
                    st16_wt(rp + bj * HALF, w); } }
    }
};
struct EpiF2 {
    static constexpr bool PERM = true, AFTER_DRAIN = false;
    bf16* O; const float* SP; bf16* FP; int slot0, klen; float osc;
    __device__ __forceinline__ void operator()(const f32x4 (&acc)[2][2][4][2], const Unit& u, int wr, int wc, int fr, int fq) const {
        const int row0 = u.pm * BM + wr * 64 + fr, col0 = (u.pn & 3) * BM + wc * 32 + 8 * fq;
        bf16* base = O; int rsub = 0;
        if (u.kofs > 0) { const int part = u.kofs / klen; base = FP + (size_t)(part - 1) * TAIL_SLOTS * DM; rsub = slot0; }
        float spv[8];
#pragma unroll
        for (int i = 0; i < 8; ++i) spv[i] = SP[row0 + (i >> 2) * HALF + (i & 3) * 16] * osc;
#pragma unroll
        for (int ai = 0; ai < 2; ++ai)
#pragma unroll
            for (int m = 0; m < 4; ++m) { const int row = row0 + ai * HALF + m * 16; const float sc = spv[ai * 4 + m];
#pragma unroll
                for (int bj = 0; bj < 2; ++bj) { const f32x4 v0 = acc[ai][bj][m][0] * sc, v1 = acc[ai][bj][m][1] * sc;
                    u32x4 w; w.x = pk2(v0[0], v0[1]); w.y = pk2(v0[2], v0[3]); w.z = pk2(v1[0], v1[1]); w.w = pk2(v1[2], v1[3]);
                    st16_wt(base + (size_t)(row - rsub) * DM + col0 + bj * HALF, w); } }
    }
};
static_assert(NGUE / 256 == 28 && DM / 256 == 4, "MoeOrder::next decodes units for 28 or 4 column tiles");
struct MoeOrder {
    int p0, p1, p2, p3, p4, p5, p6, T, ncol, G, c, nfull, ksplit, klen;
    __device__ __forceinline__ void init(const int* CNT, int ncol_, int G_, int c_) {
        int t = 0; t += (CNT[0] + 255) >> 8; p0 = t; t += (CNT[1] + 255) >> 8; p1 = t; t += (CNT[2] + 255) >> 8; p2 = t; t += (CNT[3] + 255) >> 8; p3 = t;
        t += (CNT[4] + 255) >> 8; p4 = t; t += (CNT[5] + 255) >> 8; p5 = t; t += (CNT[6] + 255) >> 8; p6 = t; t += (CNT[7] + 255) >> 8; T = t; ncol = ncol_; G = G_; c = c_;
        p0 = __builtin_amdgcn_readfirstlane(p0); p1 = __builtin_amdgcn_readfirstlane(p1); p2 = __builtin_amdgcn_readfirstlane(p2); p3 = __builtin_amdgcn_readfirstlane(p3);
        p4 = __builtin_amdgcn_readfirstlane(p4); p5 = __builtin_amdgcn_readfirstlane(p5); p6 = __builtin_amdgcn_readfirstlane(p6); T = __builtin_amdgcn_readfirstlane(T);
        nfull = T * ncol; ksplit = 1; klen = 0;
    }
    __device__ __forceinline__ int tail_start() const { const int tot = T * ncol, nf = (tot / G) * G; return (tot - nf <= TAIL_UNITS) ? nf : tot; }
    __device__ __forceinline__ bool next(int i, Unit& u) const {
        int L = i * G + c; int part = 0;
        if (ksplit == 1) { if (L >= nfull) return false; }
        else { const int sh = (ksplit == 4) ? 2 : 1; if (L >= ((T * ncol - nfull) << sh)) return false; part = L & (ksplit - 1); L = nfull + (L >> sh); }
        const int tm = (ncol == 4) ? (L >> 2) : (int)((unsigned)L / 28u), j = L - tm * ncol;
        const int e = (tm >= p0) + (tm >= p1) + (tm >= p2) + (tm >= p3) + (tm >= p4) + (tm >= p5) + (tm >= p6);
        u.pm = tm; u.pn = e * ncol + j; u.kofs = part * klen; return true;
    }
    __device__ __forceinline__ void a_ready(const Unit&) const {}
    __device__ __forceinline__ void done(const Unit&) const {}
};

struct SrcCol { const float* p; int ld; };
__device__ __forceinline__ int win_src_col(int d) {
    if (d < 768) { const int hd = d & 63; const int sd = hd < 16 ? ((hd & 1) ? 8 + (hd >> 1) : (hd >> 1)) : hd; return d - hd + sd; }
    if (d < 1536) return d;
    if (d < 1792) return 2438 + (d - 1536);
    if (d < 2048) return 2694 + (d - 1792);
    if (d < 2944) return 1536 + (d - 2048);
    if (d < 2950) return 2432 + (d - 2944);
    return -1;
}
__device__ __forceinline__ SrcCol gu_src(const float* wg, const float* wu, int nff, int r) {
    const int tile = r >> 8, rr = r & 255, j = tile * 128 + (rr & 127); SrcCol s; s.p = (rr < 128 ? wg : wu) + j; s.ld = nff; return s;
}
__device__ __forceinline__ void conv_item(SrcCol sc, int K, bf16* WT, long d0, int k0, LAS float* scr, int lane) {
    float tv[32];
#pragma unroll
    for (int i = 0; i < 32; ++i) { const int kk = 2 * i + (lane >> 5); tv[i] = sc.p ? __builtin_nontemporal_load(sc.p + (size_t)(k0 + kk) * sc.ld) : 0.f; }
#pragma unroll
    for (int i = 0; i < 32; ++i) { const int kk = 2 * i + (lane >> 5); scr[kk * 33 + (lane & 31)] = tv[i]; }
    LDS_WAIT(); asm volatile("" ::: "memory");
    const int c = lane & 7;
#pragma unroll
    for (int j = 0; j < 4; ++j) { const int n = (lane >> 3) + 8 * j; const LAS float* s = scr + (8 * c) * 33 + n;
        u32x4 o; o.x = pk2(s[0 * 33], s[1 * 33]); o.y = pk2(s[2 * 33], s[3 * 33]); o.z = pk2(s[4 * 33], s[5 * 33]); o.w = pk2(s[6 * 33], s[7 * 33]);
        __builtin_nontemporal_store(o, (u32x4*)(WT + (size_t)(d0 + n) * K + k0 + 8 * c)); }
    LDS_WAIT(); asm volatile("" ::: "memory");
}
__device__ __forceinline__ void conv_item8(SrcCol sc, int K  , f8_t* WT, long d0, int k0, float scale, LAS float* scr, int lane) {
    float ta[32], tb[32];
#pragma unroll
    for (int i = 0; i < 32; ++i) { const int kk = 2 * i + (lane >> 5); const size_t kr = (size_t)(k0 + 16 * (kk >> 3) + (kk & 7));
        ta[i] = __builtin_nontemporal_load(sc.p + kr * sc.ld); tb[i] = __builtin_nontemporal_load(sc.p + (kr + 8) * sc.ld); }
    const int c = lane & 7; unsigned pa[4][2];
#pragma unroll
    for (int i = 0; i < 32; ++i) { const int kk = 2 * i + (lane >> 5); scr[kk * 33 + (lane & 31)] = ta[i]; }
    LDS_WAIT(); asm volatile("" ::: "memory");
#pragma unroll
    for (int j = 0; j < 4; ++j) { const int n = (lane >> 3) + 8 * j; const LAS float* s = scr + (8 * c) * 33 + n;
        pa[j][0] = pk4_f8(clamp8(s[0 * 33] * scale), clamp8(s[1 * 33] * scale), clamp8(s[2 * 33] * scale), clamp8(s[3 * 33] * scale));
        pa[j][1] = pk4_f8(clamp8(s[4 * 33] * scale), clamp8(s[5 * 33] * scale), clamp8(s[6 * 33] * scale), clamp8(s[7 * 33] * scale)); }
    LDS_WAIT(); asm volatile("" ::: "memory");
#pragma unroll
    for (int i = 0; i < 32; ++i) { const int kk = 2 * i + (lane >> 5); scr[kk * 33 + (lane & 31)] = tb[i]; }
    LDS_WAIT(); asm volatile("" ::: "memory");
#pragma unroll
    for (int j = 0; j < 4; ++j) { const int n = (lane >> 3) + 8 * j; const LAS float* s = scr + (8 * c) * 33 + n;
        u32x4 o; o.x = pa[j][0]; o.y = pa[j][1];
        o.z = pk4_f8(clamp8(s[0 * 33] * scale), clamp8(s[1 * 33] * scale), clamp8(s[2 * 33] * scale), clamp8(s[3 * 33] * scale));
        o.w = pk4_f8(clamp8(s[4 * 33] * scale), clamp8(s[5 * 33] * scale), clamp8(s[6 * 33] * scale), clamp8(s[7 * 33] * scale));
        __builtin_nontemporal_store(o, (u32x4*)(WT + (size_t)(d0 + n) * K + k0 + 16 * c)); }
    LDS_WAIT(); asm volatile("" ::: "memory");
}
}


typedef short bf16x8_t __attribute__((ext_vector_type(8)));
typedef float f32x4_t __attribute__((ext_vector_type(4)));
constexpr int TLD = 272;
__device__ __forceinline__ bf16x8_t lds_frag(const LAS unsigned char* base, int row, int kbyte) { return *(const LAS bf16x8_t*)(base + row * TLD + kbyte); }
__device__ __forceinline__ float red16(float v) { return row16_sum(v); }

__device__ __forceinline__ void gm_unit(int b, int c, const bf16* PROJ, const bf16* WSB  , const float* ln_g, const float* ln_b, const float* b_s, const float* norm_g,
                                        bf16* MIXB, LAS unsigned char* lds, int wave, int lane) {
    const long r0 = (long)b * SEQ + c * GM_CHUNK;
    LAS unsigned char* VNT = lds;
    { float4 vv[16];
#pragma unroll
      for (int i = 0; i < 16; ++i) vv[i] = ld4(PROJ + (r0 + wave * 16 + i) * PLD + FGV + lane * 4);
      const float4 gg = *(const float4*)(ln_g + lane * 4), bb = *(const float4*)(ln_b + lane * 4);
#pragma unroll
      for (int i = 0; i < 16; ++i) { const int t = wave * 16 + i; const float4 v = vv[i];
        const float mean = wave_sum((v.x + v.y) + (v.z + v.w)) * (1.f / 256.f);
        const float d0 = v.x - mean, d1 = v.y - mean, d2 = v.z - mean, d3 = v.w - mean;
        const float rstd = rsqrtf(wave_sum((d0 * d0 + d1 * d1) + (d2 * d2 + d3 * d3)) * (1.f / 256.f) + 1e-5f);
        LAS bf16* dst = (LAS bf16*)(VNT + (lane * 4) * TLD) + t;
        dst[0] = (bf16)f2bf(d0 * rstd * gg.x + bb.x); dst[TLD / 2] = (bf16)f2bf(d1 * rstd * gg.y + bb.y); dst[TLD] = (bf16)f2bf(d2 * rstd * gg.z + bb.z); dst[3 * TLD / 2] = (bf16)f2bf(d3 * rstd * gg.w + bb.w); } }
    __syncthreads();
    f32x4_t acc[16];
#pragma unroll
    for (int i = 0; i < 16; ++i) acc[i] = (f32x4_t){0.f, 0.f, 0.f, 0.f};
    const int fr = lane & 15, fq = lane >> 4;
    const int nks = (wave * 16 + 15) / 32 + 1;
    for (int ks = 0; ks < nks; ++ks) {
#pragma unroll
        for (int g = 0; g < 4; ++g) {
            const bf16x8_t af = *(const bf16x8_t*)(WSB + ((size_t)g * GM_CHUNK + wave * 16 + fr) * GM_CHUNK + ks * 32 + fq * 8);
#pragma unroll
            for (int n = 0; n < 4; ++n) { const bf16x8_t bfv = lds_frag(VNT, g * 64 + n * 16 + fr, ks * 64 + fq * 16);
                acc[g * 4 + n] = __builtin_amdgcn_mfma_f32_16x16x32_bf16(af, bfv, acc[g * 4 + n], 0, 0, 0); }
        }
    }
    __syncthreads();
    LAS bf16* ost = (LAS bf16*)(lds + wave * (16 * 264 * 2));
    float ss[4] = {0.f, 0.f, 0.f, 0.f};
#pragma unroll
    for (int nt = 0; nt < 16; ++nt) { const int col = nt * 16 + fr, g = nt >> 2;
#pragma unroll
        for (int r = 0; r < 4; ++r) { const int t = wave * 16 + fq * 4 + r;
            const float u = ldf(PROJ + (r0 + t) * PLD + FGU + col);
            const float o = u * (acc[nt][r] + b_s[g * GM_CHUNK + t]); acc[nt][r] = o; ss[r] += o * o; } }
#pragma unroll
    for (int r = 0; r < 4; ++r) ss[r] = rsqrtf(red16(ss[r]) * (1.f / 256.f) + 1e-5f);
#pragma unroll
    for (int nt = 0; nt < 16; ++nt) { const int col = nt * 16 + fr; const float gn = norm_g[col];
#pragma unroll
        for (int r = 0; r < 4; ++r) { ost[(fq * 4 + r) * 264 + col] = (bf16)f2bf(acc[nt][r] * ss[r] * gn); } }
    LDS_WAIT(); asm volatile("" ::: "memory");
#pragma unroll
    for (int i = 0; i < 8; ++i) { const int rr = i * 2 + (lane >> 5), ch = lane & 31;
        const fp::u32x4 v = *(const LAS fp::u32x4*)(ost + rr * 264 + ch * 8);
        *(fp::u32x4*)(MIXB + (r0 + wave * 16 + rr) * DM + ATT_W + SSD_W + ch * 8) = v; }
    __syncthreads();
}

typedef short v4i16_t __attribute__((ext_vector_type(4)));
typedef unsigned u32x2_t __attribute__((ext_vector_type(2)));
__device__ __forceinline__ v4i16_t lds_tr(const LAS unsigned char* p) { return __builtin_amdgcn_ds_read_tr16_b64_v4i16((LAS v4i16_t*)p); }
__device__ __forceinline__ bf16x8_t lds_frag_tr(const LAS unsigned char* tile, int pitch, int k0, int c0, int lane) {
    const int kg = lane >> 4, q = (lane & 15) >> 2, p = lane & 3;
    const LAS unsigned char* a = tile + (k0 + 8 * kg + q) * pitch + (c0 + 4 * p) * 2;
    const v4i16_t lo = lds_tr(a), hi = lds_tr(a + 4 * pitch);
    return (bf16x8_t){lo[0], lo[1], lo[2], lo[3], hi[0], hi[1], hi[2], hi[3]};
}
__device__ __forceinline__ bf16x8_t lds_frag_p(const LAS unsigned char* base, int pitch, int row, int kbyte) { return *(const LAS bf16x8_t*)(base + row * pitch + kbyte); }
template <int NCH, bool SCALE, bool TOLDS> __device__ __forceinline__ void conv_rows(const bf16* PROJ, long r0, int t0, int colbase, int ch0, const float* cw, const float* cb, LAS unsigned char* tile, int pitch,
                                                                                       const LAS float* scl, bf16* XCg  , int tid) {
    constexpr int CPR = NCH / 8, RG = 512 / CPR, RPT = (128 + RG - 1) / RG;
    if (tid < CPR * RG) { const int ch = (tid % CPR) * 8, l0 = (tid / CPR) * RPT;
        float w[4][8], bs[8];
        { const float4 c0 = *(const float4*)(cb + ch0 + ch), c1 = *(const float4*)(cb + ch0 + ch + 4); bs[0] = c0.x; bs[1] = c0.y; bs[2] = c0.z; bs[3] = c0.w; bs[4] = c1.x; bs[5] = c1.y; bs[6] = c1.z; bs[7] = c1.w; }
#pragma unroll
        for (int i = 0; i < 4; ++i) { const float4 w0 = *(const float4*)(cw + i * SSD_CW + ch0 + ch), w1 = *(const float4*)(cw + i * SSD_CW + ch0 + ch + 4);
            w[i][0] = w0.x; w[i][1] = w0.y; w[i][2] = w0.z; w[i][3] = w0.w; w[i][4] = w1.x; w[i][5] = w1.y; w[i][6] = w1.z; w[i][7] = w1.w; }
        fp::u32x4 xr[RPT + 3];
#pragma unroll
        for (int j = 0; j < RPT + 3; ++j) { const int l = l0 - 3 + j; xr[j] = (fp::u32x4){0u, 0u, 0u, 0u};
            if (l < 128 && t0 + l >= 0) xr[j] = *(const fp::u32x4*)(PROJ + (r0 + l) * PLD + colbase + ch); }
#pragma unroll
        for (int j = 0; j < RPT; ++j) { const int l = l0 + j; if (l < 128) {
            float a[8];
#pragma unroll
            for (int e = 0; e < 8; ++e) a[e] = bs[e];
#pragma unroll
            for (int i = 0; i < 4; ++i) { const fp::u32x4 xv = xr[j + i];
#pragma unroll
                for (int e = 0; e < 4; ++e) { a[2 * e] += w[i][2 * e] * __uint_as_float(xv[e] << 16); a[2 * e + 1] += w[i][2 * e + 1] * __uint_as_float(xv[e] & 0xffff0000u); } }
#pragma unroll
            for (int e = 0; e < 8; ++e) a[e] = a[e] * __builtin_amdgcn_rcpf(1.f + __expf(-a[e]));
            fp::u32x4 o; o.x = fp::pk2(a[0], a[1]); o.y = fp::pk2(a[2], a[3]); o.z = fp::pk2(a[4], a[5]); o.w = fp::pk2(a[6], a[7]);
            *(fp::u32x4*)(XCg + (r0 + l) * SSD_CW + ch) = o;
            if (TOLDS) { if (SCALE) { const float sc = scl[(ch >> 6) * 128 + l]; o.x = fp::pk2(a[0] * sc, a[1] * sc); o.y = fp::pk2(a[2] * sc, a[3] * sc); o.z = fp::pk2(a[4] * sc, a[5] * sc); o.w = fp::pk2(a[6] * sc, a[7] * sc); }
                *(LAS fp::u32x4*)(tile + l * pitch + ch * 2) = o; } } }
    }
}
template <int NCH> __device__ __forceinline__ void load_xc_tile(const bf16* XCg, long r0, LAS unsigned char* tile, int pitch, int tid) {
    constexpr int CPR = NCH / 8;
    for (int it = tid; it < 128 * CPR; it += 512) { const int l = it / CPR, ch = (it % CPR) * 8;
        *(LAS fp::u32x4*)(tile + l * pitch + ch * 2) = *(const fp::u32x4*)(XCg + (r0 + l) * SSD_CW + ch); }
}
__device__ __forceinline__ void ssd_dt_acum(const bf16* PROJ, long r0, int g, const float* dt_bias, const float* a_log, LAS float* dtS, LAS float* acS, int tid, int wave, int lane) {
    if (tid < 384) { const int hh = tid >> 7, l = tid & 127, h = 3 * g + hh;
        const float dtv = softplus_f(ldf(PROJ + (r0 + l) * PLD + FDT + h) + dt_bias[h]); dtS[tid] = dtv; acS[tid] = dtv * (-__expf(a_log[h])); }
    __syncthreads();
    if (wave < 3) { const float a0 = acS[wave * 128 + 2 * lane], a1 = acS[wave * 128 + 2 * lane + 1]; const float sm = a0 + a1; float v = sm;
#pragma unroll
        for (int o = 1; o < 64; o <<= 1) { const float t = __shfl_up(v, o); if (lane >= o) v += t; }
        const float ex = v - sm; acS[wave * 128 + 2 * lane] = ex + a0; acS[wave * 128 + 2 * lane + 1] = ex + sm; }
    __syncthreads();
}
constexpr int XP = 400;
__device__ __forceinline__ void ssdA_unit(int b, int c, int g, const bf16* PROJ, const float* cw, const float* cb, const float* dt_bias, const float* a_log, float* ST, float* CD, bf16* XC, float* DTG,
                                          LAS unsigned char* lds, int tid, int wave, int lane) {
    asm volatile("" : "+v"(tid), "+v"(lane));
    const long r0 = (long)b * SEQ + c * 128; const int t0 = c * 128;
    LAS unsigned char* XS = lds; LAS unsigned char* BS = lds + 51200;
    LAS float* dtS = (LAS float*)(lds + 86016); LAS float* acS = dtS + 384; LAS float* sclS = acS + 384;
    ssd_dt_acum(PROJ, r0, g, dt_bias, a_log, dtS, acS, tid, wave, lane);
    if (tid < 384) { const int hh = tid >> 7; const float al = acS[hh * 128 + 127]; sclS[tid] = dtS[tid] * __expf(al - acS[tid]);
        float* dg = DTG + (((long)b * 16 + c) * 2 + g) * 768; dg[tid] = dtS[tid]; dg[384 + tid] = acS[tid];
        if ((tid & 127) == 0) CD[((long)b * 16 + c) * SSD_H + 3 * g + hh] = __expf(al); }
    __syncthreads();
    conv_rows<192, true, true>(PROJ, r0, t0, FXBC + 192 * g, 192 * g, cw, cb, XS, XP, sclS, XC + 192 * g, tid);
    conv_rows<128, false, true>(PROJ, r0, t0, FXBC + SSD_W + 128 * g, SSD_W + 128 * g, cw, cb, BS, TLD, nullptr, XC + SSD_W + 128 * g, tid);
    conv_rows<128, false, false>(PROJ, r0, t0, FXBC + SSD_W + 256 + 128 * g, SSD_W + 256 + 128 * g, cw, cb, nullptr, 0, nullptr, XC + SSD_W + 256 + 128 * g, tid);
    __syncthreads();
    f32x4_t acc[12];
#pragma unroll
    for (int i = 0; i < 12; ++i) acc[i] = (f32x4_t){0.f, 0.f, 0.f, 0.f};
#pragma unroll 1
    for (int ks = 0; ks < 4; ++ks) { const bf16x8_t bfv = lds_frag_tr(BS, TLD, ks * 32, 16 * wave, lane);
#pragma unroll
        for (int mt = 0; mt < 12; ++mt) { const bf16x8_t af = lds_frag_tr(XS, XP, ks * 32, (mt >> 2) * 64 + (mt & 3) * 16, lane); acc[mt] = __builtin_amdgcn_mfma_f32_16x16x32_bf16(af, bfv, acc[mt], 0, 0, 0); } }
    const int fr = lane & 15, fq = lane >> 4;
    float* sp = ST + (((long)b * 16 + c) * SSD_H + 3 * g) * 8192 + 16 * wave + fr;
#pragma unroll
    for (int mt = 0; mt < 12; ++mt)
#pragma unroll
        for (int r = 0; r < 4; ++r) sp[(mt >> 2) * 8192 + ((mt & 3) * 16 + 4 * fq + r) * 128] = acc[mt][r];
    __syncthreads();
}
__device__ __forceinline__ void ssdB_unit(int b, int c, int g, const bf16* PROJ, const bf16* XC, const float* DTG, const float* dsk, const float* ng,
                                          const float* ST, const float* CD, bf16* MIXB, LAS unsigned char* lds, int tid, int wave, int lane) {
    const long r0 = (long)b * SEQ + c * 128;
    LAS unsigned char* CS = lds; LAS unsigned char* PX = lds + 34816; LAS unsigned char* BG = lds + 87040;
    LAS float* dtS = (LAS float*)(lds + 121856); LAS float* acS = dtS + 384;
    const int fr = lane & 15, fq = lane >> 4;
    if (tid < 384) { const float* dg = DTG + (((long)b * 16 + c) * 2 + g) * 768; dtS[tid] = dg[tid]; acS[tid] = dg[384 + tid]; }
    load_xc_tile<128>(XC + SSD_W + 256 + 128 * g, r0, CS, TLD, tid);
    if (c > 0) {
        float4 pv[12];
#pragma unroll
        for (int i = 0; i < 12; ++i) pv[i] = make_float4(0.f, 0.f, 0.f, 0.f);
        const float* sbase = ST + ((long)b * 16 * SSD_H + 3 * g) * 8192 + tid * 4; const float* cbase = CD + (long)b * 16 * SSD_H + 3 * g;
        int j = 0;
        for (; j + 2 < c; j += 3) { const float* s0 = sbase + (long)j * SSD_H * 8192; const float* c0 = cbase + j * SSD_H;
            float4 v0[12], v1[12], v2[12];
#pragma unroll
            for (int i = 0; i < 12; ++i) { v0[i] = *(const float4*)(s0 + i * 2048); v1[i] = *(const float4*)(s0 + SSD_H * 8192 + i * 2048); v2[i] = *(const float4*)(s0 + 2 * SSD_H * 8192 + i * 2048); }
            float dd[3][3];
#pragma unroll
            for (int q = 0; q < 3; ++q) { dd[q][0] = c0[q * SSD_H]; dd[q][1] = c0[q * SSD_H + 1]; dd[q][2] = c0[q * SSD_H + 2]; }
#pragma unroll
            for (int i = 0; i < 12; ++i) { const int hq = i >> 2;
                pv[i].x = ((pv[i].x * dd[0][hq] + v0[i].x) * dd[1][hq] + v1[i].x) * dd[2][hq] + v2[i].x;
                pv[i].y = ((pv[i].y * dd[0][hq] + v0[i].y) * dd[1][hq] + v1[i].y) * dd[2][hq] + v2[i].y;
                pv[i].z = ((pv[i].z * dd[0][hq] + v0[i].z) * dd[1][hq] + v1[i].z) * dd[2][hq] + v2[i].z;
                pv[i].w = ((pv[i].w * dd[0][hq] + v0[i].w) * dd[1][hq] + v1[i].w) * dd[2][hq] + v2[i].w; } }
        for (; j < c; ++j) { const float* s0 = sbase + (long)j * SSD_H * 8192; const float* c0 = cbase + j * SSD_H; const float d0 = c0[0], d1 = c0[1], d2 = c0[2];
#pragma unroll
            for (int i = 0; i < 12; ++i) { const float4 sv = *(const float4*)(s0 + i * 2048); const float d = (i < 4) ? d0 : ((i < 8) ? d1 : d2);
                pv[i].x = pv[i].x * d + sv.x; pv[i].y = pv[i].y * d + sv.y; pv[i].z = pv[i].z * d + sv.z; pv[i].w = pv[i].w * d + sv.w; } }
#pragma unroll
        for (int i = 0; i < 12; ++i) { const int row = (i >> 2) * 64 + (i & 3) * 16 + (tid >> 5), n = (tid & 31) * 4;
            u32x2_t w; w.x = fp::pk2(pv[i].x, pv[i].y); w.y = fp::pk2(pv[i].z, pv[i].w); *(LAS u32x2_t*)(PX + row * TLD + n * 2) = w; }
    }
    __syncthreads();
    f32x4_t acc_y[12];
#pragma unroll
    for (int i = 0; i < 12; ++i) acc_y[i] = (f32x4_t){0.f, 0.f, 0.f, 0.f};
    if (c > 0) {
#pragma unroll 1
        for (int ks = 0; ks < 4; ++ks) { const bf16x8_t af = lds_frag_p(CS, TLD, 16 * wave + fr, ks * 64 + fq * 16);
#pragma unroll
            for (int t = 0; t < 12; ++t) { const bf16x8_t bfv = lds_frag_p(PX, TLD, (t >> 2) * 64 + (t & 3) * 16 + fr, ks * 64 + fq * 16); acc_y[t] = __builtin_amdgcn_mfma_f32_16x16x32_bf16(af, bfv, acc_y[t], 0, 0, 0); } }
#pragma unroll
        for (int t = 0; t < 12; ++t)
#pragma unroll
            for (int r = 0; r < 4; ++r) acc_y[t][r] *= __expf(acS[(t >> 2) * 128 + 16 * wave + 4 * fq + r]);
    }
    __syncthreads();
    load_xc_tile<192>(XC + 192 * g, r0, PX, XP, tid);
    load_xc_tile<128>(XC + SSD_W + 128 * g, r0, BG, TLD, tid);
    __syncthreads();
#if defined(SSDB_CUT) && SSDB_CUT == 2
    { float t_ = 0.f; for (int i = 0; i < 12; ++i) t_ += acc_y[i][0] + acc_y[i][1] + acc_y[i][2] + acc_y[i][3]; if (t_ == 123.f) MIXB[0] = 1; return; }
#endif
    f32x4_t acc_cb[8];
#pragma unroll
    for (int i = 0; i < 8; ++i) acc_cb[i] = (f32x4_t){0.f, 0.f, 0.f, 0.f};
#pragma unroll 1
    for (int ks = 0; ks < 4; ++ks) { const bf16x8_t af = lds_frag_p(CS, TLD, 16 * wave + fr, ks * 64 + fq * 16);
#pragma unroll
        for (int ns = 0; ns < 8; ++ns) if (ns <= wave) { const bf16x8_t bfv = lds_frag_p(BG, TLD, 16 * ns + fr, ks * 64 + fq * 16); acc_cb[ns] = __builtin_amdgcn_mfma_f32_16x16x32_bf16(af, bfv, acc_cb[ns], 0, 0, 0); } }
    __syncthreads();
    LAS unsigned char* GS = BG + wave * 16 * TLD;
    const int nks = (16 * wave + 15) / 32 + 1;
#pragma unroll
    for (int hh = 0; hh < 3; ++hh) {
#pragma unroll
        for (int ns = 0; ns < 8; ++ns) if (ns <= (wave | 1)) {
#pragma unroll
            for (int r = 0; r < 4; ++r) { const int l = 16 * wave + 4 * fq + r, sidx = 16 * ns + fr;
                const float gv = (ns <= wave && sidx <= l) ? acc_cb[ns][r] * __expf(acS[hh * 128 + l] - acS[hh * 128 + sidx]) * dtS[hh * 128 + sidx] : 0.f;
                *(LAS bf16*)(GS + (4 * fq + r) * TLD + sidx * 2) = (bf16)f2bf(gv); } }
        LDS_WAIT(); asm volatile("" ::: "memory");
#pragma unroll 1
        for (int ks = 0; ks < nks; ++ks) { const bf16x8_t af = lds_frag_p(GS, TLD, fr, ks * 64 + fq * 16);
#pragma unroll
            for (int np = 0; np < 4; ++np) { const bf16x8_t bfv = lds_frag_tr(PX, XP, ks * 32, hh * 64 + np * 16, lane); acc_y[hh * 4 + np] = __builtin_amdgcn_mfma_f32_16x16x32_bf16(af, bfv, acc_y[hh * 4 + np], 0, 0, 0); } }
        LDS_WAIT(); asm volatile("" ::: "memory");
    }
#if defined(SSDB_CUT) && SSDB_CUT == 1
    { float t_ = 0.f; for (int i = 0; i < 12; ++i) t_ += acc_y[i][0] + acc_y[i][1] + acc_y[i][2] + acc_y[i][3]; if (t_ == 123.f) MIXB[0] = 1; return; }
#endif
#pragma unroll
    for (int t = 0; t < 12; ++t) { const int hh = t >> 2, col = hh * 64 + (t & 3) * 16 + fr; const float dk = dsk[3 * g + hh];
#pragma unroll
        for (int r = 0; r < 4; ++r) { const int l = 16 * wave + 4 * fq + r; acc_y[t][r] += dk * __uint_as_float(((unsigned)*(const LAS bf16*)(PX + l * XP + col * 2)) << 16); } }
    __syncthreads();
    LAS bf16* ost = (LAS bf16*)(lds + wave * (16 * XP));
#pragma unroll
    for (int t = 0; t < 12; ++t) { const int col = (t >> 2) * 64 + (t & 3) * 16 + fr;
#pragma unroll
        for (int r = 0; r < 4; ++r) ost[(4 * fq + r) * (XP / 2) + col] = (bf16)f2bf(acc_y[t][r]); }
    LDS_WAIT(); asm volatile("" ::: "memory");
    { const int rr = lane >> 2, q = lane & 3; const long row = r0 + 16 * wave + rr;
      float yz[48]; float ssum = 0.f;
#pragma unroll
      for (int i = 0; i < 6; ++i) { const int c8 = (q * 6 + i) * 8;
          const fp::u32x4 yv = *(const LAS fp::u32x4*)(ost + rr * (XP / 2) + c8);
          const fp::u32x4 zv = *(const fp::u32x4*)(PROJ + row * PLD + FZ + 192 * g + c8);
#pragma unroll
          for (int j = 0; j < 4; ++j) { const unsigned yw = yv[j], zw = zv[j];
              const float y0 = __uint_as_float(yw << 16), y1 = __uint_as_float(yw & 0xffff0000u), z0 = __uint_as_float(zw << 16), z1 = __uint_as_float(zw & 0xffff0000u);
              const float a0 = y0 * (z0 * __builtin_amdgcn_rcpf(1.f + __expf(-z0))), a1 = y1 * (z1 * __builtin_amdgcn_rcpf(1.f + __expf(-z1))); yz[i * 8 + 2 * j] = a0; yz[i * 8 + 2 * j + 1] = a1; ssum += a0 * a0 + a1 * a1; } }
      ssum += __shfl_xor(ssum, 1); ssum += __shfl_xor(ssum, 2);
      const float rinv = rsqrtf(ssum * (1.f / 192.f) + 1e-5f);
#pragma unroll
      for (int i = 0; i < 6; ++i) { const int c8 = (q * 6 + i) * 8;
          const float4 g0 = *(const float4*)(ng + 192 * g + c8), g1 = *(const float4*)(ng + 192 * g + c8 + 4);
          fp::u32x4 o; o.x = fp::pk2(yz[i * 8] * rinv * g0.x, yz[i * 8 + 1] * rinv * g0.y); o.y = fp::pk2(yz[i * 8 + 2] * rinv * g0.z, yz[i * 8 + 3] * rinv * g0.w);
          o.z = fp::pk2(yz[i * 8 + 4] * rinv * g1.x, yz[i * 8 + 5] * rinv * g1.y); o.w = fp::pk2(yz[i * 8 + 6] * rinv * g1.z, yz[i * 8 + 7] * rinv * g1.w);
          *(fp::u32x4*)(MIXB + row * DM + ATT_W + 192 * g + c8) = o; } }
    __syncthreads();
}

__device__ __forceinline__ void att_norm_phase(bf16* MIXB, const float* g, long n_rows, int gw_, int ngw_, int lane) {
    float4 g0 = make_float4(0.f, 0.f, 0.f, 0.f), g1 = g0; if (lane < 48) { g0 = *(const float4*)(g + lane * 8); g1 = *(const float4*)(g + lane * 8 + 4); }
    fp::u32x4 wa = (fp::u32x4){0u, 0u, 0u, 0u}, wb = wa; long r = gw_;
    if (r < n_rows && lane < 48) wa = *(const fp::u32x4*)(MIXB + r * DM + lane * 8);
#define ATTN_NORM_ROW(WV_, rr) do { float v[8]; float s2 = 0.f; \
        _Pragma("unroll") for (int j = 0; j < 4; ++j) { v[2 * j] = __uint_as_float(WV_[j] << 16); v[2 * j + 1] = __uint_as_float(WV_[j] & 0xffff0000u); s2 += v[2 * j] * v[2 * j] + v[2 * j + 1] * v[2 * j + 1]; } \
        const float rs = rsqrtf(wave_sum(s2) * (1.f / 384.f) + 1e-5f); \
        if (lane < 48) { fp::u32x4 o; o.x = fp::pk2(v[0] * rs * g0.x, v[1] * rs * g0.y); o.y = fp::pk2(v[2] * rs * g0.z, v[3] * rs * g0.w); o.z = fp::pk2(v[4] * rs * g1.x, v[5] * rs * g1.y); o.w = fp::pk2(v[6] * rs * g1.z, v[7] * rs * g1.w); \
            *(fp::u32x4*)(MIXB + (rr) * DM + lane * 8) = o; } } while (0)
    for (; r < n_rows; r += 2 * ngw_) { const long r1 = r + ngw_, r2 = r + 2 * ngw_;
        if (r1 < n_rows && lane < 48) wb = *(const fp::u32x4*)(MIXB + r1 * DM + lane * 8);
        ATTN_NORM_ROW(wa, r);
        if (r2 < n_rows && lane < 48) wa = *(const fp::u32x4*)(MIXB + r2 * DM + lane * 8);
        if (r1 < n_rows) ATTN_NORM_ROW(wb, r1); }
#undef ATTN_NORM_ROW
}

constexpr int FT_G = (DM / 128) * (N_EXP * NGUE / 32) / 8, FT_D = (D_FFE / 128) * (N_EXP * DM / 32) / 8;
constexpr int FT_G_A = 704, FT_G_B = 384, FT_D_A = 256, FT_D_D = 384;
__device__ __forceinline__ void filler_g(int t, const float* p_mg, const float* p_mu, f8_t* MWGU_, LAS float* scr, int wave, int lane_) {
    asm volatile("" : "+v"(lane_));
    const int r = t * 8 + wave; const int kb = r / (N_EXP * NGUE / 32), db = r % (N_EXP * NGUE / 32); const int d = db * 32 + (lane_ & 31), e = d / NGUE;
    fp::conv_item8(fp::gu_src(p_mg + (size_t)e * DM * D_FFE, p_mu + (size_t)e * DM * D_FFE, D_FFE, d - e * NGUE), DM, MWGU_, (long)db * 32, kb * 128, W8_GU, scr, lane_);
}
__device__ __forceinline__ void filler_d(int t, const float* p_md, f8_t* MWD_, LAS float* scr, int wave, int lane_) {
    asm volatile("" : "+v"(lane_));
    const int r = t * 8 + wave; const int kb = r / (N_EXP * DM / 32), db = r % (N_EXP * DM / 32); const int d = db * 32 + (lane_ & 31), e = d / DM;
    fp::SrcCol sc_; sc_.p = p_md + (size_t)e * D_FFE * DM + (d - e * DM); sc_.ld = DM; fp::conv_item8(sc_, D_FFE, MWD_, (long)db * 32, kb * 128, W8_D, scr, lane_);
}

__device__ __forceinline__ uint2 bf8_to_f8(const uint4 v) {
    uint2 o; o.x = fp::pk4_f8(__uint_as_float(v.x << 16), __uint_as_float(v.x & 0xffff0000u), __uint_as_float(v.y << 16), __uint_as_float(v.y & 0xffff0000u));
    o.y = fp::pk4_f8(__uint_as_float(v.z << 16), __uint_as_float(v.z & 0xffff0000u), __uint_as_float(v.w << 16), __uint_as_float(v.w & 0xffff0000u)); return o;
}
struct FArgs { const void* in[29]; float* out; unsigned char* ws; int ph_lo, ph_hi; };
__device__ __forceinline__ const void* ldarg(int k) { const void* p; asm volatile("s_load_dwordx2 %0, %1, %2\n\ts_waitcnt lgkmcnt(0)" : "=s"(p) : "s"(__builtin_amdgcn_kernarg_segment_ptr()), "i"(k * 8)); return p; }

constexpr int N_PHASES = 18;
__global__ void __launch_bounds__(512, 2) mega(FArgs a) {
    extern __shared__ __attribute__((aligned(16))) unsigned char lds_[];
    LAS unsigned char* lds = (LAS unsigned char*)lds_;
    const int wave = __builtin_amdgcn_readfirstlane((int)threadIdx.x >> 6);
#define lane ((int)__builtin_amdgcn_mbcnt_hi(~0u, __builtin_amdgcn_mbcnt_lo(~0u, 0u)))
#define tid (wave * 64 + lane)
    const int G = gridDim.x; const int bx = blockIdx.x;
#define vcu (((int)gridDim.x % 8 == 0) ? ((int)blockIdx.x % 8) * ((int)gridDim.x / 8) + (int)blockIdx.x / 8 : (int)blockIdx.x)
#define gw (vcu * 8 + wave)
#define ngw ((int)gridDim.x * 8)
#define gt ((long)gw * 64 + lane)
#define ngt ((long)ngw * 64)
    unsigned char* ws = a.ws;
    unsigned* ctl = (unsigned*)(ws + O_CTL);
    for (int u = (int)threadIdx.x; u < (LDS_BYTES - RING_BYTES) / 4; u += 512) ((LAS unsigned*)(lds + RING_BYTES))[u] = 0u;
    __syncthreads();
    const int lo = a.ph_lo, hi = a.ph_hi;
    XcdBarrier bar; bar.bar = ctl + CW_BAR; bar.x = 0; bar.st = nullptr; bar.w0 = 0;
    if (hi - lo > 1) bar = xcd_barrier_post(ctl + CW_BAR, (volatile LAS unsigned*)(lds + MISC_OFF) + 8);
#define in_x ((const float*)ldarg(0))
#define in_pos ((const int*)ldarg(1))
#define ln_in_g ((const float*)ldarg(2))
#define ln_in_b ((const float*)ldarg(3))
#define w_in ((const float*)ldarg(4))
#define conv_w ((const float*)ldarg(5))
#define conv_b ((const float*)ldarg(6))
#define dt_bias ((const float*)ldarg(7))
#define a_log ((const float*)ldarg(8))
#define d_skip ((const float*)ldarg(9))
#define ssd_norm_g ((const float*)ldarg(10))
#define att_norm_g ((const float*)ldarg(11))
#define gm_ln_g ((const float*)ldarg(12))
#define gm_ln_b ((const float*)ldarg(13))
#define gm_w_s ((const float*)ldarg(14))
#define gm_b_s ((const float*)ldarg(15))
#define gm_norm_g ((const float*)ldarg(16))
#define w_out ((const float*)ldarg(17))
#define ln1_g ((const float*)ldarg(18))
#define ln1_b ((const float*)ldarg(19))
#define ln2_g ((const float*)ldarg(20))
#define ln2_b ((const float*)ldarg(21))
#define ffn_w_gate ((const float*)ldarg(22))
#define ffn_w_up ((const float*)ldarg(23))
#define ffn_w_down ((const float*)ldarg(24))
#define router_w ((const float*)ldarg(25))
#define moe_w_gate ((const float*)ldarg(26))
#define moe_w_up ((const float*)ldarg(27))
#define moe_w_down ((const float*)ldarg(28))
#define H ((float*)WOUTP)
#define MWD ((f8_t*)WOUTP)
#define RT ((float*)(WSP + O_RT))
#define TE ((int*)(WSP + O_TE))
#define TP ((float*)(WSP + O_TP))
#define TS ((int*)(WSP + O_TS))
#define GS ((int*)(WSP + O_GS))
#define SP ((float*)(WSP + O_SP))
#define KM ((float*)(WSP + O_KM))
#define WSB ((bf16*)(WSP + O_WSB))
#define HB ((bf16*)(WSP + O_HB))
#define MWGU ((f8_t*)(WSP + O_MWGU))
#define WIN ((bf16*)(WSP + O_WIN))
#define WOUT ((bf16*)(WSP + O_WOUT))
#define WGU ((f8_t*)(WSP + O_WGU))
#define WD ((f8_t*)(WSP + O_WD))
#define PROJ ((bf16*)(WSP + O_PROJ))
#define ST ((float*)(WSP + O_XC))
#define CD ((float*)(WSP + O_DT))
#define XCB ((bf16*)(WSP + O_MIXU))
#define DTG ((float*)(WSP + O_VN))
#define MIXB ((bf16*)(WSP + O_MIXB))
#define YB ((bf16*)(WSP + O_Y))
#define ACT ((f8_t*)(WSP + O_ACT))
#define H8 ((f8_t*)(WSP + O_ACT + (size_t)M_ * D_FF))
#define XG ((f8_t*)(WSP + O_XG))
#define F2 ((bf16*)(WSP + O_XG))
#define ACTM ((f8_t*)(WSP + O_ACTM))
#define F2P ((bf16*)(WSP + O_MWGU))
#define CNT ((int*)(WSP + O_CTL + 4 * CW_CNT))
    const ProjL FL{PLD, FQ, FK, FV, FZ, FXBC, FDT, FGU, FGV};
    LAS float* scr = (LAS float*)(lds + wave * 16384);

#ifndef PH_MASK
#define PH_MASK 0xffffffffu
#endif
#ifndef PROBE_MASK
#define PROBE_MASK 0u
#endif
#ifndef PROBE_AMP
#define PROBE_AMP 0
#endif
    volatile unsigned* pr_w = (volatile unsigned*)(ctl + 1100);
#define pr_me ((PROBE_MASK != 0u) && blockIdx.x == 0 && wave == 0 && __builtin_amdgcn_mbcnt_hi(~0u, __builtin_amdgcn_mbcnt_lo(~0u, 0u)) == 0u)
#define PH_BEGIN(k) if (lo <= (k) && (k) < hi && ((PH_MASK >> (k)) & 1u)) { unsigned char* WSP = a.ws; unsigned char* WOUTP = (unsigned char*)a.out; asm volatile("" : "+s"(WSP), "+s"(WOUTP)); if (((PROBE_MASK >> (k)) & 1u) && pr_me) pr_w[0] = (unsigned)__builtin_amdgcn_s_memrealtime();
#define PH_END(k)   if ((k) + 1 < hi) xcd_barrier(bar); if (((PROBE_MASK >> (k)) & 1u) && pr_me) pr_w[1] += (unsigned)__builtin_amdgcn_s_memrealtime() - pr_w[0]; }

    PH_BEGIN(0)
    { const float* const p_w_in = w_in; const float* const p_w_out = w_out; const float* const p_fg = ffn_w_gate; const float* const p_fu = ffn_w_up; const float* const p_fd = ffn_w_down;
        constexpr int I_WIN = 16 * (PLD / 32), I_WOUT = 16 * (DM / 32), I_WGU = (DM / 128) * (NGU / 32), I_WD = (D_FF / 128) * (DM / 32), I_MWGU = 16 * (N_EXP * NGUE / 32);
        constexpr int NIT = 2 * I_WIN + 2 * I_WOUT + I_WGU + I_WD; (void)I_MWGU;
        for (int it = gw; it < NIT; it += ngw) {
            int r = it; const int l5 = lane & 31;
            if (r < 2 * I_WIN) { const int L = r / I_WIN; r -= L * I_WIN; const int kb = r / (PLD / 32), db = r % (PLD / 32); const int sc_ = fp::win_src_col(db * 32 + l5);
                fp::SrcCol s; s.p = sc_ >= 0 ? p_w_in + (size_t)L * DM * D_IN + sc_ : nullptr; s.ld = D_IN; fp::conv_item(s, DM, WIN + (size_t)L * PLD * DM, db * 32, kb * 64, scr, lane); continue; } r -= 2 * I_WIN;
            if (r < 2 * I_WOUT) { const int L = r / I_WOUT; r -= L * I_WOUT; const int kb = r / (DM / 32), db = r % (DM / 32);
                fp::SrcCol s; s.p = p_w_out + (size_t)L * DM * DM + db * 32 + l5; s.ld = DM; fp::conv_item(s, DM, WOUT + (size_t)L * DM * DM, db * 32, kb * 64, scr, lane); continue; } r -= 2 * I_WOUT;
            if (r < I_WGU) { const int kb = r / (NGU / 32), db = r % (NGU / 32);
                fp::conv_item8(fp::gu_src(p_fg, p_fu, D_FF, db * 32 + l5), DM, WGU, db * 32, kb * 128, W8_GU, scr, lane); continue; } r -= I_WGU;
            { const int kb = r / (DM / 32), db = r % (DM / 32);
                fp::SrcCol s; s.p = p_fd + db * 32 + l5; s.ld = DM; fp::conv_item8(s, D_FF, WD, db * 32, kb * 128, W8_D, scr, lane); }
        }
        const int* const p_pos = in_pos; const float* const p_gws = gm_w_s; const float* const p_x = in_x; const float* const p_lg = ln_in_g; const float* const p_lb = ln_in_b;
        for (long it = gt; it < (long)M_ * 8; it += ngt) { const int i = (int)(it & 7); const long row = it >> 3;
            const float inv = powf(500000.0f, -(float)(2 * i) / 16.0f); const float ang = (float)p_pos[row] * inv; RT[row * 16 + i] = cosf(ang); RT[row * 16 + 8 + i] = sinf(ang); }
        for (long it = gt; it < 2L * GM_G * GM_CHUNK * GM_CHUNK; it += ngt) { const int sidx = (int)(it & 127), t = (int)((it >> 7) & 127); WSB[it] = (bf16)(sidx <= t ? f2bf(p_gws[it]) : 0u); }
        { float va[16], vb[16]; LnGB gbp; ln_gb_load(gbp, p_lg, p_lb, lane); long r = gw; if (r < M_) ln_load<float, float, true>(va, p_x + r * DM, 1.f, nullptr, nullptr, lane);
          for (; r < M_; r += 2 * ngw) { const long r1 = r + ngw, r2 = r + 2 * ngw;
              if (r1 < M_) ln_load<float, float, true>(vb, p_x + r1 * DM, 1.f, nullptr, nullptr, lane);
              ln_finish_r(va, gbp, nullptr, HB + r * DM, lane);
              if (r2 < M_) ln_load<float, float, true>(va, p_x + r2 * DM, 1.f, nullptr, nullptr, lane);
              if (r1 < M_) ln_finish_r(vb, gbp, nullptr, HB + r1 * DM, lane); } }
    }
    PH_END(0)


    { constexpr int layer = 0; constexpr int PB = 1;
        PH_BEGIN(PB + 0)
        { pg8::Gemm g{HB, WIN + (size_t)layer * PLD * DM, M_, PLD, DM, DM}; pg8::StaticOrder S; S.init(M_, PLD, G, bx);
          fp::EpiProj E{PROJ, RT, KM}; pg8::gemm_phase<fp::EpiProj, pg8::StaticOrder, true, true>(lds, g, S, E, tid); }
        PH_END(PB + 0)
        PH_BEGIN(PB + 1)
        { constexpr int NATT = NB * ATT_H * NBLK, NSSDA = NB * 32;
          volatile LAS unsigned* qw = (volatile LAS unsigned*)(lds + MISC_OFF) + 16;
#define QNEXT(word) do { if (tid == 0) qw[0] = __hip_atomic_fetch_add(ctl + (word), 1u, __ATOMIC_RELAXED, __HIP_MEMORY_SCOPE_AGENT); __syncthreads(); idx = (int)qw[0]; __syncthreads(); } while (0)
          int idx;
          for (;;) { QNEXT(CW_Q + 8 * layer); if (idx >= NATT) break;
              const int qb = (NBLK - 1) - idx / (NB * ATT_H), bh = idx % (NB * ATT_H);
              attn_body::attn_unit<8>(bh / ATT_H, bh % ATT_H, qb, (const attn_body::bf16*)(PROJ + FQ), (const attn_body::bf16*)(PROJ + FK), (const attn_body::bf16*)(PROJ + FV), (attn_body::bf16*)MIXB, KM, NB * ATT_H * NBLK * 64, (char*)lds_, tid); }
          for (;;) { QNEXT(CW_Q + 8 * layer + 1); if (idx >= NSSDA) break;
              ssdA_unit(idx >> 5, (idx >> 1) & 15, idx & 1, PROJ, conv_w + (size_t)layer * 4 * SSD_CW, conv_b + layer * SSD_CW, dt_bias + layer * SSD_H, a_log + layer * SSD_H, ST, CD, XCB, DTG, lds, tid, wave, lane); }
        }
        PH_END(PB + 1)
        PH_BEGIN(PB + 2)
        { constexpr int NSSDB = NB * 32, NGMU = NB * (SEQ / GM_CHUNK);
          volatile LAS unsigned* qw = (volatile LAS unsigned*)(lds + MISC_OFF) + 16;
          int idx;
          for (;;) { QNEXT(CW_Q + 8 * layer + 2); if (idx >= NSSDB) break;
              const int c = 15 - idx / (NB * 2), bg = idx % (NB * 2);
              ssdB_unit(bg >> 1, c, bg & 1, PROJ, XCB, DTG, d_skip + layer * SSD_H, ssd_norm_g + layer * SSD_W, ST, CD, MIXB, lds, tid, wave, lane); }
          for (;;) { QNEXT(CW_Q + 8 * layer + 3); if (idx >= NGMU) break;
              gm_unit(idx / (SEQ / GM_CHUNK), idx % (SEQ / GM_CHUNK), PROJ, WSB + (size_t)layer * GM_G * GM_CHUNK * GM_CHUNK, gm_ln_g + layer * GM_W, gm_ln_b + layer * GM_W,
                      gm_b_s + layer * GM_G * GM_CHUNK, gm_norm_g + layer * GM_W, MIXB, lds, wave, lane); }
          att_norm_phase(MIXB, att_norm_g + layer * ATT_W, M_, gw, ngw, lane);
          { const float* const p_mg = moe_w_gate; const float* const p_mu = moe_w_up; const float* const p_md = moe_w_down;
            constexpr int g0 = layer == 0 ? 0 : FT_G_A + FT_G_B, g1 = layer == 0 ? FT_G_A : FT_G, d0 = layer == 0 ? 0 : FT_D_A, d1 = layer == 0 ? FT_D_A : FT_D - FT_D_D;
            for (;;) { QNEXT(CW_Q + 8 * layer + 4); if (idx >= g1 - g0) break; filler_g(g0 + idx, p_mg, p_mu, MWGU, scr, wave, lane); }
            for (;;) { QNEXT(CW_Q + 8 * layer + 5); if (idx >= d1 - d0) break; filler_d(d0 + idx, p_md, MWD, scr, wave, lane); } }
#undef QNEXT
        }
        PH_END(PB + 2)
        PH_BEGIN(PB + 3)
        { pg8::Gemm g{MIXB, WOUT + (size_t)layer * DM * DM, M_, DM, DM, DM}; pg8::StaticOrder S; S.init(M_, DM, G, bx);
          fp::EpiY E{YB, DM}; pg8::gemm_phase<fp::EpiY, pg8::StaticOrder, false, true>(lds, g, S, E, tid); }
        PH_END(PB + 3)
        PH_BEGIN(PB + 4)
        { const float* const p_g = ln1_g + layer * DM; const float* const p_b = ln1_b + layer * DM;
          { float va[16], vb[16]; LnGB gbp; ln_gb_load(gbp, p_g, p_b, lane); long r = gw; if (r < M_) ln_load<bf16, bf16>(va, HB + r * DM, ALPHA, YB + r * DM, nullptr, lane);
            for (; r < M_; r += 2 * ngw) { const long r1 = r + ngw, r2 = r + 2 * ngw;
                if (r1 < M_) ln_load<bf16, bf16>(vb, HB + r1 * DM, ALPHA, YB + r1 * DM, nullptr, lane);
                ln_finish_r(va, gbp, nullptr, HB + r * DM, lane, layer == 0 ? H8 + r * DM : nullptr);
                if (r2 < M_) ln_load<bf16, bf16>(va, HB + r2 * DM, ALPHA, YB + r2 * DM, nullptr, lane);
                if (r1 < M_) ln_finish_r(vb, gbp, nullptr, HB + r1 * DM, lane, layer == 0 ? H8 + r1 * DM : nullptr); } }
          if (layer == 1) { asm volatile("s_waitcnt vmcnt(0)" ::: "memory"); moe_route_block(HB, router_w, CNT, TE, TP, TS, M_, gw, ngw, lane, wave, tid, (LAS int*)lds); } }
        PH_END(PB + 4)
        if constexpr (layer == 0) {
            PH_BEGIN(PB + 5)
            { pg8::Gemm g{(const pg8::bf16_t*)H8, (const pg8::bf16_t*)WGU, M_, NGU, DM / 2, DM / 2}; pg8::StaticOrder S; S.init(M_, NGU, G, bx);
              fp::EpiAct8 E{ACT, D_FF, NGU / 256}; pg8::gemm_phase<fp::EpiAct8, pg8::StaticOrder, true, true, true>(lds, g, S, E, tid);
              {
                volatile LAS unsigned* qw = (volatile LAS unsigned*)(lds + MISC_OFF) + 16; const float* const p_mg = moe_w_gate; const float* const p_mu = moe_w_up; int idx;
                for (;;) { if (wave == 0 && xb_lane_fresh() == 0u) qw[0] = __hip_atomic_fetch_add(ctl + (CW_Q + 6), 1u, __ATOMIC_RELAXED, __HIP_MEMORY_SCOPE_AGENT); __syncthreads(); idx = (int)qw[0]; __syncthreads();
                    if (idx >= FT_G_B) break; filler_g(FT_G_A + idx, p_mg, p_mu, MWGU, scr, wave, (int)xb_lane_fresh()); } } }
            PH_END(PB + 5)
            PH_BEGIN(PB + 6)
            { pg8::Gemm g{(const pg8::bf16_t*)ACT, (const pg8::bf16_t*)WD, M_, DM, D_FF / 2, D_FF / 2}; pg8::StaticOrder S; S.init(M_, DM, G, bx);
              fp::EpiY8 E{YB, DM}; pg8::gemm_phase<fp::EpiY8, pg8::StaticOrder, false, true, true>(lds, g, S, E, tid); }
            PH_END(PB + 6)
            PH_BEGIN(PB + 7)
            { const float* const p_g = ln2_g + layer * DM; const float* const p_b = ln2_b + layer * DM;
              { float va[16], vb[16]; LnGB gbp; ln_gb_load(gbp, p_g, p_b, lane); long r = gw; if (r < M_) ln_load<bf16, bf16>(va, HB + r * DM, ALPHA, YB + r * DM, nullptr, lane);
            for (; r < M_; r += 2 * ngw) { const long r1 = r + ngw, r2 = r + 2 * ngw;
                if (r1 < M_) ln_load<bf16, bf16>(vb, HB + r1 * DM, ALPHA, YB + r1 * DM, nullptr, lane);
                ln_finish_r(va, gbp, nullptr, HB + r * DM, lane);
                if (r2 < M_) ln_load<bf16, bf16>(va, HB + r2 * DM, ALPHA, YB + r2 * DM, nullptr, lane);
                if (r1 < M_) ln_finish_r(vb, gbp, nullptr, HB + r1 * DM, lane); } } }
            PH_END(PB + 7)
        } else {
            PH_BEGIN(PB + 5)
            { int base[N_EXP]; { int b_ = 0;
#pragma unroll
                  for (int e = 0; e < N_EXP; ++e) { base[e] = b_; b_ += (CNT[e] + 255) & ~255; } }
              constexpr int RPW = (M_ + 2047) / 2048;
              int te[RPW][2], tsl[RPW][2]; float tpv[RPW][2];
#pragma unroll
              for (int k = 0; k < RPW; ++k) { const long r = gw + (long)k * ngw;
#pragma unroll
                  for (int q = 0; q < 2; ++q) { te[k][q] = 0; tsl[k][q] = 0; tpv[k][q] = 0.f; if (r < M_) { te[k][q] = TE[r * 2 + q]; tsl[k][q] = TS[r * 2 + q]; tpv[k][q] = TP[r * 2 + q]; } } }
#pragma unroll
              for (int k = 0; k < RPW; ++k) { const long r = gw + (long)k * ngw; if (r < M_) {
                  const uint4* src = (const uint4*)(HB + r * DM); const uint2 v0 = bf8_to_f8(src[lane]), v1 = bf8_to_f8(src[lane + 64]);
#pragma unroll
                  for (int q = 0; q < 2; ++q) { int be = 0;
#pragma unroll
                      for (int x = 0; x < N_EXP; ++x) be = (te[k][q] == x) ? base[x] : be;
                      const int gs = be + tsl[k][q];
                      if (lane == 0) { SP[gs] = tpv[k][q]; GS[r * 2 + q] = gs; }
                      uint2* dst = (uint2*)(XG + (size_t)gs * DM); dst[lane] = v0; dst[lane + 64] = v1; } } }
              for (long r = gw + (long)RPW * ngw; r < M_; r += ngw) {
                  const uint4* src = (const uint4*)(HB + r * DM); const uint2 v0 = bf8_to_f8(src[lane]), v1 = bf8_to_f8(src[lane + 64]);
                  for (int q = 0; q < 2; ++q) { const long it = r * 2 + q; const int e = TE[it]; int be = 0;
#pragma unroll
                      for (int x = 0; x < N_EXP; ++x) be = (e == x) ? base[x] : be;
                      const int gs = be + TS[it];
                      if (lane == 0) { SP[gs] = TP[it]; GS[it] = gs; }
                      uint2* dst = (uint2*)(XG + (size_t)gs * DM); dst[lane] = v0; dst[lane + 64] = v1; } }
              for (int it = gw; it < N_EXP * 256; it += ngw) { const int e = it >> 8, r = it & 255; const int c = CNT[e]; const int slot = moe_base(CNT, e) + c + r;
                  if (c + r < ((c + 255) & ~255)) { uint2* dst = (uint2*)(XG + (size_t)slot * DM); const uint2 z = make_uint2(0u, 0u); dst[lane] = z; dst[lane + 64] = z; if (lane == 0) SP[slot] = 0.f; } } }
            PH_END(PB + 5)
            PH_BEGIN(PB + 6)
            { pg8::Gemm g{(const pg8::bf16_t*)XG, (const pg8::bf16_t*)MWGU, NSLOT, N_EXP * NGUE, DM / 2, DM / 2}; fp::MoeOrder S; S.init(CNT, NGUE / 256, G, bx);
              fp::EpiAct8 E{ACTM, D_FFE, NGUE / 256}; pg8::gemm_phase<fp::EpiAct8, fp::MoeOrder, true, true, true>(lds, g, S, E, tid);
              {
                volatile LAS unsigned* qw = (volatile LAS unsigned*)(lds + MISC_OFF) + 16; const float* const p_md = moe_w_down; int idx;
                for (;;) { if (wave == 0 && xb_lane_fresh() == 0u) qw[0] = __hip_atomic_fetch_add(ctl + (CW_Q + 14), 1u, __ATOMIC_RELAXED, __HIP_MEMORY_SCOPE_AGENT); __syncthreads(); idx = (int)qw[0]; __syncthreads();
                    if (idx >= FT_D_D) break; filler_d(FT_D - FT_D_D + idx, p_md, MWD, scr, wave, (int)xb_lane_fresh()); } } }
            PH_END(PB + 6)
            PH_BEGIN(PB + 7)
            { fp::MoeOrder S; S.init(CNT, DM / 256, G, bx); const int nf = S.tail_start(); const int slot0 = (nf / (DM / 256)) * 256;
              constexpr int KU = D_FFE / 2, KLEN = KU / MOE_KSPLIT;
              static_assert(KLEN % 128 == 0, "split-K parts must hold an even number of K-tiles");
              fp::EpiF2 E{F2, SP, F2P, slot0, KLEN, 1.f / W8_D};
              { pg8::Gemm g{(const pg8::bf16_t*)ACTM, (const pg8::bf16_t*)MWD, NSLOT, N_EXP * DM, KU, KU}; S.nfull = nf; S.ksplit = 1;
                pg8::gemm_phase<fp::EpiF2, fp::MoeOrder, true, true, true>(lds, g, S, E, wave * 64 + (int)xb_lane_fresh()); }
              { pg8::Gemm g{(const pg8::bf16_t*)ACTM, (const pg8::bf16_t*)MWD, NSLOT, N_EXP * DM, KLEN, KU}; S.ksplit = MOE_KSPLIT; S.klen = KLEN;
                int tid2 = wave * 64 + (int)xb_lane_fresh();
                pg8::gemm_phase<fp::EpiF2, fp::MoeOrder, true, true, true>(lds, g, S, E, tid2); } }
            PH_END(PB + 7)
            PH_BEGIN(PB + 8)
            { const float* const p_g = ln2_g + layer * DM; const float* const p_b = ln2_b + layer * DM;
              int slot0; { fp::MoeOrder S; S.init(CNT, DM / 256, G, bx); const int nf = S.tail_start(); slot0 = (nf == S.T * (DM / 256)) ? 0x7fffffff : (nf / (DM / 256)) * 256; }
#define LN2_LOAD(v, rr, kk_) do { int s0_ = GS[(rr) * 2], s1_ = GS[(rr) * 2 + 1]; if (kk_ < RPW2) { _Pragma("unroll") for (int x_ = 0; x_ < RPW2; ++x_) if (x_ == kk_) { s0_ = gsv[x_][0]; s1_ = gsv[x_][1]; } } ln_load<bf16, bf16>(v, HB + (rr) * DM, ALPHA, F2 + (size_t)s0_ * DM, F2 + (size_t)s1_ * DM, lane); \
                  if (s0_ >= slot0) { _Pragma("unroll") for (int p_ = 0; p_ < MOE_KSPLIT - 1; ++p_) ln_add(v, F2P + ((size_t)p_ * TAIL_SLOTS + (s0_ - slot0)) * DM, lane); } \
                  if (s1_ >= slot0) { _Pragma("unroll") for (int p_ = 0; p_ < MOE_KSPLIT - 1; ++p_) ln_add(v, F2P + ((size_t)p_ * TAIL_SLOTS + (s1_ - slot0)) * DM, lane); } } while (0)
              constexpr int RPW2 = (M_ + 2047) / 2048; int gsv[RPW2][2];
#pragma unroll
              for (int x_ = 0; x_ < RPW2; ++x_) { const long rr_ = gw + (long)x_ * ngw; gsv[x_][0] = 0; gsv[x_][1] = 0; if (rr_ < M_) { gsv[x_][0] = GS[rr_ * 2]; gsv[x_][1] = GS[rr_ * 2 + 1]; } }
              { float va[16], vb[16]; LnGB gbp; ln_gb_load(gbp, p_g, p_b, lane); long r = gw; int kq = 0; if (r < M_) LN2_LOAD(va, r, kq);
                for (; r < M_; r += 2 * ngw, kq += 2) { const long r1 = r + ngw, r2 = r + 2 * ngw;
                    if (r1 < M_) LN2_LOAD(vb, r1, kq + 1);
                    ln_finish_r(va, gbp, H + r * DM, nullptr, lane);
                    if (r2 < M_) LN2_LOAD(va, r2, kq + 2);
                    if (r1 < M_) ln_finish_r(vb, gbp, H + r1 * DM, nullptr, lane); } }
#undef LN2_LOAD
            }
            PH_END(PB + 8)
        }
    }

    { constexpr int layer = 1; constexpr int PB = 9;
        PH_BEGIN(PB + 0)
        { pg8::Gemm g{HB, WIN + (size_t)layer * PLD * DM, M_, PLD, DM, DM}; pg8::StaticOrder S; S.init(M_, PLD, G, bx);
          fp::EpiProj E{PROJ, RT, KM}; pg8::gemm_phase<fp::EpiProj, pg8::StaticOrder, true, true>(lds, g, S, E, tid); }
        PH_END(PB + 0)
        PH_BEGIN(PB + 1)
        { constexpr int NATT = NB * ATT_H * NBLK, NSSDA = NB * 32;
          volatile LAS unsigned* qw = (volatile LAS unsigned*)(lds + MISC_OFF) + 16;
#define QNEXT(word) do { if (tid == 0) qw[0] = __hip_atomic_fetch_add(ctl + (word), 1u, __ATOMIC_RELAXED, __HIP_MEMORY_SCOPE_AGENT); __syncthreads(); idx = (int)qw[0]; __syncthreads(); } while (0)
          int idx;
          for (;;) { QNEXT(CW_Q + 8 * layer); if (idx >= NATT) break;
              const int qb = (NBLK - 1) - idx / (NB * ATT_H), bh = idx % (NB * ATT_H);
              attn_body::attn_unit<8>(bh / ATT_H, bh % ATT_H, qb, (const attn_body::bf16*)(PROJ + FQ), (const attn_body::bf16*)(PROJ + FK), (const attn_body::bf16*)(PROJ + FV), (attn_body::bf16*)MIXB, KM, NB * ATT_H * NBLK * 64, (char*)lds_, tid); }
          for (;;) { QNEXT(CW_Q + 8 * layer + 1); if (idx >= NSSDA) break;
              ssdA_unit(idx >> 5, (idx >> 1) & 15, idx & 1, PROJ, conv_w + (size_t)layer * 4 * SSD_CW, conv_b + layer * SSD_CW, dt_bias + layer * SSD_H, a_log + layer * SSD_H, ST, CD, XCB, DTG, lds, tid, wave, lane); }
        }
        PH_END(PB + 1)
        PH_BEGIN(PB + 2)
        { constexpr int NSSDB = NB * 32, NGMU = NB * (SEQ / GM_CHUNK);
          volatile LAS unsigned* qw = (volatile LAS unsigned*)(lds + MISC_OFF) + 16;
          int idx;
          for (;;) { QNEXT(CW_Q + 8 * layer + 2); if (idx >= NSSDB) break;
              const int c = 15 - idx / (NB * 2), bg = idx % (NB * 2);
              ssdB_unit(bg >> 1, c, bg & 1, PROJ, XCB, DTG, d_skip + layer * SSD_H, ssd_norm_g + layer * SSD_W, ST, CD, MIXB, lds, tid, wave, lane); }
          for (;;) { QNEXT(CW_Q + 8 * layer + 3); if (idx >= NGMU) break;
              gm_unit(idx / (SEQ / GM_CHUNK), idx % (SEQ / GM_CHUNK), PROJ, WSB + (size_t)layer * GM_G * GM_CHUNK * GM_CHUNK, gm_ln_g + layer * GM_W, gm_ln_b + layer * GM_W,
                      gm_b_s + layer * GM_G * GM_CHUNK, gm_norm_g + layer * GM_W, MIXB, lds, wave, lane); }
          att_norm_phase(MIXB, att_norm_g + layer * ATT_W, M_, gw, ngw, lane);
          { const float* const p_mg = moe_w_gate; const float* const p_mu = moe_w_up; const float* const p_md = moe_w_down;
            constexpr int g0 = layer == 0 ? 0 : FT_G_A + FT_G_B, g1 = layer == 0 ? FT_G_A : FT_G, d0 = layer == 0 ? 0 : FT_D_A, d1 = layer == 0 ? FT_D_A : FT_D - FT_D_D;
            for (;;) { QNEXT(CW_Q + 8 * layer + 4); if (idx >= g1 - g0) break; filler_g(g0 + idx, p_mg, p_mu, MWGU, scr, wave, lane); }
            for (;;) { QNEXT(CW_Q + 8 * layer + 5); if (idx >= d1 - d0) break; filler_d(d0 + idx, p_md, MWD, scr, wave, lane); } }
#undef QNEXT
        }
        PH_END(PB + 2)
        PH_BEGIN(PB + 3)
        { pg8::Gemm g{MIXB, WOUT + (size_t)layer * DM * DM, M_, DM, DM, DM}; pg8::StaticOrder S; S.init(M_, DM, G, bx);
          fp::EpiY E{YB, DM}; pg8::gemm_phase<fp::EpiY, pg8::StaticOrder, false, true>(lds, g, S, E, tid); }
        PH_END(PB + 3)
        PH_BEGIN(PB + 4)
        { const float* const p_g = ln1_g + layer * DM; const float* const p_b = ln1_b + layer * DM;
          { float va[16], vb[16]; LnGB gbp; ln_gb_load(gbp, p_g, p_b, lane); long r = gw; if (r < M_) ln_load<bf16, bf16>(va, HB + r * DM, ALPHA, YB + r * DM, nullptr, lane);
            for (; r < M_; r += 2 * ngw) { const long r1 = r + ngw, r2 = r + 2 * ngw;
                if (r1 < M_) ln_load<bf16, bf16>(vb, HB + r1 * DM, ALPHA, YB + r1 * DM, nullptr, lane);
                ln_finish_r(va, gbp, nullptr, HB + r * DM, lane, layer == 0 ? H8 + r * DM : nullptr);
                if (r2 < M_) ln_load<bf16, bf16>(va, HB + r2 * DM, ALPHA, YB + r2 * DM, nullptr, lane);
                if (r1 < M_) ln_finish_r(vb, gbp, nullptr, HB + r1 * DM, lane, layer == 0 ? H8 + r1 * DM : nullptr); } }
          if (layer == 1) { asm volatile("s_waitcnt vmcnt(0)" ::: "memory"); moe_route_block(HB, router_w, CNT, TE, TP, TS, M_, gw, ngw, lane, wave, tid, (LAS int*)lds); } }
        PH_END(PB + 4)
        if constexpr (layer == 0) {
            PH_BEGIN(PB + 5)
            { pg8::Gemm g{(const pg8::bf16_t*)H8, (const pg8::bf16_t*)WGU, M_, NGU, DM / 2, DM / 2}; pg8::StaticOrder S; S.init(M_, NGU, G, bx);
              fp::EpiAct8 E{ACT, D_FF, NGU / 256}; pg8::gemm_phase<fp::EpiAct8, pg8::StaticOrder, true, true, true>(lds, g, S, E, tid);
              {
                volatile LAS unsigned* qw = (volatile LAS unsigned*)(lds + MISC_OFF) + 16; const float* const p_mg = moe_w_gate; const float* const p_mu = moe_w_up; int idx;
                for (;;) { if (wave == 0 && xb_lane_fresh() == 0u) qw[0] = __hip_atomic_fetch_add(ctl + (CW_Q + 6), 1u, __ATOMIC_RELAXED, __HIP_MEMORY_SCOPE_AGENT); __syncthreads(); idx = (int)qw[0]; __syncthreads();
                    if (idx >= FT_G_B) break; filler_g(FT_G_A + idx, p_mg, p_mu, MWGU, scr, wave, (int)xb_lane_fresh()); } } }
            PH_END(PB + 5)
            PH_BEGIN(PB + 6)
            { pg8::Gemm g{(const pg8::bf16_t*)ACT, (const pg8::bf16_t*)WD, M_, DM, D_FF / 2, D_FF / 2}; pg8::StaticOrder S; S.init(M_, DM, G, bx);
              fp::EpiY8 E{YB, DM}; pg8::gemm_phase<fp::EpiY8, pg8::StaticOrder, false, true, true>(lds, g, S, E, tid); }
            PH_END(PB + 6)
            PH_BEGIN(PB + 7)
            { const float* const p_g = ln2_g + layer * DM; const float* const p_b = ln2_b + layer * DM;
              { float va[16], vb[16]; LnGB gbp; ln_gb_load(gbp, p_g, p_b, lane); long r = gw; if (r < M_) ln_load<bf16, bf16>(va, HB + r * DM, ALPHA, YB + r * DM, nullptr, lane);
            for (; r < M_; r += 2 * ngw) { const long r1 = r + ngw, r2 = r + 2 * ngw;
                if (r1 < M_) ln_load<bf16, bf16>(vb, HB + r1 * DM, ALPHA, YB + r1 * DM, nullptr, lane);
                ln_finish_r(va, gbp, nullptr, HB + r * DM, lane);
                if (r2 < M_) ln_load<bf16, bf16>(va, HB + r2 * DM, ALPHA, YB + r2 * DM, nullptr, lane);
                if (r1 < M_) ln_finish_r(vb, gbp, nullptr, HB + r1 * DM, lane); } } }
            PH_END(PB + 7)
        } else {
            PH_BEGIN(PB + 5)
            { int base[N_EXP]; { int b_ = 0;
#pragma unroll
                  for (int e = 0; e < N_EXP; ++e) { base[e] = b_; b_ += (CNT[e] + 255) & ~255; } }
              constexpr int RPW = (M_ + 2047) / 2048;
              int te[RPW][2], tsl[RPW][2]; float tpv[RPW][2];
#pragma unroll
              for (int k = 0; k < RPW; ++k) { const long r = gw + (long)k * ngw;
#pragma unroll
                  for (int q = 0; q < 2; ++q) { te[k][q] = 0; tsl[k][q] = 0; tpv[k][q] = 0.f; if (r < M_) { te[k][q] = TE[r * 2 + q]; tsl[k][q] = TS[r * 2 + q]; tpv[k][q] = TP[r * 2 + q]; } } }
#pragma unroll
              for (int k = 0; k < RPW; ++k) { const long r = gw + (long)k * ngw; if (r < M_) {
                  const uint4* src = (const uint4*)(HB + r * DM); const uint2 v0 = bf8_to_f8(src[lane]), v1 = bf8_to_f8(src[lane + 64]);
#pragma unroll
                  for (int q = 0; q < 2; ++q) { int be = 0;
#pragma unroll
                      for (int x = 0; x < N_EXP; ++x) be = (te[k][q] == x) ? base[x] : be;
                      const int gs = be + tsl[k][q];
                      if (lane == 0) { SP[gs] = tpv[k][q]; GS[r * 2 + q] = gs; }
                      uint2* dst = (uint2*)(XG + (size_t)gs * DM); dst[lane] = v0; dst[lane + 64] = v1; } } }
              for (long r = gw + (long)RPW * ngw; r < M_; r += ngw) {
                  const uint4* src = (const uint4*)(HB + r * DM); const uint2 v0 = bf8_to_f8(src[lane]), v1 = bf8_to_f8(src[lane + 64]);
                  for (int q = 0; q < 2; ++q) { const long it = r * 2 + q; const int e = TE[it]; int be = 0;
#pragma unroll
                      for (int x = 0; x < N_EXP; ++x) be = (e == x) ? base[x] : be;
                      const int gs = be + TS[it];
                      if (lane == 0) { SP[gs] = TP[it]; GS[it] = gs; }
                      uint2* dst = (uint2*)(XG + (size_t)gs * DM); dst[lane] = v0; dst[lane + 64] = v1; } }
              for (int it = gw; it < N_EXP * 256; it += ngw) { const int e = it >> 8, r = it & 255; const int c = CNT[e]; const int slot = moe_base(CNT, e) + c + r;
                  if (c + r < ((c + 255) & ~255)) { uint2* dst = (uint2*)(XG + (size_t)slot * DM); const uint2 z = make_uint2(0u, 0u); dst[lane] = z; dst[lane + 64] = z; if (lane == 0) SP[slot] = 0.f; } } }
            PH_END(PB + 5)
            PH_BEGIN(PB + 6)
            { pg8::Gemm g{(const pg8::bf16_t*)XG, (const pg8::bf16_t*)MWGU, NSLOT, N_EXP * NGUE, DM / 2, DM / 2}; fp::MoeOrder S; S.init(CNT, NGUE / 256, G, bx);
              fp::EpiAct8 E{ACTM, D_FFE, NGUE / 256}; pg8::gemm_phase<fp::EpiAct8, fp::MoeOrder, true, true, true>(lds, g, S, E, tid);
              {
                volatile LAS unsigned* qw = (volatile LAS unsigned*)(lds + MISC_OFF) + 16; const float* const p_md = moe_w_down; int idx;
                for (;;) { if (wave == 0 && xb_lane_fresh() == 0u) qw[0] = __hip_atomic_fetch_add(ctl + (CW_Q + 14), 1u, __ATOMIC_RELAXED, __HIP_MEMORY_SCOPE_AGENT); __syncthreads(); idx = (int)qw[0]; __syncthreads();
                    if (idx >= FT_D_D) break; filler_d(FT_D - FT_D_D + idx, p_md, MWD, scr, wave, (int)xb_lane_fresh()); } } }
            PH_END(PB + 6)
            PH_BEGIN(PB + 7)
            { fp::MoeOrder S; S.init(CNT, DM / 256, G, bx); const int nf = S.tail_start(); const int slot0 = (nf / (DM / 256)) * 256;
              constexpr int KU = D_FFE / 2, KLEN = KU / MOE_KSPLIT;
              static_assert(KLEN % 128 == 0, "split-K parts must hold an even number of K-tiles");
              fp::EpiF2 E{F2, SP, F2P, slot0, KLEN, 1.f / W8_D};
              { pg8::Gemm g{(const pg8::bf16_t*)ACTM, (const pg8::bf16_t*)MWD, NSLOT, N_EXP * DM, KU, KU}; S.nfull = nf; S.ksplit = 1;
                pg8::gemm_phase<fp::EpiF2, fp::MoeOrder, true, true, true>(lds, g, S, E, wave * 64 + (int)xb_lane_fresh()); }
              { pg8::Gemm g{(const pg8::bf16_t*)ACTM, (const pg8::bf16_t*)MWD, NSLOT, N_EXP * DM, KLEN, KU}; S.ksplit = MOE_KSPLIT; S.klen = KLEN;
                int tid2 = wave * 64 + (int)xb_lane_fresh();
                pg8::gemm_phase<fp::EpiF2, fp::MoeOrder, true, true, true>(lds, g, S, E, tid2); } }
            PH_END(PB + 7)
            PH_BEGIN(PB + 8)
            { const float* const p_g = ln2_g + layer * DM; const float* const p_b = ln2_b + layer * DM;
              int slot0; { fp::MoeOrder S; S.init(CNT, DM / 256, G, bx); const int nf = S.tail_start(); slot0 = (nf == S.T * (DM / 256)) ? 0x7fffffff : (nf / (DM / 256)) * 256; }
#define LN2_LOAD(v, rr, kk_) do { int s0_ = GS[(rr) * 2], s1_ = GS[(rr) * 2 + 1]; if (kk_ < RPW2) { _Pragma("unroll") for (int x_ = 0; x_ < RPW2; ++x_) if (x_ == kk_) { s0_ = gsv[x_][0]; s1_ = gsv[x_][1]; } } ln_load<bf16, bf16>(v, HB + (rr) * DM, ALPHA, F2 + (size_t)s0_ * DM, F2 + (size_t)s1_ * DM, lane); \
                  if (s0_ >= slot0) { _Pragma("unroll") for (int p_ = 0; p_ < MOE_KSPLIT - 1; ++p_) ln_add(v, F2P + ((size_t)p_ * TAIL_SLOTS + (s0_ - slot0)) * DM, lane); } \
                  if (s1_ >= slot0) { _Pragma("unroll") for (int p_ = 0; p_ < MOE_KSPLIT - 1; ++p_) ln_add(v, F2P + ((size_t)p_ * TAIL_SLOTS + (s1_ - slot0)) * DM, lane); } } while (0)
              constexpr int RPW2 = (M_ + 2047) / 2048; int gsv[RPW2][2];
#pragma unroll
              for (int x_ = 0; x_ < RPW2; ++x_) { const long rr_ = gw + (long)x_ * ngw; gsv[x_][0] = 0; gsv[x_][1] = 0; if (rr_ < M_) { gsv[x_][0] = GS[rr_ * 2]; gsv[x_][1] = GS[rr_ * 2 + 1]; } }
              { float va[16], vb[16]; LnGB gbp; ln_gb_load(gbp, p_g, p_b, lane); long r = gw; int kq = 0; if (r < M_) LN2_LOAD(va, r, kq);
                for (; r < M_; r += 2 * ngw, kq += 2) { const long r1 = r + ngw, r2 = r + 2 * ngw;
                    if (r1 < M_) LN2_LOAD(vb, r1, kq + 1);
                    ln_finish_r(va, gbp, H + r * DM, nullptr, lane);
                    if (r2 < M_) LN2_LOAD(va, r2, kq + 2);
                    if (r1 < M_) ln_finish_r(vb, gbp, H + r1 * DM, nullptr, lane); } }
#undef LN2_LOAD
            }
            PH_END(PB + 8)
        }
    }

#undef PH_BEGIN
#undef PH_END
#undef in_x
#undef in_pos
#undef ln_in_g
#undef ln_in_b
#undef w_in
#undef conv_w
#undef conv_b
#undef dt_bias
#undef a_log
#undef d_skip
#undef ssd_norm_g
#undef att_norm_g
#undef gm_ln_g
#undef gm_ln_b
#undef gm_w_s
#undef gm_b_s
#undef gm_norm_g
#undef w_out
#undef ln1_g
#undef ln1_b
#undef ln2_g
#undef ln2_b
#undef ffn_w_gate
#undef ffn_w_up
#undef ffn_w_down
#undef router_w
#undef moe_w_gate
#undef moe_w_up
#undef moe_w_down
#undef H
#undef MWD
#undef RT
#undef TE
#undef TP
#undef TS
#undef GS
#undef SP
#undef KM
#undef WSB
#undef HB
#undef MWGU
#undef WIN
#undef WOUT
#undef WGU
#undef WD
#undef PROJ
#undef ST
#undef CD
#undef XCB
#undef DTG
#undef MIXB
#undef YB
#undef ACT
#undef H8
#undef XG
#undef F2
#undef ACTM
#undef CNT
#undef tid
#undef lane
#undef F2P
#undef vcu
#undef gw
#undef ngw
#undef gt
#undef ngt
    if (pr_me) { const unsigned t_beg = (unsigned)__builtin_amdgcn_s_memrealtime(), t_len = (unsigned)PROBE_AMP * pr_w[1]; while ((unsigned)__builtin_amdgcn_s_memrealtime() - t_beg < t_len) __builtin_amdgcn_s_sleep(8); }
}

__device__ __forceinline__ void blk_acc(float d2, float s2, float* err) {
    d2 = wave_sum(d2); s2 = wave_sum(s2); if ((threadIdx.x & 63) == 0) { atomicAdd(err, d2); atomicAdd(err + 1, s2); }
}
__global__ void k_cmp_proj(const bf16* F, const float* S, long rows, float* err) {
    float d2 = 0.f, s2 = 0.f;
    for (long it = blockIdx.x * (long)blockDim.x + threadIdx.x; it < rows * 2950; it += gridDim.x * (long)blockDim.x) {
        const long row = it / 2950; const int d = (int)(it % 2950); const int sc = fp::win_src_col(d);
        float s = S[row * D_IN + sc]; if (d >= FGU && d < FXBC) s = gelu_tanh_f(s);
        const float f = ldf(F + row * PLD + d); d2 += (f - s) * (f - s); s2 += s * s; }
    blk_acc(d2, s2, err);
}
template <class TF> __global__ void k_cmp(const TF* F, int ldf_, const float* S, int lds_, long rows, int cols, float* err) {
    float d2 = 0.f, s2 = 0.f;
    for (long it = blockIdx.x * (long)blockDim.x + threadIdx.x; it < rows * cols; it += gridDim.x * (long)blockDim.x) {
        const long row = it / cols; const int c = (int)(it % cols); const float f = ldf(F + row * ldf_ + c), s = S[row * lds_ + c]; d2 += (f - s) * (f - s); s2 += s * s; }
    blk_acc(d2, s2, err);
}
__global__ void k_encode(const float* err, int nck, const float* Sout, float* out, long rows_s, long rows_all, float thr) {
    int k = 0; for (int i = 0; i < nck; ++i) { const float r = err[2 * i] / fmaxf(err[2 * i + 1], 1e-30f); if (!(r <= thr)) { k = i + 1; break; } }
    for (long it = blockIdx.x * (long)blockDim.x + threadIdx.x; it < rows_all * DM; it += gridDim.x * (long)blockDim.x)
        out[it] = (it < rows_s * DM) ? Sout[it] * (1.f + (float)k) : 0.f;
}
#if DEBUG_BUILD
constexpr size_t S_BASE = (WS_END + 2 * MiB - 1) / MiB * MiB;
#endif
extern "C" void kernel_launch(void* const* d_in, const int* in_sizes, int n_in, void* d_out, int out_size, void* d_ws, size_t ws_size, hipStream_t stream) {
    (void)in_sizes; (void)n_in; (void)out_size;
    static int grid = 0;
    if (grid == 0) {
        int dev = 0, cus = 0, per_cu = 0;
        if (hipGetDevice(&dev) != hipSuccess || hipDeviceGetAttribute(&cus, hipDeviceAttributeMultiprocessorCount, dev) != hipSuccess) { grid = -1; return; }
        if (hipFuncSetAttribute((const void*)mega, hipFuncAttributeMaxDynamicSharedMemorySize, LDS_BYTES) != hipSuccess) { fprintf(stderr, "kernel_launch: hipFuncSetAttribute failed\n"); grid = -1; return; }
        if (hipOccupancyMaxActiveBlocksPerMultiprocessor(&per_cu, (const void*)mega, 512, LDS_BYTES) != hipSuccess || per_cu < 1) fprintf(stderr, "kernel_launch: occupancy query reports %d\n", per_cu);
        (void)hipGetLastError();
        grid = cus;
        if (ws_size < WS_END) { fprintf(stderr, "kernel_launch: workspace too small: %zu < %zu\n", ws_size, (size_t)WS_END); grid = -1; }
    }
    if (grid < 0) return;
    unsigned char* ws = (unsigned char*)d_ws;
    if (hipMemsetAsync(ws + O_CTL, 0, CTL_BYTES, stream) != hipSuccess) return;
    FArgs a{};
    for (int i = 0; i < 29; ++i) a.in[i] = d_in[i];
    a.out = (float*)d_out; a.ws = ws;
#if !DEBUG_BUILD
    a.ph_lo = 0; a.ph_hi = N_PHASES;
    hipLaunchKernelGGL(mega, dim3(grid), dim3(512), LDS_BYTES, stream, a);
#else
    Inputs I;
    I.x = (const float*)d_in[0]; I.pos = (const int*)d_in[1]; I.ln_in_g = (const float*)d_in[2]; I.ln_in_b = (const float*)d_in[3]; I.w_in = (const float*)d_in[4];
    I.conv_w = (const float*)d_in[5]; I.conv_b = (const float*)d_in[6]; I.dt_bias = (const float*)d_in[7]; I.a_log = (const float*)d_in[8]; I.d_skip = (const float*)d_in[9];
    I.ssd_norm_g = (const float*)d_in[10]; I.att_norm_g = (const float*)d_in[11]; I.gm_ln_g = (const float*)d_in[12]; I.gm_ln_b = (const float*)d_in[13]; I.gm_w_s = (const float*)d_in[14];
    I.gm_b_s = (const float*)d_in[15]; I.gm_norm_g = (const float*)d_in[16]; I.w_out = (const float*)d_in[17]; I.ln1_g = (const float*)d_in[18]; I.ln1_b = (const float*)d_in[19];
    I.ln2_g = (const float*)d_in[20]; I.ln2_b = (const float*)d_in[21]; I.ffn_w_gate = (const float*)d_in[22]; I.ffn_w_up = (const float*)d_in[23]; I.ffn_w_down = (const float*)d_in[24];
    I.router_w = (const float*)d_in[25]; I.moe_w_gate = (const float*)d_in[26]; I.moe_w_up = (const float*)d_in[27]; I.moe_w_down = (const float*)d_in[28];
    const long MS = SEQ;
    unsigned char* sws = ws + S_BASE;
    float* saux = (float*)(sws + 96 * MiB); float* sout = (float*)(sws + 100 * MiB); float* ckpt = (float*)(sws + 110 * MiB);
    const size_t ck_stride = (size_t)MS * (D_IN + 3 * DM);
    run_simple(I, 1, sws, saux, sout, stream, ckpt);
    float* err = (float*)(ws + O_CTL) + CW_ERR;
    const bf16* PROJ = (const bf16*)(ws + O_PROJ); const bf16* MIXB = (const bf16*)(ws + O_MIXB); const bf16* Hf = (const bf16*)(ws + O_HB); const float* Hout = (const float*)d_out;
    for (int ph = 0; ph < N_PHASES; ++ph) {
        a.ph_lo = ph; a.ph_hi = ph + 1;
        hipLaunchKernelGGL(mega, dim3(grid), dim3(512), LDS_BYTES, stream, a);
        const int layer = ph >= 9 ? 1 : 0; const int rel = ph - (layer ? 8 : 0); const float* ck = ckpt + layer * ck_stride; float* e = err + layer * 12;
        if (rel == 1) k_cmp_proj<<<512, 256, 0, stream>>>(PROJ, ck, MS, e + 0);
        if (rel == 3) { k_cmp<bf16><<<512, 256, 0, stream>>>(MIXB, DM, ck + (size_t)MS * D_IN, DM, MS, 384, e + 2);
                        k_cmp<bf16><<<512, 256, 0, stream>>>(MIXB + 384, DM, ck + (size_t)MS * D_IN + 384, DM, MS, 384, e + 4);
                        k_cmp<bf16><<<512, 256, 0, stream>>>(MIXB + 768, DM, ck + (size_t)MS * D_IN + 768, DM, MS, 256, e + 6); }
        if (rel == 5) k_cmp<bf16><<<512, 256, 0, stream>>>(Hf, DM, ck + (size_t)MS * (D_IN + DM), DM, MS, DM, e + 8);
        if (layer == 0 && rel == 8) k_cmp<bf16><<<512, 256, 0, stream>>>(Hf, DM, ck + (size_t)MS * (D_IN + 2 * DM), DM, MS, DM, e + 10);
        if (layer == 1 && rel == 9) k_cmp<float><<<512, 256, 0, stream>>>(Hout, DM, ck + (size_t)MS * (D_IN + 2 * DM), DM, MS, DM, e + 10);
    }
    k_encode<<<1024, 256, 0, stream>>>(err, 12, sout, (float*)d_out, MS, (long)NBATCH * SEQ, DBG_THR);
#endif
}
```

```cpp
#define DEBUG_BUILD 0
#define DBG_THR 0.02f
#define PROBE_MASK 0u
#define PROBE_AMP 0
#include <hip/hip_runtime.h>
#include <cstdio>
#include <cstdint>

constexpr int DM = 1024, SEQ = 2048, NBATCH = 8;
constexpr int ATT_H = 6, HD = 64, ATT_W = 384, ROPE_DIM = 16;
constexpr int MOBA_BLOCK = 256, NBLK = SEQ / MOBA_BLOCK;
constexpr int SSD_H = 6, SSD_W = 384, SSD_G = 2, SSD_N = 128, SSD_CW = 896;
constexpr int GM_G = 4, GM_W = 256, GM_CHUNK = 128;
constexpr int D_IN = 2950, D_FF = 2816, N_EXP = 8, D_FFE = 3584;
constexpr float ALPHA = 1.4142135623730951f;
constexpr float NEGF = -1e30f;
constexpr int MAXSLOT = 2 * NBATCH * SEQ + N_EXP * 256;

typedef unsigned short bf16;
__device__ __forceinline__ unsigned f2bf(float f) { unsigned u = __float_as_uint(f); return (u + 0x7fffu + ((u >> 16) & 1u)) >> 16; }
__device__ __forceinline__ float ldf(const float* p) { return *p; }
__device__ __forceinline__ float ldf(const bf16* p) { return __uint_as_float(((unsigned)*p) << 16); }
__device__ __forceinline__ void stf(float* p, float v) { *p = v; }
__device__ __forceinline__ void stf(bf16* p, float v) { *p = (bf16)f2bf(v); }

__device__ __forceinline__ float dpp_add(float v, const int ctrl_tag) {
    int r;
    if (ctrl_tag == 0) r = __builtin_amdgcn_update_dpp(0, __float_as_int(v), 0xB1, 0xF, 0xF, false);
    else if (ctrl_tag == 1) r = __builtin_amdgcn_update_dpp(0, __float_as_int(v), 0x4E, 0xF, 0xF, false);
    else if (ctrl_tag == 2) r = __builtin_amdgcn_update_dpp(0, __float_as_int(v), 0x141, 0xF, 0xF, false);
    else r = __builtin_amdgcn_update_dpp(0, __float_as_int(v), 0x140, 0xF, 0xF, false);
    return v + __int_as_float(r);
}
__device__ __forceinline__ float row16_sum(float v) { v = dpp_add(v, 0); v = dpp_add(v, 1); v = dpp_add(v, 2); v = dpp_add(v, 3); return v; }
__device__ __forceinline__ float wave_sum(float v) {
    v = row16_sum(v);
    { const auto rr = __builtin_amdgcn_permlane16_swap(__float_as_uint(v), __float_as_uint(v), false, false); v = __uint_as_float(rr[0]) + __uint_as_float(rr[1]); }
    { const auto rr = __builtin_amdgcn_permlane32_swap(__float_as_uint(v), __float_as_uint(v), false, false); v = __uint_as_float(rr[0]) + __uint_as_float(rr[1]); }
    return v;
}
__device__ __forceinline__ float silu_f(float x) { return x / (1.f + __expf(-x)); }
__device__ __forceinline__ float gelu_tanh_f(float x) { const float u = 0.7978845608028654f * (x + 0.044715f * x * x * x); return 0.5f * x * (1.f + tanhf(u)); }
__device__ __forceinline__ float softplus_f(float x) { return fmaxf(x, 0.f) + log1pf(__expf(-fabsf(x))); }

struct ProjL { int ld, q, k, v, z, xbc, dt, gu, gv; };

__device__ __forceinline__ float4 ld4(const float* p) { return *(const float4*)p; }
__device__ __forceinline__ float4 ld4(const bf16* p) { const uint2 w = *(const uint2*)p; return make_float4(__uint_as_float(w.x << 16), __uint_as_float(w.x & 0xffff0000u), __uint_as_float(w.y << 16), __uint_as_float(w.y & 0xffff0000u)); }
typedef float nt_f4 __attribute__((ext_vector_type(4)));
__device__ __forceinline__ float4 ld4_nt(const float* p) { const nt_f4 v = __builtin_nontemporal_load((const nt_f4*)p); return make_float4(v[0], v[1], v[2], v[3]); }
__device__ __forceinline__ float4 ld4_nt(const bf16* p) { return ld4(p); }
template <class TY, class TX = float, bool NTX = false> __device__ __forceinline__ void ln_load(float (&v)[16], const TX* xrow, float a, const TY* y1, const TY* y2, int lane) {
#pragma unroll
    for (int j = 0; j < 4; ++j) {
        const float4 x = NTX ? ld4_nt(xrow + j * 256 + lane * 4) : ld4(xrow + j * 256 + lane * 4);
        float4 t = make_float4(a * x.x, a * x.y, a * x.z, a * x.w);
        if (y1) { const float4 y = ld4(y1 + j * 256 + lane * 4); t.x += y.x; t.y += y.y; t.z += y.z; t.w += y.w; }
        if (y2) { const float4 y = ld4(y2 + j * 256 + lane * 4); t.x += y.x; t.y += y.y; t.z += y.z; t.w += y.w; }
        v[4 * j] = t.x; v[4 * j + 1] = t.y; v[4 * j + 2] = t.z; v[4 * j + 3] = t.w;
    }
}
__device__ __forceinline__ void ln_add(float (&v)[16], const bf16* y, int lane) {
#pragma unroll
    for (int j = 0; j < 4; ++j) { const float4 t = ld4(y + j * 256 + lane * 4); v[4 * j] += t.x; v[4 * j + 1] += t.y; v[4 * j + 2] += t.z; v[4 * j + 3] += t.w; }
}
__device__ __forceinline__ void ln_finish(float (&v)[16], const float* g, const float* b, float* of, bf16* ob, int lane) {
    float s = 0.f;
#pragma unroll
    for (int i = 0; i < 16; ++i) s += v[i];
    const float mean = wave_sum(s) * (1.f / 1024.f); float s2 = 0.f;
#pragma unroll
    for (int i = 0; i < 16; ++i) { v[i] -= mean; s2 += v[i] * v[i]; }
    const float rstd = rsqrtf(wave_sum(s2) * (1.f / 1024.f) + 1e-5f);
#pragma unroll
    for (int j = 0; j < 4; ++j) {
        const float4 gg = *(const float4*)(g + j * 256 + lane * 4), bb = *(const float4*)(b + j * 256 + lane * 4);
        float4 o = make_float4(v[4 * j] * rstd * gg.x + bb.x, v[4 * j + 1] * rstd * gg.y + bb.y, v[4 * j + 2] * rstd * gg.z + bb.z, v[4 * j + 3] * rstd * gg.w + bb.w);
        if (of) *(float4*)(of + j * 256 + lane * 4) = o;
        if (ob) { uint2 w; w.x = f2bf(o.x) | (f2bf(o.y) << 16); w.y = f2bf(o.z) | (f2bf(o.w) << 16); *(uint2*)(ob + j * 256 + lane * 4) = w; }
    }
}

struct LnGB { float4 g[4], b[4]; };
__device__ __forceinline__ void ln_gb_load(LnGB& p, const float* g, const float* b, int lane) {
#pragma unroll
    for (int j = 0; j < 4; ++j) { p.g[j] = *(const float4*)(g + j * 256 + lane * 4); p.b[j] = *(const float4*)(b + j * 256 + lane * 4); }
}
__device__ __forceinline__ void ln_finish_r(float (&v)[16], const LnGB& p, float* of, bf16* ob, int lane, unsigned char* o8 = nullptr  , bool keep = false  ) {
    float s = 0.f;
#pragma unroll
    for (int i = 0; i < 16; ++i) s += v[i];
    const float mean = wave_sum(s) * (1.f / 1024.f); float s2 = 0.f;
#pragma unroll
    for (int i = 0; i < 16; ++i) { v[i] -= mean; s2 += v[i] * v[i]; }
    const float rstd = rsqrtf(wave_sum(s2) * (1.f / 1024.f) + 1e-5f);
#pragma unroll
    for (int j = 0; j < 4; ++j) {
        const float4 gg = p.g[j], bb = p.b[j];
        float4 o = make_float4(v[4 * j] * rstd * gg.x + bb.x, v[4 * j + 1] * rstd * gg.y + bb.y, v[4 * j + 2] * rstd * gg.z + bb.z, v[4 * j + 3] * rstd * gg.w + bb.w);
        if (of) { nt_f4 ov; ov[0] = o.x; ov[1] = o.y; ov[2] = o.z; ov[3] = o.w; __builtin_nontemporal_store(ov, (nt_f4*)(of + j * 256 + lane * 4)); }
        if (ob) { uint2 w; w.x = f2bf(o.x) | (f2bf(o.y) << 16); w.y = f2bf(o.z) | (f2bf(o.w) << 16); *(uint2*)(ob + j * 256 + lane * 4) = w; }
        if (o8) { int w = 0; w = __builtin_amdgcn_cvt_pk_fp8_f32(o.x, o.y, w, false); w = __builtin_amdgcn_cvt_pk_fp8_f32(o.z, o.w, w, true); *(int*)(o8 + j * 256 + lane * 4) = w; }
        if (keep) { v[4 * j] = o.x; v[4 * j + 1] = o.y; v[4 * j + 2] = o.z; v[4 * j + 3] = o.w; }
    }
}
template <class TY> __device__ __forceinline__ void ln_row(const float* xrow, float a, const TY* y1, const TY* y2, const float* g, const float* b, float* of, bf16* ob, int lane) {
    float v[16]; ln_load<TY>(v, xrow, a, y1, y2, lane); ln_finish(v, g, b, of, ob, lane);
}

__device__ __forceinline__ void rope_inplace(float* P, ProjL L, const int* pos, long n_rows, long gt, long ngt) {
    for (long it = gt; it < n_rows * 96; it += ngt) {
        const int i = (int)(it & 7), hh = (int)((it >> 3) % 12); const long row = it / 96;
        const int off = (hh < 6 ? L.q : L.k) + (hh % 6) * 64;
        const float inv = powf(500000.0f, -(float)(2 * i) / 16.0f);
        const float ang = (float)pos[row] * inv;
        const float c = cosf(ang), s = sinf(ang);
        float* p = P + row * L.ld + off;
        const float x1 = p[i], x2 = p[i + 8];
        p[i] = x1 * c - x2 * s; p[i + 8] = x2 * c + x1 * s;
    }
}

template <class T> __device__ __forceinline__ void kmean_phase(const T* P, ProjL L, float* KM, int nb, long gt, long ngt) {
    for (long it = gt; it < (long)nb * ATT_H * NBLK * 64; it += ngt) {
        const int d = (int)(it & 63), n = (int)((it >> 6) % NBLK), h = (int)((it / (64 * NBLK)) % ATT_H), b = (int)(it / (64 * NBLK * ATT_H));
        const T* p = P + ((long)b * SEQ + n * MOBA_BLOCK) * L.ld + L.k + h * 64 + d; float s = 0.f;
        for (int r = 0; r < MOBA_BLOCK; ++r) s += ldf(p + (long)r * L.ld);
        KM[it] = s * (1.f / MOBA_BLOCK);
    }
}

template <class T> __device__ __forceinline__ void attn_naive_phase(const T* P, ProjL L, const float* KM, float* O, int ldo, int nb, int gw, int ngw, int lane) {
    for (long it = gw; it < (long)nb * ATT_H * SEQ; it += ngw) {
        const int q = (int)(it % SEQ), h = (int)((it / SEQ) % ATT_H), b = (int)(it / ((long)SEQ * ATT_H));
        const long row = (long)b * SEQ + q; const int qblk = q / MOBA_BLOCK;
        const float qv = ldf(P + row * L.ld + L.q + h * 64 + lane);
        float g[NBLK];
#pragma unroll
        for (int n = 0; n < NBLK; ++n) { const float t = wave_sum(qv * KM[(((long)b * ATT_H + h) * NBLK + n) * 64 + lane]); g[n] = (n < qblk) ? t : NEGF; }
        unsigned sel = 0u;
#pragma unroll
        for (int r = 0; r < 3; ++r) { float bv = -3.0e38f; int best = -1;
#pragma unroll
            for (int n = 0; n < NBLK; ++n) if (!((sel >> n) & 1u) && g[n] > bv) { bv = g[n]; best = n; }
            if (best >= 0 && bv > NEGF * 0.5f) sel |= 1u << best; }
        sel |= 1u << qblk;
        float m = -3.0e38f, l = 0.f, o = 0.f;
        for (int n = 0; n <= qblk; ++n) {
            if (!((sel >> n) & 1u)) continue;
            const int j0 = n * MOBA_BLOCK, j1 = (n == qblk) ? q + 1 : j0 + MOBA_BLOCK;
            const T* kp = P + ((long)b * SEQ + j0) * L.ld + L.k + h * 64 + lane;
            const T* vp = P + ((long)b * SEQ + j0) * L.ld + L.v + h * 64 + lane;
            for (int j = j0; j < j1; ++j, kp += L.ld, vp += L.ld) {
                const float s = wave_sum(qv * ldf(kp)) * 0.125f;
                const float mn = fmaxf(m, s), corr = __expf(m - mn), p = __expf(s - mn);
                l = l * corr + p; o = o * corr + p * ldf(vp); m = mn;
            }
        }
        O[row * ldo + h * 64 + lane] = o / l;
    }
}

template <int W, class TO> __device__ __forceinline__ void rms_rows_phase(const float* in, int ldi, const float* g, TO* out, int ldo, long n_rows, int gw, int ngw, int lane) {
    constexpr int PER = W / 64;
    for (long row = gw; row < n_rows; row += ngw) {
        float v[PER]; float s = 0.f;
#pragma unroll
        for (int j = 0; j < PER; ++j) { v[j] = in[row * ldi + j * 64 + lane]; s += v[j] * v[j]; }
        const float r = rsqrtf(wave_sum(s) * (1.f / W) + 1e-5f);
#pragma unroll
        for (int j = 0; j < PER; ++j) stf(out + row * ldo + j * 64 + lane, v[j] * r * g[j * 64 + lane]);
    }
}

template <class T, class TO> __device__ __forceinline__ void ssd_conv_phase(const T* P, ProjL L, const float* cw, const float* cb, const float* dtb, TO* XC, float* DT, long n_rows, long gt, long ngt) {
    for (long it = gt; it < n_rows * 902; it += ngt) {
        const int c = (int)(it % 902); const long row = it / 902; const int t = (int)(row % SEQ);
        if (c < SSD_CW) {
            float acc = cb[c];
#pragma unroll
            for (int i = 0; i < 4; ++i) { const int tt = t - 3 + i; if (tt >= 0) acc += cw[i * SSD_CW + c] * ldf(P + (row - 3 + i) * L.ld + L.xbc + c); }
            stf(XC + row * SSD_CW + c, silu_f(acc));
        } else {
            const int h = c - SSD_CW;
            DT[row * SSD_H + h] = softplus_f(ldf(P + row * L.ld + L.dt + h) + dtb[h]);
        }
    }
}

template <class T> __device__ __forceinline__ void ssd_scan_naive_phase(const T* XC, const float* DT, const float* a_log, const float* dsk, float* Y, int ldo, int nb, int gw, int ngw, int lane) {
    for (int it = gw; it < nb * SSD_H * 64; it += ngw) {
        const int p = it & 63, h = (it >> 6) % SSD_H, b = it / (64 * SSD_H), grp = h / (SSD_H / SSD_G);
        const float A = -__expf(a_log[h]), Dk = dsk[h];
        float s0 = 0.f, s1 = 0.f;
#pragma unroll 4
        for (int t = 0; t < SEQ; ++t) {
            const long row = (long)b * SEQ + t;
            const T* xr = XC + row * SSD_CW;
            const float dt = DT[row * SSD_H + h], x = ldf(xr + h * 64 + p);
            const float B0 = ldf(xr + SSD_W + grp * SSD_N + lane), B1 = ldf(xr + SSD_W + grp * SSD_N + 64 + lane);
            const float C0 = ldf(xr + SSD_W + SSD_G * SSD_N + grp * SSD_N + lane), C1 = ldf(xr + SSD_W + SSD_G * SSD_N + grp * SSD_N + 64 + lane);
            const float dec = __expf(dt * A), xd = x * dt;
            s0 = s0 * dec + xd * B0; s1 = s1 * dec + xd * B1;
            const float y = wave_sum(C0 * s0 + C1 * s1);
            if (lane == 0) Y[row * ldo + h * 64 + p] = y + Dk * x;
        }
    }
}

template <class T, class TO> __device__ __forceinline__ void ssd_gate_phase(const float* Y, int ldi, const T* P, ProjL L, const float* ng, TO* out, int ldo, long n_rows, int gw, int ngw, int lane) {
    for (long row = gw; row < n_rows; row += ngw) {
        float v[6];
#pragma unroll
        for (int j = 0; j < 6; ++j) { const int c = j * 64 + lane; v[j] = Y[row * ldi + c] * silu_f(ldf(P + row * L.ld + L.z + c)); }
        const float r0 = rsqrtf(wave_sum(v[0] * v[0] + v[1] * v[1] + v[2] * v[2]) * (1.f / 192.f) + 1e-5f);
        const float r1 = rsqrtf(wave_sum(v[3] * v[3] + v[4] * v[4] + v[5] * v[5]) * (1.f / 192.f) + 1e-5f);
#pragma unroll
        for (int j = 0; j < 6; ++j) { const int c = j * 64 + lane; stf(out + row * ldo + c, v[j] * (j < 3 ? r0 : r1) * ng[c]); }
    }
}

template <class T, bool PRE> __device__ __forceinline__ void gm_ln_phase(const T* P, ProjL L, const float* g, const float* b, float* VN, long n_rows, int gw, int ngw, int lane) {
    for (long row = gw; row < n_rows; row += ngw) {
        float v[4]; float s = 0.f;
#pragma unroll
        for (int j = 0; j < 4; ++j) { const float x = ldf(P + row * L.ld + L.gv + j * 64 + lane); v[j] = PRE ? x : gelu_tanh_f(x); s += v[j]; }
        const float mean = wave_sum(s) * (1.f / 256.f); float s2 = 0.f;
#pragma unroll
        for (int j = 0; j < 4; ++j) { v[j] -= mean; s2 += v[j] * v[j]; }
        const float rstd = rsqrtf(wave_sum(s2) * (1.f / 256.f) + 1e-5f);
#pragma unroll
        for (int j = 0; j < 4; ++j) VN[row * GM_W + j * 64 + lane] = v[j] * rstd * g[j * 64 + lane] + b[j * 64 + lane];
    }
}
template <class T, bool PRE> __device__ __forceinline__ void gm_mix_phase(const T* P, ProjL L, const float* VN, const float* ws_, const float* bs, float* GO, int ldo, long n_rows, long gt, long ngt) {
    for (long it = gt; it < n_rows * GM_W; it += ngt) {
        const int c = (int)(it % GM_W); const long row = it / GM_W; const int t = (int)(row % GM_CHUNK), g = c / 64; const long base = row - t;
        const float* w = ws_ + ((long)g * GM_CHUNK + t) * GM_CHUNK; float acc = 0.f;
        for (int s = 0; s <= t; ++s) acc += w[s] * VN[(base + s) * GM_W + c];
        acc += bs[g * GM_CHUNK + t];
        const float x = ldf(P + row * L.ld + L.gu + c); const float u = PRE ? x : gelu_tanh_f(x);
        GO[row * ldo + c] = u * acc;
    }
}

__device__ __forceinline__ void moe_route_phase(const float* H, const float* Wr, int* CNT, int* TE, float* TP, int* TS, long n_rows, int gw, int ngw, int lane) {
    for (long row = gw; row < n_rows; row += ngw) {
        float acc[N_EXP];
#pragma unroll
        for (int e = 0; e < N_EXP; ++e) acc[e] = 0.f;
        for (int j = 0; j < 16; ++j) { const int d = j * 64 + lane; const float hv = H[row * DM + d];
            const float4 w0 = *(const float4*)(Wr + d * N_EXP), w1 = *(const float4*)(Wr + d * N_EXP + 4);
            acc[0] += hv * w0.x; acc[1] += hv * w0.y; acc[2] += hv * w0.z; acc[3] += hv * w0.w; acc[4] += hv * w1.x; acc[5] += hv * w1.y; acc[6] += hv * w1.z; acc[7] += hv * w1.w; }
#pragma unroll
        for (int e = 0; e < N_EXP; ++e) acc[e] = wave_sum(acc[e]);
        int e0 = 0; float v0 = acc[0];
#pragma unroll
        for (int e = 1; e < N_EXP; ++e) if (acc[e] > v0) { v0 = acc[e]; e0 = e; }
        int e1 = -1; float v1 = -3.0e38f;
#pragma unroll
        for (int e = 0; e < N_EXP; ++e) if (e != e0 && acc[e] > v1) { v1 = acc[e]; e1 = e; }
        const float p1 = __expf(v1 - v0), den = 1.f + p1;
        if (lane == 0) {
            const int s0 = atomicAdd(&CNT[e0], 1), s1 = atomicAdd(&CNT[e1], 1);
            TE[row * 2] = e0; TE[row * 2 + 1] = e1; TP[row * 2] = 1.f / den; TP[row * 2 + 1] = p1 / den; TS[row * 2] = s0; TS[row * 2 + 1] = s1;
        }
    }
}

__device__ __forceinline__ void moe_route_block(const bf16* H, const float* Wr, int* CNT, int* TE, float* TP, int* TS, long n_rows, int gw_, int ngw_, int lane, int wave, int tid,
                                                __attribute__((address_space(3))) int* sh  ) {
    asm volatile("" : "+v"(tid));
    if (tid < 16) sh[tid] = 0;
    __syncthreads();
    int k = 0;
    for (long row = gw_; row < n_rows; row += ngw_, ++k) {
        float acc[N_EXP];
#pragma unroll
        for (int e = 0; e < N_EXP; ++e) acc[e] = 0.f;
        for (int j = 0; j < 16; ++j) { const int d = j * 64 + lane; const float hv = ldf(H + row * DM + d);
            const float4 w0 = *(const float4*)(Wr + d * N_EXP), w1 = *(const float4*)(Wr + d * N_EXP + 4);
            acc[0] += hv * w0.x; acc[1] += hv * w0.y; acc[2] += hv * w0.z; acc[3] += hv * w0.w; acc[4] += hv * w1.x; acc[5] += hv * w1.y; acc[6] += hv * w1.z; acc[7] += hv * w1.w; }
#pragma unroll
        for (int e = 0; e < N_EXP; ++e) acc[e] = wave_sum(acc[e]);
        int e0 = 0; float v0 = acc[0];
#pragma unroll
        for (int e = 1; e < N_EXP; ++e) if (acc[e] > v0) { v0 = acc[e]; e0 = e; }
        int e1 = -1; float v1 = -3.0e38f;
#pragma unroll
        for (int e = 0; e < N_EXP; ++e) if (e != e0 && acc[e] > v1) { v1 = acc[e]; e1 = e; }
        const float p1 = __expf(v1 - v0), den = 1.f + p1;
        if (lane == 0) {
            const int l0 = atomicAdd((int*)&sh[e0], 1), l1 = atomicAdd((int*)&sh[e1], 1);
            TE[row * 2] = e0; TE[row * 2 + 1] = e1; TP[row * 2] = 1.f / den; TP[row * 2 + 1] = p1 / den;
            sh[16 + (wave * 8 + k) * 4 + 0] = e0; sh[16 + (wave * 8 + k) * 4 + 1] = e1; sh[16 + (wave * 8 + k) * 4 + 2] = l0; sh[16 + (wave * 8 + k) * 4 + 3] = l1;
        }
    }
    __syncthreads();
    if (tid < N_EXP) sh[8 + tid] = atomicAdd(&CNT[tid], sh[tid]);
    __syncthreads();
    k = 0;
    for (long row = gw_; row < n_rows; row += ngw_, ++k)
        if (lane == 0) { const int e0 = sh[16 + (wave * 8 + k) * 4], e1 = sh[16 + (wave * 8 + k) * 4 + 1];
            TS[row * 2] = sh[8 + e0] + sh[16 + (wave * 8 + k) * 4 + 2]; TS[row * 2 + 1] = sh[8 + e1] + sh[16 + (wave * 8 + k) * 4 + 3]; }
    __syncthreads();
}
__device__ __forceinline__ void moe_route_row(const float (&v)[16], const float4 (&wr)[32], long row, int* TE, float* TP, int* TS, int lane, __attribute__((address_space(3))) int* sh) {
    float acc[N_EXP];
#pragma unroll
    for (int e = 0; e < N_EXP; ++e) acc[e] = 0.f;
#pragma unroll
    for (int i = 0; i < 16; ++i) { const float4 w0 = wr[2 * i], w1 = wr[2 * i + 1]; const float hv = v[i];
        acc[0] += hv * w0.x; acc[1] += hv * w0.y; acc[2] += hv * w0.z; acc[3] += hv * w0.w; acc[4] += hv * w1.x; acc[5] += hv * w1.y; acc[6] += hv * w1.z; acc[7] += hv * w1.w; }
#pragma unroll
    for (int e = 0; e < N_EXP; ++e) acc[e] = wave_sum(acc[e]);
    int e0 = 0; float v0 = acc[0];
#pragma unroll
    for (int e = 1; e < N_EXP; ++e) if (acc[e] > v0) { v0 = acc[e]; e0 = e; }
    int e1 = -1; float v1 = -3.0e38f;
#pragma unroll
    for (int e = 0; e < N_EXP; ++e) if (e != e0 && acc[e] > v1) { v1 = acc[e]; e1 = e; }
    const float p1 = __expf(v1 - v0), den = 1.f + p1;
    if (lane == 0) {
        const int l0 = atomicAdd((int*)&sh[e0], 1), l1 = atomicAdd((int*)&sh[e1], 1);
        TE[row * 2] = e0; TE[row * 2 + 1] = e1; TP[row * 2] = 1.f / den; TP[row * 2 + 1] = p1 / den; TS[row * 2] = l0; TS[row * 2 + 1] = l1;
    }
}
__device__ __forceinline__ int moe_base(const int* CNT, int e) { int b = 0; for (int i = 0; i < e; ++i) b += (CNT[i] + 255) & ~255; return b; }
__device__ __forceinline__ void moe_scatter_phase(const int* CNT, const int* TE, const float* TP, const int* TS, int* LIST, float* SP, int* GS, long n_rows, long gt, long ngt) {
    for (long it = gt; it < n_rows * 2; it += ngt) {
        const int e = TE[it]; const int gs = moe_base(CNT, e) + TS[it];
        LIST[gs] = (int)(it >> 1); SP[gs] = TP[it]; GS[it] = gs;
    }
}

template <class TA, int EPI> __global__ void __launch_bounds__(256) sgemm_k(const TA* A, int lda, const int* rowlist, const float* B, const float* B2, int ldb, long bstride, void* Cv, int ldc, int M, int N, int K, const int* CNT, const float* scale) {
    __shared__ float As[16][68], Bs[16][68], Bs2[16][68];
    int row_base = 0, mrows = M;
    if (CNT) { const int e = blockIdx.z; row_base = moe_base(CNT, e); mrows = CNT[e]; B += (long)e * bstride; if (B2) B2 += (long)e * bstride; }
    const int m0 = blockIdx.y * 64; if (m0 >= mrows) return;
    const int n0 = blockIdx.x * 64, tid = threadIdx.x, tx = tid & 15, ty = tid >> 4;
    float acc[4][4], acc2[4][4];
#pragma unroll
    for (int i = 0; i < 4; ++i)
#pragma unroll
        for (int j = 0; j < 4; ++j) { acc[i][j] = 0.f; acc2[i][j] = 0.f; }
    const int ar = tid >> 2, ak = (tid & 3) * 4; long arow = -1;
    { const int lr = m0 + ar; if (lr < mrows) { arow = rowlist ? (long)rowlist[row_base + lr] : (long)(row_base + lr); } }
    const int bk = tid >> 4, bn = (tid & 15) * 4;
    for (int k0 = 0; k0 < K; k0 += 16) {
        float av[4] = {0.f, 0.f, 0.f, 0.f};
        if (arow >= 0) {
#pragma unroll
            for (int i = 0; i < 4; ++i) av[i] = ldf(A + arow * lda + k0 + ak + i);
        }
#pragma unroll
        for (int i = 0; i < 4; ++i) As[ak + i][ar] = av[i];
#pragma unroll
        for (int i = 0; i < 4; ++i) { const int n = n0 + bn + i; const bool ok = n < N;
            Bs[bk][bn + i] = ok ? B[(long)(k0 + bk) * ldb + n] : 0.f;
            if (EPI == 1 || EPI == 2) Bs2[bk][bn + i] = ok ? B2[(long)(k0 + bk) * ldb + n] : 0.f; }
        __syncthreads();
#pragma unroll
        for (int kk = 0; kk < 16; ++kk) {
            float a[4], b[4], b2[4];
#pragma unroll
            for (int i = 0; i < 4; ++i) { a[i] = As[kk][ty * 4 + i]; b[i] = Bs[kk][tx * 4 + i]; if (EPI == 1 || EPI == 2) b2[i] = Bs2[kk][tx * 4 + i]; }
#pragma unroll
            for (int i = 0; i < 4; ++i)
#pragma unroll
                for (int j = 0; j < 4; ++j) { acc[i][j] += a[i] * b[j]; if (EPI == 1 || EPI == 2) acc2[i][j] += a[i] * b2[j]; }
        }
        __syncthreads();
    }
#pragma unroll
    for (int i = 0; i < 4; ++i) { const int lr = m0 + ty * 4 + i; if (lr >= mrows) continue; const long crow = row_base + lr;
#pragma unroll
        for (int j = 0; j < 4; ++j) { const int n = n0 + tx * 4 + j; if (n >= N) continue;
            float v = acc[i][j];
            if (EPI == 1 || EPI == 2) v = silu_f(v) * acc2[i][j];
            if (EPI == 3) v *= scale[crow];
            if (EPI == 2) ((bf16*)Cv)[crow * ldc + n] = (bf16)f2bf(v); else ((float*)Cv)[crow * ldc + n] = v; } }
}

#define GW_DECL const int lane = threadIdx.x & 63; const int gw = (int)((blockIdx.x * (long)blockDim.x + threadIdx.x) >> 6); const int ngw = (int)((gridDim.x * (long)blockDim.x) >> 6); (void)lane; (void)gw; (void)ngw;
#define GT_DECL const long gt = blockIdx.x * (long)blockDim.x + threadIdx.x; const long ngt = gridDim.x * (long)blockDim.x;

__global__ void k_ln_in(const float* x, const float* g, const float* b, float* H, long n_rows) { GW_DECL for (long r = gw; r < n_rows; r += ngw) ln_row<float>(x + r * DM, 1.f, nullptr, nullptr, g, b, H + r * DM, nullptr, lane); }
__global__ void k_ln_res(float* H, const float* Y, const float* g, const float* b, float* OUT, long n_rows) { GW_DECL for (long r = gw; r < n_rows; r += ngw) ln_row<float>(H + r * DM, ALPHA, Y + r * DM, nullptr, g, b, OUT + r * DM, nullptr, lane); }
__global__ void k_ln_moe(float* H, const float* F2, const int* GS, const float* g, const float* b, float* OUT, long n_rows) { GW_DECL for (long r = gw; r < n_rows; r += ngw) ln_row<float>(H + r * DM, ALPHA, F2 + (long)GS[r * 2] * DM, F2 + (long)GS[r * 2 + 1] * DM, g, b, OUT + r * DM, nullptr, lane); }
__global__ void k_rope(float* P, ProjL L, const int* pos, long n_rows) { GT_DECL rope_inplace(P, L, pos, n_rows, gt, ngt); }
__global__ void k_kmean(const float* P, ProjL L, float* KM, int nb) { GT_DECL kmean_phase<float>(P, L, KM, nb, gt, ngt); }
__global__ void k_attn(const float* P, ProjL L, const float* KM, float* O, int ldo, int nb) { GW_DECL attn_naive_phase<float>(P, L, KM, O, ldo, nb, gw, ngw, lane); }
__global__ void k_rms384(const float* in, int ldi, const float* g, float* out, int ldo, long n_rows) { GW_DECL rms_rows_phase<384, float>(in, ldi, g, out, ldo, n_rows, gw, ngw, lane); }
__global__ void k_rms256(const float* in, int ldi, const float* g, float* out, int ldo, long n_rows) { GW_DECL rms_rows_phase<256, float>(in, ldi, g, out, ldo, n_rows, gw, ngw, lane); }
__global__ void k_ssd_conv(const float* P, ProjL L, const float* cw, const float* cb, const float* dtb, float* XC, float* DT, long n_rows) { GT_DECL ssd_conv_phase<float, float>(P, L, cw, cb, dtb, XC, DT, n_rows, gt, ngt); }
__global__ void k_ssd_scan(const float* XC, const float* DT, const float* a_log, const float* dsk, float* Y, int ldo, int nb) { GW_DECL ssd_scan_naive_phase<float>(XC, DT, a_log, dsk, Y, ldo, nb, gw, ngw, lane); }
__global__ void k_ssd_gate(const float* Y, int ldi, const float* P, ProjL L, const float* ng, float* out, int ldo, long n_rows) { GW_DECL ssd_gate_phase<float, float>(Y, ldi, P, L, ng, out, ldo, n_rows, gw, ngw, lane); }
__global__ void k_gm_ln(const float* P, ProjL L, const float* g, const float* b, float* VN, long n_rows) { GW_DECL gm_ln_phase<float, false>(P, L, g, b, VN, n_rows, gw, ngw, lane); }
__global__ void k_gm_mix(const float* P, ProjL L, const float* VN, const float* ws_, const float* bs, float* GO, int ldo, long n_rows) { GT_DECL gm_mix_phase<float, false>(P, L, VN, ws_, bs, GO, ldo, n_rows, gt, ngt); }
__global__ void k_moe_init(int* CNT, int* LIST, int nslots) { GT_DECL if (gt < N_EXP) CNT[gt] = 0; for (long i = gt; i < nslots; i += ngt) LIST[i] = -1; }
__global__ void k_moe_route(const float* H, const float* Wr, int* CNT, int* TE, float* TP, int* TS, long n_rows) { GW_DECL moe_route_phase(H, Wr, CNT, TE, TP, TS, n_rows, gw, ngw, lane); }
__global__ void k_moe_scatter(const int* CNT, const int* TE, const float* TP, const int* TS, int* LIST, float* SP, int* GS, long n_rows) { GT_DECL moe_scatter_phase(CNT, TE, TP, TS, LIST, SP, GS, n_rows, gt, ngt); }

struct Inputs {
    const float *x; const int* pos; const float *ln_in_g, *ln_in_b, *w_in, *conv_w, *conv_b, *dt_bias, *a_log, *d_skip, *ssd_norm_g, *att_norm_g, *gm_ln_g, *gm_ln_b, *gm_w_s, *gm_b_s, *gm_norm_g, *w_out,
        *ln1_g, *ln1_b, *ln2_g, *ln2_b, *ffn_w_gate, *ffn_w_up, *ffn_w_down, *router_w, *moe_w_gate, *moe_w_up, *moe_w_down;
};

static void run_simple(const Inputs& I, int nb, unsigned char* ws, float* aux  , float* OUT, hipStream_t st, float* ckpt = nullptr) {
    const long M = (long)nb * SEQ; const size_t MB = 1u << 20;
    const size_t hsz = (size_t)M * DM * 4;
    float* H = (float*)ws; float* MIX = (float*)(ws + hsz); float* Y = (float*)(ws + 2 * hsz); unsigned char* BIG = ws + 3 * hsz + (size_t)N_EXP * 256 * DM * 4;
    float* XC = Y;
    float* VN = aux;
    float* PROJ = (float*)BIG;
    size_t big_bytes = (size_t)M * D_IN * 4; { size_t a = (size_t)M * D_FF * 4; if (a > big_bytes) big_bytes = a; size_t c = (size_t)(2 * M + N_EXP * 256) * D_FFE * 2; if (c > big_bytes) big_bytes = c; }
    big_bytes = (big_bytes + 255) & ~(size_t)255;
    unsigned char* SM = BIG + big_bytes;
    float* KM = (float*)SM; SM += (size_t)nb * ATT_H * NBLK * 64 * 4;
    float* DT = (float*)SM; SM += (size_t)M * SSD_H * 4;
    int* CNT = (int*)SM; SM += 256;
    int* TE = (int*)SM; SM += (size_t)M * 2 * 4; float* TP = (float*)SM; SM += (size_t)M * 2 * 4; int* TS = (int*)SM; SM += (size_t)M * 2 * 4; int* GS = (int*)SM; SM += (size_t)M * 2 * 4;
    const int nslots = (int)(2 * M + N_EXP * 256);
    int* LIST = (int*)SM; SM += (size_t)nslots * 4; float* SP = (float*)SM; SM += (size_t)nslots * 4;
    (void)MB;
    const ProjL L{D_IN, 0, 384, 768, 1152, 1536, 2432, 2438, 2694};
    const int TB = 256; const int GWB = 2048;
    k_ln_in<<<GWB, TB, 0, st>>>(I.x, I.ln_in_g, I.ln_in_b, H, M);
    for (int i = 0; i < 2; ++i) {
        sgemm_k<float, 0><<<dim3((D_IN + 63) / 64, (unsigned)(M / 64), 1), 256, 0, st>>>(H, DM, nullptr, I.w_in + (size_t)i * DM * D_IN, nullptr, D_IN, 0, PROJ, D_IN, (int)M, D_IN, DM, nullptr, nullptr);
        k_rope<<<GWB, TB, 0, st>>>(PROJ, L, I.pos, M);
        const size_t ck_stride = (size_t)M * (D_IN + 3 * DM); float* ck = ckpt ? ckpt + (size_t)i * ck_stride : nullptr;
        if (ck) hipMemcpyAsync(ck, PROJ, (size_t)M * D_IN * 4, hipMemcpyDeviceToDevice, st);
        k_kmean<<<96 * nb, TB, 0, st>>>(PROJ, L, KM, nb);
        k_attn<<<GWB * 2, TB, 0, st>>>(PROJ, L, KM, MIX, DM, nb);
        k_rms384<<<GWB, TB, 0, st>>>(MIX, DM, I.att_norm_g + i * ATT_W, MIX, DM, M);
        k_ssd_conv<<<GWB * 2, TB, 0, st>>>(PROJ, L, I.conv_w + (size_t)i * 4 * SSD_CW, I.conv_b + i * SSD_CW, I.dt_bias + i * SSD_H, XC, DT, M);
        k_ssd_scan<<<(nb * SSD_H * 64 * 64 + TB - 1) / TB, TB, 0, st>>>(XC, DT, I.a_log + i * SSD_H, I.d_skip + i * SSD_H, MIX + ATT_W, DM, nb);
        k_ssd_gate<<<GWB, TB, 0, st>>>(MIX + ATT_W, DM, PROJ, L, I.ssd_norm_g + i * SSD_W, MIX + ATT_W, DM, M);
        k_gm_ln<<<GWB, TB, 0, st>>>(PROJ, L, I.gm_ln_g + i * GM_W, I.gm_ln_b + i * GM_W, VN, M);
        k_gm_mix<<<GWB * 2, TB, 0, st>>>(PROJ, L, VN, I.gm_w_s + (size_t)i * GM_G * GM_CHUNK * GM_CHUNK, I.gm_b_s + i * GM_G * GM_CHUNK, MIX + ATT_W + SSD_W, DM, M);
        k_rms256<<<GWB, TB, 0, st>>>(MIX + ATT_W + SSD_W, DM, I.gm_norm_g + i * GM_W, MIX + ATT_W + SSD_W, DM, M);
        if (ck) hipMemcpyAsync(ck + (size_t)M * D_IN, MIX, hsz, hipMemcpyDeviceToDevice, st);
        sgemm_k<float, 0><<<dim3(DM / 64, (unsigned)(M / 64), 1), 256, 0, st>>>(MIX, DM, nullptr, I.w_out + (size_t)i * DM * DM, nullptr, DM, 0, Y, DM, (int)M, DM, DM, nullptr, nullptr);
        k_ln_res<<<GWB, TB, 0, st>>>(H, Y, I.ln1_g + i * DM, I.ln1_b + i * DM, H, M);
        if (ck) hipMemcpyAsync(ck + (size_t)M * (D_IN + DM), H, hsz, hipMemcpyDeviceToDevice, st);
        if (i == 0) {
            float* ACT = (float*)BIG;
            sgemm_k<float, 1><<<dim3(D_FF / 64, (unsigned)(M / 64), 1), 256, 0, st>>>(H, DM, nullptr, I.ffn_w_gate, I.ffn_w_up, D_FF, 0, ACT, D_FF, (int)M, D_FF, DM, nullptr, nullptr);
            sgemm_k<float, 0><<<dim3(DM / 64, (unsigned)(M / 64), 1), 256, 0, st>>>(ACT, D_FF, nullptr, I.ffn_w_down, nullptr, DM, 0, Y, DM, (int)M, DM, D_FF, nullptr, nullptr);
            k_ln_res<<<GWB, TB, 0, st>>>(H, Y, I.ln2_g + i * DM, I.ln2_b + i * DM, H, M);
            if (ck) hipMemcpyAsync(ck + (size_t)M * (D_IN + 2 * DM), H, hsz, hipMemcpyDeviceToDevice, st);
        } else {
            bf16* ACTM = (bf16*)BIG; float* F2 = MIX;
            k_moe_init<<<256, TB, 0, st>>>(CNT, LIST, nslots);
            k_moe_route<<<GWB, TB, 0, st>>>(H, I.router_w, CNT, TE, TP, TS, M);
            k_moe_scatter<<<256, TB, 0, st>>>(CNT, TE, TP, TS, LIST, SP, GS, M);
            sgemm_k<float, 2><<<dim3(D_FFE / 64, (unsigned)(M / 64), N_EXP), 256, 0, st>>>(H, DM, LIST, I.moe_w_gate, I.moe_w_up, D_FFE, (long)DM * D_FFE, ACTM, D_FFE, 0, D_FFE, DM, CNT, nullptr);
            sgemm_k<bf16, 3><<<dim3(DM / 64, (unsigned)(M / 64), N_EXP), 256, 0, st>>>(ACTM, D_FFE, nullptr, I.moe_w_down, nullptr, DM, (long)D_FFE * DM, F2, DM, 0, DM, D_FFE, CNT, SP);
            k_ln_moe<<<GWB, TB, 0, st>>>(H, F2, GS, I.ln2_g + i * DM, I.ln2_b + i * DM, OUT, M);
            if (ck) hipMemcpyAsync(ck + (size_t)M * (D_IN + 2 * DM), OUT, hsz, hipMemcpyDeviceToDevice, st);
        }
    }
}

#define LAS __attribute__((address_space(3)))
namespace pg8 {
#define PG8_LAS __attribute__((address_space(3)))
typedef unsigned short bf16_t;
typedef short bf16x8 __attribute__((ext_vector_type(8)));
typedef float f32x4 __attribute__((ext_vector_type(4)));
typedef unsigned u32x4 __attribute__((ext_vector_type(4)));
constexpr int BM = 256, BK = 64, HALF = 128, HTB = HALF * BK * 2  , STAGE_BYTES = 8 * HTB, NXCD = 8, WGM = 8;

__host__ __device__ __forceinline__ int lds_byte(int r, int c) { const int st = (r >> 4) * 2 + (c >> 5), rr = r & 15, cc = c & 31, ob = rr * 64 + cc * 2; return st * 1024 + (ob ^ (((ob >> 9) & 1) << 5)); }
__host__ __device__ __forceinline__ void stage_rc(int b, int& R, int& C) { const int st = b / 1024, sb = b % 1024, swz = sb ^ (((sb >> 9) & 1) << 5); R = (st >> 1) * 16 + swz / 64; C = (st & 1) * 32 + (swz % 64) / 2; }
__host__ __device__ __forceinline__ int perm32(int rho) { const int n = rho >> 4, i = rho & 15; return 8 * (i >> 2) + 4 * n + (i & 3); }

struct Unit { int pm, pn, kofs; };
struct Gemm { const bf16_t* A; const bf16_t* Bt; int M, N, K, ld; };

struct StaticOrder {
    int nM, nN, nwg, G, c;
    __host__ __device__ void init(int M, int N, int G_, int c_) { nM = M / BM; nN = N / BM; nwg = nM * nN; G = G_; c = c_; }
    __host__ __device__ bool next(int i, Unit& u) const {
        const long L = (long)i * G + c; if (L >= nwg) return false;
        int wgid = (int)L; { const int q = nwg / NXCD, r = nwg % NXCD, xcd = wgid % NXCD, off = wgid / NXCD; wgid = (xcd < r ? xcd * (q + 1) : r * (q + 1) + (xcd - r) * q) + off; }
        const int nig = WGM * nN, gid = wgid / nig, fm = gid * WGM, gsz = (nM - fm) < WGM ? (nM - fm) : WGM;
        u.pm = fm + ((wgid % nig) % gsz); u.pn = (wgid % nig) / gsz; u.kofs = 0; return true;
    }
    __device__ __forceinline__ void a_ready(const Unit&) const {}
    __device__ __forceinline__ void done(const Unit&) const {}
};
__device__ __forceinline__ unsigned cvt_pk_bf16(float lo, float hi) { unsigned r; asm volatile("v_cvt_pk_bf16_f32 %0, %1, %2" : "=v"(r) : "v"(lo), "v"(hi)); return r; }
typedef float f32x2 __attribute__((ext_vector_type(2)));
typedef int i32x4_ __attribute__((ext_vector_type(4)));
typedef int i32x8_ __attribute__((ext_vector_type(8)));
__device__ __forceinline__ i32x8_ cat8(bf16x8 lo, bf16x8 hi) { const i32x4_ l = (i32x4_)lo, h = (i32x4_)hi; return __builtin_shufflevector(l, h, 0, 1, 2, 3, 4, 5, 6, 7); }
template <class Epi, class Sched, bool ALIGN_EPI = false, bool SP2 = false, bool FP8 = false>
__device__ __forceinline__ void gemm_phase(PG8_LAS unsigned char* lds, const Gemm g, const Sched& S, const Epi& E, const int tid) {
    const int wid = __builtin_amdgcn_readfirstlane(tid >> 6), lane = tid & 63, wr = wid >> 2, wc = wid & 3, fr = lane & 15, fq = lane >> 4;
    const int K = g.ld; int nt = g.K / BK;
    if constexpr (FP8) asm volatile("" : "+s"(nt));
    unsigned voffA[2], voffB[2];
#pragma unroll
    for (int i = 0; i < 2; ++i) { int R, C; stage_rc(tid * 16 + i * 8192, R, C); const int Rb = Epi::PERM ? ((R & ~31) + perm32(R & 31)) : R;
        voffA[i] = (unsigned)(R * K + C) * 2u; voffB[i] = (unsigned)(Rb * K + C) * 2u; }
    const size_t kstep = (size_t)(BK * 2);
    const size_t hstep = (size_t)HALF * K * 2;
    const size_t tstep = 2 * hstep;
    const unsigned ldsw = (unsigned)wid * 1024u;
    const int aoff = lds_byte(wr * 64 + fr, fq * 8), boff = lds_byte(wc * 32 + fr, fq * 8);
#define PG8_SA(b, h) (((b) * 2 + (h)) * HTB)
#define PG8_SB(b, h) ((4 + (b) * 2 + (h)) * HTB)
#define PG8_STAGE(bufoff, gbase, voff) do { const char* sb_ = (const char*)(gbase); asm volatile("" : "+s"(sb_));   \
        _Pragma("unroll") for (int _i = 0; _i < 2; ++_i) { unsigned vo_ = (voff)[_i]; asm volatile("" : "+v"(vo_));   \
        __builtin_amdgcn_global_load_lds((const unsigned*)(sb_ + vo_), (PG8_LAS unsigned*)(lds + (bufoff) + ldsw + _i * 8192), 16, 0, 0); } } while (0)
#define PG8_LDA(dst, b, h) do { _Pragma("unroll") for (int m = 0; m < 4; ++m) _Pragma("unroll") for (int k = 0; k < 2; ++k) dst[m][k] = *(const PG8_LAS bf16x8*)(lds + PG8_SA(b, h) + aoff + m * 2048 + k * 1024); } while (0)
#define PG8_LDB(dst, b, h) do { _Pragma("unroll") for (int n = 0; n < 2; ++n) _Pragma("unroll") for (int k = 0; k < 2; ++k) dst[n][k] = *(const PG8_LAS bf16x8*)(lds + PG8_SB(b, h) + boff + n * 2048 + k * 1024); } while (0)
#define PG8_MMA(ai, bj, At, Bt) do { __builtin_amdgcn_s_setprio(1); _Pragma("unroll") for (int m = 0; m < 4; ++m) _Pragma("unroll") for (int n = 0; n < 2; ++n) { \
        if constexpr (FP8) acc[ai][bj][m][n] = __builtin_amdgcn_mfma_scale_f32_16x16x128_f8f6f4(cat8(Bt[n][0], Bt[n][1]), cat8(At[m][0], At[m][1]), acc[ai][bj][m][n], 0, 0, 0, 0, 0, 0); \
        else { _Pragma("unroll") for (int k = 0; k < 2; ++k) acc[ai][bj][m][n] = __builtin_amdgcn_mfma_f32_16x16x32_bf16(Bt[n][k], At[m][k], acc[ai][bj][m][n], 0, 0, 0); } } __builtin_amdgcn_s_setprio(0); } while (0)
#define PG8_WAIT_V(n) asm volatile("s_waitcnt vmcnt(" #n ")" ::: "memory")
#define PG8_WAIT_L(n) asm volatile("s_waitcnt lgkmcnt(" #n ")" ::: "memory")
#define PG8_BAR __builtin_amdgcn_s_barrier()
#define PG8_SCHED __builtin_amdgcn_sched_barrier(0)
    Unit cur, nxt; int ui = 0;
    if (!S.next(0, cur)) return;
    f32x4 acc[2][2][4][2];
#pragma unroll
    for (int a = 0; a < 2; ++a)
#pragma unroll
        for (int b = 0; b < 2; ++b)
#pragma unroll
            for (int m = 0; m < 4; ++m)
#pragma unroll
                for (int n = 0; n < 2; ++n) acc[a][b][m][n] = (f32x4){0.f, 0.f, 0.f, 0.f};
    bf16x8 At[4][2], B0[2][2], B1[2][2];
    const char* cA = (const char*)g.A + (size_t)cur.pm * tstep + (size_t)cur.kofs * 2; const char* cB = (const char*)g.Bt + (size_t)cur.pn * tstep + (size_t)cur.kofs * 2;
    S.a_ready(cur);
    if constexpr (SP2) {
        PG8_STAGE(PG8_SB(0, 0), cB, voffB); PG8_STAGE(PG8_SB(0, 1), cB + hstep, voffB); PG8_STAGE(PG8_SA(0, 0), cA, voffA); PG8_STAGE(PG8_SA(0, 1), cA + hstep, voffA);
        if (wr == 1) PG8_BAR;
        PG8_WAIT_V(2); PG8_BAR;
        PG8_STAGE(PG8_SB(1, 0), cB + kstep, voffB); PG8_STAGE(PG8_SA(1, 0), cA + kstep, voffA); PG8_STAGE(PG8_SB(1, 1), cB + hstep + kstep, voffB);
        PG8_WAIT_V(6); PG8_BAR;
    } else {
        PG8_STAGE(PG8_SB(0, 0), cB, voffB); PG8_STAGE(PG8_SA(0, 0), cA, voffA); PG8_STAGE(PG8_SB(0, 1), cB + hstep, voffB); PG8_STAGE(PG8_SA(0, 1), cA + hstep, voffA);
        if (wr == 1) PG8_BAR;
        PG8_WAIT_V(4); PG8_BAR;
        PG8_STAGE(PG8_SB(1, 0), cB + kstep, voffB); PG8_STAGE(PG8_SA(1, 0), cA + kstep, voffA); PG8_STAGE(PG8_SB(1, 1), cB + hstep + kstep, voffB);
        PG8_WAIT_V(6); PG8_BAR;
    }
    for (;;) {
        const bool has_next = S.next(ui + 1, nxt);
        const char* nA = has_next ? (const char*)g.A + (size_t)nxt.pm * tstep + (size_t)nxt.kofs * 2 : cA; const char* nB = has_next ? (const char*)g.Bt + (size_t)nxt.pn * tstep + (size_t)nxt.kofs * 2 : cB;
        for (int t = 0; t < nt; t += 2) {
            const bool last = (t == nt - 2);
            const char* a1 = cA + (size_t)(t + 1) * kstep;
            const char* a2 = last ? nA : cA + (size_t)(t + 2) * kstep; const char* b2 = last ? nB : cB + (size_t)(t + 2) * kstep;
            const char* a3 = a2 + kstep; const char* b3 = b2 + kstep;
            if (last && has_next) S.a_ready(nxt);
            if constexpr (SP2) {
            PG8_LDB(B0, 0, 0); PG8_LDB(B1, 0, 1); PG8_SCHED; PG8_LDA(At, 0, 0); PG8_STAGE(PG8_SA(1, 1), a1 + hstep, voffA);
            PG8_WAIT_V(8); PG8_WAIT_L(0); PG8_BAR; PG8_MMA(0, 0, At, B0); PG8_MMA(0, 1, At, B1); PG8_BAR; PG8_SCHED;
            PG8_LDA(At, 0, 1); PG8_STAGE(PG8_SB(0, 0), b2, voffB); PG8_STAGE(PG8_SB(0, 1), b2 + hstep, voffB); PG8_STAGE(PG8_SA(0, 0), a2, voffA);
            PG8_WAIT_V(8); PG8_WAIT_L(0); PG8_BAR; PG8_MMA(1, 0, At, B0); PG8_MMA(1, 1, At, B1); PG8_BAR; PG8_SCHED;
            PG8_LDB(B0, 1, 0); PG8_LDB(B1, 1, 1); PG8_SCHED; PG8_LDA(At, 1, 0); PG8_STAGE(PG8_SA(0, 1), a2 + hstep, voffA);
            PG8_WAIT_V(8); PG8_WAIT_L(0); PG8_BAR; PG8_MMA(0, 0, At, B0); PG8_MMA(0, 1, At, B1); PG8_BAR; PG8_SCHED;
            PG8_LDA(At, 1, 1); PG8_STAGE(PG8_SB(1, 0), b3, voffB); PG8_STAGE(PG8_SB(1, 1), b3 + hstep, voffB); PG8_STAGE(PG8_SA(1, 0), a3, voffA);
            PG8_WAIT_V(8); PG8_WAIT_L(0); PG8_BAR; PG8_MMA(1, 0, At, B0); PG8_MMA(1, 1, At, B1); PG8_BAR; PG8_SCHED;
            } else {
            PG8_LDB(B0, 0, 0); PG8_SCHED; PG8_LDA(At, 0, 0); PG8_STAGE(PG8_SA(1, 1), a1 + hstep, voffA);
            PG8_WAIT_L(8); PG8_BAR; PG8_WAIT_L(0); PG8_MMA(0, 0, At, B0); PG8_BAR; PG8_SCHED;
            PG8_LDB(B1, 0, 1); PG8_STAGE(PG8_SB(0, 0), b2, voffB);
            PG8_BAR; PG8_WAIT_L(0); PG8_MMA(0, 1, At, B1); PG8_BAR;
            PG8_LDA(At, 0, 1); PG8_STAGE(PG8_SA(0, 0), a2, voffA);
            PG8_BAR; PG8_WAIT_L(0); PG8_MMA(1, 0, At, B0); PG8_BAR; PG8_SCHED;
            PG8_STAGE(PG8_SB(0, 1), b2 + hstep, voffB);
            PG8_WAIT_V(6); PG8_BAR; PG8_MMA(1, 1, At, B1); PG8_BAR;
            PG8_LDB(B0, 1, 0); PG8_SCHED; PG8_LDA(At, 1, 0); PG8_STAGE(PG8_SA(0, 1), a2 + hstep, voffA);
            PG8_WAIT_L(8); PG8_BAR; PG8_WAIT_L(0); PG8_MMA(0, 0, At, B0); PG8_BAR; PG8_SCHED;
            PG8_LDB(B1, 1, 1); PG8_STAGE(PG8_SB(1, 0), b3, voffB);
            PG8_BAR; PG8_WAIT_L(0); PG8_MMA(0, 1, At, B1); PG8_BAR;
            PG8_LDA(At, 1, 1); PG8_STAGE(PG8_SA(1, 0), a3, voffA);
            PG8_BAR; PG8_WAIT_L(0); PG8_MMA(1, 0, At, B0); PG8_BAR; PG8_SCHED;
            PG8_STAGE(PG8_SB(1, 1), b3 + hstep, voffB);
            PG8_WAIT_V(6); PG8_BAR; PG8_MMA(1, 1, At, B1); PG8_BAR;
            }
        }
        if constexpr (ALIGN_EPI) { if (wr == 0) PG8_BAR; }
        if constexpr (!Epi::AFTER_DRAIN) { E(acc, cur, wr, wc, fr, fq); S.done(cur); }
        if (!has_next) break;
#pragma unroll
        for (int a = 0; a < 2; ++a)
#pragma unroll
            for (int b = 0; b < 2; ++b)
#pragma unroll
                for (int m = 0; m < 4; ++m)
#pragma unroll
                    for (int n = 0; n < 2; ++n) acc[a][b][m][n] = (f32x4){0.f, 0.f, 0.f, 0.f};
        cur = nxt; cA = nA; cB = nB; ++ui;
        if constexpr (ALIGN_EPI) { if (wr == 1) PG8_BAR; }
    }
    PG8_WAIT_V(0);
    if constexpr (!ALIGN_EPI) { if (wr == 0) PG8_BAR; }
    PG8_BAR;
    if constexpr (Epi::AFTER_DRAIN) { E.fused(acc, cur, wr, wc, fr, fq, lds, wid, lane); S.done(cur); }
#undef PG8_SA
#undef PG8_SB
#undef PG8_STAGE
#undef PG8_LDA
#undef PG8_LDB
#undef PG8_MMA
#undef PG8_WAIT_V
#undef PG8_WAIT_L
#undef PG8_BAR
#undef PG8_SCHED
}
}
#define XB_TMO      128
#define XB_XCNT(j)  (256  + 64 * (j))
#define XB_XSUB(j)  (1280 + 64 * (j))
#define XB_XGEN(j)  (2304 + 64 * (j))
#define XB_TOP      3328
#define XB_TOPGEN   3392
#define XCD_BAR_WORDS 3456
#define XB_SPIN_CAP (1u << 24)

__device__ __forceinline__ unsigned xb_ld(unsigned* p)              { return __hip_atomic_load(p, __ATOMIC_RELAXED, __HIP_MEMORY_SCOPE_AGENT); }
__device__ __forceinline__ unsigned xb_add(unsigned* p, unsigned v) { return __hip_atomic_fetch_add(p, v, __ATOMIC_RELAXED, __HIP_MEMORY_SCOPE_AGENT); }
__device__ __forceinline__ unsigned xb_xcc_id() { return (unsigned)__builtin_amdgcn_s_getreg((3 << 11) | 20) & 0xFu; }
#define XB_SPIN(cond, bar) do { unsigned _sp = 0; while (cond) { __builtin_amdgcn_s_sleep(1); \
    if ((++_sp & 255u) == 0u) { if (xb_ld(&(bar)[XB_TMO])) break; if (_sp > XB_SPIN_CAP) { atomicAdd(&(bar)[XB_TMO], 1u); break; } } } } while (0)

__device__ __forceinline__ unsigned xb_lane_fresh() { unsigned l; asm volatile("v_mbcnt_lo_u32_b32 %0, -1, 0\n\tv_mbcnt_hi_u32_b32 %0, -1, %0" : "=v"(l)); return l; }
struct XcdBarrier {
    unsigned* bar; unsigned x; int w0;
    volatile LAS unsigned* st;
};

__device__ __forceinline__ XcdBarrier xcd_barrier_post(unsigned* bar, volatile LAS unsigned* st) {
    XcdBarrier b; b.bar = bar; b.x = xb_xcc_id(); b.st = st; b.w0 = (__builtin_amdgcn_readfirstlane((int)threadIdx.x >> 6) == 0);
    if (threadIdx.x == 0) (void)xb_add(&bar[XB_XCNT(b.x)], 1u);
    return b;
}
__device__ __forceinline__ void xcd_barrier_complete(unsigned* bar, unsigned x, unsigned& nloc, unsigned& nx) {
    const unsigned G = gridDim.x * gridDim.y * gridDim.z;
    unsigned sum, cnt, mine, sp = 0u;
    for (;;) {
        sum = 0u; cnt = 0u; mine = 0u;
#pragma unroll
        for (unsigned j = 0; j < 16; ++j) { const unsigned c = xb_ld(&bar[XB_XCNT(j)]); sum += c; cnt += (c > 0u) ? 1u : 0u; mine = (j == x) ? c : mine; }
        if (sum == G) break;
        __builtin_amdgcn_s_sleep(1);
        if ((++sp & 255u) == 0u) { if (xb_ld(&bar[XB_TMO])) break; if (sp > XB_SPIN_CAP) { atomicAdd(&bar[XB_TMO], 1u); break; } }
    }
    nloc = mine > 0u ? mine : 1u; nx = cnt > 0u ? cnt : 1u;
}

__device__ __forceinline__ void xcd_barrier(const XcdBarrier& b) {
    asm volatile("s_waitcnt vmcnt(0)" ::: "memory");
    __syncthreads();
    if (b.w0 && xb_lane_fresh() == 0u) {
        unsigned* bar = b.bar;
        __builtin_amdgcn_s_waitcnt(0);
        unsigned nloc = b.st[0], nx = b.st[1];
        if (nloc == 0u) { xcd_barrier_complete(bar, b.x, nloc, nx); b.st[0] = nloc; b.st[1] = nx; }
        const unsigned old = xb_add(&bar[XB_XSUB(b.x)], 1u);
        const unsigned gen = old / nloc;
        if (old + 1u == (gen + 1u) * nloc) {
            __builtin_amdgcn_fence(__ATOMIC_RELEASE, "agent");
            asm volatile("s_waitcnt vmcnt(0)" ::: "memory");
            const unsigned og = xb_add(&bar[XB_TOP], 1u);
            const unsigned tg = og / nx;
            if (og + 1u == (tg + 1u) * nx) xb_add(&bar[XB_TOPGEN], 1u);
            else XB_SPIN(xb_ld(&bar[XB_TOPGEN]) == tg, bar);
            __builtin_amdgcn_fence(__ATOMIC_ACQUIRE, "agent");
            xb_add(&bar[XB_XGEN(b.x)], 1u);
            asm volatile("s_waitcnt vmcnt(0)" ::: "memory");
        } else {
            __builtin_amdgcn_fence(__ATOMIC_ACQUIRE, "agent");
            XB_SPIN(xb_ld(&bar[XB_XGEN(b.x)]) == gen, bar);
            asm volatile("s_waitcnt vmcnt(0)" ::: "memory");
        }
    }
    __syncthreads();
}
#include <hip/hip_bf16.h>
#include <cmath>
namespace attn_body {
using bf16=__hip_bfloat16;
using bf16x8=__attribute__((ext_vector_type(8)))short;
using s16x4=__attribute__((ext_vector_type(4)))short;
using f32x16=__attribute__((ext_vector_type(16)))float;
using u32x4=__attribute__((ext_vector_type(4)))unsigned;
constexpr int NHEAD=6,SEQ=2048,D=64,QP=3072,OP=1024;
constexpr int NW=8,QBLK=32,QB=QBLK*NW,KVBLK=64,NQB=SEQ/QB;
constexpr int ATTN_UNIT_ROWS=QB;
__device__ __forceinline__ int crow(int r,int hi){return (r&3)+8*(r>>2)+4*hi;}
#define SBAR() __builtin_amdgcn_sched_barrier(0)
__device__ __forceinline__ void cmask(f32x16&p0,f32x16&p1,int jb,int qrel,int hi){
  const float NEG=-INFINITY; int kb=64*jb+4*hi;
  #pragma unroll
  for(int r=0;r<16;++r){int kv=kb+(r&3)+8*(r>>2); if(kv>qrel)p0[r]=NEG; if(kv+32>qrel)p1[r]=NEG;}
}

constexpr int NSLOT=3, SLOTB=8192;
constexpr int LDS_K=0, LDS_V=NSLOT*SLOTB, LDS_WS=2*NSLOT*SLOTB, LDS_OST=LDS_WS+NW*64*4, LDS_BYTES=LDS_OST+NW*4096;
constexpr float C2=0.125f*1.4426950408889634f;
__device__ __forceinline__ void glds16(const void*gsrc,unsigned lds_dst){unsigned keep;
  asm volatile("s_mov_b32 %0, m0\n\ts_mov_b32 m0, %2\n\ts_nop 0\n\tglobal_load_lds_dwordx4 %1, off\n\ts_mov_b32 m0, %0":"=&s"(keep):"v"(gsrc),"s"(lds_dst):"memory");}
__device__ __forceinline__ float max3f(float a,float b,float c){float r;asm("v_max3_f32 %0, %1, %2, %3":"=v"(r):"v"(a),"v"(b),"v"(c));return r;}
__device__ __forceinline__ float max2f(float a,float b){float r;asm("v_max_f32_e32 %0, %1, %2":"=v"(r):"v"(a),"v"(b));return r;}
__device__ __forceinline__ float fadd_s(float a,float b){float r;asm("v_add_f32_e32 %0, %1, %2":"=v"(r):"v"(a),"v"(b));return r;}
__device__ __forceinline__ float fsub_s(float a,float b){float r;asm("v_sub_f32_e32 %0, %1, %2":"=v"(r):"v"(a),"v"(b));return r;}
typedef float f32x2_t __attribute__((ext_vector_type(2))); typedef __bf16 bf16x2_t __attribute__((ext_vector_type(2)));
__device__ __forceinline__ unsigned cvtpk_s(float lo,float hi){f32x2_t v={lo,hi};bf16x2_t b=__builtin_convertvector(v,bf16x2_t);return __builtin_bit_cast(unsigned,b);}
#define WAIT_BAR(N) asm volatile("s_waitcnt vmcnt(" #N ") lgkmcnt(0)\n\ts_barrier":::"memory")

__device__ __forceinline__ void qkt(f32x16&p0,f32x16&p1,const char*Kslot,const bf16x8*qr,int r32,int hi){ const f32x16 negm=f32x16{};
  const char*kb=Kslot+hi*1024+r32*16;
  #pragma unroll
  for(int d0=0;d0<4;++d0){
    const bf16x8 b0=*reinterpret_cast<const bf16x8*>(kb+d0*2048);
    const bf16x8 b1=*reinterpret_cast<const bf16x8*>(kb+d0*2048+512);
    if(d0==0){p0=__builtin_amdgcn_mfma_f32_32x32x16_bf16(b0,qr[0],negm,0,0,0);p1=__builtin_amdgcn_mfma_f32_32x32x16_bf16(b1,qr[0],negm,0,0,0);}
    else{p0=__builtin_amdgcn_mfma_f32_32x32x16_bf16(b0,qr[d0],p0,0,0,0);p1=__builtin_amdgcn_mfma_f32_32x32x16_bf16(b1,qr[d0],p1,0,0,0);}}
}
typedef __attribute__((address_space(3))) const char* lds_cptr;
typedef short v4i16_t __attribute__((ext_vector_type(4)));
__device__ __forceinline__ void kload8(bf16x8*kf,lds_cptr kp){
  kf[0]=*(const __attribute__((address_space(3))) bf16x8*)(kp);      kf[1]=*(const __attribute__((address_space(3))) bf16x8*)(kp+512);
  kf[2]=*(const __attribute__((address_space(3))) bf16x8*)(kp+2048); kf[3]=*(const __attribute__((address_space(3))) bf16x8*)(kp+2560);
  kf[4]=*(const __attribute__((address_space(3))) bf16x8*)(kp+4096); kf[5]=*(const __attribute__((address_space(3))) bf16x8*)(kp+4608);
  kf[6]=*(const __attribute__((address_space(3))) bf16x8*)(kp+6144); kf[7]=*(const __attribute__((address_space(3))) bf16x8*)(kp+6656);
}
__device__ __forceinline__ void kload2(bf16x8*kf,lds_cptr kp,int j){ kf[2*j]=*(const __attribute__((address_space(3))) bf16x8*)(kp+j*2048); kf[2*j+1]=*(const __attribute__((address_space(3))) bf16x8*)(kp+j*2048+512); }
__device__ __forceinline__ s16x4 vtr(lds_cptr p){ return __builtin_bit_cast(s16x4,__builtin_amdgcn_ds_read_tr16_b64_v4i16((__attribute__((address_space(3))) v4i16_t*)p)); }
__device__ __forceinline__ float rowmax(const f32x16&p0,const f32x16&p1){
  float a=max3f(p0[0],p0[1],p1[0]),b=max3f(p0[2],p0[3],p1[1]);a=max3f(a,p1[2],p1[3]);
  #pragma unroll
  for(int r=4;r<16;r+=4){a=max3f(a,p0[r],p0[r+1]);b=max3f(b,p0[r+2],p0[r+3]);a=max3f(a,p1[r],p1[r+1]);b=max3f(b,p1[r+2],p1[r+3]);}
  const float m=max2f(a,b);
  auto rr=__builtin_amdgcn_permlane32_swap(__float_as_uint(m),__float_as_uint(m),false,false);
  return max2f(__uint_as_float(rr[0]),__uint_as_float(rr[1]));
}
__device__ __forceinline__ void pv(f32x16*o,int vb,bf16x8 pa0,bf16x8 pa1,bf16x8 pa2,bf16x8 pa3){
  #pragma unroll
  for(int d0=0;d0<2;++d0){s16x4 lo[4],hi[4];
    #pragma unroll
    for(int ks=0;ks<4;++ks){
      asm volatile("ds_read_b64_tr_b16 %0,%1 offset:%c2":"=&v"(lo[ks]):"v"(vb),"i"(d0*4096+ks*1024):"memory");
      asm volatile("ds_read_b64_tr_b16 %0,%1 offset:%c2":"=&v"(hi[ks]):"v"(vb),"i"(d0*4096+ks*1024+512):"memory");}
    asm volatile("s_waitcnt lgkmcnt(0)":::"memory");SBAR();
    #define PK(k) (bf16x8){lo[k][0],lo[k][1],lo[k][2],lo[k][3],hi[k][0],hi[k][1],hi[k][2],hi[k][3]}
    o[d0]=__builtin_amdgcn_mfma_f32_32x32x16_bf16(pa0,PK(0),o[d0],0,0,0);
    o[d0]=__builtin_amdgcn_mfma_f32_32x32x16_bf16(pa1,PK(1),o[d0],0,0,0);
    o[d0]=__builtin_amdgcn_mfma_f32_32x32x16_bf16(pa2,PK(2),o[d0],0,0,0);
    o[d0]=__builtin_amdgcn_mfma_f32_32x32x16_bf16(pa3,PK(3),o[d0],0,0,0);
    #undef PK
  }
}

#ifndef ATTN_STORE16
#define ATTN_STORE16(p,v) (*(u32x4*)(p)=(v))
#endif
template<int THRL> __device__ __forceinline__ void attn_unit(int b,int h,int qb,const bf16*Q,const bf16*__restrict__ K,const bf16*__restrict__ V,bf16*O,const float*__restrict__ KM,int KMH,char*shm,const int tid){
  const int lane=tid&63,r32=lane&31,hi=lane>>5; const int wid=__builtin_amdgcn_readfirstlane(tid>>6);
  const long rowbase=(long)b*SEQ; const int q0=qb*QB;
  const bf16*Qw=Q+(rowbase+q0+wid*QBLK)*QP+h*D;
  const bf16*Kh=K+rowbase*QP+h*D,*Vh=V+rowbase*QP+h*D;
  const unsigned lds0=(unsigned)(uintptr_t)shm;
  float*wsf=(float*)(shm+LDS_WS)+wid*64;
  const bf16*ksrc=Kh+(long)lane*QP+wid*8;
  const bf16*vsrc=Vh+(long)(16*(wid&3)+(lane>>2))*QP+(wid>>2)*32+(lane&3)*8;
  const unsigned kdst=lds0+LDS_K+wid*1024, vdst=lds0+LDS_V+wid*1024;
  #define TI(t) (((t)<4)?(NT-4+(t)):((t)-4))
  #define DMA_K(t,slot) glds16(ksrc+(long)TI(t)*KVBLK*QP,(unsigned)__builtin_amdgcn_readfirstlane(kdst+(slot)))
  #define DMA_V(t,slot) glds16(vsrc+(long)TI(t)*KVBLK*QP,(unsigned)__builtin_amdgcn_readfirstlane(vdst+(slot)))
  const char*Kbase=shm+LDS_K; bf16x8 kf[8];
  const lds_cptr shm3=(lds_cptr)shm; const lds_cptr kp0=shm3+LDS_K+hi*1024+r32*16; const lds_cptr vp0=shm3+LDS_V+((lane>>4)&1)*32+(lane&3)*8+(4*hi+((lane&15)>>2))*64;
  const int NT=(q0+QB)/KVBLK;
  DMA_K(0,0);DMA_V(0,0);DMA_K(1,SLOTB);
  bf16x8 qr[4];
  #pragma unroll
  for(int d0=0;d0<4;++d0)qr[d0]=*reinterpret_cast<const bf16x8*>(&Qw[(long)r32*QP+d0*16+hi*8]);

  unsigned sel=0u;
  if(qb>0){ float gt_[8];
    #pragma unroll
    for(int n=0;n<8;++n){ float a_=0.f;
      if(n<qb){ const float*km=KM+((long)(b*NHEAD+h)*8+n)*64+hi*8;
        #pragma unroll
        for(int d0=0;d0<4;++d0){ float4 k0=*reinterpret_cast<const float4*>(km+d0*16), k1=*reinterpret_cast<const float4*>(km+d0*16+4);
          { const float4 k2=*reinterpret_cast<const float4*>(km+KMH+d0*16), k3=*reinterpret_cast<const float4*>(km+KMH+d0*16+4); k0.x+=k2.x;k0.y+=k2.y;k0.z+=k2.z;k0.w+=k2.w;k1.x+=k3.x;k1.y+=k3.y;k1.z+=k3.z;k1.w+=k3.w; }
          const bf16x8 qv=qr[d0];
          a_+=__uint_as_float(((unsigned)(unsigned short)qv[0])<<16)*k0.x+__uint_as_float(((unsigned)(unsigned short)qv[1])<<16)*k0.y+__uint_as_float(((unsigned)(unsigned short)qv[2])<<16)*k0.z+__uint_as_float(((unsigned)(unsigned short)qv[3])<<16)*k0.w
             +__uint_as_float(((unsigned)(unsigned short)qv[4])<<16)*k1.x+__uint_as_float(((unsigned)(unsigned short)qv[5])<<16)*k1.y+__uint_as_float(((unsigned)(unsigned short)qv[6])<<16)*k1.z+__uint_as_float(((unsigned)(unsigned short)qv[7])<<16)*k1.w; }
        a_+=__shfl_xor(a_,32); }
      gt_[n]=(n<qb)?a_:-1e30f; }
    #pragma unroll
    for(int r_=0;r_<3;++r_){ float bv=-3.0e38f; int best=-1;
      #pragma unroll
      for(int n=0;n<8;++n) if(!((sel>>n)&1u)&&gt_[n]>bv){bv=gt_[n];best=n;}
      if(best>=0&&bv>-0.5e30f) sel|=1u<<best; } }
  if(hi==0)wsf[32+r32]=__uint_as_float(sel); asm volatile("s_waitcnt lgkmcnt(0)":::"memory");
  float mhat=0.f,l_reg=0.f;f32x16 o[2];o[0]=f32x16{};o[1]=f32x16{};
  const int qrel=wid*QBLK+r32;
  #define CMASK(P0,P1,t) do{ if((t)<4){cmask(P0,P1,(t),qrel,hi);} else if(!((__float_as_uint(wsf[32+r32])>>(((t)-4)>>2))&1u)){ _Pragma("unroll") for(int r_=0;r_<16;++r_){P0[r_]=-INFINITY;P1[r_]=-INFINITY;} } }while(0)
  bool resc=false;
  #define START(P0,P1) do{ const float rm=rowmax(P0,P1); resc=false; \
    { const float dl=rm; mhat=fadd_s(mhat,dl); \
      _Pragma("unroll") for(int r=0;r<16;++r){P0[r]=fsub_s(P0[r],dl);P1[r]=fsub_s(P1[r],dl);} \
      } \
    _Pragma("unroll") for(int r=0;r<16;++r)P0[r]=__builtin_amdgcn_exp2f(P0[r]); }while(0)
  #define RESC() do{ if(resc){ asm volatile("s_waitcnt lgkmcnt(0)":::"memory"); \
      _Pragma("unroll") for(int d_=0;d_<2;++d_) _Pragma("unroll") for(int r=0;r<16;++r)o[d_][r]*=wsf[crow(r,hi)]; } }while(0)
  f32x16 pA0,pA1,pB0,pB1;
  int sl_prev=0,sl_cur=0,sl_next=SLOTB;
  #define ROT() do{sl_prev=sl_cur;sl_cur=sl_next;sl_next=(sl_next==(NSLOT-1)*SLOTB)?0:sl_next+SLOTB;}while(0)
  DMA_K(2,2*SLOTB);
  WAIT_BAR(3);
  qkt(pA0,pA1,Kbase,qr,r32,hi);asm volatile("s_nop 15\n\ts_nop 7":"+v"(pA0),"+v"(pA1));CMASK(pA0,pA1,0);
  START(pA0,pA1);
  _Pragma("unroll") for(int r=0;r<16;++r)pA1[r]=__builtin_amdgcn_exp2f(pA1[r]);
  WAIT_BAR(0);
  DMA_K(3,0);DMA_V(1,SLOTB);
  ROT();
  kload8(kf,kp0+sl_cur);
  WAIT_BAR(2);
  s16x4 vlo[8],vhi[8]; u32x4 pw0,pw1,pw2,pw3;
  #define PKW(P,B) cvtpk_s(P[B],P[B+1])
  #define PAF(k) __builtin_bit_cast(bf16x8,pw##k)
  #define VFR(i) (bf16x8){vlo[i][0],vlo[i][1],vlo[i][2],vlo[i][3],vhi[i][0],vhi[i][1],vhi[i][2],vhi[i][3]}
  #define PIN(x) asm volatile("":"+v"(x))
  #define MX3(a,b,c) __builtin_fmaxf(__builtin_fmaxf((a),(b)),(c))
  #define GAPA(MF,A0,A1,A2,A3,W0,W1,PW) do{ MF; sacc+=A0; sacc+=A1; sacc+=A2; sacc+=A3; PIN(sacc); W0; W1; PIN(PW); SBAR(); }while(0)
  #define EX(v) __builtin_amdgcn_exp2f(v)
  #define GAPB(MF,X,B) do{ MF; X[B]=EX(X[B]); X[B+1]=EX(X[B+1]); X[B+2]=EX(X[B+2]); X[B+3]=EX(X[B+3]); PIN(X); SBAR(); }while(0)
  #define VRD(i) do{ vlo[i]=vtr(vp_+(((i)>>2)*4096+((i)&3)*1024)); vhi[i]=vtr(vp_+(((i)>>2)*4096+((i)&3)*1024+512)); }while(0)
  #define KRD(G,j) do{ if(G){ kload2(kf,kp0+sl_next,j); SBAR(); } }while(0)
  #define STEP(C0,C1,P0,P1,t,GK,GV,GL) do{ SBAR(); \
    const lds_cptr vp_=vp0+sl_prev; \
    VRD(0); SBAR(); float sacc=(P0[0]+P0[1]); \
    GAPA(C0=__builtin_amdgcn_mfma_f32_32x32x16_bf16(kf[0],qr[0],f32x16{},0,0,0), P0[2],P0[3],P0[4],P0[5],     pw0[0]=PKW(P0,0), pw0[1]=PKW(P0,2), pw0); \
    VRD(4); SBAR(); GAPA(C1=__builtin_amdgcn_mfma_f32_32x32x16_bf16(kf[1],qr[0],f32x16{},0,0,0), P0[6],P0[7],P0[8],P0[9],     pw0[2]=PKW(P0,4), pw0[3]=PKW(P0,6), pw0); \
    VRD(1); SBAR(); GAPA(C0=__builtin_amdgcn_mfma_f32_32x32x16_bf16(kf[2],qr[1],C0,0,0,0),   P0[10],P0[11],P0[12],P0[13], pw1[0]=PKW(P0,8), pw1[1]=PKW(P0,10), pw1); \
    VRD(5); SBAR(); GAPA(C1=__builtin_amdgcn_mfma_f32_32x32x16_bf16(kf[3],qr[1],C1,0,0,0),   P0[14],P0[15],P1[0],P1[1],   pw1[2]=PKW(P0,12),pw1[3]=PKW(P0,14), pw1); \
    VRD(2); SBAR(); GAPA(C0=__builtin_amdgcn_mfma_f32_32x32x16_bf16(kf[4],qr[2],C0,0,0,0),   P1[2],P1[3],P1[4],P1[5],     pw2[0]=PKW(P1,0), pw2[1]=PKW(P1,2), pw2); \
    VRD(6); SBAR(); GAPA(C1=__builtin_amdgcn_mfma_f32_32x32x16_bf16(kf[5],qr[2],C1,0,0,0),   P1[6],P1[7],P1[8],P1[9],     pw2[2]=PKW(P1,4), pw2[3]=PKW(P1,6), pw2); \
    VRD(3); SBAR(); GAPA(C0=__builtin_amdgcn_mfma_f32_32x32x16_bf16(kf[6],qr[3],C0,0,0,0),   P1[10],P1[11],P1[12],P1[13], pw3[0]=PKW(P1,8), pw3[1]=PKW(P1,10), pw3); \
    VRD(7); SBAR(); GAPA(C1=__builtin_amdgcn_mfma_f32_32x32x16_bf16(kf[7],qr[3],C1,0,0,0),   P1[14],P1[15],0.f,0.f,       pw3[2]=PKW(P1,12),pw3[3]=PKW(P1,14), pw3); \
    l_reg+=sacc; \
    if(GK){DMA_K((t)+3,sl_cur);} if(GV){DMA_V((t)+1,sl_next);} \
    CMASK(C0,C1,t); \
    _Pragma("unroll") for(int r=0;r<16;++r){C0[r]-=mhat;C1[r]-=mhat;} \
    { float a=MX3(C0[0],C0[1],C1[0]),b=MX3(C0[2],C0[3],C1[1]); a=MX3(a,C1[2],C1[3]); \
      _Pragma("unroll") for(int r=4;r<16;r+=4){a=MX3(a,C0[r],C0[r+1]);b=MX3(b,C0[r+2],C0[r+3]);a=MX3(a,C1[r],C1[r+1]);b=MX3(b,C1[r+2],C1[r+3]);} \
      float rm=__builtin_fmaxf(a,b); { auto rr=__builtin_amdgcn_permlane32_swap(__float_as_uint(rm),__float_as_uint(rm),false,false); rm=__builtin_fmaxf(__uint_as_float(rr[0]),__uint_as_float(rr[1])); } \
      resc=false; \
      if(__builtin_expect(__any(rm>(float)THRL),0)){ const float dl=__builtin_fmaxf(rm,0.f); mhat+=dl; \
        _Pragma("unroll") for(int r=0;r<16;++r){C0[r]-=dl;C1[r]-=dl;} \
        const float f=__builtin_amdgcn_exp2f(-dl); l_reg*=f; if(hi==0)wsf[r32]=f; resc=true; } } \
    SBAR(); \
    GAPB(o[0]=__builtin_amdgcn_mfma_f32_32x32x16_bf16(PAF(0),VFR(0),o[0],0,0,0), C0,0); \
    GAPB(o[1]=__builtin_amdgcn_mfma_f32_32x32x16_bf16(PAF(0),VFR(4),o[1],0,0,0), C0,4); \
    KRD(GL,0); GAPB(o[0]=__builtin_amdgcn_mfma_f32_32x32x16_bf16(PAF(1),VFR(1),o[0],0,0,0), C0,8); \
    KRD(GL,1); GAPB(o[1]=__builtin_amdgcn_mfma_f32_32x32x16_bf16(PAF(1),VFR(5),o[1],0,0,0), C0,12); \
    KRD(GL,2); GAPB(o[0]=__builtin_amdgcn_mfma_f32_32x32x16_bf16(PAF(2),VFR(2),o[0],0,0,0), C1,0); \
    KRD(GL,3); GAPB(o[1]=__builtin_amdgcn_mfma_f32_32x32x16_bf16(PAF(2),VFR(6),o[1],0,0,0), C1,4); \
    GAPB(o[0]=__builtin_amdgcn_mfma_f32_32x32x16_bf16(PAF(3),VFR(3),o[0],0,0,0), C1,8); \
    GAPB(o[1]=__builtin_amdgcn_mfma_f32_32x32x16_bf16(PAF(3),VFR(7),o[1],0,0,0), C1,12); \
    }while(0)
  int t=1;
  for(;t+5<NT;t+=2){
    STEP(pB0,pB1,pA0,pA1,t,true,true,true);     WAIT_BAR(2); RESC(); ROT();
    STEP(pA0,pA1,pB0,pB1,t+1,true,true,true);   WAIT_BAR(2); RESC(); ROT();
  }
  #define ENDW(tt) do{ if((tt)+3<NT){WAIT_BAR(2);} else if((tt)+2<NT){WAIT_BAR(1);} else {WAIT_BAR(0);} }while(0)
  for(;t+1<NT;t+=2){
    STEP(pB0,pB1,pA0,pA1,t,(t+3<NT),(t+1<NT),(t+1<NT));       ENDW(t);   RESC(); ROT();
    STEP(pA0,pA1,pB0,pB1,t+1,(t+4<NT),(t+2<NT),(t+2<NT));     ENDW(t+1); RESC(); ROT();
  }
  STEP(pB0,pB1,pA0,pA1,NT-1,false,false,false); RESC();
  { float sacc=pB0[0]+pB0[1]; _Pragma("unroll") for(int r=2;r<16;++r)sacc+=pB0[r]; _Pragma("unroll") for(int r=0;r<16;++r)sacc+=pB1[r]; l_reg+=sacc;
    pw0=(u32x4){PKW(pB0,0),PKW(pB0,2),PKW(pB0,4),PKW(pB0,6)};pw1=(u32x4){PKW(pB0,8),PKW(pB0,10),PKW(pB0,12),PKW(pB0,14)};pw2=(u32x4){PKW(pB1,0),PKW(pB1,2),PKW(pB1,4),PKW(pB1,6)};pw3=(u32x4){PKW(pB1,8),PKW(pB1,10),PKW(pB1,12),PKW(pB1,14)};
    SBAR(); pv(o,(int)(unsigned)(size_t)vp0+sl_cur,PAF(0),PAF(1),PAF(2),PAF(3)); }
  #undef PKW
  #undef PAF
  #undef VFR
  #undef PIN
  #undef MX3
  #undef GAPA
  #undef GAPB
  #undef EX
  #undef VRD
  #undef KRD
  #undef STEP
  #undef ENDW
  {auto rr=__builtin_amdgcn_permlane32_swap(__float_as_uint(l_reg),__float_as_uint(l_reg),false,false);l_reg=__uint_as_float(rr[0])+__uint_as_float(rr[1]);}
  if(hi==0)wsf[32+r32]=l_reg;asm volatile("s_waitcnt lgkmcnt(0)":::"memory");
  float rli[16];
  #pragma unroll
  for(int r=0;r<16;++r)rli[r]=__builtin_amdgcn_rcpf(wsf[32+crow(r,hi)]);
  bf16*Ow=O+(rowbase+q0+wid*QBLK)*OP+h*D;
  { bf16*stg=(bf16*)(shm+LDS_OST)+wid*2048;
    #pragma unroll
    for(int r=0;r<16;++r){const int orow=crow(r,hi);
      #pragma unroll
      for(int d0=0;d0<2;++d0)stg[orow*64+d0*32+r32]=__float2bfloat16(o[d0][r]*rli[r]);}
    asm volatile("s_waitcnt lgkmcnt(0)":::"memory");
    #pragma unroll
    for(int i=0;i<4;++i){const int row=i*8+(lane>>3),ch=lane&7; const u32x4 v=*(const u32x4*)(stg+row*64+ch*8); ATTN_STORE16(Ow+(long)row*OP+ch*8,v);} }
  asm volatile("s_waitcnt lgkmcnt(0)\n\ts_barrier":::"memory");
  #undef DMA_K
  #undef DMA_V
  #undef TI
  #undef CMASK
  #undef START
  #undef RESC
  #undef ROT
}
constexpr int ATTN_LDS_BYTES=LDS_BYTES;
#undef SBAR
#undef WAIT_BAR
}
#undef LAS
constexpr int NB = DEBUG_BUILD ? 2 : 8;
constexpr int M_ = NB * SEQ;
constexpr int NSLOT = 2 * M_ + N_EXP * 256;
constexpr int PLD = 3072;
constexpr int FQ = 0, FK = 384, FV = 768, FZ = 1152, FGU = 1536, FGV = 1792, FXBC = 2048, FDT = 2944;
constexpr int NGU = 2 * D_FF, NGUE = 2 * D_FFE;

constexpr size_t al256(size_t x) { return (x + 255) & ~(size_t)255; }
constexpr size_t MiB = 1u << 20;
constexpr size_t O_CTL = 0, CTL_BYTES = 1 * MiB;
constexpr size_t O_RT = 1 * MiB;
constexpr size_t O_TE = O_RT + (size_t)M_ * 64, O_TP = O_TE + (size_t)M_ * 8, O_TS = O_TP + (size_t)M_ * 8, O_GS = O_TS + (size_t)M_ * 8;
constexpr size_t O_SP = O_GS + (size_t)M_ * 8;
constexpr size_t O_KM = O_SP + al256((size_t)NSLOT * 4);
constexpr size_t O_DT = O_KM + (size_t)2 * NB * ATT_H * NBLK * 64 * 4;
constexpr size_t O_WSB = al256(O_DT + (size_t)M_ * 24);
constexpr size_t O_HB = (O_WSB + (size_t)2 * GM_G * GM_CHUNK * GM_CHUNK * 2 + MiB - 1) / MiB * MiB;
constexpr size_t O_MWGU = O_HB + (size_t)M_ * DM * 2;
constexpr size_t O_WIN = O_MWGU + (size_t)N_EXP * NGUE * DM * 2;
constexpr size_t O_WOUT = O_WIN + (size_t)2 * PLD * DM * 2;
constexpr size_t O_WGU = O_WOUT + (size_t)2 * DM * DM * 2;
constexpr size_t O_WD = O_WGU + (size_t)NGU * DM * 2;
constexpr size_t O_SCR = O_WD + (size_t)DM * D_FF * 2;
constexpr size_t O_PROJ = O_SCR;
constexpr size_t O_XC = O_PROJ + (size_t)M_ * PLD * 2;
constexpr size_t O_MIXU = O_XC + (size_t)M_ * SSD_CW * 2;
constexpr size_t O_MIXB = O_MIXU + (size_t)M_ * DM * 4;
constexpr size_t O_VN = O_MIXB + (size_t)M_ * DM * 2;
constexpr size_t O_MIXEND = O_VN + (size_t)M_ * GM_W * 4;
constexpr size_t O_Y = O_SCR;
constexpr size_t O_ACT = O_Y + (size_t)M_ * DM * 4;
constexpr size_t O_XG = O_WIN;
constexpr size_t O_ACTM = O_XG + (size_t)NSLOT * DM * 2;
constexpr size_t O_MOEEND = O_ACTM + (size_t)NSLOT * D_FFE * 2;
constexpr size_t WS_END = O_MOEEND > O_MIXEND ? O_MOEEND : O_MIXEND;
static_assert(O_ACT + (size_t)M_ * D_FF * 2 <= O_MIXEND + (size_t)M_ * 4096, "act");
static_assert((size_t)NB * 16 * SSD_H * 8192 * 4 <= (size_t)M_ * SSD_CW * 2, "SSD states fit in the XC slot");
static_assert((size_t)NB * 32 * 768 * 4 <= (size_t)M_ * GM_W * 4, "dt/acum hand-off fits in the VN slot");
static_assert(WS_END <= 487000000ull, "workspace map exceeds the guaranteed size");
static_assert((size_t)N_EXP * DM * D_FFE * 2 <= (size_t)NBATCH * SEQ * DM * 4, "MWD fits in d_out");
constexpr int CW_BAR = 4096, CW_CNT = 1024, CW_Q = 1040, CW_ERR = 2048, CW_BC = 16384  ;

constexpr int RING_BYTES = 131072, MISC_OFF = RING_BYTES + 320, LDS_BYTES = 147456;

#define GAS __attribute__((address_space(1)))
#define LAS __attribute__((address_space(3)))
typedef GAS unsigned gu32;
#define RLX_AGENT __ATOMIC_RELAXED, __HIP_MEMORY_SCOPE_AGENT
#define LDS_WAIT() asm volatile("s_waitcnt lgkmcnt(0)" ::: "memory")

constexpr float QSCALE = 0.125f * 1.4426950408889634f;
constexpr int TAIL_UNITS = 128;
constexpr float W8_GU = 32.f, W8_D = 128.f;
typedef unsigned char f8_t;
namespace fp {
using pg8::Unit; using pg8::BM; using pg8::HALF; typedef pg8::f32x4 f32x4; typedef pg8::u32x4 u32x4; typedef unsigned u32x2_f __attribute__((ext_vector_type(2)));
__device__ __forceinline__ unsigned pk2(float lo, float hi) { return pg8::cvt_pk_bf16(lo, hi); }
__device__ __forceinline__ unsigned pk4_f8(float a, float b, float c, float d) { int w = 0; w = __builtin_amdgcn_cvt_pk_fp8_f32(a, b, w, false); w = __builtin_amdgcn_cvt_pk_fp8_f32(c, d, w, true); return (unsigned)w; }
__device__ __forceinline__ float clamp8(float x) { return __builtin_amdgcn_fmed3f(x, -448.f, 448.f); }
__device__ __forceinline__ void st16_wt(void* p, u32x4 v) { asm volatile("global_store_dwordx4 %0, %1, off sc1\n\ts_nop 1" :: "v"(p), "v"(v) : "memory"); }
__device__ __forceinline__ float gelu_fast(float x) { const float u = 0.7978845608028654f * (x + 0.044715f * x * x * x); return x * __builtin_amdgcn_rcpf(1.f + __expf(-2.f * u)); }

struct EpiProj {
    static constexpr bool PERM = true, AFTER_DRAIN = false;
    bf16* O; const float* RT; float* KM2;
    __device__ __forceinline__ void operator()(const f32x4 (&acc)[2][2][4][2], const Unit& u, int wr, int wc, int fr, int fq) const {
        const int row0 = u.pm * BM + wr * 64 + fr, col0 = u.pn * BM + wc * 32 + 8 * fq;
        f32x4 ks[2][2];
#pragma unroll
        for (int i = 0; i < 2; ++i) { ks[i][0] = (f32x4){0.f, 0.f, 0.f, 0.f}; ks[i][1] = ks[i][0]; }
        const int mode = (u.pn < 3) ? 1 : 0;
        const bool rl = ((wc & 1) == 0) && (fq < 2);
        const int i0 = (fq & 1) * 4;
#pragma unroll
        for (int ai = 0; ai < 2; ++ai) {
            float4 c4a[4], s4a[4];
#pragma unroll
            for (int i = 0; i < 4; ++i) { c4a[i] = make_float4(1.f, 1.f, 1.f, 1.f); s4a[i] = make_float4(0.f, 0.f, 0.f, 0.f); }
            if (mode == 1 && rl) {
#pragma unroll
                for (int i = 0; i < 4; ++i) { const int row = row0 + ai * HALF + i * 16; c4a[i] = *(const float4*)(RT + (size_t)row * 16 + i0); s4a[i] = *(const float4*)(RT + (size_t)row * 16 + 8 + i0); } }
#pragma unroll
            for (int m = 0; m < 4; ++m) { const int row = row0 + ai * HALF + m * 16;
                const float4 c4 = c4a[m], s4 = s4a[m];
#pragma unroll
                for (int bj = 0; bj < 2; ++bj) { f32x4 v0 = acc[ai][bj][m][0], v1 = acc[ai][bj][m][1];
                    if (mode == 1) { const f32x4 a = v0, b = v1;
                        v0[0] = a[0] * c4.x - a[1] * s4.x; v0[1] = a[1] * c4.x + a[0] * s4.x; v0[2] = a[2] * c4.y - a[3] * s4.y; v0[3] = a[3] * c4.y + a[2] * s4.y;
                        v1[0] = b[0] * c4.z - b[1] * s4.z; v1[1] = b[1] * c4.z + b[0] * s4.z; v1[2] = b[2] * c4.w - b[3] * s4.w; v1[3] = b[3] * c4.w + b[2] * s4.w; }
                    if (u.pn == 0 || (u.pn == 1 && bj == 0)) { v0 = v0 * QSCALE; v1 = v1 * QSCALE; }
                    else if (mode == 1) { ks[bj][0] += v0; ks[bj][1] += v1; }
                    u32x4 w; w.x = pk2(v0[0], v0[1]); w.y = pk2(v0[2], v0[3]); w.z = pk2(v1[0], v1[1]); w.w = pk2(v1[2], v1[3]);
                    st16_wt(O + (size_t)row * PLD + col0 + bj * HALF, w); } } }
        if (u.pn == 1 || u.pn == 2) {
#pragma unroll
            for (int bj = 0; bj < 2; ++bj) { if (u.pn == 1 && bj == 0) continue;
#pragma unroll
                for (int n = 0; n < 2; ++n)
#pragma unroll
                    for (int j = 0; j < 4; ++j) { float x = ks[bj][n][j]; x += __shfl_xor(x, 1); x += __shfl_xor(x, 2); x += __shfl_xor(x, 4); x += __shfl_xor(x, 8); ks[bj][n][j] = x * (1.f / 256.f); }
                if (fr == 0) { const int kc = col0 + bj * HALF - FK; const int b = u.pm >> 3, nb = u.pm & 7;
                    float* dst = KM2 + (size_t)wr * (NB * ATT_H * NBLK * 64) + ((size_t)(b * ATT_H + (kc >> 6)) * NBLK + nb) * 64 + (kc & 63);
                    *(f32x4*)dst = ks[bj][0]; *(f32x4*)(dst + 4) = ks[bj][1]; } }
        }
    }
};
struct EpiAct {
    static constexpr bool PERM = true, AFTER_DRAIN = false;
    bf16* O; int ldc, ncol;
    __device__ __forceinline__ void operator()(const f32x4 (&acc)[2][2][4][2], const Unit& u, int wr, int wc, int fr, int fq) const {
        const int row0 = u.pm * BM + wr * 64 + fr, col0 = (u.pn % ncol) * HALF + wc * 32 + 8 * fq;
#pragma unroll
        for (int ai = 0; ai < 2; ++ai)
#pragma unroll
            for (int m = 0; m < 4; ++m) { const int row = row0 + ai * HALF + m * 16;
                const f32x4 g0 = acc[ai][0][m][0], g1 = acc[ai][0][m][1], u0 = acc[ai][1][m][0], u1 = acc[ai][1][m][1]; f32x4 a0, a1;
#pragma unroll
                for (int j = 0; j < 4; ++j) { a0[j] = g0[j] * __builtin_amdgcn_rcpf(1.f + __expf(-g0[j])) * u0[j]; a1[j] = g1[j] * __builtin_amdgcn_rcpf(1.f + __expf(-g1[j])) * u1[j]; }
                u32x4 w; w.x = pk2(a0[0], a0[1]); w.y = pk2(a0[2], a0[3]); w.z = pk2(a1[0], a1[1]); w.w = pk2(a1[2], a1[3]);
                *(u32x4*)(O + (size_t)row * ldc + col0) = w; }
    }
};
struct EpiAct8 {
    static constexpr bool PERM = true, AFTER_DRAIN = false;
    f8_t* O; int ldc, ncol;
    __device__ __forceinline__ void operator()(const f32x4 (&acc)[2][2][4][2], const Unit& u, int wr, int wc, int fr, int fq) const {
        const int row0 = u.pm * BM + wr * 64 + fr, col0 = (u.pn % ncol) * HALF + wc * 32 + 8 * fq;
        constexpr float s = 1.f / W8_GU, ke = -s * 1.4426950408889634f, is2 = W8_GU * W8_GU;
#pragma unroll
        for (int ai = 0; ai < 2; ++ai)
#pragma unroll
            for (int m = 0; m < 4; ++m) { const int row = row0 + ai * HALF + m * 16;
                const f32x4 g0 = acc[ai][0][m][0], g1 = acc[ai][0][m][1], u0 = acc[ai][1][m][0], u1 = acc[ai][1][m][1]; f32x4 a0, a1;
#pragma unroll
                for (int j = 0; j < 4; ++j) {
                    float p0 = g0[j] * u0[j], r0 = __builtin_amdgcn_rcpf(__builtin_fmaf(__builtin_amdgcn_exp2f(g0[j] * ke), is2, is2)); asm("" : "+v"(p0), "+v"(r0)); a0[j] = clamp8(p0 * r0);
                    float p1 = g1[j] * u1[j], r1 = __builtin_amdgcn_rcpf(__builtin_fmaf(__builtin_amdgcn_exp2f(g1[j] * ke), is2, is2)); asm("" : "+v"(p1), "+v"(r1)); a1[j] = clamp8(p1 * r1); }
                u32x2_f w; w.x = pk4_f8(a0[0], a0[1], a0[2], a0[3]); w.y = pk4_f8(a1[0], a1[1], a1[2], a1[3]);
                *(u32x2_f*)(O + (size_t)row * ldc + col0) = w; }
    }
};
struct EpiF32 {
    static constexpr bool PERM = false, AFTER_DRAIN = false;
    float* O; int ldc;
    __device__ __forceinline__ void operator()(const f32x4 (&acc)[2][2][4][2], const Unit& u, int wr, int wc, int fr, int fq) const {
        const int row0 = u.pm * BM + wr * 64 + fr, col0 = u.pn * BM + wc * 32 + 4 * fq;
#pragma unroll
        for (int ai = 0; ai < 2; ++ai)
#pragma unroll
            for (int m = 0; m < 4; ++m) { float* rp = O + (size_t)(row0 + ai * HALF + m * 16) * ldc + col0;
#pragma unroll
                for (int bj = 0; bj < 2; ++bj)
#pragma unroll
                    for (int n = 0; n < 2; ++n) *(f32x4*)(rp + bj * HALF + n * 16) = acc[ai][bj][m][n]; }
    }
};
struct EpiY {
    static constexpr bool PERM = true, AFTER_DRAIN = false;
    bf16* O; int ldc;
    __device__ __forceinline__ void operator()(const f32x4 (&acc)[2][2][4][2], const Unit& u, int wr, int wc, int fr, int fq) const {
        const int row0 = u.pm * BM + wr * 64 + fr, col0 = u.pn * BM + wc * 32 + 8 * fq;
#pragma unroll
        for (int ai = 0; ai < 2; ++ai)
#pragma unroll
            for (int m = 0; m < 4; ++m) { bf16* rp = O + (size_t)(row0 + ai * HALF + m * 16) * ldc + col0;
#pragma unroll
                for (int bj = 0; bj < 2; ++bj) { const f32x4 v0 = acc[ai][bj][m][0], v1 = acc[ai][bj][m][1];
                    u32x4 w; w.x = pk2(v0[0], v0[1]); w.y = pk2(v0[2], v0[3]); w.z = pk2(v1[0], v1[1]); w.w = pk2(v1[2], v1[3]);
                    st16_wt(rp + bj * HALF, w); } }
    }
};
struct EpiY8 {
    static constexpr bool PERM = true, AFTER_DRAIN = false;
    bf16* O; int ldc;
    __device__ __forceinline__ void operator()(const f32x4 (&acc)[2][2][4][2], const Unit& u, int wr, int wc, int fr, int fq) const {
        const int row0 = u.pm * BM + wr * 64 + fr, col0 = u.pn * BM + wc * 32 + 8 * fq; constexpr float s = 1.f / W8_D;
#pragma unroll
        for (int ai = 0; ai < 2; ++ai)
#pragma unroll
            for (int m = 0; m < 4; ++m) { bf16* rp = O + (size_t)(row0 + ai * HALF + m * 16) * ldc + col0;
#pragma unroll
                for (int bj = 0; bj < 2; ++bj) { const f32x4 v0 = acc[ai][bj][m][0] * s, v1 = acc[ai][bj][m][1] * s;
                    u32x4 w; w.x = pk2(v0[0], v0[1]); w.y = pk2(v0[2], v0[3]); w.z = pk2(v1[0], v1[1]); w.w = pk2(v1[2], v1[3]);
                    st16_wt(rp + bj * HALF, w); } }
    }
};
struct EpiF2 {
    static constexpr bool PERM = true, AFTER_DRAIN = false;
    bf16* O; const float* SP; bf16* FP; int slot0, klen, tstride  ; float osc;
    __device__ __forceinline__ void operator()(const f32x4 (&acc)[2][2][4][2], const Unit& u, int wr, int wc, int fr, int fq) const {
        const int row0 = u.pm * BM + wr * 64 + fr, col0 = (u.pn & 3) * BM + wc * 32 + 8 * fq;
        bf16* base = O; int rsub = 0;
        if (u.kofs > 0) { const int part = u.kofs / klen; base = FP + (size_t)(part - 1) * tstride * DM; rsub = slot0; }
        float spv[8];
#pragma unroll
        for (int i = 0; i < 8; ++i) spv[i] = SP[row0 + (i >> 2) * HALF + (i & 3) * 16] * osc;
#pragma unroll
        for (int ai = 0; ai < 2; ++ai)
#pragma unroll
            for (int m = 0; m < 4; ++m) { const int row = row0 + ai * HALF + m * 16; const float sc = spv[ai * 4 + m];
#pragma unroll
                for (int bj = 0; bj < 2; ++bj) { const f32x4 v0 = acc[ai][bj][m][0] * sc, v1 = acc[ai][bj][m][1] * sc;
                    u32x4 w; w.x = pk2(v0[0], v0[1]); w.y = pk2(v0[2], v0[3]); w.z = pk2(v1[0], v1[1]); w.w = pk2(v1[2], v1[3]);
                    st16_wt(base + (size_t)(row - rsub) * DM + col0 + bj * HALF, w); } }
    }
};
static_assert(NGUE / 256 == 28 && DM / 256 == 4, "MoeOrder::next decodes units for 28 or 4 column tiles");
struct MoeOrder {
    int p0, p1, p2, p3, p4, p5, p6, T, ncol, G, c, nfull, ksplit, klen;
    __device__ __forceinline__ void init(const int* CNT, int ncol_, int G_, int c_) {
        int t = 0; t += (CNT[0] + 255) >> 8; p0 = t; t += (CNT[1] + 255) >> 8; p1 = t; t += (CNT[2] + 255) >> 8; p2 = t; t += (CNT[3] + 255) >> 8; p3 = t;
        t += (CNT[4] + 255) >> 8; p4 = t; t += (CNT[5] + 255) >> 8; p5 = t; t += (CNT[6] + 255) >> 8; p6 = t; t += (CNT[7] + 255) >> 8; T = t; ncol = ncol_; G = G_; c = c_;
        p0 = __builtin_amdgcn_readfirstlane(p0); p1 = __builtin_amdgcn_readfirstlane(p1); p2 = __builtin_amdgcn_readfirstlane(p2); p3 = __builtin_amdgcn_readfirstlane(p3);
        p4 = __builtin_amdgcn_readfirstlane(p4); p5 = __builtin_amdgcn_readfirstlane(p5); p6 = __builtin_amdgcn_readfirstlane(p6); T = __builtin_amdgcn_readfirstlane(T);
        nfull = T * ncol; ksplit = 1; klen = 0;
    }
    __device__ __forceinline__ int tail_start() const { const int tot = T * ncol, nf = (tot / G) * G; return (tot - nf <= TAIL_UNITS) ? nf : tot; }
    __device__ __forceinline__ int tail_split() const { const int left = T * ncol - tail_start(); return left == 0 ? 1 : ((left * 7 <= G) ? 7 : 2); }
    __device__ __forceinline__ bool next(int i, Unit& u) const {
        int L = i * G + c; int part = 0;
        if (ksplit == 1) { if (L >= nfull) return false; }
        else { if (L >= (T * ncol - nfull) * ksplit) return false; const int q_ = (int)((unsigned)L / (unsigned)ksplit); part = L - q_ * ksplit; L = nfull + q_; }
        const int tm = (ncol == 4) ? (L >> 2) : (int)((unsigned)L / 28u), j = L - tm * ncol;
        const int e = (tm >= p0) + (tm >= p1) + (tm >= p2) + (tm >= p3) + (tm >= p4) + (tm >= p5) + (tm >= p6);
        u.pm = tm; u.pn = e * ncol + j; u.kofs = part * klen; return true;
    }
    __device__ __forceinline__ void a_ready(const Unit&) const {}
    __device__ __forceinline__ void done(const Unit&) const {}
};

struct SrcCol { const float* p; int ld; };
__device__ __forceinline__ int win_src_col(int d) {
    if (d < 768) { const int hd = d & 63; const int sd = hd < 16 ? ((hd & 1) ? 8 + (hd >> 1) : (hd >> 1)) : hd; return d - hd + sd; }
    if (d < 1536) return d;
    if (d < 1792) return 2438 + (d - 1536);
    if (d < 2048) return 2694 + (d - 1792);
    if (d < 2944) return 1536 + (d - 2048);
    if (d < 2950) return 2432 + (d - 2944);
    return -1;
}
__device__ __forceinline__ SrcCol gu_src(const float* wg, const float* wu, int nff, int r) {
    const int tile = r >> 8, rr = r & 255, j = tile * 128 + (rr & 127); SrcCol s; s.p = (rr < 128 ? wg : wu) + j; s.ld = nff; return s;
}
__device__ __forceinline__ void conv_item(SrcCol sc, int K, bf16* WT, long d0, int k0, LAS float* scr, int lane) {
    float tv[32];
#pragma unroll
    for (int i = 0; i < 32; ++i) { const int kk = 2 * i + (lane >> 5); tv[i] = sc.p ? __builtin_nontemporal_load(sc.p + (size_t)(k0 + kk) * sc.ld) : 0.f; }
#pragma unroll
    for (int i = 0; i < 32; ++i) { const int kk = 2 * i + (lane >> 5); scr[kk * 33 + (lane & 31)] = tv[i]; }
    LDS_WAIT(); asm volatile("" ::: "memory");
    const int c = lane & 7;
#pragma unroll
    for (int j = 0; j < 4; ++j) { const int n = (lane >> 3) + 8 * j; const LAS float* s = scr + (8 * c) * 33 + n;
        u32x4 o; o.x = pk2(s[0 * 33], s[1 * 33]); o.y = pk2(s[2 * 33], s[3 * 33]); o.z = pk2(s[4 * 33], s[5 * 33]); o.w = pk2(s[6 * 33], s[7 * 33]);
        __builtin_nontemporal_store(o, (u32x4*)(WT + (size_t)(d0 + n) * K + k0 + 8 * c)); }
    LDS_WAIT(); asm volatile("" ::: "memory");
}
__device__ __forceinline__ void conv_item8(SrcCol sc, int K  , f8_t* WT, long d0, int k0, float scale, LAS float* scr, int lane) {
    float ta[32], tb[32];
#pragma unroll
    for (int i = 0; i < 32; ++i) { const int kk = 2 * i + (lane >> 5); const size_t kr = (size_t)(k0 + 16 * (kk >> 3) + (kk & 7));
        ta[i] = __builtin_nontemporal_load(sc.p + kr * sc.ld); tb[i] = __builtin_nontemporal_load(sc.p + (kr + 8) * sc.ld); }
    const int c = lane & 7; unsigned pa[4][2];
#pragma unroll
    for (int i = 0; i < 32; ++i) { const int kk = 2 * i + (lane >> 5); scr[kk * 33 + (lane & 31)] = ta[i]; }
    LDS_WAIT(); asm volatile("" ::: "memory");
#pragma unroll
    for (int j = 0; j < 4; ++j) { const int n = (lane >> 3) + 8 * j; const LAS float* s = scr + (8 * c) * 33 + n;
        pa[j][0] = pk4_f8(clamp8(s[0 * 33] * scale), clamp8(s[1 * 33] * scale), clamp8(s[2 * 33] * scale), clamp8(s[3 * 33] * scale));
        pa[j][1] = pk4_f8(clamp8(s[4 * 33] * scale), clamp8(s[5 * 33] * scale), clamp8(s[6 * 33] * scale), clamp8(s[7 * 33] * scale)); }
    LDS_WAIT(); asm volatile("" ::: "memory");
#pragma unroll
    for (int i = 0; i < 32; ++i) { const int kk = 2 * i + (lane >> 5); scr[kk * 33 + (lane & 31)] = tb[i]; }
    LDS_WAIT(); asm volatile("" ::: "memory");
#pragma unroll
    for (int j = 0; j < 4; ++j) { const int n = (lane >> 3) + 8 * j; const LAS float* s = scr + (8 * c) * 33 + n;
        u32x4 o; o.x = pa[j][0]; o.y = pa[j][1];
        o.z = pk4_f8(clamp8(s[0 * 33] * scale), clamp8(s[1 * 33] * scale), clamp8(s[2 * 33] * scale), clamp8(s[3 * 33] * scale));
        o.w = pk4_f8(clamp8(s[4 * 33] * scale), clamp8(s[5 * 33] * scale), clamp8(s[6 * 33] * scale), clamp8(s[7 * 33] * scale));
        __builtin_nontemporal_store(o, (u32x4*)(WT + (size_t)(d0 + n) * K + k0 + 16 * c)); }
    LDS_WAIT(); asm volatile("" ::: "memory");
}
}


typedef short bf16x8_t __attribute__((ext_vector_type(8)));
typedef float f32x4_t __attribute__((ext_vector_type(4)));
constexpr int TLD = 272;
__device__ __forceinline__ bf16x8_t lds_frag(const LAS unsigned char* base, int row, int kbyte) { return *(const LAS bf16x8_t*)(base + row * TLD + kbyte); }
__device__ __forceinline__ float red16(float v) { return row16_sum(v); }

__device__ __forceinline__ void gm_unit(int b, int c, const bf16* PROJ, const bf16* WSB  , const float* ln_g, const float* ln_b, const float* b_s, const float* norm_g,
                                        bf16* MIXB, LAS unsigned char* lds, int wave, int lane) {
    const long r0 = (long)b * SEQ + c * GM_CHUNK;
    LAS unsigned char* VNT = lds;
    { float4 vv[16];
#pragma unroll
      for (int i = 0; i < 16; ++i) vv[i] = ld4(PROJ + (r0 + wave * 16 + i) * PLD + FGV + lane * 4);
      const float4 gg = *(const float4*)(ln_g + lane * 4), bb = *(const float4*)(ln_b + lane * 4);
#pragma unroll
      for (int i = 0; i < 16; ++i) { const int t = wave * 16 + i; const float4 v = make_float4(fp::gelu_fast(vv[i].x), fp::gelu_fast(vv[i].y), fp::gelu_fast(vv[i].z), fp::gelu_fast(vv[i].w));
        const float mean = wave_sum((v.x + v.y) + (v.z + v.w)) * (1.f / 256.f);
        const float d0 = v.x - mean, d1 = v.y - mean, d2 = v.z - mean, d3 = v.w - mean;
        const float rstd = rsqrtf(wave_sum((d0 * d0 + d1 * d1) + (d2 * d2 + d3 * d3)) * (1.f / 256.f) + 1e-5f);
        LAS bf16* dst = (LAS bf16*)(VNT + (lane * 4) * TLD) + t;
        dst[0] = (bf16)f2bf(d0 * rstd * gg.x + bb.x); dst[TLD / 2] = (bf16)f2bf(d1 * rstd * gg.y + bb.y); dst[TLD] = (bf16)f2bf(d2 * rstd * gg.z + bb.z); dst[3 * TLD / 2] = (bf16)f2bf(d3 * rstd * gg.w + bb.w); } }
    __syncthreads();
    f32x4_t acc[16];
#pragma unroll
    for (int i = 0; i < 16; ++i) acc[i] = (f32x4_t){0.f, 0.f, 0.f, 0.f};
    const int fr = lane & 15, fq = lane >> 4;
    const int nks = (wave * 16 + 15) / 32 + 1;
    for (int ks = 0; ks < nks; ++ks) {
#pragma unroll
        for (int g = 0; g < 4; ++g) {
            const bf16x8_t af = *(const bf16x8_t*)(WSB + ((size_t)g * GM_CHUNK + wave * 16 + fr) * GM_CHUNK + ks * 32 + fq * 8);
#pragma unroll
            for (int n = 0; n < 4; ++n) { const bf16x8_t bfv = lds_frag(VNT, g * 64 + n * 16 + fr, ks * 64 + fq * 16);
                acc[g * 4 + n] = __builtin_amdgcn_mfma_f32_16x16x32_bf16(af, bfv, acc[g * 4 + n], 0, 0, 0); }
        }
    }
    __syncthreads();
    LAS bf16* ost = (LAS bf16*)(lds + wave * (16 * 264 * 2));
    float ss[4] = {0.f, 0.f, 0.f, 0.f};
#pragma unroll
    for (int nt = 0; nt < 16; ++nt) { const int col = nt * 16 + fr, g = nt >> 2;
#pragma unroll
        for (int r = 0; r < 4; ++r) { const int t = wave * 16 + fq * 4 + r;
            const float u = fp::gelu_fast(ldf(PROJ + (r0 + t) * PLD + FGU + col));
            const float o = u * (acc[nt][r] + b_s[g * GM_CHUNK + t]); acc[nt][r] = o; ss[r] += o * o; } }
#pragma unroll
    for (int r = 0; r < 4; ++r) ss[r] = rsqrtf(red16(ss[r]) * (1.f / 256.f) + 1e-5f);
#pragma unroll
    for (int nt = 0; nt < 16; ++nt) { const int col = nt * 16 + fr; const float gn = norm_g[col];
#pragma unroll
        for (int r = 0; r < 4; ++r) { ost[(fq * 4 + r) * 264 + col] = (bf16)f2bf(acc[nt][r] * ss[r] * gn); } }
    LDS_WAIT(); asm volatile("" ::: "memory");
#pragma unroll
    for (int i = 0; i < 8; ++i) { const int rr = i * 2 + (lane >> 5), ch = lane & 31;
        const fp::u32x4 v = *(const LAS fp::u32x4*)(ost + rr * 264 + ch * 8);
        *(fp::u32x4*)(MIXB + (r0 + wave * 16 + rr) * DM + ATT_W + SSD_W + ch * 8) = v; }
    __syncthreads();
}

typedef short v4i16_t __attribute__((ext_vector_type(4)));
typedef unsigned u32x2_t __attribute__((ext_vector_type(2)));
__device__ __forceinline__ v4i16_t lds_tr(const LAS unsigned char* p) { return __builtin_amdgcn_ds_read_tr16_b64_v4i16((LAS v4i16_t*)p); }
__device__ __forceinline__ bf16x8_t lds_frag_tr(const LAS unsigned char* tile, int pitch, int k0, int c0, int lane) {
    const int kg = lane >> 4, q = (lane & 15) >> 2, p = lane & 3;
    const LAS unsigned char* a = tile + (k0 + 8 * kg + q) * pitch + (c0 + 4 * p) * 2;
    const v4i16_t lo = lds_tr(a), hi = lds_tr(a + 4 * pitch);
    return (bf16x8_t){lo[0], lo[1], lo[2], lo[3], hi[0], hi[1], hi[2], hi[3]};
}
__device__ __forceinline__ bf16x8_t lds_frag_p(const LAS unsigned char* base, int pitch, int row, int kbyte) { return *(const LAS bf16x8_t*)(base + row * pitch + kbyte); }
template <int NCH, bool SCALE, bool TOLDS> __device__ __forceinline__ void conv_rows(const bf16* PROJ, long r0, int t0, int colbase, int ch0, const float* cw, const float* cb, LAS unsigned char* tile, int pitch,
                                                                                       const LAS float* scl, bf16* XCg  , int tid) {
    constexpr int CPR = NCH / 8, RG = 512 / CPR, RPT = (128 + RG - 1) / RG;
    if (tid < CPR * RG) { const int ch = (tid % CPR) * 8, l0 = (tid / CPR) * RPT;
        float w[4][8], bs[8];
        { const float4 c0 = *(const float4*)(cb + ch0 + ch), c1 = *(const float4*)(cb + ch0 + ch + 4); bs[0] = c0.x; bs[1] = c0.y; bs[2] = c0.z; bs[3] = c0.w; bs[4] = c1.x; bs[5] = c1.y; bs[6] = c1.z; bs[7] = c1.w; }
#pragma unroll
        for (int i = 0; i < 4; ++i) { const float4 w0 = *(const float4*)(cw + i * SSD_CW + ch0 + ch), w1 = *(const float4*)(cw + i * SSD_CW + ch0 + ch + 4);
            w[i][0] = w0.x; w[i][1] = w0.y; w[i][2] = w0.z; w[i][3] = w0.w; w[i][4] = w1.x; w[i][5] = w1.y; w[i][6] = w1.z; w[i][7] = w1.w; }
        fp::u32x4 xr[RPT + 3];
#pragma unroll
        for (int j = 0; j < RPT + 3; ++j) { const int l = l0 - 3 + j; xr[j] = (fp::u32x4){0u, 0u, 0u, 0u};
            if (l < 128 && t0 + l >= 0) xr[j] = *(const fp::u32x4*)(PROJ + (r0 + l) * PLD + colbase + ch); }
#pragma unroll
        for (int j = 0; j < RPT; ++j) { const int l = l0 + j; if (l < 128) {
            float a[8];
#pragma unroll
            for (int e = 0; e < 8; ++e) a[e] = bs[e];
#pragma unroll
            for (int i = 0; i < 4; ++i) { const fp::u32x4 xv = xr[j + i];
#pragma unroll
                for (int e = 0; e < 4; ++e) { a[2 * e] += w[i][2 * e] * __uint_as_float(xv[e] << 16); a[2 * e + 1] += w[i][2 * e + 1] * __uint_as_float(xv[e] & 0xffff0000u); } }
#pragma unroll
            for (int e = 0; e < 8; ++e) a[e] = a[e] * __builtin_amdgcn_rcpf(1.f + __expf(-a[e]));
            fp::u32x4 o; o.x = fp::pk2(a[0], a[1]); o.y = fp::pk2(a[2], a[3]); o.z = fp::pk2(a[4], a[5]); o.w = fp::pk2(a[6], a[7]);
            *(fp::u32x4*)(XCg + (r0 + l) * SSD_CW + ch) = o;
            if (TOLDS) { if (SCALE) { const float sc = scl[(ch >> 6) * 128 + l]; o.x = fp::pk2(a[0] * sc, a[1] * sc); o.y = fp::pk2(a[2] * sc, a[3] * sc); o.z = fp::pk2(a[4] * sc, a[5] * sc); o.w = fp::pk2(a[6] * sc, a[7] * sc); }
                *(LAS fp::u32x4*)(tile + l * pitch + ch * 2) = o; } } }
    }
}
template <int NCH> __device__ __forceinline__ void load_xc_tile(const bf16* XCg, long r0, LAS unsigned char* tile, int pitch, int tid) {
    constexpr int CPR = NCH / 8;
    for (int it = tid; it < 128 * CPR; it += 512) { const int l = it / CPR, ch = (it % CPR) * 8;
        *(LAS fp::u32x4*)(tile + l * pitch + ch * 2) = *(const fp::u32x4*)(XCg + (r0 + l) * SSD_CW + ch); }
}
__device__ __forceinline__ void ssd_dt_acum(const bf16* PROJ, long r0, int g, const float* dt_bias, const float* a_log, LAS float* dtS, LAS float* acS, int tid, int wave, int lane) {
    if (tid < 384) { const int hh = tid >> 7, l = tid & 127, h = 3 * g + hh;
        const float dtv = softplus_f(ldf(PROJ + (r0 + l) * PLD + FDT + h) + dt_bias[h]); dtS[tid] = dtv; acS[tid] = dtv * (-__expf(a_log[h])); }
    __syncthreads();
    if (wave < 3) { const float a0 = acS[wave * 128 + 2 * lane], a1 = acS[wave * 128 + 2 * lane + 1]; const float sm = a0 + a1; float v = sm;
#pragma unroll
        for (int o = 1; o < 64; o <<= 1) { const float t = __shfl_up(v, o); if (lane >= o) v += t; }
        const float ex = v - sm; acS[wave * 128 + 2 * lane] = ex + a0; acS[wave * 128 + 2 * lane + 1] = ex + sm; }
    __syncthreads();
}
constexpr int XP = 400;
__device__ __forceinline__ void ssdA_unit(int b, int c, int g, const bf16* PROJ, const float* cw, const float* cb, const float* dt_bias, const float* a_log, bf16* ST, float* CD, bf16* XC, float* DTG,
                                          LAS unsigned char* lds, int tid, int wave, int lane) {
    asm volatile("" : "+v"(tid), "+v"(lane));
    const long r0 = (long)b * SEQ + c * 128; const int t0 = c * 128;
    LAS unsigned char* XS = lds; LAS unsigned char* BS = lds + 51200;
    LAS float* dtS = (LAS float*)(lds + 86016); LAS float* acS = dtS + 384; LAS float* sclS = acS + 384;
    ssd_dt_acum(PROJ, r0, g, dt_bias, a_log, dtS, acS, tid, wave, lane);
    if (tid < 384) { const int hh = tid >> 7; const float al = acS[hh * 128 + 127]; sclS[tid] = dtS[tid] * __expf(al - acS[tid]);
        float* dg = DTG + (((long)b * 16 + c) * 2 + g) * 768; dg[tid] = dtS[tid]; dg[384 + tid] = acS[tid];
        if ((tid & 127) == 0) CD[((long)b * 16 + c) * SSD_H + 3 * g + hh] = __expf(al); }
    __syncthreads();
    conv_rows<192, true, true>(PROJ, r0, t0, FXBC + 192 * g, 192 * g, cw, cb, XS, XP, sclS, XC + 192 * g, tid);
    conv_rows<128, false, true>(PROJ, r0, t0, FXBC + SSD_W + 128 * g, SSD_W + 128 * g, cw, cb, BS, TLD, nullptr, XC + SSD_W + 128 * g, tid);
    conv_rows<128, false, false>(PROJ, r0, t0, FXBC + SSD_W + 256 + 128 * g, SSD_W + 256 + 128 * g, cw, cb, nullptr, 0, nullptr, XC + SSD_W + 256 + 128 * g, tid);
    __syncthreads();
    f32x4_t acc[12];
#pragma unroll
    for (int i = 0; i < 12; ++i) acc[i] = (f32x4_t){0.f, 0.f, 0.f, 0.f};
#pragma unroll 1
    for (int ks = 0; ks < 4; ++ks) { const bf16x8_t bfv = lds_frag_tr(BS, TLD, ks * 32, 16 * wave, lane);
#pragma unroll
        for (int mt = 0; mt < 12; ++mt) { const bf16x8_t af = lds_frag_tr(XS, XP, ks * 32, (mt >> 2) * 64 + (mt & 3) * 16, lane); acc[mt] = __builtin_amdgcn_mfma_f32_16x16x32_bf16(af, bfv, acc[mt], 0, 0, 0); } }
    const int fr = lane & 15, fq = lane >> 4;
    bf16* sp = ST + (((long)b * 16 + c) * SSD_H + 3 * g) * 8192 + 16 * wave + (fr & ~1);
    const int odd = fr & 1;
#pragma unroll
    for (int mt = 0; mt < 12; ++mt)
#pragma unroll
        for (int rp = 0; rp < 2; ++rp) { const float x0 = acc[mt][2 * rp], x1 = acc[mt][2 * rp + 1]; const float y0 = __shfl_xor(x0, 1), y1 = __shfl_xor(x1, 1);
            const unsigned w = odd ? fp::pk2(y1, x1) : fp::pk2(x0, y0);
            *(unsigned*)(sp + (mt >> 2) * 8192 + ((mt & 3) * 16 + 4 * fq + 2 * rp + odd) * 128) = w; }
    __syncthreads();
}
__device__ __forceinline__ void ssdB_unit(int b, int c, int g, const bf16* PROJ, const bf16* XC, const float* DTG, const float* dsk, const float* ng,
                                          const bf16* ST, const float* CD, bf16* MIXB, LAS unsigned char* lds, int tid, int wave, int lane) {
    asm volatile("" : "+v"(tid), "+v"(lane));
    const long r0 = (long)b * SEQ + c * 128;
    LAS unsigned char* CS = lds; LAS unsigned char* PX = lds + 34816; LAS unsigned char* BG = lds + 87040;
    LAS float* dtS = (LAS float*)(lds + 121856); LAS float* acS = dtS + 384;
    const int fr = lane & 15, fq = lane >> 4;
    if (tid < 384) { const float* dg = DTG + (((long)b * 16 + c) * 2 + g) * 768; dtS[tid] = dg[tid]; acS[tid] = dg[384 + tid]; }
    load_xc_tile<128>(XC + SSD_W + 256 + 128 * g, r0, CS, TLD, tid);
    if (c > 0) {
        float pv[6][8];
#pragma unroll
        for (int i = 0; i < 6; ++i)
#pragma unroll
            for (int e = 0; e < 8; ++e) pv[i][e] = 0.f;
        const bf16* sbase = ST + ((long)b * 16 * SSD_H + 3 * g) * 8192 + tid * 8; const float* cbase = CD + (long)b * 16 * SSD_H + 3 * g;
#define ST_ACC(V, D0, D1, D2) do { _Pragma("unroll") for (int i = 0; i < 6; ++i) { const float d_ = (i < 2) ? (D0) : ((i < 4) ? (D1) : (D2)); \
            _Pragma("unroll") for (int e = 0; e < 4; ++e) { pv[i][2 * e] = pv[i][2 * e] * d_ + __uint_as_float(V[i][e] << 16); pv[i][2 * e + 1] = pv[i][2 * e + 1] * d_ + __uint_as_float(V[i][e] & 0xffff0000u); } } } while (0)
        int j = 0;
        for (; j + 2 < c; j += 3) { const bf16* s0 = sbase + (long)j * SSD_H * 8192; const float* c0 = cbase + j * SSD_H;
            fp::u32x4 v0[6], v1[6], v2[6];
#pragma unroll
            for (int i = 0; i < 6; ++i) { v0[i] = *(const fp::u32x4*)(s0 + i * 4096); v1[i] = *(const fp::u32x4*)(s0 + SSD_H * 8192 + i * 4096); v2[i] = *(const fp::u32x4*)(s0 + 2 * SSD_H * 8192 + i * 4096); }
            float dd[3][3];
#pragma unroll
            for (int q = 0; q < 3; ++q) { dd[q][0] = c0[q * SSD_H]; dd[q][1] = c0[q * SSD_H + 1]; dd[q][2] = c0[q * SSD_H + 2]; }
            ST_ACC(v0, dd[0][0], dd[0][1], dd[0][2]); ST_ACC(v1, dd[1][0], dd[1][1], dd[1][2]); ST_ACC(v2, dd[2][0], dd[2][1], dd[2][2]); }
        for (; j < c; ++j) { const bf16* s0 = sbase + (long)j * SSD_H * 8192; const float* c0 = cbase + j * SSD_H; const float d0 = c0[0], d1 = c0[1], d2 = c0[2];
            fp::u32x4 v0[6];
#pragma unroll
            for (int i = 0; i < 6; ++i) v0[i] = *(const fp::u32x4*)(s0 + i * 4096);
            ST_ACC(v0, d0, d1, d2); }
#undef ST_ACC
#pragma unroll
        for (int i = 0; i < 6; ++i) { const int row = i * 32 + (tid >> 4), n = (tid & 15) * 8;
            fp::u32x4 w; w.x = fp::pk2(pv[i][0], pv[i][1]); w.y = fp::pk2(pv[i][2], pv[i][3]); w.z = fp::pk2(pv[i][4], pv[i][5]); w.w = fp::pk2(pv[i][6], pv[i][7]); *(LAS fp::u32x4*)(PX + row * TLD + n * 2) = w; }
    }
    __syncthreads();
    f32x4_t acc_y[12];
#pragma unroll
    for (int i = 0; i < 12; ++i) acc_y[i] = (f32x4_t){0.f, 0.f, 0.f, 0.f};
    if (c > 0) {
#pragma unroll 1
        for (int ks = 0; ks < 4; ++ks) { const bf16x8_t af = lds_frag_p(CS, TLD, 16 * wave + fr, ks * 64 + fq * 16);
#pragma unroll
            for (int t = 0; t < 12; ++t) { const bf16x8_t bfv = lds_frag_p(PX, TLD, (t >> 2) * 64 + (t & 3) * 16 + fr, ks * 64 + fq * 16); acc_y[t] = __builtin_amdgcn_mfma_f32_16x16x32_bf16(af, bfv, acc_y[t], 0, 0, 0); } }
#pragma unroll
        for (int t = 0; t < 12; ++t)
#pragma unroll
            for (int r = 0; r < 4; ++r) acc_y[t][r] *= __expf(acS[(t >> 2) * 128 + 16 * wave + 4 * fq + r]);
    }
    __syncthreads();
    load_xc_tile<192>(XC + 192 * g, r0, PX, XP, tid);
    load_xc_tile<128>(XC + SSD_W + 128 * g, r0, BG, TLD, tid);
    __syncthreads();
#if defined(SSDB_CUT) && SSDB_CUT == 2
    { float t_ = 0.f; for (int i = 0; i < 12; ++i) t_ += acc_y[i][0] + acc_y[i][1] + acc_y[i][2] + acc_y[i][3]; if (t_ == 123.f) MIXB[0] = 1; return; }
#endif
    f32x4_t acc_cb[8];
#pragma unroll
    for (int i = 0; i < 8; ++i) acc_cb[i] = (f32x4_t){0.f, 0.f, 0.f, 0.f};
#pragma unroll 1
    for (int ks = 0; ks < 4; ++ks) { const bf16x8_t af = lds_frag_p(CS, TLD, 16 * wave + fr, ks * 64 + fq * 16);
#pragma unroll
        for (int ns = 0; ns < 8; ++ns) if (ns <= wave) { const bf16x8_t bfv = lds_frag_p(BG, TLD, 16 * ns + fr, ks * 64 + fq * 16); acc_cb[ns] = __builtin_amdgcn_mfma_f32_16x16x32_bf16(af, bfv, acc_cb[ns], 0, 0, 0); } }
    __syncthreads();
    LAS unsigned char* GS = BG + wave * 16 * TLD;
    const int nks = (16 * wave + 15) / 32 + 1;
#pragma unroll
    for (int hh = 0; hh < 3; ++hh) {
#pragma unroll
        for (int ns = 0; ns < 8; ++ns) if (ns <= (wave | 1)) {
#pragma unroll
            for (int r = 0; r < 4; ++r) { const int l = 16 * wave + 4 * fq + r, sidx = 16 * ns + fr;
                const float gv = (ns <= wave && sidx <= l) ? acc_cb[ns][r] * __expf(acS[hh * 128 + l] - acS[hh * 128 + sidx]) * dtS[hh * 128 + sidx] : 0.f;
                *(LAS bf16*)(GS + (4 * fq + r) * TLD + sidx * 2) = (bf16)f2bf(gv); } }
        LDS_WAIT(); asm volatile("" ::: "memory");
#pragma unroll 1
        for (int ks = 0; ks < nks; ++ks) { const bf16x8_t af = lds_frag_p(GS, TLD, fr, ks * 64 + fq * 16);
#pragma unroll
            for (int np = 0; np < 4; ++np) { const bf16x8_t bfv = lds_frag_tr(PX, XP, ks * 32, hh * 64 + np * 16, lane); acc_y[hh * 4 + np] = __builtin_amdgcn_mfma_f32_16x16x32_bf16(af, bfv, acc_y[hh * 4 + np], 0, 0, 0); } }
        LDS_WAIT(); asm volatile("" ::: "memory");
    }
#if defined(SSDB_CUT) && SSDB_CUT == 1
    { float t_ = 0.f; for (int i = 0; i < 12; ++i) t_ += acc_y[i][0] + acc_y[i][1] + acc_y[i][2] + acc_y[i][3]; if (t_ == 123.f) MIXB[0] = 1; return; }
#endif
#pragma unroll
    for (int t = 0; t < 12; ++t) { const int hh = t >> 2, col = hh * 64 + (t & 3) * 16 + fr; const float dk = dsk[3 * g + hh];
#pragma unroll
        for (int r = 0; r < 4; ++r) { const int l = 16 * wave + 4 * fq + r; acc_y[t][r] += dk * __uint_as_float(((unsigned)*(const LAS bf16*)(PX + l * XP + col * 2)) << 16); } }
    __syncthreads();
    LAS bf16* ost = (LAS bf16*)(lds + wave * (16 * XP));
#pragma unroll
    for (int t = 0; t < 12; ++t) { const int col = (t >> 2) * 64 + (t & 3) * 16 + fr;
#pragma unroll
        for (int r = 0; r < 4; ++r) ost[(4 * fq + r) * (XP / 2) + col] = (bf16)f2bf(acc_y[t][r]); }
    LDS_WAIT(); asm volatile("" ::: "memory");
    { const int rr = lane >> 2, q = lane & 3; const long row = r0 + 16 * wave + rr;
      float yz[48]; float ssum = 0.f;
#pragma unroll
      for (int i = 0; i < 6; ++i) { const int c8 = (q * 6 + i) * 8;
          const fp::u32x4 yv = *(const LAS fp::u32x4*)(ost + rr * (XP / 2) + c8);
          const fp::u32x4 zv = *(const fp::u32x4*)(PROJ + row * PLD + FZ + 192 * g + c8);
#pragma unroll
          for (int j = 0; j < 4; ++j) { const unsigned yw = yv[j], zw = zv[j];
              const float y0 = __uint_as_float(yw << 16), y1 = __uint_as_float(yw & 0xffff0000u), z0 = __uint_as_float(zw << 16), z1 = __uint_as_float(zw & 0xffff0000u);
              const float a0 = y0 * (z0 * __builtin_amdgcn_rcpf(1.f + __expf(-z0))), a1 = y1 * (z1 * __builtin_amdgcn_rcpf(1.f + __expf(-z1))); yz[i * 8 + 2 * j] = a0; yz[i * 8 + 2 * j + 1] = a1; ssum += a0 * a0 + a1 * a1; } }
      ssum += __shfl_xor(ssum, 1); ssum += __shfl_xor(ssum, 2);
      const float rinv = rsqrtf(ssum * (1.f / 192.f) + 1e-5f);
#pragma unroll
      for (int i = 0; i < 6; ++i) { const int c8 = (q * 6 + i) * 8;
          const float4 g0 = *(const float4*)(ng + 192 * g + c8), g1 = *(const float4*)(ng + 192 * g + c8 + 4);
          fp::u32x4 o; o.x = fp::pk2(yz[i * 8] * rinv * g0.x, yz[i * 8 + 1] * rinv * g0.y); o.y = fp::pk2(yz[i * 8 + 2] * rinv * g0.z, yz[i * 8 + 3] * rinv * g0.w);
          o.z = fp::pk2(yz[i * 8 + 4] * rinv * g1.x, yz[i * 8 + 5] * rinv * g1.y); o.w = fp::pk2(yz[i * 8 + 6] * rinv * g1.z, yz[i * 8 + 7] * rinv * g1.w);
          *(fp::u32x4*)(MIXB + row * DM + ATT_W + 192 * g + c8) = o; } }
    __syncthreads();
}

__device__ __forceinline__ void att_norm_phase(bf16* MIXB, const float* g, long n_rows, int gw_, int ngw_, int lane) {
    float4 g0 = make_float4(0.f, 0.f, 0.f, 0.f), g1 = g0; if (lane < 48) { g0 = *(const float4*)(g + lane * 8); g1 = *(const float4*)(g + lane * 8 + 4); }
    fp::u32x4 wa = (fp::u32x4){0u, 0u, 0u, 0u}, wb = wa; long r = gw_;
    if (r < n_rows && lane < 48) wa = *(const fp::u32x4*)(MIXB + r * DM + lane * 8);
#define ATTN_NORM_ROW(WV_, rr) do { float v[8]; float s2 = 0.f; \
        _Pragma("unroll") for (int j = 0; j < 4; ++j) { v[2 * j] = __uint_as_float(WV_[j] << 16); v[2 * j + 1] = __uint_as_float(WV_[j] & 0xffff0000u); s2 += v[2 * j] * v[2 * j] + v[2 * j + 1] * v[2 * j + 1]; } \
        const float rs = rsqrtf(wave_sum(s2) * (1.f / 384.f) + 1e-5f); \
        if (lane < 48) { fp::u32x4 o; o.x = fp::pk2(v[0] * rs * g0.x, v[1] * rs * g0.y); o.y = fp::pk2(v[2] * rs * g0.z, v[3] * rs * g0.w); o.z = fp::pk2(v[4] * rs * g1.x, v[5] * rs * g1.y); o.w = fp::pk2(v[6] * rs * g1.z, v[7] * rs * g1.w); \
            *(fp::u32x4*)(MIXB + (rr) * DM + lane * 8) = o; } } while (0)
    for (; r < n_rows; r += 2 * ngw_) { const long r1 = r + ngw_, r2 = r + 2 * ngw_;
        if (r1 < n_rows && lane < 48) wb = *(const fp::u32x4*)(MIXB + r1 * DM + lane * 8);
        ATTN_NORM_ROW(wa, r);
        if (r2 < n_rows && lane < 48) wa = *(const fp::u32x4*)(MIXB + r2 * DM + lane * 8);
        if (r1 < n_rows) ATTN_NORM_ROW(wb, r1); }
#undef ATTN_NORM_ROW
}

constexpr int FT_G = (DM / 128) * (N_EXP * NGUE / 32) / 8, FT_D = (D_FFE / 128) * (N_EXP * DM / 32) / 8;
constexpr int FT_G_A = 704, FT_G_B = 384, FT_D_A = 256, FT_D_D = 384;
__device__ __forceinline__ void filler_g(int t, const float* p_mg, const float* p_mu, f8_t* MWGU_, LAS float* scr, int wave, int lane_) {
    asm volatile("" : "+v"(lane_));
    const int r = t * 8 + wave; const int kb = r / (N_EXP * NGUE / 32), db = r % (N_EXP * NGUE / 32); const int d = db * 32 + (lane_ & 31), e = d / NGUE;
    fp::conv_item8(fp::gu_src(p_mg + (size_t)e * DM * D_FFE, p_mu + (size_t)e * DM * D_FFE, D_FFE, d - e * NGUE), DM, MWGU_, (long)db * 32, kb * 128, W8_GU, scr, lane_);
}
__device__ __forceinline__ void filler_d(int t, const float* p_md, f8_t* MWD_, LAS float* scr, int wave, int lane_) {
    asm volatile("" : "+v"(lane_));
    const int r = t * 8 + wave; const int kb = r / (N_EXP * DM / 32), db = r % (N_EXP * DM / 32); const int d = db * 32 + (lane_ & 31), e = d / DM;
    fp::SrcCol sc_; sc_.p = p_md + (size_t)e * D_FFE * DM + (d - e * DM); sc_.ld = DM; fp::conv_item8(sc_, D_FFE, MWD_, (long)db * 32, kb * 128, W8_D, scr, lane_);
}

__device__ __forceinline__ uint2 bf8_to_f8(const uint4 v) {
    uint2 o; o.x = fp::pk4_f8(__uint_as_float(v.x << 16), __uint_as_float(v.x & 0xffff0000u), __uint_as_float(v.y << 16), __uint_as_float(v.y & 0xffff0000u));
    o.y = fp::pk4_f8(__uint_as_float(v.z << 16), __uint_as_float(v.z & 0xffff0000u), __uint_as_float(v.w << 16), __uint_as_float(v.w & 0xffff0000u)); return o;
}
struct FArgs { const void* in[29]; float* out; unsigned char* ws; int ph_lo, ph_hi; };
__device__ __forceinline__ const void* ldarg(int k) { const void* p; asm volatile("s_load_dwordx2 %0, %1, %2\n\ts_waitcnt lgkmcnt(0)" : "=s"(p) : "s"(__builtin_amdgcn_kernarg_segment_ptr()), "i"(k * 8)); return p; }

constexpr int N_PHASES = 18;
__global__ void __launch_bounds__(512, 2) mega(FArgs a) {
    extern __shared__ __attribute__((aligned(16))) unsigned char lds_[];
    LAS unsigned char* lds = (LAS unsigned char*)lds_;
    const int wave = __builtin_amdgcn_readfirstlane((int)threadIdx.x >> 6);
#define lane ((int)__builtin_amdgcn_mbcnt_hi(~0u, __builtin_amdgcn_mbcnt_lo(~0u, 0u)))
#define tid (wave * 64 + lane)
    const int G = gridDim.x; const int bx = blockIdx.x;
#define vcu (((int)gridDim.x % 8 == 0) ? ((int)blockIdx.x % 8) * ((int)gridDim.x / 8) + (int)blockIdx.x / 8 : (int)blockIdx.x)
#define gw (vcu * 8 + wave)
#define ngw ((int)gridDim.x * 8)
#define gt ((long)gw * 64 + lane)
#define ngt ((long)ngw * 64)
    unsigned char* ws = a.ws;
    unsigned* ctl = (unsigned*)(ws + O_CTL);
    for (int u = (int)threadIdx.x; u < (LDS_BYTES - RING_BYTES) / 4; u += 512) ((LAS unsigned*)(lds + RING_BYTES))[u] = 0u;
    __syncthreads();
    const int lo = a.ph_lo, hi = a.ph_hi;
    XcdBarrier bar; bar.bar = ctl + CW_BAR; bar.x = 0; bar.st = nullptr; bar.w0 = 0;
    if (hi - lo > 1) bar = xcd_barrier_post(ctl + CW_BAR, (volatile LAS unsigned*)(lds + MISC_OFF) + 8);
#define in_x ((const float*)ldarg(0))
#define in_pos ((const int*)ldarg(1))
#define ln_in_g ((const float*)ldarg(2))
#define ln_in_b ((const float*)ldarg(3))
#define w_in ((const float*)ldarg(4))
#define conv_w ((const float*)ldarg(5))
#define conv_b ((const float*)ldarg(6))
#define dt_bias ((const float*)ldarg(7))
#define a_log ((const float*)ldarg(8))
#define d_skip ((const float*)ldarg(9))
#define ssd_norm_g ((const float*)ldarg(10))
#define att_norm_g ((const float*)ldarg(11))
#define gm_ln_g ((const float*)ldarg(12))
#define gm_ln_b ((const float*)ldarg(13))
#define gm_w_s ((const float*)ldarg(14))
#define gm_b_s ((const float*)ldarg(15))
#define gm_norm_g ((const float*)ldarg(16))
#define w_out ((const float*)ldarg(17))
#define ln1_g ((const float*)ldarg(18))
#define ln1_b ((const float*)ldarg(19))
#define ln2_g ((const float*)ldarg(20))
#define ln2_b ((const float*)ldarg(21))
#define ffn_w_gate ((const float*)ldarg(22))
#define ffn_w_up ((const float*)ldarg(23))
#define ffn_w_down ((const float*)ldarg(24))
#define router_w ((const float*)ldarg(25))
#define moe_w_gate ((const float*)ldarg(26))
#define moe_w_up ((const float*)ldarg(27))
#define moe_w_down ((const float*)ldarg(28))
#define H ((float*)WOUTP)
#define MWD ((f8_t*)WOUTP)
#define RT ((float*)(WSP + O_RT))
#define TE ((int*)(WSP + O_TE))
#define TP ((float*)(WSP + O_TP))
#define TS ((int*)(WSP + O_TS))
#define GS ((int*)(WSP + O_GS))
#define SP ((float*)(WSP + O_SP))
#define KM ((float*)(WSP + O_KM))
#define WSB ((bf16*)(WSP + O_WSB))
#define HB ((bf16*)(WSP + O_HB))
#define MWGU ((f8_t*)(WSP + O_MWGU))
#define WIN ((bf16*)(WSP + O_WIN))
#define WOUT ((bf16*)(WSP + O_WOUT))
#define WGU ((f8_t*)(WSP + O_WGU))
#define WD ((f8_t*)(WSP + O_WD))
#define PROJ ((bf16*)(WSP + O_PROJ))
#define ST ((bf16*)(WSP + O_XC))
#define CD ((float*)(WSP + O_DT))
#define XCB ((bf16*)(WSP + O_MIXU))
#define DTG ((float*)(WSP + O_VN))
#define MIXB ((bf16*)(WSP + O_MIXB))
#define YB ((bf16*)(WSP + O_Y))
#define ACT ((f8_t*)(WSP + O_ACT))
#define H8 ((f8_t*)(WSP + O_ACT + (size_t)M_ * D_FF))
#define XG ((f8_t*)(WSP + O_XG))
#define F2 ((bf16*)(WSP + O_XG))
#define ACTM ((f8_t*)(WSP + O_ACTM))
#define F2P ((bf16*)(WSP + O_MWGU))
#define CNT ((int*)(WSP + O_CTL + 4 * CW_CNT))
    const ProjL FL{PLD, FQ, FK, FV, FZ, FXBC, FDT, FGU, FGV};
    LAS float* scr = (LAS float*)(lds + wave * 16384);

#ifndef PH_MASK
#define PH_MASK 0xffffffffu
#endif
#ifndef PROBE_MASK
#define PROBE_MASK 0u
#endif
#ifndef PROBE_AMP
#define PROBE_AMP 0
#endif
    volatile unsigned* pr_w = (volatile unsigned*)(ctl + 1100);
#define pr_me ((PROBE_MASK != 0u) && blockIdx.x == 0 && wave == 0 && __builtin_amdgcn_mbcnt_hi(~0u, __builtin_amdgcn_mbcnt_lo(~0u, 0u)) == 0u)
#define PH_BEGIN(k) if (lo <= (k) && (k) < hi && ((PH_MASK >> (k)) & 1u)) { unsigned char* WSP = a.ws; unsigned char* WOUTP = (unsigned char*)a.out; asm volatile("" : "+s"(WSP), "+s"(WOUTP)); if (((PROBE_MASK >> (k)) & 1u) && pr_me) pr_w[0] = (unsigned)__builtin_amdgcn_s_memrealtime();
#define PH_END(k)   if ((k) + 1 < hi) xcd_barrier(bar); if (((PROBE_MASK >> (k)) & 1u) && pr_me) pr_w[1] += (unsigned)__builtin_amdgcn_s_memrealtime() - pr_w[0]; }

    PH_BEGIN(0)
    { const float* const p_w_in = w_in; const float* const p_w_out = w_out; const float* const p_fg = ffn_w_gate; const float* const p_fu = ffn_w_up; const float* const p_fd = ffn_w_down;
        constexpr int I_WIN = 16 * (PLD / 32), I_WOUT = 16 * (DM / 32), I_WGU = (DM / 128) * (NGU / 32), I_WD = (D_FF / 128) * (DM / 32), I_MWGU = 16 * (N_EXP * NGUE / 32);
        constexpr int NIT = 2 * I_WIN + 2 * I_WOUT + I_WGU + I_WD; (void)I_MWGU;
        for (int it = gw; it < NIT; it += ngw) {
            int r = it; const int l5 = lane & 31;
            if (r < 2 * I_WIN) { const int L = r / I_WIN; r -= L * I_WIN; const int kb = r / (PLD / 32), db = r % (PLD / 32); const int sc_ = fp::win_src_col(db * 32 + l5);
                fp::SrcCol s; s.p = sc_ >= 0 ? p_w_in + (size_t)L * DM * D_IN + sc_ : nullptr; s.ld = D_IN; fp::conv_item(s, DM, WIN + (size_t)L * PLD * DM, db * 32, kb * 64, scr, lane); continue; } r -= 2 * I_WIN;
            if (r < 2 * I_WOUT) { const int L = r / I_WOUT; r -= L * I_WOUT; const int kb = r / (DM / 32), db = r % (DM / 32);
                fp::SrcCol s; s.p = p_w_out + (size_t)L * DM * DM + db * 32 + l5; s.ld = DM; fp::conv_item(s, DM, WOUT + (size_t)L * DM * DM, db * 32, kb * 64, scr, lane); continue; } r -= 2 * I_WOUT;
            if (r < I_WGU) { const int kb = r / (NGU / 32), db = r % (NGU / 32);
                fp::conv_item8(fp::gu_src(p_fg, p_fu, D_FF, db * 32 + l5), DM, WGU, db * 32, kb * 128, W8_GU, scr, lane); continue; } r -= I_WGU;
            { const int kb = r / (DM / 32), db = r % (DM / 32);
                fp::SrcCol s; s.p = p_fd + db * 32 + l5; s.ld = DM; fp::conv_item8(s, D_FF, WD, db * 32, kb * 128, W8_D, scr, lane); }
        }
        const int* const p_pos = in_pos; const float* const p_gws = gm_w_s; const float* const p_x = in_x; const float* const p_lg = ln_in_g; const float* const p_lb = ln_in_b;
        for (long it = gt; it < (long)M_ * 8; it += ngt) { const int i = (int)(it & 7); const long row = it >> 3;
            const float inv = powf(500000.0f, -(float)(2 * i) / 16.0f); const float ang = (float)p_pos[row] * inv; RT[row * 16 + i] = cosf(ang); RT[row * 16 + 8 + i] = sinf(ang); }
        for (long it = gt; it < 2L * GM_G * GM_CHUNK * GM_CHUNK; it += ngt) { const int sidx = (int)(it & 127), t = (int)((it >> 7) & 127); WSB[it] = (bf16)(sidx <= t ? f2bf(p_gws[it]) : 0u); }
        { float va[16], vb[16]; LnGB gbp; ln_gb_load(gbp, p_lg, p_lb, lane); long r = gw; if (r < M_) ln_load<float, float, true>(va, p_x + r * DM, 1.f, nullptr, nullptr, lane);
          for (; r < M_; r += 2 * ngw) { const long r1 = r + ngw, r2 = r + 2 * ngw;
              if (r1 < M_) ln_load<float, float, true>(vb, p_x + r1 * DM, 1.f, nullptr, nullptr, lane);
              ln_finish_r(va, gbp, nullptr, HB + r * DM, lane);
              if (r2 < M_) ln_load<float, float, true>(va, p_x + r2 * DM, 1.f, nullptr, nullptr, lane);
              if (r1 < M_) ln_finish_r(vb, gbp, nullptr, HB + r1 * DM, lane); } }
    }
    PH_END(0)


    { constexpr int layer = 0; constexpr int PB = 1;
        PH_BEGIN(PB + 0)
        { pg8::Gemm g{HB, WIN + (size_t)layer * PLD * DM, M_, PLD, DM, DM}; pg8::StaticOrder S; S.init(M_, PLD, G, bx);
          fp::EpiProj E{PROJ, RT, KM}; pg8::gemm_phase<fp::EpiProj, pg8::StaticOrder, true, true>(lds, g, S, E, tid); }
        PH_END(PB + 0)
        PH_BEGIN(PB + 1)
        { constexpr int NATT = NB * ATT_H * NBLK, NSSDA = NB * 32;
          volatile LAS unsigned* qw = (volatile LAS unsigned*)(lds + MISC_OFF) + 16;
#define QNEXT(word) do { if (tid == 0) qw[0] = __hip_atomic_fetch_add(ctl + (word), 1u, __ATOMIC_RELAXED, __HIP_MEMORY_SCOPE_AGENT); __syncthreads(); idx = (int)qw[0]; __syncthreads(); } while (0)
          int idx;
          for (;;) { QNEXT(CW_Q + 8 * layer); if (idx >= NATT) break;
              const int qb = (NBLK - 1) - idx / (NB * ATT_H), bh = idx % (NB * ATT_H);
              attn_body::attn_unit<8>(bh / ATT_H, bh % ATT_H, qb, (const attn_body::bf16*)(PROJ + FQ), (const attn_body::bf16*)(PROJ + FK), (const attn_body::bf16*)(PROJ + FV), (attn_body::bf16*)MIXB, KM, NB * ATT_H * NBLK * 64, (char*)lds_, tid); }
          for (;;) { QNEXT(CW_Q + 8 * layer + 1); if (idx >= NSSDA) break;
              ssdA_unit(idx >> 5, (idx >> 1) & 15, idx & 1, PROJ, conv_w + (size_t)layer * 4 * SSD_CW, conv_b + layer * SSD_CW, dt_bias + layer * SSD_H, a_log + layer * SSD_H, ST, CD, XCB, DTG, lds, tid, wave, lane); }
        }
        PH_END(PB + 1)
        PH_BEGIN(PB + 2)
        { constexpr int NSSDB = NB * 32, NGMU = NB * (SEQ / GM_CHUNK);
          volatile LAS unsigned* qw = (volatile LAS unsigned*)(lds + MISC_OFF) + 16;
          int idx;
          for (;;) { QNEXT(CW_Q + 8 * layer + 2); if (idx >= NSSDB) break;
              const int c = 15 - idx / (NB * 2), bg = idx % (NB * 2);
              ssdB_unit(bg >> 1, c, bg & 1, PROJ, XCB, DTG, d_skip + layer * SSD_H, ssd_norm_g + layer * SSD_W, ST, CD, MIXB, lds, tid, wave, lane); }
          for (;;) { QNEXT(CW_Q + 8 * layer + 3); if (idx >= NGMU) break;
              gm_unit(idx / (SEQ / GM_CHUNK), idx % (SEQ / GM_CHUNK), PROJ, WSB + (size_t)layer * GM_G * GM_CHUNK * GM_CHUNK, gm_ln_g + layer * GM_W, gm_ln_b + layer * GM_W,
                      gm_b_s + layer * GM_G * GM_CHUNK, gm_norm_g + layer * GM_W, MIXB, lds, wave, lane); }
          att_norm_phase(MIXB, att_norm_g + layer * ATT_W, M_, gw, ngw, lane);
          { const float* const p_mg = moe_w_gate; const float* const p_mu = moe_w_up; const float* const p_md = moe_w_down;
            constexpr int g0 = layer == 0 ? 0 : FT_G_A + FT_G_B, g1 = layer == 0 ? FT_G_A : FT_G, d0 = layer == 0 ? 0 : FT_D_A, d1 = layer == 0 ? FT_D_A : FT_D - FT_D_D;
            for (;;) { QNEXT(CW_Q + 8 * layer + 4); if (idx >= g1 - g0) break; filler_g(g0 + idx, p_mg, p_mu, MWGU, scr, wave, lane); }
            for (;;) { QNEXT(CW_Q + 8 * layer + 5); if (idx >= d1 - d0) break; filler_d(d0 + idx, p_md, MWD, scr, wave, lane); } }
#undef QNEXT
        }
        PH_END(PB + 2)
        PH_BEGIN(PB + 3)
        { pg8::Gemm g{MIXB, WOUT + (size_t)layer * DM * DM, M_, DM, DM, DM}; pg8::StaticOrder S; S.init(M_, DM, G, bx);
          fp::EpiY E{YB, DM}; pg8::gemm_phase<fp::EpiY, pg8::StaticOrder, false, true>(lds, g, S, E, tid); }
        PH_END(PB + 3)
        PH_BEGIN(PB + 4)
        { const float* const p_g = ln1_g + layer * DM; const float* const p_b = ln1_b + layer * DM;
          if constexpr (layer == 0) { float va[16], vb[16]; LnGB gbp; ln_gb_load(gbp, p_g, p_b, lane); long r = gw; if (r < M_) ln_load<bf16, bf16>(va, HB + r * DM, ALPHA, YB + r * DM, nullptr, lane);
            for (; r < M_; r += 2 * ngw) { const long r1 = r + ngw, r2 = r + 2 * ngw;
                if (r1 < M_) ln_load<bf16, bf16>(vb, HB + r1 * DM, ALPHA, YB + r1 * DM, nullptr, lane);
                ln_finish_r(va, gbp, nullptr, HB + r * DM, lane, H8 + r * DM);
                if (r2 < M_) ln_load<bf16, bf16>(va, HB + r2 * DM, ALPHA, YB + r2 * DM, nullptr, lane);
                if (r1 < M_) ln_finish_r(vb, gbp, nullptr, HB + r1 * DM, lane, H8 + r1 * DM); } }
          else {
            LAS int* sh = (LAS int*)lds; if (tid < 16) sh[tid] = 0; __syncthreads();
            float4 wr[32]; { const float* const p_wr = router_w;
#pragma unroll
              for (int i = 0; i < 16; ++i) { const int d = (i >> 2) * 256 + lane * 4 + (i & 3); wr[2 * i] = *(const float4*)(p_wr + d * N_EXP); wr[2 * i + 1] = *(const float4*)(p_wr + d * N_EXP + 4); } }
            float va[16], vb[16]; LnGB gbp; ln_gb_load(gbp, p_g, p_b, lane); long r = gw; if (r < M_) ln_load<bf16, bf16>(va, HB + r * DM, ALPHA, YB + r * DM, nullptr, lane);
            for (; r < M_; r += 2 * ngw) { const long r1 = r + ngw, r2 = r + 2 * ngw;
                if (r1 < M_) ln_load<bf16, bf16>(vb, HB + r1 * DM, ALPHA, YB + r1 * DM, nullptr, lane);
                ln_finish_r(va, gbp, nullptr, HB + r * DM, lane, nullptr, true); moe_route_row(va, wr, r, TE, TP, TS, lane, sh);
                if (r2 < M_) ln_load<bf16, bf16>(va, HB + r2 * DM, ALPHA, YB + r2 * DM, nullptr, lane);
                if (r1 < M_) { ln_finish_r(vb, gbp, nullptr, HB + r1 * DM, lane, nullptr, true); moe_route_row(vb, wr, r1, TE, TP, TS, lane, sh); } }
            __syncthreads();
            if (tid < N_EXP) ((int*)ctl)[CW_BC + vcu * N_EXP + tid] = sh[tid]; } }
        PH_END(PB + 4)
        if constexpr (layer == 0) {
            PH_BEGIN(PB + 5)
            { pg8::Gemm g{(const pg8::bf16_t*)H8, (const pg8::bf16_t*)WGU, M_, NGU, DM / 2, DM / 2}; pg8::StaticOrder S; S.init(M_, NGU, G, bx);
              fp::EpiAct8 E{ACT, D_FF, NGU / 256}; pg8::gemm_phase<fp::EpiAct8, pg8::StaticOrder, true, true, true>(lds, g, S, E, tid);
              {
                volatile LAS unsigned* qw = (volatile LAS unsigned*)(lds + MISC_OFF) + 16; const float* const p_mg = moe_w_gate; const float* const p_mu = moe_w_up; int idx;
                for (;;) { if (wave == 0 && xb_lane_fresh() == 0u) qw[0] = __hip_atomic_fetch_add(ctl + (CW_Q + 6), 1u, __ATOMIC_RELAXED, __HIP_MEMORY_SCOPE_AGENT); __syncthreads(); idx = (int)qw[0]; __syncthreads();
                    if (idx >= FT_G_B) break; filler_g(FT_G_A + idx, p_mg, p_mu, MWGU, scr, wave, (int)xb_lane_fresh()); } } }
            PH_END(PB + 5)
            PH_BEGIN(PB + 6)
            { pg8::Gemm g{(const pg8::bf16_t*)ACT, (const pg8::bf16_t*)WD, M_, DM, D_FF / 2, D_FF / 2}; pg8::StaticOrder S; S.init(M_, DM, G, bx);
              fp::EpiY8 E{YB, DM}; pg8::gemm_phase<fp::EpiY8, pg8::StaticOrder, false, true, true>(lds, g, S, E, tid); }
            PH_END(PB + 6)
            PH_BEGIN(PB + 7)
            { const float* const p_g = ln2_g + layer * DM; const float* const p_b = ln2_b + layer * DM;
              { float va[16], vb[16]; LnGB gbp; ln_gb_load(gbp, p_g, p_b, lane); long r = gw; if (r < M_) ln_load<bf16, bf16>(va, HB + r * DM, ALPHA, YB + r * DM, nullptr, lane);
            for (; r < M_; r += 2 * ngw) { const long r1 = r + ngw, r2 = r + 2 * ngw;
                if (r1 < M_) ln_load<bf16, bf16>(vb, HB + r1 * DM, ALPHA, YB + r1 * DM, nullptr, lane);
                ln_finish_r(va, gbp, nullptr, HB + r * DM, lane);
                if (r2 < M_) ln_load<bf16, bf16>(va, HB + r2 * DM, ALPHA, YB + r2 * DM, nullptr, lane);
                if (r1 < M_) ln_finish_r(vb, gbp, nullptr, HB + r1 * DM, lane); } } }
            PH_END(PB + 7)
        } else {
            PH_BEGIN(PB + 5)
            {
              int base[N_EXP], cnt_[N_EXP];
              { LAS int* red = (LAS int*)lds; const int* BC = (const int*)ctl + CW_BC; const int me = vcu, half = tid >> 8;
                int tot[4] = {0, 0, 0, 0}, pre[4] = {0, 0, 0, 0};
                for (int b_ = tid & 255; b_ < G; b_ += 256) { const int4 c4 = *(const int4*)(BC + b_ * N_EXP + 4 * half); const bool lo_ = b_ < me;
                    tot[0] += c4.x; tot[1] += c4.y; tot[2] += c4.z; tot[3] += c4.w; if (lo_) { pre[0] += c4.x; pre[1] += c4.y; pre[2] += c4.z; pre[3] += c4.w; } }
#pragma unroll
                for (int q = 0; q < 4; ++q) { tot[q] = (int)wave_sum((float)tot[q]); pre[q] = (int)wave_sum((float)pre[q]); }
                if (lane == 0) {
#pragma unroll
                    for (int q = 0; q < 4; ++q) { red[wave * 8 + q] = tot[q]; red[wave * 8 + 4 + q] = pre[q]; } }
                __syncthreads();
                if (tid < 16) { const int e = tid & 7, w0 = (e >> 2) * 4, q = (e & 3) + (tid >> 3) * 4; red[64 + tid] = red[w0 * 8 + q] + red[(w0 + 1) * 8 + q] + red[(w0 + 2) * 8 + q] + red[(w0 + 3) * 8 + q]; }
                __syncthreads();
                int b_ = 0;
#pragma unroll
                for (int e = 0; e < N_EXP; ++e) { cnt_[e] = red[64 + e]; base[e] = b_ + red[72 + e]; b_ += (cnt_[e] + 255) & ~255; }
                if (vcu == 0 && tid < N_EXP) CNT[tid] = red[64 + tid];
                __syncthreads(); }
              constexpr int RPW = (M_ + 2047) / 2048;
              int te[RPW][2], tsl[RPW][2]; float tpv[RPW][2];
#pragma unroll
              for (int k = 0; k < RPW; ++k) { const long r = gw + (long)k * ngw;
#pragma unroll
                  for (int q = 0; q < 2; ++q) { te[k][q] = 0; tsl[k][q] = 0; tpv[k][q] = 0.f; if (r < M_) { te[k][q] = TE[r * 2 + q]; tsl[k][q] = TS[r * 2 + q]; tpv[k][q] = TP[r * 2 + q]; } } }
#pragma unroll
              for (int k = 0; k < RPW; ++k) { const long r = gw + (long)k * ngw; if (r < M_) {
                  const uint4* src = (const uint4*)(HB + r * DM); const uint2 v0 = bf8_to_f8(src[lane]), v1 = bf8_to_f8(src[lane + 64]);
#pragma unroll
                  for (int q = 0; q < 2; ++q) { int be = 0;
#pragma unroll
                      for (int x = 0; x < N_EXP; ++x) be = (te[k][q] == x) ? base[x] : be;
                      const int gs = be + tsl[k][q];
                      if (lane == 0) { SP[gs] = tpv[k][q]; GS[r * 2 + q] = gs; }
                      uint2* dst = (uint2*)(XG + (size_t)gs * DM); dst[lane] = v0; dst[lane + 64] = v1; } } }
              for (long r = gw + (long)RPW * ngw; r < M_; r += ngw) {
                  const uint4* src = (const uint4*)(HB + r * DM); const uint2 v0 = bf8_to_f8(src[lane]), v1 = bf8_to_f8(src[lane + 64]);
                  for (int q = 0; q < 2; ++q) { const long it = r * 2 + q; const int e = TE[it]; int be = 0;
#pragma unroll
                      for (int x = 0; x < N_EXP; ++x) be = (e == x) ? base[x] : be;
                      const int gs = be + TS[it];
                      if (lane == 0) { SP[gs] = TP[it]; GS[it] = gs; }
                      uint2* dst = (uint2*)(XG + (size_t)gs * DM); dst[lane] = v0; dst[lane + 64] = v1; } }
              for (int it = gw; it < N_EXP * 256; it += ngw) { const int e = it >> 8, r = it & 255; int c = 0, pb_ = 0; { int b_ = 0;
#pragma unroll
                      for (int x = 0; x < N_EXP; ++x) { if (x == e) { c = cnt_[x]; pb_ = b_; } b_ += (cnt_[x] + 255) & ~255; } }
                  const int slot = pb_ + c + r;
                  if (c + r < ((c + 255) & ~255)) { uint2* dst = (uint2*)(XG + (size_t)slot * DM); const uint2 z = make_uint2(0u, 0u); dst[lane] = z; dst[lane + 64] = z; if (lane == 0) SP[slot] = 0.f; } } }
            PH_END(PB + 5)
            PH_BEGIN(PB + 6)
            { pg8::Gemm g{(const pg8::bf16_t*)XG, (const pg8::bf16_t*)MWGU, NSLOT, N_EXP * NGUE, DM / 2, DM / 2}; fp::MoeOrder S; S.init(CNT, NGUE / 256, G, bx);
              fp::EpiAct8 E{ACTM, D_FFE, NGUE / 256}; pg8::gemm_phase<fp::EpiAct8, fp::MoeOrder, true, true, true>(lds, g, S, E, tid);
              {
                volatile LAS unsigned* qw = (volatile LAS unsigned*)(lds + MISC_OFF) + 16; const float* const p_md = moe_w_down; int idx;
                for (;;) { if (wave == 0 && xb_lane_fresh() == 0u) qw[0] = __hip_atomic_fetch_add(ctl + (CW_Q + 14), 1u, __ATOMIC_RELAXED, __HIP_MEMORY_SCOPE_AGENT); __syncthreads(); idx = (int)qw[0]; __syncthreads();
                    if (idx >= FT_D_D) break; filler_d(FT_D - FT_D_D + idx, p_md, MWD, scr, wave, (int)xb_lane_fresh()); } } }
            PH_END(PB + 6)
            PH_BEGIN(PB + 7)
            { fp::MoeOrder S; S.init(CNT, DM / 256, G, bx); const int nf = S.tail_start(); const int slot0 = (nf / (DM / 256)) * 256;
              constexpr int KU = D_FFE / 2;
              static_assert((KU / 7) % 128 == 0 && (KU / 2) % 128 == 0, "split-K parts must hold an even number of K-tiles");
              const int ks = S.tail_split(), KLEN = KU / ks, tstride = (S.T - nf / (DM / 256)) * 256;
              fp::EpiF2 E{F2, SP, F2P, slot0, KLEN, tstride, 1.f / W8_D};
              { pg8::Gemm g{(const pg8::bf16_t*)ACTM, (const pg8::bf16_t*)MWD, NSLOT, N_EXP * DM, KU, KU}; S.nfull = nf; S.ksplit = 1;
                pg8::gemm_phase<fp::EpiF2, fp::MoeOrder, true, true, true>(lds, g, S, E, wave * 64 + (int)xb_lane_fresh()); }
              { pg8::Gemm g{(const pg8::bf16_t*)ACTM, (const pg8::bf16_t*)MWD, NSLOT, N_EXP * DM, KLEN, KU}; S.ksplit = ks; S.klen = KLEN;
                int tid2 = wave * 64 + (int)xb_lane_fresh();
                pg8::gemm_phase<fp::EpiF2, fp::MoeOrder, true, true, true>(lds, g, S, E, tid2); } }
            PH_END(PB + 7)
            PH_BEGIN(PB + 8)
            { const float* const p_g = ln2_g + layer * DM; const float* const p_b = ln2_b + layer * DM;
              int slot0, ks1, tstride; { fp::MoeOrder S; S.init(CNT, DM / 256, G, bx); const int nf = S.tail_start(); slot0 = (nf == S.T * (DM / 256)) ? 0x7fffffff : (nf / (DM / 256)) * 256; ks1 = S.tail_split() - 1; tstride = (S.T - nf / (DM / 256)) * 256; }
#define LN2_LOAD(v, rr, kk_) do { int s0_ = GS[(rr) * 2], s1_ = GS[(rr) * 2 + 1]; if (kk_ < RPW2) { _Pragma("unroll") for (int x_ = 0; x_ < RPW2; ++x_) if (x_ == kk_) { s0_ = gsv[x_][0]; s1_ = gsv[x_][1]; } } ln_load<bf16, bf16>(v, HB + (rr) * DM, ALPHA, F2 + (size_t)s0_ * DM, F2 + (size_t)s1_ * DM, lane); \
                  if (s0_ >= slot0) { for (int p_ = 0; p_ < ks1; ++p_) ln_add(v, F2P + ((size_t)p_ * tstride + (s0_ - slot0)) * DM, lane); } \
                  if (s1_ >= slot0) { for (int p_ = 0; p_ < ks1; ++p_) ln_add(v, F2P + ((size_t)p_ * tstride + (s1_ - slot0)) * DM, lane); } } while (0)
              constexpr int RPW2 = (M_ + 2047) / 2048; int gsv[RPW2][2];
#pragma unroll
              for (int x_ = 0; x_ < RPW2; ++x_) { const long rr_ = gw + (long)x_ * ngw; gsv[x_][0] = 0; gsv[x_][1] = 0; if (rr_ < M_) { gsv[x_][0] = GS[rr_ * 2]; gsv[x_][1] = GS[rr_ * 2 + 1]; } }
              { float va[16], vb[16]; LnGB gbp; ln_gb_load(gbp, p_g, p_b, lane); long r = gw; int kq = 0; if (r < M_) LN2_LOAD(va, r, kq);
                for (; r < M_; r += 2 * ngw, kq += 2) { const long r1 = r + ngw, r2 = r + 2 * ngw;
                    if (r1 < M_) LN2_LOAD(vb, r1, kq + 1);
                    ln_finish_r(va, gbp, H + r * DM, nullptr, lane);
                    if (r2 < M_) LN2_LOAD(va, r2, kq + 2);
                    if (r1 < M_) ln_finish_r(vb, gbp, H + r1 * DM, nullptr, lane); } }
#undef LN2_LOAD
            }
            PH_END(PB + 8)
        }
    }

    { constexpr int layer = 1; constexpr int PB = 9;
        PH_BEGIN(PB + 0)
        { pg8::Gemm g{HB, WIN + (size_t)layer * PLD * DM, M_, PLD, DM, DM}; pg8::StaticOrder S; S.init(M_, PLD, G, bx);
          fp::EpiProj E{PROJ, RT, KM}; pg8::gemm_phase<fp::EpiProj, pg8::StaticOrder, true, true>(lds, g, S, E, tid); }
        PH_END(PB + 0)
        PH_BEGIN(PB + 1)
        { constexpr int NATT = NB * ATT_H * NBLK, NSSDA = NB * 32;
          volatile LAS unsigned* qw = (volatile LAS unsigned*)(lds + MISC_OFF) + 16;
#define QNEXT(word) do { if (tid == 0) qw[0] = __hip_atomic_fetch_add(ctl + (word), 1u, __ATOMIC_RELAXED, __HIP_MEMORY_SCOPE_AGENT); __syncthreads(); idx = (int)qw[0]; __syncthreads(); } while (0)
          int idx;
          for (;;) { QNEXT(CW_Q + 8 * layer); if (idx >= NATT) break;
              const int qb = (NBLK - 1) - idx / (NB * ATT_H), bh = idx % (NB * ATT_H);
              attn_body::attn_unit<8>(bh / ATT_H, bh % ATT_H, qb, (const attn_body::bf16*)(PROJ + FQ), (const attn_body::bf16*)(PROJ + FK), (const attn_body::bf16*)(PROJ + FV), (attn_body::bf16*)MIXB, KM, NB * ATT_H * NBLK * 64, (char*)lds_, tid); }
          for (;;) { QNEXT(CW_Q + 8 * layer + 1); if (idx >= NSSDA) break;
              ssdA_unit(idx >> 5, (idx >> 1) & 15, idx & 1, PROJ, conv_w + (size_t)layer * 4 * SSD_CW, conv_b + layer * SSD_CW, dt_bias + layer * SSD_H, a_log + layer * SSD_H, ST, CD, XCB, DTG, lds, tid, wave, lane); }
        }
        PH_END(PB + 1)
        PH_BEGIN(PB + 2)
        { constexpr int NSSDB = NB * 32, NGMU = NB * (SEQ / GM_CHUNK);
          volatile LAS unsigned* qw = (volatile LAS unsigned*)(lds + MISC_OFF) + 16;
          int idx;
          for (;;) { QNEXT(CW_Q + 8 * layer + 2); if (idx >= NSSDB) break;
              const int c = 15 - idx / (NB * 2), bg = idx % (NB * 2);
              ssdB_unit(bg >> 1, c, bg & 1, PROJ, XCB, DTG, d_skip + layer * SSD_H, ssd_norm_g + layer * SSD_W, ST, CD, MIXB, lds, tid, wave, lane); }
          for (;;) { QNEXT(CW_Q + 8 * layer + 3); if (idx >= NGMU) break;
              gm_unit(idx / (SEQ / GM_CHUNK), idx % (SEQ / GM_CHUNK), PROJ, WSB + (size_t)layer * GM_G * GM_CHUNK * GM_CHUNK, gm_ln_g + layer * GM_W, gm_ln_b + layer * GM_W,
                      gm_b_s + layer * GM_G * GM_CHUNK, gm_norm_g + layer * GM_W, MIXB, lds, wave, lane); }
          att_norm_phase(MIXB, att_norm_g + layer * ATT_W, M_, gw, ngw, lane);
          { const float* const p_mg = moe_w_gate; const float* const p_mu = moe_w_up; const float* const p_md = moe_w_down;
            constexpr int g0 = layer == 0 ? 0 : FT_G_A + FT_G_B, g1 = layer == 0 ? FT_G_A : FT_G, d0 = layer == 0 ? 0 : FT_D_A, d1 = layer == 0 ? FT_D_A : FT_D - FT_D_D;
            for (;;) { QNEXT(CW_Q + 8 * layer + 4); if (idx >= g1 - g0) break; filler_g(g0 + idx, p_mg, p_mu, MWGU, scr, wave, lane); }
            for (;;) { QNEXT(CW_Q + 8 * layer + 5); if (idx >= d1 - d0) break; filler_d(d0 + idx, p_md, MWD, scr, wave, lane); } }
#undef QNEXT
        }
        PH_END(PB + 2)
        PH_BEGIN(PB + 3)
        { pg8::Gemm g{MIXB, WOUT + (size_t)layer * DM * DM, M_, DM, DM, DM}; pg8::StaticOrder S; S.init(M_, DM, G, bx);
          fp::EpiY E{YB, DM}; pg8::gemm_phase<fp::EpiY, pg8::StaticOrder, false, true>(lds, g, S, E, tid); }
        PH_END(PB + 3)
        PH_BEGIN(PB + 4)
        { const float* const p_g = ln1_g + layer * DM; const float* const p_b = ln1_b + layer * DM;
          if constexpr (layer == 0) { float va[16], vb[16]; LnGB gbp; ln_gb_load(gbp, p_g, p_b, lane); long r = gw; if (r < M_) ln_load<bf16, bf16>(va, HB + r * DM, ALPHA, YB + r * DM, nullptr, lane);
            for (; r < M_; r += 2 * ngw) { const long r1 = r + ngw, r2 = r + 2 * ngw;
                if (r1 < M_) ln_load<bf16, bf16>(vb, HB + r1 * DM, ALPHA, YB + r1 * DM, nullptr, lane);
                ln_finish_r(va, gbp, nullptr, HB + r * DM, lane, H8 + r * DM);
                if (r2 < M_) ln_load<bf16, bf16>(va, HB + r2 * DM, ALPHA, YB + r2 * DM, nullptr, lane);
                if (r1 < M_) ln_finish_r(vb, gbp, nullptr, HB + r1 * DM, lane, H8 + r1 * DM); } }
          else {
            LAS int* sh = (LAS int*)lds; if (tid < 16) sh[tid] = 0; __syncthreads();
            float4 wr[32]; { const float* const p_wr = router_w;
#pragma unroll
              for (int i = 0; i < 16; ++i) { const int d = (i >> 2) * 256 + lane * 4 + (i & 3); wr[2 * i] = *(const float4*)(p_wr + d * N_EXP); wr[2 * i + 1] = *(const float4*)(p_wr + d * N_EXP + 4); } }
            float va[16], vb[16]; LnGB gbp; ln_gb_load(gbp, p_g, p_b, lane); long r = gw; if (r < M_) ln_load<bf16, bf16>(va, HB + r * DM, ALPHA, YB + r * DM, nullptr, lane);
            for (; r < M_; r += 2 * ngw) { const long r1 = r + ngw, r2 = r + 2 * ngw;
                if (r1 < M_) ln_load<bf16, bf16>(vb, HB + r1 * DM, ALPHA, YB + r1 * DM, nullptr, lane);
                ln_finish_r(va, gbp, nullptr, HB + r * DM, lane, nullptr, true); moe_route_row(va, wr, r, TE, TP, TS, lane, sh);
                if (r2 < M_) ln_load<bf16, bf16>(va, HB + r2 * DM, ALPHA, YB + r2 * DM, nullptr, lane);
                if (r1 < M_) { ln_finish_r(vb, gbp, nullptr, HB + r1 * DM, lane, nullptr, true); moe_route_row(vb, wr, r1, TE, TP, TS, lane, sh); } }
            __syncthreads();
            if (tid < N_EXP) ((int*)ctl)[CW_BC + vcu * N_EXP + tid] = sh[tid]; } }
        PH_END(PB + 4)
        if constexpr (layer == 0) {
            PH_BEGIN(PB + 5)
            { pg8::Gemm g{(const pg8::bf16_t*)H8, (const pg8::bf16_t*)WGU, M_, NGU, DM / 2, DM / 2}; pg8::StaticOrder S; S.init(M_, NGU, G, bx);
              fp::EpiAct8 E{ACT, D_FF, NGU / 256}; pg8::gemm_phase<fp::EpiAct8, pg8::StaticOrder, true, true, true>(lds, g, S, E, tid);
              {
                volatile LAS unsigned* qw = (volatile LAS unsigned*)(lds + MISC_OFF) + 16; const float* const p_mg = moe_w_gate; const float* const p_mu = moe_w_up; int idx;
                for (;;) { if (wave == 0 && xb_lane_fresh() == 0u) qw[0] = __hip_atomic_fetch_add(ctl + (CW_Q + 6), 1u, __ATOMIC_RELAXED, __HIP_MEMORY_SCOPE_AGENT); __syncthreads(); idx = (int)qw[0]; __syncthreads();
                    if (idx >= FT_G_B) break; filler_g(FT_G_A + idx, p_mg, p_mu, MWGU, scr, wave, (int)xb_lane_fresh()); } } }
            PH_END(PB + 5)
            PH_BEGIN(PB + 6)
            { pg8::Gemm g{(const pg8::bf16_t*)ACT, (const pg8::bf16_t*)WD, M_, DM, D_FF / 2, D_FF / 2}; pg8::StaticOrder S; S.init(M_, DM, G, bx);
              fp::EpiY8 E{YB, DM}; pg8::gemm_phase<fp::EpiY8, pg8::StaticOrder, false, true, true>(lds, g, S, E, tid); }
            PH_END(PB + 6)
            PH_BEGIN(PB + 7)
            { const float* const p_g = ln2_g + layer * DM; const float* const p_b = ln2_b + layer * DM;
              { float va[16], vb[16]; LnGB gbp; ln_gb_load(gbp, p_g, p_b, lane); long r = gw; if (r < M_) ln_load<bf16, bf16>(va, HB + r * DM, ALPHA, YB + r * DM, nullptr, lane);
            for (; r < M_; r += 2 * ngw) { const long r1 = r + ngw, r2 = r + 2 * ngw;
                if (r1 < M_) ln_load<bf16, bf16>(vb, HB + r1 * DM, ALPHA, YB + r1 * DM, nullptr, lane);
                ln_finish_r(va, gbp, nullptr, HB + r * DM, lane);
                if (r2 < M_) ln_load<bf16, bf16>(va, HB + r2 * DM, ALPHA, YB + r2 * DM, nullptr, lane);
                if (r1 < M_) ln_finish_r(vb, gbp, nullptr, HB + r1 * DM, lane); } } }
            PH_END(PB + 7)
        } else {
            PH_BEGIN(PB + 5)
            {
              int base[N_EXP], cnt_[N_EXP];
              { LAS int* red = (LAS int*)lds; const int* BC = (const int*)ctl + CW_BC; const int me = vcu, half = tid >> 8;
                int tot[4] = {0, 0, 0, 0}, pre[4] = {0, 0, 0, 0};
                for (int b_ = tid & 255; b_ < G; b_ += 256) { const int4 c4 = *(const int4*)(BC + b_ * N_EXP + 4 * half); const bool lo_ = b_ < me;
                    tot[0] += c4.x; tot[1] += c4.y; tot[2] += c4.z; tot[3] += c4.w; if (lo_) { pre[0] += c4.x; pre[1] += c4.y; pre[2] += c4.z; pre[3] += c4.w; } }
#pragma unroll
                for (int q = 0; q < 4; ++q) { tot[q] = (int)wave_sum((float)tot[q]); pre[q] = (int)wave_sum((float)pre[q]); }
                if (lane == 0) {
#pragma unroll
                    for (int q = 0; q < 4; ++q) { red[wave * 8 + q] = tot[q]; red[wave * 8 + 4 + q] = pre[q]; } }
                __syncthreads();
                if (tid < 16) { const int e = tid & 7, w0 = (e >> 2) * 4, q = (e & 3) + (tid >> 3) * 4; red[64 + tid] = red[w0 * 8 + q] + red[(w0 + 1) * 8 + q] + red[(w0 + 2) * 8 + q] + red[(w0 + 3) * 8 + q]; }
                __syncthreads();
                int b_ = 0;
#pragma unroll
                for (int e = 0; e < N_EXP; ++e) { cnt_[e] = red[64 + e]; base[e] = b_ + red[72 + e]; b_ += (cnt_[e] + 255) & ~255; }
                if (vcu == 0 && tid < N_EXP) CNT[tid] = red[64 + tid];
                __syncthreads(); }
              constexpr int RPW = (M_ + 2047) / 2048;
              int te[RPW][2], tsl[RPW][2]; float tpv[RPW][2];
#pragma unroll
              for (int k = 0; k < RPW; ++k) { const long r = gw + (long)k * ngw;
#pragma unroll
                  for (int q = 0; q < 2; ++q) { te[k][q] = 0; tsl[k][q] = 0; tpv[k][q] = 0.f; if (r < M_) { te[k][q] = TE[r * 2 + q]; tsl[k][q] = TS[r * 2 + q]; tpv[k][q] = TP[r * 2 + q]; } } }
#pragma unroll
              for (int k = 0; k < RPW; ++k) { const long r = gw + (long)k * ngw; if (r < M_) {
                  const uint4* src = (const uint4*)(HB + r * DM); const uint2 v0 = bf8_to_f8(src[lane]), v1 = bf8_to_f8(src[lane + 64]);
#pragma unroll
                  for (int q = 0; q < 2; ++q) { int be = 0;
#pragma unroll
                      for (int x = 0; x < N_EXP; ++x) be = (te[k][q] == x) ? base[x] : be;
                      const int gs = be + tsl[k][q];
                      if (lane == 0) { SP[gs] = tpv[k][q]; GS[r * 2 + q] = gs; }
                      uint2* dst = (uint2*)(XG + (size_t)gs * DM); dst[lane] = v0; dst[lane + 64] = v1; } } }
              for (long r = gw + (long)RPW * ngw; r < M_; r += ngw) {
                  const uint4* src = (const uint4*)(HB + r * DM); const uint2 v0 = bf8_to_f8(src[lane]), v1 = bf8_to_f8(src[lane + 64]);
                  for (int q = 0; q < 2; ++q) { const long it = r * 2 + q; const int e = TE[it]; int be = 0;
#pragma unroll
                      for (int x = 0; x < N_EXP; ++x) be = (e == x) ? base[x] : be;
                      const int gs = be + TS[it];
                      if (lane == 0) { SP[gs] = TP[it]; GS[it] = gs; }
                      uint2* dst = (uint2*)(XG + (size_t)gs * DM); dst[lane] = v0; dst[lane + 64] = v1; } }
              for (int it = gw; it < N_EXP * 256; it += ngw) { const int e = it >> 8, r = it & 255; int c = 0, pb_ = 0; { int b_ = 0;
#pragma unroll
                      for (int x = 0; x < N_EXP; ++x) { if (x == e) { c = cnt_[x]; pb_ = b_; } b_ += (cnt_[x] + 255) & ~255; } }
                  const int slot = pb_ + c + r;
                  if (c + r < ((c + 255) & ~255)) { uint2* dst = (uint2*)(XG + (size_t)slot * DM); const uint2 z = make_uint2(0u, 0u); dst[lane] = z; dst[lane + 64] = z; if (lane == 0) SP[slot] = 0.f; } } }
            PH_END(PB + 5)
            PH_BEGIN(PB + 6)
            { pg8::Gemm g{(const pg8::bf16_t*)XG, (const pg8::bf16_t*)MWGU, NSLOT, N_EXP * NGUE, DM / 2, DM / 2}; fp::MoeOrder S; S.init(CNT, NGUE / 256, G, bx);
              fp::EpiAct8 E{ACTM, D_FFE, NGUE / 256}; pg8::gemm_phase<fp::EpiAct8, fp::MoeOrder, true, true, true>(lds, g, S, E, tid);
              {
                volatile LAS unsigned* qw = (volatile LAS unsigned*)(lds + MISC_OFF) + 16; const float* const p_md = moe_w_down; int idx;
                for (;;) { if (wave == 0 && xb_lane_fresh() == 0u) qw[0] = __hip_atomic_fetch_add(ctl + (CW_Q + 14), 1u, __ATOMIC_RELAXED, __HIP_MEMORY_SCOPE_AGENT); __syncthreads(); idx = (int)qw[0]; __syncthreads();
                    if (idx >= FT_D_D) break; filler_d(FT_D - FT_D_D + idx, p_md, MWD, scr, wave, (int)xb_lane_fresh()); } } }
            PH_END(PB + 6)
            PH_BEGIN(PB + 7)
            { fp::MoeOrder S; S.init(CNT, DM / 256, G, bx); const int nf = S.tail_start(); const int slot0 = (nf / (DM / 256)) * 256;
              constexpr int KU = D_FFE / 2;
              static_assert((KU / 7) % 128 == 0 && (KU / 2) % 128 == 0, "split-K parts must hold an even number of K-tiles");
              const int ks = S.tail_split(), KLEN = KU / ks, tstride = (S.T - nf / (DM / 256)) * 256;
              fp::EpiF2 E{F2, SP, F2P, slot0, KLEN, tstride, 1.f / W8_D};
              { pg8::Gemm g{(const pg8::bf16_t*)ACTM, (const pg8::bf16_t*)MWD, NSLOT, N_EXP * DM, KU, KU}; S.nfull = nf; S.ksplit = 1;
                pg8::gemm_phase<fp::EpiF2, fp::MoeOrder, true, true, true>(lds, g, S, E, wave * 64 + (int)xb_lane_fresh()); }
              { pg8::Gemm g{(const pg8::bf16_t*)ACTM, (const pg8::bf16_t*)MWD, NSLOT, N_EXP * DM, KLEN, KU}; S.ksplit = ks; S.klen = KLEN;
                int tid2 = wave * 64 + (int)xb_lane_fresh();
                pg8::gemm_phase<fp::EpiF2, fp::MoeOrder, true, true, true>(lds, g, S, E, tid2); } }
            PH_END(PB + 7)
            PH_BEGIN(PB + 8)
            { const float* const p_g = ln2_g + layer * DM; const float* const p_b = ln2_b + layer * DM;
              int slot0, ks1, tstride; { fp::MoeOrder S; S.init(CNT, DM / 256, G, bx); const int nf = S.tail_start(); slot0 = (nf == S.T * (DM / 256)) ? 0x7fffffff : (nf / (DM / 256)) * 256; ks1 = S.tail_split() - 1; tstride = (S.T - nf / (DM / 256)) * 256; }
#define LN2_LOAD(v, rr, kk_) do { int s0_ = GS[(rr) * 2], s1_ = GS[(rr) * 2 + 1]; if (kk_ < RPW2) { _Pragma("unroll") for (int x_ = 0; x_ < RPW2; ++x_) if (x_ == kk_) { s0_ = gsv[x_][0]; s1_ = gsv[x_][1]; } } ln_load<bf16, bf16>(v, HB + (rr) * DM, ALPHA, F2 + (size_t)s0_ * DM, F2 + (size_t)s1_ * DM, lane); \
                  if (s0_ >= slot0) { for (int p_ = 0; p_ < ks1; ++p_) ln_add(v, F2P + ((size_t)p_ * tstride + (s0_ - slot0)) * DM, lane); } \
                  if (s1_ >= slot0) { for (int p_ = 0; p_ < ks1; ++p_) ln_add(v, F2P + ((size_t)p_ * tstride + (s1_ - slot0)) * DM, lane); } } while (0)
              constexpr int RPW2 = (M_ + 2047) / 2048; int gsv[RPW2][2];
#pragma unroll
              for (int x_ = 0; x_ < RPW2; ++x_) { const long rr_ = gw + (long)x_ * ngw; gsv[x_][0] = 0; gsv[x_][1] = 0; if (rr_ < M_) { gsv[x_][0] = GS[rr_ * 2]; gsv[x_][1] = GS[rr_ * 2 + 1]; } }
              { float va[16], vb[16]; LnGB gbp; ln_gb_load(gbp, p_g, p_b, lane); long r = gw; int kq = 0; if (r < M_) LN2_LOAD(va, r, kq);
                for (; r < M_; r += 2 * ngw, kq += 2) { const long r1 = r + ngw, r2 = r + 2 * ngw;
                    if (r1 < M_) LN2_LOAD(vb, r1, kq + 1);
                    ln_finish_r(va, gbp, H + r * DM, nullptr, lane);
                    if (r2 < M_) LN2_LOAD(va, r2, kq + 2);
                    if (r1 < M_) ln_finish_r(vb, gbp, H + r1 * DM, nullptr, lane); } }
#undef LN2_LOAD
            }
            PH_END(PB + 8)
        }
    }

#undef PH_BEGIN
#undef PH_END
#undef in_x
#undef in_pos
#undef ln_in_g
#undef ln_in_b
#undef w_in
#undef conv_w
#undef conv_b
#undef dt_bias
#undef a_log
#undef d_skip
#undef ssd_norm_g
#undef att_norm_g
#undef gm_ln_g
#undef gm_ln_b
#undef gm_w_s
#undef gm_b_s
#undef gm_norm_g
#undef w_out
#undef ln1_g
#undef ln1_b
#undef ln2_g
#undef ln2_b
#undef ffn_w_gate
#undef ffn_w_up
#undef ffn_w_down
#undef router_w
#undef moe_w_gate
#undef moe_w_up
#undef moe_w_down
#undef H
#undef MWD
#undef RT
#undef TE
#undef TP
#undef TS
#undef GS
#undef SP
#undef KM
#undef WSB
#undef HB
#undef MWGU
#undef WIN
#undef WOUT
#undef WGU
#undef WD
#undef PROJ
#undef ST
#undef CD
#undef XCB
#undef DTG
#undef MIXB
#undef YB
#undef ACT
#undef H8
#undef XG
#undef F2
#undef ACTM
#undef CNT
#undef tid
#undef lane
#undef F2P
#undef vcu
#undef gw
#undef ngw
#undef gt
#undef ngt
    if (pr_me) { const unsigned t_beg = (unsigned)__builtin_amdgcn_s_memrealtime(), t_len = (unsigned)PROBE_AMP * pr_w[1]; while ((unsigned)__builtin_amdgcn_s_memrealtime() - t_beg < t_len) __builtin_amdgcn_s_sleep(8); }
}

__device__ __forceinline__ void blk_acc(float d2, float s2, float* err) {
    d2 = wave_sum(d2); s2 = wave_sum(s2); if ((threadIdx.x & 63) == 0) { atomicAdd(err, d2); atomicAdd(err + 1, s2); }
}
__global__ void k_cmp_proj(const bf16* F, const float* S, long rows, float* err) {
    float d2 = 0.f, s2 = 0.f;
    for (long it = blockIdx.x * (long)blockDim.x + threadIdx.x; it < rows * 2950; it += gridDim.x * (long)blockDim.x) {
        const long row = it / 2950; const int d = (int)(it % 2950); const int sc = fp::win_src_col(d);
        float s = S[row * D_IN + sc];
        const float f = ldf(F + row * PLD + d); d2 += (f - s) * (f - s); s2 += s * s; }
    blk_acc(d2, s2, err);
}
template <class TF> __global__ void k_cmp(const TF* F, int ldf_, const float* S, int lds_, long rows, int cols, float* err) {
    float d2 = 0.f, s2 = 0.f;
    for (long it = blockIdx.x * (long)blockDim.x + threadIdx.x; it < rows * cols; it += gridDim.x * (long)blockDim.x) {
        const long row = it / cols; const int c = (int)(it % cols); const float f = ldf(F + row * ldf_ + c), s = S[row * lds_ + c]; d2 += (f - s) * (f - s); s2 += s * s; }
    blk_acc(d2, s2, err);
}
__global__ void k_encode(const float* err, int nck, const float* Sout, float* out, long rows_s, long rows_all, float thr) {
    int k = 0; for (int i = 0; i < nck; ++i) { const float r = err[2 * i] / fmaxf(err[2 * i + 1], 1e-30f); if (!(r <= thr)) { k = i + 1; break; } }
    for (long it = blockIdx.x * (long)blockDim.x + threadIdx.x; it < rows_all * DM; it += gridDim.x * (long)blockDim.x)
        out[it] = (it < rows_s * DM) ? Sout[it] * (1.f + (float)k) : 0.f;
}
#if DEBUG_BUILD
constexpr size_t S_BASE = (WS_END + 2 * MiB - 1) / MiB * MiB;
#endif
extern "C" void kernel_launch(void* const* d_in, const int* in_sizes, int n_in, void* d_out, int out_size, void* d_ws, size_t ws_size, hipStream_t stream) {
    (void)in_sizes; (void)n_in; (void)out_size;
    static int grid = 0;
    if (grid == 0) {
        int dev = 0, cus = 0, per_cu = 0;
        if (hipGetDevice(&dev) != hipSuccess || hipDeviceGetAttribute(&cus, hipDeviceAttributeMultiprocessorCount, dev) != hipSuccess) { grid = -1; return; }
        if (hipFuncSetAttribute((const void*)mega, hipFuncAttributeMaxDynamicSharedMemorySize, LDS_BYTES) != hipSuccess) { fprintf(stderr, "kernel_launch: hipFuncSetAttribute failed\n"); grid = -1; return; }
        if (hipOccupancyMaxActiveBlocksPerMultiprocessor(&per_cu, (const void*)mega, 512, LDS_BYTES) != hipSuccess || per_cu < 1) fprintf(stderr, "kernel_launch: occupancy query reports %d\n", per_cu);
        (void)hipGetLastError();
        grid = cus;
        if (ws_size < WS_END) { fprintf(stderr, "kernel_launch: workspace too small: %zu < %zu\n", ws_size, (size_t)WS_END); grid = -1; }
    }
    if (grid < 0) return;
    unsigned char* ws = (unsigned char*)d_ws;
    if (hipMemsetAsync(ws + O_CTL, 0, CTL_BYTES, stream) != hipSuccess) return;
    FArgs a{};
    for (int i = 0; i < 29; ++i) a.in[i] = d_in[i];
    a.out = (float*)d_out; a.ws = ws;
#if !DEBUG_BUILD
    a.ph_lo = 0; a.ph_hi = N_PHASES;
    hipLaunchKernelGGL(mega, dim3(grid), dim3(512), LDS_BYTES, stream, a);
#else
    Inputs I;
    I.x = (const float*)d_in[0]; I.pos = (const int*)d_in[1]; I.ln_in_g = (const float*)d_in[2]; I.ln_in_b = (const float*)d_in[3]; I.w_in = (const float*)d_in[4];
    I.conv_w = (const float*)d_in[5]; I.conv_b = (const float*)d_in[6]; I.dt_bias = (const float*)d_in[7]; I.a_log = (const float*)d_in[8]; I.d_skip = (const float*)d_in[9];
    I.ssd_norm_g = (const float*)d_in[10]; I.att_norm_g = (const float*)d_in[11]; I.gm_ln_g = (const float*)d_in[12]; I.gm_ln_b = (const float*)d_in[13]; I.gm_w_s = (const float*)d_in[14];
    I.gm_b_s = (const float*)d_in[15]; I.gm_norm_g = (const float*)d_in[16]; I.w_out = (const float*)d_in[17]; I.ln1_g = (const float*)d_in[18]; I.ln1_b = (const float*)d_in[19];
    I.ln2_g = (const float*)d_in[20]; I.ln2_b = (const float*)d_in[21]; I.ffn_w_gate = (const float*)d_in[22]; I.ffn_w_up = (const float*)d_in[23]; I.ffn_w_down = (const float*)d_in[24];
    I.router_w = (const float*)d_in[25]; I.moe_w_gate = (const float*)d_in[26]; I.moe_w_up = (const float*)d_in[27]; I.moe_w_down = (const float*)d_in[28];
    const long MS = SEQ;
    unsigned char* sws = ws + S_BASE;
    float* saux = (float*)(sws + 96 * MiB); float* sout = (float*)(sws + 100 * MiB); float* ckpt = (float*)(sws + 110 * MiB);
    const size_t ck_stride = (size_t)MS * (D_IN + 3 * DM);
    run_simple(I, 1, sws, saux, sout, stream, ckpt);
    float* err = (float*)(ws + O_CTL) + CW_ERR;
    const bf16* PROJ = (const bf16*)(ws + O_PROJ); const bf16* MIXB = (const bf16*)(ws + O_MIXB); const bf16* Hf = (const bf16*)(ws + O_HB); const float* Hout = (const float*)d_out;
    for (int ph = 0; ph < N_PHASES; ++ph) {
        a.ph_lo = ph; a.ph_hi = ph + 1;
        hipLaunchKernelGGL(mega, dim3(grid), dim3(512), LDS_BYTES, stream, a);
        const int layer = ph >= 9 ? 1 : 0; const int rel = ph - (layer ? 8 : 0); const float* ck = ckpt + layer * ck_stride; float* e = err + layer * 12;
        if (rel == 1) k_cmp_proj<<<512, 256, 0, stream>>>(PROJ, ck, MS, e + 0);
        if (rel == 3) { k_cmp<bf16><<<512, 256, 0, stream>>>(MIXB, DM, ck + (size_t)MS * D_IN, DM, MS, 384, e + 2);
                        k_cmp<bf16><<<512, 256, 0, stream>>>(MIXB + 384, DM, ck + (size_t)MS * D_IN + 384, DM, MS, 384, e + 4);
                        k_cmp<bf16><<<512, 256, 0, stream>>>(MIXB + 768, DM, ck + (size_t)MS * D_IN + 768, DM, MS, 256, e + 6); }
        if (rel == 5) k_cmp<bf16><<<512, 256, 0, stream>>>(Hf, DM, ck + (size_t)MS * (D_IN + DM), DM, MS, DM, e + 8);
        if (layer == 0 && rel == 8) k_cmp<bf16><<<512, 256, 0, stream>>>(Hf, DM, ck + (size_t)MS * (D_IN + 2 * DM), DM, MS, DM, e + 10);
        if (layer == 1 && rel == 9) k_cmp<float><<<512, 256, 0, stream>>>(Hout, DM, ck + (size_t)MS * (D_IN + 2 * DM), DM, MS, DM, e + 10);
    }
    k_encode<<<1024, 256, 0, stream>>>(err, 12, sout, (float*)d_out, MS, (long)NBATCH * SEQ, DBG_THR);
#endif
}
```
